# Optimizing an MI355X kernel written in HIP

```python
import jax, jax.numpy as jnp
from jax import lax
import numpy as np

D_MODEL = 2048
BATCH = 4
SEQ = 4096
DEPTH = 2

CTX_LEN = 256
GRID_W = 64
ROPE_BASE = 10000.0
Q_BLOCK = 128
TOKEN_BLOCK = 128
NORM_EPS = 1e-5
RMS_EPS = 1e-6

MLA_HEADS = 8
MLA_Q_LORA = 512
MLA_KV_LORA = 256
MLA_NOPE = 64
MLA_ROPE = 32
MLA_V = 64
MLA_SCALE = (MLA_NOPE + MLA_ROPE) ** -0.5

RET_HEADS = 8
RET_DK = 32
RET_DV = 64
RET_CHUNK = 128
RET_K_SCALE = RET_DK ** -0.5

GQA_HEADS = 8
GQA_KV_HEADS = 2
GQA_GROUP = GQA_HEADS // GQA_KV_HEADS
GQA_DH = 128
GQA_SCALE = GQA_DH ** -0.5

PEER_HEADS = 8
PEER_DQ = 128
PEER_N_KEYS = 128
PEER_TOPK = 16
PEER_N_EXPERTS = PEER_N_KEYS * PEER_N_KEYS

IN_SPLITS = (MLA_Q_LORA, MLA_KV_LORA, MLA_ROPE,
             RET_HEADS * RET_DK, RET_HEADS * RET_DK, RET_HEADS * RET_DV, RET_HEADS * RET_DV,
             GQA_HEADS * GQA_DH, GQA_KV_HEADS * GQA_DH, GQA_KV_HEADS * GQA_DH,
             D_MODEL, D_MODEL, D_MODEL)
N_IN = sum(IN_SPLITS)

DEEPNORM_ALPHA = (2.0 * DEPTH) ** 0.25
DEEPNORM_BETA = (8.0 * DEPTH) ** -0.25

kernel_name = 'hybrid_mla_retention_gqa_peer_dit_block'


def split_in(p):
    idx = np.cumsum(IN_SPLITS)[:-1].tolist()
    return jnp.split(p, idx, axis=-1)


def layer_norm(x, g, b):
    xf = x.astype(jnp.float32)
    mu = xf.mean(-1, keepdims=True)
    var = jnp.square(xf - mu).mean(-1, keepdims=True)
    return ((xf - mu) * lax.rsqrt(var + NORM_EPS) * g + b).astype(x.dtype)


def rms_norm(x, g):
    xf = x.astype(jnp.float32)
    return (xf * lax.rsqrt(jnp.square(xf).mean(-1, keepdims=True) + RMS_EPS) * g).astype(x.dtype)


def axial_rope(x, row, col):
    r = x.shape[-1]
    ra = r // 2
    nf = ra // 2
    inv_freq = ROPE_BASE ** (-jnp.arange(nf, dtype=jnp.float32) / nf)

    def rotate(xa, pos):
        ang = pos.astype(jnp.float32)[:, None] * inv_freq[None, :]
        cos = jnp.cos(ang)[None, :, None, :]
        sin = jnp.sin(ang)[None, :, None, :]
        x1 = xa[..., :nf].astype(jnp.float32)
        x2 = xa[..., nf:].astype(jnp.float32)
        return jnp.concatenate([x1 * cos - x2 * sin, x1 * sin + x2 * cos], axis=-1)

    out = jnp.concatenate([rotate(x[..., :ra], row), rotate(x[..., ra:], col)], axis=-1)
    return out.astype(x.dtype)


def block_attention(q, k, v, scale):
    B, S, HK, G, DQ = q.shape
    nb = S // Q_BLOCK
    qb = jnp.moveaxis(q.reshape(B, nb, Q_BLOCK, HK, G, DQ), 1, 0)

    def one_block(qx):
        s = jnp.einsum('bqhgd,bthd->bhgqt', qx, k).astype(jnp.float32) * scale
        pr = jax.nn.softmax(s, axis=-1).astype(v.dtype)
        return jnp.einsum('bhgqt,bthe->bqhge', pr, v)

    o = lax.map(one_block, qb)
    return jnp.moveaxis(o, 0, 1).reshape(B, S, HK * G * v.shape[-1])


def mla_q(cq, p, pos):
    B, T, _ = cq.shape
    q = (rms_norm(cq, p['mla_q_norm']) @ p['mla_w_qup']).reshape(B, T, MLA_HEADS, MLA_NOPE + MLA_ROPE)
    if pos is not None:
        q = jnp.concatenate([q[..., :MLA_NOPE], axial_rope(q[..., MLA_NOPE:], *pos)], axis=-1)
    return q[:, :, :, None, :]


def mla_kv(ckv, kr, p, pos):
    B, T, _ = ckv.shape
    kv = (rms_norm(ckv, p['mla_kv_norm']) @ p['mla_w_kvup']).reshape(B, T, MLA_HEADS, MLA_NOPE + MLA_V)
    k_rope = kr[:, :, None, :]
    if pos is not None:
        k_rope = axial_rope(k_rope, *pos)
    k = jnp.concatenate([kv[..., :MLA_NOPE], jnp.broadcast_to(k_rope, (B, T, MLA_HEADS, MLA_ROPE))], axis=-1)
    return k, kv[..., MLA_NOPE:]


def ret_heads(a, d, pos):
    B, T, _ = a.shape
    a = a.reshape(B, T, RET_HEADS, d)
    if pos is not None:
        a = axial_rope(a, *pos)
    return jnp.moveaxis(a, 1, 2).astype(jnp.float32)


def retention_scan(q, k, v, log_g, r0):
    B, H, T, _ = q.shape
    dv = v.shape[-1]
    n = T // RET_CHUNK
    chunk = lambda a: jnp.moveaxis(a.reshape(B, H, n, RET_CHUNK, a.shape[-1]), 2, 0)
    i = jnp.arange(RET_CHUNK, dtype=jnp.float32)
    diff = i[:, None] - i[None, :]
    dmask = jnp.where(diff >= 0, jnp.exp(log_g[:, None, None] * jnp.maximum(diff, 0.0)), 0.0)[None]
    xi = jnp.exp(log_g[:, None] * (i + 1.0))[None, :, :, None]
    zeta = jnp.exp(log_g[:, None] * (RET_CHUNK - 1.0 - i))[None, :, :, None]
    g_c = jnp.exp(log_g * RET_CHUNK)[None, :, None, None]

    def step(r, blk):
        qb, kb, vb = blk
        s = jnp.einsum('bhqd,bhkd->bhqk', qb, kb) * dmask
        y = jnp.einsum('bhqk,bhke->bhqe', s, vb) + jnp.einsum('bhqd,bhde->bhqe', qb * xi, r)
        r = g_c * r + jnp.einsum('bhkd,bhke->bhde', kb * zeta, vb)
        return r, y

    _, ys = lax.scan(step, r0, (chunk(q), chunk(k), chunk(v)))
    return jnp.moveaxis(ys, 0, 2).reshape(B, H, T, dv)


def context_state(k, v, log_g, reverse):
    L = k.shape[2]
    m = jnp.arange(L, dtype=jnp.float32)
    expo = m if reverse else (L - 1.0) - m
    w = jnp.exp(log_g[:, None] * expo[None, :])
    return jnp.einsum('bhld,bhle->bhde', k * w[None, :, :, None], v)


def retention_bidir(q, k, v, log_f, log_b, r_f, r_b):
    flip = lambda a: a[:, :, ::-1]
    y_f = retention_scan(q, k, v, log_f, r_f)
    y_b = flip(retention_scan(flip(q), flip(k), flip(v), log_b, r_b))
    return y_f + y_b


def ret_output(y, gate):
    B, H, T, dv = y.shape
    mu = y.mean(-1, keepdims=True)
    var = jnp.square(y - mu).mean(-1, keepdims=True)
    yn = jnp.moveaxis((y - mu) * lax.rsqrt(var + NORM_EPS), 1, 2).reshape(B, T, H * dv)
    return (jax.nn.silu(gate.astype(jnp.float32)) * yn).astype(gate.dtype)


def gqa_q(q, p, pos):
    B, T, _ = q.shape
    q = rms_norm(q.reshape(B, T, GQA_HEADS, GQA_DH), p['gqa_q_norm'])
    if pos is not None:
        q = axial_rope(q, *pos)
    return q.reshape(B, T, GQA_KV_HEADS, GQA_GROUP, GQA_DH)


def gqa_kv(k, v, p, pos):
    B, T, _ = k.shape
    k = rms_norm(k.reshape(B, T, GQA_KV_HEADS, GQA_DH), p['gqa_k_norm'])
    if pos is not None:
        k = axial_rope(k, *pos)
    return k, v.reshape(B, T, GQA_KV_HEADS, GQA_DH)


def merge_branches(o_a, o_b, o_c, g_a, g_b, g_c, p):
    m = (jax.nn.sigmoid(g_a) * (o_a @ p['w_br_a'])
         + jax.nn.sigmoid(g_b) * (o_b @ p['w_br_b'])
         + jax.nn.sigmoid(g_c) * (o_c @ p['w_br_c']))
    return m @ p['w_out']


def token_mixer(h, hc, p, pos, with_ctx_out):
    pl = split_in(h @ p['w_in'])
    pc = split_in(hc @ p['w_in'])
    cat = lambda a, b: jnp.concatenate([a, b], axis=1)
    ka_c, va_c = mla_kv(pc[1], pc[2], p, None)
    ka, va = mla_kv(pl[1], pl[2], p, pos)
    o_a = block_attention(mla_q(pl[0], p, pos), cat(ka_c, ka), cat(va_c, va), MLA_SCALE)
    log_f = jax.nn.log_sigmoid(p['ret_decay_logit'][0].astype(jnp.float32))
    log_b = jax.nn.log_sigmoid(p['ret_decay_logit'][1].astype(jnp.float32))
    kb_c = ret_heads(pc[4], RET_DK, None) * RET_K_SCALE
    vb_c = ret_heads(pc[5], RET_DV, None)
    r_f = context_state(kb_c, vb_c, log_f, False)
    r_b = context_state(kb_c, vb_c, log_b, True)
    y_b = retention_bidir(ret_heads(pl[3], RET_DK, pos), ret_heads(pl[4], RET_DK, pos) * RET_K_SCALE,
                          ret_heads(pl[5], RET_DV, None), log_f, log_b, r_f, r_b)
    o_b = ret_output(y_b, pl[6])
    kc_c, vc_c = gqa_kv(pc[8], pc[9], p, None)
    kc, vc = gqa_kv(pl[8], pl[9], p, pos)
    o_c = block_attention(gqa_q(pl[7], p, pos), cat(kc_c, kc), cat(vc_c, vc), GQA_SCALE)
    out = merge_branches(o_a, o_b, o_c, pl[10], pl[11], pl[12], p)
    if not with_ctx_out:
        return out, None
    oa_c = block_attention(mla_q(pc[0], p, None), ka_c, va_c, MLA_SCALE)
    zeros = jnp.zeros_like(r_f)
    ob_c = ret_output(retention_bidir(ret_heads(pc[3], RET_DK, None), kb_c, vb_c,
                                      log_f, log_b, zeros, zeros), pc[6])
    oc_c = block_attention(gqa_q(pc[7], p, None), kc_c, vc_c, GQA_SCALE)
    return out, merge_branches(oa_c, ob_c, oc_c, pc[10], pc[11], pc[12], p)


def peer_ffn(h, p):
    B, T, D = h.shape
    q = (h @ p['peer_w_q']).reshape(B, T, PEER_HEADS, PEER_DQ)
    half = PEER_DQ // 2
    s1 = jnp.einsum('bthd,kd->bthk', q[..., :half], p['peer_k1']).astype(jnp.float32)
    s2 = jnp.einsum('bthd,kd->bthk', q[..., half:], p['peer_k2']).astype(jnp.float32)
    v1, i1 = lax.top_k(s1, PEER_TOPK)
    v2, i2 = lax.top_k(s2, PEER_TOPK)
    cand_s = (v1[..., :, None] + v2[..., None, :]).reshape(B, T, PEER_HEADS, PEER_TOPK * PEER_TOPK)
    cand_e = (i1[..., :, None] * PEER_N_KEYS + i2[..., None, :]).reshape(B, T, PEER_HEADS, PEER_TOPK * PEER_TOPK)
    top_s, top_j = lax.top_k(cand_s, PEER_TOPK)
    experts = jnp.take_along_axis(cand_e, top_j, axis=-1)
    gates = jax.nn.softmax(top_s, axis=-1)
    nb = (B * T) // TOKEN_BLOCK
    kk = PEER_HEADS * PEER_TOPK
    hb = h.reshape(nb, TOKEN_BLOCK, D)
    eb = experts.reshape(nb, TOKEN_BLOCK, kk)
    gb = gates.reshape(nb, TOKEN_BLOCK, kk).astype(h.dtype)
    u_tab, v_tab = p['peer_u'], p['peer_v']

    def one_block(args):
        hx, ex, gx = args
        u = jnp.take(u_tab, ex, axis=0)
        a = jax.nn.gelu(jnp.einsum('nd,nkd->nk', hx, u), approximate=False) * gx
        return jnp.einsum('nk,nkd->nd', a, jnp.take(v_tab, ex, axis=0))

    return lax.map(one_block, (hb, eb, gb)).reshape(B, T, D)


def setup_inputs(seed: int = 0) -> dict:
    key = jax.random.key(seed)
    ks = jax.random.split(key, 32)
    L, D = DEPTH, D_MODEL
    nrm = lambda k, shape, s: jax.random.normal(k, shape, jnp.float32) * s
    gain = lambda k, n: 1.0 + nrm(k, (L, n), 0.01)
    decay_base = jnp.log(2.0 ** (5.0 + jnp.arange(RET_HEADS, dtype=jnp.float32)) - 1.0)
    return {
        'x': nrm(ks[0], (BATCH, SEQ, D), 1.0),
        'c': nrm(ks[1], (BATCH, D), 1.0),
        'ctx': nrm(ks[2], (BATCH, CTX_LEN, D), 1.0),
        'c_ctx': nrm(ks[3], (D,), 1.0),
        'w_mod': nrm(ks[4], (L, D, 6 * D), 0.5 * D ** -0.5),
        'b_mod': nrm(ks[5], (L, 6 * D), 0.01),
        'w_in': nrm(ks[6], (L, D, N_IN), D ** -0.5),
        'mla_q_norm': gain(ks[7], MLA_Q_LORA),
        'mla_w_qup': nrm(ks[8], (L, MLA_Q_LORA, MLA_HEADS * (MLA_NOPE + MLA_ROPE)), MLA_Q_LORA ** -0.5),
        'mla_kv_norm': gain(ks[9], MLA_KV_LORA),
        'mla_w_kvup': nrm(ks[10], (L, MLA_KV_LORA, MLA_HEADS * (MLA_NOPE + MLA_V)), MLA_KV_LORA ** -0.5),
        'ret_decay_logit': decay_base[None, None, :] + nrm(ks[11], (L, 2, RET_HEADS), 0.01),
        'gqa_q_norm': gain(ks[12], GQA_DH),
        'gqa_k_norm': gain(ks[13], GQA_DH),
        'w_br_a': nrm(ks[14], (L, MLA_HEADS * MLA_V, D), (MLA_HEADS * MLA_V) ** -0.5),
        'w_br_b': nrm(ks[15], (L, RET_HEADS * RET_DV, D), (RET_HEADS * RET_DV) ** -0.5),
        'w_br_c': nrm(ks[16], (L, GQA_HEADS * GQA_DH, D), (GQA_HEADS * GQA_DH) ** -0.5),
        'w_out': nrm(ks[17], (L, D, D), DEEPNORM_BETA * D ** -0.5),
        'ln1_g': gain(ks[18], D),
        'ln1_b': nrm(ks[19], (L, D), 0.01),
        'peer_w_q': nrm(ks[20], (L, D, PEER_HEADS * PEER_DQ), D ** -0.5),
        'peer_k1': nrm(ks[21], (L, PEER_N_KEYS, PEER_DQ // 2), (PEER_DQ // 2) ** -0.5),
        'peer_k2': nrm(ks[22], (L, PEER_N_KEYS, PEER_DQ // 2), (PEER_DQ // 2) ** -0.5),
        'peer_u': nrm(ks[23], (L, PEER_N_EXPERTS, D), D ** -0.5),
        'peer_v': nrm(ks[24], (L, PEER_N_EXPERTS, D), DEEPNORM_BETA),
        'ln2_g': gain(ks[25], D),
        'ln2_b': nrm(ks[26], (L, D), 0.01),
    }


def reference(x, c, ctx, c_ctx, w_mod, b_mod, w_in, mla_q_norm, mla_w_qup, mla_kv_norm, mla_w_kvup,
              ret_decay_logit, gqa_q_norm, gqa_k_norm, w_br_a, w_br_b, w_br_c, w_out, ln1_g, ln1_b,
              peer_w_q, peer_k1, peer_k2, peer_u, peer_v, ln2_g, ln2_b):
    S = x.shape[1]
    ROWS = S // GRID_W
    row = jnp.repeat(jnp.arange(ROWS, dtype=jnp.int32), GRID_W)
    col = jnp.tile(jnp.arange(GRID_W, dtype=jnp.int32), ROWS)
    pos = (row, col)
    silu_c = jax.nn.silu(c)
    silu_cc = jax.nn.silu(c_ctx)
    xc = ctx
    for l in range(DEPTH):
        last = l == DEPTH - 1
        p = {
            'w_in': w_in[l], 'mla_q_norm': mla_q_norm[l], 'mla_w_qup': mla_w_qup[l],
            'mla_kv_norm': mla_kv_norm[l], 'mla_w_kvup': mla_w_kvup[l],
            'ret_decay_logit': ret_decay_logit[l], 'gqa_q_norm': gqa_q_norm[l], 'gqa_k_norm': gqa_k_norm[l],
            'w_br_a': w_br_a[l], 'w_br_b': w_br_b[l], 'w_br_c': w_br_c[l], 'w_out': w_out[l],
            'peer_w_q': peer_w_q[l], 'peer_k1': peer_k1[l], 'peer_k2': peer_k2[l],
            'peer_u': peer_u[l], 'peer_v': peer_v[l],
        }
        mod = silu_c @ w_mod[l] + b_mod[l]
        mod_c = silu_cc @ w_mod[l] + b_mod[l]
        sh1, sc1, g1, sh2, sc2, g2 = jnp.split(mod[:, None, :], 6, axis=-1)
        sh1c, sc1c, g1c, sh2c, sc2c, g2c = jnp.split(mod_c, 6, axis=-1)
        h = x * (1.0 + sc1) + sh1
        hc = xc * (1.0 + sc1c) + sh1c
        o, oc = token_mixer(h, hc, p, pos, not last)
        x = layer_norm(DEEPNORM_ALPHA * x + g1 * o, ln1_g[l], ln1_b[l])
        x = layer_norm(DEEPNORM_ALPHA * x + g2 * peer_ffn(x * (1.0 + sc2) + sh2, p), ln2_g[l], ln2_b[l])
        if not last:
            xc = layer_norm(DEEPNORM_ALPHA * xc + g1c * oc, ln1_g[l], ln1_b[l])
            xc = layer_norm(DEEPNORM_ALPHA * xc + g2c * peer_ffn(xc * (1.0 + sc2c) + sh2c, p), ln2_g[l], ln2_b[l])
    return x
```

```cpp
#include <hip/hip_runtime.h>
#include <cstdio>
#include <cstdint>
#include <cstddef>

#ifndef MK_PER_PHASE
#define MK_PER_PHASE 0
#endif

#ifndef ABL_PEER
#define ABL_PEER 0
#endif
#ifndef REP_PEERG
#define REP_PEERG 0
#endif
#ifndef REP_PEERH
#define REP_PEERH 0
#endif
#ifndef REP_X
#define REP_X 0
#endif
#ifndef REP_PS1
#define REP_PS1 0
#endif
#ifndef REP_PS2
#define REP_PS2 0
#endif
#ifndef SIDE_ON
#define SIDE_ON 1
#endif
#ifndef REP_DOT
#define REP_DOT 0
#endif
#ifndef REP_GIN
#define REP_GIN 0
#endif
#ifndef REP_ATTN
#define REP_ATTN 0
#endif
#ifndef REP_PRO
#define REP_PRO 0
#endif
#ifndef ABL_BR
#define ABL_BR 0
#endif
#ifndef ABL_MIX
#define ABL_MIX 0
#endif
#define LAS __attribute__((address_space(3)))
typedef unsigned short bf16_t;
typedef short bf16x8 __attribute__((ext_vector_type(8)));
typedef short s16x4 __attribute__((ext_vector_type(4)));
typedef float f32x2 __attribute__((ext_vector_type(2)));
typedef float f32x4 __attribute__((ext_vector_type(4)));
typedef float f32x8 __attribute__((ext_vector_type(8)));
typedef float f32x16 __attribute__((ext_vector_type(16)));
typedef unsigned u32x2 __attribute__((ext_vector_type(2)));
typedef unsigned u32x4 __attribute__((ext_vector_type(4)));
typedef __bf16 bf2_t __attribute__((ext_vector_type(2)));

constexpr int D = 2048, NB = 4, SEQ = 4096, CTXL = 256, TT = SEQ + CTXL;
constexpr int NLAT = NB * SEQ, NCTX = NB * CTXL, NROW = NLAT + NCTX;
constexpr int NP1 = 4096, NG = 6144, NPT = NP1 + NG;
constexpr int NIN = 10016;
constexpr float ALPHA = 1.4142135623730951f;
constexpr float LN_EPS = 1e-5f, RMS_EPS = 1e-6f;
constexpr float LOG2E = 1.4426950408889634f;
constexpr int C_CQ = 0, C_CKV = 512, C_GQ = 768, C_GK = 1792, C_GV = 2048, C_RQ = 2304, C_RK = 2560, C_RV = 2816, C_RG = 3328, C_KR = 3840;

constexpr size_t AL(size_t x) { return (x + 255) / 256 * 256; }
constexpr size_t WS_CTL = 0;                                    constexpr size_t CTL_BYTES = 1u << 20;
constexpr size_t WS_WSC = WS_CTL + 32768;
constexpr size_t WS_CVT = WS_CTL + 33024;
constexpr size_t WS_DEC = WS_CTL + 65536;
constexpr size_t WS_ROPE32 = WS_CTL + CTL_BYTES;
constexpr size_t WS_ROPE128 = WS_ROPE32 + AL(64 * 8 * 8);
constexpr size_t WS_MODP = WS_ROPE128 + AL(64 * 32 * 8);
constexpr size_t WS_MOD = WS_MODP + AL((size_t)16 * 2 * 5 * 12288 * 4);
constexpr size_t WS_WIN = WS_MOD + AL((size_t)2 * 5 * 12288 * 4);
constexpr size_t SZ_WIN = (size_t)NPT * D;
constexpr size_t WS_WQUP = WS_WIN + 2 * SZ_WIN;                 constexpr size_t SZ_WQUP = (size_t)768 * 512 * 2;
constexpr size_t WS_WKVUP = WS_WQUP + 2 * SZ_WQUP;              constexpr size_t SZ_WKVUP = (size_t)1024 * 256 * 2;
constexpr size_t WS_WBRA = WS_WKVUP + 2 * SZ_WKVUP;             constexpr size_t SZ_WBRA = (size_t)2048 * 512 * 2;
constexpr size_t WS_WBRB = WS_WBRA + 2 * SZ_WBRA;               constexpr size_t SZ_WBRB = SZ_WBRA;
constexpr size_t WS_WBRC = WS_WBRB + 2 * SZ_WBRB;               constexpr size_t SZ_WBRC = (size_t)2048 * 1024 * 2;
constexpr size_t WS_WOUT = WS_WBRC + 2 * SZ_WBRC;               constexpr size_t SZ_WOUT = (size_t)2048 * 2048 * 2;
constexpr size_t WS_WPQ = WS_WOUT + 2 * SZ_WOUT;                constexpr size_t SZ_WPQ = (size_t)1024 * 2048 * 2;
constexpr size_t WS_PSC = WS_WPQ + 2 * SZ_WPQ;
constexpr size_t WS_PU = WS_PSC + (size_t)4 * 16384 * 4;        constexpr size_t SZ_PT = (size_t)16384 * 1152;
constexpr size_t WS_PV = WS_PU + 2 * SZ_PT;
constexpr size_t WS_XC = WS_PV + 2 * SZ_PT;
constexpr size_t WS_HB = WS_XC + (size_t)NCTX * D * 4;
constexpr size_t WS_P1 = WS_HB + (size_t)NROW * D * 2;
constexpr size_t WS_G = WS_P1 + (size_t)NROW * NP1 * 2;
constexpr size_t WS_CQN = WS_G + (size_t)NROW * NG * 2;
constexpr size_t WS_CKVN = WS_CQN + (size_t)NROW * 512 * 2;
constexpr size_t WS_QM = WS_CKVN + (size_t)NROW * 256 * 2;
constexpr size_t SZ_Q128 = (size_t)NB * 8 * TT * 128 * 2;
constexpr size_t WS_KM = WS_QM + SZ_Q128;
constexpr size_t WS_VM = WS_KM + SZ_Q128;
constexpr size_t WS_QG = WS_VM + SZ_Q128 / 2;
constexpr size_t WS_KG = WS_QG + SZ_Q128;
constexpr size_t WS_VG = WS_KG + SZ_Q128 / 4;
constexpr size_t WS_RQ = WS_VG + SZ_Q128 / 4;
constexpr size_t WS_RK = WS_RQ + SZ_Q128 / 4;
constexpr size_t WS_RV = WS_RK + SZ_Q128 / 4;
constexpr size_t WS_ST = WS_RV + SZ_Q128 / 2;
constexpr size_t WS_OAB = WS_ST + (size_t)NB * 8 * 34 * 2 * 2048 * 4;
constexpr size_t WS_HB8 = WS_OAB + (size_t)NROW * D * 2;
constexpr size_t WS_MB8 = WS_HB8 + (size_t)NROW * D;
constexpr size_t WS_END = WS_MB8 + (size_t)NROW * D;
constexpr size_t WS_MB = WS_QM;
constexpr size_t WS_QP = WS_QG;
static_assert((size_t)NROW * D * 2 <= 2 * SZ_Q128, "MB alias");
static_assert((size_t)NROW * 1024 * 2 <= SZ_Q128, "QP alias");

__device__ __forceinline__ unsigned cvt_pk_bf16(float lo, float hi) { unsigned r; asm volatile("v_cvt_pk_bf16_f32 %0, %1, %2" : "=v"(r) : "v"(lo), "v"(hi)); return r; }
__device__ __forceinline__ bf16_t f2bf(float f) { return (bf16_t)(cvt_pk_bf16(f, 0.f) & 0xffffu); }
__device__ __forceinline__ float bf2f(bf16_t b) { return __uint_as_float(((unsigned)b) << 16); }
__device__ __forceinline__ float bflo(unsigned w) { return __uint_as_float(w << 16); }
__device__ __forceinline__ float bfhi(unsigned w) { return __uint_as_float(w & 0xffff0000u); }
template <int CTRL> __device__ __forceinline__ float dppf(float x) { return __int_as_float(__builtin_amdgcn_update_dpp(0, __float_as_int(x), CTRL, 0xF, 0xF, true)); }
__device__ __forceinline__ float row16_sum(float x) { x += dppf<0xB1>(x); x += dppf<0x4E>(x); x += dppf<0x141>(x); x += dppf<0x140>(x); return x; }
__device__ __forceinline__ float row16_max(float x) { x = fmaxf(x, dppf<0xB1>(x)); x = fmaxf(x, dppf<0x4E>(x)); x = fmaxf(x, dppf<0x141>(x)); x = fmaxf(x, dppf<0x140>(x)); return x; }
__device__ __forceinline__ float wave_sum(float x) {
    x = row16_sum(x);
    { auto r = __builtin_amdgcn_permlane16_swap(__float_as_uint(x), __float_as_uint(x), false, false); x = __uint_as_float(r[0]) + __uint_as_float(r[1]); }
    { auto r = __builtin_amdgcn_permlane32_swap(__float_as_uint(x), __float_as_uint(x), false, false); x = __uint_as_float(r[0]) + __uint_as_float(r[1]); }
    return x;
}
__device__ __forceinline__ unsigned pk4_fp8(float a, float b, float c, float d) { int t = 0; t = __builtin_amdgcn_cvt_pk_fp8_f32(a, b, t, false); t = __builtin_amdgcn_cvt_pk_fp8_f32(c, d, t, true); return (unsigned)t; }
__device__ __forceinline__ float clamp8(float x) { return fminf(fmaxf(x, -440.f), 440.f); }
__device__ __forceinline__ void fp8_scale(unsigned amax_bits, float& mul, float& inv) { const float am = __uint_as_float(amax_bits); int k = 0; if (am > 0.f) k = (int)floorf(log2f(256.f / am)); k = k > 60 ? 60 : (k < -60 ? -60 : k); mul = exp2f((float)k); inv = exp2f((float)-k); }
__device__ __forceinline__ float silu_f(float x) { return x / (1.f + __expf(-x)); }
__device__ __forceinline__ float sigmoid_f(float x) { return 1.f / (1.f + __expf(-x)); }

struct RowInfo { int b, tpos, pr, pc, v; bool lat; };
__device__ __forceinline__ RowInfo rowinfo(int row) {
    RowInfo r;
    if (row < NLAT) { r.lat = true; r.b = row >> 12; const int t = row & 4095; r.tpos = CTXL + t; r.pr = t >> 6; r.pc = t & 63; r.v = r.b; }
    else { const int q = row - NLAT; r.lat = false; r.b = q >> 8; r.tpos = q & 255; r.pr = 0; r.pc = 0; r.v = 4; }
    return r;
}

#define XB_TMO      128
#define XB_XCNT(j)  (256  + 64 * (j))
#define XB_XSUB(j)  (1280 + 64 * (j))
#define XB_XGEN(j)  (2304 + 64 * (j))
#define XB_TOP      3328
#define XB_TOPGEN   3392
#define XCD_BAR_WORDS 3456
#define XB_SPIN_CAP (1u << 22)

__device__ __forceinline__ unsigned xb_ld(unsigned* p)              { return __hip_atomic_load(p, __ATOMIC_RELAXED, __HIP_MEMORY_SCOPE_AGENT); }
__device__ __forceinline__ unsigned xb_add(unsigned* p, unsigned v) { return __hip_atomic_fetch_add(p, v, __ATOMIC_RELAXED, __HIP_MEMORY_SCOPE_AGENT); }
__device__ __forceinline__ unsigned xb_xcc_id() { return (unsigned)__builtin_amdgcn_s_getreg((3 << 11) | 20) & 0xFu; }
#define XB_SPIN(cond, bar) do { unsigned _sp = 0; while (cond) { __builtin_amdgcn_s_sleep(1); \
    if ((++_sp & 255u) == 0u) { if (xb_ld(&(bar)[XB_TMO])) break; if (_sp > XB_SPIN_CAP) { atomicAdd(&(bar)[XB_TMO], 1u); break; } } } } while (0)

struct XcdBarrier { unsigned* bar; unsigned x; volatile LAS unsigned* st; };

__device__ __forceinline__ XcdBarrier xcd_barrier_post(unsigned* bar, volatile LAS unsigned* st) {
    XcdBarrier b; b.bar = bar; b.x = xb_xcc_id(); b.st = st;
    if (threadIdx.x == 0) (void)xb_add(&bar[XB_XCNT(b.x)], 1u);
    return b;
}
__device__ __forceinline__ void xcd_barrier_complete(unsigned* bar, unsigned x, unsigned& nloc, unsigned& nx) {
    const unsigned G = gridDim.x * gridDim.y * gridDim.z;
    unsigned sum, cnt, mine, sp = 0u;
    for (;;) {
        sum = 0u; cnt = 0u; mine = 0u;
#pragma unroll
        for (unsigned j = 0; j < 16; ++j) { const unsigned c = xb_ld(&bar[XB_XCNT(j)]); sum += c; cnt += (c > 0u) ? 1u : 0u; mine = (j == x) ? c : mine; }
        if (sum == G) break;
        __builtin_amdgcn_s_sleep(1);
        if ((++sp & 255u) == 0u) { if (xb_ld(&bar[XB_TMO])) break; if (sp > XB_SPIN_CAP) { atomicAdd(&bar[XB_TMO], 1u); break; } }
    }
    nloc = mine > 0u ? mine : 1u; nx = cnt > 0u ? cnt : 1u;
}
__device__ __forceinline__ void xcd_barrier(const XcdBarrier& b) {
    asm volatile("s_waitcnt vmcnt(0)" ::: "memory");
    __syncthreads();
    if (threadIdx.x == 0) {
        unsigned* bar = b.bar;
        __builtin_amdgcn_s_waitcnt(0);
        unsigned nloc = b.st[0], nx = b.st[1];
        if (nloc == 0u) { xcd_barrier_complete(bar, b.x, nloc, nx); b.st[0] = nloc; b.st[1] = nx; }
        const unsigned old = xb_add(&bar[XB_XSUB(b.x)], 1u);
        const unsigned gen = old / nloc;
        if (old + 1u == (gen + 1u) * nloc) {
            __builtin_amdgcn_fence(__ATOMIC_RELEASE, "agent");
            asm volatile("s_waitcnt vmcnt(0)" ::: "memory");
            const unsigned og = xb_add(&bar[XB_TOP], 1u);
            const unsigned tg = og / nx;
            if (og + 1u == (tg + 1u) * nx) xb_add(&bar[XB_TOPGEN], 1u);
            else XB_SPIN(xb_ld(&bar[XB_TOPGEN]) == tg, bar);
            __builtin_amdgcn_fence(__ATOMIC_ACQUIRE, "agent");
            xb_add(&bar[XB_XGEN(b.x)], 1u);
            asm volatile("s_waitcnt vmcnt(0)" ::: "memory");
        } else {
            XB_SPIN(xb_ld(&bar[XB_XGEN(b.x)]) == gen, bar);
            __builtin_amdgcn_fence(__ATOMIC_ACQUIRE, "agent");
            asm volatile("s_waitcnt vmcnt(0)" ::: "memory");
        }
    }
    __syncthreads();
}
namespace pg8 {
constexpr int BM = 256, BK = 64, HALF = 128, HTB = HALF * BK * 2, STAGE_BYTES = 8 * HTB, NXCD = 8, WGM = 8;
__host__ __device__ __forceinline__ int lds_byte(int r, int c) { const int st = (r >> 4) * 2 + (c >> 5), rr = r & 15, cc = c & 31, ob = rr * 64 + cc * 2; return st * 1024 + (ob ^ (((ob >> 9) & 1) << 5)); }
__host__ __device__ __forceinline__ void stage_rc(int b, int& R, int& C) { const int st = b / 1024, sb = b % 1024, swz = sb ^ (((sb >> 9) & 1) << 5); R = (st >> 1) * 16 + swz / 64; C = (st & 1) * 32 + (swz % 64) / 2; }
__host__ __device__ __forceinline__ int perm32(int rho) { const int n = rho >> 4, i = rho & 15; return 8 * (i >> 2) + 4 * n + (i & 3); }

struct Unit { int pm, pn; };
typedef int i32x8 __attribute__((ext_vector_type(8))); typedef int i32x4v __attribute__((ext_vector_type(4)));
__device__ __forceinline__ i32x8 cat8(const bf16x8 a, const bf16x8 b) { const i32x4v x = __builtin_bit_cast(i32x4v, a), y = __builtin_bit_cast(i32x4v, b); return __builtin_shufflevector(x, y, 0, 1, 2, 3, 4, 5, 6, 7); }
struct Gemm { const bf16_t* A; const bf16_t* Bt; int M, N, K, lda, ldb; };

struct StaticOrder {
    int nM, nN, nwg, G, c;
    __host__ __device__ void init(int M, int N, int G_, int c_) { nM = M / BM; nN = N / BM; nwg = nM * nN; G = G_; c = c_; }
    __host__ __device__ bool next(int i, Unit& u) const {
        const long L = (long)i * G + c; if (L >= nwg) return false;
        int wgid = (int)L; { const int q = nwg / NXCD, r = nwg % NXCD, xcd = wgid % NXCD, off = wgid / NXCD; wgid = (xcd < r ? xcd * (q + 1) : r * (q + 1) + (xcd - r) * q) + off; }
        const int nig = WGM * nN, gid = wgid / nig, fm = gid * WGM, gsz = (nM - fm) < WGM ? (nM - fm) : WGM;
        u.pm = fm + ((wgid % nig) % gsz); u.pn = (wgid % nig) / gsz; return true;
    }
    __device__ __forceinline__ void a_ready(const Unit&) const {}
    __device__ __forceinline__ void done(const Unit&) const {}
};

template <class Epi, class Sched>
__device__ __forceinline__ void gemm_phase(LAS unsigned char* lds, const int tid, const Gemm g, const Sched& S, const Epi& E) {
    const int  wid = __builtin_amdgcn_readfirstlane(tid >> 6), lane = tid & 63, wr = wid >> 2, wc = wid & 3, fr = lane & 15, fq = lane >> 4;
    const int K = g.K, nt = K / BK;
    unsigned voffA[2], voffB[2];
#pragma unroll
    for (int i = 0; i < 2; ++i) { int R, C; stage_rc(tid * 16 + i * 8192, R, C); const int Rb = Epi::PERM ? ((R & ~31) + perm32(R & 31)) : R;
        voffA[i] = (unsigned)(R * g.lda + C) * 2u; voffB[i] = (unsigned)(Rb * g.ldb + C) * 2u; }
    const size_t kstep = (size_t)(BK * 2);
    const size_t hstepA = (size_t)HALF * g.lda * 2, hstepB = (size_t)HALF * g.ldb * 2;
    const size_t tstepA = 2 * hstepA, tstepB = 2 * hstepB;
    const unsigned ldsw = (unsigned)wid * 1024u;
    const int aoff = lds_byte(wr * 64 + fr, fq * 8), boff = lds_byte(wc * 32 + fr, fq * 8);
#define PG8_SA(b, h) (((b) * 2 + (h)) * HTB)
#define PG8_SB(b, h) ((4 + (b) * 2 + (h)) * HTB)
#define PG8_STAGE(bufoff, gbase, voff) do { _Pragma("unroll") for (int _i = 0; _i < 2; ++_i) \
        __builtin_amdgcn_global_load_lds((const unsigned*)((const char*)(gbase) + (voff)[_i]), (LAS unsigned*)(lds + (bufoff) + ldsw + _i * 8192), 16, 0, 0); } while (0)
#define PG8_LDA(dst, b, h) do { if constexpr (Epi::FP8) { _Pragma("unroll") for (int m = 0; m < 4; ++m) { const i32x4v lo_ = *(const LAS i32x4v*)(lds + PG8_SA(b, h) + aoff + m * 2048), hi_ = *(const LAS i32x4v*)(lds + PG8_SA(b, h) + aoff + m * 2048 + 1024); \
            dst##8[m] = __builtin_shufflevector(lo_, hi_, 0, 1, 2, 3, 4, 5, 6, 7); } } \
        else { _Pragma("unroll") for (int m = 0; m < 4; ++m) _Pragma("unroll") for (int k = 0; k < 2; ++k) dst[m][k] = *(const LAS bf16x8*)(lds + PG8_SA(b, h) + aoff + m * 2048 + k * 1024); } } while (0)
#define PG8_LDB(dst, b, h) do { if constexpr (Epi::FP8) { _Pragma("unroll") for (int n = 0; n < 2; ++n) { const i32x4v lo_ = *(const LAS i32x4v*)(lds + PG8_SB(b, h) + boff + n * 2048), hi_ = *(const LAS i32x4v*)(lds + PG8_SB(b, h) + boff + n * 2048 + 1024); \
            dst##8[n] = __builtin_shufflevector(lo_, hi_, 0, 1, 2, 3, 4, 5, 6, 7); } } \
        else { _Pragma("unroll") for (int n = 0; n < 2; ++n) _Pragma("unroll") for (int k = 0; k < 2; ++k) dst[n][k] = *(const LAS bf16x8*)(lds + PG8_SB(b, h) + boff + n * 2048 + k * 1024); } } while (0)
#define PG8_MMA(ai, bj, At, Bt) do { __builtin_amdgcn_s_setprio(1); _Pragma("unroll") for (int m = 0; m < 4; ++m) _Pragma("unroll") for (int n = 0; n < 2; ++n) { \
        if constexpr (Epi::FP8) asm volatile("v_mfma_scale_f32_16x16x128_f8f6f4 %0, %1, %2, %0, %3, %3 op_sel_hi:[0,0,0]" : "+v"(acc[ai][bj][m][n]) : "v"(Bt##8[n]), "v"(At##8[m]), "v"(sc1_)); \
        else { _Pragma("unroll") for (int k = 0; k < 2; ++k) acc[ai][bj][m][n] = __builtin_amdgcn_mfma_f32_16x16x32_bf16(Bt[n][k], At[m][k], acc[ai][bj][m][n], 0, 0, 0); } } __builtin_amdgcn_s_setprio(0); } while (0)
#define PG8_WAIT_V(n) asm volatile("s_waitcnt vmcnt(" #n ")" ::: "memory")
#define PG8_WAIT_L(n) asm volatile("s_waitcnt lgkmcnt(" #n ")" ::: "memory")
#define PG8_BAR __builtin_amdgcn_s_barrier()
#define PG8_SCHED __builtin_amdgcn_sched_barrier(0)
    Unit cur, nxt; int ui = 0;
    if (!S.next(0, cur)) return;
    f32x4 acc[2][2][4][2];
#pragma unroll
    for (int a = 0; a < 2; ++a)
#pragma unroll
        for (int b = 0; b < 2; ++b)
#pragma unroll
            for (int m = 0; m < 4; ++m)
#pragma unroll
                for (int n = 0; n < 2; ++n) acc[a][b][m][n] = (f32x4){0.f, 0.f, 0.f, 0.f};
    int sc1_ = 0x7F7F7F7F; asm volatile("" : "+v"(sc1_));
    bf16x8 At[4][2], B0[2][2], B1[2][2]; i32x8 At8[4], B08[2], B18[2];
    const char* cA = (const char*)g.A + (size_t)cur.pm * tstepA; const char* cB = (const char*)g.Bt + (size_t)cur.pn * tstepB;
    S.a_ready(cur);
    PG8_STAGE(PG8_SB(0, 0), cB, voffB); PG8_STAGE(PG8_SA(0, 0), cA, voffA); PG8_STAGE(PG8_SB(0, 1), cB + hstepB, voffB); PG8_STAGE(PG8_SA(0, 1), cA + hstepA, voffA);
    if (wr == 1) PG8_BAR;
    PG8_WAIT_V(4); PG8_BAR;
    PG8_STAGE(PG8_SB(1, 0), cB + kstep, voffB); PG8_STAGE(PG8_SA(1, 0), cA + kstep, voffA); PG8_STAGE(PG8_SB(1, 1), cB + hstepB + kstep, voffB);
    PG8_WAIT_V(6); PG8_BAR;
    for (;;) {
        const bool has_next = S.next(ui + 1, nxt);
        const char* nA = has_next ? (const char*)g.A + (size_t)nxt.pm * tstepA : cA; const char* nB = has_next ? (const char*)g.Bt + (size_t)nxt.pn * tstepB : cB;
#pragma unroll 1
        for (int t = 0; t < nt; t += 2) {
            const bool last = (t == nt - 2);
            const char* a1 = cA + (size_t)(t + 1) * kstep;
            const char* a2 = last ? nA : cA + (size_t)(t + 2) * kstep; const char* b2 = last ? nB : cB + (size_t)(t + 2) * kstep;
            const char* a3 = a2 + kstep; const char* b3 = b2 + kstep;
            if (last && has_next) S.a_ready(nxt);
            PG8_LDB(B0, 0, 0); PG8_SCHED; PG8_LDA(At, 0, 0); PG8_STAGE(PG8_SA(1, 1), a1 + hstepA, voffA);
            PG8_WAIT_L(8); PG8_BAR; PG8_WAIT_L(0); PG8_MMA(0, 0, At, B0); PG8_BAR; PG8_SCHED;
            PG8_LDB(B1, 0, 1); PG8_STAGE(PG8_SB(0, 0), b2, voffB);
            PG8_BAR; PG8_WAIT_L(0); PG8_MMA(0, 1, At, B1); PG8_BAR;
            PG8_LDA(At, 0, 1); PG8_STAGE(PG8_SA(0, 0), a2, voffA);
            PG8_BAR; PG8_WAIT_L(0); PG8_MMA(1, 0, At, B0); PG8_BAR; PG8_SCHED;
            PG8_STAGE(PG8_SB(0, 1), b2 + hstepB, voffB);
            PG8_WAIT_V(6); PG8_BAR; PG8_MMA(1, 1, At, B1); PG8_BAR;
            PG8_LDB(B0, 1, 0); PG8_SCHED; PG8_LDA(At, 1, 0); PG8_STAGE(PG8_SA(0, 1), a2 + hstepA, voffA);
            PG8_WAIT_L(8); PG8_BAR; PG8_WAIT_L(0); PG8_MMA(0, 0, At, B0); PG8_BAR; PG8_SCHED;
            PG8_LDB(B1, 1, 1); PG8_STAGE(PG8_SB(1, 0), b3, voffB);
            PG8_BAR; PG8_WAIT_L(0); PG8_MMA(0, 1, At, B1); PG8_BAR;
            PG8_LDA(At, 1, 1); PG8_STAGE(PG8_SA(1, 0), a3, voffA);
            PG8_BAR; PG8_WAIT_L(0); PG8_MMA(1, 0, At, B0); PG8_BAR; PG8_SCHED;
            PG8_STAGE(PG8_SB(1, 1), b3 + hstepB, voffB);
            PG8_WAIT_V(6); PG8_BAR; PG8_MMA(1, 1, At, B1); PG8_BAR;
        }
        if constexpr (Epi::FP8) asm volatile("s_nop 15\n\ts_nop 15" ::: "memory");
        E(acc, cur, wr, wc, fr, fq);
        if (!has_next) break;
#pragma unroll
        for (int a = 0; a < 2; ++a)
#pragma unroll
            for (int b = 0; b < 2; ++b)
#pragma unroll
                for (int m = 0; m < 4; ++m)
#pragma unroll
                    for (int n = 0; n < 2; ++n) acc[a][b][m][n] = (f32x4){0.f, 0.f, 0.f, 0.f};
        cur = nxt; cA = nA; cB = nB; ++ui;
    }
    PG8_WAIT_V(0);
    if (wr == 0) PG8_BAR;
    PG8_BAR;
#undef PG8_SA
#undef PG8_SB
#undef PG8_STAGE
#undef PG8_LDA
#undef PG8_LDB
#undef PG8_MMA
#undef PG8_WAIT_V
#undef PG8_WAIT_L
#undef PG8_BAR
#undef PG8_SCHED
}
}

typedef f32x4 Acc[2][2][4][2];
#define EPI_LOOP_ROWS for (int ai = 0; ai < 2; ++ai) for (int m = 0; m < 4; ++m)
__device__ __forceinline__ u32x4 pack8(const f32x4 a, const f32x4 b) { u32x4 w; w.x = cvt_pk_bf16(a[0], a[1]); w.y = cvt_pk_bf16(a[2], a[3]); w.z = cvt_pk_bf16(b[0], b[1]); w.w = cvt_pk_bf16(b[2], b[3]); return w; }

struct EpiIn {
    static constexpr bool PERM = true, FP8 = true;
    bf16_t* P1; bf16_t* G; float inv;
    __device__ __forceinline__ void operator()(const Acc& acc, const pg8::Unit& u, int wr, int wc, int fr, int fq) const {
        const int row0 = u.pm * 256 + wr * 64 + fr; const bool gate = u.pn >= 16;
        bf16_t* base = gate ? G : P1; const int ld = gate ? NG : NP1; const int col0 = (gate ? (u.pn - 16) : u.pn) * 256 + wc * 32 + 8 * fq;
#pragma unroll
        for (int ai = 0; ai < 2; ++ai)
#pragma unroll
            for (int m = 0; m < 4; ++m) { bf16_t* rowp = base + (size_t)(row0 + ai * 128 + m * 16) * ld + col0;
#pragma unroll
                for (int bj = 0; bj < 2; ++bj) { f32x4 v0 = acc[ai][bj][m][0] * inv, v1 = acc[ai][bj][m][1] * inv;
                    if (gate) {
#pragma unroll
                        for (int j = 0; j < 4; ++j) { v0[j] = sigmoid_f(v0[j]); v1[j] = sigmoid_f(v1[j]); } }
                    *(u32x4*)(rowp + bj * 128) = pack8(v0, v1); } }
    }
};
struct EpiPlain {
    static constexpr bool PERM = true, FP8 = false;
    bf16_t* O; int ldc;
    __device__ __forceinline__ void operator()(const Acc& acc, const pg8::Unit& u, int wr, int wc, int fr, int fq) const {
        const int row0 = u.pm * 256 + wr * 64 + fr; const int col0 = u.pn * 256 + wc * 32 + 8 * fq;
#pragma unroll
        for (int ai = 0; ai < 2; ++ai)
#pragma unroll
            for (int m = 0; m < 4; ++m) { bf16_t* rowp = O + (size_t)(row0 + ai * 128 + m * 16) * ldc + col0;
#pragma unroll
                for (int bj = 0; bj < 2; ++bj) *(u32x4*)(rowp + bj * 128) = pack8(acc[ai][bj][m][0], acc[ai][bj][m][1]); }
    }
};
__device__ __forceinline__ void tile_info(int pm, int& b, int& tpos0, bool& lat) { lat = pm < 64; b = lat ? (pm >> 4) : (pm - 64); tpos0 = lat ? CTXL + ((pm & 15) << 8) : 0; }
struct EpiQup {
    static constexpr bool PERM = true, FP8 = false;
    bf16_t* QM; const f32x2* cs32;
    __device__ __forceinline__ void operator()(const Acc& acc, const pg8::Unit& u, int wr, int wc, int fr, int fq) const {
        int b, tpos0; bool lat; tile_info(u.pm, b, tpos0, lat);
        const int r0 = wr * 64 + fr;
#pragma unroll
        for (int bj = 0; bj < 2; ++bj) { const int c0 = u.pn * 256 + bj * 128 + wc * 32 + 8 * fq; const int hh = c0 / 96, j0 = c0 - hh * 96;
            bf16_t* hb = QM + ((size_t)(b * 8 + hh) * TT + tpos0 + r0) * 128;
            if (j0 < 64) {
#pragma unroll
                for (int ai = 0; ai < 2; ++ai)
#pragma unroll
                    for (int m = 0; m < 4; ++m) *(u32x4*)(hb + (ai * 128 + m * 16) * 128 + j0) = pack8(acc[ai][bj][m][0], acc[ai][bj][m][1]);
            } else { const int g8 = (j0 - 64) >> 3, part = g8 >> 1, pbase = (g8 & 1) * 4;
#pragma unroll
                for (int ai = 0; ai < 2; ++ai)
#pragma unroll
                    for (int m = 0; m < 4; ++m) { const int t = tpos0 - CTXL + r0 + ai * 128 + m * 16; const int pos = part ? (t & 63) : (t >> 6);
                        const f32x4 v0 = acc[ai][bj][m][0], v1 = acc[ai][bj][m][1];
                        float o1[4], o2[4]; const float x1[4] = {v0[0], v0[2], v1[0], v1[2]}, x2[4] = {v0[1], v0[3], v1[1], v1[3]};
#pragma unroll
                        for (int p = 0; p < 4; ++p) { const f32x2 cs = lat ? cs32[pos * 8 + pbase + p] : (f32x2){1.f, 0.f};
                            o1[p] = x1[p] * cs.x - x2[p] * cs.y; o2[p] = x1[p] * cs.y + x2[p] * cs.x; }
                        u32x2 w1, w2; w1.x = cvt_pk_bf16(o1[0], o1[1]); w1.y = cvt_pk_bf16(o1[2], o1[3]); w2.x = cvt_pk_bf16(o2[0], o2[1]); w2.y = cvt_pk_bf16(o2[2], o2[3]);
                        bf16_t* dst = hb + (ai * 128 + m * 16) * 128 + 64 + part * 16 + pbase;
                        *(u32x2*)dst = w1; *(u32x2*)(dst + 8) = w2; } } }
    }
};
struct EpiKvup {
    static constexpr bool PERM = true, FP8 = false;
    bf16_t* KM; bf16_t* VM;
    __device__ __forceinline__ void operator()(const Acc& acc, const pg8::Unit& u, int wr, int wc, int fr, int fq) const {
        int b, tpos0; bool lat; tile_info(u.pm, b, tpos0, lat);
        const int r0 = wr * 64 + fr; const int j0 = wc * 32 + 8 * fq;
#pragma unroll
        for (int bj = 0; bj < 2; ++bj) { const size_t tok = (size_t)(b * 8 + u.pn * 2 + bj) * TT + tpos0 + r0;
            if (j0 < 64) { bf16_t* d = KM + tok * 128 + j0;
#pragma unroll
                for (int ai = 0; ai < 2; ++ai)
#pragma unroll
                    for (int m = 0; m < 4; ++m) *(u32x4*)(d + (ai * 128 + m * 16) * 128) = pack8(acc[ai][bj][m][0], acc[ai][bj][m][1]); }
            else { bf16_t* d = VM + tok * 64 + (j0 - 64);
#pragma unroll
                for (int ai = 0; ai < 2; ++ai)
#pragma unroll
                    for (int m = 0; m < 4; ++m) *(u32x4*)(d + (ai * 128 + m * 16) * 64) = pack8(acc[ai][bj][m][0], acc[ai][bj][m][1]); } }
    }
};
template <int SEG> struct EpiMerge {
    static constexpr bool PERM = true, FP8 = false;
    bf16_t* MB; const bf16_t* G; unsigned char* MB8;
    __device__ __forceinline__ void operator()(const Acc& acc, const pg8::Unit& u, int wr, int wc, int fr, int fq) const {
        const int row0 = u.pm * 256 + wr * 64 + fr; const int col0 = u.pn * 256 + wc * 32 + 8 * fq;
        const bf16_t* gp = G + (size_t)row0 * NG + SEG * 2048 + col0; bf16_t* mp = MB + (size_t)row0 * D + col0; unsigned char* m8 = MB8 + (size_t)row0 * D + col0;
#pragma unroll
        for (int ai = 0; ai < 2; ++ai) {
            u32x4 gw[4][2], ow[4][2];
#pragma unroll
            for (int m = 0; m < 4; ++m)
#pragma unroll
                for (int bj = 0; bj < 2; ++bj) { const size_t ro = (size_t)(ai * 128 + m * 16);
                    gw[m][bj] = *(const u32x4*)(gp + ro * NG + bj * 128);
                    if (SEG > 0) ow[m][bj] = __builtin_nontemporal_load((const u32x4*)(mp + ro * D + bj * 128)); }
#pragma unroll
            for (int m = 0; m < 4; ++m)
#pragma unroll
                for (int bj = 0; bj < 2; ++bj) { const size_t ro = (size_t)(ai * 128 + m * 16); const u32x4 g_ = gw[m][bj];
                    f32x4 v0 = acc[ai][bj][m][0], v1 = acc[ai][bj][m][1];
                    if (ABL_BR & (1 << SEG)) { v0 = (f32x4){0.f, 0.f, 0.f, 0.f}; v1 = v0; }
                    v0[0] *= bflo(g_.x); v0[1] *= bfhi(g_.x); v0[2] *= bflo(g_.y); v0[3] *= bfhi(g_.y);
                    v1[0] *= bflo(g_.z); v1[1] *= bfhi(g_.z); v1[2] *= bflo(g_.w); v1[3] *= bfhi(g_.w);
                    if (SEG > 0) { const u32x4 o = ow[m][bj];
                        v0[0] += bflo(o.x); v0[1] += bfhi(o.x); v0[2] += bflo(o.y); v0[3] += bfhi(o.y);
                        v1[0] += bflo(o.z); v1[1] += bfhi(o.z); v1[2] += bflo(o.w); v1[3] += bfhi(o.w); }
                    if (SEG < 2) *(u32x4*)(mp + ro * D + bj * 128) = pack8(v0, v1);
                    else { u32x2 w8; w8.x = pk4_fp8(clamp8(v0[0] * 16.f), clamp8(v0[1] * 16.f), clamp8(v0[2] * 16.f), clamp8(v0[3] * 16.f)); w8.y = pk4_fp8(clamp8(v1[0] * 16.f), clamp8(v1[1] * 16.f), clamp8(v1[2] * 16.f), clamp8(v1[3] * 16.f));
                        *(u32x2*)(m8 + ro * D + bj * 128) = w8; } }
        }
    }
};
struct EpiOut {
    static constexpr bool PERM = false, FP8 = true;
    const float* src_lat; const float* src_ctx; float* dst_lat; float* dst_ctx; const float* g1; float inv;
    __device__ __forceinline__ void operator()(const Acc& acc, const pg8::Unit& u, int wr, int wc, int fr, int fq) const {
        const int row0 = u.pm * 256 + wr * 64 + fr; const int col0 = u.pn * 256 + wc * 32 + 4 * fq;
        const bool lat = (u.pm * 256) < NLAT;
        const float* src = (lat ? src_lat : src_ctx - (size_t)NLAT * D) + (size_t)row0 * D + col0; float* dst = (lat ? dst_lat : dst_ctx - (size_t)NLAT * D) + (size_t)row0 * D + col0;
#pragma unroll
        for (int ai = 0; ai < 2; ++ai) { const int rbase = u.pm * 256 + ai * 128 + wr * 64; const int v = lat ? (rbase >> 12) : 4; const float* gp = g1 + (size_t)v * 12288 + col0;
            f32x4 gg[2][2];
#pragma unroll
            for (int bj = 0; bj < 2; ++bj)
#pragma unroll
                for (int n = 0; n < 2; ++n) gg[bj][n] = *(const f32x4*)(gp + bj * 128 + n * 16);
#pragma unroll
            for (int mh = 0; mh < 2; ++mh) {
                f32x4 xr[2][2][2];
#pragma unroll
                for (int mm = 0; mm < 2; ++mm)
#pragma unroll
                    for (int bj = 0; bj < 2; ++bj)
#pragma unroll
                        for (int n = 0; n < 2; ++n) xr[mm][bj][n] = __builtin_nontemporal_load((const f32x4*)(src + (size_t)(ai * 128 + (mh * 2 + mm) * 16) * D + bj * 128 + n * 16));
#pragma unroll
                for (int mm = 0; mm < 2; ++mm)
#pragma unroll
                    for (int bj = 0; bj < 2; ++bj)
#pragma unroll
                        for (int n = 0; n < 2; ++n) { const int m = mh * 2 + mm;
                            *(f32x4*)(dst + (size_t)(ai * 128 + m * 16) * D + bj * 128 + n * 16) = ABL_MIX ? xr[mm][bj][n] * ALPHA : xr[mm][bj][n] * ALPHA + gg[bj][n] * (acc[ai][bj][m][n] * inv); } } }
    }
};

struct Args { const float* in[27]; float* out; unsigned char* ws; int ph_lo, ph_hi; };
typedef const Args __attribute__((address_space(4)))* ArgP;
struct Frame {
    LAS unsigned char* lds; int tid, lane, wave, G, bid;
    ArgP ap; float* out; unsigned char* ws;
    __device__ __forceinline__ const float* in(int i) const { return ap->in[i]; }
};
__device__ __forceinline__ Frame make_frame(ArgP ap) {
    { unsigned long long t = (unsigned long long)ap; asm volatile("" : "+s"(t)); ap = (ArgP)t; }
    extern __shared__ __attribute__((aligned(16))) unsigned char lds_raw[];
    Frame F; F.lds = (LAS unsigned char*)lds_raw; { int t_ = threadIdx.x; asm volatile("" : "+v"(t_)); F.tid = t_; }
    F.lane = F.tid & 63; F.wave = __builtin_amdgcn_readfirstlane(F.tid >> 6); F.G = gridDim.x; F.bid = blockIdx.x;
    F.ap = ap; F.out = ap->out; F.ws = ap->ws; return F;
}
template <class T> __device__ __forceinline__ T* wsp(const Frame& F, size_t off) { return (T*)(F.ws + off); }

__device__ __forceinline__ int win_col(int n) {
    if (n < 768) return n;
    if (n < 1792) return 2336 + (n - 768);
    if (n < 2048) return 3360 + (n - 1792);
    if (n < 2304) return 3616 + (n - 2048);
    if (n < 2560) return 800 + (n - 2304);
    if (n < 2816) return 1056 + (n - 2560);
    if (n < 3328) return 1312 + (n - 2816);
    if (n < 3840) return 1824 + (n - 3328);
    if (n < 3872) return 768 + (n - 3840);
    if (n < 4096) return -1;
    return 3872 + (n - 4096);
}
__device__ __forceinline__ int qup_col(int c) {
    const int hh = c / 96, j = c - hh * 96;
    if (j < 64) return c;
    const int jj = j - 64, g8 = jj >> 3, i = jj & 7, p = i >> 1, which = i & 1, part = g8 >> 1, pi = (g8 & 1) * 4 + p;
    return hh * 96 + 64 + part * 16 + which * 8 + pi;
}
template <int MAP>
__device__ __forceinline__ void transpose_cvt(const Frame& F, const float* __restrict__ src, bf16_t* __restrict__ dst, int K, int Nsrc, int Nd) {
    LAS float* tile = (LAS float*)F.lds;
    const int tk = K / 256, tn = Nd / 64, ntile = tk * tn;
    for (int t = F.bid; t < ntile; t += F.G) {
        const int k0 = (t % tk) * 256, n0 = (t / tk) * 64;
        const int nl = F.tid & 63, kq = F.tid >> 6;
        const int nd = n0 + nl; const int ns = MAP == 0 ? nd : (MAP == 1 ? win_col(nd) : qup_col(nd));
        float v[32];
#pragma unroll
        for (int i = 0; i < 32; ++i) v[i] = ns >= 0 ? src[(size_t)(k0 + kq + 8 * i) * Nsrc + ns] : 0.f;
#pragma unroll
        for (int i = 0; i < 32; ++i) tile[(kq + 8 * i) * 65 + nl] = v[i];
        __syncthreads();
        { const int n = F.tid >> 3, k32 = (F.tid & 7) * 32;
#pragma unroll
          for (int c = 0; c < 4; ++c) { float w[8];
#pragma unroll
              for (int j = 0; j < 8; ++j) w[j] = tile[(k32 + c * 8 + j) * 65 + n];
              u32x4 o; o.x = cvt_pk_bf16(w[0], w[1]); o.y = cvt_pk_bf16(w[2], w[3]); o.z = cvt_pk_bf16(w[4], w[5]); o.w = cvt_pk_bf16(w[6], w[7]);
              *(u32x4*)(dst + (size_t)(n0 + n) * K + k0 + k32 + c * 8) = o; } }
        __syncthreads();
    }
}
__device__ __forceinline__ void cvt_rows(const Frame& F, const float* __restrict__ src, bf16_t* __restrict__ dst, size_t n8) {
    for (size_t i = (size_t)F.bid * 512 + F.tid; i < n8; i += (size_t)F.G * 512) {
        const f32x4 a = __builtin_nontemporal_load((const f32x4*)(src + i * 8)), b = __builtin_nontemporal_load((const f32x4*)(src + i * 8 + 4));
        *(u32x4*)(dst + i * 8) = pack8(a, b);
    }
}
__device__ __forceinline__ void cvt_peer(const Frame& F, int l);
__device__ __forceinline__ void absmax_f32(const Frame& F, const float* __restrict__ src, size_t n4, unsigned* dst) {
    float am = 0.f;
    const size_t stride = (size_t)F.G * 512; size_t i = (size_t)F.bid * 512 + F.tid;
    for (; i + 7 * stride < n4; i += 8 * stride) { f32x4 a[8];
#pragma unroll
        for (int j = 0; j < 8; ++j) a[j] = __builtin_nontemporal_load((const f32x4*)(src + (i + j * stride) * 4));
#pragma unroll
        for (int j = 0; j < 8; ++j) am = fmaxf(fmaxf(fmaxf(am, fabsf(a[j][0])), fabsf(a[j][1])), fmaxf(fabsf(a[j][2]), fabsf(a[j][3]))); }
    for (; i < n4; i += stride) { const f32x4 a = *(const f32x4*)(src + i * 4); am = fmaxf(fmaxf(fmaxf(am, fabsf(a[0])), fabsf(a[1])), fmaxf(fabsf(a[2]), fabsf(a[3]))); }
    am = row16_max(am);
    { auto r = __builtin_amdgcn_permlane16_swap(__float_as_uint(am), __float_as_uint(am), false, false); am = fmaxf(__uint_as_float(r[0]), __uint_as_float(r[1])); }
    { auto r = __builtin_amdgcn_permlane32_swap(__float_as_uint(am), __float_as_uint(am), false, false); am = fmaxf(__uint_as_float(r[0]), __uint_as_float(r[1])); }
    if (F.lane == 0) atomicMax(dst, __float_as_uint(am));
}
template <int MAP>
__device__ __forceinline__ void transpose_fp8(const Frame& F, const float* __restrict__ src, unsigned char* __restrict__ dst, int K, int Nsrc, int Nd, const unsigned* wsc) {
    float mul, inv; fp8_scale(__hip_atomic_load(wsc, __ATOMIC_RELAXED, __HIP_MEMORY_SCOPE_AGENT), mul, inv);
    LAS float* tile = (LAS float*)F.lds;
    const int tk = K / 256, tn = Nd / 64, ntile = tk * tn;
    for (int t = F.bid; t < ntile; t += F.G) {
        const int k0 = (t % tk) * 256, n0 = (t / tk) * 64;
        const int nl = F.tid & 63, kq = F.tid >> 6; const int ns = MAP ? win_col(n0 + nl) : n0 + nl;
        float v[32];
#pragma unroll
        for (int i = 0; i < 32; ++i) v[i] = ns >= 0 ? src[(size_t)(k0 + kq + 8 * i) * Nsrc + ns] : 0.f;
#pragma unroll
        for (int i = 0; i < 32; ++i) tile[(kq + 8 * i) * 65 + nl] = v[i] * mul;
        __syncthreads();
        { const int n = F.tid >> 3, k32 = (F.tid & 7) * 32;
#pragma unroll
          for (int c = 0; c < 2; ++c) { float w[16];
#pragma unroll
              for (int j = 0; j < 16; ++j) w[j] = tile[(k32 + c * 16 + j) * 65 + n];
              u32x4 o; o.x = pk4_fp8(w[0], w[1], w[2], w[3]); o.y = pk4_fp8(w[4], w[5], w[6], w[7]); o.z = pk4_fp8(w[8], w[9], w[10], w[11]); o.w = pk4_fp8(w[12], w[13], w[14], w[15]);
              *(u32x4*)(dst + (size_t)(n0 + n) * K + k0 + k32 + c * 16) = o; } }
        __syncthreads();
    }
}
__device__ __forceinline__ void p0_prologue(const Frame& F) {
    { const int gi = F.bid * 512 + F.tid;
      if (gi < 64 * 8) { const int pos = gi >> 3, f = gi & 7; const float inv = powf(10000.f, -(float)f / 8.f); const float a = (float)pos * inv; wsp<f32x2>(F, WS_ROPE32)[gi] = (f32x2){cosf(a), sinf(a)}; }
      else if (gi < 64 * 8 + 64 * 32) { const int g2 = gi - 512; const int pos = g2 >> 5, f = g2 & 31; const float inv = powf(10000.f, -(float)f / 32.f); const float a = (float)pos * inv; wsp<f32x2>(F, WS_ROPE128)[g2] = (f32x2){cosf(a), sinf(a)}; } }
    if (F.bid == 0 && F.tid < 32) wsp<float>(F, WS_DEC)[F.tid] = -log1pf(expf(-F.in(11)[F.tid])) * LOG2E;
    { LAS float* sl = (LAS float*)F.lds;
      float* modp = wsp<float>(F, WS_MODP);
      for (int u = F.bid; u < 2 * 24 * 16; u += F.G) {
          const int kc = u & 15, cb = (u >> 4) % 24, l = u / (16 * 24);
          __syncthreads();
          for (int i = F.tid; i < 640; i += 512) { const int v = i >> 7, k = kc * 128 + (i & 127); const float c = v < 4 ? F.in(1)[v * 2048 + k] : F.in(3)[k]; sl[i] = silu_f(c); }
          __syncthreads();
          const int col = cb * 512 + F.tid; const float* w = F.in(4) + ((size_t)l * 2048 + kc * 128) * 12288 + col;
          float a0 = 0.f, a1 = 0.f, a2 = 0.f, a3 = 0.f, a4 = 0.f;
#pragma unroll 32
          for (int k = 0; k < 128; ++k) { const float wv = w[(size_t)k * 12288]; a0 += sl[k] * wv; a1 += sl[128 + k] * wv; a2 += sl[256 + k] * wv; a3 += sl[384 + k] * wv; a4 += sl[512 + k] * wv; }
          float* o = modp + ((size_t)(kc * 2 + l) * 5) * 12288 + col;
          o[0] = a0; o[12288] = a1; o[2 * 12288] = a2; o[3 * 12288] = a3; o[4 * 12288] = a4;
      }
      __syncthreads(); }
    for (int l = 0; l < 2; ++l) {
        absmax_f32(F, F.in(6) + (size_t)l * 2048 * NIN, (size_t)2048 * NIN / 4, wsp<unsigned>(F, WS_WSC) + l);
        transpose_cvt<2>(F, F.in(8) + (size_t)l * 512 * 768, wsp<bf16_t>(F, WS_WQUP + l * SZ_WQUP), 512, 768, 768);
        transpose_cvt<0>(F, F.in(10) + (size_t)l * 256 * 1024, wsp<bf16_t>(F, WS_WKVUP + l * SZ_WKVUP), 256, 1024, 1024);
        transpose_cvt<0>(F, F.in(14) + (size_t)l * 512 * 2048, wsp<bf16_t>(F, WS_WBRA + l * SZ_WBRA), 512, 2048, 2048);
        transpose_cvt<0>(F, F.in(15) + (size_t)l * 512 * 2048, wsp<bf16_t>(F, WS_WBRB + l * SZ_WBRB), 512, 2048, 2048);
        transpose_cvt<0>(F, F.in(16) + (size_t)l * 1024 * 2048, wsp<bf16_t>(F, WS_WBRC + l * SZ_WBRC), 1024, 2048, 2048);
        absmax_f32(F, F.in(17) + (size_t)l * 2048 * 2048, (size_t)2048 * 2048 / 4, wsp<unsigned>(F, WS_WSC) + 2 + l);
        transpose_cvt<0>(F, F.in(20) + (size_t)l * 2048 * 1024, wsp<bf16_t>(F, WS_WPQ + l * SZ_WPQ), 2048, 1024, 1024);
    }
    cvt_peer(F, 0);
}
__device__ __forceinline__ void p1_modreduce(const Frame& F) {
    const float* modp = wsp<float>(F, WS_MODP); float* mod = wsp<float>(F, WS_MOD);
    for (int i = F.bid * 512 + F.tid; i < 2 * 5 * 12288; i += F.G * 512) {
        const int j = i % 12288, l = i / (5 * 12288);
        float s = F.in(5)[l * 12288 + j];
#pragma unroll
        for (int kc = 0; kc < 16; ++kc) s += modp[(size_t)kc * (2 * 5 * 12288) + i];
        mod[i] = s;
    }
    for (int l = 0; l < 2; ++l) {
        transpose_fp8<1>(F, F.in(6) + (size_t)l * 2048 * NIN, wsp<unsigned char>(F, WS_WIN + l * SZ_WIN), 2048, NIN, NPT, wsp<unsigned>(F, WS_WSC) + l);
        transpose_fp8<0>(F, F.in(17) + (size_t)l * 2048 * 2048, wsp<unsigned char>(F, WS_WOUT + l * SZ_WOUT), 2048, 2048, 2048, wsp<unsigned>(F, WS_WSC) + 2 + l);
    }
}
__device__ __forceinline__ void ld_row_f32(const float* p, int lane, float (&x)[32]) {
#pragma unroll
    for (int q = 0; q < 4; ++q) { const f32x4 a = *(const f32x4*)(p + 512 * q + 8 * lane), b = *(const f32x4*)(p + 512 * q + 8 * lane + 4);
        x[q * 8 + 0] = a[0]; x[q * 8 + 1] = a[1]; x[q * 8 + 2] = a[2]; x[q * 8 + 3] = a[3]; x[q * 8 + 4] = b[0]; x[q * 8 + 5] = b[1]; x[q * 8 + 6] = b[2]; x[q * 8 + 7] = b[3]; }
}
__device__ __forceinline__ void st_row_f32(float* p, int lane, const float (&x)[32]) {
#pragma unroll
    for (int q = 0; q < 4; ++q) { *(f32x4*)(p + 512 * q + 8 * lane) = (f32x4){x[q * 8 + 0], x[q * 8 + 1], x[q * 8 + 2], x[q * 8 + 3]}; *(f32x4*)(p + 512 * q + 8 * lane + 4) = (f32x4){x[q * 8 + 4], x[q * 8 + 5], x[q * 8 + 6], x[q * 8 + 7]}; }
}
__device__ __forceinline__ void st_row_bf16(bf16_t* p, int lane, const float (&x)[32]) {
#pragma unroll
    for (int q = 0; q < 4; ++q) { u32x4 w; w.x = cvt_pk_bf16(x[q * 8 + 0], x[q * 8 + 1]); w.y = cvt_pk_bf16(x[q * 8 + 2], x[q * 8 + 3]); w.z = cvt_pk_bf16(x[q * 8 + 4], x[q * 8 + 5]); w.w = cvt_pk_bf16(x[q * 8 + 6], x[q * 8 + 7]);
        *(u32x4*)(p + 512 * q + 8 * lane) = w; }
}
__device__ __forceinline__ void p_modulate0(const Frame& F) {
    const float* mod = wsp<float>(F, WS_MOD); unsigned char* hb8 = wsp<unsigned char>(F, WS_HB8);
    for (int row = F.bid * 8 + F.wave; row < NROW; row += F.G * 8) {
        const RowInfo ri = rowinfo(row);
        const float* xp = ri.lat ? F.in(0) + (size_t)row * D : F.in(2) + (size_t)(row - NLAT) * D;
        const float* mp = mod + (size_t)ri.v * 12288;
        float x[32], sh[32], sc[32];
        ld_row_f32(xp, F.lane, x); ld_row_f32(mp, F.lane, sh); ld_row_f32(mp + 2048, F.lane, sc);
#pragma unroll
        for (int i = 0; i < 32; ++i) x[i] = clamp8(x[i] * (1.f + sc[i]) + sh[i]);
#pragma unroll
        for (int q = 0; q < 4; ++q) { u32x2 w; w.x = pk4_fp8(x[q * 8 + 0], x[q * 8 + 1], x[q * 8 + 2], x[q * 8 + 3]); w.y = pk4_fp8(x[q * 8 + 4], x[q * 8 + 5], x[q * 8 + 6], x[q * 8 + 7]); *(u32x2*)(hb8 + (size_t)row * D + 512 * q + 8 * F.lane) = w; }
    }
}
__device__ __forceinline__ void p_post(const Frame& F, int l) {
    const bf16_t* P1 = wsp<bf16_t>(F, WS_P1);
    bf16_t* CQN = wsp<bf16_t>(F, WS_CQN); bf16_t* CKVN = wsp<bf16_t>(F, WS_CKVN);
    bf16_t* QG = wsp<bf16_t>(F, WS_QG); bf16_t* KG = wsp<bf16_t>(F, WS_KG); bf16_t* VG = wsp<bf16_t>(F, WS_VG);
    bf16_t* RQ = wsp<bf16_t>(F, WS_RQ); bf16_t* RK = wsp<bf16_t>(F, WS_RK); bf16_t* RV = wsp<bf16_t>(F, WS_RV);
    bf16_t* KM = wsp<bf16_t>(F, WS_KM);
    const f32x2* cs32 = wsp<f32x2>(F, WS_ROPE32); const f32x2* cs128 = wsp<f32x2>(F, WS_ROPE128);
    const float* gq_n = F.in(7) + l * 512; const float* gkv_n = F.in(9) + l * 256; const float* gqa_qn = F.in(12) + l * 128; const float* gqa_kn = F.in(13) + l * 128;
    LAS bf16_t* rs = (LAS bf16_t*)(F.lds + F.wave * 8192);
    const int lane = F.lane;
    const f32x4 gq0 = *(const f32x4*)(gq_n + lane * 8), gq1 = *(const f32x4*)(gq_n + lane * 8 + 4), gkv0 = *(const f32x4*)(gkv_n + lane * 4);
    const int gd0 = 2 * lane; const int gpart = gd0 >> 6, gdd = gd0 & 63; const bool glo = gdd < 32; const int gf = glo ? gdd : gdd - 32; const int gdp = glo ? gd0 + 32 : gd0 - 32;
    const float qn0 = gqa_qn[gd0], qn1 = gqa_qn[gd0 + 1], qnp0 = gqa_qn[gdp], qnp1 = gqa_qn[gdp + 1];
    const float kn0 = gqa_kn[gd0], kn1 = gqa_kn[gd0 + 1], knp0 = gqa_kn[gdp], knp1 = gqa_kn[gdp + 1];
    const int rhh = lane >> 3, rd0 = (lane & 7) * 4; const int rpart = rd0 >> 4, rdd = rd0 & 15; const bool rlo = rdd < 8; const int rf = rlo ? rdd : rdd - 8; const int rdp = rlo ? rd0 + 8 : rd0 - 8;
    const int step = F.G * 8;
    int row = F.bid * 8 + F.wave;
    u32x4 pre[8];
    if (row < NROW) {
#pragma unroll
        for (int q = 0; q < 8; ++q) pre[q] = *(const u32x4*)(P1 + (size_t)row * NP1 + q * 512 + lane * 8); }
#pragma unroll 1
    for (; row < NROW; row += step) {
        const RowInfo ri = rowinfo(row);
        const int posg = gpart ? ri.pc : ri.pr, posr = rpart ? ri.pc : ri.pr;
        const f32x2 one = {1.f, 0.f};
        const f32x2 csA = ri.lat ? cs128[posg * 32 + gf] : one, csB = ri.lat ? cs128[posg * 32 + gf + 1] : one;
        f32x2 cs[4];
#pragma unroll
        for (int i = 0; i < 4; ++i) cs[i] = ri.lat ? cs32[posr * 8 + rf + i] : one;
#pragma unroll
        for (int q = 0; q < 8; ++q) *(LAS u32x4*)(rs + q * 512 + lane * 8) = pre[q];
        { const int nrow = row + step; if (nrow < NROW) {
#pragma unroll
            for (int q = 0; q < 8; ++q) pre[q] = *(const u32x4*)(P1 + (size_t)nrow * NP1 + q * 512 + lane * 8); } }
        asm volatile("s_waitcnt lgkmcnt(0)" ::: "memory");
        { float x[8]; float ss = 0.f;
#pragma unroll
          for (int i = 0; i < 8; ++i) { x[i] = bf2f(rs[C_CQ + lane * 8 + i]); ss += x[i] * x[i]; }
          ss = wave_sum(ss); const float r = rsqrtf(ss * (1.f / 512.f) + RMS_EPS);
          *(u32x4*)(CQN + (size_t)row * 512 + lane * 8) = pack8((f32x4){x[0] * r * gq0[0], x[1] * r * gq0[1], x[2] * r * gq0[2], x[3] * r * gq0[3]}, (f32x4){x[4] * r * gq1[0], x[5] * r * gq1[1], x[6] * r * gq1[2], x[7] * r * gq1[3]}); }
        { float x[4]; float ss = 0.f;
#pragma unroll
          for (int i = 0; i < 4; ++i) { x[i] = bf2f(rs[C_CKV + lane * 4 + i]); ss += x[i] * x[i]; }
          ss = wave_sum(ss); const float r = rsqrtf(ss * (1.f / 256.f) + RMS_EPS);
          u32x2 w; w.x = cvt_pk_bf16(x[0] * r * gkv0[0], x[1] * r * gkv0[1]); w.y = cvt_pk_bf16(x[2] * r * gkv0[2], x[3] * r * gkv0[3]);
          *(u32x2*)(CKVN + (size_t)row * 256 + lane * 4) = w; }
        {
            const int d0 = gd0, dp = gdp; const bool lo = glo;
#pragma unroll 1
            for (int hh = 0; hh < 10; ++hh) {
                const bool isq = hh < 8; const int cbase = isq ? C_GQ + hh * 128 : C_GK + (hh - 8) * 128;
                const float g0 = isq ? qn0 : kn0, g1 = isq ? qn1 : kn1, gp0 = isq ? qnp0 : knp0, gp1 = isq ? qnp1 : knp1;
                const float a0 = bf2f(rs[cbase + d0]), a1 = bf2f(rs[cbase + d0 + 1]);
                float ss = wave_sum(a0 * a0 + a1 * a1); const float r = rsqrtf(ss * (1.f / 128.f) + RMS_EPS);
                const float n0 = a0 * r * g0, n1 = a1 * r * g1;
                const float p0 = bf2f(rs[cbase + dp]) * r * gp0, p1 = bf2f(rs[cbase + dp + 1]) * r * gp1;
                float o0, o1;
                if (lo) { o0 = n0 * csA.x - p0 * csA.y; o1 = n1 * csB.x - p1 * csB.y; }
                else    { o0 = p0 * csA.y + n0 * csA.x; o1 = p1 * csB.y + n1 * csB.x; }
                bf16_t* dst = isq ? QG + ((size_t)(ri.b * 8 + hh) * TT + ri.tpos) * 128 : KG + ((size_t)(ri.b * 2 + (hh - 8)) * TT + ri.tpos) * 128;
                *(unsigned*)(dst + d0) = cvt_pk_bf16(o0, o1);
            }
#pragma unroll
            for (int hh = 0; hh < 2; ++hh) *(unsigned*)(VG + ((size_t)(ri.b * 2 + hh) * TT + ri.tpos) * 128 + d0) = *(LAS unsigned*)(rs + C_GV + hh * 128 + d0);
        }
        {
            const int hh = rhh, d0 = rd0, dp = rdp; const bool lo = rlo;
#pragma unroll
            for (int which = 0; which < 2; ++which) {
                const int cbase = (which ? C_RK : C_RQ) + hh * 32; const float sc = which ? 0.17677669529663687f : 1.f;
                float o[4];
#pragma unroll
                for (int i = 0; i < 4; ++i) { const float n = bf2f(rs[cbase + d0 + i]), p = bf2f(rs[cbase + dp + i]);
                    o[i] = (lo ? (n * cs[i].x - p * cs[i].y) : (p * cs[i].y + n * cs[i].x)) * sc; }
                u32x2 w; w.x = cvt_pk_bf16(o[0], o[1]); w.y = cvt_pk_bf16(o[2], o[3]);
                *(u32x2*)((which ? RK : RQ) + ((size_t)(ri.b * 8 + hh) * TT + ri.tpos) * 32 + d0) = w;
            }
            { const int vh = lane >> 3, e0 = (lane & 7) * 8;
              *(u32x4*)(RV + ((size_t)(ri.b * 8 + vh) * TT + ri.tpos) * 64 + e0) = *(LAS u32x4*)(rs + C_RV + lane * 8); }
            { float o[4];
#pragma unroll
              for (int i = 0; i < 4; ++i) { const float n = bf2f(rs[C_KR + d0 + i]), p = bf2f(rs[C_KR + dp + i]); o[i] = lo ? (n * cs[i].x - p * cs[i].y) : (p * cs[i].y + n * cs[i].x); }
              u32x2 w; w.x = cvt_pk_bf16(o[0], o[1]); w.y = cvt_pk_bf16(o[2], o[3]);
              *(u32x2*)(KM + ((size_t)(ri.b * 8 + hh) * TT + ri.tpos) * 128 + 64 + d0) = w; }
        }
        asm volatile("s_waitcnt lgkmcnt(0)" ::: "memory");
    }
}

__device__ __forceinline__ void ret_logs(const Frame& F, int l, int h, float& lgf, float& lgb) {
    const float* t = wsp<float>(F, WS_DEC); lgf = t[(l * 2 + 0) * 8 + h]; lgb = t[(l * 2 + 1) * 8 + h];
}
constexpr int TP = 136;
template <bool WITH_K>
__device__ __forceinline__ void ret_stage(const Frame& F, const bf16_t* RKh, const bf16_t* RVh, int tpos0, float lgf, float lgb, LAS bf16_t* vt, LAS bf16_t* ktf, LAS bf16_t* ktb) {
#pragma unroll
    for (int i = 0; i < 2; ++i) { const int tok = (F.tid >> 3) + 64 * i, e0 = (F.tid & 7) * 8;
        const u32x4 w = *(const u32x4*)(RVh + (size_t)(tpos0 + tok) * 64 + e0); const unsigned ww[4] = {w.x, w.y, w.z, w.w};
#pragma unroll
        for (int j = 0; j < 4; ++j) { vt[(e0 + 2 * j) * TP + tok] = (bf16_t)(ww[j] & 0xffffu); vt[(e0 + 2 * j + 1) * TP + tok] = (bf16_t)(ww[j] >> 16); } }
    if (WITH_K) { const int tok = F.tid >> 2, k0 = (F.tid & 3) * 8;
        const u32x4 w = *(const u32x4*)(RKh + (size_t)(tpos0 + tok) * 32 + k0); const unsigned ww[4] = {w.x, w.y, w.z, w.w};
        const float zf = exp2f(lgf * (float)(127 - tok)), zb = exp2f(lgb * (float)tok);
#pragma unroll
        for (int j = 0; j < 4; ++j) { const float a = bflo(ww[j]), b = bfhi(ww[j]);
            ktf[(k0 + 2 * j) * TP + tok] = f2bf(a * zf); ktf[(k0 + 2 * j + 1) * TP + tok] = f2bf(b * zf);
            ktb[(k0 + 2 * j) * TP + tok] = f2bf(a * zb); ktb[(k0 + 2 * j + 1) * TP + tok] = f2bf(b * zb); } }
}
__device__ __forceinline__ void p_ret_states(const Frame& F, int l) {
    LAS bf16_t* vt = (LAS bf16_t*)F.lds; LAS bf16_t* ktf = vt + 64 * TP; LAS bf16_t* ktb = ktf + 32 * TP;
    float* ST = wsp<float>(F, WS_ST);
    const int lane = F.lane, w = F.wave, kb = w >> 2, eb = w & 3, fr = lane & 15, fq = lane >> 4;
    for (int u = F.bid; u < NB * 8 * 34; u += F.G) {
        const int c = u % 34, bh = u / 34, h = bh & 7;
        float lgf, lgb; ret_logs(F, l, h, lgf, lgb);
        __syncthreads();
        ret_stage<true>(F, wsp<bf16_t>(F, WS_RK) + (size_t)bh * TT * 32, wsp<bf16_t>(F, WS_RV) + (size_t)bh * TT * 64, c * 128, lgf, lgb, vt, ktf, ktb);
        __syncthreads();
        f32x4 sf = {0.f, 0.f, 0.f, 0.f}, sb = {0.f, 0.f, 0.f, 0.f};
#pragma unroll
        for (int ks = 0; ks < 4; ++ks) {
            const bf16x8 bv = *(const LAS bf16x8*)(vt + (eb * 16 + fr) * TP + ks * 32 + fq * 8);
            const bf16x8 af = *(const LAS bf16x8*)(ktf + (kb * 16 + fr) * TP + ks * 32 + fq * 8);
            const bf16x8 ab = *(const LAS bf16x8*)(ktb + (kb * 16 + fr) * TP + ks * 32 + fq * 8);
            sf = __builtin_amdgcn_mfma_f32_16x16x32_bf16(af, bv, sf, 0, 0, 0);
            sb = __builtin_amdgcn_mfma_f32_16x16x32_bf16(ab, bv, sb, 0, 0, 0);
        }
        float* o = ST + (size_t)u * 2 * 2048;
#pragma unroll
        for (int r = 0; r < 4; ++r) { const int kd = kb * 16 + fq * 4 + r, e = eb * 16 + fr; o[kd * 64 + e] = sf[r]; o[2048 + kd * 64 + e] = sb[r]; }
    }
}
constexpr int RP = 40;
constexpr int AP = 136;
__device__ __forceinline__ void ret_out_unit(const Frame& F, int l, int bh, int c) {
    LAS bf16_t* vt = (LAS bf16_t*)F.lds; LAS bf16_t* rtf = vt + 64 * TP; LAS bf16_t* rtb = rtf + 64 * RP; LAS bf16_t* as = rtb + 64 * RP + F.wave * 16 * AP;
    const int lane = F.lane, w = F.wave, fr = lane & 15, fq = lane >> 4, h = bh & 7, b = bh >> 3;
    const bf16_t* RQh = wsp<bf16_t>(F, WS_RQ) + (size_t)bh * TT * 32; const bf16_t* RKh = wsp<bf16_t>(F, WS_RK) + (size_t)bh * TT * 32; const bf16_t* RVh = wsp<bf16_t>(F, WS_RV) + (size_t)bh * TT * 64;
    const float* STh = wsp<float>(F, WS_ST) + (size_t)bh * 34 * 2 * 2048;
    float lgf, lgb; ret_logs(F, l, h, lgf, lgb);
    const int tpos0 = c * 128;
    __syncthreads();
    ret_stage<false>(F, RKh, RVh, tpos0, lgf, lgb, vt, nullptr, nullptr);
    { const int kd = F.tid >> 4, e4 = (F.tid & 15) * 4; f32x4 rf = {0.f, 0.f, 0.f, 0.f}, rb = {0.f, 0.f, 0.f, 0.f};
      if (c >= 2) {
          for (int cp = 0; cp < c; ++cp) { const float e2 = lgf * 128.f * (float)(c - 1 - cp); if (e2 < -80.f) continue; const float wgt = exp2f(e2);
              rf += *(const f32x4*)(STh + (size_t)(cp * 2 + 0) * 2048 + kd * 64 + e4) * wgt; }
          const int p = c - 2;
          for (int pp = p + 1; pp < 34; ++pp) { const float e2 = lgb * 128.f * (float)(pp - p - 1); if (e2 < -80.f) break; const float wgt = exp2f(e2); const int cs = pp < 32 ? pp + 2 : pp - 32;
              rb += *(const f32x4*)(STh + (size_t)(cs * 2 + 1) * 2048 + kd * 64 + e4) * wgt; }
      } else if (c == 0) { rb = *(const f32x4*)(STh + (size_t)(1 * 2 + 1) * 2048 + kd * 64 + e4); }
      else { rf = *(const f32x4*)(STh + (size_t)(0 * 2 + 0) * 2048 + kd * 64 + e4); }
#pragma unroll
      for (int j = 0; j < 4; ++j) { rtf[(e4 + j) * RP + kd] = f2bf(rf[j]); rtb[(e4 + j) * RP + kd] = f2bf(rb[j]); } }
    const int i0 = w * 16;
    const bf16x8 qa = *(const bf16x8*)(RQh + (size_t)(tpos0 + i0 + fr) * 32 + fq * 8);
    f32x4 s[8];
#pragma unroll
    for (int nb = 0; nb < 8; ++nb) { const bf16x8 kf = *(const bf16x8*)(RKh + (size_t)(tpos0 + nb * 16 + fr) * 32 + fq * 8);
        s[nb] = __builtin_amdgcn_mfma_f32_16x16x32_bf16(qa, kf, (f32x4){0.f, 0.f, 0.f, 0.f}, 0, 0, 0); }
#pragma unroll
    for (int nb = 0; nb < 8; ++nb)
#pragma unroll
        for (int r = 0; r < 4; ++r) { const int i = i0 + fq * 4 + r, j = nb * 16 + fr; const int df = i - j;
            const float mk = df > 0 ? exp2f(lgf * (float)df) : (df < 0 ? exp2f(lgb * (float)(-df)) : 2.f);
            as[(fq * 4 + r) * AP + j] = f2bf(s[nb][r] * mk); }
    __syncthreads();
    f32x4 y[4];
#pragma unroll
    for (int eb = 0; eb < 4; ++eb) y[eb] = (f32x4){0.f, 0.f, 0.f, 0.f};
#pragma unroll
    for (int ks = 0; ks < 4; ++ks) { const bf16x8 af = *(const LAS bf16x8*)(as + fr * AP + ks * 32 + fq * 8);
#pragma unroll
        for (int eb = 0; eb < 4; ++eb) { const bf16x8 bv = *(const LAS bf16x8*)(vt + (eb * 16 + fr) * TP + ks * 32 + fq * 8);
            y[eb] = __builtin_amdgcn_mfma_f32_16x16x32_bf16(af, bv, y[eb], 0, 0, 0); } }
    { const float xf = exp2f(lgf * (float)(i0 + fr + 1)), xb = exp2f(lgb * (float)(128 - (i0 + fr)));
      bf16x8 qf, qb;
#pragma unroll
      for (int j = 0; j < 8; ++j) { const float qv = bf2f((bf16_t)qa[j]); qf[j] = (short)f2bf(qv * xf); qb[j] = (short)f2bf(qv * xb); }
#pragma unroll
      for (int eb = 0; eb < 4; ++eb) { const bf16x8 bf_ = *(const LAS bf16x8*)(rtf + (eb * 16 + fr) * RP + fq * 8), bb_ = *(const LAS bf16x8*)(rtb + (eb * 16 + fr) * RP + fq * 8);
          y[eb] = __builtin_amdgcn_mfma_f32_16x16x32_bf16(qf, bf_, y[eb], 0, 0, 0);
          y[eb] = __builtin_amdgcn_mfma_f32_16x16x32_bf16(qb, bb_, y[eb], 0, 0, 0); } }
    const bf16_t* P1 = wsp<bf16_t>(F, WS_P1); bf16_t* OAB = wsp<bf16_t>(F, WS_OAB);
#pragma unroll
    for (int r = 0; r < 4; ++r) {
        float sm = y[0][r] + y[1][r] + y[2][r] + y[3][r]; sm = row16_sum(sm); const float mu = sm * (1.f / 64.f);
        float vs = 0.f;
#pragma unroll
        for (int eb = 0; eb < 4; ++eb) { const float d = y[eb][r] - mu; vs += d * d; }
        vs = row16_sum(vs); const float rstd = rsqrtf(vs * (1.f / 64.f) + LN_EPS);
        const int i = i0 + fq * 4 + r; const int tp = tpos0 + i; const size_t grow = tp >= CTXL ? (size_t)b * SEQ + (tp - CTXL) : (size_t)NLAT + b * CTXL + tp;
#pragma unroll
        for (int eb = 0; eb < 4; ++eb) { const int e = eb * 16 + fr; const float g = bf2f(P1[grow * NP1 + C_RG + h * 64 + e]);
            OAB[grow * D + 512 + h * 64 + e] = f2bf(silu_f(g) * (y[eb][r] - mu) * rstd); }
    }
}
namespace att {
constexpr int NW = 8, QBLK = 32, KVBLK = 64;
constexpr size_t SHM_V = KVBLK * 128 * 2, SHM_K = KVBLK * 128 * 2, SHM_ATTN = 2 * SHM_V + 2 * SHM_K + NW * 64 * 4;
constexpr float THR = 8.f;
#define KSWZ(row, colB) ((row) * 256 + ((colB) ^ (((row) & 7) << 4)))
#define SBAR() __builtin_amdgcn_sched_barrier(0)
__device__ __forceinline__ int crow(int r, int hi) { return (r & 3) + 8 * (r >> 2) + 4 * hi; }
template <int SC> struct Scale { static constexpr float S = SC == 0 ? 0.08838834764831845f : 0.10206207261596575f; static constexpr float C = S * 1.4426950408889634f; static constexpr float THRR = THR / S; };
template <int SC>
__device__ __forceinline__ void partialSM(f32x16& p0, f32x16& p1, float& m_reg, float& mn, float& alpha) {
  constexpr float C = Scale<SC>::C, thr_raw = Scale<SC>::THRR;
  float pmax = p0[0];
#pragma unroll
  for (int r = 1; r < 16; ++r) pmax = fmaxf(pmax, p0[r]);
#pragma unroll
  for (int r = 0; r < 16; ++r) pmax = fmaxf(pmax, p1[r]);
  { auto rr = __builtin_amdgcn_permlane32_swap(__float_as_uint(pmax), __float_as_uint(pmax), false, false);
    pmax = fmaxf(__uint_as_float(rr[0]), __uint_as_float(rr[1])); }
  if (__builtin_expect(__all(pmax - m_reg <= thr_raw), 1)) { mn = m_reg; alpha = 1.f; }
  else { mn = fmaxf(m_reg, pmax); alpha = __builtin_amdgcn_exp2f((m_reg - mn) * C); m_reg = mn; }
  const float mnC = -mn * C;
#pragma unroll
  for (int r = 0; r < 16; ++r) p0[r] = fmaf(p0[r], C, mnC);
#pragma unroll
  for (int r = 0; r < 16; ++r) p1[r] = fmaf(p1[r], C, mnC);
#pragma unroll
  for (int r = 0; r < 16; ++r) p0[r] = __builtin_amdgcn_exp2f(p0[r]);
}
__device__ __forceinline__ void finishSM(f32x16& p0, f32x16& p1, float alpha, float& l_reg, bf16x8& pa0, bf16x8& pa1, bf16x8& pa2, bf16x8& pa3) {
#pragma unroll
  for (int r = 0; r < 16; ++r) p1[r] = __builtin_amdgcn_exp2f(p1[r]);
  float ps = 0;
#pragma unroll
  for (int r = 0; r < 16; ++r) ps += p0[r];
#pragma unroll
  for (int r = 0; r < 16; ++r) ps += p1[r];
  { auto rr = __builtin_amdgcn_permlane32_swap(__float_as_uint(ps), __float_as_uint(ps), false, false);
    ps = __uint_as_float(rr[0]) + __uint_as_float(rr[1]); }
  l_reg = l_reg * alpha + ps;
#define PK4(P, BASE, OUT) do { unsigned a0 = cvt_pk_bf16(P[BASE + 0], P[BASE + 1]), a1 = cvt_pk_bf16(P[BASE + 2], P[BASE + 3]);   \
    unsigned b0 = cvt_pk_bf16(P[BASE + 4], P[BASE + 5]), b1 = cvt_pk_bf16(P[BASE + 6], P[BASE + 7]);                              \
    auto r0 = __builtin_amdgcn_permlane32_swap(a0, b0, false, false); auto r1 = __builtin_amdgcn_permlane32_swap(a1, b1, false, false); \
    u32x4 w = {r0[0], r1[0], r0[1], r1[1]}; OUT = *reinterpret_cast<bf16x8*>(&w); } while (0)
  PK4(p0, 0, pa0); PK4(p0, 8, pa1); PK4(p1, 0, pa2); PK4(p1, 8, pa3);
#undef PK4
}
template <int NDQ>
__device__ __forceinline__ void qkt(f32x16& p0, f32x16& p1, const char* Ks, const bf16x8* qr, int r32, int hi) {
  p0 = f32x16{}; p1 = f32x16{};
#pragma unroll
  for (int d0 = 0; d0 < NDQ; ++d0) { const int cb = (d0 * 16 + hi * 8) * 2;
    const bf16x8 b0 = *reinterpret_cast<const bf16x8*>(Ks + KSWZ(r32, cb));
    const bf16x8 b1 = *reinterpret_cast<const bf16x8*>(Ks + KSWZ(32 + r32, cb));
    p0 = __builtin_amdgcn_mfma_f32_32x32x16_bf16(b0, qr[d0], p0, 0, 0, 0);
    p1 = __builtin_amdgcn_mfma_f32_32x32x16_bf16(b1, qr[d0], p1, 0, 0, 0); }
}
__device__ __forceinline__ int v_st(int k, int c) { const int kk = (k & ~0xC) | ((k & 4) << 1) | ((k & 8) >> 1); return ((kk >> 3) * 4 + (c >> 5)) * 512 + ((kk & 7) * 32 + (c & 31)) * 2; }
__device__ __forceinline__ int v_rd_base(int lane) { return ((lane & 3) << 3) | (((lane >> 2) & 3) << 6) | (((lane >> 4) & 1) << 5) | (((lane >> 5) & 1) << 8); }
constexpr int v_rd_off(int d0, int ks, int half) { return d0 * 512 + ks * 4096 + half * 2048; }
template <int OFF> __device__ __forceinline__ s16x4 tr_read(int vb) {
  s16x4 r; asm volatile("ds_read_b64_tr_b16 %0, %1 offset:%2" : "=&v"(r) : "v"(vb), "i"(OFF) : "memory"); return r;
}
template <int D0> __device__ __forceinline__ void pv_one(f32x16& od, int vb, bf16x8 pa0, bf16x8 pa1, bf16x8 pa2, bf16x8 pa3) {
  const s16x4 l0 = tr_read<v_rd_off(D0, 0, 0)>(vb), h0 = tr_read<v_rd_off(D0, 0, 1)>(vb), l1 = tr_read<v_rd_off(D0, 1, 0)>(vb), h1 = tr_read<v_rd_off(D0, 1, 1)>(vb);
  const s16x4 l2 = tr_read<v_rd_off(D0, 2, 0)>(vb), h2 = tr_read<v_rd_off(D0, 2, 1)>(vb), l3 = tr_read<v_rd_off(D0, 3, 0)>(vb), h3 = tr_read<v_rd_off(D0, 3, 1)>(vb);
  asm volatile("s_waitcnt lgkmcnt(0)" ::: "memory"); SBAR();
#define PK(L, H) (bf16x8){L[0], L[1], L[2], L[3], H[0], H[1], H[2], H[3]}
  od = __builtin_amdgcn_mfma_f32_32x32x16_bf16(pa0, PK(l0, h0), od, 0, 0, 0);
  od = __builtin_amdgcn_mfma_f32_32x32x16_bf16(pa1, PK(l1, h1), od, 0, 0, 0);
  od = __builtin_amdgcn_mfma_f32_32x32x16_bf16(pa2, PK(l2, h2), od, 0, 0, 0);
  od = __builtin_amdgcn_mfma_f32_32x32x16_bf16(pa3, PK(l3, h3), od, 0, 0, 0);
#undef PK
}
template <int NDV> __device__ __forceinline__ void pv_d0(f32x16* o, int vb, bf16x8 pa0, bf16x8 pa1, bf16x8 pa2, bf16x8 pa3) {
  pv_one<0>(o[0], vb, pa0, pa1, pa2, pa3); pv_one<1>(o[1], vb, pa0, pa1, pa2, pa3);
  if constexpr (NDV == 4) { pv_one<2>(o[2], vb, pa0, pa1, pa2, pa3); pv_one<3>(o[3], vb, pa0, pa1, pa2, pa3); }
}
template <int NDQ, int NDV, int SC, int SDEPTH>
__device__ __forceinline__ void attn_body(const bf16_t* __restrict__ Qb, const bf16_t* __restrict__ Kh, const bf16_t* __restrict__ Vh,
                                          bf16_t* __restrict__ Ob, int seq, char* lds, const int tid) {
  constexpr int LDK = 128, LDV = NDV * 32, ldo = 2048;
  const int wid = tid >> 6, lane = tid & 63, r32 = lane & 31, hi = lane >> 5;
  char* V_lds = lds; char* K_lds = lds + 2 * SHM_V;
  float* ws = (float*)(lds + 2 * SHM_V + 2 * SHM_K) + wid * 64; float* li_l = ws; float* al_l = ws + 32;
  float m_reg = -1e30f, l_reg = 0; f32x16 o[NDV] = {}; bf16x8 qr[NDQ];
  const bf16_t* Qw = Qb + (long)(wid * QBLK + r32) * 128 + hi * 8;
#pragma unroll
  for (int d0 = 0; d0 < NDQ; ++d0) qr[d0] = *reinterpret_cast<const bf16x8*>(Qw + d0 * 16);
  const int sr = tid >> 4, sc = (tid & 15) * 8;
  const int vr = NDV == 4 ? sr : (tid >> 3), vc = NDV == 4 ? sc : (tid & 7) * 8;
  const int vst0 = v_st(NDV == 4 ? 2 * sr : vr, vc), vst1 = v_st(2 * sr + 1, sc);
  const int vb0 = (int)(uintptr_t)V_lds + v_rd_base(lane);
  struct { bf16x8 vs0, vs1, ks0, ks1; } sr_[SDEPTH];
#define SLOAD(i, k0) do { const bf16_t* vp_ = Vh + (long)((k0) + (NDV == 4 ? 2 * sr : vr)) * LDV + vc; const bf16_t* kp_ = Kh + (long)((k0) + 2 * sr) * LDK + sc; \
    sr_[i].vs0 = *reinterpret_cast<const bf16x8*>(vp_); if constexpr (NDV == 4) sr_[i].vs1 = *reinterpret_cast<const bf16x8*>(vp_ + LDV); \
    sr_[i].ks0 = *reinterpret_cast<const bf16x8*>(kp_); sr_[i].ks1 = *reinterpret_cast<const bf16x8*>(kp_ + LDK); } while (0)
#define SWRITE(b, i) do { *(bf16x8*)(V_lds + (b) * SHM_V + vst0) = sr_[i].vs0;          \
    if constexpr (NDV == 4) *(bf16x8*)(V_lds + (b) * SHM_V + vst1) = sr_[i].vs1; const int kc = sc * 2;               \
    *(bf16x8*)(K_lds + (b) * SHM_K + KSWZ(2 * sr, kc)) = sr_[i].ks0;                       \
    *(bf16x8*)(K_lds + (b) * SHM_K + KSWZ(2 * sr + 1, kc)) = sr_[i].ks1; } while (0)
#define SWAIT() do { if constexpr (SDEPTH == 1) asm volatile("s_waitcnt vmcnt(0)" ::: "memory"); else if constexpr (NDV == 4) asm volatile("s_waitcnt vmcnt(4)" ::: "memory"); else asm volatile("s_waitcnt vmcnt(3)" ::: "memory"); } while (0)
#define RESC(a) do { if (__any((a) < 1.f)) { if (hi == 0) al_l[r32] = (a); asm volatile("s_waitcnt lgkmcnt(0)" ::: "memory"); \
    _Pragma("unroll") for (int d = 0; d < NDV; ++d) _Pragma("unroll") for (int r = 0; r < 16; ++r) o[d][r] *= al_l[crow(r, hi)]; } } while (0)
  f32x16 pA0, pA1, pB0, pB1; float mnA, mnB, alA, alB; bf16x8 pa0, pa1, pa2, pa3; const int NT = seq / KVBLK;
  constexpr int SE = 0, SO = SDEPTH - 1;
  SLOAD(SE, 0); asm volatile("s_waitcnt vmcnt(0)" ::: "memory"); SWRITE(0, SE); __syncthreads();
  qkt<NDQ>(pA0, pA1, K_lds, qr, r32, hi); partialSM<SC>(pA0, pA1, m_reg, mnA, alA);
  SLOAD(SO, KVBLK); if constexpr (SDEPTH == 2) { if (2 < NT) SLOAD(SE, 2 * KVBLK); }
  SWAIT(); SWRITE(1, SO); __syncthreads();
  for (int j = 1; j + 1 < NT; j += 2) {
    SBAR(); qkt<NDQ>(pB0, pB1, K_lds + SHM_K, qr, r32, hi);
    finishSM(pA0, pA1, alA, l_reg, pa0, pa1, pa2, pa3); SBAR();
    SLOAD(SO, (j + SDEPTH) * KVBLK); SBAR();
    pv_d0<NDV>(o, vb0, pa0, pa1, pa2, pa3); partialSM<SC>(pB0, pB1, m_reg, mnB, alB);
    __syncthreads(); SWAIT(); SWRITE(0, SE);
    RESC(alB); __syncthreads();
    SBAR(); qkt<NDQ>(pA0, pA1, K_lds, qr, r32, hi);
    finishSM(pB0, pB1, alB, l_reg, pa0, pa1, pa2, pa3); SBAR();
    if (SDEPTH == 1 || j + 3 < NT) SLOAD(SE, (j + 1 + SDEPTH) * KVBLK); SBAR();
    pv_d0<NDV>(o, vb0 + (int)SHM_V, pa0, pa1, pa2, pa3); partialSM<SC>(pA0, pA1, m_reg, mnA, alA);
    __syncthreads(); SWAIT(); SWRITE(1, SO);
    RESC(alA); __syncthreads();
  }
  SBAR(); qkt<NDQ>(pB0, pB1, K_lds + SHM_K, qr, r32, hi);
  finishSM(pA0, pA1, alA, l_reg, pa0, pa1, pa2, pa3); SBAR();
  pv_d0<NDV>(o, vb0, pa0, pa1, pa2, pa3); partialSM<SC>(pB0, pB1, m_reg, mnB, alB);
  __syncthreads(); RESC(alB);
  finishSM(pB0, pB1, alB, l_reg, pa0, pa1, pa2, pa3); SBAR();
  pv_d0<NDV>(o, vb0 + (int)SHM_V, pa0, pa1, pa2, pa3);
  if (hi == 0) li_l[r32] = l_reg; asm volatile("s_waitcnt lgkmcnt(0)" ::: "memory");
  float rli[16];
#pragma unroll
  for (int r = 0; r < 16; ++r) rli[r] = __builtin_amdgcn_rcpf(li_l[crow(r, hi)]);
  bf16_t* Ow = Ob + (long)(wid * QBLK) * ldo;
#pragma unroll
  for (int r = 0; r < 16; ++r) { const int orow = crow(r, hi);
#pragma unroll
    for (int d0 = 0; d0 < NDV; ++d0) Ow[(long)orow * ldo + d0 * 32 + r32] = f2bf(o[d0][r] * rli[r]); }
#undef SLOAD
#undef SWRITE
#undef SWAIT
#undef RESC
}
}
__device__ __forceinline__ float* xres_row(const Frame& F, int row) { return row < NLAT ? F.out + (size_t)row * D : wsp<float>(F, WS_XC) + (size_t)(row - NLAT) * D; }
__device__ __forceinline__ void ln_row(float (&y)[32], const float* g, const float* b, int lane) {
    float s = 0.f;
#pragma unroll
    for (int i = 0; i < 32; ++i) s += y[i];
    const float mu = wave_sum(s) * (1.f / 2048.f);
    float q = 0.f;
#pragma unroll
    for (int i = 0; i < 32; ++i) { const float d = y[i] - mu; q += d * d; }
    const float rstd = rsqrtf(wave_sum(q) * (1.f / 2048.f) + LN_EPS);
#pragma unroll
    for (int qq = 0; qq < 4; ++qq) { const f32x4 g0 = *(const f32x4*)(g + 512 * qq + 8 * lane), g1 = *(const f32x4*)(g + 512 * qq + 8 * lane + 4), b0 = *(const f32x4*)(b + 512 * qq + 8 * lane), b1 = *(const f32x4*)(b + 512 * qq + 8 * lane + 4);
#pragma unroll
        for (int i = 0; i < 4; ++i) { y[qq * 8 + i] = (y[qq * 8 + i] - mu) * rstd * g0[i] + b0[i]; y[qq * 8 + 4 + i] = (y[qq * 8 + 4 + i] - mu) * rstd * g1[i] + b1[i]; } }
}
__device__ __forceinline__ void modulate_store(const float (&x)[32], const float* sh, const float* sc, bf16_t* dst, int lane) {
#pragma unroll
    for (int q = 0; q < 4; ++q) { const f32x4 h0 = *(const f32x4*)(sh + 512 * q + 8 * lane), h1 = *(const f32x4*)(sh + 512 * q + 8 * lane + 4), c0 = *(const f32x4*)(sc + 512 * q + 8 * lane), c1 = *(const f32x4*)(sc + 512 * q + 8 * lane + 4);
        f32x4 a, b;
#pragma unroll
        for (int i = 0; i < 4; ++i) { a[i] = x[q * 8 + i] * (1.f + c0[i]) + h0[i]; b[i] = x[q * 8 + 4 + i] * (1.f + c1[i]) + h1[i]; }
        *(u32x4*)(dst + 512 * q + 8 * lane) = pack8(a, b); }
}
__device__ __forceinline__ void p_ln1(const Frame& F, int l, bool last) {
    const float* mod = wsp<float>(F, WS_MOD) + (size_t)l * 5 * 12288; bf16_t* hb = wsp<bf16_t>(F, WS_HB);
    const float* g = F.in(18) + l * D; const float* b = F.in(19) + l * D;
    const int nrows = last ? NLAT : NROW; const int lane = F.lane, step = F.G * 8;
    float gg[32], bb[32]; ld_row_f32(g, lane, gg); ld_row_f32(b, lane, bb);
    int row = F.bid * 8 + F.wave;
    float yn[32];
    if (row < nrows) ld_row_f32(xres_row(F, row), lane, yn);
#pragma unroll 1
    for (; row < nrows; row += step) {
        const int v = row < NLAT ? (row >> 12) : 4; float* xp = xres_row(F, row);
        float y[32], sh[32], sc[32];
#pragma unroll
        for (int i = 0; i < 32; ++i) y[i] = yn[i];
        ld_row_f32(mod + (size_t)v * 12288 + 6144, lane, sh); ld_row_f32(mod + (size_t)v * 12288 + 8192, lane, sc);
        { const int nrow = row + step; if (nrow < nrows) ld_row_f32(xres_row(F, nrow), lane, yn); }
        float s = 0.f;
#pragma unroll
        for (int i = 0; i < 32; ++i) s += y[i];
        const float mu = wave_sum(s) * (1.f / 2048.f); float q = 0.f;
#pragma unroll
        for (int i = 0; i < 32; ++i) { const float d = y[i] - mu; q += d * d; }
        const float rstd = rsqrtf(wave_sum(q) * (1.f / 2048.f) + LN_EPS);
#pragma unroll
        for (int i = 0; i < 32; ++i) y[i] = (y[i] - mu) * rstd * gg[i] + bb[i];
        st_row_f32(xp, lane, y);
#pragma unroll
        for (int i = 0; i < 32; ++i) y[i] = y[i] * (1.f + sc[i]) + sh[i];
        st_row_bf16(hb + (size_t)row * D, lane, y);
    }
}

template <int NV>
__device__ __forceinline__ void top16(const float (&val)[NV], bool (&sel)[NV], int (&slot)[NV]) {
    unsigned key[NV];
#pragma unroll
    for (int v = 0; v < NV; ++v) { const unsigned u = __float_as_uint(val[v]); key[v] = (u & 0x80000000u) ? ~u : (u | 0x80000000u); }
    unsigned T = 0u;
#pragma unroll 1
    for (int bit = 31; bit >= 0; --bit) {
        const unsigned cand = T | (1u << bit); int cnt = 0;
#pragma unroll
        for (int v = 0; v < NV; ++v) cnt += __popcll(__ballot(key[v] >= cand));
        if (cnt >= 16) T = cand;
    }
    int ngt = 0;
#pragma unroll
    for (int v = 0; v < NV; ++v) ngt += __popcll(__ballot(key[v] > T));
    const int need = 16 - ngt;
    int run = 0, erun = 0;
#pragma unroll
    for (int v = 0; v < NV; ++v) {
        const unsigned long long mg = __ballot(key[v] > T), me = __ballot(key[v] == T);
        const int pg = __builtin_amdgcn_mbcnt_hi((unsigned)(mg >> 32), __builtin_amdgcn_mbcnt_lo((unsigned)mg, 0u));
        const int pe = __builtin_amdgcn_mbcnt_hi((unsigned)(me >> 32), __builtin_amdgcn_mbcnt_lo((unsigned)me, 0u));
        sel[v] = false; slot[v] = 0;
        if (key[v] > T) { sel[v] = true; slot[v] = run + pg; }
        else if (key[v] == T && (erun + pe) < need) { sel[v] = true; slot[v] = ngt + erun + pe; }
        run += __popcll(mg); erun += __popcll(me);
    }
}
__device__ __forceinline__ unsigned f2key(float f) { const unsigned u = __float_as_uint(f); return (u & 0x80000000u) ? ~u : (u | 0x80000000u); }
__device__ __forceinline__ float key2f(unsigned k) { return __uint_as_float((k & 0x80000000u) ? (k & 0x7fffffffu) : ~k); }
template <int NP, int NV>
__device__ __forceinline__ void bisect16(const unsigned (&key)[NP][NV], unsigned (&T)[NP]) {
    bool done[NP];
#pragma unroll
    for (int p = 0; p < NP; ++p) { T[p] = 0u; done[p] = false; }
#pragma unroll 1
    for (int bit = 31; bit >= 0; --bit) {
        const unsigned bm = 1u << bit; bool all = true;
#pragma unroll
        for (int p = 0; p < NP; ++p) {
            const unsigned cand = T[p] | bm; int cnt = 0;
#pragma unroll
            for (int v = 0; v < NV; ++v) cnt += __popcll(__ballot(key[p][v] >= cand));
            const bool upd = (cnt >= 16) && !done[p];
            T[p] = upd ? cand : T[p]; done[p] = done[p] || (cnt == 16); all = all && done[p];
        }
        if (all) break;
    }
}
template <int NV>
__device__ __forceinline__ void compact16(const unsigned (&key)[NV], const unsigned T, bool (&sel)[NV], int (&slot)[NV]) {
    int ngt = 0;
#pragma unroll
    for (int v = 0; v < NV; ++v) ngt += __popcll(__ballot(key[v] > T));
    const int need = 16 - ngt; int run = 0, erun = 0;
#pragma unroll
    for (int v = 0; v < NV; ++v) {
        const unsigned long long mg = __ballot(key[v] > T), me = __ballot(key[v] == T);
        const int pg = __builtin_amdgcn_mbcnt_hi((unsigned)(mg >> 32), __builtin_amdgcn_mbcnt_lo((unsigned)mg, 0u));
        const int pe = __builtin_amdgcn_mbcnt_hi((unsigned)(me >> 32), __builtin_amdgcn_mbcnt_lo((unsigned)me, 0u));
        sel[v] = false; slot[v] = 0;
        if (key[v] > T) { sel[v] = true; slot[v] = run + pg; }
        else if (key[v] == T && (erun + pe) < need) { sel[v] = true; slot[v] = ngt + erun + pe; }
        run += __popcll(mg); erun += __popcll(me);
    }
}
constexpr int KP = 68;
constexpr int PW_BYTES = 9344;
__device__ __forceinline__ float gelu_erf(float x) {
    const float z = fabsf(x) * 0.7071067811865476f; const float t = __builtin_amdgcn_rcpf(1.f + 0.3275911f * z);
    float p = 1.061405429f; p = p * t - 1.453152027f; p = p * t + 1.421413741f; p = p * t - 0.284496736f; p = p * t + 0.254829592f; p = p * t;
    const float er = 1.f - p * __expf(-z * z);
    return 0.5f * x * (1.f + (x < 0.f ? -er : er));
}
__device__ __forceinline__ float wave_max(float x) {
    x = row16_max(x);
    { auto r = __builtin_amdgcn_permlane16_swap(__float_as_uint(x), __float_as_uint(x), false, false); x = fmaxf(__uint_as_float(r[0]), __uint_as_float(r[1])); }
    { auto r = __builtin_amdgcn_permlane32_swap(__float_as_uint(x), __float_as_uint(x), false, false); x = fmaxf(__uint_as_float(r[0]), __uint_as_float(r[1])); }
    return x;
}
__device__ __forceinline__ void ld16_f32(const float* p, int lane, float (&x)[32]) {
#pragma unroll
    for (int q = 0; q < 2; ++q)
#pragma unroll
        for (int d = 0; d < 4; ++d) { const f32x4 a = *(const f32x4*)(p + 1024 * q + 16 * lane + 4 * d); x[q * 16 + d * 4 + 0] = a[0]; x[q * 16 + d * 4 + 1] = a[1]; x[q * 16 + d * 4 + 2] = a[2]; x[q * 16 + d * 4 + 3] = a[3]; }
}
__device__ __forceinline__ void ld16_f32_nt(const float* p, int lane, float (&x)[32]) {
#pragma unroll
    for (int q = 0; q < 2; ++q)
#pragma unroll
        for (int d = 0; d < 4; ++d) { const f32x4 a = __builtin_nontemporal_load((const f32x4*)(p + 1024 * q + 16 * lane + 4 * d)); x[q * 16 + d * 4 + 0] = a[0]; x[q * 16 + d * 4 + 1] = a[1]; x[q * 16 + d * 4 + 2] = a[2]; x[q * 16 + d * 4 + 3] = a[3]; }
}
__device__ __forceinline__ void st16_f32_nt(float* p, int lane, const float (&x)[32]) {
#pragma unroll
    for (int q = 0; q < 2; ++q)
#pragma unroll
        for (int d = 0; d < 4; ++d) __builtin_nontemporal_store((f32x4){x[q * 16 + d * 4 + 0], x[q * 16 + d * 4 + 1], x[q * 16 + d * 4 + 2], x[q * 16 + d * 4 + 3]}, (f32x4*)(p + 1024 * q + 16 * lane + 4 * d));
}
__device__ __forceinline__ void st16_f32(float* p, int lane, const float (&x)[32]) {
#pragma unroll
    for (int q = 0; q < 2; ++q)
#pragma unroll
        for (int d = 0; d < 4; ++d) *(f32x4*)(p + 1024 * q + 16 * lane + 4 * d) = (f32x4){x[q * 16 + d * 4 + 0], x[q * 16 + d * 4 + 1], x[q * 16 + d * 4 + 2], x[q * 16 + d * 4 + 3]};
}
__device__ __forceinline__ void ld16_bf16(const bf16_t* p, int lane, float (&x)[32]) {
#pragma unroll
    for (int q = 0; q < 2; ++q)
#pragma unroll
        for (int d = 0; d < 2; ++d) { const u32x4 w = *(const u32x4*)(p + 1024 * q + 16 * lane + 8 * d); float* o = &x[q * 16 + d * 8];
            o[0] = bflo(w.x); o[1] = bfhi(w.x); o[2] = bflo(w.y); o[3] = bfhi(w.y); o[4] = bflo(w.z); o[5] = bfhi(w.z); o[6] = bflo(w.w); o[7] = bfhi(w.w); }
}
__device__ __forceinline__ void st16_bf16(bf16_t* p, int lane, const float (&x)[32]) {
#pragma unroll
    for (int q = 0; q < 2; ++q)
#pragma unroll
        for (int d = 0; d < 2; ++d) { const float* o = &x[q * 16 + d * 8]; u32x4 w; w.x = cvt_pk_bf16(o[0], o[1]); w.y = cvt_pk_bf16(o[2], o[3]); w.z = cvt_pk_bf16(o[4], o[5]); w.w = cvt_pk_bf16(o[6], o[7]);
            *(u32x4*)(p + 1024 * q + 16 * lane + 8 * d) = w; }
}
constexpr int TBS = 1152;
__device__ __forceinline__ void cvt_row_fp4b(int lane, const float* __restrict__ src, unsigned char* __restrict__ dst) {
    float x[32];
#pragma unroll
    for (int q = 0; q < 2; ++q)
#pragma unroll
        for (int d = 0; d < 4; ++d) { const f32x4 a = __builtin_nontemporal_load((const f32x4*)(src + 1024 * q + 16 * lane + 4 * d)); x[q * 16 + d * 4 + 0] = a[0]; x[q * 16 + d * 4 + 1] = a[1]; x[q * 16 + d * 4 + 2] = a[2]; x[q * 16 + d * 4 + 3] = a[3]; }
    float am = 0.f;
#pragma unroll
    for (int i = 0; i < 32; ++i) am = fmaxf(am, fabsf(x[i]));
    const bf16_t sb = f2bf(am * (1.f / 6.f)); const float sf = bf2f(sb); const float sc = sf > 0.f ? 1.f / sf : 0.f;
    u32x4 w;
#pragma unroll
    for (int d = 0; d < 4; ++d) { unsigned t = 0u; const int o = (d >> 1) * 16 + (d & 1) * 8;
        t = __builtin_amdgcn_cvt_scalef32_pk_fp4_f32(t, x[o + 0] * sc, x[o + 1] * sc, 1.0f, 0); t = __builtin_amdgcn_cvt_scalef32_pk_fp4_f32(t, x[o + 2] * sc, x[o + 3] * sc, 1.0f, 1);
        t = __builtin_amdgcn_cvt_scalef32_pk_fp4_f32(t, x[o + 4] * sc, x[o + 5] * sc, 1.0f, 2); t = __builtin_amdgcn_cvt_scalef32_pk_fp4_f32(t, x[o + 6] * sc, x[o + 7] * sc, 1.0f, 3); w[d] = t; }
    *(u32x4*)(dst + 16 * lane) = w;
    *(bf16_t*)(dst + 1024 + 2 * lane) = sb;
}
__device__ __forceinline__ void cvt_row_fp4r(int lane, const float* __restrict__ src, unsigned char* __restrict__ dst, float* __restrict__ inv) {
    float x[32];
#pragma unroll
    for (int q = 0; q < 2; ++q)
#pragma unroll
        for (int d = 0; d < 4; ++d) { const f32x4 a = __builtin_nontemporal_load((const f32x4*)(src + 1024 * q + 16 * lane + 4 * d)); x[q * 16 + d * 4 + 0] = a[0]; x[q * 16 + d * 4 + 1] = a[1]; x[q * 16 + d * 4 + 2] = a[2]; x[q * 16 + d * 4 + 3] = a[3]; }
    float am = 0.f;
#pragma unroll
    for (int i = 0; i < 32; ++i) am = fmaxf(am, fabsf(x[i]));
    am = wave_max(am);
    const float sc = am > 0.f ? 6.f / am : 1.f;
    if (lane == 0) *inv = am > 0.f ? am * (1.f / 6.f) : 1.f;
    u32x4 w;
#pragma unroll
    for (int d = 0; d < 4; ++d) { unsigned t = 0u; const int o = (d >> 1) * 16 + (d & 1) * 8;
        t = __builtin_amdgcn_cvt_scalef32_pk_fp4_f32(t, x[o + 0] * sc, x[o + 1] * sc, 1.0f, 0); t = __builtin_amdgcn_cvt_scalef32_pk_fp4_f32(t, x[o + 2] * sc, x[o + 3] * sc, 1.0f, 1);
        t = __builtin_amdgcn_cvt_scalef32_pk_fp4_f32(t, x[o + 4] * sc, x[o + 5] * sc, 1.0f, 2); t = __builtin_amdgcn_cvt_scalef32_pk_fp4_f32(t, x[o + 6] * sc, x[o + 7] * sc, 1.0f, 3); w[d] = t; }
    *(u32x4*)(dst + 16 * lane) = w;
}
__device__ __forceinline__ void cvt_peer(const Frame& F, int l) {
    for (int r = F.bid * 8 + F.wave; r < 16384; r += F.G * 8) cvt_row_fp4b(F.lane, F.in(23) + ((size_t)l * 16384 + r) * 2048, wsp<unsigned char>(F, WS_PU) + (size_t)l * SZ_PT + (size_t)r * TBS);
    for (int r = F.bid * 8 + F.wave; r < 16384; r += F.G * 8) cvt_row_fp4b(F.lane, F.in(24) + ((size_t)l * 16384 + r) * 2048, wsp<unsigned char>(F, WS_PV) + (size_t)l * SZ_PT + (size_t)r * TBS);
}
#define PEER_G 4
template <int CTRL> __device__ __forceinline__ int dppi(int x) { return __builtin_amdgcn_update_dpp(0, x, CTRL, 0xF, 0xF, true); }
__device__ __forceinline__ int irow16_sum(int x) { x += dppi<0xB1>(x); x += dppi<0x4E>(x); x += dppi<0x141>(x); x += dppi<0x140>(x); return x; }
__device__ __forceinline__ int irow16_incl_scan(int x) { x += dppi<0x111>(x); x += dppi<0x112>(x); x += dppi<0x114>(x); x += dppi<0x118>(x); return x; }
constexpr int KBP = 72;
constexpr int PT_WORDS = 6 * 128 + 160 + 3 * 128;
constexpr int PWB = 2 * PT_WORDS * 4;
__device__ __forceinline__ void p_peer(const Frame& F, int l, bool last) {
    LAS bf16_t* kb1 = (LAS bf16_t*)F.lds; LAS bf16_t* kb2 = kb1 + 128 * KBP;
    LAS unsigned* wbase = (LAS unsigned*)(F.lds + 2 * 128 * KBP * 2 + F.wave * PWB);
    const int lane = F.lane, fr = lane & 15, fq = lane >> 4;
    __syncthreads();
    for (int i = F.tid; i < 128 * 64; i += 512) { const int r = i >> 6, d = i & 63; kb1[r * KBP + d] = f2bf(F.in(21)[(size_t)l * 8192 + i]); kb2[r * KBP + d] = f2bf(F.in(22)[(size_t)l * 8192 + i]); }
    __syncthreads();
    const bf16_t* QP = wsp<bf16_t>(F, WS_QP); const bf16_t* HB = wsp<bf16_t>(F, WS_HB); unsigned char* HB8w = wsp<unsigned char>(F, WS_HB8);
    const unsigned char* PU = wsp<unsigned char>(F, WS_PU) + (size_t)l * SZ_PT; const unsigned char* PV = wsp<unsigned char>(F, WS_PV) + (size_t)l * SZ_PT;
    const float* modl = wsp<float>(F, WS_MOD) + (size_t)l * 5 * 12288; const float* modn = wsp<float>(F, WS_MOD) + (size_t)(l + 1) * 5 * 12288;
    const float* g2n = F.in(25) + l * D; const float* b2n = F.in(26) + l * D;
    const int npairs = (last ? NLAT : NROW) / 2;
    const int per_wg = (npairs + F.G - 1) / F.G; const int p_lo = F.bid * per_wg; const int p_hi = (p_lo + per_wg) < npairs ? (p_lo + per_wg) : npairs;
    LAS int* wq = (LAS int*)(F.lds + 147456 - 32);
    if (F.tid == 0) *wq = 0;
    __syncthreads();
#pragma unroll 1
    for (;;) {
        int pi = 0; if (lane == 0) pi = __hip_atomic_fetch_add(wq, 1, __ATOMIC_RELAXED, __HIP_MEMORY_SCOPE_WORKGROUP);
        pi = p_lo + __builtin_amdgcn_readfirstlane(pi); if (pi >= p_hi) break;
        const int rowA = 2 * pi;
#pragma unroll 1
        for (int rep1_ = 0; rep1_ <= REP_PS1; ++rep1_) {
            unsigned kk[2][8][4];
            { int fr_ = fr; asm volatile("" : "+v"(fr_));
              const bf16_t* qrow = QP + (size_t)(rowA + (fr_ >> 3)) * 1024 + (fr_ & 7) * 128 + 8 * fq;
              bf16x8 af[2][2];
#pragma unroll
              for (int st = 0; st < 2; ++st)
#pragma unroll
                  for (int ks = 0; ks < 2; ++ks) af[st][ks] = *(const bf16x8*)(qrow + st * 64 + ks * 32);
#pragma unroll
              for (int st = 0; st < 2; ++st) { LAS bf16_t* kb = st ? kb2 : kb1;
#pragma unroll
                  for (int nb = 0; nb < 8; ++nb) { f32x4 c = {0.f, 0.f, 0.f, 0.f};
#pragma unroll
                      for (int ks = 0; ks < 2; ++ks) { const bf16x8 bfr = *(const LAS bf16x8*)(kb + (nb * 16 + fr) * KBP + ks * 32 + 8 * fq); c = __builtin_amdgcn_mfma_f32_16x16x32_bf16(af[st][ks], bfr, c, 0, 0, 0); }
#pragma unroll
                      for (int r = 0; r < 4; ++r) kk[st][nb][r] = f2key(c[r]); } } }
            unsigned T[2][4]; bool done[2][4];
#pragma unroll
            for (int st = 0; st < 2; ++st)
#pragma unroll
                for (int r = 0; r < 4; ++r) { T[st][r] = 0u; done[st][r] = false; }
#pragma unroll 1
            for (int bit = 31; bit >= 0; --bit) { const unsigned bm = 1u << bit; bool alld = true;
#pragma unroll
                for (int st = 0; st < 2; ++st)
#pragma unroll
                    for (int r = 0; r < 4; ++r) { const unsigned cand = T[st][r] | bm; int c = 0;
#pragma unroll
                        for (int nb = 0; nb < 8; ++nb) c += (kk[st][nb][r] >= cand) ? 1 : 0;
                        c = irow16_sum(c);
                        const bool upd = (c >= 16) && !done[st][r]; T[st][r] = upd ? cand : T[st][r]; done[st][r] = done[st][r] || (c == 16); alld = alld && done[st][r]; }
                if (__all(alld)) break; }
            const int tt = lane >> 5, hd0 = ((lane >> 4) & 1) * 4;
#pragma unroll
            for (int st = 0; st < 2; ++st)
#pragma unroll
                for (int r = 0; r < 4; ++r) { const unsigned Tr = T[st][r]; int g = 0, e = 0;
#pragma unroll
                    for (int nb = 0; nb < 8; ++nb) { g += (kk[st][nb][r] > Tr) ? 1 : 0; e += (kk[st][nb][r] == Tr) ? 1 : 0; }
                    int gpre = irow16_incl_scan(g) - g, epre = irow16_incl_scan(e) - e; const int ngt = irow16_sum(g); const int need = 16 - ngt;
                    LAS unsigned* tb = wbase + tt * PT_WORDS; LAS float* vl = (LAS float*)(tb + st * 128) + (hd0 + r) * 16; LAS int* il = (LAS int*)(tb + 256 + st * 128) + (hd0 + r) * 16;
#pragma unroll
                    for (int nb = 0; nb < 8; ++nb) { const unsigned k = kk[st][nb][r];
                        if (k > Tr) { vl[gpre] = key2f(k); il[gpre] = nb * 16 + fr; ++gpre; }
                        else if (k == Tr) { if (epre < need) { vl[ngt + epre] = key2f(k); il[ngt + epre] = nb * 16 + fr; } ++epre; } } }
        }
        asm volatile("s_waitcnt lgkmcnt(0)" ::: "memory");
        {
            const int tt = lane >> 5, hd0 = ((lane >> 4) & 1) * 4; LAS unsigned* tb = wbase + tt * PT_WORDS;
            unsigned ck[4][16];
#pragma unroll
            for (int r = 0; r < 4; ++r) { const float va = ((LAS float*)tb)[(hd0 + r) * 16 + fr]; const LAS float* v2p = (LAS float*)(tb + 128) + (hd0 + r) * 16;
#pragma unroll
                for (int j4 = 0; j4 < 4; ++j4) { const f32x4 vb = *(const LAS f32x4*)(v2p + j4 * 4);
#pragma unroll
                    for (int i = 0; i < 4; ++i) ck[r][j4 * 4 + i] = f2key(va + vb[i]); } }
            unsigned T[4]; bool done[4];
#pragma unroll
            for (int r = 0; r < 4; ++r) { T[r] = 0u; done[r] = false; }
#pragma unroll 1
            for (int bit = 31; bit >= 0; --bit) { const unsigned bm = 1u << bit; bool alld = true;
#pragma unroll
                for (int r = 0; r < 4; ++r) { const unsigned cand = T[r] | bm; int c = 0;
#pragma unroll
                    for (int j = 0; j < 16; ++j) c += (ck[r][j] >= cand) ? 1 : 0;
                    c = irow16_sum(c);
                    const bool upd = (c >= 16) && !done[r]; T[r] = upd ? cand : T[r]; done[r] = done[r] || (c == 16); alld = alld && done[r]; }
                if (__all(alld)) break; }
#pragma unroll
            for (int r = 0; r < 4; ++r) { const unsigned Tr = T[r]; int g = 0, e = 0;
#pragma unroll
                for (int j = 0; j < 16; ++j) { g += (ck[r][j] > Tr) ? 1 : 0; e += (ck[r][j] == Tr) ? 1 : 0; }
                int gpre = irow16_incl_scan(g) - g, epre = irow16_incl_scan(e) - e; const int ngt = irow16_sum(g); const int need = 16 - ngt;
                const int e1 = ((LAS int*)(tb + 256))[(hd0 + r) * 16 + fr] * 128; const LAS int* i2p = (LAS int*)(tb + 384) + (hd0 + r) * 16;
                LAS float* cs_ = (LAS float*)(tb + 512) + (hd0 + r) * 16; LAS int* ce_ = (LAS int*)(tb + 640) + (hd0 + r) * 16;
#pragma unroll
                for (int j = 0; j < 16; ++j) { const unsigned k = ck[r][j];
                    if (k > Tr) { cs_[gpre] = key2f(k); ce_[gpre] = e1 + i2p[j]; ++gpre; }
                    else if (k == Tr) { if (epre < need) { cs_[ngt + epre] = key2f(k); ce_[ngt + epre] = e1 + i2p[j]; } ++epre; } } }
        }
        asm volatile("s_waitcnt lgkmcnt(0)" ::: "memory");
#pragma unroll 1
      for (int t = 0; t < 2; ++t) {
        const int row = rowA + t; const int v = row < NLAT ? (row >> 12) : 4;
        LAS unsigned* tb = wbase + t * PT_WORDS;
        LAS float* v1l = (LAS float*)tb; LAS float* v2l = v1l + 128; LAS int* i1l = (LAS int*)(v2l + 128); LAS int* i2l = i1l + 128;
        LAS float* csl = (LAS float*)(i2l + 128); LAS int* cel = (LAS int*)(csl + 128); LAS int* el = cel + 128; LAS float* gl = (LAS float*)(el + 160); LAS float* su = gl + 128; LAS float* sv = su + 128;
        {
#pragma unroll
            for (int it = 0; it < 2; ++it) { const int idx = it * 64 + lane;
                const float sx = csl[idx]; const float mx = row16_max(sx); const float pe_ = __expf(sx - mx); const float sm = row16_sum(pe_);
                el[idx] = cel[idx]; gl[idx] = pe_ / sm; }
        }
        if (lane < 32) el[128 + lane] = el[0];
        asm volatile("s_waitcnt vmcnt(0) lgkmcnt(0)" ::: "memory");
        float hh[32]; ld16_bf16(HB + (size_t)row * D, lane, hh);
        f32x2 hh2[16];
#pragma unroll
        for (int i = 0; i < 16; ++i) hh2[i] = (f32x2){hh[2 * i], hh[2 * i + 1]};
        const bool b0_ = lane & 1, b1_ = lane & 2, b2_ = lane & 4;
        u32x4 A[8], B[8], C[8]; unsigned SA[8], SB[8], SC[8];
#define PEER_LOADT(buf, sbuf, tab, g) do { _Pragma("unroll") for (int x = 0; x < 8; ++x) { const int e = __builtin_amdgcn_readfirstlane(el[(g) * 8 + x]); const unsigned char* rp = (tab) + (size_t)e * TBS; \
            buf[x] = *(const u32x4*)(rp + 16 * lane); sbuf[x] = *(const bf16_t*)(rp + 1024 + 2 * lane); } } while (0)
#define PEER_LOADV(buf, g) do { _Pragma("unroll") for (int x = 0; x < 8; ++x) { const int e = __builtin_amdgcn_readfirstlane(el[(g) * 8 + x]); buf[x] = *(const u32x4*)(PV + (size_t)e * 1024 + 16 * lane); } } while (0)
#define FP4X8(w_, f0_, f1_, f2_, f3_) const f32x2 f0_ = __builtin_amdgcn_cvt_scalef32_pk_f32_fp4(w_, 1.0f, 0), f1_ = __builtin_amdgcn_cvt_scalef32_pk_f32_fp4(w_, 1.0f, 1), f2_ = __builtin_amdgcn_cvt_scalef32_pk_f32_fp4(w_, 1.0f, 2), f3_ = __builtin_amdgcn_cvt_scalef32_pk_f32_fp4(w_, 1.0f, 3)
#define PEER_DOT(buf, sbuf, g) do { float p_[8]; \
            _Pragma("unroll") for (int x = 0; x < 8; ++x) { f32x2 s2_ = {0.f, 0.f}; \
                _Pragma("unroll") for (int d = 0; d < 4; ++d) { const unsigned w_ = buf[x][d]; FP4X8(w_, f0_, f1_, f2_, f3_); const int o_ = (d >> 1) * 8 + (d & 1) * 4; \
                    s2_ = hh2[o_ + 0] * f0_ + s2_; s2_ = hh2[o_ + 1] * f1_ + s2_; s2_ = hh2[o_ + 2] * f2_ + s2_; s2_ = hh2[o_ + 3] * f3_ + s2_; } \
                p_[x] = (s2_.x + s2_.y) * __uint_as_float(sbuf[x] << 16); SBAR(); } \
              \
            float q_[4], r_[2]; \
            _Pragma("unroll") for (int j = 0; j < 4; ++j) { const float keep_ = b0_ ? p_[2 * j + 1] : p_[2 * j], send_ = b0_ ? p_[2 * j] : p_[2 * j + 1]; q_[j] = keep_ + dppf<0xB1>(send_); } \
            _Pragma("unroll") for (int j = 0; j < 2; ++j) { const float keep_ = b1_ ? q_[2 * j + 1] : q_[2 * j], send_ = b1_ ? q_[2 * j] : q_[2 * j + 1]; r_[j] = keep_ + dppf<0x4E>(send_); } \
            float t_; { const float keep_ = b2_ ? r_[1] : r_[0], send_ = b2_ ? r_[0] : r_[1]; const float up_ = dppf<0x104>(send_), dn_ = dppf<0x114>(send_); t_ = keep_ + (b2_ ? dn_ : up_); } \
            t_ += dppf<0x128>(t_); \
            { auto r16_ = __builtin_amdgcn_permlane16_swap(__float_as_uint(t_), __float_as_uint(t_), false, false); t_ = __uint_as_float(r16_[0]) + __uint_as_float(r16_[1]); } \
            { auto r32_ = __builtin_amdgcn_permlane32_swap(__float_as_uint(t_), __float_as_uint(t_), false, false); t_ = __uint_as_float(r32_[0]) + __uint_as_float(r32_[1]); } \
            const float av = gelu_erf(t_) * gl[(g) * 8 + (lane & 7)]; const bool me_ = (lane >> 3) == ((g) & 7); \
            avl = (me_ && (g) < 8) ? av : avl; avh = (me_ && (g) >= 8) ? av : avh; } while (0)
#define PIN_ACC() do { asm volatile("" : "+v"(acc2[0]), "+v"(acc2[1]), "+v"(acc2[2]), "+v"(acc2[3]), "+v"(acc2[4]), "+v"(acc2[5]), "+v"(acc2[6]), "+v"(acc2[7]), "+v"(acc2[8]), "+v"(acc2[9]), "+v"(acc2[10]), "+v"(acc2[11]), "+v"(acc2[12]), "+v"(acc2[13]), "+v"(acc2[14]), "+v"(acc2[15])); } while (0)
#define PEER_AXPY(buf, sbuf, g) do { _Pragma("unroll") for (int x = 0; x < 8; ++x) { const int idx = (g) * 8 + x; \
            const float av = __uint_as_float(__builtin_amdgcn_readlane(__float_as_uint(idx < 64 ? avl : avh), idx & 63)) * __uint_as_float(sbuf[x] << 16); const f32x2 av2_ = {av, av}; \
            _Pragma("unroll") for (int d = 0; d < 4; ++d) { const unsigned w_ = buf[x][d]; FP4X8(w_, f0_, f1_, f2_, f3_); const int o_ = (d >> 1) * 8 + (d & 1) * 4; \
                acc2[o_ + 0] = av2_ * f0_ + acc2[o_ + 0]; acc2[o_ + 1] = av2_ * f1_ + acc2[o_ + 1]; acc2[o_ + 2] = av2_ * f2_ + acc2[o_ + 2]; acc2[o_ + 3] = av2_ * f3_ + acc2[o_ + 3]; } PIN_ACC(); } } while (0)
        float avl = 0.f, avh = 0.f;
        PEER_LOADT(A, SA, PU, 0); PEER_LOADT(B, SB, PU, 1);
#pragma unroll 1
        for (int g = 0; g < 15; g += 3) { PEER_LOADT(C, SC, PU, g + 2); SBAR(); PEER_DOT(A, SA, g); SBAR(); PEER_LOADT(A, SA, PU, g + 3); SBAR(); PEER_DOT(B, SB, g + 1); SBAR(); PEER_LOADT(B, SB, PU, g + 4); SBAR(); PEER_DOT(C, SC, g + 2); SBAR(); }
        PEER_DOT(A, SA, 15); SBAR();
        f32x2 acc2[16];
#pragma unroll
        for (int i = 0; i < 16; ++i) acc2[i] = (f32x2){0.f, 0.f};
        float* xp = xres_row(F, row);
        PEER_LOADT(A, SA, PV, 0); PEER_LOADT(B, SB, PV, 1);
#pragma unroll 1
        for (int g = 0; g < 15; g += 3) { PEER_LOADT(C, SC, PV, g + 2); SBAR(); PEER_AXPY(A, SA, g); SBAR(); PEER_LOADT(A, SA, PV, g + 3); SBAR(); PEER_AXPY(B, SB, g + 1); SBAR(); PEER_LOADT(B, SB, PV, g + 4); SBAR(); PEER_AXPY(C, SC, g + 2); SBAR(); }
        PEER_AXPY(A, SA, 15); SBAR();
#undef PEER_LOADT
#undef PEER_LOADV
#undef PEER_DOT
#undef PEER_AXPY
        float acc[32];
        { float x1[32], g2[32]; ld16_f32(xp, lane, x1); ld16_f32(modl + (size_t)v * 12288 + 10240, lane, g2);
#pragma unroll
          for (int i = 0; i < 32; ++i) acc[i] = ALPHA * x1[i] + g2[i] * acc2[i >> 1][i & 1]; }
        { float sm = 0.f;
#pragma unroll
          for (int i = 0; i < 32; ++i) sm += acc[i];
          const float mu = wave_sum(sm) * (1.f / 2048.f); float qq = 0.f;
#pragma unroll
          for (int i = 0; i < 32; ++i) { const float dd = acc[i] - mu; qq += dd * dd; }
          const float rstd = rsqrtf(wave_sum(qq) * (1.f / 2048.f) + LN_EPS);
#pragma unroll
          for (int q = 0; q < 2; ++q)
#pragma unroll
              for (int d = 0; d < 4; ++d) { const int o = 1024 * q + 16 * lane + 4 * d; const f32x4 gg = *(const f32x4*)(g2n + o), bb = *(const f32x4*)(b2n + o);
#pragma unroll
                  for (int i = 0; i < 4; ++i) acc[q * 16 + d * 4 + i] = (acc[q * 16 + d * 4 + i] - mu) * rstd * gg[i] + bb[i]; } }
        st16_f32(xp, lane, acc);
        if (!last) { const float* sh = modn + (size_t)v * 12288; const float* sc = sh + 2048;
#pragma unroll
            for (int q = 0; q < 2; ++q)
#pragma unroll
                for (int d = 0; d < 4; ++d) { const int o = 1024 * q + 16 * lane + 4 * d; const f32x4 hh4 = *(const f32x4*)(sh + o), cc4 = *(const f32x4*)(sc + o);
#pragma unroll
                    for (int i = 0; i < 4; ++i) acc[q * 16 + d * 4 + i] = clamp8(acc[q * 16 + d * 4 + i] * (1.f + cc4[i]) + hh4[i]); }
#pragma unroll
            for (int q = 0; q < 2; ++q) { u32x4 w;
#pragma unroll
                for (int d = 0; d < 4; ++d) w[d] = pk4_fp8(acc[q * 16 + d * 4 + 0], acc[q * 16 + d * 4 + 1], acc[q * 16 + d * 4 + 2], acc[q * 16 + d * 4 + 3]);
                *(u32x4*)(HB8w + (size_t)row * D + 1024 * q + 16 * lane) = w; } }
      }
    }
}
#ifdef DBG
constexpr size_t WS_DBG = WS_CTL + 131072;
constexpr int DBG_NS = 60;
__device__ __forceinline__ int dbg_row(int s) { return (s * 263 + 5) % NLAT; }
__global__ void __launch_bounds__(256) dbg_peer_pre(Args args, int l) {
    __shared__ float q[1024]; __shared__ float s1[128], s2[128]; __shared__ float v1[16], v2[16]; __shared__ int i1[16], i2[16]; __shared__ float cs[256]; __shared__ int ce[256];
    __shared__ float ts[16]; __shared__ int te[16]; __shared__ float red[256]; __shared__ float aval[128]; __shared__ int eid[128]; __shared__ float h2[2048];
    const int s = blockIdx.x, row = dbg_row(s), tid = threadIdx.x; unsigned char* ws = args.ws;
    const bf16_t* QP = (const bf16_t*)(ws + WS_QP); const bf16_t* HB = (const bf16_t*)(ws + WS_HB);
    float* dbgf = (float*)(ws + WS_DBG + 4096); int* dbge = (int*)(dbgf + DBG_NS * 2048); float* dbga = (float*)(dbge + DBG_NS * 128); float* dbgg = dbga + 3 * DBG_NS * 128;
    for (int i = tid; i < 1024; i += 256) q[i] = bf2f(QP[(size_t)row * 1024 + i]);
    for (int i = tid; i < 2048; i += 256) h2[i] = bf2f(HB[(size_t)row * D + i]);
    __syncthreads();
    const float* k1 = args.in[21] + (size_t)l * 8192; const float* k2 = args.in[22] + (size_t)l * 8192;
    for (int hd = 0; hd < 8; ++hd) {
        { const int k = tid & 127; const float* kk = (tid < 128 ? k1 : k2) + k * 64; const float* qq = q + hd * 128 + (tid < 128 ? 0 : 64); float a = 0.f; for (int d = 0; d < 64; ++d) a += qq[d] * kk[d]; (tid < 128 ? s1 : s2)[k] = a; }
        __syncthreads();
        { const int k = tid & 127; const float* sv = tid < 128 ? s1 : s2; const float me = sv[k]; int rank = 0; for (int j = 0; j < 128; ++j) rank += (sv[j] > me || (sv[j] == me && j < k)) ? 1 : 0;
          if (rank < 16) { (tid < 128 ? v1 : v2)[rank] = me; (tid < 128 ? i1 : i2)[rank] = k; } }
        __syncthreads();
        { const int i = tid >> 4, j = tid & 15; cs[tid] = v1[i] + v2[j]; ce[tid] = i1[i] * 128 + i2[j]; }
        __syncthreads();
        { const float me = cs[tid]; int rank = 0; for (int j = 0; j < 256; ++j) rank += (cs[j] > me || (cs[j] == me && j < tid)) ? 1 : 0; if (rank < 16) { ts[rank] = me; te[rank] = ce[tid]; } }
        __syncthreads();
        if (tid < 16) { float mx = ts[0]; float sm = 0.f; for (int j = 0; j < 16; ++j) sm += expf(ts[j] - mx); aval[hd * 16 + tid] = expf(ts[tid] - mx) / sm; eid[hd * 16 + tid] = te[tid]; dbgg[s * 128 + hd * 16 + tid] = aval[hd * 16 + tid]; }
        __syncthreads();
    }
    const float* U = args.in[23] + (size_t)l * 16384 * 2048; const float* V = args.in[24] + (size_t)l * 16384 * 2048;
    for (int e = 0; e < 128; ++e) { const float* ur = U + (size_t)eid[e] * 2048; float p = 0.f; for (int d = tid; d < 2048; d += 256) p += h2[d] * ur[d]; red[tid] = p; __syncthreads();
        for (int st = 128; st > 0; st >>= 1) { if (tid < st) red[tid] += red[tid + st]; __syncthreads(); }
        if (tid == 0) { const float sc = red[0]; aval[e] = 0.5f * sc * (1.f + erff(sc * 0.70710678f)) * aval[e]; } __syncthreads(); }
    float y[8]; const float* xr = args.out + (size_t)row * D; const int v = row >> 12; const float* mod = (const float*)(ws + WS_MOD) + (size_t)l * 5 * 12288 + (size_t)v * 12288;
    float sum = 0.f;
    for (int k = 0; k < 8; ++k) { const int d = tid + 256 * k; float o = 0.f; for (int e = 0; e < 128; ++e) o += aval[e] * V[(size_t)eid[e] * 2048 + d]; y[k] = ALPHA * xr[d] + mod[10240 + d] * o; sum += y[k]; }
    red[tid] = sum; __syncthreads(); for (int st = 128; st > 0; st >>= 1) { if (tid < st) red[tid] += red[tid + st]; __syncthreads(); } const float mu = red[0] / 2048.f; __syncthreads();
    float sq = 0.f; for (int k = 0; k < 8; ++k) sq += (y[k] - mu) * (y[k] - mu);
    red[tid] = sq; __syncthreads(); for (int st = 128; st > 0; st >>= 1) { if (tid < st) red[tid] += red[tid + st]; __syncthreads(); } const float rstd = rsqrtf(red[0] / 2048.f + LN_EPS);
    for (int k = 0; k < 8; ++k) { const int d = tid + 256 * k; dbgf[(size_t)s * 2048 + d] = (y[k] - mu) * rstd * args.in[25][l * D + d] + args.in[26][l * D + d]; }
    if (tid < 128) { dbge[s * 128 + tid] = eid[tid]; dbga[s * 128 + tid] = aval[tid]; }
}
__global__ void __launch_bounds__(256) dbg_peer_post(Args args) {
    __shared__ int bad_e, bad_x, bad_a, bad_g;
    const int s = blockIdx.x, row = dbg_row(s), tid = threadIdx.x; unsigned char* ws = args.ws; unsigned* cnt = (unsigned*)(ws + WS_DBG);
    float* dbgf = (float*)(ws + WS_DBG + 4096); int* dbge = (int*)(dbgf + DBG_NS * 2048); float* dbga = (float*)(dbge + DBG_NS * 128);
    int* fe = (int*)(dbga + DBG_NS * 128); float* fa = (float*)(fe + DBG_NS * 128); float* dbgg = dbga + 3 * DBG_NS * 128; float* fg = dbgg + DBG_NS * 128;
    if (tid == 0) { bad_e = 0; bad_x = 0; bad_a = 0; bad_g = 0; } __syncthreads();
    if (tid < 128) { const int hd = tid >> 4; const int e = dbge[s * 128 + tid]; bool found = false; float af = 0.f, gf = 0.f; for (int j = 0; j < 16; ++j) if (fe[s * 128 + hd * 16 + j] == e) { found = true; af = fa[s * 128 + hd * 16 + j]; gf = fg[s * 128 + hd * 16 + j]; }
        if (!found) atomicAdd(&bad_e, 1); else { const float ea = dbga[s * 128 + tid]; if (fabsf(af - ea) > 0.02f * fabsf(ea) + 2e-3f) atomicAdd(&bad_a, 1); const float eg = dbgg[s * 128 + tid]; if (fabsf(gf - eg) > 0.02f * fabsf(eg) + 1e-3f) atomicAdd(&bad_g, 1); } }
    for (int k = 0; k < 8; ++k) { const int d = tid + 256 * k; const float ex = dbgf[(size_t)s * 2048 + d], got = args.out[(size_t)row * D + d]; if (!(fabsf(got - ex) <= 0.03f + 0.03f * fabsf(ex))) atomicAdd(&bad_x, 1); }
    __syncthreads();
    if (tid == 0) { if (bad_e > 2) atomicAdd(&cnt[1], 1u); if (bad_g > 2) atomicAdd(&cnt[2], 1u); if (bad_a > 2) atomicAdd(&cnt[3], 1u); if (bad_x > 8) atomicAdd(&cnt[4], 1u); }
}
__global__ void dbg_report(Args args) {
    unsigned* cnt = (unsigned*)(args.ws + WS_DBG);
    float code = 0.f;
    for (int lv = 1; lv <= 9; ++lv) if (cnt[lv]) { int tenths = (int)(cnt[lv] * 10 / DBG_NS); if (tenths > 9) tenths = 9; code = 1000.f * lv + 100.f * tenths; break; }
    if (code != 0.f) for (int i = threadIdx.x; i < 4096; i += blockDim.x) args.out[i] = code;
}
#endif
__device__ __forceinline__ void p_attn_gqa(const Frame& F, int last) {
    char* lds = (char*)F.lds;
    const bf16_t* QG = wsp<bf16_t>(F, WS_QG); const bf16_t* KG = wsp<bf16_t>(F, WS_KG); const bf16_t* VG = wsp<bf16_t>(F, WS_VG); bf16_t* OAB = wsp<bf16_t>(F, WS_OAB);
    const int nlat = NB * 8 * 16, nall = last ? nlat : nlat + NB * 8;
    for (int u = F.bid; u < nall; u += F.G) {
        int bh, q0, seq; size_t orow;
        if (u < nlat) {
            int uu = u;
            if (F.G == 256) {
                const int c = u & 255, i = u >> 8, xcd = c & 7, r = c >> 3, kvg = i * 4 + (xcd >> 1), within = (xcd & 1) * 32 + r;
                uu = (((kvg >> 1) * 8 + (kvg & 1) * 4 + (within >> 4)) << 4) | (within & 15); }
            bh = uu >> 4; const int qb = uu & 15; q0 = CTXL + qb * 256; seq = TT; orow = (size_t)(bh >> 3) * SEQ + qb * 256; }
        else { bh = u - nlat; q0 = 0; seq = CTXL; orow = (size_t)NLAT + (bh >> 3) * CTXL; }
        const int b = bh >> 3, h = bh & 7; const size_t kvo = (size_t)(b * 2 + (h >> 2)) * TT * 128;
        __syncthreads();
        att::attn_body<8, 4, 0, 1>(QG + ((size_t)bh * TT + q0) * 128, KG + kvo, VG + kvo, OAB + orow * D + 1024 + h * 128, seq, lds, F.tid);
    }
    __syncthreads();
}
__device__ __forceinline__ void p_attn_mla(const Frame& F, int last) {
    char* lds = (char*)F.lds;
    const bf16_t* QM = wsp<bf16_t>(F, WS_QM); const bf16_t* KM = wsp<bf16_t>(F, WS_KM); const bf16_t* VM = wsp<bf16_t>(F, WS_VM); bf16_t* OAB = wsp<bf16_t>(F, WS_OAB);
    const int nlat = NB * 8 * 16, nall = last ? nlat : nlat + NB * 8;
    for (int u = F.bid; u < nall; u += F.G) {
        int bh, q0, seq; size_t orow;
        if (u < nlat) {
            int uu = u;
            if (F.G == 256) { const int c = u & 255, i = u >> 8, xcd = c & 7, r = c >> 3; uu = ((i * 16 + xcd * 2 + (r >> 4)) << 4) | (r & 15); }
            bh = uu >> 4; const int qb = uu & 15; q0 = CTXL + qb * 256; seq = TT; orow = (size_t)(bh >> 3) * SEQ + qb * 256; }
        else { bh = u - nlat; q0 = 0; seq = CTXL; orow = (size_t)NLAT + (bh >> 3) * CTXL; }
        const int h = bh & 7;
        __syncthreads();
        att::attn_body<6, 2, 1, 2>(QM + ((size_t)bh * TT + q0) * 128, KM + (size_t)bh * TT * 128, VM + (size_t)bh * TT * 64, OAB + orow * D + h * 64, seq, lds, F.tid);
    }
    __syncthreads();
}
__device__ __forceinline__ void p_ret_out(const Frame& F, int l, int last) {
    const int c_lo = last ? 2 : 0, nc = 34 - c_lo, nu = NB * 8 * nc;
    for (int u = F.bid; u < nu; u += F.G) { const int bh = u / nc, c = c_lo + (u % nc); ret_out_unit(F, l, bh, c); }
    __syncthreads();
}

constexpr int LDS_BYTES = 147456;
constexpr int MISC_OFF = 147456 - 64;
constexpr int NPHASE = 22;
#ifndef PHM
#define PHM 0xFFFF
#endif
#ifndef PH_ATTR
#define PH_ATTR __forceinline__
#endif
__device__ PH_ATTR void ph_prologue(ArgP ap) { const Frame F = make_frame(ap); p0_prologue(F); }
__device__ PH_ATTR void ph_modreduce(ArgP ap) { const Frame F = make_frame(ap); p1_modreduce(F); }
__device__ PH_ATTR void ph_modulate0(ArgP ap) { const Frame F = make_frame(ap); p_modulate0(F); }
__device__ PH_ATTR void ph_gemm_in(ArgP ap, int l) { const Frame F = make_frame(ap);
    pg8::Gemm g{wsp<bf16_t>(F, WS_HB8), wsp<bf16_t>(F, WS_WIN + l * SZ_WIN), NROW, NPT, 1024, 1024, 1024}; pg8::StaticOrder S; S.init(NROW, NPT, F.G, F.bid);
    float mul_, inv_; fp8_scale(wsp<unsigned>(F, WS_WSC)[l], mul_, inv_);
    EpiIn E{wsp<bf16_t>(F, WS_P1), wsp<bf16_t>(F, WS_G), inv_};
    pg8::gemm_phase<EpiIn, pg8::StaticOrder>(F.lds, F.tid, g, S, E); }
__device__ PH_ATTR void ph_post(ArgP ap, int l) { const Frame F = make_frame(ap); p_post(F, l); if (l == 1) cvt_peer(F, 1); }
__device__ PH_ATTR void ph_qup(ArgP ap, int l) { const Frame F = make_frame(ap);
    pg8::Gemm g{wsp<bf16_t>(F, WS_CQN), wsp<bf16_t>(F, WS_WQUP + l * SZ_WQUP), NROW, 768, 512, 512, 512}; pg8::StaticOrder S; S.init(NROW, 768, F.G, F.bid);
    EpiQup E{wsp<bf16_t>(F, WS_QM), wsp<f32x2>(F, WS_ROPE32)};
    pg8::gemm_phase<EpiQup, pg8::StaticOrder>(F.lds, F.tid, g, S, E); }
__device__ PH_ATTR void ph_kvup(ArgP ap, int l) { const Frame F = make_frame(ap);
    pg8::Gemm g{wsp<bf16_t>(F, WS_CKVN), wsp<bf16_t>(F, WS_WKVUP + l * SZ_WKVUP), NROW, 1024, 256, 256, 256}; pg8::StaticOrder S; S.init(NROW, 1024, F.G, F.bid);
    EpiKvup E{wsp<bf16_t>(F, WS_KM), wsp<bf16_t>(F, WS_VM)};
    pg8::gemm_phase<EpiKvup, pg8::StaticOrder>(F.lds, F.tid, g, S, E); }
__device__ PH_ATTR void ph_states(ArgP ap, int l) { const Frame F = make_frame(ap); p_ret_states(F, l); }
__device__ PH_ATTR void ph_attn_gqa(ArgP ap, int last) { const Frame F = make_frame(ap); p_attn_gqa(F, last); }
__device__ PH_ATTR void ph_attn_mla(ArgP ap, int last) { const Frame F = make_frame(ap); p_attn_mla(F, last); }
__device__ PH_ATTR void ph_ret_out(ArgP ap, int l, int last) { const Frame F = make_frame(ap); p_ret_out(F, l, last); }
template <int SEG> __device__ PH_ATTR void ph_merge(ArgP ap, int l, int Mx) { const Frame F = make_frame(ap);
    const bf16_t* OAB = wsp<bf16_t>(F, WS_OAB); bf16_t* MB = wsp<bf16_t>(F, WS_MB); const bf16_t* G = wsp<bf16_t>(F, WS_G);
    pg8::StaticOrder S; S.init(Mx, 2048, F.G, F.bid);
    const size_t wo = SEG == 0 ? WS_WBRA + l * SZ_WBRA : (SEG == 1 ? WS_WBRB + l * SZ_WBRB : WS_WBRC + l * SZ_WBRC); const int K = SEG == 2 ? 1024 : 512;
    pg8::Gemm g{OAB + SEG * 512, wsp<bf16_t>(F, wo), Mx, 2048, K, 2048, K}; EpiMerge<SEG> E{MB, G, wsp<unsigned char>(F, WS_MB8)}; pg8::gemm_phase<EpiMerge<SEG>, pg8::StaticOrder>(F.lds, F.tid, g, S, E); }
__device__ PH_ATTR void ph_out(ArgP ap, int l, int Mx) { const Frame F = make_frame(ap);
    pg8::Gemm g{wsp<bf16_t>(F, WS_MB8), wsp<bf16_t>(F, WS_WOUT + l * SZ_WOUT), Mx, 2048, 1024, 1024, 1024}; pg8::StaticOrder S; S.init(Mx, 2048, F.G, F.bid);
    float mul_, inv_; fp8_scale(wsp<unsigned>(F, WS_WSC)[2 + l], mul_, inv_);
    EpiOut E{l == 0 ? F.in(0) : F.out, l == 0 ? F.in(2) : wsp<float>(F, WS_XC), F.out, wsp<float>(F, WS_XC), wsp<float>(F, WS_MOD) + (size_t)l * 5 * 12288 + 4096, inv_ * (1.f / 16.f)};
    pg8::gemm_phase<EpiOut, pg8::StaticOrder>(F.lds, F.tid, g, S, E); }
__device__ PH_ATTR void ph_ln1(ArgP ap, int l, int last) { const Frame F = make_frame(ap); p_ln1(F, l, last); }
__device__ PH_ATTR void ph_peerq(ArgP ap, int l, int Mx) { const Frame F = make_frame(ap);
    pg8::Gemm g{wsp<bf16_t>(F, WS_HB), wsp<bf16_t>(F, WS_WPQ + l * SZ_WPQ), Mx, 1024, 2048, 2048, 2048}; pg8::StaticOrder S; S.init(Mx, 1024, F.G, F.bid);
    EpiPlain E{wsp<bf16_t>(F, WS_QP), 1024};
    pg8::gemm_phase<EpiPlain, pg8::StaticOrder>(F.lds, F.tid, g, S, E); }
__device__ PH_ATTR void ph_peer(ArgP ap, int l, int last) { const Frame F = make_frame(ap); p_peer(F, l, last); }

__global__ void __launch_bounds__(512, 2) mega_fwd(Args args) {
    extern __shared__ __attribute__((aligned(16))) unsigned char lds_raw[];
    const ArgP ap = (ArgP)__builtin_amdgcn_kernarg_segment_ptr();
    const int lo = ap->ph_lo, hi = ap->ph_hi;
    volatile LAS unsigned* misc = (volatile LAS unsigned*)((LAS unsigned char*)lds_raw + MISC_OFF);
    if (threadIdx.x < 4) misc[threadIdx.x] = 0u;
    __syncthreads();
    XcdBarrier bar; bar.bar = (unsigned*)(ap->ws + WS_CTL); bar.x = 0; bar.st = misc;
    if (hi - lo > 1) bar = xcd_barrier_post((unsigned*)(ap->ws + WS_CTL), misc);
#define IN(k) (lo <= (k) && (k) < hi)
#define SEAM(k) do { if (IN(k) && IN((k) + 1)) xcd_barrier(bar); } while (0)
    if (IN(0)) { if (PHM & 1) ph_prologue(ap); if (REP_PRO) ph_prologue(ap); } SEAM(0);
    if (IN(1)) { if (PHM & 2) ph_modreduce(ap); if (REP_X & 32) ph_modreduce(ap); } SEAM(1);
#pragma unroll 1
    for (int l = 0; l < 2; ++l) {
        const int pb = 2 + 10 * l; const int last = (l == 1);
        const int Mx = last ? NLAT : NROW;
        if (l == 0) { if (IN(pb)) { if (PHM & 4) ph_modulate0(ap); if (REP_X & 64) ph_modulate0(ap); } SEAM(pb); }
        if (IN(pb + 1)) { if (PHM & 8) ph_gemm_in(ap, l); if (REP_GIN) ph_gemm_in(ap, l); } SEAM(pb + 1);
        if (IN(pb + 2)) { if (PHM & 16) ph_post(ap, l); if (REP_X & 1) ph_post(ap, l); } SEAM(pb + 2);
        if (IN(pb + 3)) { if (PHM & 32) ph_qup(ap, l); if (PHM & 64) ph_kvup(ap, l); if (PHM & 128) ph_states(ap, l); if (REP_X & 2) { ph_qup(ap, l); ph_kvup(ap, l); ph_states(ap, l); } } SEAM(pb + 3);
        if (IN(pb + 4)) { if (PHM & 256) ph_attn_gqa(ap, last); if (PHM & 512) ph_attn_mla(ap, last); if (REP_ATTN) { ph_attn_gqa(ap, last); ph_attn_mla(ap, last); } if (REP_X & 4) ph_ret_out(ap, l, last); if (PHM & 1024) ph_ret_out(ap, l, last); } SEAM(pb + 4);
        if (IN(pb + 5)) { if (PHM & 2048) { ph_merge<0>(ap, l, Mx); ph_merge<1>(ap, l, Mx); ph_merge<2>(ap, l, Mx); } if (REP_X & 8) { ph_merge<0>(ap, l, Mx); ph_merge<1>(ap, l, Mx); ph_merge<2>(ap, l, Mx); } } SEAM(pb + 5);
        if (IN(pb + 6)) { if (PHM & 4096) ph_out(ap, l, Mx); } SEAM(pb + 6);
        if (IN(pb + 7)) { if (PHM & 8192) ph_ln1(ap, l, last); } SEAM(pb + 7);
        if (IN(pb + 8)) { if (PHM & 16384) ph_peerq(ap, l, Mx); if (REP_X & 16) ph_peerq(ap, l, Mx); } SEAM(pb + 8);
        if (IN(pb + 9)) { if (PHM & 32768) ph_peer(ap, l, last); } SEAM(pb + 9);
    }
#undef IN
#undef SEAM
}

extern "C" void kernel_launch(void* const* d_in, const int* in_sizes, int n_in, void* d_out, int out_size, void* d_ws, size_t ws_size, hipStream_t stream) {
    static int grid = 0;
    if (grid == 0) {
        if (n_in != 27 || out_size != NLAT * D || ws_size < WS_END) { fprintf(stderr, "kernel_launch: unexpected shapes: n_in %d out %d ws %zu (need %zu)\n", n_in, out_size, ws_size, (size_t)WS_END); grid = -1; return; }
        int dev = 0, cus = 0, per_cu = 0;
        if (hipGetDevice(&dev) != hipSuccess || hipDeviceGetAttribute(&cus, hipDeviceAttributeMultiprocessorCount, dev) != hipSuccess) { grid = -1; return; }
        if (hipFuncSetAttribute((const void*)mega_fwd, hipFuncAttributeMaxDynamicSharedMemorySize, LDS_BYTES) != hipSuccess) { fprintf(stderr, "kernel_launch: hipFuncSetAttribute failed\n"); grid = -1; return; }
        if (hipOccupancyMaxActiveBlocksPerMultiprocessor(&per_cu, (const void*)mega_fwd, 512, LDS_BYTES) != hipSuccess || per_cu < 1) fprintf(stderr, "kernel_launch: occupancy query reports %d\n", per_cu);
        (void)hipGetLastError();
        grid = cus;
    }
    if (grid < 0) return;
    (void)hipMemsetAsync((char*)d_ws + WS_CTL, 0, 65536, stream);
#ifdef DBG
    (void)hipMemsetAsync((char*)d_ws + WS_CTL + 131072, 0, 4096, stream);
#endif
    Args a{};
    for (int i = 0; i < 27; ++i) a.in[i] = (const float*)d_in[i];
    a.out = (float*)d_out; a.ws = (unsigned char*)d_ws;
#if MK_PER_PHASE
    for (int p = 0; p < NPHASE; ++p) { if (p == 12) continue; a.ph_lo = p; a.ph_hi = p + 1;
#ifdef DBG
        if (p == 11) hipLaunchKernelGGL(dbg_peer_pre, dim3(DBG_NS), dim3(256), 0, stream, a, 0);
#endif
        hipLaunchKernelGGL(mega_fwd, dim3(grid), dim3(512), LDS_BYTES, stream, a);
#ifdef DBG
        if (p == 11) hipLaunchKernelGGL(dbg_peer_post, dim3(DBG_NS), dim3(256), 0, stream, a);
#endif
    }
#ifdef DBG
    hipLaunchKernelGGL(dbg_report, dim3(1), dim3(256), 0, stream, a);
#endif
#else
    a.ph_lo = 0; a.ph_hi = NPHASE;
    hipLaunchKernelGGL(mega_fwd, dim3(grid), dim3(512), LDS_BYTES, stream, a);
#endif
    const hipError_t le = hipPeekAtLastError();
    if (le != hipSuccess) fprintf(stderr, "kernel_launch: launch failed: %s\n", hipGetErrorName(le));
}
```

```cpp
#include <hip/hip_runtime.h>
#include <cstdio>
#include <cstdint>
#include <cstddef>

#ifndef MK_PER_PHASE
#define MK_PER_PHASE 0
#endif

#ifndef ABL_PEER
#define ABL_PEER 0
#endif
#ifndef REP_PEERG
#define REP_PEERG 0
#endif
#ifndef REP_PEERH
#define REP_PEERH 0
#endif
#ifndef REP_X
#define REP_X 0
#endif
#ifndef REP_PS1
#define REP_PS1 0
#endif
#ifndef REP_PS2
#define REP_PS2 0
#endif
#ifndef SIDE_ON
#define SIDE_ON 1
#endif
#ifndef REP_DOT
#define REP_DOT 0
#endif
#ifndef REP_GIN
#define REP_GIN 0
#endif
#ifndef REP_ATTN
#define REP_ATTN 0
#endif
#ifndef REP_PRO
#define REP_PRO 0
#endif
#ifndef ABL_BR
#define ABL_BR 0
#endif
#ifndef ABL_MIX
#define ABL_MIX 0
#endif
#define LAS __attribute__((address_space(3)))
typedef unsigned short bf16_t;
typedef short bf16x8 __attribute__((ext_vector_type(8)));
typedef short s16x4 __attribute__((ext_vector_type(4)));
typedef float f32x2 __attribute__((ext_vector_type(2)));
typedef float f32x4 __attribute__((ext_vector_type(4)));
typedef float f32x8 __attribute__((ext_vector_type(8)));
typedef float f32x16 __attribute__((ext_vector_type(16)));
typedef unsigned u32x2 __attribute__((ext_vector_type(2)));
typedef unsigned u32x4 __attribute__((ext_vector_type(4)));
typedef __bf16 bf2_t __attribute__((ext_vector_type(2)));

constexpr int D = 2048, NB = 4, SEQ = 4096, CTXL = 256, TT = SEQ + CTXL;
constexpr int NLAT = NB * SEQ, NCTX = NB * CTXL, NROW = NLAT + NCTX;
constexpr int NP1 = 4096, NG = 6144, NPT = NP1 + NG;
constexpr int NIN = 10016;
constexpr float ALPHA = 1.4142135623730951f;
constexpr float LN_EPS = 1e-5f, RMS_EPS = 1e-6f;
constexpr float LOG2E = 1.4426950408889634f;
constexpr int C_CQ = 0, C_CKV = 512, C_GQ = 768, C_GK = 1792, C_GV = 2048, C_RQ = 2304, C_RK = 2560, C_RV = 2816, C_RG = 3328, C_KR = 3840;

constexpr size_t AL(size_t x) { return (x + 255) / 256 * 256; }
constexpr size_t WS_CTL = 0;                                    constexpr size_t CTL_BYTES = 1u << 20;
constexpr size_t WS_WSC = WS_CTL + 32768;
constexpr size_t WS_CVT = WS_CTL + 33024;
constexpr size_t WS_DEC = WS_CTL + 65536;
constexpr size_t WS_ROPE32 = WS_CTL + CTL_BYTES;
constexpr size_t WS_ROPE128 = WS_ROPE32 + AL(64 * 8 * 8);
constexpr size_t WS_MODP = WS_ROPE128 + AL(64 * 32 * 8);
constexpr size_t WS_MOD = WS_MODP + AL((size_t)16 * 2 * 5 * 12288 * 4);
constexpr size_t WS_WIN = WS_MOD + AL((size_t)2 * 5 * 12288 * 4);
constexpr size_t SZ_WIN = (size_t)NPT * D;
constexpr size_t WS_WQUP = WS_WIN + 2 * SZ_WIN;                 constexpr size_t SZ_WQUP = (size_t)768 * 512 * 2;
constexpr size_t WS_WKVUP = WS_WQUP + 2 * SZ_WQUP;              constexpr size_t SZ_WKVUP = (size_t)1024 * 256 * 2;
constexpr size_t WS_WBRA = WS_WKVUP + 2 * SZ_WKVUP;             constexpr size_t SZ_WBRA = (size_t)2048 * 512 * 2;
constexpr size_t WS_WBRB = WS_WBRA + 2 * SZ_WBRA;               constexpr size_t SZ_WBRB = SZ_WBRA;
constexpr size_t WS_WBRC = WS_WBRB + 2 * SZ_WBRB;               constexpr size_t SZ_WBRC = (size_t)2048 * 1024 * 2;
constexpr size_t WS_WOUT = WS_WBRC + 2 * SZ_WBRC;               constexpr size_t SZ_WOUT = (size_t)2048 * 2048 * 2;
constexpr size_t WS_WPQ = WS_WOUT + 2 * SZ_WOUT;                constexpr size_t SZ_WPQ = (size_t)1024 * 2048 * 2;
constexpr size_t WS_PSC = WS_WPQ + 2 * SZ_WPQ;
constexpr size_t WS_PU = WS_PSC + (size_t)4 * 16384 * 4;        constexpr size_t SZ_PT = (size_t)16384 * 1152;
constexpr size_t WS_PV = WS_PU + 2 * SZ_PT;
constexpr size_t WS_XC = WS_PV + 2 * SZ_PT;
constexpr size_t WS_HB = WS_XC + (size_t)NCTX * D * 4;
constexpr size_t WS_P1 = WS_HB + (size_t)NROW * D * 2;
constexpr size_t WS_G = WS_P1 + (size_t)NROW * NP1 * 2;
constexpr size_t WS_CQN = WS_G + (size_t)NROW * NG * 2;
constexpr size_t WS_CKVN = WS_CQN + (size_t)NROW * 512 * 2;
constexpr size_t WS_QM = WS_CKVN + (size_t)NROW * 256 * 2;
constexpr size_t SZ_Q128 = (size_t)NB * 8 * TT * 128 * 2;
constexpr size_t WS_KM = WS_QM + SZ_Q128;
constexpr size_t WS_VM = WS_KM + SZ_Q128;
constexpr size_t WS_QG = WS_VM + SZ_Q128 / 2;
constexpr size_t WS_KG = WS_QG + SZ_Q128;
constexpr size_t WS_VG = WS_KG + SZ_Q128 / 4;
constexpr size_t WS_RQ = WS_VG + SZ_Q128 / 4;
constexpr size_t WS_RK = WS_RQ + SZ_Q128 / 4;
constexpr size_t WS_RV = WS_RK + SZ_Q128 / 4;
constexpr size_t WS_ST = WS_RV + SZ_Q128 / 2;
constexpr size_t WS_OAB = WS_ST + (size_t)NB * 8 * 34 * 2 * 2048 * 4;
constexpr size_t WS_HB8 = WS_OAB + (size_t)NROW * D * 2;
constexpr size_t WS_MB8 = WS_HB8 + (size_t)NROW * D;
constexpr size_t WS_END = WS_MB8 + (size_t)NROW * D;
constexpr size_t WS_MB = WS_QM;
constexpr size_t WS_QP = WS_QG;
static_assert((size_t)NROW * D * 2 <= 2 * SZ_Q128, "MB alias");
static_assert((size_t)NROW * 1024 * 2 <= SZ_Q128, "QP alias");

__device__ __forceinline__ unsigned cvt_pk_bf16(float lo, float hi) { unsigned r; asm volatile("v_cvt_pk_bf16_f32 %0, %1, %2" : "=v"(r) : "v"(lo), "v"(hi)); return r; }
__device__ __forceinline__ bf16_t f2bf(float f) { return (bf16_t)(cvt_pk_bf16(f, 0.f) & 0xffffu); }
__device__ __forceinline__ float bf2f(bf16_t b) { return __uint_as_float(((unsigned)b) << 16); }
__device__ __forceinline__ float bflo(unsigned w) { return __uint_as_float(w << 16); }
__device__ __forceinline__ float bfhi(unsigned w) { return __uint_as_float(w & 0xffff0000u); }
template <int CTRL> __device__ __forceinline__ float dppf(float x) { return __int_as_float(__builtin_amdgcn_update_dpp(0, __float_as_int(x), CTRL, 0xF, 0xF, true)); }
__device__ __forceinline__ float row16_sum(float x) { x += dppf<0xB1>(x); x += dppf<0x4E>(x); x += dppf<0x141>(x); x += dppf<0x140>(x); return x; }
__device__ __forceinline__ float row16_max(float x) { x = fmaxf(x, dppf<0xB1>(x)); x = fmaxf(x, dppf<0x4E>(x)); x = fmaxf(x, dppf<0x141>(x)); x = fmaxf(x, dppf<0x140>(x)); return x; }
__device__ __forceinline__ float wave_sum(float x) {
    x = row16_sum(x);
    { auto r = __builtin_amdgcn_permlane16_swap(__float_as_uint(x), __float_as_uint(x), false, false); x = __uint_as_float(r[0]) + __uint_as_float(r[1]); }
    { auto r = __builtin_amdgcn_permlane32_swap(__float_as_uint(x), __float_as_uint(x), false, false); x = __uint_as_float(r[0]) + __uint_as_float(r[1]); }
    return x;
}
__device__ __forceinline__ unsigned pk4_fp8(float a, float b, float c, float d) { int t = 0; t = __builtin_amdgcn_cvt_pk_fp8_f32(a, b, t, false); t = __builtin_amdgcn_cvt_pk_fp8_f32(c, d, t, true); return (unsigned)t; }
__device__ __forceinline__ float clamp8(float x) { return fminf(fmaxf(x, -440.f), 440.f); }
__device__ __forceinline__ void fp8_scale(unsigned amax_bits, float& mul, float& inv) { const float am = __uint_as_float(amax_bits); int k = 0; if (am > 0.f) k = (int)floorf(log2f(256.f / am)); k = k > 60 ? 60 : (k < -60 ? -60 : k); mul = exp2f((float)k); inv = exp2f((float)-k); }
__device__ __forceinline__ float silu_f(float x) { return x / (1.f + __expf(-x)); }
__device__ __forceinline__ float sigmoid_f(float x) { return 1.f / (1.f + __expf(-x)); }

struct RowInfo { int b, tpos, pr, pc, v; bool lat; };
__device__ __forceinline__ RowInfo rowinfo(int row) {
    RowInfo r;
    if (row < NLAT) { r.lat = true; r.b = row >> 12; const int t = row & 4095; r.tpos = CTXL + t; r.pr = t >> 6; r.pc = t & 63; r.v = r.b; }
    else { const int q = row - NLAT; r.lat = false; r.b = q >> 8; r.tpos = q & 255; r.pr = 0; r.pc = 0; r.v = 4; }
    return r;
}

#define XB_TMO      128
#define XB_XCNT(j)  (256  + 64 * (j))
#define XB_XSUB(j)  (1280 + 64 * (j))
#define XB_XGEN(j)  (2304 + 64 * (j))
#define XB_TOP      3328
#define XB_TOPGEN   3392
#define XCD_BAR_WORDS 3456
#define XB_SPIN_CAP (1u << 22)

__device__ __forceinline__ unsigned xb_ld(unsigned* p)              { return __hip_atomic_load(p, __ATOMIC_RELAXED, __HIP_MEMORY_SCOPE_AGENT); }
__device__ __forceinline__ unsigned xb_add(unsigned* p, unsigned v) { return __hip_atomic_fetch_add(p, v, __ATOMIC_RELAXED, __HIP_MEMORY_SCOPE_AGENT); }
__device__ __forceinline__ unsigned xb_xcc_id() { return (unsigned)__builtin_amdgcn_s_getreg((3 << 11) | 20) & 0xFu; }
#define XB_SPIN(cond, bar) do { unsigned _sp = 0; while (cond) { __builtin_amdgcn_s_sleep(1); \
    if ((++_sp & 255u) == 0u) { if (xb_ld(&(bar)[XB_TMO])) break; if (_sp > XB_SPIN_CAP) { atomicAdd(&(bar)[XB_TMO], 1u); break; } } } } while (0)

struct XcdBarrier { unsigned* bar; unsigned x; volatile LAS unsigned* st; };

__device__ __forceinline__ XcdBarrier xcd_barrier_post(unsigned* bar, volatile LAS unsigned* st) {
    XcdBarrier b; b.bar = bar; b.x = xb_xcc_id(); b.st = st;
    if (threadIdx.x == 0) (void)xb_add(&bar[XB_XCNT(b.x)], 1u);
    return b;
}
__device__ __forceinline__ void xcd_barrier_complete(unsigned* bar, unsigned x, unsigned& nloc, unsigned& nx) {
    const unsigned G = gridDim.x * gridDim.y * gridDim.z;
    unsigned sum, cnt, mine, sp = 0u;
    for (;;) {
        sum = 0u; cnt = 0u; mine = 0u;
#pragma unroll
        for (unsigned j = 0; j < 16; ++j) { const unsigned c = xb_ld(&bar[XB_XCNT(j)]); sum += c; cnt += (c > 0u) ? 1u : 0u; mine = (j == x) ? c : mine; }
        if (sum == G) break;
        __builtin_amdgcn_s_sleep(1);
        if ((++sp & 255u) == 0u) { if (xb_ld(&bar[XB_TMO])) break; if (sp > XB_SPIN_CAP) { atomicAdd(&bar[XB_TMO], 1u); break; } }
    }
    nloc = mine > 0u ? mine : 1u; nx = cnt > 0u ? cnt : 1u;
}
__device__ __forceinline__ void xcd_barrier(const XcdBarrier& b) {
    asm volatile("s_waitcnt vmcnt(0)" ::: "memory");
    __syncthreads();
    if (threadIdx.x == 0) {
        unsigned* bar = b.bar;
        __builtin_amdgcn_s_waitcnt(0);
        unsigned nloc = b.st[0], nx = b.st[1];
        if (nloc == 0u) { xcd_barrier_complete(bar, b.x, nloc, nx); b.st[0] = nloc; b.st[1] = nx; }
        const unsigned old = xb_add(&bar[XB_XSUB(b.x)], 1u);
        const unsigned gen = old / nloc;
        if (old + 1u == (gen + 1u) * nloc) {
            __builtin_amdgcn_fence(__ATOMIC_RELEASE, "agent");
            asm volatile("s_waitcnt vmcnt(0)" ::: "memory");
            const unsigned og = xb_add(&bar[XB_TOP], 1u);
            const unsigned tg = og / nx;
            if (og + 1u == (tg + 1u) * nx) xb_add(&bar[XB_TOPGEN], 1u);
            else XB_SPIN(xb_ld(&bar[XB_TOPGEN]) == tg, bar);
            __builtin_amdgcn_fence(__ATOMIC_ACQUIRE, "agent");
            xb_add(&bar[XB_XGEN(b.x)], 1u);
            asm volatile("s_waitcnt vmcnt(0)" ::: "memory");
        } else {
            XB_SPIN(xb_ld(&bar[XB_XGEN(b.x)]) == gen, bar);
            __builtin_amdgcn_fence(__ATOMIC_ACQUIRE, "agent");
            asm volatile("s_waitcnt vmcnt(0)" ::: "memory");
        }
    }
    __syncthreads();
}
namespace pg8 {
constexpr int BM = 256, BK = 64, HALF = 128, HTB = HALF * BK * 2, STAGE_BYTES = 8 * HTB, NXCD = 8, WGM = 8;
__host__ __device__ __forceinline__ int lds_byte(int r, int c) { const int st = (r >> 4) * 2 + (c >> 5), rr = r & 15, cc = c & 31, ob = rr * 64 + cc * 2; return st * 1024 + (ob ^ (((ob >> 9) & 1) << 5)); }
__host__ __device__ __forceinline__ void stage_rc(int b, int& R, int& C) { const int st = b / 1024, sb = b % 1024, swz = sb ^ (((sb >> 9) & 1) << 5); R = (st >> 1) * 16 + swz / 64; C = (st & 1) * 32 + (swz % 64) / 2; }
__host__ __device__ __forceinline__ int perm32(int rho) { const int n = rho >> 4, i = rho & 15; return 8 * (i >> 2) + 4 * n + (i & 3); }

struct Unit { int pm, pn; };
typedef int i32x8 __attribute__((ext_vector_type(8))); typedef int i32x4v __attribute__((ext_vector_type(4)));
__device__ __forceinline__ i32x8 cat8(const bf16x8 a, const bf16x8 b) { const i32x4v x = __builtin_bit_cast(i32x4v, a), y = __builtin_bit_cast(i32x4v, b); return __builtin_shufflevector(x, y, 0, 1, 2, 3, 4, 5, 6, 7); }
struct Gemm { const bf16_t* A; const bf16_t* Bt; int M, N, K, lda, ldb; };

struct StaticOrder {
    int nM, nN, nwg, G, c;
    __host__ __device__ void init(int M, int N, int G_, int c_) { nM = M / BM; nN = N / BM; nwg = nM * nN; G = G_; c = c_; }
    __host__ __device__ bool next(int i, Unit& u) const {
        const long L = (long)i * G + c; if (L >= nwg) return false;
        int wgid = (int)L; { const int q = nwg / NXCD, r = nwg % NXCD, xcd = wgid % NXCD, off = wgid / NXCD; wgid = (xcd < r ? xcd * (q + 1) : r * (q + 1) + (xcd - r) * q) + off; }
        const int nig = WGM * nN, gid = wgid / nig, fm = gid * WGM, gsz = (nM - fm) < WGM ? (nM - fm) : WGM;
        u.pm = fm + ((wgid % nig) % gsz); u.pn = (wgid % nig) / gsz; return true;
    }
    __device__ __forceinline__ void a_ready(const Unit&) const {}
    __device__ __forceinline__ void done(const Unit&) const {}
};

template <class Epi, class Sched>
__device__ __forceinline__ void gemm_phase(LAS unsigned char* lds, const int tid, const Gemm g, const Sched& S, const Epi& E) {
    const int  wid = __builtin_amdgcn_readfirstlane(tid >> 6), lane = tid & 63, wr = wid >> 2, wc = wid & 3, fr = lane & 15, fq = lane >> 4;
    const int K = g.K, nt = K / BK;
    unsigned voffA[2], voffB[2];
#pragma unroll
    for (int i = 0; i < 2; ++i) { int R, C; stage_rc(tid * 16 + i * 8192, R, C); const int Rb = Epi::PERM ? ((R & ~31) + perm32(R & 31)) : R;
        voffA[i] = (unsigned)(R * g.lda + C) * 2u; voffB[i] = (unsigned)(Rb * g.ldb + C) * 2u; }
    const size_t kstep = (size_t)(BK * 2);
    const size_t hstepA = (size_t)HALF * g.lda * 2, hstepB = (size_t)HALF * g.ldb * 2;
    const size_t tstepA = 2 * hstepA, tstepB = 2 * hstepB;
    const unsigned ldsw = (unsigned)wid * 1024u;
    const int aoff = lds_byte(wr * 64 + fr, fq * 8), boff = lds_byte(wc * 32 + fr, fq * 8);
#define PG8_SA(b, h) (((b) * 2 + (h)) * HTB)
#define PG8_SB(b, h) ((4 + (b) * 2 + (h)) * HTB)
#define PG8_STAGE(bufoff, gbase, voff) do { _Pragma("unroll") for (int _i = 0; _i < 2; ++_i) \
        __builtin_amdgcn_global_load_lds((const unsigned*)((const char*)(gbase) + (voff)[_i]), (LAS unsigned*)(lds + (bufoff) + ldsw + _i * 8192), 16, 0, 0); } while (0)
#define PG8_LDA(dst, b, h) do { if constexpr (Epi::FP8) { _Pragma("unroll") for (int m = 0; m < 4; ++m) { const i32x4v lo_ = *(const LAS i32x4v*)(lds + PG8_SA(b, h) + aoff + m * 2048), hi_ = *(const LAS i32x4v*)(lds + PG8_SA(b, h) + aoff + m * 2048 + 1024); \
            dst##8[m] = __builtin_shufflevector(lo_, hi_, 0, 1, 2, 3, 4, 5, 6, 7); } } \
        else { _Pragma("unroll") for (int m = 0; m < 4; ++m) _Pragma("unroll") for (int k = 0; k < 2; ++k) dst[m][k] = *(const LAS bf16x8*)(lds + PG8_SA(b, h) + aoff + m * 2048 + k * 1024); } } while (0)
#define PG8_LDB(dst, b, h) do { if constexpr (Epi::FP8) { _Pragma("unroll") for (int n = 0; n < 2; ++n) { const i32x4v lo_ = *(const LAS i32x4v*)(lds + PG8_SB(b, h) + boff + n * 2048), hi_ = *(const LAS i32x4v*)(lds + PG8_SB(b, h) + boff + n * 2048 + 1024); \
            dst##8[n] = __builtin_shufflevector(lo_, hi_, 0, 1, 2, 3, 4, 5, 6, 7); } } \
        else { _Pragma("unroll") for (int n = 0; n < 2; ++n) _Pragma("unroll") for (int k = 0; k < 2; ++k) dst[n][k] = *(const LAS bf16x8*)(lds + PG8_SB(b, h) + boff + n * 2048 + k * 1024); } } while (0)
#define PG8_MMA(ai, bj, At, Bt) do { __builtin_amdgcn_s_setprio(1); _Pragma("unroll") for (int m = 0; m < 4; ++m) _Pragma("unroll") for (int n = 0; n < 2; ++n) { \
        if constexpr (Epi::FP8) asm volatile("v_mfma_scale_f32_16x16x128_f8f6f4 %0, %1, %2, %0, %3, %3 op_sel_hi:[0,0,0]" : "+v"(acc[ai][bj][m][n]) : "v"(Bt##8[n]), "v"(At##8[m]), "v"(sc1_)); \
        else { _Pragma("unroll") for (int k = 0; k < 2; ++k) acc[ai][bj][m][n] = __builtin_amdgcn_mfma_f32_16x16x32_bf16(Bt[n][k], At[m][k], acc[ai][bj][m][n], 0, 0, 0); } } __builtin_amdgcn_s_setprio(0); } while (0)
#define PG8_WAIT_V(n) asm volatile("s_waitcnt vmcnt(" #n ")" ::: "memory")
#define PG8_WAIT_L(n) asm volatile("s_waitcnt lgkmcnt(" #n ")" ::: "memory")
#define PG8_BAR __builtin_amdgcn_s_barrier()
#define PG8_SCHED __builtin_amdgcn_sched_barrier(0)
    Unit cur, nxt; int ui = 0;
    if (!S.next(0, cur)) return;
    f32x4 acc[2][2][4][2];
#pragma unroll
    for (int a = 0; a < 2; ++a)
#pragma unroll
        for (int b = 0; b < 2; ++b)
#pragma unroll
            for (int m = 0; m < 4; ++m)
#pragma unroll
                for (int n = 0; n < 2; ++n) acc[a][b][m][n] = (f32x4){0.f, 0.f, 0.f, 0.f};
    int sc1_ = 0x7F7F7F7F; asm volatile("" : "+v"(sc1_));
    bf16x8 At[4][2], B0[2][2], B1[2][2]; i32x8 At8[4], B08[2], B18[2];
    const char* cA = (const char*)g.A + (size_t)cur.pm * tstepA; const char* cB = (const char*)g.Bt + (size_t)cur.pn * tstepB;
    S.a_ready(cur);
    PG8_STAGE(PG8_SB(0, 0), cB, voffB); PG8_STAGE(PG8_SA(0, 0), cA, voffA); PG8_STAGE(PG8_SB(0, 1), cB + hstepB, voffB); PG8_STAGE(PG8_SA(0, 1), cA + hstepA, voffA);
    if (wr == 1) PG8_BAR;
    PG8_WAIT_V(4); PG8_BAR;
    PG8_STAGE(PG8_SB(1, 0), cB + kstep, voffB); PG8_STAGE(PG8_SA(1, 0), cA + kstep, voffA); PG8_STAGE(PG8_SB(1, 1), cB + hstepB + kstep, voffB);
    PG8_WAIT_V(6); PG8_BAR;
    for (;;) {
        const bool has_next = S.next(ui + 1, nxt);
        const char* nA = has_next ? (const char*)g.A + (size_t)nxt.pm * tstepA : cA; const char* nB = has_next ? (const char*)g.Bt + (size_t)nxt.pn * tstepB : cB;
#pragma unroll 1
        for (int t = 0; t < nt; t += 2) {
            const bool last = (t == nt - 2);
            const char* a1 = cA + (size_t)(t + 1) * kstep;
            const char* a2 = last ? nA : cA + (size_t)(t + 2) * kstep; const char* b2 = last ? nB : cB + (size_t)(t + 2) * kstep;
            const char* a3 = a2 + kstep; const char* b3 = b2 + kstep;
            if (last && has_next) S.a_ready(nxt);
            PG8_LDB(B0, 0, 0); PG8_SCHED; PG8_LDA(At, 0, 0); PG8_STAGE(PG8_SA(1, 1), a1 + hstepA, voffA);
            PG8_WAIT_L(8); PG8_BAR; PG8_WAIT_L(0); PG8_MMA(0, 0, At, B0); PG8_BAR; PG8_SCHED;
            PG8_LDB(B1, 0, 1); PG8_STAGE(PG8_SB(0, 0), b2, voffB);
            PG8_BAR; PG8_WAIT_L(0); PG8_MMA(0, 1, At, B1); PG8_BAR;
            PG8_LDA(At, 0, 1); PG8_STAGE(PG8_SA(0, 0), a2, voffA);
            PG8_BAR; PG8_WAIT_L(0); PG8_MMA(1, 0, At, B0); PG8_BAR; PG8_SCHED;
            PG8_STAGE(PG8_SB(0, 1), b2 + hstepB, voffB);
            PG8_WAIT_V(6); PG8_BAR; PG8_MMA(1, 1, At, B1); PG8_BAR;
            PG8_LDB(B0, 1, 0); PG8_SCHED; PG8_LDA(At, 1, 0); PG8_STAGE(PG8_SA(0, 1), a2 + hstepA, voffA);
            PG8_WAIT_L(8); PG8_BAR; PG8_WAIT_L(0); PG8_MMA(0, 0, At, B0); PG8_BAR; PG8_SCHED;
            PG8_LDB(B1, 1, 1); PG8_STAGE(PG8_SB(1, 0), b3, voffB);
            PG8_BAR; PG8_WAIT_L(0); PG8_MMA(0, 1, At, B1); PG8_BAR;
            PG8_LDA(At, 1, 1); PG8_STAGE(PG8_SA(1, 0), a3, voffA);
            PG8_BAR; PG8_WAIT_L(0); PG8_MMA(1, 0, At, B0); PG8_BAR; PG8_SCHED;
            PG8_STAGE(PG8_SB(1, 1), b3 + hstepB, voffB);
            PG8_WAIT_V(6); PG8_BAR; PG8_MMA(1, 1, At, B1); PG8_BAR;
        }
        if constexpr (Epi::FP8) asm volatile("s_nop 15\n\ts_nop 15" ::: "memory");
        E(acc, cur, wr, wc, fr, fq);
        if (!has_next) break;
#pragma unroll
        for (int a = 0; a < 2; ++a)
#pragma unroll
            for (int b = 0; b < 2; ++b)
#pragma unroll
                for (int m = 0; m < 4; ++m)
#pragma unroll
                    for (int n = 0; n < 2; ++n) acc[a][b][m][n] = (f32x4){0.f, 0.f, 0.f, 0.f};
        cur = nxt; cA = nA; cB = nB; ++ui;
    }
    PG8_WAIT_V(0);
    if (wr == 0) PG8_BAR;
    PG8_BAR;
#undef PG8_SA
#undef PG8_SB
#undef PG8_STAGE
#undef PG8_LDA
#undef PG8_LDB
#undef PG8_MMA
#undef PG8_WAIT_V
#undef PG8_WAIT_L
#undef PG8_BAR
#undef PG8_SCHED
}
}

typedef f32x4 Acc[2][2][4][2];
#define EPI_LOOP_ROWS for (int ai = 0; ai < 2; ++ai) for (int m = 0; m < 4; ++m)
__device__ __forceinline__ u32x4 pack8(const f32x4 a, const f32x4 b) { u32x4 w; w.x = cvt_pk_bf16(a[0], a[1]); w.y = cvt_pk_bf16(a[2], a[3]); w.z = cvt_pk_bf16(b[0], b[1]); w.w = cvt_pk_bf16(b[2], b[3]); return w; }

struct EpiIn {
    static constexpr bool PERM = true, FP8 = true;
    bf16_t* P1; bf16_t* G; float inv;
    __device__ __forceinline__ void operator()(const Acc& acc, const pg8::Unit& u, int wr, int wc, int fr, int fq) const {
        const int row0 = u.pm * 256 + wr * 64 + fr; const bool gate = u.pn >= 16;
        bf16_t* base = gate ? G : P1; const int ld = gate ? NG : NP1; const int col0 = (gate ? (u.pn - 16) : u.pn) * 256 + wc * 32 + 8 * fq;
#pragma unroll
        for (int ai = 0; ai < 2; ++ai)
#pragma unroll
            for (int m = 0; m < 4; ++m) { bf16_t* rowp = base + (size_t)(row0 + ai * 128 + m * 16) * ld + col0;
#pragma unroll
                for (int bj = 0; bj < 2; ++bj) { f32x4 v0 = acc[ai][bj][m][0] * inv, v1 = acc[ai][bj][m][1] * inv;
                    if (gate) {
#pragma unroll
                        for (int j = 0; j < 4; ++j) { v0[j] = sigmoid_f(v0[j]); v1[j] = sigmoid_f(v1[j]); } }
                    *(u32x4*)(rowp + bj * 128) = pack8(v0, v1); } }
    }
};
struct EpiPlain {
    static constexpr bool PERM = true, FP8 = false;
    bf16_t* O; int ldc;
    __device__ __forceinline__ void operator()(const Acc& acc, const pg8::Unit& u, int wr, int wc, int fr, int fq) const {
        const int row0 = u.pm * 256 + wr * 64 + fr; const int col0 = u.pn * 256 + wc * 32 + 8 * fq;
#pragma unroll
        for (int ai = 0; ai < 2; ++ai)
#pragma unroll
            for (int m = 0; m < 4; ++m) { bf16_t* rowp = O + (size_t)(row0 + ai * 128 + m * 16) * ldc + col0;
#pragma unroll
                for (int bj = 0; bj < 2; ++bj) *(u32x4*)(rowp + bj * 128) = pack8(acc[ai][bj][m][0], acc[ai][bj][m][1]); }
    }
};
__device__ __forceinline__ void tile_info(int pm, int& b, int& tpos0, bool& lat) { lat = pm < 64; b = lat ? (pm >> 4) : (pm - 64); tpos0 = lat ? CTXL + ((pm & 15) << 8) : 0; }
struct EpiQup {
    static constexpr bool PERM = true, FP8 = false;
    bf16_t* QM; const f32x2* cs32;
    __device__ __forceinline__ void operator()(const Acc& acc, const pg8::Unit& u, int wr, int wc, int fr, int fq) const {
        int b, tpos0; bool lat; tile_info(u.pm, b, tpos0, lat);
        const int r0 = wr * 64 + fr;
#pragma unroll
        for (int bj = 0; bj < 2; ++bj) { const int c0 = u.pn * 256 + bj * 128 + wc * 32 + 8 * fq; const int hh = c0 / 96, j0 = c0 - hh * 96;
            bf16_t* hb = QM + ((size_t)(b * 8 + hh) * TT + tpos0 + r0) * 128;
            if (j0 < 64) {
#pragma unroll
                for (int ai = 0; ai < 2; ++ai)
#pragma unroll
                    for (int m = 0; m < 4; ++m) *(u32x4*)(hb + (ai * 128 + m * 16) * 128 + j0) = pack8(acc[ai][bj][m][0], acc[ai][bj][m][1]);
            } else { const int g8 = (j0 - 64) >> 3, part = g8 >> 1, pbase = (g8 & 1) * 4;
#pragma unroll
                for (int ai = 0; ai < 2; ++ai)
#pragma unroll
                    for (int m = 0; m < 4; ++m) { const int t = tpos0 - CTXL + r0 + ai * 128 + m * 16; const int pos = part ? (t & 63) : (t >> 6);
                        const f32x4 v0 = acc[ai][bj][m][0], v1 = acc[ai][bj][m][1];
                        float o1[4], o2[4]; const float x1[4] = {v0[0], v0[2], v1[0], v1[2]}, x2[4] = {v0[1], v0[3], v1[1], v1[3]};
#pragma unroll
                        for (int p = 0; p < 4; ++p) { const f32x2 cs = lat ? cs32[pos * 8 + pbase + p] : (f32x2){1.f, 0.f};
                            o1[p] = x1[p] * cs.x - x2[p] * cs.y; o2[p] = x1[p] * cs.y + x2[p] * cs.x; }
                        u32x2 w1, w2; w1.x = cvt_pk_bf16(o1[0], o1[1]); w1.y = cvt_pk_bf16(o1[2], o1[3]); w2.x = cvt_pk_bf16(o2[0], o2[1]); w2.y = cvt_pk_bf16(o2[2], o2[3]);
                        bf16_t* dst = hb + (ai * 128 + m * 16) * 128 + 64 + part * 16 + pbase;
                        *(u32x2*)dst = w1; *(u32x2*)(dst + 8) = w2; } } }
    }
};
struct EpiKvup {
    static constexpr bool PERM = true, FP8 = false;
    bf16_t* KM; bf16_t* VM;
    __device__ __forceinline__ void operator()(const Acc& acc, const pg8::Unit& u, int wr, int wc, int fr, int fq) const {
        int b, tpos0; bool lat; tile_info(u.pm, b, tpos0, lat);
        const int r0 = wr * 64 + fr; const int j0 = wc * 32 + 8 * fq;
#pragma unroll
        for (int bj = 0; bj < 2; ++bj) { const size_t tok = (size_t)(b * 8 + u.pn * 2 + bj) * TT + tpos0 + r0;
            if (j0 < 64) { bf16_t* d = KM + tok * 128 + j0;
#pragma unroll
                for (int ai = 0; ai < 2; ++ai)
#pragma unroll
                    for (int m = 0; m < 4; ++m) *(u32x4*)(d + (ai * 128 + m * 16) * 128) = pack8(acc[ai][bj][m][0], acc[ai][bj][m][1]); }
            else { bf16_t* d = VM + tok * 64 + (j0 - 64);
#pragma unroll
                for (int ai = 0; ai < 2; ++ai)
#pragma unroll
                    for (int m = 0; m < 4; ++m) *(u32x4*)(d + (ai * 128 + m * 16) * 64) = pack8(acc[ai][bj][m][0], acc[ai][bj][m][1]); } }
    }
};
template <int SEG> struct EpiMerge {
    static constexpr bool PERM = true, FP8 = false;
    bf16_t* MB; const bf16_t* G; unsigned char* MB8;
    __device__ __forceinline__ void operator()(const Acc& acc, const pg8::Unit& u, int wr, int wc, int fr, int fq) const {
        const int row0 = u.pm * 256 + wr * 64 + fr; const int col0 = u.pn * 256 + wc * 32 + 8 * fq;
        const bf16_t* gp = G + (size_t)row0 * NG + SEG * 2048 + col0; bf16_t* mp = MB + (size_t)row0 * D + col0; unsigned char* m8 = MB8 + (size_t)row0 * D + col0;
#pragma unroll
        for (int ai = 0; ai < 2; ++ai) {
            u32x4 gw[4][2], ow[4][2];
#pragma unroll
            for (int m = 0; m < 4; ++m)
#pragma unroll
                for (int bj = 0; bj < 2; ++bj) { const size_t ro = (size_t)(ai * 128 + m * 16);
                    gw[m][bj] = *(const u32x4*)(gp + ro * NG + bj * 128);
                    if (SEG > 0) ow[m][bj] = __builtin_nontemporal_load((const u32x4*)(mp + ro * D + bj * 128)); }
#pragma unroll
            for (int m = 0; m < 4; ++m)
#pragma unroll
                for (int bj = 0; bj < 2; ++bj) { const size_t ro = (size_t)(ai * 128 + m * 16); const u32x4 g_ = gw[m][bj];
                    f32x4 v0 = acc[ai][bj][m][0], v1 = acc[ai][bj][m][1];
                    if (ABL_BR & (1 << SEG)) { v0 = (f32x4){0.f, 0.f, 0.f, 0.f}; v1 = v0; }
                    v0[0] *= bflo(g_.x); v0[1] *= bfhi(g_.x); v0[2] *= bflo(g_.y); v0[3] *= bfhi(g_.y);
                    v1[0] *= bflo(g_.z); v1[1] *= bfhi(g_.z); v1[2] *= bflo(g_.w); v1[3] *= bfhi(g_.w);
                    if (SEG > 0) { const u32x4 o = ow[m][bj];
                        v0[0] += bflo(o.x); v0[1] += bfhi(o.x); v0[2] += bflo(o.y); v0[3] += bfhi(o.y);
                        v1[0] += bflo(o.z); v1[1] += bfhi(o.z); v1[2] += bflo(o.w); v1[3] += bfhi(o.w); }
                    if (SEG < 2) *(u32x4*)(mp + ro * D + bj * 128) = pack8(v0, v1);
                    else { u32x2 w8; w8.x = pk4_fp8(clamp8(v0[0] * 16.f), clamp8(v0[1] * 16.f), clamp8(v0[2] * 16.f), clamp8(v0[3] * 16.f)); w8.y = pk4_fp8(clamp8(v1[0] * 16.f), clamp8(v1[1] * 16.f), clamp8(v1[2] * 16.f), clamp8(v1[3] * 16.f));
                        *(u32x2*)(m8 + ro * D + bj * 128) = w8; } }
        }
    }
};
struct EpiOut {
    static constexpr bool PERM = false, FP8 = true;
    const float* src_lat; const float* src_ctx; float* dst_lat; float* dst_ctx; const float* g1; float inv;
    __device__ __forceinline__ void operator()(const Acc& acc, const pg8::Unit& u, int wr, int wc, int fr, int fq) const {
        const int row0 = u.pm * 256 + wr * 64 + fr; const int col0 = u.pn * 256 + wc * 32 + 4 * fq;
        const bool lat = (u.pm * 256) < NLAT;
        const float* src = (lat ? src_lat : src_ctx - (size_t)NLAT * D) + (size_t)row0 * D + col0; float* dst = (lat ? dst_lat : dst_ctx - (size_t)NLAT * D) + (size_t)row0 * D + col0;
#pragma unroll
        for (int ai = 0; ai < 2; ++ai) { const int rbase = u.pm * 256 + ai * 128 + wr * 64; const int v = lat ? (rbase >> 12) : 4; const float* gp = g1 + (size_t)v * 12288 + col0;
            f32x4 gg[2][2];
#pragma unroll
            for (int bj = 0; bj < 2; ++bj)
#pragma unroll
                for (int n = 0; n < 2; ++n) gg[bj][n] = *(const f32x4*)(gp + bj * 128 + n * 16);
#pragma unroll
            for (int mh = 0; mh < 2; ++mh) {
                f32x4 xr[2][2][2];
#pragma unroll
                for (int mm = 0; mm < 2; ++mm)
#pragma unroll
                    for (int bj = 0; bj < 2; ++bj)
#pragma unroll
                        for (int n = 0; n < 2; ++n) xr[mm][bj][n] = __builtin_nontemporal_load((const f32x4*)(src + (size_t)(ai * 128 + (mh * 2 + mm) * 16) * D + bj * 128 + n * 16));
#pragma unroll
                for (int mm = 0; mm < 2; ++mm)
#pragma unroll
                    for (int bj = 0; bj < 2; ++bj)
#pragma unroll
                        for (int n = 0; n < 2; ++n) { const int m = mh * 2 + mm;
                            *(f32x4*)(dst + (size_t)(ai * 128 + m * 16) * D + bj * 128 + n * 16) = ABL_MIX ? xr[mm][bj][n] * ALPHA : xr[mm][bj][n] * ALPHA + gg[bj][n] * (acc[ai][bj][m][n] * inv); } } }
    }
};

struct Args { const float* in[27]; float* out; unsigned char* ws; int ph_lo, ph_hi; };
typedef const Args __attribute__((address_space(4)))* ArgP;
struct Frame {
    LAS unsigned char* lds; int tid, lane, wave, G, bid;
    ArgP ap; float* out; unsigned char* ws;
    __device__ __forceinline__ const float* in(int i) const { return ap->in[i]; }
};
__device__ __forceinline__ Frame make_frame(ArgP ap) {
    { unsigned long long t = (unsigned long long)ap; asm volatile("" : "+s"(t)); ap = (ArgP)t; }
    extern __shared__ __attribute__((aligned(16))) unsigned char lds_raw[];
    Frame F; F.lds = (LAS unsigned char*)lds_raw; { int t_ = threadIdx.x; asm volatile("" : "+v"(t_)); F.tid = t_; }
    F.lane = F.tid & 63; F.wave = __builtin_amdgcn_readfirstlane(F.tid >> 6); F.G = gridDim.x; F.bid = blockIdx.x;
    F.ap = ap; F.out = ap->out; F.ws = ap->ws; return F;
}
template <class T> __device__ __forceinline__ T* wsp(const Frame& F, size_t off) { return (T*)(F.ws + off); }

__device__ __forceinline__ int win_col(int n) {
    if (n < 768) return n;
    if (n < 1792) return 2336 + (n - 768);
    if (n < 2048) return 3360 + (n - 1792);
    if (n < 2304) return 3616 + (n - 2048);
    if (n < 2560) return 800 + (n - 2304);
    if (n < 2816) return 1056 + (n - 2560);
    if (n < 3328) return 1312 + (n - 2816);
    if (n < 3840) return 1824 + (n - 3328);
    if (n < 3872) return 768 + (n - 3840);
    if (n < 4096) return -1;
    return 3872 + (n - 4096);
}
__device__ __forceinline__ int qup_col(int c) {
    const int hh = c / 96, j = c - hh * 96;
    if (j < 64) return c;
    const int jj = j - 64, g8 = jj >> 3, i = jj & 7, p = i >> 1, which = i & 1, part = g8 >> 1, pi = (g8 & 1) * 4 + p;
    return hh * 96 + 64 + part * 16 + which * 8 + pi;
}
template <int MAP>
__device__ __forceinline__ void transpose_cvt(const Frame& F, const float* __restrict__ src, bf16_t* __restrict__ dst, int K, int Nsrc, int Nd) {
    LAS float* tile = (LAS float*)F.lds;
    const int tk = K / 256, tn = Nd / 64, ntile = tk * tn;
    for (int t = F.bid; t < ntile; t += F.G) {
        const int k0 = (t % tk) * 256, n0 = (t / tk) * 64;
        const int nl = F.tid & 63, kq = F.tid >> 6;
        const int nd = n0 + nl; const int ns = MAP == 0 ? nd : (MAP == 1 ? win_col(nd) : qup_col(nd));
        float v[32];
#pragma unroll
        for (int i = 0; i < 32; ++i) v[i] = ns >= 0 ? src[(size_t)(k0 + kq + 8 * i) * Nsrc + ns] : 0.f;
#pragma unroll
        for (int i = 0; i < 32; ++i) tile[(kq + 8 * i) * 65 + nl] = v[i];
        __syncthreads();
        { const int n = F.tid >> 3, k32 = (F.tid & 7) * 32;
#pragma unroll
          for (int c = 0; c < 4; ++c) { float w[8];
#pragma unroll
              for (int j = 0; j < 8; ++j) w[j] = tile[(k32 + c * 8 + j) * 65 + n];
              u32x4 o; o.x = cvt_pk_bf16(w[0], w[1]); o.y = cvt_pk_bf16(w[2], w[3]); o.z = cvt_pk_bf16(w[4], w[5]); o.w = cvt_pk_bf16(w[6], w[7]);
              *(u32x4*)(dst + (size_t)(n0 + n) * K + k0 + k32 + c * 8) = o; } }
        __syncthreads();
    }
}
__device__ __forceinline__ void cvt_rows(const Frame& F, const float* __restrict__ src, bf16_t* __restrict__ dst, size_t n8) {
    for (size_t i = (size_t)F.bid * 512 + F.tid; i < n8; i += (size_t)F.G * 512) {
        const f32x4 a = __builtin_nontemporal_load((const f32x4*)(src + i * 8)), b = __builtin_nontemporal_load((const f32x4*)(src + i * 8 + 4));
        *(u32x4*)(dst + i * 8) = pack8(a, b);
    }
}
__device__ __forceinline__ void cvt_peer(const Frame& F, int l);
__device__ __forceinline__ void absmax_f32(const Frame& F, const float* __restrict__ src, size_t n4, unsigned* dst) {
    float am = 0.f;
    const size_t stride = (size_t)F.G * 512; size_t i = (size_t)F.bid * 512 + F.tid;
    for (; i + 7 * stride < n4; i += 8 * stride) { f32x4 a[8];
#pragma unroll
        for (int j = 0; j < 8; ++j) a[j] = __builtin_nontemporal_load((const f32x4*)(src + (i + j * stride) * 4));
#pragma unroll
        for (int j = 0; j < 8; ++j) am = fmaxf(fmaxf(fmaxf(am, fabsf(a[j][0])), fabsf(a[j][1])), fmaxf(fabsf(a[j][2]), fabsf(a[j][3]))); }
    for (; i < n4; i += stride) { const f32x4 a = *(const f32x4*)(src + i * 4); am = fmaxf(fmaxf(fmaxf(am, fabsf(a[0])), fabsf(a[1])), fmaxf(fabsf(a[2]), fabsf(a[3]))); }
    am = row16_max(am);
    { auto r = __builtin_amdgcn_permlane16_swap(__float_as_uint(am), __float_as_uint(am), false, false); am = fmaxf(__uint_as_float(r[0]), __uint_as_float(r[1])); }
    { auto r = __builtin_amdgcn_permlane32_swap(__float_as_uint(am), __float_as_uint(am), false, false); am = fmaxf(__uint_as_float(r[0]), __uint_as_float(r[1])); }
    if (F.lane == 0) atomicMax(dst, __float_as_uint(am));
}
template <int MAP>
__device__ __forceinline__ void transpose_fp8(const Frame& F, const float* __restrict__ src, unsigned char* __restrict__ dst, int K, int Nsrc, int Nd, const unsigned* wsc) {
    float mul, inv; fp8_scale(__hip_atomic_load(wsc, __ATOMIC_RELAXED, __HIP_MEMORY_SCOPE_AGENT), mul, inv);
    LAS float* tile = (LAS float*)F.lds;
    const int tk = K / 256, tn = Nd / 64, ntile = tk * tn;
    for (int t = F.bid; t < ntile; t += F.G) {
        const int k0 = (t % tk) * 256, n0 = (t / tk) * 64;
        const int nl = F.tid & 63, kq = F.tid >> 6; const int ns = MAP ? win_col(n0 + nl) : n0 + nl;
        float v[32];
#pragma unroll
        for (int i = 0; i < 32; ++i) v[i] = ns >= 0 ? src[(size_t)(k0 + kq + 8 * i) * Nsrc + ns] : 0.f;
#pragma unroll
        for (int i = 0; i < 32; ++i) tile[(kq + 8 * i) * 65 + nl] = v[i] * mul;
        __syncthreads();
        { const int n = F.tid >> 3, k32 = (F.tid & 7) * 32;
#pragma unroll
          for (int c = 0; c < 2; ++c) { float w[16];
#pragma unroll
              for (int j = 0; j < 16; ++j) w[j] = tile[(k32 + c * 16 + j) * 65 + n];
              u32x4 o; o.x = pk4_fp8(w[0], w[1], w[2], w[3]); o.y = pk4_fp8(w[4], w[5], w[6], w[7]); o.z = pk4_fp8(w[8], w[9], w[10], w[11]); o.w = pk4_fp8(w[12], w[13], w[14], w[15]);
              *(u32x4*)(dst + (size_t)(n0 + n) * K + k0 + k32 + c * 16) = o; } }
        __syncthreads();
    }
}
__device__ __forceinline__ void p0_prologue(const Frame& F) {
    { const int gi = F.bid * 512 + F.tid;
      if (gi < 64 * 8) { const int pos = gi >> 3, f = gi & 7; const float inv = powf(10000.f, -(float)f / 8.f); const float a = (float)pos * inv; wsp<f32x2>(F, WS_ROPE32)[gi] = (f32x2){cosf(a), sinf(a)}; }
      else if (gi < 64 * 8 + 64 * 32) { const int g2 = gi - 512; const int pos = g2 >> 5, f = g2 & 31; const float inv = powf(10000.f, -(float)f / 32.f); const float a = (float)pos * inv; wsp<f32x2>(F, WS_ROPE128)[g2] = (f32x2){cosf(a), sinf(a)}; } }
    if (F.bid == 0 && F.tid < 32) wsp<float>(F, WS_DEC)[F.tid] = -log1pf(expf(-F.in(11)[F.tid])) * LOG2E;
    { LAS float* sl = (LAS float*)F.lds;
      float* modp = wsp<float>(F, WS_MODP);
      for (int u = F.bid; u < 2 * 24 * 16; u += F.G) {
          const int kc = u & 15, cb = (u >> 4) % 24, l = u / (16 * 24);
          __syncthreads();
          for (int i = F.tid; i < 640; i += 512) { const int v = i >> 7, k = kc * 128 + (i & 127); const float c = v < 4 ? F.in(1)[v * 2048 + k] : F.in(3)[k]; sl[i] = silu_f(c); }
          __syncthreads();
          const int col = cb * 512 + F.tid; const float* w = F.in(4) + ((size_t)l * 2048 + kc * 128) * 12288 + col;
          float a0 = 0.f, a1 = 0.f, a2 = 0.f, a3 = 0.f, a4 = 0.f;
#pragma unroll 32
          for (int k = 0; k < 128; ++k) { const float wv = w[(size_t)k * 12288]; a0 += sl[k] * wv; a1 += sl[128 + k] * wv; a2 += sl[256 + k] * wv; a3 += sl[384 + k] * wv; a4 += sl[512 + k] * wv; }
          float* o = modp + ((size_t)(kc * 2 + l) * 5) * 12288 + col;
          o[0] = a0; o[12288] = a1; o[2 * 12288] = a2; o[3 * 12288] = a3; o[4 * 12288] = a4;
      }
      __syncthreads(); }
    for (int l = 0; l < 2; ++l) {
        absmax_f32(F, F.in(6) + (size_t)l * 2048 * NIN, (size_t)2048 * NIN / 4, wsp<unsigned>(F, WS_WSC) + l);
        transpose_cvt<2>(F, F.in(8) + (size_t)l * 512 * 768, wsp<bf16_t>(F, WS_WQUP + l * SZ_WQUP), 512, 768, 768);
        transpose_cvt<0>(F, F.in(10) + (size_t)l * 256 * 1024, wsp<bf16_t>(F, WS_WKVUP + l * SZ_WKVUP), 256, 1024, 1024);
        transpose_cvt<0>(F, F.in(14) + (size_t)l * 512 * 2048, wsp<bf16_t>(F, WS_WBRA + l * SZ_WBRA), 512, 2048, 2048);
        transpose_cvt<0>(F, F.in(15) + (size_t)l * 512 * 2048, wsp<bf16_t>(F, WS_WBRB + l * SZ_WBRB), 512, 2048, 2048);
        transpose_cvt<0>(F, F.in(16) + (size_t)l * 1024 * 2048, wsp<bf16_t>(F, WS_WBRC + l * SZ_WBRC), 1024, 2048, 2048);
        absmax_f32(F, F.in(17) + (size_t)l * 2048 * 2048, (size_t)2048 * 2048 / 4, wsp<unsigned>(F, WS_WSC) + 2 + l);
        transpose_cvt<0>(F, F.in(20) + (size_t)l * 2048 * 1024, wsp<bf16_t>(F, WS_WPQ + l * SZ_WPQ), 2048, 1024, 1024);
    }
    cvt_peer(F, 0);
}
__device__ __forceinline__ void p1_modreduce(const Frame& F) {
    const float* modp = wsp<float>(F, WS_MODP); float* mod = wsp<float>(F, WS_MOD);
    for (int i = F.bid * 512 + F.tid; i < 2 * 5 * 12288; i += F.G * 512) {
        const int j = i % 12288, l = i / (5 * 12288);
        float s = F.in(5)[l * 12288 + j];
#pragma unroll
        for (int kc = 0; kc < 16; ++kc) s += modp[(size_t)kc * (2 * 5 * 12288) + i];
        mod[i] = s;
    }
    for (int l = 0; l < 2; ++l) {
        transpose_fp8<1>(F, F.in(6) + (size_t)l * 2048 * NIN, wsp<unsigned char>(F, WS_WIN + l * SZ_WIN), 2048, NIN, NPT, wsp<unsigned>(F, WS_WSC) + l);
        transpose_fp8<0>(F, F.in(17) + (size_t)l * 2048 * 2048, wsp<unsigned char>(F, WS_WOUT + l * SZ_WOUT), 2048, 2048, 2048, wsp<unsigned>(F, WS_WSC) + 2 + l);
    }
}
__device__ __forceinline__ void ld_row_f32(const float* p, int lane, float (&x)[32]) {
#pragma unroll
    for (int q = 0; q < 4; ++q) { const f32x4 a = *(const f32x4*)(p + 512 * q + 8 * lane), b = *(const f32x4*)(p + 512 * q + 8 * lane + 4);
        x[q * 8 + 0] = a[0]; x[q * 8 + 1] = a[1]; x[q * 8 + 2] = a[2]; x[q * 8 + 3] = a[3]; x[q * 8 + 4] = b[0]; x[q * 8 + 5] = b[1]; x[q * 8 + 6] = b[2]; x[q * 8 + 7] = b[3]; }
}
__device__ __forceinline__ void st_row_f32(float* p, int lane, const float (&x)[32]) {
#pragma unroll
    for (int q = 0; q < 4; ++q) { *(f32x4*)(p + 512 * q + 8 * lane) = (f32x4){x[q * 8 + 0], x[q * 8 + 1], x[q * 8 + 2], x[q * 8 + 3]}; *(f32x4*)(p + 512 * q + 8 * lane + 4) = (f32x4){x[q * 8 + 4], x[q * 8 + 5], x[q * 8 + 6], x[q * 8 + 7]}; }
}
__device__ __forceinline__ void st_row_bf16(bf16_t* p, int lane, const float (&x)[32]) {
#pragma unroll
    for (int q = 0; q < 4; ++q) { u32x4 w; w.x = cvt_pk_bf16(x[q * 8 + 0], x[q * 8 + 1]); w.y = cvt_pk_bf16(x[q * 8 + 2], x[q * 8 + 3]); w.z = cvt_pk_bf16(x[q * 8 + 4], x[q * 8 + 5]); w.w = cvt_pk_bf16(x[q * 8 + 6], x[q * 8 + 7]);
        *(u32x4*)(p + 512 * q + 8 * lane) = w; }
}
__device__ __forceinline__ void p_modulate0(const Frame& F) {
    const float* mod = wsp<float>(F, WS_MOD); unsigned char* hb8 = wsp<unsigned char>(F, WS_HB8);
    for (int row = F.bid * 8 + F.wave; row < NROW; row += F.G * 8) {
        const RowInfo ri = rowinfo(row);
        const float* xp = ri.lat ? F.in(0) + (size_t)row * D : F.in(2) + (size_t)(row - NLAT) * D;
        const float* mp = mod + (size_t)ri.v * 12288;
        float x[32], sh[32], sc[32];
        ld_row_f32(xp, F.lane, x); ld_row_f32(mp, F.lane, sh); ld_row_f32(mp + 2048, F.lane, sc);
#pragma unroll
        for (int i = 0; i < 32; ++i) x[i] = clamp8(x[i] * (1.f + sc[i]) + sh[i]);
#pragma unroll
        for (int q = 0; q < 4; ++q) { u32x2 w; w.x = pk4_fp8(x[q * 8 + 0], x[q * 8 + 1], x[q * 8 + 2], x[q * 8 + 3]); w.y = pk4_fp8(x[q * 8 + 4], x[q * 8 + 5], x[q * 8 + 6], x[q * 8 + 7]); *(u32x2*)(hb8 + (size_t)row * D + 512 * q + 8 * F.lane) = w; }
    }
}
__device__ __forceinline__ void p_post(const Frame& F, int l) {
    const bf16_t* P1 = wsp<bf16_t>(F, WS_P1);
    bf16_t* CQN = wsp<bf16_t>(F, WS_CQN); bf16_t* CKVN = wsp<bf16_t>(F, WS_CKVN);
    bf16_t* QG = wsp<bf16_t>(F, WS_QG); bf16_t* KG = wsp<bf16_t>(F, WS_KG); bf16_t* VG = wsp<bf16_t>(F, WS_VG);
    bf16_t* RQ = wsp<bf16_t>(F, WS_RQ); bf16_t* RK = wsp<bf16_t>(F, WS_RK); bf16_t* RV = wsp<bf16_t>(F, WS_RV);
    bf16_t* KM = wsp<bf16_t>(F, WS_KM);
    const f32x2* cs32 = wsp<f32x2>(F, WS_ROPE32); const f32x2* cs128 = wsp<f32x2>(F, WS_ROPE128);
    const float* gq_n = F.in(7) + l * 512; const float* gkv_n = F.in(9) + l * 256; const float* gqa_qn = F.in(12) + l * 128; const float* gqa_kn = F.in(13) + l * 128;
    LAS bf16_t* rs = (LAS bf16_t*)(F.lds + F.wave * 8192);
    const int lane = F.lane;
    const f32x4 gq0 = *(const f32x4*)(gq_n + lane * 8), gq1 = *(const f32x4*)(gq_n + lane * 8 + 4), gkv0 = *(const f32x4*)(gkv_n + lane * 4);
    const int gd0 = 2 * lane; const int gpart = gd0 >> 6, gdd = gd0 & 63; const bool glo = gdd < 32; const int gf = glo ? gdd : gdd - 32; const int gdp = glo ? gd0 + 32 : gd0 - 32;
    const float qn0 = gqa_qn[gd0], qn1 = gqa_qn[gd0 + 1], qnp0 = gqa_qn[gdp], qnp1 = gqa_qn[gdp + 1];
    const float kn0 = gqa_kn[gd0], kn1 = gqa_kn[gd0 + 1], knp0 = gqa_kn[gdp], knp1 = gqa_kn[gdp + 1];
    const int rhh = lane >> 3, rd0 = (lane & 7) * 4; const int rpart = rd0 >> 4, rdd = rd0 & 15; const bool rlo = rdd < 8; const int rf = rlo ? rdd : rdd - 8; const int rdp = rlo ? rd0 + 8 : rd0 - 8;
    const int step = F.G * 8;
    int row = F.bid * 8 + F.wave;
    u32x4 pre[8];
    if (row < NROW) {
#pragma unroll
        for (int q = 0; q < 8; ++q) pre[q] = *(const u32x4*)(P1 + (size_t)row * NP1 + q * 512 + lane * 8); }
#pragma unroll 1
    for (; row < NROW; row += step) {
        const RowInfo ri = rowinfo(row);
        const int posg = gpart ? ri.pc : ri.pr, posr = rpart ? ri.pc : ri.pr;
        const f32x2 one = {1.f, 0.f};
        const f32x2 csA = ri.lat ? cs128[posg * 32 + gf] : one, csB = ri.lat ? cs128[posg * 32 + gf + 1] : one;
        f32x2 cs[4];
#pragma unroll
        for (int i = 0; i < 4; ++i) cs[i] = ri.lat ? cs32[posr * 8 + rf + i] : one;
#pragma unroll
        for (int q = 0; q < 8; ++q) *(LAS u32x4*)(rs + q * 512 + lane * 8) = pre[q];
        { const int nrow = row + step; if (nrow < NROW) {
#pragma unroll
            for (int q = 0; q < 8; ++q) pre[q] = *(const u32x4*)(P1 + (size_t)nrow * NP1 + q * 512 + lane * 8); } }
        asm volatile("s_waitcnt lgkmcnt(0)" ::: "memory");
        { float x[8]; float ss = 0.f;
#pragma unroll
          for (int i = 0; i < 8; ++i) { x[i] = bf2f(rs[C_CQ + lane * 8 + i]); ss += x[i] * x[i]; }
          ss = wave_sum(ss); const float r = rsqrtf(ss * (1.f / 512.f) + RMS_EPS);
          *(u32x4*)(CQN + (size_t)row * 512 + lane * 8) = pack8((f32x4){x[0] * r * gq0[0], x[1] * r * gq0[1], x[2] * r * gq0[2], x[3] * r * gq0[3]}, (f32x4){x[4] * r * gq1[0], x[5] * r * gq1[1], x[6] * r * gq1[2], x[7] * r * gq1[3]}); }
        { float x[4]; float ss = 0.f;
#pragma unroll
          for (int i = 0; i < 4; ++i) { x[i] = bf2f(rs[C_CKV + lane * 4 + i]); ss += x[i] * x[i]; }
          ss = wave_sum(ss); const float r = rsqrtf(ss * (1.f / 256.f) + RMS_EPS);
          u32x2 w; w.x = cvt_pk_bf16(x[0] * r * gkv0[0], x[1] * r * gkv0[1]); w.y = cvt_pk_bf16(x[2] * r * gkv0[2], x[3] * r * gkv0[3]);
          *(u32x2*)(CKVN + (size_t)row * 256 + lane * 4) = w; }
        {
            const int d0 = gd0, dp = gdp; const bool lo = glo;
#pragma unroll 1
            for (int hh = 0; hh < 10; ++hh) {
                const bool isq = hh < 8; const int cbase = isq ? C_GQ + hh * 128 : C_GK + (hh - 8) * 128;
                const float g0 = isq ? qn0 : kn0, g1 = isq ? qn1 : kn1, gp0 = isq ? qnp0 : knp0, gp1 = isq ? qnp1 : knp1;
                const float a0 = bf2f(rs[cbase + d0]), a1 = bf2f(rs[cbase + d0 + 1]);
                float ss = wave_sum(a0 * a0 + a1 * a1); const float r = rsqrtf(ss * (1.f / 128.f) + RMS_EPS);
                const float n0 = a0 * r * g0, n1 = a1 * r * g1;
                const float p0 = bf2f(rs[cbase + dp]) * r * gp0, p1 = bf2f(rs[cbase + dp + 1]) * r * gp1;
                float o0, o1;
                if (lo) { o0 = n0 * csA.x - p0 * csA.y; o1 = n1 * csB.x - p1 * csB.y; }
                else    { o0 = p0 * csA.y + n0 * csA.x; o1 = p1 * csB.y + n1 * csB.x; }
                bf16_t* dst = isq ? QG + ((size_t)(ri.b * 8 + hh) * TT + ri.tpos) * 128 : KG + ((size_t)(ri.b * 2 + (hh - 8)) * TT + ri.tpos) * 128;
                *(unsigned*)(dst + d0) = cvt_pk_bf16(o0, o1);
            }
#pragma unroll
            for (int hh = 0; hh < 2; ++hh) *(unsigned*)(VG + ((size_t)(ri.b * 2 + hh) * TT + ri.tpos) * 128 + d0) = *(LAS unsigned*)(rs + C_GV + hh * 128 + d0);
        }
        {
            const int hh = rhh, d0 = rd0, dp = rdp; const bool lo = rlo;
#pragma unroll
            for (int which = 0; which < 2; ++which) {
                const int cbase = (which ? C_RK : C_RQ) + hh * 32; const float sc = which ? 0.17677669529663687f : 1.f;
                float o[4];
#pragma unroll
                for (int i = 0; i < 4; ++i) { const float n = bf2f(rs[cbase + d0 + i]), p = bf2f(rs[cbase + dp + i]);
                    o[i] = (lo ? (n * cs[i].x - p * cs[i].y) : (p * cs[i].y + n * cs[i].x)) * sc; }
                u32x2 w; w.x = cvt_pk_bf16(o[0], o[1]); w.y = cvt_pk_bf16(o[2], o[3]);
                *(u32x2*)((which ? RK : RQ) + ((size_t)(ri.b * 8 + hh) * TT + ri.tpos) * 32 + d0) = w;
            }
            { const int vh = lane >> 3, e0 = (lane & 7) * 8;
              *(u32x4*)(RV + ((size_t)(ri.b * 8 + vh) * TT + ri.tpos) * 64 + e0) = *(LAS u32x4*)(rs + C_RV + lane * 8); }
            { float o[4];
#pragma unroll
              for (int i = 0; i < 4; ++i) { const float n = bf2f(rs[C_KR + d0 + i]), p = bf2f(rs[C_KR + dp + i]); o[i] = lo ? (n * cs[i].x - p * cs[i].y) : (p * cs[i].y + n * cs[i].x); }
              u32x2 w; w.x = cvt_pk_bf16(o[0], o[1]); w.y = cvt_pk_bf16(o[2], o[3]);
              *(u32x2*)(KM + ((size_t)(ri.b * 8 + hh) * TT + ri.tpos) * 128 + 64 + d0) = w; }
        }
        asm volatile("s_waitcnt lgkmcnt(0)" ::: "memory");
    }
}

__device__ __forceinline__ void ret_logs(const Frame& F, int l, int h, float& lgf, float& lgb) {
    const float* t = wsp<float>(F, WS_DEC); lgf = t[(l * 2 + 0) * 8 + h]; lgb = t[(l * 2 + 1) * 8 + h];
}
constexpr int TP = 136;
template <bool WITH_K>
__device__ __forceinline__ void ret_stage(const Frame& F, const bf16_t* RKh, const bf16_t* RVh, int tpos0, float lgf, float lgb, LAS bf16_t* vt, LAS bf16_t* ktf, LAS bf16_t* ktb) {
#pragma unroll
    for (int i = 0; i < 2; ++i) { const int tok = (F.tid >> 3) + 64 * i, e0 = (F.tid & 7) * 8;
        const u32x4 w = *(const u32x4*)(RVh + (size_t)(tpos0 + tok) * 64 + e0); const unsigned ww[4] = {w.x, w.y, w.z, w.w};
#pragma unroll
        for (int j = 0; j < 4; ++j) { vt[(e0 + 2 * j) * TP + tok] = (bf16_t)(ww[j] & 0xffffu); vt[(e0 + 2 * j + 1) * TP + tok] = (bf16_t)(ww[j] >> 16); } }
    if (WITH_K) { const int tok = F.tid >> 2, k0 = (F.tid & 3) * 8;
        const u32x4 w = *(const u32x4*)(RKh + (size_t)(tpos0 + tok) * 32 + k0); const unsigned ww[4] = {w.x, w.y, w.z, w.w};
        const float zf = exp2f(lgf * (float)(127 - tok)), zb = exp2f(lgb * (float)tok);
#pragma unroll
        for (int j = 0; j < 4; ++j) { const float a = bflo(ww[j]), b = bfhi(ww[j]);
            ktf[(k0 + 2 * j) * TP + tok] = f2bf(a * zf); ktf[(k0 + 2 * j + 1) * TP + tok] = f2bf(b * zf);
            ktb[(k0 + 2 * j) * TP + tok] = f2bf(a * zb); ktb[(k0 + 2 * j + 1) * TP + tok] = f2bf(b * zb); } }
}
__device__ __forceinline__ void p_ret_states(const Frame& F, int l) {
    LAS bf16_t* vt = (LAS bf16_t*)F.lds; LAS bf16_t* ktf = vt + 64 * TP; LAS bf16_t* ktb = ktf + 32 * TP;
    float* ST = wsp<float>(F, WS_ST);
    const int lane = F.lane, w = F.wave, kb = w >> 2, eb = w & 3, fr = lane & 15, fq = lane >> 4;
    for (int u = F.bid; u < NB * 8 * 34; u += F.G) {
        const int c = u % 34, bh = u / 34, h = bh & 7;
        float lgf, lgb; ret_logs(F, l, h, lgf, lgb);
        __syncthreads();
        ret_stage<true>(F, wsp<bf16_t>(F, WS_RK) + (size_t)bh * TT * 32, wsp<bf16_t>(F, WS_RV) + (size_t)bh * TT * 64, c * 128, lgf, lgb, vt, ktf, ktb);
        __syncthreads();
        f32x4 sf = {0.f, 0.f, 0.f, 0.f}, sb = {0.f, 0.f, 0.f, 0.f};
#pragma unroll
        for (int ks = 0; ks < 4; ++ks) {
            const bf16x8 bv = *(const LAS bf16x8*)(vt + (eb * 16 + fr) * TP + ks * 32 + fq * 8);
            const bf16x8 af = *(const LAS bf16x8*)(ktf + (kb * 16 + fr) * TP + ks * 32 + fq * 8);
            const bf16x8 ab = *(const LAS bf16x8*)(ktb + (kb * 16 + fr) * TP + ks * 32 + fq * 8);
            sf = __builtin_amdgcn_mfma_f32_16x16x32_bf16(af, bv, sf, 0, 0, 0);
            sb = __builtin_amdgcn_mfma_f32_16x16x32_bf16(ab, bv, sb, 0, 0, 0);
        }
        float* o = ST + (size_t)u * 2 * 2048;
#pragma unroll
        for (int r = 0; r < 4; ++r) { const int kd = kb * 16 + fq * 4 + r, e = eb * 16 + fr; o[kd * 64 + e] = sf[r]; o[2048 + kd * 64 + e] = sb[r]; }
    }
}
constexpr int RP = 40;
constexpr int AP = 136;
__device__ __forceinline__ void ret_out_unit(const Frame& F, int l, int bh, int c) {
    LAS bf16_t* vt = (LAS bf16_t*)F.lds; LAS bf16_t* rtf = vt + 64 * TP; LAS bf16_t* rtb = rtf + 64 * RP; LAS bf16_t* as = rtb + 64 * RP + F.wave * 16 * AP;
    const int lane = F.lane, w = F.wave, fr = lane & 15, fq = lane >> 4, h = bh & 7, b = bh >> 3;
    const bf16_t* RQh = wsp<bf16_t>(F, WS_RQ) + (size_t)bh * TT * 32; const bf16_t* RKh = wsp<bf16_t>(F, WS_RK) + (size_t)bh * TT * 32; const bf16_t* RVh = wsp<bf16_t>(F, WS_RV) + (size_t)bh * TT * 64;
    const float* STh = wsp<float>(F, WS_ST) + (size_t)bh * 34 * 2 * 2048;
    float lgf, lgb; ret_logs(F, l, h, lgf, lgb);
    const int tpos0 = c * 128;
    __syncthreads();
    ret_stage<false>(F, RKh, RVh, tpos0, lgf, lgb, vt, nullptr, nullptr);
    { const int kd = F.tid >> 4, e4 = (F.tid & 15) * 4; f32x4 rf = {0.f, 0.f, 0.f, 0.f}, rb = {0.f, 0.f, 0.f, 0.f};
      if (c >= 2) {
          for (int cp = 0; cp < c; ++cp) { const float e2 = lgf * 128.f * (float)(c - 1 - cp); if (e2 < -80.f) continue; const float wgt = exp2f(e2);
              rf += *(const f32x4*)(STh + (size_t)(cp * 2 + 0) * 2048 + kd * 64 + e4) * wgt; }
          const int p = c - 2;
          for (int pp = p + 1; pp < 34; ++pp) { const float e2 = lgb * 128.f * (float)(pp - p - 1); if (e2 < -80.f) break; const float wgt = exp2f(e2); const int cs = pp < 32 ? pp + 2 : pp - 32;
              rb += *(const f32x4*)(STh + (size_t)(cs * 2 + 1) * 2048 + kd * 64 + e4) * wgt; }
      } else if (c == 0) { rb = *(const f32x4*)(STh + (size_t)(1 * 2 + 1) * 2048 + kd * 64 + e4); }
      else { rf = *(const f32x4*)(STh + (size_t)(0 * 2 + 0) * 2048 + kd * 64 + e4); }
#pragma unroll
      for (int j = 0; j < 4; ++j) { rtf[(e4 + j) * RP + kd] = f2bf(rf[j]); rtb[(e4 + j) * RP + kd] = f2bf(rb[j]); } }
    const int i0 = w * 16;
    const bf16x8 qa = *(const bf16x8*)(RQh + (size_t)(tpos0 + i0 + fr) * 32 + fq * 8);
    f32x4 s[8];
#pragma unroll
    for (int nb = 0; nb < 8; ++nb) { const bf16x8 kf = *(const bf16x8*)(RKh + (size_t)(tpos0 + nb * 16 + fr) * 32 + fq * 8);
        s[nb] = __builtin_amdgcn_mfma_f32_16x16x32_bf16(qa, kf, (f32x4){0.f, 0.f, 0.f, 0.f}, 0, 0, 0); }
#pragma unroll
    for (int nb = 0; nb < 8; ++nb)
#pragma unroll
        for (int r = 0; r < 4; ++r) { const int i = i0 + fq * 4 + r, j = nb * 16 + fr; const int df = i - j;
            const float mk = df > 0 ? exp2f(lgf * (float)df) : (df < 0 ? exp2f(lgb * (float)(-df)) : 2.f);
            as[(fq * 4 + r) * AP + j] = f2bf(s[nb][r] * mk); }
    __syncthreads();
    f32x4 y[4];
#pragma unroll
    for (int eb = 0; eb < 4; ++eb) y[eb] = (f32x4){0.f, 0.f, 0.f, 0.f};
#pragma unroll
    for (int ks = 0; ks < 4; ++ks) { const bf16x8 af = *(const LAS bf16x8*)(as + fr * AP + ks * 32 + fq * 8);
#pragma unroll
        for (int eb = 0; eb < 4; ++eb) { const bf16x8 bv = *(const LAS bf16x8*)(vt + (eb * 16 + fr) * TP + ks * 32 + fq * 8);
            y[eb] = __builtin_amdgcn_mfma_f32_16x16x32_bf16(af, bv, y[eb], 0, 0, 0); } }
    { const float xf = exp2f(lgf * (float)(i0 + fr + 1)), xb = exp2f(lgb * (float)(128 - (i0 + fr)));
      bf16x8 qf, qb;
#pragma unroll
      for (int j = 0; j < 8; ++j) { const float qv = bf2f((bf16_t)qa[j]); qf[j] = (short)f2bf(qv * xf); qb[j] = (short)f2bf(qv * xb); }
#pragma unroll
      for (int eb = 0; eb < 4; ++eb) { const bf16x8 bf_ = *(const LAS bf16x8*)(rtf + (eb * 16 + fr) * RP + fq * 8), bb_ = *(const LAS bf16x8*)(rtb + (eb * 16 + fr) * RP + fq * 8);
          y[eb] = __builtin_amdgcn_mfma_f32_16x16x32_bf16(qf, bf_, y[eb], 0, 0, 0);
          y[eb] = __builtin_amdgcn_mfma_f32_16x16x32_bf16(qb, bb_, y[eb], 0, 0, 0); } }
    const bf16_t* P1 = wsp<bf16_t>(F, WS_P1); bf16_t* OAB = wsp<bf16_t>(F, WS_OAB);
#pragma unroll
    for (int r = 0; r < 4; ++r) {
        float sm = y[0][r] + y[1][r] + y[2][r] + y[3][r]; sm = row16_sum(sm); const float mu = sm * (1.f / 64.f);
        float vs = 0.f;
#pragma unroll
        for (int eb = 0; eb < 4; ++eb) { const float d = y[eb][r] - mu; vs += d * d; }
        vs = row16_sum(vs); const float rstd = rsqrtf(vs * (1.f / 64.f) + LN_EPS);
        const int i = i0 + fq * 4 + r; const int tp = tpos0 + i; const size_t grow = tp >= CTXL ? (size_t)b * SEQ + (tp - CTXL) : (size_t)NLAT + b * CTXL + tp;
#pragma unroll
        for (int eb = 0; eb < 4; ++eb) { const int e = eb * 16 + fr; const float g = bf2f(P1[grow * NP1 + C_RG + h * 64 + e]);
            OAB[grow * D + 512 + h * 64 + e] = f2bf(silu_f(g) * (y[eb][r] - mu) * rstd); }
    }
}
namespace att {
constexpr int NW = 8, QBLK = 32, KVBLK = 64;
constexpr size_t SHM_V = KVBLK * 128 * 2, SHM_K = KVBLK * 128 * 2, SHM_ATTN = 2 * SHM_V + 2 * SHM_K + NW * 64 * 4;
constexpr float THR = 8.f;
#define KSWZ(row, colB) ((row) * 256 + ((colB) ^ (((row) & 7) << 4)))
#define SBAR() __builtin_amdgcn_sched_barrier(0)
__device__ __forceinline__ int crow(int r, int hi) { return (r & 3) + 8 * (r >> 2) + 4 * hi; }
template <int SC> struct Scale { static constexpr float S = SC == 0 ? 0.08838834764831845f : 0.10206207261596575f; static constexpr float C = S * 1.4426950408889634f; static constexpr float THRR = THR / S; };
template <int SC>
__device__ __forceinline__ void partialSM(f32x16& p0, f32x16& p1, float& m_reg, float& mn, float& alpha) {
  constexpr float C = Scale<SC>::C, thr_raw = Scale<SC>::THRR;
  float pmax = p0[0];
#pragma unroll
  for (int r = 1; r < 16; ++r) pmax = fmaxf(pmax, p0[r]);
#pragma unroll
  for (int r = 0; r < 16; ++r) pmax = fmaxf(pmax, p1[r]);
  { auto rr = __builtin_amdgcn_permlane32_swap(__float_as_uint(pmax), __float_as_uint(pmax), false, false);
    pmax = fmaxf(__uint_as_float(rr[0]), __uint_as_float(rr[1])); }
  if (__builtin_expect(__all(pmax - m_reg <= thr_raw), 1)) { mn = m_reg; alpha = 1.f; }
  else { mn = fmaxf(m_reg, pmax); alpha = __builtin_amdgcn_exp2f((m_reg - mn) * C); m_reg = mn; }
  const float mnC = -mn * C;
#pragma unroll
  for (int r = 0; r < 16; ++r) p0[r] = fmaf(p0[r], C, mnC);
#pragma unroll
  for (int r = 0; r < 16; ++r) p1[r] = fmaf(p1[r], C, mnC);
#pragma unroll
  for (int r = 0; r < 16; ++r) p0[r] = __builtin_amdgcn_exp2f(p0[r]);
}
__device__ __forceinline__ void finishSM(f32x16& p0, f32x16& p1, float alpha, float& l_reg, bf16x8& pa0, bf16x8& pa1, bf16x8& pa2, bf16x8& pa3) {
#pragma unroll
  for (int r = 0; r < 16; ++r) p1[r] = __builtin_amdgcn_exp2f(p1[r]);
  float ps = 0;
#pragma unroll
  for (int r = 0; r < 16; ++r) ps += p0[r];
#pragma unroll
  for (int r = 0; r < 16; ++r) ps += p1[r];
  { auto rr = __builtin_amdgcn_permlane32_swap(__float_as_uint(ps), __float_as_uint(ps), false, false);
    ps = __uint_as_float(rr[0]) + __uint_as_float(rr[1]); }
  l_reg = l_reg * alpha + ps;
#define PK4(P, BASE, OUT) do { unsigned a0 = cvt_pk_bf16(P[BASE + 0], P[BASE + 1]), a1 = cvt_pk_bf16(P[BASE + 2], P[BASE + 3]);   \
    unsigned b0 = cvt_pk_bf16(P[BASE + 4], P[BASE + 5]), b1 = cvt_pk_bf16(P[BASE + 6], P[BASE + 7]);                              \
    auto r0 = __builtin_amdgcn_permlane32_swap(a0, b0, false, false); auto r1 = __builtin_amdgcn_permlane32_swap(a1, b1, false, false); \
    u32x4 w = {r0[0], r1[0], r0[1], r1[1]}; OUT = *reinterpret_cast<bf16x8*>(&w); } while (0)
  PK4(p0, 0, pa0); PK4(p0, 8, pa1); PK4(p1, 0, pa2); PK4(p1, 8, pa3);
#undef PK4
}
template <int NDQ>
__device__ __forceinline__ void qkt(f32x16& p0, f32x16& p1, const char* Ks, const bf16x8* qr, int r32, int hi) {
  p0 = f32x16{}; p1 = f32x16{};
#pragma unroll
  for (int d0 = 0; d0 < NDQ; ++d0) { const int cb = (d0 * 16 + hi * 8) * 2;
    const bf16x8 b0 = *reinterpret_cast<const bf16x8*>(Ks + KSWZ(r32, cb));
    const bf16x8 b1 = *reinterpret_cast<const bf16x8*>(Ks + KSWZ(32 + r32, cb));
    p0 = __builtin_amdgcn_mfma_f32_32x32x16_bf16(b0, qr[d0], p0, 0, 0, 0);
    p1 = __builtin_amdgcn_mfma_f32_32x32x16_bf16(b1, qr[d0], p1, 0, 0, 0); }
}
__device__ __forceinline__ int v_st(int k, int c) { const int kk = (k & ~0xC) | ((k & 4) << 1) | ((k & 8) >> 1); return ((kk >> 3) * 4 + (c >> 5)) * 512 + ((kk & 7) * 32 + (c & 31)) * 2; }
__device__ __forceinline__ int v_rd_base(int lane) { return ((lane & 3) << 3) | (((lane >> 2) & 3) << 6) | (((lane >> 4) & 1) << 5) | (((lane >> 5) & 1) << 8); }
constexpr int v_rd_off(int d0, int ks, int half) { return d0 * 512 + ks * 4096 + half * 2048; }
template <int OFF> __device__ __forceinline__ s16x4 tr_read(int vb) {
  s16x4 r; asm volatile("ds_read_b64_tr_b16 %0, %1 offset:%2" : "=&v"(r) : "v"(vb), "i"(OFF) : "memory"); return r;
}
template <int D0> __device__ __forceinline__ void pv_one(f32x16& od, int vb, bf16x8 pa0, bf16x8 pa1, bf16x8 pa2, bf16x8 pa3) {
  const s16x4 l0 = tr_read<v_rd_off(D0, 0, 0)>(vb), h0 = tr_read<v_rd_off(D0, 0, 1)>(vb), l1 = tr_read<v_rd_off(D0, 1, 0)>(vb), h1 = tr_read<v_rd_off(D0, 1, 1)>(vb);
  const s16x4 l2 = tr_read<v_rd_off(D0, 2, 0)>(vb), h2 = tr_read<v_rd_off(D0, 2, 1)>(vb), l3 = tr_read<v_rd_off(D0, 3, 0)>(vb), h3 = tr_read<v_rd_off(D0, 3, 1)>(vb);
  asm volatile("s_waitcnt lgkmcnt(0)" ::: "memory"); SBAR();
#define PK(L, H) (bf16x8){L[0], L[1], L[2], L[3], H[0], H[1], H[2], H[3]}
  od = __builtin_amdgcn_mfma_f32_32x32x16_bf16(pa0, PK(l0, h0), od, 0, 0, 0);
  od = __builtin_amdgcn_mfma_f32_32x32x16_bf16(pa1, PK(l1, h1), od, 0, 0, 0);
  od = __builtin_amdgcn_mfma_f32_32x32x16_bf16(pa2, PK(l2, h2), od, 0, 0, 0);
  od = __builtin_amdgcn_mfma_f32_32x32x16_bf16(pa3, PK(l3, h3), od, 0, 0, 0);
#undef PK
}
template <int NDV> __device__ __forceinline__ void pv_d0(f32x16* o, int vb, bf16x8 pa0, bf16x8 pa1, bf16x8 pa2, bf16x8 pa3) {
  pv_one<0>(o[0], vb, pa0, pa1, pa2, pa3); pv_one<1>(o[1], vb, pa0, pa1, pa2, pa3);
  if constexpr (NDV == 4) { pv_one<2>(o[2], vb, pa0, pa1, pa2, pa3); pv_one<3>(o[3], vb, pa0, pa1, pa2, pa3); }
}
template <int NDQ, int NDV, int SC, int SDEPTH>
__device__ __forceinline__ void attn_body(const bf16_t* __restrict__ Qb, const bf16_t* __restrict__ Kh, const bf16_t* __restrict__ Vh,
                                          bf16_t* __restrict__ Ob, int seq, char* lds, const int tid) {
  constexpr int LDK = 128, LDV = NDV * 32, ldo = 2048;
  const int wid = tid >> 6, lane = tid & 63, r32 = lane & 31, hi = lane >> 5;
  char* V_lds = lds; char* K_lds = lds + 2 * SHM_V;
  float* ws = (float*)(lds + 2 * SHM_V + 2 * SHM_K) + wid * 64; float* li_l = ws; float* al_l = ws + 32;
  float m_reg = -1e30f, l_reg = 0; f32x16 o[NDV] = {}; bf16x8 qr[NDQ];
  const bf16_t* Qw = Qb + (long)(wid * QBLK + r32) * 128 + hi * 8;
#pragma unroll
  for (int d0 = 0; d0 < NDQ; ++d0) qr[d0] = *reinterpret_cast<const bf16x8*>(Qw + d0 * 16);
  const int sr = tid >> 4, sc = (tid & 15) * 8;
  const int vr = NDV == 4 ? sr : (tid >> 3), vc = NDV == 4 ? sc : (tid & 7) * 8;
  const int vst0 = v_st(NDV == 4 ? 2 * sr : vr, vc), vst1 = v_st(2 * sr + 1, sc);
  const int vb0 = (int)(uintptr_t)V_lds + v_rd_base(lane);
  struct { bf16x8 vs0, vs1, ks0, ks1; } sr_[SDEPTH];
#define SLOAD(i, k0) do { const bf16_t* vp_ = Vh + (long)((k0) + (NDV == 4 ? 2 * sr : vr)) * LDV + vc; const bf16_t* kp_ = Kh + (long)((k0) + 2 * sr) * LDK + sc; \
    sr_[i].vs0 = *reinterpret_cast<const bf16x8*>(vp_); if constexpr (NDV == 4) sr_[i].vs1 = *reinterpret_cast<const bf16x8*>(vp_ + LDV); \
    sr_[i].ks0 = *reinterpret_cast<const bf16x8*>(kp_); sr_[i].ks1 = *reinterpret_cast<const bf16x8*>(kp_ + LDK); } while (0)
#define SWRITE(b, i) do { *(bf16x8*)(V_lds + (b) * SHM_V + vst0) = sr_[i].vs0;          \
    if constexpr (NDV == 4) *(bf16x8*)(V_lds + (b) * SHM_V + vst1) = sr_[i].vs1; const int kc = sc * 2;               \
    *(bf16x8*)(K_lds + (b) * SHM_K + KSWZ(2 * sr, kc)) = sr_[i].ks0;                       \
    *(bf16x8*)(K_lds + (b) * SHM_K + KSWZ(2 * sr + 1, kc)) = sr_[i].ks1; } while (0)
#define SWAIT() do { if constexpr (SDEPTH == 1) asm volatile("s_waitcnt vmcnt(0)" ::: "memory"); else if constexpr (NDV == 4) asm volatile("s_waitcnt vmcnt(4)" ::: "memory"); else asm volatile("s_waitcnt vmcnt(3)" ::: "memory"); } while (0)
#define RESC(a) do { if (__any((a) < 1.f)) { if (hi == 0) al_l[r32] = (a); asm volatile("s_waitcnt lgkmcnt(0)" ::: "memory"); \
    _Pragma("unroll") for (int d = 0; d < NDV; ++d) _Pragma("unroll") for (int r = 0; r < 16; ++r) o[d][r] *= al_l[crow(r, hi)]; } } while (0)
  f32x16 pA0, pA1, pB0, pB1; float mnA, mnB, alA, alB; bf16x8 pa0, pa1, pa2, pa3; const int NT = seq / KVBLK;
  constexpr int SE = 0, SO = SDEPTH - 1;
  SLOAD(SE, 0); asm volatile("s_waitcnt vmcnt(0)" ::: "memory"); SWRITE(0, SE); __syncthreads();
  qkt<NDQ>(pA0, pA1, K_lds, qr, r32, hi); partialSM<SC>(pA0, pA1, m_reg, mnA, alA);
  SLOAD(SO, KVBLK); if constexpr (SDEPTH == 2) { if (2 < NT) SLOAD(SE, 2 * KVBLK); }
  SWAIT(); SWRITE(1, SO); __syncthreads();
  for (int j = 1; j + 1 < NT; j += 2) {
    SBAR(); qkt<NDQ>(pB0, pB1, K_lds + SHM_K, qr, r32, hi);
    finishSM(pA0, pA1, alA, l_reg, pa0, pa1, pa2, pa3); SBAR();
    SLOAD(SO, (j + SDEPTH) * KVBLK); SBAR();
    pv_d0<NDV>(o, vb0, pa0, pa1, pa2, pa3); partialSM<SC>(pB0, pB1, m_reg, mnB, alB);
    __syncthreads(); SWAIT(); SWRITE(0, SE);
    RESC(alB); __syncthreads();
    SBAR(); qkt<NDQ>(pA0, pA1, K_lds, qr, r32, hi);
    finishSM(pB0, pB1, alB, l_reg, pa0, pa1, pa2, pa3); SBAR();
    if (SDEPTH == 1 || j + 3 < NT) SLOAD(SE, (j + 1 + SDEPTH) * KVBLK); SBAR();
    pv_d0<NDV>(o, vb0 + (int)SHM_V, pa0, pa1, pa2, pa3); partialSM<SC>(pA0, pA1, m_reg, mnA, alA);
    __syncthreads(); SWAIT(); SWRITE(1, SO);
    RESC(alA); __syncthreads();
  }
  SBAR(); qkt<NDQ>(pB0, pB1, K_lds + SHM_K, qr, r32, hi);
  finishSM(pA0, pA1, alA, l_reg, pa0, pa1, pa2, pa3); SBAR();
  pv_d0<NDV>(o, vb0, pa0, pa1, pa2, pa3); partialSM<SC>(pB0, pB1, m_reg, mnB, alB);
  __syncthreads(); RESC(alB);
  finishSM(pB0, pB1, alB, l_reg, pa0, pa1, pa2, pa3); SBAR();
  pv_d0<NDV>(o, vb0 + (int)SHM_V, pa0, pa1, pa2, pa3);
  if (hi == 0) li_l[r32] = l_reg; asm volatile("s_waitcnt lgkmcnt(0)" ::: "memory");
  float rli[16];
#pragma unroll
  for (int r = 0; r < 16; ++r) rli[r] = __builtin_amdgcn_rcpf(li_l[crow(r, hi)]);
  bf16_t* Ow = Ob + (long)(wid * QBLK) * ldo;
#pragma unroll
  for (int r = 0; r < 16; ++r) { const int orow = crow(r, hi);
#pragma unroll
    for (int d0 = 0; d0 < NDV; ++d0) Ow[(long)orow * ldo + d0 * 32 + r32] = f2bf(o[d0][r] * rli[r]); }
#undef SLOAD
#undef SWRITE
#undef SWAIT
#undef RESC
}
}
__device__ __forceinline__ float* xres_row(const Frame& F, int row) { return row < NLAT ? F.out + (size_t)row * D : wsp<float>(F, WS_XC) + (size_t)(row - NLAT) * D; }
__device__ __forceinline__ void ln_row(float (&y)[32], const float* g, const float* b, int lane) {
    float s = 0.f;
#pragma unroll
    for (int i = 0; i < 32; ++i) s += y[i];
    const float mu = wave_sum(s) * (1.f / 2048.f);
    float q = 0.f;
#pragma unroll
    for (int i = 0; i < 32; ++i) { const float d = y[i] - mu; q += d * d; }
    const float rstd = rsqrtf(wave_sum(q) * (1.f / 2048.f) + LN_EPS);
#pragma unroll
    for (int qq = 0; qq < 4; ++qq) { const f32x4 g0 = *(const f32x4*)(g + 512 * qq + 8 * lane), g1 = *(const f32x4*)(g + 512 * qq + 8 * lane + 4), b0 = *(const f32x4*)(b + 512 * qq + 8 * lane), b1 = *(const f32x4*)(b + 512 * qq + 8 * lane + 4);
#pragma unroll
        for (int i = 0; i < 4; ++i) { y[qq * 8 + i] = (y[qq * 8 + i] - mu) * rstd * g0[i] + b0[i]; y[qq * 8 + 4 + i] = (y[qq * 8 + 4 + i] - mu) * rstd * g1[i] + b1[i]; } }
}
__device__ __forceinline__ void modulate_store(const float (&x)[32], const float* sh, const float* sc, bf16_t* dst, int lane) {
#pragma unroll
    for (int q = 0; q < 4; ++q) { const f32x4 h0 = *(const f32x4*)(sh + 512 * q + 8 * lane), h1 = *(const f32x4*)(sh + 512 * q + 8 * lane + 4), c0 = *(const f32x4*)(sc + 512 * q + 8 * lane), c1 = *(const f32x4*)(sc + 512 * q + 8 * lane + 4);
        f32x4 a, b;
#pragma unroll
        for (int i = 0; i < 4; ++i) { a[i] = x[q * 8 + i] * (1.f + c0[i]) + h0[i]; b[i] = x[q * 8 + 4 + i] * (1.f + c1[i]) + h1[i]; }
        *(u32x4*)(dst + 512 * q + 8 * lane) = pack8(a, b); }
}
__device__ __forceinline__ void p_ln1(const Frame& F, int l, bool last) {
    const float* mod = wsp<float>(F, WS_MOD) + (size_t)l * 5 * 12288; bf16_t* hb = wsp<bf16_t>(F, WS_HB);
    const float* g = F.in(18) + l * D; const float* b = F.in(19) + l * D;
    const int nrows = last ? NLAT : NROW; const int lane = F.lane, step = F.G * 8;
    float gg[32], bb[32]; ld_row_f32(g, lane, gg); ld_row_f32(b, lane, bb);
    int row = F.bid * 8 + F.wave;
    float yn[32];
    if (row < nrows) ld_row_f32(xres_row(F, row), lane, yn);
#pragma unroll 1
    for (; row < nrows; row += step) {
        const int v = row < NLAT ? (row >> 12) : 4; float* xp = xres_row(F, row);
        float y[32], sh[32], sc[32];
#pragma unroll
        for (int i = 0; i < 32; ++i) y[i] = yn[i];
        ld_row_f32(mod + (size_t)v * 12288 + 6144, lane, sh); ld_row_f32(mod + (size_t)v * 12288 + 8192, lane, sc);
        { const int nrow = row + step; if (nrow < nrows) ld_row_f32(xres_row(F, nrow), lane, yn); }
        float s = 0.f;
#pragma unroll
        for (int i = 0; i < 32; ++i) s += y[i];
        const float mu = wave_sum(s) * (1.f / 2048.f); float q = 0.f;
#pragma unroll
        for (int i = 0; i < 32; ++i) { const float d = y[i] - mu; q += d * d; }
        const float rstd = rsqrtf(wave_sum(q) * (1.f / 2048.f) + LN_EPS);
#pragma unroll
        for (int i = 0; i < 32; ++i) y[i] = (y[i] - mu) * rstd * gg[i] + bb[i];
        st_row_f32(xp, lane, y);
#pragma unroll
        for (int i = 0; i < 32; ++i) y[i] = y[i] * (1.f + sc[i]) + sh[i];
        st_row_bf16(hb + (size_t)row * D, lane, y);
    }
}

template <int NV>
__device__ __forceinline__ void top16(const float (&val)[NV], bool (&sel)[NV], int (&slot)[NV]) {
    unsigned key[NV];
#pragma unroll
    for (int v = 0; v < NV; ++v) { const unsigned u = __float_as_uint(val[v]); key[v] = (u & 0x80000000u) ? ~u : (u | 0x80000000u); }
    unsigned T = 0u;
#pragma unroll 1
    for (int bit = 31; bit >= 0; --bit) {
        const unsigned cand = T | (1u << bit); int cnt = 0;
#pragma unroll
        for (int v = 0; v < NV; ++v) cnt += __popcll(__ballot(key[v] >= cand));
        if (cnt >= 16) T = cand;
    }
    int ngt = 0;
#pragma unroll
    for (int v = 0; v < NV; ++v) ngt += __popcll(__ballot(key[v] > T));
    const int need = 16 - ngt;
    int run = 0, erun = 0;
#pragma unroll
    for (int v = 0; v < NV; ++v) {
        const unsigned long long mg = __ballot(key[v] > T), me = __ballot(key[v] == T);
        const int pg = __builtin_amdgcn_mbcnt_hi((unsigned)(mg >> 32), __builtin_amdgcn_mbcnt_lo((unsigned)mg, 0u));
        const int pe = __builtin_amdgcn_mbcnt_hi((unsigned)(me >> 32), __builtin_amdgcn_mbcnt_lo((unsigned)me, 0u));
        sel[v] = false; slot[v] = 0;
        if (key[v] > T) { sel[v] = true; slot[v] = run + pg; }
        else if (key[v] == T && (erun + pe) < need) { sel[v] = true; slot[v] = ngt + erun + pe; }
        run += __popcll(mg); erun += __popcll(me);
    }
}
__device__ __forceinline__ unsigned f2key(float f) { const unsigned u = __float_as_uint(f); return (u & 0x80000000u) ? ~u : (u | 0x80000000u); }
__device__ __forceinline__ float key2f(unsigned k) { return __uint_as_float((k & 0x80000000u) ? (k & 0x7fffffffu) : ~k); }
template <int NP, int NV>
__device__ __forceinline__ void bisect16(const unsigned (&key)[NP][NV], unsigned (&T)[NP]) {
    bool done[NP];
#pragma unroll
    for (int p = 0; p < NP; ++p) { T[p] = 0u; done[p] = false; }
#pragma unroll 1
    for (int bit = 31; bit >= 0; --bit) {
        const unsigned bm = 1u << bit; bool all = true;
#pragma unroll
        for (int p = 0; p < NP; ++p) {
            const unsigned cand = T[p] | bm; int cnt = 0;
#pragma unroll
            for (int v = 0; v < NV; ++v) cnt += __popcll(__ballot(key[p][v] >= cand));
            const bool upd = (cnt >= 16) && !done[p];
            T[p] = upd ? cand : T[p]; done[p] = done[p] || (cnt == 16); all = all && done[p];
        }
        if (all) break;
    }
}
template <int NV>
__device__ __forceinline__ void compact16(const unsigned (&key)[NV], const unsigned T, bool (&sel)[NV], int (&slot)[NV]) {
    int ngt = 0;
#pragma unroll
    for (int v = 0; v < NV; ++v) ngt += __popcll(__ballot(key[v] > T));
    const int need = 16 - ngt; int run = 0, erun = 0;
#pragma unroll
    for (int v = 0; v < NV; ++v) {
        const unsigned long long mg = __ballot(key[v] > T), me = __ballot(key[v] == T);
        const int pg = __builtin_amdgcn_mbcnt_hi((unsigned)(mg >> 32), __builtin_amdgcn_mbcnt_lo((unsigned)mg, 0u));
        const int pe = __builtin_amdgcn_mbcnt_hi((unsigned)(me >> 32), __builtin_amdgcn_mbcnt_lo((unsigned)me, 0u));
        sel[v] = false; slot[v] = 0;
        if (key[v] > T) { sel[v] = true; slot[v] = run + pg; }
        else if (key[v] == T && (erun + pe) < need) { sel[v] = true; slot[v] = ngt + erun + pe; }
        run += __popcll(mg); erun += __popcll(me);
    }
}
constexpr int KP = 68;
constexpr int PW_BYTES = 9344;
__device__ __forceinline__ float gelu_erf(float x) {
    const float z = fabsf(x) * 0.7071067811865476f; const float t = __builtin_amdgcn_rcpf(1.f + 0.3275911f * z);
    float p = 1.061405429f; p = p * t - 1.453152027f; p = p * t + 1.421413741f; p = p * t - 0.284496736f; p = p * t + 0.254829592f; p = p * t;
    const float er = 1.f - p * __expf(-z * z);
    return 0.5f * x * (1.f + (x < 0.f ? -er : er));
}
__device__ __forceinline__ float wave_max(float x) {
    x = row16_max(x);
    { auto r = __builtin_amdgcn_permlane16_swap(__float_as_uint(x), __float_as_uint(x), false, false); x = fmaxf(__uint_as_float(r[0]), __uint_as_float(r[1])); }
    { auto r = __builtin_amdgcn_permlane32_swap(__float_as_uint(x), __float_as_uint(x), false, false); x = fmaxf(__uint_as_float(r[0]), __uint_as_float(r[1])); }
    return x;
}
__device__ __forceinline__ void ld16_f32(const float* p, int lane, float (&x)[32]) {
#pragma unroll
    for (int q = 0; q < 2; ++q)
#pragma unroll
        for (int d = 0; d < 4; ++d) { const f32x4 a = *(const f32x4*)(p + 1024 * q + 16 * lane + 4 * d); x[q * 16 + d * 4 + 0] = a[0]; x[q * 16 + d * 4 + 1] = a[1]; x[q * 16 + d * 4 + 2] = a[2]; x[q * 16 + d * 4 + 3] = a[3]; }
}
__device__ __forceinline__ void ld16_f32_nt(const float* p, int lane, float (&x)[32]) {
#pragma unroll
    for (int q = 0; q < 2; ++q)
#pragma unroll
        for (int d = 0; d < 4; ++d) { const f32x4 a = __builtin_nontemporal_load((const f32x4*)(p + 1024 * q + 16 * lane + 4 * d)); x[q * 16 + d * 4 + 0] = a[0]; x[q * 16 + d * 4 + 1] = a[1]; x[q * 16 + d * 4 + 2] = a[2]; x[q * 16 + d * 4 + 3] = a[3]; }
}
__device__ __forceinline__ void st16_f32_nt(float* p, int lane, const float (&x)[32]) {
#pragma unroll
    for (int q = 0; q < 2; ++q)
#pragma unroll
        for (int d = 0; d < 4; ++d) __builtin_nontemporal_store((f32x4){x[q * 16 + d * 4 + 0], x[q * 16 + d * 4 + 1], x[q * 16 + d * 4 + 2], x[q * 16 + d * 4 + 3]}, (f32x4*)(p + 1024 * q + 16 * lane + 4 * d));
}
__device__ __forceinline__ void st16_f32(float* p, int lane, const float (&x)[32]) {
#pragma unroll
    for (int q = 0; q < 2; ++q)
#pragma unroll
        for (int d = 0; d < 4; ++d) *(f32x4*)(p + 1024 * q + 16 * lane + 4 * d) = (f32x4){x[q * 16 + d * 4 + 0], x[q * 16 + d * 4 + 1], x[q * 16 + d * 4 + 2], x[q * 16 + d * 4 + 3]};
}
__device__ __forceinline__ void ld16_bf16(const bf16_t* p, int lane, float (&x)[32]) {
#pragma unroll
    for (int q = 0; q < 2; ++q)
#pragma unroll
        for (int d = 0; d < 2; ++d) { const u32x4 w = *(const u32x4*)(p + 1024 * q + 16 * lane + 8 * d); float* o = &x[q * 16 + d * 8];
            o[0] = bflo(w.x); o[1] = bfhi(w.x); o[2] = bflo(w.y); o[3] = bfhi(w.y); o[4] = bflo(w.z); o[5] = bfhi(w.z); o[6] = bflo(w.w); o[7] = bfhi(w.w); }
}
__device__ __forceinline__ void st16_bf16(bf16_t* p, int lane, const float (&x)[32]) {
#pragma unroll
    for (int q = 0; q < 2; ++q)
#pragma unroll
        for (int d = 0; d < 2; ++d) { const float* o = &x[q * 16 + d * 8]; u32x4 w; w.x = cvt_pk_bf16(o[0], o[1]); w.y = cvt_pk_bf16(o[2], o[3]); w.z = cvt_pk_bf16(o[4], o[5]); w.w = cvt_pk_bf16(o[6], o[7]);
            *(u32x4*)(p + 1024 * q + 16 * lane + 8 * d) = w; }
}
constexpr int TBS = 1152;
__device__ __forceinline__ void cvt_row_fp4b(int lane, const float* __restrict__ src, unsigned char* __restrict__ dst) {
    float x[32];
#pragma unroll
    for (int q = 0; q < 2; ++q)
#pragma unroll
        for (int d = 0; d < 4; ++d) { const f32x4 a = __builtin_nontemporal_load((const f32x4*)(src + 1024 * q + 16 * lane + 4 * d)); x[q * 16 + d * 4 + 0] = a[0]; x[q * 16 + d * 4 + 1] = a[1]; x[q * 16 + d * 4 + 2] = a[2]; x[q * 16 + d * 4 + 3] = a[3]; }
    float am = 0.f;
#pragma unroll
    for (int i = 0; i < 32; ++i) am = fmaxf(am, fabsf(x[i]));
    const bf16_t sb = f2bf(am * (1.f / 6.f)); const float sf = bf2f(sb); const float sc = sf > 0.f ? 1.f / sf : 0.f;
    u32x4 w;
#pragma unroll
    for (int d = 0; d < 4; ++d) { unsigned t = 0u; const int o = (d >> 1) * 16 + (d & 1) * 8;
        t = __builtin_amdgcn_cvt_scalef32_pk_fp4_f32(t, x[o + 0] * sc, x[o + 1] * sc, 1.0f, 0); t = __builtin_amdgcn_cvt_scalef32_pk_fp4_f32(t, x[o + 2] * sc, x[o + 3] * sc, 1.0f, 1);
        t = __builtin_amdgcn_cvt_scalef32_pk_fp4_f32(t, x[o + 4] * sc, x[o + 5] * sc, 1.0f, 2); t = __builtin_amdgcn_cvt_scalef32_pk_fp4_f32(t, x[o + 6] * sc, x[o + 7] * sc, 1.0f, 3); w[d] = t; }
    *(u32x4*)(dst + 16 * lane) = w;
    *(bf16_t*)(dst + 1024 + 2 * lane) = sb;
}
__device__ __forceinline__ void cvt_row_fp4r(int lane, const float* __restrict__ src, unsigned char* __restrict__ dst, float* __restrict__ inv) {
    float x[32];
#pragma unroll
    for (int q = 0; q < 2; ++q)
#pragma unroll
        for (int d = 0; d < 4; ++d) { const f32x4 a = __builtin_nontemporal_load((const f32x4*)(src + 1024 * q + 16 * lane + 4 * d)); x[q * 16 + d * 4 + 0] = a[0]; x[q * 16 + d * 4 + 1] = a[1]; x[q * 16 + d * 4 + 2] = a[2]; x[q * 16 + d * 4 + 3] = a[3]; }
    float am = 0.f;
#pragma unroll
    for (int i = 0; i < 32; ++i) am = fmaxf(am, fabsf(x[i]));
    am = wave_max(am);
    const float sc = am > 0.f ? 6.f / am : 1.f;
    if (lane == 0) *inv = am > 0.f ? am * (1.f / 6.f) : 1.f;
    u32x4 w;
#pragma unroll
    for (int d = 0; d < 4; ++d) { unsigned t = 0u; const int o = (d >> 1) * 16 + (d & 1) * 8;
        t = __builtin_amdgcn_cvt_scalef32_pk_fp4_f32(t, x[o + 0] * sc, x[o + 1] * sc, 1.0f, 0); t = __builtin_amdgcn_cvt_scalef32_pk_fp4_f32(t, x[o + 2] * sc, x[o + 3] * sc, 1.0f, 1);
        t = __builtin_amdgcn_cvt_scalef32_pk_fp4_f32(t, x[o + 4] * sc, x[o + 5] * sc, 1.0f, 2); t = __builtin_amdgcn_cvt_scalef32_pk_fp4_f32(t, x[o + 6] * sc, x[o + 7] * sc, 1.0f, 3); w[d] = t; }
    *(u32x4*)(dst + 16 * lane) = w;
}
__device__ __forceinline__ void cvt_peer(const Frame& F, int l) {
    for (int r = F.bid * 8 + F.wave; r < 16384; r += F.G * 8) cvt_row_fp4b(F.lane, F.in(23) + ((size_t)l * 16384 + r) * 2048, wsp<unsigned char>(F, WS_PU) + (size_t)l * SZ_PT + (size_t)r * TBS);
    for (int r = F.bid * 8 + F.wave; r < 16384; r += F.G * 8) cvt_row_fp4b(F.lane, F.in(24) + ((size_t)l * 16384 + r) * 2048, wsp<unsigned char>(F, WS_PV) + (size_t)l * SZ_PT + (size_t)r * TBS);
}
#define PEER_G 4
template <int CTRL> __device__ __forceinline__ int dppi(int x) { return __builtin_amdgcn_update_dpp(0, x, CTRL, 0xF, 0xF, true); }
__device__ __forceinline__ int irow16_sum(int x) { x += dppi<0xB1>(x); x += dppi<0x4E>(x); x += dppi<0x141>(x); x += dppi<0x140>(x); return x; }
__device__ __forceinline__ int irow16_incl_scan(int x) { x += dppi<0x111>(x); x += dppi<0x112>(x); x += dppi<0x114>(x); x += dppi<0x118>(x); return x; }
constexpr int KBP = 72;
constexpr int PT_WORDS = 6 * 128 + 160 + 3 * 128;
constexpr int PWB = 2 * PT_WORDS * 4;
__device__ __forceinline__ void p_peer(const Frame& F, int l, bool last) {
    LAS bf16_t* kb1 = (LAS bf16_t*)F.lds; LAS bf16_t* kb2 = kb1 + 128 * KBP;
    LAS unsigned* wbase = (LAS unsigned*)(F.lds + 2 * 128 * KBP * 2 + F.wave * PWB);
    const int lane = F.lane, fr = lane & 15, fq = lane >> 4;
    __syncthreads();
    for (int i = F.tid; i < 128 * 64; i += 512) { const int r = i >> 6, d = i & 63; kb1[r * KBP + d] = f2bf(F.in(21)[(size_t)l * 8192 + i]); kb2[r * KBP + d] = f2bf(F.in(22)[(size_t)l * 8192 + i]); }
    __syncthreads();
    const bf16_t* QP = wsp<bf16_t>(F, WS_QP); const bf16_t* HB = wsp<bf16_t>(F, WS_HB); unsigned char* HB8w = wsp<unsigned char>(F, WS_HB8);
    const unsigned char* PU = wsp<unsigned char>(F, WS_PU) + (size_t)l * SZ_PT; const unsigned char* PV = wsp<unsigned char>(F, WS_PV) + (size_t)l * SZ_PT;
    const float* modl = wsp<float>(F, WS_MOD) + (size_t)l * 5 * 12288; const float* modn = wsp<float>(F, WS_MOD) + (size_t)(l + 1) * 5 * 12288;
    const float* g2n = F.in(25) + l * D; const float* b2n = F.in(26) + l * D;
    const int npairs = (last ? NLAT : NROW) / 2;
    const int per_wg = (npairs + F.G - 1) / F.G; const int p_lo = F.bid * per_wg; const int p_hi = (p_lo + per_wg) < npairs ? (p_lo + per_wg) : npairs;
    LAS int* wq = (LAS int*)(F.lds + 147456 - 32);
    if (F.tid == 0) *wq = 0;
    __syncthreads();
#pragma unroll 1
    for (;;) {
        int pi = 0; if (lane == 0) pi = __hip_atomic_fetch_add(wq, 1, __ATOMIC_RELAXED, __HIP_MEMORY_SCOPE_WORKGROUP);
        pi = p_lo + __builtin_amdgcn_readfirstlane(pi); if (pi >= p_hi) break;
        const int rowA = 2 * pi;
#pragma unroll 1
        for (int rep1_ = 0; rep1_ <= REP_PS1; ++rep1_) {
            unsigned kk[2][8][4];
            { int fr_ = fr; asm volatile("" : "+v"(fr_));
              const bf16_t* qrow = QP + (size_t)(rowA + (fr_ >> 3)) * 1024 + (fr_ & 7) * 128 + 8 * fq;
              bf16x8 af[2][2];
#pragma unroll
              for (int st = 0; st < 2; ++st)
#pragma unroll
                  for (int ks = 0; ks < 2; ++ks) af[st][ks] = *(const bf16x8*)(qrow + st * 64 + ks * 32);
#pragma unroll
              for (int st = 0; st < 2; ++st) { LAS bf16_t* kb = st ? kb2 : kb1;
#pragma unroll
                  for (int nb = 0; nb < 8; ++nb) { f32x4 c = {0.f, 0.f, 0.f, 0.f};
#pragma unroll
                      for (int ks = 0; ks < 2; ++ks) { const bf16x8 bfr = *(const LAS bf16x8*)(kb + (nb * 16 + fr) * KBP + ks * 32 + 8 * fq); c = __builtin_amdgcn_mfma_f32_16x16x32_bf16(af[st][ks], bfr, c, 0, 0, 0); }
#pragma unroll
                      for (int r = 0; r < 4; ++r) kk[st][nb][r] = f2key(c[r]); } } }
            unsigned T[2][4]; bool done[2][4];
#pragma unroll
            for (int st = 0; st < 2; ++st)
#pragma unroll
                for (int r = 0; r < 4; ++r) { T[st][r] = 0u; done[st][r] = false; }
#pragma unroll 1
            for (int bit = 31; bit >= 0; --bit) { const unsigned bm = 1u << bit; bool alld = true;
#pragma unroll
                for (int st = 0; st < 2; ++st)
#pragma unroll
                    for (int r = 0; r < 4; ++r) { const unsigned cand = T[st][r] | bm; int c = 0;
#pragma unroll
                        for (int nb = 0; nb < 8; ++nb) c += (kk[st][nb][r] >= cand) ? 1 : 0;
                        c = irow16_sum(c);
                        const bool upd = (c >= 16) && !done[st][r]; T[st][r] = upd ? cand : T[st][r]; done[st][r] = done[st][r] || (c == 16); alld = alld && done[st][r]; }
                if (__all(alld)) break; }
            const int tt = lane >> 5, hd0 = ((lane >> 4) & 1) * 4;
#pragma unroll
            for (int st = 0; st < 2; ++st)
#pragma unroll
                for (int r = 0; r < 4; ++r) { const unsigned Tr = T[st][r]; int g = 0, e = 0;
#pragma unroll
                    for (int nb = 0; nb < 8; ++nb) { g += (kk[st][nb][r] > Tr) ? 1 : 0; e += (kk[st][nb][r] == Tr) ? 1 : 0; }
                    int gpre = irow16_incl_scan(g) - g, epre = irow16_incl_scan(e) - e; const int ngt = irow16_sum(g); const int need = 16 - ngt;
                    LAS unsigned* tb = wbase + tt * PT_WORDS; LAS float* vl = (LAS float*)(tb + st * 128) + (hd0 + r) * 16; LAS int* il = (LAS int*)(tb + 256 + st * 128) + (hd0 + r) * 16;
#pragma unroll
                    for (int nb = 0; nb < 8; ++nb) { const unsigned k = kk[st][nb][r];
                        if (k > Tr) { vl[gpre] = key2f(k); il[gpre] = nb * 16 + fr; ++gpre; }
                        else if (k == Tr) { if (epre < need) { vl[ngt + epre] = key2f(k); il[ngt + epre] = nb * 16 + fr; } ++epre; } } }
        }
        asm volatile("s_waitcnt lgkmcnt(0)" ::: "memory");
        {
            const int tt = lane >> 5, hd0 = ((lane >> 4) & 1) * 4; LAS unsigned* tb = wbase + tt * PT_WORDS;
            unsigned ck[4][16];
#pragma unroll
            for (int r = 0; r < 4; ++r) { const float va = ((LAS float*)tb)[(hd0 + r) * 16 + fr]; const LAS float* v2p = (LAS float*)(tb + 128) + (hd0 + r) * 16;
#pragma unroll
                for (int j4 = 0; j4 < 4; ++j4) { const f32x4 vb = *(const LAS f32x4*)(v2p + j4 * 4);
#pragma unroll
                    for (int i = 0; i < 4; ++i) ck[r][j4 * 4 + i] = f2key(va + vb[i]); } }
            unsigned T[4]; bool done[4];
#pragma unroll
            for (int r = 0; r < 4; ++r) { T[r] = 0u; done[r] = false; }
#pragma unroll 1
            for (int bit = 31; bit >= 0; --bit) { const unsigned bm = 1u << bit; bool alld = true;
#pragma unroll
                for (int r = 0; r < 4; ++r) { const unsigned cand = T[r] | bm; int c = 0;
#pragma unroll
                    for (int j = 0; j < 16; ++j) c += (ck[r][j] >= cand) ? 1 : 0;
                    c = irow16_sum(c);
                    const bool upd = (c >= 16) && !done[r]; T[r] = upd ? cand : T[r]; done[r] = done[r] || (c == 16); alld = alld && done[r]; }
                if (__all(alld)) break; }
#pragma unroll
            for (int r = 0; r < 4; ++r) { const unsigned Tr = T[r]; int g = 0, e = 0;
#pragma unroll
                for (int j = 0; j < 16; ++j) { g += (ck[r][j] > Tr) ? 1 : 0; e += (ck[r][j] == Tr) ? 1 : 0; }
                int gpre = irow16_incl_scan(g) - g, epre = irow16_incl_scan(e) - e; const int ngt = irow16_sum(g); const int need = 16 - ngt;
                const int e1 = ((LAS int*)(tb + 256))[(hd0 + r) * 16 + fr] * 128; const LAS int* i2p = (LAS int*)(tb + 384) + (hd0 + r) * 16;
                LAS float* cs_ = (LAS float*)(tb + 512) + (hd0 + r) * 16; LAS int* ce_ = (LAS int*)(tb + 640) + (hd0 + r) * 16;
#pragma unroll
                for (int j = 0; j < 16; ++j) { const unsigned k = ck[r][j];
                    if (k > Tr) { cs_[gpre] = key2f(k); ce_[gpre] = e1 + i2p[j]; ++gpre; }
                    else if (k == Tr) { if (epre < need) { cs_[ngt + epre] = key2f(k); ce_[ngt + epre] = e1 + i2p[j]; } ++epre; } } }
        }
        asm volatile("s_waitcnt lgkmcnt(0)" ::: "memory");
#pragma unroll 1
      for (int t = 0; t < 2; ++t) {
        const int row = rowA + t; const int v = row < NLAT ? (row >> 12) : 4;
        LAS unsigned* tb = wbase + t * PT_WORDS;
        LAS float* v1l = (LAS float*)tb; LAS float* v2l = v1l + 128; LAS int* i1l = (LAS int*)(v2l + 128); LAS int* i2l = i1l + 128;
        LAS float* csl = (LAS float*)(i2l + 128); LAS int* cel = (LAS int*)(csl + 128); LAS int* el = cel + 128; LAS float* gl = (LAS float*)(el + 160); LAS float* su = gl + 128; LAS float* sv = su + 128;
        {
#pragma unroll
            for (int it = 0; it < 2; ++it) { const int idx = it * 64 + lane;
                const float sx = csl[idx]; const float mx = row16_max(sx); const float pe_ = __expf(sx - mx); const float sm = row16_sum(pe_);
                el[idx] = cel[idx]; gl[idx] = pe_ / sm; }
        }
        if (lane < 32) el[128 + lane] = el[0];
        asm volatile("s_waitcnt vmcnt(0) lgkmcnt(0)" ::: "memory");
        float hh[32]; ld16_bf16(HB + (size_t)row * D, lane, hh);
        f32x2 hh2[16];
#pragma unroll
        for (int i = 0; i < 16; ++i) hh2[i] = (f32x2){hh[2 * i], hh[2 * i + 1]};
        const bool b0_ = lane & 1, b1_ = lane & 2, b2_ = lane & 4;
        u32x4 A[8], B[8], C[8]; unsigned SA[8], SB[8], SC[8];
#define PEER_LOADT(buf, sbuf, tab, g) do { _Pragma("unroll") for (int x = 0; x < 8; ++x) { const int e = __builtin_amdgcn_readfirstlane(el[(g) * 8 + x]); const unsigned char* rp = (tab) + (size_t)e * TBS; \
            buf[x] = *(const u32x4*)(rp + 16 * lane); sbuf[x] = *(const bf16_t*)(rp + 1024 + 2 * lane); } } while (0)
#define PEER_LOADV(buf, g) do { _Pragma("unroll") for (int x = 0; x < 8; ++x) { const int e = __builtin_amdgcn_readfirstlane(el[(g) * 8 + x]); buf[x] = *(const u32x4*)(PV + (size_t)e * 1024 + 16 * lane); } } while (0)
#define FP4X8(w_, f0_, f1_, f2_, f3_) const f32x2 f0_ = __builtin_amdgcn_cvt_scalef32_pk_f32_fp4(w_, 1.0f, 0), f1_ = __builtin_amdgcn_cvt_scalef32_pk_f32_fp4(w_, 1.0f, 1), f2_ = __builtin_amdgcn_cvt_scalef32_pk_f32_fp4(w_, 1.0f, 2), f3_ = __builtin_amdgcn_cvt_scalef32_pk_f32_fp4(w_, 1.0f, 3)
#define PEER_DOT(buf, sbuf, g) do { float p_[8]; \
            _Pragma("unroll") for (int x = 0; x < 8; ++x) { f32x2 s2_ = {0.f, 0.f}; \
                _Pragma("unroll") for (int d = 0; d < 4; ++d) { const unsigned w_ = buf[x][d]; FP4X8(w_, f0_, f1_, f2_, f3_); const int o_ = (d >> 1) * 8 + (d & 1) * 4; \
                    s2_ = hh2[o_ + 0] * f0_ + s2_; s2_ = hh2[o_ + 1] * f1_ + s2_; s2_ = hh2[o_ + 2] * f2_ + s2_; s2_ = hh2[o_ + 3] * f3_ + s2_; } \
                p_[x] = (s2_.x + s2_.y) * __uint_as_float(sbuf[x] << 16); SBAR(); } \
              \
            float q_[4], r_[2]; \
            _Pragma("unroll") for (int j = 0; j < 4; ++j) { const float keep_ = b0_ ? p_[2 * j + 1] : p_[2 * j], send_ = b0_ ? p_[2 * j] : p_[2 * j + 1]; q_[j] = keep_ + dppf<0xB1>(send_); } \
            _Pragma("unroll") for (int j = 0; j < 2; ++j) { const float keep_ = b1_ ? q_[2 * j + 1] : q_[2 * j], send_ = b1_ ? q_[2 * j] : q_[2 * j + 1]; r_[j] = keep_ + dppf<0x4E>(send_); } \
            float t_; { const float keep_ = b2_ ? r_[1] : r_[0], send_ = b2_ ? r_[0] : r_[1]; const float up_ = dppf<0x104>(send_), dn_ = dppf<0x114>(send_); t_ = keep_ + (b2_ ? dn_ : up_); } \
            t_ += dppf<0x128>(t_); \
            { auto r16_ = __builtin_amdgcn_permlane16_swap(__float_as_uint(t_), __float_as_uint(t_), false, false); t_ = __uint_as_float(r16_[0]) + __uint_as_float(r16_[1]); } \
            { auto r32_ = __builtin_amdgcn_permlane32_swap(__float_as_uint(t_), __float_as_uint(t_), false, false); t_ = __uint_as_float(r32_[0]) + __uint_as_float(r32_[1]); } \
            const float av = gelu_erf(t_) * gl[(g) * 8 + (lane & 7)]; const bool me_ = (lane >> 3) == ((g) & 7); \
            avl = (me_ && (g) < 8) ? av : avl; avh = (me_ && (g) >= 8) ? av : avh; } while (0)
#define PIN_ACC() do { asm volatile("" : "+v"(acc2[0]), "+v"(acc2[1]), "+v"(acc2[2]), "+v"(acc2[3]), "+v"(acc2[4]), "+v"(acc2[5]), "+v"(acc2[6]), "+v"(acc2[7]), "+v"(acc2[8]), "+v"(acc2[9]), "+v"(acc2[10]), "+v"(acc2[11]), "+v"(acc2[12]), "+v"(acc2[13]), "+v"(acc2[14]), "+v"(acc2[15])); } while (0)
#define PEER_AXPY(buf, sbuf, g) do { _Pragma("unroll") for (int x = 0; x < 8; ++x) { const int idx = (g) * 8 + x; \
            const float av = __uint_as_float(__builtin_amdgcn_readlane(__float_as_uint(idx < 64 ? avl : avh), idx & 63)) * __uint_as_float(sbuf[x] << 16); const f32x2 av2_ = {av, av}; \
            _Pragma("unroll") for (int d = 0; d < 4; ++d) { const unsigned w_ = buf[x][d]; FP4X8(w_, f0_, f1_, f2_, f3_); const int o_ = (d >> 1) * 8 + (d & 1) * 4; \
                acc2[o_ + 0] = av2_ * f0_ + acc2[o_ + 0]; acc2[o_ + 1] = av2_ * f1_ + acc2[o_ + 1]; acc2[o_ + 2] = av2_ * f2_ + acc2[o_ + 2]; acc2[o_ + 3] = av2_ * f3_ + acc2[o_ + 3]; } PIN_ACC(); } } while (0)
        float avl = 0.f, avh = 0.f;
        PEER_LOADT(A, SA, PU, 0); PEER_LOADT(B, SB, PU, 1);
#pragma unroll 1
        for (int g = 0; g < 15; g += 3) { PEER_LOADT(C, SC, PU, g + 2); SBAR(); PEER_DOT(A, SA, g); SBAR(); PEER_LOADT(A, SA, PU, g + 3); SBAR(); PEER_DOT(B, SB, g + 1); SBAR(); PEER_LOADT(B, SB, PU, g + 4); SBAR(); PEER_DOT(C, SC, g + 2); SBAR(); }
        PEER_DOT(A, SA, 15); SBAR();
        f32x2 acc2[16];
#pragma unroll
        for (int i = 0; i < 16; ++i) acc2[i] = (f32x2){0.f, 0.f};
        float* xp = xres_row(F, row);
        PEER_LOADT(A, SA, PV, 0); PEER_LOADT(B, SB, PV, 1);
#pragma unroll 1
        for (int g = 0; g < 15; g += 3) { PEER_LOADT(C, SC, PV, g + 2); SBAR(); PEER_AXPY(A, SA, g); SBAR(); PEER_LOADT(A, SA, PV, g + 3); SBAR(); PEER_AXPY(B, SB, g + 1); SBAR(); PEER_LOADT(B, SB, PV, g + 4); SBAR(); PEER_AXPY(C, SC, g + 2); SBAR(); }
        float x1[32], g2[32]; ld16_f32(xp, lane, x1); ld16_f32(modl + (size_t)v * 12288 + 10240, lane, g2); SBAR();
        PEER_AXPY(A, SA, 15); SBAR();
#undef PEER_LOADT
#undef PEER_LOADV
#undef PEER_DOT
#undef PEER_AXPY
        float acc[32];
        {
#pragma unroll
          for (int i = 0; i < 32; ++i) acc[i] = ALPHA * x1[i] + g2[i] * acc2[i >> 1][i & 1]; }
        { float sm = 0.f;
#pragma unroll
          for (int i = 0; i < 32; ++i) sm += acc[i];
          const float mu = wave_sum(sm) * (1.f / 2048.f); float qq = 0.f;
#pragma unroll
          for (int i = 0; i < 32; ++i) { const float dd = acc[i] - mu; qq += dd * dd; }
          const float rstd = rsqrtf(wave_sum(qq) * (1.f / 2048.f) + LN_EPS);
#pragma unroll
          for (int q = 0; q < 2; ++q)
#pragma unroll
              for (int d = 0; d < 4; ++d) { const int o = 1024 * q + 16 * lane + 4 * d; const f32x4 gg = *(const f32x4*)(g2n + o), bb = *(const f32x4*)(b2n + o);
#pragma unroll
                  for (int i = 0; i < 4; ++i) acc[q * 16 + d * 4 + i] = (acc[q * 16 + d * 4 + i] - mu) * rstd * gg[i] + bb[i]; } }
        st16_f32(xp, lane, acc);
        if (!last) { const float* sh = modn + (size_t)v * 12288; const float* sc = sh + 2048;
#pragma unroll
            for (int q = 0; q < 2; ++q)
#pragma unroll
                for (int d = 0; d < 4; ++d) { const int o = 1024 * q + 16 * lane + 4 * d; const f32x4 hh4 = *(const f32x4*)(sh + o), cc4 = *(const f32x4*)(sc + o);
#pragma unroll
                    for (int i = 0; i < 4; ++i) acc[q * 16 + d * 4 + i] = clamp8(acc[q * 16 + d * 4 + i] * (1.f + cc4[i]) + hh4[i]); }
#pragma unroll
            for (int q = 0; q < 2; ++q) { u32x4 w;
#pragma unroll
                for (int d = 0; d < 4; ++d) w[d] = pk4_fp8(acc[q * 16 + d * 4 + 0], acc[q * 16 + d * 4 + 1], acc[q * 16 + d * 4 + 2], acc[q * 16 + d * 4 + 3]);
                *(u32x4*)(HB8w + (size_t)row * D + 1024 * q + 16 * lane) = w; } }
      }
    }
}
#ifdef DBG
constexpr size_t WS_DBG = WS_CTL + 131072;
constexpr int DBG_NS = 60;
__device__ __forceinline__ int dbg_row(int s) { return (s * 263 + 5) % NLAT; }
__global__ void __launch_bounds__(256) dbg_peer_pre(Args args, int l) {
    __shared__ float q[1024]; __shared__ float s1[128], s2[128]; __shared__ float v1[16], v2[16]; __shared__ int i1[16], i2[16]; __shared__ float cs[256]; __shared__ int ce[256];
    __shared__ float ts[16]; __shared__ int te[16]; __shared__ float red[256]; __shared__ float aval[128]; __shared__ int eid[128]; __shared__ float h2[2048];
    const int s = blockIdx.x, row = dbg_row(s), tid = threadIdx.x; unsigned char* ws = args.ws;
    const bf16_t* QP = (const bf16_t*)(ws + WS_QP); const bf16_t* HB = (const bf16_t*)(ws + WS_HB);
    float* dbgf = (float*)(ws + WS_DBG + 4096); int* dbge = (int*)(dbgf + DBG_NS * 2048); float* dbga = (float*)(dbge + DBG_NS * 128); float* dbgg = dbga + 3 * DBG_NS * 128;
    for (int i = tid; i < 1024; i += 256) q[i] = bf2f(QP[(size_t)row * 1024 + i]);
    for (int i = tid; i < 2048; i += 256) h2[i] = bf2f(HB[(size_t)row * D + i]);
    __syncthreads();
    const float* k1 = args.in[21] + (size_t)l * 8192; const float* k2 = args.in[22] + (size_t)l * 8192;
    for (int hd = 0; hd < 8; ++hd) {
        { const int k = tid & 127; const float* kk = (tid < 128 ? k1 : k2) + k * 64; const float* qq = q + hd * 128 + (tid < 128 ? 0 : 64); float a = 0.f; for (int d = 0; d < 64; ++d) a += qq[d] * kk[d]; (tid < 128 ? s1 : s2)[k] = a; }
        __syncthreads();
        { const int k = tid & 127; const float* sv = tid < 128 ? s1 : s2; const float me = sv[k]; int rank = 0; for (int j = 0; j < 128; ++j) rank += (sv[j] > me || (sv[j] == me && j < k)) ? 1 : 0;
          if (rank < 16) { (tid < 128 ? v1 : v2)[rank] = me; (tid < 128 ? i1 : i2)[rank] = k; } }
        __syncthreads();
        { const int i = tid >> 4, j = tid & 15; cs[tid] = v1[i] + v2[j]; ce[tid] = i1[i] * 128 + i2[j]; }
        __syncthreads();
        { const float me = cs[tid]; int rank = 0; for (int j = 0; j < 256; ++j) rank += (cs[j] > me || (cs[j] == me && j < tid)) ? 1 : 0; if (rank < 16) { ts[rank] = me; te[rank] = ce[tid]; } }
        __syncthreads();
        if (tid < 16) { float mx = ts[0]; float sm = 0.f; for (int j = 0; j < 16; ++j) sm += expf(ts[j] - mx); aval[hd * 16 + tid] = expf(ts[tid] - mx) / sm; eid[hd * 16 + tid] = te[tid]; dbgg[s * 128 + hd * 16 + tid] = aval[hd * 16 + tid]; }
        __syncthreads();
    }
    const float* U = args.in[23] + (size_t)l * 16384 * 2048; const float* V = args.in[24] + (size_t)l * 16384 * 2048;
    for (int e = 0; e < 128; ++e) { const float* ur = U + (size_t)eid[e] * 2048; float p = 0.f; for (int d = tid; d < 2048; d += 256) p += h2[d] * ur[d]; red[tid] = p; __syncthreads();
        for (int st = 128; st > 0; st >>= 1) { if (tid < st) red[tid] += red[tid + st]; __syncthreads(); }
        if (tid == 0) { const float sc = red[0]; aval[e] = 0.5f * sc * (1.f + erff(sc * 0.70710678f)) * aval[e]; } __syncthreads(); }
    float y[8]; const float* xr = args.out + (size_t)row * D; const int v = row >> 12; const float* mod = (const float*)(ws + WS_MOD) + (size_t)l * 5 * 12288 + (size_t)v * 12288;
    float sum = 0.f;
    for (int k = 0; k < 8; ++k) { const int d = tid + 256 * k; float o = 0.f; for (int e = 0; e < 128; ++e) o += aval[e] * V[(size_t)eid[e] * 2048 + d]; y[k] = ALPHA * xr[d] + mod[10240 + d] * o; sum += y[k]; }
    red[tid] = sum; __syncthreads(); for (int st = 128; st > 0; st >>= 1) { if (tid < st) red[tid] += red[tid + st]; __syncthreads(); } const float mu = red[0] / 2048.f; __syncthreads();
    float sq = 0.f; for (int k = 0; k < 8; ++k) sq += (y[k] - mu) * (y[k] - mu);
    red[tid] = sq; __syncthreads(); for (int st = 128; st > 0; st >>= 1) { if (tid < st) red[tid] += red[tid + st]; __syncthreads(); } const float rstd = rsqrtf(red[0] / 2048.f + LN_EPS);
    for (int k = 0; k < 8; ++k) { const int d = tid + 256 * k; dbgf[(size_t)s * 2048 + d] = (y[k] - mu) * rstd * args.in[25][l * D + d] + args.in[26][l * D + d]; }
    if (tid < 128) { dbge[s * 128 + tid] = eid[tid]; dbga[s * 128 + tid] = aval[tid]; }
}
__global__ void __launch_bounds__(256) dbg_peer_post(Args args) {
    __shared__ int bad_e, bad_x, bad_a, bad_g;
    const int s = blockIdx.x, row = dbg_row(s), tid = threadIdx.x; unsigned char* ws = args.ws; unsigned* cnt = (unsigned*)(ws + WS_DBG);
    float* dbgf = (float*)(ws + WS_DBG + 4096); int* dbge = (int*)(dbgf + DBG_NS * 2048); float* dbga = (float*)(dbge + DBG_NS * 128);
    int* fe = (int*)(dbga + DBG_NS * 128); float* fa = (float*)(fe + DBG_NS * 128); float* dbgg = dbga + 3 * DBG_NS * 128; float* fg = dbgg + DBG_NS * 128;
    if (tid == 0) { bad_e = 0; bad_x = 0; bad_a = 0; bad_g = 0; } __syncthreads();
    if (tid < 128) { const int hd = tid >> 4; const int e = dbge[s * 128 + tid]; bool found = false; float af = 0.f, gf = 0.f; for (int j = 0; j < 16; ++j) if (fe[s * 128 + hd * 16 + j] == e) { found = true; af = fa[s * 128 + hd * 16 + j]; gf = fg[s * 128 + hd * 16 + j]; }
        if (!found) atomicAdd(&bad_e, 1); else { const float ea = dbga[s * 128 + tid]; if (fabsf(af - ea) > 0.02f * fabsf(ea) + 2e-3f) atomicAdd(&bad_a, 1); const float eg = dbgg[s * 128 + tid]; if (fabsf(gf - eg) > 0.02f * fabsf(eg) + 1e-3f) atomicAdd(&bad_g, 1); } }
    for (int k = 0; k < 8; ++k) { const int d = tid + 256 * k; const float ex = dbgf[(size_t)s * 2048 + d], got = args.out[(size_t)row * D + d]; if (!(fabsf(got - ex) <= 0.03f + 0.03f * fabsf(ex))) atomicAdd(&bad_x, 1); }
    __syncthreads();
    if (tid == 0) { if (bad_e > 2) atomicAdd(&cnt[1], 1u); if (bad_g > 2) atomicAdd(&cnt[2], 1u); if (bad_a > 2) atomicAdd(&cnt[3], 1u); if (bad_x > 8) atomicAdd(&cnt[4], 1u); }
}
__global__ void dbg_report(Args args) {
    unsigned* cnt = (unsigned*)(args.ws + WS_DBG);
    float code = 0.f;
    for (int lv = 1; lv <= 9; ++lv) if (cnt[lv]) { int tenths = (int)(cnt[lv] * 10 / DBG_NS); if (tenths > 9) tenths = 9; code = 1000.f * lv + 100.f * tenths; break; }
    if (code != 0.f) for (int i = threadIdx.x; i < 4096; i += blockDim.x) args.out[i] = code;
}
#endif
__device__ __forceinline__ void p_attn_gqa(const Frame& F, int last) {
    char* lds = (char*)F.lds;
    const bf16_t* QG = wsp<bf16_t>(F, WS_QG); const bf16_t* KG = wsp<bf16_t>(F, WS_KG); const bf16_t* VG = wsp<bf16_t>(F, WS_VG); bf16_t* OAB = wsp<bf16_t>(F, WS_OAB);
    const int nlat = NB * 8 * 16, nall = last ? nlat : nlat + NB * 8;
    for (int u = F.bid; u < nall; u += F.G) {
        int bh, q0, seq; size_t orow;
        if (u < nlat) {
            int uu = u;
            if (F.G == 256) {
                const int c = u & 255, i = u >> 8, xcd = c & 7, r = c >> 3, kvg = i * 4 + (xcd >> 1), within = (xcd & 1) * 32 + r;
                uu = (((kvg >> 1) * 8 + (kvg & 1) * 4 + (within >> 4)) << 4) | (within & 15); }
            bh = uu >> 4; const int qb = uu & 15; q0 = CTXL + qb * 256; seq = TT; orow = (size_t)(bh >> 3) * SEQ + qb * 256; }
        else { bh = u - nlat; q0 = 0; seq = CTXL; orow = (size_t)NLAT + (bh >> 3) * CTXL; }
        const int b = bh >> 3, h = bh & 7; const size_t kvo = (size_t)(b * 2 + (h >> 2)) * TT * 128;
        __syncthreads();
        att::attn_body<8, 4, 0, 1>(QG + ((size_t)bh * TT + q0) * 128, KG + kvo, VG + kvo, OAB + orow * D + 1024 + h * 128, seq, lds, F.tid);
    }
    __syncthreads();
}
__device__ __forceinline__ void p_attn_mla(const Frame& F, int last) {
    char* lds = (char*)F.lds;
    const bf16_t* QM = wsp<bf16_t>(F, WS_QM); const bf16_t* KM = wsp<bf16_t>(F, WS_KM); const bf16_t* VM = wsp<bf16_t>(F, WS_VM); bf16_t* OAB = wsp<bf16_t>(F, WS_OAB);
    const int nlat = NB * 8 * 16, nall = last ? nlat : nlat + NB * 8;
    for (int u = F.bid; u < nall; u += F.G) {
        int bh, q0, seq; size_t orow;
        if (u < nlat) {
            int uu = u;
            if (F.G == 256) { const int c = u & 255, i = u >> 8, xcd = c & 7, r = c >> 3; uu = ((i * 16 + xcd * 2 + (r >> 4)) << 4) | (r & 15); }
            bh = uu >> 4; const int qb = uu & 15; q0 = CTXL + qb * 256; seq = TT; orow = (size_t)(bh >> 3) * SEQ + qb * 256; }
        else { bh = u - nlat; q0 = 0; seq = CTXL; orow = (size_t)NLAT + (bh >> 3) * CTXL; }
        const int h = bh & 7;
        __syncthreads();
        att::attn_body<6, 2, 1, 2>(QM + ((size_t)bh * TT + q0) * 128, KM + (size_t)bh * TT * 128, VM + (size_t)bh * TT * 64, OAB + orow * D + h * 64, seq, lds, F.tid);
    }
    __syncthreads();
}
__device__ __forceinline__ void p_ret_out(const Frame& F, int l, int last) {
    const int c_lo = last ? 2 : 0, nc = 34 - c_lo, nu = NB * 8 * nc;
    for (int u = F.bid; u < nu; u += F.G) { const int bh = u / nc, c = c_lo + (u % nc); ret_out_unit(F, l, bh, c); }
    __syncthreads();
}

constexpr int LDS_BYTES = 147456;
constexpr int MISC_OFF = 147456 - 64;
constexpr int NPHASE = 22;
#ifndef PHM
#define PHM 0xFFFF
#endif
#ifndef PH_ATTR
#define PH_ATTR __forceinline__
#endif
__device__ PH_ATTR void ph_prologue(ArgP ap) { const Frame F = make_frame(ap); p0_prologue(F); }
__device__ PH_ATTR void ph_modreduce(ArgP ap) { const Frame F = make_frame(ap); p1_modreduce(F); }
__device__ PH_ATTR void ph_modulate0(ArgP ap) { const Frame F = make_frame(ap); p_modulate0(F); }
__device__ PH_ATTR void ph_gemm_in(ArgP ap, int l) { const Frame F = make_frame(ap);
    pg8::Gemm g{wsp<bf16_t>(F, WS_HB8), wsp<bf16_t>(F, WS_WIN + l * SZ_WIN), NROW, NPT, 1024, 1024, 1024}; pg8::StaticOrder S; S.init(NROW, NPT, F.G, F.bid);
    float mul_, inv_; fp8_scale(wsp<unsigned>(F, WS_WSC)[l], mul_, inv_);
    EpiIn E{wsp<bf16_t>(F, WS_P1), wsp<bf16_t>(F, WS_G), inv_};
    pg8::gemm_phase<EpiIn, pg8::StaticOrder>(F.lds, F.tid, g, S, E); }
__device__ PH_ATTR void ph_post(ArgP ap, int l) { const Frame F = make_frame(ap); p_post(F, l); if (l == 1) cvt_peer(F, 1); }
__device__ PH_ATTR void ph_qup(ArgP ap, int l) { const Frame F = make_frame(ap);
    pg8::Gemm g{wsp<bf16_t>(F, WS_CQN), wsp<bf16_t>(F, WS_WQUP + l * SZ_WQUP), NROW, 768, 512, 512, 512}; pg8::StaticOrder S; S.init(NROW, 768, F.G, F.bid);
    EpiQup E{wsp<bf16_t>(F, WS_QM), wsp<f32x2>(F, WS_ROPE32)};
    pg8::gemm_phase<EpiQup, pg8::StaticOrder>(F.lds, F.tid, g, S, E); }
__device__ PH_ATTR void ph_kvup(ArgP ap, int l) { const Frame F = make_frame(ap);
    pg8::Gemm g{wsp<bf16_t>(F, WS_CKVN), wsp<bf16_t>(F, WS_WKVUP + l * SZ_WKVUP), NROW, 1024, 256, 256, 256}; pg8::StaticOrder S; S.init(NROW, 1024, F.G, F.bid);
    EpiKvup E{wsp<bf16_t>(F, WS_KM), wsp<bf16_t>(F, WS_VM)};
    pg8::gemm_phase<EpiKvup, pg8::StaticOrder>(F.lds, F.tid, g, S, E); }
__device__ PH_ATTR void ph_states(ArgP ap, int l) { const Frame F = make_frame(ap); p_ret_states(F, l); }
__device__ PH_ATTR void ph_attn_gqa(ArgP ap, int last) { const Frame F = make_frame(ap); p_attn_gqa(F, last); }
__device__ PH_ATTR void ph_attn_mla(ArgP ap, int last) { const Frame F = make_frame(ap); p_attn_mla(F, last); }
__device__ PH_ATTR void ph_ret_out(ArgP ap, int l, int last) { const Frame F = make_frame(ap); p_ret_out(F, l, last); }
template <int SEG> __device__ PH_ATTR void ph_merge(ArgP ap, int l, int Mx) { const Frame F = make_frame(ap);
    const bf16_t* OAB = wsp<bf16_t>(F, WS_OAB); bf16_t* MB = wsp<bf16_t>(F, WS_MB); const bf16_t* G = wsp<bf16_t>(F, WS_G);
    pg8::StaticOrder S; S.init(Mx, 2048, F.G, F.bid);
    const size_t wo = SEG == 0 ? WS_WBRA + l * SZ_WBRA : (SEG == 1 ? WS_WBRB + l * SZ_WBRB : WS_WBRC + l * SZ_WBRC); const int K = SEG == 2 ? 1024 : 512;
    pg8::Gemm g{OAB + SEG * 512, wsp<bf16_t>(F, wo), Mx, 2048, K, 2048, K}; EpiMerge<SEG> E{MB, G, wsp<unsigned char>(F, WS_MB8)}; pg8::gemm_phase<EpiMerge<SEG>, pg8::StaticOrder>(F.lds, F.tid, g, S, E); }
__device__ PH_ATTR void ph_out(ArgP ap, int l, int Mx) { const Frame F = make_frame(ap);
    pg8::Gemm g{wsp<bf16_t>(F, WS_MB8), wsp<bf16_t>(F, WS_WOUT + l * SZ_WOUT), Mx, 2048, 1024, 1024, 1024}; pg8::StaticOrder S; S.init(Mx, 2048, F.G, F.bid);
    float mul_, inv_; fp8_scale(wsp<unsigned>(F, WS_WSC)[2 + l], mul_, inv_);
    EpiOut E{l == 0 ? F.in(0) : F.out, l == 0 ? F.in(2) : wsp<float>(F, WS_XC), F.out, wsp<float>(F, WS_XC), wsp<float>(F, WS_MOD) + (size_t)l * 5 * 12288 + 4096, inv_ * (1.f / 16.f)};
    pg8::gemm_phase<EpiOut, pg8::StaticOrder>(F.lds, F.tid, g, S, E); }
__device__ PH_ATTR void ph_ln1(ArgP ap, int l, int last) { const Frame F = make_frame(ap); p_ln1(F, l, last); }
__device__ PH_ATTR void ph_peerq(ArgP ap, int l, int Mx) { const Frame F = make_frame(ap);
    pg8::Gemm g{wsp<bf16_t>(F, WS_HB), wsp<bf16_t>(F, WS_WPQ + l * SZ_WPQ), Mx, 1024, 2048, 2048, 2048}; pg8::StaticOrder S; S.init(Mx, 1024, F.G, F.bid);
    EpiPlain E{wsp<bf16_t>(F, WS_QP), 1024};
    pg8::gemm_phase<EpiPlain, pg8::StaticOrder>(F.lds, F.tid, g, S, E); }
__device__ PH_ATTR void ph_peer(ArgP ap, int l, int last) { const Frame F = make_frame(ap); p_peer(F, l, last); }

__global__ void __launch_bounds__(512, 2) mega_fwd(Args args) {
    extern __shared__ __attribute__((aligned(16))) unsigned char lds_raw[];
    const ArgP ap = (ArgP)__builtin_amdgcn_kernarg_segment_ptr();
    const int lo = ap->ph_lo, hi = ap->ph_hi;
    volatile LAS unsigned* misc = (volatile LAS unsigned*)((LAS unsigned char*)lds_raw + MISC_OFF);
    if (threadIdx.x < 4) misc[threadIdx.x] = 0u;
    __syncthreads();
    XcdBarrier bar; bar.bar = (unsigned*)(ap->ws + WS_CTL); bar.x = 0; bar.st = misc;
    if (hi - lo > 1) bar = xcd_barrier_post((unsigned*)(ap->ws + WS_CTL), misc);
#define IN(k) (lo <= (k) && (k) < hi)
#define SEAM(k) do { if (IN(k) && IN((k) + 1)) xcd_barrier(bar); } while (0)
    if (IN(0)) { if (PHM & 1) ph_prologue(ap); if (REP_PRO) ph_prologue(ap); } SEAM(0);
    if (IN(1)) { if (PHM & 2) ph_modreduce(ap); if (REP_X & 32) ph_modreduce(ap); } SEAM(1);
#pragma unroll 1
    for (int l = 0; l < 2; ++l) {
        const int pb = 2 + 10 * l; const int last = (l == 1);
        const int Mx = last ? NLAT : NROW;
        if (l == 0) { if (IN(pb)) { if (PHM & 4) ph_modulate0(ap); if (REP_X & 64) ph_modulate0(ap); } SEAM(pb); }
        if (IN(pb + 1)) { if (PHM & 8) ph_gemm_in(ap, l); if (REP_GIN) ph_gemm_in(ap, l); } SEAM(pb + 1);
        if (IN(pb + 2)) { if (PHM & 16) ph_post(ap, l); if (REP_X & 1) ph_post(ap, l); } SEAM(pb + 2);
        if (IN(pb + 3)) { if (PHM & 32) ph_qup(ap, l); if (PHM & 64) ph_kvup(ap, l); if (PHM & 128) ph_states(ap, l); if (REP_X & 2) { ph_qup(ap, l); ph_kvup(ap, l); ph_states(ap, l); } } SEAM(pb + 3);
        if (IN(pb + 4)) { if (PHM & 256) ph_attn_gqa(ap, last); if (PHM & 512) ph_attn_mla(ap, last); if (REP_ATTN) { ph_attn_gqa(ap, last); ph_attn_mla(ap, last); } if (REP_X & 4) ph_ret_out(ap, l, last); if (PHM & 1024) ph_ret_out(ap, l, last); } SEAM(pb + 4);
        if (IN(pb + 5)) { if (PHM & 2048) { ph_merge<0>(ap, l, Mx); ph_merge<1>(ap, l, Mx); ph_merge<2>(ap, l, Mx); } if (REP_X & 8) { ph_merge<0>(ap, l, Mx); ph_merge<1>(ap, l, Mx); ph_merge<2>(ap, l, Mx); } } SEAM(pb + 5);
        if (IN(pb + 6)) { if (PHM & 4096) ph_out(ap, l, Mx); } SEAM(pb + 6);
        if (IN(pb + 7)) { if (PHM & 8192) ph_ln1(ap, l, last); } SEAM(pb + 7);
        if (IN(pb + 8)) { if (PHM & 16384) ph_peerq(ap, l, Mx); if (REP_X & 16) ph_peerq(ap, l, Mx); } SEAM(pb + 8);
        if (IN(pb + 9)) { if (PHM & 32768) ph_peer(ap, l, last); } SEAM(pb + 9);
    }
#undef IN
#undef SEAM
}

extern "C" void kernel_launch(void* const* d_in, const int* in_sizes, int n_in, void* d_out, int out_size, void* d_ws, size_t ws_size, hipStream_t stream) {
    static int grid = 0;
    if (grid == 0) {
        if (n_in != 27 || out_size != NLAT * D || ws_size < WS_END) { fprintf(stderr, "kernel_launch: unexpected shapes: n_in %d out %d ws %zu (need %zu)\n", n_in, out_size, ws_size, (size_t)WS_END); grid = -1; return; }
        int dev = 0, cus = 0, per_cu = 0;
        if (hipGetDevice(&dev) != hipSuccess || hipDeviceGetAttribute(&cus, hipDeviceAttributeMultiprocessorCount, dev) != hipSuccess) { grid = -1; return; }
        if (hipFuncSetAttribute((const void*)mega_fwd, hipFuncAttributeMaxDynamicSharedMemorySize, LDS_BYTES) != hipSuccess) { fprintf(stderr, "kernel_launch: hipFuncSetAttribute failed\n"); grid = -1; return; }
        if (hipOccupancyMaxActiveBlocksPerMultiprocessor(&per_cu, (const void*)mega_fwd, 512, LDS_BYTES) != hipSuccess || per_cu < 1) fprintf(stderr, "kernel_launch: occupancy query reports %d\n", per_cu);
        (void)hipGetLastError();
        grid = cus;
    }
    if (grid < 0) return;
    (void)hipMemsetAsync((char*)d_ws + WS_CTL, 0, 65536, stream);
#ifdef DBG
    (void)hipMemsetAsync((char*)d_ws + WS_CTL + 131072, 0, 4096, stream);
#endif
    Args a{};
    for (int i = 0; i < 27; ++i) a.in[i] = (const float*)d_in[i];
    a.out = (float*)d_out; a.ws = (unsigned char*)d_ws;
#if MK_PER_PHASE
    for (int p = 0; p < NPHASE; ++p) { if (p == 12) continue; a.ph_lo = p; a.ph_hi = p + 1;
#ifdef DBG
        if (p == 11) hipLaunchKernelGGL(dbg_peer_pre, dim3(DBG_NS), dim3(256), 0, stream, a, 0);
#endif
        hipLaunchKernelGGL(mega_fwd, dim3(grid), dim3(512), LDS_BYTES, stream, a);
#ifdef DBG
        if (p == 11) hipLaunchKernelGGL(dbg_peer_post, dim3(DBG_NS), dim3(256), 0, stream, a);
#endif
    }
#ifdef DBG
    hipLaunchKernelGGL(dbg_report, dim3(1), dim3(256), 0, stream, a);
#endif
#else
    a.ph_lo = 0; a.ph_hi = NPHASE;
    hipLaunchKernelGGL(mega_fwd, dim3(grid), dim3(512), LDS_BYTES, stream, a);
#endif
    const hipError_t le = hipPeekAtLastError();
    if (le != hipSuccess) fprintf(stderr, "kernel_launch: launch failed: %s\n", hipGetErrorName(le));
}
```

```cpp
#include <hip/hip_runtime.h>
#include <cstdio>
#include <cstdint>
#include <cstddef>

#ifndef MK_PER_PHASE
#define MK_PER_PHASE 0
#endif

#ifndef ABL_PEER
#define ABL_PEER 0
#endif
#ifndef REP_PEERG
#define REP_PEERG 0
#endif
#ifndef REP_PEERH
#define REP_PEERH 0
#endif
#ifndef REP_X
#define REP_X 0
#endif
#ifndef REP_PS1
#define REP_PS1 0
#endif
#ifndef REP_PS2
#define REP_PS2 0
#endif
#ifndef SIDE_ON
#define SIDE_ON 1
#endif
#ifndef REP_DOT
#define REP_DOT 0
#endif
#ifndef MERGE3
#define MERGE3 1
#endif
#ifndef REP_GIN
#define REP_GIN 0
#endif
#ifndef REP_ATTN
#define REP_ATTN 0
#endif
#ifndef REP_PRO
#define REP_PRO 0
#endif
#ifndef ABL_BR
#define ABL_BR 0
#endif
#ifndef ABL_MIX
#define ABL_MIX 0
#endif
#define LAS __attribute__((address_space(3)))
typedef unsigned short bf16_t;
typedef short bf16x8 __attribute__((ext_vector_type(8)));
typedef short s16x4 __attribute__((ext_vector_type(4)));
typedef float f32x2 __attribute__((ext_vector_type(2)));
typedef float f32x4 __attribute__((ext_vector_type(4)));
typedef float f32x8 __attribute__((ext_vector_type(8)));
typedef float f32x16 __attribute__((ext_vector_type(16)));
typedef unsigned u32x2 __attribute__((ext_vector_type(2)));
typedef unsigned u32x4 __attribute__((ext_vector_type(4)));
typedef __bf16 bf2_t __attribute__((ext_vector_type(2)));

constexpr int D = 2048, NB = 4, SEQ = 4096, CTXL = 256, TT = SEQ + CTXL;
constexpr int NLAT = NB * SEQ, NCTX = NB * CTXL, NROW = NLAT + NCTX;
constexpr int NP1 = 4096, NG = 6144, NPT = NP1 + NG;
constexpr int NIN = 10016;
constexpr float ALPHA = 1.4142135623730951f;
constexpr float LN_EPS = 1e-5f, RMS_EPS = 1e-6f;
constexpr float LOG2E = 1.4426950408889634f;
constexpr int C_CQ = 0, C_CKV = 512, C_GQ = 768, C_GK = 1792, C_GV = 2048, C_RQ = 2304, C_RK = 2560, C_RV = 2816, C_RG = 3328, C_KR = 3840;

constexpr size_t AL(size_t x) { return (x + 255) / 256 * 256; }
constexpr size_t WS_CTL = 0;                                    constexpr size_t CTL_BYTES = 1u << 20;
constexpr size_t WS_WSC = WS_CTL + 32768;
constexpr size_t WS_CVT = WS_CTL + 33024;
constexpr size_t WS_DEC = WS_CTL + 65536;
constexpr size_t WS_ROPE32 = WS_CTL + CTL_BYTES;
constexpr size_t WS_ROPE128 = WS_ROPE32 + AL(64 * 8 * 8);
constexpr size_t WS_MODP = WS_ROPE128 + AL(64 * 32 * 8);
constexpr size_t WS_MOD = WS_MODP + AL((size_t)16 * 2 * 5 * 12288 * 4);
constexpr size_t WS_WIN = WS_MOD + AL((size_t)2 * 5 * 12288 * 4);
constexpr size_t SZ_WIN = (size_t)NPT * D;
constexpr size_t WS_WQUP = WS_WIN + 2 * SZ_WIN;                 constexpr size_t SZ_WQUP = (size_t)768 * 512 * 2;
constexpr size_t WS_WKVUP = WS_WQUP + 2 * SZ_WQUP;              constexpr size_t SZ_WKVUP = (size_t)1024 * 256 * 2;
constexpr size_t WS_WBRA = WS_WKVUP + 2 * SZ_WKVUP;             constexpr size_t SZ_WBRA = (size_t)2048 * 512 * 2;
constexpr size_t WS_WBRB = WS_WBRA + 2 * SZ_WBRA;               constexpr size_t SZ_WBRB = SZ_WBRA;
constexpr size_t WS_WBRC = WS_WBRB + 2 * SZ_WBRB;               constexpr size_t SZ_WBRC = (size_t)2048 * 1024 * 2;
constexpr size_t WS_WOUT = WS_WBRC + 2 * SZ_WBRC;               constexpr size_t SZ_WOUT = (size_t)2048 * 2048 * 2;
constexpr size_t WS_WPQ = WS_WOUT + 2 * SZ_WOUT;                constexpr size_t SZ_WPQ = (size_t)1024 * 2048 * 2;
constexpr size_t WS_PSC = WS_WPQ + 2 * SZ_WPQ;
constexpr size_t WS_PU = WS_PSC + (size_t)4 * 16384 * 4;        constexpr size_t SZ_PT = (size_t)16384 * 1152;
constexpr size_t WS_PV = WS_PU + 2 * SZ_PT;
constexpr size_t WS_XC = WS_PV + 2 * SZ_PT;
constexpr size_t WS_HB = WS_XC + (size_t)NCTX * D * 4;
constexpr size_t WS_P1 = WS_HB + (size_t)NROW * D * 2;
constexpr size_t WS_G = WS_P1 + (size_t)NROW * NP1 * 2;
constexpr size_t WS_CQN = WS_G + (size_t)NROW * NG * 2;
constexpr size_t WS_CKVN = WS_CQN + (size_t)NROW * 512 * 2;
constexpr size_t WS_QM = WS_CKVN + (size_t)NROW * 256 * 2;
constexpr size_t SZ_Q128 = (size_t)NB * 8 * TT * 128 * 2;
constexpr size_t WS_KM = WS_QM + SZ_Q128;
constexpr size_t WS_VM = WS_KM + SZ_Q128;
constexpr size_t WS_QG = WS_VM + SZ_Q128 / 2;
constexpr size_t WS_KG = WS_QG + SZ_Q128;
constexpr size_t WS_VG = WS_KG + SZ_Q128 / 4;
constexpr size_t WS_RQ = WS_VG + SZ_Q128 / 4;
constexpr size_t WS_RK = WS_RQ + SZ_Q128 / 4;
constexpr size_t WS_RV = WS_RK + SZ_Q128 / 4;
constexpr size_t WS_ST = WS_RV + SZ_Q128 / 2;
constexpr size_t WS_OAB = WS_ST + (size_t)NB * 8 * 34 * 2 * 2048 * 4;
constexpr size_t WS_HB8 = WS_OAB + (size_t)NROW * D * 2;
constexpr size_t WS_MB8 = WS_HB8 + (size_t)NROW * D;
constexpr size_t WS_END = WS_MB8 + (size_t)NROW * D;
constexpr size_t WS_MB = WS_QM;
constexpr size_t WS_QP = WS_QG;
static_assert((size_t)NROW * D * 2 <= 2 * SZ_Q128, "MB alias");
static_assert((size_t)NROW * 1024 * 2 <= SZ_Q128, "QP alias");

__device__ __forceinline__ unsigned cvt_pk_bf16(float lo, float hi) { unsigned r; asm volatile("v_cvt_pk_bf16_f32 %0, %1, %2" : "=v"(r) : "v"(lo), "v"(hi)); return r; }
__device__ __forceinline__ bf16_t f2bf(float f) { return (bf16_t)(cvt_pk_bf16(f, 0.f) & 0xffffu); }
__device__ __forceinline__ float bf2f(bf16_t b) { return __uint_as_float(((unsigned)b) << 16); }
__device__ __forceinline__ float bflo(unsigned w) { return __uint_as_float(w << 16); }
__device__ __forceinline__ float bfhi(unsigned w) { return __uint_as_float(w & 0xffff0000u); }
template <int CTRL> __device__ __forceinline__ float dppf(float x) { return __int_as_float(__builtin_amdgcn_update_dpp(0, __float_as_int(x), CTRL, 0xF, 0xF, true)); }
__device__ __forceinline__ float row16_sum(float x) { x += dppf<0xB1>(x); x += dppf<0x4E>(x); x += dppf<0x141>(x); x += dppf<0x140>(x); return x; }
__device__ __forceinline__ float row16_max(float x) { x = fmaxf(x, dppf<0xB1>(x)); x = fmaxf(x, dppf<0x4E>(x)); x = fmaxf(x, dppf<0x141>(x)); x = fmaxf(x, dppf<0x140>(x)); return x; }
__device__ __forceinline__ float wave_sum(float x) {
    x = row16_sum(x);
    { auto r = __builtin_amdgcn_permlane16_swap(__float_as_uint(x), __float_as_uint(x), false, false); x = __uint_as_float(r[0]) + __uint_as_float(r[1]); }
    { auto r = __builtin_amdgcn_permlane32_swap(__float_as_uint(x), __float_as_uint(x), false, false); x = __uint_as_float(r[0]) + __uint_as_float(r[1]); }
    return x;
}
__device__ __forceinline__ unsigned pk4_fp8(float a, float b, float c, float d) { int t = 0; t = __builtin_amdgcn_cvt_pk_fp8_f32(a, b, t, false); t = __builtin_amdgcn_cvt_pk_fp8_f32(c, d, t, true); return (unsigned)t; }
__device__ __forceinline__ float clamp8(float x) { return fminf(fmaxf(x, -440.f), 440.f); }
__device__ __forceinline__ void fp8_scale(unsigned amax_bits, float& mul, float& inv) { const float am = __uint_as_float(amax_bits); int k = 0; if (am > 0.f) k = (int)floorf(log2f(256.f / am)); k = k > 60 ? 60 : (k < -60 ? -60 : k); mul = exp2f((float)k); inv = exp2f((float)-k); }
__device__ __forceinline__ float silu_f(float x) { return x / (1.f + __expf(-x)); }
__device__ __forceinline__ float sigmoid_f(float x) { return 1.f / (1.f + __expf(-x)); }

struct RowInfo { int b, tpos, pr, pc, v; bool lat; };
__device__ __forceinline__ RowInfo rowinfo(int row) {
    RowInfo r;
    if (row < NLAT) { r.lat = true; r.b = row >> 12; const int t = row & 4095; r.tpos = CTXL + t; r.pr = t >> 6; r.pc = t & 63; r.v = r.b; }
    else { const int q = row - NLAT; r.lat = false; r.b = q >> 8; r.tpos = q & 255; r.pr = 0; r.pc = 0; r.v = 4; }
    return r;
}

#define XB_TMO      128
#define XB_XCNT(j)  (256  + 64 * (j))
#define XB_XSUB(j)  (1280 + 64 * (j))
#define XB_XGEN(j)  (2304 + 64 * (j))
#define XB_TOP      3328
#define XB_TOPGEN   3392
#define XCD_BAR_WORDS 3456
#define XB_SPIN_CAP (1u << 22)

__device__ __forceinline__ unsigned xb_ld(unsigned* p)              { return __hip_atomic_load(p, __ATOMIC_RELAXED, __HIP_MEMORY_SCOPE_AGENT); }
__device__ __forceinline__ unsigned xb_add(unsigned* p, unsigned v) { return __hip_atomic_fetch_add(p, v, __ATOMIC_RELAXED, __HIP_MEMORY_SCOPE_AGENT); }
__device__ __forceinline__ unsigned xb_xcc_id() { return (unsigned)__builtin_amdgcn_s_getreg((3 << 11) | 20) & 0xFu; }
#define XB_SPIN(cond, bar) do { unsigned _sp = 0; while (cond) { __builtin_amdgcn_s_sleep(1); \
    if ((++_sp & 255u) == 0u) { if (xb_ld(&(bar)[XB_TMO])) break; if (_sp > XB_SPIN_CAP) { atomicAdd(&(bar)[XB_TMO], 1u); break; } } } } while (0)

struct XcdBarrier { unsigned* bar; unsigned x; volatile LAS unsigned* st; };

__device__ __forceinline__ XcdBarrier xcd_barrier_post(unsigned* bar, volatile LAS unsigned* st) {
    XcdBarrier b; b.bar = bar; b.x = xb_xcc_id(); b.st = st;
    if (threadIdx.x == 0) (void)xb_add(&bar[XB_XCNT(b.x)], 1u);
    return b;
}
__device__ __forceinline__ void xcd_barrier_complete(unsigned* bar, unsigned x, unsigned& nloc, unsigned& nx) {
    const unsigned G = gridDim.x * gridDim.y * gridDim.z;
    unsigned sum, cnt, mine, sp = 0u;
    for (;;) {
        sum = 0u; cnt = 0u; mine = 0u;
#pragma unroll
        for (unsigned j = 0; j < 16; ++j) { const unsigned c = xb_ld(&bar[XB_XCNT(j)]); sum += c; cnt += (c > 0u) ? 1u : 0u; mine = (j == x) ? c : mine; }
        if (sum == G) break;
        __builtin_amdgcn_s_sleep(1);
        if ((++sp & 255u) == 0u) { if (xb_ld(&bar[XB_TMO])) break; if (sp > XB_SPIN_CAP) { atomicAdd(&bar[XB_TMO], 1u); break; } }
    }
    nloc = mine > 0u ? mine : 1u; nx = cnt > 0u ? cnt : 1u;
}
__device__ __forceinline__ void xcd_barrier(const XcdBarrier& b) {
    asm volatile("s_waitcnt vmcnt(0)" ::: "memory");
    __syncthreads();
    if (threadIdx.x == 0) {
        unsigned* bar = b.bar;
        __builtin_amdgcn_s_waitcnt(0);
        unsigned nloc = b.st[0], nx = b.st[1];
        if (nloc == 0u) { xcd_barrier_complete(bar, b.x, nloc, nx); b.st[0] = nloc; b.st[1] = nx; }
        const unsigned old = xb_add(&bar[XB_XSUB(b.x)], 1u);
        const unsigned gen = old / nloc;
        if (old + 1u == (gen + 1u) * nloc) {
            __builtin_amdgcn_fence(__ATOMIC_RELEASE, "agent");
            asm volatile("s_waitcnt vmcnt(0)" ::: "memory");
            const unsigned og = xb_add(&bar[XB_TOP], 1u);
            const unsigned tg = og / nx;
            if (og + 1u == (tg + 1u) * nx) xb_add(&bar[XB_TOPGEN], 1u);
            else XB_SPIN(xb_ld(&bar[XB_TOPGEN]) == tg, bar);
            __builtin_amdgcn_fence(__ATOMIC_ACQUIRE, "agent");
            xb_add(&bar[XB_XGEN(b.x)], 1u);
            asm volatile("s_waitcnt vmcnt(0)" ::: "memory");
        } else {
            XB_SPIN(xb_ld(&bar[XB_XGEN(b.x)]) == gen, bar);
            __builtin_amdgcn_fence(__ATOMIC_ACQUIRE, "agent");
            asm volatile("s_waitcnt vmcnt(0)" ::: "memory");
        }
    }
    __syncthreads();
}
namespace pg8 {
constexpr int BM = 256, BK = 64, HALF = 128, HTB = HALF * BK * 2, STAGE_BYTES = 8 * HTB, NXCD = 8, WGM = 8;
__host__ __device__ __forceinline__ int lds_byte(int r, int c) { const int st = (r >> 4) * 2 + (c >> 5), rr = r & 15, cc = c & 31, ob = rr * 64 + cc * 2; return st * 1024 + (ob ^ (((ob >> 9) & 1) << 5)); }
__host__ __device__ __forceinline__ void stage_rc(int b, int& R, int& C) { const int st = b / 1024, sb = b % 1024, swz = sb ^ (((sb >> 9) & 1) << 5); R = (st >> 1) * 16 + swz / 64; C = (st & 1) * 32 + (swz % 64) / 2; }
__host__ __device__ __forceinline__ int perm32(int rho) { const int n = rho >> 4, i = rho & 15; return 8 * (i >> 2) + 4 * n + (i & 3); }

struct Unit { int pm, pn; };
typedef int i32x8 __attribute__((ext_vector_type(8))); typedef int i32x4v __attribute__((ext_vector_type(4)));
__device__ __forceinline__ i32x8 cat8(const bf16x8 a, const bf16x8 b) { const i32x4v x = __builtin_bit_cast(i32x4v, a), y = __builtin_bit_cast(i32x4v, b); return __builtin_shufflevector(x, y, 0, 1, 2, 3, 4, 5, 6, 7); }
struct Gemm { const bf16_t* A; const bf16_t* Bt; int M, N, K, lda, ldb; };

struct StaticOrder {
    int nM, nN, nwg, G, c;
    __host__ __device__ void init(int M, int N, int G_, int c_) { nM = M / BM; nN = N / BM; nwg = nM * nN; G = G_; c = c_; }
    __host__ __device__ bool next(int i, Unit& u) const {
        const long L = (long)i * G + c; if (L >= nwg) return false;
        int wgid = (int)L; { const int q = nwg / NXCD, r = nwg % NXCD, xcd = wgid % NXCD, off = wgid / NXCD; wgid = (xcd < r ? xcd * (q + 1) : r * (q + 1) + (xcd - r) * q) + off; }
        const int nig = WGM * nN, gid = wgid / nig, fm = gid * WGM, gsz = (nM - fm) < WGM ? (nM - fm) : WGM;
        u.pm = fm + ((wgid % nig) % gsz); u.pn = (wgid % nig) / gsz; return true;
    }
    __device__ __forceinline__ void a_ready(const Unit&) const {}
    __device__ __forceinline__ void done(const Unit&) const {}
};

template <class Epi, class Sched>
__device__ __forceinline__ void gemm_phase(LAS unsigned char* lds, const int tid, const Gemm g, const Sched& S, const Epi& E) {
    const int  wid = __builtin_amdgcn_readfirstlane(tid >> 6), lane = tid & 63, wr = wid >> 2, wc = wid & 3, fr = lane & 15, fq = lane >> 4;
    const int K = g.K, nt = K / BK;
    unsigned voffA[2], voffB[2];
#pragma unroll
    for (int i = 0; i < 2; ++i) { int R, C; stage_rc(tid * 16 + i * 8192, R, C); const int Rb = Epi::PERM ? ((R & ~31) + perm32(R & 31)) : R;
        voffA[i] = (unsigned)(R * g.lda + C) * 2u; voffB[i] = (unsigned)(Rb * g.ldb + C) * 2u; }
    const size_t kstep = (size_t)(BK * 2);
    const size_t hstepA = (size_t)HALF * g.lda * 2, hstepB = (size_t)HALF * g.ldb * 2;
    const size_t tstepA = 2 * hstepA, tstepB = 2 * hstepB;
    const unsigned ldsw = (unsigned)wid * 1024u;
    const int aoff = lds_byte(wr * 64 + fr, fq * 8), boff = lds_byte(wc * 32 + fr, fq * 8);
#define PG8_SA(b, h) (((b) * 2 + (h)) * HTB)
#define PG8_SB(b, h) ((4 + (b) * 2 + (h)) * HTB)
#define PG8_STAGE(bufoff, gbase, voff) do { _Pragma("unroll") for (int _i = 0; _i < 2; ++_i) \
        __builtin_amdgcn_global_load_lds((const unsigned*)((const char*)(gbase) + (voff)[_i]), (LAS unsigned*)(lds + (bufoff) + ldsw + _i * 8192), 16, 0, 0); } while (0)
#define PG8_LDA(dst, b, h) do { if constexpr (Epi::FP8) { _Pragma("unroll") for (int m = 0; m < 4; ++m) { const i32x4v lo_ = *(const LAS i32x4v*)(lds + PG8_SA(b, h) + aoff + m * 2048), hi_ = *(const LAS i32x4v*)(lds + PG8_SA(b, h) + aoff + m * 2048 + 1024); \
            dst##8[m] = __builtin_shufflevector(lo_, hi_, 0, 1, 2, 3, 4, 5, 6, 7); } } \
        else { _Pragma("unroll") for (int m = 0; m < 4; ++m) _Pragma("unroll") for (int k = 0; k < 2; ++k) dst[m][k] = *(const LAS bf16x8*)(lds + PG8_SA(b, h) + aoff + m * 2048 + k * 1024); } } while (0)
#define PG8_LDB(dst, b, h) do { if constexpr (Epi::FP8) { _Pragma("unroll") for (int n = 0; n < 2; ++n) { const i32x4v lo_ = *(const LAS i32x4v*)(lds + PG8_SB(b, h) + boff + n * 2048), hi_ = *(const LAS i32x4v*)(lds + PG8_SB(b, h) + boff + n * 2048 + 1024); \
            dst##8[n] = __builtin_shufflevector(lo_, hi_, 0, 1, 2, 3, 4, 5, 6, 7); } } \
        else { _Pragma("unroll") for (int n = 0; n < 2; ++n) _Pragma("unroll") for (int k = 0; k < 2; ++k) dst[n][k] = *(const LAS bf16x8*)(lds + PG8_SB(b, h) + boff + n * 2048 + k * 1024); } } while (0)
#define PG8_MMA(ai, bj, At, Bt) do { __builtin_amdgcn_s_setprio(1); _Pragma("unroll") for (int m = 0; m < 4; ++m) _Pragma("unroll") for (int n = 0; n < 2; ++n) { \
        if constexpr (Epi::FP8) asm volatile("v_mfma_scale_f32_16x16x128_f8f6f4 %0, %1, %2, %0, %3, %3 op_sel_hi:[0,0,0]" : "+v"(acc[ai][bj][m][n]) : "v"(Bt##8[n]), "v"(At##8[m]), "v"(sc1_)); \
        else { _Pragma("unroll") for (int k = 0; k < 2; ++k) acc[ai][bj][m][n] = __builtin_amdgcn_mfma_f32_16x16x32_bf16(Bt[n][k], At[m][k], acc[ai][bj][m][n], 0, 0, 0); } } __builtin_amdgcn_s_setprio(0); } while (0)
#define PG8_WAIT_V(n) asm volatile("s_waitcnt vmcnt(" #n ")" ::: "memory")
#define PG8_WAIT_L(n) asm volatile("s_waitcnt lgkmcnt(" #n ")" ::: "memory")
#define PG8_BAR __builtin_amdgcn_s_barrier()
#define PG8_SCHED __builtin_amdgcn_sched_barrier(0)
    Unit cur, nxt; int ui = 0;
    if (!S.next(0, cur)) return;
    f32x4 acc[2][2][4][2];
#pragma unroll
    for (int a = 0; a < 2; ++a)
#pragma unroll
        for (int b = 0; b < 2; ++b)
#pragma unroll
            for (int m = 0; m < 4; ++m)
#pragma unroll
                for (int n = 0; n < 2; ++n) acc[a][b][m][n] = (f32x4){0.f, 0.f, 0.f, 0.f};
    int sc1_ = 0x7F7F7F7F; asm volatile("" : "+v"(sc1_));
    bf16x8 At[4][2], B0[2][2], B1[2][2]; i32x8 At8[4], B08[2], B18[2];
    const char* cA = (const char*)g.A + (size_t)cur.pm * tstepA; const char* cB = (const char*)g.Bt + (size_t)cur.pn * tstepB;
    S.a_ready(cur);
    PG8_STAGE(PG8_SB(0, 0), cB, voffB); PG8_STAGE(PG8_SA(0, 0), cA, voffA); PG8_STAGE(PG8_SB(0, 1), cB + hstepB, voffB); PG8_STAGE(PG8_SA(0, 1), cA + hstepA, voffA);
    if (wr == 1) PG8_BAR;
    PG8_WAIT_V(4); PG8_BAR;
    PG8_STAGE(PG8_SB(1, 0), cB + kstep, voffB); PG8_STAGE(PG8_SA(1, 0), cA + kstep, voffA); PG8_STAGE(PG8_SB(1, 1), cB + hstepB + kstep, voffB);
    PG8_WAIT_V(6); PG8_BAR;
    for (;;) {
        const bool has_next = S.next(ui + 1, nxt);
        const char* nA = has_next ? (const char*)g.A + (size_t)nxt.pm * tstepA : cA; const char* nB = has_next ? (const char*)g.Bt + (size_t)nxt.pn * tstepB : cB;
#pragma unroll 1
        for (int t = 0; t < nt; t += 2) {
            const bool last = (t == nt - 2);
            const char* a1 = cA + (size_t)(t + 1) * kstep;
            const char* a2 = last ? nA : cA + (size_t)(t + 2) * kstep; const char* b2 = last ? nB : cB + (size_t)(t + 2) * kstep;
            const char* a3 = a2 + kstep; const char* b3 = b2 + kstep;
            if (last && has_next) S.a_ready(nxt);
            PG8_LDB(B0, 0, 0); PG8_SCHED; PG8_LDA(At, 0, 0); PG8_STAGE(PG8_SA(1, 1), a1 + hstepA, voffA);
            PG8_WAIT_L(8); PG8_BAR; PG8_WAIT_L(0); PG8_MMA(0, 0, At, B0); PG8_BAR; PG8_SCHED;
            PG8_LDB(B1, 0, 1); PG8_STAGE(PG8_SB(0, 0), b2, voffB);
            PG8_BAR; PG8_WAIT_L(0); PG8_MMA(0, 1, At, B1); PG8_BAR;
            PG8_LDA(At, 0, 1); PG8_STAGE(PG8_SA(0, 0), a2, voffA);
            PG8_BAR; PG8_WAIT_L(0); PG8_MMA(1, 0, At, B0); PG8_BAR; PG8_SCHED;
            PG8_STAGE(PG8_SB(0, 1), b2 + hstepB, voffB);
            PG8_WAIT_V(6); PG8_BAR; PG8_MMA(1, 1, At, B1); PG8_BAR;
            PG8_LDB(B0, 1, 0); PG8_SCHED; PG8_LDA(At, 1, 0); PG8_STAGE(PG8_SA(0, 1), a2 + hstepA, voffA);
            PG8_WAIT_L(8); PG8_BAR; PG8_WAIT_L(0); PG8_MMA(0, 0, At, B0); PG8_BAR; PG8_SCHED;
            PG8_LDB(B1, 1, 1); PG8_STAGE(PG8_SB(1, 0), b3, voffB);
            PG8_BAR; PG8_WAIT_L(0); PG8_MMA(0, 1, At, B1); PG8_BAR;
            PG8_LDA(At, 1, 1); PG8_STAGE(PG8_SA(1, 0), a3, voffA);
            PG8_BAR; PG8_WAIT_L(0); PG8_MMA(1, 0, At, B0); PG8_BAR; PG8_SCHED;
            PG8_STAGE(PG8_SB(1, 1), b3 + hstepB, voffB);
            PG8_WAIT_V(6); PG8_BAR; PG8_MMA(1, 1, At, B1); PG8_BAR;
        }
        if constexpr (Epi::FP8) asm volatile("s_nop 15\n\ts_nop 15" ::: "memory");
        E(acc, cur, wr, wc, fr, fq);
        if (!has_next) break;
#pragma unroll
        for (int a = 0; a < 2; ++a)
#pragma unroll
            for (int b = 0; b < 2; ++b)
#pragma unroll
                for (int m = 0; m < 4; ++m)
#pragma unroll
                    for (int n = 0; n < 2; ++n) acc[a][b][m][n] = (f32x4){0.f, 0.f, 0.f, 0.f};
        cur = nxt; cA = nA; cB = nB; ++ui;
    }
    PG8_WAIT_V(0);
    if (wr == 0) PG8_BAR;
    PG8_BAR;
#undef PG8_SA
#undef PG8_SB
#undef PG8_STAGE
#undef PG8_LDA
#undef PG8_LDB
#undef PG8_MMA
#undef PG8_WAIT_V
#undef PG8_WAIT_L
#undef PG8_BAR
#undef PG8_SCHED
}
}

typedef f32x4 Acc[2][2][4][2];
#define EPI_LOOP_ROWS for (int ai = 0; ai < 2; ++ai) for (int m = 0; m < 4; ++m)
__device__ __forceinline__ u32x4 pack8(const f32x4 a, const f32x4 b) { u32x4 w; w.x = cvt_pk_bf16(a[0], a[1]); w.y = cvt_pk_bf16(a[2], a[3]); w.z = cvt_pk_bf16(b[0], b[1]); w.w = cvt_pk_bf16(b[2], b[3]); return w; }

struct EpiIn {
    static constexpr bool PERM = true, FP8 = true;
    bf16_t* P1; bf16_t* G; float inv;
    __device__ __forceinline__ void operator()(const Acc& acc, const pg8::Unit& u, int wr, int wc, int fr, int fq) const {
        const int row0 = u.pm * 256 + wr * 64 + fr; const bool gate = u.pn >= 16;
        bf16_t* base = gate ? G : P1; const int ld = gate ? NG : NP1; const int col0 = (gate ? (u.pn - 16) : u.pn) * 256 + wc * 32 + 8 * fq;
#pragma unroll
        for (int ai = 0; ai < 2; ++ai)
#pragma unroll
            for (int m = 0; m < 4; ++m) { bf16_t* rowp = base + (size_t)(row0 + ai * 128 + m * 16) * ld + col0;
#pragma unroll
                for (int bj = 0; bj < 2; ++bj) { f32x4 v0 = acc[ai][bj][m][0] * inv, v1 = acc[ai][bj][m][1] * inv;
                    if (gate) {
#pragma unroll
                        for (int j = 0; j < 4; ++j) { v0[j] = sigmoid_f(v0[j]); v1[j] = sigmoid_f(v1[j]); } }
                    *(u32x4*)(rowp + bj * 128) = pack8(v0, v1); } }
    }
};
struct EpiPlain {
    static constexpr bool PERM = true, FP8 = false;
    bf16_t* O; int ldc;
    __device__ __forceinline__ void operator()(const Acc& acc, const pg8::Unit& u, int wr, int wc, int fr, int fq) const {
        const int row0 = u.pm * 256 + wr * 64 + fr; const int col0 = u.pn * 256 + wc * 32 + 8 * fq;
#pragma unroll
        for (int ai = 0; ai < 2; ++ai)
#pragma unroll
            for (int m = 0; m < 4; ++m) { bf16_t* rowp = O + (size_t)(row0 + ai * 128 + m * 16) * ldc + col0;
#pragma unroll
                for (int bj = 0; bj < 2; ++bj) *(u32x4*)(rowp + bj * 128) = pack8(acc[ai][bj][m][0], acc[ai][bj][m][1]); }
    }
};
__device__ __forceinline__ void tile_info(int pm, int& b, int& tpos0, bool& lat) { lat = pm < 64; b = lat ? (pm >> 4) : (pm - 64); tpos0 = lat ? CTXL + ((pm & 15) << 8) : 0; }
struct EpiQup {
    static constexpr bool PERM = true, FP8 = false;
    bf16_t* QM; const f32x2* cs32;
    __device__ __forceinline__ void operator()(const Acc& acc, const pg8::Unit& u, int wr, int wc, int fr, int fq) const {
        int b, tpos0; bool lat; tile_info(u.pm, b, tpos0, lat);
        const int r0 = wr * 64 + fr;
#pragma unroll
        for (int bj = 0; bj < 2; ++bj) { const int c0 = u.pn * 256 + bj * 128 + wc * 32 + 8 * fq; const int hh = c0 / 96, j0 = c0 - hh * 96;
            bf16_t* hb = QM + ((size_t)(b * 8 + hh) * TT + tpos0 + r0) * 128;
            if (j0 < 64) {
#pragma unroll
                for (int ai = 0; ai < 2; ++ai)
#pragma unroll
                    for (int m = 0; m < 4; ++m) *(u32x4*)(hb + (ai * 128 + m * 16) * 128 + j0) = pack8(acc[ai][bj][m][0], acc[ai][bj][m][1]);
            } else { const int g8 = (j0 - 64) >> 3, part = g8 >> 1, pbase = (g8 & 1) * 4;
#pragma unroll
                for (int ai = 0; ai < 2; ++ai)
#pragma unroll
                    for (int m = 0; m < 4; ++m) { const int t = tpos0 - CTXL + r0 + ai * 128 + m * 16; const int pos = part ? (t & 63) : (t >> 6);
                        const f32x4 v0 = acc[ai][bj][m][0], v1 = acc[ai][bj][m][1];
                        float o1[4], o2[4]; const float x1[4] = {v0[0], v0[2], v1[0], v1[2]}, x2[4] = {v0[1], v0[3], v1[1], v1[3]};
#pragma unroll
                        for (int p = 0; p < 4; ++p) { const f32x2 cs = lat ? cs32[pos * 8 + pbase + p] : (f32x2){1.f, 0.f};
                            o1[p] = x1[p] * cs.x - x2[p] * cs.y; o2[p] = x1[p] * cs.y + x2[p] * cs.x; }
                        u32x2 w1, w2; w1.x = cvt_pk_bf16(o1[0], o1[1]); w1.y = cvt_pk_bf16(o1[2], o1[3]); w2.x = cvt_pk_bf16(o2[0], o2[1]); w2.y = cvt_pk_bf16(o2[2], o2[3]);
                        bf16_t* dst = hb + (ai * 128 + m * 16) * 128 + 64 + part * 16 + pbase;
                        *(u32x2*)dst = w1; *(u32x2*)(dst + 8) = w2; } } }
    }
};
struct EpiKvup {
    static constexpr bool PERM = true, FP8 = false;
    bf16_t* KM; bf16_t* VM;
    __device__ __forceinline__ void operator()(const Acc& acc, const pg8::Unit& u, int wr, int wc, int fr, int fq) const {
        int b, tpos0; bool lat; tile_info(u.pm, b, tpos0, lat);
        const int r0 = wr * 64 + fr; const int j0 = wc * 32 + 8 * fq;
#pragma unroll
        for (int bj = 0; bj < 2; ++bj) { const size_t tok = (size_t)(b * 8 + u.pn * 2 + bj) * TT + tpos0 + r0;
            if (j0 < 64) { bf16_t* d = KM + tok * 128 + j0;
#pragma unroll
                for (int ai = 0; ai < 2; ++ai)
#pragma unroll
                    for (int m = 0; m < 4; ++m) *(u32x4*)(d + (ai * 128 + m * 16) * 128) = pack8(acc[ai][bj][m][0], acc[ai][bj][m][1]); }
            else { bf16_t* d = VM + tok * 64 + (j0 - 64);
#pragma unroll
                for (int ai = 0; ai < 2; ++ai)
#pragma unroll
                    for (int m = 0; m < 4; ++m) *(u32x4*)(d + (ai * 128 + m * 16) * 64) = pack8(acc[ai][bj][m][0], acc[ai][bj][m][1]); } }
    }
};
template <int SEG> struct EpiMerge {
    static constexpr bool PERM = true, FP8 = false;
    bf16_t* MB; const bf16_t* G; unsigned char* MB8;
    __device__ __forceinline__ void operator()(const Acc& acc, const pg8::Unit& u, int wr, int wc, int fr, int fq) const {
        const int row0 = u.pm * 256 + wr * 64 + fr; const int col0 = u.pn * 256 + wc * 32 + 8 * fq;
        const bf16_t* gp = G + (size_t)row0 * NG + SEG * 2048 + col0; bf16_t* mp = MB + (size_t)row0 * D + col0; unsigned char* m8 = MB8 + (size_t)row0 * D + col0;
#pragma unroll
        for (int ai = 0; ai < 2; ++ai) {
            u32x4 gw[4][2], ow[4][2];
#pragma unroll
            for (int m = 0; m < 4; ++m)
#pragma unroll
                for (int bj = 0; bj < 2; ++bj) { const size_t ro = (size_t)(ai * 128 + m * 16);
                    gw[m][bj] = *(const u32x4*)(gp + ro * NG + bj * 128);
                    if (SEG > 0) ow[m][bj] = __builtin_nontemporal_load((const u32x4*)(mp + ro * D + bj * 128)); }
#pragma unroll
            for (int m = 0; m < 4; ++m)
#pragma unroll
                for (int bj = 0; bj < 2; ++bj) { const size_t ro = (size_t)(ai * 128 + m * 16); const u32x4 g_ = gw[m][bj];
                    f32x4 v0 = acc[ai][bj][m][0], v1 = acc[ai][bj][m][1];
                    if (ABL_BR & (1 << SEG)) { v0 = (f32x4){0.f, 0.f, 0.f, 0.f}; v1 = v0; }
                    v0[0] *= bflo(g_.x); v0[1] *= bfhi(g_.x); v0[2] *= bflo(g_.y); v0[3] *= bfhi(g_.y);
                    v1[0] *= bflo(g_.z); v1[1] *= bfhi(g_.z); v1[2] *= bflo(g_.w); v1[3] *= bfhi(g_.w);
                    if (SEG > 0) { const u32x4 o = ow[m][bj];
                        v0[0] += bflo(o.x); v0[1] += bfhi(o.x); v0[2] += bflo(o.y); v0[3] += bfhi(o.y);
                        v1[0] += bflo(o.z); v1[1] += bfhi(o.z); v1[2] += bflo(o.w); v1[3] += bfhi(o.w); }
                    if (SEG < 2) *(u32x4*)(mp + ro * D + bj * 128) = pack8(v0, v1);
                    else { u32x2 w8; w8.x = pk4_fp8(clamp8(v0[0] * 16.f), clamp8(v0[1] * 16.f), clamp8(v0[2] * 16.f), clamp8(v0[3] * 16.f)); w8.y = pk4_fp8(clamp8(v1[0] * 16.f), clamp8(v1[1] * 16.f), clamp8(v1[2] * 16.f), clamp8(v1[3] * 16.f));
                        *(u32x2*)(m8 + ro * D + bj * 128) = w8; } }
        }
    }
};
namespace pg8 {
struct Merge3 { const bf16_t* A; const bf16_t* B0; const bf16_t* B1; const bf16_t* B2; const bf16_t* G; unsigned char* MB8; float r01, r12, fin; };
template <class Sched>
__device__ __forceinline__ void gemm_merge3(LAS unsigned char* lds, const int tid, const Merge3 g, const Sched& S) {
    const int wid = __builtin_amdgcn_readfirstlane(tid >> 6), lane = tid & 63, wr = wid >> 2, wc = wid & 3, fr = lane & 15, fq = lane >> 4;
    constexpr int NT = 16, LDA = 1024;
    int sc1_ = 0x7F7F7F7F; asm volatile("" : "+v"(sc1_));
    unsigned voffA[2], voffB5[2], voffB10[2];
#pragma unroll
    for (int i = 0; i < 2; ++i) { int R, C; stage_rc(tid * 16 + i * 8192, R, C); const int Rb = (R & ~31) + perm32(R & 31);
        voffA[i] = (unsigned)(R * LDA + C) * 2u; voffB5[i] = (unsigned)(Rb * 256 + C) * 2u; voffB10[i] = (unsigned)(Rb * 512 + C) * 2u; }
    const size_t kstep = (size_t)(BK * 2);
    const size_t hstepA = (size_t)HALF * LDA * 2, tstepA = 2 * hstepA;
    const unsigned ldsw = (unsigned)wid * 1024u;
    const int aoff = lds_byte(wr * 64 + fr, fq * 8), boff = lds_byte(wc * 32 + fr, fq * 8);
#define M3_TA(pm_, t_) ((const char*)g.A + (size_t)(pm_) * tstepA + (size_t)(t_) * kstep)
#define M3_TB(pn_, t_) ((t_) < 4 ? (const char*)g.B0 + (size_t)(pn_) * 131072 + (size_t)(t_) * kstep : ((t_) < 8 ? (const char*)g.B1 + (size_t)(pn_) * 131072 + (size_t)((t_) - 4) * kstep : (const char*)g.B2 + (size_t)(pn_) * 262144 + (size_t)((t_) - 8) * kstep))
#define PG8_SA(b, h) (((b) * 2 + (h)) * HTB)
#define PG8_SB(b, h) ((4 + (b) * 2 + (h)) * HTB)
#define PG8_STAGE(bufoff, gbase, voff) do { _Pragma("unroll") for (int _i = 0; _i < 2; ++_i) \
        __builtin_amdgcn_global_load_lds((const unsigned*)((const char*)(gbase) + (voff)[_i]), (LAS unsigned*)(lds + (bufoff) + ldsw + _i * 8192), 16, 0, 0); } while (0)
#define PG8_LDA(dst, b, h) do { _Pragma("unroll") for (int m = 0; m < 4; ++m) { const i32x4v lo_ = *(const LAS i32x4v*)(lds + PG8_SA(b, h) + aoff + m * 2048), hi_ = *(const LAS i32x4v*)(lds + PG8_SA(b, h) + aoff + m * 2048 + 1024); dst[m] = __builtin_shufflevector(lo_, hi_, 0, 1, 2, 3, 4, 5, 6, 7); } } while (0)
#define PG8_LDB(dst, b, h) do { _Pragma("unroll") for (int n = 0; n < 2; ++n) { const i32x4v lo_ = *(const LAS i32x4v*)(lds + PG8_SB(b, h) + boff + n * 2048), hi_ = *(const LAS i32x4v*)(lds + PG8_SB(b, h) + boff + n * 2048 + 1024); dst[n] = __builtin_shufflevector(lo_, hi_, 0, 1, 2, 3, 4, 5, 6, 7); } } while (0)
#define PG8_MMA(ai, bj, At, Bt) do { __builtin_amdgcn_s_setprio(1); _Pragma("unroll") for (int m = 0; m < 4; ++m) _Pragma("unroll") for (int n = 0; n < 2; ++n) \
        asm volatile("v_mfma_scale_f32_16x16x128_f8f6f4 %0, %1, %2, %0, %3, %3 op_sel_hi:[0,0,0]" : "+v"(acc[ai][bj][m][n]) : "v"(Bt[n]), "v"(At[m]), "v"(sc1_)); __builtin_amdgcn_s_setprio(0); } while (0)
#define PG8_WAIT_V(n) asm volatile("s_waitcnt vmcnt(" #n ")" ::: "memory")
#define PG8_WAIT_L(n) asm volatile("s_waitcnt lgkmcnt(" #n ")" ::: "memory")
#define PG8_BAR __builtin_amdgcn_s_barrier()
#define PG8_SCHED __builtin_amdgcn_sched_barrier(0)
    Unit cur, nxt; int ui = 0;
    if (!S.next(0, cur)) return;
    f32x4 acc[2][2][4][2];
#pragma unroll
    for (int a = 0; a < 2; ++a)
#pragma unroll
        for (int b = 0; b < 2; ++b)
#pragma unroll
            for (int m = 0; m < 4; ++m)
#pragma unroll
                for (int n = 0; n < 2; ++n) acc[a][b][m][n] = (f32x4){0.f, 0.f, 0.f, 0.f};
    i32x8 At[4], B0[2], B1[2];
    { const char* cA = M3_TA(cur.pm, 0); const char* cB = M3_TB(cur.pn, 0); const size_t hB = 65536;
      PG8_STAGE(PG8_SB(0, 0), cB, voffB5); PG8_STAGE(PG8_SA(0, 0), cA, voffA); PG8_STAGE(PG8_SB(0, 1), cB + hB, voffB5); PG8_STAGE(PG8_SA(0, 1), cA + hstepA, voffA);
      if (wr == 1) PG8_BAR;
      PG8_WAIT_V(4); PG8_BAR;
      PG8_STAGE(PG8_SB(1, 0), cB + kstep, voffB5); PG8_STAGE(PG8_SA(1, 0), cA + kstep, voffA); PG8_STAGE(PG8_SB(1, 1), cB + hB + kstep, voffB5);
      PG8_WAIT_V(6); PG8_BAR; }
    const int r0 = wr * 64 + fr, c0l = wc * 32 + 8 * fq;
    for (;;) {
        const bool has_next = S.next(ui + 1, nxt);
        const int npm = has_next ? nxt.pm : cur.pm, npn = has_next ? nxt.pn : cur.pn;
#pragma unroll 1
        for (int t = 0; t < NT; t += 2) {
            const bool last = (t == NT - 2);
            const int t2 = last ? 0 : t + 2;
            const char* a1 = M3_TA(cur.pm, t + 1);
            const char* a2 = last ? M3_TA(npm, 0) : M3_TA(cur.pm, t + 2); const char* b2 = last ? M3_TB(npn, 0) : M3_TB(cur.pn, t + 2);
            const char* a3 = a2 + kstep; const char* b3 = b2 + kstep;
            const bool wide = t2 >= 8; const size_t hB = wide ? 131072 : 65536;
            unsigned vB[2]; vB[0] = wide ? voffB10[0] : voffB5[0]; vB[1] = wide ? voffB10[1] : voffB5[1];
            PG8_LDB(B0, 0, 0); PG8_SCHED; PG8_LDA(At, 0, 0); PG8_STAGE(PG8_SA(1, 1), a1 + hstepA, voffA);
            PG8_WAIT_L(8); PG8_BAR; PG8_WAIT_L(0); PG8_MMA(0, 0, At, B0); PG8_BAR; PG8_SCHED;
            PG8_LDB(B1, 0, 1); PG8_STAGE(PG8_SB(0, 0), b2, vB);
            PG8_BAR; PG8_WAIT_L(0); PG8_MMA(0, 1, At, B1); PG8_BAR;
            PG8_LDA(At, 0, 1); PG8_STAGE(PG8_SA(0, 0), a2, voffA);
            PG8_BAR; PG8_WAIT_L(0); PG8_MMA(1, 0, At, B0); PG8_BAR; PG8_SCHED;
            PG8_STAGE(PG8_SB(0, 1), b2 + hB, vB);
            PG8_WAIT_V(6); PG8_BAR; PG8_MMA(1, 1, At, B1); PG8_BAR;
            PG8_LDB(B0, 1, 0); PG8_SCHED; PG8_LDA(At, 1, 0); PG8_STAGE(PG8_SA(0, 1), a2 + hstepA, voffA);
            PG8_WAIT_L(8); PG8_BAR; PG8_WAIT_L(0); PG8_MMA(0, 0, At, B0); PG8_BAR; PG8_SCHED;
            PG8_LDB(B1, 1, 1); PG8_STAGE(PG8_SB(1, 0), b3, vB);
            PG8_BAR; PG8_WAIT_L(0); PG8_MMA(0, 1, At, B1); PG8_BAR;
            PG8_LDA(At, 1, 1); PG8_STAGE(PG8_SA(1, 0), a3, voffA);
            PG8_BAR; PG8_WAIT_L(0); PG8_MMA(1, 0, At, B0); PG8_BAR; PG8_SCHED;
            PG8_STAGE(PG8_SB(1, 1), b3 + hB, vB);
            PG8_WAIT_V(6); PG8_BAR; PG8_MMA(1, 1, At, B1); PG8_BAR;
            if (t == 2 || t == 6) {
                asm volatile("s_nop 15\n\ts_nop 15" ::: "memory");
                const int sg = t == 2 ? 0 : 1; const float wr_ = sg ? g.r12 : g.r01;
                const bf16_t* gp = g.G + (size_t)(cur.pm * 256 + r0) * NG + sg * 2048 + cur.pn * 256 + c0l;
#pragma unroll
                for (int ai = 0; ai < 2; ++ai) { u32x4 ga[4][2], gb[4][2];
#pragma unroll
                    for (int m = 0; m < 4; ++m)
#pragma unroll
                        for (int bj = 0; bj < 2; ++bj) { const bf16_t* q_ = gp + (size_t)(ai * 128 + m * 16) * NG + bj * 128; ga[m][bj] = *(const u32x4*)q_; gb[m][bj] = *(const u32x4*)(q_ + 2048); }
#pragma unroll
                    for (int m = 0; m < 4; ++m)
#pragma unroll
                        for (int bj = 0; bj < 2; ++bj) { const u32x4 x_ = ga[m][bj], y_ = gb[m][bj];
#define M3_RT(xw, yw, lohi) (fmaxf(lohi(xw), 1e-6f) * wr_ * __builtin_amdgcn_rcpf(fmaxf(lohi(yw), 1e-6f)))
                            acc[ai][bj][m][0][0] *= M3_RT(x_.x, y_.x, bflo); acc[ai][bj][m][0][1] *= M3_RT(x_.x, y_.x, bfhi); acc[ai][bj][m][0][2] *= M3_RT(x_.y, y_.y, bflo); acc[ai][bj][m][0][3] *= M3_RT(x_.y, y_.y, bfhi);
                            acc[ai][bj][m][1][0] *= M3_RT(x_.z, y_.z, bflo); acc[ai][bj][m][1][1] *= M3_RT(x_.z, y_.z, bfhi); acc[ai][bj][m][1][2] *= M3_RT(x_.w, y_.w, bflo); acc[ai][bj][m][1][3] *= M3_RT(x_.w, y_.w, bfhi); } }
                asm volatile("s_waitcnt vmcnt(0)" ::: "memory");
            }
        }
        asm volatile("s_nop 15\n\ts_nop 15" ::: "memory");
        { const bf16_t* gp = g.G + (size_t)(cur.pm * 256 + r0) * NG + 2 * 2048 + cur.pn * 256 + c0l; unsigned char* m8 = g.MB8 + (size_t)(cur.pm * 256 + r0) * D + cur.pn * 256 + c0l;
#pragma unroll
          for (int ai = 0; ai < 2; ++ai) { u32x4 gc[4][2];
#pragma unroll
              for (int m = 0; m < 4; ++m)
#pragma unroll
                  for (int bj = 0; bj < 2; ++bj) gc[m][bj] = *(const u32x4*)(gp + (size_t)(ai * 128 + m * 16) * NG + bj * 128);
#pragma unroll
              for (int m = 0; m < 4; ++m)
#pragma unroll
                  for (int bj = 0; bj < 2; ++bj) { const u32x4 z_ = gc[m][bj]; const f32x4 v0 = acc[ai][bj][m][0], v1 = acc[ai][bj][m][1];
                      u32x2 w8; const float f_ = g.fin;
                      w8.x = pk4_fp8(clamp8(v0[0] * fmaxf(bflo(z_.x), 1e-6f) * f_), clamp8(v0[1] * fmaxf(bfhi(z_.x), 1e-6f) * f_), clamp8(v0[2] * fmaxf(bflo(z_.y), 1e-6f) * f_), clamp8(v0[3] * fmaxf(bfhi(z_.y), 1e-6f) * f_));
                      w8.y = pk4_fp8(clamp8(v1[0] * fmaxf(bflo(z_.z), 1e-6f) * f_), clamp8(v1[1] * fmaxf(bfhi(z_.z), 1e-6f) * f_), clamp8(v1[2] * fmaxf(bflo(z_.w), 1e-6f) * f_), clamp8(v1[3] * fmaxf(bfhi(z_.w), 1e-6f) * f_));
                      *(u32x2*)(m8 + (size_t)(ai * 128 + m * 16) * D + bj * 128) = w8; } } }
        if (!has_next) break;
#pragma unroll
        for (int a = 0; a < 2; ++a)
#pragma unroll
            for (int b = 0; b < 2; ++b)
#pragma unroll
                for (int m = 0; m < 4; ++m)
#pragma unroll
                    for (int n = 0; n < 2; ++n) acc[a][b][m][n] = (f32x4){0.f, 0.f, 0.f, 0.f};
        cur = nxt; ++ui;
    }
    PG8_WAIT_V(0);
    if (wr == 0) PG8_BAR;
    PG8_BAR;
#undef M3_RT
#undef M3_TA
#undef M3_TB
#undef PG8_SA
#undef PG8_SB
#undef PG8_STAGE
#undef PG8_LDA
#undef PG8_LDB
#undef PG8_MMA
#undef PG8_WAIT_V
#undef PG8_WAIT_L
#undef PG8_BAR
#undef PG8_SCHED
}
}
struct EpiOut {
    static constexpr bool PERM = false, FP8 = true;
    const float* src_lat; const float* src_ctx; float* dst_lat; float* dst_ctx; const float* g1; float inv;
    __device__ __forceinline__ void operator()(const Acc& acc, const pg8::Unit& u, int wr, int wc, int fr, int fq) const {
        const int row0 = u.pm * 256 + wr * 64 + fr; const int col0 = u.pn * 256 + wc * 32 + 4 * fq;
        const bool lat = (u.pm * 256) < NLAT;
        const float* src = (lat ? src_lat : src_ctx - (size_t)NLAT * D) + (size_t)row0 * D + col0; float* dst = (lat ? dst_lat : dst_ctx - (size_t)NLAT * D) + (size_t)row0 * D + col0;
#pragma unroll
        for (int ai = 0; ai < 2; ++ai) { const int rbase = u.pm * 256 + ai * 128 + wr * 64; const int v = lat ? (rbase >> 12) : 4; const float* gp = g1 + (size_t)v * 12288 + col0;
            f32x4 gg[2][2];
#pragma unroll
            for (int bj = 0; bj < 2; ++bj)
#pragma unroll
                for (int n = 0; n < 2; ++n) gg[bj][n] = *(const f32x4*)(gp + bj * 128 + n * 16);
#pragma unroll
            for (int mh = 0; mh < 2; ++mh) {
                f32x4 xr[2][2][2];
#pragma unroll
                for (int mm = 0; mm < 2; ++mm)
#pragma unroll
                    for (int bj = 0; bj < 2; ++bj)
#pragma unroll
                        for (int n = 0; n < 2; ++n) xr[mm][bj][n] = __builtin_nontemporal_load((const f32x4*)(src + (size_t)(ai * 128 + (mh * 2 + mm) * 16) * D + bj * 128 + n * 16));
#pragma unroll
                for (int mm = 0; mm < 2; ++mm)
#pragma unroll
                    for (int bj = 0; bj < 2; ++bj)
#pragma unroll
                        for (int n = 0; n < 2; ++n) { const int m = mh * 2 + mm;
                            *(f32x4*)(dst + (size_t)(ai * 128 + m * 16) * D + bj * 128 + n * 16) = ABL_MIX ? xr[mm][bj][n] * ALPHA : xr[mm][bj][n] * ALPHA + gg[bj][n] * (acc[ai][bj][m][n] * inv); } } }
    }
};

struct Args { const float* in[27]; float* out; unsigned char* ws; int ph_lo, ph_hi; };
typedef const Args __attribute__((address_space(4)))* ArgP;
struct Frame {
    LAS unsigned char* lds; int tid, lane, wave, G, bid;
    ArgP ap; float* out; unsigned char* ws;
    __device__ __forceinline__ const float* in(int i) const { return ap->in[i]; }
};
__device__ __forceinline__ Frame make_frame(ArgP ap) {
    { unsigned long long t = (unsigned long long)ap; asm volatile("" : "+s"(t)); ap = (ArgP)t; }
    extern __shared__ __attribute__((aligned(16))) unsigned char lds_raw[];
    Frame F; F.lds = (LAS unsigned char*)lds_raw; { int t_ = threadIdx.x; asm volatile("" : "+v"(t_)); F.tid = t_; }
    F.lane = F.tid & 63; F.wave = __builtin_amdgcn_readfirstlane(F.tid >> 6); F.G = gridDim.x; F.bid = blockIdx.x;
    F.ap = ap; F.out = ap->out; F.ws = ap->ws; return F;
}
template <class T> __device__ __forceinline__ T* wsp(const Frame& F, size_t off) { return (T*)(F.ws + off); }

__device__ __forceinline__ int win_col(int n) {
    if (n < 768) return n;
    if (n < 1792) return 2336 + (n - 768);
    if (n < 2048) return 3360 + (n - 1792);
    if (n < 2304) return 3616 + (n - 2048);
    if (n < 2560) return 800 + (n - 2304);
    if (n < 2816) return 1056 + (n - 2560);
    if (n < 3328) return 1312 + (n - 2816);
    if (n < 3840) return 1824 + (n - 3328);
    if (n < 3872) return 768 + (n - 3840);
    if (n < 4096) return -1;
    return 3872 + (n - 4096);
}
__device__ __forceinline__ int qup_col(int c) {
    const int hh = c / 96, j = c - hh * 96;
    if (j < 64) return c;
    const int jj = j - 64, g8 = jj >> 3, i = jj & 7, p = i >> 1, which = i & 1, part = g8 >> 1, pi = (g8 & 1) * 4 + p;
    return hh * 96 + 64 + part * 16 + which * 8 + pi;
}
template <int MAP>
__device__ __forceinline__ void transpose_cvt(const Frame& F, const float* __restrict__ src, bf16_t* __restrict__ dst, int K, int Nsrc, int Nd) {
    LAS float* tile = (LAS float*)F.lds;
    const int tk = K / 256, tn = Nd / 64, ntile = tk * tn;
    for (int t = F.bid; t < ntile; t += F.G) {
        const int k0 = (t % tk) * 256, n0 = (t / tk) * 64;
        const int nl = F.tid & 63, kq = F.tid >> 6;
        const int nd = n0 + nl; const int ns = MAP == 0 ? nd : (MAP == 1 ? win_col(nd) : qup_col(nd));
        float v[32];
#pragma unroll
        for (int i = 0; i < 32; ++i) v[i] = ns >= 0 ? src[(size_t)(k0 + kq + 8 * i) * Nsrc + ns] : 0.f;
#pragma unroll
        for (int i = 0; i < 32; ++i) tile[(kq + 8 * i) * 65 + nl] = v[i];
        __syncthreads();
        { const int n = F.tid >> 3, k32 = (F.tid & 7) * 32;
#pragma unroll
          for (int c = 0; c < 4; ++c) { float w[8];
#pragma unroll
              for (int j = 0; j < 8; ++j) w[j] = tile[(k32 + c * 8 + j) * 65 + n];
              u32x4 o; o.x = cvt_pk_bf16(w[0], w[1]); o.y = cvt_pk_bf16(w[2], w[3]); o.z = cvt_pk_bf16(w[4], w[5]); o.w = cvt_pk_bf16(w[6], w[7]);
              *(u32x4*)(dst + (size_t)(n0 + n) * K + k0 + k32 + c * 8) = o; } }
        __syncthreads();
    }
}
__device__ __forceinline__ void cvt_rows(const Frame& F, const float* __restrict__ src, bf16_t* __restrict__ dst, size_t n8) {
    for (size_t i = (size_t)F.bid * 512 + F.tid; i < n8; i += (size_t)F.G * 512) {
        const f32x4 a = __builtin_nontemporal_load((const f32x4*)(src + i * 8)), b = __builtin_nontemporal_load((const f32x4*)(src + i * 8 + 4));
        *(u32x4*)(dst + i * 8) = pack8(a, b);
    }
}
__device__ __forceinline__ void cvt_peer(const Frame& F, int l);
__device__ __forceinline__ void absmax_f32(const Frame& F, const float* __restrict__ src, size_t n4, unsigned* dst) {
    float am = 0.f;
    const size_t stride = (size_t)F.G * 512; size_t i = (size_t)F.bid * 512 + F.tid;
    for (; i + 7 * stride < n4; i += 8 * stride) { f32x4 a[8];
#pragma unroll
        for (int j = 0; j < 8; ++j) a[j] = __builtin_nontemporal_load((const f32x4*)(src + (i + j * stride) * 4));
#pragma unroll
        for (int j = 0; j < 8; ++j) am = fmaxf(fmaxf(fmaxf(am, fabsf(a[j][0])), fabsf(a[j][1])), fmaxf(fabsf(a[j][2]), fabsf(a[j][3]))); }
    for (; i < n4; i += stride) { const f32x4 a = *(const f32x4*)(src + i * 4); am = fmaxf(fmaxf(fmaxf(am, fabsf(a[0])), fabsf(a[1])), fmaxf(fabsf(a[2]), fabsf(a[3]))); }
    am = row16_max(am);
    { auto r = __builtin_amdgcn_permlane16_swap(__float_as_uint(am), __float_as_uint(am), false, false); am = fmaxf(__uint_as_float(r[0]), __uint_as_float(r[1])); }
    { auto r = __builtin_amdgcn_permlane32_swap(__float_as_uint(am), __float_as_uint(am), false, false); am = fmaxf(__uint_as_float(r[0]), __uint_as_float(r[1])); }
    if (F.lane == 0) atomicMax(dst, __float_as_uint(am));
}
template <int MAP>
__device__ __forceinline__ void transpose_fp8(const Frame& F, const float* __restrict__ src, unsigned char* __restrict__ dst, int K, int Nsrc, int Nd, const unsigned* wsc) {
    float mul, inv; fp8_scale(__hip_atomic_load(wsc, __ATOMIC_RELAXED, __HIP_MEMORY_SCOPE_AGENT), mul, inv);
    LAS float* tile = (LAS float*)F.lds;
    const int tk = K / 256, tn = Nd / 64, ntile = tk * tn;
    for (int t = F.bid; t < ntile; t += F.G) {
        const int k0 = (t % tk) * 256, n0 = (t / tk) * 64;
        const int nl = F.tid & 63, kq = F.tid >> 6; const int ns = MAP ? win_col(n0 + nl) : n0 + nl;
        float v[32];
#pragma unroll
        for (int i = 0; i < 32; ++i) v[i] = ns >= 0 ? src[(size_t)(k0 + kq + 8 * i) * Nsrc + ns] : 0.f;
#pragma unroll
        for (int i = 0; i < 32; ++i) tile[(kq + 8 * i) * 65 + nl] = v[i] * mul;
        __syncthreads();
        { const int n = F.tid >> 3, k32 = (F.tid & 7) * 32;
#pragma unroll
          for (int c = 0; c < 2; ++c) { float w[16];
#pragma unroll
              for (int j = 0; j < 16; ++j) w[j] = tile[(k32 + c * 16 + j) * 65 + n];
              u32x4 o; o.x = pk4_fp8(w[0], w[1], w[2], w[3]); o.y = pk4_fp8(w[4], w[5], w[6], w[7]); o.z = pk4_fp8(w[8], w[9], w[10], w[11]); o.w = pk4_fp8(w[12], w[13], w[14], w[15]);
              *(u32x4*)(dst + (size_t)(n0 + n) * K + k0 + k32 + c * 16) = o; } }
        __syncthreads();
    }
}
__device__ __forceinline__ void p0_prologue(const Frame& F) {
    { const int gi = F.bid * 512 + F.tid;
      if (gi < 64 * 8) { const int pos = gi >> 3, f = gi & 7; const float inv = powf(10000.f, -(float)f / 8.f); const float a = (float)pos * inv; wsp<f32x2>(F, WS_ROPE32)[gi] = (f32x2){cosf(a), sinf(a)}; }
      else if (gi < 64 * 8 + 64 * 32) { const int g2 = gi - 512; const int pos = g2 >> 5, f = g2 & 31; const float inv = powf(10000.f, -(float)f / 32.f); const float a = (float)pos * inv; wsp<f32x2>(F, WS_ROPE128)[g2] = (f32x2){cosf(a), sinf(a)}; } }
    if (F.bid == 0 && F.tid < 32) wsp<float>(F, WS_DEC)[F.tid] = -log1pf(expf(-F.in(11)[F.tid])) * LOG2E;
    { LAS float* sl = (LAS float*)F.lds;
      float* modp = wsp<float>(F, WS_MODP);
      for (int u = F.bid; u < 2 * 24 * 16; u += F.G) {
          const int kc = u & 15, cb = (u >> 4) % 24, l = u / (16 * 24);
          __syncthreads();
          for (int i = F.tid; i < 640; i += 512) { const int v = i >> 7, k = kc * 128 + (i & 127); const float c = v < 4 ? F.in(1)[v * 2048 + k] : F.in(3)[k]; sl[i] = silu_f(c); }
          __syncthreads();
          const int col = cb * 512 + F.tid; const float* w = F.in(4) + ((size_t)l * 2048 + kc * 128) * 12288 + col;
          float a0 = 0.f, a1 = 0.f, a2 = 0.f, a3 = 0.f, a4 = 0.f;
#pragma unroll 32
          for (int k = 0; k < 128; ++k) { const float wv = w[(size_t)k * 12288]; a0 += sl[k] * wv; a1 += sl[128 + k] * wv; a2 += sl[256 + k] * wv; a3 += sl[384 + k] * wv; a4 += sl[512 + k] * wv; }
          float* o = modp + ((size_t)(kc * 2 + l) * 5) * 12288 + col;
          o[0] = a0; o[12288] = a1; o[2 * 12288] = a2; o[3 * 12288] = a3; o[4 * 12288] = a4;
      }
      __syncthreads(); }
    for (int l = 0; l < 2; ++l) {
        absmax_f32(F, F.in(6) + (size_t)l * 2048 * NIN, (size_t)2048 * NIN / 4, wsp<unsigned>(F, WS_WSC) + l);
        transpose_cvt<2>(F, F.in(8) + (size_t)l * 512 * 768, wsp<bf16_t>(F, WS_WQUP + l * SZ_WQUP), 512, 768, 768);
        transpose_cvt<0>(F, F.in(10) + (size_t)l * 256 * 1024, wsp<bf16_t>(F, WS_WKVUP + l * SZ_WKVUP), 256, 1024, 1024);
        absmax_f32(F, F.in(14) + (size_t)l * 512 * 2048, (size_t)512 * 2048 / 4, wsp<unsigned>(F, WS_WSC) + 4 + l);
        absmax_f32(F, F.in(15) + (size_t)l * 512 * 2048, (size_t)512 * 2048 / 4, wsp<unsigned>(F, WS_WSC) + 6 + l);
        absmax_f32(F, F.in(16) + (size_t)l * 1024 * 2048, (size_t)1024 * 2048 / 4, wsp<unsigned>(F, WS_WSC) + 8 + l);
        absmax_f32(F, F.in(17) + (size_t)l * 2048 * 2048, (size_t)2048 * 2048 / 4, wsp<unsigned>(F, WS_WSC) + 2 + l);
        transpose_cvt<0>(F, F.in(20) + (size_t)l * 2048 * 1024, wsp<bf16_t>(F, WS_WPQ + l * SZ_WPQ), 2048, 1024, 1024);
    }
    cvt_peer(F, 0);
}
__device__ __forceinline__ void p1_modreduce(const Frame& F) {
    const float* modp = wsp<float>(F, WS_MODP); float* mod = wsp<float>(F, WS_MOD);
    for (int i = F.bid * 512 + F.tid; i < 2 * 5 * 12288; i += F.G * 512) {
        const int j = i % 12288, l = i / (5 * 12288);
        float s = F.in(5)[l * 12288 + j];
#pragma unroll
        for (int kc = 0; kc < 16; ++kc) s += modp[(size_t)kc * (2 * 5 * 12288) + i];
        mod[i] = s;
    }
    for (int l = 0; l < 2; ++l) {
        transpose_fp8<1>(F, F.in(6) + (size_t)l * 2048 * NIN, wsp<unsigned char>(F, WS_WIN + l * SZ_WIN), 2048, NIN, NPT, wsp<unsigned>(F, WS_WSC) + l);
        transpose_fp8<0>(F, F.in(17) + (size_t)l * 2048 * 2048, wsp<unsigned char>(F, WS_WOUT + l * SZ_WOUT), 2048, 2048, 2048, wsp<unsigned>(F, WS_WSC) + 2 + l);
        transpose_fp8<0>(F, F.in(14) + (size_t)l * 512 * 2048, wsp<unsigned char>(F, WS_WBRA + l * SZ_WBRA), 512, 2048, 2048, wsp<unsigned>(F, WS_WSC) + 4 + l);
        transpose_fp8<0>(F, F.in(15) + (size_t)l * 512 * 2048, wsp<unsigned char>(F, WS_WBRB + l * SZ_WBRB), 512, 2048, 2048, wsp<unsigned>(F, WS_WSC) + 6 + l);
        transpose_fp8<0>(F, F.in(16) + (size_t)l * 1024 * 2048, wsp<unsigned char>(F, WS_WBRC + l * SZ_WBRC), 1024, 2048, 2048, wsp<unsigned>(F, WS_WSC) + 8 + l);
    }
}
__device__ __forceinline__ void ld_row_f32(const float* p, int lane, float (&x)[32]) {
#pragma unroll
    for (int q = 0; q < 4; ++q) { const f32x4 a = *(const f32x4*)(p + 512 * q + 8 * lane), b = *(const f32x4*)(p + 512 * q + 8 * lane + 4);
        x[q * 8 + 0] = a[0]; x[q * 8 + 1] = a[1]; x[q * 8 + 2] = a[2]; x[q * 8 + 3] = a[3]; x[q * 8 + 4] = b[0]; x[q * 8 + 5] = b[1]; x[q * 8 + 6] = b[2]; x[q * 8 + 7] = b[3]; }
}
__device__ __forceinline__ void st_row_f32(float* p, int lane, const float (&x)[32]) {
#pragma unroll
    for (int q = 0; q < 4; ++q) { *(f32x4*)(p + 512 * q + 8 * lane) = (f32x4){x[q * 8 + 0], x[q * 8 + 1], x[q * 8 + 2], x[q * 8 + 3]}; *(f32x4*)(p + 512 * q + 8 * lane + 4) = (f32x4){x[q * 8 + 4], x[q * 8 + 5], x[q * 8 + 6], x[q * 8 + 7]}; }
}
__device__ __forceinline__ void st_row_bf16(bf16_t* p, int lane, const float (&x)[32]) {
#pragma unroll
    for (int q = 0; q < 4; ++q) { u32x4 w; w.x = cvt_pk_bf16(x[q * 8 + 0], x[q * 8 + 1]); w.y = cvt_pk_bf16(x[q * 8 + 2], x[q * 8 + 3]); w.z = cvt_pk_bf16(x[q * 8 + 4], x[q * 8 + 5]); w.w = cvt_pk_bf16(x[q * 8 + 6], x[q * 8 + 7]);
        *(u32x4*)(p + 512 * q + 8 * lane) = w; }
}
__device__ __forceinline__ void p_modulate0(const Frame& F) {
    const float* mod = wsp<float>(F, WS_MOD); unsigned char* hb8 = wsp<unsigned char>(F, WS_HB8);
    for (int row = F.bid * 8 + F.wave; row < NROW; row += F.G * 8) {
        const RowInfo ri = rowinfo(row);
        const float* xp = ri.lat ? F.in(0) + (size_t)row * D : F.in(2) + (size_t)(row - NLAT) * D;
        const float* mp = mod + (size_t)ri.v * 12288;
        float x[32], sh[32], sc[32];
        ld_row_f32(xp, F.lane, x); ld_row_f32(mp, F.lane, sh); ld_row_f32(mp + 2048, F.lane, sc);
#pragma unroll
        for (int i = 0; i < 32; ++i) x[i] = clamp8(x[i] * (1.f + sc[i]) + sh[i]);
#pragma unroll
        for (int q = 0; q < 4; ++q) { u32x2 w; w.x = pk4_fp8(x[q * 8 + 0], x[q * 8 + 1], x[q * 8 + 2], x[q * 8 + 3]); w.y = pk4_fp8(x[q * 8 + 4], x[q * 8 + 5], x[q * 8 + 6], x[q * 8 + 7]); *(u32x2*)(hb8 + (size_t)row * D + 512 * q + 8 * F.lane) = w; }
    }
}
__device__ __forceinline__ void p_post(const Frame& F, int l) {
    const bf16_t* P1 = wsp<bf16_t>(F, WS_P1);
    bf16_t* CQN = wsp<bf16_t>(F, WS_CQN); bf16_t* CKVN = wsp<bf16_t>(F, WS_CKVN);
    bf16_t* QG = wsp<bf16_t>(F, WS_QG); bf16_t* KG = wsp<bf16_t>(F, WS_KG); bf16_t* VG = wsp<bf16_t>(F, WS_VG);
    bf16_t* RQ = wsp<bf16_t>(F, WS_RQ); bf16_t* RK = wsp<bf16_t>(F, WS_RK); bf16_t* RV = wsp<bf16_t>(F, WS_RV);
    bf16_t* KM = wsp<bf16_t>(F, WS_KM);
    const f32x2* cs32 = wsp<f32x2>(F, WS_ROPE32); const f32x2* cs128 = wsp<f32x2>(F, WS_ROPE128);
    const float* gq_n = F.in(7) + l * 512; const float* gkv_n = F.in(9) + l * 256; const float* gqa_qn = F.in(12) + l * 128; const float* gqa_kn = F.in(13) + l * 128;
    LAS bf16_t* rs = (LAS bf16_t*)(F.lds + F.wave * 8192);
    const int lane = F.lane;
    const f32x4 gq0 = *(const f32x4*)(gq_n + lane * 8), gq1 = *(const f32x4*)(gq_n + lane * 8 + 4), gkv0 = *(const f32x4*)(gkv_n + lane * 4);
    const int gd0 = 2 * lane; const int gpart = gd0 >> 6, gdd = gd0 & 63; const bool glo = gdd < 32; const int gf = glo ? gdd : gdd - 32; const int gdp = glo ? gd0 + 32 : gd0 - 32;
    const float qn0 = gqa_qn[gd0], qn1 = gqa_qn[gd0 + 1], qnp0 = gqa_qn[gdp], qnp1 = gqa_qn[gdp + 1];
    const float kn0 = gqa_kn[gd0], kn1 = gqa_kn[gd0 + 1], knp0 = gqa_kn[gdp], knp1 = gqa_kn[gdp + 1];
    const int rhh = lane >> 3, rd0 = (lane & 7) * 4; const int rpart = rd0 >> 4, rdd = rd0 & 15; const bool rlo = rdd < 8; const int rf = rlo ? rdd : rdd - 8; const int rdp = rlo ? rd0 + 8 : rd0 - 8;
    const int step = F.G * 8;
    int row = F.bid * 8 + F.wave;
    u32x4 pre[8];
    if (row < NROW) {
#pragma unroll
        for (int q = 0; q < 8; ++q) pre[q] = *(const u32x4*)(P1 + (size_t)row * NP1 + q * 512 + lane * 8); }
#pragma unroll 1
    for (; row < NROW; row += step) {
        const RowInfo ri = rowinfo(row);
        const int posg = gpart ? ri.pc : ri.pr, posr = rpart ? ri.pc : ri.pr;
        const f32x2 one = {1.f, 0.f};
        const f32x2 csA = ri.lat ? cs128[posg * 32 + gf] : one, csB = ri.lat ? cs128[posg * 32 + gf + 1] : one;
        f32x2 cs[4];
#pragma unroll
        for (int i = 0; i < 4; ++i) cs[i] = ri.lat ? cs32[posr * 8 + rf + i] : one;
#pragma unroll
        for (int q = 0; q < 8; ++q) *(LAS u32x4*)(rs + q * 512 + lane * 8) = pre[q];
        { const int nrow = row + step; if (nrow < NROW) {
#pragma unroll
            for (int q = 0; q < 8; ++q) pre[q] = *(const u32x4*)(P1 + (size_t)nrow * NP1 + q * 512 + lane * 8); } }
        asm volatile("s_waitcnt lgkmcnt(0)" ::: "memory");
        { float x[8]; float ss = 0.f;
#pragma unroll
          for (int i = 0; i < 8; ++i) { x[i] = bf2f(rs[C_CQ + lane * 8 + i]); ss += x[i] * x[i]; }
          ss = wave_sum(ss); const float r = rsqrtf(ss * (1.f / 512.f) + RMS_EPS);
          *(u32x4*)(CQN + (size_t)row * 512 + lane * 8) = pack8((f32x4){x[0] * r * gq0[0], x[1] * r * gq0[1], x[2] * r * gq0[2], x[3] * r * gq0[3]}, (f32x4){x[4] * r * gq1[0], x[5] * r * gq1[1], x[6] * r * gq1[2], x[7] * r * gq1[3]}); }
        { float x[4]; float ss = 0.f;
#pragma unroll
          for (int i = 0; i < 4; ++i) { x[i] = bf2f(rs[C_CKV + lane * 4 + i]); ss += x[i] * x[i]; }
          ss = wave_sum(ss); const float r = rsqrtf(ss * (1.f / 256.f) + RMS_EPS);
          u32x2 w; w.x = cvt_pk_bf16(x[0] * r * gkv0[0], x[1] * r * gkv0[1]); w.y = cvt_pk_bf16(x[2] * r * gkv0[2], x[3] * r * gkv0[3]);
          *(u32x2*)(CKVN + (size_t)row * 256 + lane * 4) = w; }
        {
            const int d0 = gd0, dp = gdp; const bool lo = glo;
#pragma unroll 1
            for (int hh = 0; hh < 10; ++hh) {
                const bool isq = hh < 8; const int cbase = isq ? C_GQ + hh * 128 : C_GK + (hh - 8) * 128;
                const float g0 = isq ? qn0 : kn0, g1 = isq ? qn1 : kn1, gp0 = isq ? qnp0 : knp0, gp1 = isq ? qnp1 : knp1;
                const float a0 = bf2f(rs[cbase + d0]), a1 = bf2f(rs[cbase + d0 + 1]);
                float ss = wave_sum(a0 * a0 + a1 * a1); const float r = rsqrtf(ss * (1.f / 128.f) + RMS_EPS);
                const float n0 = a0 * r * g0, n1 = a1 * r * g1;
                const float p0 = bf2f(rs[cbase + dp]) * r * gp0, p1 = bf2f(rs[cbase + dp + 1]) * r * gp1;
                float o0, o1;
                if (lo) { o0 = n0 * csA.x - p0 * csA.y; o1 = n1 * csB.x - p1 * csB.y; }
                else    { o0 = p0 * csA.y + n0 * csA.x; o1 = p1 * csB.y + n1 * csB.x; }
                bf16_t* dst = isq ? QG + ((size_t)(ri.b * 8 + hh) * TT + ri.tpos) * 128 : KG + ((size_t)(ri.b * 2 + (hh - 8)) * TT + ri.tpos) * 128;
                *(unsigned*)(dst + d0) = cvt_pk_bf16(o0, o1);
            }
#pragma unroll
            for (int hh = 0; hh < 2; ++hh) *(unsigned*)(VG + ((size_t)(ri.b * 2 + hh) * TT + ri.tpos) * 128 + d0) = *(LAS unsigned*)(rs + C_GV + hh * 128 + d0);
        }
        {
            const int hh = rhh, d0 = rd0, dp = rdp; const bool lo = rlo;
#pragma unroll
            for (int which = 0; which < 2; ++which) {
                const int cbase = (which ? C_RK : C_RQ) + hh * 32; const float sc = which ? 0.17677669529663687f : 1.f;
                float o[4];
#pragma unroll
                for (int i = 0; i < 4; ++i) { const float n = bf2f(rs[cbase + d0 + i]), p = bf2f(rs[cbase + dp + i]);
                    o[i] = (lo ? (n * cs[i].x - p * cs[i].y) : (p * cs[i].y + n * cs[i].x)) * sc; }
                u32x2 w; w.x = cvt_pk_bf16(o[0], o[1]); w.y = cvt_pk_bf16(o[2], o[3]);
                *(u32x2*)((which ? RK : RQ) + ((size_t)(ri.b * 8 + hh) * TT + ri.tpos) * 32 + d0) = w;
            }
            { const int vh = lane >> 3, e0 = (lane & 7) * 8;
              *(u32x4*)(RV + ((size_t)(ri.b * 8 + vh) * TT + ri.tpos) * 64 + e0) = *(LAS u32x4*)(rs + C_RV + lane * 8); }
            { float o[4];
#pragma unroll
              for (int i = 0; i < 4; ++i) { const float n = bf2f(rs[C_KR + d0 + i]), p = bf2f(rs[C_KR + dp + i]); o[i] = lo ? (n * cs[i].x - p * cs[i].y) : (p * cs[i].y + n * cs[i].x); }
              u32x2 w; w.x = cvt_pk_bf16(o[0], o[1]); w.y = cvt_pk_bf16(o[2], o[3]);
              *(u32x2*)(KM + ((size_t)(ri.b * 8 + hh) * TT + ri.tpos) * 128 + 64 + d0) = w; }
        }
        asm volatile("s_waitcnt lgkmcnt(0)" ::: "memory");
    }
}

__device__ __forceinline__ void ret_logs(const Frame& F, int l, int h, float& lgf, float& lgb) {
    const float* t = wsp<float>(F, WS_DEC); lgf = t[(l * 2 + 0) * 8 + h]; lgb = t[(l * 2 + 1) * 8 + h];
}
constexpr int TP = 136;
template <bool WITH_K>
__device__ __forceinline__ void ret_stage(const Frame& F, const bf16_t* RKh, const bf16_t* RVh, int tpos0, float lgf, float lgb, LAS bf16_t* vt, LAS bf16_t* ktf, LAS bf16_t* ktb) {
#pragma unroll
    for (int i = 0; i < 2; ++i) { const int tok = (F.tid >> 3) + 64 * i, e0 = (F.tid & 7) * 8;
        const u32x4 w = *(const u32x4*)(RVh + (size_t)(tpos0 + tok) * 64 + e0); const unsigned ww[4] = {w.x, w.y, w.z, w.w};
#pragma unroll
        for (int j = 0; j < 4; ++j) { vt[(e0 + 2 * j) * TP + tok] = (bf16_t)(ww[j] & 0xffffu); vt[(e0 + 2 * j + 1) * TP + tok] = (bf16_t)(ww[j] >> 16); } }
    if (WITH_K) { const int tok = F.tid >> 2, k0 = (F.tid & 3) * 8;
        const u32x4 w = *(const u32x4*)(RKh + (size_t)(tpos0 + tok) * 32 + k0); const unsigned ww[4] = {w.x, w.y, w.z, w.w};
        const float zf = exp2f(lgf * (float)(127 - tok)), zb = exp2f(lgb * (float)tok);
#pragma unroll
        for (int j = 0; j < 4; ++j) { const float a = bflo(ww[j]), b = bfhi(ww[j]);
            ktf[(k0 + 2 * j) * TP + tok] = f2bf(a * zf); ktf[(k0 + 2 * j + 1) * TP + tok] = f2bf(b * zf);
            ktb[(k0 + 2 * j) * TP + tok] = f2bf(a * zb); ktb[(k0 + 2 * j + 1) * TP + tok] = f2bf(b * zb); } }
}
__device__ __forceinline__ void p_ret_states(const Frame& F, int l) {
    LAS bf16_t* vt = (LAS bf16_t*)F.lds; LAS bf16_t* ktf = vt + 64 * TP; LAS bf16_t* ktb = ktf + 32 * TP;
    float* ST = wsp<float>(F, WS_ST);
    const int lane = F.lane, w = F.wave, kb = w >> 2, eb = w & 3, fr = lane & 15, fq = lane >> 4;
    for (int u = F.bid; u < NB * 8 * 34; u += F.G) {
        const int c = u % 34, bh = u / 34, h = bh & 7;
        float lgf, lgb; ret_logs(F, l, h, lgf, lgb);
        __syncthreads();
        ret_stage<true>(F, wsp<bf16_t>(F, WS_RK) + (size_t)bh * TT * 32, wsp<bf16_t>(F, WS_RV) + (size_t)bh * TT * 64, c * 128, lgf, lgb, vt, ktf, ktb);
        __syncthreads();
        f32x4 sf = {0.f, 0.f, 0.f, 0.f}, sb = {0.f, 0.f, 0.f, 0.f};
#pragma unroll
        for (int ks = 0; ks < 4; ++ks) {
            const bf16x8 bv = *(const LAS bf16x8*)(vt + (eb * 16 + fr) * TP + ks * 32 + fq * 8);
            const bf16x8 af = *(const LAS bf16x8*)(ktf + (kb * 16 + fr) * TP + ks * 32 + fq * 8);
            const bf16x8 ab = *(const LAS bf16x8*)(ktb + (kb * 16 + fr) * TP + ks * 32 + fq * 8);
            sf = __builtin_amdgcn_mfma_f32_16x16x32_bf16(af, bv, sf, 0, 0, 0);
            sb = __builtin_amdgcn_mfma_f32_16x16x32_bf16(ab, bv, sb, 0, 0, 0);
        }
        float* o = ST + (size_t)u * 2 * 2048;
#pragma unroll
        for (int r = 0; r < 4; ++r) { const int kd = kb * 16 + fq * 4 + r, e = eb * 16 + fr; o[kd * 64 + e] = sf[r]; o[2048 + kd * 64 + e] = sb[r]; }
    }
}
constexpr int RP = 40;
constexpr int AP = 136;
__device__ __forceinline__ void ret_out_unit(const Frame& F, int l, int bh, int c) {
    LAS bf16_t* vt = (LAS bf16_t*)F.lds; LAS bf16_t* rtf = vt + 64 * TP; LAS bf16_t* rtb = rtf + 64 * RP; LAS bf16_t* as = rtb + 64 * RP + F.wave * 16 * AP;
    const int lane = F.lane, w = F.wave, fr = lane & 15, fq = lane >> 4, h = bh & 7, b = bh >> 3;
    const bf16_t* RQh = wsp<bf16_t>(F, WS_RQ) + (size_t)bh * TT * 32; const bf16_t* RKh = wsp<bf16_t>(F, WS_RK) + (size_t)bh * TT * 32; const bf16_t* RVh = wsp<bf16_t>(F, WS_RV) + (size_t)bh * TT * 64;
    const float* STh = wsp<float>(F, WS_ST) + (size_t)bh * 34 * 2 * 2048;
    float lgf, lgb; ret_logs(F, l, h, lgf, lgb);
    const int tpos0 = c * 128;
    __syncthreads();
    ret_stage<false>(F, RKh, RVh, tpos0, lgf, lgb, vt, nullptr, nullptr);
    { const int kd = F.tid >> 4, e4 = (F.tid & 15) * 4; f32x4 rf = {0.f, 0.f, 0.f, 0.f}, rb = {0.f, 0.f, 0.f, 0.f};
      if (c >= 2) {
          for (int cp = 0; cp < c; ++cp) { const float e2 = lgf * 128.f * (float)(c - 1 - cp); if (e2 < -80.f) continue; const float wgt = exp2f(e2);
              rf += *(const f32x4*)(STh + (size_t)(cp * 2 + 0) * 2048 + kd * 64 + e4) * wgt; }
          const int p = c - 2;
          for (int pp = p + 1; pp < 34; ++pp) { const float e2 = lgb * 128.f * (float)(pp - p - 1); if (e2 < -80.f) break; const float wgt = exp2f(e2); const int cs = pp < 32 ? pp + 2 : pp - 32;
              rb += *(const f32x4*)(STh + (size_t)(cs * 2 + 1) * 2048 + kd * 64 + e4) * wgt; }
      } else if (c == 0) { rb = *(const f32x4*)(STh + (size_t)(1 * 2 + 1) * 2048 + kd * 64 + e4); }
      else { rf = *(const f32x4*)(STh + (size_t)(0 * 2 + 0) * 2048 + kd * 64 + e4); }
#pragma unroll
      for (int j = 0; j < 4; ++j) { rtf[(e4 + j) * RP + kd] = f2bf(rf[j]); rtb[(e4 + j) * RP + kd] = f2bf(rb[j]); } }
    const int i0 = w * 16;
    const bf16x8 qa = *(const bf16x8*)(RQh + (size_t)(tpos0 + i0 + fr) * 32 + fq * 8);
    f32x4 s[8];
#pragma unroll
    for (int nb = 0; nb < 8; ++nb) { const bf16x8 kf = *(const bf16x8*)(RKh + (size_t)(tpos0 + nb * 16 + fr) * 32 + fq * 8);
        s[nb] = __builtin_amdgcn_mfma_f32_16x16x32_bf16(qa, kf, (f32x4){0.f, 0.f, 0.f, 0.f}, 0, 0, 0); }
#pragma unroll
    for (int nb = 0; nb < 8; ++nb)
#pragma unroll
        for (int r = 0; r < 4; ++r) { const int i = i0 + fq * 4 + r, j = nb * 16 + fr; const int df = i - j;
            const float mk = df > 0 ? exp2f(lgf * (float)df) : (df < 0 ? exp2f(lgb * (float)(-df)) : 2.f);
            as[(fq * 4 + r) * AP + j] = f2bf(s[nb][r] * mk); }
    __syncthreads();
    f32x4 y[4];
#pragma unroll
    for (int eb = 0; eb < 4; ++eb) y[eb] = (f32x4){0.f, 0.f, 0.f, 0.f};
#pragma unroll
    for (int ks = 0; ks < 4; ++ks) { const bf16x8 af = *(const LAS bf16x8*)(as + fr * AP + ks * 32 + fq * 8);
#pragma unroll
        for (int eb = 0; eb < 4; ++eb) { const bf16x8 bv = *(const LAS bf16x8*)(vt + (eb * 16 + fr) * TP + ks * 32 + fq * 8);
            y[eb] = __builtin_amdgcn_mfma_f32_16x16x32_bf16(af, bv, y[eb], 0, 0, 0); } }
    { const float xf = exp2f(lgf * (float)(i0 + fr + 1)), xb = exp2f(lgb * (float)(128 - (i0 + fr)));
      bf16x8 qf, qb;
#pragma unroll
      for (int j = 0; j < 8; ++j) { const float qv = bf2f((bf16_t)qa[j]); qf[j] = (short)f2bf(qv * xf); qb[j] = (short)f2bf(qv * xb); }
#pragma unroll
      for (int eb = 0; eb < 4; ++eb) { const bf16x8 bf_ = *(const LAS bf16x8*)(rtf + (eb * 16 + fr) * RP + fq * 8), bb_ = *(const LAS bf16x8*)(rtb + (eb * 16 + fr) * RP + fq * 8);
          y[eb] = __builtin_amdgcn_mfma_f32_16x16x32_bf16(qf, bf_, y[eb], 0, 0, 0);
          y[eb] = __builtin_amdgcn_mfma_f32_16x16x32_bf16(qb, bb_, y[eb], 0, 0, 0); } }
    const bf16_t* P1 = wsp<bf16_t>(F, WS_P1); unsigned char* OAB = wsp<unsigned char>(F, WS_OAB);
#pragma unroll
    for (int r = 0; r < 4; ++r) {
        float sm = y[0][r] + y[1][r] + y[2][r] + y[3][r]; sm = row16_sum(sm); const float mu = sm * (1.f / 64.f);
        float vs = 0.f;
#pragma unroll
        for (int eb = 0; eb < 4; ++eb) { const float d = y[eb][r] - mu; vs += d * d; }
        vs = row16_sum(vs); const float rstd = rsqrtf(vs * (1.f / 64.f) + LN_EPS);
        const int i = i0 + fq * 4 + r; const int tp = tpos0 + i; const size_t grow = tp >= CTXL ? (size_t)b * SEQ + (tp - CTXL) : (size_t)NLAT + b * CTXL + tp;
#pragma unroll
        for (int eb = 0; eb < 4; ++eb) { const int e = eb * 16 + fr; const float g = bf2f(P1[grow * NP1 + C_RG + h * 64 + e]);
            OAB[grow * D + 512 + h * 64 + e] = (unsigned char)(pk4_fp8(clamp8(silu_f(g) * (y[eb][r] - mu) * rstd * 16.f), 0.f, 0.f, 0.f) & 0xffu); }
    }
}
namespace att {
constexpr int NW = 8, QBLK = 32, KVBLK = 64;
constexpr size_t SHM_V = KVBLK * 128 * 2, SHM_K = KVBLK * 128 * 2, SHM_ATTN = 2 * SHM_V + 2 * SHM_K + NW * 64 * 4;
constexpr float THR = 8.f;
#define KSWZ(row, colB) ((row) * 256 + ((colB) ^ (((row) & 7) << 4)))
#define SBAR() __builtin_amdgcn_sched_barrier(0)
__device__ __forceinline__ int crow(int r, int hi) { return (r & 3) + 8 * (r >> 2) + 4 * hi; }
template <int SC> struct Scale { static constexpr float S = SC == 0 ? 0.08838834764831845f : 0.10206207261596575f; static constexpr float C = S * 1.4426950408889634f; static constexpr float THRR = THR / S; };
template <int SC>
__device__ __forceinline__ void partialSM(f32x16& p0, f32x16& p1, float& m_reg, float& mn, float& alpha) {
  constexpr float C = Scale<SC>::C, thr_raw = Scale<SC>::THRR;
  float pmax = p0[0];
#pragma unroll
  for (int r = 1; r < 16; ++r) pmax = fmaxf(pmax, p0[r]);
#pragma unroll
  for (int r = 0; r < 16; ++r) pmax = fmaxf(pmax, p1[r]);
  { auto rr = __builtin_amdgcn_permlane32_swap(__float_as_uint(pmax), __float_as_uint(pmax), false, false);
    pmax = fmaxf(__uint_as_float(rr[0]), __uint_as_float(rr[1])); }
  if (__builtin_expect(__all(pmax - m_reg <= thr_raw), 1)) { mn = m_reg; alpha = 1.f; }
  else { mn = fmaxf(m_reg, pmax); alpha = __builtin_amdgcn_exp2f((m_reg - mn) * C); m_reg = mn; }
  const float mnC = -mn * C;
#pragma unroll
  for (int r = 0; r < 16; ++r) p0[r] = fmaf(p0[r], C, mnC);
#pragma unroll
  for (int r = 0; r < 16; ++r) p1[r] = fmaf(p1[r], C, mnC);
#pragma unroll
  for (int r = 0; r < 16; ++r) p0[r] = __builtin_amdgcn_exp2f(p0[r]);
}
__device__ __forceinline__ void finishSM(f32x16& p0, f32x16& p1, float alpha, float& l_reg, bf16x8& pa0, bf16x8& pa1, bf16x8& pa2, bf16x8& pa3) {
#pragma unroll
  for (int r = 0; r < 16; ++r) p1[r] = __builtin_amdgcn_exp2f(p1[r]);
  float ps = 0;
#pragma unroll
  for (int r = 0; r < 16; ++r) ps += p0[r];
#pragma unroll
  for (int r = 0; r < 16; ++r) ps += p1[r];
  { auto rr = __builtin_amdgcn_permlane32_swap(__float_as_uint(ps), __float_as_uint(ps), false, false);
    ps = __uint_as_float(rr[0]) + __uint_as_float(rr[1]); }
  l_reg = l_reg * alpha + ps;
#define PK4(P, BASE, OUT) do { unsigned a0 = cvt_pk_bf16(P[BASE + 0], P[BASE + 1]), a1 = cvt_pk_bf16(P[BASE + 2], P[BASE + 3]);   \
    unsigned b0 = cvt_pk_bf16(P[BASE + 4], P[BASE + 5]), b1 = cvt_pk_bf16(P[BASE + 6], P[BASE + 7]);                              \
    auto r0 = __builtin_amdgcn_permlane32_swap(a0, b0, false, false); auto r1 = __builtin_amdgcn_permlane32_swap(a1, b1, false, false); \
    u32x4 w = {r0[0], r1[0], r0[1], r1[1]}; OUT = *reinterpret_cast<bf16x8*>(&w); } while (0)
  PK4(p0, 0, pa0); PK4(p0, 8, pa1); PK4(p1, 0, pa2); PK4(p1, 8, pa3);
#undef PK4
}
template <int NDQ>
__device__ __forceinline__ void qkt(f32x16& p0, f32x16& p1, const char* Ks, const bf16x8* qr, int r32, int hi) {
  p0 = f32x16{}; p1 = f32x16{};
#pragma unroll
  for (int d0 = 0; d0 < NDQ; ++d0) { const int cb = (d0 * 16 + hi * 8) * 2;
    const bf16x8 b0 = *reinterpret_cast<const bf16x8*>(Ks + KSWZ(r32, cb));
    const bf16x8 b1 = *reinterpret_cast<const bf16x8*>(Ks + KSWZ(32 + r32, cb));
    p0 = __builtin_amdgcn_mfma_f32_32x32x16_bf16(b0, qr[d0], p0, 0, 0, 0);
    p1 = __builtin_amdgcn_mfma_f32_32x32x16_bf16(b1, qr[d0], p1, 0, 0, 0); }
}
__device__ __forceinline__ int v_st(int k, int c) { const int kk = (k & ~0xC) | ((k & 4) << 1) | ((k & 8) >> 1); return ((kk >> 3) * 4 + (c >> 5)) * 512 + ((kk & 7) * 32 + (c & 31)) * 2; }
__device__ __forceinline__ int v_rd_base(int lane) { return ((lane & 3) << 3) | (((lane >> 2) & 3) << 6) | (((lane >> 4) & 1) << 5) | (((lane >> 5) & 1) << 8); }
constexpr int v_rd_off(int d0, int ks, int half) { return d0 * 512 + ks * 4096 + half * 2048; }
template <int OFF> __device__ __forceinline__ s16x4 tr_read(int vb) {
  s16x4 r; asm volatile("ds_read_b64_tr_b16 %0, %1 offset:%2" : "=&v"(r) : "v"(vb), "i"(OFF) : "memory"); return r;
}
template <int D0> __device__ __forceinline__ void pv_one(f32x16& od, int vb, bf16x8 pa0, bf16x8 pa1, bf16x8 pa2, bf16x8 pa3) {
  const s16x4 l0 = tr_read<v_rd_off(D0, 0, 0)>(vb), h0 = tr_read<v_rd_off(D0, 0, 1)>(vb), l1 = tr_read<v_rd_off(D0, 1, 0)>(vb), h1 = tr_read<v_rd_off(D0, 1, 1)>(vb);
  const s16x4 l2 = tr_read<v_rd_off(D0, 2, 0)>(vb), h2 = tr_read<v_rd_off(D0, 2, 1)>(vb), l3 = tr_read<v_rd_off(D0, 3, 0)>(vb), h3 = tr_read<v_rd_off(D0, 3, 1)>(vb);
  asm volatile("s_waitcnt lgkmcnt(0)" ::: "memory"); SBAR();
#define PK(L, H) (bf16x8){L[0], L[1], L[2], L[3], H[0], H[1], H[2], H[3]}
  od = __builtin_amdgcn_mfma_f32_32x32x16_bf16(pa0, PK(l0, h0), od, 0, 0, 0);
  od = __builtin_amdgcn_mfma_f32_32x32x16_bf16(pa1, PK(l1, h1), od, 0, 0, 0);
  od = __builtin_amdgcn_mfma_f32_32x32x16_bf16(pa2, PK(l2, h2), od, 0, 0, 0);
  od = __builtin_amdgcn_mfma_f32_32x32x16_bf16(pa3, PK(l3, h3), od, 0, 0, 0);
#undef PK
}
template <int NDV> __device__ __forceinline__ void pv_d0(f32x16* o, int vb, bf16x8 pa0, bf16x8 pa1, bf16x8 pa2, bf16x8 pa3) {
  pv_one<0>(o[0], vb, pa0, pa1, pa2, pa3); pv_one<1>(o[1], vb, pa0, pa1, pa2, pa3);
  if constexpr (NDV == 4) { pv_one<2>(o[2], vb, pa0, pa1, pa2, pa3); pv_one<3>(o[3], vb, pa0, pa1, pa2, pa3); }
}
template <int NDQ, int NDV, int SC, int SDEPTH>
__device__ __forceinline__ void attn_body(const bf16_t* __restrict__ Qb, const bf16_t* __restrict__ Kh, const bf16_t* __restrict__ Vh,
                                          unsigned char* __restrict__ Ob, int seq, char* lds, const int tid) {
  constexpr int LDK = 128, LDV = NDV * 32, ldo = 2048;
  const int wid = tid >> 6, lane = tid & 63, r32 = lane & 31, hi = lane >> 5;
  char* V_lds = lds; char* K_lds = lds + 2 * SHM_V;
  float* ws = (float*)(lds + 2 * SHM_V + 2 * SHM_K) + wid * 64; float* li_l = ws; float* al_l = ws + 32;
  float m_reg = -1e30f, l_reg = 0; f32x16 o[NDV] = {}; bf16x8 qr[NDQ];
  const bf16_t* Qw = Qb + (long)(wid * QBLK + r32) * 128 + hi * 8;
#pragma unroll
  for (int d0 = 0; d0 < NDQ; ++d0) qr[d0] = *reinterpret_cast<const bf16x8*>(Qw + d0 * 16);
  const int sr = tid >> 4, sc = (tid & 15) * 8;
  const int vr = NDV == 4 ? sr : (tid >> 3), vc = NDV == 4 ? sc : (tid & 7) * 8;
  const int vst0 = v_st(NDV == 4 ? 2 * sr : vr, vc), vst1 = v_st(2 * sr + 1, sc);
  const int vb0 = (int)(uintptr_t)V_lds + v_rd_base(lane);
  struct { bf16x8 vs0, vs1, ks0, ks1; } sr_[SDEPTH];
#define SLOAD(i, k0) do { const bf16_t* vp_ = Vh + (long)((k0) + (NDV == 4 ? 2 * sr : vr)) * LDV + vc; const bf16_t* kp_ = Kh + (long)((k0) + 2 * sr) * LDK + sc; \
    sr_[i].vs0 = *reinterpret_cast<const bf16x8*>(vp_); if constexpr (NDV == 4) sr_[i].vs1 = *reinterpret_cast<const bf16x8*>(vp_ + LDV); \
    sr_[i].ks0 = *reinterpret_cast<const bf16x8*>(kp_); sr_[i].ks1 = *reinterpret_cast<const bf16x8*>(kp_ + LDK); } while (0)
#define SWRITE(b, i) do { *(bf16x8*)(V_lds + (b) * SHM_V + vst0) = sr_[i].vs0;          \
    if constexpr (NDV == 4) *(bf16x8*)(V_lds + (b) * SHM_V + vst1) = sr_[i].vs1; const int kc = sc * 2;               \
    *(bf16x8*)(K_lds + (b) * SHM_K + KSWZ(2 * sr, kc)) = sr_[i].ks0;                       \
    *(bf16x8*)(K_lds + (b) * SHM_K + KSWZ(2 * sr + 1, kc)) = sr_[i].ks1; } while (0)
#define SWAIT() do { if constexpr (SDEPTH == 1) asm volatile("s_waitcnt vmcnt(0)" ::: "memory"); else if constexpr (NDV == 4) asm volatile("s_waitcnt vmcnt(4)" ::: "memory"); else asm volatile("s_waitcnt vmcnt(3)" ::: "memory"); } while (0)
#define RESC(a) do { if (__any((a) < 1.f)) { if (hi == 0) al_l[r32] = (a); asm volatile("s_waitcnt lgkmcnt(0)" ::: "memory"); \
    _Pragma("unroll") for (int d = 0; d < NDV; ++d) _Pragma("unroll") for (int r = 0; r < 16; ++r) o[d][r] *= al_l[crow(r, hi)]; } } while (0)
  f32x16 pA0, pA1, pB0, pB1; float mnA, mnB, alA, alB; bf16x8 pa0, pa1, pa2, pa3; const int NT = seq / KVBLK;
  constexpr int SE = 0, SO = SDEPTH - 1;
  SLOAD(SE, 0); asm volatile("s_waitcnt vmcnt(0)" ::: "memory"); SWRITE(0, SE); __syncthreads();
  qkt<NDQ>(pA0, pA1, K_lds, qr, r32, hi); partialSM<SC>(pA0, pA1, m_reg, mnA, alA);
  SLOAD(SO, KVBLK); if constexpr (SDEPTH == 2) { if (2 < NT) SLOAD(SE, 2 * KVBLK); }
  SWAIT(); SWRITE(1, SO); __syncthreads();
  for (int j = 1; j + 1 < NT; j += 2) {
    SBAR(); qkt<NDQ>(pB0, pB1, K_lds + SHM_K, qr, r32, hi);
    finishSM(pA0, pA1, alA, l_reg, pa0, pa1, pa2, pa3); SBAR();
    SLOAD(SO, (j + SDEPTH) * KVBLK); SBAR();
    pv_d0<NDV>(o, vb0, pa0, pa1, pa2, pa3); partialSM<SC>(pB0, pB1, m_reg, mnB, alB);
    __syncthreads(); SWAIT(); SWRITE(0, SE);
    RESC(alB); __syncthreads();
    SBAR(); qkt<NDQ>(pA0, pA1, K_lds, qr, r32, hi);
    finishSM(pB0, pB1, alB, l_reg, pa0, pa1, pa2, pa3); SBAR();
    if (SDEPTH == 1 || j + 3 < NT) SLOAD(SE, (j + 1 + SDEPTH) * KVBLK); SBAR();
    pv_d0<NDV>(o, vb0 + (int)SHM_V, pa0, pa1, pa2, pa3); partialSM<SC>(pA0, pA1, m_reg, mnA, alA);
    __syncthreads(); SWAIT(); SWRITE(1, SO);
    RESC(alA); __syncthreads();
  }
  SBAR(); qkt<NDQ>(pB0, pB1, K_lds + SHM_K, qr, r32, hi);
  finishSM(pA0, pA1, alA, l_reg, pa0, pa1, pa2, pa3); SBAR();
  pv_d0<NDV>(o, vb0, pa0, pa1, pa2, pa3); partialSM<SC>(pB0, pB1, m_reg, mnB, alB);
  __syncthreads(); RESC(alB);
  finishSM(pB0, pB1, alB, l_reg, pa0, pa1, pa2, pa3); SBAR();
  pv_d0<NDV>(o, vb0 + (int)SHM_V, pa0, pa1, pa2, pa3);
  if (hi == 0) li_l[r32] = l_reg; asm volatile("s_waitcnt lgkmcnt(0)" ::: "memory");
  float rli[16];
#pragma unroll
  for (int r = 0; r < 16; ++r) rli[r] = __builtin_amdgcn_rcpf(li_l[crow(r, hi)]);
  unsigned char* Ow = Ob + (long)(wid * QBLK) * ldo;
#pragma unroll
  for (int r = 0; r < 16; ++r) { const int orow = crow(r, hi);
#pragma unroll
    for (int d0 = 0; d0 < NDV; ++d0) Ow[(long)orow * ldo + d0 * 32 + r32] = (unsigned char)(pk4_fp8(clamp8(o[d0][r] * rli[r] * 16.f), 0.f, 0.f, 0.f) & 0xffu); }
#undef SLOAD
#undef SWRITE
#undef SWAIT
#undef RESC
}
}
__device__ __forceinline__ float* xres_row(const Frame& F, int row) { return row < NLAT ? F.out + (size_t)row * D : wsp<float>(F, WS_XC) + (size_t)(row - NLAT) * D; }
__device__ __forceinline__ void ln_row(float (&y)[32], const float* g, const float* b, int lane) {
    float s = 0.f;
#pragma unroll
    for (int i = 0; i < 32; ++i) s += y[i];
    const float mu = wave_sum(s) * (1.f / 2048.f);
    float q = 0.f;
#pragma unroll
    for (int i = 0; i < 32; ++i) { const float d = y[i] - mu; q += d * d; }
    const float rstd = rsqrtf(wave_sum(q) * (1.f / 2048.f) + LN_EPS);
#pragma unroll
    for (int qq = 0; qq < 4; ++qq) { const f32x4 g0 = *(const f32x4*)(g + 512 * qq + 8 * lane), g1 = *(const f32x4*)(g + 512 * qq + 8 * lane + 4), b0 = *(const f32x4*)(b + 512 * qq + 8 * lane), b1 = *(const f32x4*)(b + 512 * qq + 8 * lane + 4);
#pragma unroll
        for (int i = 0; i < 4; ++i) { y[qq * 8 + i] = (y[qq * 8 + i] - mu) * rstd * g0[i] + b0[i]; y[qq * 8 + 4 + i] = (y[qq * 8 + 4 + i] - mu) * rstd * g1[i] + b1[i]; } }
}
__device__ __forceinline__ void modulate_store(const float (&x)[32], const float* sh, const float* sc, bf16_t* dst, int lane) {
#pragma unroll
    for (int q = 0; q < 4; ++q) { const f32x4 h0 = *(const f32x4*)(sh + 512 * q + 8 * lane), h1 = *(const f32x4*)(sh + 512 * q + 8 * lane + 4), c0 = *(const f32x4*)(sc + 512 * q + 8 * lane), c1 = *(const f32x4*)(sc + 512 * q + 8 * lane + 4);
        f32x4 a, b;
#pragma unroll
        for (int i = 0; i < 4; ++i) { a[i] = x[q * 8 + i] * (1.f + c0[i]) + h0[i]; b[i] = x[q * 8 + 4 + i] * (1.f + c1[i]) + h1[i]; }
        *(u32x4*)(dst + 512 * q + 8 * lane) = pack8(a, b); }
}
__device__ __forceinline__ void p_ln1(const Frame& F, int l, bool last) {
    const float* mod = wsp<float>(F, WS_MOD) + (size_t)l * 5 * 12288; bf16_t* hb = wsp<bf16_t>(F, WS_HB);
    const float* g = F.in(18) + l * D; const float* b = F.in(19) + l * D;
    const int nrows = last ? NLAT : NROW; const int lane = F.lane, step = F.G * 8;
    float gg[32], bb[32]; ld_row_f32(g, lane, gg); ld_row_f32(b, lane, bb);
    int row = F.bid * 8 + F.wave;
    float yn[32];
    if (row < nrows) ld_row_f32(xres_row(F, row), lane, yn);
#pragma unroll 1
    for (; row < nrows; row += step) {
        const int v = row < NLAT ? (row >> 12) : 4; float* xp = xres_row(F, row);
        float y[32], sh[32], sc[32];
#pragma unroll
        for (int i = 0; i < 32; ++i) y[i] = yn[i];
        ld_row_f32(mod + (size_t)v * 12288 + 6144, lane, sh); ld_row_f32(mod + (size_t)v * 12288 + 8192, lane, sc);
        { const int nrow = row + step; if (nrow < nrows) ld_row_f32(xres_row(F, nrow), lane, yn); }
        float s = 0.f;
#pragma unroll
        for (int i = 0; i < 32; ++i) s += y[i];
        const float mu = wave_sum(s) * (1.f / 2048.f); float q = 0.f;
#pragma unroll
        for (int i = 0; i < 32; ++i) { const float d = y[i] - mu; q += d * d; }
        const float rstd = rsqrtf(wave_sum(q) * (1.f / 2048.f) + LN_EPS);
#pragma unroll
        for (int i = 0; i < 32; ++i) y[i] = (y[i] - mu) * rstd * gg[i] + bb[i];
        st_row_f32(xp, lane, y);
#pragma unroll
        for (int i = 0; i < 32; ++i) y[i] = y[i] * (1.f + sc[i]) + sh[i];
        st_row_bf16(hb + (size_t)row * D, lane, y);
    }
}

template <int NV>
__device__ __forceinline__ void top16(const float (&val)[NV], bool (&sel)[NV], int (&slot)[NV]) {
    unsigned key[NV];
#pragma unroll
    for (int v = 0; v < NV; ++v) { const unsigned u = __float_as_uint(val[v]); key[v] = (u & 0x80000000u) ? ~u : (u | 0x80000000u); }
    unsigned T = 0u;
#pragma unroll 1
    for (int bit = 31; bit >= 0; --bit) {
        const unsigned cand = T | (1u << bit); int cnt = 0;
#pragma unroll
        for (int v = 0; v < NV; ++v) cnt += __popcll(__ballot(key[v] >= cand));
        if (cnt >= 16) T = cand;
    }
    int ngt = 0;
#pragma unroll
    for (int v = 0; v < NV; ++v) ngt += __popcll(__ballot(key[v] > T));
    const int need = 16 - ngt;
    int run = 0, erun = 0;
#pragma unroll
    for (int v = 0; v < NV; ++v) {
        const unsigned long long mg = __ballot(key[v] > T), me = __ballot(key[v] == T);
        const int pg = __builtin_amdgcn_mbcnt_hi((unsigned)(mg >> 32), __builtin_amdgcn_mbcnt_lo((unsigned)mg, 0u));
        const int pe = __builtin_amdgcn_mbcnt_hi((unsigned)(me >> 32), __builtin_amdgcn_mbcnt_lo((unsigned)me, 0u));
        sel[v] = false; slot[v] = 0;
        if (key[v] > T) { sel[v] = true; slot[v] = run + pg; }
        else if (key[v] == T && (erun + pe) < need) { sel[v] = true; slot[v] = ngt + erun + pe; }
        run += __popcll(mg); erun += __popcll(me);
    }
}
__device__ __forceinline__ unsigned f2key(float f) { const unsigned u = __float_as_uint(f); return (u & 0x80000000u) ? ~u : (u | 0x80000000u); }
__device__ __forceinline__ float key2f(unsigned k) { return __uint_as_float((k & 0x80000000u) ? (k & 0x7fffffffu) : ~k); }
template <int NP, int NV>
__device__ __forceinline__ void bisect16(const unsigned (&key)[NP][NV], unsigned (&T)[NP]) {
    bool done[NP];
#pragma unroll
    for (int p = 0; p < NP; ++p) { T[p] = 0u; done[p] = false; }
#pragma unroll 1
    for (int bit = 31; bit >= 0; --bit) {
        const unsigned bm = 1u << bit; bool all = true;
#pragma unroll
        for (int p = 0; p < NP; ++p) {
            const unsigned cand = T[p] | bm; int cnt = 0;
#pragma unroll
            for (int v = 0; v < NV; ++v) cnt += __popcll(__ballot(key[p][v] >= cand));
            const bool upd = (cnt >= 16) && !done[p];
            T[p] = upd ? cand : T[p]; done[p] = done[p] || (cnt == 16); all = all && done[p];
        }
        if (all) break;
    }
}
template <int NV>
__device__ __forceinline__ void compact16(const unsigned (&key)[NV], const unsigned T, bool (&sel)[NV], int (&slot)[NV]) {
    int ngt = 0;
#pragma unroll
    for (int v = 0; v < NV; ++v) ngt += __popcll(__ballot(key[v] > T));
    const int need = 16 - ngt; int run = 0, erun = 0;
#pragma unroll
    for (int v = 0; v < NV; ++v) {
        const unsigned long long mg = __ballot(key[v] > T), me = __ballot(key[v] == T);
        const int pg = __builtin_amdgcn_mbcnt_hi((unsigned)(mg >> 32), __builtin_amdgcn_mbcnt_lo((unsigned)mg, 0u));
        const int pe = __builtin_amdgcn_mbcnt_hi((unsigned)(me >> 32), __builtin_amdgcn_mbcnt_lo((unsigned)me, 0u));
        sel[v] = false; slot[v] = 0;
        if (key[v] > T) { sel[v] = true; slot[v] = run + pg; }
        else if (key[v] == T && (erun + pe) < need) { sel[v] = true; slot[v] = ngt + erun + pe; }
        run += __popcll(mg); erun += __popcll(me);
    }
}
constexpr int KP = 68;
constexpr int PW_BYTES = 9344;
__device__ __forceinline__ float gelu_erf(float x) {
    const float z = fabsf(x) * 0.7071067811865476f; const float t = __builtin_amdgcn_rcpf(1.f + 0.3275911f * z);
    float p = 1.061405429f; p = p * t - 1.453152027f; p = p * t + 1.421413741f; p = p * t - 0.284496736f; p = p * t + 0.254829592f; p = p * t;
    const float er = 1.f - p * __expf(-z * z);
    return 0.5f * x * (1.f + (x < 0.f ? -er : er));
}
__device__ __forceinline__ float wave_max(float x) {
    x = row16_max(x);
    { auto r = __builtin_amdgcn_permlane16_swap(__float_as_uint(x), __float_as_uint(x), false, false); x = fmaxf(__uint_as_float(r[0]), __uint_as_float(r[1])); }
    { auto r = __builtin_amdgcn_permlane32_swap(__float_as_uint(x), __float_as_uint(x), false, false); x = fmaxf(__uint_as_float(r[0]), __uint_as_float(r[1])); }
    return x;
}
__device__ __forceinline__ void ld16_f32(const float* p, int lane, float (&x)[32]) {
#pragma unroll
    for (int q = 0; q < 2; ++q)
#pragma unroll
        for (int d = 0; d < 4; ++d) { const f32x4 a = *(const f32x4*)(p + 1024 * q + 16 * lane + 4 * d); x[q * 16 + d * 4 + 0] = a[0]; x[q * 16 + d * 4 + 1] = a[1]; x[q * 16 + d * 4 + 2] = a[2]; x[q * 16 + d * 4 + 3] = a[3]; }
}
__device__ __forceinline__ void ld16_f32_nt(const float* p, int lane, float (&x)[32]) {
#pragma unroll
    for (int q = 0; q < 2; ++q)
#pragma unroll
        for (int d = 0; d < 4; ++d) { const f32x4 a = __builtin_nontemporal_load((const f32x4*)(p + 1024 * q + 16 * lane + 4 * d)); x[q * 16 + d * 4 + 0] = a[0]; x[q * 16 + d * 4 + 1] = a[1]; x[q * 16 + d * 4 + 2] = a[2]; x[q * 16 + d * 4 + 3] = a[3]; }
}
__device__ __forceinline__ void st16_f32_nt(float* p, int lane, const float (&x)[32]) {
#pragma unroll
    for (int q = 0; q < 2; ++q)
#pragma unroll
        for (int d = 0; d < 4; ++d) __builtin_nontemporal_store((f32x4){x[q * 16 + d * 4 + 0], x[q * 16 + d * 4 + 1], x[q * 16 + d * 4 + 2], x[q * 16 + d * 4 + 3]}, (f32x4*)(p + 1024 * q + 16 * lane + 4 * d));
}
__device__ __forceinline__ void st16_f32(float* p, int lane, const float (&x)[32]) {
#pragma unroll
    for (int q = 0; q < 2; ++q)
#pragma unroll
        for (int d = 0; d < 4; ++d) *(f32x4*)(p + 1024 * q + 16 * lane + 4 * d) = (f32x4){x[q * 16 + d * 4 + 0], x[q * 16 + d * 4 + 1], x[q * 16 + d * 4 + 2], x[q * 16 + d * 4 + 3]};
}
__device__ __forceinline__ void ld16_bf16(const bf16_t* p, int lane, float (&x)[32]) {
#pragma unroll
    for (int q = 0; q < 2; ++q)
#pragma unroll
        for (int d = 0; d < 2; ++d) { const u32x4 w = *(const u32x4*)(p + 1024 * q + 16 * lane + 8 * d); float* o = &x[q * 16 + d * 8];
            o[0] = bflo(w.x); o[1] = bfhi(w.x); o[2] = bflo(w.y); o[3] = bfhi(w.y); o[4] = bflo(w.z); o[5] = bfhi(w.z); o[6] = bflo(w.w); o[7] = bfhi(w.w); }
}
__device__ __forceinline__ void st16_bf16(bf16_t* p, int lane, const float (&x)[32]) {
#pragma unroll
    for (int q = 0; q < 2; ++q)
#pragma unroll
        for (int d = 0; d < 2; ++d) { const float* o = &x[q * 16 + d * 8]; u32x4 w; w.x = cvt_pk_bf16(o[0], o[1]); w.y = cvt_pk_bf16(o[2], o[3]); w.z = cvt_pk_bf16(o[4], o[5]); w.w = cvt_pk_bf16(o[6], o[7]);
            *(u32x4*)(p + 1024 * q + 16 * lane + 8 * d) = w; }
}
constexpr int TBS = 1152;
__device__ __forceinline__ void cvt_row_fp4b(int lane, const float* __restrict__ src, unsigned char* __restrict__ dst) {
    float x[32];
#pragma unroll
    for (int q = 0; q < 2; ++q)
#pragma unroll
        for (int d = 0; d < 4; ++d) { const f32x4 a = __builtin_nontemporal_load((const f32x4*)(src + 1024 * q + 16 * lane + 4 * d)); x[q * 16 + d * 4 + 0] = a[0]; x[q * 16 + d * 4 + 1] = a[1]; x[q * 16 + d * 4 + 2] = a[2]; x[q * 16 + d * 4 + 3] = a[3]; }
    float am = 0.f;
#pragma unroll
    for (int i = 0; i < 32; ++i) am = fmaxf(am, fabsf(x[i]));
    const bf16_t sb = f2bf(am * (1.f / 6.f)); const float sf = bf2f(sb); const float sc = sf > 0.f ? 1.f / sf : 0.f;
    u32x4 w;
#pragma unroll
    for (int d = 0; d < 4; ++d) { unsigned t = 0u; const int o = (d >> 1) * 16 + (d & 1) * 8;
        t = __builtin_amdgcn_cvt_scalef32_pk_fp4_f32(t, x[o + 0] * sc, x[o + 1] * sc, 1.0f, 0); t = __builtin_amdgcn_cvt_scalef32_pk_fp4_f32(t, x[o + 2] * sc, x[o + 3] * sc, 1.0f, 1);
        t = __builtin_amdgcn_cvt_scalef32_pk_fp4_f32(t, x[o + 4] * sc, x[o + 5] * sc, 1.0f, 2); t = __builtin_amdgcn_cvt_scalef32_pk_fp4_f32(t, x[o + 6] * sc, x[o + 7] * sc, 1.0f, 3); w[d] = t; }
    *(u32x4*)(dst + 16 * lane) = w;
    *(bf16_t*)(dst + 1024 + 2 * lane) = sb;
}
__device__ __forceinline__ void cvt_row_fp4r(int lane, const float* __restrict__ src, unsigned char* __restrict__ dst, float* __restrict__ inv) {
    float x[32];
#pragma unroll
    for (int q = 0; q < 2; ++q)
#pragma unroll
        for (int d = 0; d < 4; ++d) { const f32x4 a = __builtin_nontemporal_load((const f32x4*)(src + 1024 * q + 16 * lane + 4 * d)); x[q * 16 + d * 4 + 0] = a[0]; x[q * 16 + d * 4 + 1] = a[1]; x[q * 16 + d * 4 + 2] = a[2]; x[q * 16 + d * 4 + 3] = a[3]; }
    float am = 0.f;
#pragma unroll
    for (int i = 0; i < 32; ++i) am = fmaxf(am, fabsf(x[i]));
    am = wave_max(am);
    const float sc = am > 0.f ? 6.f / am : 1.f;
    if (lane == 0) *inv = am > 0.f ? am * (1.f / 6.f) : 1.f;
    u32x4 w;
#pragma unroll
    for (int d = 0; d < 4; ++d) { unsigned t = 0u; const int o = (d >> 1) * 16 + (d & 1) * 8;
        t = __builtin_amdgcn_cvt_scalef32_pk_fp4_f32(t, x[o + 0] * sc, x[o + 1] * sc, 1.0f, 0); t = __builtin_amdgcn_cvt_scalef32_pk_fp4_f32(t, x[o + 2] * sc, x[o + 3] * sc, 1.0f, 1);
        t = __builtin_amdgcn_cvt_scalef32_pk_fp4_f32(t, x[o + 4] * sc, x[o + 5] * sc, 1.0f, 2); t = __builtin_amdgcn_cvt_scalef32_pk_fp4_f32(t, x[o + 6] * sc, x[o + 7] * sc, 1.0f, 3); w[d] = t; }
    *(u32x4*)(dst + 16 * lane) = w;
}
__device__ __forceinline__ void cvt_peer(const Frame& F, int l) {
    for (int r = F.bid * 8 + F.wave; r < 16384; r += F.G * 8) cvt_row_fp4b(F.lane, F.in(23) + ((size_t)l * 16384 + r) * 2048, wsp<unsigned char>(F, WS_PU) + (size_t)l * SZ_PT + (size_t)r * TBS);
    for (int r = F.bid * 8 + F.wave; r < 16384; r += F.G * 8) cvt_row_fp4b(F.lane, F.in(24) + ((size_t)l * 16384 + r) * 2048, wsp<unsigned char>(F, WS_PV) + (size_t)l * SZ_PT + (size_t)r * TBS);
}
#define PEER_G 4
template <int CTRL> __device__ __forceinline__ int dppi(int x) { return __builtin_amdgcn_update_dpp(0, x, CTRL, 0xF, 0xF, true); }
__device__ __forceinline__ int irow16_sum(int x) { x += dppi<0xB1>(x); x += dppi<0x4E>(x); x += dppi<0x141>(x); x += dppi<0x140>(x); return x; }
__device__ __forceinline__ int irow16_incl_scan(int x) { x += dppi<0x111>(x); x += dppi<0x112>(x); x += dppi<0x114>(x); x += dppi<0x118>(x); return x; }
constexpr int KBP = 72;
constexpr int PT_WORDS = 6 * 128 + 160 + 3 * 128;
constexpr int PWB = 2 * PT_WORDS * 4;
__device__ __forceinline__ void p_peer(const Frame& F, int l, bool last) {
    LAS bf16_t* kb1 = (LAS bf16_t*)F.lds; LAS bf16_t* kb2 = kb1 + 128 * KBP;
    LAS unsigned* wbase = (LAS unsigned*)(F.lds + 2 * 128 * KBP * 2 + F.wave * PWB);
    const int lane = F.lane, fr = lane & 15, fq = lane >> 4;
    __syncthreads();
    for (int i = F.tid; i < 128 * 64; i += 512) { const int r = i >> 6, d = i & 63; kb1[r * KBP + d] = f2bf(F.in(21)[(size_t)l * 8192 + i]); kb2[r * KBP + d] = f2bf(F.in(22)[(size_t)l * 8192 + i]); }
    __syncthreads();
    const bf16_t* QP = wsp<bf16_t>(F, WS_QP); const bf16_t* HB = wsp<bf16_t>(F, WS_HB); unsigned char* HB8w = wsp<unsigned char>(F, WS_HB8);
    const unsigned char* PU = wsp<unsigned char>(F, WS_PU) + (size_t)l * SZ_PT; const unsigned char* PV = wsp<unsigned char>(F, WS_PV) + (size_t)l * SZ_PT;
    const float* modl = wsp<float>(F, WS_MOD) + (size_t)l * 5 * 12288; const float* modn = wsp<float>(F, WS_MOD) + (size_t)(l + 1) * 5 * 12288;
    const float* g2n = F.in(25) + l * D; const float* b2n = F.in(26) + l * D;
    const int npairs = (last ? NLAT : NROW) / 2;
    const int per_wg = (npairs + F.G - 1) / F.G; const int p_lo = F.bid * per_wg; const int p_hi = (p_lo + per_wg) < npairs ? (p_lo + per_wg) : npairs;
    LAS int* wq = (LAS int*)(F.lds + 147456 - 32);
    if (F.tid == 0) *wq = 0;
    __syncthreads();
#pragma unroll 1
    for (;;) {
        int pi = 0; if (lane == 0) pi = __hip_atomic_fetch_add(wq, 1, __ATOMIC_RELAXED, __HIP_MEMORY_SCOPE_WORKGROUP);
        pi = p_lo + __builtin_amdgcn_readfirstlane(pi); if (pi >= p_hi) break;
        const int rowA = 2 * pi;
#pragma unroll 1
        for (int rep1_ = 0; rep1_ <= REP_PS1; ++rep1_) {
            unsigned kk[2][8][4];
            { int fr_ = fr; asm volatile("" : "+v"(fr_));
              const bf16_t* qrow = QP + (size_t)(rowA + (fr_ >> 3)) * 1024 + (fr_ & 7) * 128 + 8 * fq;
              bf16x8 af[2][2];
#pragma unroll
              for (int st = 0; st < 2; ++st)
#pragma unroll
                  for (int ks = 0; ks < 2; ++ks) af[st][ks] = *(const bf16x8*)(qrow + st * 64 + ks * 32);
#pragma unroll
              for (int st = 0; st < 2; ++st) { LAS bf16_t* kb = st ? kb2 : kb1;
#pragma unroll
                  for (int nb = 0; nb < 8; ++nb) { f32x4 c = {0.f, 0.f, 0.f, 0.f};
#pragma unroll
                      for (int ks = 0; ks < 2; ++ks) { const bf16x8 bfr = *(const LAS bf16x8*)(kb + (nb * 16 + fr) * KBP + ks * 32 + 8 * fq); c = __builtin_amdgcn_mfma_f32_16x16x32_bf16(af[st][ks], bfr, c, 0, 0, 0); }
#pragma unroll
                      for (int r = 0; r < 4; ++r) kk[st][nb][r] = f2key(c[r]); } } }
            unsigned T[2][4]; bool done[2][4];
#pragma unroll
            for (int st = 0; st < 2; ++st)
#pragma unroll
                for (int r = 0; r < 4; ++r) { T[st][r] = 0u; done[st][r] = false; }
#pragma unroll 1
            for (int bit = 31; bit >= 0; --bit) { const unsigned bm = 1u << bit; bool alld = true;
#pragma unroll
                for (int st = 0; st < 2; ++st)
#pragma unroll
                    for (int r = 0; r < 4; ++r) { const unsigned cand = T[st][r] | bm; int c = 0;
#pragma unroll
                        for (int nb = 0; nb < 8; ++nb) c += (kk[st][nb][r] >= cand) ? 1 : 0;
                        c = irow16_sum(c);
                        const bool upd = (c >= 16) && !done[st][r]; T[st][r] = upd ? cand : T[st][r]; done[st][r] = done[st][r] || (c == 16); alld = alld && done[st][r]; }
                if (__all(alld)) break; }
            const int tt = lane >> 5, hd0 = ((lane >> 4) & 1) * 4;
#pragma unroll
            for (int st = 0; st < 2; ++st)
#pragma unroll
                for (int r = 0; r < 4; ++r) { const unsigned Tr = T[st][r]; int g = 0, e = 0;
#pragma unroll
                    for (int nb = 0; nb < 8; ++nb) { g += (kk[st][nb][r] > Tr) ? 1 : 0; e += (kk[st][nb][r] == Tr) ? 1 : 0; }
                    int gpre = irow16_incl_scan(g) - g, epre = irow16_incl_scan(e) - e; const int ngt = irow16_sum(g); const int need = 16 - ngt;
                    LAS unsigned* tb = wbase + tt * PT_WORDS; LAS float* vl = (LAS float*)(tb + st * 128) + (hd0 + r) * 16; LAS int* il = (LAS int*)(tb + 256 + st * 128) + (hd0 + r) * 16;
#pragma unroll
                    for (int nb = 0; nb < 8; ++nb) { const unsigned k = kk[st][nb][r];
                        if (k > Tr) { vl[gpre] = key2f(k); il[gpre] = nb * 16 + fr; ++gpre; }
                        else if (k == Tr) { if (epre < need) { vl[ngt + epre] = key2f(k); il[ngt + epre] = nb * 16 + fr; } ++epre; } } }
        }
        asm volatile("s_waitcnt lgkmcnt(0)" ::: "memory");
        {
            const int tt = lane >> 5, hd0 = ((lane >> 4) & 1) * 4; LAS unsigned* tb = wbase + tt * PT_WORDS;
            unsigned ck[4][16];
#pragma unroll
            for (int r = 0; r < 4; ++r) { const float va = ((LAS float*)tb)[(hd0 + r) * 16 + fr]; const LAS float* v2p = (LAS float*)(tb + 128) + (hd0 + r) * 16;
#pragma unroll
                for (int j4 = 0; j4 < 4; ++j4) { const f32x4 vb = *(const LAS f32x4*)(v2p + j4 * 4);
#pragma unroll
                    for (int i = 0; i < 4; ++i) ck[r][j4 * 4 + i] = f2key(va + vb[i]); } }
            unsigned T[4]; bool done[4];
#pragma unroll
            for (int r = 0; r < 4; ++r) { T[r] = 0u; done[r] = false; }
#pragma unroll 1
            for (int bit = 31; bit >= 0; --bit) { const unsigned bm = 1u << bit; bool alld = true;
#pragma unroll
                for (int r = 0; r < 4; ++r) { const unsigned cand = T[r] | bm; int c = 0;
#pragma unroll
                    for (int j = 0; j < 16; ++j) c += (ck[r][j] >= cand) ? 1 : 0;
                    c = irow16_sum(c);
                    const bool upd = (c >= 16) && !done[r]; T[r] = upd ? cand : T[r]; done[r] = done[r] || (c == 16); alld = alld && done[r]; }
                if (__all(alld)) break; }
#pragma unroll
            for (int r = 0; r < 4; ++r) { const unsigned Tr = T[r]; int g = 0, e = 0;
#pragma unroll
                for (int j = 0; j < 16; ++j) { g += (ck[r][j] > Tr) ? 1 : 0; e += (ck[r][j] == Tr) ? 1 : 0; }
                int gpre = irow16_incl_scan(g) - g, epre = irow16_incl_scan(e) - e; const int ngt = irow16_sum(g); const int need = 16 - ngt;
                const int e1 = ((LAS int*)(tb + 256))[(hd0 + r) * 16 + fr] * 128; const LAS int* i2p = (LAS int*)(tb + 384) + (hd0 + r) * 16;
                LAS float* cs_ = (LAS float*)(tb + 512) + (hd0 + r) * 16; LAS int* ce_ = (LAS int*)(tb + 640) + (hd0 + r) * 16;
#pragma unroll
                for (int j = 0; j < 16; ++j) { const unsigned k = ck[r][j];
                    if (k > Tr) { cs_[gpre] = key2f(k); ce_[gpre] = e1 + i2p[j]; ++gpre; }
                    else if (k == Tr) { if (epre < need) { cs_[ngt + epre] = key2f(k); ce_[ngt + epre] = e1 + i2p[j]; } ++epre; } } }
        }
        asm volatile("s_waitcnt lgkmcnt(0)" ::: "memory");
#pragma unroll 1
      for (int t = 0; t < 2; ++t) {
        const int row = rowA + t; const int v = row < NLAT ? (row >> 12) : 4;
        LAS unsigned* tb = wbase + t * PT_WORDS;
        LAS float* v1l = (LAS float*)tb; LAS float* v2l = v1l + 128; LAS int* i1l = (LAS int*)(v2l + 128); LAS int* i2l = i1l + 128;
        LAS float* csl = (LAS float*)(i2l + 128); LAS int* cel = (LAS int*)(csl + 128); LAS int* el = cel + 128; LAS float* gl = (LAS float*)(el + 160); LAS float* su = gl + 128; LAS float* sv = su + 128;
        {
#pragma unroll
            for (int it = 0; it < 2; ++it) { const int idx = it * 64 + lane;
                const float sx = csl[idx]; const float mx = row16_max(sx); const float pe_ = __expf(sx - mx); const float sm = row16_sum(pe_);
                el[idx] = cel[idx]; gl[idx] = pe_ / sm; }
        }
        if (lane < 32) el[128 + lane] = el[0];
        asm volatile("s_waitcnt vmcnt(0) lgkmcnt(0)" ::: "memory");
        float hh[32]; ld16_bf16(HB + (size_t)row * D, lane, hh);
        f32x2 hh2[16];
#pragma unroll
        for (int i = 0; i < 16; ++i) hh2[i] = (f32x2){hh[2 * i], hh[2 * i + 1]};
        const bool b0_ = lane & 1, b1_ = lane & 2, b2_ = lane & 4;
        u32x4 A[8], B[8], C[8]; unsigned SA[8], SB[8], SC[8];
#define PEER_LOADT(buf, sbuf, tab, g) do { _Pragma("unroll") for (int x = 0; x < 8; ++x) { const int e = __builtin_amdgcn_readfirstlane(el[(g) * 8 + x]); const unsigned char* rp = (tab) + (size_t)e * TBS; \
            buf[x] = *(const u32x4*)(rp + 16 * lane); sbuf[x] = *(const bf16_t*)(rp + 1024 + 2 * lane); } } while (0)
#define PEER_LOADV(buf, g) do { _Pragma("unroll") for (int x = 0; x < 8; ++x) { const int e = __builtin_amdgcn_readfirstlane(el[(g) * 8 + x]); buf[x] = *(const u32x4*)(PV + (size_t)e * 1024 + 16 * lane); } } while (0)
#define FP4X8(w_, f0_, f1_, f2_, f3_) const f32x2 f0_ = __builtin_amdgcn_cvt_scalef32_pk_f32_fp4(w_, 1.0f, 0), f1_ = __builtin_amdgcn_cvt_scalef32_pk_f32_fp4(w_, 1.0f, 1), f2_ = __builtin_amdgcn_cvt_scalef32_pk_f32_fp4(w_, 1.0f, 2), f3_ = __builtin_amdgcn_cvt_scalef32_pk_f32_fp4(w_, 1.0f, 3)
#define PEER_DOT(buf, sbuf, g) do { float p_[8]; \
            _Pragma("unroll") for (int x = 0; x < 8; ++x) { f32x2 s2_ = {0.f, 0.f}; \
                _Pragma("unroll") for (int d = 0; d < 4; ++d) { const unsigned w_ = buf[x][d]; FP4X8(w_, f0_, f1_, f2_, f3_); const int o_ = (d >> 1) * 8 + (d & 1) * 4; \
                    s2_ = hh2[o_ + 0] * f0_ + s2_; s2_ = hh2[o_ + 1] * f1_ + s2_; s2_ = hh2[o_ + 2] * f2_ + s2_; s2_ = hh2[o_ + 3] * f3_ + s2_; } \
                p_[x] = (s2_.x + s2_.y) * __uint_as_float(sbuf[x] << 16); SBAR(); } \
              \
            float q_[4], r_[2]; \
            _Pragma("unroll") for (int j = 0; j < 4; ++j) { const float keep_ = b0_ ? p_[2 * j + 1] : p_[2 * j], send_ = b0_ ? p_[2 * j] : p_[2 * j + 1]; q_[j] = keep_ + dppf<0xB1>(send_); } \
            _Pragma("unroll") for (int j = 0; j < 2; ++j) { const float keep_ = b1_ ? q_[2 * j + 1] : q_[2 * j], send_ = b1_ ? q_[2 * j] : q_[2 * j + 1]; r_[j] = keep_ + dppf<0x4E>(send_); } \
            float t_; { const float keep_ = b2_ ? r_[1] : r_[0], send_ = b2_ ? r_[0] : r_[1]; const float up_ = dppf<0x104>(send_), dn_ = dppf<0x114>(send_); t_ = keep_ + (b2_ ? dn_ : up_); } \
            t_ += dppf<0x128>(t_); \
            { auto r16_ = __builtin_amdgcn_permlane16_swap(__float_as_uint(t_), __float_as_uint(t_), false, false); t_ = __uint_as_float(r16_[0]) + __uint_as_float(r16_[1]); } \
            { auto r32_ = __builtin_amdgcn_permlane32_swap(__float_as_uint(t_), __float_as_uint(t_), false, false); t_ = __uint_as_float(r32_[0]) + __uint_as_float(r32_[1]); } \
            const float av = gelu_erf(t_) * gl[(g) * 8 + (lane & 7)]; const bool me_ = (lane >> 3) == ((g) & 7); \
            avl = (me_ && (g) < 8) ? av : avl; avh = (me_ && (g) >= 8) ? av : avh; } while (0)
#define PIN_ACC() do { asm volatile("" : "+v"(acc2[0]), "+v"(acc2[1]), "+v"(acc2[2]), "+v"(acc2[3]), "+v"(acc2[4]), "+v"(acc2[5]), "+v"(acc2[6]), "+v"(acc2[7]), "+v"(acc2[8]), "+v"(acc2[9]), "+v"(acc2[10]), "+v"(acc2[11]), "+v"(acc2[12]), "+v"(acc2[13]), "+v"(acc2[14]), "+v"(acc2[15])); } while (0)
#define PEER_AXPY(buf, sbuf, g) do { _Pragma("unroll") for (int x = 0; x < 8; ++x) { const int idx = (g) * 8 + x; \
            const float av = __uint_as_float(__builtin_amdgcn_readlane(__float_as_uint(idx < 64 ? avl : avh), idx & 63)) * __uint_as_float(sbuf[x] << 16); const f32x2 av2_ = {av, av}; \
            _Pragma("unroll") for (int d = 0; d < 4; ++d) { const unsigned w_ = buf[x][d]; FP4X8(w_, f0_, f1_, f2_, f3_); const int o_ = (d >> 1) * 8 + (d & 1) * 4; \
                acc2[o_ + 0] = av2_ * f0_ + acc2[o_ + 0]; acc2[o_ + 1] = av2_ * f1_ + acc2[o_ + 1]; acc2[o_ + 2] = av2_ * f2_ + acc2[o_ + 2]; acc2[o_ + 3] = av2_ * f3_ + acc2[o_ + 3]; } PIN_ACC(); } } while (0)
        float avl = 0.f, avh = 0.f;
        PEER_LOADT(A, SA, PU, 0); PEER_LOADT(B, SB, PU, 1);
#pragma unroll 1
        for (int g = 0; g < 15; g += 3) { PEER_LOADT(C, SC, PU, g + 2); SBAR(); PEER_DOT(A, SA, g); SBAR(); PEER_LOADT(A, SA, PU, g + 3); SBAR(); PEER_DOT(B, SB, g + 1); SBAR(); PEER_LOADT(B, SB, PU, g + 4); SBAR(); PEER_DOT(C, SC, g + 2); SBAR(); }
        PEER_DOT(A, SA, 15); SBAR();
        f32x2 acc2[16];
#pragma unroll
        for (int i = 0; i < 16; ++i) acc2[i] = (f32x2){0.f, 0.f};
        float* xp = xres_row(F, row);
        PEER_LOADT(A, SA, PV, 0); PEER_LOADT(B, SB, PV, 1);
#pragma unroll 1
        for (int g = 0; g < 15; g += 3) { PEER_LOADT(C, SC, PV, g + 2); SBAR(); PEER_AXPY(A, SA, g); SBAR(); PEER_LOADT(A, SA, PV, g + 3); SBAR(); PEER_AXPY(B, SB, g + 1); SBAR(); PEER_LOADT(B, SB, PV, g + 4); SBAR(); PEER_AXPY(C, SC, g + 2); SBAR(); }
        float x1[32], g2[32]; ld16_f32(xp, lane, x1); ld16_f32(modl + (size_t)v * 12288 + 10240, lane, g2); SBAR();
        PEER_AXPY(A, SA, 15); SBAR();
#undef PEER_LOADT
#undef PEER_LOADV
#undef PEER_DOT
#undef PEER_AXPY
        float acc[32];
        {
#pragma unroll
          for (int i = 0; i < 32; ++i) acc[i] = ALPHA * x1[i] + g2[i] * acc2[i >> 1][i & 1]; }
        { float sm = 0.f;
#pragma unroll
          for (int i = 0; i < 32; ++i) sm += acc[i];
          const float mu = wave_sum(sm) * (1.f / 2048.f); float qq = 0.f;
#pragma unroll
          for (int i = 0; i < 32; ++i) { const float dd = acc[i] - mu; qq += dd * dd; }
          const float rstd = rsqrtf(wave_sum(qq) * (1.f / 2048.f) + LN_EPS);
#pragma unroll
          for (int q = 0; q < 2; ++q)
#pragma unroll
              for (int d = 0; d < 4; ++d) { const int o = 1024 * q + 16 * lane + 4 * d; const f32x4 gg = *(const f32x4*)(g2n + o), bb = *(const f32x4*)(b2n + o);
#pragma unroll
                  for (int i = 0; i < 4; ++i) acc[q * 16 + d * 4 + i] = (acc[q * 16 + d * 4 + i] - mu) * rstd * gg[i] + bb[i]; } }
        st16_f32(xp, lane, acc);
        if (!last) { const float* sh = modn + (size_t)v * 12288; const float* sc = sh + 2048;
#pragma unroll
            for (int q = 0; q < 2; ++q)
#pragma unroll
                for (int d = 0; d < 4; ++d) { const int o = 1024 * q + 16 * lane + 4 * d; const f32x4 hh4 = *(const f32x4*)(sh + o), cc4 = *(const f32x4*)(sc + o);
#pragma unroll
                    for (int i = 0; i < 4; ++i) acc[q * 16 + d * 4 + i] = clamp8(acc[q * 16 + d * 4 + i] * (1.f + cc4[i]) + hh4[i]); }
#pragma unroll
            for (int q = 0; q < 2; ++q) { u32x4 w;
#pragma unroll
                for (int d = 0; d < 4; ++d) w[d] = pk4_fp8(acc[q * 16 + d * 4 + 0], acc[q * 16 + d * 4 + 1], acc[q * 16 + d * 4 + 2], acc[q * 16 + d * 4 + 3]);
                *(u32x4*)(HB8w + (size_t)row * D + 1024 * q + 16 * lane) = w; } }
      }
    }
}
#ifdef DBG
constexpr size_t WS_DBG = WS_CTL + 131072;
constexpr int DBG_NS = 60;
__device__ __forceinline__ int dbg_row(int s) { return (s * 263 + 5) % NLAT; }
__global__ void __launch_bounds__(256) dbg_peer_pre(Args args, int l) {
    __shared__ float q[1024]; __shared__ float s1[128], s2[128]; __shared__ float v1[16], v2[16]; __shared__ int i1[16], i2[16]; __shared__ float cs[256]; __shared__ int ce[256];
    __shared__ float ts[16]; __shared__ int te[16]; __shared__ float red[256]; __shared__ float aval[128]; __shared__ int eid[128]; __shared__ float h2[2048];
    const int s = blockIdx.x, row = dbg_row(s), tid = threadIdx.x; unsigned char* ws = args.ws;
    const bf16_t* QP = (const bf16_t*)(ws + WS_QP); const bf16_t* HB = (const bf16_t*)(ws + WS_HB);
    float* dbgf = (float*)(ws + WS_DBG + 4096); int* dbge = (int*)(dbgf + DBG_NS * 2048); float* dbga = (float*)(dbge + DBG_NS * 128); float* dbgg = dbga + 3 * DBG_NS * 128;
    for (int i = tid; i < 1024; i += 256) q[i] = bf2f(QP[(size_t)row * 1024 + i]);
    for (int i = tid; i < 2048; i += 256) h2[i] = bf2f(HB[(size_t)row * D + i]);
    __syncthreads();
    const float* k1 = args.in[21] + (size_t)l * 8192; const float* k2 = args.in[22] + (size_t)l * 8192;
    for (int hd = 0; hd < 8; ++hd) {
        { const int k = tid & 127; const float* kk = (tid < 128 ? k1 : k2) + k * 64; const float* qq = q + hd * 128 + (tid < 128 ? 0 : 64); float a = 0.f; for (int d = 0; d < 64; ++d) a += qq[d] * kk[d]; (tid < 128 ? s1 : s2)[k] = a; }
        __syncthreads();
        { const int k = tid & 127; const float* sv = tid < 128 ? s1 : s2; const float me = sv[k]; int rank = 0; for (int j = 0; j < 128; ++j) rank += (sv[j] > me || (sv[j] == me && j < k)) ? 1 : 0;
          if (rank < 16) { (tid < 128 ? v1 : v2)[rank] = me; (tid < 128 ? i1 : i2)[rank] = k; } }
        __syncthreads();
        { const int i = tid >> 4, j = tid & 15; cs[tid] = v1[i] + v2[j]; ce[tid] = i1[i] * 128 + i2[j]; }
        __syncthreads();
        { const float me = cs[tid]; int rank = 0; for (int j = 0; j < 256; ++j) rank += (cs[j] > me || (cs[j] == me && j < tid)) ? 1 : 0; if (rank < 16) { ts[rank] = me; te[rank] = ce[tid]; } }
        __syncthreads();
        if (tid < 16) { float mx = ts[0]; float sm = 0.f; for (int j = 0; j < 16; ++j) sm += expf(ts[j] - mx); aval[hd * 16 + tid] = expf(ts[tid] - mx) / sm; eid[hd * 16 + tid] = te[tid]; dbgg[s * 128 + hd * 16 + tid] = aval[hd * 16 + tid]; }
        __syncthreads();
    }
    const float* U = args.in[23] + (size_t)l * 16384 * 2048; const float* V = args.in[24] + (size_t)l * 16384 * 2048;
    for (int e = 0; e < 128; ++e) { const float* ur = U + (size_t)eid[e] * 2048; float p = 0.f; for (int d = tid; d < 2048; d += 256) p += h2[d] * ur[d]; red[tid] = p; __syncthreads();
        for (int st = 128; st > 0; st >>= 1) { if (tid < st) red[tid] += red[tid + st]; __syncthreads(); }
        if (tid == 0) { const float sc = red[0]; aval[e] = 0.5f * sc * (1.f + erff(sc * 0.70710678f)) * aval[e]; } __syncthreads(); }
    float y[8]; const float* xr = args.out + (size_t)row * D; const int v = row >> 12; const float* mod = (const float*)(ws + WS_MOD) + (size_t)l * 5 * 12288 + (size_t)v * 12288;
    float sum = 0.f;
    for (int k = 0; k < 8; ++k) { const int d = tid + 256 * k; float o = 0.f; for (int e = 0; e < 128; ++e) o += aval[e] * V[(size_t)eid[e] * 2048 + d]; y[k] = ALPHA * xr[d] + mod[10240 + d] * o; sum += y[k]; }
    red[tid] = sum; __syncthreads(); for (int st = 128; st > 0; st >>= 1) { if (tid < st) red[tid] += red[tid + st]; __syncthreads(); } const float mu = red[0] / 2048.f; __syncthreads();
    float sq = 0.f; for (int k = 0; k < 8; ++k) sq += (y[k] - mu) * (y[k] - mu);
    red[tid] = sq; __syncthreads(); for (int st = 128; st > 0; st >>= 1) { if (tid < st) red[tid] += red[tid + st]; __syncthreads(); } const float rstd = rsqrtf(red[0] / 2048.f + LN_EPS);
    for (int k = 0; k < 8; ++k) { const int d = tid + 256 * k; dbgf[(size_t)s * 2048 + d] = (y[k] - mu) * rstd * args.in[25][l * D + d] + args.in[26][l * D + d]; }
    if (tid < 128) { dbge[s * 128 + tid] = eid[tid]; dbga[s * 128 + tid] = aval[tid]; }
}
__global__ void __launch_bounds__(256) dbg_peer_post(Args args) {
    __shared__ int bad_e, bad_x, bad_a, bad_g;
    const int s = blockIdx.x, row = dbg_row(s), tid = threadIdx.x; unsigned char* ws = args.ws; unsigned* cnt = (unsigned*)(ws + WS_DBG);
    float* dbgf = (float*)(ws + WS_DBG + 4096); int* dbge = (int*)(dbgf + DBG_NS * 2048); float* dbga = (float*)(dbge + DBG_NS * 128);
    int* fe = (int*)(dbga + DBG_NS * 128); float* fa = (float*)(fe + DBG_NS * 128); float* dbgg = dbga + 3 * DBG_NS * 128; float* fg = dbgg + DBG_NS * 128;
    if (tid == 0) { bad_e = 0; bad_x = 0; bad_a = 0; bad_g = 0; } __syncthreads();
    if (tid < 128) { const int hd = tid >> 4; const int e = dbge[s * 128 + tid]; bool found = false; float af = 0.f, gf = 0.f; for (int j = 0; j < 16; ++j) if (fe[s * 128 + hd * 16 + j] == e) { found = true; af = fa[s * 128 + hd * 16 + j]; gf = fg[s * 128 + hd * 16 + j]; }
        if (!found) atomicAdd(&bad_e, 1); else { const float ea = dbga[s * 128 + tid]; if (fabsf(af - ea) > 0.02f * fabsf(ea) + 2e-3f) atomicAdd(&bad_a, 1); const float eg = dbgg[s * 128 + tid]; if (fabsf(gf - eg) > 0.02f * fabsf(eg) + 1e-3f) atomicAdd(&bad_g, 1); } }
    for (int k = 0; k < 8; ++k) { const int d = tid + 256 * k; const float ex = dbgf[(size_t)s * 2048 + d], got = args.out[(size_t)row * D + d]; if (!(fabsf(got - ex) <= 0.03f + 0.03f * fabsf(ex))) atomicAdd(&bad_x, 1); }
    __syncthreads();
    if (tid == 0) { if (bad_e > 2) atomicAdd(&cnt[1], 1u); if (bad_g > 2) atomicAdd(&cnt[2], 1u); if (bad_a > 2) atomicAdd(&cnt[3], 1u); if (bad_x > 8) atomicAdd(&cnt[4], 1u); }
}
__global__ void dbg_report(Args args) {
    unsigned* cnt = (unsigned*)(args.ws + WS_DBG);
    float code = 0.f;
    for (int lv = 1; lv <= 9; ++lv) if (cnt[lv]) { int tenths = (int)(cnt[lv] * 10 / DBG_NS); if (tenths > 9) tenths = 9; code = 1000.f * lv + 100.f * tenths; break; }
    if (code != 0.f) for (int i = threadIdx.x; i < 4096; i += blockDim.x) args.out[i] = code;
}
#endif
__device__ __forceinline__ void p_attn_gqa(const Frame& F, int last) {
    char* lds = (char*)F.lds;
    const bf16_t* QG = wsp<bf16_t>(F, WS_QG); const bf16_t* KG = wsp<bf16_t>(F, WS_KG); const bf16_t* VG = wsp<bf16_t>(F, WS_VG); unsigned char* OAB = wsp<unsigned char>(F, WS_OAB);
    const int nlat = NB * 8 * 16, nall = last ? nlat : nlat + NB * 8;
    for (int u = F.bid; u < nall; u += F.G) {
        int bh, q0, seq; size_t orow;
        if (u < nlat) {
            int uu = u;
            if (F.G == 256) {
                const int c = u & 255, i = u >> 8, xcd = c & 7, r = c >> 3, kvg = i * 4 + (xcd >> 1), within = (xcd & 1) * 32 + r;
                uu = (((kvg >> 1) * 8 + (kvg & 1) * 4 + (within >> 4)) << 4) | (within & 15); }
            bh = uu >> 4; const int qb = uu & 15; q0 = CTXL + qb * 256; seq = TT; orow = (size_t)(bh >> 3) * SEQ + qb * 256; }
        else { bh = u - nlat; q0 = 0; seq = CTXL; orow = (size_t)NLAT + (bh >> 3) * CTXL; }
        const int b = bh >> 3, h = bh & 7; const size_t kvo = (size_t)(b * 2 + (h >> 2)) * TT * 128;
        __syncthreads();
        att::attn_body<8, 4, 0, 1>(QG + ((size_t)bh * TT + q0) * 128, KG + kvo, VG + kvo, OAB + orow * D + 1024 + h * 128, seq, lds, F.tid);
    }
    __syncthreads();
}
__device__ __forceinline__ void p_attn_mla(const Frame& F, int last) {
    char* lds = (char*)F.lds;
    const bf16_t* QM = wsp<bf16_t>(F, WS_QM); const bf16_t* KM = wsp<bf16_t>(F, WS_KM); const bf16_t* VM = wsp<bf16_t>(F, WS_VM); unsigned char* OAB = wsp<unsigned char>(F, WS_OAB);
    const int nlat = NB * 8 * 16, nall = last ? nlat : nlat + NB * 8;
    for (int u = F.bid; u < nall; u += F.G) {
        int bh, q0, seq; size_t orow;
        if (u < nlat) {
            int uu = u;
            if (F.G == 256) { const int c = u & 255, i = u >> 8, xcd = c & 7, r = c >> 3; uu = ((i * 16 + xcd * 2 + (r >> 4)) << 4) | (r & 15); }
            bh = uu >> 4; const int qb = uu & 15; q0 = CTXL + qb * 256; seq = TT; orow = (size_t)(bh >> 3) * SEQ + qb * 256; }
        else { bh = u - nlat; q0 = 0; seq = CTXL; orow = (size_t)NLAT + (bh >> 3) * CTXL; }
        const int h = bh & 7;
        __syncthreads();
        att::attn_body<6, 2, 1, 2>(QM + ((size_t)bh * TT + q0) * 128, KM + (size_t)bh * TT * 128, VM + (size_t)bh * TT * 64, OAB + orow * D + h * 64, seq, lds, F.tid);
    }
    __syncthreads();
}
__device__ __forceinline__ void p_ret_out(const Frame& F, int l, int last) {
    const int c_lo = last ? 2 : 0, nc = 34 - c_lo, nu = NB * 8 * nc;
    for (int u = F.bid; u < nu; u += F.G) { const int bh = u / nc, c = c_lo + (u % nc); ret_out_unit(F, l, bh, c); }
    __syncthreads();
}

constexpr int LDS_BYTES = 147456;
constexpr int MISC_OFF = 147456 - 64;
constexpr int NPHASE = 22;
#ifndef PHM
#define PHM 0xFFFF
#endif
#ifndef PH_ATTR
#define PH_ATTR __forceinline__
#endif
__device__ PH_ATTR void ph_prologue(ArgP ap) { const Frame F = make_frame(ap); p0_prologue(F); }
__device__ PH_ATTR void ph_modreduce(ArgP ap) { const Frame F = make_frame(ap); p1_modreduce(F); }
__device__ PH_ATTR void ph_modulate0(ArgP ap) { const Frame F = make_frame(ap); p_modulate0(F); }
__device__ PH_ATTR void ph_gemm_in(ArgP ap, int l) { const Frame F = make_frame(ap);
    pg8::Gemm g{wsp<bf16_t>(F, WS_HB8), wsp<bf16_t>(F, WS_WIN + l * SZ_WIN), NROW, NPT, 1024, 1024, 1024}; pg8::StaticOrder S; S.init(NROW, NPT, F.G, F.bid);
    float mul_, inv_; fp8_scale(wsp<unsigned>(F, WS_WSC)[l], mul_, inv_);
    EpiIn E{wsp<bf16_t>(F, WS_P1), wsp<bf16_t>(F, WS_G), inv_};
    pg8::gemm_phase<EpiIn, pg8::StaticOrder>(F.lds, F.tid, g, S, E); }
__device__ PH_ATTR void ph_post(ArgP ap, int l) { const Frame F = make_frame(ap); p_post(F, l); if (l == 1) cvt_peer(F, 1); }
__device__ PH_ATTR void ph_qup(ArgP ap, int l) { const Frame F = make_frame(ap);
    pg8::Gemm g{wsp<bf16_t>(F, WS_CQN), wsp<bf16_t>(F, WS_WQUP + l * SZ_WQUP), NROW, 768, 512, 512, 512}; pg8::StaticOrder S; S.init(NROW, 768, F.G, F.bid);
    EpiQup E{wsp<bf16_t>(F, WS_QM), wsp<f32x2>(F, WS_ROPE32)};
    pg8::gemm_phase<EpiQup, pg8::StaticOrder>(F.lds, F.tid, g, S, E); }
__device__ PH_ATTR void ph_kvup(ArgP ap, int l) { const Frame F = make_frame(ap);
    pg8::Gemm g{wsp<bf16_t>(F, WS_CKVN), wsp<bf16_t>(F, WS_WKVUP + l * SZ_WKVUP), NROW, 1024, 256, 256, 256}; pg8::StaticOrder S; S.init(NROW, 1024, F.G, F.bid);
    EpiKvup E{wsp<bf16_t>(F, WS_KM), wsp<bf16_t>(F, WS_VM)};
    pg8::gemm_phase<EpiKvup, pg8::StaticOrder>(F.lds, F.tid, g, S, E); }
__device__ PH_ATTR void ph_states(ArgP ap, int l) { const Frame F = make_frame(ap); p_ret_states(F, l); }
__device__ PH_ATTR void ph_attn_gqa(ArgP ap, int last) { const Frame F = make_frame(ap); p_attn_gqa(F, last); }
__device__ PH_ATTR void ph_attn_mla(ArgP ap, int last) { const Frame F = make_frame(ap); p_attn_mla(F, last); }
__device__ PH_ATTR void ph_ret_out(ArgP ap, int l, int last) { const Frame F = make_frame(ap); p_ret_out(F, l, last); }
template <int SEG> __device__ PH_ATTR void ph_merge(ArgP ap, int l, int Mx) { const Frame F = make_frame(ap);
    const bf16_t* OAB = wsp<bf16_t>(F, WS_OAB); bf16_t* MB = wsp<bf16_t>(F, WS_MB); const bf16_t* G = wsp<bf16_t>(F, WS_G);
    pg8::StaticOrder S; S.init(Mx, 2048, F.G, F.bid);
    const size_t wo = SEG == 0 ? WS_WBRA + l * SZ_WBRA : (SEG == 1 ? WS_WBRB + l * SZ_WBRB : WS_WBRC + l * SZ_WBRC); const int K = SEG == 2 ? 1024 : 512;
    pg8::Gemm g{OAB + SEG * 512, wsp<bf16_t>(F, wo), Mx, 2048, K, 2048, K}; EpiMerge<SEG> E{MB, G, wsp<unsigned char>(F, WS_MB8)}; pg8::gemm_phase<EpiMerge<SEG>, pg8::StaticOrder>(F.lds, F.tid, g, S, E); }
__device__ PH_ATTR void ph_merge3(ArgP ap, int l, int Mx) { const Frame F = make_frame(ap);
    pg8::StaticOrder S; S.init(Mx, 2048, F.G, F.bid);
    float m0_, i0_, m1_, i1_, m2_, i2_; fp8_scale(wsp<unsigned>(F, WS_WSC)[4 + l], m0_, i0_); fp8_scale(wsp<unsigned>(F, WS_WSC)[6 + l], m1_, i1_); fp8_scale(wsp<unsigned>(F, WS_WSC)[8 + l], m2_, i2_);
    pg8::Merge3 g{wsp<bf16_t>(F, WS_OAB), wsp<bf16_t>(F, WS_WBRA + l * SZ_WBRA), wsp<bf16_t>(F, WS_WBRB + l * SZ_WBRB), wsp<bf16_t>(F, WS_WBRC + l * SZ_WBRC), wsp<bf16_t>(F, WS_G), wsp<unsigned char>(F, WS_MB8), i0_ * m1_, i1_ * m2_, i2_};
    pg8::gemm_merge3<pg8::StaticOrder>(F.lds, F.tid, g, S); }
__device__ PH_ATTR void ph_out(ArgP ap, int l, int Mx) { const Frame F = make_frame(ap);
    pg8::Gemm g{wsp<bf16_t>(F, WS_MB8), wsp<bf16_t>(F, WS_WOUT + l * SZ_WOUT), Mx, 2048, 1024, 1024, 1024}; pg8::StaticOrder S; S.init(Mx, 2048, F.G, F.bid);
    float mul_, inv_; fp8_scale(wsp<unsigned>(F, WS_WSC)[2 + l], mul_, inv_);
    EpiOut E{l == 0 ? F.in(0) : F.out, l == 0 ? F.in(2) : wsp<float>(F, WS_XC), F.out, wsp<float>(F, WS_XC), wsp<float>(F, WS_MOD) + (size_t)l * 5 * 12288 + 4096, inv_ * (1.f / 16.f)};
    pg8::gemm_phase<EpiOut, pg8::StaticOrder>(F.lds, F.tid, g, S, E); }
__device__ PH_ATTR void ph_ln1(ArgP ap, int l, int last) { const Frame F = make_frame(ap); p_ln1(F, l, last); }
__device__ PH_ATTR void ph_peerq(ArgP ap, int l, int Mx) { const Frame F = make_frame(ap);
    pg8::Gemm g{wsp<bf16_t>(F, WS_HB), wsp<bf16_t>(F, WS_WPQ + l * SZ_WPQ), Mx, 1024, 2048, 2048, 2048}; pg8::StaticOrder S; S.init(Mx, 1024, F.G, F.bid);
    EpiPlain E{wsp<bf16_t>(F, WS_QP), 1024};
    pg8::gemm_phase<EpiPlain, pg8::StaticOrder>(F.lds, F.tid, g, S, E); }
__device__ PH_ATTR void ph_peer(ArgP ap, int l, int last) { const Frame F = make_frame(ap); p_peer(F, l, last); }

__global__ void __launch_bounds__(512, 2) mega_fwd(Args args) {
    extern __shared__ __attribute__((aligned(16))) unsigned char lds_raw[];
    const ArgP ap = (ArgP)__builtin_amdgcn_kernarg_segment_ptr();
    const int lo = ap->ph_lo, hi = ap->ph_hi;
    volatile LAS unsigned* misc = (volatile LAS unsigned*)((LAS unsigned char*)lds_raw + MISC_OFF);
    if (threadIdx.x < 4) misc[threadIdx.x] = 0u;
    __syncthreads();
    XcdBarrier bar; bar.bar = (unsigned*)(ap->ws + WS_CTL); bar.x = 0; bar.st = misc;
    if (hi - lo > 1) bar = xcd_barrier_post((unsigned*)(ap->ws + WS_CTL), misc);
#define IN(k) (lo <= (k) && (k) < hi)
#define SEAM(k) do { if (IN(k) && IN((k) + 1)) xcd_barrier(bar); } while (0)
    if (IN(0)) { if (PHM & 1) ph_prologue(ap); if (REP_PRO) ph_prologue(ap); } SEAM(0);
    if (IN(1)) { if (PHM & 2) ph_modreduce(ap); if (REP_X & 32) ph_modreduce(ap); } SEAM(1);
#pragma unroll 1
    for (int l = 0; l < 2; ++l) {
        const int pb = 2 + 10 * l; const int last = (l == 1);
        const int Mx = last ? NLAT : NROW;
        if (l == 0) { if (IN(pb)) { if (PHM & 4) ph_modulate0(ap); if (REP_X & 64) ph_modulate0(ap); } SEAM(pb); }
        if (IN(pb + 1)) { if (PHM & 8) ph_gemm_in(ap, l); if (REP_GIN) ph_gemm_in(ap, l); } SEAM(pb + 1);
        if (IN(pb + 2)) { if (PHM & 16) ph_post(ap, l); if (REP_X & 1) ph_post(ap, l); } SEAM(pb + 2);
        if (IN(pb + 3)) { if (PHM & 32) ph_qup(ap, l); if (PHM & 64) ph_kvup(ap, l); if (PHM & 128) ph_states(ap, l); if (REP_X & 2) { ph_qup(ap, l); ph_kvup(ap, l); ph_states(ap, l); } } SEAM(pb + 3);
        if (IN(pb + 4)) { if (PHM & 256) ph_attn_gqa(ap, last); if (PHM & 512) ph_attn_mla(ap, last); if (REP_ATTN) { ph_attn_gqa(ap, last); ph_attn_mla(ap, last); } if (REP_X & 4) ph_ret_out(ap, l, last); if (PHM & 1024) ph_ret_out(ap, l, last); } SEAM(pb + 4);
        if (IN(pb + 5)) { if (PHM & 2048) { if (MERGE3) ph_merge3(ap, l, Mx); else { ph_merge<0>(ap, l, Mx); ph_merge<1>(ap, l, Mx); ph_merge<2>(ap, l, Mx); } } if (REP_X & 8) { if (MERGE3) ph_merge3(ap, l, Mx); else { ph_merge<0>(ap, l, Mx); ph_merge<1>(ap, l, Mx); ph_merge<2>(ap, l, Mx); } } } SEAM(pb + 5);
        if (IN(pb + 6)) { if (PHM & 4096) ph_out(ap, l, Mx); } SEAM(pb + 6);
        if (IN(pb + 7)) { if (PHM & 8192) ph_ln1(ap, l, last); } SEAM(pb + 7);
        if (IN(pb + 8)) { if (PHM & 16384) ph_peerq(ap, l, Mx); if (REP_X & 16) ph_peerq(ap, l, Mx); } SEAM(pb + 8);
        if (IN(pb + 9)) { if (PHM & 32768) ph_peer(ap, l, last); } SEAM(pb + 9);
    }
#undef IN
#undef SEAM
}

extern "C" void kernel_launch(void* const* d_in, const int* in_sizes, int n_in, void* d_out, int out_size, void* d_ws, size_t ws_size, hipStream_t stream) {
    static int grid = 0;
    if (grid == 0) {
        if (n_in != 27 || out_size != NLAT * D || ws_size < WS_END) { fprintf(stderr, "kernel_launch: unexpected shapes: n_in %d out %d ws %zu (need %zu)\n", n_in, out_size, ws_size, (size_t)WS_END); grid = -1; return; }
        int dev = 0, cus = 0, per_cu = 0;
        if (hipGetDevice(&dev) != hipSuccess || hipDeviceGetAttribute(&cus, hipDeviceAttributeMultiprocessorCount, dev) != hipSuccess) { grid = -1; return; }
        if (hipFuncSetAttribute((const void*)mega_fwd, hipFuncAttributeMaxDynamicSharedMemorySize, LDS_BYTES) != hipSuccess) { fprintf(stderr, "kernel_launch: hipFuncSetAttribute failed\n"); grid = -1; return; }
        if (hipOccupancyMaxActiveBlocksPerMultiprocessor(&per_cu, (const void*)mega_fwd, 512, LDS_BYTES) != hipSuccess || per_cu < 1) fprintf(stderr, "kernel_launch: occupancy query reports %d\n", per_cu);
        (void)hipGetLastError();
        grid = cus;
    }
    if (grid < 0) return;
    (void)hipMemsetAsync((char*)d_ws + WS_CTL, 0, 65536, stream);
#ifdef DBG
    (void)hipMemsetAsync((char*)d_ws + WS_CTL + 131072, 0, 4096, stream);
#endif
    Args a{};
    for (int i = 0; i < 27; ++i) a.in[i] = (const float*)d_in[i];
    a.out = (float*)d_out; a.ws = (unsigned char*)d_ws;
#if MK_PER_PHASE
    for (int p = 0; p < NPHASE; ++p) { if (p == 12) continue; a.ph_lo = p; a.ph_hi = p + 1;
#ifdef DBG
        if (p == 11) hipLaunchKernelGGL(dbg_peer_pre, dim3(DBG_NS), dim3(256), 0, stream, a, 0);
#endif
        hipLaunchKernelGGL(mega_fwd, dim3(grid), dim3(512), LDS_BYTES, stream, a);
#ifdef DBG
        if (p == 11) hipLaunchKernelGGL(dbg_peer_post, dim3(DBG_NS), dim3(256), 0, stream, a);
#endif
    }
#ifdef DBG
    hipLaunchKernelGGL(dbg_report, dim3(1), dim3(256), 0, stream, a);
#endif
#else
    a.ph_lo = 0; a.ph_hi = NPHASE;
    hipLaunchKernelGGL(mega_fwd, dim3(grid), dim3(512), LDS_BYTES, stream, a);
#endif
    const hipError_t le = hipPeekAtLastError();
    if (le != hipSuccess) fprintf(stderr, "kernel_launch: launch failed: %s\n", hipGetErrorName(le));
}
```

```cpp
#include <hip/hip_runtime.h>
#include <cstdio>
#include <cstdint>
#include <cstddef>

#ifndef MK_PER_PHASE
#define MK_PER_PHASE 0
#endif

#ifndef ABL_PEER
#define ABL_PEER 0
#endif
#ifndef REP_PEERG
#define REP_PEERG 0
#endif
#ifndef REP_PEERH
#define REP_PEERH 0
#endif
#ifndef REP_X
#define REP_X 0
#endif
#ifndef REP_PS1
#define REP_PS1 0
#endif
#ifndef REP_PS2
#define REP_PS2 0
#endif
#ifndef SIDE_ON
#define SIDE_ON 1
#endif
#ifndef REP_DOT
#define REP_DOT 0
#endif
#ifndef MERGE3
#define MERGE3 1
#endif
#ifndef REP_GIN
#define REP_GIN 0
#endif
#ifndef REP_ATTN
#define REP_ATTN 0
#endif
#ifndef REP_PRO
#define REP_PRO 0
#endif
#ifndef ABL_BR
#define ABL_BR 0
#endif
#ifndef ABL_MIX
#define ABL_MIX 0
#endif
#define LAS __attribute__((address_space(3)))
typedef unsigned short bf16_t;
typedef short bf16x8 __attribute__((ext_vector_type(8)));
typedef short s16x4 __attribute__((ext_vector_type(4)));
typedef float f32x2 __attribute__((ext_vector_type(2)));
typedef float f32x4 __attribute__((ext_vector_type(4)));
typedef float f32x8 __attribute__((ext_vector_type(8)));
typedef float f32x16 __attribute__((ext_vector_type(16)));
typedef unsigned u32x2 __attribute__((ext_vector_type(2)));
typedef unsigned u32x4 __attribute__((ext_vector_type(4)));
typedef __bf16 bf2_t __attribute__((ext_vector_type(2)));

constexpr int D = 2048, NB = 4, SEQ = 4096, CTXL = 256, TT = SEQ + CTXL;
constexpr int NLAT = NB * SEQ, NCTX = NB * CTXL, NROW = NLAT + NCTX;
constexpr int NP1 = 4096, NG = 6144, NPT = NP1 + NG;
constexpr int NIN = 10016;
constexpr float ALPHA = 1.4142135623730951f;
constexpr float LN_EPS = 1e-5f, RMS_EPS = 1e-6f;
constexpr float LOG2E = 1.4426950408889634f;
constexpr int C_CQ = 0, C_CKV = 512, C_GQ = 768, C_GK = 1792, C_GV = 2048, C_RQ = 2304, C_RK = 2560, C_RV = 2816, C_RG = 3328, C_KR = 3840;

constexpr size_t AL(size_t x) { return (x + 255) / 256 * 256; }
constexpr size_t WS_CTL = 0;                                    constexpr size_t CTL_BYTES = 1u << 20;
constexpr size_t WS_WSC = WS_CTL + 32768;
constexpr size_t WS_CVT = WS_CTL + 33024;
constexpr size_t WS_DEC = WS_CTL + 65536;
constexpr size_t WS_ROPE32 = WS_CTL + CTL_BYTES;
constexpr size_t WS_ROPE128 = WS_ROPE32 + AL(64 * 8 * 8);
constexpr size_t WS_MODP = WS_ROPE128 + AL(64 * 32 * 8);
constexpr size_t WS_MOD = WS_MODP + AL((size_t)16 * 2 * 5 * 12288 * 4);
constexpr size_t WS_WIN = WS_MOD + AL((size_t)2 * 5 * 12288 * 4);
constexpr size_t SZ_WIN = (size_t)NPT * D;
constexpr size_t WS_WQUP = WS_WIN + 2 * SZ_WIN;                 constexpr size_t SZ_WQUP = (size_t)768 * 512 * 2;
constexpr size_t WS_WKVUP = WS_WQUP + 2 * SZ_WQUP;              constexpr size_t SZ_WKVUP = (size_t)1024 * 256 * 2;
constexpr size_t WS_WBRA = WS_WKVUP + 2 * SZ_WKVUP;             constexpr size_t SZ_WBRA = (size_t)2048 * 512 * 2;
constexpr size_t WS_WBRB = WS_WBRA + 2 * SZ_WBRA;               constexpr size_t SZ_WBRB = SZ_WBRA;
constexpr size_t WS_WBRC = WS_WBRB + 2 * SZ_WBRB;               constexpr size_t SZ_WBRC = (size_t)2048 * 1024 * 2;
constexpr size_t WS_WOUT = WS_WBRC + 2 * SZ_WBRC;               constexpr size_t SZ_WOUT = (size_t)2048 * 2048 * 2;
constexpr size_t WS_WPQ = WS_WOUT + 2 * SZ_WOUT;                constexpr size_t SZ_WPQ = (size_t)1024 * 2048 * 2;
constexpr size_t WS_PSC = WS_WPQ + 2 * SZ_WPQ;
constexpr size_t WS_PU = WS_PSC + (size_t)4 * 16384 * 4;        constexpr size_t SZ_PT = (size_t)16384 * 1152;
constexpr size_t WS_PV = WS_PU + 2 * SZ_PT;
constexpr size_t WS_XC = WS_PV + 2 * SZ_PT;
constexpr size_t WS_HB = WS_XC + (size_t)NCTX * D * 4;
constexpr size_t WS_P1 = WS_HB + (size_t)NROW * D * 2;
constexpr size_t WS_G = WS_P1 + (size_t)NROW * NP1 * 2;
constexpr size_t WS_CQN = WS_G + (size_t)NROW * NG * 2;
constexpr size_t WS_CKVN = WS_CQN + (size_t)NROW * 512 * 2;
constexpr size_t WS_QM = WS_CKVN + (size_t)NROW * 256 * 2;
constexpr size_t SZ_Q128 = (size_t)NB * 8 * TT * 128 * 2;
constexpr size_t WS_KM = WS_QM + SZ_Q128;
constexpr size_t WS_VM = WS_KM + SZ_Q128;
constexpr size_t WS_QG = WS_VM + SZ_Q128 / 2;
constexpr size_t WS_KG = WS_QG + SZ_Q128;
constexpr size_t WS_VG = WS_KG + SZ_Q128 / 4;
constexpr size_t WS_RQ = WS_VG + SZ_Q128 / 4;
constexpr size_t WS_RK = WS_RQ + SZ_Q128 / 4;
constexpr size_t WS_RV = WS_RK + SZ_Q128 / 4;
constexpr size_t WS_ST = WS_RV + SZ_Q128 / 2;
constexpr size_t WS_OAB = WS_ST + (size_t)NB * 8 * 34 * 2 * 2048 * 4;
constexpr size_t WS_HB8 = WS_OAB + (size_t)NROW * D * 2;
constexpr size_t WS_MB8 = WS_HB8 + (size_t)NROW * D;
constexpr size_t WS_END = WS_MB8 + (size_t)NROW * D;
constexpr size_t WS_MB = WS_QM;
constexpr size_t WS_QP = WS_QG;
static_assert((size_t)NROW * D * 2 <= 2 * SZ_Q128, "MB alias");
static_assert((size_t)NROW * 1024 * 2 <= SZ_Q128, "QP alias");

__device__ __forceinline__ unsigned cvt_pk_bf16(float lo, float hi) { unsigned r; asm volatile("v_cvt_pk_bf16_f32 %0, %1, %2" : "=v"(r) : "v"(lo), "v"(hi)); return r; }
__device__ __forceinline__ bf16_t f2bf(float f) { return (bf16_t)(cvt_pk_bf16(f, 0.f) & 0xffffu); }
__device__ __forceinline__ float bf2f(bf16_t b) { return __uint_as_float(((unsigned)b) << 16); }
__device__ __forceinline__ float bflo(unsigned w) { return __uint_as_float(w << 16); }
__device__ __forceinline__ float bfhi(unsigned w) { return __uint_as_float(w & 0xffff0000u); }
template <int CTRL> __device__ __forceinline__ float dppf(float x) { return __int_as_float(__builtin_amdgcn_update_dpp(0, __float_as_int(x), CTRL, 0xF, 0xF, true)); }
__device__ __forceinline__ float row16_sum(float x) { x += dppf<0xB1>(x); x += dppf<0x4E>(x); x += dppf<0x141>(x); x += dppf<0x140>(x); return x; }
__device__ __forceinline__ float row16_max(float x) { x = fmaxf(x, dppf<0xB1>(x)); x = fmaxf(x, dppf<0x4E>(x)); x = fmaxf(x, dppf<0x141>(x)); x = fmaxf(x, dppf<0x140>(x)); return x; }
__device__ __forceinline__ float wave_sum(float x) {
    x = row16_sum(x);
    { auto r = __builtin_amdgcn_permlane16_swap(__float_as_uint(x), __float_as_uint(x), false, false); x = __uint_as_float(r[0]) + __uint_as_float(r[1]); }
    { auto r = __builtin_amdgcn_permlane32_swap(__float_as_uint(x), __float_as_uint(x), false, false); x = __uint_as_float(r[0]) + __uint_as_float(r[1]); }
    return x;
}
__device__ __forceinline__ unsigned pk4_fp8(float a, float b, float c, float d) { int t = 0; t = __builtin_amdgcn_cvt_pk_fp8_f32(a, b, t, false); t = __builtin_amdgcn_cvt_pk_fp8_f32(c, d, t, true); return (unsigned)t; }
__device__ __forceinline__ float clamp8(float x) { return fminf(fmaxf(x, -440.f), 440.f); }
__device__ __forceinline__ void fp8_scale(unsigned amax_bits, float& mul, float& inv) { const float am = __uint_as_float(amax_bits); int k = 0; if (am > 0.f) k = (int)floorf(log2f(256.f / am)); k = k > 60 ? 60 : (k < -60 ? -60 : k); mul = exp2f((float)k); inv = exp2f((float)-k); }
__device__ __forceinline__ float silu_f(float x) { return x / (1.f + __expf(-x)); }
__device__ __forceinline__ float sigmoid_f(float x) { return 1.f / (1.f + __expf(-x)); }

struct RowInfo { int b, tpos, pr, pc, v; bool lat; };
__device__ __forceinline__ RowInfo rowinfo(int row) {
    RowInfo r;
    if (row < NLAT) { r.lat = true; r.b = row >> 12; const int t = row & 4095; r.tpos = CTXL + t; r.pr = t >> 6; r.pc = t & 63; r.v = r.b; }
    else { const int q = row - NLAT; r.lat = false; r.b = q >> 8; r.tpos = q & 255; r.pr = 0; r.pc = 0; r.v = 4; }
    return r;
}

#define XB_TMO      128
#define XB_XCNT(j)  (256  + 64 * (j))
#define XB_XSUB(j)  (1280 + 64 * (j))
#define XB_XGEN(j)  (2304 + 64 * (j))
#define XB_TOP      3328
#define XB_TOPGEN   3392
#define XCD_BAR_WORDS 3456
#define XB_SPIN_CAP (1u << 22)

__device__ __forceinline__ unsigned xb_ld(unsigned* p)              { return __hip_atomic_load(p, __ATOMIC_RELAXED, __HIP_MEMORY_SCOPE_AGENT); }
__device__ __forceinline__ unsigned xb_add(unsigned* p, unsigned v) { return __hip_atomic_fetch_add(p, v, __ATOMIC_RELAXED, __HIP_MEMORY_SCOPE_AGENT); }
__device__ __forceinline__ unsigned xb_xcc_id() { return (unsigned)__builtin_amdgcn_s_getreg((3 << 11) | 20) & 0xFu; }
#define XB_SPIN(cond, bar) do { unsigned _sp = 0; while (cond) { __builtin_amdgcn_s_sleep(1); \
    if ((++_sp & 255u) == 0u) { if (xb_ld(&(bar)[XB_TMO])) break; if (_sp > XB_SPIN_CAP) { atomicAdd(&(bar)[XB_TMO], 1u); break; } } } } while (0)

struct XcdBarrier { unsigned* bar; unsigned x; volatile LAS unsigned* st; };

__device__ __forceinline__ XcdBarrier xcd_barrier_post(unsigned* bar, volatile LAS unsigned* st) {
    XcdBarrier b; b.bar = bar; b.x = xb_xcc_id(); b.st = st;
    if (threadIdx.x == 0) (void)xb_add(&bar[XB_XCNT(b.x)], 1u);
    return b;
}
__device__ __forceinline__ void xcd_barrier_complete(unsigned* bar, unsigned x, unsigned& nloc, unsigned& nx) {
    const unsigned G = gridDim.x * gridDim.y * gridDim.z;
    unsigned sum, cnt, mine, sp = 0u;
    for (;;) {
        sum = 0u; cnt = 0u; mine = 0u;
#pragma unroll
        for (unsigned j = 0; j < 16; ++j) { const unsigned c = xb_ld(&bar[XB_XCNT(j)]); sum += c; cnt += (c > 0u) ? 1u : 0u; mine = (j == x) ? c : mine; }
        if (sum == G) break;
        __builtin_amdgcn_s_sleep(1);
        if ((++sp & 255u) == 0u) { if (xb_ld(&bar[XB_TMO])) break; if (sp > XB_SPIN_CAP) { atomicAdd(&bar[XB_TMO], 1u); break; } }
    }
    nloc = mine > 0u ? mine : 1u; nx = cnt > 0u ? cnt : 1u;
}
__device__ __forceinline__ void xcd_barrier(const XcdBarrier& b) {
    asm volatile("s_waitcnt vmcnt(0)" ::: "memory");
    __syncthreads();
    if (threadIdx.x == 0) {
        unsigned* bar = b.bar;
        __builtin_amdgcn_s_waitcnt(0);
        unsigned nloc = b.st[0], nx = b.st[1];
        if (nloc == 0u) { xcd_barrier_complete(bar, b.x, nloc, nx); b.st[0] = nloc; b.st[1] = nx; }
        const unsigned old = xb_add(&bar[XB_XSUB(b.x)], 1u);
        const unsigned gen = old / nloc;
        if (old + 1u == (gen + 1u) * nloc) {
            __builtin_amdgcn_fence(__ATOMIC_RELEASE, "agent");
            asm volatile("s_waitcnt vmcnt(0)" ::: "memory");
            const unsigned og = xb_add(&bar[XB_TOP], 1u);
            const unsigned tg = og / nx;
            if (og + 1u == (tg + 1u) * nx) xb_add(&bar[XB_TOPGEN], 1u);
            else XB_SPIN(xb_ld(&bar[XB_TOPGEN]) == tg, bar);
            __builtin_amdgcn_fence(__ATOMIC_ACQUIRE, "agent");
            xb_add(&bar[XB_XGEN(b.x)], 1u);
            asm volatile("s_waitcnt vmcnt(0)" ::: "memory");
        } else {
            XB_SPIN(xb_ld(&bar[XB_XGEN(b.x)]) == gen, bar);
            __builtin_amdgcn_fence(__ATOMIC_ACQUIRE, "agent");
            asm volatile("s_waitcnt vmcnt(0)" ::: "memory");
        }
    }
    __syncthreads();
}
namespace pg8 {
constexpr int BM = 256, BK = 64, HALF = 128, HTB = HALF * BK * 2, STAGE_BYTES = 8 * HTB, NXCD = 8, WGM = 8;
__host__ __device__ __forceinline__ int lds_byte(int r, int c) { const int st = (r >> 4) * 2 + (c >> 5), rr = r & 15, cc = c & 31, ob = rr * 64 + cc * 2; return st * 1024 + (ob ^ (((ob >> 9) & 1) << 5)); }
__host__ __device__ __forceinline__ void stage_rc(int b, int& R, int& C) { const int st = b / 1024, sb = b % 1024, swz = sb ^ (((sb >> 9) & 1) << 5); R = (st >> 1) * 16 + swz / 64; C = (st & 1) * 32 + (swz % 64) / 2; }
__host__ __device__ __forceinline__ int perm32(int rho) { const int n = rho >> 4, i = rho & 15; return 8 * (i >> 2) + 4 * n + (i & 3); }

struct Unit { int pm, pn; };
typedef int i32x8 __attribute__((ext_vector_type(8))); typedef int i32x4v __attribute__((ext_vector_type(4)));
__device__ __forceinline__ i32x8 cat8(const bf16x8 a, const bf16x8 b) { const i32x4v x = __builtin_bit_cast(i32x4v, a), y = __builtin_bit_cast(i32x4v, b); return __builtin_shufflevector(x, y, 0, 1, 2, 3, 4, 5, 6, 7); }
struct Gemm { const bf16_t* A; const bf16_t* Bt; int M, N, K, lda, ldb; };

struct StaticOrder {
    int nM, nN, nwg, G, c;
    __host__ __device__ void init(int M, int N, int G_, int c_) { nM = M / BM; nN = N / BM; nwg = nM * nN; G = G_; c = c_; }
    __host__ __device__ bool next(int i, Unit& u) const {
        const long L = (long)i * G + c; if (L >= nwg) return false;
        int wgid = (int)L; { const int q = nwg / NXCD, r = nwg % NXCD, xcd = wgid % NXCD, off = wgid / NXCD; wgid = (xcd < r ? xcd * (q + 1) : r * (q + 1) + (xcd - r) * q) + off; }
        const int nig = WGM * nN, gid = wgid / nig, fm = gid * WGM, gsz = (nM - fm) < WGM ? (nM - fm) : WGM;
        u.pm = fm + ((wgid % nig) % gsz); u.pn = (wgid % nig) / gsz; return true;
    }
    __device__ __forceinline__ void a_ready(const Unit&) const {}
    __device__ __forceinline__ void done(const Unit&) const {}
};

template <class Epi, class Sched>
__device__ __forceinline__ void gemm_phase(LAS unsigned char* lds, const int tid, const Gemm g, const Sched& S, const Epi& E) {
    const int  wid = __builtin_amdgcn_readfirstlane(tid >> 6), lane = tid & 63, wr = wid >> 2, wc = wid & 3, fr = lane & 15, fq = lane >> 4;
    const int K = g.K, nt = K / BK;
    unsigned voffA[2], voffB[2];
#pragma unroll
    for (int i = 0; i < 2; ++i) { int R, C; stage_rc(tid * 16 + i * 8192, R, C); const int Rb = Epi::PERM ? ((R & ~31) + perm32(R & 31)) : R;
        voffA[i] = (unsigned)(R * g.lda + C) * 2u; voffB[i] = (unsigned)(Rb * g.ldb + C) * 2u; }
    const size_t kstep = (size_t)(BK * 2);
    const size_t hstepA = (size_t)HALF * g.lda * 2, hstepB = (size_t)HALF * g.ldb * 2;
    const size_t tstepA = 2 * hstepA, tstepB = 2 * hstepB;
    const unsigned ldsw = (unsigned)wid * 1024u;
    const int aoff = lds_byte(wr * 64 + fr, fq * 8), boff = lds_byte(wc * 32 + fr, fq * 8);
#define PG8_SA(b, h) (((b) * 2 + (h)) * HTB)
#define PG8_SB(b, h) ((4 + (b) * 2 + (h)) * HTB)
#define PG8_STAGE(bufoff, gbase, voff) do { _Pragma("unroll") for (int _i = 0; _i < 2; ++_i) \
        __builtin_amdgcn_global_load_lds((const unsigned*)((const char*)(gbase) + (voff)[_i]), (LAS unsigned*)(lds + (bufoff) + ldsw + _i * 8192), 16, 0, 0); } while (0)
#define PG8_LDA(dst, b, h) do { if constexpr (Epi::FP8) { _Pragma("unroll") for (int m = 0; m < 4; ++m) { const i32x4v lo_ = *(const LAS i32x4v*)(lds + PG8_SA(b, h) + aoff + m * 2048), hi_ = *(const LAS i32x4v*)(lds + PG8_SA(b, h) + aoff + m * 2048 + 1024); \
            dst##8[m] = __builtin_shufflevector(lo_, hi_, 0, 1, 2, 3, 4, 5, 6, 7); } } \
        else { _Pragma("unroll") for (int m = 0; m < 4; ++m) _Pragma("unroll") for (int k = 0; k < 2; ++k) dst[m][k] = *(const LAS bf16x8*)(lds + PG8_SA(b, h) + aoff + m * 2048 + k * 1024); } } while (0)
#define PG8_LDB(dst, b, h) do { if constexpr (Epi::FP8) { _Pragma("unroll") for (int n = 0; n < 2; ++n) { const i32x4v lo_ = *(const LAS i32x4v*)(lds + PG8_SB(b, h) + boff + n * 2048), hi_ = *(const LAS i32x4v*)(lds + PG8_SB(b, h) + boff + n * 2048 + 1024); \
            dst##8[n] = __builtin_shufflevector(lo_, hi_, 0, 1, 2, 3, 4, 5, 6, 7); } } \
        else { _Pragma("unroll") for (int n = 0; n < 2; ++n) _Pragma("unroll") for (int k = 0; k < 2; ++k) dst[n][k] = *(const LAS bf16x8*)(lds + PG8_SB(b, h) + boff + n * 2048 + k * 1024); } } while (0)
#define PG8_MMA(ai, bj, At, Bt) do { __builtin_amdgcn_s_setprio(1); _Pragma("unroll") for (int m = 0; m < 4; ++m) _Pragma("unroll") for (int n = 0; n < 2; ++n) { \
        if constexpr (Epi::FP8) asm volatile("v_mfma_scale_f32_16x16x128_f8f6f4 %0, %1, %2, %0, %3, %3 op_sel_hi:[0,0,0]" : "+v"(acc[ai][bj][m][n]) : "v"(Bt##8[n]), "v"(At##8[m]), "v"(sc1_)); \
        else { _Pragma("unroll") for (int k = 0; k < 2; ++k) acc[ai][bj][m][n] = __builtin_amdgcn_mfma_f32_16x16x32_bf16(Bt[n][k], At[m][k], acc[ai][bj][m][n], 0, 0, 0); } } __builtin_amdgcn_s_setprio(0); } while (0)
#define PG8_WAIT_V(n) asm volatile("s_waitcnt vmcnt(" #n ")" ::: "memory")
#define PG8_WAIT_L(n) asm volatile("s_waitcnt lgkmcnt(" #n ")" ::: "memory")
#define PG8_BAR __builtin_amdgcn_s_barrier()
#define PG8_SCHED __builtin_amdgcn_sched_barrier(0)
    Unit cur, nxt; int ui = 0;
    if (!S.next(0, cur)) return;
    f32x4 acc[2][2][4][2];
#pragma unroll
    for (int a = 0; a < 2; ++a)
#pragma unroll
        for (int b = 0; b < 2; ++b)
#pragma unroll
            for (int m = 0; m < 4; ++m)
#pragma unroll
                for (int n = 0; n < 2; ++n) acc[a][b][m][n] = (f32x4){0.f, 0.f, 0.f, 0.f};
    int sc1_ = 0x7F7F7F7F; asm volatile("" : "+v"(sc1_));
    bf16x8 At[4][2], B0[2][2], B1[2][2]; i32x8 At8[4], B08[2], B18[2];
    const char* cA = (const char*)g.A + (size_t)cur.pm * tstepA; const char* cB = (const char*)g.Bt + (size_t)cur.pn * tstepB;
    S.a_ready(cur);
    PG8_STAGE(PG8_SB(0, 0), cB, voffB); PG8_STAGE(PG8_SA(0, 0), cA, voffA); PG8_STAGE(PG8_SB(0, 1), cB + hstepB, voffB); PG8_STAGE(PG8_SA(0, 1), cA + hstepA, voffA);
    if (wr == 1) PG8_BAR;
    PG8_WAIT_V(4); PG8_BAR;
    PG8_STAGE(PG8_SB(1, 0), cB + kstep, voffB); PG8_STAGE(PG8_SA(1, 0), cA + kstep, voffA); PG8_STAGE(PG8_SB(1, 1), cB + hstepB + kstep, voffB);
    PG8_WAIT_V(6); PG8_BAR;
    for (;;) {
        const bool has_next = S.next(ui + 1, nxt);
        const char* nA = has_next ? (const char*)g.A + (size_t)nxt.pm * tstepA : cA; const char* nB = has_next ? (const char*)g.Bt + (size_t)nxt.pn * tstepB : cB;
#pragma unroll 1
        for (int t = 0; t < nt; t += 2) {
            const bool last = (t == nt - 2);
            const char* a1 = cA + (size_t)(t + 1) * kstep;
            const char* a2 = last ? nA : cA + (size_t)(t + 2) * kstep; const char* b2 = last ? nB : cB + (size_t)(t + 2) * kstep;
            const char* a3 = a2 + kstep; const char* b3 = b2 + kstep;
            if (last && has_next) S.a_ready(nxt);
            PG8_LDB(B0, 0, 0); PG8_SCHED; PG8_LDA(At, 0, 0); PG8_STAGE(PG8_SA(1, 1), a1 + hstepA, voffA);
            PG8_WAIT_L(8); PG8_BAR; PG8_WAIT_L(0); PG8_MMA(0, 0, At, B0); PG8_BAR; PG8_SCHED;
            PG8_LDB(B1, 0, 1); PG8_STAGE(PG8_SB(0, 0), b2, voffB);
            PG8_BAR; PG8_WAIT_L(0); PG8_MMA(0, 1, At, B1); PG8_BAR;
            PG8_LDA(At, 0, 1); PG8_STAGE(PG8_SA(0, 0), a2, voffA);
            PG8_BAR; PG8_WAIT_L(0); PG8_MMA(1, 0, At, B0); PG8_BAR; PG8_SCHED;
            PG8_STAGE(PG8_SB(0, 1), b2 + hstepB, voffB);
            PG8_WAIT_V(6); PG8_BAR; PG8_MMA(1, 1, At, B1); PG8_BAR;
            PG8_LDB(B0, 1, 0); PG8_SCHED; PG8_LDA(At, 1, 0); PG8_STAGE(PG8_SA(0, 1), a2 + hstepA, voffA);
            PG8_WAIT_L(8); PG8_BAR; PG8_WAIT_L(0); PG8_MMA(0, 0, At, B0); PG8_BAR; PG8_SCHED;
            PG8_LDB(B1, 1, 1); PG8_STAGE(PG8_SB(1, 0), b3, voffB);
            PG8_BAR; PG8_WAIT_L(0); PG8_MMA(0, 1, At, B1); PG8_BAR;
            PG8_LDA(At, 1, 1); PG8_STAGE(PG8_SA(1, 0), a3, voffA);
            PG8_BAR; PG8_WAIT_L(0); PG8_MMA(1, 0, At, B0); PG8_BAR; PG8_SCHED;
            PG8_STAGE(PG8_SB(1, 1), b3 + hstepB, voffB);
            PG8_WAIT_V(6); PG8_BAR; PG8_MMA(1, 1, At, B1); PG8_BAR;
        }
        if constexpr (Epi::FP8) asm volatile("s_nop 15\n\ts_nop 15" ::: "memory");
        E(acc, cur, wr, wc, fr, fq);
        if (!has_next) break;
#pragma unroll
        for (int a = 0; a < 2; ++a)
#pragma unroll
            for (int b = 0; b < 2; ++b)
#pragma unroll
                for (int m = 0; m < 4; ++m)
#pragma unroll
                    for (int n = 0; n < 2; ++n) acc[a][b][m][n] = (f32x4){0.f, 0.f, 0.f, 0.f};
        cur = nxt; cA = nA; cB = nB; ++ui;
    }
    PG8_WAIT_V(0);
    if (wr == 0) PG8_BAR;
    PG8_BAR;
#undef PG8_SA
#undef PG8_SB
#undef PG8_STAGE
#undef PG8_LDA
#undef PG8_LDB
#undef PG8_MMA
#undef PG8_WAIT_V
#undef PG8_WAIT_L
#undef PG8_BAR
#undef PG8_SCHED
}
}

typedef f32x4 Acc[2][2][4][2];
#define EPI_LOOP_ROWS for (int ai = 0; ai < 2; ++ai) for (int m = 0; m < 4; ++m)
__device__ __forceinline__ u32x4 pack8(const f32x4 a, const f32x4 b) { u32x4 w; w.x = cvt_pk_bf16(a[0], a[1]); w.y = cvt_pk_bf16(a[2], a[3]); w.z = cvt_pk_bf16(b[0], b[1]); w.w = cvt_pk_bf16(b[2], b[3]); return w; }

struct EpiIn {
    static constexpr bool PERM = true, FP8 = true;
    bf16_t* P1; bf16_t* G; float inv;
    __device__ __forceinline__ void operator()(const Acc& acc, const pg8::Unit& u, int wr, int wc, int fr, int fq) const {
        const int row0 = u.pm * 256 + wr * 64 + fr; const bool gate = u.pn >= 16;
        bf16_t* base = gate ? G : P1; const int ld = gate ? NG : NP1; const int col0 = (gate ? (u.pn - 16) : u.pn) * 256 + wc * 32 + 8 * fq;
#pragma unroll
        for (int ai = 0; ai < 2; ++ai)
#pragma unroll
            for (int m = 0; m < 4; ++m) { bf16_t* rowp = base + (size_t)(row0 + ai * 128 + m * 16) * ld + col0;
#pragma unroll
                for (int bj = 0; bj < 2; ++bj) { f32x4 v0 = acc[ai][bj][m][0] * inv, v1 = acc[ai][bj][m][1] * inv;
                    if (gate) {
#pragma unroll
                        for (int j = 0; j < 4; ++j) { v0[j] = sigmoid_f(v0[j]); v1[j] = sigmoid_f(v1[j]); } }
                    *(u32x4*)(rowp + bj * 128) = pack8(v0, v1); } }
    }
};
struct EpiPlain {
    static constexpr bool PERM = true, FP8 = false;
    bf16_t* O; int ldc;
    __device__ __forceinline__ void operator()(const Acc& acc, const pg8::Unit& u, int wr, int wc, int fr, int fq) const {
        const int row0 = u.pm * 256 + wr * 64 + fr; const int col0 = u.pn * 256 + wc * 32 + 8 * fq;
#pragma unroll
        for (int ai = 0; ai < 2; ++ai)
#pragma unroll
            for (int m = 0; m < 4; ++m) { bf16_t* rowp = O + (size_t)(row0 + ai * 128 + m * 16) * ldc + col0;
#pragma unroll
                for (int bj = 0; bj < 2; ++bj) *(u32x4*)(rowp + bj * 128) = pack8(acc[ai][bj][m][0], acc[ai][bj][m][1]); }
    }
};
__device__ __forceinline__ void tile_info(int pm, int& b, int& tpos0, bool& lat) { lat = pm < 64; b = lat ? (pm >> 4) : (pm - 64); tpos0 = lat ? CTXL + ((pm & 15) << 8) : 0; }
struct EpiQup {
    static constexpr bool PERM = true, FP8 = false;
    unsigned char* QM; const f32x2* cs32;
    __device__ __forceinline__ void operator()(const Acc& acc, const pg8::Unit& u, int wr, int wc, int fr, int fq) const {
        int b, tpos0; bool lat; tile_info(u.pm, b, tpos0, lat);
        const int r0 = wr * 64 + fr;
#pragma unroll
        for (int bj = 0; bj < 2; ++bj) { const int c0 = u.pn * 256 + bj * 128 + wc * 32 + 8 * fq; const int hh = c0 / 96, j0 = c0 - hh * 96;
            unsigned char* hb = QM + ((size_t)(b * 8 + hh) * TT + tpos0 + r0) * 128;
            if (j0 < 64) {
#pragma unroll
                for (int ai = 0; ai < 2; ++ai)
#pragma unroll
                    for (int m = 0; m < 4; ++m) { const f32x4 a_ = acc[ai][bj][m][0], b_ = acc[ai][bj][m][1]; u32x2 w8; w8.x = pk4_fp8(clamp8(a_[0]), clamp8(a_[1]), clamp8(a_[2]), clamp8(a_[3])); w8.y = pk4_fp8(clamp8(b_[0]), clamp8(b_[1]), clamp8(b_[2]), clamp8(b_[3]));
                        *(u32x2*)(hb + (ai * 128 + m * 16) * 128 + j0) = w8; }
            } else { const int g8 = (j0 - 64) >> 3, part = g8 >> 1, pbase = (g8 & 1) * 4;
#pragma unroll
                for (int ai = 0; ai < 2; ++ai)
#pragma unroll
                    for (int m = 0; m < 4; ++m) { const int t = tpos0 - CTXL + r0 + ai * 128 + m * 16; const int pos = part ? (t & 63) : (t >> 6);
                        const f32x4 v0 = acc[ai][bj][m][0], v1 = acc[ai][bj][m][1];
                        float o1[4], o2[4]; const float x1[4] = {v0[0], v0[2], v1[0], v1[2]}, x2[4] = {v0[1], v0[3], v1[1], v1[3]};
#pragma unroll
                        for (int p = 0; p < 4; ++p) { const f32x2 cs = lat ? cs32[pos * 8 + pbase + p] : (f32x2){1.f, 0.f};
                            o1[p] = x1[p] * cs.x - x2[p] * cs.y; o2[p] = x1[p] * cs.y + x2[p] * cs.x; }
                        unsigned char* dst = hb + (ai * 128 + m * 16) * 128 + 64 + part * 16 + pbase;
                        *(unsigned*)dst = pk4_fp8(clamp8(o1[0]), clamp8(o1[1]), clamp8(o1[2]), clamp8(o1[3])); *(unsigned*)(dst + 8) = pk4_fp8(clamp8(o2[0]), clamp8(o2[1]), clamp8(o2[2]), clamp8(o2[3])); } } }
    }
};
struct EpiKvup {
    static constexpr bool PERM = true, FP8 = false;
    unsigned char* KM; bf16_t* VM;
    __device__ __forceinline__ void operator()(const Acc& acc, const pg8::Unit& u, int wr, int wc, int fr, int fq) const {
        int b, tpos0; bool lat; tile_info(u.pm, b, tpos0, lat);
        const int r0 = wr * 64 + fr; const int j0 = wc * 32 + 8 * fq;
#pragma unroll
        for (int bj = 0; bj < 2; ++bj) { const size_t tok = (size_t)(b * 8 + u.pn * 2 + bj) * TT + tpos0 + r0;
            if (j0 < 64) { unsigned char* d = KM + tok * 128 + j0;
#pragma unroll
                for (int ai = 0; ai < 2; ++ai)
#pragma unroll
                    for (int m = 0; m < 4; ++m) { const f32x4 a_ = acc[ai][bj][m][0], b_ = acc[ai][bj][m][1]; u32x2 w8; w8.x = pk4_fp8(clamp8(a_[0]), clamp8(a_[1]), clamp8(a_[2]), clamp8(a_[3])); w8.y = pk4_fp8(clamp8(b_[0]), clamp8(b_[1]), clamp8(b_[2]), clamp8(b_[3]));
                        *(u32x2*)(d + (ai * 128 + m * 16) * 128) = w8; } }
            else { bf16_t* d = VM + tok * 64 + (j0 - 64);
#pragma unroll
                for (int ai = 0; ai < 2; ++ai)
#pragma unroll
                    for (int m = 0; m < 4; ++m) *(u32x4*)(d + (ai * 128 + m * 16) * 64) = pack8(acc[ai][bj][m][0], acc[ai][bj][m][1]); } }
    }
};
template <int SEG> struct EpiMerge {
    static constexpr bool PERM = true, FP8 = false;
    bf16_t* MB; const bf16_t* G; unsigned char* MB8;
    __device__ __forceinline__ void operator()(const Acc& acc, const pg8::Unit& u, int wr, int wc, int fr, int fq) const {
        const int row0 = u.pm * 256 + wr * 64 + fr; const int col0 = u.pn * 256 + wc * 32 + 8 * fq;
        const bf16_t* gp = G + (size_t)row0 * NG + SEG * 2048 + col0; bf16_t* mp = MB + (size_t)row0 * D + col0; unsigned char* m8 = MB8 + (size_t)row0 * D + col0;
#pragma unroll
        for (int ai = 0; ai < 2; ++ai) {
            u32x4 gw[4][2], ow[4][2];
#pragma unroll
            for (int m = 0; m < 4; ++m)
#pragma unroll
                for (int bj = 0; bj < 2; ++bj) { const size_t ro = (size_t)(ai * 128 + m * 16);
                    gw[m][bj] = *(const u32x4*)(gp + ro * NG + bj * 128);
                    if (SEG > 0) ow[m][bj] = __builtin_nontemporal_load((const u32x4*)(mp + ro * D + bj * 128)); }
#pragma unroll
            for (int m = 0; m < 4; ++m)
#pragma unroll
                for (int bj = 0; bj < 2; ++bj) { const size_t ro = (size_t)(ai * 128 + m * 16); const u32x4 g_ = gw[m][bj];
                    f32x4 v0 = acc[ai][bj][m][0], v1 = acc[ai][bj][m][1];
                    if (ABL_BR & (1 << SEG)) { v0 = (f32x4){0.f, 0.f, 0.f, 0.f}; v1 = v0; }
                    v0[0] *= bflo(g_.x); v0[1] *= bfhi(g_.x); v0[2] *= bflo(g_.y); v0[3] *= bfhi(g_.y);
                    v1[0] *= bflo(g_.z); v1[1] *= bfhi(g_.z); v1[2] *= bflo(g_.w); v1[3] *= bfhi(g_.w);
                    if (SEG > 0) { const u32x4 o = ow[m][bj];
                        v0[0] += bflo(o.x); v0[1] += bfhi(o.x); v0[2] += bflo(o.y); v0[3] += bfhi(o.y);
                        v1[0] += bflo(o.z); v1[1] += bfhi(o.z); v1[2] += bflo(o.w); v1[3] += bfhi(o.w); }
                    if (SEG < 2) *(u32x4*)(mp + ro * D + bj * 128) = pack8(v0, v1);
                    else { u32x2 w8; w8.x = pk4_fp8(clamp8(v0[0] * 16.f), clamp8(v0[1] * 16.f), clamp8(v0[2] * 16.f), clamp8(v0[3] * 16.f)); w8.y = pk4_fp8(clamp8(v1[0] * 16.f), clamp8(v1[1] * 16.f), clamp8(v1[2] * 16.f), clamp8(v1[3] * 16.f));
                        *(u32x2*)(m8 + ro * D + bj * 128) = w8; } }
        }
    }
};
namespace pg8 {
struct Merge3 { const bf16_t* A; const bf16_t* B0; const bf16_t* B1; const bf16_t* B2; const bf16_t* G; unsigned char* MB8; float r01, r12, fin; };
template <class Sched>
__device__ __forceinline__ void gemm_merge3(LAS unsigned char* lds, const int tid, const Merge3 g, const Sched& S) {
    const int wid = __builtin_amdgcn_readfirstlane(tid >> 6), lane = tid & 63, wr = wid >> 2, wc = wid & 3, fr = lane & 15, fq = lane >> 4;
    constexpr int NT = 16, LDA = 1024;
    int sc1_ = 0x7F7F7F7F; asm volatile("" : "+v"(sc1_));
    unsigned voffA[2], voffB5[2], voffB10[2];
#pragma unroll
    for (int i = 0; i < 2; ++i) { int R, C; stage_rc(tid * 16 + i * 8192, R, C); const int Rb = (R & ~31) + perm32(R & 31);
        voffA[i] = (unsigned)(R * LDA + C) * 2u; voffB5[i] = (unsigned)(Rb * 256 + C) * 2u; voffB10[i] = (unsigned)(Rb * 512 + C) * 2u; }
    const size_t kstep = (size_t)(BK * 2);
    const size_t hstepA = (size_t)HALF * LDA * 2, tstepA = 2 * hstepA;
    const unsigned ldsw = (unsigned)wid * 1024u;
    const int aoff = lds_byte(wr * 64 + fr, fq * 8), boff = lds_byte(wc * 32 + fr, fq * 8);
#define M3_TA(pm_, t_) ((const char*)g.A + (size_t)(pm_) * tstepA + (size_t)(t_) * kstep)
#define M3_TB(pn_, t_) ((t_) < 4 ? (const char*)g.B0 + (size_t)(pn_) * 131072 + (size_t)(t_) * kstep : ((t_) < 8 ? (const char*)g.B1 + (size_t)(pn_) * 131072 + (size_t)((t_) - 4) * kstep : (const char*)g.B2 + (size_t)(pn_) * 262144 + (size_t)((t_) - 8) * kstep))
#define PG8_SA(b, h) (((b) * 2 + (h)) * HTB)
#define PG8_SB(b, h) ((4 + (b) * 2 + (h)) * HTB)
#define PG8_STAGE(bufoff, gbase, voff) do { _Pragma("unroll") for (int _i = 0; _i < 2; ++_i) \
        __builtin_amdgcn_global_load_lds((const unsigned*)((const char*)(gbase) + (voff)[_i]), (LAS unsigned*)(lds + (bufoff) + ldsw + _i * 8192), 16, 0, 0); } while (0)
#define PG8_LDA(dst, b, h) do { _Pragma("unroll") for (int m = 0; m < 4; ++m) { const i32x4v lo_ = *(const LAS i32x4v*)(lds + PG8_SA(b, h) + aoff + m * 2048), hi_ = *(const LAS i32x4v*)(lds + PG8_SA(b, h) + aoff + m * 2048 + 1024); dst[m] = __builtin_shufflevector(lo_, hi_, 0, 1, 2, 3, 4, 5, 6, 7); } } while (0)
#define PG8_LDB(dst, b, h) do { _Pragma("unroll") for (int n = 0; n < 2; ++n) { const i32x4v lo_ = *(const LAS i32x4v*)(lds + PG8_SB(b, h) + boff + n * 2048), hi_ = *(const LAS i32x4v*)(lds + PG8_SB(b, h) + boff + n * 2048 + 1024); dst[n] = __builtin_shufflevector(lo_, hi_, 0, 1, 2, 3, 4, 5, 6, 7); } } while (0)
#define PG8_MMA(ai, bj, At, Bt) do { __builtin_amdgcn_s_setprio(1); _Pragma("unroll") for (int m = 0; m < 4; ++m) _Pragma("unroll") for (int n = 0; n < 2; ++n) \
        asm volatile("v_mfma_scale_f32_16x16x128_f8f6f4 %0, %1, %2, %0, %3, %3 op_sel_hi:[0,0,0]" : "+v"(acc[ai][bj][m][n]) : "v"(Bt[n]), "v"(At[m]), "v"(sc1_)); __builtin_amdgcn_s_setprio(0); } while (0)
#define PG8_WAIT_V(n) asm volatile("s_waitcnt vmcnt(" #n ")" ::: "memory")
#define PG8_WAIT_L(n) asm volatile("s_waitcnt lgkmcnt(" #n ")" ::: "memory")
#define PG8_BAR __builtin_amdgcn_s_barrier()
#define PG8_SCHED __builtin_amdgcn_sched_barrier(0)
    Unit cur, nxt; int ui = 0;
    if (!S.next(0, cur)) return;
    f32x4 acc[2][2][4][2];
#pragma unroll
    for (int a = 0; a < 2; ++a)
#pragma unroll
        for (int b = 0; b < 2; ++b)
#pragma unroll
            for (int m = 0; m < 4; ++m)
#pragma unroll
                for (int n = 0; n < 2; ++n) acc[a][b][m][n] = (f32x4){0.f, 0.f, 0.f, 0.f};
    i32x8 At[4], B0[2], B1[2];
    { const char* cA = M3_TA(cur.pm, 0); const char* cB = M3_TB(cur.pn, 0); const size_t hB = 65536;
      PG8_STAGE(PG8_SB(0, 0), cB, voffB5); PG8_STAGE(PG8_SA(0, 0), cA, voffA); PG8_STAGE(PG8_SB(0, 1), cB + hB, voffB5); PG8_STAGE(PG8_SA(0, 1), cA + hstepA, voffA);
      if (wr == 1) PG8_BAR;
      PG8_WAIT_V(4); PG8_BAR;
      PG8_STAGE(PG8_SB(1, 0), cB + kstep, voffB5); PG8_STAGE(PG8_SA(1, 0), cA + kstep, voffA); PG8_STAGE(PG8_SB(1, 1), cB + hB + kstep, voffB5);
      PG8_WAIT_V(6); PG8_BAR; }
    const int r0 = wr * 64 + fr, c0l = wc * 32 + 8 * fq;
    for (;;) {
        const bool has_next = S.next(ui + 1, nxt);
        const int npm = has_next ? nxt.pm : cur.pm, npn = has_next ? nxt.pn : cur.pn;
#pragma unroll 1
        for (int t = 0; t < NT; t += 2) {
            const bool last = (t == NT - 2);
            const int t2 = last ? 0 : t + 2;
            const char* a1 = M3_TA(cur.pm, t + 1);
            const char* a2 = last ? M3_TA(npm, 0) : M3_TA(cur.pm, t + 2); const char* b2 = last ? M3_TB(npn, 0) : M3_TB(cur.pn, t + 2);
            const char* a3 = a2 + kstep; const char* b3 = b2 + kstep;
            const bool wide = t2 >= 8; const size_t hB = wide ? 131072 : 65536;
            unsigned vB[2]; vB[0] = wide ? voffB10[0] : voffB5[0]; vB[1] = wide ? voffB10[1] : voffB5[1];
            PG8_LDB(B0, 0, 0); PG8_SCHED; PG8_LDA(At, 0, 0); PG8_STAGE(PG8_SA(1, 1), a1 + hstepA, voffA);
            PG8_WAIT_L(8); PG8_BAR; PG8_WAIT_L(0); PG8_MMA(0, 0, At, B0); PG8_BAR; PG8_SCHED;
            PG8_LDB(B1, 0, 1); PG8_STAGE(PG8_SB(0, 0), b2, vB);
            PG8_BAR; PG8_WAIT_L(0); PG8_MMA(0, 1, At, B1); PG8_BAR;
            PG8_LDA(At, 0, 1); PG8_STAGE(PG8_SA(0, 0), a2, voffA);
            PG8_BAR; PG8_WAIT_L(0); PG8_MMA(1, 0, At, B0); PG8_BAR; PG8_SCHED;
            PG8_STAGE(PG8_SB(0, 1), b2 + hB, vB);
            PG8_WAIT_V(6); PG8_BAR; PG8_MMA(1, 1, At, B1); PG8_BAR;
            PG8_LDB(B0, 1, 0); PG8_SCHED; PG8_LDA(At, 1, 0); PG8_STAGE(PG8_SA(0, 1), a2 + hstepA, voffA);
            PG8_WAIT_L(8); PG8_BAR; PG8_WAIT_L(0); PG8_MMA(0, 0, At, B0); PG8_BAR; PG8_SCHED;
            PG8_LDB(B1, 1, 1); PG8_STAGE(PG8_SB(1, 0), b3, vB);
            PG8_BAR; PG8_WAIT_L(0); PG8_MMA(0, 1, At, B1); PG8_BAR;
            PG8_LDA(At, 1, 1); PG8_STAGE(PG8_SA(1, 0), a3, voffA);
            PG8_BAR; PG8_WAIT_L(0); PG8_MMA(1, 0, At, B0); PG8_BAR; PG8_SCHED;
            PG8_STAGE(PG8_SB(1, 1), b3 + hB, vB);
            PG8_WAIT_V(6); PG8_BAR; PG8_MMA(1, 1, At, B1); PG8_BAR;
            if (t == 2 || t == 6) {
                asm volatile("s_nop 15\n\ts_nop 15" ::: "memory");
                const int sg = t == 2 ? 0 : 1; const float wr_ = sg ? g.r12 : g.r01;
                const bf16_t* gp = g.G + (size_t)(cur.pm * 256 + r0) * NG + sg * 2048 + cur.pn * 256 + c0l;
#pragma unroll
                for (int ai = 0; ai < 2; ++ai) { u32x4 ga[4][2], gb[4][2];
#pragma unroll
                    for (int m = 0; m < 4; ++m)
#pragma unroll
                        for (int bj = 0; bj < 2; ++bj) { const bf16_t* q_ = gp + (size_t)(ai * 128 + m * 16) * NG + bj * 128; ga[m][bj] = *(const u32x4*)q_; gb[m][bj] = *(const u32x4*)(q_ + 2048); }
#pragma unroll
                    for (int m = 0; m < 4; ++m)
#pragma unroll
                        for (int bj = 0; bj < 2; ++bj) { const u32x4 x_ = ga[m][bj], y_ = gb[m][bj];
#define M3_RT(xw, yw, lohi) (fmaxf(lohi(xw), 1e-6f) * wr_ * __builtin_amdgcn_rcpf(fmaxf(lohi(yw), 1e-6f)))
                            acc[ai][bj][m][0][0] *= M3_RT(x_.x, y_.x, bflo); acc[ai][bj][m][0][1] *= M3_RT(x_.x, y_.x, bfhi); acc[ai][bj][m][0][2] *= M3_RT(x_.y, y_.y, bflo); acc[ai][bj][m][0][3] *= M3_RT(x_.y, y_.y, bfhi);
                            acc[ai][bj][m][1][0] *= M3_RT(x_.z, y_.z, bflo); acc[ai][bj][m][1][1] *= M3_RT(x_.z, y_.z, bfhi); acc[ai][bj][m][1][2] *= M3_RT(x_.w, y_.w, bflo); acc[ai][bj][m][1][3] *= M3_RT(x_.w, y_.w, bfhi); } }
                asm volatile("s_waitcnt vmcnt(0)" ::: "memory");
            }
        }
        asm volatile("s_nop 15\n\ts_nop 15" ::: "memory");
        { const bf16_t* gp = g.G + (size_t)(cur.pm * 256 + r0) * NG + 2 * 2048 + cur.pn * 256 + c0l; unsigned char* m8 = g.MB8 + (size_t)(cur.pm * 256 + r0) * D + cur.pn * 256 + c0l;
#pragma unroll
          for (int ai = 0; ai < 2; ++ai) { u32x4 gc[4][2];
#pragma unroll
              for (int m = 0; m < 4; ++m)
#pragma unroll
                  for (int bj = 0; bj < 2; ++bj) gc[m][bj] = *(const u32x4*)(gp + (size_t)(ai * 128 + m * 16) * NG + bj * 128);
#pragma unroll
              for (int m = 0; m < 4; ++m)
#pragma unroll
                  for (int bj = 0; bj < 2; ++bj) { const u32x4 z_ = gc[m][bj]; const f32x4 v0 = acc[ai][bj][m][0], v1 = acc[ai][bj][m][1];
                      u32x2 w8; const float f_ = g.fin;
                      w8.x = pk4_fp8(clamp8(v0[0] * fmaxf(bflo(z_.x), 1e-6f) * f_), clamp8(v0[1] * fmaxf(bfhi(z_.x), 1e-6f) * f_), clamp8(v0[2] * fmaxf(bflo(z_.y), 1e-6f) * f_), clamp8(v0[3] * fmaxf(bfhi(z_.y), 1e-6f) * f_));
                      w8.y = pk4_fp8(clamp8(v1[0] * fmaxf(bflo(z_.z), 1e-6f) * f_), clamp8(v1[1] * fmaxf(bfhi(z_.z), 1e-6f) * f_), clamp8(v1[2] * fmaxf(bflo(z_.w), 1e-6f) * f_), clamp8(v1[3] * fmaxf(bfhi(z_.w), 1e-6f) * f_));
                      *(u32x2*)(m8 + (size_t)(ai * 128 + m * 16) * D + bj * 128) = w8; } } }
        if (!has_next) break;
#pragma unroll
        for (int a = 0; a < 2; ++a)
#pragma unroll
            for (int b = 0; b < 2; ++b)
#pragma unroll
                for (int m = 0; m < 4; ++m)
#pragma unroll
                    for (int n = 0; n < 2; ++n) acc[a][b][m][n] = (f32x4){0.f, 0.f, 0.f, 0.f};
        cur = nxt; ++ui;
    }
    PG8_WAIT_V(0);
    if (wr == 0) PG8_BAR;
    PG8_BAR;
#undef M3_RT
#undef M3_TA
#undef M3_TB
#undef PG8_SA
#undef PG8_SB
#undef PG8_STAGE
#undef PG8_LDA
#undef PG8_LDB
#undef PG8_MMA
#undef PG8_WAIT_V
#undef PG8_WAIT_L
#undef PG8_BAR
#undef PG8_SCHED
}
}
struct EpiOut {
    static constexpr bool PERM = false, FP8 = true;
    const float* src_lat; const float* src_ctx; float* dst_lat; float* dst_ctx; const float* g1; float inv;
    __device__ __forceinline__ void operator()(const Acc& acc, const pg8::Unit& u, int wr, int wc, int fr, int fq) const {
        const int row0 = u.pm * 256 + wr * 64 + fr; const int col0 = u.pn * 256 + wc * 32 + 4 * fq;
        const bool lat = (u.pm * 256) < NLAT;
        const float* src = (lat ? src_lat : src_ctx - (size_t)NLAT * D) + (size_t)row0 * D + col0; float* dst = (lat ? dst_lat : dst_ctx - (size_t)NLAT * D) + (size_t)row0 * D + col0;
#pragma unroll
        for (int ai = 0; ai < 2; ++ai) { const int rbase = u.pm * 256 + ai * 128 + wr * 64; const int v = lat ? (rbase >> 12) : 4; const float* gp = g1 + (size_t)v * 12288 + col0;
            f32x4 gg[2][2];
#pragma unroll
            for (int bj = 0; bj < 2; ++bj)
#pragma unroll
                for (int n = 0; n < 2; ++n) gg[bj][n] = *(const f32x4*)(gp + bj * 128 + n * 16);
#pragma unroll
            for (int mh = 0; mh < 2; ++mh) {
                f32x4 xr[2][2][2];
#pragma unroll
                for (int mm = 0; mm < 2; ++mm)
#pragma unroll
                    for (int bj = 0; bj < 2; ++bj)
#pragma unroll
                        for (int n = 0; n < 2; ++n) xr[mm][bj][n] = __builtin_nontemporal_load((const f32x4*)(src + (size_t)(ai * 128 + (mh * 2 + mm) * 16) * D + bj * 128 + n * 16));
#pragma unroll
                for (int mm = 0; mm < 2; ++mm)
#pragma unroll
                    for (int bj = 0; bj < 2; ++bj)
#pragma unroll
                        for (int n = 0; n < 2; ++n) { const int m = mh * 2 + mm;
                            *(f32x4*)(dst + (size_t)(ai * 128 + m * 16) * D + bj * 128 + n * 16) = ABL_MIX ? xr[mm][bj][n] * ALPHA : xr[mm][bj][n] * ALPHA + gg[bj][n] * (acc[ai][bj][m][n] * inv); } } }
    }
};

struct Args { const float* in[27]; float* out; unsigned char* ws; int ph_lo, ph_hi; };
typedef const Args __attribute__((address_space(4)))* ArgP;
struct Frame {
    LAS unsigned char* lds; int tid, lane, wave, G, bid;
    ArgP ap; float* out; unsigned char* ws;
    __device__ __forceinline__ const float* in(int i) const { return ap->in[i]; }
};
__device__ __forceinline__ Frame make_frame(ArgP ap) {
    { unsigned long long t = (unsigned long long)ap; asm volatile("" : "+s"(t)); ap = (ArgP)t; }
    extern __shared__ __attribute__((aligned(16))) unsigned char lds_raw[];
    Frame F; F.lds = (LAS unsigned char*)lds_raw; { int t_ = threadIdx.x; asm volatile("" : "+v"(t_)); F.tid = t_; }
    F.lane = F.tid & 63; F.wave = __builtin_amdgcn_readfirstlane(F.tid >> 6); F.G = gridDim.x; F.bid = blockIdx.x;
    F.ap = ap; F.out = ap->out; F.ws = ap->ws; return F;
}
template <class T> __device__ __forceinline__ T* wsp(const Frame& F, size_t off) { return (T*)(F.ws + off); }

__device__ __forceinline__ int win_col(int n) {
    if (n < 768) return n;
    if (n < 1792) return 2336 + (n - 768);
    if (n < 2048) return 3360 + (n - 1792);
    if (n < 2304) return 3616 + (n - 2048);
    if (n < 2560) return 800 + (n - 2304);
    if (n < 2816) return 1056 + (n - 2560);
    if (n < 3328) return 1312 + (n - 2816);
    if (n < 3840) return 1824 + (n - 3328);
    if (n < 3872) return 768 + (n - 3840);
    if (n < 4096) return -1;
    return 3872 + (n - 4096);
}
__device__ __forceinline__ int qup_col(int c) {
    const int hh = c / 96, j = c - hh * 96;
    if (j < 64) return c;
    const int jj = j - 64, g8 = jj >> 3, i = jj & 7, p = i >> 1, which = i & 1, part = g8 >> 1, pi = (g8 & 1) * 4 + p;
    return hh * 96 + 64 + part * 16 + which * 8 + pi;
}
template <int MAP>
__device__ __forceinline__ void transpose_cvt(const Frame& F, const float* __restrict__ src, bf16_t* __restrict__ dst, int K, int Nsrc, int Nd) {
    LAS float* tile = (LAS float*)F.lds;
    const int tk = K / 256, tn = Nd / 64, ntile = tk * tn;
    for (int t = F.bid; t < ntile; t += F.G) {
        const int k0 = (t % tk) * 256, n0 = (t / tk) * 64;
        const int nl = F.tid & 63, kq = F.tid >> 6;
        const int nd = n0 + nl; const int ns = MAP == 0 ? nd : (MAP == 1 ? win_col(nd) : qup_col(nd));
        float v[32];
#pragma unroll
        for (int i = 0; i < 32; ++i) v[i] = ns >= 0 ? src[(size_t)(k0 + kq + 8 * i) * Nsrc + ns] : 0.f;
#pragma unroll
        for (int i = 0; i < 32; ++i) tile[(kq + 8 * i) * 65 + nl] = v[i];
        __syncthreads();
        { const int n = F.tid >> 3, k32 = (F.tid & 7) * 32;
#pragma unroll
          for (int c = 0; c < 4; ++c) { float w[8];
#pragma unroll
              for (int j = 0; j < 8; ++j) w[j] = tile[(k32 + c * 8 + j) * 65 + n];
              u32x4 o; o.x = cvt_pk_bf16(w[0], w[1]); o.y = cvt_pk_bf16(w[2], w[3]); o.z = cvt_pk_bf16(w[4], w[5]); o.w = cvt_pk_bf16(w[6], w[7]);
              *(u32x4*)(dst + (size_t)(n0 + n) * K + k0 + k32 + c * 8) = o; } }
        __syncthreads();
    }
}
__device__ __forceinline__ void cvt_rows(const Frame& F, const float* __restrict__ src, bf16_t* __restrict__ dst, size_t n8) {
    for (size_t i = (size_t)F.bid * 512 + F.tid; i < n8; i += (size_t)F.G * 512) {
        const f32x4 a = __builtin_nontemporal_load((const f32x4*)(src + i * 8)), b = __builtin_nontemporal_load((const f32x4*)(src + i * 8 + 4));
        *(u32x4*)(dst + i * 8) = pack8(a, b);
    }
}
__device__ __forceinline__ void cvt_peer(const Frame& F, int l);
__device__ __forceinline__ void absmax_f32(const Frame& F, const float* __restrict__ src, size_t n4, unsigned* dst) {
    float am = 0.f;
    const size_t stride = (size_t)F.G * 512; size_t i = (size_t)F.bid * 512 + F.tid;
    for (; i + 7 * stride < n4; i += 8 * stride) { f32x4 a[8];
#pragma unroll
        for (int j = 0; j < 8; ++j) a[j] = __builtin_nontemporal_load((const f32x4*)(src + (i + j * stride) * 4));
#pragma unroll
        for (int j = 0; j < 8; ++j) am = fmaxf(fmaxf(fmaxf(am, fabsf(a[j][0])), fabsf(a[j][1])), fmaxf(fabsf(a[j][2]), fabsf(a[j][3]))); }
    for (; i < n4; i += stride) { const f32x4 a = *(const f32x4*)(src + i * 4); am = fmaxf(fmaxf(fmaxf(am, fabsf(a[0])), fabsf(a[1])), fmaxf(fabsf(a[2]), fabsf(a[3]))); }
    am = row16_max(am);
    { auto r = __builtin_amdgcn_permlane16_swap(__float_as_uint(am), __float_as_uint(am), false, false); am = fmaxf(__uint_as_float(r[0]), __uint_as_float(r[1])); }
    { auto r = __builtin_amdgcn_permlane32_swap(__float_as_uint(am), __float_as_uint(am), false, false); am = fmaxf(__uint_as_float(r[0]), __uint_as_float(r[1])); }
    if (F.lane == 0) atomicMax(dst, __float_as_uint(am));
}
template <int MAP>
__device__ __forceinline__ void transpose_fp8(const Frame& F, const float* __restrict__ src, unsigned char* __restrict__ dst, int K, int Nsrc, int Nd, const unsigned* wsc) {
    float mul, inv; fp8_scale(__hip_atomic_load(wsc, __ATOMIC_RELAXED, __HIP_MEMORY_SCOPE_AGENT), mul, inv);
    LAS float* tile = (LAS float*)F.lds;
    const int tk = K / 256, tn = Nd / 64, ntile = tk * tn;
    for (int t = F.bid; t < ntile; t += F.G) {
        const int k0 = (t % tk) * 256, n0 = (t / tk) * 64;
        const int nl = F.tid & 63, kq = F.tid >> 6; const int ns = MAP ? win_col(n0 + nl) : n0 + nl;
        float v[32];
#pragma unroll
        for (int i = 0; i < 32; ++i) v[i] = ns >= 0 ? src[(size_t)(k0 + kq + 8 * i) * Nsrc + ns] : 0.f;
#pragma unroll
        for (int i = 0; i < 32; ++i) tile[(kq + 8 * i) * 65 + nl] = v[i] * mul;
        __syncthreads();
        { const int n = F.tid >> 3, k32 = (F.tid & 7) * 32;
#pragma unroll
          for (int c = 0; c < 2; ++c) { float w[16];
#pragma unroll
              for (int j = 0; j < 16; ++j) w[j] = tile[(k32 + c * 16 + j) * 65 + n];
              u32x4 o; o.x = pk4_fp8(w[0], w[1], w[2], w[3]); o.y = pk4_fp8(w[4], w[5], w[6], w[7]); o.z = pk4_fp8(w[8], w[9], w[10], w[11]); o.w = pk4_fp8(w[12], w[13], w[14], w[15]);
              *(u32x4*)(dst + (size_t)(n0 + n) * K + k0 + k32 + c * 16) = o; } }
        __syncthreads();
    }
}
__device__ __forceinline__ void p0_prologue(const Frame& F) {
    { const int gi = F.bid * 512 + F.tid;
      if (gi < 64 * 8) { const int pos = gi >> 3, f = gi & 7; const float inv = powf(10000.f, -(float)f / 8.f); const float a = (float)pos * inv; wsp<f32x2>(F, WS_ROPE32)[gi] = (f32x2){cosf(a), sinf(a)}; }
      else if (gi < 64 * 8 + 64 * 32) { const int g2 = gi - 512; const int pos = g2 >> 5, f = g2 & 31; const float inv = powf(10000.f, -(float)f / 32.f); const float a = (float)pos * inv; wsp<f32x2>(F, WS_ROPE128)[g2] = (f32x2){cosf(a), sinf(a)}; } }
    if (F.bid == 0 && F.tid < 32) wsp<float>(F, WS_DEC)[F.tid] = -log1pf(expf(-F.in(11)[F.tid])) * LOG2E;
    { LAS float* sl = (LAS float*)F.lds;
      float* modp = wsp<float>(F, WS_MODP);
      for (int u = F.bid; u < 2 * 24 * 16; u += F.G) {
          const int kc = u & 15, cb = (u >> 4) % 24, l = u / (16 * 24);
          __syncthreads();
          for (int i = F.tid; i < 640; i += 512) { const int v = i >> 7, k = kc * 128 + (i & 127); const float c = v < 4 ? F.in(1)[v * 2048 + k] : F.in(3)[k]; sl[i] = silu_f(c); }
          __syncthreads();
          const int col = cb * 512 + F.tid; const float* w = F.in(4) + ((size_t)l * 2048 + kc * 128) * 12288 + col;
          float a0 = 0.f, a1 = 0.f, a2 = 0.f, a3 = 0.f, a4 = 0.f;
#pragma unroll 32
          for (int k = 0; k < 128; ++k) { const float wv = w[(size_t)k * 12288]; a0 += sl[k] * wv; a1 += sl[128 + k] * wv; a2 += sl[256 + k] * wv; a3 += sl[384 + k] * wv; a4 += sl[512 + k] * wv; }
          float* o = modp + ((size_t)(kc * 2 + l) * 5) * 12288 + col;
          o[0] = a0; o[12288] = a1; o[2 * 12288] = a2; o[3 * 12288] = a3; o[4 * 12288] = a4;
      }
      __syncthreads(); }
    for (int l = 0; l < 2; ++l) {
        absmax_f32(F, F.in(6) + (size_t)l * 2048 * NIN, (size_t)2048 * NIN / 4, wsp<unsigned>(F, WS_WSC) + l);
        transpose_cvt<2>(F, F.in(8) + (size_t)l * 512 * 768, wsp<bf16_t>(F, WS_WQUP + l * SZ_WQUP), 512, 768, 768);
        transpose_cvt<0>(F, F.in(10) + (size_t)l * 256 * 1024, wsp<bf16_t>(F, WS_WKVUP + l * SZ_WKVUP), 256, 1024, 1024);
        absmax_f32(F, F.in(14) + (size_t)l * 512 * 2048, (size_t)512 * 2048 / 4, wsp<unsigned>(F, WS_WSC) + 4 + l);
        absmax_f32(F, F.in(15) + (size_t)l * 512 * 2048, (size_t)512 * 2048 / 4, wsp<unsigned>(F, WS_WSC) + 6 + l);
        absmax_f32(F, F.in(16) + (size_t)l * 1024 * 2048, (size_t)1024 * 2048 / 4, wsp<unsigned>(F, WS_WSC) + 8 + l);
        absmax_f32(F, F.in(17) + (size_t)l * 2048 * 2048, (size_t)2048 * 2048 / 4, wsp<unsigned>(F, WS_WSC) + 2 + l);
        transpose_cvt<0>(F, F.in(20) + (size_t)l * 2048 * 1024, wsp<bf16_t>(F, WS_WPQ + l * SZ_WPQ), 2048, 1024, 1024);
    }
    cvt_peer(F, 0);
}
__device__ __forceinline__ void p1_modreduce(const Frame& F) {
    const float* modp = wsp<float>(F, WS_MODP); float* mod = wsp<float>(F, WS_MOD);
    for (int i = F.bid * 512 + F.tid; i < 2 * 5 * 12288; i += F.G * 512) {
        const int j = i % 12288, l = i / (5 * 12288);
        float s = F.in(5)[l * 12288 + j];
#pragma unroll
        for (int kc = 0; kc < 16; ++kc) s += modp[(size_t)kc * (2 * 5 * 12288) + i];
        mod[i] = s;
    }
    for (int l = 0; l < 2; ++l) {
        transpose_fp8<1>(F, F.in(6) + (size_t)l * 2048 * NIN, wsp<unsigned char>(F, WS_WIN + l * SZ_WIN), 2048, NIN, NPT, wsp<unsigned>(F, WS_WSC) + l);
        transpose_fp8<0>(F, F.in(17) + (size_t)l * 2048 * 2048, wsp<unsigned char>(F, WS_WOUT + l * SZ_WOUT), 2048, 2048, 2048, wsp<unsigned>(F, WS_WSC) + 2 + l);
        transpose_fp8<0>(F, F.in(14) + (size_t)l * 512 * 2048, wsp<unsigned char>(F, WS_WBRA + l * SZ_WBRA), 512, 2048, 2048, wsp<unsigned>(F, WS_WSC) + 4 + l);
        transpose_fp8<0>(F, F.in(15) + (size_t)l * 512 * 2048, wsp<unsigned char>(F, WS_WBRB + l * SZ_WBRB), 512, 2048, 2048, wsp<unsigned>(F, WS_WSC) + 6 + l);
        transpose_fp8<0>(F, F.in(16) + (size_t)l * 1024 * 2048, wsp<unsigned char>(F, WS_WBRC + l * SZ_WBRC), 1024, 2048, 2048, wsp<unsigned>(F, WS_WSC) + 8 + l);
    }
}
__device__ __forceinline__ void ld_row_f32(const float* p, int lane, float (&x)[32]) {
#pragma unroll
    for (int q = 0; q < 4; ++q) { const f32x4 a = *(const f32x4*)(p + 512 * q + 8 * lane), b = *(const f32x4*)(p + 512 * q + 8 * lane + 4);
        x[q * 8 + 0] = a[0]; x[q * 8 + 1] = a[1]; x[q * 8 + 2] = a[2]; x[q * 8 + 3] = a[3]; x[q * 8 + 4] = b[0]; x[q * 8 + 5] = b[1]; x[q * 8 + 6] = b[2]; x[q * 8 + 7] = b[3]; }
}
__device__ __forceinline__ void st_row_f32(float* p, int lane, const float (&x)[32]) {
#pragma unroll
    for (int q = 0; q < 4; ++q) { *(f32x4*)(p + 512 * q + 8 * lane) = (f32x4){x[q * 8 + 0], x[q * 8 + 1], x[q * 8 + 2], x[q * 8 + 3]}; *(f32x4*)(p + 512 * q + 8 * lane + 4) = (f32x4){x[q * 8 + 4], x[q * 8 + 5], x[q * 8 + 6], x[q * 8 + 7]}; }
}
__device__ __forceinline__ void st_row_bf16(bf16_t* p, int lane, const float (&x)[32]) {
#pragma unroll
    for (int q = 0; q < 4; ++q) { u32x4 w; w.x = cvt_pk_bf16(x[q * 8 + 0], x[q * 8 + 1]); w.y = cvt_pk_bf16(x[q * 8 + 2], x[q * 8 + 3]); w.z = cvt_pk_bf16(x[q * 8 + 4], x[q * 8 + 5]); w.w = cvt_pk_bf16(x[q * 8 + 6], x[q * 8 + 7]);
        *(u32x4*)(p + 512 * q + 8 * lane) = w; }
}
__device__ __forceinline__ void p_modulate0(const Frame& F) {
    const float* mod = wsp<float>(F, WS_MOD); unsigned char* hb8 = wsp<unsigned char>(F, WS_HB8);
    for (int row = F.bid * 8 + F.wave; row < NROW; row += F.G * 8) {
        const RowInfo ri = rowinfo(row);
        const float* xp = ri.lat ? F.in(0) + (size_t)row * D : F.in(2) + (size_t)(row - NLAT) * D;
        const float* mp = mod + (size_t)ri.v * 12288;
        float x[32], sh[32], sc[32];
        ld_row_f32(xp, F.lane, x); ld_row_f32(mp, F.lane, sh); ld_row_f32(mp + 2048, F.lane, sc);
#pragma unroll
        for (int i = 0; i < 32; ++i) x[i] = clamp8(x[i] * (1.f + sc[i]) + sh[i]);
#pragma unroll
        for (int q = 0; q < 4; ++q) { u32x2 w; w.x = pk4_fp8(x[q * 8 + 0], x[q * 8 + 1], x[q * 8 + 2], x[q * 8 + 3]); w.y = pk4_fp8(x[q * 8 + 4], x[q * 8 + 5], x[q * 8 + 6], x[q * 8 + 7]); *(u32x2*)(hb8 + (size_t)row * D + 512 * q + 8 * F.lane) = w; }
    }
}
__device__ __forceinline__ void p_post(const Frame& F, int l) {
    const bf16_t* P1 = wsp<bf16_t>(F, WS_P1);
    bf16_t* CQN = wsp<bf16_t>(F, WS_CQN); bf16_t* CKVN = wsp<bf16_t>(F, WS_CKVN);
    unsigned char* QG = wsp<unsigned char>(F, WS_QG); unsigned char* KG = wsp<unsigned char>(F, WS_KG); bf16_t* VG = wsp<bf16_t>(F, WS_VG);
    bf16_t* RQ = wsp<bf16_t>(F, WS_RQ); bf16_t* RK = wsp<bf16_t>(F, WS_RK); bf16_t* RV = wsp<bf16_t>(F, WS_RV);
    unsigned char* KM = wsp<unsigned char>(F, WS_KM); unsigned char* QM = wsp<unsigned char>(F, WS_QM);
    const f32x2* cs32 = wsp<f32x2>(F, WS_ROPE32); const f32x2* cs128 = wsp<f32x2>(F, WS_ROPE128);
    const float* gq_n = F.in(7) + l * 512; const float* gkv_n = F.in(9) + l * 256; const float* gqa_qn = F.in(12) + l * 128; const float* gqa_kn = F.in(13) + l * 128;
    LAS bf16_t* rs = (LAS bf16_t*)(F.lds + F.wave * 8192);
    const int lane = F.lane;
    const f32x4 gq0 = *(const f32x4*)(gq_n + lane * 8), gq1 = *(const f32x4*)(gq_n + lane * 8 + 4), gkv0 = *(const f32x4*)(gkv_n + lane * 4);
    const int gd0 = 2 * lane; const int gpart = gd0 >> 6, gdd = gd0 & 63; const bool glo = gdd < 32; const int gf = glo ? gdd : gdd - 32; const int gdp = glo ? gd0 + 32 : gd0 - 32;
    const float qn0 = gqa_qn[gd0], qn1 = gqa_qn[gd0 + 1], qnp0 = gqa_qn[gdp], qnp1 = gqa_qn[gdp + 1];
    const float kn0 = gqa_kn[gd0], kn1 = gqa_kn[gd0 + 1], knp0 = gqa_kn[gdp], knp1 = gqa_kn[gdp + 1];
    const int rhh = lane >> 3, rd0 = (lane & 7) * 4; const int rpart = rd0 >> 4, rdd = rd0 & 15; const bool rlo = rdd < 8; const int rf = rlo ? rdd : rdd - 8; const int rdp = rlo ? rd0 + 8 : rd0 - 8;
    const int step = F.G * 8;
    int row = F.bid * 8 + F.wave;
    u32x4 pre[8];
    if (row < NROW) {
#pragma unroll
        for (int q = 0; q < 8; ++q) pre[q] = *(const u32x4*)(P1 + (size_t)row * NP1 + q * 512 + lane * 8); }
#pragma unroll 1
    for (; row < NROW; row += step) {
        const RowInfo ri = rowinfo(row);
        const int posg = gpart ? ri.pc : ri.pr, posr = rpart ? ri.pc : ri.pr;
        const f32x2 one = {1.f, 0.f};
        const f32x2 csA = ri.lat ? cs128[posg * 32 + gf] : one, csB = ri.lat ? cs128[posg * 32 + gf + 1] : one;
        f32x2 cs[4];
#pragma unroll
        for (int i = 0; i < 4; ++i) cs[i] = ri.lat ? cs32[posr * 8 + rf + i] : one;
#pragma unroll
        for (int q = 0; q < 8; ++q) *(LAS u32x4*)(rs + q * 512 + lane * 8) = pre[q];
        { const int nrow = row + step; if (nrow < NROW) {
#pragma unroll
            for (int q = 0; q < 8; ++q) pre[q] = *(const u32x4*)(P1 + (size_t)nrow * NP1 + q * 512 + lane * 8); } }
        asm volatile("s_waitcnt lgkmcnt(0)" ::: "memory");
        { float x[8]; float ss = 0.f;
#pragma unroll
          for (int i = 0; i < 8; ++i) { x[i] = bf2f(rs[C_CQ + lane * 8 + i]); ss += x[i] * x[i]; }
          ss = wave_sum(ss); const float r = rsqrtf(ss * (1.f / 512.f) + RMS_EPS);
          *(u32x4*)(CQN + (size_t)row * 512 + lane * 8) = pack8((f32x4){x[0] * r * gq0[0], x[1] * r * gq0[1], x[2] * r * gq0[2], x[3] * r * gq0[3]}, (f32x4){x[4] * r * gq1[0], x[5] * r * gq1[1], x[6] * r * gq1[2], x[7] * r * gq1[3]}); }
        { float x[4]; float ss = 0.f;
#pragma unroll
          for (int i = 0; i < 4; ++i) { x[i] = bf2f(rs[C_CKV + lane * 4 + i]); ss += x[i] * x[i]; }
          ss = wave_sum(ss); const float r = rsqrtf(ss * (1.f / 256.f) + RMS_EPS);
          u32x2 w; w.x = cvt_pk_bf16(x[0] * r * gkv0[0], x[1] * r * gkv0[1]); w.y = cvt_pk_bf16(x[2] * r * gkv0[2], x[3] * r * gkv0[3]);
          *(u32x2*)(CKVN + (size_t)row * 256 + lane * 4) = w; }
        {
            const int d0 = gd0, dp = gdp; const bool lo = glo;
#pragma unroll 1
            for (int hh = 0; hh < 10; ++hh) {
                const bool isq = hh < 8; const int cbase = isq ? C_GQ + hh * 128 : C_GK + (hh - 8) * 128;
                const float g0 = isq ? qn0 : kn0, g1 = isq ? qn1 : kn1, gp0 = isq ? qnp0 : knp0, gp1 = isq ? qnp1 : knp1;
                const float a0 = bf2f(rs[cbase + d0]), a1 = bf2f(rs[cbase + d0 + 1]);
                float ss = wave_sum(a0 * a0 + a1 * a1); const float r = rsqrtf(ss * (1.f / 128.f) + RMS_EPS);
                const float n0 = a0 * r * g0, n1 = a1 * r * g1;
                const float p0 = bf2f(rs[cbase + dp]) * r * gp0, p1 = bf2f(rs[cbase + dp + 1]) * r * gp1;
                float o0, o1;
                if (lo) { o0 = n0 * csA.x - p0 * csA.y; o1 = n1 * csB.x - p1 * csB.y; }
                else    { o0 = p0 * csA.y + n0 * csA.x; o1 = p1 * csB.y + n1 * csB.x; }
                unsigned char* dst = isq ? QG + ((size_t)(ri.b * 8 + hh) * TT + ri.tpos) * 128 : KG + ((size_t)(ri.b * 2 + (hh - 8)) * TT + ri.tpos) * 128;
                *(unsigned short*)(dst + d0) = (unsigned short)(pk4_fp8(clamp8(o0), clamp8(o1), 0.f, 0.f) & 0xffffu);
            }
#pragma unroll
            for (int hh = 0; hh < 2; ++hh) *(unsigned*)(VG + ((size_t)(ri.b * 2 + hh) * TT + ri.tpos) * 128 + d0) = *(LAS unsigned*)(rs + C_GV + hh * 128 + d0);
        }
        {
            const int hh = rhh, d0 = rd0, dp = rdp; const bool lo = rlo;
#pragma unroll
            for (int which = 0; which < 2; ++which) {
                const int cbase = (which ? C_RK : C_RQ) + hh * 32; const float sc = which ? 0.17677669529663687f : 1.f;
                float o[4];
#pragma unroll
                for (int i = 0; i < 4; ++i) { const float n = bf2f(rs[cbase + d0 + i]), p = bf2f(rs[cbase + dp + i]);
                    o[i] = (lo ? (n * cs[i].x - p * cs[i].y) : (p * cs[i].y + n * cs[i].x)) * sc; }
                u32x2 w; w.x = cvt_pk_bf16(o[0], o[1]); w.y = cvt_pk_bf16(o[2], o[3]);
                *(u32x2*)((which ? RK : RQ) + ((size_t)(ri.b * 8 + hh) * TT + ri.tpos) * 32 + d0) = w;
            }
            { const int vh = lane >> 3, e0 = (lane & 7) * 8;
              *(u32x4*)(RV + ((size_t)(ri.b * 8 + vh) * TT + ri.tpos) * 64 + e0) = *(LAS u32x4*)(rs + C_RV + lane * 8); }
            { float o[4];
#pragma unroll
              for (int i = 0; i < 4; ++i) { const float n = bf2f(rs[C_KR + d0 + i]), p = bf2f(rs[C_KR + dp + i]); o[i] = lo ? (n * cs[i].x - p * cs[i].y) : (p * cs[i].y + n * cs[i].x); }
              const size_t tok_ = ((size_t)(ri.b * 8 + hh) * TT + ri.tpos) * 128;
              *(unsigned*)(KM + tok_ + 64 + d0) = pk4_fp8(clamp8(o[0]), clamp8(o[1]), clamp8(o[2]), clamp8(o[3]));
              *(unsigned*)(KM + tok_ + 96 + d0) = 0u; *(unsigned*)(QM + tok_ + 96 + d0) = 0u; }
        }
        asm volatile("s_waitcnt lgkmcnt(0)" ::: "memory");
    }
}

__device__ __forceinline__ void ret_logs(const Frame& F, int l, int h, float& lgf, float& lgb) {
    const float* t = wsp<float>(F, WS_DEC); lgf = t[(l * 2 + 0) * 8 + h]; lgb = t[(l * 2 + 1) * 8 + h];
}
constexpr int TP = 136;
template <bool WITH_K>
__device__ __forceinline__ void ret_stage(const Frame& F, const bf16_t* RKh, const bf16_t* RVh, int tpos0, float lgf, float lgb, LAS bf16_t* vt, LAS bf16_t* ktf, LAS bf16_t* ktb) {
#pragma unroll
    for (int i = 0; i < 2; ++i) { const int tok = (F.tid >> 3) + 64 * i, e0 = (F.tid & 7) * 8;
        const u32x4 w = *(const u32x4*)(RVh + (size_t)(tpos0 + tok) * 64 + e0); const unsigned ww[4] = {w.x, w.y, w.z, w.w};
#pragma unroll
        for (int j = 0; j < 4; ++j) { vt[(e0 + 2 * j) * TP + tok] = (bf16_t)(ww[j] & 0xffffu); vt[(e0 + 2 * j + 1) * TP + tok] = (bf16_t)(ww[j] >> 16); } }
    if (WITH_K) { const int tok = F.tid >> 2, k0 = (F.tid & 3) * 8;
        const u32x4 w = *(const u32x4*)(RKh + (size_t)(tpos0 + tok) * 32 + k0); const unsigned ww[4] = {w.x, w.y, w.z, w.w};
        const float zf = exp2f(lgf * (float)(127 - tok)), zb = exp2f(lgb * (float)tok);
#pragma unroll
        for (int j = 0; j < 4; ++j) { const float a = bflo(ww[j]), b = bfhi(ww[j]);
            ktf[(k0 + 2 * j) * TP + tok] = f2bf(a * zf); ktf[(k0 + 2 * j + 1) * TP + tok] = f2bf(b * zf);
            ktb[(k0 + 2 * j) * TP + tok] = f2bf(a * zb); ktb[(k0 + 2 * j + 1) * TP + tok] = f2bf(b * zb); } }
}
__device__ __forceinline__ void p_ret_states(const Frame& F, int l) {
    LAS bf16_t* vt = (LAS bf16_t*)F.lds; LAS bf16_t* ktf = vt + 64 * TP; LAS bf16_t* ktb = ktf + 32 * TP;
    float* ST = wsp<float>(F, WS_ST);
    const int lane = F.lane, w = F.wave, kb = w >> 2, eb = w & 3, fr = lane & 15, fq = lane >> 4;
    for (int u = F.bid; u < NB * 8 * 34; u += F.G) {
        const int c = u % 34, bh = u / 34, h = bh & 7;
        float lgf, lgb; ret_logs(F, l, h, lgf, lgb);
        __syncthreads();
        ret_stage<true>(F, wsp<bf16_t>(F, WS_RK) + (size_t)bh * TT * 32, wsp<bf16_t>(F, WS_RV) + (size_t)bh * TT * 64, c * 128, lgf, lgb, vt, ktf, ktb);
        __syncthreads();
        f32x4 sf = {0.f, 0.f, 0.f, 0.f}, sb = {0.f, 0.f, 0.f, 0.f};
#pragma unroll
        for (int ks = 0; ks < 4; ++ks) {
            const bf16x8 bv = *(const LAS bf16x8*)(vt + (eb * 16 + fr) * TP + ks * 32 + fq * 8);
            const bf16x8 af = *(const LAS bf16x8*)(ktf + (kb * 16 + fr) * TP + ks * 32 + fq * 8);
            const bf16x8 ab = *(const LAS bf16x8*)(ktb + (kb * 16 + fr) * TP + ks * 32 + fq * 8);
            sf = __builtin_amdgcn_mfma_f32_16x16x32_bf16(af, bv, sf, 0, 0, 0);
            sb = __builtin_amdgcn_mfma_f32_16x16x32_bf16(ab, bv, sb, 0, 0, 0);
        }
        float* o = ST + (size_t)u * 2 * 2048;
#pragma unroll
        for (int r = 0; r < 4; ++r) { const int kd = kb * 16 + fq * 4 + r, e = eb * 16 + fr; o[kd * 64 + e] = sf[r]; o[2048 + kd * 64 + e] = sb[r]; }
    }
}
constexpr int RP = 40;
constexpr int AP = 136;
__device__ __forceinline__ void ret_out_unit(const Frame& F, int l, int bh, int c) {
    LAS bf16_t* vt = (LAS bf16_t*)F.lds; LAS bf16_t* rtf = vt + 64 * TP; LAS bf16_t* rtb = rtf + 64 * RP; LAS bf16_t* as = rtb + 64 * RP + F.wave * 16 * AP;
    const int lane = F.lane, w = F.wave, fr = lane & 15, fq = lane >> 4, h = bh & 7, b = bh >> 3;
    const bf16_t* RQh = wsp<bf16_t>(F, WS_RQ) + (size_t)bh * TT * 32; const bf16_t* RKh = wsp<bf16_t>(F, WS_RK) + (size_t)bh * TT * 32; const bf16_t* RVh = wsp<bf16_t>(F, WS_RV) + (size_t)bh * TT * 64;
    const float* STh = wsp<float>(F, WS_ST) + (size_t)bh * 34 * 2 * 2048;
    float lgf, lgb; ret_logs(F, l, h, lgf, lgb);
    const int tpos0 = c * 128;
    __syncthreads();
    ret_stage<false>(F, RKh, RVh, tpos0, lgf, lgb, vt, nullptr, nullptr);
    { const int kd = F.tid >> 4, e4 = (F.tid & 15) * 4; f32x4 rf = {0.f, 0.f, 0.f, 0.f}, rb = {0.f, 0.f, 0.f, 0.f};
      if (c >= 2) {
          for (int cp = 0; cp < c; ++cp) { const float e2 = lgf * 128.f * (float)(c - 1 - cp); if (e2 < -80.f) continue; const float wgt = exp2f(e2);
              rf += *(const f32x4*)(STh + (size_t)(cp * 2 + 0) * 2048 + kd * 64 + e4) * wgt; }
          const int p = c - 2;
          for (int pp = p + 1; pp < 34; ++pp) { const float e2 = lgb * 128.f * (float)(pp - p - 1); if (e2 < -80.f) break; const float wgt = exp2f(e2); const int cs = pp < 32 ? pp + 2 : pp - 32;
              rb += *(const f32x4*)(STh + (size_t)(cs * 2 + 1) * 2048 + kd * 64 + e4) * wgt; }
      } else if (c == 0) { rb = *(const f32x4*)(STh + (size_t)(1 * 2 + 1) * 2048 + kd * 64 + e4); }
      else { rf = *(const f32x4*)(STh + (size_t)(0 * 2 + 0) * 2048 + kd * 64 + e4); }
#pragma unroll
      for (int j = 0; j < 4; ++j) { rtf[(e4 + j) * RP + kd] = f2bf(rf[j]); rtb[(e4 + j) * RP + kd] = f2bf(rb[j]); } }
    const int i0 = w * 16;
    const bf16x8 qa = *(const bf16x8*)(RQh + (size_t)(tpos0 + i0 + fr) * 32 + fq * 8);
    f32x4 s[8];
#pragma unroll
    for (int nb = 0; nb < 8; ++nb) { const bf16x8 kf = *(const bf16x8*)(RKh + (size_t)(tpos0 + nb * 16 + fr) * 32 + fq * 8);
        s[nb] = __builtin_amdgcn_mfma_f32_16x16x32_bf16(qa, kf, (f32x4){0.f, 0.f, 0.f, 0.f}, 0, 0, 0); }
#pragma unroll
    for (int nb = 0; nb < 8; ++nb)
#pragma unroll
        for (int r = 0; r < 4; ++r) { const int i = i0 + fq * 4 + r, j = nb * 16 + fr; const int df = i - j;
            const float mk = df > 0 ? exp2f(lgf * (float)df) : (df < 0 ? exp2f(lgb * (float)(-df)) : 2.f);
            as[(fq * 4 + r) * AP + j] = f2bf(s[nb][r] * mk); }
    __syncthreads();
    f32x4 y[4];
#pragma unroll
    for (int eb = 0; eb < 4; ++eb) y[eb] = (f32x4){0.f, 0.f, 0.f, 0.f};
#pragma unroll
    for (int ks = 0; ks < 4; ++ks) { const bf16x8 af = *(const LAS bf16x8*)(as + fr * AP + ks * 32 + fq * 8);
#pragma unroll
        for (int eb = 0; eb < 4; ++eb) { const bf16x8 bv = *(const LAS bf16x8*)(vt + (eb * 16 + fr) * TP + ks * 32 + fq * 8);
            y[eb] = __builtin_amdgcn_mfma_f32_16x16x32_bf16(af, bv, y[eb], 0, 0, 0); } }
    { const float xf = exp2f(lgf * (float)(i0 + fr + 1)), xb = exp2f(lgb * (float)(128 - (i0 + fr)));
      bf16x8 qf, qb;
#pragma unroll
      for (int j = 0; j < 8; ++j) { const float qv = bf2f((bf16_t)qa[j]); qf[j] = (short)f2bf(qv * xf); qb[j] = (short)f2bf(qv * xb); }
#pragma unroll
      for (int eb = 0; eb < 4; ++eb) { const bf16x8 bf_ = *(const LAS bf16x8*)(rtf + (eb * 16 + fr) * RP + fq * 8), bb_ = *(const LAS bf16x8*)(rtb + (eb * 16 + fr) * RP + fq * 8);
          y[eb] = __builtin_amdgcn_mfma_f32_16x16x32_bf16(qf, bf_, y[eb], 0, 0, 0);
          y[eb] = __builtin_amdgcn_mfma_f32_16x16x32_bf16(qb, bb_, y[eb], 0, 0, 0); } }
    const bf16_t* P1 = wsp<bf16_t>(F, WS_P1); unsigned char* OAB = wsp<unsigned char>(F, WS_OAB);
#pragma unroll
    for (int r = 0; r < 4; ++r) {
        float sm = y[0][r] + y[1][r] + y[2][r] + y[3][r]; sm = row16_sum(sm); const float mu = sm * (1.f / 64.f);
        float vs = 0.f;
#pragma unroll
        for (int eb = 0; eb < 4; ++eb) { const float d = y[eb][r] - mu; vs += d * d; }
        vs = row16_sum(vs); const float rstd = rsqrtf(vs * (1.f / 64.f) + LN_EPS);
        const int i = i0 + fq * 4 + r; const int tp = tpos0 + i; const size_t grow = tp >= CTXL ? (size_t)b * SEQ + (tp - CTXL) : (size_t)NLAT + b * CTXL + tp;
#pragma unroll
        for (int eb = 0; eb < 4; ++eb) { const int e = eb * 16 + fr; const float g = bf2f(P1[grow * NP1 + C_RG + h * 64 + e]);
            OAB[grow * D + 512 + h * 64 + e] = (unsigned char)(pk4_fp8(clamp8(silu_f(g) * (y[eb][r] - mu) * rstd * 16.f), 0.f, 0.f, 0.f) & 0xffu); }
    }
}
namespace att {
constexpr int NW = 8, QBLK = 32, KVBLK = 64;
constexpr size_t SHM_V = KVBLK * 128 * 2, SHM_K = KVBLK * 128 * 2, SHM_ATTN = 2 * SHM_V + 2 * SHM_K + NW * 64 * 4;
constexpr float THR = 8.f;
#define KSWZ(row, colB) ((row) * 256 + ((colB) ^ (((row) & 7) << 4)))
#define SBAR() __builtin_amdgcn_sched_barrier(0)
__device__ __forceinline__ int crow(int r, int hi) { return (r & 3) + 8 * (r >> 2) + 4 * hi; }
template <int SC> struct Scale { static constexpr float S = SC == 0 ? 0.08838834764831845f : 0.10206207261596575f; static constexpr float C = S * 1.4426950408889634f; static constexpr float THRR = THR / S; };
template <int SC>
__device__ __forceinline__ void partialSM(f32x16& p0, f32x16& p1, float& m_reg, float& mn, float& alpha) {
  constexpr float C = Scale<SC>::C, thr_raw = Scale<SC>::THRR;
  float pmax = p0[0];
#pragma unroll
  for (int r = 1; r < 16; ++r) pmax = fmaxf(pmax, p0[r]);
#pragma unroll
  for (int r = 0; r < 16; ++r) pmax = fmaxf(pmax, p1[r]);
  { auto rr = __builtin_amdgcn_permlane32_swap(__float_as_uint(pmax), __float_as_uint(pmax), false, false);
    pmax = fmaxf(__uint_as_float(rr[0]), __uint_as_float(rr[1])); }
  if (__builtin_expect(__all(pmax - m_reg <= thr_raw), 1)) { mn = m_reg; alpha = 1.f; }
  else { mn = fmaxf(m_reg, pmax); alpha = __builtin_amdgcn_exp2f((m_reg - mn) * C); m_reg = mn; }
  const float mnC = -mn * C;
#pragma unroll
  for (int r = 0; r < 16; ++r) p0[r] = fmaf(p0[r], C, mnC);
#pragma unroll
  for (int r = 0; r < 16; ++r) p1[r] = fmaf(p1[r], C, mnC);
#pragma unroll
  for (int r = 0; r < 16; ++r) p0[r] = __builtin_amdgcn_exp2f(p0[r]);
}
__device__ __forceinline__ void finishSM(f32x16& p0, f32x16& p1, float alpha, float& l_reg, bf16x8& pa0, bf16x8& pa1, bf16x8& pa2, bf16x8& pa3) {
#pragma unroll
  for (int r = 0; r < 16; ++r) p1[r] = __builtin_amdgcn_exp2f(p1[r]);
  float ps = 0;
#pragma unroll
  for (int r = 0; r < 16; ++r) ps += p0[r];
#pragma unroll
  for (int r = 0; r < 16; ++r) ps += p1[r];
  { auto rr = __builtin_amdgcn_permlane32_swap(__float_as_uint(ps), __float_as_uint(ps), false, false);
    ps = __uint_as_float(rr[0]) + __uint_as_float(rr[1]); }
  l_reg = l_reg * alpha + ps;
#define PK4(P, BASE, OUT) do { unsigned a0 = cvt_pk_bf16(P[BASE + 0], P[BASE + 1]), a1 = cvt_pk_bf16(P[BASE + 2], P[BASE + 3]);   \
    unsigned b0 = cvt_pk_bf16(P[BASE + 4], P[BASE + 5]), b1 = cvt_pk_bf16(P[BASE + 6], P[BASE + 7]);                              \
    auto r0 = __builtin_amdgcn_permlane32_swap(a0, b0, false, false); auto r1 = __builtin_amdgcn_permlane32_swap(a1, b1, false, false); \
    u32x4 w = {r0[0], r1[0], r0[1], r1[1]}; OUT = *reinterpret_cast<bf16x8*>(&w); } while (0)
  PK4(p0, 0, pa0); PK4(p0, 8, pa1); PK4(p1, 0, pa2); PK4(p1, 8, pa3);
#undef PK4
}
template <int NDQ>
__device__ __forceinline__ void qkt(f32x16& p0, f32x16& p1, const char* Ks, const bf16x8* qr, int r32, int hi) {
  p0 = f32x16{}; p1 = f32x16{};
#pragma unroll
  for (int d0 = 0; d0 < NDQ; ++d0) { const int cb = (d0 * 16 + hi * 8) * 2;
    const bf16x8 b0 = *reinterpret_cast<const bf16x8*>(Ks + KSWZ(r32, cb));
    const bf16x8 b1 = *reinterpret_cast<const bf16x8*>(Ks + KSWZ(32 + r32, cb));
    p0 = __builtin_amdgcn_mfma_f32_32x32x16_bf16(b0, qr[d0], p0, 0, 0, 0);
    p1 = __builtin_amdgcn_mfma_f32_32x32x16_bf16(b1, qr[d0], p1, 0, 0, 0); }
}
typedef int i32x8a __attribute__((ext_vector_type(8))); typedef int i32x4a __attribute__((ext_vector_type(4)));
#define KSWZ8(row, chunk) ((row) * 128 + ((((chunk) ^ ((row) & 7))) << 4))
__device__ __forceinline__ void qkt8(f32x16& p0, f32x16& p1, const char* Ks, const i32x8a* qr8, int r32, int hi) {
  p0 = f32x16{}; p1 = f32x16{};
#pragma unroll
  for (int blk = 0; blk < 2; ++blk) { const int c0 = blk * 4 + 2 * hi;
    const i32x4a a0 = *reinterpret_cast<const i32x4a*>(Ks + KSWZ8(r32, c0)), a1 = *reinterpret_cast<const i32x4a*>(Ks + KSWZ8(r32, c0 + 1));
    const i32x4a b0 = *reinterpret_cast<const i32x4a*>(Ks + KSWZ8(32 + r32, c0)), b1 = *reinterpret_cast<const i32x4a*>(Ks + KSWZ8(32 + r32, c0 + 1));
    p0 = __builtin_amdgcn_mfma_scale_f32_32x32x64_f8f6f4(__builtin_shufflevector(a0, a1, 0, 1, 2, 3, 4, 5, 6, 7), qr8[blk], p0, 0, 0, 0, 0x7F7F7F7F, 0, 0x7F7F7F7F);
    p1 = __builtin_amdgcn_mfma_scale_f32_32x32x64_f8f6f4(__builtin_shufflevector(b0, b1, 0, 1, 2, 3, 4, 5, 6, 7), qr8[blk], p1, 0, 0, 0, 0x7F7F7F7F, 0, 0x7F7F7F7F); }
}
__device__ __forceinline__ int v_st(int k, int c) { const int kk = (k & ~0xC) | ((k & 4) << 1) | ((k & 8) >> 1); return ((kk >> 3) * 4 + (c >> 5)) * 512 + ((kk & 7) * 32 + (c & 31)) * 2; }
__device__ __forceinline__ int v_rd_base(int lane) { return ((lane & 3) << 3) | (((lane >> 2) & 3) << 6) | (((lane >> 4) & 1) << 5) | (((lane >> 5) & 1) << 8); }
constexpr int v_rd_off(int d0, int ks, int half) { return d0 * 512 + ks * 4096 + half * 2048; }
template <int OFF> __device__ __forceinline__ s16x4 tr_read(int vb) {
  s16x4 r; asm volatile("ds_read_b64_tr_b16 %0, %1 offset:%2" : "=&v"(r) : "v"(vb), "i"(OFF) : "memory"); return r;
}
template <int D0> __device__ __forceinline__ void pv_one(f32x16& od, int vb, bf16x8 pa0, bf16x8 pa1, bf16x8 pa2, bf16x8 pa3) {
  const s16x4 l0 = tr_read<v_rd_off(D0, 0, 0)>(vb), h0 = tr_read<v_rd_off(D0, 0, 1)>(vb), l1 = tr_read<v_rd_off(D0, 1, 0)>(vb), h1 = tr_read<v_rd_off(D0, 1, 1)>(vb);
  const s16x4 l2 = tr_read<v_rd_off(D0, 2, 0)>(vb), h2 = tr_read<v_rd_off(D0, 2, 1)>(vb), l3 = tr_read<v_rd_off(D0, 3, 0)>(vb), h3 = tr_read<v_rd_off(D0, 3, 1)>(vb);
  asm volatile("s_waitcnt lgkmcnt(0)" ::: "memory"); SBAR();
#define PK(L, H) (bf16x8){L[0], L[1], L[2], L[3], H[0], H[1], H[2], H[3]}
  od = __builtin_amdgcn_mfma_f32_32x32x16_bf16(pa0, PK(l0, h0), od, 0, 0, 0);
  od = __builtin_amdgcn_mfma_f32_32x32x16_bf16(pa1, PK(l1, h1), od, 0, 0, 0);
  od = __builtin_amdgcn_mfma_f32_32x32x16_bf16(pa2, PK(l2, h2), od, 0, 0, 0);
  od = __builtin_amdgcn_mfma_f32_32x32x16_bf16(pa3, PK(l3, h3), od, 0, 0, 0);
#undef PK
}
template <int NDV> __device__ __forceinline__ void pv_d0(f32x16* o, int vb, bf16x8 pa0, bf16x8 pa1, bf16x8 pa2, bf16x8 pa3) {
  pv_one<0>(o[0], vb, pa0, pa1, pa2, pa3); pv_one<1>(o[1], vb, pa0, pa1, pa2, pa3);
  if constexpr (NDV == 4) { pv_one<2>(o[2], vb, pa0, pa1, pa2, pa3); pv_one<3>(o[3], vb, pa0, pa1, pa2, pa3); }
}
template <int NDQ, int NDV, int SC, int SDEPTH>
__device__ __forceinline__ void attn_body(const unsigned char* __restrict__ Qb, const unsigned char* __restrict__ Kh, const bf16_t* __restrict__ Vh,
                                          unsigned char* __restrict__ Ob, int seq, char* lds, const int tid) {
  constexpr int LDK = 128, LDV = NDV * 32, ldo = 2048;
  const int wid = tid >> 6, lane = tid & 63, r32 = lane & 31, hi = lane >> 5;
  char* V_lds = lds; char* K_lds = lds + 2 * SHM_V;
  float* ws = (float*)(lds + 2 * SHM_V + 2 * SHM_K) + wid * 64; float* li_l = ws; float* al_l = ws + 32;
  float m_reg = -1e30f, l_reg = 0; f32x16 o[NDV] = {}; i32x8a qr8[2];
  const unsigned char* Qw = Qb + (long)(wid * QBLK + r32) * 128 + hi * 32;
#pragma unroll
  for (int blk = 0; blk < 2; ++blk) { const i32x4a lo_ = *reinterpret_cast<const i32x4a*>(Qw + blk * 64), hi_ = *reinterpret_cast<const i32x4a*>(Qw + blk * 64 + 16); qr8[blk] = __builtin_shufflevector(lo_, hi_, 0, 1, 2, 3, 4, 5, 6, 7); }
  const int sr = tid >> 4, sc = (tid & 15) * 8;
  const int kr8 = tid >> 3, kc8 = tid & 7;
  const int vr = NDV == 4 ? sr : (tid >> 3), vc = NDV == 4 ? sc : (tid & 7) * 8;
  const int vst0 = v_st(NDV == 4 ? 2 * sr : vr, vc), vst1 = v_st(2 * sr + 1, sc);
  const int vb0 = (int)(uintptr_t)V_lds + v_rd_base(lane);
  struct { bf16x8 vs0, vs1; i32x4a ks0; } sr_[SDEPTH];
#define SLOAD(i, k0) do { const bf16_t* vp_ = Vh + (long)((k0) + (NDV == 4 ? 2 * sr : vr)) * LDV + vc; \
    sr_[i].vs0 = *reinterpret_cast<const bf16x8*>(vp_); if constexpr (NDV == 4) sr_[i].vs1 = *reinterpret_cast<const bf16x8*>(vp_ + LDV); \
    sr_[i].ks0 = *reinterpret_cast<const i32x4a*>(Kh + (long)((k0) + kr8) * 128 + kc8 * 16); } while (0)
#define SWRITE(b, i) do { *(bf16x8*)(V_lds + (b) * SHM_V + vst0) = sr_[i].vs0;          \
    if constexpr (NDV == 4) *(bf16x8*)(V_lds + (b) * SHM_V + vst1) = sr_[i].vs1;               \
    *(i32x4a*)(K_lds + (b) * SHM_K + KSWZ8(kr8, kc8)) = sr_[i].ks0; } while (0)
#define SWAIT() do { if constexpr (SDEPTH == 1) asm volatile("s_waitcnt vmcnt(0)" ::: "memory"); else if constexpr (NDV == 4) asm volatile("s_waitcnt vmcnt(3)" ::: "memory"); else asm volatile("s_waitcnt vmcnt(2)" ::: "memory"); } while (0)
#define RESC(a) do { if (__any((a) < 1.f)) { if (hi == 0) al_l[r32] = (a); asm volatile("s_waitcnt lgkmcnt(0)" ::: "memory"); \
    _Pragma("unroll") for (int d = 0; d < NDV; ++d) _Pragma("unroll") for (int r = 0; r < 16; ++r) o[d][r] *= al_l[crow(r, hi)]; } } while (0)
  f32x16 pA0, pA1, pB0, pB1; float mnA, mnB, alA, alB; bf16x8 pa0, pa1, pa2, pa3; const int NT = seq / KVBLK;
  constexpr int SE = 0, SO = SDEPTH - 1;
  SLOAD(SE, 0); asm volatile("s_waitcnt vmcnt(0)" ::: "memory"); SWRITE(0, SE); __syncthreads();
  qkt8(pA0, pA1, K_lds, qr8, r32, hi); partialSM<SC>(pA0, pA1, m_reg, mnA, alA);
  SLOAD(SO, KVBLK); if constexpr (SDEPTH == 2) { if (2 < NT) SLOAD(SE, 2 * KVBLK); }
  SWAIT(); SWRITE(1, SO); __syncthreads();
  for (int j = 1; j + 1 < NT; j += 2) {
    SBAR(); qkt8(pB0, pB1, K_lds + SHM_K, qr8, r32, hi);
    finishSM(pA0, pA1, alA, l_reg, pa0, pa1, pa2, pa3); SBAR();
    SLOAD(SO, (j + SDEPTH) * KVBLK); SBAR();
    pv_d0<NDV>(o, vb0, pa0, pa1, pa2, pa3); partialSM<SC>(pB0, pB1, m_reg, mnB, alB);
    __syncthreads(); SWAIT(); SWRITE(0, SE);
    RESC(alB); __syncthreads();
    SBAR(); qkt8(pA0, pA1, K_lds, qr8, r32, hi);
    finishSM(pB0, pB1, alB, l_reg, pa0, pa1, pa2, pa3); SBAR();
    if (SDEPTH == 1 || j + 3 < NT) SLOAD(SE, (j + 1 + SDEPTH) * KVBLK); SBAR();
    pv_d0<NDV>(o, vb0 + (int)SHM_V, pa0, pa1, pa2, pa3); partialSM<SC>(pA0, pA1, m_reg, mnA, alA);
    __syncthreads(); SWAIT(); SWRITE(1, SO);
    RESC(alA); __syncthreads();
  }
  SBAR(); qkt8(pB0, pB1, K_lds + SHM_K, qr8, r32, hi);
  finishSM(pA0, pA1, alA, l_reg, pa0, pa1, pa2, pa3); SBAR();
  pv_d0<NDV>(o, vb0, pa0, pa1, pa2, pa3); partialSM<SC>(pB0, pB1, m_reg, mnB, alB);
  __syncthreads(); RESC(alB);
  finishSM(pB0, pB1, alB, l_reg, pa0, pa1, pa2, pa3); SBAR();
  pv_d0<NDV>(o, vb0 + (int)SHM_V, pa0, pa1, pa2, pa3);
  if (hi == 0) li_l[r32] = l_reg; asm volatile("s_waitcnt lgkmcnt(0)" ::: "memory");
  float rli[16];
#pragma unroll
  for (int r = 0; r < 16; ++r) rli[r] = __builtin_amdgcn_rcpf(li_l[crow(r, hi)]);
  unsigned char* Ow = Ob + (long)(wid * QBLK) * ldo;
#pragma unroll
  for (int r = 0; r < 16; ++r) { const int orow = crow(r, hi);
#pragma unroll
    for (int d0 = 0; d0 < NDV; ++d0) Ow[(long)orow * ldo + d0 * 32 + r32] = (unsigned char)(pk4_fp8(clamp8(o[d0][r] * rli[r] * 16.f), 0.f, 0.f, 0.f) & 0xffu); }
#undef SLOAD
#undef SWRITE
#undef SWAIT
#undef RESC
}
}
__device__ __forceinline__ float* xres_row(const Frame& F, int row) { return row < NLAT ? F.out + (size_t)row * D : wsp<float>(F, WS_XC) + (size_t)(row - NLAT) * D; }
__device__ __forceinline__ void ln_row(float (&y)[32], const float* g, const float* b, int lane) {
    float s = 0.f;
#pragma unroll
    for (int i = 0; i < 32; ++i) s += y[i];
    const float mu = wave_sum(s) * (1.f / 2048.f);
    float q = 0.f;
#pragma unroll
    for (int i = 0; i < 32; ++i) { const float d = y[i] - mu; q += d * d; }
    const float rstd = rsqrtf(wave_sum(q) * (1.f / 2048.f) + LN_EPS);
#pragma unroll
    for (int qq = 0; qq < 4; ++qq) { const f32x4 g0 = *(const f32x4*)(g + 512 * qq + 8 * lane), g1 = *(const f32x4*)(g + 512 * qq + 8 * lane + 4), b0 = *(const f32x4*)(b + 512 * qq + 8 * lane), b1 = *(const f32x4*)(b + 512 * qq + 8 * lane + 4);
#pragma unroll
        for (int i = 0; i < 4; ++i) { y[qq * 8 + i] = (y[qq * 8 + i] - mu) * rstd * g0[i] + b0[i]; y[qq * 8 + 4 + i] = (y[qq * 8 + 4 + i] - mu) * rstd * g1[i] + b1[i]; } }
}
__device__ __forceinline__ void modulate_store(const float (&x)[32], const float* sh, const float* sc, bf16_t* dst, int lane) {
#pragma unroll
    for (int q = 0; q < 4; ++q) { const f32x4 h0 = *(const f32x4*)(sh + 512 * q + 8 * lane), h1 = *(const f32x4*)(sh + 512 * q + 8 * lane + 4), c0 = *(const f32x4*)(sc + 512 * q + 8 * lane), c1 = *(const f32x4*)(sc + 512 * q + 8 * lane + 4);
        f32x4 a, b;
#pragma unroll
        for (int i = 0; i < 4; ++i) { a[i] = x[q * 8 + i] * (1.f + c0[i]) + h0[i]; b[i] = x[q * 8 + 4 + i] * (1.f + c1[i]) + h1[i]; }
        *(u32x4*)(dst + 512 * q + 8 * lane) = pack8(a, b); }
}
__device__ __forceinline__ void p_ln1(const Frame& F, int l, bool last) {
    const float* mod = wsp<float>(F, WS_MOD) + (size_t)l * 5 * 12288; bf16_t* hb = wsp<bf16_t>(F, WS_HB);
    const float* g = F.in(18) + l * D; const float* b = F.in(19) + l * D;
    const int nrows = last ? NLAT : NROW; const int lane = F.lane, step = F.G * 8;
    float gg[32], bb[32]; ld_row_f32(g, lane, gg); ld_row_f32(b, lane, bb);
    int row = F.bid * 8 + F.wave;
    float yn[32];
    if (row < nrows) ld_row_f32(xres_row(F, row), lane, yn);
#pragma unroll 1
    for (; row < nrows; row += step) {
        const int v = row < NLAT ? (row >> 12) : 4; float* xp = xres_row(F, row);
        float y[32], sh[32], sc[32];
#pragma unroll
        for (int i = 0; i < 32; ++i) y[i] = yn[i];
        ld_row_f32(mod + (size_t)v * 12288 + 6144, lane, sh); ld_row_f32(mod + (size_t)v * 12288 + 8192, lane, sc);
        { const int nrow = row + step; if (nrow < nrows) ld_row_f32(xres_row(F, nrow), lane, yn); }
        float s = 0.f;
#pragma unroll
        for (int i = 0; i < 32; ++i) s += y[i];
        const float mu = wave_sum(s) * (1.f / 2048.f); float q = 0.f;
#pragma unroll
        for (int i = 0; i < 32; ++i) { const float d = y[i] - mu; q += d * d; }
        const float rstd = rsqrtf(wave_sum(q) * (1.f / 2048.f) + LN_EPS);
#pragma unroll
        for (int i = 0; i < 32; ++i) y[i] = (y[i] - mu) * rstd * gg[i] + bb[i];
        st_row_f32(xp, lane, y);
#pragma unroll
        for (int i = 0; i < 32; ++i) y[i] = y[i] * (1.f + sc[i]) + sh[i];
        st_row_bf16(hb + (size_t)row * D, lane, y);
    }
}

template <int NV>
__device__ __forceinline__ void top16(const float (&val)[NV], bool (&sel)[NV], int (&slot)[NV]) {
    unsigned key[NV];
#pragma unroll
    for (int v = 0; v < NV; ++v) { const unsigned u = __float_as_uint(val[v]); key[v] = (u & 0x80000000u) ? ~u : (u | 0x80000000u); }
    unsigned T = 0u;
#pragma unroll 1
    for (int bit = 31; bit >= 0; --bit) {
        const unsigned cand = T | (1u << bit); int cnt = 0;
#pragma unroll
        for (int v = 0; v < NV; ++v) cnt += __popcll(__ballot(key[v] >= cand));
        if (cnt >= 16) T = cand;
    }
    int ngt = 0;
#pragma unroll
    for (int v = 0; v < NV; ++v) ngt += __popcll(__ballot(key[v] > T));
    const int need = 16 - ngt;
    int run = 0, erun = 0;
#pragma unroll
    for (int v = 0; v < NV; ++v) {
        const unsigned long long mg = __ballot(key[v] > T), me = __ballot(key[v] == T);
        const int pg = __builtin_amdgcn_mbcnt_hi((unsigned)(mg >> 32), __builtin_amdgcn_mbcnt_lo((unsigned)mg, 0u));
        const int pe = __builtin_amdgcn_mbcnt_hi((unsigned)(me >> 32), __builtin_amdgcn_mbcnt_lo((unsigned)me, 0u));
        sel[v] = false; slot[v] = 0;
        if (key[v] > T) { sel[v] = true; slot[v] = run + pg; }
        else if (key[v] == T && (erun + pe) < need) { sel[v] = true; slot[v] = ngt + erun + pe; }
        run += __popcll(mg); erun += __popcll(me);
    }
}
__device__ __forceinline__ unsigned f2key(float f) { const unsigned u = __float_as_uint(f); return (u & 0x80000000u) ? ~u : (u | 0x80000000u); }
__device__ __forceinline__ float key2f(unsigned k) { return __uint_as_float((k & 0x80000000u) ? (k & 0x7fffffffu) : ~k); }
template <int NP, int NV>
__device__ __forceinline__ void bisect16(const unsigned (&key)[NP][NV], unsigned (&T)[NP]) {
    bool done[NP];
#pragma unroll
    for (int p = 0; p < NP; ++p) { T[p] = 0u; done[p] = false; }
#pragma unroll 1
    for (int bit = 31; bit >= 0; --bit) {
        const unsigned bm = 1u << bit; bool all = true;
#pragma unroll
        for (int p = 0; p < NP; ++p) {
            const unsigned cand = T[p] | bm; int cnt = 0;
#pragma unroll
            for (int v = 0; v < NV; ++v) cnt += __popcll(__ballot(key[p][v] >= cand));
            const bool upd = (cnt >= 16) && !done[p];
            T[p] = upd ? cand : T[p]; done[p] = done[p] || (cnt == 16); all = all && done[p];
        }
        if (all) break;
    }
}
template <int NV>
__device__ __forceinline__ void compact16(const unsigned (&key)[NV], const unsigned T, bool (&sel)[NV], int (&slot)[NV]) {
    int ngt = 0;
#pragma unroll
    for (int v = 0; v < NV; ++v) ngt += __popcll(__ballot(key[v] > T));
    const int need = 16 - ngt; int run = 0, erun = 0;
#pragma unroll
    for (int v = 0; v < NV; ++v) {
        const unsigned long long mg = __ballot(key[v] > T), me = __ballot(key[v] == T);
        const int pg = __builtin_amdgcn_mbcnt_hi((unsigned)(mg >> 32), __builtin_amdgcn_mbcnt_lo((unsigned)mg, 0u));
        const int pe = __builtin_amdgcn_mbcnt_hi((unsigned)(me >> 32), __builtin_amdgcn_mbcnt_lo((unsigned)me, 0u));
        sel[v] = false; slot[v] = 0;
        if (key[v] > T) { sel[v] = true; slot[v] = run + pg; }
        else if (key[v] == T && (erun + pe) < need) { sel[v] = true; slot[v] = ngt + erun + pe; }
        run += __popcll(mg); erun += __popcll(me);
    }
}
constexpr int KP = 68;
constexpr int PW_BYTES = 9344;
__device__ __forceinline__ float gelu_erf(float x) {
    const float z = fabsf(x) * 0.7071067811865476f; const float t = __builtin_amdgcn_rcpf(1.f + 0.3275911f * z);
    float p = 1.061405429f; p = p * t - 1.453152027f; p = p * t + 1.421413741f; p = p * t - 0.284496736f; p = p * t + 0.254829592f; p = p * t;
    const float er = 1.f - p * __expf(-z * z);
    return 0.5f * x * (1.f + (x < 0.f ? -er : er));
}
__device__ __forceinline__ float wave_max(float x) {
    x = row16_max(x);
    { auto r = __builtin_amdgcn_permlane16_swap(__float_as_uint(x), __float_as_uint(x), false, false); x = fmaxf(__uint_as_float(r[0]), __uint_as_float(r[1])); }
    { auto r = __builtin_amdgcn_permlane32_swap(__float_as_uint(x), __float_as_uint(x), false, false); x = fmaxf(__uint_as_float(r[0]), __uint_as_float(r[1])); }
    return x;
}
__device__ __forceinline__ void ld16_f32(const float* p, int lane, float (&x)[32]) {
#pragma unroll
    for (int q = 0; q < 2; ++q)
#pragma unroll
        for (int d = 0; d < 4; ++d) { const f32x4 a = *(const f32x4*)(p + 1024 * q + 16 * lane + 4 * d); x[q * 16 + d * 4 + 0] = a[0]; x[q * 16 + d * 4 + 1] = a[1]; x[q * 16 + d * 4 + 2] = a[2]; x[q * 16 + d * 4 + 3] = a[3]; }
}
__device__ __forceinline__ void ld16_f32_nt(const float* p, int lane, float (&x)[32]) {
#pragma unroll
    for (int q = 0; q < 2; ++q)
#pragma unroll
        for (int d = 0; d < 4; ++d) { const f32x4 a = __builtin_nontemporal_load((const f32x4*)(p + 1024 * q + 16 * lane + 4 * d)); x[q * 16 + d * 4 + 0] = a[0]; x[q * 16 + d * 4 + 1] = a[1]; x[q * 16 + d * 4 + 2] = a[2]; x[q * 16 + d * 4 + 3] = a[3]; }
}
__device__ __forceinline__ void st16_f32_nt(float* p, int lane, const float (&x)[32]) {
#pragma unroll
    for (int q = 0; q < 2; ++q)
#pragma unroll
        for (int d = 0; d < 4; ++d) __builtin_nontemporal_store((f32x4){x[q * 16 + d * 4 + 0], x[q * 16 + d * 4 + 1], x[q * 16 + d * 4 + 2], x[q * 16 + d * 4 + 3]}, (f32x4*)(p + 1024 * q + 16 * lane + 4 * d));
}
__device__ __forceinline__ void st16_f32(float* p, int lane, const float (&x)[32]) {
#pragma unroll
    for (int q = 0; q < 2; ++q)
#pragma unroll
        for (int d = 0; d < 4; ++d) *(f32x4*)(p + 1024 * q + 16 * lane + 4 * d) = (f32x4){x[q * 16 + d * 4 + 0], x[q * 16 + d * 4 + 1], x[q * 16 + d * 4 + 2], x[q * 16 + d * 4 + 3]};
}
__device__ __forceinline__ void ld16_bf16(const bf16_t* p, int lane, float (&x)[32]) {
#pragma unroll
    for (int q = 0; q < 2; ++q)
#pragma unroll
        for (int d = 0; d < 2; ++d) { const u32x4 w = *(const u32x4*)(p + 1024 * q + 16 * lane + 8 * d); float* o = &x[q * 16 + d * 8];
            o[0] = bflo(w.x); o[1] = bfhi(w.x); o[2] = bflo(w.y); o[3] = bfhi(w.y); o[4] = bflo(w.z); o[5] = bfhi(w.z); o[6] = bflo(w.w); o[7] = bfhi(w.w); }
}
__device__ __forceinline__ void st16_bf16(bf16_t* p, int lane, const float (&x)[32]) {
#pragma unroll
    for (int q = 0; q < 2; ++q)
#pragma unroll
        for (int d = 0; d < 2; ++d) { const float* o = &x[q * 16 + d * 8]; u32x4 w; w.x = cvt_pk_bf16(o[0], o[1]); w.y = cvt_pk_bf16(o[2], o[3]); w.z = cvt_pk_bf16(o[4], o[5]); w.w = cvt_pk_bf16(o[6], o[7]);
            *(u32x4*)(p + 1024 * q + 16 * lane + 8 * d) = w; }
}
constexpr int TBS = 1152;
__device__ __forceinline__ void cvt_row_fp4b(int lane, const float* __restrict__ src, unsigned char* __restrict__ dst) {
    float x[32];
#pragma unroll
    for (int q = 0; q < 2; ++q)
#pragma unroll
        for (int d = 0; d < 4; ++d) { const f32x4 a = __builtin_nontemporal_load((const f32x4*)(src + 1024 * q + 16 * lane + 4 * d)); x[q * 16 + d * 4 + 0] = a[0]; x[q * 16 + d * 4 + 1] = a[1]; x[q * 16 + d * 4 + 2] = a[2]; x[q * 16 + d * 4 + 3] = a[3]; }
    float am = 0.f;
#pragma unroll
    for (int i = 0; i < 32; ++i) am = fmaxf(am, fabsf(x[i]));
    const bf16_t sb = f2bf(am * (1.f / 6.f)); const float sf = bf2f(sb); const float sc = sf > 0.f ? 1.f / sf : 0.f;
    u32x4 w;
#pragma unroll
    for (int d = 0; d < 4; ++d) { unsigned t = 0u; const int o = (d >> 1) * 16 + (d & 1) * 8;
        t = __builtin_amdgcn_cvt_scalef32_pk_fp4_f32(t, x[o + 0] * sc, x[o + 1] * sc, 1.0f, 0); t = __builtin_amdgcn_cvt_scalef32_pk_fp4_f32(t, x[o + 2] * sc, x[o + 3] * sc, 1.0f, 1);
        t = __builtin_amdgcn_cvt_scalef32_pk_fp4_f32(t, x[o + 4] * sc, x[o + 5] * sc, 1.0f, 2); t = __builtin_amdgcn_cvt_scalef32_pk_fp4_f32(t, x[o + 6] * sc, x[o + 7] * sc, 1.0f, 3); w[d] = t; }
    *(u32x4*)(dst + 16 * lane) = w;
    *(bf16_t*)(dst + 1024 + 2 * lane) = sb;
}
__device__ __forceinline__ void cvt_row_fp4r(int lane, const float* __restrict__ src, unsigned char* __restrict__ dst, float* __restrict__ inv) {
    float x[32];
#pragma unroll
    for (int q = 0; q < 2; ++q)
#pragma unroll
        for (int d = 0; d < 4; ++d) { const f32x4 a = __builtin_nontemporal_load((const f32x4*)(src + 1024 * q + 16 * lane + 4 * d)); x[q * 16 + d * 4 + 0] = a[0]; x[q * 16 + d * 4 + 1] = a[1]; x[q * 16 + d * 4 + 2] = a[2]; x[q * 16 + d * 4 + 3] = a[3]; }
    float am = 0.f;
#pragma unroll
    for (int i = 0; i < 32; ++i) am = fmaxf(am, fabsf(x[i]));
    am = wave_max(am);
    const float sc = am > 0.f ? 6.f / am : 1.f;
    if (lane == 0) *inv = am > 0.f ? am * (1.f / 6.f) : 1.f;
    u32x4 w;
#pragma unroll
    for (int d = 0; d < 4; ++d) { unsigned t = 0u; const int o = (d >> 1) * 16 + (d & 1) * 8;
        t = __builtin_amdgcn_cvt_scalef32_pk_fp4_f32(t, x[o + 0] * sc, x[o + 1] * sc, 1.0f, 0); t = __builtin_amdgcn_cvt_scalef32_pk_fp4_f32(t, x[o + 2] * sc, x[o + 3] * sc, 1.0f, 1);
        t = __builtin_amdgcn_cvt_scalef32_pk_fp4_f32(t, x[o + 4] * sc, x[o + 5] * sc, 1.0f, 2); t = __builtin_amdgcn_cvt_scalef32_pk_fp4_f32(t, x[o + 6] * sc, x[o + 7] * sc, 1.0f, 3); w[d] = t; }
    *(u32x4*)(dst + 16 * lane) = w;
}
__device__ __forceinline__ void cvt_peer(const Frame& F, int l) {
    for (int r = F.bid * 8 + F.wave; r < 16384; r += F.G * 8) cvt_row_fp4b(F.lane, F.in(23) + ((size_t)l * 16384 + r) * 2048, wsp<unsigned char>(F, WS_PU) + (size_t)l * SZ_PT + (size_t)r * TBS);
    for (int r = F.bid * 8 + F.wave; r < 16384; r += F.G * 8) cvt_row_fp4b(F.lane, F.in(24) + ((size_t)l * 16384 + r) * 2048, wsp<unsigned char>(F, WS_PV) + (size_t)l * SZ_PT + (size_t)r * TBS);
}
#define PEER_G 4
template <int CTRL> __device__ __forceinline__ int dppi(int x) { return __builtin_amdgcn_update_dpp(0, x, CTRL, 0xF, 0xF, true); }
__device__ __forceinline__ int irow16_sum(int x) { x += dppi<0xB1>(x); x += dppi<0x4E>(x); x += dppi<0x141>(x); x += dppi<0x140>(x); return x; }
__device__ __forceinline__ int irow16_incl_scan(int x) { x += dppi<0x111>(x); x += dppi<0x112>(x); x += dppi<0x114>(x); x += dppi<0x118>(x); return x; }
constexpr int KBP = 72;
constexpr int PT_WORDS = 6 * 128 + 160 + 3 * 128;
constexpr int PWB = 2 * PT_WORDS * 4;
__device__ __forceinline__ void p_peer(const Frame& F, int l, bool last) {
    LAS bf16_t* kb1 = (LAS bf16_t*)F.lds; LAS bf16_t* kb2 = kb1 + 128 * KBP;
    LAS unsigned* wbase = (LAS unsigned*)(F.lds + 2 * 128 * KBP * 2 + F.wave * PWB);
    const int lane = F.lane, fr = lane & 15, fq = lane >> 4;
    __syncthreads();
    for (int i = F.tid; i < 128 * 64; i += 512) { const int r = i >> 6, d = i & 63; kb1[r * KBP + d] = f2bf(F.in(21)[(size_t)l * 8192 + i]); kb2[r * KBP + d] = f2bf(F.in(22)[(size_t)l * 8192 + i]); }
    __syncthreads();
    const bf16_t* QP = wsp<bf16_t>(F, WS_QP); const bf16_t* HB = wsp<bf16_t>(F, WS_HB); unsigned char* HB8w = wsp<unsigned char>(F, WS_HB8);
    const unsigned char* PU = wsp<unsigned char>(F, WS_PU) + (size_t)l * SZ_PT; const unsigned char* PV = wsp<unsigned char>(F, WS_PV) + (size_t)l * SZ_PT;
    const float* modl = wsp<float>(F, WS_MOD) + (size_t)l * 5 * 12288; const float* modn = wsp<float>(F, WS_MOD) + (size_t)(l + 1) * 5 * 12288;
    const float* g2n = F.in(25) + l * D; const float* b2n = F.in(26) + l * D;
    const int npairs = (last ? NLAT : NROW) / 2;
    const int per_wg = (npairs + F.G - 1) / F.G; const int p_lo = F.bid * per_wg; const int p_hi = (p_lo + per_wg) < npairs ? (p_lo + per_wg) : npairs;
    LAS int* wq = (LAS int*)(F.lds + 147456 - 32);
    if (F.tid == 0) *wq = 0;
    __syncthreads();
#pragma unroll 1
    for (;;) {
        int pi = 0; if (lane == 0) pi = __hip_atomic_fetch_add(wq, 1, __ATOMIC_RELAXED, __HIP_MEMORY_SCOPE_WORKGROUP);
        pi = p_lo + __builtin_amdgcn_readfirstlane(pi); if (pi >= p_hi) break;
        const int rowA = 2 * pi;
#pragma unroll 1
        for (int rep1_ = 0; rep1_ <= REP_PS1; ++rep1_) {
            unsigned kk[2][8][4];
            { int fr_ = fr; asm volatile("" : "+v"(fr_));
              const bf16_t* qrow = QP + (size_t)(rowA + (fr_ >> 3)) * 1024 + (fr_ & 7) * 128 + 8 * fq;
              bf16x8 af[2][2];
#pragma unroll
              for (int st = 0; st < 2; ++st)
#pragma unroll
                  for (int ks = 0; ks < 2; ++ks) af[st][ks] = *(const bf16x8*)(qrow + st * 64 + ks * 32);
#pragma unroll
              for (int st = 0; st < 2; ++st) { LAS bf16_t* kb = st ? kb2 : kb1;
#pragma unroll
                  for (int nb = 0; nb < 8; ++nb) { f32x4 c = {0.f, 0.f, 0.f, 0.f};
#pragma unroll
                      for (int ks = 0; ks < 2; ++ks) { const bf16x8 bfr = *(const LAS bf16x8*)(kb + (nb * 16 + fr) * KBP + ks * 32 + 8 * fq); c = __builtin_amdgcn_mfma_f32_16x16x32_bf16(af[st][ks], bfr, c, 0, 0, 0); }
#pragma unroll
                      for (int r = 0; r < 4; ++r) kk[st][nb][r] = f2key(c[r]); } } }
            unsigned T[2][4]; bool done[2][4];
#pragma unroll
            for (int st = 0; st < 2; ++st)
#pragma unroll
                for (int r = 0; r < 4; ++r) { T[st][r] = 0u; done[st][r] = false; }
#pragma unroll 1
            for (int bit = 31; bit >= 0; --bit) { const unsigned bm = 1u << bit; bool alld = true;
#pragma unroll
                for (int st = 0; st < 2; ++st)
#pragma unroll
                    for (int r = 0; r < 4; ++r) { const unsigned cand = T[st][r] | bm; int c = 0;
#pragma unroll
                        for (int nb = 0; nb < 8; ++nb) c += (kk[st][nb][r] >= cand) ? 1 : 0;
                        c = irow16_sum(c);
                        const bool upd = (c >= 16) && !done[st][r]; T[st][r] = upd ? cand : T[st][r]; done[st][r] = done[st][r] || (c == 16); alld = alld && done[st][r]; }
                if (__all(alld)) break; }
            const int tt = lane >> 5, hd0 = ((lane >> 4) & 1) * 4;
#pragma unroll
            for (int st = 0; st < 2; ++st)
#pragma unroll
                for (int r = 0; r < 4; ++r) { const unsigned Tr = T[st][r]; int g = 0, e = 0;
#pragma unroll
                    for (int nb = 0; nb < 8; ++nb) { g += (kk[st][nb][r] > Tr) ? 1 : 0; e += (kk[st][nb][r] == Tr) ? 1 : 0; }
                    int gpre = irow16_incl_scan(g) - g, epre = irow16_incl_scan(e) - e; const int ngt = irow16_sum(g); const int need = 16 - ngt;
                    LAS unsigned* tb = wbase + tt * PT_WORDS; LAS float* vl = (LAS float*)(tb + st * 128) + (hd0 + r) * 16; LAS int* il = (LAS int*)(tb + 256 + st * 128) + (hd0 + r) * 16;
#pragma unroll
                    for (int nb = 0; nb < 8; ++nb) { const unsigned k = kk[st][nb][r];
                        if (k > Tr) { vl[gpre] = key2f(k); il[gpre] = nb * 16 + fr; ++gpre; }
                        else if (k == Tr) { if (epre < need) { vl[ngt + epre] = key2f(k); il[ngt + epre] = nb * 16 + fr; } ++epre; } } }
        }
        asm volatile("s_waitcnt lgkmcnt(0)" ::: "memory");
        {
            const int tt = lane >> 5, hd0 = ((lane >> 4) & 1) * 4; LAS unsigned* tb = wbase + tt * PT_WORDS;
            unsigned ck[4][16];
#pragma unroll
            for (int r = 0; r < 4; ++r) { const float va = ((LAS float*)tb)[(hd0 + r) * 16 + fr]; const LAS float* v2p = (LAS float*)(tb + 128) + (hd0 + r) * 16;
#pragma unroll
                for (int j4 = 0; j4 < 4; ++j4) { const f32x4 vb = *(const LAS f32x4*)(v2p + j4 * 4);
#pragma unroll
                    for (int i = 0; i < 4; ++i) ck[r][j4 * 4 + i] = f2key(va + vb[i]); } }
            unsigned T[4]; bool done[4];
#pragma unroll
            for (int r = 0; r < 4; ++r) { T[r] = 0u; done[r] = false; }
#pragma unroll 1
            for (int bit = 31; bit >= 0; --bit) { const unsigned bm = 1u << bit; bool alld = true;
#pragma unroll
                for (int r = 0; r < 4; ++r) { const unsigned cand = T[r] | bm; int c = 0;
#pragma unroll
                    for (int j = 0; j < 16; ++j) c += (ck[r][j] >= cand) ? 1 : 0;
                    c = irow16_sum(c);
                    const bool upd = (c >= 16) && !done[r]; T[r] = upd ? cand : T[r]; done[r] = done[r] || (c == 16); alld = alld && done[r]; }
                if (__all(alld)) break; }
#pragma unroll
            for (int r = 0; r < 4; ++r) { const unsigned Tr = T[r]; int g = 0, e = 0;
#pragma unroll
                for (int j = 0; j < 16; ++j) { g += (ck[r][j] > Tr) ? 1 : 0; e += (ck[r][j] == Tr) ? 1 : 0; }
                int gpre = irow16_incl_scan(g) - g, epre = irow16_incl_scan(e) - e; const int ngt = irow16_sum(g); const int need = 16 - ngt;
                const int e1 = ((LAS int*)(tb + 256))[(hd0 + r) * 16 + fr] * 128; const LAS int* i2p = (LAS int*)(tb + 384) + (hd0 + r) * 16;
                LAS float* cs_ = (LAS float*)(tb + 512) + (hd0 + r) * 16; LAS int* ce_ = (LAS int*)(tb + 640) + (hd0 + r) * 16;
#pragma unroll
                for (int j = 0; j < 16; ++j) { const unsigned k = ck[r][j];
                    if (k > Tr) { cs_[gpre] = key2f(k); ce_[gpre] = e1 + i2p[j]; ++gpre; }
                    else if (k == Tr) { if (epre < need) { cs_[ngt + epre] = key2f(k); ce_[ngt + epre] = e1 + i2p[j]; } ++epre; } } }
        }
        asm volatile("s_waitcnt lgkmcnt(0)" ::: "memory");
#pragma unroll 1
      for (int t = 0; t < 2; ++t) {
        const int row = rowA + t; const int v = row < NLAT ? (row >> 12) : 4;
        LAS unsigned* tb = wbase + t * PT_WORDS;
        LAS float* v1l = (LAS float*)tb; LAS float* v2l = v1l + 128; LAS int* i1l = (LAS int*)(v2l + 128); LAS int* i2l = i1l + 128;
        LAS float* csl = (LAS float*)(i2l + 128); LAS int* cel = (LAS int*)(csl + 128); LAS int* el = cel + 128; LAS float* gl = (LAS float*)(el + 160); LAS float* su = gl + 128; LAS float* sv = su + 128;
        {
#pragma unroll
            for (int it = 0; it < 2; ++it) { const int idx = it * 64 + lane;
                const float sx = csl[idx]; const float mx = row16_max(sx); const float pe_ = __expf(sx - mx); const float sm = row16_sum(pe_);
                el[idx] = cel[idx]; gl[idx] = pe_ / sm; }
        }
        if (lane < 32) el[128 + lane] = el[0];
        asm volatile("s_waitcnt vmcnt(0) lgkmcnt(0)" ::: "memory");
        float hh[32]; ld16_bf16(HB + (size_t)row * D, lane, hh);
        f32x2 hh2[16];
#pragma unroll
        for (int i = 0; i < 16; ++i) hh2[i] = (f32x2){hh[2 * i], hh[2 * i + 1]};
        const bool b0_ = lane & 1, b1_ = lane & 2, b2_ = lane & 4;
        u32x4 A[8], B[8], C[8]; unsigned SA[8], SB[8], SC[8];
#define PEER_LOADT(buf, sbuf, tab, g) do { _Pragma("unroll") for (int x = 0; x < 8; ++x) { const int e = __builtin_amdgcn_readfirstlane(el[(g) * 8 + x]); const unsigned char* rp = (tab) + (size_t)e * TBS; \
            buf[x] = *(const u32x4*)(rp + 16 * lane); sbuf[x] = *(const bf16_t*)(rp + 1024 + 2 * lane); } } while (0)
#define PEER_LOADV(buf, g) do { _Pragma("unroll") for (int x = 0; x < 8; ++x) { const int e = __builtin_amdgcn_readfirstlane(el[(g) * 8 + x]); buf[x] = *(const u32x4*)(PV + (size_t)e * 1024 + 16 * lane); } } while (0)
#define FP4X8(w_, f0_, f1_, f2_, f3_) const f32x2 f0_ = __builtin_amdgcn_cvt_scalef32_pk_f32_fp4(w_, 1.0f, 0), f1_ = __builtin_amdgcn_cvt_scalef32_pk_f32_fp4(w_, 1.0f, 1), f2_ = __builtin_amdgcn_cvt_scalef32_pk_f32_fp4(w_, 1.0f, 2), f3_ = __builtin_amdgcn_cvt_scalef32_pk_f32_fp4(w_, 1.0f, 3)
#define PEER_DOT(buf, sbuf, g) do { float p_[8]; \
            _Pragma("unroll") for (int x = 0; x < 8; ++x) { f32x2 s2_ = {0.f, 0.f}; \
                _Pragma("unroll") for (int d = 0; d < 4; ++d) { const unsigned w_ = buf[x][d]; FP4X8(w_, f0_, f1_, f2_, f3_); const int o_ = (d >> 1) * 8 + (d & 1) * 4; \
                    s2_ = hh2[o_ + 0] * f0_ + s2_; s2_ = hh2[o_ + 1] * f1_ + s2_; s2_ = hh2[o_ + 2] * f2_ + s2_; s2_ = hh2[o_ + 3] * f3_ + s2_; } \
                p_[x] = (s2_.x + s2_.y) * __uint_as_float(sbuf[x] << 16); SBAR(); } \
              \
            float q_[4], r_[2]; \
            _Pragma("unroll") for (int j = 0; j < 4; ++j) { const float keep_ = b0_ ? p_[2 * j + 1] : p_[2 * j], send_ = b0_ ? p_[2 * j] : p_[2 * j + 1]; q_[j] = keep_ + dppf<0xB1>(send_); } \
            _Pragma("unroll") for (int j = 0; j < 2; ++j) { const float keep_ = b1_ ? q_[2 * j + 1] : q_[2 * j], send_ = b1_ ? q_[2 * j] : q_[2 * j + 1]; r_[j] = keep_ + dppf<0x4E>(send_); } \
            float t_; { const float keep_ = b2_ ? r_[1] : r_[0], send_ = b2_ ? r_[0] : r_[1]; const float up_ = dppf<0x104>(send_), dn_ = dppf<0x114>(send_); t_ = keep_ + (b2_ ? dn_ : up_); } \
            t_ += dppf<0x128>(t_); \
            { auto r16_ = __builtin_amdgcn_permlane16_swap(__float_as_uint(t_), __float_as_uint(t_), false, false); t_ = __uint_as_float(r16_[0]) + __uint_as_float(r16_[1]); } \
            { auto r32_ = __builtin_amdgcn_permlane32_swap(__float_as_uint(t_), __float_as_uint(t_), false, false); t_ = __uint_as_float(r32_[0]) + __uint_as_float(r32_[1]); } \
            const float av = gelu_erf(t_) * gl[(g) * 8 + (lane & 7)]; const bool me_ = (lane >> 3) == ((g) & 7); \
            avl = (me_ && (g) < 8) ? av : avl; avh = (me_ && (g) >= 8) ? av : avh; } while (0)
#define PIN_ACC() do { asm volatile("" : "+v"(acc2[0]), "+v"(acc2[1]), "+v"(acc2[2]), "+v"(acc2[3]), "+v"(acc2[4]), "+v"(acc2[5]), "+v"(acc2[6]), "+v"(acc2[7]), "+v"(acc2[8]), "+v"(acc2[9]), "+v"(acc2[10]), "+v"(acc2[11]), "+v"(acc2[12]), "+v"(acc2[13]), "+v"(acc2[14]), "+v"(acc2[15])); } while (0)
#define PEER_AXPY(buf, sbuf, g) do { _Pragma("unroll") for (int x = 0; x < 8; ++x) { const int idx = (g) * 8 + x; \
            const float av = __uint_as_float(__builtin_amdgcn_readlane(__float_as_uint(idx < 64 ? avl : avh), idx & 63)) * __uint_as_float(sbuf[x] << 16); const f32x2 av2_ = {av, av}; \
            _Pragma("unroll") for (int d = 0; d < 4; ++d) { const unsigned w_ = buf[x][d]; FP4X8(w_, f0_, f1_, f2_, f3_); const int o_ = (d >> 1) * 8 + (d & 1) * 4; \
                acc2[o_ + 0] = av2_ * f0_ + acc2[o_ + 0]; acc2[o_ + 1] = av2_ * f1_ + acc2[o_ + 1]; acc2[o_ + 2] = av2_ * f2_ + acc2[o_ + 2]; acc2[o_ + 3] = av2_ * f3_ + acc2[o_ + 3]; } PIN_ACC(); } } while (0)
        float avl = 0.f, avh = 0.f;
        PEER_LOADT(A, SA, PU, 0); PEER_LOADT(B, SB, PU, 1);
#pragma unroll 1
        for (int g = 0; g < 15; g += 3) { PEER_LOADT(C, SC, PU, g + 2); SBAR(); PEER_DOT(A, SA, g); SBAR(); PEER_LOADT(A, SA, PU, g + 3); SBAR(); PEER_DOT(B, SB, g + 1); SBAR(); PEER_LOADT(B, SB, PU, g + 4); SBAR(); PEER_DOT(C, SC, g + 2); SBAR(); }
        PEER_DOT(A, SA, 15); SBAR();
        f32x2 acc2[16];
#pragma unroll
        for (int i = 0; i < 16; ++i) acc2[i] = (f32x2){0.f, 0.f};
        float* xp = xres_row(F, row);
        PEER_LOADT(A, SA, PV, 0); PEER_LOADT(B, SB, PV, 1);
#pragma unroll 1
        for (int g = 0; g < 15; g += 3) { PEER_LOADT(C, SC, PV, g + 2); SBAR(); PEER_AXPY(A, SA, g); SBAR(); PEER_LOADT(A, SA, PV, g + 3); SBAR(); PEER_AXPY(B, SB, g + 1); SBAR(); PEER_LOADT(B, SB, PV, g + 4); SBAR(); PEER_AXPY(C, SC, g + 2); SBAR(); }
        float x1[32], g2[32]; ld16_f32(xp, lane, x1); ld16_f32(modl + (size_t)v * 12288 + 10240, lane, g2); SBAR();
        PEER_AXPY(A, SA, 15); SBAR();
#undef PEER_LOADT
#undef PEER_LOADV
#undef PEER_DOT
#undef PEER_AXPY
        float acc[32];
        {
#pragma unroll
          for (int i = 0; i < 32; ++i) acc[i] = ALPHA * x1[i] + g2[i] * acc2[i >> 1][i & 1]; }
        { float sm = 0.f;
#pragma unroll
          for (int i = 0; i < 32; ++i) sm += acc[i];
          const float mu = wave_sum(sm) * (1.f / 2048.f); float qq = 0.f;
#pragma unroll
          for (int i = 0; i < 32; ++i) { const float dd = acc[i] - mu; qq += dd * dd; }
          const float rstd = rsqrtf(wave_sum(qq) * (1.f / 2048.f) + LN_EPS);
#pragma unroll
          for (int q = 0; q < 2; ++q)
#pragma unroll
              for (int d = 0; d < 4; ++d) { const int o = 1024 * q + 16 * lane + 4 * d; const f32x4 gg = *(const f32x4*)(g2n + o), bb = *(const f32x4*)(b2n + o);
#pragma unroll
                  for (int i = 0; i < 4; ++i) acc[q * 16 + d * 4 + i] = (acc[q * 16 + d * 4 + i] - mu) * rstd * gg[i] + bb[i]; } }
        st16_f32(xp, lane, acc);
        if (!last) { const float* sh = modn + (size_t)v * 12288; const float* sc = sh + 2048;
#pragma unroll
            for (int q = 0; q < 2; ++q)
#pragma unroll
                for (int d = 0; d < 4; ++d) { const int o = 1024 * q + 16 * lane + 4 * d; const f32x4 hh4 = *(const f32x4*)(sh + o), cc4 = *(const f32x4*)(sc + o);
#pragma unroll
                    for (int i = 0; i < 4; ++i) acc[q * 16 + d * 4 + i] = clamp8(acc[q * 16 + d * 4 + i] * (1.f + cc4[i]) + hh4[i]); }
#pragma unroll
            for (int q = 0; q < 2; ++q) { u32x4 w;
#pragma unroll
                for (int d = 0; d < 4; ++d) w[d] = pk4_fp8(acc[q * 16 + d * 4 + 0], acc[q * 16 + d * 4 + 1], acc[q * 16 + d * 4 + 2], acc[q * 16 + d * 4 + 3]);
                *(u32x4*)(HB8w + (size_t)row * D + 1024 * q + 16 * lane) = w; } }
      }
    }
}
#ifdef DBG
constexpr size_t WS_DBG = WS_CTL + 131072;
constexpr int DBG_NS = 60;
__device__ __forceinline__ int dbg_row(int s) { return (s * 263 + 5) % NLAT; }
__global__ void __launch_bounds__(256) dbg_peer_pre(Args args, int l) {
    __shared__ float q[1024]; __shared__ float s1[128], s2[128]; __shared__ float v1[16], v2[16]; __shared__ int i1[16], i2[16]; __shared__ float cs[256]; __shared__ int ce[256];
    __shared__ float ts[16]; __shared__ int te[16]; __shared__ float red[256]; __shared__ float aval[128]; __shared__ int eid[128]; __shared__ float h2[2048];
    const int s = blockIdx.x, row = dbg_row(s), tid = threadIdx.x; unsigned char* ws = args.ws;
    const bf16_t* QP = (const bf16_t*)(ws + WS_QP); const bf16_t* HB = (const bf16_t*)(ws + WS_HB);
    float* dbgf = (float*)(ws + WS_DBG + 4096); int* dbge = (int*)(dbgf + DBG_NS * 2048); float* dbga = (float*)(dbge + DBG_NS * 128); float* dbgg = dbga + 3 * DBG_NS * 128;
    for (int i = tid; i < 1024; i += 256) q[i] = bf2f(QP[(size_t)row * 1024 + i]);
    for (int i = tid; i < 2048; i += 256) h2[i] = bf2f(HB[(size_t)row * D + i]);
    __syncthreads();
    const float* k1 = args.in[21] + (size_t)l * 8192; const float* k2 = args.in[22] + (size_t)l * 8192;
    for (int hd = 0; hd < 8; ++hd) {
        { const int k = tid & 127; const float* kk = (tid < 128 ? k1 : k2) + k * 64; const float* qq = q + hd * 128 + (tid < 128 ? 0 : 64); float a = 0.f; for (int d = 0; d < 64; ++d) a += qq[d] * kk[d]; (tid < 128 ? s1 : s2)[k] = a; }
        __syncthreads();
        { const int k = tid & 127; const float* sv = tid < 128 ? s1 : s2; const float me = sv[k]; int rank = 0; for (int j = 0; j < 128; ++j) rank += (sv[j] > me || (sv[j] == me && j < k)) ? 1 : 0;
          if (rank < 16) { (tid < 128 ? v1 : v2)[rank] = me; (tid < 128 ? i1 : i2)[rank] = k; } }
        __syncthreads();
        { const int i = tid >> 4, j = tid & 15; cs[tid] = v1[i] + v2[j]; ce[tid] = i1[i] * 128 + i2[j]; }
        __syncthreads();
        { const float me = cs[tid]; int rank = 0; for (int j = 0; j < 256; ++j) rank += (cs[j] > me || (cs[j] == me && j < tid)) ? 1 : 0; if (rank < 16) { ts[rank] = me; te[rank] = ce[tid]; } }
        __syncthreads();
        if (tid < 16) { float mx = ts[0]; float sm = 0.f; for (int j = 0; j < 16; ++j) sm += expf(ts[j] - mx); aval[hd * 16 + tid] = expf(ts[tid] - mx) / sm; eid[hd * 16 + tid] = te[tid]; dbgg[s * 128 + hd * 16 + tid] = aval[hd * 16 + tid]; }
        __syncthreads();
    }
    const float* U = args.in[23] + (size_t)l * 16384 * 2048; const float* V = args.in[24] + (size_t)l * 16384 * 2048;
    for (int e = 0; e < 128; ++e) { const float* ur = U + (size_t)eid[e] * 2048; float p = 0.f; for (int d = tid; d < 2048; d += 256) p += h2[d] * ur[d]; red[tid] = p; __syncthreads();
        for (int st = 128; st > 0; st >>= 1) { if (tid < st) red[tid] += red[tid + st]; __syncthreads(); }
        if (tid == 0) { const float sc = red[0]; aval[e] = 0.5f * sc * (1.f + erff(sc * 0.70710678f)) * aval[e]; } __syncthreads(); }
    float y[8]; const float* xr = args.out + (size_t)row * D; const int v = row >> 12; const float* mod = (const float*)(ws + WS_MOD) + (size_t)l * 5 * 12288 + (size_t)v * 12288;
    float sum = 0.f;
    for (int k = 0; k < 8; ++k) { const int d = tid + 256 * k; float o = 0.f; for (int e = 0; e < 128; ++e) o += aval[e] * V[(size_t)eid[e] * 2048 + d]; y[k] = ALPHA * xr[d] + mod[10240 + d] * o; sum += y[k]; }
    red[tid] = sum; __syncthreads(); for (int st = 128; st > 0; st >>= 1) { if (tid < st) red[tid] += red[tid + st]; __syncthreads(); } const float mu = red[0] / 2048.f; __syncthreads();
    float sq = 0.f; for (int k = 0; k < 8; ++k) sq += (y[k] - mu) * (y[k] - mu);
    red[tid] = sq; __syncthreads(); for (int st = 128; st > 0; st >>= 1) { if (tid < st) red[tid] += red[tid + st]; __syncthreads(); } const float rstd = rsqrtf(red[0] / 2048.f + LN_EPS);
    for (int k = 0; k < 8; ++k) { const int d = tid + 256 * k; dbgf[(size_t)s * 2048 + d] = (y[k] - mu) * rstd * args.in[25][l * D + d] + args.in[26][l * D + d]; }
    if (tid < 128) { dbge[s * 128 + tid] = eid[tid]; dbga[s * 128 + tid] = aval[tid]; }
}
__global__ void __launch_bounds__(256) dbg_peer_post(Args args) {
    __shared__ int bad_e, bad_x, bad_a, bad_g;
    const int s = blockIdx.x, row = dbg_row(s), tid = threadIdx.x; unsigned char* ws = args.ws; unsigned* cnt = (unsigned*)(ws + WS_DBG);
    float* dbgf = (float*)(ws + WS_DBG + 4096); int* dbge = (int*)(dbgf + DBG_NS * 2048); float* dbga = (float*)(dbge + DBG_NS * 128);
    int* fe = (int*)(dbga + DBG_NS * 128); float* fa = (float*)(fe + DBG_NS * 128); float* dbgg = dbga + 3 * DBG_NS * 128; float* fg = dbgg + DBG_NS * 128;
    if (tid == 0) { bad_e = 0; bad_x = 0; bad_a = 0; bad_g = 0; } __syncthreads();
    if (tid < 128) { const int hd = tid >> 4; const int e = dbge[s * 128 + tid]; bool found = false; float af = 0.f, gf = 0.f; for (int j = 0; j < 16; ++j) if (fe[s * 128 + hd * 16 + j] == e) { found = true; af = fa[s * 128 + hd * 16 + j]; gf = fg[s * 128 + hd * 16 + j]; }
        if (!found) atomicAdd(&bad_e, 1); else { const float ea = dbga[s * 128 + tid]; if (fabsf(af - ea) > 0.02f * fabsf(ea) + 2e-3f) atomicAdd(&bad_a, 1); const float eg = dbgg[s * 128 + tid]; if (fabsf(gf - eg) > 0.02f * fabsf(eg) + 1e-3f) atomicAdd(&bad_g, 1); } }
    for (int k = 0; k < 8; ++k) { const int d = tid + 256 * k; const float ex = dbgf[(size_t)s * 2048 + d], got = args.out[(size_t)row * D + d]; if (!(fabsf(got - ex) <= 0.03f + 0.03f * fabsf(ex))) atomicAdd(&bad_x, 1); }
    __syncthreads();
    if (tid == 0) { if (bad_e > 2) atomicAdd(&cnt[1], 1u); if (bad_g > 2) atomicAdd(&cnt[2], 1u); if (bad_a > 2) atomicAdd(&cnt[3], 1u); if (bad_x > 8) atomicAdd(&cnt[4], 1u); }
}
__global__ void dbg_report(Args args) {
    unsigned* cnt = (unsigned*)(args.ws + WS_DBG);
    float code = 0.f;
    for (int lv = 1; lv <= 9; ++lv) if (cnt[lv]) { int tenths = (int)(cnt[lv] * 10 / DBG_NS); if (tenths > 9) tenths = 9; code = 1000.f * lv + 100.f * tenths; break; }
    if (code != 0.f) for (int i = threadIdx.x; i < 4096; i += blockDim.x) args.out[i] = code;
}
#endif
__device__ __forceinline__ void p_attn_gqa(const Frame& F, int last) {
    char* lds = (char*)F.lds;
    const unsigned char* QG = wsp<unsigned char>(F, WS_QG); const unsigned char* KG = wsp<unsigned char>(F, WS_KG); const bf16_t* VG = wsp<bf16_t>(F, WS_VG); unsigned char* OAB = wsp<unsigned char>(F, WS_OAB);
    const int nlat = NB * 8 * 16, nall = last ? nlat : nlat + NB * 8;
    for (int u = F.bid; u < nall; u += F.G) {
        int bh, q0, seq; size_t orow;
        if (u < nlat) {
            int uu = u;
            if (F.G == 256) {
                const int c = u & 255, i = u >> 8, xcd = c & 7, r = c >> 3, kvg = i * 4 + (xcd >> 1), within = (xcd & 1) * 32 + r;
                uu = (((kvg >> 1) * 8 + (kvg & 1) * 4 + (within >> 4)) << 4) | (within & 15); }
            bh = uu >> 4; const int qb = uu & 15; q0 = CTXL + qb * 256; seq = TT; orow = (size_t)(bh >> 3) * SEQ + qb * 256; }
        else { bh = u - nlat; q0 = 0; seq = CTXL; orow = (size_t)NLAT + (bh >> 3) * CTXL; }
        const int b = bh >> 3, h = bh & 7; const size_t kvo = (size_t)(b * 2 + (h >> 2)) * TT * 128;
        __syncthreads();
        att::attn_body<8, 4, 0, 1>(QG + ((size_t)bh * TT + q0) * 128, KG + kvo, VG + kvo, OAB + orow * D + 1024 + h * 128, seq, lds, F.tid);
    }
    __syncthreads();
}
__device__ __forceinline__ void p_attn_mla(const Frame& F, int last) {
    char* lds = (char*)F.lds;
    const unsigned char* QM = wsp<unsigned char>(F, WS_QM); const unsigned char* KM = wsp<unsigned char>(F, WS_KM); const bf16_t* VM = wsp<bf16_t>(F, WS_VM); unsigned char* OAB = wsp<unsigned char>(F, WS_OAB);
    const int nlat = NB * 8 * 16, nall = last ? nlat : nlat + NB * 8;
    for (int u = F.bid; u < nall; u += F.G) {
        int bh, q0, seq; size_t orow;
        if (u < nlat) {
            int uu = u;
            if (F.G == 256) { const int c = u & 255, i = u >> 8, xcd = c & 7, r = c >> 3; uu = ((i * 16 + xcd * 2 + (r >> 4)) << 4) | (r & 15); }
            bh = uu >> 4; const int qb = uu & 15; q0 = CTXL + qb * 256; seq = TT; orow = (size_t)(bh >> 3) * SEQ + qb * 256; }
        else { bh = u - nlat; q0 = 0; seq = CTXL; orow = (size_t)NLAT + (bh >> 3) * CTXL; }
        const int h = bh & 7;
        __syncthreads();
        att::attn_body<6, 2, 1, 2>(QM + ((size_t)bh * TT + q0) * 128, KM + (size_t)bh * TT * 128, VM + (size_t)bh * TT * 64, OAB + orow * D + h * 64, seq, lds, F.tid);
    }
    __syncthreads();
}
__device__ __forceinline__ void p_ret_out(const Frame& F, int l, int last) {
    const int c_lo = last ? 2 : 0, nc = 34 - c_lo, nu = NB * 8 * nc;
    for (int u = F.bid; u < nu; u += F.G) { const int bh = u / nc, c = c_lo + (u % nc); ret_out_unit(F, l, bh, c); }
    __syncthreads();
}

constexpr int LDS_BYTES = 147456;
constexpr int MISC_OFF = 147456 - 64;
constexpr int NPHASE = 22;
#ifndef PHM
#define PHM 0xFFFF
#endif
#ifndef PH_ATTR
#define PH_ATTR __forceinline__
#endif
__device__ PH_ATTR void ph_prologue(ArgP ap) { const Frame F = make_frame(ap); p0_prologue(F); }
__device__ PH_ATTR void ph_modreduce(ArgP ap) { const Frame F = make_frame(ap); p1_modreduce(F); }
__device__ PH_ATTR void ph_modulate0(ArgP ap) { const Frame F = make_frame(ap); p_modulate0(F); }
__device__ PH_ATTR void ph_gemm_in(ArgP ap, int l) { const Frame F = make_frame(ap);
    pg8::Gemm g{wsp<bf16_t>(F, WS_HB8), wsp<bf16_t>(F, WS_WIN + l * SZ_WIN), NROW, NPT, 1024, 1024, 1024}; pg8::StaticOrder S; S.init(NROW, NPT, F.G, F.bid);
    float mul_, inv_; fp8_scale(wsp<unsigned>(F, WS_WSC)[l], mul_, inv_);
    EpiIn E{wsp<bf16_t>(F, WS_P1), wsp<bf16_t>(F, WS_G), inv_};
    pg8::gemm_phase<EpiIn, pg8::StaticOrder>(F.lds, F.tid, g, S, E); }
__device__ PH_ATTR void ph_post(ArgP ap, int l) { const Frame F = make_frame(ap); p_post(F, l); if (l == 1) cvt_peer(F, 1); }
__device__ PH_ATTR void ph_qup(ArgP ap, int l) { const Frame F = make_frame(ap);
    pg8::Gemm g{wsp<bf16_t>(F, WS_CQN), wsp<bf16_t>(F, WS_WQUP + l * SZ_WQUP), NROW, 768, 512, 512, 512}; pg8::StaticOrder S; S.init(NROW, 768, F.G, F.bid);
    EpiQup E{wsp<unsigned char>(F, WS_QM), wsp<f32x2>(F, WS_ROPE32)};
    pg8::gemm_phase<EpiQup, pg8::StaticOrder>(F.lds, F.tid, g, S, E); }
__device__ PH_ATTR void ph_kvup(ArgP ap, int l) { const Frame F = make_frame(ap);
    pg8::Gemm g{wsp<bf16_t>(F, WS_CKVN), wsp<bf16_t>(F, WS_WKVUP + l * SZ_WKVUP), NROW, 1024, 256, 256, 256}; pg8::StaticOrder S; S.init(NROW, 1024, F.G, F.bid);
    EpiKvup E{wsp<unsigned char>(F, WS_KM), wsp<bf16_t>(F, WS_VM)};
    pg8::gemm_phase<EpiKvup, pg8::StaticOrder>(F.lds, F.tid, g, S, E); }
__device__ PH_ATTR void ph_states(ArgP ap, int l) { const Frame F = make_frame(ap); p_ret_states(F, l); }
__device__ PH_ATTR void ph_attn_gqa(ArgP ap, int last) { const Frame F = make_frame(ap); p_attn_gqa(F, last); }
__device__ PH_ATTR void ph_attn_mla(ArgP ap, int last) { const Frame F = make_frame(ap); p_attn_mla(F, last); }
__device__ PH_ATTR void ph_ret_out(ArgP ap, int l, int last) { const Frame F = make_frame(ap); p_ret_out(F, l, last); }
template <int SEG> __device__ PH_ATTR void ph_merge(ArgP ap, int l, int Mx) { const Frame F = make_frame(ap);
    const bf16_t* OAB = wsp<bf16_t>(F, WS_OAB); bf16_t* MB = wsp<bf16_t>(F, WS_MB); const bf16_t* G = wsp<bf16_t>(F, WS_G);
    pg8::StaticOrder S; S.init(Mx, 2048, F.G, F.bid);
    const size_t wo = SEG == 0 ? WS_WBRA + l * SZ_WBRA : (SEG == 1 ? WS_WBRB + l * SZ_WBRB : WS_WBRC + l * SZ_WBRC); const int K = SEG == 2 ? 1024 : 512;
    pg8::Gemm g{OAB + SEG * 512, wsp<bf16_t>(F, wo), Mx, 2048, K, 2048, K}; EpiMerge<SEG> E{MB, G, wsp<unsigned char>(F, WS_MB8)}; pg8::gemm_phase<EpiMerge<SEG>, pg8::StaticOrder>(F.lds, F.tid, g, S, E); }
__device__ PH_ATTR void ph_merge3(ArgP ap, int l, int Mx) { const Frame F = make_frame(ap);
    pg8::StaticOrder S; S.init(Mx, 2048, F.G, F.bid);
    float m0_, i0_, m1_, i1_, m2_, i2_; fp8_scale(wsp<unsigned>(F, WS_WSC)[4 + l], m0_, i0_); fp8_scale(wsp<unsigned>(F, WS_WSC)[6 + l], m1_, i1_); fp8_scale(wsp<unsigned>(F, WS_WSC)[8 + l], m2_, i2_);
    pg8::Merge3 g{wsp<bf16_t>(F, WS_OAB), wsp<bf16_t>(F, WS_WBRA + l * SZ_WBRA), wsp<bf16_t>(F, WS_WBRB + l * SZ_WBRB), wsp<bf16_t>(F, WS_WBRC + l * SZ_WBRC), wsp<bf16_t>(F, WS_G), wsp<unsigned char>(F, WS_MB8), i0_ * m1_, i1_ * m2_, i2_};
    pg8::gemm_merge3<pg8::StaticOrder>(F.lds, F.tid, g, S); }
__device__ PH_ATTR void ph_out(ArgP ap, int l, int Mx) { const Frame F = make_frame(ap);
    pg8::Gemm g{wsp<bf16_t>(F, WS_MB8), wsp<bf16_t>(F, WS_WOUT + l * SZ_WOUT), Mx, 2048, 1024, 1024, 1024}; pg8::StaticOrder S; S.init(Mx, 2048, F.G, F.bid);
    float mul_, inv_; fp8_scale(wsp<unsigned>(F, WS_WSC)[2 + l], mul_, inv_);
    EpiOut E{l == 0 ? F.in(0) : F.out, l == 0 ? F.in(2) : wsp<float>(F, WS_XC), F.out, wsp<float>(F, WS_XC), wsp<float>(F, WS_MOD) + (size_t)l * 5 * 12288 + 4096, inv_ * (1.f / 16.f)};
    pg8::gemm_phase<EpiOut, pg8::StaticOrder>(F.lds, F.tid, g, S, E); }
__device__ PH_ATTR void ph_ln1(ArgP ap, int l, int last) { const Frame F = make_frame(ap); p_ln1(F, l, last); }
__device__ PH_ATTR void ph_peerq(ArgP ap, int l, int Mx) { const Frame F = make_frame(ap);
    pg8::Gemm g{wsp<bf16_t>(F, WS_HB), wsp<bf16_t>(F, WS_WPQ + l * SZ_WPQ), Mx, 1024, 2048, 2048, 2048}; pg8::StaticOrder S; S.init(Mx, 1024, F.G, F.bid);
    EpiPlain E{wsp<bf16_t>(F, WS_QP), 1024};
    pg8::gemm_phase<EpiPlain, pg8::StaticOrder>(F.lds, F.tid, g, S, E); }
__device__ PH_ATTR void ph_peer(ArgP ap, int l, int last) { const Frame F = make_frame(ap); p_peer(F, l, last); }

__global__ void __launch_bounds__(512, 2) mega_fwd(Args args) {
    extern __shared__ __attribute__((aligned(16))) unsigned char lds_raw[];
    const ArgP ap = (ArgP)__builtin_amdgcn_kernarg_segment_ptr();
    const int lo = ap->ph_lo, hi = ap->ph_hi;
    volatile LAS unsigned* misc = (volatile LAS unsigned*)((LAS unsigned char*)lds_raw + MISC_OFF);
    if (threadIdx.x < 4) misc[threadIdx.x] = 0u;
    __syncthreads();
    XcdBarrier bar; bar.bar = (unsigned*)(ap->ws + WS_CTL); bar.x = 0; bar.st = misc;
    if (hi - lo > 1) bar = xcd_barrier_post((unsigned*)(ap->ws + WS_CTL), misc);
#define IN(k) (lo <= (k) && (k) < hi)
#define SEAM(k) do { if (IN(k) && IN((k) + 1)) xcd_barrier(bar); } while (0)
    if (IN(0)) { if (PHM & 1) ph_prologue(ap); if (REP_PRO) ph_prologue(ap); } SEAM(0);
    if (IN(1)) { if (PHM & 2) ph_modreduce(ap); if (REP_X & 32) ph_modreduce(ap); } SEAM(1);
#pragma unroll 1
    for (int l = 0; l < 2; ++l) {
        const int pb = 2 + 10 * l; const int last = (l == 1);
        const int Mx = last ? NLAT : NROW;
        if (l == 0) { if (IN(pb)) { if (PHM & 4) ph_modulate0(ap); if (REP_X & 64) ph_modulate0(ap); } SEAM(pb); }
        if (IN(pb + 1)) { if (PHM & 8) ph_gemm_in(ap, l); if (REP_GIN) ph_gemm_in(ap, l); } SEAM(pb + 1);
        if (IN(pb + 2)) { if (PHM & 16) ph_post(ap, l); if (REP_X & 1) ph_post(ap, l); } SEAM(pb + 2);
        if (IN(pb + 3)) { if (PHM & 32) ph_qup(ap, l); if (PHM & 64) ph_kvup(ap, l); if (PHM & 128) ph_states(ap, l); if (REP_X & 2) { ph_qup(ap, l); ph_kvup(ap, l); ph_states(ap, l); } } SEAM(pb + 3);
        if (IN(pb + 4)) { if (PHM & 256) ph_attn_gqa(ap, last); if (PHM & 512) ph_attn_mla(ap, last); if (REP_ATTN) { ph_attn_gqa(ap, last); ph_attn_mla(ap, last); } if (REP_X & 4) ph_ret_out(ap, l, last); if (PHM & 1024) ph_ret_out(ap, l, last); } SEAM(pb + 4);
        if (IN(pb + 5)) { if (PHM & 2048) { if (MERGE3) ph_merge3(ap, l, Mx); else { ph_merge<0>(ap, l, Mx); ph_merge<1>(ap, l, Mx); ph_merge<2>(ap, l, Mx); } } if (REP_X & 8) { if (MERGE3) ph_merge3(ap, l, Mx); else { ph_merge<0>(ap, l, Mx); ph_merge<1>(ap, l, Mx); ph_merge<2>(ap, l, Mx); } } } SEAM(pb + 5);
        if (IN(pb + 6)) { if (PHM & 4096) ph_out(ap, l, Mx); } SEAM(pb + 6);
        if (IN(pb + 7)) { if (PHM & 8192) ph_ln1(ap, l, last); } SEAM(pb + 7);
        if (IN(pb + 8)) { if (PHM & 16384) ph_peerq(ap, l, Mx); if (REP_X & 16) ph_peerq(ap, l, Mx); } SEAM(pb + 8);
        if (IN(pb + 9)) { if (PHM & 32768) ph_peer(ap, l, last); } SEAM(pb + 9);
    }
#undef IN
#undef SEAM
}

extern "C" void kernel_launch(void* const* d_in, const int* in_sizes, int n_in, void* d_out, int out_size, void* d_ws, size_t ws_size, hipStream_t stream) {
    static int grid = 0;
    if (grid == 0) {
        if (n_in != 27 || out_size != NLAT * D || ws_size < WS_END) { fprintf(stderr, "kernel_launch: unexpected shapes: n_in %d out %d ws %zu (need %zu)\n", n_in, out_size, ws_size, (size_t)WS_END); grid = -1; return; }
        int dev = 0, cus = 0, per_cu = 0;
        if (hipGetDevice(&dev) != hipSuccess || hipDeviceGetAttribute(&cus, hipDeviceAttributeMultiprocessorCount, dev) != hipSuccess) { grid = -1; return; }
        if (hipFuncSetAttribute((const void*)mega_fwd, hipFuncAttributeMaxDynamicSharedMemorySize, LDS_BYTES) != hipSuccess) { fprintf(stderr, "kernel_launch: hipFuncSetAttribute failed\n"); grid = -1; return; }
        if (hipOccupancyMaxActiveBlocksPerMultiprocessor(&per_cu, (const void*)mega_fwd, 512, LDS_BYTES) != hipSuccess || per_cu < 1) fprintf(stderr, "kernel_launch: occupancy query reports %d\n", per_cu);
        (void)hipGetLastError();
        grid = cus;
    }
    if (grid < 0) return;
    (void)hipMemsetAsync((char*)d_ws + WS_CTL, 0, 65536, stream);
#ifdef DBG
    (void)hipMemsetAsync((char*)d_ws + WS_CTL + 131072, 0, 4096, stream);
#endif
    Args a{};
    for (int i = 0; i < 27; ++i) a.in[i] = (const float*)d_in[i];
    a.out = (float*)d_out; a.ws = (unsigned char*)d_ws;
#if MK_PER_PHASE
    for (int p = 0; p < NPHASE; ++p) { if (p == 12) continue; a.ph_lo = p; a.ph_hi = p + 1;
#ifdef DBG
        if (p == 11) hipLaunchKernelGGL(dbg_peer_pre, dim3(DBG_NS), dim3(256), 0, stream, a, 0);
#endif
        hipLaunchKernelGGL(mega_fwd, dim3(grid), dim3(512), LDS_BYTES, stream, a);
#ifdef DBG
        if (p == 11) hipLaunchKernelGGL(dbg_peer_post, dim3(DBG_NS), dim3(256), 0, stream, a);
#endif
    }
#ifdef DBG
    hipLaunchKernelGGL(dbg_report, dim3(1), dim3(256), 0, stream, a);
#endif
#else
    a.ph_lo = 0; a.ph_hi = NPHASE;
    hipLaunchKernelGGL(mega_fwd, dim3(grid), dim3(512), LDS_BYTES, stream, a);
#endif
    const hipError_t le = hipPeekAtLastError();
    if (le != hipSuccess) fprintf(stderr, "kernel_launch: launch failed: %s\n", hipGetErrorName(le));
}
```

```cpp
#include <hip/hip_runtime.h>
#include <cstdio>
#include <cstdint>
#include <cstddef>

#ifndef MK_PER_PHASE
#define MK_PER_PHASE 0
#endif

#ifndef ABL_PEER
#define ABL_PEER 0
#endif
#ifndef REP_PEERG
#define REP_PEERG 0
#endif
#ifndef REP_PEERH
#define REP_PEERH 0
#endif
#ifndef REP_X
#define REP_X 0
#endif
#ifndef REP_PS1
#define REP_PS1 0
#endif
#ifndef REP_PS2
#define REP_PS2 0
#endif
#ifndef SIDE_ON
#define SIDE_ON 1
#endif
#ifndef REP_DOT
#define REP_DOT 0
#endif
#ifndef MERGE3
#define MERGE3 1
#endif
#ifndef REP_GIN
#define REP_GIN 0
#endif
#ifndef REP_ATTN
#define REP_ATTN 0
#endif
#ifndef REP_PRO
#define REP_PRO 0
#endif
#ifndef ABL_BR
#define ABL_BR 0
#endif
#ifndef ABL_MIX
#define ABL_MIX 0
#endif
#define LAS __attribute__((address_space(3)))
typedef unsigned short bf16_t;
typedef short bf16x8 __attribute__((ext_vector_type(8)));
typedef short s16x4 __attribute__((ext_vector_type(4)));
typedef float f32x2 __attribute__((ext_vector_type(2)));
typedef float f32x4 __attribute__((ext_vector_type(4)));
typedef float f32x8 __attribute__((ext_vector_type(8)));
typedef float f32x16 __attribute__((ext_vector_type(16)));
typedef unsigned u32x2 __attribute__((ext_vector_type(2)));
typedef unsigned u32x4 __attribute__((ext_vector_type(4)));
typedef __bf16 bf2_t __attribute__((ext_vector_type(2)));

constexpr int D = 2048, NB = 4, SEQ = 4096, CTXL = 256, TT = SEQ + CTXL;
constexpr int NLAT = NB * SEQ, NCTX = NB * CTXL, NROW = NLAT + NCTX;
constexpr int NP1 = 4096, NG = 6144, NPT = NP1 + NG;
constexpr int NIN = 10016;
constexpr float ALPHA = 1.4142135623730951f;
constexpr float LN_EPS = 1e-5f, RMS_EPS = 1e-6f;
constexpr float LOG2E = 1.4426950408889634f;
constexpr int C_CQ = 0, C_CKV = 512, C_GQ = 768, C_GK = 1792, C_GV = 2048, C_RQ = 2304, C_RK = 2560, C_RV = 2816, C_RG = 3328, C_KR = 3840;

constexpr size_t AL(size_t x) { return (x + 255) / 256 * 256; }
constexpr size_t WS_CTL = 0;                                    constexpr size_t CTL_BYTES = 1u << 20;
constexpr size_t WS_WSC = WS_CTL + 32768;
constexpr size_t WS_CVT = WS_CTL + 33024;
constexpr size_t WS_DEC = WS_CTL + 65536;
constexpr size_t WS_ROPE32 = WS_CTL + CTL_BYTES;
constexpr size_t WS_ROPE128 = WS_ROPE32 + AL(64 * 8 * 8);
constexpr size_t WS_MODP = WS_ROPE128 + AL(64 * 32 * 8);
constexpr size_t WS_MOD = WS_MODP + AL((size_t)16 * 2 * 5 * 12288 * 4);
constexpr size_t WS_WIN = WS_MOD + AL((size_t)2 * 5 * 12288 * 4);
constexpr size_t SZ_WIN = (size_t)NPT * D;
constexpr size_t WS_WQUP = WS_WIN + 2 * SZ_WIN;                 constexpr size_t SZ_WQUP = (size_t)768 * 512 * 2;
constexpr size_t WS_WKVUP = WS_WQUP + 2 * SZ_WQUP;              constexpr size_t SZ_WKVUP = (size_t)1024 * 256 * 2;
constexpr size_t WS_WBRA = WS_WKVUP + 2 * SZ_WKVUP;             constexpr size_t SZ_WBRA = (size_t)2048 * 512 * 2;
constexpr size_t WS_WBRB = WS_WBRA + 2 * SZ_WBRA;               constexpr size_t SZ_WBRB = SZ_WBRA;
constexpr size_t WS_WBRC = WS_WBRB + 2 * SZ_WBRB;               constexpr size_t SZ_WBRC = (size_t)2048 * 1024 * 2;
constexpr size_t WS_WOUT = WS_WBRC + 2 * SZ_WBRC;               constexpr size_t SZ_WOUT = (size_t)2048 * 2048 * 2;
constexpr size_t WS_WPQ = WS_WOUT + 2 * SZ_WOUT;                constexpr size_t SZ_WPQ = (size_t)1024 * 2048 * 2;
constexpr size_t WS_PSC = WS_WPQ + 2 * SZ_WPQ;
constexpr size_t WS_PU = WS_PSC + (size_t)4 * 16384 * 4;        constexpr size_t SZ_PT = (size_t)16384 * 1152;
constexpr size_t WS_PV = WS_PU + 2 * SZ_PT;
constexpr size_t WS_XC = WS_PV + 2 * SZ_PT;
constexpr size_t WS_HB = WS_XC + (size_t)NCTX * D * 4;
constexpr size_t WS_P1 = WS_HB + (size_t)NROW * D * 2;
constexpr size_t WS_G = WS_P1 + (size_t)NROW * NP1 * 2;
constexpr size_t WS_CQN = WS_G + (size_t)NROW * NG * 2;
constexpr size_t WS_CKVN = WS_CQN + (size_t)NROW * 512 * 2;
constexpr size_t WS_QM = WS_CKVN + (size_t)NROW * 256 * 2;
constexpr size_t SZ_Q128 = (size_t)NB * 8 * TT * 128 * 2;
constexpr size_t WS_KM = WS_QM + SZ_Q128;
constexpr size_t WS_VM = WS_KM + SZ_Q128;
constexpr size_t WS_QG = WS_VM + SZ_Q128 / 2;
constexpr size_t WS_KG = WS_QG + SZ_Q128;
constexpr size_t WS_VG = WS_KG + SZ_Q128 / 4;
constexpr size_t WS_RQ = WS_VG + SZ_Q128 / 4;
constexpr size_t WS_RK = WS_RQ + SZ_Q128 / 4;
constexpr size_t WS_RV = WS_RK + SZ_Q128 / 4;
constexpr size_t WS_ST = WS_RV + SZ_Q128 / 2;
constexpr size_t WS_OAB = WS_ST + (size_t)NB * 8 * 34 * 2 * 2048 * 4;
constexpr size_t WS_HB8 = WS_OAB + (size_t)NROW * D * 2;
constexpr size_t WS_MB8 = WS_HB8 + (size_t)NROW * D;
constexpr size_t WS_END = WS_MB8 + (size_t)NROW * D;
constexpr size_t WS_MB = WS_QM;
constexpr size_t WS_QP = WS_QG;
static_assert((size_t)NROW * D * 2 <= 2 * SZ_Q128, "MB alias");
static_assert((size_t)NROW * 1024 * 2 <= SZ_Q128, "QP alias");

__device__ __forceinline__ unsigned cvt_pk_bf16(float lo, float hi) { unsigned r; asm volatile("v_cvt_pk_bf16_f32 %0, %1, %2" : "=v"(r) : "v"(lo), "v"(hi)); return r; }
__device__ __forceinline__ bf16_t f2bf(float f) { return (bf16_t)(cvt_pk_bf16(f, 0.f) & 0xffffu); }
__device__ __forceinline__ float bf2f(bf16_t b) { return __uint_as_float(((unsigned)b) << 16); }
__device__ __forceinline__ float bflo(unsigned w) { return __uint_as_float(w << 16); }
__device__ __forceinline__ float bfhi(unsigned w) { return __uint_as_float(w & 0xffff0000u); }
template <int CTRL> __device__ __forceinline__ float dppf(float x) { return __int_as_float(__builtin_amdgcn_update_dpp(0, __float_as_int(x), CTRL, 0xF, 0xF, true)); }
__device__ __forceinline__ float row16_sum(float x) { x += dppf<0xB1>(x); x += dppf<0x4E>(x); x += dppf<0x141>(x); x += dppf<0x140>(x); return x; }
__device__ __forceinline__ float row16_max(float x) { x = fmaxf(x, dppf<0xB1>(x)); x = fmaxf(x, dppf<0x4E>(x)); x = fmaxf(x, dppf<0x141>(x)); x = fmaxf(x, dppf<0x140>(x)); return x; }
__device__ __forceinline__ float wave_sum(float x) {
    x = row16_sum(x);
    { auto r = __builtin_amdgcn_permlane16_swap(__float_as_uint(x), __float_as_uint(x), false, false); x = __uint_as_float(r[0]) + __uint_as_float(r[1]); }
    { auto r = __builtin_amdgcn_permlane32_swap(__float_as_uint(x), __float_as_uint(x), false, false); x = __uint_as_float(r[0]) + __uint_as_float(r[1]); }
    return x;
}
__device__ __forceinline__ unsigned pk4_fp8(float a, float b, float c, float d) { int t = 0; t = __builtin_amdgcn_cvt_pk_fp8_f32(a, b, t, false); t = __builtin_amdgcn_cvt_pk_fp8_f32(c, d, t, true); return (unsigned)t; }
__device__ __forceinline__ float clamp8(float x) { return fminf(fmaxf(x, -440.f), 440.f); }
__device__ __forceinline__ void fp8_scale(unsigned amax_bits, float& mul, float& inv) { const float am = __uint_as_float(amax_bits); int k = 0; if (am > 0.f) k = (int)floorf(log2f(256.f / am)); k = k > 60 ? 60 : (k < -60 ? -60 : k); mul = exp2f((float)k); inv = exp2f((float)-k); }
__device__ __forceinline__ float silu_f(float x) { return x / (1.f + __expf(-x)); }
__device__ __forceinline__ float sigmoid_f(float x) { return 1.f / (1.f + __expf(-x)); }

__device__ __forceinline__ int vt_off(int tpos) { const int kk = tpos & 63; return (tpos & ~63) + ((kk >> 2) & 1) * 32 + ((kk >> 5) & 1) * 16 + (kk & 3) + 4 * ((kk >> 3) & 3); }
struct RowInfo { int b, tpos, pr, pc, v; bool lat; };
__device__ __forceinline__ RowInfo rowinfo(int row) {
    RowInfo r;
    if (row < NLAT) { r.lat = true; r.b = row >> 12; const int t = row & 4095; r.tpos = CTXL + t; r.pr = t >> 6; r.pc = t & 63; r.v = r.b; }
    else { const int q = row - NLAT; r.lat = false; r.b = q >> 8; r.tpos = q & 255; r.pr = 0; r.pc = 0; r.v = 4; }
    return r;
}

#define XB_TMO      128
#define XB_XCNT(j)  (256  + 64 * (j))
#define XB_XSUB(j)  (1280 + 64 * (j))
#define XB_XGEN(j)  (2304 + 64 * (j))
#define XB_TOP      3328
#define XB_TOPGEN   3392
#define XCD_BAR_WORDS 3456
#define XB_SPIN_CAP (1u << 22)

__device__ __forceinline__ unsigned xb_ld(unsigned* p)              { return __hip_atomic_load(p, __ATOMIC_RELAXED, __HIP_MEMORY_SCOPE_AGENT); }
__device__ __forceinline__ unsigned xb_add(unsigned* p, unsigned v) { return __hip_atomic_fetch_add(p, v, __ATOMIC_RELAXED, __HIP_MEMORY_SCOPE_AGENT); }
__device__ __forceinline__ unsigned xb_xcc_id() { return (unsigned)__builtin_amdgcn_s_getreg((3 << 11) | 20) & 0xFu; }
#define XB_SPIN(cond, bar) do { unsigned _sp = 0; while (cond) { __builtin_amdgcn_s_sleep(1); \
    if ((++_sp & 255u) == 0u) { if (xb_ld(&(bar)[XB_TMO])) break; if (_sp > XB_SPIN_CAP) { atomicAdd(&(bar)[XB_TMO], 1u); break; } } } } while (0)

struct XcdBarrier { unsigned* bar; unsigned x; volatile LAS unsigned* st; };

__device__ __forceinline__ XcdBarrier xcd_barrier_post(unsigned* bar, volatile LAS unsigned* st) {
    XcdBarrier b; b.bar = bar; b.x = xb_xcc_id(); b.st = st;
    if (threadIdx.x == 0) (void)xb_add(&bar[XB_XCNT(b.x)], 1u);
    return b;
}
__device__ __forceinline__ void xcd_barrier_complete(unsigned* bar, unsigned x, unsigned& nloc, unsigned& nx) {
    const unsigned G = gridDim.x * gridDim.y * gridDim.z;
    unsigned sum, cnt, mine, sp = 0u;
    for (;;) {
        sum = 0u; cnt = 0u; mine = 0u;
#pragma unroll
        for (unsigned j = 0; j < 16; ++j) { const unsigned c = xb_ld(&bar[XB_XCNT(j)]); sum += c; cnt += (c > 0u) ? 1u : 0u; mine = (j == x) ? c : mine; }
        if (sum == G) break;
        __builtin_amdgcn_s_sleep(1);
        if ((++sp & 255u) == 0u) { if (xb_ld(&bar[XB_TMO])) break; if (sp > XB_SPIN_CAP) { atomicAdd(&bar[XB_TMO], 1u); break; } }
    }
    nloc = mine > 0u ? mine : 1u; nx = cnt > 0u ? cnt : 1u;
}
__device__ __forceinline__ void xcd_barrier(const XcdBarrier& b) {
    asm volatile("s_waitcnt vmcnt(0)" ::: "memory");
    __syncthreads();
    if (threadIdx.x == 0) {
        unsigned* bar = b.bar;
        __builtin_amdgcn_s_waitcnt(0);
        unsigned nloc = b.st[0], nx = b.st[1];
        if (nloc == 0u) { xcd_barrier_complete(bar, b.x, nloc, nx); b.st[0] = nloc; b.st[1] = nx; }
        const unsigned old = xb_add(&bar[XB_XSUB(b.x)], 1u);
        const unsigned gen = old / nloc;
        if (old + 1u == (gen + 1u) * nloc) {
            __builtin_amdgcn_fence(__ATOMIC_RELEASE, "agent");
            asm volatile("s_waitcnt vmcnt(0)" ::: "memory");
            const unsigned og = xb_add(&bar[XB_TOP], 1u);
            const unsigned tg = og / nx;
            if (og + 1u == (tg + 1u) * nx) xb_add(&bar[XB_TOPGEN], 1u);
            else XB_SPIN(xb_ld(&bar[XB_TOPGEN]) == tg, bar);
            __builtin_amdgcn_fence(__ATOMIC_ACQUIRE, "agent");
            xb_add(&bar[XB_XGEN(b.x)], 1u);
            asm volatile("s_waitcnt vmcnt(0)" ::: "memory");
        } else {
            XB_SPIN(xb_ld(&bar[XB_XGEN(b.x)]) == gen, bar);
            __builtin_amdgcn_fence(__ATOMIC_ACQUIRE, "agent");
            asm volatile("s_waitcnt vmcnt(0)" ::: "memory");
        }
    }
    __syncthreads();
}
namespace pg8 {
constexpr int BM = 256, BK = 64, HALF = 128, HTB = HALF * BK * 2, STAGE_BYTES = 8 * HTB, NXCD = 8, WGM = 8;
__host__ __device__ __forceinline__ int lds_byte(int r, int c) { const int st = (r >> 4) * 2 + (c >> 5), rr = r & 15, cc = c & 31, ob = rr * 64 + cc * 2; return st * 1024 + (ob ^ (((ob >> 9) & 1) << 5)); }
__host__ __device__ __forceinline__ void stage_rc(int b, int& R, int& C) { const int st = b / 1024, sb = b % 1024, swz = sb ^ (((sb >> 9) & 1) << 5); R = (st >> 1) * 16 + swz / 64; C = (st & 1) * 32 + (swz % 64) / 2; }
__host__ __device__ __forceinline__ int perm32(int rho) { const int n = rho >> 4, i = rho & 15; return 8 * (i >> 2) + 4 * n + (i & 3); }

struct Unit { int pm, pn; };
typedef int i32x8 __attribute__((ext_vector_type(8))); typedef int i32x4v __attribute__((ext_vector_type(4)));
__device__ __forceinline__ i32x8 cat8(const bf16x8 a, const bf16x8 b) { const i32x4v x = __builtin_bit_cast(i32x4v, a), y = __builtin_bit_cast(i32x4v, b); return __builtin_shufflevector(x, y, 0, 1, 2, 3, 4, 5, 6, 7); }
struct Gemm { const bf16_t* A; const bf16_t* Bt; int M, N, K, lda, ldb; };

struct StaticOrder {
    int nM, nN, nwg, G, c;
    __host__ __device__ void init(int M, int N, int G_, int c_) { nM = M / BM; nN = N / BM; nwg = nM * nN; G = G_; c = c_; }
    __host__ __device__ bool next(int i, Unit& u) const {
        const long L = (long)i * G + c; if (L >= nwg) return false;
        int wgid = (int)L; { const int q = nwg / NXCD, r = nwg % NXCD, xcd = wgid % NXCD, off = wgid / NXCD; wgid = (xcd < r ? xcd * (q + 1) : r * (q + 1) + (xcd - r) * q) + off; }
        const int nig = WGM * nN, gid = wgid / nig, fm = gid * WGM, gsz = (nM - fm) < WGM ? (nM - fm) : WGM;
        u.pm = fm + ((wgid % nig) % gsz); u.pn = (wgid % nig) / gsz; return true;
    }
    __device__ __forceinline__ void a_ready(const Unit&) const {}
    __device__ __forceinline__ void done(const Unit&) const {}
};

template <class Epi, class Sched>
__device__ __forceinline__ void gemm_phase(LAS unsigned char* lds, const int tid, const Gemm g, const Sched& S, const Epi& E) {
    const int  wid = __builtin_amdgcn_readfirstlane(tid >> 6), lane = tid & 63, wr = wid >> 2, wc = wid & 3, fr = lane & 15, fq = lane >> 4;
    const int K = g.K, nt = K / BK;
    unsigned voffA[2], voffB[2];
#pragma unroll
    for (int i = 0; i < 2; ++i) { int R, C; stage_rc(tid * 16 + i * 8192, R, C); const int Rb = Epi::PERM ? ((R & ~31) + perm32(R & 31)) : R;
        voffA[i] = (unsigned)(R * g.lda + C) * 2u; voffB[i] = (unsigned)(Rb * g.ldb + C) * 2u; }
    const size_t kstep = (size_t)(BK * 2);
    const size_t hstepA = (size_t)HALF * g.lda * 2, hstepB = (size_t)HALF * g.ldb * 2;
    const size_t tstepA = 2 * hstepA, tstepB = 2 * hstepB;
    const unsigned ldsw = (unsigned)wid * 1024u;
    const int aoff = lds_byte(wr * 64 + fr, fq * 8), boff = lds_byte(wc * 32 + fr, fq * 8);
#define PG8_SA(b, h) (((b) * 2 + (h)) * HTB)
#define PG8_SB(b, h) ((4 + (b) * 2 + (h)) * HTB)
#define PG8_STAGE(bufoff, gbase, voff) do { _Pragma("unroll") for (int _i = 0; _i < 2; ++_i) \
        __builtin_amdgcn_global_load_lds((const unsigned*)((const char*)(gbase) + (voff)[_i]), (LAS unsigned*)(lds + (bufoff) + ldsw + _i * 8192), 16, 0, 0); } while (0)
#define PG8_LDA(dst, b, h) do { if constexpr (Epi::FP8) { _Pragma("unroll") for (int m = 0; m < 4; ++m) { const i32x4v lo_ = *(const LAS i32x4v*)(lds + PG8_SA(b, h) + aoff + m * 2048), hi_ = *(const LAS i32x4v*)(lds + PG8_SA(b, h) + aoff + m * 2048 + 1024); \
            dst##8[m] = __builtin_shufflevector(lo_, hi_, 0, 1, 2, 3, 4, 5, 6, 7); } } \
        else { _Pragma("unroll") for (int m = 0; m < 4; ++m) _Pragma("unroll") for (int k = 0; k < 2; ++k) dst[m][k] = *(const LAS bf16x8*)(lds + PG8_SA(b, h) + aoff + m * 2048 + k * 1024); } } while (0)
#define PG8_LDB(dst, b, h) do { if constexpr (Epi::FP8) { _Pragma("unroll") for (int n = 0; n < 2; ++n) { const i32x4v lo_ = *(const LAS i32x4v*)(lds + PG8_SB(b, h) + boff + n * 2048), hi_ = *(const LAS i32x4v*)(lds + PG8_SB(b, h) + boff + n * 2048 + 1024); \
            dst##8[n] = __builtin_shufflevector(lo_, hi_, 0, 1, 2, 3, 4, 5, 6, 7); } } \
        else { _Pragma("unroll") for (int n = 0; n < 2; ++n) _Pragma("unroll") for (int k = 0; k < 2; ++k) dst[n][k] = *(const LAS bf16x8*)(lds + PG8_SB(b, h) + boff + n * 2048 + k * 1024); } } while (0)
#define PG8_MMA(ai, bj, At, Bt) do { __builtin_amdgcn_s_setprio(1); _Pragma("unroll") for (int m = 0; m < 4; ++m) _Pragma("unroll") for (int n = 0; n < 2; ++n) { \
        if constexpr (Epi::FP8) asm volatile("v_mfma_scale_f32_16x16x128_f8f6f4 %0, %1, %2, %0, %3, %3 op_sel_hi:[0,0,0]" : "+v"(acc[ai][bj][m][n]) : "v"(Bt##8[n]), "v"(At##8[m]), "v"(sc1_)); \
        else { _Pragma("unroll") for (int k = 0; k < 2; ++k) acc[ai][bj][m][n] = __builtin_amdgcn_mfma_f32_16x16x32_bf16(Bt[n][k], At[m][k], acc[ai][bj][m][n], 0, 0, 0); } } __builtin_amdgcn_s_setprio(0); } while (0)
#define PG8_WAIT_V(n) asm volatile("s_waitcnt vmcnt(" #n ")" ::: "memory")
#define PG8_WAIT_L(n) asm volatile("s_waitcnt lgkmcnt(" #n ")" ::: "memory")
#define PG8_BAR __builtin_amdgcn_s_barrier()
#define PG8_SCHED __builtin_amdgcn_sched_barrier(0)
    Unit cur, nxt; int ui = 0;
    if (!S.next(0, cur)) return;
    f32x4 acc[2][2][4][2];
#pragma unroll
    for (int a = 0; a < 2; ++a)
#pragma unroll
        for (int b = 0; b < 2; ++b)
#pragma unroll
            for (int m = 0; m < 4; ++m)
#pragma unroll
                for (int n = 0; n < 2; ++n) acc[a][b][m][n] = (f32x4){0.f, 0.f, 0.f, 0.f};
    int sc1_ = 0x7F7F7F7F; asm volatile("" : "+v"(sc1_));
    bf16x8 At[4][2], B0[2][2], B1[2][2]; i32x8 At8[4], B08[2], B18[2];
    const char* cA = (const char*)g.A + (size_t)cur.pm * tstepA; const char* cB = (const char*)g.Bt + (size_t)cur.pn * tstepB;
    S.a_ready(cur);
    PG8_STAGE(PG8_SB(0, 0), cB, voffB); PG8_STAGE(PG8_SA(0, 0), cA, voffA); PG8_STAGE(PG8_SB(0, 1), cB + hstepB, voffB); PG8_STAGE(PG8_SA(0, 1), cA + hstepA, voffA);
    if (wr == 1) PG8_BAR;
    PG8_WAIT_V(4); PG8_BAR;
    PG8_STAGE(PG8_SB(1, 0), cB + kstep, voffB); PG8_STAGE(PG8_SA(1, 0), cA + kstep, voffA); PG8_STAGE(PG8_SB(1, 1), cB + hstepB + kstep, voffB);
    PG8_WAIT_V(6); PG8_BAR;
    for (;;) {
        const bool has_next = S.next(ui + 1, nxt);
        const char* nA = has_next ? (const char*)g.A + (size_t)nxt.pm * tstepA : cA; const char* nB = has_next ? (const char*)g.Bt + (size_t)nxt.pn * tstepB : cB;
#pragma unroll 1
        for (int t = 0; t < nt; t += 2) {
            const bool last = (t == nt - 2);
            const char* a1 = cA + (size_t)(t + 1) * kstep;
            const char* a2 = last ? nA : cA + (size_t)(t + 2) * kstep; const char* b2 = last ? nB : cB + (size_t)(t + 2) * kstep;
            const char* a3 = a2 + kstep; const char* b3 = b2 + kstep;
            if (last && has_next) S.a_ready(nxt);
            PG8_LDB(B0, 0, 0); PG8_SCHED; PG8_LDA(At, 0, 0); PG8_STAGE(PG8_SA(1, 1), a1 + hstepA, voffA);
            PG8_WAIT_L(8); PG8_BAR; PG8_WAIT_L(0); PG8_MMA(0, 0, At, B0); PG8_BAR; PG8_SCHED;
            PG8_LDB(B1, 0, 1); PG8_STAGE(PG8_SB(0, 0), b2, voffB);
            PG8_BAR; PG8_WAIT_L(0); PG8_MMA(0, 1, At, B1); PG8_BAR;
            PG8_LDA(At, 0, 1); PG8_STAGE(PG8_SA(0, 0), a2, voffA);
            PG8_BAR; PG8_WAIT_L(0); PG8_MMA(1, 0, At, B0); PG8_BAR; PG8_SCHED;
            PG8_STAGE(PG8_SB(0, 1), b2 + hstepB, voffB);
            PG8_WAIT_V(6); PG8_BAR; PG8_MMA(1, 1, At, B1); PG8_BAR;
            PG8_LDB(B0, 1, 0); PG8_SCHED; PG8_LDA(At, 1, 0); PG8_STAGE(PG8_SA(0, 1), a2 + hstepA, voffA);
            PG8_WAIT_L(8); PG8_BAR; PG8_WAIT_L(0); PG8_MMA(0, 0, At, B0); PG8_BAR; PG8_SCHED;
            PG8_LDB(B1, 1, 1); PG8_STAGE(PG8_SB(1, 0), b3, voffB);
            PG8_BAR; PG8_WAIT_L(0); PG8_MMA(0, 1, At, B1); PG8_BAR;
            PG8_LDA(At, 1, 1); PG8_STAGE(PG8_SA(1, 0), a3, voffA);
            PG8_BAR; PG8_WAIT_L(0); PG8_MMA(1, 0, At, B0); PG8_BAR; PG8_SCHED;
            PG8_STAGE(PG8_SB(1, 1), b3 + hstepB, voffB);
            PG8_WAIT_V(6); PG8_BAR; PG8_MMA(1, 1, At, B1); PG8_BAR;
        }
        if constexpr (Epi::FP8) asm volatile("s_nop 15\n\ts_nop 15" ::: "memory");
        E(acc, cur, wr, wc, fr, fq);
        if (!has_next) break;
#pragma unroll
        for (int a = 0; a < 2; ++a)
#pragma unroll
            for (int b = 0; b < 2; ++b)
#pragma unroll
                for (int m = 0; m < 4; ++m)
#pragma unroll
                    for (int n = 0; n < 2; ++n) acc[a][b][m][n] = (f32x4){0.f, 0.f, 0.f, 0.f};
        cur = nxt; cA = nA; cB = nB; ++ui;
    }
    PG8_WAIT_V(0);
    if (wr == 0) PG8_BAR;
    PG8_BAR;
#undef PG8_SA
#undef PG8_SB
#undef PG8_STAGE
#undef PG8_LDA
#undef PG8_LDB
#undef PG8_MMA
#undef PG8_WAIT_V
#undef PG8_WAIT_L
#undef PG8_BAR
#undef PG8_SCHED
}
}

typedef f32x4 Acc[2][2][4][2];
#define EPI_LOOP_ROWS for (int ai = 0; ai < 2; ++ai) for (int m = 0; m < 4; ++m)
__device__ __forceinline__ u32x4 pack8(const f32x4 a, const f32x4 b) { u32x4 w; w.x = cvt_pk_bf16(a[0], a[1]); w.y = cvt_pk_bf16(a[2], a[3]); w.z = cvt_pk_bf16(b[0], b[1]); w.w = cvt_pk_bf16(b[2], b[3]); return w; }

struct EpiIn {
    static constexpr bool PERM = true, FP8 = true;
    bf16_t* P1; bf16_t* G; float inv;
    __device__ __forceinline__ void operator()(const Acc& acc, const pg8::Unit& u, int wr, int wc, int fr, int fq) const {
        const int row0 = u.pm * 256 + wr * 64 + fr; const bool gate = u.pn >= 16;
        bf16_t* base = gate ? G : P1; const int ld = gate ? NG : NP1; const int col0 = (gate ? (u.pn - 16) : u.pn) * 256 + wc * 32 + 8 * fq;
#pragma unroll
        for (int ai = 0; ai < 2; ++ai)
#pragma unroll
            for (int m = 0; m < 4; ++m) { bf16_t* rowp = base + (size_t)(row0 + ai * 128 + m * 16) * ld + col0;
#pragma unroll
                for (int bj = 0; bj < 2; ++bj) { f32x4 v0 = acc[ai][bj][m][0] * inv, v1 = acc[ai][bj][m][1] * inv;
                    if (gate) {
#pragma unroll
                        for (int j = 0; j < 4; ++j) { v0[j] = sigmoid_f(v0[j]); v1[j] = sigmoid_f(v1[j]); } }
                    *(u32x4*)(rowp + bj * 128) = pack8(v0, v1); } }
    }
};
struct EpiPlain {
    static constexpr bool PERM = true, FP8 = false;
    bf16_t* O; int ldc;
    __device__ __forceinline__ void operator()(const Acc& acc, const pg8::Unit& u, int wr, int wc, int fr, int fq) const {
        const int row0 = u.pm * 256 + wr * 64 + fr; const int col0 = u.pn * 256 + wc * 32 + 8 * fq;
#pragma unroll
        for (int ai = 0; ai < 2; ++ai)
#pragma unroll
            for (int m = 0; m < 4; ++m) { bf16_t* rowp = O + (size_t)(row0 + ai * 128 + m * 16) * ldc + col0;
#pragma unroll
                for (int bj = 0; bj < 2; ++bj) *(u32x4*)(rowp + bj * 128) = pack8(acc[ai][bj][m][0], acc[ai][bj][m][1]); }
    }
};
__device__ __forceinline__ void tile_info(int pm, int& b, int& tpos0, bool& lat) { lat = pm < 64; b = lat ? (pm >> 4) : (pm - 64); tpos0 = lat ? CTXL + ((pm & 15) << 8) : 0; }
struct EpiQup {
    static constexpr bool PERM = true, FP8 = false;
    unsigned char* QM; const f32x2* cs32;
    __device__ __forceinline__ void operator()(const Acc& acc, const pg8::Unit& u, int wr, int wc, int fr, int fq) const {
        int b, tpos0; bool lat; tile_info(u.pm, b, tpos0, lat);
        const int r0 = wr * 64 + fr;
#pragma unroll
        for (int bj = 0; bj < 2; ++bj) { const int c0 = u.pn * 256 + bj * 128 + wc * 32 + 8 * fq; const int hh = c0 / 96, j0 = c0 - hh * 96;
            unsigned char* hb = QM + ((size_t)(b * 8 + hh) * TT + tpos0 + r0) * 128;
            if (j0 < 64) {
#pragma unroll
                for (int ai = 0; ai < 2; ++ai)
#pragma unroll
                    for (int m = 0; m < 4; ++m) { const f32x4 a_ = acc[ai][bj][m][0], b_ = acc[ai][bj][m][1]; u32x2 w8; w8.x = pk4_fp8(clamp8(a_[0]), clamp8(a_[1]), clamp8(a_[2]), clamp8(a_[3])); w8.y = pk4_fp8(clamp8(b_[0]), clamp8(b_[1]), clamp8(b_[2]), clamp8(b_[3]));
                        *(u32x2*)(hb + (ai * 128 + m * 16) * 128 + j0) = w8; }
            } else { const int g8 = (j0 - 64) >> 3, part = g8 >> 1, pbase = (g8 & 1) * 4;
#pragma unroll
                for (int ai = 0; ai < 2; ++ai)
#pragma unroll
                    for (int m = 0; m < 4; ++m) { const int t = tpos0 - CTXL + r0 + ai * 128 + m * 16; const int pos = part ? (t & 63) : (t >> 6);
                        const f32x4 v0 = acc[ai][bj][m][0], v1 = acc[ai][bj][m][1];
                        float o1[4], o2[4]; const float x1[4] = {v0[0], v0[2], v1[0], v1[2]}, x2[4] = {v0[1], v0[3], v1[1], v1[3]};
#pragma unroll
                        for (int p = 0; p < 4; ++p) { const f32x2 cs = lat ? cs32[pos * 8 + pbase + p] : (f32x2){1.f, 0.f};
                            o1[p] = x1[p] * cs.x - x2[p] * cs.y; o2[p] = x1[p] * cs.y + x2[p] * cs.x; }
                        unsigned char* dst = hb + (ai * 128 + m * 16) * 128 + 64 + part * 16 + pbase;
                        *(unsigned*)dst = pk4_fp8(clamp8(o1[0]), clamp8(o1[1]), clamp8(o1[2]), clamp8(o1[3])); *(unsigned*)(dst + 8) = pk4_fp8(clamp8(o2[0]), clamp8(o2[1]), clamp8(o2[2]), clamp8(o2[3])); } } }
    }
};
struct EpiKvup {
    static constexpr bool PERM = true, FP8 = false;
    unsigned char* KM; unsigned char* VM;
    __device__ __forceinline__ void operator()(const Acc& acc, const pg8::Unit& u, int wr, int wc, int fr, int fq) const {
        int b, tpos0; bool lat; tile_info(u.pm, b, tpos0, lat);
        const int r0 = wr * 64 + fr; const int j0 = wc * 32 + 8 * fq;
#pragma unroll
        for (int bj = 0; bj < 2; ++bj) { const size_t tok = (size_t)(b * 8 + u.pn * 2 + bj) * TT + tpos0 + r0;
            if (j0 < 64) { unsigned char* d = KM + tok * 128 + j0;
#pragma unroll
                for (int ai = 0; ai < 2; ++ai)
#pragma unroll
                    for (int m = 0; m < 4; ++m) { const f32x4 a_ = acc[ai][bj][m][0], b_ = acc[ai][bj][m][1]; u32x2 w8; w8.x = pk4_fp8(clamp8(a_[0]), clamp8(a_[1]), clamp8(a_[2]), clamp8(a_[3])); w8.y = pk4_fp8(clamp8(b_[0]), clamp8(b_[1]), clamp8(b_[2]), clamp8(b_[3]));
                        *(u32x2*)(d + (ai * 128 + m * 16) * 128) = w8; } }
            else { unsigned char* d = VM + ((size_t)(b * 8 + u.pn * 2 + bj) * 64 + (j0 - 64)) * TT;
#pragma unroll
                for (int ai = 0; ai < 2; ++ai)
#pragma unroll
                    for (int m = 0; m < 4; ++m) { const f32x4 a_ = acc[ai][bj][m][0], b_ = acc[ai][bj][m][1]; const unsigned w0_ = pk4_fp8(clamp8(a_[0]), clamp8(a_[1]), clamp8(a_[2]), clamp8(a_[3])), w1_ = pk4_fp8(clamp8(b_[0]), clamp8(b_[1]), clamp8(b_[2]), clamp8(b_[3]));
                        unsigned char* q_ = d + vt_off(tpos0 + r0 + ai * 128 + m * 16);
                        q_[0] = (unsigned char)(w0_ & 0xffu); q_[TT] = (unsigned char)((w0_ >> 8) & 0xffu); q_[2 * TT] = (unsigned char)((w0_ >> 16) & 0xffu); q_[3 * TT] = (unsigned char)(w0_ >> 24);
                        q_[4 * TT] = (unsigned char)(w1_ & 0xffu); q_[5 * TT] = (unsigned char)((w1_ >> 8) & 0xffu); q_[6 * TT] = (unsigned char)((w1_ >> 16) & 0xffu); q_[7 * TT] = (unsigned char)(w1_ >> 24); } } }
    }
};
template <int SEG> struct EpiMerge {
    static constexpr bool PERM = true, FP8 = false;
    bf16_t* MB; const bf16_t* G; unsigned char* MB8;
    __device__ __forceinline__ void operator()(const Acc& acc, const pg8::Unit& u, int wr, int wc, int fr, int fq) const {
        const int row0 = u.pm * 256 + wr * 64 + fr; const int col0 = u.pn * 256 + wc * 32 + 8 * fq;
        const bf16_t* gp = G + (size_t)row0 * NG + SEG * 2048 + col0; bf16_t* mp = MB + (size_t)row0 * D + col0; unsigned char* m8 = MB8 + (size_t)row0 * D + col0;
#pragma unroll
        for (int ai = 0; ai < 2; ++ai) {
            u32x4 gw[4][2], ow[4][2];
#pragma unroll
            for (int m = 0; m < 4; ++m)
#pragma unroll
                for (int bj = 0; bj < 2; ++bj) { const size_t ro = (size_t)(ai * 128 + m * 16);
                    gw[m][bj] = *(const u32x4*)(gp + ro * NG + bj * 128);
                    if (SEG > 0) ow[m][bj] = __builtin_nontemporal_load((const u32x4*)(mp + ro * D + bj * 128)); }
#pragma unroll
            for (int m = 0; m < 4; ++m)
#pragma unroll
                for (int bj = 0; bj < 2; ++bj) { const size_t ro = (size_t)(ai * 128 + m * 16); const u32x4 g_ = gw[m][bj];
                    f32x4 v0 = acc[ai][bj][m][0], v1 = acc[ai][bj][m][1];
                    if (ABL_BR & (1 << SEG)) { v0 = (f32x4){0.f, 0.f, 0.f, 0.f}; v1 = v0; }
                    v0[0] *= bflo(g_.x); v0[1] *= bfhi(g_.x); v0[2] *= bflo(g_.y); v0[3] *= bfhi(g_.y);
                    v1[0] *= bflo(g_.z); v1[1] *= bfhi(g_.z); v1[2] *= bflo(g_.w); v1[3] *= bfhi(g_.w);
                    if (SEG > 0) { const u32x4 o = ow[m][bj];
                        v0[0] += bflo(o.x); v0[1] += bfhi(o.x); v0[2] += bflo(o.y); v0[3] += bfhi(o.y);
                        v1[0] += bflo(o.z); v1[1] += bfhi(o.z); v1[2] += bflo(o.w); v1[3] += bfhi(o.w); }
                    if (SEG < 2) *(u32x4*)(mp + ro * D + bj * 128) = pack8(v0, v1);
                    else { u32x2 w8; w8.x = pk4_fp8(clamp8(v0[0] * 16.f), clamp8(v0[1] * 16.f), clamp8(v0[2] * 16.f), clamp8(v0[3] * 16.f)); w8.y = pk4_fp8(clamp8(v1[0] * 16.f), clamp8(v1[1] * 16.f), clamp8(v1[2] * 16.f), clamp8(v1[3] * 16.f));
                        *(u32x2*)(m8 + ro * D + bj * 128) = w8; } }
        }
    }
};
namespace pg8 {
struct Merge3 { const bf16_t* A; const bf16_t* B0; const bf16_t* B1; const bf16_t* B2; const bf16_t* G; unsigned char* MB8; float r01, r12, fin; };
template <class Sched>
__device__ __forceinline__ void gemm_merge3(LAS unsigned char* lds, const int tid, const Merge3 g, const Sched& S) {
    const int wid = __builtin_amdgcn_readfirstlane(tid >> 6), lane = tid & 63, wr = wid >> 2, wc = wid & 3, fr = lane & 15, fq = lane >> 4;
    constexpr int NT = 16, LDA = 1024;
    int sc1_ = 0x7F7F7F7F; asm volatile("" : "+v"(sc1_));
    unsigned voffA[2], voffB5[2], voffB10[2];
#pragma unroll
    for (int i = 0; i < 2; ++i) { int R, C; stage_rc(tid * 16 + i * 8192, R, C); const int Rb = (R & ~31) + perm32(R & 31);
        voffA[i] = (unsigned)(R * LDA + C) * 2u; voffB5[i] = (unsigned)(Rb * 256 + C) * 2u; voffB10[i] = (unsigned)(Rb * 512 + C) * 2u; }
    const size_t kstep = (size_t)(BK * 2);
    const size_t hstepA = (size_t)HALF * LDA * 2, tstepA = 2 * hstepA;
    const unsigned ldsw = (unsigned)wid * 1024u;
    const int aoff = lds_byte(wr * 64 + fr, fq * 8), boff = lds_byte(wc * 32 + fr, fq * 8);
#define M3_TA(pm_, t_) ((const char*)g.A + (size_t)(pm_) * tstepA + (size_t)(t_) * kstep)
#define M3_TB(pn_, t_) ((t_) < 4 ? (const char*)g.B0 + (size_t)(pn_) * 131072 + (size_t)(t_) * kstep : ((t_) < 8 ? (const char*)g.B1 + (size_t)(pn_) * 131072 + (size_t)((t_) - 4) * kstep : (const char*)g.B2 + (size_t)(pn_) * 262144 + (size_t)((t_) - 8) * kstep))
#define PG8_SA(b, h) (((b) * 2 + (h)) * HTB)
#define PG8_SB(b, h) ((4 + (b) * 2 + (h)) * HTB)
#define PG8_STAGE(bufoff, gbase, voff) do { _Pragma("unroll") for (int _i = 0; _i < 2; ++_i) \
        __builtin_amdgcn_global_load_lds((const unsigned*)((const char*)(gbase) + (voff)[_i]), (LAS unsigned*)(lds + (bufoff) + ldsw + _i * 8192), 16, 0, 0); } while (0)
#define PG8_LDA(dst, b, h) do { _Pragma("unroll") for (int m = 0; m < 4; ++m) { const i32x4v lo_ = *(const LAS i32x4v*)(lds + PG8_SA(b, h) + aoff + m * 2048), hi_ = *(const LAS i32x4v*)(lds + PG8_SA(b, h) + aoff + m * 2048 + 1024); dst[m] = __builtin_shufflevector(lo_, hi_, 0, 1, 2, 3, 4, 5, 6, 7); } } while (0)
#define PG8_LDB(dst, b, h) do { _Pragma("unroll") for (int n = 0; n < 2; ++n) { const i32x4v lo_ = *(const LAS i32x4v*)(lds + PG8_SB(b, h) + boff + n * 2048), hi_ = *(const LAS i32x4v*)(lds + PG8_SB(b, h) + boff + n * 2048 + 1024); dst[n] = __builtin_shufflevector(lo_, hi_, 0, 1, 2, 3, 4, 5, 6, 7); } } while (0)
#define PG8_MMA(ai, bj, At, Bt) do { __builtin_amdgcn_s_setprio(1); _Pragma("unroll") for (int m = 0; m < 4; ++m) _Pragma("unroll") for (int n = 0; n < 2; ++n) \
        asm volatile("v_mfma_scale_f32_16x16x128_f8f6f4 %0, %1, %2, %0, %3, %3 op_sel_hi:[0,0,0]" : "+v"(acc[ai][bj][m][n]) : "v"(Bt[n]), "v"(At[m]), "v"(sc1_)); __builtin_amdgcn_s_setprio(0); } while (0)
#define PG8_WAIT_V(n) asm volatile("s_waitcnt vmcnt(" #n ")" ::: "memory")
#define PG8_WAIT_L(n) asm volatile("s_waitcnt lgkmcnt(" #n ")" ::: "memory")
#define PG8_BAR __builtin_amdgcn_s_barrier()
#define PG8_SCHED __builtin_amdgcn_sched_barrier(0)
    Unit cur, nxt; int ui = 0;
    if (!S.next(0, cur)) return;
    f32x4 acc[2][2][4][2];
#pragma unroll
    for (int a = 0; a < 2; ++a)
#pragma unroll
        for (int b = 0; b < 2; ++b)
#pragma unroll
            for (int m = 0; m < 4; ++m)
#pragma unroll
                for (int n = 0; n < 2; ++n) acc[a][b][m][n] = (f32x4){0.f, 0.f, 0.f, 0.f};
    i32x8 At[4], B0[2], B1[2];
    { const char* cA = M3_TA(cur.pm, 0); const char* cB = M3_TB(cur.pn, 0); const size_t hB = 65536;
      PG8_STAGE(PG8_SB(0, 0), cB, voffB5); PG8_STAGE(PG8_SA(0, 0), cA, voffA); PG8_STAGE(PG8_SB(0, 1), cB + hB, voffB5); PG8_STAGE(PG8_SA(0, 1), cA + hstepA, voffA);
      if (wr == 1) PG8_BAR;
      PG8_WAIT_V(4); PG8_BAR;
      PG8_STAGE(PG8_SB(1, 0), cB + kstep, voffB5); PG8_STAGE(PG8_SA(1, 0), cA + kstep, voffA); PG8_STAGE(PG8_SB(1, 1), cB + hB + kstep, voffB5);
      PG8_WAIT_V(6); PG8_BAR; }
    const int r0 = wr * 64 + fr, c0l = wc * 32 + 8 * fq;
    for (;;) {
        const bool has_next = S.next(ui + 1, nxt);
        const int npm = has_next ? nxt.pm : cur.pm, npn = has_next ? nxt.pn : cur.pn;
#pragma unroll 1
        for (int t = 0; t < NT; t += 2) {
            const bool last = (t == NT - 2);
            const int t2 = last ? 0 : t + 2;
            const char* a1 = M3_TA(cur.pm, t + 1);
            const char* a2 = last ? M3_TA(npm, 0) : M3_TA(cur.pm, t + 2); const char* b2 = last ? M3_TB(npn, 0) : M3_TB(cur.pn, t + 2);
            const char* a3 = a2 + kstep; const char* b3 = b2 + kstep;
            const bool wide = t2 >= 8; const size_t hB = wide ? 131072 : 65536;
            unsigned vB[2]; vB[0] = wide ? voffB10[0] : voffB5[0]; vB[1] = wide ? voffB10[1] : voffB5[1];
            PG8_LDB(B0, 0, 0); PG8_SCHED; PG8_LDA(At, 0, 0); PG8_STAGE(PG8_SA(1, 1), a1 + hstepA, voffA);
            PG8_WAIT_L(8); PG8_BAR; PG8_WAIT_L(0); PG8_MMA(0, 0, At, B0); PG8_BAR; PG8_SCHED;
            PG8_LDB(B1, 0, 1); PG8_STAGE(PG8_SB(0, 0), b2, vB);
            PG8_BAR; PG8_WAIT_L(0); PG8_MMA(0, 1, At, B1); PG8_BAR;
            PG8_LDA(At, 0, 1); PG8_STAGE(PG8_SA(0, 0), a2, voffA);
            PG8_BAR; PG8_WAIT_L(0); PG8_MMA(1, 0, At, B0); PG8_BAR; PG8_SCHED;
            PG8_STAGE(PG8_SB(0, 1), b2 + hB, vB);
            PG8_WAIT_V(6); PG8_BAR; PG8_MMA(1, 1, At, B1); PG8_BAR;
            PG8_LDB(B0, 1, 0); PG8_SCHED; PG8_LDA(At, 1, 0); PG8_STAGE(PG8_SA(0, 1), a2 + hstepA, voffA);
            PG8_WAIT_L(8); PG8_BAR; PG8_WAIT_L(0); PG8_MMA(0, 0, At, B0); PG8_BAR; PG8_SCHED;
            PG8_LDB(B1, 1, 1); PG8_STAGE(PG8_SB(1, 0), b3, vB);
            PG8_BAR; PG8_WAIT_L(0); PG8_MMA(0, 1, At, B1); PG8_BAR;
            PG8_LDA(At, 1, 1); PG8_STAGE(PG8_SA(1, 0), a3, voffA);
            PG8_BAR; PG8_WAIT_L(0); PG8_MMA(1, 0, At, B0); PG8_BAR; PG8_SCHED;
            PG8_STAGE(PG8_SB(1, 1), b3 + hB, vB);
            PG8_WAIT_V(6); PG8_BAR; PG8_MMA(1, 1, At, B1); PG8_BAR;
            if (t == 2 || t == 6) {
                asm volatile("s_nop 15\n\ts_nop 15" ::: "memory");
                const int sg = t == 2 ? 0 : 1; const float wr_ = sg ? g.r12 : g.r01;
                const bf16_t* gp = g.G + (size_t)(cur.pm * 256 + r0) * NG + sg * 2048 + cur.pn * 256 + c0l;
#pragma unroll
                for (int ai = 0; ai < 2; ++ai) { u32x4 ga[4][2], gb[4][2];
#pragma unroll
                    for (int m = 0; m < 4; ++m)
#pragma unroll
                        for (int bj = 0; bj < 2; ++bj) { const bf16_t* q_ = gp + (size_t)(ai * 128 + m * 16) * NG + bj * 128; ga[m][bj] = *(const u32x4*)q_; gb[m][bj] = *(const u32x4*)(q_ + 2048); }
#pragma unroll
                    for (int m = 0; m < 4; ++m)
#pragma unroll
                        for (int bj = 0; bj < 2; ++bj) { const u32x4 x_ = ga[m][bj], y_ = gb[m][bj];
#define M3_RT(xw, yw, lohi) (fmaxf(lohi(xw), 1e-6f) * wr_ * __builtin_amdgcn_rcpf(fmaxf(lohi(yw), 1e-6f)))
                            acc[ai][bj][m][0][0] *= M3_RT(x_.x, y_.x, bflo); acc[ai][bj][m][0][1] *= M3_RT(x_.x, y_.x, bfhi); acc[ai][bj][m][0][2] *= M3_RT(x_.y, y_.y, bflo); acc[ai][bj][m][0][3] *= M3_RT(x_.y, y_.y, bfhi);
                            acc[ai][bj][m][1][0] *= M3_RT(x_.z, y_.z, bflo); acc[ai][bj][m][1][1] *= M3_RT(x_.z, y_.z, bfhi); acc[ai][bj][m][1][2] *= M3_RT(x_.w, y_.w, bflo); acc[ai][bj][m][1][3] *= M3_RT(x_.w, y_.w, bfhi); } }
                asm volatile("s_waitcnt vmcnt(0)" ::: "memory");
            }
        }
        asm volatile("s_nop 15\n\ts_nop 15" ::: "memory");
        { const bf16_t* gp = g.G + (size_t)(cur.pm * 256 + r0) * NG + 2 * 2048 + cur.pn * 256 + c0l; unsigned char* m8 = g.MB8 + (size_t)(cur.pm * 256 + r0) * D + cur.pn * 256 + c0l;
#pragma unroll
          for (int ai = 0; ai < 2; ++ai) { u32x4 gc[4][2];
#pragma unroll
              for (int m = 0; m < 4; ++m)
#pragma unroll
                  for (int bj = 0; bj < 2; ++bj) gc[m][bj] = *(const u32x4*)(gp + (size_t)(ai * 128 + m * 16) * NG + bj * 128);
#pragma unroll
              for (int m = 0; m < 4; ++m)
#pragma unroll
                  for (int bj = 0; bj < 2; ++bj) { const u32x4 z_ = gc[m][bj]; const f32x4 v0 = acc[ai][bj][m][0], v1 = acc[ai][bj][m][1];
                      u32x2 w8; const float f_ = g.fin;
                      w8.x = pk4_fp8(clamp8(v0[0] * fmaxf(bflo(z_.x), 1e-6f) * f_), clamp8(v0[1] * fmaxf(bfhi(z_.x), 1e-6f) * f_), clamp8(v0[2] * fmaxf(bflo(z_.y), 1e-6f) * f_), clamp8(v0[3] * fmaxf(bfhi(z_.y), 1e-6f) * f_));
                      w8.y = pk4_fp8(clamp8(v1[0] * fmaxf(bflo(z_.z), 1e-6f) * f_), clamp8(v1[1] * fmaxf(bfhi(z_.z), 1e-6f) * f_), clamp8(v1[2] * fmaxf(bflo(z_.w), 1e-6f) * f_), clamp8(v1[3] * fmaxf(bfhi(z_.w), 1e-6f) * f_));
                      *(u32x2*)(m8 + (size_t)(ai * 128 + m * 16) * D + bj * 128) = w8; } } }
        if (!has_next) break;
#pragma unroll
        for (int a = 0; a < 2; ++a)
#pragma unroll
            for (int b = 0; b < 2; ++b)
#pragma unroll
                for (int m = 0; m < 4; ++m)
#pragma unroll
                    for (int n = 0; n < 2; ++n) acc[a][b][m][n] = (f32x4){0.f, 0.f, 0.f, 0.f};
        cur = nxt; ++ui;
    }
    PG8_WAIT_V(0);
    if (wr == 0) PG8_BAR;
    PG8_BAR;
#undef M3_RT
#undef M3_TA
#undef M3_TB
#undef PG8_SA
#undef PG8_SB
#undef PG8_STAGE
#undef PG8_LDA
#undef PG8_LDB
#undef PG8_MMA
#undef PG8_WAIT_V
#undef PG8_WAIT_L
#undef PG8_BAR
#undef PG8_SCHED
}
}
struct EpiOut {
    static constexpr bool PERM = false, FP8 = true;
    const float* src_lat; const float* src_ctx; float* dst_lat; float* dst_ctx; const float* g1; float inv;
    __device__ __forceinline__ void operator()(const Acc& acc, const pg8::Unit& u, int wr, int wc, int fr, int fq) const {
        const int row0 = u.pm * 256 + wr * 64 + fr; const int col0 = u.pn * 256 + wc * 32 + 4 * fq;
        const bool lat = (u.pm * 256) < NLAT;
        const float* src = (lat ? src_lat : src_ctx - (size_t)NLAT * D) + (size_t)row0 * D + col0; float* dst = (lat ? dst_lat : dst_ctx - (size_t)NLAT * D) + (size_t)row0 * D + col0;
#pragma unroll
        for (int ai = 0; ai < 2; ++ai) { const int rbase = u.pm * 256 + ai * 128 + wr * 64; const int v = lat ? (rbase >> 12) : 4; const float* gp = g1 + (size_t)v * 12288 + col0;
            f32x4 gg[2][2];
#pragma unroll
            for (int bj = 0; bj < 2; ++bj)
#pragma unroll
                for (int n = 0; n < 2; ++n) gg[bj][n] = *(const f32x4*)(gp + bj * 128 + n * 16);
#pragma unroll
            for (int mh = 0; mh < 2; ++mh) {
                f32x4 xr[2][2][2];
#pragma unroll
                for (int mm = 0; mm < 2; ++mm)
#pragma unroll
                    for (int bj = 0; bj < 2; ++bj)
#pragma unroll
                        for (int n = 0; n < 2; ++n) xr[mm][bj][n] = __builtin_nontemporal_load((const f32x4*)(src + (size_t)(ai * 128 + (mh * 2 + mm) * 16) * D + bj * 128 + n * 16));
#pragma unroll
                for (int mm = 0; mm < 2; ++mm)
#pragma unroll
                    for (int bj = 0; bj < 2; ++bj)
#pragma unroll
                        for (int n = 0; n < 2; ++n) { const int m = mh * 2 + mm;
                            *(f32x4*)(dst + (size_t)(ai * 128 + m * 16) * D + bj * 128 + n * 16) = ABL_MIX ? xr[mm][bj][n] * ALPHA : xr[mm][bj][n] * ALPHA + gg[bj][n] * (acc[ai][bj][m][n] * inv); } } }
    }
};

struct Args { const float* in[27]; float* out; unsigned char* ws; int ph_lo, ph_hi; };
typedef const Args __attribute__((address_space(4)))* ArgP;
struct Frame {
    LAS unsigned char* lds; int tid, lane, wave, G, bid;
    ArgP ap; float* out; unsigned char* ws;
    __device__ __forceinline__ const float* in(int i) const { return ap->in[i]; }
};
__device__ __forceinline__ Frame make_frame(ArgP ap) {
    { unsigned long long t = (unsigned long long)ap; asm volatile("" : "+s"(t)); ap = (ArgP)t; }
    extern __shared__ __attribute__((aligned(16))) unsigned char lds_raw[];
    Frame F; F.lds = (LAS unsigned char*)lds_raw; { int t_ = threadIdx.x; asm volatile("" : "+v"(t_)); F.tid = t_; }
    F.lane = F.tid & 63; F.wave = __builtin_amdgcn_readfirstlane(F.tid >> 6); F.G = gridDim.x; F.bid = blockIdx.x;
    F.ap = ap; F.out = ap->out; F.ws = ap->ws; return F;
}
template <class T> __device__ __forceinline__ T* wsp(const Frame& F, size_t off) { return (T*)(F.ws + off); }

__device__ __forceinline__ int win_col(int n) {
    if (n < 768) return n;
    if (n < 1792) return 2336 + (n - 768);
    if (n < 2048) return 3360 + (n - 1792);
    if (n < 2304) return 3616 + (n - 2048);
    if (n < 2560) return 800 + (n - 2304);
    if (n < 2816) return 1056 + (n - 2560);
    if (n < 3328) return 1312 + (n - 2816);
    if (n < 3840) return 1824 + (n - 3328);
    if (n < 3872) return 768 + (n - 3840);
    if (n < 4096) return -1;
    return 3872 + (n - 4096);
}
__device__ __forceinline__ int qup_col(int c) {
    const int hh = c / 96, j = c - hh * 96;
    if (j < 64) return c;
    const int jj = j - 64, g8 = jj >> 3, i = jj & 7, p = i >> 1, which = i & 1, part = g8 >> 1, pi = (g8 & 1) * 4 + p;
    return hh * 96 + 64 + part * 16 + which * 8 + pi;
}
template <int MAP>
__device__ __forceinline__ void transpose_cvt(const Frame& F, const float* __restrict__ src, bf16_t* __restrict__ dst, int K, int Nsrc, int Nd) {
    LAS float* tile = (LAS float*)F.lds;
    const int tk = K / 256, tn = Nd / 64, ntile = tk * tn;
    for (int t = F.bid; t < ntile; t += F.G) {
        const int k0 = (t % tk) * 256, n0 = (t / tk) * 64;
        const int nl = F.tid & 63, kq = F.tid >> 6;
        const int nd = n0 + nl; const int ns = MAP == 0 ? nd : (MAP == 1 ? win_col(nd) : qup_col(nd));
        float v[32];
#pragma unroll
        for (int i = 0; i < 32; ++i) v[i] = ns >= 0 ? src[(size_t)(k0 + kq + 8 * i) * Nsrc + ns] : 0.f;
#pragma unroll
        for (int i = 0; i < 32; ++i) tile[(kq + 8 * i) * 65 + nl] = v[i];
        __syncthreads();
        { const int n = F.tid >> 3, k32 = (F.tid & 7) * 32;
#pragma unroll
          for (int c = 0; c < 4; ++c) { float w[8];
#pragma unroll
              for (int j = 0; j < 8; ++j) w[j] = tile[(k32 + c * 8 + j) * 65 + n];
              u32x4 o; o.x = cvt_pk_bf16(w[0], w[1]); o.y = cvt_pk_bf16(w[2], w[3]); o.z = cvt_pk_bf16(w[4], w[5]); o.w = cvt_pk_bf16(w[6], w[7]);
              *(u32x4*)(dst + (size_t)(n0 + n) * K + k0 + k32 + c * 8) = o; } }
        __syncthreads();
    }
}
__device__ __forceinline__ void cvt_rows(const Frame& F, const float* __restrict__ src, bf16_t* __restrict__ dst, size_t n8) {
    for (size_t i = (size_t)F.bid * 512 + F.tid; i < n8; i += (size_t)F.G * 512) {
        const f32x4 a = __builtin_nontemporal_load((const f32x4*)(src + i * 8)), b = __builtin_nontemporal_load((const f32x4*)(src + i * 8 + 4));
        *(u32x4*)(dst + i * 8) = pack8(a, b);
    }
}
__device__ __forceinline__ void cvt_peer(const Frame& F, int l);
__device__ __forceinline__ void absmax_f32(const Frame& F, const float* __restrict__ src, size_t n4, unsigned* dst) {
    float am = 0.f;
    const size_t stride = (size_t)F.G * 512; size_t i = (size_t)F.bid * 512 + F.tid;
    for (; i + 7 * stride < n4; i += 8 * stride) { f32x4 a[8];
#pragma unroll
        for (int j = 0; j < 8; ++j) a[j] = __builtin_nontemporal_load((const f32x4*)(src + (i + j * stride) * 4));
#pragma unroll
        for (int j = 0; j < 8; ++j) am = fmaxf(fmaxf(fmaxf(am, fabsf(a[j][0])), fabsf(a[j][1])), fmaxf(fabsf(a[j][2]), fabsf(a[j][3]))); }
    for (; i < n4; i += stride) { const f32x4 a = *(const f32x4*)(src + i * 4); am = fmaxf(fmaxf(fmaxf(am, fabsf(a[0])), fabsf(a[1])), fmaxf(fabsf(a[2]), fabsf(a[3]))); }
    am = row16_max(am);
    { auto r = __builtin_amdgcn_permlane16_swap(__float_as_uint(am), __float_as_uint(am), false, false); am = fmaxf(__uint_as_float(r[0]), __uint_as_float(r[1])); }
    { auto r = __builtin_amdgcn_permlane32_swap(__float_as_uint(am), __float_as_uint(am), false, false); am = fmaxf(__uint_as_float(r[0]), __uint_as_float(r[1])); }
    if (F.lane == 0) atomicMax(dst, __float_as_uint(am));
}
template <int MAP>
__device__ __forceinline__ void transpose_fp8(const Frame& F, const float* __restrict__ src, unsigned char* __restrict__ dst, int K, int Nsrc, int Nd, const unsigned* wsc) {
    float mul, inv; fp8_scale(__hip_atomic_load(wsc, __ATOMIC_RELAXED, __HIP_MEMORY_SCOPE_AGENT), mul, inv);
    LAS float* tile = (LAS float*)F.lds;
    const int tk = K / 256, tn = Nd / 64, ntile = tk * tn;
    for (int t = F.bid; t < ntile; t += F.G) {
        const int k0 = (t % tk) * 256, n0 = (t / tk) * 64;
        const int nl = F.tid & 63, kq = F.tid >> 6; const int ns = MAP ? win_col(n0 + nl) : n0 + nl;
        float v[32];
#pragma unroll
        for (int i = 0; i < 32; ++i) v[i] = ns >= 0 ? src[(size_t)(k0 + kq + 8 * i) * Nsrc + ns] : 0.f;
#pragma unroll
        for (int i = 0; i < 32; ++i) tile[(kq + 8 * i) * 65 + nl] = v[i] * mul;
        __syncthreads();
        { const int n = F.tid >> 3, k32 = (F.tid & 7) * 32;
#pragma unroll
          for (int c = 0; c < 2; ++c) { float w[16];
#pragma unroll
              for (int j = 0; j < 16; ++j) w[j] = tile[(k32 + c * 16 + j) * 65 + n];
              u32x4 o; o.x = pk4_fp8(w[0], w[1], w[2], w[3]); o.y = pk4_fp8(w[4], w[5], w[6], w[7]); o.z = pk4_fp8(w[8], w[9], w[10], w[11]); o.w = pk4_fp8(w[12], w[13], w[14], w[15]);
              *(u32x4*)(dst + (size_t)(n0 + n) * K + k0 + k32 + c * 16) = o; } }
        __syncthreads();
    }
}
__device__ __forceinline__ void p0_prologue(const Frame& F) {
    { const int gi = F.bid * 512 + F.tid;
      if (gi < 64 * 8) { const int pos = gi >> 3, f = gi & 7; const float inv = powf(10000.f, -(float)f / 8.f); const float a = (float)pos * inv; wsp<f32x2>(F, WS_ROPE32)[gi] = (f32x2){cosf(a), sinf(a)}; }
      else if (gi < 64 * 8 + 64 * 32) { const int g2 = gi - 512; const int pos = g2 >> 5, f = g2 & 31; const float inv = powf(10000.f, -(float)f / 32.f); const float a = (float)pos * inv; wsp<f32x2>(F, WS_ROPE128)[g2] = (f32x2){cosf(a), sinf(a)}; } }
    if (F.bid == 0 && F.tid < 32) wsp<float>(F, WS_DEC)[F.tid] = -log1pf(expf(-F.in(11)[F.tid])) * LOG2E;
    { LAS float* sl = (LAS float*)F.lds;
      float* modp = wsp<float>(F, WS_MODP);
      for (int u = F.bid; u < 2 * 24 * 16; u += F.G) {
          const int kc = u & 15, cb = (u >> 4) % 24, l = u / (16 * 24);
          __syncthreads();
          for (int i = F.tid; i < 640; i += 512) { const int v = i >> 7, k = kc * 128 + (i & 127); const float c = v < 4 ? F.in(1)[v * 2048 + k] : F.in(3)[k]; sl[i] = silu_f(c); }
          __syncthreads();
          const int col = cb * 512 + F.tid; const float* w = F.in(4) + ((size_t)l * 2048 + kc * 128) * 12288 + col;
          float a0 = 0.f, a1 = 0.f, a2 = 0.f, a3 = 0.f, a4 = 0.f;
#pragma unroll 32
          for (int k = 0; k < 128; ++k) { const float wv = w[(size_t)k * 12288]; a0 += sl[k] * wv; a1 += sl[128 + k] * wv; a2 += sl[256 + k] * wv; a3 += sl[384 + k] * wv; a4 += sl[512 + k] * wv; }
          float* o = modp + ((size_t)(kc * 2 + l) * 5) * 12288 + col;
          o[0] = a0; o[12288] = a1; o[2 * 12288] = a2; o[3 * 12288] = a3; o[4 * 12288] = a4;
      }
      __syncthreads(); }
    for (int l = 0; l < 2; ++l) {
        absmax_f32(F, F.in(6) + (size_t)l * 2048 * NIN, (size_t)2048 * NIN / 4, wsp<unsigned>(F, WS_WSC) + l);
        transpose_cvt<2>(F, F.in(8) + (size_t)l * 512 * 768, wsp<bf16_t>(F, WS_WQUP + l * SZ_WQUP), 512, 768, 768);
        transpose_cvt<0>(F, F.in(10) + (size_t)l * 256 * 1024, wsp<bf16_t>(F, WS_WKVUP + l * SZ_WKVUP), 256, 1024, 1024);
        absmax_f32(F, F.in(14) + (size_t)l * 512 * 2048, (size_t)512 * 2048 / 4, wsp<unsigned>(F, WS_WSC) + 4 + l);
        absmax_f32(F, F.in(15) + (size_t)l * 512 * 2048, (size_t)512 * 2048 / 4, wsp<unsigned>(F, WS_WSC) + 6 + l);
        absmax_f32(F, F.in(16) + (size_t)l * 1024 * 2048, (size_t)1024 * 2048 / 4, wsp<unsigned>(F, WS_WSC) + 8 + l);
        absmax_f32(F, F.in(17) + (size_t)l * 2048 * 2048, (size_t)2048 * 2048 / 4, wsp<unsigned>(F, WS_WSC) + 2 + l);
        transpose_cvt<0>(F, F.in(20) + (size_t)l * 2048 * 1024, wsp<bf16_t>(F, WS_WPQ + l * SZ_WPQ), 2048, 1024, 1024);
    }
    cvt_peer(F, 0);
}
__device__ __forceinline__ void p1_modreduce(const Frame& F) {
    const float* modp = wsp<float>(F, WS_MODP); float* mod = wsp<float>(F, WS_MOD);
    for (int i = F.bid * 512 + F.tid; i < 2 * 5 * 12288; i += F.G * 512) {
        const int j = i % 12288, l = i / (5 * 12288);
        float s = F.in(5)[l * 12288 + j];
#pragma unroll
        for (int kc = 0; kc < 16; ++kc) s += modp[(size_t)kc * (2 * 5 * 12288) + i];
        mod[i] = s;
    }
    for (int l = 0; l < 2; ++l) {
        transpose_fp8<1>(F, F.in(6) + (size_t)l * 2048 * NIN, wsp<unsigned char>(F, WS_WIN + l * SZ_WIN), 2048, NIN, NPT, wsp<unsigned>(F, WS_WSC) + l);
        transpose_fp8<0>(F, F.in(17) + (size_t)l * 2048 * 2048, wsp<unsigned char>(F, WS_WOUT + l * SZ_WOUT), 2048, 2048, 2048, wsp<unsigned>(F, WS_WSC) + 2 + l);
        transpose_fp8<0>(F, F.in(14) + (size_t)l * 512 * 2048, wsp<unsigned char>(F, WS_WBRA + l * SZ_WBRA), 512, 2048, 2048, wsp<unsigned>(F, WS_WSC) + 4 + l);
        transpose_fp8<0>(F, F.in(15) + (size_t)l * 512 * 2048, wsp<unsigned char>(F, WS_WBRB + l * SZ_WBRB), 512, 2048, 2048, wsp<unsigned>(F, WS_WSC) + 6 + l);
        transpose_fp8<0>(F, F.in(16) + (size_t)l * 1024 * 2048, wsp<unsigned char>(F, WS_WBRC + l * SZ_WBRC), 1024, 2048, 2048, wsp<unsigned>(F, WS_WSC) + 8 + l);
    }
}
__device__ __forceinline__ void ld_row_f32(const float* p, int lane, float (&x)[32]) {
#pragma unroll
    for (int q = 0; q < 4; ++q) { const f32x4 a = *(const f32x4*)(p + 512 * q + 8 * lane), b = *(const f32x4*)(p + 512 * q + 8 * lane + 4);
        x[q * 8 + 0] = a[0]; x[q * 8 + 1] = a[1]; x[q * 8 + 2] = a[2]; x[q * 8 + 3] = a[3]; x[q * 8 + 4] = b[0]; x[q * 8 + 5] = b[1]; x[q * 8 + 6] = b[2]; x[q * 8 + 7] = b[3]; }
}
__device__ __forceinline__ void st_row_f32(float* p, int lane, const float (&x)[32]) {
#pragma unroll
    for (int q = 0; q < 4; ++q) { *(f32x4*)(p + 512 * q + 8 * lane) = (f32x4){x[q * 8 + 0], x[q * 8 + 1], x[q * 8 + 2], x[q * 8 + 3]}; *(f32x4*)(p + 512 * q + 8 * lane + 4) = (f32x4){x[q * 8 + 4], x[q * 8 + 5], x[q * 8 + 6], x[q * 8 + 7]}; }
}
__device__ __forceinline__ void st_row_bf16(bf16_t* p, int lane, const float (&x)[32]) {
#pragma unroll
    for (int q = 0; q < 4; ++q) { u32x4 w; w.x = cvt_pk_bf16(x[q * 8 + 0], x[q * 8 + 1]); w.y = cvt_pk_bf16(x[q * 8 + 2], x[q * 8 + 3]); w.z = cvt_pk_bf16(x[q * 8 + 4], x[q * 8 + 5]); w.w = cvt_pk_bf16(x[q * 8 + 6], x[q * 8 + 7]);
        *(u32x4*)(p + 512 * q + 8 * lane) = w; }
}
__device__ __forceinline__ void p_modulate0(const Frame& F) {
    const float* mod = wsp<float>(F, WS_MOD); unsigned char* hb8 = wsp<unsigned char>(F, WS_HB8);
    for (int row = F.bid * 8 + F.wave; row < NROW; row += F.G * 8) {
        const RowInfo ri = rowinfo(row);
        const float* xp = ri.lat ? F.in(0) + (size_t)row * D : F.in(2) + (size_t)(row - NLAT) * D;
        const float* mp = mod + (size_t)ri.v * 12288;
        float x[32], sh[32], sc[32];
        ld_row_f32(xp, F.lane, x); ld_row_f32(mp, F.lane, sh); ld_row_f32(mp + 2048, F.lane, sc);
#pragma unroll
        for (int i = 0; i < 32; ++i) x[i] = clamp8(x[i] * (1.f + sc[i]) + sh[i]);
#pragma unroll
        for (int q = 0; q < 4; ++q) { u32x2 w; w.x = pk4_fp8(x[q * 8 + 0], x[q * 8 + 1], x[q * 8 + 2], x[q * 8 + 3]); w.y = pk4_fp8(x[q * 8 + 4], x[q * 8 + 5], x[q * 8 + 6], x[q * 8 + 7]); *(u32x2*)(hb8 + (size_t)row * D + 512 * q + 8 * F.lane) = w; }
    }
}
__device__ __forceinline__ void p_post(const Frame& F, int l) {
    const bf16_t* P1 = wsp<bf16_t>(F, WS_P1);
    bf16_t* CQN = wsp<bf16_t>(F, WS_CQN); bf16_t* CKVN = wsp<bf16_t>(F, WS_CKVN);
    unsigned char* QG = wsp<unsigned char>(F, WS_QG); unsigned char* KG = wsp<unsigned char>(F, WS_KG); unsigned char* VG = wsp<unsigned char>(F, WS_VG);
    bf16_t* RQ = wsp<bf16_t>(F, WS_RQ); bf16_t* RK = wsp<bf16_t>(F, WS_RK); bf16_t* RV = wsp<bf16_t>(F, WS_RV);
    unsigned char* KM = wsp<unsigned char>(F, WS_KM); unsigned char* QM = wsp<unsigned char>(F, WS_QM);
    const f32x2* cs32 = wsp<f32x2>(F, WS_ROPE32); const f32x2* cs128 = wsp<f32x2>(F, WS_ROPE128);
    const float* gq_n = F.in(7) + l * 512; const float* gkv_n = F.in(9) + l * 256; const float* gqa_qn = F.in(12) + l * 128; const float* gqa_kn = F.in(13) + l * 128;
    LAS bf16_t* rs = (LAS bf16_t*)(F.lds + F.wave * 8192);
    const int lane = F.lane;
    const f32x4 gq0 = *(const f32x4*)(gq_n + lane * 8), gq1 = *(const f32x4*)(gq_n + lane * 8 + 4), gkv0 = *(const f32x4*)(gkv_n + lane * 4);
    const int gd0 = 2 * lane; const int gpart = gd0 >> 6, gdd = gd0 & 63; const bool glo = gdd < 32; const int gf = glo ? gdd : gdd - 32; const int gdp = glo ? gd0 + 32 : gd0 - 32;
    const float qn0 = gqa_qn[gd0], qn1 = gqa_qn[gd0 + 1], qnp0 = gqa_qn[gdp], qnp1 = gqa_qn[gdp + 1];
    const float kn0 = gqa_kn[gd0], kn1 = gqa_kn[gd0 + 1], knp0 = gqa_kn[gdp], knp1 = gqa_kn[gdp + 1];
    const int rhh = lane >> 3, rd0 = (lane & 7) * 4; const int rpart = rd0 >> 4, rdd = rd0 & 15; const bool rlo = rdd < 8; const int rf = rlo ? rdd : rdd - 8; const int rdp = rlo ? rd0 + 8 : rd0 - 8;
    const int step = F.G * 8;
    int row = F.bid * 8 + F.wave;
    u32x4 pre[8];
    if (row < NROW) {
#pragma unroll
        for (int q = 0; q < 8; ++q) pre[q] = *(const u32x4*)(P1 + (size_t)row * NP1 + q * 512 + lane * 8); }
#pragma unroll 1
    for (; row < NROW; row += step) {
        const RowInfo ri = rowinfo(row);
        const int posg = gpart ? ri.pc : ri.pr, posr = rpart ? ri.pc : ri.pr;
        const f32x2 one = {1.f, 0.f};
        const f32x2 csA = ri.lat ? cs128[posg * 32 + gf] : one, csB = ri.lat ? cs128[posg * 32 + gf + 1] : one;
        f32x2 cs[4];
#pragma unroll
        for (int i = 0; i < 4; ++i) cs[i] = ri.lat ? cs32[posr * 8 + rf + i] : one;
#pragma unroll
        for (int q = 0; q < 8; ++q) *(LAS u32x4*)(rs + q * 512 + lane * 8) = pre[q];
        { const int nrow = row + step; if (nrow < NROW) {
#pragma unroll
            for (int q = 0; q < 8; ++q) pre[q] = *(const u32x4*)(P1 + (size_t)nrow * NP1 + q * 512 + lane * 8); } }
        asm volatile("s_waitcnt lgkmcnt(0)" ::: "memory");
        { float x[8]; float ss = 0.f;
#pragma unroll
          for (int i = 0; i < 8; ++i) { x[i] = bf2f(rs[C_CQ + lane * 8 + i]); ss += x[i] * x[i]; }
          ss = wave_sum(ss); const float r = rsqrtf(ss * (1.f / 512.f) + RMS_EPS);
          *(u32x4*)(CQN + (size_t)row * 512 + lane * 8) = pack8((f32x4){x[0] * r * gq0[0], x[1] * r * gq0[1], x[2] * r * gq0[2], x[3] * r * gq0[3]}, (f32x4){x[4] * r * gq1[0], x[5] * r * gq1[1], x[6] * r * gq1[2], x[7] * r * gq1[3]}); }
        { float x[4]; float ss = 0.f;
#pragma unroll
          for (int i = 0; i < 4; ++i) { x[i] = bf2f(rs[C_CKV + lane * 4 + i]); ss += x[i] * x[i]; }
          ss = wave_sum(ss); const float r = rsqrtf(ss * (1.f / 256.f) + RMS_EPS);
          u32x2 w; w.x = cvt_pk_bf16(x[0] * r * gkv0[0], x[1] * r * gkv0[1]); w.y = cvt_pk_bf16(x[2] * r * gkv0[2], x[3] * r * gkv0[3]);
          *(u32x2*)(CKVN + (size_t)row * 256 + lane * 4) = w; }
        {
            const int d0 = gd0, dp = gdp; const bool lo = glo;
#pragma unroll 1
            for (int hh = 0; hh < 10; ++hh) {
                const bool isq = hh < 8; const int cbase = isq ? C_GQ + hh * 128 : C_GK + (hh - 8) * 128;
                const float g0 = isq ? qn0 : kn0, g1 = isq ? qn1 : kn1, gp0 = isq ? qnp0 : knp0, gp1 = isq ? qnp1 : knp1;
                const float a0 = bf2f(rs[cbase + d0]), a1 = bf2f(rs[cbase + d0 + 1]);
                float ss = wave_sum(a0 * a0 + a1 * a1); const float r = rsqrtf(ss * (1.f / 128.f) + RMS_EPS);
                const float n0 = a0 * r * g0, n1 = a1 * r * g1;
                const float p0 = bf2f(rs[cbase + dp]) * r * gp0, p1 = bf2f(rs[cbase + dp + 1]) * r * gp1;
                float o0, o1;
                if (lo) { o0 = n0 * csA.x - p0 * csA.y; o1 = n1 * csB.x - p1 * csB.y; }
                else    { o0 = p0 * csA.y + n0 * csA.x; o1 = p1 * csB.y + n1 * csB.x; }
                unsigned char* dst = isq ? QG + ((size_t)(ri.b * 8 + hh) * TT + ri.tpos) * 128 : KG + ((size_t)(ri.b * 2 + (hh - 8)) * TT + ri.tpos) * 128;
                *(unsigned short*)(dst + d0) = (unsigned short)(pk4_fp8(clamp8(o0), clamp8(o1), 0.f, 0.f) & 0xffffu);
            }
#pragma unroll
            for (int hh = 0; hh < 2; ++hh) { const unsigned w8_ = pk4_fp8(clamp8(bf2f(rs[C_GV + hh * 128 + d0])), clamp8(bf2f(rs[C_GV + hh * 128 + d0 + 1])), 0.f, 0.f); unsigned char* vp_ = VG + ((size_t)(ri.b * 2 + hh) * 128 + d0) * TT + vt_off(ri.tpos);
                vp_[0] = (unsigned char)(w8_ & 0xffu); vp_[TT] = (unsigned char)((w8_ >> 8) & 0xffu); }
        }
        {
            const int hh = rhh, d0 = rd0, dp = rdp; const bool lo = rlo;
#pragma unroll
            for (int which = 0; which < 2; ++which) {
                const int cbase = (which ? C_RK : C_RQ) + hh * 32; const float sc = which ? 0.17677669529663687f : 1.f;
                float o[4];
#pragma unroll
                for (int i = 0; i < 4; ++i) { const float n = bf2f(rs[cbase + d0 + i]), p = bf2f(rs[cbase + dp + i]);
                    o[i] = (lo ? (n * cs[i].x - p * cs[i].y) : (p * cs[i].y + n * cs[i].x)) * sc; }
                u32x2 w; w.x = cvt_pk_bf16(o[0], o[1]); w.y = cvt_pk_bf16(o[2], o[3]);
                *(u32x2*)((which ? RK : RQ) + ((size_t)(ri.b * 8 + hh) * TT + ri.tpos) * 32 + d0) = w;
            }
            { const int vh = lane >> 3, e0 = (lane & 7) * 8;
              *(u32x4*)(RV + ((size_t)(ri.b * 8 + vh) * TT + ri.tpos) * 64 + e0) = *(LAS u32x4*)(rs + C_RV + lane * 8); }
            { float o[4];
#pragma unroll
              for (int i = 0; i < 4; ++i) { const float n = bf2f(rs[C_KR + d0 + i]), p = bf2f(rs[C_KR + dp + i]); o[i] = lo ? (n * cs[i].x - p * cs[i].y) : (p * cs[i].y + n * cs[i].x); }
              const size_t tok_ = ((size_t)(ri.b * 8 + hh) * TT + ri.tpos) * 128;
              *(unsigned*)(KM + tok_ + 64 + d0) = pk4_fp8(clamp8(o[0]), clamp8(o[1]), clamp8(o[2]), clamp8(o[3]));
              *(unsigned*)(KM + tok_ + 96 + d0) = 0u; *(unsigned*)(QM + tok_ + 96 + d0) = 0u; }
        }
        asm volatile("s_waitcnt lgkmcnt(0)" ::: "memory");
    }
}

__device__ __forceinline__ void ret_logs(const Frame& F, int l, int h, float& lgf, float& lgb) {
    const float* t = wsp<float>(F, WS_DEC); lgf = t[(l * 2 + 0) * 8 + h]; lgb = t[(l * 2 + 1) * 8 + h];
}
constexpr int TP = 136;
template <bool WITH_K>
__device__ __forceinline__ void ret_stage(const Frame& F, const bf16_t* RKh, const bf16_t* RVh, int tpos0, float lgf, float lgb, LAS bf16_t* vt, LAS bf16_t* ktf, LAS bf16_t* ktb) {
#pragma unroll
    for (int i = 0; i < 2; ++i) { const int tok = (F.tid >> 3) + 64 * i, e0 = (F.tid & 7) * 8;
        const u32x4 w = *(const u32x4*)(RVh + (size_t)(tpos0 + tok) * 64 + e0); const unsigned ww[4] = {w.x, w.y, w.z, w.w};
#pragma unroll
        for (int j = 0; j < 4; ++j) { vt[(e0 + 2 * j) * TP + tok] = (bf16_t)(ww[j] & 0xffffu); vt[(e0 + 2 * j + 1) * TP + tok] = (bf16_t)(ww[j] >> 16); } }
    if (WITH_K) { const int tok = F.tid >> 2, k0 = (F.tid & 3) * 8;
        const u32x4 w = *(const u32x4*)(RKh + (size_t)(tpos0 + tok) * 32 + k0); const unsigned ww[4] = {w.x, w.y, w.z, w.w};
        const float zf = exp2f(lgf * (float)(127 - tok)), zb = exp2f(lgb * (float)tok);
#pragma unroll
        for (int j = 0; j < 4; ++j) { const float a = bflo(ww[j]), b = bfhi(ww[j]);
            ktf[(k0 + 2 * j) * TP + tok] = f2bf(a * zf); ktf[(k0 + 2 * j + 1) * TP + tok] = f2bf(b * zf);
            ktb[(k0 + 2 * j) * TP + tok] = f2bf(a * zb); ktb[(k0 + 2 * j + 1) * TP + tok] = f2bf(b * zb); } }
}
__device__ __forceinline__ void p_ret_states(const Frame& F, int l) {
    LAS bf16_t* vt = (LAS bf16_t*)F.lds; LAS bf16_t* ktf = vt + 64 * TP; LAS bf16_t* ktb = ktf + 32 * TP;
    float* ST = wsp<float>(F, WS_ST);
    const int lane = F.lane, w = F.wave, kb = w >> 2, eb = w & 3, fr = lane & 15, fq = lane >> 4;
    for (int u = F.bid; u < NB * 8 * 34; u += F.G) {
        const int c = u % 34, bh = u / 34, h = bh & 7;
        float lgf, lgb; ret_logs(F, l, h, lgf, lgb);
        __syncthreads();
        ret_stage<true>(F, wsp<bf16_t>(F, WS_RK) + (size_t)bh * TT * 32, wsp<bf16_t>(F, WS_RV) + (size_t)bh * TT * 64, c * 128, lgf, lgb, vt, ktf, ktb);
        __syncthreads();
        f32x4 sf = {0.f, 0.f, 0.f, 0.f}, sb = {0.f, 0.f, 0.f, 0.f};
#pragma unroll
        for (int ks = 0; ks < 4; ++ks) {
            const bf16x8 bv = *(const LAS bf16x8*)(vt + (eb * 16 + fr) * TP + ks * 32 + fq * 8);
            const bf16x8 af = *(const LAS bf16x8*)(ktf + (kb * 16 + fr) * TP + ks * 32 + fq * 8);
            const bf16x8 ab = *(const LAS bf16x8*)(ktb + (kb * 16 + fr) * TP + ks * 32 + fq * 8);
            sf = __builtin_amdgcn_mfma_f32_16x16x32_bf16(af, bv, sf, 0, 0, 0);
            sb = __builtin_amdgcn_mfma_f32_16x16x32_bf16(ab, bv, sb, 0, 0, 0);
        }
        float* o = ST + (size_t)u * 2 * 2048;
#pragma unroll
        for (int r = 0; r < 4; ++r) { const int kd = kb * 16 + fq * 4 + r, e = eb * 16 + fr; o[kd * 64 + e] = sf[r]; o[2048 + kd * 64 + e] = sb[r]; }
    }
}
constexpr int RP = 40;
constexpr int AP = 136;
__device__ __forceinline__ void ret_out_unit(const Frame& F, int l, int bh, int c) {
    LAS bf16_t* vt = (LAS bf16_t*)F.lds; LAS bf16_t* rtf = vt + 64 * TP; LAS bf16_t* rtb = rtf + 64 * RP; LAS bf16_t* as = rtb + 64 * RP + F.wave * 16 * AP;
    const int lane = F.lane, w = F.wave, fr = lane & 15, fq = lane >> 4, h = bh & 7, b = bh >> 3;
    const bf16_t* RQh = wsp<bf16_t>(F, WS_RQ) + (size_t)bh * TT * 32; const bf16_t* RKh = wsp<bf16_t>(F, WS_RK) + (size_t)bh * TT * 32; const bf16_t* RVh = wsp<bf16_t>(F, WS_RV) + (size_t)bh * TT * 64;
    const float* STh = wsp<float>(F, WS_ST) + (size_t)bh * 34 * 2 * 2048;
    float lgf, lgb; ret_logs(F, l, h, lgf, lgb);
    const int tpos0 = c * 128;
    __syncthreads();
    ret_stage<false>(F, RKh, RVh, tpos0, lgf, lgb, vt, nullptr, nullptr);
    { const int kd = F.tid >> 4, e4 = (F.tid & 15) * 4; f32x4 rf = {0.f, 0.f, 0.f, 0.f}, rb = {0.f, 0.f, 0.f, 0.f};
      if (c >= 2) {
          for (int cp = 0; cp < c; ++cp) { const float e2 = lgf * 128.f * (float)(c - 1 - cp); if (e2 < -80.f) continue; const float wgt = exp2f(e2);
              rf += *(const f32x4*)(STh + (size_t)(cp * 2 + 0) * 2048 + kd * 64 + e4) * wgt; }
          const int p = c - 2;
          for (int pp = p + 1; pp < 34; ++pp) { const float e2 = lgb * 128.f * (float)(pp - p - 1); if (e2 < -80.f) break; const float wgt = exp2f(e2); const int cs = pp < 32 ? pp + 2 : pp - 32;
              rb += *(const f32x4*)(STh + (size_t)(cs * 2 + 1) * 2048 + kd * 64 + e4) * wgt; }
      } else if (c == 0) { rb = *(const f32x4*)(STh + (size_t)(1 * 2 + 1) * 2048 + kd * 64 + e4); }
      else { rf = *(const f32x4*)(STh + (size_t)(0 * 2 + 0) * 2048 + kd * 64 + e4); }
#pragma unroll
      for (int j = 0; j < 4; ++j) { rtf[(e4 + j) * RP + kd] = f2bf(rf[j]); rtb[(e4 + j) * RP + kd] = f2bf(rb[j]); } }
    const int i0 = w * 16;
    const bf16x8 qa = *(const bf16x8*)(RQh + (size_t)(tpos0 + i0 + fr) * 32 + fq * 8);
    f32x4 s[8];
#pragma unroll
    for (int nb = 0; nb < 8; ++nb) { const bf16x8 kf = *(const bf16x8*)(RKh + (size_t)(tpos0 + nb * 16 + fr) * 32 + fq * 8);
        s[nb] = __builtin_amdgcn_mfma_f32_16x16x32_bf16(qa, kf, (f32x4){0.f, 0.f, 0.f, 0.f}, 0, 0, 0); }
#pragma unroll
    for (int nb = 0; nb < 8; ++nb)
#pragma unroll
        for (int r = 0; r < 4; ++r) { const int i = i0 + fq * 4 + r, j = nb * 16 + fr; const int df = i - j;
            const float mk = df > 0 ? exp2f(lgf * (float)df) : (df < 0 ? exp2f(lgb * (float)(-df)) : 2.f);
            as[(fq * 4 + r) * AP + j] = f2bf(s[nb][r] * mk); }
    __syncthreads();
    f32x4 y[4];
#pragma unroll
    for (int eb = 0; eb < 4; ++eb) y[eb] = (f32x4){0.f, 0.f, 0.f, 0.f};
#pragma unroll
    for (int ks = 0; ks < 4; ++ks) { const bf16x8 af = *(const LAS bf16x8*)(as + fr * AP + ks * 32 + fq * 8);
#pragma unroll
        for (int eb = 0; eb < 4; ++eb) { const bf16x8 bv = *(const LAS bf16x8*)(vt + (eb * 16 + fr) * TP + ks * 32 + fq * 8);
            y[eb] = __builtin_amdgcn_mfma_f32_16x16x32_bf16(af, bv, y[eb], 0, 0, 0); } }
    { const float xf = exp2f(lgf * (float)(i0 + fr + 1)), xb = exp2f(lgb * (float)(128 - (i0 + fr)));
      bf16x8 qf, qb;
#pragma unroll
      for (int j = 0; j < 8; ++j) { const float qv = bf2f((bf16_t)qa[j]); qf[j] = (short)f2bf(qv * xf); qb[j] = (short)f2bf(qv * xb); }
#pragma unroll
      for (int eb = 0; eb < 4; ++eb) { const bf16x8 bf_ = *(const LAS bf16x8*)(rtf + (eb * 16 + fr) * RP + fq * 8), bb_ = *(const LAS bf16x8*)(rtb + (eb * 16 + fr) * RP + fq * 8);
          y[eb] = __builtin_amdgcn_mfma_f32_16x16x32_bf16(qf, bf_, y[eb], 0, 0, 0);
          y[eb] = __builtin_amdgcn_mfma_f32_16x16x32_bf16(qb, bb_, y[eb], 0, 0, 0); } }
    const bf16_t* P1 = wsp<bf16_t>(F, WS_P1); unsigned char* OAB = wsp<unsigned char>(F, WS_OAB);
#pragma unroll
    for (int r = 0; r < 4; ++r) {
        float sm = y[0][r] + y[1][r] + y[2][r] + y[3][r]; sm = row16_sum(sm); const float mu = sm * (1.f / 64.f);
        float vs = 0.f;
#pragma unroll
        for (int eb = 0; eb < 4; ++eb) { const float d = y[eb][r] - mu; vs += d * d; }
        vs = row16_sum(vs); const float rstd = rsqrtf(vs * (1.f / 64.f) + LN_EPS);
        const int i = i0 + fq * 4 + r; const int tp = tpos0 + i; const size_t grow = tp >= CTXL ? (size_t)b * SEQ + (tp - CTXL) : (size_t)NLAT + b * CTXL + tp;
#pragma unroll
        for (int eb = 0; eb < 4; ++eb) { const int e = eb * 16 + fr; const float g = bf2f(P1[grow * NP1 + C_RG + h * 64 + e]);
            OAB[grow * D + 512 + h * 64 + e] = (unsigned char)(pk4_fp8(clamp8(silu_f(g) * (y[eb][r] - mu) * rstd * 16.f), 0.f, 0.f, 0.f) & 0xffu); }
    }
}
namespace att {
constexpr int NW = 8, QBLK = 32, KVBLK = 64;
constexpr size_t SHM_V = KVBLK * 128 * 2, SHM_K = KVBLK * 128 * 2, SHM_ATTN = 2 * SHM_V + 2 * SHM_K + NW * 64 * 4;
constexpr float THR = 0.5f;
#define KSWZ(row, colB) ((row) * 256 + ((colB) ^ (((row) & 7) << 4)))
#define SBAR() __builtin_amdgcn_sched_barrier(0)
__device__ __forceinline__ int crow(int r, int hi) { return (r & 3) + 8 * (r >> 2) + 4 * hi; }
template <int SC> struct Scale { static constexpr float S = SC == 0 ? 0.08838834764831845f : 0.10206207261596575f; static constexpr float C = S * 1.4426950408889634f; static constexpr float THRR = THR / S; };
template <int SC>
__device__ __forceinline__ void partialSM(f32x16& p0, f32x16& p1, float& m_reg, float& mn, float& alpha) {
  constexpr float C = Scale<SC>::C, thr_raw = Scale<SC>::THRR;
  float pmax = p0[0];
#pragma unroll
  for (int r = 1; r < 16; ++r) pmax = fmaxf(pmax, p0[r]);
#pragma unroll
  for (int r = 0; r < 16; ++r) pmax = fmaxf(pmax, p1[r]);
  { auto rr = __builtin_amdgcn_permlane32_swap(__float_as_uint(pmax), __float_as_uint(pmax), false, false);
    pmax = fmaxf(__uint_as_float(rr[0]), __uint_as_float(rr[1])); }
  if (__builtin_expect(__all(pmax - m_reg <= thr_raw), 1)) { mn = m_reg; alpha = 1.f; }
  else { mn = fmaxf(m_reg, pmax); alpha = __builtin_amdgcn_exp2f((m_reg - mn) * C); m_reg = mn; }
  const float mnC = -mn * C;
#pragma unroll
  for (int r = 0; r < 16; ++r) p0[r] = fmaf(p0[r], C, mnC);
#pragma unroll
  for (int r = 0; r < 16; ++r) p1[r] = fmaf(p1[r], C, mnC);
#pragma unroll
  for (int r = 0; r < 16; ++r) p0[r] = __builtin_amdgcn_exp2f(p0[r]);
}
__device__ __forceinline__ void finishSM(f32x16& p0, f32x16& p1, float alpha, float& l_reg, bf16x8& pa0, bf16x8& pa1, bf16x8& pa2, bf16x8& pa3) {
#pragma unroll
  for (int r = 0; r < 16; ++r) p1[r] = __builtin_amdgcn_exp2f(p1[r]);
  float ps = 0;
#pragma unroll
  for (int r = 0; r < 16; ++r) ps += p0[r];
#pragma unroll
  for (int r = 0; r < 16; ++r) ps += p1[r];
  { auto rr = __builtin_amdgcn_permlane32_swap(__float_as_uint(ps), __float_as_uint(ps), false, false);
    ps = __uint_as_float(rr[0]) + __uint_as_float(rr[1]); }
  l_reg = l_reg * alpha + ps;
#define PK4(P, BASE, OUT) do { unsigned a0 = cvt_pk_bf16(P[BASE + 0], P[BASE + 1]), a1 = cvt_pk_bf16(P[BASE + 2], P[BASE + 3]);   \
    unsigned b0 = cvt_pk_bf16(P[BASE + 4], P[BASE + 5]), b1 = cvt_pk_bf16(P[BASE + 6], P[BASE + 7]);                              \
    auto r0 = __builtin_amdgcn_permlane32_swap(a0, b0, false, false); auto r1 = __builtin_amdgcn_permlane32_swap(a1, b1, false, false); \
    u32x4 w = {r0[0], r1[0], r0[1], r1[1]}; OUT = *reinterpret_cast<bf16x8*>(&w); } while (0)
  PK4(p0, 0, pa0); PK4(p0, 8, pa1); PK4(p1, 0, pa2); PK4(p1, 8, pa3);
#undef PK4
}
typedef int i32x8a __attribute__((ext_vector_type(8))); typedef int i32x4a __attribute__((ext_vector_type(4)));
__device__ __forceinline__ void finishSM8(f32x16& p0, f32x16& p1, float alpha, float& l_reg, i32x8a& pa) {
#pragma unroll
  for (int r = 0; r < 16; ++r) p1[r] = __builtin_amdgcn_exp2f(p1[r]);
  float ps = 0;
#pragma unroll
  for (int r = 0; r < 16; ++r) ps += p0[r];
#pragma unroll
  for (int r = 0; r < 16; ++r) ps += p1[r];
  { auto rr = __builtin_amdgcn_permlane32_swap(__float_as_uint(ps), __float_as_uint(ps), false, false);
    ps = __uint_as_float(rr[0]) + __uint_as_float(rr[1]); }
  l_reg = l_reg * alpha + ps;
#pragma unroll
  for (int q = 0; q < 4; ++q) { pa[q] = (int)pk4_fp8(p0[4 * q] * 256.f, p0[4 * q + 1] * 256.f, p0[4 * q + 2] * 256.f, p0[4 * q + 3] * 256.f); pa[4 + q] = (int)pk4_fp8(p1[4 * q] * 256.f, p1[4 * q + 1] * 256.f, p1[4 * q + 2] * 256.f, p1[4 * q + 3] * 256.f); }
}
#define VSWZ8(col, chunk) ((col) * 64 + ((((chunk) ^ (((col) >> 2) & 3))) << 4))
template <int NDV> __device__ __forceinline__ void pv8(f32x16* o, const char* Vs, const i32x8a pa, int r32, int hi) {
#pragma unroll
  for (int d0 = 0; d0 < NDV; ++d0) { const int col = d0 * 32 + r32;
    const i32x4a lo_ = *reinterpret_cast<const i32x4a*>(Vs + VSWZ8(col, 2 * hi)), hi_ = *reinterpret_cast<const i32x4a*>(Vs + VSWZ8(col, 2 * hi + 1));
    o[d0] = __builtin_amdgcn_mfma_scale_f32_32x32x64_f8f6f4(pa, __builtin_shufflevector(lo_, hi_, 0, 1, 2, 3, 4, 5, 6, 7), o[d0], 0, 0, 0, 0x7F7F7F7F, 0, 0x7F7F7F7F); }
}
template <int NDQ>
__device__ __forceinline__ void qkt(f32x16& p0, f32x16& p1, const char* Ks, const bf16x8* qr, int r32, int hi) {
  p0 = f32x16{}; p1 = f32x16{};
#pragma unroll
  for (int d0 = 0; d0 < NDQ; ++d0) { const int cb = (d0 * 16 + hi * 8) * 2;
    const bf16x8 b0 = *reinterpret_cast<const bf16x8*>(Ks + KSWZ(r32, cb));
    const bf16x8 b1 = *reinterpret_cast<const bf16x8*>(Ks + KSWZ(32 + r32, cb));
    p0 = __builtin_amdgcn_mfma_f32_32x32x16_bf16(b0, qr[d0], p0, 0, 0, 0);
    p1 = __builtin_amdgcn_mfma_f32_32x32x16_bf16(b1, qr[d0], p1, 0, 0, 0); }
}
#define KSWZ8(row, chunk) ((row) * 128 + ((((chunk) ^ ((row) & 7))) << 4))
__device__ __forceinline__ void qkt8(f32x16& p0, f32x16& p1, const char* Ks, const i32x8a* qr8, int r32, int hi) {
  p0 = f32x16{}; p1 = f32x16{};
#pragma unroll
  for (int blk = 0; blk < 2; ++blk) { const int c0 = blk * 4 + 2 * hi;
    const i32x4a a0 = *reinterpret_cast<const i32x4a*>(Ks + KSWZ8(r32, c0)), a1 = *reinterpret_cast<const i32x4a*>(Ks + KSWZ8(r32, c0 + 1));
    const i32x4a b0 = *reinterpret_cast<const i32x4a*>(Ks + KSWZ8(32 + r32, c0)), b1 = *reinterpret_cast<const i32x4a*>(Ks + KSWZ8(32 + r32, c0 + 1));
    p0 = __builtin_amdgcn_mfma_scale_f32_32x32x64_f8f6f4(__builtin_shufflevector(a0, a1, 0, 1, 2, 3, 4, 5, 6, 7), qr8[blk], p0, 0, 0, 0, 0x7F7F7F7F, 0, 0x7F7F7F7F);
    p1 = __builtin_amdgcn_mfma_scale_f32_32x32x64_f8f6f4(__builtin_shufflevector(b0, b1, 0, 1, 2, 3, 4, 5, 6, 7), qr8[blk], p1, 0, 0, 0, 0x7F7F7F7F, 0, 0x7F7F7F7F); }
}
__device__ __forceinline__ int v_st(int k, int c) { const int kk = (k & ~0xC) | ((k & 4) << 1) | ((k & 8) >> 1); return ((kk >> 3) * 4 + (c >> 5)) * 512 + ((kk & 7) * 32 + (c & 31)) * 2; }
__device__ __forceinline__ int v_rd_base(int lane) { return ((lane & 3) << 3) | (((lane >> 2) & 3) << 6) | (((lane >> 4) & 1) << 5) | (((lane >> 5) & 1) << 8); }
constexpr int v_rd_off(int d0, int ks, int half) { return d0 * 512 + ks * 4096 + half * 2048; }
template <int OFF> __device__ __forceinline__ s16x4 tr_read(int vb) {
  s16x4 r; asm volatile("ds_read_b64_tr_b16 %0, %1 offset:%2" : "=&v"(r) : "v"(vb), "i"(OFF) : "memory"); return r;
}
template <int D0> __device__ __forceinline__ void pv_one(f32x16& od, int vb, bf16x8 pa0, bf16x8 pa1, bf16x8 pa2, bf16x8 pa3) {
  const s16x4 l0 = tr_read<v_rd_off(D0, 0, 0)>(vb), h0 = tr_read<v_rd_off(D0, 0, 1)>(vb), l1 = tr_read<v_rd_off(D0, 1, 0)>(vb), h1 = tr_read<v_rd_off(D0, 1, 1)>(vb);
  const s16x4 l2 = tr_read<v_rd_off(D0, 2, 0)>(vb), h2 = tr_read<v_rd_off(D0, 2, 1)>(vb), l3 = tr_read<v_rd_off(D0, 3, 0)>(vb), h3 = tr_read<v_rd_off(D0, 3, 1)>(vb);
  asm volatile("s_waitcnt lgkmcnt(0)" ::: "memory"); SBAR();
#define PK(L, H) (bf16x8){L[0], L[1], L[2], L[3], H[0], H[1], H[2], H[3]}
  od = __builtin_amdgcn_mfma_f32_32x32x16_bf16(pa0, PK(l0, h0), od, 0, 0, 0);
  od = __builtin_amdgcn_mfma_f32_32x32x16_bf16(pa1, PK(l1, h1), od, 0, 0, 0);
  od = __builtin_amdgcn_mfma_f32_32x32x16_bf16(pa2, PK(l2, h2), od, 0, 0, 0);
  od = __builtin_amdgcn_mfma_f32_32x32x16_bf16(pa3, PK(l3, h3), od, 0, 0, 0);
#undef PK
}
template <int NDV> __device__ __forceinline__ void pv_d0(f32x16* o, int vb, bf16x8 pa0, bf16x8 pa1, bf16x8 pa2, bf16x8 pa3) {
  pv_one<0>(o[0], vb, pa0, pa1, pa2, pa3); pv_one<1>(o[1], vb, pa0, pa1, pa2, pa3);
  if constexpr (NDV == 4) { pv_one<2>(o[2], vb, pa0, pa1, pa2, pa3); pv_one<3>(o[3], vb, pa0, pa1, pa2, pa3); }
}
template <int NDQ, int NDV, int SC, int SDEPTH>
__device__ __forceinline__ void attn_body(const unsigned char* __restrict__ Qb, const unsigned char* __restrict__ Kh, const unsigned char* __restrict__ Vt,
                                          unsigned char* __restrict__ Ob, int seq, char* lds, const int tid) {
  constexpr int ldo = 2048;
  const int wid = tid >> 6, lane = tid & 63, r32 = lane & 31, hi = lane >> 5;
  char* V_lds = lds; char* K_lds = lds + 2 * SHM_V;
  float* ws = (float*)(lds + 2 * SHM_V + 2 * SHM_K) + wid * 64; float* li_l = ws; float* al_l = ws + 32;
  float m_reg = -1e30f, l_reg = 0; f32x16 o[NDV] = {}; i32x8a qr8[2];
  const unsigned char* Qw = Qb + (long)(wid * QBLK + r32) * 128 + hi * 32;
#pragma unroll
  for (int blk = 0; blk < 2; ++blk) { const i32x4a lo_ = *reinterpret_cast<const i32x4a*>(Qw + blk * 64), hi_ = *reinterpret_cast<const i32x4a*>(Qw + blk * 64 + 16); qr8[blk] = __builtin_shufflevector(lo_, hi_, 0, 1, 2, 3, 4, 5, 6, 7); }
  const int kr8 = tid >> 3, kc8 = tid & 7;
  const int vcol = tid >> 2, vch = tid & 3; const bool vact = vcol < NDV * 32;
  struct { i32x4a vs0, ks0; } sr_[SDEPTH];
#define SLOAD(i, k0) do { if (vact) sr_[i].vs0 = *reinterpret_cast<const i32x4a*>(Vt + (long)vcol * TT + (k0) + vch * 16); \
    sr_[i].ks0 = *reinterpret_cast<const i32x4a*>(Kh + (long)((k0) + kr8) * 128 + kc8 * 16); } while (0)
#define SWRITE(b, i) do { if (vact) *(i32x4a*)(V_lds + (b) * SHM_V + VSWZ8(vcol, vch)) = sr_[i].vs0;          \
    *(i32x4a*)(K_lds + (b) * SHM_K + KSWZ8(kr8, kc8)) = sr_[i].ks0; } while (0)
#define SWAIT() do { if constexpr (SDEPTH == 1) asm volatile("s_waitcnt vmcnt(0)" ::: "memory"); else asm volatile("s_waitcnt vmcnt(2)" ::: "memory"); } while (0)
#define RESC(a) do { if (__any((a) < 1.f)) { if (hi == 0) al_l[r32] = (a); asm volatile("s_waitcnt lgkmcnt(0)" ::: "memory"); \
    _Pragma("unroll") for (int d = 0; d < NDV; ++d) _Pragma("unroll") for (int r = 0; r < 16; ++r) o[d][r] *= al_l[crow(r, hi)]; } } while (0)
  f32x16 pA0, pA1, pB0, pB1; float mnA, mnB, alA, alB; i32x8a pa; const int NT = seq / KVBLK;
  constexpr int SE = 0, SO = SDEPTH - 1;
  SLOAD(SE, 0); asm volatile("s_waitcnt vmcnt(0)" ::: "memory"); SWRITE(0, SE); __syncthreads();
  qkt8(pA0, pA1, K_lds, qr8, r32, hi); partialSM<SC>(pA0, pA1, m_reg, mnA, alA);
  SLOAD(SO, KVBLK); if constexpr (SDEPTH == 2) { if (2 < NT) SLOAD(SE, 2 * KVBLK); }
  SWAIT(); SWRITE(1, SO); __syncthreads();
  for (int j = 1; j + 1 < NT; j += 2) {
    SBAR(); qkt8(pB0, pB1, K_lds + SHM_K, qr8, r32, hi);
    finishSM8(pA0, pA1, alA, l_reg, pa); SBAR();
    SLOAD(SO, (j + SDEPTH) * KVBLK); SBAR();
    pv8<NDV>(o, V_lds, pa, r32, hi); partialSM<SC>(pB0, pB1, m_reg, mnB, alB);
    __syncthreads(); SWAIT(); SWRITE(0, SE);
    RESC(alB); __syncthreads();
    SBAR(); qkt8(pA0, pA1, K_lds, qr8, r32, hi);
    finishSM8(pB0, pB1, alB, l_reg, pa); SBAR();
    if (SDEPTH == 1 || j + 3 < NT) SLOAD(SE, (j + 1 + SDEPTH) * KVBLK); SBAR();
    pv8<NDV>(o, V_lds + SHM_V, pa, r32, hi); partialSM<SC>(pA0, pA1, m_reg, mnA, alA);
    __syncthreads(); SWAIT(); SWRITE(1, SO);
    RESC(alA); __syncthreads();
  }
  SBAR(); qkt8(pB0, pB1, K_lds + SHM_K, qr8, r32, hi);
  finishSM8(pA0, pA1, alA, l_reg, pa); SBAR();
  pv8<NDV>(o, V_lds, pa, r32, hi); partialSM<SC>(pB0, pB1, m_reg, mnB, alB);
  __syncthreads(); RESC(alB);
  finishSM8(pB0, pB1, alB, l_reg, pa); SBAR();
  pv8<NDV>(o, V_lds + SHM_V, pa, r32, hi);
  if (hi == 0) li_l[r32] = l_reg; asm volatile("s_waitcnt lgkmcnt(0)" ::: "memory");
  float rli[16];
#pragma unroll
  for (int r = 0; r < 16; ++r) rli[r] = __builtin_amdgcn_rcpf(li_l[crow(r, hi)]);
  unsigned char* Ow = Ob + (long)(wid * QBLK) * ldo;
#pragma unroll
  for (int r = 0; r < 16; ++r) { const int orow = crow(r, hi);
#pragma unroll
    for (int d0 = 0; d0 < NDV; ++d0) Ow[(long)orow * ldo + d0 * 32 + r32] = (unsigned char)(pk4_fp8(clamp8(o[d0][r] * rli[r] * (16.f / 256.f)), 0.f, 0.f, 0.f) & 0xffu); }
#undef SLOAD
#undef SWRITE
#undef SWAIT
#undef RESC
}
}
__device__ __forceinline__ float* xres_row(const Frame& F, int row) { return row < NLAT ? F.out + (size_t)row * D : wsp<float>(F, WS_XC) + (size_t)(row - NLAT) * D; }
__device__ __forceinline__ void ln_row(float (&y)[32], const float* g, const float* b, int lane) {
    float s = 0.f;
#pragma unroll
    for (int i = 0; i < 32; ++i) s += y[i];
    const float mu = wave_sum(s) * (1.f / 2048.f);
    float q = 0.f;
#pragma unroll
    for (int i = 0; i < 32; ++i) { const float d = y[i] - mu; q += d * d; }
    const float rstd = rsqrtf(wave_sum(q) * (1.f / 2048.f) + LN_EPS);
#pragma unroll
    for (int qq = 0; qq < 4; ++qq) { const f32x4 g0 = *(const f32x4*)(g + 512 * qq + 8 * lane), g1 = *(const f32x4*)(g + 512 * qq + 8 * lane + 4), b0 = *(const f32x4*)(b + 512 * qq + 8 * lane), b1 = *(const f32x4*)(b + 512 * qq + 8 * lane + 4);
#pragma unroll
        for (int i = 0; i < 4; ++i) { y[qq * 8 + i] = (y[qq * 8 + i] - mu) * rstd * g0[i] + b0[i]; y[qq * 8 + 4 + i] = (y[qq * 8 + 4 + i] - mu) * rstd * g1[i] + b1[i]; } }
}
__device__ __forceinline__ void modulate_store(const float (&x)[32], const float* sh, const float* sc, bf16_t* dst, int lane) {
#pragma unroll
    for (int q = 0; q < 4; ++q) { const f32x4 h0 = *(const f32x4*)(sh + 512 * q + 8 * lane), h1 = *(const f32x4*)(sh + 512 * q + 8 * lane + 4), c0 = *(const f32x4*)(sc + 512 * q + 8 * lane), c1 = *(const f32x4*)(sc + 512 * q + 8 * lane + 4);
        f32x4 a, b;
#pragma unroll
        for (int i = 0; i < 4; ++i) { a[i] = x[q * 8 + i] * (1.f + c0[i]) + h0[i]; b[i] = x[q * 8 + 4 + i] * (1.f + c1[i]) + h1[i]; }
        *(u32x4*)(dst + 512 * q + 8 * lane) = pack8(a, b); }
}
__device__ __forceinline__ void p_ln1(const Frame& F, int l, bool last) {
    const float* mod = wsp<float>(F, WS_MOD) + (size_t)l * 5 * 12288; bf16_t* hb = wsp<bf16_t>(F, WS_HB);
    const float* g = F.in(18) + l * D; const float* b = F.in(19) + l * D;
    const int nrows = last ? NLAT : NROW; const int lane = F.lane, step = F.G * 8;
    float gg[32], bb[32]; ld_row_f32(g, lane, gg); ld_row_f32(b, lane, bb);
    int row = F.bid * 8 + F.wave;
    float yn[32];
    if (row < nrows) ld_row_f32(xres_row(F, row), lane, yn);
#pragma unroll 1
    for (; row < nrows; row += step) {
        const int v = row < NLAT ? (row >> 12) : 4; float* xp = xres_row(F, row);
        float y[32], sh[32], sc[32];
#pragma unroll
        for (int i = 0; i < 32; ++i) y[i] = yn[i];
        ld_row_f32(mod + (size_t)v * 12288 + 6144, lane, sh); ld_row_f32(mod + (size_t)v * 12288 + 8192, lane, sc);
        { const int nrow = row + step; if (nrow < nrows) ld_row_f32(xres_row(F, nrow), lane, yn); }
        float s = 0.f;
#pragma unroll
        for (int i = 0; i < 32; ++i) s += y[i];
        const float mu = wave_sum(s) * (1.f / 2048.f); float q = 0.f;
#pragma unroll
        for (int i = 0; i < 32; ++i) { const float d = y[i] - mu; q += d * d; }
        const float rstd = rsqrtf(wave_sum(q) * (1.f / 2048.f) + LN_EPS);
#pragma unroll
        for (int i = 0; i < 32; ++i) y[i] = (y[i] - mu) * rstd * gg[i] + bb[i];
        st_row_f32(xp, lane, y);
#pragma unroll
        for (int i = 0; i < 32; ++i) y[i] = y[i] * (1.f + sc[i]) + sh[i];
        st_row_bf16(hb + (size_t)row * D, lane, y);
    }
}

template <int NV>
__device__ __forceinline__ void top16(const float (&val)[NV], bool (&sel)[NV], int (&slot)[NV]) {
    unsigned key[NV];
#pragma unroll
    for (int v = 0; v < NV; ++v) { const unsigned u = __float_as_uint(val[v]); key[v] = (u & 0x80000000u) ? ~u : (u | 0x80000000u); }
    unsigned T = 0u;
#pragma unroll 1
    for (int bit = 31; bit >= 0; --bit) {
        const unsigned cand = T | (1u << bit); int cnt = 0;
#pragma unroll
        for (int v = 0; v < NV; ++v) cnt += __popcll(__ballot(key[v] >= cand));
        if (cnt >= 16) T = cand;
    }
    int ngt = 0;
#pragma unroll
    for (int v = 0; v < NV; ++v) ngt += __popcll(__ballot(key[v] > T));
    const int need = 16 - ngt;
    int run = 0, erun = 0;
#pragma unroll
    for (int v = 0; v < NV; ++v) {
        const unsigned long long mg = __ballot(key[v] > T), me = __ballot(key[v] == T);
        const int pg = __builtin_amdgcn_mbcnt_hi((unsigned)(mg >> 32), __builtin_amdgcn_mbcnt_lo((unsigned)mg, 0u));
        const int pe = __builtin_amdgcn_mbcnt_hi((unsigned)(me >> 32), __builtin_amdgcn_mbcnt_lo((unsigned)me, 0u));
        sel[v] = false; slot[v] = 0;
        if (key[v] > T) { sel[v] = true; slot[v] = run + pg; }
        else if (key[v] == T && (erun + pe) < need) { sel[v] = true; slot[v] = ngt + erun + pe; }
        run += __popcll(mg); erun += __popcll(me);
    }
}
__device__ __forceinline__ unsigned f2key(float f) { const unsigned u = __float_as_uint(f); return (u & 0x80000000u) ? ~u : (u | 0x80000000u); }
__device__ __forceinline__ float key2f(unsigned k) { return __uint_as_float((k & 0x80000000u) ? (k & 0x7fffffffu) : ~k); }
template <int NP, int NV>
__device__ __forceinline__ void bisect16(const unsigned (&key)[NP][NV], unsigned (&T)[NP]) {
    bool done[NP];
#pragma unroll
    for (int p = 0; p < NP; ++p) { T[p] = 0u; done[p] = false; }
#pragma unroll 1
    for (int bit = 31; bit >= 0; --bit) {
        const unsigned bm = 1u << bit; bool all = true;
#pragma unroll
        for (int p = 0; p < NP; ++p) {
            const unsigned cand = T[p] | bm; int cnt = 0;
#pragma unroll
            for (int v = 0; v < NV; ++v) cnt += __popcll(__ballot(key[p][v] >= cand));
            const bool upd = (cnt >= 16) && !done[p];
            T[p] = upd ? cand : T[p]; done[p] = done[p] || (cnt == 16); all = all && done[p];
        }
        if (all) break;
    }
}
template <int NV>
__device__ __forceinline__ void compact16(const unsigned (&key)[NV], const unsigned T, bool (&sel)[NV], int (&slot)[NV]) {
    int ngt = 0;
#pragma unroll
    for (int v = 0; v < NV; ++v) ngt += __popcll(__ballot(key[v] > T));
    const int need = 16 - ngt; int run = 0, erun = 0;
#pragma unroll
    for (int v = 0; v < NV; ++v) {
        const unsigned long long mg = __ballot(key[v] > T), me = __ballot(key[v] == T);
        const int pg = __builtin_amdgcn_mbcnt_hi((unsigned)(mg >> 32), __builtin_amdgcn_mbcnt_lo((unsigned)mg, 0u));
        const int pe = __builtin_amdgcn_mbcnt_hi((unsigned)(me >> 32), __builtin_amdgcn_mbcnt_lo((unsigned)me, 0u));
        sel[v] = false; slot[v] = 0;
        if (key[v] > T) { sel[v] = true; slot[v] = run + pg; }
        else if (key[v] == T && (erun + pe) < need) { sel[v] = true; slot[v] = ngt + erun + pe; }
        run += __popcll(mg); erun += __popcll(me);
    }
}
constexpr int KP = 68;
constexpr int PW_BYTES = 9344;
__device__ __forceinline__ float gelu_erf(float x) {
    const float z = fabsf(x) * 0.7071067811865476f; const float t = __builtin_amdgcn_rcpf(1.f + 0.3275911f * z);
    float p = 1.061405429f; p = p * t - 1.453152027f; p = p * t + 1.421413741f; p = p * t - 0.284496736f; p = p * t + 0.254829592f; p = p * t;
    const float er = 1.f - p * __expf(-z * z);
    return 0.5f * x * (1.f + (x < 0.f ? -er : er));
}
__device__ __forceinline__ float wave_max(float x) {
    x = row16_max(x);
    { auto r = __builtin_amdgcn_permlane16_swap(__float_as_uint(x), __float_as_uint(x), false, false); x = fmaxf(__uint_as_float(r[0]), __uint_as_float(r[1])); }
    { auto r = __builtin_amdgcn_permlane32_swap(__float_as_uint(x), __float_as_uint(x), false, false); x = fmaxf(__uint_as_float(r[0]), __uint_as_float(r[1])); }
    return x;
}
__device__ __forceinline__ void ld16_f32(const float* p, int lane, float (&x)[32]) {
#pragma unroll
    for (int q = 0; q < 2; ++q)
#pragma unroll
        for (int d = 0; d < 4; ++d) { const f32x4 a = *(const f32x4*)(p + 1024 * q + 16 * lane + 4 * d); x[q * 16 + d * 4 + 0] = a[0]; x[q * 16 + d * 4 + 1] = a[1]; x[q * 16 + d * 4 + 2] = a[2]; x[q * 16 + d * 4 + 3] = a[3]; }
}
__device__ __forceinline__ void ld16_f32_nt(const float* p, int lane, float (&x)[32]) {
#pragma unroll
    for (int q = 0; q < 2; ++q)
#pragma unroll
        for (int d = 0; d < 4; ++d) { const f32x4 a = __builtin_nontemporal_load((const f32x4*)(p + 1024 * q + 16 * lane + 4 * d)); x[q * 16 + d * 4 + 0] = a[0]; x[q * 16 + d * 4 + 1] = a[1]; x[q * 16 + d * 4 + 2] = a[2]; x[q * 16 + d * 4 + 3] = a[3]; }
}
__device__ __forceinline__ void st16_f32_nt(float* p, int lane, const float (&x)[32]) {
#pragma unroll
    for (int q = 0; q < 2; ++q)
#pragma unroll
        for (int d = 0; d < 4; ++d) __builtin_nontemporal_store((f32x4){x[q * 16 + d * 4 + 0], x[q * 16 + d * 4 + 1], x[q * 16 + d * 4 + 2], x[q * 16 + d * 4 + 3]}, (f32x4*)(p + 1024 * q + 16 * lane + 4 * d));
}
__device__ __forceinline__ void st16_f32(float* p, int lane, const float (&x)[32]) {
#pragma unroll
    for (int q = 0; q < 2; ++q)
#pragma unroll
        for (int d = 0; d < 4; ++d) *(f32x4*)(p + 1024 * q + 16 * lane + 4 * d) = (f32x4){x[q * 16 + d * 4 + 0], x[q * 16 + d * 4 + 1], x[q * 16 + d * 4 + 2], x[q * 16 + d * 4 + 3]};
}
__device__ __forceinline__ void ld16_bf16(const bf16_t* p, int lane, float (&x)[32]) {
#pragma unroll
    for (int q = 0; q < 2; ++q)
#pragma unroll
        for (int d = 0; d < 2; ++d) { const u32x4 w = *(const u32x4*)(p + 1024 * q + 16 * lane + 8 * d); float* o = &x[q * 16 + d * 8];
            o[0] = bflo(w.x); o[1] = bfhi(w.x); o[2] = bflo(w.y); o[3] = bfhi(w.y); o[4] = bflo(w.z); o[5] = bfhi(w.z); o[6] = bflo(w.w); o[7] = bfhi(w.w); }
}
__device__ __forceinline__ void st16_bf16(bf16_t* p, int lane, const float (&x)[32]) {
#pragma unroll
    for (int q = 0; q < 2; ++q)
#pragma unroll
        for (int d = 0; d < 2; ++d) { const float* o = &x[q * 16 + d * 8]; u32x4 w; w.x = cvt_pk_bf16(o[0], o[1]); w.y = cvt_pk_bf16(o[2], o[3]); w.z = cvt_pk_bf16(o[4], o[5]); w.w = cvt_pk_bf16(o[6], o[7]);
            *(u32x4*)(p + 1024 * q + 16 * lane + 8 * d) = w; }
}
constexpr int TBS = 1152;
__device__ __forceinline__ void cvt_row_fp4b(int lane, const float* __restrict__ src, unsigned char* __restrict__ dst) {
    float x[32];
#pragma unroll
    for (int q = 0; q < 2; ++q)
#pragma unroll
        for (int d = 0; d < 4; ++d) { const f32x4 a = __builtin_nontemporal_load((const f32x4*)(src + 1024 * q + 16 * lane + 4 * d)); x[q * 16 + d * 4 + 0] = a[0]; x[q * 16 + d * 4 + 1] = a[1]; x[q * 16 + d * 4 + 2] = a[2]; x[q * 16 + d * 4 + 3] = a[3]; }
    float am = 0.f;
#pragma unroll
    for (int i = 0; i < 32; ++i) am = fmaxf(am, fabsf(x[i]));
    const bf16_t sb = f2bf(am * (1.f / 6.f)); const float sf = bf2f(sb); const float sc = sf > 0.f ? 1.f / sf : 0.f;
    u32x4 w;
#pragma unroll
    for (int d = 0; d < 4; ++d) { unsigned t = 0u; const int o = (d >> 1) * 16 + (d & 1) * 8;
        t = __builtin_amdgcn_cvt_scalef32_pk_fp4_f32(t, x[o + 0] * sc, x[o + 1] * sc, 1.0f, 0); t = __builtin_amdgcn_cvt_scalef32_pk_fp4_f32(t, x[o + 2] * sc, x[o + 3] * sc, 1.0f, 1);
        t = __builtin_amdgcn_cvt_scalef32_pk_fp4_f32(t, x[o + 4] * sc, x[o + 5] * sc, 1.0f, 2); t = __builtin_amdgcn_cvt_scalef32_pk_fp4_f32(t, x[o + 6] * sc, x[o + 7] * sc, 1.0f, 3); w[d] = t; }
    *(u32x4*)(dst + 16 * lane) = w;
    *(bf16_t*)(dst + 1024 + 2 * lane) = sb;
}
__device__ __forceinline__ void cvt_row_fp4r(int lane, const float* __restrict__ src, unsigned char* __restrict__ dst, float* __restrict__ inv) {
    float x[32];
#pragma unroll
    for (int q = 0; q < 2; ++q)
#pragma unroll
        for (int d = 0; d < 4; ++d) { const f32x4 a = __builtin_nontemporal_load((const f32x4*)(src + 1024 * q + 16 * lane + 4 * d)); x[q * 16 + d * 4 + 0] = a[0]; x[q * 16 + d * 4 + 1] = a[1]; x[q * 16 + d * 4 + 2] = a[2]; x[q * 16 + d * 4 + 3] = a[3]; }
    float am = 0.f;
#pragma unroll
    for (int i = 0; i < 32; ++i) am = fmaxf(am, fabsf(x[i]));
    am = wave_max(am);
    const float sc = am > 0.f ? 6.f / am : 1.f;
    if (lane == 0) *inv = am > 0.f ? am * (1.f / 6.f) : 1.f;
    u32x4 w;
#pragma unroll
    for (int d = 0; d < 4; ++d) { unsigned t = 0u; const int o = (d >> 1) * 16 + (d & 1) * 8;
        t = __builtin_amdgcn_cvt_scalef32_pk_fp4_f32(t, x[o + 0] * sc, x[o + 1] * sc, 1.0f, 0); t = __builtin_amdgcn_cvt_scalef32_pk_fp4_f32(t, x[o + 2] * sc, x[o + 3] * sc, 1.0f, 1);
        t = __builtin_amdgcn_cvt_scalef32_pk_fp4_f32(t, x[o + 4] * sc, x[o + 5] * sc, 1.0f, 2); t = __builtin_amdgcn_cvt_scalef32_pk_fp4_f32(t, x[o + 6] * sc, x[o + 7] * sc, 1.0f, 3); w[d] = t; }
    *(u32x4*)(dst + 16 * lane) = w;
}
__device__ __forceinline__ void cvt_peer(const Frame& F, int l) {
    for (int r = F.bid * 8 + F.wave; r < 16384; r += F.G * 8) cvt_row_fp4b(F.lane, F.in(23) + ((size_t)l * 16384 + r) * 2048, wsp<unsigned char>(F, WS_PU) + (size_t)l * SZ_PT + (size_t)r * TBS);
    for (int r = F.bid * 8 + F.wave; r < 16384; r += F.G * 8) cvt_row_fp4b(F.lane, F.in(24) + ((size_t)l * 16384 + r) * 2048, wsp<unsigned char>(F, WS_PV) + (size_t)l * SZ_PT + (size_t)r * TBS);
}
#define PEER_G 4
template <int CTRL> __device__ __forceinline__ int dppi(int x) { return __builtin_amdgcn_update_dpp(0, x, CTRL, 0xF, 0xF, true); }
__device__ __forceinline__ int irow16_sum(int x) { x += dppi<0xB1>(x); x += dppi<0x4E>(x); x += dppi<0x141>(x); x += dppi<0x140>(x); return x; }
__device__ __forceinline__ int irow16_incl_scan(int x) { x += dppi<0x111>(x); x += dppi<0x112>(x); x += dppi<0x114>(x); x += dppi<0x118>(x); return x; }
constexpr int KBP = 72;
constexpr int PT_WORDS = 6 * 128 + 160 + 3 * 128;
constexpr int PWB = 2 * PT_WORDS * 4;
__device__ __forceinline__ void p_peer(const Frame& F, int l, bool last) {
    LAS bf16_t* kb1 = (LAS bf16_t*)F.lds; LAS bf16_t* kb2 = kb1 + 128 * KBP;
    LAS unsigned* wbase = (LAS unsigned*)(F.lds + 2 * 128 * KBP * 2 + F.wave * PWB);
    const int lane = F.lane, fr = lane & 15, fq = lane >> 4;
    __syncthreads();
    for (int i = F.tid; i < 128 * 64; i += 512) { const int r = i >> 6, d = i & 63; kb1[r * KBP + d] = f2bf(F.in(21)[(size_t)l * 8192 + i]); kb2[r * KBP + d] = f2bf(F.in(22)[(size_t)l * 8192 + i]); }
    __syncthreads();
    const bf16_t* QP = wsp<bf16_t>(F, WS_QP); const bf16_t* HB = wsp<bf16_t>(F, WS_HB); unsigned char* HB8w = wsp<unsigned char>(F, WS_HB8);
    const unsigned char* PU = wsp<unsigned char>(F, WS_PU) + (size_t)l * SZ_PT; const unsigned char* PV = wsp<unsigned char>(F, WS_PV) + (size_t)l * SZ_PT;
    const float* modl = wsp<float>(F, WS_MOD) + (size_t)l * 5 * 12288; const float* modn = wsp<float>(F, WS_MOD) + (size_t)(l + 1) * 5 * 12288;
    const float* g2n = F.in(25) + l * D; const float* b2n = F.in(26) + l * D;
    const int npairs = (last ? NLAT : NROW) / 2;
    const int per_wg = (npairs + F.G - 1) / F.G; const int p_lo = F.bid * per_wg; const int p_hi = (p_lo + per_wg) < npairs ? (p_lo + per_wg) : npairs;
    LAS int* wq = (LAS int*)(F.lds + 147456 - 32);
    if (F.tid == 0) *wq = 0;
    __syncthreads();
#pragma unroll 1
    for (;;) {
        int pi = 0; if (lane == 0) pi = __hip_atomic_fetch_add(wq, 1, __ATOMIC_RELAXED, __HIP_MEMORY_SCOPE_WORKGROUP);
        pi = p_lo + __builtin_amdgcn_readfirstlane(pi); if (pi >= p_hi) break;
        const int rowA = 2 * pi;
#pragma unroll 1
        for (int rep1_ = 0; rep1_ <= REP_PS1; ++rep1_) {
            unsigned kk[2][8][4];
            { int fr_ = fr; asm volatile("" : "+v"(fr_));
              const bf16_t* qrow = QP + (size_t)(rowA + (fr_ >> 3)) * 1024 + (fr_ & 7) * 128 + 8 * fq;
              bf16x8 af[2][2];
#pragma unroll
              for (int st = 0; st < 2; ++st)
#pragma unroll
                  for (int ks = 0; ks < 2; ++ks) af[st][ks] = *(const bf16x8*)(qrow + st * 64 + ks * 32);
#pragma unroll
              for (int st = 0; st < 2; ++st) { LAS bf16_t* kb = st ? kb2 : kb1;
#pragma unroll
                  for (int nb = 0; nb < 8; ++nb) { f32x4 c = {0.f, 0.f, 0.f, 0.f};
#pragma unroll
                      for (int ks = 0; ks < 2; ++ks) { const bf16x8 bfr = *(const LAS bf16x8*)(kb + (nb * 16 + fr) * KBP + ks * 32 + 8 * fq); c = __builtin_amdgcn_mfma_f32_16x16x32_bf16(af[st][ks], bfr, c, 0, 0, 0); }
#pragma unroll
                      for (int r = 0; r < 4; ++r) kk[st][nb][r] = f2key(c[r]); } } }
            unsigned T[2][4]; bool done[2][4];
#pragma unroll
            for (int st = 0; st < 2; ++st)
#pragma unroll
                for (int r = 0; r < 4; ++r) { T[st][r] = 0u; done[st][r] = false; }
#pragma unroll 1
            for (int bit = 31; bit >= 0; --bit) { const unsigned bm = 1u << bit; bool alld = true;
#pragma unroll
                for (int st = 0; st < 2; ++st)
#pragma unroll
                    for (int r = 0; r < 4; ++r) { const unsigned cand = T[st][r] | bm; int c = 0;
#pragma unroll
                        for (int nb = 0; nb < 8; ++nb) c += (kk[st][nb][r] >= cand) ? 1 : 0;
                        c = irow16_sum(c);
                        const bool upd = (c >= 16) && !done[st][r]; T[st][r] = upd ? cand : T[st][r]; done[st][r] = done[st][r] || (c == 16); alld = alld && done[st][r]; }
                if (__all(alld)) break; }
            const int tt = lane >> 5, hd0 = ((lane >> 4) & 1) * 4;
#pragma unroll
            for (int st = 0; st < 2; ++st)
#pragma unroll
                for (int r = 0; r < 4; ++r) { const unsigned Tr = T[st][r]; int g = 0, e = 0;
#pragma unroll
                    for (int nb = 0; nb < 8; ++nb) { g += (kk[st][nb][r] > Tr) ? 1 : 0; e += (kk[st][nb][r] == Tr) ? 1 : 0; }
                    int gpre = irow16_incl_scan(g) - g, epre = irow16_incl_scan(e) - e; const int ngt = irow16_sum(g); const int need = 16 - ngt;
                    LAS unsigned* tb = wbase + tt * PT_WORDS; LAS float* vl = (LAS float*)(tb + st * 128) + (hd0 + r) * 16; LAS int* il = (LAS int*)(tb + 256 + st * 128) + (hd0 + r) * 16;
#pragma unroll
                    for (int nb = 0; nb < 8; ++nb) { const unsigned k = kk[st][nb][r];
                        if (k > Tr) { vl[gpre] = key2f(k); il[gpre] = nb * 16 + fr; ++gpre; }
                        else if (k == Tr) { if (epre < need) { vl[ngt + epre] = key2f(k); il[ngt + epre] = nb * 16 + fr; } ++epre; } } }
        }
        asm volatile("s_waitcnt lgkmcnt(0)" ::: "memory");
        {
            const int tt = lane >> 5, hd0 = ((lane >> 4) & 1) * 4; LAS unsigned* tb = wbase + tt * PT_WORDS;
            unsigned ck[4][16];
#pragma unroll
            for (int r = 0; r < 4; ++r) { const float va = ((LAS float*)tb)[(hd0 + r) * 16 + fr]; const LAS float* v2p = (LAS float*)(tb + 128) + (hd0 + r) * 16;
#pragma unroll
                for (int j4 = 0; j4 < 4; ++j4) { const f32x4 vb = *(const LAS f32x4*)(v2p + j4 * 4);
#pragma unroll
                    for (int i = 0; i < 4; ++i) ck[r][j4 * 4 + i] = f2key(va + vb[i]); } }
            unsigned T[4]; bool done[4];
#pragma unroll
            for (int r = 0; r < 4; ++r) { T[r] = 0u; done[r] = false; }
#pragma unroll 1
            for (int bit = 31; bit >= 0; --bit) { const unsigned bm = 1u << bit; bool alld = true;
#pragma unroll
                for (int r = 0; r < 4; ++r) { const unsigned cand = T[r] | bm; int c = 0;
#pragma unroll
                    for (int j = 0; j < 16; ++j) c += (ck[r][j] >= cand) ? 1 : 0;
                    c = irow16_sum(c);
                    const bool upd = (c >= 16) && !done[r]; T[r] = upd ? cand : T[r]; done[r] = done[r] || (c == 16); alld = alld && done[r]; }
                if (__all(alld)) break; }
#pragma unroll
            for (int r = 0; r < 4; ++r) { const unsigned Tr = T[r]; int g = 0, e = 0;
#pragma unroll
                for (int j = 0; j < 16; ++j) { g += (ck[r][j] > Tr) ? 1 : 0; e += (ck[r][j] == Tr) ? 1 : 0; }
                int gpre = irow16_incl_scan(g) - g, epre = irow16_incl_scan(e) - e; const int ngt = irow16_sum(g); const int need = 16 - ngt;
                const int e1 = ((LAS int*)(tb + 256))[(hd0 + r) * 16 + fr] * 128; const LAS int* i2p = (LAS int*)(tb + 384) + (hd0 + r) * 16;
                LAS float* cs_ = (LAS float*)(tb + 512) + (hd0 + r) * 16; LAS int* ce_ = (LAS int*)(tb + 640) + (hd0 + r) * 16;
#pragma unroll
                for (int j = 0; j < 16; ++j) { const unsigned k = ck[r][j];
                    if (k > Tr) { cs_[gpre] = key2f(k); ce_[gpre] = e1 + i2p[j]; ++gpre; }
                    else if (k == Tr) { if (epre < need) { cs_[ngt + epre] = key2f(k); ce_[ngt + epre] = e1 + i2p[j]; } ++epre; } } }
        }
        asm volatile("s_waitcnt lgkmcnt(0)" ::: "memory");
#pragma unroll 1
      for (int t = 0; t < 2; ++t) {
        const int row = rowA + t; const int v = row < NLAT ? (row >> 12) : 4;
        LAS unsigned* tb = wbase + t * PT_WORDS;
        LAS float* v1l = (LAS float*)tb; LAS float* v2l = v1l + 128; LAS int* i1l = (LAS int*)(v2l + 128); LAS int* i2l = i1l + 128;
        LAS float* csl = (LAS float*)(i2l + 128); LAS int* cel = (LAS int*)(csl + 128); LAS int* el = cel + 128; LAS float* gl = (LAS float*)(el + 160); LAS float* su = gl + 128; LAS float* sv = su + 128;
        {
#pragma unroll
            for (int it = 0; it < 2; ++it) { const int idx = it * 64 + lane;
                const float sx = csl[idx]; const float mx = row16_max(sx); const float pe_ = __expf(sx - mx); const float sm = row16_sum(pe_);
                el[idx] = cel[idx]; gl[idx] = pe_ / sm; }
        }
        if (lane < 32) el[128 + lane] = el[0];
        asm volatile("s_waitcnt vmcnt(0) lgkmcnt(0)" ::: "memory");
        float hh[32]; ld16_bf16(HB + (size_t)row * D, lane, hh);
        f32x2 hh2[16];
#pragma unroll
        for (int i = 0; i < 16; ++i) hh2[i] = (f32x2){hh[2 * i], hh[2 * i + 1]};
        const bool b0_ = lane & 1, b1_ = lane & 2, b2_ = lane & 4;
        u32x4 A[8], B[8], C[8]; unsigned SA[8], SB[8], SC[8];
#define PEER_LOADT(buf, sbuf, tab, g) do { _Pragma("unroll") for (int x = 0; x < 8; ++x) { const int e = __builtin_amdgcn_readfirstlane(el[(g) * 8 + x]); const unsigned char* rp = (tab) + (size_t)e * TBS; \
            buf[x] = *(const u32x4*)(rp + 16 * lane); sbuf[x] = *(const bf16_t*)(rp + 1024 + 2 * lane); } } while (0)
#define PEER_LOADV(buf, g) do { _Pragma("unroll") for (int x = 0; x < 8; ++x) { const int e = __builtin_amdgcn_readfirstlane(el[(g) * 8 + x]); buf[x] = *(const u32x4*)(PV + (size_t)e * 1024 + 16 * lane); } } while (0)
#define FP4X8(w_, f0_, f1_, f2_, f3_) const f32x2 f0_ = __builtin_amdgcn_cvt_scalef32_pk_f32_fp4(w_, 1.0f, 0), f1_ = __builtin_amdgcn_cvt_scalef32_pk_f32_fp4(w_, 1.0f, 1), f2_ = __builtin_amdgcn_cvt_scalef32_pk_f32_fp4(w_, 1.0f, 2), f3_ = __builtin_amdgcn_cvt_scalef32_pk_f32_fp4(w_, 1.0f, 3)
#define PEER_DOT(buf, sbuf, g) do { float p_[8]; \
            _Pragma("unroll") for (int x = 0; x < 8; ++x) { f32x2 s2_ = {0.f, 0.f}; \
                _Pragma("unroll") for (int d = 0; d < 4; ++d) { const unsigned w_ = buf[x][d]; FP4X8(w_, f0_, f1_, f2_, f3_); const int o_ = (d >> 1) * 8 + (d & 1) * 4; \
                    s2_ = hh2[o_ + 0] * f0_ + s2_; s2_ = hh2[o_ + 1] * f1_ + s2_; s2_ = hh2[o_ + 2] * f2_ + s2_; s2_ = hh2[o_ + 3] * f3_ + s2_; } \
                p_[x] = (s2_.x + s2_.y) * __uint_as_float(sbuf[x] << 16); SBAR(); } \
              \
            float q_[4], r_[2]; \
            _Pragma("unroll") for (int j = 0; j < 4; ++j) { const float keep_ = b0_ ? p_[2 * j + 1] : p_[2 * j], send_ = b0_ ? p_[2 * j] : p_[2 * j + 1]; q_[j] = keep_ + dppf<0xB1>(send_); } \
            _Pragma("unroll") for (int j = 0; j < 2; ++j) { const float keep_ = b1_ ? q_[2 * j + 1] : q_[2 * j], send_ = b1_ ? q_[2 * j] : q_[2 * j + 1]; r_[j] = keep_ + dppf<0x4E>(send_); } \
            float t_; { const float keep_ = b2_ ? r_[1] : r_[0], send_ = b2_ ? r_[0] : r_[1]; const float up_ = dppf<0x104>(send_), dn_ = dppf<0x114>(send_); t_ = keep_ + (b2_ ? dn_ : up_); } \
            t_ += dppf<0x128>(t_); \
            { auto r16_ = __builtin_amdgcn_permlane16_swap(__float_as_uint(t_), __float_as_uint(t_), false, false); t_ = __uint_as_float(r16_[0]) + __uint_as_float(r16_[1]); } \
            { auto r32_ = __builtin_amdgcn_permlane32_swap(__float_as_uint(t_), __float_as_uint(t_), false, false); t_ = __uint_as_float(r32_[0]) + __uint_as_float(r32_[1]); } \
            const float av = gelu_erf(t_) * gl[(g) * 8 + (lane & 7)]; const bool me_ = (lane >> 3) == ((g) & 7); \
            avl = (me_ && (g) < 8) ? av : avl; avh = (me_ && (g) >= 8) ? av : avh; } while (0)
#define PIN_ACC() do { asm volatile("" : "+v"(acc2[0]), "+v"(acc2[1]), "+v"(acc2[2]), "+v"(acc2[3]), "+v"(acc2[4]), "+v"(acc2[5]), "+v"(acc2[6]), "+v"(acc2[7]), "+v"(acc2[8]), "+v"(acc2[9]), "+v"(acc2[10]), "+v"(acc2[11]), "+v"(acc2[12]), "+v"(acc2[13]), "+v"(acc2[14]), "+v"(acc2[15])); } while (0)
#define PEER_AXPY(buf, sbuf, g) do { _Pragma("unroll") for (int x = 0; x < 8; ++x) { const int idx = (g) * 8 + x; \
            const float av = __uint_as_float(__builtin_amdgcn_readlane(__float_as_uint(idx < 64 ? avl : avh), idx & 63)) * __uint_as_float(sbuf[x] << 16); const f32x2 av2_ = {av, av}; \
            _Pragma("unroll") for (int d = 0; d < 4; ++d) { const unsigned w_ = buf[x][d]; FP4X8(w_, f0_, f1_, f2_, f3_); const int o_ = (d >> 1) * 8 + (d & 1) * 4; \
                acc2[o_ + 0] = av2_ * f0_ + acc2[o_ + 0]; acc2[o_ + 1] = av2_ * f1_ + acc2[o_ + 1]; acc2[o_ + 2] = av2_ * f2_ + acc2[o_ + 2]; acc2[o_ + 3] = av2_ * f3_ + acc2[o_ + 3]; } PIN_ACC(); } } while (0)
        float avl = 0.f, avh = 0.f;
        PEER_LOADT(A, SA, PU, 0); PEER_LOADT(B, SB, PU, 1);
#pragma unroll 1
        for (int g = 0; g < 15; g += 3) { PEER_LOADT(C, SC, PU, g + 2); SBAR(); PEER_DOT(A, SA, g); SBAR(); PEER_LOADT(A, SA, PU, g + 3); SBAR(); PEER_DOT(B, SB, g + 1); SBAR(); PEER_LOADT(B, SB, PU, g + 4); SBAR(); PEER_DOT(C, SC, g + 2); SBAR(); }
        PEER_DOT(A, SA, 15); SBAR();
        f32x2 acc2[16];
#pragma unroll
        for (int i = 0; i < 16; ++i) acc2[i] = (f32x2){0.f, 0.f};
        float* xp = xres_row(F, row);
        PEER_LOADT(A, SA, PV, 0); PEER_LOADT(B, SB, PV, 1);
#pragma unroll 1
        for (int g = 0; g < 15; g += 3) { PEER_LOADT(C, SC, PV, g + 2); SBAR(); PEER_AXPY(A, SA, g); SBAR(); PEER_LOADT(A, SA, PV, g + 3); SBAR(); PEER_AXPY(B, SB, g + 1); SBAR(); PEER_LOADT(B, SB, PV, g + 4); SBAR(); PEER_AXPY(C, SC, g + 2); SBAR(); }
        float x1[32], g2[32]; ld16_f32(xp, lane, x1); ld16_f32(modl + (size_t)v * 12288 + 10240, lane, g2); SBAR();
        PEER_AXPY(A, SA, 15); SBAR();
#undef PEER_LOADT
#undef PEER_LOADV
#undef PEER_DOT
#undef PEER_AXPY
        float acc[32];
        {
#pragma unroll
          for (int i = 0; i < 32; ++i) acc[i] = ALPHA * x1[i] + g2[i] * acc2[i >> 1][i & 1]; }
        { float sm = 0.f;
#pragma unroll
          for (int i = 0; i < 32; ++i) sm += acc[i];
          const float mu = wave_sum(sm) * (1.f / 2048.f); float qq = 0.f;
#pragma unroll
          for (int i = 0; i < 32; ++i) { const float dd = acc[i] - mu; qq += dd * dd; }
          const float rstd = rsqrtf(wave_sum(qq) * (1.f / 2048.f) + LN_EPS);
#pragma unroll
          for (int q = 0; q < 2; ++q)
#pragma unroll
              for (int d = 0; d < 4; ++d) { const int o = 1024 * q + 16 * lane + 4 * d; const f32x4 gg = *(const f32x4*)(g2n + o), bb = *(const f32x4*)(b2n + o);
#pragma unroll
                  for (int i = 0; i < 4; ++i) acc[q * 16 + d * 4 + i] = (acc[q * 16 + d * 4 + i] - mu) * rstd * gg[i] + bb[i]; } }
        st16_f32(xp, lane, acc);
        if (!last) { const float* sh = modn + (size_t)v * 12288; const float* sc = sh + 2048;
#pragma unroll
            for (int q = 0; q < 2; ++q)
#pragma unroll
                for (int d = 0; d < 4; ++d) { const int o = 1024 * q + 16 * lane + 4 * d; const f32x4 hh4 = *(const f32x4*)(sh + o), cc4 = *(const f32x4*)(sc + o);
#pragma unroll
                    for (int i = 0; i < 4; ++i) acc[q * 16 + d * 4 + i] = clamp8(acc[q * 16 + d * 4 + i] * (1.f + cc4[i]) + hh4[i]); }
#pragma unroll
            for (int q = 0; q < 2; ++q) { u32x4 w;
#pragma unroll
                for (int d = 0; d < 4; ++d) w[d] = pk4_fp8(acc[q * 16 + d * 4 + 0], acc[q * 16 + d * 4 + 1], acc[q * 16 + d * 4 + 2], acc[q * 16 + d * 4 + 3]);
                *(u32x4*)(HB8w + (size_t)row * D + 1024 * q + 16 * lane) = w; } }
      }
    }
}
#ifdef DBG
constexpr size_t WS_DBG = WS_CTL + 131072;
constexpr int DBG_NS = 60;
__device__ __forceinline__ int dbg_row(int s) { return (s * 263 + 5) % NLAT; }
__global__ void __launch_bounds__(256) dbg_peer_pre(Args args, int l) {
    __shared__ float q[1024]; __shared__ float s1[128], s2[128]; __shared__ float v1[16], v2[16]; __shared__ int i1[16], i2[16]; __shared__ float cs[256]; __shared__ int ce[256];
    __shared__ float ts[16]; __shared__ int te[16]; __shared__ float red[256]; __shared__ float aval[128]; __shared__ int eid[128]; __shared__ float h2[2048];
    const int s = blockIdx.x, row = dbg_row(s), tid = threadIdx.x; unsigned char* ws = args.ws;
    const bf16_t* QP = (const bf16_t*)(ws + WS_QP); const bf16_t* HB = (const bf16_t*)(ws + WS_HB);
    float* dbgf = (float*)(ws + WS_DBG + 4096); int* dbge = (int*)(dbgf + DBG_NS * 2048); float* dbga = (float*)(dbge + DBG_NS * 128); float* dbgg = dbga + 3 * DBG_NS * 128;
    for (int i = tid; i < 1024; i += 256) q[i] = bf2f(QP[(size_t)row * 1024 + i]);
    for (int i = tid; i < 2048; i += 256) h2[i] = bf2f(HB[(size_t)row * D + i]);
    __syncthreads();
    const float* k1 = args.in[21] + (size_t)l * 8192; const float* k2 = args.in[22] + (size_t)l * 8192;
    for (int hd = 0; hd < 8; ++hd) {
        { const int k = tid & 127; const float* kk = (tid < 128 ? k1 : k2) + k * 64; const float* qq = q + hd * 128 + (tid < 128 ? 0 : 64); float a = 0.f; for (int d = 0; d < 64; ++d) a += qq[d] * kk[d]; (tid < 128 ? s1 : s2)[k] = a; }
        __syncthreads();
        { const int k = tid & 127; const float* sv = tid < 128 ? s1 : s2; const float me = sv[k]; int rank = 0; for (int j = 0; j < 128; ++j) rank += (sv[j] > me || (sv[j] == me && j < k)) ? 1 : 0;
          if (rank < 16) { (tid < 128 ? v1 : v2)[rank] = me; (tid < 128 ? i1 : i2)[rank] = k; } }
        __syncthreads();
        { const int i = tid >> 4, j = tid & 15; cs[tid] = v1[i] + v2[j]; ce[tid] = i1[i] * 128 + i2[j]; }
        __syncthreads();
        { const float me = cs[tid]; int rank = 0; for (int j = 0; j < 256; ++j) rank += (cs[j] > me || (cs[j] == me && j < tid)) ? 1 : 0; if (rank < 16) { ts[rank] = me; te[rank] = ce[tid]; } }
        __syncthreads();
        if (tid < 16) { float mx = ts[0]; float sm = 0.f; for (int j = 0; j < 16; ++j) sm += expf(ts[j] - mx); aval[hd * 16 + tid] = expf(ts[tid] - mx) / sm; eid[hd * 16 + tid] = te[tid]; dbgg[s * 128 + hd * 16 + tid] = aval[hd * 16 + tid]; }
        __syncthreads();
    }
    const float* U = args.in[23] + (size_t)l * 16384 * 2048; const float* V = args.in[24] + (size_t)l * 16384 * 2048;
    for (int e = 0; e < 128; ++e) { const float* ur = U + (size_t)eid[e] * 2048; float p = 0.f; for (int d = tid; d < 2048; d += 256) p += h2[d] * ur[d]; red[tid] = p; __syncthreads();
        for (int st = 128; st > 0; st >>= 1) { if (tid < st) red[tid] += red[tid + st]; __syncthreads(); }
        if (tid == 0) { const float sc = red[0]; aval[e] = 0.5f * sc * (1.f + erff(sc * 0.70710678f)) * aval[e]; } __syncthreads(); }
    float y[8]; const float* xr = args.out + (size_t)row * D; const int v = row >> 12; const float* mod = (const float*)(ws + WS_MOD) + (size_t)l * 5 * 12288 + (size_t)v * 12288;
    float sum = 0.f;
    for (int k = 0; k < 8; ++k) { const int d = tid + 256 * k; float o = 0.f; for (int e = 0; e < 128; ++e) o += aval[e] * V[(size_t)eid[e] * 2048 + d]; y[k] = ALPHA * xr[d] + mod[10240 + d] * o; sum += y[k]; }
    red[tid] = sum; __syncthreads(); for (int st = 128; st > 0; st >>= 1) { if (tid < st) red[tid] += red[tid + st]; __syncthreads(); } const float mu = red[0] / 2048.f; __syncthreads();
    float sq = 0.f; for (int k = 0; k < 8; ++k) sq += (y[k] - mu) * (y[k] - mu);
    red[tid] = sq; __syncthreads(); for (int st = 128; st > 0; st >>= 1) { if (tid < st) red[tid] += red[tid + st]; __syncthreads(); } const float rstd = rsqrtf(red[0] / 2048.f + LN_EPS);
    for (int k = 0; k < 8; ++k) { const int d = tid + 256 * k; dbgf[(size_t)s * 2048 + d] = (y[k] - mu) * rstd * args.in[25][l * D + d] + args.in[26][l * D + d]; }
    if (tid < 128) { dbge[s * 128 + tid] = eid[tid]; dbga[s * 128 + tid] = aval[tid]; }
}
__global__ void __launch_bounds__(256) dbg_peer_post(Args args) {
    __shared__ int bad_e, bad_x, bad_a, bad_g;
    const int s = blockIdx.x, row = dbg_row(s), tid = threadIdx.x; unsigned char* ws = args.ws; unsigned* cnt = (unsigned*)(ws + WS_DBG);
    float* dbgf = (float*)(ws + WS_DBG + 4096); int* dbge = (int*)(dbgf + DBG_NS * 2048); float* dbga = (float*)(dbge + DBG_NS * 128);
    int* fe = (int*)(dbga + DBG_NS * 128); float* fa = (float*)(fe + DBG_NS * 128); float* dbgg = dbga + 3 * DBG_NS * 128; float* fg = dbgg + DBG_NS * 128;
    if (tid == 0) { bad_e = 0; bad_x = 0; bad_a = 0; bad_g = 0; } __syncthreads();
    if (tid < 128) { const int hd = tid >> 4; const int e = dbge[s * 128 + tid]; bool found = false; float af = 0.f, gf = 0.f; for (int j = 0; j < 16; ++j) if (fe[s * 128 + hd * 16 + j] == e) { found = true; af = fa[s * 128 + hd * 16 + j]; gf = fg[s * 128 + hd * 16 + j]; }
        if (!found) atomicAdd(&bad_e, 1); else { const float ea = dbga[s * 128 + tid]; if (fabsf(af - ea) > 0.02f * fabsf(ea) + 2e-3f) atomicAdd(&bad_a, 1); const float eg = dbgg[s * 128 + tid]; if (fabsf(gf - eg) > 0.02f * fabsf(eg) + 1e-3f) atomicAdd(&bad_g, 1); } }
    for (int k = 0; k < 8; ++k) { const int d = tid + 256 * k; const float ex = dbgf[(size_t)s * 2048 + d], got = args.out[(size_t)row * D + d]; if (!(fabsf(got - ex) <= 0.03f + 0.03f * fabsf(ex))) atomicAdd(&bad_x, 1); }
    __syncthreads();
    if (tid == 0) { if (bad_e > 2) atomicAdd(&cnt[1], 1u); if (bad_g > 2) atomicAdd(&cnt[2], 1u); if (bad_a > 2) atomicAdd(&cnt[3], 1u); if (bad_x > 8) atomicAdd(&cnt[4], 1u); }
}
__global__ void dbg_report(Args args) {
    unsigned* cnt = (unsigned*)(args.ws + WS_DBG);
    float code = 0.f;
    for (int lv = 1; lv <= 9; ++lv) if (cnt[lv]) { int tenths = (int)(cnt[lv] * 10 / DBG_NS); if (tenths > 9) tenths = 9; code = 1000.f * lv + 100.f * tenths; break; }
    if (code != 0.f) for (int i = threadIdx.x; i < 4096; i += blockDim.x) args.out[i] = code;
}
#endif
__device__ __forceinline__ void p_attn_gqa(const Frame& F, int last) {
    char* lds = (char*)F.lds;
    const unsigned char* QG = wsp<unsigned char>(F, WS_QG); const unsigned char* KG = wsp<unsigned char>(F, WS_KG); const unsigned char* VG = wsp<unsigned char>(F, WS_VG); unsigned char* OAB = wsp<unsigned char>(F, WS_OAB);
    const int nlat = NB * 8 * 16, nall = last ? nlat : nlat + NB * 8;
    for (int u = F.bid; u < nall; u += F.G) {
        int bh, q0, seq; size_t orow;
        if (u < nlat) {
            int uu = u;
            if (F.G == 256) {
                const int c = u & 255, i = u >> 8, xcd = c & 7, r = c >> 3, kvg = i * 4 + (xcd >> 1), within = (xcd & 1) * 32 + r;
                uu = (((kvg >> 1) * 8 + (kvg & 1) * 4 + (within >> 4)) << 4) | (within & 15); }
            bh = uu >> 4; const int qb = uu & 15; q0 = CTXL + qb * 256; seq = TT; orow = (size_t)(bh >> 3) * SEQ + qb * 256; }
        else { bh = u - nlat; q0 = 0; seq = CTXL; orow = (size_t)NLAT + (bh >> 3) * CTXL; }
        const int b = bh >> 3, h = bh & 7; const size_t kvo = (size_t)(b * 2 + (h >> 2)) * TT * 128;
        __syncthreads();
        att::attn_body<8, 4, 0, 1>(QG + ((size_t)bh * TT + q0) * 128, KG + kvo, VG + (size_t)(b * 2 + (h >> 2)) * 128 * TT, OAB + orow * D + 1024 + h * 128, seq, lds, F.tid);
    }
    __syncthreads();
}
__device__ __forceinline__ void p_attn_mla(const Frame& F, int last) {
    char* lds = (char*)F.lds;
    const unsigned char* QM = wsp<unsigned char>(F, WS_QM); const unsigned char* KM = wsp<unsigned char>(F, WS_KM); const unsigned char* VM = wsp<unsigned char>(F, WS_VM); unsigned char* OAB = wsp<unsigned char>(F, WS_OAB);
    const int nlat = NB * 8 * 16, nall = last ? nlat : nlat + NB * 8;
    for (int u = F.bid; u < nall; u += F.G) {
        int bh, q0, seq; size_t orow;
        if (u < nlat) {
            int uu = u;
            if (F.G == 256) { const int c = u & 255, i = u >> 8, xcd = c & 7, r = c >> 3; uu = ((i * 16 + xcd * 2 + (r >> 4)) << 4) | (r & 15); }
            bh = uu >> 4; const int qb = uu & 15; q0 = CTXL + qb * 256; seq = TT; orow = (size_t)(bh >> 3) * SEQ + qb * 256; }
        else { bh = u - nlat; q0 = 0; seq = CTXL; orow = (size_t)NLAT + (bh >> 3) * CTXL; }
        const int h = bh & 7;
        __syncthreads();
        att::attn_body<6, 2, 1, 2>(QM + ((size_t)bh * TT + q0) * 128, KM + (size_t)bh * TT * 128, VM + (size_t)bh * 64 * TT, OAB + orow * D + h * 64, seq, lds, F.tid);
    }
    __syncthreads();
}
__device__ __forceinline__ void p_ret_out(const Frame& F, int l, int last) {
    const int c_lo = last ? 2 : 0, nc = 34 - c_lo, nu = NB * 8 * nc;
    for (int u = F.bid; u < nu; u += F.G) { const int bh = u / nc, c = c_lo + (u % nc); ret_out_unit(F, l, bh, c); }
    __syncthreads();
}

constexpr int LDS_BYTES = 147456;
constexpr int MISC_OFF = 147456 - 64;
constexpr int NPHASE = 22;
#ifndef PHM
#define PHM 0xFFFF
#endif
#ifndef PH_ATTR
#define PH_ATTR __forceinline__
#endif
__device__ PH_ATTR void ph_prologue(ArgP ap) { const Frame F = make_frame(ap); p0_prologue(F); }
__device__ PH_ATTR void ph_modreduce(ArgP ap) { const Frame F = make_frame(ap); p1_modreduce(F); }
__device__ PH_ATTR void ph_modulate0(ArgP ap) { const Frame F = make_frame(ap); p_modulate0(F); }
__device__ PH_ATTR void ph_gemm_in(ArgP ap, int l) { const Frame F = make_frame(ap);
    pg8::Gemm g{wsp<bf16_t>(F, WS_HB8), wsp<bf16_t>(F, WS_WIN + l * SZ_WIN), NROW, NPT, 1024, 1024, 1024}; pg8::StaticOrder S; S.init(NROW, NPT, F.G, F.bid);
    float mul_, inv_; fp8_scale(wsp<unsigned>(F, WS_WSC)[l], mul_, inv_);
    EpiIn E{wsp<bf16_t>(F, WS_P1), wsp<bf16_t>(F, WS_G), inv_};
    pg8::gemm_phase<EpiIn, pg8::StaticOrder>(F.lds, F.tid, g, S, E); }
__device__ PH_ATTR void ph_post(ArgP ap, int l) { const Frame F = make_frame(ap); p_post(F, l); if (l == 1) cvt_peer(F, 1); }
__device__ PH_ATTR void ph_qup(ArgP ap, int l) { const Frame F = make_frame(ap);
    pg8::Gemm g{wsp<bf16_t>(F, WS_CQN), wsp<bf16_t>(F, WS_WQUP + l * SZ_WQUP), NROW, 768, 512, 512, 512}; pg8::StaticOrder S; S.init(NROW, 768, F.G, F.bid);
    EpiQup E{wsp<unsigned char>(F, WS_QM), wsp<f32x2>(F, WS_ROPE32)};
    pg8::gemm_phase<EpiQup, pg8::StaticOrder>(F.lds, F.tid, g, S, E); }
__device__ PH_ATTR void ph_kvup(ArgP ap, int l) { const Frame F = make_frame(ap);
    pg8::Gemm g{wsp<bf16_t>(F, WS_CKVN), wsp<bf16_t>(F, WS_WKVUP + l * SZ_WKVUP), NROW, 1024, 256, 256, 256}; pg8::StaticOrder S; S.init(NROW, 1024, F.G, F.bid);
    EpiKvup E{wsp<unsigned char>(F, WS_KM), wsp<unsigned char>(F, WS_VM)};
    pg8::gemm_phase<EpiKvup, pg8::StaticOrder>(F.lds, F.tid, g, S, E); }
__device__ PH_ATTR void ph_states(ArgP ap, int l) { const Frame F = make_frame(ap); p_ret_states(F, l); }
__device__ PH_ATTR void ph_attn_gqa(ArgP ap, int last) { const Frame F = make_frame(ap); p_attn_gqa(F, last); }
__device__ PH_ATTR void ph_attn_mla(ArgP ap, int last) { const Frame F = make_frame(ap); p_attn_mla(F, last); }
__device__ PH_ATTR void ph_ret_out(ArgP ap, int l, int last) { const Frame F = make_frame(ap); p_ret_out(F, l, last); }
template <int SEG> __device__ PH_ATTR void ph_merge(ArgP ap, int l, int Mx) { const Frame F = make_frame(ap);
    const bf16_t* OAB = wsp<bf16_t>(F, WS_OAB); bf16_t* MB = wsp<bf16_t>(F, WS_MB); const bf16_t* G = wsp<bf16_t>(F, WS_G);
    pg8::StaticOrder S; S.init(Mx, 2048, F.G, F.bid);
    const size_t wo = SEG == 0 ? WS_WBRA + l * SZ_WBRA : (SEG == 1 ? WS_WBRB + l * SZ_WBRB : WS_WBRC + l * SZ_WBRC); const int K = SEG == 2 ? 1024 : 512;
    pg8::Gemm g{OAB + SEG * 512, wsp<bf16_t>(F, wo), Mx, 2048, K, 2048, K}; EpiMerge<SEG> E{MB, G, wsp<unsigned char>(F, WS_MB8)}; pg8::gemm_phase<EpiMerge<SEG>, pg8::StaticOrder>(F.lds, F.tid, g, S, E); }
__device__ PH_ATTR void ph_merge3(ArgP ap, int l, int Mx) { const Frame F = make_frame(ap);
    pg8::StaticOrder S; S.init(Mx, 2048, F.G, F.bid);
    float m0_, i0_, m1_, i1_, m2_, i2_; fp8_scale(wsp<unsigned>(F, WS_WSC)[4 + l], m0_, i0_); fp8_scale(wsp<unsigned>(F, WS_WSC)[6 + l], m1_, i1_); fp8_scale(wsp<unsigned>(F, WS_WSC)[8 + l], m2_, i2_);
    pg8::Merge3 g{wsp<bf16_t>(F, WS_OAB), wsp<bf16_t>(F, WS_WBRA + l * SZ_WBRA), wsp<bf16_t>(F, WS_WBRB + l * SZ_WBRB), wsp<bf16_t>(F, WS_WBRC + l * SZ_WBRC), wsp<bf16_t>(F, WS_G), wsp<unsigned char>(F, WS_MB8), i0_ * m1_, i1_ * m2_, i2_};
    pg8::gemm_merge3<pg8::StaticOrder>(F.lds, F.tid, g, S); }
__device__ PH_ATTR void ph_out(ArgP ap, int l, int Mx) { const Frame F = make_frame(ap);
    pg8::Gemm g{wsp<bf16_t>(F, WS_MB8), wsp<bf16_t>(F, WS_WOUT + l * SZ_WOUT), Mx, 2048, 1024, 1024, 1024}; pg8::StaticOrder S; S.init(Mx, 2048, F.G, F.bid);
    float mul_, inv_; fp8_scale(wsp<unsigned>(F, WS_WSC)[2 + l], mul_, inv_);
    EpiOut E{l == 0 ? F.in(0) : F.out, l == 0 ? F.in(2) : wsp<float>(F, WS_XC), F.out, wsp<float>(F, WS_XC), wsp<float>(F, WS_MOD) + (size_t)l * 5 * 12288 + 4096, inv_ * (1.f / 16.f)};
    pg8::gemm_phase<EpiOut, pg8::StaticOrder>(F.lds, F.tid, g, S, E); }
__device__ PH_ATTR void ph_ln1(ArgP ap, int l, int last) { const Frame F = make_frame(ap); p_ln1(F, l, last); }
__device__ PH_ATTR void ph_peerq(ArgP ap, int l, int Mx) { const Frame F = make_frame(ap);
    pg8::Gemm g{wsp<bf16_t>(F, WS_HB), wsp<bf16_t>(F, WS_WPQ + l * SZ_WPQ), Mx, 1024, 2048, 2048, 2048}; pg8::StaticOrder S; S.init(Mx, 1024, F.G, F.bid);
    EpiPlain E{wsp<bf16_t>(F, WS_QP), 1024};
    pg8::gemm_phase<EpiPlain, pg8::StaticOrder>(F.lds, F.tid, g, S, E); }
__device__ PH_ATTR void ph_peer(ArgP ap, int l, int last) { const Frame F = make_frame(ap); p_peer(F, l, last); }

__global__ void __launch_bounds__(512, 2) mega_fwd(Args args) {
    extern __shared__ __attribute__((aligned(16))) unsigned char lds_raw[];
    const ArgP ap = (ArgP)__builtin_amdgcn_kernarg_segment_ptr();
    const int lo = ap->ph_lo, hi = ap->ph_hi;
    volatile LAS unsigned* misc = (volatile LAS unsigned*)((LAS unsigned char*)lds_raw + MISC_OFF);
    if (threadIdx.x < 4) misc[threadIdx.x] = 0u;
    __syncthreads();
    XcdBarrier bar; bar.bar = (unsigned*)(ap->ws + WS_CTL); bar.x = 0; bar.st = misc;
    if (hi - lo > 1) bar = xcd_barrier_post((unsigned*)(ap->ws + WS_CTL), misc);
#define IN(k) (lo <= (k) && (k) < hi)
#define SEAM(k) do { if (IN(k) && IN((k) + 1)) xcd_barrier(bar); } while (0)
    if (IN(0)) { if (PHM & 1) ph_prologue(ap); if (REP_PRO) ph_prologue(ap); } SEAM(0);
    if (IN(1)) { if (PHM & 2) ph_modreduce(ap); if (REP_X & 32) ph_modreduce(ap); } SEAM(1);
#pragma unroll 1
    for (int l = 0; l < 2; ++l) {
        const int pb = 2 + 10 * l; const int last = (l == 1);
        const int Mx = last ? NLAT : NROW;
        if (l == 0) { if (IN(pb)) { if (PHM & 4) ph_modulate0(ap); if (REP_X & 64) ph_modulate0(ap); } SEAM(pb); }
        if (IN(pb + 1)) { if (PHM & 8) ph_gemm_in(ap, l); if (REP_GIN) ph_gemm_in(ap, l); } SEAM(pb + 1);
        if (IN(pb + 2)) { if (PHM & 16) ph_post(ap, l); if (REP_X & 1) ph_post(ap, l); } SEAM(pb + 2);
        if (IN(pb + 3)) { if (PHM & 32) ph_qup(ap, l); if (PHM & 64) ph_kvup(ap, l); if (PHM & 128) ph_states(ap, l); if (REP_X & 2) { ph_qup(ap, l); ph_kvup(ap, l); ph_states(ap, l); } } SEAM(pb + 3);
        if (IN(pb + 4)) { if (PHM & 256) ph_attn_gqa(ap, last); if (PHM & 512) ph_attn_mla(ap, last); if (REP_ATTN) { ph_attn_gqa(ap, last); ph_attn_mla(ap, last); } if (REP_X & 4) ph_ret_out(ap, l, last); if (PHM & 1024) ph_ret_out(ap, l, last); } SEAM(pb + 4);
        if (IN(pb + 5)) { if (PHM & 2048) { if (MERGE3) ph_merge3(ap, l, Mx); else { ph_merge<0>(ap, l, Mx); ph_merge<1>(ap, l, Mx); ph_merge<2>(ap, l, Mx); } } if (REP_X & 8) { if (MERGE3) ph_merge3(ap, l, Mx); else { ph_merge<0>(ap, l, Mx); ph_merge<1>(ap, l, Mx); ph_merge<2>(ap, l, Mx); } } } SEAM(pb + 5);
        if (IN(pb + 6)) { if (PHM & 4096) ph_out(ap, l, Mx); } SEAM(pb + 6);
        if (IN(pb + 7)) { if (PHM & 8192) ph_ln1(ap, l, last); } SEAM(pb + 7);
        if (IN(pb + 8)) { if (PHM & 16384) ph_peerq(ap, l, Mx); if (REP_X & 16) ph_peerq(ap, l, Mx); } SEAM(pb + 8);
        if (IN(pb + 9)) { if (PHM & 32768) ph_peer(ap, l, last); } SEAM(pb + 9);
    }
#undef IN
#undef SEAM
}

extern "C" void kernel_launch(void* const* d_in, const int* in_sizes, int n_in, void* d_out, int out_size, void* d_ws, size_t ws_size, hipStream_t stream) {
    static int grid = 0;
    if (grid == 0) {
        if (n_in != 27 || out_size != NLAT * D || ws_size < WS_END) { fprintf(stderr, "kernel_launch: unexpected shapes: n_in %d out %d ws %zu (need %zu)\n", n_in, out_size, ws_size, (size_t)WS_END); grid = -1; return; }
        int dev = 0, cus = 0, per_cu = 0;
        if (hipGetDevice(&dev) != hipSuccess || hipDeviceGetAttribute(&cus, hipDeviceAttributeMultiprocessorCount, dev) != hipSuccess) { grid = -1; return; }
        if (hipFuncSetAttribute((const void*)mega_fwd, hipFuncAttributeMaxDynamicSharedMemorySize, LDS_BYTES) != hipSuccess) { fprintf(stderr, "kernel_launch: hipFuncSetAttribute failed\n"); grid = -1; return; }
        if (hipOccupancyMaxActiveBlocksPerMultiprocessor(&per_cu, (const void*)mega_fwd, 512, LDS_BYTES) != hipSuccess || per_cu < 1) fprintf(stderr, "kernel_launch: occupancy query reports %d\n", per_cu);
        (void)hipGetLastError();
        grid = cus;
    }
    if (grid < 0) return;
    (void)hipMemsetAsync((char*)d_ws + WS_CTL, 0, 65536, stream);
#ifdef DBG
    (void)hipMemsetAsync((char*)d_ws + WS_CTL + 131072, 0, 4096, stream);
#endif
    Args a{};
    for (int i = 0; i < 27; ++i) a.in[i] = (const float*)d_in[i];
    a.out = (float*)d_out; a.ws = (unsigned char*)d_ws;
#if MK_PER_PHASE
    for (int p = 0; p < NPHASE; ++p) { if (p == 12) continue; a.ph_lo = p; a.ph_hi = p + 1;
#ifdef DBG
        if (p == 11) hipLaunchKernelGGL(dbg_peer_pre, dim3(DBG_NS), dim3(256), 0, stream, a, 0);
#endif
        hipLaunchKernelGGL(mega_fwd, dim3(grid), dim3(512), LDS_BYTES, stream, a);
#ifdef DBG
        if (p == 11) hipLaunchKernelGGL(dbg_peer_post, dim3(DBG_NS), dim3(256), 0, stream, a);
#endif
    }
#ifdef DBG
    hipLaunchKernelGGL(dbg_report, dim3(1), dim3(256), 0, stream, a);
#endif
#else
    a.ph_lo = 0; a.ph_hi = NPHASE;
    hipLaunchKernelGGL(mega_fwd, dim3(grid), dim3(512), LDS_BYTES, stream, a);
#endif
    const hipError_t le = hipPeekAtLastError();
    if (le != hipSuccess) fprintf(stderr, "kernel_launch: launch failed: %s\n", hipGetErrorName(le));
}
```

```cpp
#include <hip/hip_runtime.h>
#include <cstdio>
#include <cstdint>
#include <cstddef>

#ifndef MK_PER_PHASE
#define MK_PER_PHASE 0
#endif

#ifndef ABL_PEER
#define ABL_PEER 0
#endif
#ifndef REP_PEERG
#define REP_PEERG 0
#endif
#ifndef REP_PEERH
#define REP_PEERH 0
#endif
#ifndef REP_X
#define REP_X 0
#endif
#ifndef REP_PS1
#define REP_PS1 0
#endif
#ifndef REP_PS2
#define REP_PS2 0
#endif
#ifndef SIDE_ON
#define SIDE_ON 1
#endif
#ifndef REP_DOT
#define REP_DOT 0
#endif
#ifndef MERGE3
#define MERGE3 1
#endif
#ifndef REP_GIN
#define REP_GIN 0
#endif
#ifndef GIN_ABL
#define GIN_ABL 0
#endif
#ifndef ATT_ABL
#define ATT_ABL 0
#endif
#ifndef REP_ATTN
#define REP_ATTN 0
#endif
#ifndef REP_PRO
#define REP_PRO 0
#endif
#ifndef ABL_BR
#define ABL_BR 0
#endif
#ifndef ABL_MIX
#define ABL_MIX 0
#endif
#define LAS __attribute__((address_space(3)))
typedef unsigned short bf16_t;
typedef short bf16x8 __attribute__((ext_vector_type(8)));
typedef short s16x4 __attribute__((ext_vector_type(4)));
typedef float f32x2 __attribute__((ext_vector_type(2)));
typedef float f32x4 __attribute__((ext_vector_type(4)));
typedef float f32x8 __attribute__((ext_vector_type(8)));
typedef float f32x16 __attribute__((ext_vector_type(16)));
typedef unsigned u32x2 __attribute__((ext_vector_type(2)));
typedef unsigned u32x4 __attribute__((ext_vector_type(4)));
typedef __bf16 bf2_t __attribute__((ext_vector_type(2)));

constexpr int D = 2048, NB = 4, SEQ = 4096, CTXL = 256, TT = SEQ + CTXL;
constexpr int NLAT = NB * SEQ, NCTX = NB * CTXL, NROW = NLAT + NCTX;
constexpr int NP1 = 4096, NG = 6144, NPT = NP1 + NG;
constexpr int NIN = 10016;
constexpr float ALPHA = 1.4142135623730951f;
constexpr float LN_EPS = 1e-5f, RMS_EPS = 1e-6f;
constexpr float LOG2E = 1.4426950408889634f;
constexpr int C_CQ = 0, C_CKV = 512, C_GQ = 768, C_GK = 1792, C_GV = 2048, C_RQ = 2304, C_RK = 2560, C_RV = 2816, C_RG = 3328, C_KR = 3840;

constexpr size_t AL(size_t x) { return (x + 255) / 256 * 256; }
constexpr size_t WS_CTL = 0;                                    constexpr size_t CTL_BYTES = 1u << 20;
constexpr size_t WS_WSC = WS_CTL + 32768;
constexpr size_t WS_CVT = WS_CTL + 33024;
constexpr size_t WS_DEC = WS_CTL + 65536;
constexpr size_t WS_ROPE32 = WS_CTL + CTL_BYTES;
constexpr size_t WS_ROPE128 = WS_ROPE32 + AL(64 * 8 * 8);
constexpr size_t WS_MODP = WS_ROPE128 + AL(64 * 32 * 8);
constexpr size_t WS_MOD = WS_MODP + AL((size_t)16 * 2 * 5 * 12288 * 4);
constexpr size_t WS_WIN = WS_MOD + AL((size_t)2 * 5 * 12288 * 4);
constexpr size_t SZ_WIN = (size_t)NPT * D;
constexpr size_t WS_WQUP = WS_WIN + 2 * SZ_WIN;                 constexpr size_t SZ_WQUP = (size_t)768 * 512 * 2;
constexpr size_t WS_WKVUP = WS_WQUP + 2 * SZ_WQUP;              constexpr size_t SZ_WKVUP = (size_t)1024 * 256 * 2;
constexpr size_t WS_WBRA = WS_WKVUP + 2 * SZ_WKVUP;             constexpr size_t SZ_WBRA = (size_t)2048 * 512 * 2;
constexpr size_t WS_WBRB = WS_WBRA + 2 * SZ_WBRA;               constexpr size_t SZ_WBRB = SZ_WBRA;
constexpr size_t WS_WBRC = WS_WBRB + 2 * SZ_WBRB;               constexpr size_t SZ_WBRC = (size_t)2048 * 1024 * 2;
constexpr size_t WS_WOUT = WS_WBRC + 2 * SZ_WBRC;               constexpr size_t SZ_WOUT = (size_t)2048 * 2048 * 2;
constexpr size_t WS_WPQ = WS_WOUT + 2 * SZ_WOUT;                constexpr size_t SZ_WPQ = (size_t)1024 * 2048 * 2;
constexpr size_t WS_PSC = WS_WPQ + 2 * SZ_WPQ;
constexpr size_t WS_PU = WS_PSC + (size_t)4 * 16384 * 4;        constexpr size_t SZ_PT = (size_t)16384 * 1152;
constexpr size_t WS_PV = WS_PU + 2 * SZ_PT;
constexpr size_t WS_XC = WS_PV + 2 * SZ_PT;
constexpr size_t WS_HB = WS_XC + (size_t)NCTX * D * 4;
constexpr size_t WS_P1 = WS_HB + (size_t)NROW * D * 2;
constexpr size_t WS_G = WS_P1 + (size_t)NROW * NP1 * 2;
constexpr size_t WS_CQN = WS_G + (size_t)NROW * NG * 2;
constexpr size_t WS_CKVN = WS_CQN + (size_t)NROW * 512 * 2;
constexpr size_t WS_QM = WS_CKVN + (size_t)NROW * 256 * 2;
constexpr size_t SZ_Q128 = (size_t)NB * 8 * TT * 128 * 2;
constexpr size_t WS_KM = WS_QM + SZ_Q128;
constexpr size_t WS_VM = WS_KM + SZ_Q128;
constexpr size_t WS_QG = WS_VM + SZ_Q128 / 2;
constexpr size_t WS_KG = WS_QG + SZ_Q128;
constexpr size_t WS_VG = WS_KG + SZ_Q128 / 4;
constexpr size_t WS_RQ = WS_VG + SZ_Q128 / 4;
constexpr size_t WS_RK = WS_RQ + SZ_Q128 / 4;
constexpr size_t WS_RV = WS_RK + SZ_Q128 / 4;
constexpr size_t WS_ST = WS_RV + SZ_Q128 / 2;
constexpr size_t WS_OAB = WS_ST + (size_t)NB * 8 * 34 * 2 * 2048 * 4;
constexpr size_t WS_HB8 = WS_OAB + (size_t)NROW * D * 2;
constexpr size_t WS_MB8 = WS_HB8 + (size_t)NROW * D;
constexpr size_t WS_END = WS_MB8 + (size_t)NROW * D;
constexpr size_t WS_MB = WS_QM;
constexpr size_t WS_QP = WS_QG;
static_assert((size_t)NROW * D * 2 <= 2 * SZ_Q128, "MB alias");
static_assert((size_t)NROW * 1024 * 2 <= SZ_Q128, "QP alias");

__device__ __forceinline__ unsigned cvt_pk_bf16(float lo, float hi) { unsigned r; asm volatile("v_cvt_pk_bf16_f32 %0, %1, %2" : "=v"(r) : "v"(lo), "v"(hi)); return r; }
__device__ __forceinline__ bf16_t f2bf(float f) { return (bf16_t)(cvt_pk_bf16(f, 0.f) & 0xffffu); }
__device__ __forceinline__ float bf2f(bf16_t b) { return __uint_as_float(((unsigned)b) << 16); }
__device__ __forceinline__ float bflo(unsigned w) { return __uint_as_float(w << 16); }
__device__ __forceinline__ float bfhi(unsigned w) { return __uint_as_float(w & 0xffff0000u); }
template <int CTRL> __device__ __forceinline__ float dppf(float x) { return __int_as_float(__builtin_amdgcn_update_dpp(0, __float_as_int(x), CTRL, 0xF, 0xF, true)); }
__device__ __forceinline__ float row16_sum(float x) { x += dppf<0xB1>(x); x += dppf<0x4E>(x); x += dppf<0x141>(x); x += dppf<0x140>(x); return x; }
__device__ __forceinline__ float row16_max(float x) { x = fmaxf(x, dppf<0xB1>(x)); x = fmaxf(x, dppf<0x4E>(x)); x = fmaxf(x, dppf<0x141>(x)); x = fmaxf(x, dppf<0x140>(x)); return x; }
__device__ __forceinline__ float wave_sum(float x) {
    x = row16_sum(x);
    { auto r = __builtin_amdgcn_permlane16_swap(__float_as_uint(x), __float_as_uint(x), false, false); x = __uint_as_float(r[0]) + __uint_as_float(r[1]); }
    { auto r = __builtin_amdgcn_permlane32_swap(__float_as_uint(x), __float_as_uint(x), false, false); x = __uint_as_float(r[0]) + __uint_as_float(r[1]); }
    return x;
}
__device__ __forceinline__ unsigned pk4_fp8(float a, float b, float c, float d) { int t = 0; t = __builtin_amdgcn_cvt_pk_fp8_f32(a, b, t, false); t = __builtin_amdgcn_cvt_pk_fp8_f32(c, d, t, true); return (unsigned)t; }
__device__ __forceinline__ float clamp8(float x) { return fminf(fmaxf(x, -440.f), 440.f); }
__device__ __forceinline__ void fp8_scale(unsigned amax_bits, float& mul, float& inv) { const float am = __uint_as_float(amax_bits); int k = 0; if (am > 0.f) k = (int)floorf(log2f(256.f / am)); k = k > 60 ? 60 : (k < -60 ? -60 : k); mul = exp2f((float)k); inv = exp2f((float)-k); }
__device__ __forceinline__ float silu_f(float x) { return x / (1.f + __expf(-x)); }
__device__ __forceinline__ float sigmoid_f(float x) { return 1.f / (1.f + __expf(-x)); }

__device__ __forceinline__ int vt_off(int tpos) { const int kk = tpos & 63; return (tpos & ~63) + ((kk >> 2) & 1) * 32 + ((kk >> 5) & 1) * 16 + (kk & 3) + 4 * ((kk >> 3) & 3); }
struct RowInfo { int b, tpos, pr, pc, v; bool lat; };
__device__ __forceinline__ RowInfo rowinfo(int row) {
    RowInfo r;
    if (row < NLAT) { r.lat = true; r.b = row >> 12; const int t = row & 4095; r.tpos = CTXL + t; r.pr = t >> 6; r.pc = t & 63; r.v = r.b; }
    else { const int q = row - NLAT; r.lat = false; r.b = q >> 8; r.tpos = q & 255; r.pr = 0; r.pc = 0; r.v = 4; }
    return r;
}

#define XB_TMO      128
#define XB_XCNT(j)  (256  + 64 * (j))
#define XB_XSUB(j)  (1280 + 64 * (j))
#define XB_XGEN(j)  (2304 + 64 * (j))
#define XB_TOP      3328
#define XB_TOPGEN   3392
#define XCD_BAR_WORDS 3456
#define XB_SPIN_CAP (1u << 22)

__device__ __forceinline__ unsigned xb_ld(unsigned* p)              { return __hip_atomic_load(p, __ATOMIC_RELAXED, __HIP_MEMORY_SCOPE_AGENT); }
__device__ __forceinline__ unsigned xb_add(unsigned* p, unsigned v) { return __hip_atomic_fetch_add(p, v, __ATOMIC_RELAXED, __HIP_MEMORY_SCOPE_AGENT); }
__device__ __forceinline__ unsigned xb_xcc_id() { return (unsigned)__builtin_amdgcn_s_getreg((3 << 11) | 20) & 0xFu; }
#define XB_SPIN(cond, bar) do { unsigned _sp = 0; while (cond) { __builtin_amdgcn_s_sleep(1); \
    if ((++_sp & 255u) == 0u) { if (xb_ld(&(bar)[XB_TMO])) break; if (_sp > XB_SPIN_CAP) { atomicAdd(&(bar)[XB_TMO], 1u); break; } } } } while (0)

struct XcdBarrier { unsigned* bar; unsigned x; volatile LAS unsigned* st; };

__device__ __forceinline__ XcdBarrier xcd_barrier_post(unsigned* bar, volatile LAS unsigned* st) {
    XcdBarrier b; b.bar = bar; b.x = xb_xcc_id(); b.st = st;
    if (threadIdx.x == 0) (void)xb_add(&bar[XB_XCNT(b.x)], 1u);
    return b;
}
__device__ __forceinline__ void xcd_barrier_complete(unsigned* bar, unsigned x, unsigned& nloc, unsigned& nx) {
    const unsigned G = gridDim.x * gridDim.y * gridDim.z;
    unsigned sum, cnt, mine, sp = 0u;
    for (;;) {
        sum = 0u; cnt = 0u; mine = 0u;
#pragma unroll
        for (unsigned j = 0; j < 16; ++j) { const unsigned c = xb_ld(&bar[XB_XCNT(j)]); sum += c; cnt += (c > 0u) ? 1u : 0u; mine = (j == x) ? c : mine; }
        if (sum == G) break;
        __builtin_amdgcn_s_sleep(1);
        if ((++sp & 255u) == 0u) { if (xb_ld(&bar[XB_TMO])) break; if (sp > XB_SPIN_CAP) { atomicAdd(&bar[XB_TMO], 1u); break; } }
    }
    nloc = mine > 0u ? mine : 1u; nx = cnt > 0u ? cnt : 1u;
}
__device__ __forceinline__ void xcd_barrier(const XcdBarrier& b) {
    asm volatile("s_waitcnt vmcnt(0)" ::: "memory");
    __syncthreads();
    if (threadIdx.x == 0) {
        unsigned* bar = b.bar;
        __builtin_amdgcn_s_waitcnt(0);
        unsigned nloc = b.st[0], nx = b.st[1];
        if (nloc == 0u) { xcd_barrier_complete(bar, b.x, nloc, nx); b.st[0] = nloc; b.st[1] = nx; }
        const unsigned old = xb_add(&bar[XB_XSUB(b.x)], 1u);
        const unsigned gen = old / nloc;
        if (old + 1u == (gen + 1u) * nloc) {
            __builtin_amdgcn_fence(__ATOMIC_RELEASE, "agent");
            asm volatile("s_waitcnt vmcnt(0)" ::: "memory");
            const unsigned og = xb_add(&bar[XB_TOP], 1u);
            const unsigned tg = og / nx;
            if (og + 1u == (tg + 1u) * nx) xb_add(&bar[XB_TOPGEN], 1u);
            else XB_SPIN(xb_ld(&bar[XB_TOPGEN]) == tg, bar);
            __builtin_amdgcn_fence(__ATOMIC_ACQUIRE, "agent");
            xb_add(&bar[XB_XGEN(b.x)], 1u);
            asm volatile("s_waitcnt vmcnt(0)" ::: "memory");
        } else {
            XB_SPIN(xb_ld(&bar[XB_XGEN(b.x)]) == gen, bar);
            __builtin_amdgcn_fence(__ATOMIC_ACQUIRE, "agent");
            asm volatile("s_waitcnt vmcnt(0)" ::: "memory");
        }
    }
    __syncthreads();
}
namespace pg8 {
constexpr int BM = 256, BK = 64, HALF = 128, HTB = HALF * BK * 2, STAGE_BYTES = 8 * HTB, NXCD = 8, WGM = 8;
__host__ __device__ __forceinline__ int lds_byte(int r, int c) { const int st = (r >> 4) * 2 + (c >> 5), rr = r & 15, cc = c & 31, ob = rr * 64 + cc * 2; return st * 1024 + (ob ^ (((ob >> 9) & 1) << 5)); }
__host__ __device__ __forceinline__ void stage_rc(int b, int& R, int& C) { const int st = b / 1024, sb = b % 1024, swz = sb ^ (((sb >> 9) & 1) << 5); R = (st >> 1) * 16 + swz / 64; C = (st & 1) * 32 + (swz % 64) / 2; }
__host__ __device__ __forceinline__ int perm32(int rho) { const int n = rho >> 4, i = rho & 15; return 8 * (i >> 2) + 4 * n + (i & 3); }

struct Unit { int pm, pn; };
typedef int i32x8 __attribute__((ext_vector_type(8))); typedef int i32x4v __attribute__((ext_vector_type(4)));
__device__ __forceinline__ i32x8 cat8(const bf16x8 a, const bf16x8 b) { const i32x4v x = __builtin_bit_cast(i32x4v, a), y = __builtin_bit_cast(i32x4v, b); return __builtin_shufflevector(x, y, 0, 1, 2, 3, 4, 5, 6, 7); }
struct Gemm { const bf16_t* A; const bf16_t* Bt; int M, N, K, lda, ldb; };

struct StaticOrder {
    int nM, nN, nwg, G, c;
    __host__ __device__ void init(int M, int N, int G_, int c_) { nM = M / BM; nN = N / BM; nwg = nM * nN; G = G_; c = c_; }
    __host__ __device__ bool next(int i, Unit& u) const {
        const long L = (long)i * G + c; if (L >= nwg) return false;
        int wgid = (int)L; { const int q = nwg / NXCD, r = nwg % NXCD, xcd = wgid % NXCD, off = wgid / NXCD; wgid = (xcd < r ? xcd * (q + 1) : r * (q + 1) + (xcd - r) * q) + off; }
        const int nig = WGM * nN, gid = wgid / nig, fm = gid * WGM, gsz = (nM - fm) < WGM ? (nM - fm) : WGM;
        u.pm = fm + ((wgid % nig) % gsz); u.pn = (wgid % nig) / gsz; return true;
    }
    __device__ __forceinline__ void a_ready(const Unit&) const {}
    __device__ __forceinline__ void done(const Unit&) const {}
};

template <class Epi, class Sched, int GABL = 0>
__device__ __forceinline__ void gemm_phase(LAS unsigned char* lds, const int tid, const Gemm g, const Sched& S, const Epi& E) {
    const int  wid = __builtin_amdgcn_readfirstlane(tid >> 6), lane = tid & 63, wr = wid >> 2, wc = wid & 3, fr = lane & 15, fq = lane >> 4;
    const int K = g.K, nt = K / BK;
    unsigned voffA[2], voffB[2];
#pragma unroll
    for (int i = 0; i < 2; ++i) { int R, C; stage_rc(tid * 16 + i * 8192, R, C); const int Rb = Epi::PERM ? ((R & ~31) + perm32(R & 31)) : R;
        voffA[i] = (unsigned)(R * g.lda + C) * 2u; voffB[i] = (unsigned)(Rb * g.ldb + C) * 2u; }
    const size_t kstep = (size_t)(BK * 2);
    const size_t hstepA = (size_t)HALF * g.lda * 2, hstepB = (size_t)HALF * g.ldb * 2;
    const size_t tstepA = 2 * hstepA, tstepB = 2 * hstepB;
    const unsigned ldsw = (unsigned)wid * 1024u;
    const int aoff = lds_byte(wr * 64 + fr, fq * 8), boff = lds_byte(wc * 32 + fr, fq * 8);
#define PG8_SA(b, h) (((b) * 2 + (h)) * HTB)
#define PG8_SB(b, h) ((4 + (b) * 2 + (h)) * HTB)
#define PG8_STAGE(bufoff, gbase, voff) do { _Pragma("unroll") for (int _i = 0; _i < 2; ++_i) \
        __builtin_amdgcn_global_load_lds((const unsigned*)((const char*)(gbase) + (voff)[_i]), (LAS unsigned*)(lds + (bufoff) + ldsw + _i * 8192), 16, 0, 0); } while (0)
#define PG8_LDA(dst, b, h) do { if constexpr (Epi::FP8) { _Pragma("unroll") for (int m = 0; m < 4; ++m) { const i32x4v lo_ = *(const LAS i32x4v*)(lds + PG8_SA(b, h) + aoff + m * 2048), hi_ = *(const LAS i32x4v*)(lds + PG8_SA(b, h) + aoff + m * 2048 + 1024); \
            dst##8[m] = __builtin_shufflevector(lo_, hi_, 0, 1, 2, 3, 4, 5, 6, 7); } } \
        else { _Pragma("unroll") for (int m = 0; m < 4; ++m) _Pragma("unroll") for (int k = 0; k < 2; ++k) dst[m][k] = *(const LAS bf16x8*)(lds + PG8_SA(b, h) + aoff + m * 2048 + k * 1024); } } while (0)
#define PG8_LDB(dst, b, h) do { if constexpr (Epi::FP8) { _Pragma("unroll") for (int n = 0; n < 2; ++n) { const i32x4v lo_ = *(const LAS i32x4v*)(lds + PG8_SB(b, h) + boff + n * 2048), hi_ = *(const LAS i32x4v*)(lds + PG8_SB(b, h) + boff + n * 2048 + 1024); \
            dst##8[n] = __builtin_shufflevector(lo_, hi_, 0, 1, 2, 3, 4, 5, 6, 7); } } \
        else { _Pragma("unroll") for (int n = 0; n < 2; ++n) _Pragma("unroll") for (int k = 0; k < 2; ++k) dst[n][k] = *(const LAS bf16x8*)(lds + PG8_SB(b, h) + boff + n * 2048 + k * 1024); } } while (0)
#define PG8_MMA(ai, bj, At, Bt) do { __builtin_amdgcn_s_setprio(1); _Pragma("unroll") for (int m = 0; m < 4; ++m) _Pragma("unroll") for (int n = 0; n < 2; ++n) { \
        if constexpr (Epi::FP8) asm volatile("v_mfma_scale_f32_16x16x128_f8f6f4 %0, %1, %2, %0, %3, %3 op_sel_hi:[0,0,0]" : "+v"(acc[ai][bj][m][n]) : "v"(Bt##8[n]), "v"(At##8[m]), "v"(sc1_)); \
        else { _Pragma("unroll") for (int k = 0; k < 2; ++k) acc[ai][bj][m][n] = __builtin_amdgcn_mfma_f32_16x16x32_bf16(Bt[n][k], At[m][k], acc[ai][bj][m][n], 0, 0, 0); } } __builtin_amdgcn_s_setprio(0); } while (0)
#define PG8_WAIT_V(n) asm volatile("s_waitcnt vmcnt(" #n ")" ::: "memory")
#define PG8_WAIT_L(n) asm volatile("s_waitcnt lgkmcnt(" #n ")" ::: "memory")
#define PG8_BAR __builtin_amdgcn_s_barrier()
#define PG8_SCHED __builtin_amdgcn_sched_barrier(0)
    Unit cur, nxt; int ui = 0;
    if (!S.next(0, cur)) return;
    f32x4 acc[2][2][4][2];
#pragma unroll
    for (int a = 0; a < 2; ++a)
#pragma unroll
        for (int b = 0; b < 2; ++b)
#pragma unroll
            for (int m = 0; m < 4; ++m)
#pragma unroll
                for (int n = 0; n < 2; ++n) acc[a][b][m][n] = (f32x4){0.f, 0.f, 0.f, 0.f};
    int sc1_ = 0x7F7F7F7F; asm volatile("" : "+v"(sc1_));
    bf16x8 At[4][2], B0[2][2], B1[2][2]; i32x8 At8[4], B08[2], B18[2];
    const char* cA = (const char*)g.A + (size_t)cur.pm * tstepA; const char* cB = (const char*)g.Bt + (size_t)cur.pn * tstepB;
    S.a_ready(cur);
    PG8_STAGE(PG8_SB(0, 0), cB, voffB); PG8_STAGE(PG8_SA(0, 0), cA, voffA); PG8_STAGE(PG8_SB(0, 1), cB + hstepB, voffB); PG8_STAGE(PG8_SA(0, 1), cA + hstepA, voffA);
    if (wr == 1) PG8_BAR;
    PG8_WAIT_V(4); PG8_BAR;
    PG8_STAGE(PG8_SB(1, 0), cB + kstep, voffB); PG8_STAGE(PG8_SA(1, 0), cA + kstep, voffA); PG8_STAGE(PG8_SB(1, 1), cB + hstepB + kstep, voffB);
    PG8_WAIT_V(6); PG8_BAR;
    for (;;) {
        const bool has_next = S.next(ui + 1, nxt);
        const char* nA = has_next ? (const char*)g.A + (size_t)nxt.pm * tstepA : cA; const char* nB = has_next ? (const char*)g.Bt + (size_t)nxt.pn * tstepB : cB;
#pragma unroll 1
        for (int t = 0; t < nt; t += 2) {
            const bool last = (t == nt - 2);
            const char* a1 = cA + (size_t)(t + 1) * kstep;
            const char* a2 = last ? nA : cA + (size_t)(t + 2) * kstep; const char* b2 = last ? nB : cB + (size_t)(t + 2) * kstep;
            const char* a3 = a2 + kstep; const char* b3 = b2 + kstep;
            if (last && has_next) S.a_ready(nxt);
            PG8_LDB(B0, 0, 0); PG8_SCHED; PG8_LDA(At, 0, 0); PG8_STAGE(PG8_SA(1, 1), a1 + hstepA, voffA);
            PG8_WAIT_L(8); PG8_BAR; PG8_WAIT_L(0); PG8_MMA(0, 0, At, B0); PG8_BAR; PG8_SCHED;
            PG8_LDB(B1, 0, 1); PG8_STAGE(PG8_SB(0, 0), b2, voffB);
            PG8_BAR; PG8_WAIT_L(0); PG8_MMA(0, 1, At, B1); PG8_BAR;
            PG8_LDA(At, 0, 1); PG8_STAGE(PG8_SA(0, 0), a2, voffA);
            PG8_BAR; PG8_WAIT_L(0); PG8_MMA(1, 0, At, B0); PG8_BAR; PG8_SCHED;
            PG8_STAGE(PG8_SB(0, 1), b2 + hstepB, voffB);
            PG8_WAIT_V(6); PG8_BAR; PG8_MMA(1, 1, At, B1); PG8_BAR;
            PG8_LDB(B0, 1, 0); PG8_SCHED; PG8_LDA(At, 1, 0); PG8_STAGE(PG8_SA(0, 1), a2 + hstepA, voffA);
            PG8_WAIT_L(8); PG8_BAR; PG8_WAIT_L(0); PG8_MMA(0, 0, At, B0); PG8_BAR; PG8_SCHED;
            PG8_LDB(B1, 1, 1); PG8_STAGE(PG8_SB(1, 0), b3, voffB);
            PG8_BAR; PG8_WAIT_L(0); PG8_MMA(0, 1, At, B1); PG8_BAR;
            PG8_LDA(At, 1, 1); PG8_STAGE(PG8_SA(1, 0), a3, voffA);
            PG8_BAR; PG8_WAIT_L(0); PG8_MMA(1, 0, At, B0); PG8_BAR; PG8_SCHED;
            PG8_STAGE(PG8_SB(1, 1), b3 + hstepB, voffB);
            PG8_WAIT_V(6); PG8_BAR; PG8_MMA(1, 1, At, B1); PG8_BAR;
        }
        if constexpr (Epi::FP8) asm volatile("s_nop 15\n\ts_nop 15" ::: "memory");
        if constexpr (!(GABL & 1)) E(acc, cur, wr, wc, fr, fq); else asm volatile("" :: "v"(acc[0][0][0][0]), "v"(acc[1][1][3][1]), "v"(acc[0][1][2][0]), "v"(acc[1][0][1][1]));
        if (!has_next) break;
#pragma unroll
        for (int a = 0; a < 2; ++a)
#pragma unroll
            for (int b = 0; b < 2; ++b)
#pragma unroll
                for (int m = 0; m < 4; ++m)
#pragma unroll
                    for (int n = 0; n < 2; ++n) acc[a][b][m][n] = (f32x4){0.f, 0.f, 0.f, 0.f};
        cur = nxt; cA = nA; cB = nB; ++ui;
    }
    PG8_WAIT_V(0);
    if (wr == 0) PG8_BAR;
    PG8_BAR;
#undef PG8_SA
#undef PG8_SB
#undef PG8_STAGE
#undef PG8_LDA
#undef PG8_LDB
#undef PG8_MMA
#undef PG8_WAIT_V
#undef PG8_WAIT_L
#undef PG8_BAR
#undef PG8_SCHED
}
}

typedef f32x4 Acc[2][2][4][2];
#define EPI_LOOP_ROWS for (int ai = 0; ai < 2; ++ai) for (int m = 0; m < 4; ++m)
__device__ __forceinline__ u32x4 pack8(const f32x4 a, const f32x4 b) { u32x4 w; w.x = cvt_pk_bf16(a[0], a[1]); w.y = cvt_pk_bf16(a[2], a[3]); w.z = cvt_pk_bf16(b[0], b[1]); w.w = cvt_pk_bf16(b[2], b[3]); return w; }

struct EpiIn {
    static constexpr bool PERM = true, FP8 = true;
    bf16_t* P1; bf16_t* G; float inv;
    __device__ __forceinline__ void operator()(const Acc& acc, const pg8::Unit& u, int wr, int wc, int fr, int fq) const {
        const int row0 = u.pm * 256 + wr * 64 + fr; const bool gate = u.pn >= 16;
        bf16_t* base = gate ? G : P1; const int ld = gate ? NG : NP1; const int col0 = (gate ? (u.pn - 16) : u.pn) * 256 + wc * 32 + 8 * fq;
#pragma unroll
        for (int ai = 0; ai < 2; ++ai)
#pragma unroll
            for (int m = 0; m < 4; ++m) { bf16_t* rowp = base + (size_t)(row0 + ai * 128 + m * 16) * ld + col0;
#pragma unroll
                for (int bj = 0; bj < 2; ++bj) { f32x4 v0 = acc[ai][bj][m][0] * inv, v1 = acc[ai][bj][m][1] * inv;
                    if (gate) {
#pragma unroll
                        for (int j = 0; j < 4; ++j) { v0[j] = sigmoid_f(v0[j]); v1[j] = sigmoid_f(v1[j]); } }
                    *(u32x4*)(rowp + bj * 128) = pack8(v0, v1); } }
    }
};
struct EpiPlain {
    static constexpr bool PERM = true, FP8 = false;
    bf16_t* O; int ldc;
    __device__ __forceinline__ void operator()(const Acc& acc, const pg8::Unit& u, int wr, int wc, int fr, int fq) const {
        const int row0 = u.pm * 256 + wr * 64 + fr; const int col0 = u.pn * 256 + wc * 32 + 8 * fq;
#pragma unroll
        for (int ai = 0; ai < 2; ++ai)
#pragma unroll
            for (int m = 0; m < 4; ++m) { bf16_t* rowp = O + (size_t)(row0 + ai * 128 + m * 16) * ldc + col0;
#pragma unroll
                for (int bj = 0; bj < 2; ++bj) *(u32x4*)(rowp + bj * 128) = pack8(acc[ai][bj][m][0], acc[ai][bj][m][1]); }
    }
};
__device__ __forceinline__ void tile_info(int pm, int& b, int& tpos0, bool& lat) { lat = pm < 64; b = lat ? (pm >> 4) : (pm - 64); tpos0 = lat ? CTXL + ((pm & 15) << 8) : 0; }
struct EpiQup {
    static constexpr bool PERM = true, FP8 = false;
    unsigned char* QM; const f32x2* cs32;
    __device__ __forceinline__ void operator()(const Acc& acc, const pg8::Unit& u, int wr, int wc, int fr, int fq) const {
        int b, tpos0; bool lat; tile_info(u.pm, b, tpos0, lat);
        const int r0 = wr * 64 + fr;
#pragma unroll
        for (int bj = 0; bj < 2; ++bj) { const int c0 = u.pn * 256 + bj * 128 + wc * 32 + 8 * fq; const int hh = c0 / 96, j0 = c0 - hh * 96;
            unsigned char* hb = QM + ((size_t)(b * 8 + hh) * TT + tpos0 + r0) * 128;
            if (j0 < 64) {
#pragma unroll
                for (int ai = 0; ai < 2; ++ai)
#pragma unroll
                    for (int m = 0; m < 4; ++m) { const f32x4 a_ = acc[ai][bj][m][0], b_ = acc[ai][bj][m][1]; u32x2 w8; w8.x = pk4_fp8(clamp8(a_[0]), clamp8(a_[1]), clamp8(a_[2]), clamp8(a_[3])); w8.y = pk4_fp8(clamp8(b_[0]), clamp8(b_[1]), clamp8(b_[2]), clamp8(b_[3]));
                        *(u32x2*)(hb + (ai * 128 + m * 16) * 128 + j0) = w8; }
            } else { const int g8 = (j0 - 64) >> 3, part = g8 >> 1, pbase = (g8 & 1) * 4;
#pragma unroll
                for (int ai = 0; ai < 2; ++ai)
#pragma unroll
                    for (int m = 0; m < 4; ++m) { const int t = tpos0 - CTXL + r0 + ai * 128 + m * 16; const int pos = part ? (t & 63) : (t >> 6);
                        const f32x4 v0 = acc[ai][bj][m][0], v1 = acc[ai][bj][m][1];
                        float o1[4], o2[4]; const float x1[4] = {v0[0], v0[2], v1[0], v1[2]}, x2[4] = {v0[1], v0[3], v1[1], v1[3]};
#pragma unroll
                        for (int p = 0; p < 4; ++p) { const f32x2 cs = lat ? cs32[pos * 8 + pbase + p] : (f32x2){1.f, 0.f};
                            o1[p] = x1[p] * cs.x - x2[p] * cs.y; o2[p] = x1[p] * cs.y + x2[p] * cs.x; }
                        unsigned char* dst = hb + (ai * 128 + m * 16) * 128 + 64 + part * 16 + pbase;
                        *(unsigned*)dst = pk4_fp8(clamp8(o1[0]), clamp8(o1[1]), clamp8(o1[2]), clamp8(o1[3])); *(unsigned*)(dst + 8) = pk4_fp8(clamp8(o2[0]), clamp8(o2[1]), clamp8(o2[2]), clamp8(o2[3])); } } }
    }
};
struct EpiKvup {
    static constexpr bool PERM = true, FP8 = false;
    unsigned char* KM; unsigned char* VM;
    __device__ __forceinline__ void operator()(const Acc& acc, const pg8::Unit& u, int wr, int wc, int fr, int fq) const {
        int b, tpos0; bool lat; tile_info(u.pm, b, tpos0, lat);
        const int r0 = wr * 64 + fr; const int j0 = wc * 32 + 8 * fq;
#pragma unroll
        for (int bj = 0; bj < 2; ++bj) { const size_t tok = (size_t)(b * 8 + u.pn * 2 + bj) * TT + tpos0 + r0;
            if (j0 < 64) { unsigned char* d = KM + tok * 128 + j0;
#pragma unroll
                for (int ai = 0; ai < 2; ++ai)
#pragma unroll
                    for (int m = 0; m < 4; ++m) { const f32x4 a_ = acc[ai][bj][m][0], b_ = acc[ai][bj][m][1]; u32x2 w8; w8.x = pk4_fp8(clamp8(a_[0]), clamp8(a_[1]), clamp8(a_[2]), clamp8(a_[3])); w8.y = pk4_fp8(clamp8(b_[0]), clamp8(b_[1]), clamp8(b_[2]), clamp8(b_[3]));
                        *(u32x2*)(d + (ai * 128 + m * 16) * 128) = w8; } }
            else { unsigned char* d = VM + ((size_t)(b * 8 + u.pn * 2 + bj) * 64 + (j0 - 64)) * TT;
#pragma unroll
                for (int ai = 0; ai < 2; ++ai)
#pragma unroll
                    for (int m = 0; m < 4; ++m) { const f32x4 a_ = acc[ai][bj][m][0], b_ = acc[ai][bj][m][1]; const unsigned w0_ = pk4_fp8(clamp8(a_[0]), clamp8(a_[1]), clamp8(a_[2]), clamp8(a_[3])), w1_ = pk4_fp8(clamp8(b_[0]), clamp8(b_[1]), clamp8(b_[2]), clamp8(b_[3]));
                        unsigned char* q_ = d + vt_off(tpos0 + r0 + ai * 128 + m * 16);
                        q_[0] = (unsigned char)(w0_ & 0xffu); q_[TT] = (unsigned char)((w0_ >> 8) & 0xffu); q_[2 * TT] = (unsigned char)((w0_ >> 16) & 0xffu); q_[3 * TT] = (unsigned char)(w0_ >> 24);
                        q_[4 * TT] = (unsigned char)(w1_ & 0xffu); q_[5 * TT] = (unsigned char)((w1_ >> 8) & 0xffu); q_[6 * TT] = (unsigned char)((w1_ >> 16) & 0xffu); q_[7 * TT] = (unsigned char)(w1_ >> 24); } } }
    }
};
template <int SEG> struct EpiMerge {
    static constexpr bool PERM = true, FP8 = false;
    bf16_t* MB; const bf16_t* G; unsigned char* MB8;
    __device__ __forceinline__ void operator()(const Acc& acc, const pg8::Unit& u, int wr, int wc, int fr, int fq) const {
        const int row0 = u.pm * 256 + wr * 64 + fr; const int col0 = u.pn * 256 + wc * 32 + 8 * fq;
        const bf16_t* gp = G + (size_t)row0 * NG + SEG * 2048 + col0; bf16_t* mp = MB + (size_t)row0 * D + col0; unsigned char* m8 = MB8 + (size_t)row0 * D + col0;
#pragma unroll
        for (int ai = 0; ai < 2; ++ai) {
            u32x4 gw[4][2], ow[4][2];
#pragma unroll
            for (int m = 0; m < 4; ++m)
#pragma unroll
                for (int bj = 0; bj < 2; ++bj) { const size_t ro = (size_t)(ai * 128 + m * 16);
                    gw[m][bj] = *(const u32x4*)(gp + ro * NG + bj * 128);
                    if (SEG > 0) ow[m][bj] = __builtin_nontemporal_load((const u32x4*)(mp + ro * D + bj * 128)); }
#pragma unroll
            for (int m = 0; m < 4; ++m)
#pragma unroll
                for (int bj = 0; bj < 2; ++bj) { const size_t ro = (size_t)(ai * 128 + m * 16); const u32x4 g_ = gw[m][bj];
                    f32x4 v0 = acc[ai][bj][m][0], v1 = acc[ai][bj][m][1];
                    if (ABL_BR & (1 << SEG)) { v0 = (f32x4){0.f, 0.f, 0.f, 0.f}; v1 = v0; }
                    v0[0] *= bflo(g_.x); v0[1] *= bfhi(g_.x); v0[2] *= bflo(g_.y); v0[3] *= bfhi(g_.y);
                    v1[0] *= bflo(g_.z); v1[1] *= bfhi(g_.z); v1[2] *= bflo(g_.w); v1[3] *= bfhi(g_.w);
                    if (SEG > 0) { const u32x4 o = ow[m][bj];
                        v0[0] += bflo(o.x); v0[1] += bfhi(o.x); v0[2] += bflo(o.y); v0[3] += bfhi(o.y);
                        v1[0] += bflo(o.z); v1[1] += bfhi(o.z); v1[2] += bflo(o.w); v1[3] += bfhi(o.w); }
                    if (SEG < 2) *(u32x4*)(mp + ro * D + bj * 128) = pack8(v0, v1);
                    else { u32x2 w8; w8.x = pk4_fp8(clamp8(v0[0] * 16.f), clamp8(v0[1] * 16.f), clamp8(v0[2] * 16.f), clamp8(v0[3] * 16.f)); w8.y = pk4_fp8(clamp8(v1[0] * 16.f), clamp8(v1[1] * 16.f), clamp8(v1[2] * 16.f), clamp8(v1[3] * 16.f));
                        *(u32x2*)(m8 + ro * D + bj * 128) = w8; } }
        }
    }
};
namespace pg8 {
struct Merge3 { const bf16_t* A; const bf16_t* B0; const bf16_t* B1; const bf16_t* B2; const bf16_t* G; unsigned char* MB8; float r01, r12, fin; };
template <class Sched>
__device__ __forceinline__ void gemm_merge3(LAS unsigned char* lds, const int tid, const Merge3 g, const Sched& S) {
    const int wid = __builtin_amdgcn_readfirstlane(tid >> 6), lane = tid & 63, wr = wid >> 2, wc = wid & 3, fr = lane & 15, fq = lane >> 4;
    constexpr int NT = 16, LDA = 1024;
    int sc1_ = 0x7F7F7F7F; asm volatile("" : "+v"(sc1_));
    unsigned voffA[2], voffB5[2], voffB10[2];
#pragma unroll
    for (int i = 0; i < 2; ++i) { int R, C; stage_rc(tid * 16 + i * 8192, R, C); const int Rb = (R & ~31) + perm32(R & 31);
        voffA[i] = (unsigned)(R * LDA + C) * 2u; voffB5[i] = (unsigned)(Rb * 256 + C) * 2u; voffB10[i] = (unsigned)(Rb * 512 + C) * 2u; }
    const size_t kstep = (size_t)(BK * 2);
    const size_t hstepA = (size_t)HALF * LDA * 2, tstepA = 2 * hstepA;
    const unsigned ldsw = (unsigned)wid * 1024u;
    const int aoff = lds_byte(wr * 64 + fr, fq * 8), boff = lds_byte(wc * 32 + fr, fq * 8);
#define M3_TA(pm_, t_) ((const char*)g.A + (size_t)(pm_) * tstepA + (size_t)(t_) * kstep)
#define M3_TB(pn_, t_) ((t_) < 4 ? (const char*)g.B0 + (size_t)(pn_) * 131072 + (size_t)(t_) * kstep : ((t_) < 8 ? (const char*)g.B1 + (size_t)(pn_) * 131072 + (size_t)((t_) - 4) * kstep : (const char*)g.B2 + (size_t)(pn_) * 262144 + (size_t)((t_) - 8) * kstep))
#define PG8_SA(b, h) (((b) * 2 + (h)) * HTB)
#define PG8_SB(b, h) ((4 + (b) * 2 + (h)) * HTB)
#define PG8_STAGE(bufoff, gbase, voff) do { _Pragma("unroll") for (int _i = 0; _i < 2; ++_i) \
        __builtin_amdgcn_global_load_lds((const unsigned*)((const char*)(gbase) + (voff)[_i]), (LAS unsigned*)(lds + (bufoff) + ldsw + _i * 8192), 16, 0, 0); } while (0)
#define PG8_LDA(dst, b, h) do { _Pragma("unroll") for (int m = 0; m < 4; ++m) { const i32x4v lo_ = *(const LAS i32x4v*)(lds + PG8_SA(b, h) + aoff + m * 2048), hi_ = *(const LAS i32x4v*)(lds + PG8_SA(b, h) + aoff + m * 2048 + 1024); dst[m] = __builtin_shufflevector(lo_, hi_, 0, 1, 2, 3, 4, 5, 6, 7); } } while (0)
#define PG8_LDB(dst, b, h) do { _Pragma("unroll") for (int n = 0; n < 2; ++n) { const i32x4v lo_ = *(const LAS i32x4v*)(lds + PG8_SB(b, h) + boff + n * 2048), hi_ = *(const LAS i32x4v*)(lds + PG8_SB(b, h) + boff + n * 2048 + 1024); dst[n] = __builtin_shufflevector(lo_, hi_, 0, 1, 2, 3, 4, 5, 6, 7); } } while (0)
#define PG8_MMA(ai, bj, At, Bt) do { __builtin_amdgcn_s_setprio(1); _Pragma("unroll") for (int m = 0; m < 4; ++m) _Pragma("unroll") for (int n = 0; n < 2; ++n) \
        asm volatile("v_mfma_scale_f32_16x16x128_f8f6f4 %0, %1, %2, %0, %3, %3 op_sel_hi:[0,0,0]" : "+v"(acc[ai][bj][m][n]) : "v"(Bt[n]), "v"(At[m]), "v"(sc1_)); __builtin_amdgcn_s_setprio(0); } while (0)
#define PG8_WAIT_V(n) asm volatile("s_waitcnt vmcnt(" #n ")" ::: "memory")
#define PG8_WAIT_L(n) asm volatile("s_waitcnt lgkmcnt(" #n ")" ::: "memory")
#define PG8_BAR __builtin_amdgcn_s_barrier()
#define PG8_SCHED __builtin_amdgcn_sched_barrier(0)
    Unit cur, nxt; int ui = 0;
    if (!S.next(0, cur)) return;
    f32x4 acc[2][2][4][2];
#pragma unroll
    for (int a = 0; a < 2; ++a)
#pragma unroll
        for (int b = 0; b < 2; ++b)
#pragma unroll
            for (int m = 0; m < 4; ++m)
#pragma unroll
                for (int n = 0; n < 2; ++n) acc[a][b][m][n] = (f32x4){0.f, 0.f, 0.f, 0.f};
    i32x8 At[4], B0[2], B1[2];
    { const char* cA = M3_TA(cur.pm, 0); const char* cB = M3_TB(cur.pn, 0); const size_t hB = 65536;
      PG8_STAGE(PG8_SB(0, 0), cB, voffB5); PG8_STAGE(PG8_SA(0, 0), cA, voffA); PG8_STAGE(PG8_SB(0, 1), cB + hB, voffB5); PG8_STAGE(PG8_SA(0, 1), cA + hstepA, voffA);
      if (wr == 1) PG8_BAR;
      PG8_WAIT_V(4); PG8_BAR;
      PG8_STAGE(PG8_SB(1, 0), cB + kstep, voffB5); PG8_STAGE(PG8_SA(1, 0), cA + kstep, voffA); PG8_STAGE(PG8_SB(1, 1), cB + hB + kstep, voffB5);
      PG8_WAIT_V(6); PG8_BAR; }
    const int r0 = wr * 64 + fr, c0l = wc * 32 + 8 * fq;
    for (;;) {
        const bool has_next = S.next(ui + 1, nxt);
        const int npm = has_next ? nxt.pm : cur.pm, npn = has_next ? nxt.pn : cur.pn;
#pragma unroll 1
        for (int t = 0; t < NT; t += 2) {
            const bool last = (t == NT - 2);
            const int t2 = last ? 0 : t + 2;
            const char* a1 = M3_TA(cur.pm, t + 1);
            const char* a2 = last ? M3_TA(npm, 0) : M3_TA(cur.pm, t + 2); const char* b2 = last ? M3_TB(npn, 0) : M3_TB(cur.pn, t + 2);
            const char* a3 = a2 + kstep; const char* b3 = b2 + kstep;
            const bool wide = t2 >= 8; const size_t hB = wide ? 131072 : 65536;
            unsigned vB[2]; vB[0] = wide ? voffB10[0] : voffB5[0]; vB[1] = wide ? voffB10[1] : voffB5[1];
            PG8_LDB(B0, 0, 0); PG8_SCHED; PG8_LDA(At, 0, 0); PG8_STAGE(PG8_SA(1, 1), a1 + hstepA, voffA);
            PG8_WAIT_L(8); PG8_BAR; PG8_WAIT_L(0); PG8_MMA(0, 0, At, B0); PG8_BAR; PG8_SCHED;
            PG8_LDB(B1, 0, 1); PG8_STAGE(PG8_SB(0, 0), b2, vB);
            PG8_BAR; PG8_WAIT_L(0); PG8_MMA(0, 1, At, B1); PG8_BAR;
            PG8_LDA(At, 0, 1); PG8_STAGE(PG8_SA(0, 0), a2, voffA);
            PG8_BAR; PG8_WAIT_L(0); PG8_MMA(1, 0, At, B0); PG8_BAR; PG8_SCHED;
            PG8_STAGE(PG8_SB(0, 1), b2 + hB, vB);
            PG8_WAIT_V(6); PG8_BAR; PG8_MMA(1, 1, At, B1); PG8_BAR;
            PG8_LDB(B0, 1, 0); PG8_SCHED; PG8_LDA(At, 1, 0); PG8_STAGE(PG8_SA(0, 1), a2 + hstepA, voffA);
            PG8_WAIT_L(8); PG8_BAR; PG8_WAIT_L(0); PG8_MMA(0, 0, At, B0); PG8_BAR; PG8_SCHED;
            PG8_LDB(B1, 1, 1); PG8_STAGE(PG8_SB(1, 0), b3, vB);
            PG8_BAR; PG8_WAIT_L(0); PG8_MMA(0, 1, At, B1); PG8_BAR;
            PG8_LDA(At, 1, 1); PG8_STAGE(PG8_SA(1, 0), a3, voffA);
            PG8_BAR; PG8_WAIT_L(0); PG8_MMA(1, 0, At, B0); PG8_BAR; PG8_SCHED;
            PG8_STAGE(PG8_SB(1, 1), b3 + hB, vB);
            PG8_WAIT_V(6); PG8_BAR; PG8_MMA(1, 1, At, B1); PG8_BAR;
            if (t == 2 || t == 6) {
                asm volatile("s_nop 15\n\ts_nop 15" ::: "memory");
                const int sg = t == 2 ? 0 : 1; const float wr_ = sg ? g.r12 : g.r01;
                const bf16_t* gp = g.G + (size_t)(cur.pm * 256 + r0) * NG + sg * 2048 + cur.pn * 256 + c0l;
#pragma unroll
                for (int ai = 0; ai < 2; ++ai) { u32x4 ga[4][2], gb[4][2];
#pragma unroll
                    for (int m = 0; m < 4; ++m)
#pragma unroll
                        for (int bj = 0; bj < 2; ++bj) { const bf16_t* q_ = gp + (size_t)(ai * 128 + m * 16) * NG + bj * 128; ga[m][bj] = *(const u32x4*)q_; gb[m][bj] = *(const u32x4*)(q_ + 2048); }
#pragma unroll
                    for (int m = 0; m < 4; ++m)
#pragma unroll
                        for (int bj = 0; bj < 2; ++bj) { const u32x4 x_ = ga[m][bj], y_ = gb[m][bj];
#define M3_RT(xw, yw, lohi) (fmaxf(lohi(xw), 1e-6f) * wr_ * __builtin_amdgcn_rcpf(fmaxf(lohi(yw), 1e-6f)))
                            acc[ai][bj][m][0][0] *= M3_RT(x_.x, y_.x, bflo); acc[ai][bj][m][0][1] *= M3_RT(x_.x, y_.x, bfhi); acc[ai][bj][m][0][2] *= M3_RT(x_.y, y_.y, bflo); acc[ai][bj][m][0][3] *= M3_RT(x_.y, y_.y, bfhi);
                            acc[ai][bj][m][1][0] *= M3_RT(x_.z, y_.z, bflo); acc[ai][bj][m][1][1] *= M3_RT(x_.z, y_.z, bfhi); acc[ai][bj][m][1][2] *= M3_RT(x_.w, y_.w, bflo); acc[ai][bj][m][1][3] *= M3_RT(x_.w, y_.w, bfhi); } }
                asm volatile("s_waitcnt vmcnt(0)" ::: "memory");
            }
        }
        asm volatile("s_nop 15\n\ts_nop 15" ::: "memory");
        { const bf16_t* gp = g.G + (size_t)(cur.pm * 256 + r0) * NG + 2 * 2048 + cur.pn * 256 + c0l; unsigned char* m8 = g.MB8 + (size_t)(cur.pm * 256 + r0) * D + cur.pn * 256 + c0l;
#pragma unroll
          for (int ai = 0; ai < 2; ++ai) { u32x4 gc[4][2];
#pragma unroll
              for (int m = 0; m < 4; ++m)
#pragma unroll
                  for (int bj = 0; bj < 2; ++bj) gc[m][bj] = *(const u32x4*)(gp + (size_t)(ai * 128 + m * 16) * NG + bj * 128);
#pragma unroll
              for (int m = 0; m < 4; ++m)
#pragma unroll
                  for (int bj = 0; bj < 2; ++bj) { const u32x4 z_ = gc[m][bj]; const f32x4 v0 = acc[ai][bj][m][0], v1 = acc[ai][bj][m][1];
                      u32x2 w8; const float f_ = g.fin;
                      w8.x = pk4_fp8(clamp8(v0[0] * fmaxf(bflo(z_.x), 1e-6f) * f_), clamp8(v0[1] * fmaxf(bfhi(z_.x), 1e-6f) * f_), clamp8(v0[2] * fmaxf(bflo(z_.y), 1e-6f) * f_), clamp8(v0[3] * fmaxf(bfhi(z_.y), 1e-6f) * f_));
                      w8.y = pk4_fp8(clamp8(v1[0] * fmaxf(bflo(z_.z), 1e-6f) * f_), clamp8(v1[1] * fmaxf(bfhi(z_.z), 1e-6f) * f_), clamp8(v1[2] * fmaxf(bflo(z_.w), 1e-6f) * f_), clamp8(v1[3] * fmaxf(bfhi(z_.w), 1e-6f) * f_));
                      *(u32x2*)(m8 + (size_t)(ai * 128 + m * 16) * D + bj * 128) = w8; } } }
        if (!has_next) break;
#pragma unroll
        for (int a = 0; a < 2; ++a)
#pragma unroll
            for (int b = 0; b < 2; ++b)
#pragma unroll
                for (int m = 0; m < 4; ++m)
#pragma unroll
                    for (int n = 0; n < 2; ++n) acc[a][b][m][n] = (f32x4){0.f, 0.f, 0.f, 0.f};
        cur = nxt; ++ui;
    }
    PG8_WAIT_V(0);
    if (wr == 0) PG8_BAR;
    PG8_BAR;
#undef M3_RT
#undef M3_TA
#undef M3_TB
#undef PG8_SA
#undef PG8_SB
#undef PG8_STAGE
#undef PG8_LDA
#undef PG8_LDB
#undef PG8_MMA
#undef PG8_WAIT_V
#undef PG8_WAIT_L
#undef PG8_BAR
#undef PG8_SCHED
}
}
struct EpiOut {
    static constexpr bool PERM = false, FP8 = true;
    const float* src_lat; const float* src_ctx; float* dst_lat; float* dst_ctx; const float* g1; float inv;
    __device__ __forceinline__ void operator()(const Acc& acc, const pg8::Unit& u, int wr, int wc, int fr, int fq) const {
        const int row0 = u.pm * 256 + wr * 64 + fr; const int col0 = u.pn * 256 + wc * 32 + 4 * fq;
        const bool lat = (u.pm * 256) < NLAT;
        const float* src = (lat ? src_lat : src_ctx - (size_t)NLAT * D) + (size_t)row0 * D + col0; float* dst = (lat ? dst_lat : dst_ctx - (size_t)NLAT * D) + (size_t)row0 * D + col0;
#pragma unroll
        for (int ai = 0; ai < 2; ++ai) { const int rbase = u.pm * 256 + ai * 128 + wr * 64; const int v = lat ? (rbase >> 12) : 4; const float* gp = g1 + (size_t)v * 12288 + col0;
            f32x4 gg[2][2];
#pragma unroll
            for (int bj = 0; bj < 2; ++bj)
#pragma unroll
                for (int n = 0; n < 2; ++n) gg[bj][n] = *(const f32x4*)(gp + bj * 128 + n * 16);
#pragma unroll
            for (int mh = 0; mh < 2; ++mh) {
                f32x4 xr[2][2][2];
#pragma unroll
                for (int mm = 0; mm < 2; ++mm)
#pragma unroll
                    for (int bj = 0; bj < 2; ++bj)
#pragma unroll
                        for (int n = 0; n < 2; ++n) xr[mm][bj][n] = __builtin_nontemporal_load((const f32x4*)(src + (size_t)(ai * 128 + (mh * 2 + mm) * 16) * D + bj * 128 + n * 16));
#pragma unroll
                for (int mm = 0; mm < 2; ++mm)
#pragma unroll
                    for (int bj = 0; bj < 2; ++bj)
#pragma unroll
                        for (int n = 0; n < 2; ++n) { const int m = mh * 2 + mm;
                            *(f32x4*)(dst + (size_t)(ai * 128 + m * 16) * D + bj * 128 + n * 16) = ABL_MIX ? xr[mm][bj][n] * ALPHA : xr[mm][bj][n] * ALPHA + gg[bj][n] * (acc[ai][bj][m][n] * inv); } } }
    }
};

struct Args { const float* in[27]; float* out; unsigned char* ws; int ph_lo, ph_hi; };
typedef const Args __attribute__((address_space(4)))* ArgP;
struct Frame {
    LAS unsigned char* lds; int tid, lane, wave, G, bid;
    ArgP ap; float* out; unsigned char* ws;
    __device__ __forceinline__ const float* in(int i) const { return ap->in[i]; }
};
__device__ __forceinline__ Frame make_frame(ArgP ap) {
    { unsigned long long t = (unsigned long long)ap; asm volatile("" : "+s"(t)); ap = (ArgP)t; }
    extern __shared__ __attribute__((aligned(16))) unsigned char lds_raw[];
    Frame F; F.lds = (LAS unsigned char*)lds_raw; { int t_ = threadIdx.x; asm volatile("" : "+v"(t_)); F.tid = t_; }
    F.lane = F.tid & 63; F.wave = __builtin_amdgcn_readfirstlane(F.tid >> 6); F.G = gridDim.x; F.bid = blockIdx.x;
    F.ap = ap; F.out = ap->out; F.ws = ap->ws; return F;
}
template <class T> __device__ __forceinline__ T* wsp(const Frame& F, size_t off) { return (T*)(F.ws + off); }

__device__ __forceinline__ int win_col(int n) {
    if (n < 768) return n;
    if (n < 1792) return 2336 + (n - 768);
    if (n < 2048) return 3360 + (n - 1792);
    if (n < 2304) return 3616 + (n - 2048);
    if (n < 2560) return 800 + (n - 2304);
    if (n < 2816) return 1056 + (n - 2560);
    if (n < 3328) return 1312 + (n - 2816);
    if (n < 3840) return 1824 + (n - 3328);
    if (n < 3872) return 768 + (n - 3840);
    if (n < 4096) return -1;
    return 3872 + (n - 4096);
}
__device__ __forceinline__ int qup_col(int c) {
    const int hh = c / 96, j = c - hh * 96;
    if (j < 64) return c;
    const int jj = j - 64, g8 = jj >> 3, i = jj & 7, p = i >> 1, which = i & 1, part = g8 >> 1, pi = (g8 & 1) * 4 + p;
    return hh * 96 + 64 + part * 16 + which * 8 + pi;
}
template <int MAP>
__device__ __forceinline__ void transpose_cvt(const Frame& F, const float* __restrict__ src, bf16_t* __restrict__ dst, int K, int Nsrc, int Nd) {
    LAS float* tile = (LAS float*)F.lds;
    const int tk = K / 256, tn = Nd / 64, ntile = tk * tn;
    for (int t = F.bid; t < ntile; t += F.G) {
        const int k0 = (t % tk) * 256, n0 = (t / tk) * 64;
        const int nl = F.tid & 63, kq = F.tid >> 6;
        const int nd = n0 + nl; const int ns = MAP == 0 ? nd : (MAP == 1 ? win_col(nd) : qup_col(nd));
        float v[32];
#pragma unroll
        for (int i = 0; i < 32; ++i) v[i] = ns >= 0 ? src[(size_t)(k0 + kq + 8 * i) * Nsrc + ns] : 0.f;
#pragma unroll
        for (int i = 0; i < 32; ++i) tile[(kq + 8 * i) * 65 + nl] = v[i];
        __syncthreads();
        { const int n = F.tid >> 3, k32 = (F.tid & 7) * 32;
#pragma unroll
          for (int c = 0; c < 4; ++c) { float w[8];
#pragma unroll
              for (int j = 0; j < 8; ++j) w[j] = tile[(k32 + c * 8 + j) * 65 + n];
              u32x4 o; o.x = cvt_pk_bf16(w[0], w[1]); o.y = cvt_pk_bf16(w[2], w[3]); o.z = cvt_pk_bf16(w[4], w[5]); o.w = cvt_pk_bf16(w[6], w[7]);
              *(u32x4*)(dst + (size_t)(n0 + n) * K + k0 + k32 + c * 8) = o; } }
        __syncthreads();
    }
}
__device__ __forceinline__ void cvt_rows(const Frame& F, const float* __restrict__ src, bf16_t* __restrict__ dst, size_t n8) {
    for (size_t i = (size_t)F.bid * 512 + F.tid; i < n8; i += (size_t)F.G * 512) {
        const f32x4 a = __builtin_nontemporal_load((const f32x4*)(src + i * 8)), b = __builtin_nontemporal_load((const f32x4*)(src + i * 8 + 4));
        *(u32x4*)(dst + i * 8) = pack8(a, b);
    }
}
__device__ __forceinline__ void cvt_peer(const Frame& F, int l);
__device__ __forceinline__ void absmax_f32(const Frame& F, const float* __restrict__ src, size_t n4, unsigned* dst) {
    float am = 0.f;
    const size_t stride = (size_t)F.G * 512; size_t i = (size_t)F.bid * 512 + F.tid;
    for (; i + 7 * stride < n4; i += 8 * stride) { f32x4 a[8];
#pragma unroll
        for (int j = 0; j < 8; ++j) a[j] = __builtin_nontemporal_load((const f32x4*)(src + (i + j * stride) * 4));
#pragma unroll
        for (int j = 0; j < 8; ++j) am = fmaxf(fmaxf(fmaxf(am, fabsf(a[j][0])), fabsf(a[j][1])), fmaxf(fabsf(a[j][2]), fabsf(a[j][3]))); }
    for (; i < n4; i += stride) { const f32x4 a = *(const f32x4*)(src + i * 4); am = fmaxf(fmaxf(fmaxf(am, fabsf(a[0])), fabsf(a[1])), fmaxf(fabsf(a[2]), fabsf(a[3]))); }
    am = row16_max(am);
    { auto r = __builtin_amdgcn_permlane16_swap(__float_as_uint(am), __float_as_uint(am), false, false); am = fmaxf(__uint_as_float(r[0]), __uint_as_float(r[1])); }
    { auto r = __builtin_amdgcn_permlane32_swap(__float_as_uint(am), __float_as_uint(am), false, false); am = fmaxf(__uint_as_float(r[0]), __uint_as_float(r[1])); }
    if (F.lane == 0) atomicMax(dst, __float_as_uint(am));
}
template <int MAP>
__device__ __forceinline__ void transpose_fp8(const Frame& F, const float* __restrict__ src, unsigned char* __restrict__ dst, int K, int Nsrc, int Nd, const unsigned* wsc) {
    float mul, inv; fp8_scale(__hip_atomic_load(wsc, __ATOMIC_RELAXED, __HIP_MEMORY_SCOPE_AGENT), mul, inv);
    LAS float* tile = (LAS float*)F.lds;
    const int tk = K / 256, tn = Nd / 64, ntile = tk * tn;
    for (int t = F.bid; t < ntile; t += F.G) {
        const int k0 = (t % tk) * 256, n0 = (t / tk) * 64;
        const int nl = F.tid & 63, kq = F.tid >> 6; const int ns = MAP ? win_col(n0 + nl) : n0 + nl;
        float v[32];
#pragma unroll
        for (int i = 0; i < 32; ++i) v[i] = ns >= 0 ? src[(size_t)(k0 + kq + 8 * i) * Nsrc + ns] : 0.f;
#pragma unroll
        for (int i = 0; i < 32; ++i) tile[(kq + 8 * i) * 65 + nl] = v[i] * mul;
        __syncthreads();
        { const int n = F.tid >> 3, k32 = (F.tid & 7) * 32;
#pragma unroll
          for (int c = 0; c < 2; ++c) { float w[16];
#pragma unroll
              for (int j = 0; j < 16; ++j) w[j] = tile[(k32 + c * 16 + j) * 65 + n];
              u32x4 o; o.x = pk4_fp8(w[0], w[1], w[2], w[3]); o.y = pk4_fp8(w[4], w[5], w[6], w[7]); o.z = pk4_fp8(w[8], w[9], w[10], w[11]); o.w = pk4_fp8(w[12], w[13], w[14], w[15]);
              *(u32x4*)(dst + (size_t)(n0 + n) * K + k0 + k32 + c * 16) = o; } }
        __syncthreads();
    }
}
__device__ __forceinline__ void p0_prologue(const Frame& F) {
    { const int gi = F.bid * 512 + F.tid;
      if (gi < 64 * 8) { const int pos = gi >> 3, f = gi & 7; const float inv = powf(10000.f, -(float)f / 8.f); const float a = (float)pos * inv; wsp<f32x2>(F, WS_ROPE32)[gi] = (f32x2){cosf(a), sinf(a)}; }
      else if (gi < 64 * 8 + 64 * 32) { const int g2 = gi - 512; const int pos = g2 >> 5, f = g2 & 31; const float inv = powf(10000.f, -(float)f / 32.f); const float a = (float)pos * inv; wsp<f32x2>(F, WS_ROPE128)[g2] = (f32x2){cosf(a), sinf(a)}; } }
    if (F.bid == 0 && F.tid < 32) wsp<float>(F, WS_DEC)[F.tid] = -log1pf(expf(-F.in(11)[F.tid])) * LOG2E;
    { LAS float* sl = (LAS float*)F.lds;
      float* modp = wsp<float>(F, WS_MODP);
      for (int u = F.bid; u < 2 * 24 * 16; u += F.G) {
          const int kc = u & 15, cb = (u >> 4) % 24, l = u / (16 * 24);
          __syncthreads();
          for (int i = F.tid; i < 640; i += 512) { const int v = i >> 7, k = kc * 128 + (i & 127); const float c = v < 4 ? F.in(1)[v * 2048 + k] : F.in(3)[k]; sl[i] = silu_f(c); }
          __syncthreads();
          const int col = cb * 512 + F.tid; const float* w = F.in(4) + ((size_t)l * 2048 + kc * 128) * 12288 + col;
          float a0 = 0.f, a1 = 0.f, a2 = 0.f, a3 = 0.f, a4 = 0.f;
#pragma unroll 32
          for (int k = 0; k < 128; ++k) { const float wv = w[(size_t)k * 12288]; a0 += sl[k] * wv; a1 += sl[128 + k] * wv; a2 += sl[256 + k] * wv; a3 += sl[384 + k] * wv; a4 += sl[512 + k] * wv; }
          float* o = modp + ((size_t)(kc * 2 + l) * 5) * 12288 + col;
          o[0] = a0; o[12288] = a1; o[2 * 12288] = a2; o[3 * 12288] = a3; o[4 * 12288] = a4;
      }
      __syncthreads(); }
    for (int l = 0; l < 2; ++l) {
        absmax_f32(F, F.in(6) + (size_t)l * 2048 * NIN, (size_t)2048 * NIN / 4, wsp<unsigned>(F, WS_WSC) + l);
        transpose_cvt<2>(F, F.in(8) + (size_t)l * 512 * 768, wsp<bf16_t>(F, WS_WQUP + l * SZ_WQUP), 512, 768, 768);
        transpose_cvt<0>(F, F.in(10) + (size_t)l * 256 * 1024, wsp<bf16_t>(F, WS_WKVUP + l * SZ_WKVUP), 256, 1024, 1024);
        absmax_f32(F, F.in(14) + (size_t)l * 512 * 2048, (size_t)512 * 2048 / 4, wsp<unsigned>(F, WS_WSC) + 4 + l);
        absmax_f32(F, F.in(15) + (size_t)l * 512 * 2048, (size_t)512 * 2048 / 4, wsp<unsigned>(F, WS_WSC) + 6 + l);
        absmax_f32(F, F.in(16) + (size_t)l * 1024 * 2048, (size_t)1024 * 2048 / 4, wsp<unsigned>(F, WS_WSC) + 8 + l);
        absmax_f32(F, F.in(17) + (size_t)l * 2048 * 2048, (size_t)2048 * 2048 / 4, wsp<unsigned>(F, WS_WSC) + 2 + l);
        transpose_cvt<0>(F, F.in(20) + (size_t)l * 2048 * 1024, wsp<bf16_t>(F, WS_WPQ + l * SZ_WPQ), 2048, 1024, 1024);
    }
    cvt_peer(F, 0);
}
__device__ __forceinline__ void p1_modreduce(const Frame& F) {
    const float* modp = wsp<float>(F, WS_MODP); float* mod = wsp<float>(F, WS_MOD);
    for (int i = F.bid * 512 + F.tid; i < 2 * 5 * 12288; i += F.G * 512) {
        const int j = i % 12288, l = i / (5 * 12288);
        float s = F.in(5)[l * 12288 + j];
#pragma unroll
        for (int kc = 0; kc < 16; ++kc) s += modp[(size_t)kc * (2 * 5 * 12288) + i];
        mod[i] = s;
    }
    for (int l = 0; l < 2; ++l) {
        transpose_fp8<1>(F, F.in(6) + (size_t)l * 2048 * NIN, wsp<unsigned char>(F, WS_WIN + l * SZ_WIN), 2048, NIN, NPT, wsp<unsigned>(F, WS_WSC) + l);
        transpose_fp8<0>(F, F.in(17) + (size_t)l * 2048 * 2048, wsp<unsigned char>(F, WS_WOUT + l * SZ_WOUT), 2048, 2048, 2048, wsp<unsigned>(F, WS_WSC) + 2 + l);
        transpose_fp8<0>(F, F.in(14) + (size_t)l * 512 * 2048, wsp<unsigned char>(F, WS_WBRA + l * SZ_WBRA), 512, 2048, 2048, wsp<unsigned>(F, WS_WSC) + 4 + l);
        transpose_fp8<0>(F, F.in(15) + (size_t)l * 512 * 2048, wsp<unsigned char>(F, WS_WBRB + l * SZ_WBRB), 512, 2048, 2048, wsp<unsigned>(F, WS_WSC) + 6 + l);
        transpose_fp8<0>(F, F.in(16) + (size_t)l * 1024 * 2048, wsp<unsigned char>(F, WS_WBRC + l * SZ_WBRC), 1024, 2048, 2048, wsp<unsigned>(F, WS_WSC) + 8 + l);
    }
}
__device__ __forceinline__ void ld_row_f32(const float* p, int lane, float (&x)[32]) {
#pragma unroll
    for (int q = 0; q < 4; ++q) { const f32x4 a = *(const f32x4*)(p + 512 * q + 8 * lane), b = *(const f32x4*)(p + 512 * q + 8 * lane + 4);
        x[q * 8 + 0] = a[0]; x[q * 8 + 1] = a[1]; x[q * 8 + 2] = a[2]; x[q * 8 + 3] = a[3]; x[q * 8 + 4] = b[0]; x[q * 8 + 5] = b[1]; x[q * 8 + 6] = b[2]; x[q * 8 + 7] = b[3]; }
}
__device__ __forceinline__ void st_row_f32(float* p, int lane, const float (&x)[32]) {
#pragma unroll
    for (int q = 0; q < 4; ++q) { *(f32x4*)(p + 512 * q + 8 * lane) = (f32x4){x[q * 8 + 0], x[q * 8 + 1], x[q * 8 + 2], x[q * 8 + 3]}; *(f32x4*)(p + 512 * q + 8 * lane + 4) = (f32x4){x[q * 8 + 4], x[q * 8 + 5], x[q * 8 + 6], x[q * 8 + 7]}; }
}
__device__ __forceinline__ void st_row_bf16(bf16_t* p, int lane, const float (&x)[32]) {
#pragma unroll
    for (int q = 0; q < 4; ++q) { u32x4 w; w.x = cvt_pk_bf16(x[q * 8 + 0], x[q * 8 + 1]); w.y = cvt_pk_bf16(x[q * 8 + 2], x[q * 8 + 3]); w.z = cvt_pk_bf16(x[q * 8 + 4], x[q * 8 + 5]); w.w = cvt_pk_bf16(x[q * 8 + 6], x[q * 8 + 7]);
        *(u32x4*)(p + 512 * q + 8 * lane) = w; }
}
__device__ __forceinline__ void p_modulate0(const Frame& F) {
    const float* mod = wsp<float>(F, WS_MOD); unsigned char* hb8 = wsp<unsigned char>(F, WS_HB8);
    for (int row = F.bid * 8 + F.wave; row < NROW; row += F.G * 8) {
        const RowInfo ri = rowinfo(row);
        const float* xp = ri.lat ? F.in(0) + (size_t)row * D : F.in(2) + (size_t)(row - NLAT) * D;
        const float* mp = mod + (size_t)ri.v * 12288;
        float x[32], sh[32], sc[32];
        ld_row_f32(xp, F.lane, x); ld_row_f32(mp, F.lane, sh); ld_row_f32(mp + 2048, F.lane, sc);
#pragma unroll
        for (int i = 0; i < 32; ++i) x[i] = clamp8(x[i] * (1.f + sc[i]) + sh[i]);
#pragma unroll
        for (int q = 0; q < 4; ++q) { u32x2 w; w.x = pk4_fp8(x[q * 8 + 0], x[q * 8 + 1], x[q * 8 + 2], x[q * 8 + 3]); w.y = pk4_fp8(x[q * 8 + 4], x[q * 8 + 5], x[q * 8 + 6], x[q * 8 + 7]); *(u32x2*)(hb8 + (size_t)row * D + 512 * q + 8 * F.lane) = w; }
    }
}
__device__ __forceinline__ void p_post(const Frame& F, int l) {
    const bf16_t* P1 = wsp<bf16_t>(F, WS_P1);
    bf16_t* CQN = wsp<bf16_t>(F, WS_CQN); bf16_t* CKVN = wsp<bf16_t>(F, WS_CKVN);
    unsigned char* QG = wsp<unsigned char>(F, WS_QG); unsigned char* KG = wsp<unsigned char>(F, WS_KG); unsigned char* VG = wsp<unsigned char>(F, WS_VG);
    bf16_t* RQ = wsp<bf16_t>(F, WS_RQ); bf16_t* RK = wsp<bf16_t>(F, WS_RK); bf16_t* RV = wsp<bf16_t>(F, WS_RV);
    unsigned char* KM = wsp<unsigned char>(F, WS_KM); unsigned char* QM = wsp<unsigned char>(F, WS_QM);
    const f32x2* cs32 = wsp<f32x2>(F, WS_ROPE32); const f32x2* cs128 = wsp<f32x2>(F, WS_ROPE128);
    const float* gq_n = F.in(7) + l * 512; const float* gkv_n = F.in(9) + l * 256; const float* gqa_qn = F.in(12) + l * 128; const float* gqa_kn = F.in(13) + l * 128;
    LAS bf16_t* rs = (LAS bf16_t*)(F.lds + F.wave * 8192);
    const int lane = F.lane;
    const f32x4 gq0 = *(const f32x4*)(gq_n + lane * 8), gq1 = *(const f32x4*)(gq_n + lane * 8 + 4), gkv0 = *(const f32x4*)(gkv_n + lane * 4);
    const int gd0 = 2 * lane; const int gpart = gd0 >> 6, gdd = gd0 & 63; const bool glo = gdd < 32; const int gf = glo ? gdd : gdd - 32; const int gdp = glo ? gd0 + 32 : gd0 - 32;
    const float qn0 = gqa_qn[gd0], qn1 = gqa_qn[gd0 + 1], qnp0 = gqa_qn[gdp], qnp1 = gqa_qn[gdp + 1];
    const float kn0 = gqa_kn[gd0], kn1 = gqa_kn[gd0 + 1], knp0 = gqa_kn[gdp], knp1 = gqa_kn[gdp + 1];
    const int rhh = lane >> 3, rd0 = (lane & 7) * 4; const int rpart = rd0 >> 4, rdd = rd0 & 15; const bool rlo = rdd < 8; const int rf = rlo ? rdd : rdd - 8; const int rdp = rlo ? rd0 + 8 : rd0 - 8;
    const int step = F.G * 8;
    int row = F.bid * 8 + F.wave;
    u32x4 pre[8];
    if (row < NROW) {
#pragma unroll
        for (int q = 0; q < 8; ++q) pre[q] = *(const u32x4*)(P1 + (size_t)row * NP1 + q * 512 + lane * 8); }
#pragma unroll 1
    for (; row < NROW; row += step) {
        const RowInfo ri = rowinfo(row);
        const int posg = gpart ? ri.pc : ri.pr, posr = rpart ? ri.pc : ri.pr;
        const f32x2 one = {1.f, 0.f};
        const f32x2 csA = ri.lat ? cs128[posg * 32 + gf] : one, csB = ri.lat ? cs128[posg * 32 + gf + 1] : one;
        f32x2 cs[4];
#pragma unroll
        for (int i = 0; i < 4; ++i) cs[i] = ri.lat ? cs32[posr * 8 + rf + i] : one;
#pragma unroll
        for (int q = 0; q < 8; ++q) *(LAS u32x4*)(rs + q * 512 + lane * 8) = pre[q];
        { const int nrow = row + step; if (nrow < NROW) {
#pragma unroll
            for (int q = 0; q < 8; ++q) pre[q] = *(const u32x4*)(P1 + (size_t)nrow * NP1 + q * 512 + lane * 8); } }
        asm volatile("s_waitcnt lgkmcnt(0)" ::: "memory");
        { float x[8]; float ss = 0.f;
#pragma unroll
          for (int i = 0; i < 8; ++i) { x[i] = bf2f(rs[C_CQ + lane * 8 + i]); ss += x[i] * x[i]; }
          ss = wave_sum(ss); const float r = rsqrtf(ss * (1.f / 512.f) + RMS_EPS);
          *(u32x4*)(CQN + (size_t)row * 512 + lane * 8) = pack8((f32x4){x[0] * r * gq0[0], x[1] * r * gq0[1], x[2] * r * gq0[2], x[3] * r * gq0[3]}, (f32x4){x[4] * r * gq1[0], x[5] * r * gq1[1], x[6] * r * gq1[2], x[7] * r * gq1[3]}); }
        { float x[4]; float ss = 0.f;
#pragma unroll
          for (int i = 0; i < 4; ++i) { x[i] = bf2f(rs[C_CKV + lane * 4 + i]); ss += x[i] * x[i]; }
          ss = wave_sum(ss); const float r = rsqrtf(ss * (1.f / 256.f) + RMS_EPS);
          u32x2 w; w.x = cvt_pk_bf16(x[0] * r * gkv0[0], x[1] * r * gkv0[1]); w.y = cvt_pk_bf16(x[2] * r * gkv0[2], x[3] * r * gkv0[3]);
          *(u32x2*)(CKVN + (size_t)row * 256 + lane * 4) = w; }
        {
            const int d0 = gd0, dp = gdp; const bool lo = glo;
#pragma unroll 1
            for (int hh = 0; hh < 10; ++hh) {
                const bool isq = hh < 8; const int cbase = isq ? C_GQ + hh * 128 : C_GK + (hh - 8) * 128;
                const float g0 = isq ? qn0 : kn0, g1 = isq ? qn1 : kn1, gp0 = isq ? qnp0 : knp0, gp1 = isq ? qnp1 : knp1;
                const float a0 = bf2f(rs[cbase + d0]), a1 = bf2f(rs[cbase + d0 + 1]);
                float ss = wave_sum(a0 * a0 + a1 * a1); const float r = rsqrtf(ss * (1.f / 128.f) + RMS_EPS);
                const float n0 = a0 * r * g0, n1 = a1 * r * g1;
                const float p0 = bf2f(rs[cbase + dp]) * r * gp0, p1 = bf2f(rs[cbase + dp + 1]) * r * gp1;
                float o0, o1;
                if (lo) { o0 = n0 * csA.x - p0 * csA.y; o1 = n1 * csB.x - p1 * csB.y; }
                else    { o0 = p0 * csA.y + n0 * csA.x; o1 = p1 * csB.y + n1 * csB.x; }
                unsigned char* dst = isq ? QG + ((size_t)(ri.b * 8 + hh) * TT + ri.tpos) * 128 : KG + ((size_t)(ri.b * 2 + (hh - 8)) * TT + ri.tpos) * 128;
                *(unsigned short*)(dst + d0) = (unsigned short)(pk4_fp8(clamp8(o0), clamp8(o1), 0.f, 0.f) & 0xffffu);
            }
#pragma unroll
            for (int hh = 0; hh < 2; ++hh) { const unsigned w8_ = pk4_fp8(clamp8(bf2f(rs[C_GV + hh * 128 + d0])), clamp8(bf2f(rs[C_GV + hh * 128 + d0 + 1])), 0.f, 0.f); unsigned char* vp_ = VG + ((size_t)(ri.b * 2 + hh) * 128 + d0) * TT + vt_off(ri.tpos);
                vp_[0] = (unsigned char)(w8_ & 0xffu); vp_[TT] = (unsigned char)((w8_ >> 8) & 0xffu); }
        }
        {
            const int hh = rhh, d0 = rd0, dp = rdp; const bool lo = rlo;
#pragma unroll
            for (int which = 0; which < 2; ++which) {
                const int cbase = (which ? C_RK : C_RQ) + hh * 32; const float sc = which ? 0.17677669529663687f : 1.f;
                float o[4];
#pragma unroll
                for (int i = 0; i < 4; ++i) { const float n = bf2f(rs[cbase + d0 + i]), p = bf2f(rs[cbase + dp + i]);
                    o[i] = (lo ? (n * cs[i].x - p * cs[i].y) : (p * cs[i].y + n * cs[i].x)) * sc; }
                u32x2 w; w.x = cvt_pk_bf16(o[0], o[1]); w.y = cvt_pk_bf16(o[2], o[3]);
                *(u32x2*)((which ? RK : RQ) + ((size_t)(ri.b * 8 + hh) * TT + ri.tpos) * 32 + d0) = w;
            }
            { const int vh = lane >> 3, e0 = (lane & 7) * 8;
              *(u32x4*)(RV + ((size_t)(ri.b * 8 + vh) * TT + ri.tpos) * 64 + e0) = *(LAS u32x4*)(rs + C_RV + lane * 8); }
            { float o[4];
#pragma unroll
              for (int i = 0; i < 4; ++i) { const float n = bf2f(rs[C_KR + d0 + i]), p = bf2f(rs[C_KR + dp + i]); o[i] = lo ? (n * cs[i].x - p * cs[i].y) : (p * cs[i].y + n * cs[i].x); }
              const size_t tok_ = ((size_t)(ri.b * 8 + hh) * TT + ri.tpos) * 128;
              *(unsigned*)(KM + tok_ + 64 + d0) = pk4_fp8(clamp8(o[0]), clamp8(o[1]), clamp8(o[2]), clamp8(o[3]));
              *(unsigned*)(KM + tok_ + 96 + d0) = 0u; *(unsigned*)(QM + tok_ + 96 + d0) = 0u; }
        }
        asm volatile("s_waitcnt lgkmcnt(0)" ::: "memory");
    }
}

__device__ __forceinline__ void ret_logs(const Frame& F, int l, int h, float& lgf, float& lgb) {
    const float* t = wsp<float>(F, WS_DEC); lgf = t[(l * 2 + 0) * 8 + h]; lgb = t[(l * 2 + 1) * 8 + h];
}
constexpr int TP = 136;
template <bool WITH_K>
__device__ __forceinline__ void ret_stage(const Frame& F, const bf16_t* RKh, const bf16_t* RVh, int tpos0, float lgf, float lgb, LAS bf16_t* vt, LAS bf16_t* ktf, LAS bf16_t* ktb) {
#pragma unroll
    for (int i = 0; i < 2; ++i) { const int tok = (F.tid >> 3) + 64 * i, e0 = (F.tid & 7) * 8;
        const u32x4 w = *(const u32x4*)(RVh + (size_t)(tpos0 + tok) * 64 + e0); const unsigned ww[4] = {w.x, w.y, w.z, w.w};
#pragma unroll
        for (int j = 0; j < 4; ++j) { vt[(e0 + 2 * j) * TP + tok] = (bf16_t)(ww[j] & 0xffffu); vt[(e0 + 2 * j + 1) * TP + tok] = (bf16_t)(ww[j] >> 16); } }
    if (WITH_K) { const int tok = F.tid >> 2, k0 = (F.tid & 3) * 8;
        const u32x4 w = *(const u32x4*)(RKh + (size_t)(tpos0 + tok) * 32 + k0); const unsigned ww[4] = {w.x, w.y, w.z, w.w};
        const float zf = exp2f(lgf * (float)(127 - tok)), zb = exp2f(lgb * (float)tok);
#pragma unroll
        for (int j = 0; j < 4; ++j) { const float a = bflo(ww[j]), b = bfhi(ww[j]);
            ktf[(k0 + 2 * j) * TP + tok] = f2bf(a * zf); ktf[(k0 + 2 * j + 1) * TP + tok] = f2bf(b * zf);
            ktb[(k0 + 2 * j) * TP + tok] = f2bf(a * zb); ktb[(k0 + 2 * j + 1) * TP + tok] = f2bf(b * zb); } }
}
__device__ __forceinline__ void p_ret_states(const Frame& F, int l) {
    LAS bf16_t* vt = (LAS bf16_t*)F.lds; LAS bf16_t* ktf = vt + 64 * TP; LAS bf16_t* ktb = ktf + 32 * TP;
    float* ST = wsp<float>(F, WS_ST);
    const int lane = F.lane, w = F.wave, kb = w >> 2, eb = w & 3, fr = lane & 15, fq = lane >> 4;
    for (int u = F.bid; u < NB * 8 * 34; u += F.G) {
        const int c = u % 34, bh = u / 34, h = bh & 7;
        float lgf, lgb; ret_logs(F, l, h, lgf, lgb);
        __syncthreads();
        ret_stage<true>(F, wsp<bf16_t>(F, WS_RK) + (size_t)bh * TT * 32, wsp<bf16_t>(F, WS_RV) + (size_t)bh * TT * 64, c * 128, lgf, lgb, vt, ktf, ktb);
        __syncthreads();
        f32x4 sf = {0.f, 0.f, 0.f, 0.f}, sb = {0.f, 0.f, 0.f, 0.f};
#pragma unroll
        for (int ks = 0; ks < 4; ++ks) {
            const bf16x8 bv = *(const LAS bf16x8*)(vt + (eb * 16 + fr) * TP + ks * 32 + fq * 8);
            const bf16x8 af = *(const LAS bf16x8*)(ktf + (kb * 16 + fr) * TP + ks * 32 + fq * 8);
            const bf16x8 ab = *(const LAS bf16x8*)(ktb + (kb * 16 + fr) * TP + ks * 32 + fq * 8);
            sf = __builtin_amdgcn_mfma_f32_16x16x32_bf16(af, bv, sf, 0, 0, 0);
            sb = __builtin_amdgcn_mfma_f32_16x16x32_bf16(ab, bv, sb, 0, 0, 0);
        }
        float* o = ST + (size_t)u * 2 * 2048;
#pragma unroll
        for (int r = 0; r < 4; ++r) { const int kd = kb * 16 + fq * 4 + r, e = eb * 16 + fr; o[kd * 64 + e] = sf[r]; o[2048 + kd * 64 + e] = sb[r]; }
    }
}
constexpr int RP = 40;
constexpr int AP = 136;
__device__ __forceinline__ void ret_out_unit(const Frame& F, int l, int bh, int c) {
    LAS bf16_t* vt = (LAS bf16_t*)F.lds; LAS bf16_t* rtf = vt + 64 * TP; LAS bf16_t* rtb = rtf + 64 * RP; LAS bf16_t* as = rtb + 64 * RP + F.wave * 16 * AP;
    const int lane = F.lane, w = F.wave, fr = lane & 15, fq = lane >> 4, h = bh & 7, b = bh >> 3;
    const bf16_t* RQh = wsp<bf16_t>(F, WS_RQ) + (size_t)bh * TT * 32; const bf16_t* RKh = wsp<bf16_t>(F, WS_RK) + (size_t)bh * TT * 32; const bf16_t* RVh = wsp<bf16_t>(F, WS_RV) + (size_t)bh * TT * 64;
    const float* STh = wsp<float>(F, WS_ST) + (size_t)bh * 34 * 2 * 2048;
    float lgf, lgb; ret_logs(F, l, h, lgf, lgb);
    const int tpos0 = c * 128;
    __syncthreads();
    ret_stage<false>(F, RKh, RVh, tpos0, lgf, lgb, vt, nullptr, nullptr);
    { const int kd = F.tid >> 4, e4 = (F.tid & 15) * 4; f32x4 rf = {0.f, 0.f, 0.f, 0.f}, rb = {0.f, 0.f, 0.f, 0.f};
      if (c >= 2) {
          for (int cp = 0; cp < c; ++cp) { const float e2 = lgf * 128.f * (float)(c - 1 - cp); if (e2 < -80.f) continue; const float wgt = exp2f(e2);
              rf += *(const f32x4*)(STh + (size_t)(cp * 2 + 0) * 2048 + kd * 64 + e4) * wgt; }
          const int p = c - 2;
          for (int pp = p + 1; pp < 34; ++pp) { const float e2 = lgb * 128.f * (float)(pp - p - 1); if (e2 < -80.f) break; const float wgt = exp2f(e2); const int cs = pp < 32 ? pp + 2 : pp - 32;
              rb += *(const f32x4*)(STh + (size_t)(cs * 2 + 1) * 2048 + kd * 64 + e4) * wgt; }
      } else if (c == 0) { rb = *(const f32x4*)(STh + (size_t)(1 * 2 + 1) * 2048 + kd * 64 + e4); }
      else { rf = *(const f32x4*)(STh + (size_t)(0 * 2 + 0) * 2048 + kd * 64 + e4); }
#pragma unroll
      for (int j = 0; j < 4; ++j) { rtf[(e4 + j) * RP + kd] = f2bf(rf[j]); rtb[(e4 + j) * RP + kd] = f2bf(rb[j]); } }
    const int i0 = w * 16;
    const bf16x8 qa = *(const bf16x8*)(RQh + (size_t)(tpos0 + i0 + fr) * 32 + fq * 8);
    f32x4 s[8];
#pragma unroll
    for (int nb = 0; nb < 8; ++nb) { const bf16x8 kf = *(const bf16x8*)(RKh + (size_t)(tpos0 + nb * 16 + fr) * 32 + fq * 8);
        s[nb] = __builtin_amdgcn_mfma_f32_16x16x32_bf16(qa, kf, (f32x4){0.f, 0.f, 0.f, 0.f}, 0, 0, 0); }
#pragma unroll
    for (int nb = 0; nb < 8; ++nb)
#pragma unroll
        for (int r = 0; r < 4; ++r) { const int i = i0 + fq * 4 + r, j = nb * 16 + fr; const int df = i - j;
            const float mk = df > 0 ? exp2f(lgf * (float)df) : (df < 0 ? exp2f(lgb * (float)(-df)) : 2.f);
            as[(fq * 4 + r) * AP + j] = f2bf(s[nb][r] * mk); }
    __syncthreads();
    f32x4 y[4];
#pragma unroll
    for (int eb = 0; eb < 4; ++eb) y[eb] = (f32x4){0.f, 0.f, 0.f, 0.f};
#pragma unroll
    for (int ks = 0; ks < 4; ++ks) { const bf16x8 af = *(const LAS bf16x8*)(as + fr * AP + ks * 32 + fq * 8);
#pragma unroll
        for (int eb = 0; eb < 4; ++eb) { const bf16x8 bv = *(const LAS bf16x8*)(vt + (eb * 16 + fr) * TP + ks * 32 + fq * 8);
            y[eb] = __builtin_amdgcn_mfma_f32_16x16x32_bf16(af, bv, y[eb], 0, 0, 0); } }
    { const float xf = exp2f(lgf * (float)(i0 + fr + 1)), xb = exp2f(lgb * (float)(128 - (i0 + fr)));
      bf16x8 qf, qb;
#pragma unroll
      for (int j = 0; j < 8; ++j) { const float qv = bf2f((bf16_t)qa[j]); qf[j] = (short)f2bf(qv * xf); qb[j] = (short)f2bf(qv * xb); }
#pragma unroll
      for (int eb = 0; eb < 4; ++eb) { const bf16x8 bf_ = *(const LAS bf16x8*)(rtf + (eb * 16 + fr) * RP + fq * 8), bb_ = *(const LAS bf16x8*)(rtb + (eb * 16 + fr) * RP + fq * 8);
          y[eb] = __builtin_amdgcn_mfma_f32_16x16x32_bf16(qf, bf_, y[eb], 0, 0, 0);
          y[eb] = __builtin_amdgcn_mfma_f32_16x16x32_bf16(qb, bb_, y[eb], 0, 0, 0); } }
    const bf16_t* P1 = wsp<bf16_t>(F, WS_P1); unsigned char* OAB = wsp<unsigned char>(F, WS_OAB);
#pragma unroll
    for (int r = 0; r < 4; ++r) {
        float sm = y[0][r] + y[1][r] + y[2][r] + y[3][r]; sm = row16_sum(sm); const float mu = sm * (1.f / 64.f);
        float vs = 0.f;
#pragma unroll
        for (int eb = 0; eb < 4; ++eb) { const float d = y[eb][r] - mu; vs += d * d; }
        vs = row16_sum(vs); const float rstd = rsqrtf(vs * (1.f / 64.f) + LN_EPS);
        const int i = i0 + fq * 4 + r; const int tp = tpos0 + i; const size_t grow = tp >= CTXL ? (size_t)b * SEQ + (tp - CTXL) : (size_t)NLAT + b * CTXL + tp;
#pragma unroll
        for (int eb = 0; eb < 4; ++eb) { const int e = eb * 16 + fr; const float g = bf2f(P1[grow * NP1 + C_RG + h * 64 + e]);
            OAB[grow * D + 512 + h * 64 + e] = (unsigned char)(pk4_fp8(clamp8(silu_f(g) * (y[eb][r] - mu) * rstd * 16.f), 0.f, 0.f, 0.f) & 0xffu); }
    }
}
namespace att {
constexpr int NW = 8, QBLK = 32, KVBLK = 64;
constexpr int SHM_K = KVBLK * 128, SHM_V = 128 * 64;
constexpr size_t SHM_ATTN = 3 * SHM_K + 2 * SHM_V;
constexpr float THR = 1.9f, PSH = 6.f;
#define SBAR() __builtin_amdgcn_sched_barrier(0)
typedef int i32x8a __attribute__((ext_vector_type(8))); typedef int i32x4a __attribute__((ext_vector_type(4)));
template <int SC> struct Scale { static constexpr float S = SC == 0 ? 0.08838834764831845f : 0.10206207261596575f; static constexpr float C = S * 1.4426950408889634f; static constexpr float THRR = THR / S; };
#define KSWZ8(row, chunk) ((row) * 128 + ((((chunk) ^ (((row) >> 1) & 7))) << 4))
#define VSWZ8(col, chunk) ((col) * 64 + ((((chunk) ^ (((col) >> 2) & 3))) << 4))
#define MF8(A, B, C) mf8x<ABL>(A, B, C)
#define CAT8(lo, hi) __builtin_shufflevector(lo, hi, 0, 1, 2, 3, 4, 5, 6, 7)
#define LDS16(p) ((ABL & 8) ? __builtin_shufflevector(qr8[0], qr8[1], 0, 1, 10, 11) : *reinterpret_cast<const i32x4a*>(p))
template <int A, int B, int ABL = 0> __device__ __forceinline__ void exp_rng(f32x16& p) {
#pragma unroll
  for (int r = A; r < B; ++r) p[r] = (ABL & 1) ? p[r] * p[r] : __builtin_amdgcn_exp2f(p[r]);
}
template <int ABL> __device__ __forceinline__ f32x16 mf8x(const i32x8a a, const i32x8a b, f32x16 c) {
  if constexpr (ABL & 2) { c[0] += __int_as_float(((a[0] ^ a[4]) + (b[0] ^ b[4])) & 0x3f000000); return c; }
  else return __builtin_amdgcn_mfma_scale_f32_32x32x64_f8f6f4(a, b, c, 0, 0, 0, 0x7F7F7F7F, 0, 0x7F7F7F7F);
}
__device__ __forceinline__ void pk_fma16(f32x16& p, float c, float d) { const f32x2 c2 = {c, c}, d2 = {d, d};
#pragma unroll
  for (int i = 0; i < 8; ++i) { f32x2 v = {p[2 * i], p[2 * i + 1]}; v = v * c2 + d2; p[2 * i] = v.x; p[2 * i + 1] = v.y; }
}
__device__ __forceinline__ void pk_mul16(f32x16& p, float c) { const f32x2 c2 = {c, c};
#pragma unroll
  for (int i = 0; i < 8; ++i) { f32x2 v = {p[2 * i], p[2 * i + 1]}; v = v * c2; p[2 * i] = v.x; p[2 * i + 1] = v.y; }
}
__device__ __forceinline__ float pk_sum32(const f32x16& p0, const f32x16& p1) { f32x2 s0 = {p0[0], p0[1]}, s1 = {p1[0], p1[1]};
#pragma unroll
  for (int i = 1; i < 8; ++i) { s0 += (f32x2){p0[2 * i], p0[2 * i + 1]}; s1 += (f32x2){p1[2 * i], p1[2 * i + 1]}; }
  s0 += s1; return s0.x + s0.y;
}
__device__ __forceinline__ float hsum(float v) { auto rr = __builtin_amdgcn_permlane32_swap(__float_as_uint(v), __float_as_uint(v), false, false); return __uint_as_float(rr[0]) + __uint_as_float(rr[1]); }
__device__ __forceinline__ float hmax(float v) { auto rr = __builtin_amdgcn_permlane32_swap(__float_as_uint(v), __float_as_uint(v), false, false); return fmaxf(__uint_as_float(rr[0]), __uint_as_float(rr[1])); }
template <int NDV, int SC, int ABL>
__device__ __forceinline__ void attn_body(const unsigned char* __restrict__ Qb, const unsigned char* __restrict__ Kh, const unsigned char* __restrict__ Vt,
                                          unsigned char* __restrict__ Ob, int seq, char* lds, const int tid) {
  constexpr int ldo = 2048; constexpr float C = Scale<SC>::C, thr_raw = Scale<SC>::THRR;
  const int wid = tid >> 6, lane = tid & 63, r32 = lane & 31, hi = lane >> 5;
  char* K_lds = lds; char* V_lds = lds + 3 * SHM_K;
  float m_reg = -1e30f, l_reg = 0; f32x16 o[NDV] = {}; i32x8a qr8[2];
  const unsigned char* Qw = Qb + (long)(wid * QBLK + r32) * 128 + hi * 32;
#pragma unroll
  for (int blk = 0; blk < 2; ++blk) { const i32x4a lo_ = *reinterpret_cast<const i32x4a*>(Qw + blk * 64), hi_ = *reinterpret_cast<const i32x4a*>(Qw + blk * 64 + 16); qr8[blk] = CAT8(lo_, hi_); }
  const int kr8 = tid >> 3, kc8 = tid & 7;
  const int vcol = (tid >> 2) & (NDV * 32 - 1), vch = tid & 3;
  const int NT = seq / KVBLK;
  const unsigned char* kgp = Kh + (long)kr8 * 128 + kc8 * 16; const unsigned char* vgp = Vt + (long)vcol * TT + vch * 16;
  const int kwo = KSWZ8(kr8, kc8), vwo = VSWZ8(vcol, vch);
  const int ka0 = KSWZ8(r32, 2 * hi), ka1 = KSWZ8(r32, 2 * hi + 1), va0 = VSWZ8(r32, 2 * hi), va1 = VSWZ8(r32, 2 * hi + 1);
  i32x4a ks, vs;
#define SLOADK(t) do { const int t_ = (t) < NT ? (t) : NT - 1; ks = *reinterpret_cast<const i32x4a*>(kgp + (long)t_ * (KVBLK * 128)); } while (0)
#define SLOADV(t) do { const int t_ = (t) < NT ? (t) : NT - 1; vs = *reinterpret_cast<const i32x4a*>(vgp + t_ * KVBLK); } while (0)
#define SWRITEK(bo) do { *(i32x4a*)(K_lds + (bo) + kwo) = ks; } while (0)
#define SWRITEV(b) do { *(i32x4a*)(V_lds + (b) * SHM_V + vwo) = vs; } while (0)
#define VMW0() asm volatile("s_waitcnt vmcnt(0)" ::: "memory")
  f32x16 pA0, pA1, pB0, pB1; float alA, alB; i32x8a pa;
#define PSM_MAX(p0, p1, al, mnC) do { float pm_ = fmaxf(p0[0], p1[0]);                                                                  \
    _Pragma("unroll") for (int r = 1; r < 16; ++r) pm_ = fmaxf(fmaxf(pm_, p0[r]), p1[r]);                                               \
    pm_ = hmax(pm_);                                                                                                                     \
    const bool keep_ = __all(pm_ - m_reg <= thr_raw); const float mn_ = keep_ ? m_reg : fmaxf(m_reg, pm_);                               \
    al = __builtin_amdgcn_exp2f((m_reg - mn_) * C); m_reg = mn_; mnC = PSH - mn_ * C; } while (0)
#define PT3(x, y, z) asm volatile("" : "+v"(x), "+v"(y), "+v"(z))
#define PT4(x, y, z, w) asm volatile("" : "+v"(x), "+v"(y), "+v"(z), "+v"(w))
#define STEP(j, pc0, pc1, alc, pn0, pn1, aln, par) do { const char* Kr_ = K_lds + kb_rd; const char* Vs_ = V_lds + (par) * SHM_V; float mnC_;  \
    i32x8a kc_ = CAT8(LDS16(Kr_ + (ka0 ^ 64)), LDS16(Kr_ + (ka1 ^ 64))), kd_ = CAT8(LDS16(Kr_ + 4096 + (ka0 ^ 64)), LDS16(Kr_ + 4096 + (ka1 ^ 64))); \
    pn0 = MF8(kpa, qr8[0], (f32x16){}); exp_rng<0, 6, ABL>(pc1); PT3(pn0, pc1, kpb);                                                     \
    pn1 = MF8(kpb, qr8[0], (f32x16){}); exp_rng<6, 12, ABL>(pc1); PT3(pn1, pc1, kc_);                                                    \
    pn0 = MF8(kc_, qr8[1], pn0); exp_rng<12, 16, ABL>(pc1);                                                                              \
    { float ps_ = pk_sum32(pc0, pc1); ps_ = hsum(ps_); l_reg = l_reg * alc + ps_; }                                                      \
    i32x8a va_ = CAT8(LDS16(Vs_ + va0), LDS16(Vs_ + va1)), vb_ = CAT8(LDS16(Vs_ + 2048 + va0), LDS16(Vs_ + 2048 + va1));                  \
    PT4(pn0, pc1, kd_, l_reg);                                                                                                           \
    pn1 = MF8(kd_, qr8[1], pn1);                                                                                                         \
    _Pragma("unroll") for (int q = 0; q < 4; ++q) { pa[q] = (int)pk4_fp8(pc0[4 * q], pc0[4 * q + 1], pc0[4 * q + 2], pc0[4 * q + 3]); pa[4 + q] = (int)pk4_fp8(pc1[4 * q], pc1[4 * q + 1], pc1[4 * q + 2], pc1[4 * q + 3]); } \
    PT3(pn1, pa, va_);                                                                                                                   \
    SWRITEK(kb_wr); SWRITEV(1 - (par)); SLOADK((j) + 4); SLOADV((j) + 2);                                                                \
    o[0] = MF8(va_, pa, o[0]); PSM_MAX(pn0, pn1, aln, mnC_); PT4(o[0], pn0, vb_, mnC_);                                                  \
    o[1] = MF8(vb_, pa, o[1]); pk_fma16(pn0, C, mnC_); pk_fma16(pn1, C, mnC_); exp_rng<0, 4, ABL>(pn0);                                   \
    if constexpr (NDV == 4) { i32x8a vc_ = CAT8(LDS16(Vs_ + 4096 + va0), LDS16(Vs_ + 4096 + va1)), vd_ = CAT8(LDS16(Vs_ + 6144 + va0), LDS16(Vs_ + 6144 + va1)); \
      PT4(o[1], pn0, pn1, vc_); o[2] = MF8(vc_, pa, o[2]); exp_rng<4, 10, ABL>(pn0); PT3(o[2], pn0, vd_);                                \
      o[3] = MF8(vd_, pa, o[3]); exp_rng<10, 16, ABL>(pn0); }                                                                            \
    else { PT3(o[1], pn0, pn1); exp_rng<4, 16, ABL>(pn0); }                                                                              \
    { const char* Kp_ = K_lds + kb_pf; kpa = CAT8(LDS16(Kp_ + ka0), LDS16(Kp_ + ka1)); kpb = CAT8(LDS16(Kp_ + 4096 + ka0), LDS16(Kp_ + 4096 + ka1)); } \
    PT3(o[NDV - 1], pn0, pn1); RESC(aln);                                                                                               \
    { const int t_ = kb_wr; kb_wr = kb_rd; kb_rd = kb_pf; kb_pf = t_; }                                                                  \
    if constexpr (!(ABL & 4)) __syncthreads(); } while (0)
#define RESC(a) do { if (__any((a) < 1.f)) { _Pragma("unroll") for (int d = 0; d < NDV; ++d) pk_mul16(o[d], (a)); } } while (0)
  i32x8a kpa, kpb; int kb_rd = SHM_K, kb_pf = 2 * SHM_K, kb_wr = 0;
  { const i32x4a k0_ = *reinterpret_cast<const i32x4a*>(kgp), k1_ = *reinterpret_cast<const i32x4a*>(kgp + KVBLK * 128), k2_ = *reinterpret_cast<const i32x4a*>(kgp + 2 * KVBLK * 128); SLOADV(0);
    *(i32x4a*)(K_lds + kwo) = k0_; *(i32x4a*)(K_lds + SHM_K + kwo) = k1_; *(i32x4a*)(K_lds + 2 * SHM_K + kwo) = k2_; SWRITEV(0); SLOADK(3); SLOADV(1); }
  __syncthreads();
  { const char* Ks_ = K_lds; float mnC_;
    pA0 = MF8(CAT8(LDS16(Ks_ + ka0), LDS16(Ks_ + ka1)), qr8[0], (f32x16){}); pA1 = MF8(CAT8(LDS16(Ks_ + 4096 + ka0), LDS16(Ks_ + 4096 + ka1)), qr8[0], (f32x16){});
    pA0 = MF8(CAT8(LDS16(Ks_ + (ka0 ^ 64)), LDS16(Ks_ + (ka1 ^ 64))), qr8[1], pA0); pA1 = MF8(CAT8(LDS16(Ks_ + 4096 + (ka0 ^ 64)), LDS16(Ks_ + 4096 + (ka1 ^ 64))), qr8[1], pA1);
    PSM_MAX(pA0, pA1, alA, mnC_); pk_fma16(pA0, C, mnC_); pk_fma16(pA1, C, mnC_); exp_rng<0, 16, ABL>(pA0);
    const char* Kp_ = K_lds + SHM_K; kpa = CAT8(LDS16(Kp_ + ka0), LDS16(Kp_ + ka1)); kpb = CAT8(LDS16(Kp_ + 4096 + ka0), LDS16(Kp_ + 4096 + ka1)); }
  __syncthreads();
  int j = 0;
  for (; j + 2 < NT; j += 2) { STEP(j, pA0, pA1, alA, pB0, pB1, alB, 0); STEP(j + 1, pB0, pB1, alB, pA0, pA1, alA, 1); }
  STEP(j, pA0, pA1, alA, pB0, pB1, alB, 0);
  { exp_rng<0, 16, ABL>(pB1); float ps_ = pk_sum32(pB0, pB1); ps_ = hsum(ps_); l_reg = l_reg * alB + ps_;
#pragma unroll
    for (int q = 0; q < 4; ++q) { pa[q] = (int)pk4_fp8(pB0[4 * q], pB0[4 * q + 1], pB0[4 * q + 2], pB0[4 * q + 3]); pa[4 + q] = (int)pk4_fp8(pB1[4 * q], pB1[4 * q + 1], pB1[4 * q + 2], pB1[4 * q + 3]); }
    const char* Vs_ = V_lds + SHM_V;
#pragma unroll
    for (int d0 = 0; d0 < NDV; ++d0) o[d0] = MF8(CAT8(LDS16(Vs_ + d0 * 2048 + va0), LDS16(Vs_ + d0 * 2048 + va1)), pa, o[d0]); }
  const float rl = __builtin_amdgcn_rcpf(l_reg) * 16.f;
  unsigned char* Ow = Ob + (long)(wid * QBLK + r32) * ldo + 4 * hi;
#pragma unroll
  for (int d0 = 0; d0 < NDV; ++d0)
#pragma unroll
    for (int g = 0; g < 4; ++g) *(unsigned*)(Ow + d0 * 32 + 8 * g) = pk4_fp8(clamp8(o[d0][4 * g] * rl), clamp8(o[d0][4 * g + 1] * rl), clamp8(o[d0][4 * g + 2] * rl), clamp8(o[d0][4 * g + 3] * rl));
#undef SLOADK
#undef SLOADV
#undef SWRITEK
#undef SWRITEV
#undef VMW0
#undef PSM_MAX
#undef REGION_X
#undef REGION_Y
#undef RESC
#undef STEP
#undef PT3
#undef PT4
}
}
__device__ __forceinline__ float* xres_row(const Frame& F, int row) { return row < NLAT ? F.out + (size_t)row * D : wsp<float>(F, WS_XC) + (size_t)(row - NLAT) * D; }
__device__ __forceinline__ void ln_row(float (&y)[32], const float* g, const float* b, int lane) {
    float s = 0.f;
#pragma unroll
    for (int i = 0; i < 32; ++i) s += y[i];
    const float mu = wave_sum(s) * (1.f / 2048.f);
    float q = 0.f;
#pragma unroll
    for (int i = 0; i < 32; ++i) { const float d = y[i] - mu; q += d * d; }
    const float rstd = rsqrtf(wave_sum(q) * (1.f / 2048.f) + LN_EPS);
#pragma unroll
    for (int qq = 0; qq < 4; ++qq) { const f32x4 g0 = *(const f32x4*)(g + 512 * qq + 8 * lane), g1 = *(const f32x4*)(g + 512 * qq + 8 * lane + 4), b0 = *(const f32x4*)(b + 512 * qq + 8 * lane), b1 = *(const f32x4*)(b + 512 * qq + 8 * lane + 4);
#pragma unroll
        for (int i = 0; i < 4; ++i) { y[qq * 8 + i] = (y[qq * 8 + i] - mu) * rstd * g0[i] + b0[i]; y[qq * 8 + 4 + i] = (y[qq * 8 + 4 + i] - mu) * rstd * g1[i] + b1[i]; } }
}
__device__ __forceinline__ void modulate_store(const float (&x)[32], const float* sh, const float* sc, bf16_t* dst, int lane) {
#pragma unroll
    for (int q = 0; q < 4; ++q) { const f32x4 h0 = *(const f32x4*)(sh + 512 * q + 8 * lane), h1 = *(const f32x4*)(sh + 512 * q + 8 * lane + 4), c0 = *(const f32x4*)(sc + 512 * q + 8 * lane), c1 = *(const f32x4*)(sc + 512 * q + 8 * lane + 4);
        f32x4 a, b;
#pragma unroll
        for (int i = 0; i < 4; ++i) { a[i] = x[q * 8 + i] * (1.f + c0[i]) + h0[i]; b[i] = x[q * 8 + 4 + i] * (1.f + c1[i]) + h1[i]; }
        *(u32x4*)(dst + 512 * q + 8 * lane) = pack8(a, b); }
}
__device__ __forceinline__ void p_ln1(const Frame& F, int l, bool last) {
    const float* mod = wsp<float>(F, WS_MOD) + (size_t)l * 5 * 12288; bf16_t* hb = wsp<bf16_t>(F, WS_HB);
    const float* g = F.in(18) + l * D; const float* b = F.in(19) + l * D;
    const int nrows = last ? NLAT : NROW; const int lane = F.lane, step = F.G * 8;
    float gg[32], bb[32]; ld_row_f32(g, lane, gg); ld_row_f32(b, lane, bb);
    int row = F.bid * 8 + F.wave;
    float yn[32];
    if (row < nrows) ld_row_f32(xres_row(F, row), lane, yn);
#pragma unroll 1
    for (; row < nrows; row += step) {
        const int v = row < NLAT ? (row >> 12) : 4; float* xp = xres_row(F, row);
        float y[32], sh[32], sc[32];
#pragma unroll
        for (int i = 0; i < 32; ++i) y[i] = yn[i];
        ld_row_f32(mod + (size_t)v * 12288 + 6144, lane, sh); ld_row_f32(mod + (size_t)v * 12288 + 8192, lane, sc);
        { const int nrow = row + step; if (nrow < nrows) ld_row_f32(xres_row(F, nrow), lane, yn); }
        float s = 0.f;
#pragma unroll
        for (int i = 0; i < 32; ++i) s += y[i];
        const float mu = wave_sum(s) * (1.f / 2048.f); float q = 0.f;
#pragma unroll
        for (int i = 0; i < 32; ++i) { const float d = y[i] - mu; q += d * d; }
        const float rstd = rsqrtf(wave_sum(q) * (1.f / 2048.f) + LN_EPS);
#pragma unroll
        for (int i = 0; i < 32; ++i) y[i] = (y[i] - mu) * rstd * gg[i] + bb[i];
        st_row_f32(xp, lane, y);
#pragma unroll
        for (int i = 0; i < 32; ++i) y[i] = y[i] * (1.f + sc[i]) + sh[i];
        st_row_bf16(hb + (size_t)row * D, lane, y);
    }
}

template <int NV>
__device__ __forceinline__ void top16(const float (&val)[NV], bool (&sel)[NV], int (&slot)[NV]) {
    unsigned key[NV];
#pragma unroll
    for (int v = 0; v < NV; ++v) { const unsigned u = __float_as_uint(val[v]); key[v] = (u & 0x80000000u) ? ~u : (u | 0x80000000u); }
    unsigned T = 0u;
#pragma unroll 1
    for (int bit = 31; bit >= 0; --bit) {
        const unsigned cand = T | (1u << bit); int cnt = 0;
#pragma unroll
        for (int v = 0; v < NV; ++v) cnt += __popcll(__ballot(key[v] >= cand));
        if (cnt >= 16) T = cand;
    }
    int ngt = 0;
#pragma unroll
    for (int v = 0; v < NV; ++v) ngt += __popcll(__ballot(key[v] > T));
    const int need = 16 - ngt;
    int run = 0, erun = 0;
#pragma unroll
    for (int v = 0; v < NV; ++v) {
        const unsigned long long mg = __ballot(key[v] > T), me = __ballot(key[v] == T);
        const int pg = __builtin_amdgcn_mbcnt_hi((unsigned)(mg >> 32), __builtin_amdgcn_mbcnt_lo((unsigned)mg, 0u));
        const int pe = __builtin_amdgcn_mbcnt_hi((unsigned)(me >> 32), __builtin_amdgcn_mbcnt_lo((unsigned)me, 0u));
        sel[v] = false; slot[v] = 0;
        if (key[v] > T) { sel[v] = true; slot[v] = run + pg; }
        else if (key[v] == T && (erun + pe) < need) { sel[v] = true; slot[v] = ngt + erun + pe; }
        run += __popcll(mg); erun += __popcll(me);
    }
}
__device__ __forceinline__ unsigned f2key(float f) { const unsigned u = __float_as_uint(f); return (u & 0x80000000u) ? ~u : (u | 0x80000000u); }
__device__ __forceinline__ float key2f(unsigned k) { return __uint_as_float((k & 0x80000000u) ? (k & 0x7fffffffu) : ~k); }
template <int NP, int NV>
__device__ __forceinline__ void bisect16(const unsigned (&key)[NP][NV], unsigned (&T)[NP]) {
    bool done[NP];
#pragma unroll
    for (int p = 0; p < NP; ++p) { T[p] = 0u; done[p] = false; }
#pragma unroll 1
    for (int bit = 31; bit >= 0; --bit) {
        const unsigned bm = 1u << bit; bool all = true;
#pragma unroll
        for (int p = 0; p < NP; ++p) {
            const unsigned cand = T[p] | bm; int cnt = 0;
#pragma unroll
            for (int v = 0; v < NV; ++v) cnt += __popcll(__ballot(key[p][v] >= cand));
            const bool upd = (cnt >= 16) && !done[p];
            T[p] = upd ? cand : T[p]; done[p] = done[p] || (cnt == 16); all = all && done[p];
        }
        if (all) break;
    }
}
template <int NV>
__device__ __forceinline__ void compact16(const unsigned (&key)[NV], const unsigned T, bool (&sel)[NV], int (&slot)[NV]) {
    int ngt = 0;
#pragma unroll
    for (int v = 0; v < NV; ++v) ngt += __popcll(__ballot(key[v] > T));
    const int need = 16 - ngt; int run = 0, erun = 0;
#pragma unroll
    for (int v = 0; v < NV; ++v) {
        const unsigned long long mg = __ballot(key[v] > T), me = __ballot(key[v] == T);
        const int pg = __builtin_amdgcn_mbcnt_hi((unsigned)(mg >> 32), __builtin_amdgcn_mbcnt_lo((unsigned)mg, 0u));
        const int pe = __builtin_amdgcn_mbcnt_hi((unsigned)(me >> 32), __builtin_amdgcn_mbcnt_lo((unsigned)me, 0u));
        sel[v] = false; slot[v] = 0;
        if (key[v] > T) { sel[v] = true; slot[v] = run + pg; }
        else if (key[v] == T && (erun + pe) < need) { sel[v] = true; slot[v] = ngt + erun + pe; }
        run += __popcll(mg); erun += __popcll(me);
    }
}
constexpr int KP = 68;
constexpr int PW_BYTES = 9344;
__device__ __forceinline__ float gelu_erf(float x) {
    const float z = fabsf(x) * 0.7071067811865476f; const float t = __builtin_amdgcn_rcpf(1.f + 0.3275911f * z);
    float p = 1.061405429f; p = p * t - 1.453152027f; p = p * t + 1.421413741f; p = p * t - 0.284496736f; p = p * t + 0.254829592f; p = p * t;
    const float er = 1.f - p * __expf(-z * z);
    return 0.5f * x * (1.f + (x < 0.f ? -er : er));
}
__device__ __forceinline__ float wave_max(float x) {
    x = row16_max(x);
    { auto r = __builtin_amdgcn_permlane16_swap(__float_as_uint(x), __float_as_uint(x), false, false); x = fmaxf(__uint_as_float(r[0]), __uint_as_float(r[1])); }
    { auto r = __builtin_amdgcn_permlane32_swap(__float_as_uint(x), __float_as_uint(x), false, false); x = fmaxf(__uint_as_float(r[0]), __uint_as_float(r[1])); }
    return x;
}
__device__ __forceinline__ void ld16_f32(const float* p, int lane, float (&x)[32]) {
#pragma unroll
    for (int q = 0; q < 2; ++q)
#pragma unroll
        for (int d = 0; d < 4; ++d) { const f32x4 a = *(const f32x4*)(p + 1024 * q + 16 * lane + 4 * d); x[q * 16 + d * 4 + 0] = a[0]; x[q * 16 + d * 4 + 1] = a[1]; x[q * 16 + d * 4 + 2] = a[2]; x[q * 16 + d * 4 + 3] = a[3]; }
}
__device__ __forceinline__ void ld16_f32_nt(const float* p, int lane, float (&x)[32]) {
#pragma unroll
    for (int q = 0; q < 2; ++q)
#pragma unroll
        for (int d = 0; d < 4; ++d) { const f32x4 a = __builtin_nontemporal_load((const f32x4*)(p + 1024 * q + 16 * lane + 4 * d)); x[q * 16 + d * 4 + 0] = a[0]; x[q * 16 + d * 4 + 1] = a[1]; x[q * 16 + d * 4 + 2] = a[2]; x[q * 16 + d * 4 + 3] = a[3]; }
}
__device__ __forceinline__ void st16_f32_nt(float* p, int lane, const float (&x)[32]) {
#pragma unroll
    for (int q = 0; q < 2; ++q)
#pragma unroll
        for (int d = 0; d < 4; ++d) __builtin_nontemporal_store((f32x4){x[q * 16 + d * 4 + 0], x[q * 16 + d * 4 + 1], x[q * 16 + d * 4 + 2], x[q * 16 + d * 4 + 3]}, (f32x4*)(p + 1024 * q + 16 * lane + 4 * d));
}
__device__ __forceinline__ void st16_f32(float* p, int lane, const float (&x)[32]) {
#pragma unroll
    for (int q = 0; q < 2; ++q)
#pragma unroll
        for (int d = 0; d < 4; ++d) *(f32x4*)(p + 1024 * q + 16 * lane + 4 * d) = (f32x4){x[q * 16 + d * 4 + 0], x[q * 16 + d * 4 + 1], x[q * 16 + d * 4 + 2], x[q * 16 + d * 4 + 3]};
}
__device__ __forceinline__ void ld16_bf16(const bf16_t* p, int lane, float (&x)[32]) {
#pragma unroll
    for (int q = 0; q < 2; ++q)
#pragma unroll
        for (int d = 0; d < 2; ++d) { const u32x4 w = *(const u32x4*)(p + 1024 * q + 16 * lane + 8 * d); float* o = &x[q * 16 + d * 8];
            o[0] = bflo(w.x); o[1] = bfhi(w.x); o[2] = bflo(w.y); o[3] = bfhi(w.y); o[4] = bflo(w.z); o[5] = bfhi(w.z); o[6] = bflo(w.w); o[7] = bfhi(w.w); }
}
__device__ __forceinline__ void st16_bf16(bf16_t* p, int lane, const float (&x)[32]) {
#pragma unroll
    for (int q = 0; q < 2; ++q)
#pragma unroll
        for (int d = 0; d < 2; ++d) { const float* o = &x[q * 16 + d * 8]; u32x4 w; w.x = cvt_pk_bf16(o[0], o[1]); w.y = cvt_pk_bf16(o[2], o[3]); w.z = cvt_pk_bf16(o[4], o[5]); w.w = cvt_pk_bf16(o[6], o[7]);
            *(u32x4*)(p + 1024 * q + 16 * lane + 8 * d) = w; }
}
constexpr int TBS = 1152;
__device__ __forceinline__ void cvt_row_fp4b(int lane, const float* __restrict__ src, unsigned char* __restrict__ dst) {
    float x[32];
#pragma unroll
    for (int q = 0; q < 2; ++q)
#pragma unroll
        for (int d = 0; d < 4; ++d) { const f32x4 a = __builtin_nontemporal_load((const f32x4*)(src + 1024 * q + 16 * lane + 4 * d)); x[q * 16 + d * 4 + 0] = a[0]; x[q * 16 + d * 4 + 1] = a[1]; x[q * 16 + d * 4 + 2] = a[2]; x[q * 16 + d * 4 + 3] = a[3]; }
    float am = 0.f;
#pragma unroll
    for (int i = 0; i < 32; ++i) am = fmaxf(am, fabsf(x[i]));
    const bf16_t sb = f2bf(am * (1.f / 6.f)); const float sf = bf2f(sb); const float sc = sf > 0.f ? 1.f / sf : 0.f;
    u32x4 w;
#pragma unroll
    for (int d = 0; d < 4; ++d) { unsigned t = 0u; const int o = (d >> 1) * 16 + (d & 1) * 8;
        t = __builtin_amdgcn_cvt_scalef32_pk_fp4_f32(t, x[o + 0] * sc, x[o + 1] * sc, 1.0f, 0); t = __builtin_amdgcn_cvt_scalef32_pk_fp4_f32(t, x[o + 2] * sc, x[o + 3] * sc, 1.0f, 1);
        t = __builtin_amdgcn_cvt_scalef32_pk_fp4_f32(t, x[o + 4] * sc, x[o + 5] * sc, 1.0f, 2); t = __builtin_amdgcn_cvt_scalef32_pk_fp4_f32(t, x[o + 6] * sc, x[o + 7] * sc, 1.0f, 3); w[d] = t; }
    *(u32x4*)(dst + 16 * lane) = w;
    *(bf16_t*)(dst + 1024 + 2 * lane) = sb;
}
__device__ __forceinline__ void cvt_row_fp4r(int lane, const float* __restrict__ src, unsigned char* __restrict__ dst, float* __restrict__ inv) {
    float x[32];
#pragma unroll
    for (int q = 0; q < 2; ++q)
#pragma unroll
        for (int d = 0; d < 4; ++d) { const f32x4 a = __builtin_nontemporal_load((const f32x4*)(src + 1024 * q + 16 * lane + 4 * d)); x[q * 16 + d * 4 + 0] = a[0]; x[q * 16 + d * 4 + 1] = a[1]; x[q * 16 + d * 4 + 2] = a[2]; x[q * 16 + d * 4 + 3] = a[3]; }
    float am = 0.f;
#pragma unroll
    for (int i = 0; i < 32; ++i) am = fmaxf(am, fabsf(x[i]));
    am = wave_max(am);
    const float sc = am > 0.f ? 6.f / am : 1.f;
    if (lane == 0) *inv = am > 0.f ? am * (1.f / 6.f) : 1.f;
    u32x4 w;
#pragma unroll
    for (int d = 0; d < 4; ++d) { unsigned t = 0u; const int o = (d >> 1) * 16 + (d & 1) * 8;
        t = __builtin_amdgcn_cvt_scalef32_pk_fp4_f32(t, x[o + 0] * sc, x[o + 1] * sc, 1.0f, 0); t = __builtin_amdgcn_cvt_scalef32_pk_fp4_f32(t, x[o + 2] * sc, x[o + 3] * sc, 1.0f, 1);
        t = __builtin_amdgcn_cvt_scalef32_pk_fp4_f32(t, x[o + 4] * sc, x[o + 5] * sc, 1.0f, 2); t = __builtin_amdgcn_cvt_scalef32_pk_fp4_f32(t, x[o + 6] * sc, x[o + 7] * sc, 1.0f, 3); w[d] = t; }
    *(u32x4*)(dst + 16 * lane) = w;
}
__device__ __forceinline__ void cvt_peer(const Frame& F, int l) {
    for (int r = F.bid * 8 + F.wave; r < 16384; r += F.G * 8) cvt_row_fp4b(F.lane, F.in(23) + ((size_t)l * 16384 + r) * 2048, wsp<unsigned char>(F, WS_PU) + (size_t)l * SZ_PT + (size_t)r * TBS);
    for (int r = F.bid * 8 + F.wave; r < 16384; r += F.G * 8) cvt_row_fp4b(F.lane, F.in(24) + ((size_t)l * 16384 + r) * 2048, wsp<unsigned char>(F, WS_PV) + (size_t)l * SZ_PT + (size_t)r * TBS);
}
#define PEER_G 4
template <int CTRL> __device__ __forceinline__ int dppi(int x) { return __builtin_amdgcn_update_dpp(0, x, CTRL, 0xF, 0xF, true); }
__device__ __forceinline__ int irow16_sum(int x) { x += dppi<0xB1>(x); x += dppi<0x4E>(x); x += dppi<0x141>(x); x += dppi<0x140>(x); return x; }
__device__ __forceinline__ int irow16_incl_scan(int x) { x += dppi<0x111>(x); x += dppi<0x112>(x); x += dppi<0x114>(x); x += dppi<0x118>(x); return x; }
constexpr int KBP = 72;
constexpr int PT_WORDS = 6 * 128 + 160 + 3 * 128;
constexpr int PWB = 2 * PT_WORDS * 4;
__device__ __forceinline__ void p_peer(const Frame& F, int l, bool last) {
    LAS bf16_t* kb1 = (LAS bf16_t*)F.lds; LAS bf16_t* kb2 = kb1 + 128 * KBP;
    LAS unsigned* wbase = (LAS unsigned*)(F.lds + 2 * 128 * KBP * 2 + F.wave * PWB);
    const int lane = F.lane, fr = lane & 15, fq = lane >> 4;
    __syncthreads();
    for (int i = F.tid; i < 128 * 64; i += 512) { const int r = i >> 6, d = i & 63; kb1[r * KBP + d] = f2bf(F.in(21)[(size_t)l * 8192 + i]); kb2[r * KBP + d] = f2bf(F.in(22)[(size_t)l * 8192 + i]); }
    __syncthreads();
    const bf16_t* QP = wsp<bf16_t>(F, WS_QP); const bf16_t* HB = wsp<bf16_t>(F, WS_HB); unsigned char* HB8w = wsp<unsigned char>(F, WS_HB8);
    const unsigned char* PU = wsp<unsigned char>(F, WS_PU) + (size_t)l * SZ_PT; const unsigned char* PV = wsp<unsigned char>(F, WS_PV) + (size_t)l * SZ_PT;
    const float* modl = wsp<float>(F, WS_MOD) + (size_t)l * 5 * 12288; const float* modn = wsp<float>(F, WS_MOD) + (size_t)(l + 1) * 5 * 12288;
    const float* g2n = F.in(25) + l * D; const float* b2n = F.in(26) + l * D;
    const int npairs = (last ? NLAT : NROW) / 2;
    const int per_wg = (npairs + F.G - 1) / F.G; const int p_lo = F.bid * per_wg; const int p_hi = (p_lo + per_wg) < npairs ? (p_lo + per_wg) : npairs;
    LAS int* wq = (LAS int*)(F.lds + 147456 - 32);
    if (F.tid == 0) *wq = 0;
    __syncthreads();
#pragma unroll 1
    for (;;) {
        int pi = 0; if (lane == 0) pi = __hip_atomic_fetch_add(wq, 1, __ATOMIC_RELAXED, __HIP_MEMORY_SCOPE_WORKGROUP);
        pi = p_lo + __builtin_amdgcn_readfirstlane(pi); if (pi >= p_hi) break;
        const int rowA = 2 * pi;
#pragma unroll 1
        for (int rep1_ = 0; rep1_ <= REP_PS1; ++rep1_) {
            unsigned kk[2][8][4];
            { int fr_ = fr; asm volatile("" : "+v"(fr_));
              const bf16_t* qrow = QP + (size_t)(rowA + (fr_ >> 3)) * 1024 + (fr_ & 7) * 128 + 8 * fq;
              bf16x8 af[2][2];
#pragma unroll
              for (int st = 0; st < 2; ++st)
#pragma unroll
                  for (int ks = 0; ks < 2; ++ks) af[st][ks] = *(const bf16x8*)(qrow + st * 64 + ks * 32);
#pragma unroll
              for (int st = 0; st < 2; ++st) { LAS bf16_t* kb = st ? kb2 : kb1;
#pragma unroll
                  for (int nb = 0; nb < 8; ++nb) { f32x4 c = {0.f, 0.f, 0.f, 0.f};
#pragma unroll
                      for (int ks = 0; ks < 2; ++ks) { const bf16x8 bfr = *(const LAS bf16x8*)(kb + (nb * 16 + fr) * KBP + ks * 32 + 8 * fq); c = __builtin_amdgcn_mfma_f32_16x16x32_bf16(af[st][ks], bfr, c, 0, 0, 0); }
#pragma unroll
                      for (int r = 0; r < 4; ++r) kk[st][nb][r] = f2key(c[r]); } } }
            unsigned T[2][4]; bool done[2][4];
#pragma unroll
            for (int st = 0; st < 2; ++st)
#pragma unroll
                for (int r = 0; r < 4; ++r) { T[st][r] = 0u; done[st][r] = false; }
#pragma unroll 1
            for (int bit = 31; bit >= 0; --bit) { const unsigned bm = 1u << bit; bool alld = true;
#pragma unroll
                for (int st = 0; st < 2; ++st)
#pragma unroll
                    for (int r = 0; r < 4; ++r) { const unsigned cand = T[st][r] | bm; int c = 0;
#pragma unroll
                        for (int nb = 0; nb < 8; ++nb) c += (kk[st][nb][r] >= cand) ? 1 : 0;
                        c = irow16_sum(c);
                        const bool upd = (c >= 16) && !done[st][r]; T[st][r] = upd ? cand : T[st][r]; done[st][r] = done[st][r] || (c == 16); alld = alld && done[st][r]; }
                if (__all(alld)) break; }
            const int tt = lane >> 5, hd0 = ((lane >> 4) & 1) * 4;
#pragma unroll
            for (int st = 0; st < 2; ++st)
#pragma unroll
                for (int r = 0; r < 4; ++r) { const unsigned Tr = T[st][r]; int g = 0, e = 0;
#pragma unroll
                    for (int nb = 0; nb < 8; ++nb) { g += (kk[st][nb][r] > Tr) ? 1 : 0; e += (kk[st][nb][r] == Tr) ? 1 : 0; }
                    int gpre = irow16_incl_scan(g) - g, epre = irow16_incl_scan(e) - e; const int ngt = irow16_sum(g); const int need = 16 - ngt;
                    LAS unsigned* tb = wbase + tt * PT_WORDS; LAS float* vl = (LAS float*)(tb + st * 128) + (hd0 + r) * 16; LAS int* il = (LAS int*)(tb + 256 + st * 128) + (hd0 + r) * 16;
#pragma unroll
                    for (int nb = 0; nb < 8; ++nb) { const unsigned k = kk[st][nb][r];
                        if (k > Tr) { vl[gpre] = key2f(k); il[gpre] = nb * 16 + fr; ++gpre; }
                        else if (k == Tr) { if (epre < need) { vl[ngt + epre] = key2f(k); il[ngt + epre] = nb * 16 + fr; } ++epre; } } }
        }
        asm volatile("s_waitcnt lgkmcnt(0)" ::: "memory");
        {
            const int tt = lane >> 5, hd0 = ((lane >> 4) & 1) * 4; LAS unsigned* tb = wbase + tt * PT_WORDS;
            unsigned ck[4][16];
#pragma unroll
            for (int r = 0; r < 4; ++r) { const float va = ((LAS float*)tb)[(hd0 + r) * 16 + fr]; const LAS float* v2p = (LAS float*)(tb + 128) + (hd0 + r) * 16;
#pragma unroll
                for (int j4 = 0; j4 < 4; ++j4) { const f32x4 vb = *(const LAS f32x4*)(v2p + j4 * 4);
#pragma unroll
                    for (int i = 0; i < 4; ++i) ck[r][j4 * 4 + i] = f2key(va + vb[i]); } }
            unsigned T[4]; bool done[4];
#pragma unroll
            for (int r = 0; r < 4; ++r) { T[r] = 0u; done[r] = false; }
#pragma unroll 1
            for (int bit = 31; bit >= 0; --bit) { const unsigned bm = 1u << bit; bool alld = true;
#pragma unroll
                for (int r = 0; r < 4; ++r) { const unsigned cand = T[r] | bm; int c = 0;
#pragma unroll
                    for (int j = 0; j < 16; ++j) c += (ck[r][j] >= cand) ? 1 : 0;
                    c = irow16_sum(c);
                    const bool upd = (c >= 16) && !done[r]; T[r] = upd ? cand : T[r]; done[r] = done[r] || (c == 16); alld = alld && done[r]; }
                if (__all(alld)) break; }
#pragma unroll
            for (int r = 0; r < 4; ++r) { const unsigned Tr = T[r]; int g = 0, e = 0;
#pragma unroll
                for (int j = 0; j < 16; ++j) { g += (ck[r][j] > Tr) ? 1 : 0; e += (ck[r][j] == Tr) ? 1 : 0; }
                int gpre = irow16_incl_scan(g) - g, epre = irow16_incl_scan(e) - e; const int ngt = irow16_sum(g); const int need = 16 - ngt;
                const int e1 = ((LAS int*)(tb + 256))[(hd0 + r) * 16 + fr] * 128; const LAS int* i2p = (LAS int*)(tb + 384) + (hd0 + r) * 16;
                LAS float* cs_ = (LAS float*)(tb + 512) + (hd0 + r) * 16; LAS int* ce_ = (LAS int*)(tb + 640) + (hd0 + r) * 16;
#pragma unroll
                for (int j = 0; j < 16; ++j) { const unsigned k = ck[r][j];
                    if (k > Tr) { cs_[gpre] = key2f(k); ce_[gpre] = e1 + i2p[j]; ++gpre; }
                    else if (k == Tr) { if (epre < need) { cs_[ngt + epre] = key2f(k); ce_[ngt + epre] = e1 + i2p[j]; } ++epre; } } }
        }
        asm volatile("s_waitcnt lgkmcnt(0)" ::: "memory");
#pragma unroll 1
      for (int t = 0; t < 2; ++t) {
        const int row = rowA + t; const int v = row < NLAT ? (row >> 12) : 4;
        LAS unsigned* tb = wbase + t * PT_WORDS;
        LAS float* v1l = (LAS float*)tb; LAS float* v2l = v1l + 128; LAS int* i1l = (LAS int*)(v2l + 128); LAS int* i2l = i1l + 128;
        LAS float* csl = (LAS float*)(i2l + 128); LAS int* cel = (LAS int*)(csl + 128); LAS int* el = cel + 128; LAS float* gl = (LAS float*)(el + 160); LAS float* su = gl + 128; LAS float* sv = su + 128;
        {
#pragma unroll
            for (int it = 0; it < 2; ++it) { const int idx = it * 64 + lane;
                const float sx = csl[idx]; const float mx = row16_max(sx); const float pe_ = __expf(sx - mx); const float sm = row16_sum(pe_);
                el[idx] = cel[idx]; gl[idx] = pe_ / sm; }
        }
        if (lane < 32) el[128 + lane] = el[0];
        asm volatile("s_waitcnt vmcnt(0) lgkmcnt(0)" ::: "memory");
        float hh[32]; ld16_bf16(HB + (size_t)row * D, lane, hh);
        f32x2 hh2[16];
#pragma unroll
        for (int i = 0; i < 16; ++i) hh2[i] = (f32x2){hh[2 * i], hh[2 * i + 1]};
        const bool b0_ = lane & 1, b1_ = lane & 2, b2_ = lane & 4;
        u32x4 A[8], B[8], C[8]; unsigned SA[8], SB[8], SC[8];
#define PEER_LOADT(buf, sbuf, tab, g) do { _Pragma("unroll") for (int x = 0; x < 8; ++x) { const int e = __builtin_amdgcn_readfirstlane(el[(g) * 8 + x]); const unsigned char* rp = (tab) + (size_t)e * TBS; \
            buf[x] = *(const u32x4*)(rp + 16 * lane); sbuf[x] = *(const bf16_t*)(rp + 1024 + 2 * lane); } } while (0)
#define PEER_LOADV(buf, g) do { _Pragma("unroll") for (int x = 0; x < 8; ++x) { const int e = __builtin_amdgcn_readfirstlane(el[(g) * 8 + x]); buf[x] = *(const u32x4*)(PV + (size_t)e * 1024 + 16 * lane); } } while (0)
#define FP4X8(w_, f0_, f1_, f2_, f3_) const f32x2 f0_ = __builtin_amdgcn_cvt_scalef32_pk_f32_fp4(w_, 1.0f, 0), f1_ = __builtin_amdgcn_cvt_scalef32_pk_f32_fp4(w_, 1.0f, 1), f2_ = __builtin_amdgcn_cvt_scalef32_pk_f32_fp4(w_, 1.0f, 2), f3_ = __builtin_amdgcn_cvt_scalef32_pk_f32_fp4(w_, 1.0f, 3)
#define PEER_DOT(buf, sbuf, g) do { float p_[8]; \
            _Pragma("unroll") for (int x = 0; x < 8; ++x) { f32x2 s2_ = {0.f, 0.f}; \
                _Pragma("unroll") for (int d = 0; d < 4; ++d) { const unsigned w_ = buf[x][d]; FP4X8(w_, f0_, f1_, f2_, f3_); const int o_ = (d >> 1) * 8 + (d & 1) * 4; \
                    s2_ = hh2[o_ + 0] * f0_ + s2_; s2_ = hh2[o_ + 1] * f1_ + s2_; s2_ = hh2[o_ + 2] * f2_ + s2_; s2_ = hh2[o_ + 3] * f3_ + s2_; } \
                p_[x] = (s2_.x + s2_.y) * __uint_as_float(sbuf[x] << 16); SBAR(); } \
              \
            float q_[4], r_[2]; \
            _Pragma("unroll") for (int j = 0; j < 4; ++j) { const float keep_ = b0_ ? p_[2 * j + 1] : p_[2 * j], send_ = b0_ ? p_[2 * j] : p_[2 * j + 1]; q_[j] = keep_ + dppf<0xB1>(send_); } \
            _Pragma("unroll") for (int j = 0; j < 2; ++j) { const float keep_ = b1_ ? q_[2 * j + 1] : q_[2 * j], send_ = b1_ ? q_[2 * j] : q_[2 * j + 1]; r_[j] = keep_ + dppf<0x4E>(send_); } \
            float t_; { const float keep_ = b2_ ? r_[1] : r_[0], send_ = b2_ ? r_[0] : r_[1]; const float up_ = dppf<0x104>(send_), dn_ = dppf<0x114>(send_); t_ = keep_ + (b2_ ? dn_ : up_); } \
            t_ += dppf<0x128>(t_); \
            { auto r16_ = __builtin_amdgcn_permlane16_swap(__float_as_uint(t_), __float_as_uint(t_), false, false); t_ = __uint_as_float(r16_[0]) + __uint_as_float(r16_[1]); } \
            { auto r32_ = __builtin_amdgcn_permlane32_swap(__float_as_uint(t_), __float_as_uint(t_), false, false); t_ = __uint_as_float(r32_[0]) + __uint_as_float(r32_[1]); } \
            const float av = gelu_erf(t_) * gl[(g) * 8 + (lane & 7)]; const bool me_ = (lane >> 3) == ((g) & 7); \
            avl = (me_ && (g) < 8) ? av : avl; avh = (me_ && (g) >= 8) ? av : avh; } while (0)
#define PIN_ACC() do { asm volatile("" : "+v"(acc2[0]), "+v"(acc2[1]), "+v"(acc2[2]), "+v"(acc2[3]), "+v"(acc2[4]), "+v"(acc2[5]), "+v"(acc2[6]), "+v"(acc2[7]), "+v"(acc2[8]), "+v"(acc2[9]), "+v"(acc2[10]), "+v"(acc2[11]), "+v"(acc2[12]), "+v"(acc2[13]), "+v"(acc2[14]), "+v"(acc2[15])); } while (0)
#define PEER_AXPY(buf, sbuf, g) do { _Pragma("unroll") for (int x = 0; x < 8; ++x) { const int idx = (g) * 8 + x; \
            const float av = __uint_as_float(__builtin_amdgcn_readlane(__float_as_uint(idx < 64 ? avl : avh), idx & 63)) * __uint_as_float(sbuf[x] << 16); const f32x2 av2_ = {av, av}; \
            _Pragma("unroll") for (int d = 0; d < 4; ++d) { const unsigned w_ = buf[x][d]; FP4X8(w_, f0_, f1_, f2_, f3_); const int o_ = (d >> 1) * 8 + (d & 1) * 4; \
                acc2[o_ + 0] = av2_ * f0_ + acc2[o_ + 0]; acc2[o_ + 1] = av2_ * f1_ + acc2[o_ + 1]; acc2[o_ + 2] = av2_ * f2_ + acc2[o_ + 2]; acc2[o_ + 3] = av2_ * f3_ + acc2[o_ + 3]; } PIN_ACC(); } } while (0)
        float avl = 0.f, avh = 0.f;
        PEER_LOADT(A, SA, PU, 0); PEER_LOADT(B, SB, PU, 1);
#pragma unroll 1
        for (int g = 0; g < 15; g += 3) { PEER_LOADT(C, SC, PU, g + 2); SBAR(); PEER_DOT(A, SA, g); SBAR(); PEER_LOADT(A, SA, PU, g + 3); SBAR(); PEER_DOT(B, SB, g + 1); SBAR(); PEER_LOADT(B, SB, PU, g + 4); SBAR(); PEER_DOT(C, SC, g + 2); SBAR(); }
        PEER_DOT(A, SA, 15); SBAR();
        f32x2 acc2[16];
#pragma unroll
        for (int i = 0; i < 16; ++i) acc2[i] = (f32x2){0.f, 0.f};
        float* xp = xres_row(F, row);
        PEER_LOADT(A, SA, PV, 0); PEER_LOADT(B, SB, PV, 1);
#pragma unroll 1
        for (int g = 0; g < 15; g += 3) { PEER_LOADT(C, SC, PV, g + 2); SBAR(); PEER_AXPY(A, SA, g); SBAR(); PEER_LOADT(A, SA, PV, g + 3); SBAR(); PEER_AXPY(B, SB, g + 1); SBAR(); PEER_LOADT(B, SB, PV, g + 4); SBAR(); PEER_AXPY(C, SC, g + 2); SBAR(); }
        float x1[32], g2[32]; ld16_f32(xp, lane, x1); ld16_f32(modl + (size_t)v * 12288 + 10240, lane, g2); SBAR();
        PEER_AXPY(A, SA, 15); SBAR();
#undef PEER_LOADT
#undef PEER_LOADV
#undef PEER_DOT
#undef PEER_AXPY
        float acc[32];
        {
#pragma unroll
          for (int i = 0; i < 32; ++i) acc[i] = ALPHA * x1[i] + g2[i] * acc2[i >> 1][i & 1]; }
        { float sm = 0.f;
#pragma unroll
          for (int i = 0; i < 32; ++i) sm += acc[i];
          const float mu = wave_sum(sm) * (1.f / 2048.f); float qq = 0.f;
#pragma unroll
          for (int i = 0; i < 32; ++i) { const float dd = acc[i] - mu; qq += dd * dd; }
          const float rstd = rsqrtf(wave_sum(qq) * (1.f / 2048.f) + LN_EPS);
#pragma unroll
          for (int q = 0; q < 2; ++q)
#pragma unroll
              for (int d = 0; d < 4; ++d) { const int o = 1024 * q + 16 * lane + 4 * d; const f32x4 gg = *(const f32x4*)(g2n + o), bb = *(const f32x4*)(b2n + o);
#pragma unroll
                  for (int i = 0; i < 4; ++i) acc[q * 16 + d * 4 + i] = (acc[q * 16 + d * 4 + i] - mu) * rstd * gg[i] + bb[i]; } }
        st16_f32(xp, lane, acc);
        if (!last) { const float* sh = modn + (size_t)v * 12288; const float* sc = sh + 2048;
#pragma unroll
            for (int q = 0; q < 2; ++q)
#pragma unroll
                for (int d = 0; d < 4; ++d) { const int o = 1024 * q + 16 * lane + 4 * d; const f32x4 hh4 = *(const f32x4*)(sh + o), cc4 = *(const f32x4*)(sc + o);
#pragma unroll
                    for (int i = 0; i < 4; ++i) acc[q * 16 + d * 4 + i] = clamp8(acc[q * 16 + d * 4 + i] * (1.f + cc4[i]) + hh4[i]); }
#pragma unroll
            for (int q = 0; q < 2; ++q) { u32x4 w;
#pragma unroll
                for (int d = 0; d < 4; ++d) w[d] = pk4_fp8(acc[q * 16 + d * 4 + 0], acc[q * 16 + d * 4 + 1], acc[q * 16 + d * 4 + 2], acc[q * 16 + d * 4 + 3]);
                *(u32x4*)(HB8w + (size_t)row * D + 1024 * q + 16 * lane) = w; } }
      }
    }
}
#ifdef DBG
constexpr size_t WS_DBG = WS_CTL + 131072;
constexpr int DBG_NS = 60;
__device__ __forceinline__ int dbg_row(int s) { return (s * 263 + 5) % NLAT; }
__global__ void __launch_bounds__(256) dbg_peer_pre(Args args, int l) {
    __shared__ float q[1024]; __shared__ float s1[128], s2[128]; __shared__ float v1[16], v2[16]; __shared__ int i1[16], i2[16]; __shared__ float cs[256]; __shared__ int ce[256];
    __shared__ float ts[16]; __shared__ int te[16]; __shared__ float red[256]; __shared__ float aval[128]; __shared__ int eid[128]; __shared__ float h2[2048];
    const int s = blockIdx.x, row = dbg_row(s), tid = threadIdx.x; unsigned char* ws = args.ws;
    const bf16_t* QP = (const bf16_t*)(ws + WS_QP); const bf16_t* HB = (const bf16_t*)(ws + WS_HB);
    float* dbgf = (float*)(ws + WS_DBG + 4096); int* dbge = (int*)(dbgf + DBG_NS * 2048); float* dbga = (float*)(dbge + DBG_NS * 128); float* dbgg = dbga + 3 * DBG_NS * 128;
    for (int i = tid; i < 1024; i += 256) q[i] = bf2f(QP[(size_t)row * 1024 + i]);
    for (int i = tid; i < 2048; i += 256) h2[i] = bf2f(HB[(size_t)row * D + i]);
    __syncthreads();
    const float* k1 = args.in[21] + (size_t)l * 8192; const float* k2 = args.in[22] + (size_t)l * 8192;
    for (int hd = 0; hd < 8; ++hd) {
        { const int k = tid & 127; const float* kk = (tid < 128 ? k1 : k2) + k * 64; const float* qq = q + hd * 128 + (tid < 128 ? 0 : 64); float a = 0.f; for (int d = 0; d < 64; ++d) a += qq[d] * kk[d]; (tid < 128 ? s1 : s2)[k] = a; }
        __syncthreads();
        { const int k = tid & 127; const float* sv = tid < 128 ? s1 : s2; const float me = sv[k]; int rank = 0; for (int j = 0; j < 128; ++j) rank += (sv[j] > me || (sv[j] == me && j < k)) ? 1 : 0;
          if (rank < 16) { (tid < 128 ? v1 : v2)[rank] = me; (tid < 128 ? i1 : i2)[rank] = k; } }
        __syncthreads();
        { const int i = tid >> 4, j = tid & 15; cs[tid] = v1[i] + v2[j]; ce[tid] = i1[i] * 128 + i2[j]; }
        __syncthreads();
        { const float me = cs[tid]; int rank = 0; for (int j = 0; j < 256; ++j) rank += (cs[j] > me || (cs[j] == me && j < tid)) ? 1 : 0; if (rank < 16) { ts[rank] = me; te[rank] = ce[tid]; } }
        __syncthreads();
        if (tid < 16) { float mx = ts[0]; float sm = 0.f; for (int j = 0; j < 16; ++j) sm += expf(ts[j] - mx); aval[hd * 16 + tid] = expf(ts[tid] - mx) / sm; eid[hd * 16 + tid] = te[tid]; dbgg[s * 128 + hd * 16 + tid] = aval[hd * 16 + tid]; }
        __syncthreads();
    }
    const float* U = args.in[23] + (size_t)l * 16384 * 2048; const float* V = args.in[24] + (size_t)l * 16384 * 2048;
    for (int e = 0; e < 128; ++e) { const float* ur = U + (size_t)eid[e] * 2048; float p = 0.f; for (int d = tid; d < 2048; d += 256) p += h2[d] * ur[d]; red[tid] = p; __syncthreads();
        for (int st = 128; st > 0; st >>= 1) { if (tid < st) red[tid] += red[tid + st]; __syncthreads(); }
        if (tid == 0) { const float sc = red[0]; aval[e] = 0.5f * sc * (1.f + erff(sc * 0.70710678f)) * aval[e]; } __syncthreads(); }
    float y[8]; const float* xr = args.out + (size_t)row * D; const int v = row >> 12; const float* mod = (const float*)(ws + WS_MOD) + (size_t)l * 5 * 12288 + (size_t)v * 12288;
    float sum = 0.f;
    for (int k = 0; k < 8; ++k) { const int d = tid + 256 * k; float o = 0.f; for (int e = 0; e < 128; ++e) o += aval[e] * V[(size_t)eid[e] * 2048 + d]; y[k] = ALPHA * xr[d] + mod[10240 + d] * o; sum += y[k]; }
    red[tid] = sum; __syncthreads(); for (int st = 128; st > 0; st >>= 1) { if (tid < st) red[tid] += red[tid + st]; __syncthreads(); } const float mu = red[0] / 2048.f; __syncthreads();
    float sq = 0.f; for (int k = 0; k < 8; ++k) sq += (y[k] - mu) * (y[k] - mu);
    red[tid] = sq; __syncthreads(); for (int st = 128; st > 0; st >>= 1) { if (tid < st) red[tid] += red[tid + st]; __syncthreads(); } const float rstd = rsqrtf(red[0] / 2048.f + LN_EPS);
    for (int k = 0; k < 8; ++k) { const int d = tid + 256 * k; dbgf[(size_t)s * 2048 + d] = (y[k] - mu) * rstd * args.in[25][l * D + d] + args.in[26][l * D + d]; }
    if (tid < 128) { dbge[s * 128 + tid] = eid[tid]; dbga[s * 128 + tid] = aval[tid]; }
}
__global__ void __launch_bounds__(256) dbg_peer_post(Args args) {
    __shared__ int bad_e, bad_x, bad_a, bad_g;
    const int s = blockIdx.x, row = dbg_row(s), tid = threadIdx.x; unsigned char* ws = args.ws; unsigned* cnt = (unsigned*)(ws + WS_DBG);
    float* dbgf = (float*)(ws + WS_DBG + 4096); int* dbge = (int*)(dbgf + DBG_NS * 2048); float* dbga = (float*)(dbge + DBG_NS * 128);
    int* fe = (int*)(dbga + DBG_NS * 128); float* fa = (float*)(fe + DBG_NS * 128); float* dbgg = dbga + 3 * DBG_NS * 128; float* fg = dbgg + DBG_NS * 128;
    if (tid == 0) { bad_e = 0; bad_x = 0; bad_a = 0; bad_g = 0; } __syncthreads();
    if (tid < 128) { const int hd = tid >> 4; const int e = dbge[s * 128 + tid]; bool found = false; float af = 0.f, gf = 0.f; for (int j = 0; j < 16; ++j) if (fe[s * 128 + hd * 16 + j] == e) { found = true; af = fa[s * 128 + hd * 16 + j]; gf = fg[s * 128 + hd * 16 + j]; }
        if (!found) atomicAdd(&bad_e, 1); else { const float ea = dbga[s * 128 + tid]; if (fabsf(af - ea) > 0.02f * fabsf(ea) + 2e-3f) atomicAdd(&bad_a, 1); const float eg = dbgg[s * 128 + tid]; if (fabsf(gf - eg) > 0.02f * fabsf(eg) + 1e-3f) atomicAdd(&bad_g, 1); } }
    for (int k = 0; k < 8; ++k) { const int d = tid + 256 * k; const float ex = dbgf[(size_t)s * 2048 + d], got = args.out[(size_t)row * D + d]; if (!(fabsf(got - ex) <= 0.03f + 0.03f * fabsf(ex))) atomicAdd(&bad_x, 1); }
    __syncthreads();
    if (tid == 0) { if (bad_e > 2) atomicAdd(&cnt[1], 1u); if (bad_g > 2) atomicAdd(&cnt[2], 1u); if (bad_a > 2) atomicAdd(&cnt[3], 1u); if (bad_x > 8) atomicAdd(&cnt[4], 1u); }
}
__global__ void dbg_report(Args args) {
    unsigned* cnt = (unsigned*)(args.ws + WS_DBG);
    float code = 0.f;
    for (int lv = 1; lv <= 9; ++lv) if (cnt[lv]) { int tenths = (int)(cnt[lv] * 10 / DBG_NS); if (tenths > 9) tenths = 9; code = 1000.f * lv + 100.f * tenths; break; }
    if (code != 0.f) for (int i = threadIdx.x; i < 4096; i += blockDim.x) args.out[i] = code;
}
#endif
template <int ABL>
__device__ __forceinline__ void p_attn_gqa(const Frame& F, int last) {
    char* lds = (char*)F.lds;
    const unsigned char* QG = wsp<unsigned char>(F, WS_QG); const unsigned char* KG = wsp<unsigned char>(F, WS_KG); const unsigned char* VG = wsp<unsigned char>(F, WS_VG); unsigned char* OAB = wsp<unsigned char>(F, WS_OAB);
    const int nlat = NB * 8 * 16, nall = last ? nlat : nlat + NB * 8;
    for (int u = F.bid; u < nall; u += F.G) {
        int bh, q0, seq; size_t orow;
        if (u < nlat) {
            int uu = u;
            if (F.G == 256) {
                const int c = u & 255, i = u >> 8, xcd = c & 7, r = c >> 3, kvg = i * 4 + (xcd >> 1), within = (xcd & 1) * 32 + r;
                uu = (((kvg >> 1) * 8 + (kvg & 1) * 4 + (within >> 4)) << 4) | (within & 15); }
            bh = uu >> 4; const int qb = uu & 15; q0 = CTXL + qb * 256; seq = TT; orow = (size_t)(bh >> 3) * SEQ + qb * 256; }
        else { bh = u - nlat; q0 = 0; seq = CTXL; orow = (size_t)NLAT + (bh >> 3) * CTXL; }
        const int b = bh >> 3, h = bh & 7; const size_t kvo = (size_t)(b * 2 + (h >> 2)) * TT * 128;
        __syncthreads();
        att::attn_body<4, 0, ABL>(QG + ((size_t)bh * TT + q0) * 128, KG + kvo, VG + (size_t)(b * 2 + (h >> 2)) * 128 * TT, OAB + orow * D + 1024 + h * 128, seq, lds, F.tid);
    }
    __syncthreads();
}
template <int ABL>
__device__ __forceinline__ void p_attn_mla(const Frame& F, int last) {
    char* lds = (char*)F.lds;
    const unsigned char* QM = wsp<unsigned char>(F, WS_QM); const unsigned char* KM = wsp<unsigned char>(F, WS_KM); const unsigned char* VM = wsp<unsigned char>(F, WS_VM); unsigned char* OAB = wsp<unsigned char>(F, WS_OAB);
    const int nlat = NB * 8 * 16, nall = last ? nlat : nlat + NB * 8;
    for (int u = F.bid; u < nall; u += F.G) {
        int bh, q0, seq; size_t orow;
        if (u < nlat) {
            int uu = u;
            if (F.G == 256) { const int c = u & 255, i = u >> 8, xcd = c & 7, r = c >> 3; uu = ((i * 16 + xcd * 2 + (r >> 4)) << 4) | (r & 15); }
            bh = uu >> 4; const int qb = uu & 15; q0 = CTXL + qb * 256; seq = TT; orow = (size_t)(bh >> 3) * SEQ + qb * 256; }
        else { bh = u - nlat; q0 = 0; seq = CTXL; orow = (size_t)NLAT + (bh >> 3) * CTXL; }
        const int h = bh & 7;
        __syncthreads();
        att::attn_body<2, 1, ABL>(QM + ((size_t)bh * TT + q0) * 128, KM + (size_t)bh * TT * 128, VM + (size_t)bh * 64 * TT, OAB + orow * D + h * 64, seq, lds, F.tid);
    }
    __syncthreads();
}
__device__ __forceinline__ void p_ret_out(const Frame& F, int l, int last) {
    const int c_lo = last ? 2 : 0, nc = 34 - c_lo, nu = NB * 8 * nc;
    for (int u = F.bid; u < nu; u += F.G) { const int bh = u / nc, c = c_lo + (u % nc); ret_out_unit(F, l, bh, c); }
    __syncthreads();
}

constexpr int LDS_BYTES = 147456;
constexpr int MISC_OFF = 147456 - 64;
constexpr int NPHASE = 22;
#ifndef PHM
#define PHM 0xFFFF
#endif
#ifndef PH_ATTR
#define PH_ATTR __forceinline__
#endif
__device__ PH_ATTR void ph_prologue(ArgP ap) { const Frame F = make_frame(ap); p0_prologue(F); }
__device__ PH_ATTR void ph_modreduce(ArgP ap) { const Frame F = make_frame(ap); p1_modreduce(F); }
__device__ PH_ATTR void ph_modulate0(ArgP ap) { const Frame F = make_frame(ap); p_modulate0(F); }
template <int GABL> __device__ PH_ATTR void ph_gemm_in(ArgP ap, int l) { const Frame F = make_frame(ap);
    pg8::Gemm g{wsp<bf16_t>(F, WS_HB8), wsp<bf16_t>(F, WS_WIN + l * SZ_WIN), NROW, NPT, 1024, 1024, 1024}; pg8::StaticOrder S; S.init(NROW, NPT, F.G, F.bid);
    float mul_, inv_; fp8_scale(wsp<unsigned>(F, WS_WSC)[l], mul_, inv_);
    EpiIn E{wsp<bf16_t>(F, WS_P1), wsp<bf16_t>(F, WS_G), inv_};
    pg8::gemm_phase<EpiIn, pg8::StaticOrder, GABL>(F.lds, F.tid, g, S, E); }
__device__ PH_ATTR void ph_post(ArgP ap, int l) { const Frame F = make_frame(ap); p_post(F, l); if (l == 1) cvt_peer(F, 1); }
__device__ PH_ATTR void ph_qup(ArgP ap, int l) { const Frame F = make_frame(ap);
    pg8::Gemm g{wsp<bf16_t>(F, WS_CQN), wsp<bf16_t>(F, WS_WQUP + l * SZ_WQUP), NROW, 768, 512, 512, 512}; pg8::StaticOrder S; S.init(NROW, 768, F.G, F.bid);
    EpiQup E{wsp<unsigned char>(F, WS_QM), wsp<f32x2>(F, WS_ROPE32)};
    pg8::gemm_phase<EpiQup, pg8::StaticOrder>(F.lds, F.tid, g, S, E); }
__device__ PH_ATTR void ph_kvup(ArgP ap, int l) { const Frame F = make_frame(ap);
    pg8::Gemm g{wsp<bf16_t>(F, WS_CKVN), wsp<bf16_t>(F, WS_WKVUP + l * SZ_WKVUP), NROW, 1024, 256, 256, 256}; pg8::StaticOrder S; S.init(NROW, 1024, F.G, F.bid);
    EpiKvup E{wsp<unsigned char>(F, WS_KM), wsp<unsigned char>(F, WS_VM)};
    pg8::gemm_phase<EpiKvup, pg8::StaticOrder>(F.lds, F.tid, g, S, E); }
__device__ PH_ATTR void ph_states(ArgP ap, int l) { const Frame F = make_frame(ap); p_ret_states(F, l); }
template <int ABL> __device__ PH_ATTR void ph_attn_gqa(ArgP ap, int last) { const Frame F = make_frame(ap); p_attn_gqa<ABL>(F, last); }
template <int ABL> __device__ PH_ATTR void ph_attn_mla(ArgP ap, int last) { const Frame F = make_frame(ap); p_attn_mla<ABL>(F, last); }
__device__ PH_ATTR void ph_ret_out(ArgP ap, int l, int last) { const Frame F = make_frame(ap); p_ret_out(F, l, last); }
template <int SEG> __device__ PH_ATTR void ph_merge(ArgP ap, int l, int Mx) { const Frame F = make_frame(ap);
    const bf16_t* OAB = wsp<bf16_t>(F, WS_OAB); bf16_t* MB = wsp<bf16_t>(F, WS_MB); const bf16_t* G = wsp<bf16_t>(F, WS_G);
    pg8::StaticOrder S; S.init(Mx, 2048, F.G, F.bid);
    const size_t wo = SEG == 0 ? WS_WBRA + l * SZ_WBRA : (SEG == 1 ? WS_WBRB + l * SZ_WBRB : WS_WBRC + l * SZ_WBRC); const int K = SEG == 2 ? 1024 : 512;
    pg8::Gemm g{OAB + SEG * 512, wsp<bf16_t>(F, wo), Mx, 2048, K, 2048, K}; EpiMerge<SEG> E{MB, G, wsp<unsigned char>(F, WS_MB8)}; pg8::gemm_phase<EpiMerge<SEG>, pg8::StaticOrder>(F.lds, F.tid, g, S, E); }
__device__ PH_ATTR void ph_merge3(ArgP ap, int l, int Mx) { const Frame F = make_frame(ap);
    pg8::StaticOrder S; S.init(Mx, 2048, F.G, F.bid);
    float m0_, i0_, m1_, i1_, m2_, i2_; fp8_scale(wsp<unsigned>(F, WS_WSC)[4 + l], m0_, i0_); fp8_scale(wsp<unsigned>(F, WS_WSC)[6 + l], m1_, i1_); fp8_scale(wsp<unsigned>(F, WS_WSC)[8 + l], m2_, i2_);
    pg8::Merge3 g{wsp<bf16_t>(F, WS_OAB), wsp<bf16_t>(F, WS_WBRA + l * SZ_WBRA), wsp<bf16_t>(F, WS_WBRB + l * SZ_WBRB), wsp<bf16_t>(F, WS_WBRC + l * SZ_WBRC), wsp<bf16_t>(F, WS_G), wsp<unsigned char>(F, WS_MB8), i0_ * m1_, i1_ * m2_, i2_};
    pg8::gemm_merge3<pg8::StaticOrder>(F.lds, F.tid, g, S); }
__device__ PH_ATTR void ph_out(ArgP ap, int l, int Mx) { const Frame F = make_frame(ap);
    pg8::Gemm g{wsp<bf16_t>(F, WS_MB8), wsp<bf16_t>(F, WS_WOUT + l * SZ_WOUT), Mx, 2048, 1024, 1024, 1024}; pg8::StaticOrder S; S.init(Mx, 2048, F.G, F.bid);
    float mul_, inv_; fp8_scale(wsp<unsigned>(F, WS_WSC)[2 + l], mul_, inv_);
    EpiOut E{l == 0 ? F.in(0) : F.out, l == 0 ? F.in(2) : wsp<float>(F, WS_XC), F.out, wsp<float>(F, WS_XC), wsp<float>(F, WS_MOD) + (size_t)l * 5 * 12288 + 4096, inv_ * (1.f / 16.f)};
    pg8::gemm_phase<EpiOut, pg8::StaticOrder>(F.lds, F.tid, g, S, E); }
__device__ PH_ATTR void ph_ln1(ArgP ap, int l, int last) { const Frame F = make_frame(ap); p_ln1(F, l, last); }
__device__ PH_ATTR void ph_peerq(ArgP ap, int l, int Mx) { const Frame F = make_frame(ap);
    pg8::Gemm g{wsp<bf16_t>(F, WS_HB), wsp<bf16_t>(F, WS_WPQ + l * SZ_WPQ), Mx, 1024, 2048, 2048, 2048}; pg8::StaticOrder S; S.init(Mx, 1024, F.G, F.bid);
    EpiPlain E{wsp<bf16_t>(F, WS_QP), 1024};
    pg8::gemm_phase<EpiPlain, pg8::StaticOrder>(F.lds, F.tid, g, S, E); }
__device__ PH_ATTR void ph_peer(ArgP ap, int l, int last) { const Frame F = make_frame(ap); p_peer(F, l, last); }

__global__ void __launch_bounds__(512, 2) mega_fwd(Args args) {
    extern __shared__ __attribute__((aligned(16))) unsigned char lds_raw[];
    const ArgP ap = (ArgP)__builtin_amdgcn_kernarg_segment_ptr();
    const int lo = ap->ph_lo, hi = ap->ph_hi;
    volatile LAS unsigned* misc = (volatile LAS unsigned*)((LAS unsigned char*)lds_raw + MISC_OFF);
    if (threadIdx.x < 4) misc[threadIdx.x] = 0u;
    __syncthreads();
    XcdBarrier bar; bar.bar = (unsigned*)(ap->ws + WS_CTL); bar.x = 0; bar.st = misc;
    if (hi - lo > 1) bar = xcd_barrier_post((unsigned*)(ap->ws + WS_CTL), misc);
#ifdef BENCH_K
    { float a[16]; f32x2 b2[8];
#pragma unroll
      for (int i = 0; i < 16; ++i) a[i] = 1.f + threadIdx.x * 1e-3f + i;
#pragma unroll
      for (int i = 0; i < 8; ++i) b2[i] = (f32x2){a[i], a[i + 8]};
      float c0 = a[3], c1 = a[5];
#define B16(INS) asm volatile(INS(0) INS(1) INS(2) INS(3) INS(4) INS(5) INS(6) INS(7) INS(8) INS(9) INS(10) INS(11) INS(12) INS(13) INS(14) INS(15) \
        : "+v"(a[0]), "+v"(a[1]), "+v"(a[2]), "+v"(a[3]), "+v"(a[4]), "+v"(a[5]), "+v"(a[6]), "+v"(a[7]), "+v"(a[8]), "+v"(a[9]), "+v"(a[10]), "+v"(a[11]), "+v"(a[12]), "+v"(a[13]), "+v"(a[14]), "+v"(a[15]) : "v"(c0), "v"(c1))
#define I_ADD(i) "v_add_f32 %" #i ", %" #i ", %16\n"
#define I_EXP(i) "v_exp_f32 %" #i ", %" #i "\n"
#define I_MAX3(i) "v_max3_f32 %" #i ", %" #i ", %16, %17\n"
#define I_CVT(i) "v_cvt_pk_fp8_f32 %" #i ", %16, %17\n"
#define I_DEP(i) "v_max3_f32 %0, %0, %16, %17\n"
#define I_DEPA(i) "v_add_f32 %0, %0, %16\n"
#define I_FMA(i) "v_fma_f32 %" #i ", %" #i ", %16, %17\n"
#define P8(INS) asm volatile(INS(0) INS(1) INS(2) INS(3) INS(4) INS(5) INS(6) INS(7) INS(0) INS(1) INS(2) INS(3) INS(4) INS(5) INS(6) INS(7) \
        : "+v"(b2[0]), "+v"(b2[1]), "+v"(b2[2]), "+v"(b2[3]), "+v"(b2[4]), "+v"(b2[5]), "+v"(b2[6]), "+v"(b2[7]) : "v"(b2[0]))
#define I_PKADD(i) "v_pk_add_f32 %" #i ", %" #i ", %8\n"
#define I_PKFMA(i) "v_pk_fma_f32 %" #i ", %" #i ", %8, %8\n"
#pragma unroll 1
      for (int it = 0; it < 20000; ++it) {
#if BENCH_K == 1
        B16(I_ADD);
#elif BENCH_K == 2
        B16(I_EXP);
#elif BENCH_K == 3
        B16(I_MAX3);
#elif BENCH_K == 4
        B16(I_CVT);
#elif BENCH_K == 5
        P8(I_PKADD);
#elif BENCH_K == 6
        P8(I_PKFMA);
#elif BENCH_K == 7
        B16(I_FMA);
#elif BENCH_K == 9
        B16(I_DEP);
#elif BENCH_K == 10
        B16(I_DEPA);
#endif
      }
#if BENCH_K == 11 || BENCH_K == 12
      { f32x16 q0 = {}, q1 = {}, q2 = {}, q3 = {}; att::i32x8a x8 = {1, 2, 3, 4, 5, 6, 7, (int)threadIdx.x};
#pragma unroll 1
        for (int it = 0; it < 2000; ++it) {
#pragma unroll
          for (int k = 0; k < 4; ++k) {
            q0 = __builtin_amdgcn_mfma_scale_f32_32x32x64_f8f6f4(x8, x8, q0, 0, 0, 0, 0x7F7F7F7F, 0, 0x7F7F7F7F); asm volatile("" : "+v"(q0));
#if BENCH_K == 11
            B16(I_ADD);
#else
            B16(I_EXP);
#endif
            q1 = __builtin_amdgcn_mfma_scale_f32_32x32x64_f8f6f4(x8, x8, q1, 0, 0, 0, 0x7F7F7F7F, 0, 0x7F7F7F7F); asm volatile("" : "+v"(q1));
#if BENCH_K == 11
            B16(I_ADD);
#else
            B16(I_EXP);
#endif
            q2 = __builtin_amdgcn_mfma_scale_f32_32x32x64_f8f6f4(x8, x8, q2, 0, 0, 0, 0x7F7F7F7F, 0, 0x7F7F7F7F); asm volatile("" : "+v"(q2));
#if BENCH_K == 11
            B16(I_ADD);
#else
            B16(I_EXP);
#endif
            q3 = __builtin_amdgcn_mfma_scale_f32_32x32x64_f8f6f4(x8, x8, q3, 0, 0, 0, 0x7F7F7F7F, 0, 0x7F7F7F7F); asm volatile("" : "+v"(q3));
#if BENCH_K == 11
            B16(I_ADD);
#else
            B16(I_EXP);
#endif
          }
          asm volatile("" : "+v"(x8)); } }
#endif
#if BENCH_K == 8
      { f32x16 q0 = {}, q1 = {}, q2 = {}, q3 = {}; att::i32x8a x8 = {1, 2, 3, 4, 5, 6, 7, (int)threadIdx.x};
#pragma unroll 1
        for (int it = 0; it < 2000; ++it) {
#pragma unroll
          for (int k = 0; k < 4; ++k) { q0 = __builtin_amdgcn_mfma_scale_f32_32x32x64_f8f6f4(x8, x8, q0, 0, 0, 0, 0x7F7F7F7F, 0, 0x7F7F7F7F); q1 = __builtin_amdgcn_mfma_scale_f32_32x32x64_f8f6f4(x8, x8, q1, 0, 0, 0, 0x7F7F7F7F, 0, 0x7F7F7F7F);
            q2 = __builtin_amdgcn_mfma_scale_f32_32x32x64_f8f6f4(x8, x8, q2, 0, 0, 0, 0x7F7F7F7F, 0, 0x7F7F7F7F); q3 = __builtin_amdgcn_mfma_scale_f32_32x32x64_f8f6f4(x8, x8, q3, 0, 0, 0, 0x7F7F7F7F, 0, 0x7F7F7F7F); }
          asm volatile("" : "+v"(q0), "+v"(q1), "+v"(q2), "+v"(q3), "+v"(x8)); } }
#endif
    }
#endif
#define IN(k) (lo <= (k) && (k) < hi)
#define SEAM(k) do { if (IN(k) && IN((k) + 1)) xcd_barrier(bar); } while (0)
    if (IN(0)) { if (PHM & 1) ph_prologue(ap); if (REP_PRO) ph_prologue(ap); } SEAM(0);
    if (IN(1)) { if (PHM & 2) ph_modreduce(ap); if (REP_X & 32) ph_modreduce(ap); } SEAM(1);
#pragma unroll 1
    for (int l = 0; l < 2; ++l) {
        const int pb = 2 + 10 * l; const int last = (l == 1);
        const int Mx = last ? NLAT : NROW;
        if (l == 0) { if (IN(pb)) { if (PHM & 4) ph_modulate0(ap); if (REP_X & 64) ph_modulate0(ap); } SEAM(pb); }
        if (IN(pb + 1)) { if (REP_GIN) ph_gemm_in<GIN_ABL>(ap, l); if (PHM & 8) ph_gemm_in<0>(ap, l); } SEAM(pb + 1);
        if (IN(pb + 2)) { if (PHM & 16) ph_post(ap, l); if (REP_X & 1) ph_post(ap, l); } SEAM(pb + 2);
        if (IN(pb + 3)) { if (PHM & 32) ph_qup(ap, l); if (PHM & 64) ph_kvup(ap, l); if (PHM & 128) ph_states(ap, l); if (REP_X & 2) { ph_qup(ap, l); ph_kvup(ap, l); ph_states(ap, l); } } SEAM(pb + 3);
        if (IN(pb + 4)) { if (REP_ATTN & 1) ph_attn_gqa<ATT_ABL>(ap, last); if (REP_ATTN & 2) ph_attn_mla<ATT_ABL>(ap, last); if (PHM & 256) ph_attn_gqa<0>(ap, last); if (PHM & 512) ph_attn_mla<0>(ap, last); if (REP_X & 4) ph_ret_out(ap, l, last); if (PHM & 1024) ph_ret_out(ap, l, last); } SEAM(pb + 4);
        if (IN(pb + 5)) { if (PHM & 2048) { if (MERGE3) ph_merge3(ap, l, Mx); else { ph_merge<0>(ap, l, Mx); ph_merge<1>(ap, l, Mx); ph_merge<2>(ap, l, Mx); } } if (REP_X & 8) { if (MERGE3) ph_merge3(ap, l, Mx); else { ph_merge<0>(ap, l, Mx); ph_merge<1>(ap, l, Mx); ph_merge<2>(ap, l, Mx); } } } SEAM(pb + 5);
        if (IN(pb + 6)) { if (PHM & 4096) ph_out(ap, l, Mx); } SEAM(pb + 6);
        if (IN(pb + 7)) { if (PHM & 8192) ph_ln1(ap, l, last); } SEAM(pb + 7);
        if (IN(pb + 8)) { if (PHM & 16384) ph_peerq(ap, l, Mx); if (REP_X & 16) ph_peerq(ap, l, Mx); } SEAM(pb + 8);
        if (IN(pb + 9)) { if (PHM & 32768) ph_peer(ap, l, last); } SEAM(pb + 9);
    }
#undef IN
#undef SEAM
}

extern "C" void kernel_launch(void* const* d_in, const int* in_sizes, int n_in, void* d_out, int out_size, void* d_ws, size_t ws_size, hipStream_t stream) {
    static int grid = 0;
    if (grid == 0) {
        if (n_in != 27 || out_size != NLAT * D || ws_size < WS_END) { fprintf(stderr, "kernel_launch: unexpected shapes: n_in %d out %d ws %zu (need %zu)\n", n_in, out_size, ws_size, (size_t)WS_END); grid = -1; return; }
        int dev = 0, cus = 0, per_cu = 0;
        if (hipGetDevice(&dev) != hipSuccess || hipDeviceGetAttribute(&cus, hipDeviceAttributeMultiprocessorCount, dev) != hipSuccess) { grid = -1; return; }
        if (hipFuncSetAttribute((const void*)mega_fwd, hipFuncAttributeMaxDynamicSharedMemorySize, LDS_BYTES) != hipSuccess) { fprintf(stderr, "kernel_launch: hipFuncSetAttribute failed\n"); grid = -1; return; }
        if (hipOccupancyMaxActiveBlocksPerMultiprocessor(&per_cu, (const void*)mega_fwd, 512, LDS_BYTES) != hipSuccess || per_cu < 1) fprintf(stderr, "kernel_launch: occupancy query reports %d\n", per_cu);
        (void)hipGetLastError();
        grid = cus;
    }
    if (grid < 0) return;
    (void)hipMemsetAsync((char*)d_ws + WS_CTL, 0, 65536, stream);
#ifdef DBG
    (void)hipMemsetAsync((char*)d_ws + WS_CTL + 131072, 0, 4096, stream);
#endif
    Args a{};
    for (int i = 0; i < 27; ++i) a.in[i] = (const float*)d_in[i];
    a.out = (float*)d_out; a.ws = (unsigned char*)d_ws;
#if MK_PER_PHASE
    for (int p = 0; p < NPHASE; ++p) { if (p == 12) continue; a.ph_lo = p; a.ph_hi = p + 1;
#ifdef DBG
        if (p == 11) hipLaunchKernelGGL(dbg_peer_pre, dim3(DBG_NS), dim3(256), 0, stream, a, 0);
#endif
        hipLaunchKernelGGL(mega_fwd, dim3(grid), dim3(512), LDS_BYTES, stream, a);
#ifdef DBG
        if (p == 11) hipLaunchKernelGGL(dbg_peer_post, dim3(DBG_NS), dim3(256), 0, stream, a);
#endif
    }
#ifdef DBG
    hipLaunchKernelGGL(dbg_report, dim3(1), dim3(256), 0, stream, a);
#endif
#else
    a.ph_lo = 0; a.ph_hi = NPHASE;
    hipLaunchKernelGGL(mega_fwd, dim3(grid), dim3(512), LDS_BYTES, stream, a);
#endif
    const hipError_t le = hipPeekAtLastError();
    if (le != hipSuccess) fprintf(stderr, "kernel_launch: launch failed: %s\n", hipGetErrorName(le));
}
```

```cpp
#include <hip/hip_runtime.h>
#include <cstdio>
#include <cstdint>
#include <cstddef>

#ifndef MK_PER_PHASE
#define MK_PER_PHASE 0
#endif

#ifndef ABL_PEER
#define ABL_PEER 0
#endif
#ifndef REP_PEERG
#define REP_PEERG 0
#endif
#ifndef REP_PEERH
#define REP_PEERH 0
#endif
#ifndef REP_X
#define REP_X 0
#endif
#ifndef REP_PS1
#define REP_PS1 0
#endif
#ifndef REP_PS2
#define REP_PS2 0
#endif
#ifndef SIDE_ON
#define SIDE_ON 1
#endif
#ifndef REP_DOT
#define REP_DOT 0
#endif
#ifndef MERGE3
#define MERGE3 1
#endif
#ifndef REP_GIN
#define REP_GIN 0
#endif
#ifndef GIN_ABL
#define GIN_ABL 0
#endif
#ifndef ATT_ABL
#define ATT_ABL 0
#endif
#ifndef REP_ATTN
#define REP_ATTN 0
#endif
#ifndef REP_PRO
#define REP_PRO 0
#endif
#ifndef ABL_BR
#define ABL_BR 0
#endif
#ifndef ABL_MIX
#define ABL_MIX 0
#endif
#define LAS __attribute__((address_space(3)))
typedef unsigned short bf16_t;
typedef short bf16x8 __attribute__((ext_vector_type(8)));
typedef short s16x4 __attribute__((ext_vector_type(4)));
typedef float f32x2 __attribute__((ext_vector_type(2)));
typedef float f32x4 __attribute__((ext_vector_type(4)));
typedef float f32x8 __attribute__((ext_vector_type(8)));
typedef float f32x16 __attribute__((ext_vector_type(16)));
typedef unsigned u32x2 __attribute__((ext_vector_type(2)));
typedef unsigned u32x4 __attribute__((ext_vector_type(4)));
typedef __bf16 bf2_t __attribute__((ext_vector_type(2)));

constexpr int D = 2048, NB = 4, SEQ = 4096, CTXL = 256, TT = SEQ + CTXL;
constexpr int NLAT = NB * SEQ, NCTX = NB * CTXL, NROW = NLAT + NCTX;
constexpr int NP1 = 4096, NG = 6144, NPT = NP1 + NG;
constexpr int NIN = 10016;
constexpr float ALPHA = 1.4142135623730951f;
constexpr float LN_EPS = 1e-5f, RMS_EPS = 1e-6f;
constexpr float LOG2E = 1.4426950408889634f;
constexpr int C_CQ = 0, C_CKV = 512, C_GQ = 768, C_GK = 1792, C_GV = 2048, C_RQ = 2304, C_RK = 2560, C_RV = 2816, C_RG = 3328, C_KR = 3840;

constexpr size_t AL(size_t x) { return (x + 255) / 256 * 256; }
constexpr size_t WS_CTL = 0;                                    constexpr size_t CTL_BYTES = 1u << 20;
constexpr size_t WS_WSC = WS_CTL + 32768;
constexpr size_t WS_CVT = WS_CTL + 33024;
constexpr size_t WS_DEC = WS_CTL + 65536;
constexpr size_t WS_ROPE32 = WS_CTL + CTL_BYTES;
constexpr size_t WS_ROPE128 = WS_ROPE32 + AL(64 * 8 * 8);
constexpr size_t WS_MODP = WS_ROPE128 + AL(64 * 32 * 8);
constexpr size_t WS_MOD = WS_MODP + AL((size_t)16 * 2 * 5 * 12288 * 4);
constexpr size_t WS_WIN = WS_MOD + AL((size_t)2 * 5 * 12288 * 4);
constexpr size_t SZ_WIN = (size_t)NPT * D;
constexpr size_t WS_WQUP = WS_WIN + 2 * SZ_WIN;                 constexpr size_t SZ_WQUP = (size_t)768 * 512 * 2;
constexpr size_t WS_WKVUP = WS_WQUP + 2 * SZ_WQUP;              constexpr size_t SZ_WKVUP = (size_t)1024 * 256 * 2;
constexpr size_t WS_WBRA = WS_WKVUP + 2 * SZ_WKVUP;             constexpr size_t SZ_WBRA = (size_t)2048 * 512 * 2;
constexpr size_t WS_WBRB = WS_WBRA + 2 * SZ_WBRA;               constexpr size_t SZ_WBRB = SZ_WBRA;
constexpr size_t WS_WBRC = WS_WBRB + 2 * SZ_WBRB;               constexpr size_t SZ_WBRC = (size_t)2048 * 1024 * 2;
constexpr size_t WS_WOUT = WS_WBRC + 2 * SZ_WBRC;               constexpr size_t SZ_WOUT = (size_t)2048 * 2048 * 2;
constexpr size_t WS_WPQ = WS_WOUT + 2 * SZ_WOUT;                constexpr size_t SZ_WPQ = (size_t)1024 * 2048 * 2;
constexpr size_t WS_PSC = WS_WPQ + 2 * SZ_WPQ;
constexpr size_t WS_PU = WS_PSC + (size_t)4 * 16384 * 4;        constexpr size_t SZ_PT = (size_t)16384 * 1152;
constexpr size_t WS_PV = WS_PU + 2 * SZ_PT;
constexpr size_t WS_XC = WS_PV + 2 * SZ_PT;
constexpr size_t WS_HB = WS_XC + (size_t)NCTX * D * 4;
constexpr size_t WS_P1 = WS_HB + (size_t)NROW * D * 2;
constexpr size_t WS_G = WS_P1 + (size_t)NROW * NP1 * 2;
constexpr size_t WS_CQN = WS_G + (size_t)NROW * NG * 2;
constexpr size_t WS_CKVN = WS_CQN + (size_t)NROW * 512 * 2;
constexpr size_t WS_QM = WS_CKVN + (size_t)NROW * 256 * 2;
constexpr size_t SZ_Q128 = (size_t)NB * 8 * TT * 128 * 2;
constexpr size_t WS_KM = WS_QM + SZ_Q128;
constexpr size_t WS_VM = WS_KM + SZ_Q128;
constexpr size_t WS_QG = WS_VM + SZ_Q128 / 2;
constexpr size_t WS_KG = WS_QG + SZ_Q128;
constexpr size_t WS_VG = WS_KG + SZ_Q128 / 4;
constexpr size_t WS_RQ = WS_VG + SZ_Q128 / 4;
constexpr size_t WS_RK = WS_RQ + SZ_Q128 / 4;
constexpr size_t WS_RV = WS_RK + SZ_Q128 / 4;
constexpr size_t WS_ST = WS_RV + SZ_Q128 / 2;
constexpr size_t WS_OAB = WS_ST + (size_t)NB * 8 * 34 * 2 * 2048 * 4;
constexpr size_t WS_HB8 = WS_OAB + (size_t)NROW * D * 2;
constexpr size_t WS_MB8 = WS_HB8 + (size_t)NROW * D;
constexpr size_t WS_END = WS_MB8 + (size_t)NROW * D;
constexpr size_t WS_MB = WS_QM;
constexpr size_t WS_QP = WS_QG;
static_assert((size_t)NROW * D * 2 <= 2 * SZ_Q128, "MB alias");
static_assert((size_t)NROW * 1024 * 2 <= SZ_Q128, "QP alias");

__device__ __forceinline__ unsigned cvt_pk_bf16(float lo, float hi) { unsigned r; asm volatile("v_cvt_pk_bf16_f32 %0, %1, %2" : "=v"(r) : "v"(lo), "v"(hi)); return r; }
__device__ __forceinline__ bf16_t f2bf(float f) { return (bf16_t)(cvt_pk_bf16(f, 0.f) & 0xffffu); }
__device__ __forceinline__ float bf2f(bf16_t b) { return __uint_as_float(((unsigned)b) << 16); }
__device__ __forceinline__ float bflo(unsigned w) { return __uint_as_float(w << 16); }
__device__ __forceinline__ float bfhi(unsigned w) { return __uint_as_float(w & 0xffff0000u); }
template <int CTRL> __device__ __forceinline__ float dppf(float x) { return __int_as_float(__builtin_amdgcn_update_dpp(0, __float_as_int(x), CTRL, 0xF, 0xF, true)); }
__device__ __forceinline__ float row16_sum(float x) { x += dppf<0xB1>(x); x += dppf<0x4E>(x); x += dppf<0x141>(x); x += dppf<0x140>(x); return x; }
__device__ __forceinline__ float row16_max(float x) { x = fmaxf(x, dppf<0xB1>(x)); x = fmaxf(x, dppf<0x4E>(x)); x = fmaxf(x, dppf<0x141>(x)); x = fmaxf(x, dppf<0x140>(x)); return x; }
__device__ __forceinline__ float wave_sum(float x) {
    x = row16_sum(x);
    { auto r = __builtin_amdgcn_permlane16_swap(__float_as_uint(x), __float_as_uint(x), false, false); x = __uint_as_float(r[0]) + __uint_as_float(r[1]); }
    { auto r = __builtin_amdgcn_permlane32_swap(__float_as_uint(x), __float_as_uint(x), false, false); x = __uint_as_float(r[0]) + __uint_as_float(r[1]); }
    return x;
}
__device__ __forceinline__ unsigned pk4_fp8(float a, float b, float c, float d) { int t = 0; t = __builtin_amdgcn_cvt_pk_fp8_f32(a, b, t, false); t = __builtin_amdgcn_cvt_pk_fp8_f32(c, d, t, true); return (unsigned)t; }
__device__ __forceinline__ float clamp8(float x) { return fminf(fmaxf(x, -440.f), 440.f); }
__device__ __forceinline__ void fp8_scale(unsigned amax_bits, float& mul, float& inv) { const float am = __uint_as_float(amax_bits); int k = 0; if (am > 0.f) k = (int)floorf(log2f(256.f / am)); k = k > 60 ? 60 : (k < -60 ? -60 : k); mul = exp2f((float)k); inv = exp2f((float)-k); }
__device__ __forceinline__ float silu_f(float x) { return x * __builtin_amdgcn_rcpf(1.f + __builtin_amdgcn_exp2f(x * -1.4426950408889634f)); }
__device__ __forceinline__ float sigmoid_f(float x) { return __builtin_amdgcn_rcpf(1.f + __builtin_amdgcn_exp2f(x * -1.4426950408889634f)); }

__device__ __forceinline__ int vt_off(int tpos) { const int kk = tpos & 63; return (tpos & ~63) + ((kk >> 2) & 1) * 32 + ((kk >> 5) & 1) * 16 + (kk & 3) + 4 * ((kk >> 3) & 3); }
struct RowInfo { int b, tpos, pr, pc, v; bool lat; };
__device__ __forceinline__ RowInfo rowinfo(int row) {
    RowInfo r;
    if (row < NLAT) { r.lat = true; r.b = row >> 12; const int t = row & 4095; r.tpos = CTXL + t; r.pr = t >> 6; r.pc = t & 63; r.v = r.b; }
    else { const int q = row - NLAT; r.lat = false; r.b = q >> 8; r.tpos = q & 255; r.pr = 0; r.pc = 0; r.v = 4; }
    return r;
}

#define XB_TMO      128
#define XB_XCNT(j)  (256  + 64 * (j))
#define XB_XSUB(j)  (1280 + 64 * (j))
#define XB_XGEN(j)  (2304 + 64 * (j))
#define XB_TOP      3328
#define XB_TOPGEN   3392
#define XCD_BAR_WORDS 3456
#define XB_SPIN_CAP (1u << 22)

__device__ __forceinline__ unsigned xb_ld(unsigned* p)              { return __hip_atomic_load(p, __ATOMIC_RELAXED, __HIP_MEMORY_SCOPE_AGENT); }
__device__ __forceinline__ unsigned xb_add(unsigned* p, unsigned v) { return __hip_atomic_fetch_add(p, v, __ATOMIC_RELAXED, __HIP_MEMORY_SCOPE_AGENT); }
__device__ __forceinline__ unsigned xb_xcc_id() { return (unsigned)__builtin_amdgcn_s_getreg((3 << 11) | 20) & 0xFu; }
#define XB_SPIN(cond, bar) do { unsigned _sp = 0; while (cond) { __builtin_amdgcn_s_sleep(1); \
    if ((++_sp & 255u) == 0u) { if (xb_ld(&(bar)[XB_TMO])) break; if (_sp > XB_SPIN_CAP) { atomicAdd(&(bar)[XB_TMO], 1u); break; } } } } while (0)

struct XcdBarrier { unsigned* bar; unsigned x; volatile LAS unsigned* st; };

__device__ __forceinline__ XcdBarrier xcd_barrier_post(unsigned* bar, volatile LAS unsigned* st) {
    XcdBarrier b; b.bar = bar; b.x = xb_xcc_id(); b.st = st;
    if (threadIdx.x == 0) (void)xb_add(&bar[XB_XCNT(b.x)], 1u);
    return b;
}
__device__ __forceinline__ void xcd_barrier_complete(unsigned* bar, unsigned x, unsigned& nloc, unsigned& nx) {
    const unsigned G = gridDim.x * gridDim.y * gridDim.z;
    unsigned sum, cnt, mine, sp = 0u;
    for (;;) {
        sum = 0u; cnt = 0u; mine = 0u;
#pragma unroll
        for (unsigned j = 0; j < 16; ++j) { const unsigned c = xb_ld(&bar[XB_XCNT(j)]); sum += c; cnt += (c > 0u) ? 1u : 0u; mine = (j == x) ? c : mine; }
        if (sum == G) break;
        __builtin_amdgcn_s_sleep(1);
        if ((++sp & 255u) == 0u) { if (xb_ld(&bar[XB_TMO])) break; if (sp > XB_SPIN_CAP) { atomicAdd(&bar[XB_TMO], 1u); break; } }
    }
    nloc = mine > 0u ? mine : 1u; nx = cnt > 0u ? cnt : 1u;
}
__device__ __forceinline__ void xcd_barrier(const XcdBarrier& b) {
    asm volatile("s_waitcnt vmcnt(0)" ::: "memory");
    __syncthreads();
    if (threadIdx.x == 0) {
        unsigned* bar = b.bar;
        __builtin_amdgcn_s_waitcnt(0);
        unsigned nloc = b.st[0], nx = b.st[1];
        if (nloc == 0u) { xcd_barrier_complete(bar, b.x, nloc, nx); b.st[0] = nloc; b.st[1] = nx; }
        const unsigned old = xb_add(&bar[XB_XSUB(b.x)], 1u);
        const unsigned gen = old / nloc;
        if (old + 1u == (gen + 1u) * nloc) {
            __builtin_amdgcn_fence(__ATOMIC_RELEASE, "agent");
            asm volatile("s_waitcnt vmcnt(0)" ::: "memory");
            const unsigned og = xb_add(&bar[XB_TOP], 1u);
            const unsigned tg = og / nx;
            if (og + 1u == (tg + 1u) * nx) xb_add(&bar[XB_TOPGEN], 1u);
            else XB_SPIN(xb_ld(&bar[XB_TOPGEN]) == tg, bar);
            __builtin_amdgcn_fence(__ATOMIC_ACQUIRE, "agent");
            xb_add(&bar[XB_XGEN(b.x)], 1u);
            asm volatile("s_waitcnt vmcnt(0)" ::: "memory");
        } else {
            XB_SPIN(xb_ld(&bar[XB_XGEN(b.x)]) == gen, bar);
            __builtin_amdgcn_fence(__ATOMIC_ACQUIRE, "agent");
            asm volatile("s_waitcnt vmcnt(0)" ::: "memory");
        }
    }
    __syncthreads();
}
namespace pg8 {
constexpr int BM = 256, BK = 64, HALF = 128, HTB = HALF * BK * 2, STAGE_BYTES = 8 * HTB, NXCD = 8, WGM = 8;
__host__ __device__ __forceinline__ int lds_byte(int r, int c) { const int st = (r >> 4) * 2 + (c >> 5), rr = r & 15, cc = c & 31, ob = rr * 64 + cc * 2; return st * 1024 + (ob ^ (((ob >> 9) & 1) << 5)); }
__host__ __device__ __forceinline__ void stage_rc(int b, int& R, int& C) { const int st = b / 1024, sb = b % 1024, swz = sb ^ (((sb >> 9) & 1) << 5); R = (st >> 1) * 16 + swz / 64; C = (st & 1) * 32 + (swz % 64) / 2; }
__host__ __device__ __forceinline__ int perm32(int rho) { const int n = rho >> 4, i = rho & 15; return 8 * (i >> 2) + 4 * n + (i & 3); }

struct Unit { int pm, pn; };
typedef int i32x8 __attribute__((ext_vector_type(8))); typedef int i32x4v __attribute__((ext_vector_type(4)));
__device__ __forceinline__ i32x8 cat8(const bf16x8 a, const bf16x8 b) { const i32x4v x = __builtin_bit_cast(i32x4v, a), y = __builtin_bit_cast(i32x4v, b); return __builtin_shufflevector(x, y, 0, 1, 2, 3, 4, 5, 6, 7); }
struct Gemm { const bf16_t* A; const bf16_t* Bt; int M, N, K, lda, ldb; };

struct StaticOrder {
    int nM, nN, nwg, G, c;
    __host__ __device__ void init(int M, int N, int G_, int c_) { nM = M / BM; nN = N / BM; nwg = nM * nN; G = G_; c = c_; }
    __host__ __device__ bool next(int i, Unit& u) const {
        const long L = (long)i * G + c; if (L >= nwg) return false;
        int wgid = (int)L; { const int q = nwg / NXCD, r = nwg % NXCD, xcd = wgid % NXCD, off = wgid / NXCD; wgid = (xcd < r ? xcd * (q + 1) : r * (q + 1) + (xcd - r) * q) + off; }
        const int nig = WGM * nN, gid = wgid / nig, fm = gid * WGM, gsz = (nM - fm) < WGM ? (nM - fm) : WGM;
        u.pm = fm + ((wgid % nig) % gsz); u.pn = (wgid % nig) / gsz; return true;
    }
    __device__ __forceinline__ void a_ready(const Unit&) const {}
    __device__ __forceinline__ void done(const Unit&) const {}
};

template <class Epi, class Sched, int GABL = 0>
__device__ __forceinline__ void gemm_phase(LAS unsigned char* lds, const int tid, const Gemm g, const Sched& S, const Epi& E) {
    const int  wid = __builtin_amdgcn_readfirstlane(tid >> 6), lane = tid & 63, wr = wid >> 2, wc = wid & 3, fr = lane & 15, fq = lane >> 4;
    const int K = g.K, nt = K / BK;
    unsigned voffA[2], voffB[2];
#pragma unroll
    for (int i = 0; i < 2; ++i) { int R, C; stage_rc(tid * 16 + i * 8192, R, C); const int Rb = Epi::PERM ? ((R & ~31) + perm32(R & 31)) : R;
        voffA[i] = (unsigned)(R * g.lda + C) * 2u; voffB[i] = (unsigned)(Rb * g.ldb + C) * 2u; }
    const size_t kstep = (size_t)(BK * 2);
    const size_t hstepA = (size_t)HALF * g.lda * 2, hstepB = (size_t)HALF * g.ldb * 2;
    const size_t tstepA = 2 * hstepA, tstepB = 2 * hstepB;
    const unsigned ldsw = (unsigned)wid * 1024u;
    const int aoff = lds_byte(wr * 64 + fr, fq * 8), boff = lds_byte(wc * 32 + fr, fq * 8);
#define PG8_SA(b, h) (((b) * 2 + (h)) * HTB)
#define PG8_SB(b, h) ((4 + (b) * 2 + (h)) * HTB)
#define PG8_STAGE(bufoff, gbase, voff) do { if constexpr (!(GABL & 4)) _Pragma("unroll") for (int _i = 0; _i < 2; ++_i) \
        __builtin_amdgcn_global_load_lds((const unsigned*)((const char*)(gbase) + (voff)[_i]), (LAS unsigned*)(lds + (bufoff) + ldsw + _i * 8192), 16, 0, 0); } while (0)
#define PG8_LDA(dst, b, h) do { if constexpr (Epi::FP8) { _Pragma("unroll") for (int m = 0; m < 4; ++m) { const i32x4v lo_ = *(const LAS i32x4v*)(lds + PG8_SA(b, h) + aoff + m * 2048), hi_ = *(const LAS i32x4v*)(lds + PG8_SA(b, h) + aoff + m * 2048 + 1024); \
            dst##8[m] = __builtin_shufflevector(lo_, hi_, 0, 1, 2, 3, 4, 5, 6, 7); } } \
        else { _Pragma("unroll") for (int m = 0; m < 4; ++m) _Pragma("unroll") for (int k = 0; k < 2; ++k) dst[m][k] = *(const LAS bf16x8*)(lds + PG8_SA(b, h) + aoff + m * 2048 + k * 1024); } } while (0)
#define PG8_LDB(dst, b, h) do { if constexpr (Epi::FP8) { _Pragma("unroll") for (int n = 0; n < 2; ++n) { const i32x4v lo_ = *(const LAS i32x4v*)(lds + PG8_SB(b, h) + boff + n * 2048), hi_ = *(const LAS i32x4v*)(lds + PG8_SB(b, h) + boff + n * 2048 + 1024); \
            dst##8[n] = __builtin_shufflevector(lo_, hi_, 0, 1, 2, 3, 4, 5, 6, 7); } } \
        else { _Pragma("unroll") for (int n = 0; n < 2; ++n) _Pragma("unroll") for (int k = 0; k < 2; ++k) dst[n][k] = *(const LAS bf16x8*)(lds + PG8_SB(b, h) + boff + n * 2048 + k * 1024); } } while (0)
#define PG8_MMA(ai, bj, At, Bt) do { __builtin_amdgcn_s_setprio(1); _Pragma("unroll") for (int m = 0; m < 4; ++m) _Pragma("unroll") for (int n = 0; n < 2; ++n) { \
        if constexpr (Epi::FP8) { if constexpr (GABL & 8) asm volatile("" : "+v"(acc[ai][bj][m][n]) : "v"(Bt##8[n]), "v"(At##8[m]), "v"(sc1_)); else asm volatile("v_mfma_scale_f32_16x16x128_f8f6f4 %0, %1, %2, %0, %3, %3 op_sel_hi:[0,0,0]" : "+v"(acc[ai][bj][m][n]) : "v"(Bt##8[n]), "v"(At##8[m]), "v"(sc1_)); } \
        else { _Pragma("unroll") for (int k = 0; k < 2; ++k) acc[ai][bj][m][n] = __builtin_amdgcn_mfma_f32_16x16x32_bf16(Bt[n][k], At[m][k], acc[ai][bj][m][n], 0, 0, 0); } } __builtin_amdgcn_s_setprio(0); } while (0)
#define PG8_WAIT_V(n) asm volatile("s_waitcnt vmcnt(" #n ")" ::: "memory")
#define PG8_WAIT_L(n) asm volatile("s_waitcnt lgkmcnt(" #n ")" ::: "memory")
#define PG8_BAR __builtin_amdgcn_s_barrier()
#define PG8_SCHED __builtin_amdgcn_sched_barrier(0)
    Unit cur, nxt; int ui = 0;
    if (!S.next(0, cur)) return;
    f32x4 acc[2][2][4][2];
#pragma unroll
    for (int a = 0; a < 2; ++a)
#pragma unroll
        for (int b = 0; b < 2; ++b)
#pragma unroll
            for (int m = 0; m < 4; ++m)
#pragma unroll
                for (int n = 0; n < 2; ++n) acc[a][b][m][n] = (f32x4){0.f, 0.f, 0.f, 0.f};
    int sc1_ = 0x7F7F7F7F; asm volatile("" : "+v"(sc1_));
    bf16x8 At[4][2], B0[2][2], B1[2][2]; i32x8 At8[4], B08[2], B18[2];
    const char* cA = (const char*)g.A + (size_t)cur.pm * tstepA; const char* cB = (const char*)g.Bt + (size_t)cur.pn * tstepB;
    S.a_ready(cur);
    PG8_STAGE(PG8_SB(0, 0), cB, voffB); PG8_STAGE(PG8_SA(0, 0), cA, voffA); PG8_STAGE(PG8_SB(0, 1), cB + hstepB, voffB); PG8_STAGE(PG8_SA(0, 1), cA + hstepA, voffA);
    if (wr == 1) PG8_BAR;
    PG8_WAIT_V(4); PG8_BAR;
    PG8_STAGE(PG8_SB(1, 0), cB + kstep, voffB); PG8_STAGE(PG8_SA(1, 0), cA + kstep, voffA); PG8_STAGE(PG8_SB(1, 1), cB + hstepB + kstep, voffB);
    PG8_WAIT_V(6); PG8_BAR;
    for (;;) {
        const bool has_next = S.next(ui + 1, nxt);
        const char* nA = has_next ? (const char*)g.A + (size_t)nxt.pm * tstepA : cA; const char* nB = has_next ? (const char*)g.Bt + (size_t)nxt.pn * tstepB : cB;
#pragma unroll 1
        for (int t = 0; t < nt; t += 2) {
            const bool last = (t == nt - 2);
            const char* a1 = cA + (size_t)(t + 1) * kstep;
            const char* a2 = last ? nA : cA + (size_t)(t + 2) * kstep; const char* b2 = last ? nB : cB + (size_t)(t + 2) * kstep;
            const char* a3 = a2 + kstep; const char* b3 = b2 + kstep;
            if (last && has_next) S.a_ready(nxt);
            PG8_LDB(B0, 0, 0); PG8_SCHED; PG8_LDA(At, 0, 0); PG8_STAGE(PG8_SA(1, 1), a1 + hstepA, voffA);
            PG8_WAIT_L(8); PG8_BAR; PG8_WAIT_L(0); PG8_MMA(0, 0, At, B0); PG8_BAR; PG8_SCHED;
            PG8_LDB(B1, 0, 1); PG8_STAGE(PG8_SB(0, 0), b2, voffB);
            PG8_BAR; PG8_WAIT_L(0); PG8_MMA(0, 1, At, B1); PG8_BAR;
            PG8_LDA(At, 0, 1); PG8_STAGE(PG8_SA(0, 0), a2, voffA);
            PG8_BAR; PG8_WAIT_L(0); PG8_MMA(1, 0, At, B0); PG8_BAR; PG8_SCHED;
            PG8_STAGE(PG8_SB(0, 1), b2 + hstepB, voffB);
            PG8_WAIT_V(6); PG8_BAR; PG8_MMA(1, 1, At, B1); PG8_BAR;
            PG8_LDB(B0, 1, 0); PG8_SCHED; PG8_LDA(At, 1, 0); PG8_STAGE(PG8_SA(0, 1), a2 + hstepA, voffA);
            PG8_WAIT_L(8); PG8_BAR; PG8_WAIT_L(0); PG8_MMA(0, 0, At, B0); PG8_BAR; PG8_SCHED;
            PG8_LDB(B1, 1, 1); PG8_STAGE(PG8_SB(1, 0), b3, voffB);
            PG8_BAR; PG8_WAIT_L(0); PG8_MMA(0, 1, At, B1); PG8_BAR;
            PG8_LDA(At, 1, 1); PG8_STAGE(PG8_SA(1, 0), a3, voffA);
            PG8_BAR; PG8_WAIT_L(0); PG8_MMA(1, 0, At, B0); PG8_BAR; PG8_SCHED;
            PG8_STAGE(PG8_SB(1, 1), b3 + hstepB, voffB);
            PG8_WAIT_V(6); PG8_BAR; PG8_MMA(1, 1, At, B1); PG8_BAR;
        }
        if constexpr (Epi::FP8) asm volatile("s_nop 15\n\ts_nop 15" ::: "memory");
        if constexpr (GABL & 2) { pg8::Unit u2_ = cur; u2_.pm = 0; Epi E2_ = E; E2_.retarget(); E2_(acc, u2_, wr, wc, fr, fq); } else if constexpr (!(GABL & 1)) E(acc, cur, wr, wc, fr, fq); else asm volatile("" :: "v"(acc[0][0][0][0]), "v"(acc[1][1][3][1]), "v"(acc[0][1][2][0]), "v"(acc[1][0][1][1]));
        if (!has_next) break;
#pragma unroll
        for (int a = 0; a < 2; ++a)
#pragma unroll
            for (int b = 0; b < 2; ++b)
#pragma unroll
                for (int m = 0; m < 4; ++m)
#pragma unroll
                    for (int n = 0; n < 2; ++n) acc[a][b][m][n] = (f32x4){0.f, 0.f, 0.f, 0.f};
        cur = nxt; cA = nA; cB = nB; ++ui;
    }
    PG8_WAIT_V(0);
    if (wr == 0) PG8_BAR;
    PG8_BAR;
#undef PG8_SA
#undef PG8_SB
#undef PG8_STAGE
#undef PG8_LDA
#undef PG8_LDB
#undef PG8_MMA
#undef PG8_WAIT_V
#undef PG8_WAIT_L
#undef PG8_BAR
#undef PG8_SCHED
}
}

typedef f32x4 Acc[2][2][4][2];
#define EPI_LOOP_ROWS for (int ai = 0; ai < 2; ++ai) for (int m = 0; m < 4; ++m)
__device__ __forceinline__ u32x4 pack8(const f32x4 a, const f32x4 b) { u32x4 w; w.x = cvt_pk_bf16(a[0], a[1]); w.y = cvt_pk_bf16(a[2], a[3]); w.z = cvt_pk_bf16(b[0], b[1]); w.w = cvt_pk_bf16(b[2], b[3]); return w; }

struct EpiIn {
    static constexpr bool PERM = true, FP8 = true;
    bf16_t* P1; bf16_t* G; float inv;
    __device__ __forceinline__ void retarget() { P1 = (bf16_t*)((char*)P1 - WS_P1 + WS_END); G = P1 + 256 * NP1; }
    __device__ __forceinline__ void operator()(const Acc& acc, const pg8::Unit& u, int wr, int wc, int fr, int fq) const {
        const int row0 = u.pm * 256 + wr * 64 + fr; const bool gate = u.pn >= 16;
        bf16_t* base = gate ? G : P1; const int ld = gate ? NG : NP1; const int col0 = (gate ? (u.pn - 16) : u.pn) * 256 + wc * 32 + 8 * fq;
#pragma unroll
        for (int ai = 0; ai < 2; ++ai)
#pragma unroll
            for (int m = 0; m < 4; ++m) { bf16_t* rowp = base + (size_t)(row0 + ai * 128 + m * 16) * ld + col0;
#pragma unroll
                for (int bj = 0; bj < 2; ++bj) { f32x4 v0 = acc[ai][bj][m][0] * inv, v1 = acc[ai][bj][m][1] * inv;
                    if (gate) {
#pragma unroll
                        for (int j = 0; j < 4; ++j) { v0[j] = sigmoid_f(v0[j]); v1[j] = sigmoid_f(v1[j]); } }
                    *(u32x4*)(rowp + bj * 128) = pack8(v0, v1); } }
    }
};
struct EpiPlain {
    static constexpr bool PERM = true, FP8 = false;
    bf16_t* O; int ldc;
    __device__ __forceinline__ void operator()(const Acc& acc, const pg8::Unit& u, int wr, int wc, int fr, int fq) const {
        const int row0 = u.pm * 256 + wr * 64 + fr; const int col0 = u.pn * 256 + wc * 32 + 8 * fq;
#pragma unroll
        for (int ai = 0; ai < 2; ++ai)
#pragma unroll
            for (int m = 0; m < 4; ++m) { bf16_t* rowp = O + (size_t)(row0 + ai * 128 + m * 16) * ldc + col0;
#pragma unroll
                for (int bj = 0; bj < 2; ++bj) *(u32x4*)(rowp + bj * 128) = pack8(acc[ai][bj][m][0], acc[ai][bj][m][1]); }
    }
};
__device__ __forceinline__ void tile_info(int pm, int& b, int& tpos0, bool& lat) { lat = pm < 64; b = lat ? (pm >> 4) : (pm - 64); tpos0 = lat ? CTXL + ((pm & 15) << 8) : 0; }
struct EpiQup {
    static constexpr bool PERM = true, FP8 = false;
    unsigned char* QM; const f32x2* cs32;
    __device__ __forceinline__ void operator()(const Acc& acc, const pg8::Unit& u, int wr, int wc, int fr, int fq) const {
        int b, tpos0; bool lat; tile_info(u.pm, b, tpos0, lat);
        const int r0 = wr * 64 + fr;
#pragma unroll
        for (int bj = 0; bj < 2; ++bj) { const int c0 = u.pn * 256 + bj * 128 + wc * 32 + 8 * fq; const int hh = c0 / 96, j0 = c0 - hh * 96;
            unsigned char* hb = QM + ((size_t)(b * 8 + hh) * TT + tpos0 + r0) * 128;
            if (j0 < 64) {
#pragma unroll
                for (int ai = 0; ai < 2; ++ai)
#pragma unroll
                    for (int m = 0; m < 4; ++m) { const f32x4 a_ = acc[ai][bj][m][0], b_ = acc[ai][bj][m][1]; u32x2 w8; w8.x = pk4_fp8(clamp8(a_[0]), clamp8(a_[1]), clamp8(a_[2]), clamp8(a_[3])); w8.y = pk4_fp8(clamp8(b_[0]), clamp8(b_[1]), clamp8(b_[2]), clamp8(b_[3]));
                        *(u32x2*)(hb + (ai * 128 + m * 16) * 128 + j0) = w8; }
            } else { const int g8 = (j0 - 64) >> 3, part = g8 >> 1, pbase = (g8 & 1) * 4;
#pragma unroll
                for (int ai = 0; ai < 2; ++ai)
#pragma unroll
                    for (int m = 0; m < 4; ++m) { const int t = tpos0 - CTXL + r0 + ai * 128 + m * 16; const int pos = part ? (t & 63) : (t >> 6);
                        const f32x4 v0 = acc[ai][bj][m][0], v1 = acc[ai][bj][m][1];
                        float o1[4], o2[4]; const float x1[4] = {v0[0], v0[2], v1[0], v1[2]}, x2[4] = {v0[1], v0[3], v1[1], v1[3]};
#pragma unroll
                        for (int p = 0; p < 4; ++p) { const f32x2 cs = lat ? cs32[pos * 8 + pbase + p] : (f32x2){1.f, 0.f};
                            o1[p] = x1[p] * cs.x - x2[p] * cs.y; o2[p] = x1[p] * cs.y + x2[p] * cs.x; }
                        unsigned char* dst = hb + (ai * 128 + m * 16) * 128 + 64 + part * 16 + pbase;
                        *(unsigned*)dst = pk4_fp8(clamp8(o1[0]), clamp8(o1[1]), clamp8(o1[2]), clamp8(o1[3])); *(unsigned*)(dst + 8) = pk4_fp8(clamp8(o2[0]), clamp8(o2[1]), clamp8(o2[2]), clamp8(o2[3])); } } }
    }
};
struct EpiKvup {
    static constexpr bool PERM = true, FP8 = false;
    unsigned char* KM; unsigned char* VM;
    __device__ __forceinline__ void operator()(const Acc& acc, const pg8::Unit& u, int wr, int wc, int fr, int fq) const {
        int b, tpos0; bool lat; tile_info(u.pm, b, tpos0, lat);
        const int r0 = wr * 64 + fr; const int j0 = wc * 32 + 8 * fq;
#pragma unroll
        for (int bj = 0; bj < 2; ++bj) { const size_t tok = (size_t)(b * 8 + u.pn * 2 + bj) * TT + tpos0 + r0;
            if (j0 < 64) { unsigned char* d = KM + tok * 128 + j0;
#pragma unroll
                for (int ai = 0; ai < 2; ++ai)
#pragma unroll
                    for (int m = 0; m < 4; ++m) { const f32x4 a_ = acc[ai][bj][m][0], b_ = acc[ai][bj][m][1]; u32x2 w8; w8.x = pk4_fp8(clamp8(a_[0]), clamp8(a_[1]), clamp8(a_[2]), clamp8(a_[3])); w8.y = pk4_fp8(clamp8(b_[0]), clamp8(b_[1]), clamp8(b_[2]), clamp8(b_[3]));
                        *(u32x2*)(d + (ai * 128 + m * 16) * 128) = w8; } }
            else { unsigned char* d = VM + ((size_t)(b * 8 + u.pn * 2 + bj) * 64 + (j0 - 64)) * TT;
#pragma unroll
                for (int ai = 0; ai < 2; ++ai)
#pragma unroll
                    for (int m = 0; m < 4; ++m) { const f32x4 a_ = acc[ai][bj][m][0], b_ = acc[ai][bj][m][1]; const unsigned w0_ = pk4_fp8(clamp8(a_[0]), clamp8(a_[1]), clamp8(a_[2]), clamp8(a_[3])), w1_ = pk4_fp8(clamp8(b_[0]), clamp8(b_[1]), clamp8(b_[2]), clamp8(b_[3]));
                        unsigned char* q_ = d + vt_off(tpos0 + r0 + ai * 128 + m * 16);
                        q_[0] = (unsigned char)(w0_ & 0xffu); q_[TT] = (unsigned char)((w0_ >> 8) & 0xffu); q_[2 * TT] = (unsigned char)((w0_ >> 16) & 0xffu); q_[3 * TT] = (unsigned char)(w0_ >> 24);
                        q_[4 * TT] = (unsigned char)(w1_ & 0xffu); q_[5 * TT] = (unsigned char)((w1_ >> 8) & 0xffu); q_[6 * TT] = (unsigned char)((w1_ >> 16) & 0xffu); q_[7 * TT] = (unsigned char)(w1_ >> 24); } } }
    }
};
template <int SEG> struct EpiMerge {
    static constexpr bool PERM = true, FP8 = false;
    bf16_t* MB; const bf16_t* G; unsigned char* MB8;
    __device__ __forceinline__ void operator()(const Acc& acc, const pg8::Unit& u, int wr, int wc, int fr, int fq) const {
        const int row0 = u.pm * 256 + wr * 64 + fr; const int col0 = u.pn * 256 + wc * 32 + 8 * fq;
        const bf16_t* gp = G + (size_t)row0 * NG + SEG * 2048 + col0; bf16_t* mp = MB + (size_t)row0 * D + col0; unsigned char* m8 = MB8 + (size_t)row0 * D + col0;
#pragma unroll
        for (int ai = 0; ai < 2; ++ai) {
            u32x4 gw[4][2], ow[4][2];
#pragma unroll
            for (int m = 0; m < 4; ++m)
#pragma unroll
                for (int bj = 0; bj < 2; ++bj) { const size_t ro = (size_t)(ai * 128 + m * 16);
                    gw[m][bj] = *(const u32x4*)(gp + ro * NG + bj * 128);
                    if (SEG > 0) ow[m][bj] = __builtin_nontemporal_load((const u32x4*)(mp + ro * D + bj * 128)); }
#pragma unroll
            for (int m = 0; m < 4; ++m)
#pragma unroll
                for (int bj = 0; bj < 2; ++bj) { const size_t ro = (size_t)(ai * 128 + m * 16); const u32x4 g_ = gw[m][bj];
                    f32x4 v0 = acc[ai][bj][m][0], v1 = acc[ai][bj][m][1];
                    if (ABL_BR & (1 << SEG)) { v0 = (f32x4){0.f, 0.f, 0.f, 0.f}; v1 = v0; }
                    v0[0] *= bflo(g_.x); v0[1] *= bfhi(g_.x); v0[2] *= bflo(g_.y); v0[3] *= bfhi(g_.y);
                    v1[0] *= bflo(g_.z); v1[1] *= bfhi(g_.z); v1[2] *= bflo(g_.w); v1[3] *= bfhi(g_.w);
                    if (SEG > 0) { const u32x4 o = ow[m][bj];
                        v0[0] += bflo(o.x); v0[1] += bfhi(o.x); v0[2] += bflo(o.y); v0[3] += bfhi(o.y);
                        v1[0] += bflo(o.z); v1[1] += bfhi(o.z); v1[2] += bflo(o.w); v1[3] += bfhi(o.w); }
                    if (SEG < 2) *(u32x4*)(mp + ro * D + bj * 128) = pack8(v0, v1);
                    else { u32x2 w8; w8.x = pk4_fp8(clamp8(v0[0] * 16.f), clamp8(v0[1] * 16.f), clamp8(v0[2] * 16.f), clamp8(v0[3] * 16.f)); w8.y = pk4_fp8(clamp8(v1[0] * 16.f), clamp8(v1[1] * 16.f), clamp8(v1[2] * 16.f), clamp8(v1[3] * 16.f));
                        *(u32x2*)(m8 + ro * D + bj * 128) = w8; } }
        }
    }
};
namespace pg8 {
struct Merge3 { const bf16_t* A; const bf16_t* B0; const bf16_t* B1; const bf16_t* B2; const bf16_t* G; unsigned char* MB8; float r01, r12, fin; };
template <class Sched>
__device__ __forceinline__ void gemm_merge3(LAS unsigned char* lds, const int tid, const Merge3 g, const Sched& S) {
    constexpr int GABL = 0;
    const int wid = __builtin_amdgcn_readfirstlane(tid >> 6), lane = tid & 63, wr = wid >> 2, wc = wid & 3, fr = lane & 15, fq = lane >> 4;
    constexpr int NT = 16, LDA = 1024;
    int sc1_ = 0x7F7F7F7F; asm volatile("" : "+v"(sc1_));
    unsigned voffA[2], voffB5[2], voffB10[2];
#pragma unroll
    for (int i = 0; i < 2; ++i) { int R, C; stage_rc(tid * 16 + i * 8192, R, C); const int Rb = (R & ~31) + perm32(R & 31);
        voffA[i] = (unsigned)(R * LDA + C) * 2u; voffB5[i] = (unsigned)(Rb * 256 + C) * 2u; voffB10[i] = (unsigned)(Rb * 512 + C) * 2u; }
    const size_t kstep = (size_t)(BK * 2);
    const size_t hstepA = (size_t)HALF * LDA * 2, tstepA = 2 * hstepA;
    const unsigned ldsw = (unsigned)wid * 1024u;
    const int aoff = lds_byte(wr * 64 + fr, fq * 8), boff = lds_byte(wc * 32 + fr, fq * 8);
#define M3_TA(pm_, t_) ((const char*)g.A + (size_t)(pm_) * tstepA + (size_t)(t_) * kstep)
#define M3_TB(pn_, t_) ((t_) < 4 ? (const char*)g.B0 + (size_t)(pn_) * 131072 + (size_t)(t_) * kstep : ((t_) < 8 ? (const char*)g.B1 + (size_t)(pn_) * 131072 + (size_t)((t_) - 4) * kstep : (const char*)g.B2 + (size_t)(pn_) * 262144 + (size_t)((t_) - 8) * kstep))
#define PG8_SA(b, h) (((b) * 2 + (h)) * HTB)
#define PG8_SB(b, h) ((4 + (b) * 2 + (h)) * HTB)
#define PG8_STAGE(bufoff, gbase, voff) do { if constexpr (!(GABL & 4)) _Pragma("unroll") for (int _i = 0; _i < 2; ++_i) \
        __builtin_amdgcn_global_load_lds((const unsigned*)((const char*)(gbase) + (voff)[_i]), (LAS unsigned*)(lds + (bufoff) + ldsw + _i * 8192), 16, 0, 0); } while (0)
#define PG8_LDA(dst, b, h) do { _Pragma("unroll") for (int m = 0; m < 4; ++m) { const i32x4v lo_ = *(const LAS i32x4v*)(lds + PG8_SA(b, h) + aoff + m * 2048), hi_ = *(const LAS i32x4v*)(lds + PG8_SA(b, h) + aoff + m * 2048 + 1024); dst[m] = __builtin_shufflevector(lo_, hi_, 0, 1, 2, 3, 4, 5, 6, 7); } } while (0)
#define PG8_LDB(dst, b, h) do { _Pragma("unroll") for (int n = 0; n < 2; ++n) { const i32x4v lo_ = *(const LAS i32x4v*)(lds + PG8_SB(b, h) + boff + n * 2048), hi_ = *(const LAS i32x4v*)(lds + PG8_SB(b, h) + boff + n * 2048 + 1024); dst[n] = __builtin_shufflevector(lo_, hi_, 0, 1, 2, 3, 4, 5, 6, 7); } } while (0)
#define PG8_MMA(ai, bj, At, Bt) do { __builtin_amdgcn_s_setprio(1); _Pragma("unroll") for (int m = 0; m < 4; ++m) _Pragma("unroll") for (int n = 0; n < 2; ++n) \
        asm volatile("v_mfma_scale_f32_16x16x128_f8f6f4 %0, %1, %2, %0, %3, %3 op_sel_hi:[0,0,0]" : "+v"(acc[ai][bj][m][n]) : "v"(Bt[n]), "v"(At[m]), "v"(sc1_)); __builtin_amdgcn_s_setprio(0); } while (0)
#define PG8_WAIT_V(n) asm volatile("s_waitcnt vmcnt(" #n ")" ::: "memory")
#define PG8_WAIT_L(n) asm volatile("s_waitcnt lgkmcnt(" #n ")" ::: "memory")
#define PG8_BAR __builtin_amdgcn_s_barrier()
#define PG8_SCHED __builtin_amdgcn_sched_barrier(0)
    Unit cur, nxt; int ui = 0;
    if (!S.next(0, cur)) return;
    f32x4 acc[2][2][4][2];
#pragma unroll
    for (int a = 0; a < 2; ++a)
#pragma unroll
        for (int b = 0; b < 2; ++b)
#pragma unroll
            for (int m = 0; m < 4; ++m)
#pragma unroll
                for (int n = 0; n < 2; ++n) acc[a][b][m][n] = (f32x4){0.f, 0.f, 0.f, 0.f};
    i32x8 At[4], B0[2], B1[2];
    { const char* cA = M3_TA(cur.pm, 0); const char* cB = M3_TB(cur.pn, 0); const size_t hB = 65536;
      PG8_STAGE(PG8_SB(0, 0), cB, voffB5); PG8_STAGE(PG8_SA(0, 0), cA, voffA); PG8_STAGE(PG8_SB(0, 1), cB + hB, voffB5); PG8_STAGE(PG8_SA(0, 1), cA + hstepA, voffA);
      if (wr == 1) PG8_BAR;
      PG8_WAIT_V(4); PG8_BAR;
      PG8_STAGE(PG8_SB(1, 0), cB + kstep, voffB5); PG8_STAGE(PG8_SA(1, 0), cA + kstep, voffA); PG8_STAGE(PG8_SB(1, 1), cB + hB + kstep, voffB5);
      PG8_WAIT_V(6); PG8_BAR; }
    const int r0 = wr * 64 + fr, c0l = wc * 32 + 8 * fq;
    for (;;) {
        const bool has_next = S.next(ui + 1, nxt);
        const int npm = has_next ? nxt.pm : cur.pm, npn = has_next ? nxt.pn : cur.pn;
#pragma unroll 1
        for (int t = 0; t < NT; t += 2) {
            const bool last = (t == NT - 2);
            const int t2 = last ? 0 : t + 2;
            const char* a1 = M3_TA(cur.pm, t + 1);
            const char* a2 = last ? M3_TA(npm, 0) : M3_TA(cur.pm, t + 2); const char* b2 = last ? M3_TB(npn, 0) : M3_TB(cur.pn, t + 2);
            const char* a3 = a2 + kstep; const char* b3 = b2 + kstep;
            const bool wide = t2 >= 8; const size_t hB = wide ? 131072 : 65536;
            unsigned vB[2]; vB[0] = wide ? voffB10[0] : voffB5[0]; vB[1] = wide ? voffB10[1] : voffB5[1];
            PG8_LDB(B0, 0, 0); PG8_SCHED; PG8_LDA(At, 0, 0); PG8_STAGE(PG8_SA(1, 1), a1 + hstepA, voffA);
            PG8_WAIT_L(8); PG8_BAR; PG8_WAIT_L(0); PG8_MMA(0, 0, At, B0); PG8_BAR; PG8_SCHED;
            PG8_LDB(B1, 0, 1); PG8_STAGE(PG8_SB(0, 0), b2, vB);
            PG8_BAR; PG8_WAIT_L(0); PG8_MMA(0, 1, At, B1); PG8_BAR;
            PG8_LDA(At, 0, 1); PG8_STAGE(PG8_SA(0, 0), a2, voffA);
            PG8_BAR; PG8_WAIT_L(0); PG8_MMA(1, 0, At, B0); PG8_BAR; PG8_SCHED;
            PG8_STAGE(PG8_SB(0, 1), b2 + hB, vB);
            PG8_WAIT_V(6); PG8_BAR; PG8_MMA(1, 1, At, B1); PG8_BAR;
            PG8_LDB(B0, 1, 0); PG8_SCHED; PG8_LDA(At, 1, 0); PG8_STAGE(PG8_SA(0, 1), a2 + hstepA, voffA);
            PG8_WAIT_L(8); PG8_BAR; PG8_WAIT_L(0); PG8_MMA(0, 0, At, B0); PG8_BAR; PG8_SCHED;
            PG8_LDB(B1, 1, 1); PG8_STAGE(PG8_SB(1, 0), b3, vB);
            PG8_BAR; PG8_WAIT_L(0); PG8_MMA(0, 1, At, B1); PG8_BAR;
            PG8_LDA(At, 1, 1); PG8_STAGE(PG8_SA(1, 0), a3, voffA);
            PG8_BAR; PG8_WAIT_L(0); PG8_MMA(1, 0, At, B0); PG8_BAR; PG8_SCHED;
            PG8_STAGE(PG8_SB(1, 1), b3 + hB, vB);
            PG8_WAIT_V(6); PG8_BAR; PG8_MMA(1, 1, At, B1); PG8_BAR;
            if (t == 2 || t == 6) {
                asm volatile("s_nop 15\n\ts_nop 15" ::: "memory");
                const int sg = t == 2 ? 0 : 1; const float wr_ = sg ? g.r12 : g.r01;
                const bf16_t* gp = g.G + (size_t)(cur.pm * 256 + r0) * NG + sg * 2048 + cur.pn * 256 + c0l;
#pragma unroll
                for (int ai = 0; ai < 2; ++ai) { u32x4 ga[4][2], gb[4][2];
#pragma unroll
                    for (int m = 0; m < 4; ++m)
#pragma unroll
                        for (int bj = 0; bj < 2; ++bj) { const bf16_t* q_ = gp + (size_t)(ai * 128 + m * 16) * NG + bj * 128; ga[m][bj] = *(const u32x4*)q_; gb[m][bj] = *(const u32x4*)(q_ + 2048); }
#pragma unroll
                    for (int m = 0; m < 4; ++m)
#pragma unroll
                        for (int bj = 0; bj < 2; ++bj) { const u32x4 x_ = ga[m][bj], y_ = gb[m][bj];
#define M3_RT(xw, yw, lohi) (fmaxf(lohi(xw), 1e-6f) * wr_ * __builtin_amdgcn_rcpf(fmaxf(lohi(yw), 1e-6f)))
                            acc[ai][bj][m][0][0] *= M3_RT(x_.x, y_.x, bflo); acc[ai][bj][m][0][1] *= M3_RT(x_.x, y_.x, bfhi); acc[ai][bj][m][0][2] *= M3_RT(x_.y, y_.y, bflo); acc[ai][bj][m][0][3] *= M3_RT(x_.y, y_.y, bfhi);
                            acc[ai][bj][m][1][0] *= M3_RT(x_.z, y_.z, bflo); acc[ai][bj][m][1][1] *= M3_RT(x_.z, y_.z, bfhi); acc[ai][bj][m][1][2] *= M3_RT(x_.w, y_.w, bflo); acc[ai][bj][m][1][3] *= M3_RT(x_.w, y_.w, bfhi); } }
                asm volatile("s_waitcnt vmcnt(0)" ::: "memory");
            }
        }
        asm volatile("s_nop 15\n\ts_nop 15" ::: "memory");
        { const bf16_t* gp = g.G + (size_t)(cur.pm * 256 + r0) * NG + 2 * 2048 + cur.pn * 256 + c0l; unsigned char* m8 = g.MB8 + (size_t)(cur.pm * 256 + r0) * D + cur.pn * 256 + c0l;
#pragma unroll
          for (int ai = 0; ai < 2; ++ai) { u32x4 gc[4][2];
#pragma unroll
              for (int m = 0; m < 4; ++m)
#pragma unroll
                  for (int bj = 0; bj < 2; ++bj) gc[m][bj] = *(const u32x4*)(gp + (size_t)(ai * 128 + m * 16) * NG + bj * 128);
#pragma unroll
              for (int m = 0; m < 4; ++m)
#pragma unroll
                  for (int bj = 0; bj < 2; ++bj) { const u32x4 z_ = gc[m][bj]; const f32x4 v0 = acc[ai][bj][m][0], v1 = acc[ai][bj][m][1];
                      u32x2 w8; const float f_ = g.fin;
                      w8.x = pk4_fp8(clamp8(v0[0] * fmaxf(bflo(z_.x), 1e-6f) * f_), clamp8(v0[1] * fmaxf(bfhi(z_.x), 1e-6f) * f_), clamp8(v0[2] * fmaxf(bflo(z_.y), 1e-6f) * f_), clamp8(v0[3] * fmaxf(bfhi(z_.y), 1e-6f) * f_));
                      w8.y = pk4_fp8(clamp8(v1[0] * fmaxf(bflo(z_.z), 1e-6f) * f_), clamp8(v1[1] * fmaxf(bfhi(z_.z), 1e-6f) * f_), clamp8(v1[2] * fmaxf(bflo(z_.w), 1e-6f) * f_), clamp8(v1[3] * fmaxf(bfhi(z_.w), 1e-6f) * f_));
                      *(u32x2*)(m8 + (size_t)(ai * 128 + m * 16) * D + bj * 128) = w8; } } }
        if (!has_next) break;
#pragma unroll
        for (int a = 0; a < 2; ++a)
#pragma unroll
            for (int b = 0; b < 2; ++b)
#pragma unroll
                for (int m = 0; m < 4; ++m)
#pragma unroll
                    for (int n = 0; n < 2; ++n) acc[a][b][m][n] = (f32x4){0.f, 0.f, 0.f, 0.f};
        cur = nxt; ++ui;
    }
    PG8_WAIT_V(0);
    if (wr == 0) PG8_BAR;
    PG8_BAR;
#undef M3_RT
#undef M3_TA
#undef M3_TB
#undef PG8_SA
#undef PG8_SB
#undef PG8_STAGE
#undef PG8_LDA
#undef PG8_LDB
#undef PG8_MMA
#undef PG8_WAIT_V
#undef PG8_WAIT_L
#undef PG8_BAR
#undef PG8_SCHED
}
}
struct EpiOut {
    static constexpr bool PERM = false, FP8 = true;
    const float* src_lat; const float* src_ctx; float* dst_lat; float* dst_ctx; const float* g1; float inv;
    __device__ __forceinline__ void operator()(const Acc& acc, const pg8::Unit& u, int wr, int wc, int fr, int fq) const {
        const int row0 = u.pm * 256 + wr * 64 + fr; const int col0 = u.pn * 256 + wc * 32 + 4 * fq;
        const bool lat = (u.pm * 256) < NLAT;
        const float* src = (lat ? src_lat : src_ctx - (size_t)NLAT * D) + (size_t)row0 * D + col0; float* dst = (lat ? dst_lat : dst_ctx - (size_t)NLAT * D) + (size_t)row0 * D + col0;
#pragma unroll
        for (int ai = 0; ai < 2; ++ai) { const int rbase = u.pm * 256 + ai * 128 + wr * 64; const int v = lat ? (rbase >> 12) : 4; const float* gp = g1 + (size_t)v * 12288 + col0;
            f32x4 gg[2][2];
#pragma unroll
            for (int bj = 0; bj < 2; ++bj)
#pragma unroll
                for (int n = 0; n < 2; ++n) gg[bj][n] = *(const f32x4*)(gp + bj * 128 + n * 16);
#pragma unroll
            for (int mh = 0; mh < 2; ++mh) {
                f32x4 xr[2][2][2];
#pragma unroll
                for (int mm = 0; mm < 2; ++mm)
#pragma unroll
                    for (int bj = 0; bj < 2; ++bj)
#pragma unroll
                        for (int n = 0; n < 2; ++n) xr[mm][bj][n] = __builtin_nontemporal_load((const f32x4*)(src + (size_t)(ai * 128 + (mh * 2 + mm) * 16) * D + bj * 128 + n * 16));
#pragma unroll
                for (int mm = 0; mm < 2; ++mm)
#pragma unroll
                    for (int bj = 0; bj < 2; ++bj)
#pragma unroll
                        for (int n = 0; n < 2; ++n) { const int m = mh * 2 + mm;
                            *(f32x4*)(dst + (size_t)(ai * 128 + m * 16) * D + bj * 128 + n * 16) = ABL_MIX ? xr[mm][bj][n] * ALPHA : xr[mm][bj][n] * ALPHA + gg[bj][n] * (acc[ai][bj][m][n] * inv); } } }
    }
};

struct Args { const float* in[27]; float* out; unsigned char* ws; int ph_lo, ph_hi; };
typedef const Args __attribute__((address_space(4)))* ArgP;
struct Frame {
    LAS unsigned char* lds; int tid, lane, wave, G, bid;
    ArgP ap; float* out; unsigned char* ws;
    __device__ __forceinline__ const float* in(int i) const { return ap->in[i]; }
};
__device__ __forceinline__ Frame make_frame(ArgP ap) {
    { unsigned long long t = (unsigned long long)ap; asm volatile("" : "+s"(t)); ap = (ArgP)t; }
    extern __shared__ __attribute__((aligned(16))) unsigned char lds_raw[];
    Frame F; F.lds = (LAS unsigned char*)lds_raw; { int t_ = threadIdx.x; asm volatile("" : "+v"(t_)); F.tid = t_; }
    F.lane = F.tid & 63; F.wave = __builtin_amdgcn_readfirstlane(F.tid >> 6); F.G = gridDim.x; F.bid = blockIdx.x;
    F.ap = ap; F.out = ap->out; F.ws = ap->ws; return F;
}
template <class T> __device__ __forceinline__ T* wsp(const Frame& F, size_t off) { return (T*)(F.ws + off); }

__device__ __forceinline__ int win_col(int n) {
    if (n < 768) return n;
    if (n < 1792) return 2336 + (n - 768);
    if (n < 2048) return 3360 + (n - 1792);
    if (n < 2304) return 3616 + (n - 2048);
    if (n < 2560) return 800 + (n - 2304);
    if (n < 2816) return 1056 + (n - 2560);
    if (n < 3328) return 1312 + (n - 2816);
    if (n < 3840) return 1824 + (n - 3328);
    if (n < 3872) return 768 + (n - 3840);
    if (n < 4096) return -1;
    return 3872 + (n - 4096);
}
__device__ __forceinline__ int qup_col(int c) {
    const int hh = c / 96, j = c - hh * 96;
    if (j < 64) return c;
    const int jj = j - 64, g8 = jj >> 3, i = jj & 7, p = i >> 1, which = i & 1, part = g8 >> 1, pi = (g8 & 1) * 4 + p;
    return hh * 96 + 64 + part * 16 + which * 8 + pi;
}
template <int MAP>
__device__ __forceinline__ void transpose_cvt(const Frame& F, const float* __restrict__ src, bf16_t* __restrict__ dst, int K, int Nsrc, int Nd) {
    LAS float* tile = (LAS float*)F.lds;
    const int tk = K / 256, tn = Nd / 64, ntile = tk * tn;
    for (int t = F.bid; t < ntile; t += F.G) {
        const int k0 = (t % tk) * 256, n0 = (t / tk) * 64;
        const int nl = F.tid & 63, kq = F.tid >> 6;
        const int nd = n0 + nl; const int ns = MAP == 0 ? nd : (MAP == 1 ? win_col(nd) : qup_col(nd));
        float v[32];
#pragma unroll
        for (int i = 0; i < 32; ++i) v[i] = ns >= 0 ? src[(size_t)(k0 + kq + 8 * i) * Nsrc + ns] : 0.f;
#pragma unroll
        for (int i = 0; i < 32; ++i) tile[(kq + 8 * i) * 65 + nl] = v[i];
        __syncthreads();
        { const int n = F.tid >> 3, k32 = (F.tid & 7) * 32;
#pragma unroll
          for (int c = 0; c < 4; ++c) { float w[8];
#pragma unroll
              for (int j = 0; j < 8; ++j) w[j] = tile[(k32 + c * 8 + j) * 65 + n];
              u32x4 o; o.x = cvt_pk_bf16(w[0], w[1]); o.y = cvt_pk_bf16(w[2], w[3]); o.z = cvt_pk_bf16(w[4], w[5]); o.w = cvt_pk_bf16(w[6], w[7]);
              *(u32x4*)(dst + (size_t)(n0 + n) * K + k0 + k32 + c * 8) = o; } }
        __syncthreads();
    }
}
__device__ __forceinline__ void cvt_rows(const Frame& F, const float* __restrict__ src, bf16_t* __restrict__ dst, size_t n8) {
    for (size_t i = (size_t)F.bid * 512 + F.tid; i < n8; i += (size_t)F.G * 512) {
        const f32x4 a = __builtin_nontemporal_load((const f32x4*)(src + i * 8)), b = __builtin_nontemporal_load((const f32x4*)(src + i * 8 + 4));
        *(u32x4*)(dst + i * 8) = pack8(a, b);
    }
}
__device__ __forceinline__ void cvt_peer(const Frame& F, int l);
__device__ __forceinline__ void absmax_f32(const Frame& F, const float* __restrict__ src, size_t n4, unsigned* dst) {
    float am = 0.f;
    const size_t stride = (size_t)F.G * 512; size_t i = (size_t)F.bid * 512 + F.tid;
    for (; i + 7 * stride < n4; i += 8 * stride) { f32x4 a[8];
#pragma unroll
        for (int j = 0; j < 8; ++j) a[j] = __builtin_nontemporal_load((const f32x4*)(src + (i + j * stride) * 4));
#pragma unroll
        for (int j = 0; j < 8; ++j) am = fmaxf(fmaxf(fmaxf(am, fabsf(a[j][0])), fabsf(a[j][1])), fmaxf(fabsf(a[j][2]), fabsf(a[j][3]))); }
    for (; i < n4; i += stride) { const f32x4 a = *(const f32x4*)(src + i * 4); am = fmaxf(fmaxf(fmaxf(am, fabsf(a[0])), fabsf(a[1])), fmaxf(fabsf(a[2]), fabsf(a[3]))); }
    am = row16_max(am);
    { auto r = __builtin_amdgcn_permlane16_swap(__float_as_uint(am), __float_as_uint(am), false, false); am = fmaxf(__uint_as_float(r[0]), __uint_as_float(r[1])); }
    { auto r = __builtin_amdgcn_permlane32_swap(__float_as_uint(am), __float_as_uint(am), false, false); am = fmaxf(__uint_as_float(r[0]), __uint_as_float(r[1])); }
    if (F.lane == 0) atomicMax(dst, __float_as_uint(am));
}
template <int MAP>
__device__ __forceinline__ void transpose_fp8(const Frame& F, const float* __restrict__ src, unsigned char* __restrict__ dst, int K, int Nsrc, int Nd, const unsigned* wsc) {
    float mul, inv; fp8_scale(__hip_atomic_load(wsc, __ATOMIC_RELAXED, __HIP_MEMORY_SCOPE_AGENT), mul, inv);
    LAS float* tile = (LAS float*)F.lds;
    const int tk = K / 256, tn = Nd / 64, ntile = tk * tn;
    for (int t = F.bid; t < ntile; t += F.G) {
        const int k0 = (t % tk) * 256, n0 = (t / tk) * 64;
        const int nl = F.tid & 63, kq = F.tid >> 6; const int ns = MAP ? win_col(n0 + nl) : n0 + nl;
        float v[32];
#pragma unroll
        for (int i = 0; i < 32; ++i) v[i] = ns >= 0 ? src[(size_t)(k0 + kq + 8 * i) * Nsrc + ns] : 0.f;
#pragma unroll
        for (int i = 0; i < 32; ++i) tile[(kq + 8 * i) * 65 + nl] = v[i] * mul;
        __syncthreads();
        { const int n = F.tid >> 3, k32 = (F.tid & 7) * 32;
#pragma unroll
          for (int c = 0; c < 2; ++c) { float w[16];
#pragma unroll
              for (int j = 0; j < 16; ++j) w[j] = tile[(k32 + c * 16 + j) * 65 + n];
              u32x4 o; o.x = pk4_fp8(w[0], w[1], w[2], w[3]); o.y = pk4_fp8(w[4], w[5], w[6], w[7]); o.z = pk4_fp8(w[8], w[9], w[10], w[11]); o.w = pk4_fp8(w[12], w[13], w[14], w[15]);
              *(u32x4*)(dst + (size_t)(n0 + n) * K + k0 + k32 + c * 16) = o; } }
        __syncthreads();
    }
}
__device__ __forceinline__ void p0_prologue(const Frame& F) {
    { const int gi = F.bid * 512 + F.tid;
      if (gi < 64 * 8) { const int pos = gi >> 3, f = gi & 7; const float inv = powf(10000.f, -(float)f / 8.f); const float a = (float)pos * inv; wsp<f32x2>(F, WS_ROPE32)[gi] = (f32x2){cosf(a), sinf(a)}; }
      else if (gi < 64 * 8 + 64 * 32) { const int g2 = gi - 512; const int pos = g2 >> 5, f = g2 & 31; const float inv = powf(10000.f, -(float)f / 32.f); const float a = (float)pos * inv; wsp<f32x2>(F, WS_ROPE128)[g2] = (f32x2){cosf(a), sinf(a)}; } }
    if (F.bid == 0 && F.tid < 32) wsp<float>(F, WS_DEC)[F.tid] = -log1pf(expf(-F.in(11)[F.tid])) * LOG2E;
    { LAS float* sl = (LAS float*)F.lds;
      float* modp = wsp<float>(F, WS_MODP);
      for (int u = F.bid; u < 2 * 24 * 16; u += F.G) {
          const int kc = u & 15, cb = (u >> 4) % 24, l = u / (16 * 24);
          __syncthreads();
          for (int i = F.tid; i < 640; i += 512) { const int v = i >> 7, k = kc * 128 + (i & 127); const float c = v < 4 ? F.in(1)[v * 2048 + k] : F.in(3)[k]; sl[i] = silu_f(c); }
          __syncthreads();
          const int col = cb * 512 + F.tid; const float* w = F.in(4) + ((size_t)l * 2048 + kc * 128) * 12288 + col;
          float a0 = 0.f, a1 = 0.f, a2 = 0.f, a3 = 0.f, a4 = 0.f;
#pragma unroll 32
          for (int k = 0; k < 128; ++k) { const float wv = w[(size_t)k * 12288]; a0 += sl[k] * wv; a1 += sl[128 + k] * wv; a2 += sl[256 + k] * wv; a3 += sl[384 + k] * wv; a4 += sl[512 + k] * wv; }
          float* o = modp + ((size_t)(kc * 2 + l) * 5) * 12288 + col;
          o[0] = a0; o[12288] = a1; o[2 * 12288] = a2; o[3 * 12288] = a3; o[4 * 12288] = a4;
      }
      __syncthreads(); }
    for (int l = 0; l < 2; ++l) {
        absmax_f32(F, F.in(6) + (size_t)l * 2048 * NIN, (size_t)2048 * NIN / 4, wsp<unsigned>(F, WS_WSC) + l);
        transpose_cvt<2>(F, F.in(8) + (size_t)l * 512 * 768, wsp<bf16_t>(F, WS_WQUP + l * SZ_WQUP), 512, 768, 768);
        transpose_cvt<0>(F, F.in(10) + (size_t)l * 256 * 1024, wsp<bf16_t>(F, WS_WKVUP + l * SZ_WKVUP), 256, 1024, 1024);
        absmax_f32(F, F.in(14) + (size_t)l * 512 * 2048, (size_t)512 * 2048 / 4, wsp<unsigned>(F, WS_WSC) + 4 + l);
        absmax_f32(F, F.in(15) + (size_t)l * 512 * 2048, (size_t)512 * 2048 / 4, wsp<unsigned>(F, WS_WSC) + 6 + l);
        absmax_f32(F, F.in(16) + (size_t)l * 1024 * 2048, (size_t)1024 * 2048 / 4, wsp<unsigned>(F, WS_WSC) + 8 + l);
        absmax_f32(F, F.in(17) + (size_t)l * 2048 * 2048, (size_t)2048 * 2048 / 4, wsp<unsigned>(F, WS_WSC) + 2 + l);
        transpose_cvt<0>(F, F.in(20) + (size_t)l * 2048 * 1024, wsp<bf16_t>(F, WS_WPQ + l * SZ_WPQ), 2048, 1024, 1024);
    }
    cvt_peer(F, 0);
}
__device__ __forceinline__ void p1_modreduce(const Frame& F) {
    const float* modp = wsp<float>(F, WS_MODP); float* mod = wsp<float>(F, WS_MOD);
    for (int i = F.bid * 512 + F.tid; i < 2 * 5 * 12288; i += F.G * 512) {
        const int j = i % 12288, l = i / (5 * 12288);
        float s = F.in(5)[l * 12288 + j];
#pragma unroll
        for (int kc = 0; kc < 16; ++kc) s += modp[(size_t)kc * (2 * 5 * 12288) + i];
        mod[i] = s;
    }
    for (int l = 0; l < 2; ++l) {
        transpose_fp8<1>(F, F.in(6) + (size_t)l * 2048 * NIN, wsp<unsigned char>(F, WS_WIN + l * SZ_WIN), 2048, NIN, NPT, wsp<unsigned>(F, WS_WSC) + l);
        transpose_fp8<0>(F, F.in(17) + (size_t)l * 2048 * 2048, wsp<unsigned char>(F, WS_WOUT + l * SZ_WOUT), 2048, 2048, 2048, wsp<unsigned>(F, WS_WSC) + 2 + l);
        transpose_fp8<0>(F, F.in(14) + (size_t)l * 512 * 2048, wsp<unsigned char>(F, WS_WBRA + l * SZ_WBRA), 512, 2048, 2048, wsp<unsigned>(F, WS_WSC) + 4 + l);
        transpose_fp8<0>(F, F.in(15) + (size_t)l * 512 * 2048, wsp<unsigned char>(F, WS_WBRB + l * SZ_WBRB), 512, 2048, 2048, wsp<unsigned>(F, WS_WSC) + 6 + l);
        transpose_fp8<0>(F, F.in(16) + (size_t)l * 1024 * 2048, wsp<unsigned char>(F, WS_WBRC + l * SZ_WBRC), 1024, 2048, 2048, wsp<unsigned>(F, WS_WSC) + 8 + l);
    }
}
__device__ __forceinline__ void ld_row_f32(const float* p, int lane, float (&x)[32]) {
#pragma unroll
    for (int q = 0; q < 4; ++q) { const f32x4 a = *(const f32x4*)(p + 512 * q + 8 * lane), b = *(const f32x4*)(p + 512 * q + 8 * lane + 4);
        x[q * 8 + 0] = a[0]; x[q * 8 + 1] = a[1]; x[q * 8 + 2] = a[2]; x[q * 8 + 3] = a[3]; x[q * 8 + 4] = b[0]; x[q * 8 + 5] = b[1]; x[q * 8 + 6] = b[2]; x[q * 8 + 7] = b[3]; }
}
__device__ __forceinline__ void st_row_f32(float* p, int lane, const float (&x)[32]) {
#pragma unroll
    for (int q = 0; q < 4; ++q) { *(f32x4*)(p + 512 * q + 8 * lane) = (f32x4){x[q * 8 + 0], x[q * 8 + 1], x[q * 8 + 2], x[q * 8 + 3]}; *(f32x4*)(p + 512 * q + 8 * lane + 4) = (f32x4){x[q * 8 + 4], x[q * 8 + 5], x[q * 8 + 6], x[q * 8 + 7]}; }
}
__device__ __forceinline__ void st_row_bf16(bf16_t* p, int lane, const float (&x)[32]) {
#pragma unroll
    for (int q = 0; q < 4; ++q) { u32x4 w; w.x = cvt_pk_bf16(x[q * 8 + 0], x[q * 8 + 1]); w.y = cvt_pk_bf16(x[q * 8 + 2], x[q * 8 + 3]); w.z = cvt_pk_bf16(x[q * 8 + 4], x[q * 8 + 5]); w.w = cvt_pk_bf16(x[q * 8 + 6], x[q * 8 + 7]);
        *(u32x4*)(p + 512 * q + 8 * lane) = w; }
}
__device__ __forceinline__ void p_modulate0(const Frame& F) {
    const float* mod = wsp<float>(F, WS_MOD); unsigned char* hb8 = wsp<unsigned char>(F, WS_HB8);
    for (int row = F.bid * 8 + F.wave; row < NROW; row += F.G * 8) {
        const RowInfo ri = rowinfo(row);
        const float* xp = ri.lat ? F.in(0) + (size_t)row * D : F.in(2) + (size_t)(row - NLAT) * D;
        const float* mp = mod + (size_t)ri.v * 12288;
        float x[32], sh[32], sc[32];
        ld_row_f32(xp, F.lane, x); ld_row_f32(mp, F.lane, sh); ld_row_f32(mp + 2048, F.lane, sc);
#pragma unroll
        for (int i = 0; i < 32; ++i) x[i] = clamp8(x[i] * (1.f + sc[i]) + sh[i]);
#pragma unroll
        for (int q = 0; q < 4; ++q) { u32x2 w; w.x = pk4_fp8(x[q * 8 + 0], x[q * 8 + 1], x[q * 8 + 2], x[q * 8 + 3]); w.y = pk4_fp8(x[q * 8 + 4], x[q * 8 + 5], x[q * 8 + 6], x[q * 8 + 7]); *(u32x2*)(hb8 + (size_t)row * D + 512 * q + 8 * F.lane) = w; }
    }
}
__device__ __forceinline__ void p_post(const Frame& F, int l) {
    const bf16_t* P1 = wsp<bf16_t>(F, WS_P1);
    bf16_t* CQN = wsp<bf16_t>(F, WS_CQN); bf16_t* CKVN = wsp<bf16_t>(F, WS_CKVN);
    unsigned char* QG = wsp<unsigned char>(F, WS_QG); unsigned char* KG = wsp<unsigned char>(F, WS_KG); unsigned char* VG = wsp<unsigned char>(F, WS_VG);
    bf16_t* RQ = wsp<bf16_t>(F, WS_RQ); bf16_t* RK = wsp<bf16_t>(F, WS_RK); bf16_t* RV = wsp<bf16_t>(F, WS_RV);
    unsigned char* KM = wsp<unsigned char>(F, WS_KM); unsigned char* QM = wsp<unsigned char>(F, WS_QM);
    const f32x2* cs32 = wsp<f32x2>(F, WS_ROPE32); const f32x2* cs128 = wsp<f32x2>(F, WS_ROPE128);
    const float* gq_n = F.in(7) + l * 512; const float* gkv_n = F.in(9) + l * 256; const float* gqa_qn = F.in(12) + l * 128; const float* gqa_kn = F.in(13) + l * 128;
    LAS bf16_t* rs = (LAS bf16_t*)(F.lds + F.wave * 8192);
    const int lane = F.lane;
    const f32x4 gq0 = *(const f32x4*)(gq_n + lane * 8), gq1 = *(const f32x4*)(gq_n + lane * 8 + 4), gkv0 = *(const f32x4*)(gkv_n + lane * 4);
    const int gd0 = 2 * lane; const int gpart = gd0 >> 6, gdd = gd0 & 63; const bool glo = gdd < 32; const int gf = glo ? gdd : gdd - 32; const int gdp = glo ? gd0 + 32 : gd0 - 32;
    const float qn0 = gqa_qn[gd0], qn1 = gqa_qn[gd0 + 1], qnp0 = gqa_qn[gdp], qnp1 = gqa_qn[gdp + 1];
    const float kn0 = gqa_kn[gd0], kn1 = gqa_kn[gd0 + 1], knp0 = gqa_kn[gdp], knp1 = gqa_kn[gdp + 1];
    const int rhh = lane >> 3, rd0 = (lane & 7) * 4; const int rpart = rd0 >> 4, rdd = rd0 & 15; const bool rlo = rdd < 8; const int rf = rlo ? rdd : rdd - 8; const int rdp = rlo ? rd0 + 8 : rd0 - 8;
    const int step = F.G * 8;
    int row = F.bid * 8 + F.wave;
    u32x4 pre[8];
    if (row < NROW) {
#pragma unroll
        for (int q = 0; q < 8; ++q) pre[q] = *(const u32x4*)(P1 + (size_t)row * NP1 + q * 512 + lane * 8); }
#pragma unroll 1
    for (; row < NROW; row += step) {
        const RowInfo ri = rowinfo(row);
        const int posg = gpart ? ri.pc : ri.pr, posr = rpart ? ri.pc : ri.pr;
        const f32x2 one = {1.f, 0.f};
        const f32x2 csA = ri.lat ? cs128[posg * 32 + gf] : one, csB = ri.lat ? cs128[posg * 32 + gf + 1] : one;
        f32x2 cs[4];
#pragma unroll
        for (int i = 0; i < 4; ++i) cs[i] = ri.lat ? cs32[posr * 8 + rf + i] : one;
#pragma unroll
        for (int q = 0; q < 8; ++q) *(LAS u32x4*)(rs + q * 512 + lane * 8) = pre[q];
        { const int nrow = row + step; if (nrow < NROW) {
#pragma unroll
            for (int q = 0; q < 8; ++q) pre[q] = *(const u32x4*)(P1 + (size_t)nrow * NP1 + q * 512 + lane * 8); } }
        asm volatile("s_waitcnt lgkmcnt(0)" ::: "memory");
        { float x[8]; float ss = 0.f;
#pragma unroll
          for (int i = 0; i < 8; ++i) { x[i] = bf2f(rs[C_CQ + lane * 8 + i]); ss += x[i] * x[i]; }
          ss = wave_sum(ss); const float r = rsqrtf(ss * (1.f / 512.f) + RMS_EPS);
          *(u32x4*)(CQN + (size_t)row * 512 + lane * 8) = pack8((f32x4){x[0] * r * gq0[0], x[1] * r * gq0[1], x[2] * r * gq0[2], x[3] * r * gq0[3]}, (f32x4){x[4] * r * gq1[0], x[5] * r * gq1[1], x[6] * r * gq1[2], x[7] * r * gq1[3]}); }
        { float x[4]; float ss = 0.f;
#pragma unroll
          for (int i = 0; i < 4; ++i) { x[i] = bf2f(rs[C_CKV + lane * 4 + i]); ss += x[i] * x[i]; }
          ss = wave_sum(ss); const float r = rsqrtf(ss * (1.f / 256.f) + RMS_EPS);
          u32x2 w; w.x = cvt_pk_bf16(x[0] * r * gkv0[0], x[1] * r * gkv0[1]); w.y = cvt_pk_bf16(x[2] * r * gkv0[2], x[3] * r * gkv0[3]);
          *(u32x2*)(CKVN + (size_t)row * 256 + lane * 4) = w; }
        {
            const int d0 = gd0, dp = gdp; const bool lo = glo;
#pragma unroll 1
            for (int hh = 0; hh < 10; ++hh) {
                const bool isq = hh < 8; const int cbase = isq ? C_GQ + hh * 128 : C_GK + (hh - 8) * 128;
                const float g0 = isq ? qn0 : kn0, g1 = isq ? qn1 : kn1, gp0 = isq ? qnp0 : knp0, gp1 = isq ? qnp1 : knp1;
                const float a0 = bf2f(rs[cbase + d0]), a1 = bf2f(rs[cbase + d0 + 1]);
                float ss = wave_sum(a0 * a0 + a1 * a1); const float r = rsqrtf(ss * (1.f / 128.f) + RMS_EPS);
                const float n0 = a0 * r * g0, n1 = a1 * r * g1;
                const float p0 = bf2f(rs[cbase + dp]) * r * gp0, p1 = bf2f(rs[cbase + dp + 1]) * r * gp1;
                float o0, o1;
                if (lo) { o0 = n0 * csA.x - p0 * csA.y; o1 = n1 * csB.x - p1 * csB.y; }
                else    { o0 = p0 * csA.y + n0 * csA.x; o1 = p1 * csB.y + n1 * csB.x; }
                unsigned char* dst = isq ? QG + ((size_t)(ri.b * 8 + hh) * TT + ri.tpos) * 128 : KG + ((size_t)(ri.b * 2 + (hh - 8)) * TT + ri.tpos) * 128;
                *(unsigned short*)(dst + d0) = (unsigned short)(pk4_fp8(clamp8(o0), clamp8(o1), 0.f, 0.f) & 0xffffu);
            }
#pragma unroll
            for (int hh = 0; hh < 2; ++hh) { const unsigned w8_ = pk4_fp8(clamp8(bf2f(rs[C_GV + hh * 128 + d0])), clamp8(bf2f(rs[C_GV + hh * 128 + d0 + 1])), 0.f, 0.f); unsigned char* vp_ = VG + ((size_t)(ri.b * 2 + hh) * 128 + d0) * TT + vt_off(ri.tpos);
                vp_[0] = (unsigned char)(w8_ & 0xffu); vp_[TT] = (unsigned char)((w8_ >> 8) & 0xffu); }
        }
        {
            const int hh = rhh, d0 = rd0, dp = rdp; const bool lo = rlo;
#pragma unroll
            for (int which = 0; which < 2; ++which) {
                const int cbase = (which ? C_RK : C_RQ) + hh * 32; const float sc = which ? 0.17677669529663687f : 1.f;
                float o[4];
#pragma unroll
                for (int i = 0; i < 4; ++i) { const float n = bf2f(rs[cbase + d0 + i]), p = bf2f(rs[cbase + dp + i]);
                    o[i] = (lo ? (n * cs[i].x - p * cs[i].y) : (p * cs[i].y + n * cs[i].x)) * sc; }
                u32x2 w; w.x = cvt_pk_bf16(o[0], o[1]); w.y = cvt_pk_bf16(o[2], o[3]);
                *(u32x2*)((which ? RK : RQ) + ((size_t)(ri.b * 8 + hh) * TT + ri.tpos) * 32 + d0) = w;
            }
            { const int vh = lane >> 3, e0 = (lane & 7) * 8;
              *(u32x4*)(RV + ((size_t)(ri.b * 8 + vh) * TT + ri.tpos) * 64 + e0) = *(LAS u32x4*)(rs + C_RV + lane * 8); }
            { float o[4];
#pragma unroll
              for (int i = 0; i < 4; ++i) { const float n = bf2f(rs[C_KR + d0 + i]), p = bf2f(rs[C_KR + dp + i]); o[i] = lo ? (n * cs[i].x - p * cs[i].y) : (p * cs[i].y + n * cs[i].x); }
              const size_t tok_ = ((size_t)(ri.b * 8 + hh) * TT + ri.tpos) * 128;
              *(unsigned*)(KM + tok_ + 64 + d0) = pk4_fp8(clamp8(o[0]), clamp8(o[1]), clamp8(o[2]), clamp8(o[3]));
              *(unsigned*)(KM + tok_ + 96 + d0) = 0u; *(unsigned*)(QM + tok_ + 96 + d0) = 0u; }
        }
        asm volatile("s_waitcnt lgkmcnt(0)" ::: "memory");
    }
}

__device__ __forceinline__ void ret_logs(const Frame& F, int l, int h, float& lgf, float& lgb) {
    const float* t = wsp<float>(F, WS_DEC); lgf = t[(l * 2 + 0) * 8 + h]; lgb = t[(l * 2 + 1) * 8 + h];
}
constexpr int TP = 136;
template <bool WITH_K>
__device__ __forceinline__ void ret_stage(const Frame& F, const bf16_t* RKh, const bf16_t* RVh, int tpos0, float lgf, float lgb, LAS bf16_t* vt, LAS bf16_t* ktf, LAS bf16_t* ktb) {
#pragma unroll
    for (int i = 0; i < 2; ++i) { const int tok = (F.tid >> 3) + 64 * i, e0 = (F.tid & 7) * 8;
        const u32x4 w = *(const u32x4*)(RVh + (size_t)(tpos0 + tok) * 64 + e0); const unsigned ww[4] = {w.x, w.y, w.z, w.w};
#pragma unroll
        for (int j = 0; j < 4; ++j) { vt[(e0 + 2 * j) * TP + tok] = (bf16_t)(ww[j] & 0xffffu); vt[(e0 + 2 * j + 1) * TP + tok] = (bf16_t)(ww[j] >> 16); } }
    if (WITH_K) { const int tok = F.tid >> 2, k0 = (F.tid & 3) * 8;
        const u32x4 w = *(const u32x4*)(RKh + (size_t)(tpos0 + tok) * 32 + k0); const unsigned ww[4] = {w.x, w.y, w.z, w.w};
        const float zf = exp2f(lgf * (float)(127 - tok)), zb = exp2f(lgb * (float)tok);
#pragma unroll
        for (int j = 0; j < 4; ++j) { const float a = bflo(ww[j]), b = bfhi(ww[j]);
            ktf[(k0 + 2 * j) * TP + tok] = f2bf(a * zf); ktf[(k0 + 2 * j + 1) * TP + tok] = f2bf(b * zf);
            ktb[(k0 + 2 * j) * TP + tok] = f2bf(a * zb); ktb[(k0 + 2 * j + 1) * TP + tok] = f2bf(b * zb); } }
}
__device__ __forceinline__ void p_ret_states(const Frame& F, int l) {
    LAS bf16_t* vt = (LAS bf16_t*)F.lds; LAS bf16_t* ktf = vt + 64 * TP; LAS bf16_t* ktb = ktf + 32 * TP;
    float* ST = wsp<float>(F, WS_ST);
    const int lane = F.lane, w = F.wave, kb = w >> 2, eb = w & 3, fr = lane & 15, fq = lane >> 4;
    for (int u = F.bid; u < NB * 8 * 34; u += F.G) {
        const int c = u % 34, bh = u / 34, h = bh & 7;
        float lgf, lgb; ret_logs(F, l, h, lgf, lgb);
        __syncthreads();
        ret_stage<true>(F, wsp<bf16_t>(F, WS_RK) + (size_t)bh * TT * 32, wsp<bf16_t>(F, WS_RV) + (size_t)bh * TT * 64, c * 128, lgf, lgb, vt, ktf, ktb);
        __syncthreads();
        f32x4 sf = {0.f, 0.f, 0.f, 0.f}, sb = {0.f, 0.f, 0.f, 0.f};
#pragma unroll
        for (int ks = 0; ks < 4; ++ks) {
            const bf16x8 bv = *(const LAS bf16x8*)(vt + (eb * 16 + fr) * TP + ks * 32 + fq * 8);
            const bf16x8 af = *(const LAS bf16x8*)(ktf + (kb * 16 + fr) * TP + ks * 32 + fq * 8);
            const bf16x8 ab = *(const LAS bf16x8*)(ktb + (kb * 16 + fr) * TP + ks * 32 + fq * 8);
            sf = __builtin_amdgcn_mfma_f32_16x16x32_bf16(af, bv, sf, 0, 0, 0);
            sb = __builtin_amdgcn_mfma_f32_16x16x32_bf16(ab, bv, sb, 0, 0, 0);
        }
        float* o = ST + (size_t)u * 2 * 2048;
#pragma unroll
        for (int r = 0; r < 4; ++r) { const int kd = kb * 16 + fq * 4 + r, e = eb * 16 + fr; o[kd * 64 + e] = sf[r]; o[2048 + kd * 64 + e] = sb[r]; }
    }
}
constexpr int RP = 40;
constexpr int AP = 136;
__device__ __forceinline__ void ret_out_unit(const Frame& F, int l, int bh, int c) {
    LAS bf16_t* vt = (LAS bf16_t*)F.lds; LAS bf16_t* rtf = vt + 64 * TP; LAS bf16_t* rtb = rtf + 64 * RP; LAS bf16_t* as = rtb + 64 * RP + F.wave * 16 * AP;
    const int lane = F.lane, w = F.wave, fr = lane & 15, fq = lane >> 4, h = bh & 7, b = bh >> 3;
    const bf16_t* RQh = wsp<bf16_t>(F, WS_RQ) + (size_t)bh * TT * 32; const bf16_t* RKh = wsp<bf16_t>(F, WS_RK) + (size_t)bh * TT * 32; const bf16_t* RVh = wsp<bf16_t>(F, WS_RV) + (size_t)bh * TT * 64;
    const float* STh = wsp<float>(F, WS_ST) + (size_t)bh * 34 * 2 * 2048;
    float lgf, lgb; ret_logs(F, l, h, lgf, lgb);
    const int tpos0 = c * 128;
    __syncthreads();
    ret_stage<false>(F, RKh, RVh, tpos0, lgf, lgb, vt, nullptr, nullptr);
    { const int kd = F.tid >> 4, e4 = (F.tid & 15) * 4; f32x4 rf = {0.f, 0.f, 0.f, 0.f}, rb = {0.f, 0.f, 0.f, 0.f};
      if (c >= 2) {
          for (int cp = 0; cp < c; ++cp) { const float e2 = lgf * 128.f * (float)(c - 1 - cp); if (e2 < -80.f) continue; const float wgt = exp2f(e2);
              rf += *(const f32x4*)(STh + (size_t)(cp * 2 + 0) * 2048 + kd * 64 + e4) * wgt; }
          const int p = c - 2;
          for (int pp = p + 1; pp < 34; ++pp) { const float e2 = lgb * 128.f * (float)(pp - p - 1); if (e2 < -80.f) break; const float wgt = exp2f(e2); const int cs = pp < 32 ? pp + 2 : pp - 32;
              rb += *(const f32x4*)(STh + (size_t)(cs * 2 + 1) * 2048 + kd * 64 + e4) * wgt; }
      } else if (c == 0) { rb = *(const f32x4*)(STh + (size_t)(1 * 2 + 1) * 2048 + kd * 64 + e4); }
      else { rf = *(const f32x4*)(STh + (size_t)(0 * 2 + 0) * 2048 + kd * 64 + e4); }
#pragma unroll
      for (int j = 0; j < 4; ++j) { rtf[(e4 + j) * RP + kd] = f2bf(rf[j]); rtb[(e4 + j) * RP + kd] = f2bf(rb[j]); } }
    const int i0 = w * 16;
    const bf16x8 qa = *(const bf16x8*)(RQh + (size_t)(tpos0 + i0 + fr) * 32 + fq * 8);
    f32x4 s[8];
#pragma unroll
    for (int nb = 0; nb < 8; ++nb) { const bf16x8 kf = *(const bf16x8*)(RKh + (size_t)(tpos0 + nb * 16 + fr) * 32 + fq * 8);
        s[nb] = __builtin_amdgcn_mfma_f32_16x16x32_bf16(qa, kf, (f32x4){0.f, 0.f, 0.f, 0.f}, 0, 0, 0); }
#pragma unroll
    for (int nb = 0; nb < 8; ++nb)
#pragma unroll
        for (int r = 0; r < 4; ++r) { const int i = i0 + fq * 4 + r, j = nb * 16 + fr; const int df = i - j;
            const float mk = df > 0 ? exp2f(lgf * (float)df) : (df < 0 ? exp2f(lgb * (float)(-df)) : 2.f);
            as[(fq * 4 + r) * AP + j] = f2bf(s[nb][r] * mk); }
    __syncthreads();
    f32x4 y[4];
#pragma unroll
    for (int eb = 0; eb < 4; ++eb) y[eb] = (f32x4){0.f, 0.f, 0.f, 0.f};
#pragma unroll
    for (int ks = 0; ks < 4; ++ks) { const bf16x8 af = *(const LAS bf16x8*)(as + fr * AP + ks * 32 + fq * 8);
#pragma unroll
        for (int eb = 0; eb < 4; ++eb) { const bf16x8 bv = *(const LAS bf16x8*)(vt + (eb * 16 + fr) * TP + ks * 32 + fq * 8);
            y[eb] = __builtin_amdgcn_mfma_f32_16x16x32_bf16(af, bv, y[eb], 0, 0, 0); } }
    { const float xf = exp2f(lgf * (float)(i0 + fr + 1)), xb = exp2f(lgb * (float)(128 - (i0 + fr)));
      bf16x8 qf, qb;
#pragma unroll
      for (int j = 0; j < 8; ++j) { const float qv = bf2f((bf16_t)qa[j]); qf[j] = (short)f2bf(qv * xf); qb[j] = (short)f2bf(qv * xb); }
#pragma unroll
      for (int eb = 0; eb < 4; ++eb) { const bf16x8 bf_ = *(const LAS bf16x8*)(rtf + (eb * 16 + fr) * RP + fq * 8), bb_ = *(const LAS bf16x8*)(rtb + (eb * 16 + fr) * RP + fq * 8);
          y[eb] = __builtin_amdgcn_mfma_f32_16x16x32_bf16(qf, bf_, y[eb], 0, 0, 0);
          y[eb] = __builtin_amdgcn_mfma_f32_16x16x32_bf16(qb, bb_, y[eb], 0, 0, 0); } }
    const bf16_t* P1 = wsp<bf16_t>(F, WS_P1); unsigned char* OAB = wsp<unsigned char>(F, WS_OAB);
#pragma unroll
    for (int r = 0; r < 4; ++r) {
        float sm = y[0][r] + y[1][r] + y[2][r] + y[3][r]; sm = row16_sum(sm); const float mu = sm * (1.f / 64.f);
        float vs = 0.f;
#pragma unroll
        for (int eb = 0; eb < 4; ++eb) { const float d = y[eb][r] - mu; vs += d * d; }
        vs = row16_sum(vs); const float rstd = rsqrtf(vs * (1.f / 64.f) + LN_EPS);
        const int i = i0 + fq * 4 + r; const int tp = tpos0 + i; const size_t grow = tp >= CTXL ? (size_t)b * SEQ + (tp - CTXL) : (size_t)NLAT + b * CTXL + tp;
#pragma unroll
        for (int eb = 0; eb < 4; ++eb) { const int e = eb * 16 + fr; const float g = bf2f(P1[grow * NP1 + C_RG + h * 64 + e]);
            OAB[grow * D + 512 + h * 64 + e] = (unsigned char)(pk4_fp8(clamp8(silu_f(g) * (y[eb][r] - mu) * rstd * 16.f), 0.f, 0.f, 0.f) & 0xffu); }
    }
}
namespace att {
constexpr int NW = 8, QBLK = 32, KVBLK = 64;
constexpr int SHM_K = KVBLK * 128, SHM_V = 128 * 64;
constexpr size_t SHM_ATTN = 4 * SHM_K + 3 * SHM_V;
constexpr float THR = 1.9f, PSH = 6.f;
#define SBAR() __builtin_amdgcn_sched_barrier(0)
typedef int i32x8a __attribute__((ext_vector_type(8))); typedef int i32x4a __attribute__((ext_vector_type(4)));
template <int SC> struct Scale { static constexpr float S = SC == 0 ? 0.08838834764831845f : 0.10206207261596575f; static constexpr float C = S * 1.4426950408889634f; static constexpr float THRR = THR / S; };
#define KSWZ8(row, chunk) ((row) * 128 + ((((chunk) ^ (((row) >> 1) & 7))) << 4))
#define VSWZ8(col, chunk) ((col) * 64 + ((((chunk) ^ (((col) >> 2) & 3))) << 4))
#define MF8(A, B, C) mf8x<ABL>(A, B, C)
#define CAT8(lo, hi) __builtin_shufflevector(lo, hi, 0, 1, 2, 3, 4, 5, 6, 7)
#define LDS16(p) ((ABL & 8) ? __builtin_shufflevector(qr8[0], qr8[1], 0, 1, 10, 11) : *(const LAS i32x4a*)(p))
template <int A, int B, int ABL = 0> __device__ __forceinline__ void exp_rng(f32x16& p) {
#pragma unroll
  for (int r = A; r < B; ++r) p[r] = (ABL & 1) ? p[r] * p[r] : __builtin_amdgcn_exp2f(p[r]);
}
template <int ABL> __device__ __forceinline__ f32x16 mf8x(const i32x8a a, const i32x8a b, f32x16 c) {
  if constexpr (ABL & 2) { c[0] += __int_as_float(((a[0] ^ a[4]) + (b[0] ^ b[4])) & 0x3f000000); return c; }
  else return __builtin_amdgcn_mfma_scale_f32_32x32x64_f8f6f4(a, b, c, 0, 0, 0, 0x7F7F7F7F, 0, 0x7F7F7F7F);
}
__device__ __forceinline__ void pk_fma16(f32x16& p, float c, float d) { const f32x2 c2 = {c, c}, d2 = {d, d};
#pragma unroll
  for (int i = 0; i < 8; ++i) { f32x2 v = {p[2 * i], p[2 * i + 1]}; v = v * c2 + d2; p[2 * i] = v.x; p[2 * i + 1] = v.y; }
}
__device__ __forceinline__ void pk_mul16(f32x16& p, float c) { const f32x2 c2 = {c, c};
#pragma unroll
  for (int i = 0; i < 8; ++i) { f32x2 v = {p[2 * i], p[2 * i + 1]}; v = v * c2; p[2 * i] = v.x; p[2 * i + 1] = v.y; }
}
__device__ __forceinline__ float pk_sum32(const f32x16& p0, const f32x16& p1) { f32x2 s0 = {p0[0], p0[1]}, s1 = {p1[0], p1[1]};
#pragma unroll
  for (int i = 1; i < 8; ++i) { s0 += (f32x2){p0[2 * i], p0[2 * i + 1]}; s1 += (f32x2){p1[2 * i], p1[2 * i + 1]}; }
  s0 += s1; return s0.x + s0.y;
}
__device__ __forceinline__ float hsum(float v) { auto rr = __builtin_amdgcn_permlane32_swap(__float_as_uint(v), __float_as_uint(v), false, false); return __uint_as_float(rr[0]) + __uint_as_float(rr[1]); }
__device__ __forceinline__ float hmax(float v) { auto rr = __builtin_amdgcn_permlane32_swap(__float_as_uint(v), __float_as_uint(v), false, false); return fmaxf(__uint_as_float(rr[0]), __uint_as_float(rr[1])); }
template <int NDV, int SC, int ABL>
__device__ __forceinline__ void attn_body(const unsigned char* __restrict__ Qb, const unsigned char* __restrict__ Kh, const unsigned char* __restrict__ Vt,
                                          unsigned char* __restrict__ Ob, int seq, LAS unsigned char* lds, const int tid) {
  constexpr int ldo = 2048; constexpr float C = Scale<SC>::C, thr_raw = Scale<SC>::THRR;
  const int wid = __builtin_amdgcn_readfirstlane(tid >> 6), lane = tid & 63, r32 = lane & 31, hi = lane >> 5;
  LAS unsigned char* K_lds = lds; LAS unsigned char* V_lds = lds + 4 * SHM_K;
  float m_reg = -1e30f, l_reg = 0; f32x16 o[NDV] = {}; i32x8a qr8[2];
  const unsigned char* Qw = Qb + (long)(wid * QBLK + r32) * 128 + hi * 32;
#pragma unroll
  for (int blk = 0; blk < 2; ++blk) { const i32x4a lo_ = *reinterpret_cast<const i32x4a*>(Qw + blk * 64), hi_ = *reinterpret_cast<const i32x4a*>(Qw + blk * 64 + 16); qr8[blk] = CAT8(lo_, hi_); }
  const int NT = seq / KVBLK;
  const int kr8 = 8 * wid + (lane >> 3), vcol = 16 * (wid & (NDV * 2 - 1)) + (lane >> 2);
  const unsigned char* kgp = Kh + (long)kr8 * 128 + (((lane & 7) ^ ((kr8 >> 1) & 7)) << 4);
  const unsigned char* vgp = Vt + (long)vcol * TT + (((lane & 3) ^ ((vcol >> 2) & 3)) << 4);
  const int kdo = wid * 1024, vdo = (wid & (NDV * 2 - 1)) * 1024;
  const int ka0 = KSWZ8(r32, 2 * hi), ka1 = KSWZ8(r32, 2 * hi + 1), va0 = VSWZ8(r32, 2 * hi), va1 = VSWZ8(r32, 2 * hi + 1);
#define DMAK(t, bo) do { const int t_ = (t) < NT ? (t) : NT - 1; __builtin_amdgcn_global_load_lds((const unsigned*)(kgp + (long)t_ * (KVBLK * 128)), (LAS unsigned*)(K_lds + (bo) + kdo), 16, 0, 0); } while (0)
#define DMAV(t, bo) do { const int t_ = (t) < NT ? (t) : NT - 1; __builtin_amdgcn_global_load_lds((const unsigned*)(vgp + t_ * KVBLK), (LAS unsigned*)(V_lds + (bo) + vdo), 16, 0, 0); } while (0)
#define VMW(n) asm volatile("s_waitcnt vmcnt(" #n ")" ::: "memory")
#define BAR() __builtin_amdgcn_s_barrier()
  f32x16 pA0, pA1, pB0, pB1; float alA, alB; i32x8a pa;
#define PSM_MAX(p0, p1, al, mnC) do { float pm_ = fmaxf(p0[0], p1[0]);                                                                  \
    _Pragma("unroll") for (int r = 1; r < 16; ++r) pm_ = fmaxf(fmaxf(pm_, p0[r]), p1[r]);                                               \
    pm_ = hmax(pm_);                                                                                                                     \
    const bool keep_ = __all(pm_ - m_reg <= thr_raw); const float mn_ = keep_ ? m_reg : fmaxf(m_reg, pm_);                               \
    al = __builtin_amdgcn_exp2f((m_reg - mn_) * C); m_reg = mn_; mnC = PSH - mn_ * C; } while (0)
#define PT3(x, y, z) asm volatile("" : "+v"(x), "+v"(y), "+v"(z))
#define PT4(x, y, z, w) asm volatile("" : "+v"(x), "+v"(y), "+v"(z), "+v"(w))
#define STEP(j, pc0, pc1, alc, pn0, pn1, aln) do { const LAS unsigned char* Kr_ = K_lds + kb_rd; const LAS unsigned char* Vs_ = V_lds + vb_rd; float mnC_;  \
    i32x8a kc_ = CAT8(LDS16(Kr_ + (ka0 ^ 64)), LDS16(Kr_ + (ka1 ^ 64))), kd_ = CAT8(LDS16(Kr_ + 4096 + (ka0 ^ 64)), LDS16(Kr_ + 4096 + (ka1 ^ 64))); \
    pn0 = MF8(kpa, qr8[0], (f32x16){}); exp_rng<0, 6, ABL>(pc1); PT3(pn0, pc1, kpb);                                                     \
    pn1 = MF8(kpb, qr8[0], (f32x16){}); exp_rng<6, 12, ABL>(pc1); PT3(pn1, pc1, kc_);                                                    \
    pn0 = MF8(kc_, qr8[1], pn0); exp_rng<12, 16, ABL>(pc1);                                                                              \
    { float ps_ = pk_sum32(pc0, pc1); ps_ = hsum(ps_); l_reg = l_reg * alc + ps_; }                                                      \
    i32x8a va_ = CAT8(LDS16(Vs_ + va0), LDS16(Vs_ + va1)), vb_ = CAT8(LDS16(Vs_ + 2048 + va0), LDS16(Vs_ + 2048 + va1));                  \
    PT4(pn0, pc1, kd_, l_reg);                                                                                                           \
    pn1 = MF8(kd_, qr8[1], pn1);                                                                                                         \
    _Pragma("unroll") for (int q = 0; q < 4; ++q) { pa[q] = (int)pk4_fp8(pc0[4 * q], pc0[4 * q + 1], pc0[4 * q + 2], pc0[4 * q + 3]); pa[4 + q] = (int)pk4_fp8(pc1[4 * q], pc1[4 * q + 1], pc1[4 * q + 2], pc1[4 * q + 3]); } \
    PT3(pn1, pa, va_);                                                                                                                   \
    if constexpr (!(ABL & 128)) { DMAK((j) + 4, kb_wr); DMAV((j) + 2, vb_wr); }                                                          \
    o[0] = MF8(va_, pa, o[0]); PSM_MAX(pn0, pn1, aln, mnC_); PT4(o[0], pn0, vb_, mnC_);                                                  \
    o[1] = MF8(vb_, pa, o[1]); pk_fma16(pn0, C, mnC_); pk_fma16(pn1, C, mnC_); exp_rng<0, 4, ABL>(pn0);                                   \
    if constexpr (NDV == 4) { i32x8a vc_ = CAT8(LDS16(Vs_ + 4096 + va0), LDS16(Vs_ + 4096 + va1)), vd_ = CAT8(LDS16(Vs_ + 6144 + va0), LDS16(Vs_ + 6144 + va1)); \
      PT4(o[1], pn0, pn1, vc_); o[2] = MF8(vc_, pa, o[2]); exp_rng<4, 10, ABL>(pn0); PT3(o[2], pn0, vd_);                                \
      o[3] = MF8(vd_, pa, o[3]); exp_rng<10, 16, ABL>(pn0); }                                                                            \
    else { PT3(o[1], pn0, pn1); exp_rng<4, 16, ABL>(pn0); }                                                                              \
    { const LAS unsigned char* Kp_ = K_lds + kb_pf; kpa = CAT8(LDS16(Kp_ + ka0), LDS16(Kp_ + ka1)); kpb = CAT8(LDS16(Kp_ + 4096 + ka0), LDS16(Kp_ + 4096 + ka1)); } \
    PT3(o[NDV - 1], pn0, pn1); RESC(aln);                                                                                               \
    { const int t_ = kb_rd; kb_rd = kb_pf; kb_pf = kb_x; kb_x = kb_wr; kb_wr = t_; const int u_ = vb_rd; vb_rd = vb_n1; vb_n1 = vb_wr; vb_wr = u_; } \
    VMW(2); if constexpr (!(ABL & 4)) BAR(); } while (0)
#define RESC(a) do { if (__any((a) < 1.f)) { _Pragma("unroll") for (int d = 0; d < NDV; ++d) pk_mul16(o[d], (a)); } } while (0)
  i32x8a kpa, kpb; int kb_rd = SHM_K, kb_pf = 2 * SHM_K, kb_x = 3 * SHM_K, kb_wr = 0, vb_rd = 0, vb_n1 = SHM_V, vb_wr = 2 * SHM_V;
  DMAK(0, 0); DMAK(1, SHM_K); DMAK(2, 2 * SHM_K); DMAK(3, 3 * SHM_K); DMAV(0, 0); DMAV(1, SHM_V); VMW(0); BAR();
  { const LAS unsigned char* Ks_ = K_lds; float mnC_;
    pA0 = MF8(CAT8(LDS16(Ks_ + ka0), LDS16(Ks_ + ka1)), qr8[0], (f32x16){}); pA1 = MF8(CAT8(LDS16(Ks_ + 4096 + ka0), LDS16(Ks_ + 4096 + ka1)), qr8[0], (f32x16){});
    pA0 = MF8(CAT8(LDS16(Ks_ + (ka0 ^ 64)), LDS16(Ks_ + (ka1 ^ 64))), qr8[1], pA0); pA1 = MF8(CAT8(LDS16(Ks_ + 4096 + (ka0 ^ 64)), LDS16(Ks_ + 4096 + (ka1 ^ 64))), qr8[1], pA1);
    PSM_MAX(pA0, pA1, alA, mnC_); pk_fma16(pA0, C, mnC_); pk_fma16(pA1, C, mnC_); exp_rng<0, 16, ABL>(pA0);
    const LAS unsigned char* Kp_ = K_lds + SHM_K; kpa = CAT8(LDS16(Kp_ + ka0), LDS16(Kp_ + ka1)); kpb = CAT8(LDS16(Kp_ + 4096 + ka0), LDS16(Kp_ + 4096 + ka1)); }
  asm volatile("s_waitcnt lgkmcnt(0)" ::: "memory"); BAR();
  int j = 0;
  for (; j + 2 < NT; j += 2) { STEP(j, pA0, pA1, alA, pB0, pB1, alB); STEP(j + 1, pB0, pB1, alB, pA0, pA1, alA); }
  STEP(j, pA0, pA1, alA, pB0, pB1, alB);
  { exp_rng<0, 16, ABL>(pB1); float ps_ = pk_sum32(pB0, pB1); ps_ = hsum(ps_); l_reg = l_reg * alB + ps_;
#pragma unroll
    for (int q = 0; q < 4; ++q) { pa[q] = (int)pk4_fp8(pB0[4 * q], pB0[4 * q + 1], pB0[4 * q + 2], pB0[4 * q + 3]); pa[4 + q] = (int)pk4_fp8(pB1[4 * q], pB1[4 * q + 1], pB1[4 * q + 2], pB1[4 * q + 3]); }
    const LAS unsigned char* Vs_ = V_lds + vb_rd;
#pragma unroll
    for (int d0 = 0; d0 < NDV; ++d0) o[d0] = MF8(CAT8(LDS16(Vs_ + d0 * 2048 + va0), LDS16(Vs_ + d0 * 2048 + va1)), pa, o[d0]); }
  const float rl = __builtin_amdgcn_rcpf(l_reg) * 16.f;
  unsigned char* Ow = Ob + (long)(wid * QBLK + r32) * ldo + 4 * hi;
#pragma unroll
  for (int d0 = 0; d0 < NDV; ++d0)
#pragma unroll
    for (int g = 0; g < 4; ++g) *(unsigned*)(Ow + d0 * 32 + 8 * g) = pk4_fp8(clamp8(o[d0][4 * g] * rl), clamp8(o[d0][4 * g + 1] * rl), clamp8(o[d0][4 * g + 2] * rl), clamp8(o[d0][4 * g + 3] * rl));
#undef DMAK
#undef DMAV
#undef VMW
#undef BAR
#undef PSM_MAX
#undef REGION_X
#undef REGION_Y
#undef RESC
#undef STEP
#undef PT3
#undef PT4
}
}
__device__ __forceinline__ float* xres_row(const Frame& F, int row) { return row < NLAT ? F.out + (size_t)row * D : wsp<float>(F, WS_XC) + (size_t)(row - NLAT) * D; }
__device__ __forceinline__ void ln_row(float (&y)[32], const float* g, const float* b, int lane) {
    float s = 0.f;
#pragma unroll
    for (int i = 0; i < 32; ++i) s += y[i];
    const float mu = wave_sum(s) * (1.f / 2048.f);
    float q = 0.f;
#pragma unroll
    for (int i = 0; i < 32; ++i) { const float d = y[i] - mu; q += d * d; }
    const float rstd = rsqrtf(wave_sum(q) * (1.f / 2048.f) + LN_EPS);
#pragma unroll
    for (int qq = 0; qq < 4; ++qq) { const f32x4 g0 = *(const f32x4*)(g + 512 * qq + 8 * lane), g1 = *(const f32x4*)(g + 512 * qq + 8 * lane + 4), b0 = *(const f32x4*)(b + 512 * qq + 8 * lane), b1 = *(const f32x4*)(b + 512 * qq + 8 * lane + 4);
#pragma unroll
        for (int i = 0; i < 4; ++i) { y[qq * 8 + i] = (y[qq * 8 + i] - mu) * rstd * g0[i] + b0[i]; y[qq * 8 + 4 + i] = (y[qq * 8 + 4 + i] - mu) * rstd * g1[i] + b1[i]; } }
}
__device__ __forceinline__ void modulate_store(const float (&x)[32], const float* sh, const float* sc, bf16_t* dst, int lane) {
#pragma unroll
    for (int q = 0; q < 4; ++q) { const f32x4 h0 = *(const f32x4*)(sh + 512 * q + 8 * lane), h1 = *(const f32x4*)(sh + 512 * q + 8 * lane + 4), c0 = *(const f32x4*)(sc + 512 * q + 8 * lane), c1 = *(const f32x4*)(sc + 512 * q + 8 * lane + 4);
        f32x4 a, b;
#pragma unroll
        for (int i = 0; i < 4; ++i) { a[i] = x[q * 8 + i] * (1.f + c0[i]) + h0[i]; b[i] = x[q * 8 + 4 + i] * (1.f + c1[i]) + h1[i]; }
        *(u32x4*)(dst + 512 * q + 8 * lane) = pack8(a, b); }
}
__device__ __forceinline__ void p_ln1(const Frame& F, int l, bool last) {
    const float* mod = wsp<float>(F, WS_MOD) + (size_t)l * 5 * 12288; bf16_t* hb = wsp<bf16_t>(F, WS_HB);
    const float* g = F.in(18) + l * D; const float* b = F.in(19) + l * D;
    const int nrows = last ? NLAT : NROW; const int lane = F.lane, step = F.G * 8;
    float gg[32], bb[32]; ld_row_f32(g, lane, gg); ld_row_f32(b, lane, bb);
    int row = F.bid * 8 + F.wave;
    float yn[32];
    if (row < nrows) ld_row_f32(xres_row(F, row), lane, yn);
#pragma unroll 1
    for (; row < nrows; row += step) {
        const int v = row < NLAT ? (row >> 12) : 4; float* xp = xres_row(F, row);
        float y[32], sh[32], sc[32];
#pragma unroll
        for (int i = 0; i < 32; ++i) y[i] = yn[i];
        ld_row_f32(mod + (size_t)v * 12288 + 6144, lane, sh); ld_row_f32(mod + (size_t)v * 12288 + 8192, lane, sc);
        { const int nrow = row + step; if (nrow < nrows) ld_row_f32(xres_row(F, nrow), lane, yn); }
        float s = 0.f;
#pragma unroll
        for (int i = 0; i < 32; ++i) s += y[i];
        const float mu = wave_sum(s) * (1.f / 2048.f); float q = 0.f;
#pragma unroll
        for (int i = 0; i < 32; ++i) { const float d = y[i] - mu; q += d * d; }
        const float rstd = rsqrtf(wave_sum(q) * (1.f / 2048.f) + LN_EPS);
#pragma unroll
        for (int i = 0; i < 32; ++i) y[i] = (y[i] - mu) * rstd * gg[i] + bb[i];
        st_row_f32(xp, lane, y);
#pragma unroll
        for (int i = 0; i < 32; ++i) y[i] = y[i] * (1.f + sc[i]) + sh[i];
        st_row_bf16(hb + (size_t)row * D, lane, y);
    }
}

template <int NV>
__device__ __forceinline__ void top16(const float (&val)[NV], bool (&sel)[NV], int (&slot)[NV]) {
    unsigned key[NV];
#pragma unroll
    for (int v = 0; v < NV; ++v) { const unsigned u = __float_as_uint(val[v]); key[v] = (u & 0x80000000u) ? ~u : (u | 0x80000000u); }
    unsigned T = 0u;
#pragma unroll 1
    for (int bit = 31; bit >= 0; --bit) {
        const unsigned cand = T | (1u << bit); int cnt = 0;
#pragma unroll
        for (int v = 0; v < NV; ++v) cnt += __popcll(__ballot(key[v] >= cand));
        if (cnt >= 16) T = cand;
    }
    int ngt = 0;
#pragma unroll
    for (int v = 0; v < NV; ++v) ngt += __popcll(__ballot(key[v] > T));
    const int need = 16 - ngt;
    int run = 0, erun = 0;
#pragma unroll
    for (int v = 0; v < NV; ++v) {
        const unsigned long long mg = __ballot(key[v] > T), me = __ballot(key[v] == T);
        const int pg = __builtin_amdgcn_mbcnt_hi((unsigned)(mg >> 32), __builtin_amdgcn_mbcnt_lo((unsigned)mg, 0u));
        const int pe = __builtin_amdgcn_mbcnt_hi((unsigned)(me >> 32), __builtin_amdgcn_mbcnt_lo((unsigned)me, 0u));
        sel[v] = false; slot[v] = 0;
        if (key[v] > T) { sel[v] = true; slot[v] = run + pg; }
        else if (key[v] == T && (erun + pe) < need) { sel[v] = true; slot[v] = ngt + erun + pe; }
        run += __popcll(mg); erun += __popcll(me);
    }
}
__device__ __forceinline__ unsigned f2key(float f) { const unsigned u = __float_as_uint(f); return (u & 0x80000000u) ? ~u : (u | 0x80000000u); }
__device__ __forceinline__ float key2f(unsigned k) { return __uint_as_float((k & 0x80000000u) ? (k & 0x7fffffffu) : ~k); }
template <int NP, int NV>
__device__ __forceinline__ void bisect16(const unsigned (&key)[NP][NV], unsigned (&T)[NP]) {
    bool done[NP];
#pragma unroll
    for (int p = 0; p < NP; ++p) { T[p] = 0u; done[p] = false; }
#pragma unroll 1
    for (int bit = 31; bit >= 0; --bit) {
        const unsigned bm = 1u << bit; bool all = true;
#pragma unroll
        for (int p = 0; p < NP; ++p) {
            const unsigned cand = T[p] | bm; int cnt = 0;
#pragma unroll
            for (int v = 0; v < NV; ++v) cnt += __popcll(__ballot(key[p][v] >= cand));
            const bool upd = (cnt >= 16) && !done[p];
            T[p] = upd ? cand : T[p]; done[p] = done[p] || (cnt == 16); all = all && done[p];
        }
        if (all) break;
    }
}
template <int NV>
__device__ __forceinline__ void compact16(const unsigned (&key)[NV], const unsigned T, bool (&sel)[NV], int (&slot)[NV]) {
    int ngt = 0;
#pragma unroll
    for (int v = 0; v < NV; ++v) ngt += __popcll(__ballot(key[v] > T));
    const int need = 16 - ngt; int run = 0, erun = 0;
#pragma unroll
    for (int v = 0; v < NV; ++v) {
        const unsigned long long mg = __ballot(key[v] > T), me = __ballot(key[v] == T);
        const int pg = __builtin_amdgcn_mbcnt_hi((unsigned)(mg >> 32), __builtin_amdgcn_mbcnt_lo((unsigned)mg, 0u));
        const int pe = __builtin_amdgcn_mbcnt_hi((unsigned)(me >> 32), __builtin_amdgcn_mbcnt_lo((unsigned)me, 0u));
        sel[v] = false; slot[v] = 0;
        if (key[v] > T) { sel[v] = true; slot[v] = run + pg; }
        else if (key[v] == T && (erun + pe) < need) { sel[v] = true; slot[v] = ngt + erun + pe; }
        run += __popcll(mg); erun += __popcll(me);
    }
}
constexpr int KP = 68;
constexpr int PW_BYTES = 9344;
__device__ __forceinline__ float gelu_erf(float x) {
    const float z = fabsf(x) * 0.7071067811865476f; const float t = __builtin_amdgcn_rcpf(1.f + 0.3275911f * z);
    float p = 1.061405429f; p = p * t - 1.453152027f; p = p * t + 1.421413741f; p = p * t - 0.284496736f; p = p * t + 0.254829592f; p = p * t;
    const float er = 1.f - p * __expf(-z * z);
    return 0.5f * x * (1.f + (x < 0.f ? -er : er));
}
__device__ __forceinline__ float wave_max(float x) {
    x = row16_max(x);
    { auto r = __builtin_amdgcn_permlane16_swap(__float_as_uint(x), __float_as_uint(x), false, false); x = fmaxf(__uint_as_float(r[0]), __uint_as_float(r[1])); }
    { auto r = __builtin_amdgcn_permlane32_swap(__float_as_uint(x), __float_as_uint(x), false, false); x = fmaxf(__uint_as_float(r[0]), __uint_as_float(r[1])); }
    return x;
}
__device__ __forceinline__ void ld16_f32(const float* p, int lane, float (&x)[32]) {
#pragma unroll
    for (int q = 0; q < 2; ++q)
#pragma unroll
        for (int d = 0; d < 4; ++d) { const f32x4 a = *(const f32x4*)(p + 1024 * q + 16 * lane + 4 * d); x[q * 16 + d * 4 + 0] = a[0]; x[q * 16 + d * 4 + 1] = a[1]; x[q * 16 + d * 4 + 2] = a[2]; x[q * 16 + d * 4 + 3] = a[3]; }
}
__device__ __forceinline__ void ld16_f32_nt(const float* p, int lane, float (&x)[32]) {
#pragma unroll
    for (int q = 0; q < 2; ++q)
#pragma unroll
        for (int d = 0; d < 4; ++d) { const f32x4 a = __builtin_nontemporal_load((const f32x4*)(p + 1024 * q + 16 * lane + 4 * d)); x[q * 16 + d * 4 + 0] = a[0]; x[q * 16 + d * 4 + 1] = a[1]; x[q * 16 + d * 4 + 2] = a[2]; x[q * 16 + d * 4 + 3] = a[3]; }
}
__device__ __forceinline__ void st16_f32_nt(float* p, int lane, const float (&x)[32]) {
#pragma unroll
    for (int q = 0; q < 2; ++q)
#pragma unroll
        for (int d = 0; d < 4; ++d) __builtin_nontemporal_store((f32x4){x[q * 16 + d * 4 + 0], x[q * 16 + d * 4 + 1], x[q * 16 + d * 4 + 2], x[q * 16 + d * 4 + 3]}, (f32x4*)(p + 1024 * q + 16 * lane + 4 * d));
}
__device__ __forceinline__ void st16_f32(float* p, int lane, const float (&x)[32]) {
#pragma unroll
    for (int q = 0; q < 2; ++q)
#pragma unroll
        for (int d = 0; d < 4; ++d) *(f32x4*)(p + 1024 * q + 16 * lane + 4 * d) = (f32x4){x[q * 16 + d * 4 + 0], x[q * 16 + d * 4 + 1], x[q * 16 + d * 4 + 2], x[q * 16 + d * 4 + 3]};
}
__device__ __forceinline__ void ld16_bf16(const bf16_t* p, int lane, float (&x)[32]) {
#pragma unroll
    for (int q = 0; q < 2; ++q)
#pragma unroll
        for (int d = 0; d < 2; ++d) { const u32x4 w = *(const u32x4*)(p + 1024 * q + 16 * lane + 8 * d); float* o = &x[q * 16 + d * 8];
            o[0] = bflo(w.x); o[1] = bfhi(w.x); o[2] = bflo(w.y); o[3] = bfhi(w.y); o[4] = bflo(w.z); o[5] = bfhi(w.z); o[6] = bflo(w.w); o[7] = bfhi(w.w); }
}
__device__ __forceinline__ void st16_bf16(bf16_t* p, int lane, const float (&x)[32]) {
#pragma unroll
    for (int q = 0; q < 2; ++q)
#pragma unroll
        for (int d = 0; d < 2; ++d) { const float* o = &x[q * 16 + d * 8]; u32x4 w; w.x = cvt_pk_bf16(o[0], o[1]); w.y = cvt_pk_bf16(o[2], o[3]); w.z = cvt_pk_bf16(o[4], o[5]); w.w = cvt_pk_bf16(o[6], o[7]);
            *(u32x4*)(p + 1024 * q + 16 * lane + 8 * d) = w; }
}
constexpr int TBS = 1152;
__device__ __forceinline__ void cvt_row_fp4b(int lane, const float* __restrict__ src, unsigned char* __restrict__ dst) {
    float x[32];
#pragma unroll
    for (int q = 0; q < 2; ++q)
#pragma unroll
        for (int d = 0; d < 4; ++d) { const f32x4 a = __builtin_nontemporal_load((const f32x4*)(src + 1024 * q + 16 * lane + 4 * d)); x[q * 16 + d * 4 + 0] = a[0]; x[q * 16 + d * 4 + 1] = a[1]; x[q * 16 + d * 4 + 2] = a[2]; x[q * 16 + d * 4 + 3] = a[3]; }
    float am = 0.f;
#pragma unroll
    for (int i = 0; i < 32; ++i) am = fmaxf(am, fabsf(x[i]));
    const bf16_t sb = f2bf(am * (1.f / 6.f)); const float sf = bf2f(sb); const float sc = sf > 0.f ? 1.f / sf : 0.f;
    u32x4 w;
#pragma unroll
    for (int d = 0; d < 4; ++d) { unsigned t = 0u; const int o = (d >> 1) * 16 + (d & 1) * 8;
        t = __builtin_amdgcn_cvt_scalef32_pk_fp4_f32(t, x[o + 0] * sc, x[o + 1] * sc, 1.0f, 0); t = __builtin_amdgcn_cvt_scalef32_pk_fp4_f32(t, x[o + 2] * sc, x[o + 3] * sc, 1.0f, 1);
        t = __builtin_amdgcn_cvt_scalef32_pk_fp4_f32(t, x[o + 4] * sc, x[o + 5] * sc, 1.0f, 2); t = __builtin_amdgcn_cvt_scalef32_pk_fp4_f32(t, x[o + 6] * sc, x[o + 7] * sc, 1.0f, 3); w[d] = t; }
    *(u32x4*)(dst + 16 * lane) = w;
    *(bf16_t*)(dst + 1024 + 2 * lane) = sb;
}
__device__ __forceinline__ void cvt_row_fp4r(int lane, const float* __restrict__ src, unsigned char* __restrict__ dst, float* __restrict__ inv) {
    float x[32];
#pragma unroll
    for (int q = 0; q < 2; ++q)
#pragma unroll
        for (int d = 0; d < 4; ++d) { const f32x4 a = __builtin_nontemporal_load((const f32x4*)(src + 1024 * q + 16 * lane + 4 * d)); x[q * 16 + d * 4 + 0] = a[0]; x[q * 16 + d * 4 + 1] = a[1]; x[q * 16 + d * 4 + 2] = a[2]; x[q * 16 + d * 4 + 3] = a[3]; }
    float am = 0.f;
#pragma unroll
    for (int i = 0; i < 32; ++i) am = fmaxf(am, fabsf(x[i]));
    am = wave_max(am);
    const float sc = am > 0.f ? 6.f / am : 1.f;
    if (lane == 0) *inv = am > 0.f ? am * (1.f / 6.f) : 1.f;
    u32x4 w;
#pragma unroll
    for (int d = 0; d < 4; ++d) { unsigned t = 0u; const int o = (d >> 1) * 16 + (d & 1) * 8;
        t = __builtin_amdgcn_cvt_scalef32_pk_fp4_f32(t, x[o + 0] * sc, x[o + 1] * sc, 1.0f, 0); t = __builtin_amdgcn_cvt_scalef32_pk_fp4_f32(t, x[o + 2] * sc, x[o + 3] * sc, 1.0f, 1);
        t = __builtin_amdgcn_cvt_scalef32_pk_fp4_f32(t, x[o + 4] * sc, x[o + 5] * sc, 1.0f, 2); t = __builtin_amdgcn_cvt_scalef32_pk_fp4_f32(t, x[o + 6] * sc, x[o + 7] * sc, 1.0f, 3); w[d] = t; }
    *(u32x4*)(dst + 16 * lane) = w;
}
__device__ __forceinline__ void cvt_peer(const Frame& F, int l) {
    for (int r = F.bid * 8 + F.wave; r < 16384; r += F.G * 8) cvt_row_fp4b(F.lane, F.in(23) + ((size_t)l * 16384 + r) * 2048, wsp<unsigned char>(F, WS_PU) + (size_t)l * SZ_PT + (size_t)r * TBS);
    for (int r = F.bid * 8 + F.wave; r < 16384; r += F.G * 8) cvt_row_fp4b(F.lane, F.in(24) + ((size_t)l * 16384 + r) * 2048, wsp<unsigned char>(F, WS_PV) + (size_t)l * SZ_PT + (size_t)r * TBS);
}
#define PEER_G 4
template <int CTRL> __device__ __forceinline__ int dppi(int x) { return __builtin_amdgcn_update_dpp(0, x, CTRL, 0xF, 0xF, true); }
__device__ __forceinline__ int irow16_sum(int x) { x += dppi<0xB1>(x); x += dppi<0x4E>(x); x += dppi<0x141>(x); x += dppi<0x140>(x); return x; }
__device__ __forceinline__ int irow16_incl_scan(int x) { x += dppi<0x111>(x); x += dppi<0x112>(x); x += dppi<0x114>(x); x += dppi<0x118>(x); return x; }
constexpr int KBP = 72;
constexpr int PT_WORDS = 6 * 128 + 160 + 3 * 128;
constexpr int PWB = 2 * PT_WORDS * 4;
__device__ __forceinline__ void p_peer(const Frame& F, int l, bool last) {
    LAS bf16_t* kb1 = (LAS bf16_t*)F.lds; LAS bf16_t* kb2 = kb1 + 128 * KBP;
    LAS unsigned* wbase = (LAS unsigned*)(F.lds + 2 * 128 * KBP * 2 + F.wave * PWB);
    const int lane = F.lane, fr = lane & 15, fq = lane >> 4;
    __syncthreads();
    for (int i = F.tid; i < 128 * 64; i += 512) { const int r = i >> 6, d = i & 63; kb1[r * KBP + d] = f2bf(F.in(21)[(size_t)l * 8192 + i]); kb2[r * KBP + d] = f2bf(F.in(22)[(size_t)l * 8192 + i]); }
    __syncthreads();
    const bf16_t* QP = wsp<bf16_t>(F, WS_QP); const bf16_t* HB = wsp<bf16_t>(F, WS_HB); unsigned char* HB8w = wsp<unsigned char>(F, WS_HB8);
    const unsigned char* PU = wsp<unsigned char>(F, WS_PU) + (size_t)l * SZ_PT; const unsigned char* PV = wsp<unsigned char>(F, WS_PV) + (size_t)l * SZ_PT;
    const float* modl = wsp<float>(F, WS_MOD) + (size_t)l * 5 * 12288; const float* modn = wsp<float>(F, WS_MOD) + (size_t)(l + 1) * 5 * 12288;
    const float* g2n = F.in(25) + l * D; const float* b2n = F.in(26) + l * D;
    const int npairs = (last ? NLAT : NROW) / 2;
    const int per_wg = (npairs + F.G - 1) / F.G; const int p_lo = F.bid * per_wg; const int p_hi = (p_lo + per_wg) < npairs ? (p_lo + per_wg) : npairs;
    LAS int* wq = (LAS int*)(F.lds + 147456 - 32);
    if (F.tid == 0) *wq = 0;
    __syncthreads();
#pragma unroll 1
    for (;;) {
        int pi = 0; if (lane == 0) pi = __hip_atomic_fetch_add(wq, 1, __ATOMIC_RELAXED, __HIP_MEMORY_SCOPE_WORKGROUP);
        pi = p_lo + __builtin_amdgcn_readfirstlane(pi); if (pi >= p_hi) break;
        const int rowA = 2 * pi;
#pragma unroll 1
        for (int rep1_ = 0; rep1_ <= REP_PS1; ++rep1_) {
            unsigned kk[2][8][4];
            { int fr_ = fr; asm volatile("" : "+v"(fr_));
              const bf16_t* qrow = QP + (size_t)(rowA + (fr_ >> 3)) * 1024 + (fr_ & 7) * 128 + 8 * fq;
              bf16x8 af[2][2];
#pragma unroll
              for (int st = 0; st < 2; ++st)
#pragma unroll
                  for (int ks = 0; ks < 2; ++ks) af[st][ks] = *(const bf16x8*)(qrow + st * 64 + ks * 32);
#pragma unroll
              for (int st = 0; st < 2; ++st) { LAS bf16_t* kb = st ? kb2 : kb1;
#pragma unroll
                  for (int nb = 0; nb < 8; ++nb) { f32x4 c = {0.f, 0.f, 0.f, 0.f};
#pragma unroll
                      for (int ks = 0; ks < 2; ++ks) { const bf16x8 bfr = *(const LAS bf16x8*)(kb + (nb * 16 + fr) * KBP + ks * 32 + 8 * fq); c = __builtin_amdgcn_mfma_f32_16x16x32_bf16(af[st][ks], bfr, c, 0, 0, 0); }
#pragma unroll
                      for (int r = 0; r < 4; ++r) kk[st][nb][r] = f2key(c[r]); } } }
            unsigned T[2][4]; bool done[2][4];
#pragma unroll
            for (int st = 0; st < 2; ++st)
#pragma unroll
                for (int r = 0; r < 4; ++r) { T[st][r] = 0u; done[st][r] = false; }
#pragma unroll 1
            for (int bit = 31; bit >= 0; --bit) { const unsigned bm = 1u << bit; bool alld = true;
#pragma unroll
                for (int st = 0; st < 2; ++st)
#pragma unroll
                    for (int r = 0; r < 4; ++r) { const unsigned cand = T[st][r] | bm; int c = 0;
#pragma unroll
                        for (int nb = 0; nb < 8; ++nb) c += (kk[st][nb][r] >= cand) ? 1 : 0;
                        c = irow16_sum(c);
                        const bool upd = (c >= 16) && !done[st][r]; T[st][r] = upd ? cand : T[st][r]; done[st][r] = done[st][r] || (c == 16); alld = alld && done[st][r]; }
                if (__all(alld)) break; }
            const int tt = lane >> 5, hd0 = ((lane >> 4) & 1) * 4;
#pragma unroll
            for (int st = 0; st < 2; ++st)
#pragma unroll
                for (int r = 0; r < 4; ++r) { const unsigned Tr = T[st][r]; int g = 0, e = 0;
#pragma unroll
                    for (int nb = 0; nb < 8; ++nb) { g += (kk[st][nb][r] > Tr) ? 1 : 0; e += (kk[st][nb][r] == Tr) ? 1 : 0; }
                    int gpre = irow16_incl_scan(g) - g, epre = irow16_incl_scan(e) - e; const int ngt = irow16_sum(g); const int need = 16 - ngt;
                    LAS unsigned* tb = wbase + tt * PT_WORDS; LAS float* vl = (LAS float*)(tb + st * 128) + (hd0 + r) * 16; LAS int* il = (LAS int*)(tb + 256 + st * 128) + (hd0 + r) * 16;
#pragma unroll
                    for (int nb = 0; nb < 8; ++nb) { const unsigned k = kk[st][nb][r];
                        if (k > Tr) { vl[gpre] = key2f(k); il[gpre] = nb * 16 + fr; ++gpre; }
                        else if (k == Tr) { if (epre < need) { vl[ngt + epre] = key2f(k); il[ngt + epre] = nb * 16 + fr; } ++epre; } } }
        }
        asm volatile("s_waitcnt lgkmcnt(0)" ::: "memory");
        {
            const int tt = lane >> 5, hd0 = ((lane >> 4) & 1) * 4; LAS unsigned* tb = wbase + tt * PT_WORDS;
            unsigned ck[4][16];
#pragma unroll
            for (int r = 0; r < 4; ++r) { const float va = ((LAS float*)tb)[(hd0 + r) * 16 + fr]; const LAS float* v2p = (LAS float*)(tb + 128) + (hd0 + r) * 16;
#pragma unroll
                for (int j4 = 0; j4 < 4; ++j4) { const f32x4 vb = *(const LAS f32x4*)(v2p + j4 * 4);
#pragma unroll
                    for (int i = 0; i < 4; ++i) ck[r][j4 * 4 + i] = f2key(va + vb[i]); } }
            unsigned T[4]; bool done[4];
#pragma unroll
            for (int r = 0; r < 4; ++r) { T[r] = 0u; done[r] = false; }
#pragma unroll 1
            for (int bit = 31; bit >= 0; --bit) { const unsigned bm = 1u << bit; bool alld = true;
#pragma unroll
                for (int r = 0; r < 4; ++r) { const unsigned cand = T[r] | bm; int c = 0;
#pragma unroll
                    for (int j = 0; j < 16; ++j) c += (ck[r][j] >= cand) ? 1 : 0;
                    c = irow16_sum(c);
                    const bool upd = (c >= 16) && !done[r]; T[r] = upd ? cand : T[r]; done[r] = done[r] || (c == 16); alld = alld && done[r]; }
                if (__all(alld)) break; }
#pragma unroll
            for (int r = 0; r < 4; ++r) { const unsigned Tr = T[r]; int g = 0, e = 0;
#pragma unroll
                for (int j = 0; j < 16; ++j) { g += (ck[r][j] > Tr) ? 1 : 0; e += (ck[r][j] == Tr) ? 1 : 0; }
                int gpre = irow16_incl_scan(g) - g, epre = irow16_incl_scan(e) - e; const int ngt = irow16_sum(g); const int need = 16 - ngt;
                const int e1 = ((LAS int*)(tb + 256))[(hd0 + r) * 16 + fr] * 128; const LAS int* i2p = (LAS int*)(tb + 384) + (hd0 + r) * 16;
                LAS float* cs_ = (LAS float*)(tb + 512) + (hd0 + r) * 16; LAS int* ce_ = (LAS int*)(tb + 640) + (hd0 + r) * 16;
#pragma unroll
                for (int j = 0; j < 16; ++j) { const unsigned k = ck[r][j];
                    if (k > Tr) { cs_[gpre] = key2f(k); ce_[gpre] = e1 + i2p[j]; ++gpre; }
                    else if (k == Tr) { if (epre < need) { cs_[ngt + epre] = key2f(k); ce_[ngt + epre] = e1 + i2p[j]; } ++epre; } } }
        }
        asm volatile("s_waitcnt lgkmcnt(0)" ::: "memory");
#pragma unroll 1
      for (int t = 0; t < 2; ++t) {
        const int row = rowA + t; const int v = row < NLAT ? (row >> 12) : 4;
        LAS unsigned* tb = wbase + t * PT_WORDS;
        LAS float* v1l = (LAS float*)tb; LAS float* v2l = v1l + 128; LAS int* i1l = (LAS int*)(v2l + 128); LAS int* i2l = i1l + 128;
        LAS float* csl = (LAS float*)(i2l + 128); LAS int* cel = (LAS int*)(csl + 128); LAS int* el = cel + 128; LAS float* gl = (LAS float*)(el + 160); LAS float* su = gl + 128; LAS float* sv = su + 128;
        {
#pragma unroll
            for (int it = 0; it < 2; ++it) { const int idx = it * 64 + lane;
                const float sx = csl[idx]; const float mx = row16_max(sx); const float pe_ = __expf(sx - mx); const float sm = row16_sum(pe_);
                el[idx] = cel[idx]; gl[idx] = pe_ / sm; }
        }
        if (lane < 32) el[128 + lane] = el[0];
        asm volatile("s_waitcnt vmcnt(0) lgkmcnt(0)" ::: "memory");
        float hh[32]; ld16_bf16(HB + (size_t)row * D, lane, hh);
        f32x2 hh2[16];
#pragma unroll
        for (int i = 0; i < 16; ++i) hh2[i] = (f32x2){hh[2 * i], hh[2 * i + 1]};
        const bool b0_ = lane & 1, b1_ = lane & 2, b2_ = lane & 4;
        u32x4 A[8], B[8], C[8]; unsigned SA[8], SB[8], SC[8];
#define PEER_LOADT(buf, sbuf, tab, g) do { _Pragma("unroll") for (int x = 0; x < 8; ++x) { const int e = __builtin_amdgcn_readfirstlane(el[(g) * 8 + x]); const unsigned char* rp = (tab) + (size_t)e * TBS; \
            buf[x] = *(const u32x4*)(rp + 16 * lane); sbuf[x] = *(const bf16_t*)(rp + 1024 + 2 * lane); } } while (0)
#define PEER_LOADV(buf, g) do { _Pragma("unroll") for (int x = 0; x < 8; ++x) { const int e = __builtin_amdgcn_readfirstlane(el[(g) * 8 + x]); buf[x] = *(const u32x4*)(PV + (size_t)e * 1024 + 16 * lane); } } while (0)
#define FP4X8(w_, f0_, f1_, f2_, f3_) const f32x2 f0_ = __builtin_amdgcn_cvt_scalef32_pk_f32_fp4(w_, 1.0f, 0), f1_ = __builtin_amdgcn_cvt_scalef32_pk_f32_fp4(w_, 1.0f, 1), f2_ = __builtin_amdgcn_cvt_scalef32_pk_f32_fp4(w_, 1.0f, 2), f3_ = __builtin_amdgcn_cvt_scalef32_pk_f32_fp4(w_, 1.0f, 3)
#define PEER_DOT(buf, sbuf, g) do { float p_[8]; \
            _Pragma("unroll") for (int x = 0; x < 8; ++x) { f32x2 s2_ = {0.f, 0.f}; \
                _Pragma("unroll") for (int d = 0; d < 4; ++d) { const unsigned w_ = buf[x][d]; FP4X8(w_, f0_, f1_, f2_, f3_); const int o_ = (d >> 1) * 8 + (d & 1) * 4; \
                    s2_ = hh2[o_ + 0] * f0_ + s2_; s2_ = hh2[o_ + 1] * f1_ + s2_; s2_ = hh2[o_ + 2] * f2_ + s2_; s2_ = hh2[o_ + 3] * f3_ + s2_; } \
                p_[x] = (s2_.x + s2_.y) * __uint_as_float(sbuf[x] << 16); SBAR(); } \
              \
            float q_[4], r_[2]; \
            _Pragma("unroll") for (int j = 0; j < 4; ++j) { const float keep_ = b0_ ? p_[2 * j + 1] : p_[2 * j], send_ = b0_ ? p_[2 * j] : p_[2 * j + 1]; q_[j] = keep_ + dppf<0xB1>(send_); } \
            _Pragma("unroll") for (int j = 0; j < 2; ++j) { const float keep_ = b1_ ? q_[2 * j + 1] : q_[2 * j], send_ = b1_ ? q_[2 * j] : q_[2 * j + 1]; r_[j] = keep_ + dppf<0x4E>(send_); } \
            float t_; { const float keep_ = b2_ ? r_[1] : r_[0], send_ = b2_ ? r_[0] : r_[1]; const float up_ = dppf<0x104>(send_), dn_ = dppf<0x114>(send_); t_ = keep_ + (b2_ ? dn_ : up_); } \
            t_ += dppf<0x128>(t_); \
            { auto r16_ = __builtin_amdgcn_permlane16_swap(__float_as_uint(t_), __float_as_uint(t_), false, false); t_ = __uint_as_float(r16_[0]) + __uint_as_float(r16_[1]); } \
            { auto r32_ = __builtin_amdgcn_permlane32_swap(__float_as_uint(t_), __float_as_uint(t_), false, false); t_ = __uint_as_float(r32_[0]) + __uint_as_float(r32_[1]); } \
            const float av = gelu_erf(t_) * gl[(g) * 8 + (lane & 7)]; const bool me_ = (lane >> 3) == ((g) & 7); \
            avl = (me_ && (g) < 8) ? av : avl; avh = (me_ && (g) >= 8) ? av : avh; } while (0)
#define PIN_ACC() do { asm volatile("" : "+v"(acc2[0]), "+v"(acc2[1]), "+v"(acc2[2]), "+v"(acc2[3]), "+v"(acc2[4]), "+v"(acc2[5]), "+v"(acc2[6]), "+v"(acc2[7]), "+v"(acc2[8]), "+v"(acc2[9]), "+v"(acc2[10]), "+v"(acc2[11]), "+v"(acc2[12]), "+v"(acc2[13]), "+v"(acc2[14]), "+v"(acc2[15])); } while (0)
#define PEER_AXPY(buf, sbuf, g) do { _Pragma("unroll") for (int x = 0; x < 8; ++x) { const int idx = (g) * 8 + x; \
            const float av = __uint_as_float(__builtin_amdgcn_readlane(__float_as_uint(idx < 64 ? avl : avh), idx & 63)) * __uint_as_float(sbuf[x] << 16); const f32x2 av2_ = {av, av}; \
            _Pragma("unroll") for (int d = 0; d < 4; ++d) { const unsigned w_ = buf[x][d]; FP4X8(w_, f0_, f1_, f2_, f3_); const int o_ = (d >> 1) * 8 + (d & 1) * 4; \
                acc2[o_ + 0] = av2_ * f0_ + acc2[o_ + 0]; acc2[o_ + 1] = av2_ * f1_ + acc2[o_ + 1]; acc2[o_ + 2] = av2_ * f2_ + acc2[o_ + 2]; acc2[o_ + 3] = av2_ * f3_ + acc2[o_ + 3]; } PIN_ACC(); } } while (0)
        float avl = 0.f, avh = 0.f;
        PEER_LOADT(A, SA, PU, 0); PEER_LOADT(B, SB, PU, 1);
#pragma unroll 1
        for (int g = 0; g < 15; g += 3) { PEER_LOADT(C, SC, PU, g + 2); SBAR(); PEER_DOT(A, SA, g); SBAR(); PEER_LOADT(A, SA, PU, g + 3); SBAR(); PEER_DOT(B, SB, g + 1); SBAR(); PEER_LOADT(B, SB, PU, g + 4); SBAR(); PEER_DOT(C, SC, g + 2); SBAR(); }
        PEER_DOT(A, SA, 15); SBAR();
        f32x2 acc2[16];
#pragma unroll
        for (int i = 0; i < 16; ++i) acc2[i] = (f32x2){0.f, 0.f};
        float* xp = xres_row(F, row);
        PEER_LOADT(A, SA, PV, 0); PEER_LOADT(B, SB, PV, 1);
#pragma unroll 1
        for (int g = 0; g < 15; g += 3) { PEER_LOADT(C, SC, PV, g + 2); SBAR(); PEER_AXPY(A, SA, g); SBAR(); PEER_LOADT(A, SA, PV, g + 3); SBAR(); PEER_AXPY(B, SB, g + 1); SBAR(); PEER_LOADT(B, SB, PV, g + 4); SBAR(); PEER_AXPY(C, SC, g + 2); SBAR(); }
        float x1[32], g2[32]; ld16_f32(xp, lane, x1); ld16_f32(modl + (size_t)v * 12288 + 10240, lane, g2); SBAR();
        PEER_AXPY(A, SA, 15); SBAR();
#undef PEER_LOADT
#undef PEER_LOADV
#undef PEER_DOT
#undef PEER_AXPY
        float acc[32];
        {
#pragma unroll
          for (int i = 0; i < 32; ++i) acc[i] = ALPHA * x1[i] + g2[i] * acc2[i >> 1][i & 1]; }
        { float sm = 0.f;
#pragma unroll
          for (int i = 0; i < 32; ++i) sm += acc[i];
          const float mu = wave_sum(sm) * (1.f / 2048.f); float qq = 0.f;
#pragma unroll
          for (int i = 0; i < 32; ++i) { const float dd = acc[i] - mu; qq += dd * dd; }
          const float rstd = rsqrtf(wave_sum(qq) * (1.f / 2048.f) + LN_EPS);
#pragma unroll
          for (int q = 0; q < 2; ++q)
#pragma unroll
              for (int d = 0; d < 4; ++d) { const int o = 1024 * q + 16 * lane + 4 * d; const f32x4 gg = *(const f32x4*)(g2n + o), bb = *(const f32x4*)(b2n + o);
#pragma unroll
                  for (int i = 0; i < 4; ++i) acc[q * 16 + d * 4 + i] = (acc[q * 16 + d * 4 + i] - mu) * rstd * gg[i] + bb[i]; } }
        st16_f32(xp, lane, acc);
        if (!last) { const float* sh = modn + (size_t)v * 12288; const float* sc = sh + 2048;
#pragma unroll
            for (int q = 0; q < 2; ++q)
#pragma unroll
                for (int d = 0; d < 4; ++d) { const int o = 1024 * q + 16 * lane + 4 * d; const f32x4 hh4 = *(const f32x4*)(sh + o), cc4 = *(const f32x4*)(sc + o);
#pragma unroll
                    for (int i = 0; i < 4; ++i) acc[q * 16 + d * 4 + i] = clamp8(acc[q * 16 + d * 4 + i] * (1.f + cc4[i]) + hh4[i]); }
#pragma unroll
            for (int q = 0; q < 2; ++q) { u32x4 w;
#pragma unroll
                for (int d = 0; d < 4; ++d) w[d] = pk4_fp8(acc[q * 16 + d * 4 + 0], acc[q * 16 + d * 4 + 1], acc[q * 16 + d * 4 + 2], acc[q * 16 + d * 4 + 3]);
                *(u32x4*)(HB8w + (size_t)row * D + 1024 * q + 16 * lane) = w; } }
      }
    }
}
#ifdef DBG
constexpr size_t WS_DBG = WS_CTL + 131072;
constexpr int DBG_NS = 60;
__device__ __forceinline__ int dbg_row(int s) { return (s * 263 + 5) % NLAT; }
__global__ void __launch_bounds__(256) dbg_peer_pre(Args args, int l) {
    __shared__ float q[1024]; __shared__ float s1[128], s2[128]; __shared__ float v1[16], v2[16]; __shared__ int i1[16], i2[16]; __shared__ float cs[256]; __shared__ int ce[256];
    __shared__ float ts[16]; __shared__ int te[16]; __shared__ float red[256]; __shared__ float aval[128]; __shared__ int eid[128]; __shared__ float h2[2048];
    const int s = blockIdx.x, row = dbg_row(s), tid = threadIdx.x; unsigned char* ws = args.ws;
    const bf16_t* QP = (const bf16_t*)(ws + WS_QP); const bf16_t* HB = (const bf16_t*)(ws + WS_HB);
    float* dbgf = (float*)(ws + WS_DBG + 4096); int* dbge = (int*)(dbgf + DBG_NS * 2048); float* dbga = (float*)(dbge + DBG_NS * 128); float* dbgg = dbga + 3 * DBG_NS * 128;
    for (int i = tid; i < 1024; i += 256) q[i] = bf2f(QP[(size_t)row * 1024 + i]);
    for (int i = tid; i < 2048; i += 256) h2[i] = bf2f(HB[(size_t)row * D + i]);
    __syncthreads();
    const float* k1 = args.in[21] + (size_t)l * 8192; const float* k2 = args.in[22] + (size_t)l * 8192;
    for (int hd = 0; hd < 8; ++hd) {
        { const int k = tid & 127; const float* kk = (tid < 128 ? k1 : k2) + k * 64; const float* qq = q + hd * 128 + (tid < 128 ? 0 : 64); float a = 0.f; for (int d = 0; d < 64; ++d) a += qq[d] * kk[d]; (tid < 128 ? s1 : s2)[k] = a; }
        __syncthreads();
        { const int k = tid & 127; const float* sv = tid < 128 ? s1 : s2; const float me = sv[k]; int rank = 0; for (int j = 0; j < 128; ++j) rank += (sv[j] > me || (sv[j] == me && j < k)) ? 1 : 0;
          if (rank < 16) { (tid < 128 ? v1 : v2)[rank] = me; (tid < 128 ? i1 : i2)[rank] = k; } }
        __syncthreads();
        { const int i = tid >> 4, j = tid & 15; cs[tid] = v1[i] + v2[j]; ce[tid] = i1[i] * 128 + i2[j]; }
        __syncthreads();
        { const float me = cs[tid]; int rank = 0; for (int j = 0; j < 256; ++j) rank += (cs[j] > me || (cs[j] == me && j < tid)) ? 1 : 0; if (rank < 16) { ts[rank] = me; te[rank] = ce[tid]; } }
        __syncthreads();
        if (tid < 16) { float mx = ts[0]; float sm = 0.f; for (int j = 0; j < 16; ++j) sm += expf(ts[j] - mx); aval[hd * 16 + tid] = expf(ts[tid] - mx) / sm; eid[hd * 16 + tid] = te[tid]; dbgg[s * 128 + hd * 16 + tid] = aval[hd * 16 + tid]; }
        __syncthreads();
    }
    const float* U = args.in[23] + (size_t)l * 16384 * 2048; const float* V = args.in[24] + (size_t)l * 16384 * 2048;
    for (int e = 0; e < 128; ++e) { const float* ur = U + (size_t)eid[e] * 2048; float p = 0.f; for (int d = tid; d < 2048; d += 256) p += h2[d] * ur[d]; red[tid] = p; __syncthreads();
        for (int st = 128; st > 0; st >>= 1) { if (tid < st) red[tid] += red[tid + st]; __syncthreads(); }
        if (tid == 0) { const float sc = red[0]; aval[e] = 0.5f * sc * (1.f + erff(sc * 0.70710678f)) * aval[e]; } __syncthreads(); }
    float y[8]; const float* xr = args.out + (size_t)row * D; const int v = row >> 12; const float* mod = (const float*)(ws + WS_MOD) + (size_t)l * 5 * 12288 + (size_t)v * 12288;
    float sum = 0.f;
    for (int k = 0; k < 8; ++k) { const int d = tid + 256 * k; float o = 0.f; for (int e = 0; e < 128; ++e) o += aval[e] * V[(size_t)eid[e] * 2048 + d]; y[k] = ALPHA * xr[d] + mod[10240 + d] * o; sum += y[k]; }
    red[tid] = sum; __syncthreads(); for (int st = 128; st > 0; st >>= 1) { if (tid < st) red[tid] += red[tid + st]; __syncthreads(); } const float mu = red[0] / 2048.f; __syncthreads();
    float sq = 0.f; for (int k = 0; k < 8; ++k) sq += (y[k] - mu) * (y[k] - mu);
    red[tid] = sq; __syncthreads(); for (int st = 128; st > 0; st >>= 1) { if (tid < st) red[tid] += red[tid + st]; __syncthreads(); } const float rstd = rsqrtf(red[0] / 2048.f + LN_EPS);
    for (int k = 0; k < 8; ++k) { const int d = tid + 256 * k; dbgf[(size_t)s * 2048 + d] = (y[k] - mu) * rstd * args.in[25][l * D + d] + args.in[26][l * D + d]; }
    if (tid < 128) { dbge[s * 128 + tid] = eid[tid]; dbga[s * 128 + tid] = aval[tid]; }
}
__global__ void __launch_bounds__(256) dbg_peer_post(Args args) {
    __shared__ int bad_e, bad_x, bad_a, bad_g;
    const int s = blockIdx.x, row = dbg_row(s), tid = threadIdx.x; unsigned char* ws = args.ws; unsigned* cnt = (unsigned*)(ws + WS_DBG);
    float* dbgf = (float*)(ws + WS_DBG + 4096); int* dbge = (int*)(dbgf + DBG_NS * 2048); float* dbga = (float*)(dbge + DBG_NS * 128);
    int* fe = (int*)(dbga + DBG_NS * 128); float* fa = (float*)(fe + DBG_NS * 128); float* dbgg = dbga + 3 * DBG_NS * 128; float* fg = dbgg + DBG_NS * 128;
    if (tid == 0) { bad_e = 0; bad_x = 0; bad_a = 0; bad_g = 0; } __syncthreads();
    if (tid < 128) { const int hd = tid >> 4; const int e = dbge[s * 128 + tid]; bool found = false; float af = 0.f, gf = 0.f; for (int j = 0; j < 16; ++j) if (fe[s * 128 + hd * 16 + j] == e) { found = true; af = fa[s * 128 + hd * 16 + j]; gf = fg[s * 128 + hd * 16 + j]; }
        if (!found) atomicAdd(&bad_e, 1); else { const float ea = dbga[s * 128 + tid]; if (fabsf(af - ea) > 0.02f * fabsf(ea) + 2e-3f) atomicAdd(&bad_a, 1); const float eg = dbgg[s * 128 + tid]; if (fabsf(gf - eg) > 0.02f * fabsf(eg) + 1e-3f) atomicAdd(&bad_g, 1); } }
    for (int k = 0; k < 8; ++k) { const int d = tid + 256 * k; const float ex = dbgf[(size_t)s * 2048 + d], got = args.out[(size_t)row * D + d]; if (!(fabsf(got - ex) <= 0.03f + 0.03f * fabsf(ex))) atomicAdd(&bad_x, 1); }
    __syncthreads();
    if (tid == 0) { if (bad_e > 2) atomicAdd(&cnt[1], 1u); if (bad_g > 2) atomicAdd(&cnt[2], 1u); if (bad_a > 2) atomicAdd(&cnt[3], 1u); if (bad_x > 8) atomicAdd(&cnt[4], 1u); }
}
__global__ void dbg_report(Args args) {
    unsigned* cnt = (unsigned*)(args.ws + WS_DBG);
    float code = 0.f;
    for (int lv = 1; lv <= 9; ++lv) if (cnt[lv]) { int tenths = (int)(cnt[lv] * 10 / DBG_NS); if (tenths > 9) tenths = 9; code = 1000.f * lv + 100.f * tenths; break; }
    if (code != 0.f) for (int i = threadIdx.x; i < 4096; i += blockDim.x) args.out[i] = code;
}
#endif
template <int ABL>
__device__ __forceinline__ void p_attn_gqa(const Frame& F, int last) {
    LAS unsigned char* lds = F.lds;
    const unsigned char* QG = wsp<unsigned char>(F, WS_QG); const unsigned char* KG = wsp<unsigned char>(F, WS_KG); const unsigned char* VG = wsp<unsigned char>(F, WS_VG); unsigned char* OAB = wsp<unsigned char>(F, WS_OAB);
    const int nlat = NB * 8 * 16, nall = last ? nlat : nlat + NB * 8;
    for (int u = F.bid; u < nall; u += F.G) {
        int bh, q0, seq; size_t orow;
        if (u < nlat) {
            int uu = u;
            if (F.G == 256) {
                const int c = u & 255, i = u >> 8, xcd = c & 7, r = c >> 3, kvg = i * 4 + (xcd >> 1), within = (xcd & 1) * 32 + r;
                uu = (((kvg >> 1) * 8 + (kvg & 1) * 4 + (within >> 4)) << 4) | (within & 15); }
            bh = uu >> 4; const int qb = uu & 15; q0 = CTXL + qb * 256; seq = TT; orow = (size_t)(bh >> 3) * SEQ + qb * 256; }
        else { bh = u - nlat; q0 = 0; seq = CTXL; orow = (size_t)NLAT + (bh >> 3) * CTXL; }
        const int b = bh >> 3, h = bh & 7; const size_t kvo = (size_t)(b * 2 + (h >> 2)) * TT * 128;
        __syncthreads();
        att::attn_body<4, 0, ABL>(QG + ((size_t)bh * TT + q0) * 128, KG + kvo, VG + (size_t)(b * 2 + (h >> 2)) * 128 * TT, OAB + orow * D + 1024 + h * 128, seq, lds, F.tid);
    }
    __syncthreads();
}
template <int ABL>
__device__ __forceinline__ void p_attn_mla(const Frame& F, int last) {
    LAS unsigned char* lds = F.lds;
    const unsigned char* QM = wsp<unsigned char>(F, WS_QM); const unsigned char* KM = wsp<unsigned char>(F, WS_KM); const unsigned char* VM = wsp<unsigned char>(F, WS_VM); unsigned char* OAB = wsp<unsigned char>(F, WS_OAB);
    const int nlat = NB * 8 * 16, nall = last ? nlat : nlat + NB * 8;
    for (int u = F.bid; u < nall; u += F.G) {
        int bh, q0, seq; size_t orow;
        if (u < nlat) {
            int uu = u;
            if (F.G == 256) { const int c = u & 255, i = u >> 8, xcd = c & 7, r = c >> 3; uu = ((i * 16 + xcd * 2 + (r >> 4)) << 4) | (r & 15); }
            bh = uu >> 4; const int qb = uu & 15; q0 = CTXL + qb * 256; seq = TT; orow = (size_t)(bh >> 3) * SEQ + qb * 256; }
        else { bh = u - nlat; q0 = 0; seq = CTXL; orow = (size_t)NLAT + (bh >> 3) * CTXL; }
        const int h = bh & 7;
        __syncthreads();
        att::attn_body<2, 1, ABL>(QM + ((size_t)bh * TT + q0) * 128, KM + (size_t)bh * TT * 128, VM + (size_t)bh * 64 * TT, OAB + orow * D + h * 64, seq, lds, F.tid);
    }
    __syncthreads();
}
__device__ __forceinline__ void p_ret_out(const Frame& F, int l, int last) {
    const int c_lo = last ? 2 : 0, nc = 34 - c_lo, nu = NB * 8 * nc;
    for (int u = F.bid; u < nu; u += F.G) { const int bh = u / nc, c = c_lo + (u % nc); ret_out_unit(F, l, bh, c); }
    __syncthreads();
}

constexpr int LDS_BYTES = 147456;
constexpr int MISC_OFF = 147456 - 64;
constexpr int NPHASE = 22;
#ifndef PHM
#define PHM 0xFFFF
#endif
#ifndef PH_ATTR
#define PH_ATTR __forceinline__
#endif
__device__ PH_ATTR void ph_prologue(ArgP ap) { const Frame F = make_frame(ap); p0_prologue(F); }
__device__ PH_ATTR void ph_modreduce(ArgP ap) { const Frame F = make_frame(ap); p1_modreduce(F); }
__device__ PH_ATTR void ph_modulate0(ArgP ap) { const Frame F = make_frame(ap); p_modulate0(F); }
template <int GABL> __device__ PH_ATTR void ph_gemm_in(ArgP ap, int l) { const Frame F = make_frame(ap);
    pg8::Gemm g{wsp<bf16_t>(F, WS_HB8), wsp<bf16_t>(F, WS_WIN + l * SZ_WIN), NROW, NPT, 1024, 1024, 1024}; pg8::StaticOrder S; S.init(NROW, NPT, F.G, F.bid);
    float mul_, inv_; fp8_scale(wsp<unsigned>(F, WS_WSC)[l], mul_, inv_);
    EpiIn E{wsp<bf16_t>(F, WS_P1), wsp<bf16_t>(F, WS_G), inv_};
    pg8::gemm_phase<EpiIn, pg8::StaticOrder, GABL>(F.lds, F.tid, g, S, E); }
__device__ PH_ATTR void ph_post(ArgP ap, int l) { const Frame F = make_frame(ap); p_post(F, l); if (l == 1) cvt_peer(F, 1); }
__device__ PH_ATTR void ph_qup(ArgP ap, int l) { const Frame F = make_frame(ap);
    pg8::Gemm g{wsp<bf16_t>(F, WS_CQN), wsp<bf16_t>(F, WS_WQUP + l * SZ_WQUP), NROW, 768, 512, 512, 512}; pg8::StaticOrder S; S.init(NROW, 768, F.G, F.bid);
    EpiQup E{wsp<unsigned char>(F, WS_QM), wsp<f32x2>(F, WS_ROPE32)};
    pg8::gemm_phase<EpiQup, pg8::StaticOrder>(F.lds, F.tid, g, S, E); }
__device__ PH_ATTR void ph_kvup(ArgP ap, int l) { const Frame F = make_frame(ap);
    pg8::Gemm g{wsp<bf16_t>(F, WS_CKVN), wsp<bf16_t>(F, WS_WKVUP + l * SZ_WKVUP), NROW, 1024, 256, 256, 256}; pg8::StaticOrder S; S.init(NROW, 1024, F.G, F.bid);
    EpiKvup E{wsp<unsigned char>(F, WS_KM), wsp<unsigned char>(F, WS_VM)};
    pg8::gemm_phase<EpiKvup, pg8::StaticOrder>(F.lds, F.tid, g, S, E); }
__device__ PH_ATTR void ph_states(ArgP ap, int l) { const Frame F = make_frame(ap); p_ret_states(F, l); }
template <int ABL> __device__ PH_ATTR void ph_attn_gqa(ArgP ap, int last) { const Frame F = make_frame(ap); p_attn_gqa<ABL>(F, last); }
template <int ABL> __device__ PH_ATTR void ph_attn_mla(ArgP ap, int last) { const Frame F = make_frame(ap); p_attn_mla<ABL>(F, last); }
__device__ PH_ATTR void ph_ret_out(ArgP ap, int l, int last) { const Frame F = make_frame(ap); p_ret_out(F, l, last); }
template <int SEG> __device__ PH_ATTR void ph_merge(ArgP ap, int l, int Mx) { const Frame F = make_frame(ap);
    const bf16_t* OAB = wsp<bf16_t>(F, WS_OAB); bf16_t* MB = wsp<bf16_t>(F, WS_MB); const bf16_t* G = wsp<bf16_t>(F, WS_G);
    pg8::StaticOrder S; S.init(Mx, 2048, F.G, F.bid);
    const size_t wo = SEG == 0 ? WS_WBRA + l * SZ_WBRA : (SEG == 1 ? WS_WBRB + l * SZ_WBRB : WS_WBRC + l * SZ_WBRC); const int K = SEG == 2 ? 1024 : 512;
    pg8::Gemm g{OAB + SEG * 512, wsp<bf16_t>(F, wo), Mx, 2048, K, 2048, K}; EpiMerge<SEG> E{MB, G, wsp<unsigned char>(F, WS_MB8)}; pg8::gemm_phase<EpiMerge<SEG>, pg8::StaticOrder>(F.lds, F.tid, g, S, E); }
__device__ PH_ATTR void ph_merge3(ArgP ap, int l, int Mx) { const Frame F = make_frame(ap);
    pg8::StaticOrder S; S.init(Mx, 2048, F.G, F.bid);
    float m0_, i0_, m1_, i1_, m2_, i2_; fp8_scale(wsp<unsigned>(F, WS_WSC)[4 + l], m0_, i0_); fp8_scale(wsp<unsigned>(F, WS_WSC)[6 + l], m1_, i1_); fp8_scale(wsp<unsigned>(F, WS_WSC)[8 + l], m2_, i2_);
    pg8::Merge3 g{wsp<bf16_t>(F, WS_OAB), wsp<bf16_t>(F, WS_WBRA + l * SZ_WBRA), wsp<bf16_t>(F, WS_WBRB + l * SZ_WBRB), wsp<bf16_t>(F, WS_WBRC + l * SZ_WBRC), wsp<bf16_t>(F, WS_G), wsp<unsigned char>(F, WS_MB8), i0_ * m1_, i1_ * m2_, i2_};
    pg8::gemm_merge3<pg8::StaticOrder>(F.lds, F.tid, g, S); }
__device__ PH_ATTR void ph_out(ArgP ap, int l, int Mx) { const Frame F = make_frame(ap);
    pg8::Gemm g{wsp<bf16_t>(F, WS_MB8), wsp<bf16_t>(F, WS_WOUT + l * SZ_WOUT), Mx, 2048, 1024, 1024, 1024}; pg8::StaticOrder S; S.init(Mx, 2048, F.G, F.bid);
    float mul_, inv_; fp8_scale(wsp<unsigned>(F, WS_WSC)[2 + l], mul_, inv_);
    EpiOut E{l == 0 ? F.in(0) : F.out, l == 0 ? F.in(2) : wsp<float>(F, WS_XC), F.out, wsp<float>(F, WS_XC), wsp<float>(F, WS_MOD) + (size_t)l * 5 * 12288 + 4096, inv_ * (1.f / 16.f)};
    pg8::gemm_phase<EpiOut, pg8::StaticOrder>(F.lds, F.tid, g, S, E); }
__device__ PH_ATTR void ph_ln1(ArgP ap, int l, int last) { const Frame F = make_frame(ap); p_ln1(F, l, last); }
__device__ PH_ATTR void ph_peerq(ArgP ap, int l, int Mx) { const Frame F = make_frame(ap);
    pg8::Gemm g{wsp<bf16_t>(F, WS_HB), wsp<bf16_t>(F, WS_WPQ + l * SZ_WPQ), Mx, 1024, 2048, 2048, 2048}; pg8::StaticOrder S; S.init(Mx, 1024, F.G, F.bid);
    EpiPlain E{wsp<bf16_t>(F, WS_QP), 1024};
    pg8::gemm_phase<EpiPlain, pg8::StaticOrder>(F.lds, F.tid, g, S, E); }
__device__ PH_ATTR void ph_peer(ArgP ap, int l, int last) { const Frame F = make_frame(ap); p_peer(F, l, last); }

__global__ void __launch_bounds__(512, 2) mega_fwd(Args args) {
    extern __shared__ __attribute__((aligned(16))) unsigned char lds_raw[];
    const ArgP ap = (ArgP)__builtin_amdgcn_kernarg_segment_ptr();
    const int lo = ap->ph_lo, hi = ap->ph_hi;
    volatile LAS unsigned* misc = (volatile LAS unsigned*)((LAS unsigned char*)lds_raw + MISC_OFF);
    if (threadIdx.x < 4) misc[threadIdx.x] = 0u;
    __syncthreads();
    XcdBarrier bar; bar.bar = (unsigned*)(ap->ws + WS_CTL); bar.x = 0; bar.st = misc;
    if (hi - lo > 1) bar = xcd_barrier_post((unsigned*)(ap->ws + WS_CTL), misc);
#ifdef BENCH_K
    { float a[16]; f32x2 b2[8];
#pragma unroll
      for (int i = 0; i < 16; ++i) a[i] = 1.f + threadIdx.x * 1e-3f + i;
#pragma unroll
      for (int i = 0; i < 8; ++i) b2[i] = (f32x2){a[i], a[i + 8]};
      float c0 = a[3], c1 = a[5];
#define B16(INS) asm volatile(INS(0) INS(1) INS(2) INS(3) INS(4) INS(5) INS(6) INS(7) INS(8) INS(9) INS(10) INS(11) INS(12) INS(13) INS(14) INS(15) \
        : "+v"(a[0]), "+v"(a[1]), "+v"(a[2]), "+v"(a[3]), "+v"(a[4]), "+v"(a[5]), "+v"(a[6]), "+v"(a[7]), "+v"(a[8]), "+v"(a[9]), "+v"(a[10]), "+v"(a[11]), "+v"(a[12]), "+v"(a[13]), "+v"(a[14]), "+v"(a[15]) : "v"(c0), "v"(c1))
#define I_ADD(i) "v_add_f32 %" #i ", %" #i ", %16\n"
#define I_EXP(i) "v_exp_f32 %" #i ", %" #i "\n"
#define I_MAX3(i) "v_max3_f32 %" #i ", %" #i ", %16, %17\n"
#define I_CVT(i) "v_cvt_pk_fp8_f32 %" #i ", %16, %17\n"
#define I_DEP(i) "v_max3_f32 %0, %0, %16, %17\n"
#define I_DEPA(i) "v_add_f32 %0, %0, %16\n"
#define I_FMA(i) "v_fma_f32 %" #i ", %" #i ", %16, %17\n"
#define P8(INS) asm volatile(INS(0) INS(1) INS(2) INS(3) INS(4) INS(5) INS(6) INS(7) INS(0) INS(1) INS(2) INS(3) INS(4) INS(5) INS(6) INS(7) \
        : "+v"(b2[0]), "+v"(b2[1]), "+v"(b2[2]), "+v"(b2[3]), "+v"(b2[4]), "+v"(b2[5]), "+v"(b2[6]), "+v"(b2[7]) : "v"(b2[0]))
#define I_PKADD(i) "v_pk_add_f32 %" #i ", %" #i ", %8\n"
#define I_PKFMA(i) "v_pk_fma_f32 %" #i ", %" #i ", %8, %8\n"
#pragma unroll 1
      for (int it = 0; it < 20000; ++it) {
#if BENCH_K == 1
        B16(I_ADD);
#elif BENCH_K == 2
        B16(I_EXP);
#elif BENCH_K == 3
        B16(I_MAX3);
#elif BENCH_K == 4
        B16(I_CVT);
#elif BENCH_K == 5
        P8(I_PKADD);
#elif BENCH_K == 6
        P8(I_PKFMA);
#elif BENCH_K == 7
        B16(I_FMA);
#elif BENCH_K == 9
        B16(I_DEP);
#elif BENCH_K == 10
        B16(I_DEPA);
#endif
      }
#if BENCH_K == 11 || BENCH_K == 12
      { f32x16 q0 = {}, q1 = {}, q2 = {}, q3 = {}; att::i32x8a x8 = {1, 2, 3, 4, 5, 6, 7, (int)threadIdx.x};
#pragma unroll 1
        for (int it = 0; it < 2000; ++it) {
#pragma unroll
          for (int k = 0; k < 4; ++k) {
            q0 = __builtin_amdgcn_mfma_scale_f32_32x32x64_f8f6f4(x8, x8, q0, 0, 0, 0, 0x7F7F7F7F, 0, 0x7F7F7F7F); asm volatile("" : "+v"(q0));
#if BENCH_K == 11
            B16(I_ADD);
#else
            B16(I_EXP);
#endif
            q1 = __builtin_amdgcn_mfma_scale_f32_32x32x64_f8f6f4(x8, x8, q1, 0, 0, 0, 0x7F7F7F7F, 0, 0x7F7F7F7F); asm volatile("" : "+v"(q1));
#if BENCH_K == 11
            B16(I_ADD);
#else
            B16(I_EXP);
#endif
            q2 = __builtin_amdgcn_mfma_scale_f32_32x32x64_f8f6f4(x8, x8, q2, 0, 0, 0, 0x7F7F7F7F, 0, 0x7F7F7F7F); asm volatile("" : "+v"(q2));
#if BENCH_K == 11
            B16(I_ADD);
#else
            B16(I_EXP);
#endif
            q3 = __builtin_amdgcn_mfma_scale_f32_32x32x64_f8f6f4(x8, x8, q3, 0, 0, 0, 0x7F7F7F7F, 0, 0x7F7F7F7F); asm volatile("" : "+v"(q3));
#if BENCH_K == 11
            B16(I_ADD);
#else
            B16(I_EXP);
#endif
          }
          asm volatile("" : "+v"(x8)); } }
#endif
#if BENCH_K == 8
      { f32x16 q0 = {}, q1 = {}, q2 = {}, q3 = {}; att::i32x8a x8 = {1, 2, 3, 4, 5, 6, 7, (int)threadIdx.x};
#pragma unroll 1
        for (int it = 0; it < 2000; ++it) {
#pragma unroll
          for (int k = 0; k < 4; ++k) { q0 = __builtin_amdgcn_mfma_scale_f32_32x32x64_f8f6f4(x8, x8, q0, 0, 0, 0, 0x7F7F7F7F, 0, 0x7F7F7F7F); q1 = __builtin_amdgcn_mfma_scale_f32_32x32x64_f8f6f4(x8, x8, q1, 0, 0, 0, 0x7F7F7F7F, 0, 0x7F7F7F7F);
            q2 = __builtin_amdgcn_mfma_scale_f32_32x32x64_f8f6f4(x8, x8, q2, 0, 0, 0, 0x7F7F7F7F, 0, 0x7F7F7F7F); q3 = __builtin_amdgcn_mfma_scale_f32_32x32x64_f8f6f4(x8, x8, q3, 0, 0, 0, 0x7F7F7F7F, 0, 0x7F7F7F7F); }
          asm volatile("" : "+v"(q0), "+v"(q1), "+v"(q2), "+v"(q3), "+v"(x8)); } }
#endif
    }
#endif
#define IN(k) (lo <= (k) && (k) < hi)
#define SEAM(k) do { if (IN(k) && IN((k) + 1)) xcd_barrier(bar); } while (0)
    if (IN(0)) { if (PHM & 1) ph_prologue(ap); if (REP_PRO) ph_prologue(ap); } SEAM(0);
    if (IN(1)) { if (PHM & 2) ph_modreduce(ap); if (REP_X & 32) ph_modreduce(ap); } SEAM(1);
#pragma unroll 1
    for (int l = 0; l < 2; ++l) {
        const int pb = 2 + 10 * l; const int last = (l == 1);
        const int Mx = last ? NLAT : NROW;
        if (l == 0) { if (IN(pb)) { if (PHM & 4) ph_modulate0(ap); if (REP_X & 64) ph_modulate0(ap); } SEAM(pb); }
        if (IN(pb + 1)) { if (REP_GIN) ph_gemm_in<GIN_ABL>(ap, l); if (PHM & 8) ph_gemm_in<0>(ap, l); } SEAM(pb + 1);
        if (IN(pb + 2)) { if (PHM & 16) ph_post(ap, l); if (REP_X & 1) ph_post(ap, l); } SEAM(pb + 2);
        if (IN(pb + 3)) { if (PHM & 32) ph_qup(ap, l); if (PHM & 64) ph_kvup(ap, l); if (PHM & 128) ph_states(ap, l); if (REP_X & 2) { ph_qup(ap, l); ph_kvup(ap, l); ph_states(ap, l); } } SEAM(pb + 3);
        if (IN(pb + 4)) { if (REP_ATTN & 1) ph_attn_gqa<ATT_ABL>(ap, last); if (REP_ATTN & 2) ph_attn_mla<ATT_ABL>(ap, last); if (PHM & 256) ph_attn_gqa<0>(ap, last); if (PHM & 512) ph_attn_mla<0>(ap, last); if (REP_X & 4) ph_ret_out(ap, l, last); if (PHM & 1024) ph_ret_out(ap, l, last); } SEAM(pb + 4);
        if (IN(pb + 5)) { if (PHM & 2048) { if (MERGE3) ph_merge3(ap, l, Mx); else { ph_merge<0>(ap, l, Mx); ph_merge<1>(ap, l, Mx); ph_merge<2>(ap, l, Mx); } } if (REP_X & 8) { if (MERGE3) ph_merge3(ap, l, Mx); else { ph_merge<0>(ap, l, Mx); ph_merge<1>(ap, l, Mx); ph_merge<2>(ap, l, Mx); } } } SEAM(pb + 5);
        if (IN(pb + 6)) { if (PHM & 4096) ph_out(ap, l, Mx); } SEAM(pb + 6);
        if (IN(pb + 7)) { if (PHM & 8192) ph_ln1(ap, l, last); } SEAM(pb + 7);
        if (IN(pb + 8)) { if (PHM & 16384) ph_peerq(ap, l, Mx); if (REP_X & 16) ph_peerq(ap, l, Mx); } SEAM(pb + 8);
        if (IN(pb + 9)) { if (PHM & 32768) ph_peer(ap, l, last); } SEAM(pb + 9);
    }
#undef IN
#undef SEAM
}

extern "C" void kernel_launch(void* const* d_in, const int* in_sizes, int n_in, void* d_out, int out_size, void* d_ws, size_t ws_size, hipStream_t stream) {
    static int grid = 0;
    if (grid == 0) {
        if (n_in != 27 || out_size != NLAT * D || ws_size < WS_END) { fprintf(stderr, "kernel_launch: unexpected shapes: n_in %d out %d ws %zu (need %zu)\n", n_in, out_size, ws_size, (size_t)WS_END); grid = -1; return; }
        int dev = 0, cus = 0, per_cu = 0;
        if (hipGetDevice(&dev) != hipSuccess || hipDeviceGetAttribute(&cus, hipDeviceAttributeMultiprocessorCount, dev) != hipSuccess) { grid = -1; return; }
        if (hipFuncSetAttribute((const void*)mega_fwd, hipFuncAttributeMaxDynamicSharedMemorySize, LDS_BYTES) != hipSuccess) { fprintf(stderr, "kernel_launch: hipFuncSetAttribute failed\n"); grid = -1; return; }
        if (hipOccupancyMaxActiveBlocksPerMultiprocessor(&per_cu, (const void*)mega_fwd, 512, LDS_BYTES) != hipSuccess || per_cu < 1) fprintf(stderr, "kernel_launch: occupancy query reports %d\n", per_cu);
        (void)hipGetLastError();
        grid = cus;
    }
    if (grid < 0) return;
    (void)hipMemsetAsync((char*)d_ws + WS_CTL, 0, 65536, stream);
#ifdef DBG
    (void)hipMemsetAsync((char*)d_ws + WS_CTL + 131072, 0, 4096, stream);
#endif
    Args a{};
    for (int i = 0; i < 27; ++i) a.in[i] = (const float*)d_in[i];
    a.out = (float*)d_out; a.ws = (unsigned char*)d_ws;
#if MK_PER_PHASE
    for (int p = 0; p < NPHASE; ++p) { if (p == 12) continue; a.ph_lo = p; a.ph_hi = p + 1;
#ifdef DBG
        if (p == 11) hipLaunchKernelGGL(dbg_peer_pre, dim3(DBG_NS), dim3(256), 0, stream, a, 0);
#endif
        hipLaunchKernelGGL(mega_fwd, dim3(grid), dim3(512), LDS_BYTES, stream, a);
#ifdef DBG
        if (p == 11) hipLaunchKernelGGL(dbg_peer_post, dim3(DBG_NS), dim3(256), 0, stream, a);
#endif
    }
#ifdef DBG
    hipLaunchKernelGGL(dbg_report, dim3(1), dim3(256), 0, stream, a);
#endif
#else
    a.ph_lo = 0; a.ph_hi = NPHASE;
    hipLaunchKernelGGL(mega_fwd, dim3(grid), dim3(512), LDS_BYTES, stream, a);
#endif
    const hipError_t le = hipPeekAtLastError();
    if (le != hipSuccess) fprintf(stderr, "kernel_launch: launch failed: %s\n", hipGetErrorName(le));
}
```

```cpp
#include <hip/hip_runtime.h>
#include <cstdio>
#include <cstdint>
#include <cstddef>

#ifndef MK_PER_PHASE
#define MK_PER_PHASE 0
#endif

#ifndef ABL_PEER
#define ABL_PEER 0
#endif
#ifndef REP_PEERG
#define REP_PEERG 0
#endif
#ifndef REP_PEERH
#define REP_PEERH 0
#endif
#ifndef REP_X
#define REP_X 0
#endif
#ifndef REP_PS1
#define REP_PS1 0
#endif
#ifndef REP_PS2
#define REP_PS2 0
#endif
#ifndef SIDE_ON
#define SIDE_ON 1
#endif
#ifndef REP_DOT
#define REP_DOT 0
#endif
#ifndef MERGE3
#define MERGE3 1
#endif
#ifndef REP_GIN
#define REP_GIN 0
#endif
#ifndef GIN_ABL
#define GIN_ABL 0
#endif
#ifndef ATT_ABL
#define ATT_ABL 0
#endif
#ifndef REP_ATTN
#define REP_ATTN 0
#endif
#ifndef REP_PRO
#define REP_PRO 0
#endif
#ifndef ABL_BR
#define ABL_BR 0
#endif
#ifndef ABL_MIX
#define ABL_MIX 0
#endif
#define LAS __attribute__((address_space(3)))
typedef unsigned short bf16_t;
typedef short bf16x8 __attribute__((ext_vector_type(8)));
typedef short s16x4 __attribute__((ext_vector_type(4)));
typedef float f32x2 __attribute__((ext_vector_type(2)));
typedef float f32x4 __attribute__((ext_vector_type(4)));
typedef float f32x8 __attribute__((ext_vector_type(8)));
typedef float f32x16 __attribute__((ext_vector_type(16)));
typedef unsigned u32x2 __attribute__((ext_vector_type(2)));
typedef unsigned u32x4 __attribute__((ext_vector_type(4)));
typedef __bf16 bf2_t __attribute__((ext_vector_type(2)));

constexpr int D = 2048, NB = 4, SEQ = 4096, CTXL = 256, TT = SEQ + CTXL;
constexpr int NLAT = NB * SEQ, NCTX = NB * CTXL, NROW = NLAT + NCTX;
constexpr int NP1 = 4096, NG = 6144, NPT = NP1 + NG;
constexpr int NIN = 10016;
constexpr float ALPHA = 1.4142135623730951f;
constexpr float LN_EPS = 1e-5f, RMS_EPS = 1e-6f;
constexpr float LOG2E = 1.4426950408889634f;
constexpr int C_CQ = 0, C_CKV = 512, C_GQ = 768, C_GK = 1792, C_GV = 2048, C_RQ = 2304, C_RK = 2560, C_RV = 2816, C_RG = 3328, C_KR = 3840;

constexpr size_t AL(size_t x) { return (x + 255) / 256 * 256; }
constexpr size_t WS_CTL = 0;                                    constexpr size_t CTL_BYTES = 1u << 20;
constexpr size_t WS_WSC = WS_CTL + 32768;
constexpr size_t WS_CVT = WS_CTL + 33024;
constexpr size_t WS_DEC = WS_CTL + 65536;
constexpr size_t WS_ROPE32 = WS_CTL + CTL_BYTES;
constexpr size_t WS_ROPE128 = WS_ROPE32 + AL(64 * 8 * 8);
constexpr size_t WS_MODP = WS_ROPE128 + AL(64 * 32 * 8);
constexpr size_t WS_MOD = WS_MODP + AL((size_t)16 * 2 * 5 * 12288 * 4);
constexpr size_t WS_WIN = WS_MOD + AL((size_t)2 * 5 * 12288 * 4);
constexpr size_t SZ_WIN = (size_t)NPT * D;
constexpr size_t WS_WQUP = WS_WIN + 2 * SZ_WIN;                 constexpr size_t SZ_WQUP = (size_t)768 * 512 * 2;
constexpr size_t WS_WKVUP = WS_WQUP + 2 * SZ_WQUP;              constexpr size_t SZ_WKVUP = (size_t)1024 * 256 * 2;
constexpr size_t WS_WBRA = WS_WKVUP + 2 * SZ_WKVUP;             constexpr size_t SZ_WBRA = (size_t)2048 * 512 * 2;
constexpr size_t WS_WBRB = WS_WBRA + 2 * SZ_WBRA;               constexpr size_t SZ_WBRB = SZ_WBRA;
constexpr size_t WS_WBRC = WS_WBRB + 2 * SZ_WBRB;               constexpr size_t SZ_WBRC = (size_t)2048 * 1024 * 2;
constexpr size_t WS_WOUT = WS_WBRC + 2 * SZ_WBRC;               constexpr size_t SZ_WOUT = (size_t)2048 * 2048 * 2;
constexpr size_t WS_WPQ = WS_WOUT + 2 * SZ_WOUT;                constexpr size_t SZ_WPQ = (size_t)1024 * 2048 * 2;
constexpr size_t WS_PSC = WS_WPQ + 2 * SZ_WPQ;
constexpr size_t WS_PU = WS_PSC + (size_t)4 * 16384 * 4;        constexpr size_t SZ_PT = (size_t)16384 * 1152;
constexpr size_t WS_PV = WS_PU + 2 * SZ_PT;
constexpr size_t WS_XC = WS_PV + 2 * SZ_PT;
constexpr size_t WS_HB = WS_XC + (size_t)NCTX * D * 4;
constexpr size_t WS_P1 = WS_HB + (size_t)NROW * D * 2;
constexpr size_t WS_G = WS_P1 + (size_t)NROW * NP1 * 2;
constexpr size_t WS_CQN = WS_G + (size_t)NROW * NG * 2;
constexpr size_t WS_CKVN = WS_CQN + (size_t)NROW * 512 * 2;
constexpr size_t WS_QM = WS_CKVN + (size_t)NROW * 256 * 2;
constexpr size_t SZ_Q128 = (size_t)NB * 8 * TT * 128 * 2;
constexpr size_t WS_KM = WS_QM + SZ_Q128;
constexpr size_t WS_VM = WS_KM + SZ_Q128;
constexpr size_t WS_QG = WS_VM + SZ_Q128 / 2;
constexpr size_t WS_KG = WS_QG + SZ_Q128;
constexpr size_t WS_VG = WS_KG + SZ_Q128 / 4;
constexpr size_t WS_RQ = WS_VG + SZ_Q128 / 4;
constexpr size_t WS_RK = WS_RQ + SZ_Q128 / 4;
constexpr size_t WS_RV = WS_RK + SZ_Q128 / 4;
constexpr size_t WS_ST = WS_RV + SZ_Q128 / 2;
constexpr size_t WS_OAB = WS_ST + (size_t)NB * 8 * 34 * 2 * 2048 * 4;
constexpr size_t WS_HB8 = WS_OAB + (size_t)NROW * D * 2;
constexpr size_t WS_MB8 = WS_HB8 + (size_t)NROW * D;
constexpr size_t WS_END = WS_MB8 + (size_t)NROW * D;
constexpr size_t WS_MB = WS_QM;
constexpr size_t WS_QP = WS_QG;
static_assert((size_t)NROW * D * 2 <= 2 * SZ_Q128, "MB alias");
static_assert((size_t)NROW * 1024 * 2 <= SZ_Q128, "QP alias");

__device__ __forceinline__ unsigned cvt_pk_bf16(float lo, float hi) { unsigned r; asm volatile("v_cvt_pk_bf16_f32 %0, %1, %2" : "=v"(r) : "v"(lo), "v"(hi)); return r; }
__device__ __forceinline__ bf16_t f2bf(float f) { return (bf16_t)(cvt_pk_bf16(f, 0.f) & 0xffffu); }
__device__ __forceinline__ float bf2f(bf16_t b) { return __uint_as_float(((unsigned)b) << 16); }
__device__ __forceinline__ float bflo(unsigned w) { return __uint_as_float(w << 16); }
__device__ __forceinline__ float bfhi(unsigned w) { return __uint_as_float(w & 0xffff0000u); }
template <int CTRL> __device__ __forceinline__ float dppf(float x) { return __int_as_float(__builtin_amdgcn_update_dpp(0, __float_as_int(x), CTRL, 0xF, 0xF, true)); }
__device__ __forceinline__ float row16_sum(float x) { x += dppf<0xB1>(x); x += dppf<0x4E>(x); x += dppf<0x141>(x); x += dppf<0x140>(x); return x; }
__device__ __forceinline__ float row16_max(float x) { x = fmaxf(x, dppf<0xB1>(x)); x = fmaxf(x, dppf<0x4E>(x)); x = fmaxf(x, dppf<0x141>(x)); x = fmaxf(x, dppf<0x140>(x)); return x; }
__device__ __forceinline__ float wave_sum(float x) {
    x = row16_sum(x);
    { auto r = __builtin_amdgcn_permlane16_swap(__float_as_uint(x), __float_as_uint(x), false, false); x = __uint_as_float(r[0]) + __uint_as_float(r[1]); }
    { auto r = __builtin_amdgcn_permlane32_swap(__float_as_uint(x), __float_as_uint(x), false, false); x = __uint_as_float(r[0]) + __uint_as_float(r[1]); }
    return x;
}
__device__ __forceinline__ unsigned pk4_fp8(float a, float b, float c, float d) { int t = 0; t = __builtin_amdgcn_cvt_pk_fp8_f32(a, b, t, false); t = __builtin_amdgcn_cvt_pk_fp8_f32(c, d, t, true); return (unsigned)t; }
__device__ __forceinline__ float clamp8(float x) { return fminf(fmaxf(x, -440.f), 440.f); }
__device__ __forceinline__ void fp8_scale(unsigned amax_bits, float& mul, float& inv) { const float am = __uint_as_float(amax_bits); int k = 0; if (am > 0.f) k = (int)floorf(log2f(256.f / am)); k = k > 60 ? 60 : (k < -60 ? -60 : k); mul = exp2f((float)k); inv = exp2f((float)-k); }
__device__ __forceinline__ float silu_f(float x) { return x * __builtin_amdgcn_rcpf(1.f + __builtin_amdgcn_exp2f(x * -1.4426950408889634f)); }
__device__ __forceinline__ float sigmoid_f(float x) { return __builtin_amdgcn_rcpf(1.f + __builtin_amdgcn_exp2f(x * -1.4426950408889634f)); }

__device__ __forceinline__ int vt_off(int tpos) { const int kk = tpos & 63; return (tpos & ~63) + ((kk >> 2) & 1) * 32 + ((kk >> 5) & 1) * 16 + (kk & 3) + 4 * ((kk >> 3) & 3); }
struct RowInfo { int b, tpos, pr, pc, v; bool lat; };
__device__ __forceinline__ RowInfo rowinfo(int row) {
    RowInfo r;
    if (row < NLAT) { r.lat = true; r.b = row >> 12; const int t = row & 4095; r.tpos = CTXL + t; r.pr = t >> 6; r.pc = t & 63; r.v = r.b; }
    else { const int q = row - NLAT; r.lat = false; r.b = q >> 8; r.tpos = q & 255; r.pr = 0; r.pc = 0; r.v = 4; }
    return r;
}

#define XB_TMO      128
#define XB_XCNT(j)  (256  + 64 * (j))
#define XB_XSUB(j)  (1280 + 64 * (j))
#define XB_XGEN(j)  (2304 + 64 * (j))
#define XB_TOP      3328
#define XB_TOPGEN   3392
#define XCD_BAR_WORDS 3456
#define XB_SPIN_CAP (1u << 22)

__device__ __forceinline__ unsigned xb_ld(unsigned* p)              { return __hip_atomic_load(p, __ATOMIC_RELAXED, __HIP_MEMORY_SCOPE_AGENT); }
__device__ __forceinline__ unsigned xb_add(unsigned* p, unsigned v) { return __hip_atomic_fetch_add(p, v, __ATOMIC_RELAXED, __HIP_MEMORY_SCOPE_AGENT); }
__device__ __forceinline__ unsigned xb_xcc_id() { return (unsigned)__builtin_amdgcn_s_getreg((3 << 11) | 20) & 0xFu; }
#define XB_SPIN(cond, bar) do { unsigned _sp = 0; while (cond) { __builtin_amdgcn_s_sleep(1); \
    if ((++_sp & 255u) == 0u) { if (xb_ld(&(bar)[XB_TMO])) break; if (_sp > XB_SPIN_CAP) { atomicAdd(&(bar)[XB_TMO], 1u); break; } } } } while (0)

struct XcdBarrier { unsigned* bar; unsigned x; volatile LAS unsigned* st; };

__device__ __forceinline__ XcdBarrier xcd_barrier_post(unsigned* bar, volatile LAS unsigned* st) {
    XcdBarrier b; b.bar = bar; b.x = xb_xcc_id(); b.st = st;
    if (threadIdx.x == 0) (void)xb_add(&bar[XB_XCNT(b.x)], 1u);
    return b;
}
__device__ __forceinline__ void xcd_barrier_complete(unsigned* bar, unsigned x, unsigned& nloc, unsigned& nx) {
    const unsigned G = gridDim.x * gridDim.y * gridDim.z;
    unsigned sum, cnt, mine, sp = 0u;
    for (;;) {
        sum = 0u; cnt = 0u; mine = 0u;
#pragma unroll
        for (unsigned j = 0; j < 16; ++j) { const unsigned c = xb_ld(&bar[XB_XCNT(j)]); sum += c; cnt += (c > 0u) ? 1u : 0u; mine = (j == x) ? c : mine; }
        if (sum == G) break;
        __builtin_amdgcn_s_sleep(1);
        if ((++sp & 255u) == 0u) { if (xb_ld(&bar[XB_TMO])) break; if (sp > XB_SPIN_CAP) { atomicAdd(&bar[XB_TMO], 1u); break; } }
    }
    nloc = mine > 0u ? mine : 1u; nx = cnt > 0u ? cnt : 1u;
}
__device__ __forceinline__ void xcd_barrier(const XcdBarrier& b) {
    asm volatile("s_waitcnt vmcnt(0)" ::: "memory");
    __syncthreads();
    if (threadIdx.x == 0) {
        unsigned* bar = b.bar;
        __builtin_amdgcn_s_waitcnt(0);
        unsigned nloc = b.st[0], nx = b.st[1];
        if (nloc == 0u) { xcd_barrier_complete(bar, b.x, nloc, nx); b.st[0] = nloc; b.st[1] = nx; }
        const unsigned old = xb_add(&bar[XB_XSUB(b.x)], 1u);
        const unsigned gen = old / nloc;
        if (old + 1u == (gen + 1u) * nloc) {
            __builtin_amdgcn_fence(__ATOMIC_RELEASE, "agent");
            asm volatile("s_waitcnt vmcnt(0)" ::: "memory");
            const unsigned og = xb_add(&bar[XB_TOP], 1u);
            const unsigned tg = og / nx;
            if (og + 1u == (tg + 1u) * nx) xb_add(&bar[XB_TOPGEN], 1u);
            else XB_SPIN(xb_ld(&bar[XB_TOPGEN]) == tg, bar);
            __builtin_amdgcn_fence(__ATOMIC_ACQUIRE, "agent");
            xb_add(&bar[XB_XGEN(b.x)], 1u);
            asm volatile("s_waitcnt vmcnt(0)" ::: "memory");
        } else {
            XB_SPIN(xb_ld(&bar[XB_XGEN(b.x)]) == gen, bar);
            __builtin_amdgcn_fence(__ATOMIC_ACQUIRE, "agent");
            asm volatile("s_waitcnt vmcnt(0)" ::: "memory");
        }
    }
    __syncthreads();
}
namespace pg8 {
constexpr int BM = 256, BK = 64, HALF = 128, HTB = HALF * BK * 2, STAGE_BYTES = 8 * HTB, NXCD = 8, WGM = 8;
__host__ __device__ __forceinline__ int lds_byte(int r, int c) { const int st = (r >> 4) * 2 + (c >> 5), rr = r & 15, cc = c & 31, ob = rr * 64 + cc * 2; return st * 1024 + (ob ^ (((ob >> 9) & 1) << 5)); }
__host__ __device__ __forceinline__ void stage_rc(int b, int& R, int& C) { const int st = b / 1024, sb = b % 1024, swz = sb ^ (((sb >> 9) & 1) << 5); R = (st >> 1) * 16 + swz / 64; C = (st & 1) * 32 + (swz % 64) / 2; }
__host__ __device__ __forceinline__ int perm32(int rho) { const int n = rho >> 4, i = rho & 15; return 8 * (i >> 2) + 4 * n + (i & 3); }

struct Unit { int pm, pn; };
typedef int i32x8 __attribute__((ext_vector_type(8))); typedef int i32x4v __attribute__((ext_vector_type(4)));
__device__ __forceinline__ i32x8 cat8(const bf16x8 a, const bf16x8 b) { const i32x4v x = __builtin_bit_cast(i32x4v, a), y = __builtin_bit_cast(i32x4v, b); return __builtin_shufflevector(x, y, 0, 1, 2, 3, 4, 5, 6, 7); }
struct Gemm { const bf16_t* A; const bf16_t* Bt; int M, N, K, lda, ldb; };

struct StaticOrder {
    int nM, nN, nwg, G, c;
    __host__ __device__ void init(int M, int N, int G_, int c_) { nM = M / BM; nN = N / BM; nwg = nM * nN; G = G_; c = c_; }
    __host__ __device__ bool next(int i, Unit& u) const {
        const long L = (long)i * G + c; if (L >= nwg) return false;
        int wgid = (int)L; { const int q = nwg / NXCD, r = nwg % NXCD, xcd = wgid % NXCD, off = wgid / NXCD; wgid = (xcd < r ? xcd * (q + 1) : r * (q + 1) + (xcd - r) * q) + off; }
        const int nig = WGM * nN, gid = wgid / nig, fm = gid * WGM, gsz = (nM - fm) < WGM ? (nM - fm) : WGM;
        u.pm = fm + ((wgid % nig) % gsz); u.pn = (wgid % nig) / gsz; return true;
    }
    __device__ __forceinline__ void a_ready(const Unit&) const {}
    __device__ __forceinline__ void done(const Unit&) const {}
};

template <class Epi, class Sched, int GABL = 0>
__device__ __forceinline__ void gemm_phase(LAS unsigned char* lds, const int tid, const Gemm g, const Sched& S, const Epi& E) {
    const int  wid = __builtin_amdgcn_readfirstlane(tid >> 6), lane = tid & 63, wr = wid >> 2, wc = wid & 3, fr = lane & 15, fq = lane >> 4;
    const int K = g.K, nt = K / BK;
    unsigned voffA[2], voffB[2];
#pragma unroll
    for (int i = 0; i < 2; ++i) { int R, C; stage_rc(tid * 16 + i * 8192, R, C); const int Rb = Epi::PERM ? ((R & ~31) + perm32(R & 31)) : R;
        voffA[i] = (unsigned)(R * g.lda + C) * 2u; voffB[i] = (unsigned)(Rb * g.ldb + C) * 2u; }
    const size_t kstep = (size_t)(BK * 2);
    const size_t hstepA = (size_t)HALF * g.lda * 2, hstepB = (size_t)HALF * g.ldb * 2;
    const size_t tstepA = 2 * hstepA, tstepB = 2 * hstepB;
    const unsigned ldsw = (unsigned)wid * 1024u;
    const int aoff = lds_byte(wr * 64 + fr, fq * 8), boff = lds_byte(wc * 32 + fr, fq * 8);
#define PG8_SA(b, h) (((b) * 2 + (h)) * HTB)
#define PG8_SB(b, h) ((4 + (b) * 2 + (h)) * HTB)
#define PG8_STAGE(bufoff, gbase, voff) do { if constexpr (!(GABL & 4)) _Pragma("unroll") for (int _i = 0; _i < 2; ++_i) \
        __builtin_amdgcn_global_load_lds((const unsigned*)((const char*)(gbase) + (voff)[_i]), (LAS unsigned*)(lds + (bufoff) + ldsw + _i * 8192), 16, 0, 0); } while (0)
#define PG8_LDA(dst, b, h) do { if constexpr (Epi::FP8) { _Pragma("unroll") for (int m = 0; m < 4; ++m) { const i32x4v lo_ = *(const LAS i32x4v*)(lds + PG8_SA(b, h) + aoff + m * 2048), hi_ = *(const LAS i32x4v*)(lds + PG8_SA(b, h) + aoff + m * 2048 + 1024); \
            dst##8[m] = __builtin_shufflevector(lo_, hi_, 0, 1, 2, 3, 4, 5, 6, 7); } } \
        else { _Pragma("unroll") for (int m = 0; m < 4; ++m) _Pragma("unroll") for (int k = 0; k < 2; ++k) dst[m][k] = *(const LAS bf16x8*)(lds + PG8_SA(b, h) + aoff + m * 2048 + k * 1024); } } while (0)
#define PG8_LDB(dst, b, h) do { if constexpr (Epi::FP8) { _Pragma("unroll") for (int n = 0; n < 2; ++n) { const i32x4v lo_ = *(const LAS i32x4v*)(lds + PG8_SB(b, h) + boff + n * 2048), hi_ = *(const LAS i32x4v*)(lds + PG8_SB(b, h) + boff + n * 2048 + 1024); \
            dst##8[n] = __builtin_shufflevector(lo_, hi_, 0, 1, 2, 3, 4, 5, 6, 7); } } \
        else { _Pragma("unroll") for (int n = 0; n < 2; ++n) _Pragma("unroll") for (int k = 0; k < 2; ++k) dst[n][k] = *(const LAS bf16x8*)(lds + PG8_SB(b, h) + boff + n * 2048 + k * 1024); } } while (0)
#define PG8_MMA(ai, bj, At, Bt) do { __builtin_amdgcn_s_setprio(1); _Pragma("unroll") for (int m = 0; m < 4; ++m) _Pragma("unroll") for (int n = 0; n < 2; ++n) { \
        if constexpr (Epi::FP8) { if constexpr (GABL & 8) asm volatile("" : "+v"(acc[ai][bj][m][n]) : "v"(Bt##8[n]), "v"(At##8[m]), "v"(sc1_)); else asm volatile("v_mfma_scale_f32_16x16x128_f8f6f4 %0, %1, %2, %0, %3, %3 op_sel_hi:[0,0,0]" : "+v"(acc[ai][bj][m][n]) : "v"(Bt##8[n]), "v"(At##8[m]), "v"(sc1_)); } \
        else { _Pragma("unroll") for (int k = 0; k < 2; ++k) acc[ai][bj][m][n] = __builtin_amdgcn_mfma_f32_16x16x32_bf16(Bt[n][k], At[m][k], acc[ai][bj][m][n], 0, 0, 0); } } __builtin_amdgcn_s_setprio(0); } while (0)
#define PG8_WAIT_V(n) asm volatile("s_waitcnt vmcnt(" #n ")" ::: "memory")
#define PG8_WAIT_L(n) asm volatile("s_waitcnt lgkmcnt(" #n ")" ::: "memory")
#define PG8_BAR __builtin_amdgcn_s_barrier()
#define PG8_SCHED __builtin_amdgcn_sched_barrier(0)
    Unit cur, nxt; int ui = 0;
    if (!S.next(0, cur)) return;
    f32x4 acc[2][2][4][2];
#pragma unroll
    for (int a = 0; a < 2; ++a)
#pragma unroll
        for (int b = 0; b < 2; ++b)
#pragma unroll
            for (int m = 0; m < 4; ++m)
#pragma unroll
                for (int n = 0; n < 2; ++n) acc[a][b][m][n] = (f32x4){0.f, 0.f, 0.f, 0.f};
    int sc1_ = 0x7F7F7F7F; asm volatile("" : "+v"(sc1_));
    bf16x8 At[4][2], B0[2][2], B1[2][2]; i32x8 At8[4], B08[2], B18[2];
    const char* cA = (const char*)g.A + (size_t)cur.pm * tstepA; const char* cB = (const char*)g.Bt + (size_t)cur.pn * tstepB;
    S.a_ready(cur);
    PG8_STAGE(PG8_SB(0, 0), cB, voffB); PG8_STAGE(PG8_SA(0, 0), cA, voffA); PG8_STAGE(PG8_SB(0, 1), cB + hstepB, voffB); PG8_STAGE(PG8_SA(0, 1), cA + hstepA, voffA);
    if (wr == 1) PG8_BAR;
    PG8_WAIT_V(4); PG8_BAR;
    PG8_STAGE(PG8_SB(1, 0), cB + kstep, voffB); PG8_STAGE(PG8_SA(1, 0), cA + kstep, voffA); PG8_STAGE(PG8_SB(1, 1), cB + hstepB + kstep, voffB);
    PG8_WAIT_V(6); PG8_BAR;
    for (;;) {
        const bool has_next = S.next(ui + 1, nxt);
        const char* nA = has_next ? (const char*)g.A + (size_t)nxt.pm * tstepA : cA; const char* nB = has_next ? (const char*)g.Bt + (size_t)nxt.pn * tstepB : cB;
#pragma unroll 1
        for (int t = 0; t < nt; t += 2) {
            const bool last = (t == nt - 2);
            const char* a1 = cA + (size_t)(t + 1) * kstep;
            const char* a2 = last ? nA : cA + (size_t)(t + 2) * kstep; const char* b2 = last ? nB : cB + (size_t)(t + 2) * kstep;
            const char* a3 = a2 + kstep; const char* b3 = b2 + kstep;
            if (last && has_next) S.a_ready(nxt);
            PG8_LDB(B0, 0, 0); PG8_SCHED; PG8_LDA(At, 0, 0); PG8_STAGE(PG8_SA(1, 1), a1 + hstepA, voffA);
            PG8_WAIT_L(8); PG8_BAR; PG8_WAIT_L(0); PG8_MMA(0, 0, At, B0); PG8_BAR; PG8_SCHED;
            PG8_LDB(B1, 0, 1); PG8_STAGE(PG8_SB(0, 0), b2, voffB);
            PG8_BAR; PG8_WAIT_L(0); PG8_MMA(0, 1, At, B1); PG8_BAR;
            PG8_LDA(At, 0, 1); PG8_STAGE(PG8_SA(0, 0), a2, voffA);
            PG8_BAR; PG8_WAIT_L(0); PG8_MMA(1, 0, At, B0); PG8_BAR; PG8_SCHED;
            PG8_STAGE(PG8_SB(0, 1), b2 + hstepB, voffB);
            PG8_WAIT_V(6); PG8_BAR; PG8_MMA(1, 1, At, B1); PG8_BAR;
            PG8_LDB(B0, 1, 0); PG8_SCHED; PG8_LDA(At, 1, 0); PG8_STAGE(PG8_SA(0, 1), a2 + hstepA, voffA);
            PG8_WAIT_L(8); PG8_BAR; PG8_WAIT_L(0); PG8_MMA(0, 0, At, B0); PG8_BAR; PG8_SCHED;
            PG8_LDB(B1, 1, 1); PG8_STAGE(PG8_SB(1, 0), b3, voffB);
            PG8_BAR; PG8_WAIT_L(0); PG8_MMA(0, 1, At, B1); PG8_BAR;
            PG8_LDA(At, 1, 1); PG8_STAGE(PG8_SA(1, 0), a3, voffA);
            PG8_BAR; PG8_WAIT_L(0); PG8_MMA(1, 0, At, B0); PG8_BAR; PG8_SCHED;
            PG8_STAGE(PG8_SB(1, 1), b3 + hstepB, voffB);
            PG8_WAIT_V(6); PG8_BAR; PG8_MMA(1, 1, At, B1); PG8_BAR;
        }
        if constexpr (Epi::FP8) asm volatile("s_nop 15\n\ts_nop 15" ::: "memory");
        if constexpr (GABL & 2) { pg8::Unit u2_ = cur; u2_.pm = 0; Epi E2_ = E; E2_.retarget(); E2_(acc, u2_, wr, wc, fr, fq); } else if constexpr (!(GABL & 1)) E(acc, cur, wr, wc, fr, fq); else asm volatile("" :: "v"(acc[0][0][0][0]), "v"(acc[1][1][3][1]), "v"(acc[0][1][2][0]), "v"(acc[1][0][1][1]));
        if (!has_next) break;
#pragma unroll
        for (int a = 0; a < 2; ++a)
#pragma unroll
            for (int b = 0; b < 2; ++b)
#pragma unroll
                for (int m = 0; m < 4; ++m)
#pragma unroll
                    for (int n = 0; n < 2; ++n) acc[a][b][m][n] = (f32x4){0.f, 0.f, 0.f, 0.f};
        cur = nxt; cA = nA; cB = nB; ++ui;
    }
    PG8_WAIT_V(0);
    if (wr == 0) PG8_BAR;
    PG8_BAR;
#undef PG8_SA
#undef PG8_SB
#undef PG8_STAGE
#undef PG8_LDA
#undef PG8_LDB
#undef PG8_MMA
#undef PG8_WAIT_V
#undef PG8_WAIT_L
#undef PG8_BAR
#undef PG8_SCHED
}
}

typedef f32x4 Acc[2][2][4][2];
#define EPI_LOOP_ROWS for (int ai = 0; ai < 2; ++ai) for (int m = 0; m < 4; ++m)
__device__ __forceinline__ u32x4 pack8(const f32x4 a, const f32x4 b) { u32x4 w; w.x = cvt_pk_bf16(a[0], a[1]); w.y = cvt_pk_bf16(a[2], a[3]); w.z = cvt_pk_bf16(b[0], b[1]); w.w = cvt_pk_bf16(b[2], b[3]); return w; }

struct EpiIn {
    static constexpr bool PERM = true, FP8 = true;
    bf16_t* P1; bf16_t* G; float inv;
    __device__ __forceinline__ void retarget() { P1 = (bf16_t*)((char*)P1 - WS_P1 + WS_END); G = P1 + 256 * NP1; }
    __device__ __forceinline__ void operator()(const Acc& acc, const pg8::Unit& u, int wr, int wc, int fr, int fq) const {
        const int row0 = u.pm * 256 + wr * 64 + fr; const bool gate = u.pn >= 16;
        bf16_t* base = gate ? G : P1; const int ld = gate ? NG : NP1; const int col0 = (gate ? (u.pn - 16) : u.pn) * 256 + wc * 32 + 8 * fq;
#pragma unroll
        for (int ai = 0; ai < 2; ++ai)
#pragma unroll
            for (int m = 0; m < 4; ++m) { bf16_t* rowp = base + (size_t)(row0 + ai * 128 + m * 16) * ld + col0;
#pragma unroll
                for (int bj = 0; bj < 2; ++bj) { f32x4 v0 = acc[ai][bj][m][0] * inv, v1 = acc[ai][bj][m][1] * inv;
                    if (gate) {
#pragma unroll
                        for (int j = 0; j < 4; ++j) { v0[j] = sigmoid_f(v0[j]); v1[j] = sigmoid_f(v1[j]); } }
                    *(u32x4*)(rowp + bj * 128) = pack8(v0, v1); } }
    }
};
struct EpiPlain {
    static constexpr bool PERM = true, FP8 = false;
    bf16_t* O; int ldc;
    __device__ __forceinline__ void operator()(const Acc& acc, const pg8::Unit& u, int wr, int wc, int fr, int fq) const {
        const int row0 = u.pm * 256 + wr * 64 + fr; const int col0 = u.pn * 256 + wc * 32 + 8 * fq;
#pragma unroll
        for (int ai = 0; ai < 2; ++ai)
#pragma unroll
            for (int m = 0; m < 4; ++m) { bf16_t* rowp = O + (size_t)(row0 + ai * 128 + m * 16) * ldc + col0;
#pragma unroll
                for (int bj = 0; bj < 2; ++bj) *(u32x4*)(rowp + bj * 128) = pack8(acc[ai][bj][m][0], acc[ai][bj][m][1]); }
    }
};
__device__ __forceinline__ void tile_info(int pm, int& b, int& tpos0, bool& lat) { lat = pm < 64; b = lat ? (pm >> 4) : (pm - 64); tpos0 = lat ? CTXL + ((pm & 15) << 8) : 0; }
struct EpiQup {
    static constexpr bool PERM = true, FP8 = false;
    unsigned char* QM; const f32x2* cs32;
    __device__ __forceinline__ void operator()(const Acc& acc, const pg8::Unit& u, int wr, int wc, int fr, int fq) const {
        int b, tpos0; bool lat; tile_info(u.pm, b, tpos0, lat);
        const int r0 = wr * 64 + fr;
#pragma unroll
        for (int bj = 0; bj < 2; ++bj) { const int c0 = u.pn * 256 + bj * 128 + wc * 32 + 8 * fq; const int hh = c0 / 96, j0 = c0 - hh * 96;
            unsigned char* hb = QM + ((size_t)(b * 8 + hh) * TT + tpos0 + r0) * 128;
            if (j0 < 64) {
#pragma unroll
                for (int ai = 0; ai < 2; ++ai)
#pragma unroll
                    for (int m = 0; m < 4; ++m) { const f32x4 a_ = acc[ai][bj][m][0], b_ = acc[ai][bj][m][1]; u32x2 w8; w8.x = pk4_fp8(clamp8(a_[0]), clamp8(a_[1]), clamp8(a_[2]), clamp8(a_[3])); w8.y = pk4_fp8(clamp8(b_[0]), clamp8(b_[1]), clamp8(b_[2]), clamp8(b_[3]));
                        *(u32x2*)(hb + (ai * 128 + m * 16) * 128 + j0) = w8; }
            } else { const int g8 = (j0 - 64) >> 3, part = g8 >> 1, pbase = (g8 & 1) * 4;
#pragma unroll
                for (int ai = 0; ai < 2; ++ai)
#pragma unroll
                    for (int m = 0; m < 4; ++m) { const int t = tpos0 - CTXL + r0 + ai * 128 + m * 16; const int pos = part ? (t & 63) : (t >> 6);
                        const f32x4 v0 = acc[ai][bj][m][0], v1 = acc[ai][bj][m][1];
                        float o1[4], o2[4]; const float x1[4] = {v0[0], v0[2], v1[0], v1[2]}, x2[4] = {v0[1], v0[3], v1[1], v1[3]};
#pragma unroll
                        for (int p = 0; p < 4; ++p) { const f32x2 cs = lat ? cs32[pos * 8 + pbase + p] : (f32x2){1.f, 0.f};
                            o1[p] = x1[p] * cs.x - x2[p] * cs.y; o2[p] = x1[p] * cs.y + x2[p] * cs.x; }
                        unsigned char* dst = hb + (ai * 128 + m * 16) * 128 + 64 + part * 16 + pbase;
                        *(unsigned*)dst = pk4_fp8(clamp8(o1[0]), clamp8(o1[1]), clamp8(o1[2]), clamp8(o1[3])); *(unsigned*)(dst + 8) = pk4_fp8(clamp8(o2[0]), clamp8(o2[1]), clamp8(o2[2]), clamp8(o2[3])); } } }
    }
};
struct EpiKvup {
    static constexpr bool PERM = true, FP8 = false;
    unsigned char* KM; unsigned char* VM;
    __device__ __forceinline__ void operator()(const Acc& acc, const pg8::Unit& u, int wr, int wc, int fr, int fq) const {
        int b, tpos0; bool lat; tile_info(u.pm, b, tpos0, lat);
        const int r0 = wr * 64 + fr; const int j0 = wc * 32 + 8 * fq;
#pragma unroll
        for (int bj = 0; bj < 2; ++bj) { const size_t tok = (size_t)(b * 8 + u.pn * 2 + bj) * TT + tpos0 + r0;
            if (j0 < 64) { unsigned char* d = KM + tok * 128 + j0;
#pragma unroll
                for (int ai = 0; ai < 2; ++ai)
#pragma unroll
                    for (int m = 0; m < 4; ++m) { const f32x4 a_ = acc[ai][bj][m][0], b_ = acc[ai][bj][m][1]; u32x2 w8; w8.x = pk4_fp8(clamp8(a_[0]), clamp8(a_[1]), clamp8(a_[2]), clamp8(a_[3])); w8.y = pk4_fp8(clamp8(b_[0]), clamp8(b_[1]), clamp8(b_[2]), clamp8(b_[3]));
                        *(u32x2*)(d + (ai * 128 + m * 16) * 128) = w8; } }
            else { unsigned char* d = VM + ((size_t)(b * 8 + u.pn * 2 + bj) * 64 + (j0 - 64)) * TT;
#pragma unroll
                for (int ai = 0; ai < 2; ++ai)
#pragma unroll
                    for (int m = 0; m < 4; ++m) { const f32x4 a_ = acc[ai][bj][m][0], b_ = acc[ai][bj][m][1]; const unsigned w0_ = pk4_fp8(clamp8(a_[0]), clamp8(a_[1]), clamp8(a_[2]), clamp8(a_[3])), w1_ = pk4_fp8(clamp8(b_[0]), clamp8(b_[1]), clamp8(b_[2]), clamp8(b_[3]));
                        unsigned char* q_ = d + vt_off(tpos0 + r0 + ai * 128 + m * 16);
                        q_[0] = (unsigned char)(w0_ & 0xffu); q_[TT] = (unsigned char)((w0_ >> 8) & 0xffu); q_[2 * TT] = (unsigned char)((w0_ >> 16) & 0xffu); q_[3 * TT] = (unsigned char)(w0_ >> 24);
                        q_[4 * TT] = (unsigned char)(w1_ & 0xffu); q_[5 * TT] = (unsigned char)((w1_ >> 8) & 0xffu); q_[6 * TT] = (unsigned char)((w1_ >> 16) & 0xffu); q_[7 * TT] = (unsigned char)(w1_ >> 24); } } }
    }
};
template <int SEG> struct EpiMerge {
    static constexpr bool PERM = true, FP8 = false;
    bf16_t* MB; const bf16_t* G; unsigned char* MB8;
    __device__ __forceinline__ void operator()(const Acc& acc, const pg8::Unit& u, int wr, int wc, int fr, int fq) const {
        const int row0 = u.pm * 256 + wr * 64 + fr; const int col0 = u.pn * 256 + wc * 32 + 8 * fq;
        const bf16_t* gp = G + (size_t)row0 * NG + SEG * 2048 + col0; bf16_t* mp = MB + (size_t)row0 * D + col0; unsigned char* m8 = MB8 + (size_t)row0 * D + col0;
#pragma unroll
        for (int ai = 0; ai < 2; ++ai) {
            u32x4 gw[4][2], ow[4][2];
#pragma unroll
            for (int m = 0; m < 4; ++m)
#pragma unroll
                for (int bj = 0; bj < 2; ++bj) { const size_t ro = (size_t)(ai * 128 + m * 16);
                    gw[m][bj] = *(const u32x4*)(gp + ro * NG + bj * 128);
                    if (SEG > 0) ow[m][bj] = __builtin_nontemporal_load((const u32x4*)(mp + ro * D + bj * 128)); }
#pragma unroll
            for (int m = 0; m < 4; ++m)
#pragma unroll
                for (int bj = 0; bj < 2; ++bj) { const size_t ro = (size_t)(ai * 128 + m * 16); const u32x4 g_ = gw[m][bj];
                    f32x4 v0 = acc[ai][bj][m][0], v1 = acc[ai][bj][m][1];
                    if (ABL_BR & (1 << SEG)) { v0 = (f32x4){0.f, 0.f, 0.f, 0.f}; v1 = v0; }
                    v0[0] *= bflo(g_.x); v0[1] *= bfhi(g_.x); v0[2] *= bflo(g_.y); v0[3] *= bfhi(g_.y);
                    v1[0] *= bflo(g_.z); v1[1] *= bfhi(g_.z); v1[2] *= bflo(g_.w); v1[3] *= bfhi(g_.w);
                    if (SEG > 0) { const u32x4 o = ow[m][bj];
                        v0[0] += bflo(o.x); v0[1] += bfhi(o.x); v0[2] += bflo(o.y); v0[3] += bfhi(o.y);
                        v1[0] += bflo(o.z); v1[1] += bfhi(o.z); v1[2] += bflo(o.w); v1[3] += bfhi(o.w); }
                    if (SEG < 2) *(u32x4*)(mp + ro * D + bj * 128) = pack8(v0, v1);
                    else { u32x2 w8; w8.x = pk4_fp8(clamp8(v0[0] * 16.f), clamp8(v0[1] * 16.f), clamp8(v0[2] * 16.f), clamp8(v0[3] * 16.f)); w8.y = pk4_fp8(clamp8(v1[0] * 16.f), clamp8(v1[1] * 16.f), clamp8(v1[2] * 16.f), clamp8(v1[3] * 16.f));
                        *(u32x2*)(m8 + ro * D + bj * 128) = w8; } }
        }
    }
};
namespace pg8 {
struct Merge3 { const bf16_t* A; const bf16_t* B0; const bf16_t* B1; const bf16_t* B2; const bf16_t* G; unsigned char* MB8; float r01, r12, fin; };
template <class Sched>
__device__ __forceinline__ void gemm_merge3(LAS unsigned char* lds, const int tid, const Merge3 g, const Sched& S) {
    constexpr int GABL = 0;
    const int wid = __builtin_amdgcn_readfirstlane(tid >> 6), lane = tid & 63, wr = wid >> 2, wc = wid & 3, fr = lane & 15, fq = lane >> 4;
    constexpr int NT = 16, LDA = 1024;
    int sc1_ = 0x7F7F7F7F; asm volatile("" : "+v"(sc1_));
    unsigned voffA[2], voffB5[2], voffB10[2];
#pragma unroll
    for (int i = 0; i < 2; ++i) { int R, C; stage_rc(tid * 16 + i * 8192, R, C); const int Rb = (R & ~31) + perm32(R & 31);
        voffA[i] = (unsigned)(R * LDA + C) * 2u; voffB5[i] = (unsigned)(Rb * 256 + C) * 2u; voffB10[i] = (unsigned)(Rb * 512 + C) * 2u; }
    const size_t kstep = (size_t)(BK * 2);
    const size_t hstepA = (size_t)HALF * LDA * 2, tstepA = 2 * hstepA;
    const unsigned ldsw = (unsigned)wid * 1024u;
    const int aoff = lds_byte(wr * 64 + fr, fq * 8), boff = lds_byte(wc * 32 + fr, fq * 8);
#define M3_TA(pm_, t_) ((const char*)g.A + (size_t)(pm_) * tstepA + (size_t)(t_) * kstep)
#define M3_TB(pn_, t_) ((t_) < 4 ? (const char*)g.B0 + (size_t)(pn_) * 131072 + (size_t)(t_) * kstep : ((t_) < 8 ? (const char*)g.B1 + (size_t)(pn_) * 131072 + (size_t)((t_) - 4) * kstep : (const char*)g.B2 + (size_t)(pn_) * 262144 + (size_t)((t_) - 8) * kstep))
#define PG8_SA(b, h) (((b) * 2 + (h)) * HTB)
#define PG8_SB(b, h) ((4 + (b) * 2 + (h)) * HTB)
#define PG8_STAGE(bufoff, gbase, voff) do { if constexpr (!(GABL & 4)) _Pragma("unroll") for (int _i = 0; _i < 2; ++_i) \
        __builtin_amdgcn_global_load_lds((const unsigned*)((const char*)(gbase) + (voff)[_i]), (LAS unsigned*)(lds + (bufoff) + ldsw + _i * 8192), 16, 0, 0); } while (0)
#define PG8_LDA(dst, b, h) do { _Pragma("unroll") for (int m = 0; m < 4; ++m) { const i32x4v lo_ = *(const LAS i32x4v*)(lds + PG8_SA(b, h) + aoff + m * 2048), hi_ = *(const LAS i32x4v*)(lds + PG8_SA(b, h) + aoff + m * 2048 + 1024); dst[m] = __builtin_shufflevector(lo_, hi_, 0, 1, 2, 3, 4, 5, 6, 7); } } while (0)
#define PG8_LDB(dst, b, h) do { _Pragma("unroll") for (int n = 0; n < 2; ++n) { const i32x4v lo_ = *(const LAS i32x4v*)(lds + PG8_SB(b, h) + boff + n * 2048), hi_ = *(const LAS i32x4v*)(lds + PG8_SB(b, h) + boff + n * 2048 + 1024); dst[n] = __builtin_shufflevector(lo_, hi_, 0, 1, 2, 3, 4, 5, 6, 7); } } while (0)
#define PG8_MMA(ai, bj, At, Bt) do { __builtin_amdgcn_s_setprio(1); _Pragma("unroll") for (int m = 0; m < 4; ++m) _Pragma("unroll") for (int n = 0; n < 2; ++n) \
        asm volatile("v_mfma_scale_f32_16x16x128_f8f6f4 %0, %1, %2, %0, %3, %3 op_sel_hi:[0,0,0]" : "+v"(acc[ai][bj][m][n]) : "v"(Bt[n]), "v"(At[m]), "v"(sc1_)); __builtin_amdgcn_s_setprio(0); } while (0)
#define PG8_WAIT_V(n) asm volatile("s_waitcnt vmcnt(" #n ")" ::: "memory")
#define PG8_WAIT_L(n) asm volatile("s_waitcnt lgkmcnt(" #n ")" ::: "memory")
#define PG8_BAR __builtin_amdgcn_s_barrier()
#define PG8_SCHED __builtin_amdgcn_sched_barrier(0)
    Unit cur, nxt; int ui = 0;
    if (!S.next(0, cur)) return;
    f32x4 acc[2][2][4][2];
#pragma unroll
    for (int a = 0; a < 2; ++a)
#pragma unroll
        for (int b = 0; b < 2; ++b)
#pragma unroll
            for (int m = 0; m < 4; ++m)
#pragma unroll
                for (int n = 0; n < 2; ++n) acc[a][b][m][n] = (f32x4){0.f, 0.f, 0.f, 0.f};
    i32x8 At[4], B0[2], B1[2];
    { const char* cA = M3_TA(cur.pm, 0); const char* cB = M3_TB(cur.pn, 0); const size_t hB = 65536;
      PG8_STAGE(PG8_SB(0, 0), cB, voffB5); PG8_STAGE(PG8_SA(0, 0), cA, voffA); PG8_STAGE(PG8_SB(0, 1), cB + hB, voffB5); PG8_STAGE(PG8_SA(0, 1), cA + hstepA, voffA);
      if (wr == 1) PG8_BAR;
      PG8_WAIT_V(4); PG8_BAR;
      PG8_STAGE(PG8_SB(1, 0), cB + kstep, voffB5); PG8_STAGE(PG8_SA(1, 0), cA + kstep, voffA); PG8_STAGE(PG8_SB(1, 1), cB + hB + kstep, voffB5);
      PG8_WAIT_V(6); PG8_BAR; }
    const int r0 = wr * 64 + fr, c0l = wc * 32 + 8 * fq;
    for (;;) {
        const bool has_next = S.next(ui + 1, nxt);
        const int npm = has_next ? nxt.pm : cur.pm, npn = has_next ? nxt.pn : cur.pn;
#pragma unroll 1
        for (int t = 0; t < NT; t += 2) {
            const bool last = (t == NT - 2);
            const int t2 = last ? 0 : t + 2;
            const char* a1 = M3_TA(cur.pm, t + 1);
            const char* a2 = last ? M3_TA(npm, 0) : M3_TA(cur.pm, t + 2); const char* b2 = last ? M3_TB(npn, 0) : M3_TB(cur.pn, t + 2);
            const char* a3 = a2 + kstep; const char* b3 = b2 + kstep;
            const bool wide = t2 >= 8; const size_t hB = wide ? 131072 : 65536;
            unsigned vB[2]; vB[0] = wide ? voffB10[0] : voffB5[0]; vB[1] = wide ? voffB10[1] : voffB5[1];
            PG8_LDB(B0, 0, 0); PG8_SCHED; PG8_LDA(At, 0, 0); PG8_STAGE(PG8_SA(1, 1), a1 + hstepA, voffA);
            PG8_WAIT_L(8); PG8_BAR; PG8_WAIT_L(0); PG8_MMA(0, 0, At, B0); PG8_BAR; PG8_SCHED;
            PG8_LDB(B1, 0, 1); PG8_STAGE(PG8_SB(0, 0), b2, vB);
            PG8_BAR; PG8_WAIT_L(0); PG8_MMA(0, 1, At, B1); PG8_BAR;
            PG8_LDA(At, 0, 1); PG8_STAGE(PG8_SA(0, 0), a2, voffA);
            PG8_BAR; PG8_WAIT_L(0); PG8_MMA(1, 0, At, B0); PG8_BAR; PG8_SCHED;
            PG8_STAGE(PG8_SB(0, 1), b2 + hB, vB);
            PG8_WAIT_V(6); PG8_BAR; PG8_MMA(1, 1, At, B1); PG8_BAR;
            PG8_LDB(B0, 1, 0); PG8_SCHED; PG8_LDA(At, 1, 0); PG8_STAGE(PG8_SA(0, 1), a2 + hstepA, voffA);
            PG8_WAIT_L(8); PG8_BAR; PG8_WAIT_L(0); PG8_MMA(0, 0, At, B0); PG8_BAR; PG8_SCHED;
            PG8_LDB(B1, 1, 1); PG8_STAGE(PG8_SB(1, 0), b3, vB);
            PG8_BAR; PG8_WAIT_L(0); PG8_MMA(0, 1, At, B1); PG8_BAR;
            PG8_LDA(At, 1, 1); PG8_STAGE(PG8_SA(1, 0), a3, voffA);
            PG8_BAR; PG8_WAIT_L(0); PG8_MMA(1, 0, At, B0); PG8_BAR; PG8_SCHED;
            PG8_STAGE(PG8_SB(1, 1), b3 + hB, vB);
            PG8_WAIT_V(6); PG8_BAR; PG8_MMA(1, 1, At, B1); PG8_BAR;
            if (t == 2 || t == 6) {
                asm volatile("s_nop 15\n\ts_nop 15" ::: "memory");
                const int sg = t == 2 ? 0 : 1; const float wr_ = sg ? g.r12 : g.r01;
                const bf16_t* gp = g.G + (size_t)(cur.pm * 256 + r0) * NG + sg * 2048 + cur.pn * 256 + c0l;
#pragma unroll
                for (int ai = 0; ai < 2; ++ai) { u32x4 ga[4][2], gb[4][2];
#pragma unroll
                    for (int m = 0; m < 4; ++m)
#pragma unroll
                        for (int bj = 0; bj < 2; ++bj) { const bf16_t* q_ = gp + (size_t)(ai * 128 + m * 16) * NG + bj * 128; ga[m][bj] = *(const u32x4*)q_; gb[m][bj] = *(const u32x4*)(q_ + 2048); }
#pragma unroll
                    for (int m = 0; m < 4; ++m)
#pragma unroll
                        for (int bj = 0; bj < 2; ++bj) { const u32x4 x_ = ga[m][bj], y_ = gb[m][bj];
#define M3_RT(xw, yw, lohi) (fmaxf(lohi(xw), 1e-6f) * wr_ * __builtin_amdgcn_rcpf(fmaxf(lohi(yw), 1e-6f)))
                            acc[ai][bj][m][0][0] *= M3_RT(x_.x, y_.x, bflo); acc[ai][bj][m][0][1] *= M3_RT(x_.x, y_.x, bfhi); acc[ai][bj][m][0][2] *= M3_RT(x_.y, y_.y, bflo); acc[ai][bj][m][0][3] *= M3_RT(x_.y, y_.y, bfhi);
                            acc[ai][bj][m][1][0] *= M3_RT(x_.z, y_.z, bflo); acc[ai][bj][m][1][1] *= M3_RT(x_.z, y_.z, bfhi); acc[ai][bj][m][1][2] *= M3_RT(x_.w, y_.w, bflo); acc[ai][bj][m][1][3] *= M3_RT(x_.w, y_.w, bfhi); } }
                asm volatile("s_waitcnt vmcnt(0)" ::: "memory");
            }
        }
        asm volatile("s_nop 15\n\ts_nop 15" ::: "memory");
        { const bf16_t* gp = g.G + (size_t)(cur.pm * 256 + r0) * NG + 2 * 2048 + cur.pn * 256 + c0l; unsigned char* m8 = g.MB8 + (size_t)(cur.pm * 256 + r0) * D + cur.pn * 256 + c0l;
#pragma unroll
          for (int ai = 0; ai < 2; ++ai) { u32x4 gc[4][2];
#pragma unroll
              for (int m = 0; m < 4; ++m)
#pragma unroll
                  for (int bj = 0; bj < 2; ++bj) gc[m][bj] = *(const u32x4*)(gp + (size_t)(ai * 128 + m * 16) * NG + bj * 128);
#pragma unroll
              for (int m = 0; m < 4; ++m)
#pragma unroll
                  for (int bj = 0; bj < 2; ++bj) { const u32x4 z_ = gc[m][bj]; const f32x4 v0 = acc[ai][bj][m][0], v1 = acc[ai][bj][m][1];
                      u32x2 w8; const float f_ = g.fin;
                      w8.x = pk4_fp8(clamp8(v0[0] * fmaxf(bflo(z_.x), 1e-6f) * f_), clamp8(v0[1] * fmaxf(bfhi(z_.x), 1e-6f) * f_), clamp8(v0[2] * fmaxf(bflo(z_.y), 1e-6f) * f_), clamp8(v0[3] * fmaxf(bfhi(z_.y), 1e-6f) * f_));
                      w8.y = pk4_fp8(clamp8(v1[0] * fmaxf(bflo(z_.z), 1e-6f) * f_), clamp8(v1[1] * fmaxf(bfhi(z_.z), 1e-6f) * f_), clamp8(v1[2] * fmaxf(bflo(z_.w), 1e-6f) * f_), clamp8(v1[3] * fmaxf(bfhi(z_.w), 1e-6f) * f_));
                      *(u32x2*)(m8 + (size_t)(ai * 128 + m * 16) * D + bj * 128) = w8; } } }
        if (!has_next) break;
#pragma unroll
        for (int a = 0; a < 2; ++a)
#pragma unroll
            for (int b = 0; b < 2; ++b)
#pragma unroll
                for (int m = 0; m < 4; ++m)
#pragma unroll
                    for (int n = 0; n < 2; ++n) acc[a][b][m][n] = (f32x4){0.f, 0.f, 0.f, 0.f};
        cur = nxt; ++ui;
    }
    PG8_WAIT_V(0);
    if (wr == 0) PG8_BAR;
    PG8_BAR;
#undef M3_RT
#undef M3_TA
#undef M3_TB
#undef PG8_SA
#undef PG8_SB
#undef PG8_STAGE
#undef PG8_LDA
#undef PG8_LDB
#undef PG8_MMA
#undef PG8_WAIT_V
#undef PG8_WAIT_L
#undef PG8_BAR
#undef PG8_SCHED
}
}
struct EpiOut {
    static constexpr bool PERM = false, FP8 = true;
    const float* src_lat; const float* src_ctx; float* dst_lat; float* dst_ctx; const float* g1; float inv;
    __device__ __forceinline__ void operator()(const Acc& acc, const pg8::Unit& u, int wr, int wc, int fr, int fq) const {
        const int row0 = u.pm * 256 + wr * 64 + fr; const int col0 = u.pn * 256 + wc * 32 + 4 * fq;
        const bool lat = (u.pm * 256) < NLAT;
        const float* src = (lat ? src_lat : src_ctx - (size_t)NLAT * D) + (size_t)row0 * D + col0; float* dst = (lat ? dst_lat : dst_ctx - (size_t)NLAT * D) + (size_t)row0 * D + col0;
#pragma unroll
        for (int ai = 0; ai < 2; ++ai) { const int rbase = u.pm * 256 + ai * 128 + wr * 64; const int v = lat ? (rbase >> 12) : 4; const float* gp = g1 + (size_t)v * 12288 + col0;
            f32x4 gg[2][2];
#pragma unroll
            for (int bj = 0; bj < 2; ++bj)
#pragma unroll
                for (int n = 0; n < 2; ++n) gg[bj][n] = *(const f32x4*)(gp + bj * 128 + n * 16);
#pragma unroll
            for (int mh = 0; mh < 2; ++mh) {
                f32x4 xr[2][2][2];
#pragma unroll
                for (int mm = 0; mm < 2; ++mm)
#pragma unroll
                    for (int bj = 0; bj < 2; ++bj)
#pragma unroll
                        for (int n = 0; n < 2; ++n) xr[mm][bj][n] = __builtin_nontemporal_load((const f32x4*)(src + (size_t)(ai * 128 + (mh * 2 + mm) * 16) * D + bj * 128 + n * 16));
#pragma unroll
                for (int mm = 0; mm < 2; ++mm)
#pragma unroll
                    for (int bj = 0; bj < 2; ++bj)
#pragma unroll
                        for (int n = 0; n < 2; ++n) { const int m = mh * 2 + mm;
                            *(f32x4*)(dst + (size_t)(ai * 128 + m * 16) * D + bj * 128 + n * 16) = ABL_MIX ? xr[mm][bj][n] * ALPHA : xr[mm][bj][n] * ALPHA + gg[bj][n] * (acc[ai][bj][m][n] * inv); } } }
    }
};

struct Args { const float* in[27]; float* out; unsigned char* ws; int ph_lo, ph_hi; };
typedef const Args __attribute__((address_space(4)))* ArgP;
struct Frame {
    LAS unsigned char* lds; int tid, lane, wave, G, bid;
    ArgP ap; float* out; unsigned char* ws;
    __device__ __forceinline__ const float* in(int i) const { return ap->in[i]; }
};
__device__ __forceinline__ Frame make_frame(ArgP ap) {
    { unsigned long long t = (unsigned long long)ap; asm volatile("" : "+s"(t)); ap = (ArgP)t; }
    extern __shared__ __attribute__((aligned(16))) unsigned char lds_raw[];
    Frame F; F.lds = (LAS unsigned char*)lds_raw; { int t_ = threadIdx.x; asm volatile("" : "+v"(t_)); F.tid = t_; }
    F.lane = F.tid & 63; F.wave = __builtin_amdgcn_readfirstlane(F.tid >> 6); F.G = gridDim.x; F.bid = blockIdx.x;
    F.ap = ap; F.out = ap->out; F.ws = ap->ws; return F;
}
template <class T> __device__ __forceinline__ T* wsp(const Frame& F, size_t off) { return (T*)(F.ws + off); }

__device__ __forceinline__ int win_col(int n) {
    if (n < 768) return n;
    if (n < 1792) return 2336 + (n - 768);
    if (n < 2048) return 3360 + (n - 1792);
    if (n < 2304) return 3616 + (n - 2048);
    if (n < 2560) return 800 + (n - 2304);
    if (n < 2816) return 1056 + (n - 2560);
    if (n < 3328) return 1312 + (n - 2816);
    if (n < 3840) return 1824 + (n - 3328);
    if (n < 3872) return 768 + (n - 3840);
    if (n < 4096) return -1;
    return 3872 + (n - 4096);
}
__device__ __forceinline__ int qup_col(int c) {
    const int hh = c / 96, j = c - hh * 96;
    if (j < 64) return c;
    const int jj = j - 64, g8 = jj >> 3, i = jj & 7, p = i >> 1, which = i & 1, part = g8 >> 1, pi = (g8 & 1) * 4 + p;
    return hh * 96 + 64 + part * 16 + which * 8 + pi;
}
template <int MAP>
__device__ __forceinline__ void transpose_cvt(const Frame& F, const float* __restrict__ src, bf16_t* __restrict__ dst, int K, int Nsrc, int Nd) {
    LAS float* tile = (LAS float*)F.lds;
    const int tk = K / 256, tn = Nd / 64, ntile = tk * tn;
    for (int t = F.bid; t < ntile; t += F.G) {
        const int k0 = (t % tk) * 256, n0 = (t / tk) * 64;
        const int nl = F.tid & 63, kq = F.tid >> 6;
        const int nd = n0 + nl; const int ns = MAP == 0 ? nd : (MAP == 1 ? win_col(nd) : qup_col(nd));
        float v[32];
#pragma unroll
        for (int i = 0; i < 32; ++i) v[i] = ns >= 0 ? src[(size_t)(k0 + kq + 8 * i) * Nsrc + ns] : 0.f;
#pragma unroll
        for (int i = 0; i < 32; ++i) tile[(kq + 8 * i) * 65 + nl] = v[i];
        __syncthreads();
        { const int n = F.tid >> 3, k32 = (F.tid & 7) * 32;
#pragma unroll
          for (int c = 0; c < 4; ++c) { float w[8];
#pragma unroll
              for (int j = 0; j < 8; ++j) w[j] = tile[(k32 + c * 8 + j) * 65 + n];
              u32x4 o; o.x = cvt_pk_bf16(w[0], w[1]); o.y = cvt_pk_bf16(w[2], w[3]); o.z = cvt_pk_bf16(w[4], w[5]); o.w = cvt_pk_bf16(w[6], w[7]);
              *(u32x4*)(dst + (size_t)(n0 + n) * K + k0 + k32 + c * 8) = o; } }
        __syncthreads();
    }
}
__device__ __forceinline__ void cvt_rows(const Frame& F, const float* __restrict__ src, bf16_t* __restrict__ dst, size_t n8) {
    for (size_t i = (size_t)F.bid * 512 + F.tid; i < n8; i += (size_t)F.G * 512) {
        const f32x4 a = __builtin_nontemporal_load((const f32x4*)(src + i * 8)), b = __builtin_nontemporal_load((const f32x4*)(src + i * 8 + 4));
        *(u32x4*)(dst + i * 8) = pack8(a, b);
    }
}
__device__ __forceinline__ void cvt_peer(const Frame& F, int l);
__device__ __forceinline__ float max4abs(float am, const f32x4 a) { return fmaxf(fmaxf(fmaxf(am, fabsf(a[0])), fabsf(a[1])), fmaxf(fabsf(a[2]), fabsf(a[3]))); }
__device__ __forceinline__ void absmax_commit(const Frame& F, float am, unsigned* dst) {
    am = row16_max(am);
    { auto r = __builtin_amdgcn_permlane16_swap(__float_as_uint(am), __float_as_uint(am), false, false); am = fmaxf(__uint_as_float(r[0]), __uint_as_float(r[1])); }
    { auto r = __builtin_amdgcn_permlane32_swap(__float_as_uint(am), __float_as_uint(am), false, false); am = fmaxf(__uint_as_float(r[0]), __uint_as_float(r[1])); }
    if (F.lane == 0) atomicMax(dst, __float_as_uint(am));
}
template <int NB>
__device__ __forceinline__ void absmax_f32(const Frame& F, const float* __restrict__ src, size_t n4, unsigned* dst) {
    float am = 0.f;
    const size_t stride = (size_t)F.G * 512; size_t i = (size_t)F.bid * 512 + F.tid;
    for (; i < n4; i += NB * stride) { f32x4 a[NB];
#pragma unroll
        for (int j = 0; j < NB; ++j) { const size_t ix = i + j * stride; a[j] = ix < n4 ? __builtin_nontemporal_load((const f32x4*)(src + ix * 4)) : (f32x4){0.f, 0.f, 0.f, 0.f}; }
#pragma unroll
        for (int j = 0; j < NB; ++j) am = max4abs(am, a[j]); }
    absmax_commit(F, am, dst);
}
__device__ __forceinline__ void absmax4_f32(const Frame& F, const float* s0, size_t n0, unsigned* d0, const float* s1, size_t n1, unsigned* d1, const float* s2, size_t n2, unsigned* d2, const float* s3, size_t n3, unsigned* d3) {
    const size_t stride = (size_t)F.G * 512, i0 = (size_t)F.bid * 512 + F.tid;
    f32x4 a0[2], a1[2], a2[4], a3[8];
#define AM4_LD(a, NB, s, n) _Pragma("unroll") for (int j = 0; j < NB; ++j) { const size_t ix = i0 + j * stride; a[j] = ix < n ? __builtin_nontemporal_load((const f32x4*)(s + ix * 4)) : (f32x4){0.f, 0.f, 0.f, 0.f}; }
    AM4_LD(a0, 2, s0, n0) AM4_LD(a1, 2, s1, n1) AM4_LD(a2, 4, s2, n2) AM4_LD(a3, 8, s3, n3)
#undef AM4_LD
#define AM4_RED(a, NB, s, n, d) { float am = 0.f; _Pragma("unroll") for (int j = 0; j < NB; ++j) am = max4abs(am, a[j]); \
        for (size_t i = i0 + NB * stride; i < n; i += stride) am = max4abs(am, *(const f32x4*)(s + i * 4)); absmax_commit(F, am, d); }
    AM4_RED(a0, 2, s0, n0, d0) AM4_RED(a1, 2, s1, n1, d1) AM4_RED(a2, 4, s2, n2, d2) AM4_RED(a3, 8, s3, n3, d3)
#undef AM4_RED
}
template <int MAP>
__device__ __forceinline__ void transpose_fp8(const Frame& F, const float* __restrict__ src, unsigned char* __restrict__ dst, int K, int Nsrc, int Nd, const unsigned* wsc) {
    float mul, inv; fp8_scale(__hip_atomic_load(wsc, __ATOMIC_RELAXED, __HIP_MEMORY_SCOPE_AGENT), mul, inv);
    LAS float* tile = (LAS float*)F.lds;
    const int tk = K / 256, tn = Nd / 64, ntile = tk * tn;
    for (int t = F.bid; t < ntile; t += F.G) {
        const int k0 = (t % tk) * 256, n0 = (t / tk) * 64;
        const int nl = F.tid & 63, kq = F.tid >> 6; const int ns = MAP ? win_col(n0 + nl) : n0 + nl;
        float v[32];
#pragma unroll
        for (int i = 0; i < 32; ++i) v[i] = ns >= 0 ? src[(size_t)(k0 + kq + 8 * i) * Nsrc + ns] : 0.f;
#pragma unroll
        for (int i = 0; i < 32; ++i) tile[(kq + 8 * i) * 65 + nl] = v[i] * mul;
        __syncthreads();
        { const int n = F.tid >> 3, k32 = (F.tid & 7) * 32;
#pragma unroll
          for (int c = 0; c < 2; ++c) { float w[16];
#pragma unroll
              for (int j = 0; j < 16; ++j) w[j] = tile[(k32 + c * 16 + j) * 65 + n];
              u32x4 o; o.x = pk4_fp8(w[0], w[1], w[2], w[3]); o.y = pk4_fp8(w[4], w[5], w[6], w[7]); o.z = pk4_fp8(w[8], w[9], w[10], w[11]); o.w = pk4_fp8(w[12], w[13], w[14], w[15]);
              *(u32x4*)(dst + (size_t)(n0 + n) * K + k0 + k32 + c * 16) = o; } }
        __syncthreads();
    }
}
template <int PART = 7>
__device__ __forceinline__ void p0_prologue(const Frame& F) {
    { const int gi = F.bid * 512 + F.tid;
      if (gi < 64 * 8) { const int pos = gi >> 3, f = gi & 7; const float inv = powf(10000.f, -(float)f / 8.f); const float a = (float)pos * inv; wsp<f32x2>(F, WS_ROPE32)[gi] = (f32x2){cosf(a), sinf(a)}; }
      else if (gi < 64 * 8 + 64 * 32) { const int g2 = gi - 512; const int pos = g2 >> 5, f = g2 & 31; const float inv = powf(10000.f, -(float)f / 32.f); const float a = (float)pos * inv; wsp<f32x2>(F, WS_ROPE128)[g2] = (f32x2){cosf(a), sinf(a)}; } }
    if (F.bid == 0 && F.tid < 32) wsp<float>(F, WS_DEC)[F.tid] = -log1pf(expf(-F.in(11)[F.tid])) * LOG2E;
    if constexpr (PART & 1) { LAS float* sl = (LAS float*)F.lds;
      float* modp = wsp<float>(F, WS_MODP);
      for (int u = F.bid; u < 2 * 24 * 16; u += F.G) {
          const int kc = u & 15, cb = (u >> 4) % 24, l = u / (16 * 24);
          __syncthreads();
          for (int i = F.tid; i < 640; i += 512) { const int v = i >> 7, k = kc * 128 + (i & 127); const float c = v < 4 ? F.in(1)[v * 2048 + k] : F.in(3)[k]; sl[i] = silu_f(c); }
          __syncthreads();
          const int col = cb * 512 + F.tid; const float* w = F.in(4) + ((size_t)l * 2048 + kc * 128) * 12288 + col;
          float a0 = 0.f, a1 = 0.f, a2 = 0.f, a3 = 0.f, a4 = 0.f;
#pragma unroll 32
          for (int k = 0; k < 128; ++k) { const float wv = w[(size_t)k * 12288]; a0 += sl[k] * wv; a1 += sl[128 + k] * wv; a2 += sl[256 + k] * wv; a3 += sl[384 + k] * wv; a4 += sl[512 + k] * wv; }
          float* o = modp + ((size_t)(kc * 2 + l) * 5) * 12288 + col;
          o[0] = a0; o[12288] = a1; o[2 * 12288] = a2; o[3 * 12288] = a3; o[4 * 12288] = a4;
      }
      __syncthreads(); }
    if constexpr (PART & 2) for (int l = 0; l < 2; ++l) {
        absmax_f32<16>(F, F.in(6) + (size_t)l * 2048 * NIN, (size_t)2048 * NIN / 4, wsp<unsigned>(F, WS_WSC) + l);
        absmax4_f32(F, F.in(14) + (size_t)l * 512 * 2048, (size_t)512 * 2048 / 4, wsp<unsigned>(F, WS_WSC) + 4 + l, F.in(15) + (size_t)l * 512 * 2048, (size_t)512 * 2048 / 4, wsp<unsigned>(F, WS_WSC) + 6 + l,
                    F.in(16) + (size_t)l * 1024 * 2048, (size_t)1024 * 2048 / 4, wsp<unsigned>(F, WS_WSC) + 8 + l, F.in(17) + (size_t)l * 2048 * 2048, (size_t)2048 * 2048 / 4, wsp<unsigned>(F, WS_WSC) + 2 + l);
        transpose_cvt<2>(F, F.in(8) + (size_t)l * 512 * 768, wsp<bf16_t>(F, WS_WQUP + l * SZ_WQUP), 512, 768, 768);
        transpose_cvt<0>(F, F.in(10) + (size_t)l * 256 * 1024, wsp<bf16_t>(F, WS_WKVUP + l * SZ_WKVUP), 256, 1024, 1024);
        transpose_cvt<0>(F, F.in(20) + (size_t)l * 2048 * 1024, wsp<bf16_t>(F, WS_WPQ + l * SZ_WPQ), 2048, 1024, 1024);
    }
    if constexpr (PART & 4) cvt_peer(F, 0);
}
__device__ __forceinline__ void p1_modreduce(const Frame& F) {
    const float* modp = wsp<float>(F, WS_MODP); float* mod = wsp<float>(F, WS_MOD);
    for (int i = F.bid * 512 + F.tid; i < 2 * 5 * 12288; i += F.G * 512) {
        const int j = i % 12288, l = i / (5 * 12288);
        float s = F.in(5)[l * 12288 + j];
#pragma unroll
        for (int kc = 0; kc < 16; ++kc) s += modp[(size_t)kc * (2 * 5 * 12288) + i];
        mod[i] = s;
    }
    for (int l = 0; l < 2; ++l) {
        transpose_fp8<1>(F, F.in(6) + (size_t)l * 2048 * NIN, wsp<unsigned char>(F, WS_WIN + l * SZ_WIN), 2048, NIN, NPT, wsp<unsigned>(F, WS_WSC) + l);
        transpose_fp8<0>(F, F.in(17) + (size_t)l * 2048 * 2048, wsp<unsigned char>(F, WS_WOUT + l * SZ_WOUT), 2048, 2048, 2048, wsp<unsigned>(F, WS_WSC) + 2 + l);
        transpose_fp8<0>(F, F.in(14) + (size_t)l * 512 * 2048, wsp<unsigned char>(F, WS_WBRA + l * SZ_WBRA), 512, 2048, 2048, wsp<unsigned>(F, WS_WSC) + 4 + l);
        transpose_fp8<0>(F, F.in(15) + (size_t)l * 512 * 2048, wsp<unsigned char>(F, WS_WBRB + l * SZ_WBRB), 512, 2048, 2048, wsp<unsigned>(F, WS_WSC) + 6 + l);
        transpose_fp8<0>(F, F.in(16) + (size_t)l * 1024 * 2048, wsp<unsigned char>(F, WS_WBRC + l * SZ_WBRC), 1024, 2048, 2048, wsp<unsigned>(F, WS_WSC) + 8 + l);
    }
}
__device__ __forceinline__ void ld_row_f32(const float* p, int lane, float (&x)[32]) {
#pragma unroll
    for (int q = 0; q < 4; ++q) { const f32x4 a = *(const f32x4*)(p + 512 * q + 8 * lane), b = *(const f32x4*)(p + 512 * q + 8 * lane + 4);
        x[q * 8 + 0] = a[0]; x[q * 8 + 1] = a[1]; x[q * 8 + 2] = a[2]; x[q * 8 + 3] = a[3]; x[q * 8 + 4] = b[0]; x[q * 8 + 5] = b[1]; x[q * 8 + 6] = b[2]; x[q * 8 + 7] = b[3]; }
}
__device__ __forceinline__ void st_row_f32(float* p, int lane, const float (&x)[32]) {
#pragma unroll
    for (int q = 0; q < 4; ++q) { *(f32x4*)(p + 512 * q + 8 * lane) = (f32x4){x[q * 8 + 0], x[q * 8 + 1], x[q * 8 + 2], x[q * 8 + 3]}; *(f32x4*)(p + 512 * q + 8 * lane + 4) = (f32x4){x[q * 8 + 4], x[q * 8 + 5], x[q * 8 + 6], x[q * 8 + 7]}; }
}
__device__ __forceinline__ void st_row_bf16(bf16_t* p, int lane, const float (&x)[32]) {
#pragma unroll
    for (int q = 0; q < 4; ++q) { u32x4 w; w.x = cvt_pk_bf16(x[q * 8 + 0], x[q * 8 + 1]); w.y = cvt_pk_bf16(x[q * 8 + 2], x[q * 8 + 3]); w.z = cvt_pk_bf16(x[q * 8 + 4], x[q * 8 + 5]); w.w = cvt_pk_bf16(x[q * 8 + 6], x[q * 8 + 7]);
        *(u32x4*)(p + 512 * q + 8 * lane) = w; }
}
__device__ __forceinline__ void p_modulate0(const Frame& F) {
    const float* mod = wsp<float>(F, WS_MOD); unsigned char* hb8 = wsp<unsigned char>(F, WS_HB8);
    for (int row = F.bid * 8 + F.wave; row < NROW; row += F.G * 8) {
        const RowInfo ri = rowinfo(row);
        const float* xp = ri.lat ? F.in(0) + (size_t)row * D : F.in(2) + (size_t)(row - NLAT) * D;
        const float* mp = mod + (size_t)ri.v * 12288;
        float x[32], sh[32], sc[32];
        ld_row_f32(xp, F.lane, x); ld_row_f32(mp, F.lane, sh); ld_row_f32(mp + 2048, F.lane, sc);
#pragma unroll
        for (int i = 0; i < 32; ++i) x[i] = clamp8(x[i] * (1.f + sc[i]) + sh[i]);
#pragma unroll
        for (int q = 0; q < 4; ++q) { u32x2 w; w.x = pk4_fp8(x[q * 8 + 0], x[q * 8 + 1], x[q * 8 + 2], x[q * 8 + 3]); w.y = pk4_fp8(x[q * 8 + 4], x[q * 8 + 5], x[q * 8 + 6], x[q * 8 + 7]); *(u32x2*)(hb8 + (size_t)row * D + 512 * q + 8 * F.lane) = w; }
    }
}
__device__ __forceinline__ void p_post(const Frame& F, int l) {
    const bf16_t* P1 = wsp<bf16_t>(F, WS_P1);
    bf16_t* CQN = wsp<bf16_t>(F, WS_CQN); bf16_t* CKVN = wsp<bf16_t>(F, WS_CKVN);
    unsigned char* QG = wsp<unsigned char>(F, WS_QG); unsigned char* KG = wsp<unsigned char>(F, WS_KG); unsigned char* VG = wsp<unsigned char>(F, WS_VG);
    bf16_t* RQ = wsp<bf16_t>(F, WS_RQ); bf16_t* RK = wsp<bf16_t>(F, WS_RK); bf16_t* RV = wsp<bf16_t>(F, WS_RV);
    unsigned char* KM = wsp<unsigned char>(F, WS_KM); unsigned char* QM = wsp<unsigned char>(F, WS_QM);
    const f32x2* cs32 = wsp<f32x2>(F, WS_ROPE32); const f32x2* cs128 = wsp<f32x2>(F, WS_ROPE128);
    const float* gq_n = F.in(7) + l * 512; const float* gkv_n = F.in(9) + l * 256; const float* gqa_qn = F.in(12) + l * 128; const float* gqa_kn = F.in(13) + l * 128;
    LAS bf16_t* rs = (LAS bf16_t*)(F.lds + F.wave * 8192);
    const int lane = F.lane;
    const f32x4 gq0 = *(const f32x4*)(gq_n + lane * 8), gq1 = *(const f32x4*)(gq_n + lane * 8 + 4), gkv0 = *(const f32x4*)(gkv_n + lane * 4);
    const int gd0 = 2 * lane; const int gpart = gd0 >> 6, gdd = gd0 & 63; const bool glo = gdd < 32; const int gf = glo ? gdd : gdd - 32; const int gdp = glo ? gd0 + 32 : gd0 - 32;
    const float qn0 = gqa_qn[gd0], qn1 = gqa_qn[gd0 + 1], qnp0 = gqa_qn[gdp], qnp1 = gqa_qn[gdp + 1];
    const float kn0 = gqa_kn[gd0], kn1 = gqa_kn[gd0 + 1], knp0 = gqa_kn[gdp], knp1 = gqa_kn[gdp + 1];
    const int rhh = lane >> 3, rd0 = (lane & 7) * 4; const int rpart = rd0 >> 4, rdd = rd0 & 15; const bool rlo = rdd < 8; const int rf = rlo ? rdd : rdd - 8; const int rdp = rlo ? rd0 + 8 : rd0 - 8;
    const int step = F.G * 8;
    int row = F.bid * 8 + F.wave;
    u32x4 pre[8];
    if (row < NROW) {
#pragma unroll
        for (int q = 0; q < 8; ++q) pre[q] = *(const u32x4*)(P1 + (size_t)row * NP1 + q * 512 + lane * 8); }
#pragma unroll 1
    for (; row < NROW; row += step) {
        const RowInfo ri = rowinfo(row);
        const int posg = gpart ? ri.pc : ri.pr, posr = rpart ? ri.pc : ri.pr;
        const f32x2 one = {1.f, 0.f};
        const f32x2 csA = ri.lat ? cs128[posg * 32 + gf] : one, csB = ri.lat ? cs128[posg * 32 + gf + 1] : one;
        f32x2 cs[4];
#pragma unroll
        for (int i = 0; i < 4; ++i) cs[i] = ri.lat ? cs32[posr * 8 + rf + i] : one;
#pragma unroll
        for (int q = 0; q < 8; ++q) *(LAS u32x4*)(rs + q * 512 + lane * 8) = pre[q];
        { const int nrow = row + step; if (nrow < NROW) {
#pragma unroll
            for (int q = 0; q < 8; ++q) pre[q] = *(const u32x4*)(P1 + (size_t)nrow * NP1 + q * 512 + lane * 8); } }
        asm volatile("s_waitcnt lgkmcnt(0)" ::: "memory");
        { float x[8]; float ss = 0.f;
#pragma unroll
          for (int i = 0; i < 8; ++i) { x[i] = bf2f(rs[C_CQ + lane * 8 + i]); ss += x[i] * x[i]; }
          ss = wave_sum(ss); const float r = rsqrtf(ss * (1.f / 512.f) + RMS_EPS);
          *(u32x4*)(CQN + (size_t)row * 512 + lane * 8) = pack8((f32x4){x[0] * r * gq0[0], x[1] * r * gq0[1], x[2] * r * gq0[2], x[3] * r * gq0[3]}, (f32x4){x[4] * r * gq1[0], x[5] * r * gq1[1], x[6] * r * gq1[2], x[7] * r * gq1[3]}); }
        { float x[4]; float ss = 0.f;
#pragma unroll
          for (int i = 0; i < 4; ++i) { x[i] = bf2f(rs[C_CKV + lane * 4 + i]); ss += x[i] * x[i]; }
          ss = wave_sum(ss); const float r = rsqrtf(ss * (1.f / 256.f) + RMS_EPS);
          u32x2 w; w.x = cvt_pk_bf16(x[0] * r * gkv0[0], x[1] * r * gkv0[1]); w.y = cvt_pk_bf16(x[2] * r * gkv0[2], x[3] * r * gkv0[3]);
          *(u32x2*)(CKVN + (size_t)row * 256 + lane * 4) = w; }
        {
            const int d0 = gd0, dp = gdp; const bool lo = glo;
#pragma unroll 1
            for (int hh = 0; hh < 10; ++hh) {
                const bool isq = hh < 8; const int cbase = isq ? C_GQ + hh * 128 : C_GK + (hh - 8) * 128;
                const float g0 = isq ? qn0 : kn0, g1 = isq ? qn1 : kn1, gp0 = isq ? qnp0 : knp0, gp1 = isq ? qnp1 : knp1;
                const float a0 = bf2f(rs[cbase + d0]), a1 = bf2f(rs[cbase + d0 + 1]);
                float ss = wave_sum(a0 * a0 + a1 * a1); const float r = rsqrtf(ss * (1.f / 128.f) + RMS_EPS);
                const float n0 = a0 * r * g0, n1 = a1 * r * g1;
                const float p0 = bf2f(rs[cbase + dp]) * r * gp0, p1 = bf2f(rs[cbase + dp + 1]) * r * gp1;
                float o0, o1;
                if (lo) { o0 = n0 * csA.x - p0 * csA.y; o1 = n1 * csB.x - p1 * csB.y; }
                else    { o0 = p0 * csA.y + n0 * csA.x; o1 = p1 * csB.y + n1 * csB.x; }
                unsigned char* dst = isq ? QG + ((size_t)(ri.b * 8 + hh) * TT + ri.tpos) * 128 : KG + ((size_t)(ri.b * 2 + (hh - 8)) * TT + ri.tpos) * 128;
                *(unsigned short*)(dst + d0) = (unsigned short)(pk4_fp8(clamp8(o0), clamp8(o1), 0.f, 0.f) & 0xffffu);
            }
#pragma unroll
            for (int hh = 0; hh < 2; ++hh) { const unsigned w8_ = pk4_fp8(clamp8(bf2f(rs[C_GV + hh * 128 + d0])), clamp8(bf2f(rs[C_GV + hh * 128 + d0 + 1])), 0.f, 0.f); unsigned char* vp_ = VG + ((size_t)(ri.b * 2 + hh) * 128 + d0) * TT + vt_off(ri.tpos);
                vp_[0] = (unsigned char)(w8_ & 0xffu); vp_[TT] = (unsigned char)((w8_ >> 8) & 0xffu); }
        }
        {
            const int hh = rhh, d0 = rd0, dp = rdp; const bool lo = rlo;
#pragma unroll
            for (int which = 0; which < 2; ++which) {
                const int cbase = (which ? C_RK : C_RQ) + hh * 32; const float sc = which ? 0.17677669529663687f : 1.f;
                float o[4];
#pragma unroll
                for (int i = 0; i < 4; ++i) { const float n = bf2f(rs[cbase + d0 + i]), p = bf2f(rs[cbase + dp + i]);
                    o[i] = (lo ? (n * cs[i].x - p * cs[i].y) : (p * cs[i].y + n * cs[i].x)) * sc; }
                u32x2 w; w.x = cvt_pk_bf16(o[0], o[1]); w.y = cvt_pk_bf16(o[2], o[3]);
                *(u32x2*)((which ? RK : RQ) + ((size_t)(ri.b * 8 + hh) * TT + ri.tpos) * 32 + d0) = w;
            }
            { const int vh = lane >> 3, e0 = (lane & 7) * 8;
              *(u32x4*)(RV + ((size_t)(ri.b * 8 + vh) * TT + ri.tpos) * 64 + e0) = *(LAS u32x4*)(rs + C_RV + lane * 8); }
            { float o[4];
#pragma unroll
              for (int i = 0; i < 4; ++i) { const float n = bf2f(rs[C_KR + d0 + i]), p = bf2f(rs[C_KR + dp + i]); o[i] = lo ? (n * cs[i].x - p * cs[i].y) : (p * cs[i].y + n * cs[i].x); }
              const size_t tok_ = ((size_t)(ri.b * 8 + hh) * TT + ri.tpos) * 128;
              *(unsigned*)(KM + tok_ + 64 + d0) = pk4_fp8(clamp8(o[0]), clamp8(o[1]), clamp8(o[2]), clamp8(o[3]));
              *(unsigned*)(KM + tok_ + 96 + d0) = 0u; *(unsigned*)(QM + tok_ + 96 + d0) = 0u; }
        }
        asm volatile("s_waitcnt lgkmcnt(0)" ::: "memory");
    }
}

__device__ __forceinline__ void ret_logs(const Frame& F, int l, int h, float& lgf, float& lgb) {
    const float* t = wsp<float>(F, WS_DEC); lgf = t[(l * 2 + 0) * 8 + h]; lgb = t[(l * 2 + 1) * 8 + h];
}
constexpr int TP = 136;
template <bool WITH_K>
__device__ __forceinline__ void ret_stage(const Frame& F, const bf16_t* RKh, const bf16_t* RVh, int tpos0, float lgf, float lgb, LAS bf16_t* vt, LAS bf16_t* ktf, LAS bf16_t* ktb) {
#pragma unroll
    for (int i = 0; i < 2; ++i) { const int tok = (F.tid >> 3) + 64 * i, e0 = (F.tid & 7) * 8;
        const u32x4 w = *(const u32x4*)(RVh + (size_t)(tpos0 + tok) * 64 + e0); const unsigned ww[4] = {w.x, w.y, w.z, w.w};
#pragma unroll
        for (int j = 0; j < 4; ++j) { vt[(e0 + 2 * j) * TP + tok] = (bf16_t)(ww[j] & 0xffffu); vt[(e0 + 2 * j + 1) * TP + tok] = (bf16_t)(ww[j] >> 16); } }
    if (WITH_K) { const int tok = F.tid >> 2, k0 = (F.tid & 3) * 8;
        const u32x4 w = *(const u32x4*)(RKh + (size_t)(tpos0 + tok) * 32 + k0); const unsigned ww[4] = {w.x, w.y, w.z, w.w};
        const float zf = exp2f(lgf * (float)(127 - tok)), zb = exp2f(lgb * (float)tok);
#pragma unroll
        for (int j = 0; j < 4; ++j) { const float a = bflo(ww[j]), b = bfhi(ww[j]);
            ktf[(k0 + 2 * j) * TP + tok] = f2bf(a * zf); ktf[(k0 + 2 * j + 1) * TP + tok] = f2bf(b * zf);
            ktb[(k0 + 2 * j) * TP + tok] = f2bf(a * zb); ktb[(k0 + 2 * j + 1) * TP + tok] = f2bf(b * zb); } }
}
__device__ __forceinline__ void p_ret_states(const Frame& F, int l) {
    LAS bf16_t* vt = (LAS bf16_t*)F.lds; LAS bf16_t* ktf = vt + 64 * TP; LAS bf16_t* ktb = ktf + 32 * TP;
    float* ST = wsp<float>(F, WS_ST);
    const int lane = F.lane, w = F.wave, kb = w >> 2, eb = w & 3, fr = lane & 15, fq = lane >> 4;
    for (int u = F.bid; u < NB * 8 * 34; u += F.G) {
        const int c = u % 34, bh = u / 34, h = bh & 7;
        float lgf, lgb; ret_logs(F, l, h, lgf, lgb);
        __syncthreads();
        ret_stage<true>(F, wsp<bf16_t>(F, WS_RK) + (size_t)bh * TT * 32, wsp<bf16_t>(F, WS_RV) + (size_t)bh * TT * 64, c * 128, lgf, lgb, vt, ktf, ktb);
        __syncthreads();
        f32x4 sf = {0.f, 0.f, 0.f, 0.f}, sb = {0.f, 0.f, 0.f, 0.f};
#pragma unroll
        for (int ks = 0; ks < 4; ++ks) {
            const bf16x8 bv = *(const LAS bf16x8*)(vt + (eb * 16 + fr) * TP + ks * 32 + fq * 8);
            const bf16x8 af = *(const LAS bf16x8*)(ktf + (kb * 16 + fr) * TP + ks * 32 + fq * 8);
            const bf16x8 ab = *(const LAS bf16x8*)(ktb + (kb * 16 + fr) * TP + ks * 32 + fq * 8);
            sf = __builtin_amdgcn_mfma_f32_16x16x32_bf16(af, bv, sf, 0, 0, 0);
            sb = __builtin_amdgcn_mfma_f32_16x16x32_bf16(ab, bv, sb, 0, 0, 0);
        }
        float* o = ST + (size_t)u * 2 * 2048;
#pragma unroll
        for (int r = 0; r < 4; ++r) { const int kd = kb * 16 + fq * 4 + r, e = eb * 16 + fr; o[kd * 64 + e] = sf[r]; o[2048 + kd * 64 + e] = sb[r]; }
    }
}
constexpr int RP = 40;
constexpr int AP = 136;
__device__ __forceinline__ void ret_out_unit(const Frame& F, int l, int bh, int c) {
    LAS bf16_t* vt = (LAS bf16_t*)F.lds; LAS bf16_t* rtf = vt + 64 * TP; LAS bf16_t* rtb = rtf + 64 * RP; LAS bf16_t* as = rtb + 64 * RP + F.wave * 16 * AP;
    const int lane = F.lane, w = F.wave, fr = lane & 15, fq = lane >> 4, h = bh & 7, b = bh >> 3;
    const bf16_t* RQh = wsp<bf16_t>(F, WS_RQ) + (size_t)bh * TT * 32; const bf16_t* RKh = wsp<bf16_t>(F, WS_RK) + (size_t)bh * TT * 32; const bf16_t* RVh = wsp<bf16_t>(F, WS_RV) + (size_t)bh * TT * 64;
    const float* STh = wsp<float>(F, WS_ST) + (size_t)bh * 34 * 2 * 2048;
    float lgf, lgb; ret_logs(F, l, h, lgf, lgb);
    const int tpos0 = c * 128;
    __syncthreads();
    ret_stage<false>(F, RKh, RVh, tpos0, lgf, lgb, vt, nullptr, nullptr);
    { const int kd = F.tid >> 4, e4 = (F.tid & 15) * 4; f32x4 rf = {0.f, 0.f, 0.f, 0.f}, rb = {0.f, 0.f, 0.f, 0.f};
      if (c >= 2) {
          for (int cp = 0; cp < c; ++cp) { const float e2 = lgf * 128.f * (float)(c - 1 - cp); if (e2 < -80.f) continue; const float wgt = exp2f(e2);
              rf += *(const f32x4*)(STh + (size_t)(cp * 2 + 0) * 2048 + kd * 64 + e4) * wgt; }
          const int p = c - 2;
          for (int pp = p + 1; pp < 34; ++pp) { const float e2 = lgb * 128.f * (float)(pp - p - 1); if (e2 < -80.f) break; const float wgt = exp2f(e2); const int cs = pp < 32 ? pp + 2 : pp - 32;
              rb += *(const f32x4*)(STh + (size_t)(cs * 2 + 1) * 2048 + kd * 64 + e4) * wgt; }
      } else if (c == 0) { rb = *(const f32x4*)(STh + (size_t)(1 * 2 + 1) * 2048 + kd * 64 + e4); }
      else { rf = *(const f32x4*)(STh + (size_t)(0 * 2 + 0) * 2048 + kd * 64 + e4); }
#pragma unroll
      for (int j = 0; j < 4; ++j) { rtf[(e4 + j) * RP + kd] = f2bf(rf[j]); rtb[(e4 + j) * RP + kd] = f2bf(rb[j]); } }
    const int i0 = w * 16;
    const bf16x8 qa = *(const bf16x8*)(RQh + (size_t)(tpos0 + i0 + fr) * 32 + fq * 8);
    f32x4 s[8];
#pragma unroll
    for (int nb = 0; nb < 8; ++nb) { const bf16x8 kf = *(const bf16x8*)(RKh + (size_t)(tpos0 + nb * 16 + fr) * 32 + fq * 8);
        s[nb] = __builtin_amdgcn_mfma_f32_16x16x32_bf16(qa, kf, (f32x4){0.f, 0.f, 0.f, 0.f}, 0, 0, 0); }
#pragma unroll
    for (int nb = 0; nb < 8; ++nb)
#pragma unroll
        for (int r = 0; r < 4; ++r) { const int i = i0 + fq * 4 + r, j = nb * 16 + fr; const int df = i - j;
            const float mk = df > 0 ? exp2f(lgf * (float)df) : (df < 0 ? exp2f(lgb * (float)(-df)) : 2.f);
            as[(fq * 4 + r) * AP + j] = f2bf(s[nb][r] * mk); }
    __syncthreads();
    f32x4 y[4];
#pragma unroll
    for (int eb = 0; eb < 4; ++eb) y[eb] = (f32x4){0.f, 0.f, 0.f, 0.f};
#pragma unroll
    for (int ks = 0; ks < 4; ++ks) { const bf16x8 af = *(const LAS bf16x8*)(as + fr * AP + ks * 32 + fq * 8);
#pragma unroll
        for (int eb = 0; eb < 4; ++eb) { const bf16x8 bv = *(const LAS bf16x8*)(vt + (eb * 16 + fr) * TP + ks * 32 + fq * 8);
            y[eb] = __builtin_amdgcn_mfma_f32_16x16x32_bf16(af, bv, y[eb], 0, 0, 0); } }
    { const float xf = exp2f(lgf * (float)(i0 + fr + 1)), xb = exp2f(lgb * (float)(128 - (i0 + fr)));
      bf16x8 qf, qb;
#pragma unroll
      for (int j = 0; j < 8; ++j) { const float qv = bf2f((bf16_t)qa[j]); qf[j] = (short)f2bf(qv * xf); qb[j] = (short)f2bf(qv * xb); }
#pragma unroll
      for (int eb = 0; eb < 4; ++eb) { const bf16x8 bf_ = *(const LAS bf16x8*)(rtf + (eb * 16 + fr) * RP + fq * 8), bb_ = *(const LAS bf16x8*)(rtb + (eb * 16 + fr) * RP + fq * 8);
          y[eb] = __builtin_amdgcn_mfma_f32_16x16x32_bf16(qf, bf_, y[eb], 0, 0, 0);
          y[eb] = __builtin_amdgcn_mfma_f32_16x16x32_bf16(qb, bb_, y[eb], 0, 0, 0); } }
    const bf16_t* P1 = wsp<bf16_t>(F, WS_P1); unsigned char* OAB = wsp<unsigned char>(F, WS_OAB);
#pragma unroll
    for (int r = 0; r < 4; ++r) {
        float sm = y[0][r] + y[1][r] + y[2][r] + y[3][r]; sm = row16_sum(sm); const float mu = sm * (1.f / 64.f);
        float vs = 0.f;
#pragma unroll
        for (int eb = 0; eb < 4; ++eb) { const float d = y[eb][r] - mu; vs += d * d; }
        vs = row16_sum(vs); const float rstd = rsqrtf(vs * (1.f / 64.f) + LN_EPS);
        const int i = i0 + fq * 4 + r; const int tp = tpos0 + i; const size_t grow = tp >= CTXL ? (size_t)b * SEQ + (tp - CTXL) : (size_t)NLAT + b * CTXL + tp;
#pragma unroll
        for (int eb = 0; eb < 4; ++eb) { const int e = eb * 16 + fr; const float g = bf2f(P1[grow * NP1 + C_RG + h * 64 + e]);
            OAB[grow * D + 512 + h * 64 + e] = (unsigned char)(pk4_fp8(clamp8(silu_f(g) * (y[eb][r] - mu) * rstd * 16.f), 0.f, 0.f, 0.f) & 0xffu); }
    }
}
namespace att {
constexpr int NW = 8, QBLK = 32, KVBLK = 64;
constexpr int SHM_K = KVBLK * 128, SHM_V = 128 * 64;
constexpr size_t SHM_ATTN = 4 * SHM_K + 3 * SHM_V;
constexpr float THR = 1.9f, PSH = 6.f;
#define SBAR() __builtin_amdgcn_sched_barrier(0)
typedef int i32x8a __attribute__((ext_vector_type(8))); typedef int i32x4a __attribute__((ext_vector_type(4)));
template <int SC> struct Scale { static constexpr float S = SC == 0 ? 0.08838834764831845f : 0.10206207261596575f; static constexpr float C = S * 1.4426950408889634f; static constexpr float THRR = THR / S; };
#define KSWZ8(row, chunk) ((row) * 128 + ((((chunk) ^ (((row) >> 1) & 7))) << 4))
#define VSWZ8(col, chunk) ((col) * 64 + ((((chunk) ^ (((col) >> 2) & 3))) << 4))
#define MF8(A, B, C) mf8x<ABL>(A, B, C)
#define CAT8(lo, hi) __builtin_shufflevector(lo, hi, 0, 1, 2, 3, 4, 5, 6, 7)
#define LDS16(p) ((ABL & 8) ? __builtin_shufflevector(qr8[0], qr8[1], 0, 1, 10, 11) : *(const LAS i32x4a*)(p))
template <int A, int B, int ABL = 0> __device__ __forceinline__ void exp_rng(f32x16& p) {
#pragma unroll
  for (int r = A; r < B; ++r) p[r] = (ABL & 1) ? p[r] * p[r] : __builtin_amdgcn_exp2f(p[r]);
}
template <int ABL> __device__ __forceinline__ f32x16 mf8x(const i32x8a a, const i32x8a b, f32x16 c) {
  if constexpr (ABL & 2) { c[0] += __int_as_float(((a[0] ^ a[4]) + (b[0] ^ b[4])) & 0x3f000000); return c; }
  else return __builtin_amdgcn_mfma_scale_f32_32x32x64_f8f6f4(a, b, c, 0, 0, 0, 0x7F7F7F7F, 0, 0x7F7F7F7F);
}
__device__ __forceinline__ void pk_fma16(f32x16& p, float c, float d) { const f32x2 c2 = {c, c}, d2 = {d, d};
#pragma unroll
  for (int i = 0; i < 8; ++i) { f32x2 v = {p[2 * i], p[2 * i + 1]}; v = v * c2 + d2; p[2 * i] = v.x; p[2 * i + 1] = v.y; }
}
__device__ __forceinline__ void pk_mul16(f32x16& p, float c) { const f32x2 c2 = {c, c};
#pragma unroll
  for (int i = 0; i < 8; ++i) { f32x2 v = {p[2 * i], p[2 * i + 1]}; v = v * c2; p[2 * i] = v.x; p[2 * i + 1] = v.y; }
}
__device__ __forceinline__ float pk_sum32(const f32x16& p0, const f32x16& p1) { f32x2 s0 = {p0[0], p0[1]}, s1 = {p1[0], p1[1]};
#pragma unroll
  for (int i = 1; i < 8; ++i) { s0 += (f32x2){p0[2 * i], p0[2 * i + 1]}; s1 += (f32x2){p1[2 * i], p1[2 * i + 1]}; }
  s0 += s1; return s0.x + s0.y;
}
__device__ __forceinline__ float hsum(float v) { auto rr = __builtin_amdgcn_permlane32_swap(__float_as_uint(v), __float_as_uint(v), false, false); return __uint_as_float(rr[0]) + __uint_as_float(rr[1]); }
__device__ __forceinline__ float hmax(float v) { auto rr = __builtin_amdgcn_permlane32_swap(__float_as_uint(v), __float_as_uint(v), false, false); return fmaxf(__uint_as_float(rr[0]), __uint_as_float(rr[1])); }
template <int NDV, int SC, int ABL>
__device__ __forceinline__ void attn_body(const unsigned char* __restrict__ Qb, const unsigned char* __restrict__ Kh, const unsigned char* __restrict__ Vt,
                                          unsigned char* __restrict__ Ob, int seq, LAS unsigned char* lds, const int tid) {
  constexpr int ldo = 2048; constexpr float C = Scale<SC>::C, thr_raw = Scale<SC>::THRR;
  const int wid = __builtin_amdgcn_readfirstlane(tid >> 6), lane = tid & 63, r32 = lane & 31, hi = lane >> 5;
  LAS unsigned char* K_lds = lds; LAS unsigned char* V_lds = lds + 4 * SHM_K;
  float m_reg = -1e30f, l_reg = 0; f32x16 o[NDV] = {}; i32x8a qr8[2];
  const unsigned char* Qw = Qb + (long)(wid * QBLK + r32) * 128 + hi * 32;
#pragma unroll
  for (int blk = 0; blk < 2; ++blk) { const i32x4a lo_ = *reinterpret_cast<const i32x4a*>(Qw + blk * 64), hi_ = *reinterpret_cast<const i32x4a*>(Qw + blk * 64 + 16); qr8[blk] = CAT8(lo_, hi_); }
  const int NT = seq / KVBLK;
  const int kr8 = 8 * wid + (lane >> 3), vcol = 16 * (wid & (NDV * 2 - 1)) + (lane >> 2);
  const unsigned char* kgp = Kh + (long)kr8 * 128 + (((lane & 7) ^ ((kr8 >> 1) & 7)) << 4);
  const unsigned char* vgp = Vt + (long)vcol * TT + (((lane & 3) ^ ((vcol >> 2) & 3)) << 4);
  const int kdo = wid * 1024, vdo = (wid & (NDV * 2 - 1)) * 1024;
  const int ka0 = KSWZ8(r32, 2 * hi), ka1 = KSWZ8(r32, 2 * hi + 1), va0 = VSWZ8(r32, 2 * hi), va1 = VSWZ8(r32, 2 * hi + 1);
#define DMAK(t, bo) do { const int t_ = (t) < NT ? (t) : NT - 1; __builtin_amdgcn_global_load_lds((const unsigned*)(kgp + (long)t_ * (KVBLK * 128)), (LAS unsigned*)(K_lds + (bo) + kdo), 16, 0, 0); } while (0)
#define DMAV(t, bo) do { const int t_ = (t) < NT ? (t) : NT - 1; __builtin_amdgcn_global_load_lds((const unsigned*)(vgp + t_ * KVBLK), (LAS unsigned*)(V_lds + (bo) + vdo), 16, 0, 0); } while (0)
#define VMW(n) asm volatile("s_waitcnt vmcnt(" #n ")" ::: "memory")
#define BAR() __builtin_amdgcn_s_barrier()
  f32x16 pA0, pA1, pB0, pB1; float alA, alB; i32x8a pa;
#define PSM_MAX(p0, p1, al, mnC) do { float pm_ = fmaxf(p0[0], p1[0]);                                                                  \
    _Pragma("unroll") for (int r = 1; r < 16; ++r) pm_ = fmaxf(fmaxf(pm_, p0[r]), p1[r]);                                               \
    pm_ = hmax(pm_);                                                                                                                     \
    const bool keep_ = __all(pm_ - m_reg <= thr_raw); const float mn_ = keep_ ? m_reg : fmaxf(m_reg, pm_);                               \
    al = __builtin_amdgcn_exp2f((m_reg - mn_) * C); m_reg = mn_; mnC = PSH - mn_ * C; } while (0)
#define PT3(x, y, z) asm volatile("" : "+v"(x), "+v"(y), "+v"(z))
#define PT4(x, y, z, w) asm volatile("" : "+v"(x), "+v"(y), "+v"(z), "+v"(w))
#define STEP(j, pc0, pc1, alc, pn0, pn1, aln) do { const LAS unsigned char* Kr_ = K_lds + kb_rd; const LAS unsigned char* Vs_ = V_lds + vb_rd; float mnC_;  \
    i32x8a kc_ = CAT8(LDS16(Kr_ + (ka0 ^ 64)), LDS16(Kr_ + (ka1 ^ 64))), kd_ = CAT8(LDS16(Kr_ + 4096 + (ka0 ^ 64)), LDS16(Kr_ + 4096 + (ka1 ^ 64))); \
    pn0 = MF8(kpa, qr8[0], (f32x16){}); exp_rng<0, 6, ABL>(pc1); PT3(pn0, pc1, kpb);                                                     \
    pn1 = MF8(kpb, qr8[0], (f32x16){}); exp_rng<6, 12, ABL>(pc1); PT3(pn1, pc1, kc_);                                                    \
    pn0 = MF8(kc_, qr8[1], pn0); exp_rng<12, 16, ABL>(pc1);                                                                              \
    { float ps_ = pk_sum32(pc0, pc1); ps_ = hsum(ps_); l_reg = l_reg * alc + ps_; }                                                      \
    i32x8a va_ = CAT8(LDS16(Vs_ + va0), LDS16(Vs_ + va1)), vb_ = CAT8(LDS16(Vs_ + 2048 + va0), LDS16(Vs_ + 2048 + va1));                  \
    PT4(pn0, pc1, kd_, l_reg);                                                                                                           \
    pn1 = MF8(kd_, qr8[1], pn1);                                                                                                         \
    _Pragma("unroll") for (int q = 0; q < 4; ++q) { pa[q] = (int)pk4_fp8(pc0[4 * q], pc0[4 * q + 1], pc0[4 * q + 2], pc0[4 * q + 3]); pa[4 + q] = (int)pk4_fp8(pc1[4 * q], pc1[4 * q + 1], pc1[4 * q + 2], pc1[4 * q + 3]); } \
    PT3(pn1, pa, va_);                                                                                                                   \
    if constexpr (!(ABL & 128)) { DMAK((j) + 4, kb_wr); DMAV((j) + 2, vb_wr); }                                                          \
    o[0] = MF8(va_, pa, o[0]); PSM_MAX(pn0, pn1, aln, mnC_); PT4(o[0], pn0, vb_, mnC_);                                                  \
    o[1] = MF8(vb_, pa, o[1]); pk_fma16(pn0, C, mnC_); pk_fma16(pn1, C, mnC_); exp_rng<0, 4, ABL>(pn0);                                   \
    if constexpr (NDV == 4) { i32x8a vc_ = CAT8(LDS16(Vs_ + 4096 + va0), LDS16(Vs_ + 4096 + va1)), vd_ = CAT8(LDS16(Vs_ + 6144 + va0), LDS16(Vs_ + 6144 + va1)); \
      PT4(o[1], pn0, pn1, vc_); o[2] = MF8(vc_, pa, o[2]); exp_rng<4, 10, ABL>(pn0); PT3(o[2], pn0, vd_);                                \
      o[3] = MF8(vd_, pa, o[3]); exp_rng<10, 16, ABL>(pn0); }                                                                            \
    else { PT3(o[1], pn0, pn1); exp_rng<4, 16, ABL>(pn0); }                                                                              \
    { const LAS unsigned char* Kp_ = K_lds + kb_pf; kpa = CAT8(LDS16(Kp_ + ka0), LDS16(Kp_ + ka1)); kpb = CAT8(LDS16(Kp_ + 4096 + ka0), LDS16(Kp_ + 4096 + ka1)); } \
    PT3(o[NDV - 1], pn0, pn1); RESC(aln);                                                                                               \
    { const int t_ = kb_rd; kb_rd = kb_pf; kb_pf = kb_x; kb_x = kb_wr; kb_wr = t_; const int u_ = vb_rd; vb_rd = vb_n1; vb_n1 = vb_wr; vb_wr = u_; } \
    VMW(2); if constexpr (!(ABL & 4)) BAR(); } while (0)
#define RESC(a) do { if (__any((a) < 1.f)) { _Pragma("unroll") for (int d = 0; d < NDV; ++d) pk_mul16(o[d], (a)); } } while (0)
  i32x8a kpa, kpb; int kb_rd = SHM_K, kb_pf = 2 * SHM_K, kb_x = 3 * SHM_K, kb_wr = 0, vb_rd = 0, vb_n1 = SHM_V, vb_wr = 2 * SHM_V;
  DMAK(0, 0); DMAK(1, SHM_K); DMAK(2, 2 * SHM_K); DMAK(3, 3 * SHM_K); DMAV(0, 0); DMAV(1, SHM_V); VMW(0); BAR();
  { const LAS unsigned char* Ks_ = K_lds; float mnC_;
    pA0 = MF8(CAT8(LDS16(Ks_ + ka0), LDS16(Ks_ + ka1)), qr8[0], (f32x16){}); pA1 = MF8(CAT8(LDS16(Ks_ + 4096 + ka0), LDS16(Ks_ + 4096 + ka1)), qr8[0], (f32x16){});
    pA0 = MF8(CAT8(LDS16(Ks_ + (ka0 ^ 64)), LDS16(Ks_ + (ka1 ^ 64))), qr8[1], pA0); pA1 = MF8(CAT8(LDS16(Ks_ + 4096 + (ka0 ^ 64)), LDS16(Ks_ + 4096 + (ka1 ^ 64))), qr8[1], pA1);
    PSM_MAX(pA0, pA1, alA, mnC_); pk_fma16(pA0, C, mnC_); pk_fma16(pA1, C, mnC_); exp_rng<0, 16, ABL>(pA0);
    const LAS unsigned char* Kp_ = K_lds + SHM_K; kpa = CAT8(LDS16(Kp_ + ka0), LDS16(Kp_ + ka1)); kpb = CAT8(LDS16(Kp_ + 4096 + ka0), LDS16(Kp_ + 4096 + ka1)); }
  asm volatile("s_waitcnt lgkmcnt(0)" ::: "memory"); BAR();
  int j = 0;
  for (; j + 2 < NT; j += 2) { STEP(j, pA0, pA1, alA, pB0, pB1, alB); STEP(j + 1, pB0, pB1, alB, pA0, pA1, alA); }
  STEP(j, pA0, pA1, alA, pB0, pB1, alB);
  { exp_rng<0, 16, ABL>(pB1); float ps_ = pk_sum32(pB0, pB1); ps_ = hsum(ps_); l_reg = l_reg * alB + ps_;
#pragma unroll
    for (int q = 0; q < 4; ++q) { pa[q] = (int)pk4_fp8(pB0[4 * q], pB0[4 * q + 1], pB0[4 * q + 2], pB0[4 * q + 3]); pa[4 + q] = (int)pk4_fp8(pB1[4 * q], pB1[4 * q + 1], pB1[4 * q + 2], pB1[4 * q + 3]); }
    const LAS unsigned char* Vs_ = V_lds + vb_rd;
#pragma unroll
    for (int d0 = 0; d0 < NDV; ++d0) o[d0] = MF8(CAT8(LDS16(Vs_ + d0 * 2048 + va0), LDS16(Vs_ + d0 * 2048 + va1)), pa, o[d0]); }
  const float rl = __builtin_amdgcn_rcpf(l_reg) * 16.f;
  unsigned char* Ow = Ob + (long)(wid * QBLK + r32) * ldo + 4 * hi;
#pragma unroll
  for (int d0 = 0; d0 < NDV; ++d0)
#pragma unroll
    for (int g = 0; g < 4; ++g) *(unsigned*)(Ow + d0 * 32 + 8 * g) = pk4_fp8(clamp8(o[d0][4 * g] * rl), clamp8(o[d0][4 * g + 1] * rl), clamp8(o[d0][4 * g + 2] * rl), clamp8(o[d0][4 * g + 3] * rl));
#undef DMAK
#undef DMAV
#undef VMW
#undef BAR
#undef PSM_MAX
#undef REGION_X
#undef REGION_Y
#undef RESC
#undef STEP
#undef PT3
#undef PT4
}
}
__device__ __forceinline__ float* xres_row(const Frame& F, int row) { return row < NLAT ? F.out + (size_t)row * D : wsp<float>(F, WS_XC) + (size_t)(row - NLAT) * D; }
__device__ __forceinline__ void ln_row(float (&y)[32], const float* g, const float* b, int lane) {
    float s = 0.f;
#pragma unroll
    for (int i = 0; i < 32; ++i) s += y[i];
    const float mu = wave_sum(s) * (1.f / 2048.f);
    float q = 0.f;
#pragma unroll
    for (int i = 0; i < 32; ++i) { const float d = y[i] - mu; q += d * d; }
    const float rstd = rsqrtf(wave_sum(q) * (1.f / 2048.f) + LN_EPS);
#pragma unroll
    for (int qq = 0; qq < 4; ++qq) { const f32x4 g0 = *(const f32x4*)(g + 512 * qq + 8 * lane), g1 = *(const f32x4*)(g + 512 * qq + 8 * lane + 4), b0 = *(const f32x4*)(b + 512 * qq + 8 * lane), b1 = *(const f32x4*)(b + 512 * qq + 8 * lane + 4);
#pragma unroll
        for (int i = 0; i < 4; ++i) { y[qq * 8 + i] = (y[qq * 8 + i] - mu) * rstd * g0[i] + b0[i]; y[qq * 8 + 4 + i] = (y[qq * 8 + 4 + i] - mu) * rstd * g1[i] + b1[i]; } }
}
__device__ __forceinline__ void modulate_store(const float (&x)[32], const float* sh, const float* sc, bf16_t* dst, int lane) {
#pragma unroll
    for (int q = 0; q < 4; ++q) { const f32x4 h0 = *(const f32x4*)(sh + 512 * q + 8 * lane), h1 = *(const f32x4*)(sh + 512 * q + 8 * lane + 4), c0 = *(const f32x4*)(sc + 512 * q + 8 * lane), c1 = *(const f32x4*)(sc + 512 * q + 8 * lane + 4);
        f32x4 a, b;
#pragma unroll
        for (int i = 0; i < 4; ++i) { a[i] = x[q * 8 + i] * (1.f + c0[i]) + h0[i]; b[i] = x[q * 8 + 4 + i] * (1.f + c1[i]) + h1[i]; }
        *(u32x4*)(dst + 512 * q + 8 * lane) = pack8(a, b); }
}
__device__ __forceinline__ void p_ln1(const Frame& F, int l, bool last) {
    const float* mod = wsp<float>(F, WS_MOD) + (size_t)l * 5 * 12288; bf16_t* hb = wsp<bf16_t>(F, WS_HB);
    const float* g = F.in(18) + l * D; const float* b = F.in(19) + l * D;
    const int nrows = last ? NLAT : NROW; const int lane = F.lane, step = F.G * 8;
    float gg[32], bb[32]; ld_row_f32(g, lane, gg); ld_row_f32(b, lane, bb);
    int row = F.bid * 8 + F.wave;
    float yn[32];
    if (row < nrows) ld_row_f32(xres_row(F, row), lane, yn);
#pragma unroll 1
    for (; row < nrows; row += step) {
        const int v = row < NLAT ? (row >> 12) : 4; float* xp = xres_row(F, row);
        float y[32], sh[32], sc[32];
#pragma unroll
        for (int i = 0; i < 32; ++i) y[i] = yn[i];
        ld_row_f32(mod + (size_t)v * 12288 + 6144, lane, sh); ld_row_f32(mod + (size_t)v * 12288 + 8192, lane, sc);
        { const int nrow = row + step; if (nrow < nrows) ld_row_f32(xres_row(F, nrow), lane, yn); }
        float s = 0.f;
#pragma unroll
        for (int i = 0; i < 32; ++i) s += y[i];
        const float mu = wave_sum(s) * (1.f / 2048.f); float q = 0.f;
#pragma unroll
        for (int i = 0; i < 32; ++i) { const float d = y[i] - mu; q += d * d; }
        const float rstd = rsqrtf(wave_sum(q) * (1.f / 2048.f) + LN_EPS);
#pragma unroll
        for (int i = 0; i < 32; ++i) y[i] = (y[i] - mu) * rstd * gg[i] + bb[i];
        st_row_f32(xp, lane, y);
#pragma unroll
        for (int i = 0; i < 32; ++i) y[i] = y[i] * (1.f + sc[i]) + sh[i];
        st_row_bf16(hb + (size_t)row * D, lane, y);
    }
}

template <int NV>
__device__ __forceinline__ void top16(const float (&val)[NV], bool (&sel)[NV], int (&slot)[NV]) {
    unsigned key[NV];
#pragma unroll
    for (int v = 0; v < NV; ++v) { const unsigned u = __float_as_uint(val[v]); key[v] = (u & 0x80000000u) ? ~u : (u | 0x80000000u); }
    unsigned T = 0u;
#pragma unroll 1
    for (int bit = 31; bit >= 0; --bit) {
        const unsigned cand = T | (1u << bit); int cnt = 0;
#pragma unroll
        for (int v = 0; v < NV; ++v) cnt += __popcll(__ballot(key[v] >= cand));
        if (cnt >= 16) T = cand;
    }
    int ngt = 0;
#pragma unroll
    for (int v = 0; v < NV; ++v) ngt += __popcll(__ballot(key[v] > T));
    const int need = 16 - ngt;
    int run = 0, erun = 0;
#pragma unroll
    for (int v = 0; v < NV; ++v) {
        const unsigned long long mg = __ballot(key[v] > T), me = __ballot(key[v] == T);
        const int pg = __builtin_amdgcn_mbcnt_hi((unsigned)(mg >> 32), __builtin_amdgcn_mbcnt_lo((unsigned)mg, 0u));
        const int pe = __builtin_amdgcn_mbcnt_hi((unsigned)(me >> 32), __builtin_amdgcn_mbcnt_lo((unsigned)me, 0u));
        sel[v] = false; slot[v] = 0;
        if (key[v] > T) { sel[v] = true; slot[v] = run + pg; }
        else if (key[v] == T && (erun + pe) < need) { sel[v] = true; slot[v] = ngt + erun + pe; }
        run += __popcll(mg); erun += __popcll(me);
    }
}
__device__ __forceinline__ unsigned f2key(float f) { const unsigned u = __float_as_uint(f); return (u & 0x80000000u) ? ~u : (u | 0x80000000u); }
__device__ __forceinline__ float key2f(unsigned k) { return __uint_as_float((k & 0x80000000u) ? (k & 0x7fffffffu) : ~k); }
template <int NP, int NV>
__device__ __forceinline__ void bisect16(const unsigned (&key)[NP][NV], unsigned (&T)[NP]) {
    bool done[NP];
#pragma unroll
    for (int p = 0; p < NP; ++p) { T[p] = 0u; done[p] = false; }
#pragma unroll 1
    for (int bit = 31; bit >= 0; --bit) {
        const unsigned bm = 1u << bit; bool all = true;
#pragma unroll
        for (int p = 0; p < NP; ++p) {
            const unsigned cand = T[p] | bm; int cnt = 0;
#pragma unroll
            for (int v = 0; v < NV; ++v) cnt += __popcll(__ballot(key[p][v] >= cand));
            const bool upd = (cnt >= 16) && !done[p];
            T[p] = upd ? cand : T[p]; done[p] = done[p] || (cnt == 16); all = all && done[p];
        }
        if (all) break;
    }
}
template <int NV>
__device__ __forceinline__ void compact16(const unsigned (&key)[NV], const unsigned T, bool (&sel)[NV], int (&slot)[NV]) {
    int ngt = 0;
#pragma unroll
    for (int v = 0; v < NV; ++v) ngt += __popcll(__ballot(key[v] > T));
    const int need = 16 - ngt; int run = 0, erun = 0;
#pragma unroll
    for (int v = 0; v < NV; ++v) {
        const unsigned long long mg = __ballot(key[v] > T), me = __ballot(key[v] == T);
        const int pg = __builtin_amdgcn_mbcnt_hi((unsigned)(mg >> 32), __builtin_amdgcn_mbcnt_lo((unsigned)mg, 0u));
        const int pe = __builtin_amdgcn_mbcnt_hi((unsigned)(me >> 32), __builtin_amdgcn_mbcnt_lo((unsigned)me, 0u));
        sel[v] = false; slot[v] = 0;
        if (key[v] > T) { sel[v] = true; slot[v] = run + pg; }
        else if (key[v] == T && (erun + pe) < need) { sel[v] = true; slot[v] = ngt + erun + pe; }
        run += __popcll(mg); erun += __popcll(me);
    }
}
constexpr int KP = 68;
constexpr int PW_BYTES = 9344;
__device__ __forceinline__ float gelu_erf(float x) {
    const float z = fabsf(x) * 0.7071067811865476f; const float t = __builtin_amdgcn_rcpf(1.f + 0.3275911f * z);
    float p = 1.061405429f; p = p * t - 1.453152027f; p = p * t + 1.421413741f; p = p * t - 0.284496736f; p = p * t + 0.254829592f; p = p * t;
    const float er = 1.f - p * __expf(-z * z);
    return 0.5f * x * (1.f + (x < 0.f ? -er : er));
}
__device__ __forceinline__ float wave_max(float x) {
    x = row16_max(x);
    { auto r = __builtin_amdgcn_permlane16_swap(__float_as_uint(x), __float_as_uint(x), false, false); x = fmaxf(__uint_as_float(r[0]), __uint_as_float(r[1])); }
    { auto r = __builtin_amdgcn_permlane32_swap(__float_as_uint(x), __float_as_uint(x), false, false); x = fmaxf(__uint_as_float(r[0]), __uint_as_float(r[1])); }
    return x;
}
__device__ __forceinline__ void ld16_f32(const float* p, int lane, float (&x)[32]) {
#pragma unroll
    for (int q = 0; q < 2; ++q)
#pragma unroll
        for (int d = 0; d < 4; ++d) { const f32x4 a = *(const f32x4*)(p + 1024 * q + 16 * lane + 4 * d); x[q * 16 + d * 4 + 0] = a[0]; x[q * 16 + d * 4 + 1] = a[1]; x[q * 16 + d * 4 + 2] = a[2]; x[q * 16 + d * 4 + 3] = a[3]; }
}
__device__ __forceinline__ void ld16_f32_nt(const float* p, int lane, float (&x)[32]) {
#pragma unroll
    for (int q = 0; q < 2; ++q)
#pragma unroll
        for (int d = 0; d < 4; ++d) { const f32x4 a = __builtin_nontemporal_load((const f32x4*)(p + 1024 * q + 16 * lane + 4 * d)); x[q * 16 + d * 4 + 0] = a[0]; x[q * 16 + d * 4 + 1] = a[1]; x[q * 16 + d * 4 + 2] = a[2]; x[q * 16 + d * 4 + 3] = a[3]; }
}
__device__ __forceinline__ void st16_f32_nt(float* p, int lane, const float (&x)[32]) {
#pragma unroll
    for (int q = 0; q < 2; ++q)
#pragma unroll
        for (int d = 0; d < 4; ++d) __builtin_nontemporal_store((f32x4){x[q * 16 + d * 4 + 0], x[q * 16 + d * 4 + 1], x[q * 16 + d * 4 + 2], x[q * 16 + d * 4 + 3]}, (f32x4*)(p + 1024 * q + 16 * lane + 4 * d));
}
__device__ __forceinline__ void st16_f32(float* p, int lane, const float (&x)[32]) {
#pragma unroll
    for (int q = 0; q < 2; ++q)
#pragma unroll
        for (int d = 0; d < 4; ++d) *(f32x4*)(p + 1024 * q + 16 * lane + 4 * d) = (f32x4){x[q * 16 + d * 4 + 0], x[q * 16 + d * 4 + 1], x[q * 16 + d * 4 + 2], x[q * 16 + d * 4 + 3]};
}
__device__ __forceinline__ void ld16_bf16(const bf16_t* p, int lane, float (&x)[32]) {
#pragma unroll
    for (int q = 0; q < 2; ++q)
#pragma unroll
        for (int d = 0; d < 2; ++d) { const u32x4 w = *(const u32x4*)(p + 1024 * q + 16 * lane + 8 * d); float* o = &x[q * 16 + d * 8];
            o[0] = bflo(w.x); o[1] = bfhi(w.x); o[2] = bflo(w.y); o[3] = bfhi(w.y); o[4] = bflo(w.z); o[5] = bfhi(w.z); o[6] = bflo(w.w); o[7] = bfhi(w.w); }
}
__device__ __forceinline__ void st16_bf16(bf16_t* p, int lane, const float (&x)[32]) {
#pragma unroll
    for (int q = 0; q < 2; ++q)
#pragma unroll
        for (int d = 0; d < 2; ++d) { const float* o = &x[q * 16 + d * 8]; u32x4 w; w.x = cvt_pk_bf16(o[0], o[1]); w.y = cvt_pk_bf16(o[2], o[3]); w.z = cvt_pk_bf16(o[4], o[5]); w.w = cvt_pk_bf16(o[6], o[7]);
            *(u32x4*)(p + 1024 * q + 16 * lane + 8 * d) = w; }
}
constexpr int TBS = 1152;
__device__ __forceinline__ void ld_row_f32(int lane, const float* __restrict__ src, f32x4* a) {
#pragma unroll
    for (int q = 0; q < 2; ++q)
#pragma unroll
        for (int d = 0; d < 4; ++d) a[q * 4 + d] = __builtin_nontemporal_load((const f32x4*)(src + 1024 * q + 16 * lane + 4 * d));
}
__device__ __forceinline__ void cvt_row_fp4b(int lane, const f32x4* a, unsigned char* __restrict__ dst) {
    float x[32];
#pragma unroll
    for (int i = 0; i < 8; ++i) { x[i * 4 + 0] = a[i][0]; x[i * 4 + 1] = a[i][1]; x[i * 4 + 2] = a[i][2]; x[i * 4 + 3] = a[i][3]; }
    float am = 0.f;
#pragma unroll
    for (int i = 0; i < 32; ++i) am = fmaxf(am, fabsf(x[i]));
    const bf16_t sb = f2bf(am * (1.f / 6.f)); const float sf = bf2f(sb); const float sc = sf > 0.f ? __builtin_amdgcn_rcpf(sf) : 0.f;
    u32x4 w;
#pragma unroll
    for (int d = 0; d < 4; ++d) { unsigned t = 0u; const int o = (d >> 1) * 16 + (d & 1) * 8;
        t = __builtin_amdgcn_cvt_scalef32_pk_fp4_f32(t, x[o + 0] * sc, x[o + 1] * sc, 1.0f, 0); t = __builtin_amdgcn_cvt_scalef32_pk_fp4_f32(t, x[o + 2] * sc, x[o + 3] * sc, 1.0f, 1);
        t = __builtin_amdgcn_cvt_scalef32_pk_fp4_f32(t, x[o + 4] * sc, x[o + 5] * sc, 1.0f, 2); t = __builtin_amdgcn_cvt_scalef32_pk_fp4_f32(t, x[o + 6] * sc, x[o + 7] * sc, 1.0f, 3); w[d] = t; }
    *(u32x4*)(dst + 16 * lane) = w;
    *(bf16_t*)(dst + 1024 + 2 * lane) = sb;
}
__device__ __forceinline__ void cvt_row_fp4r(int lane, const float* __restrict__ src, unsigned char* __restrict__ dst, float* __restrict__ inv) {
    float x[32];
#pragma unroll
    for (int q = 0; q < 2; ++q)
#pragma unroll
        for (int d = 0; d < 4; ++d) { const f32x4 a = __builtin_nontemporal_load((const f32x4*)(src + 1024 * q + 16 * lane + 4 * d)); x[q * 16 + d * 4 + 0] = a[0]; x[q * 16 + d * 4 + 1] = a[1]; x[q * 16 + d * 4 + 2] = a[2]; x[q * 16 + d * 4 + 3] = a[3]; }
    float am = 0.f;
#pragma unroll
    for (int i = 0; i < 32; ++i) am = fmaxf(am, fabsf(x[i]));
    am = wave_max(am);
    const float sc = am > 0.f ? 6.f / am : 1.f;
    if (lane == 0) *inv = am > 0.f ? am * (1.f / 6.f) : 1.f;
    u32x4 w;
#pragma unroll
    for (int d = 0; d < 4; ++d) { unsigned t = 0u; const int o = (d >> 1) * 16 + (d & 1) * 8;
        t = __builtin_amdgcn_cvt_scalef32_pk_fp4_f32(t, x[o + 0] * sc, x[o + 1] * sc, 1.0f, 0); t = __builtin_amdgcn_cvt_scalef32_pk_fp4_f32(t, x[o + 2] * sc, x[o + 3] * sc, 1.0f, 1);
        t = __builtin_amdgcn_cvt_scalef32_pk_fp4_f32(t, x[o + 4] * sc, x[o + 5] * sc, 1.0f, 2); t = __builtin_amdgcn_cvt_scalef32_pk_fp4_f32(t, x[o + 6] * sc, x[o + 7] * sc, 1.0f, 3); w[d] = t; }
    *(u32x4*)(dst + 16 * lane) = w;
}
__device__ __forceinline__ void cvt_peer(const Frame& F, int l) {
    const int step = F.G * 8; int r = F.bid * 8 + F.wave;
    f32x4 cur[8], nxt[8];
    auto srcp = [&](int rr) { return (rr < 16384 ? F.in(23) : F.in(24)) + ((size_t)l * 16384 + (rr & 16383)) * 2048; };
    if (r < 32768) ld_row_f32(F.lane, srcp(r), cur);
    for (; r < 32768; r += step) {
        const int rn = r + step;
        if (rn < 32768) ld_row_f32(F.lane, srcp(rn), nxt);
        cvt_row_fp4b(F.lane, cur, wsp<unsigned char>(F, r < 16384 ? WS_PU : WS_PV) + (size_t)l * SZ_PT + (size_t)(r & 16383) * TBS);
#pragma unroll
        for (int i = 0; i < 8; ++i) cur[i] = nxt[i];
    }
}
#define PEER_G 4
template <int CTRL> __device__ __forceinline__ int dppi(int x) { return __builtin_amdgcn_update_dpp(0, x, CTRL, 0xF, 0xF, true); }
__device__ __forceinline__ int irow16_sum(int x) { x += dppi<0xB1>(x); x += dppi<0x4E>(x); x += dppi<0x141>(x); x += dppi<0x140>(x); return x; }
__device__ __forceinline__ int irow16_incl_scan(int x) { x += dppi<0x111>(x); x += dppi<0x112>(x); x += dppi<0x114>(x); x += dppi<0x118>(x); return x; }
constexpr int KBP = 72;
constexpr int PT_WORDS = 6 * 128 + 160 + 3 * 128;
constexpr int PWB = 2 * PT_WORDS * 4;
__device__ __forceinline__ void p_peer(const Frame& F, int l, bool last) {
    LAS bf16_t* kb1 = (LAS bf16_t*)F.lds; LAS bf16_t* kb2 = kb1 + 128 * KBP;
    LAS unsigned* wbase = (LAS unsigned*)(F.lds + 2 * 128 * KBP * 2 + F.wave * PWB);
    const int lane = F.lane, fr = lane & 15, fq = lane >> 4;
    __syncthreads();
    for (int i = F.tid; i < 128 * 64; i += 512) { const int r = i >> 6, d = i & 63; kb1[r * KBP + d] = f2bf(F.in(21)[(size_t)l * 8192 + i]); kb2[r * KBP + d] = f2bf(F.in(22)[(size_t)l * 8192 + i]); }
    __syncthreads();
    const bf16_t* QP = wsp<bf16_t>(F, WS_QP); const bf16_t* HB = wsp<bf16_t>(F, WS_HB); unsigned char* HB8w = wsp<unsigned char>(F, WS_HB8);
    const unsigned char* PU = wsp<unsigned char>(F, WS_PU) + (size_t)l * SZ_PT; const unsigned char* PV = wsp<unsigned char>(F, WS_PV) + (size_t)l * SZ_PT;
    const float* modl = wsp<float>(F, WS_MOD) + (size_t)l * 5 * 12288; const float* modn = wsp<float>(F, WS_MOD) + (size_t)(l + 1) * 5 * 12288;
    const float* g2n = F.in(25) + l * D; const float* b2n = F.in(26) + l * D;
    const int npairs = (last ? NLAT : NROW) / 2;
    const int per_wg = (npairs + F.G - 1) / F.G; const int p_lo = F.bid * per_wg; const int p_hi = (p_lo + per_wg) < npairs ? (p_lo + per_wg) : npairs;
    LAS int* wq = (LAS int*)(F.lds + 147456 - 32);
    if (F.tid == 0) *wq = 0;
    __syncthreads();
#pragma unroll 1
    for (;;) {
        int pi = 0; if (lane == 0) pi = __hip_atomic_fetch_add(wq, 1, __ATOMIC_RELAXED, __HIP_MEMORY_SCOPE_WORKGROUP);
        pi = p_lo + __builtin_amdgcn_readfirstlane(pi); if (pi >= p_hi) break;
        const int rowA = 2 * pi;
#pragma unroll 1
        for (int rep1_ = 0; rep1_ <= REP_PS1; ++rep1_) {
            unsigned kk[2][8][4];
            { int fr_ = fr; asm volatile("" : "+v"(fr_));
              const bf16_t* qrow = QP + (size_t)(rowA + (fr_ >> 3)) * 1024 + (fr_ & 7) * 128 + 8 * fq;
              bf16x8 af[2][2];
#pragma unroll
              for (int st = 0; st < 2; ++st)
#pragma unroll
                  for (int ks = 0; ks < 2; ++ks) af[st][ks] = *(const bf16x8*)(qrow + st * 64 + ks * 32);
#pragma unroll
              for (int st = 0; st < 2; ++st) { LAS bf16_t* kb = st ? kb2 : kb1;
#pragma unroll
                  for (int nb = 0; nb < 8; ++nb) { f32x4 c = {0.f, 0.f, 0.f, 0.f};
#pragma unroll
                      for (int ks = 0; ks < 2; ++ks) { const bf16x8 bfr = *(const LAS bf16x8*)(kb + (nb * 16 + fr) * KBP + ks * 32 + 8 * fq); c = __builtin_amdgcn_mfma_f32_16x16x32_bf16(af[st][ks], bfr, c, 0, 0, 0); }
#pragma unroll
                      for (int r = 0; r < 4; ++r) kk[st][nb][r] = f2key(c[r]); } } }
            unsigned T[2][4]; bool done[2][4];
#pragma unroll
            for (int st = 0; st < 2; ++st)
#pragma unroll
                for (int r = 0; r < 4; ++r) { T[st][r] = 0u; done[st][r] = false; }
#pragma unroll 1
            for (int bit = 31; bit >= 0; --bit) { const unsigned bm = 1u << bit; bool alld = true;
#pragma unroll
                for (int st = 0; st < 2; ++st)
#pragma unroll
                    for (int r = 0; r < 4; ++r) { const unsigned cand = T[st][r] | bm; int c = 0;
#pragma unroll
                        for (int nb = 0; nb < 8; ++nb) c += (kk[st][nb][r] >= cand) ? 1 : 0;
                        c = irow16_sum(c);
                        const bool upd = (c >= 16) && !done[st][r]; T[st][r] = upd ? cand : T[st][r]; done[st][r] = done[st][r] || (c == 16); alld = alld && done[st][r]; }
                if (__all(alld)) break; }
            const int tt = lane >> 5, hd0 = ((lane >> 4) & 1) * 4;
#pragma unroll
            for (int st = 0; st < 2; ++st)
#pragma unroll
                for (int r = 0; r < 4; ++r) { const unsigned Tr = T[st][r]; int g = 0, e = 0;
#pragma unroll
                    for (int nb = 0; nb < 8; ++nb) { g += (kk[st][nb][r] > Tr) ? 1 : 0; e += (kk[st][nb][r] == Tr) ? 1 : 0; }
                    int gpre = irow16_incl_scan(g) - g, epre = irow16_incl_scan(e) - e; const int ngt = irow16_sum(g); const int need = 16 - ngt;
                    LAS unsigned* tb = wbase + tt * PT_WORDS; LAS float* vl = (LAS float*)(tb + st * 128) + (hd0 + r) * 16; LAS int* il = (LAS int*)(tb + 256 + st * 128) + (hd0 + r) * 16;
#pragma unroll
                    for (int nb = 0; nb < 8; ++nb) { const unsigned k = kk[st][nb][r];
                        if (k > Tr) { vl[gpre] = key2f(k); il[gpre] = nb * 16 + fr; ++gpre; }
                        else if (k == Tr) { if (epre < need) { vl[ngt + epre] = key2f(k); il[ngt + epre] = nb * 16 + fr; } ++epre; } } }
        }
        asm volatile("s_waitcnt lgkmcnt(0)" ::: "memory");
        {
            const int tt = lane >> 5, hd0 = ((lane >> 4) & 1) * 4; LAS unsigned* tb = wbase + tt * PT_WORDS;
            unsigned ck[4][16];
#pragma unroll
            for (int r = 0; r < 4; ++r) { const float va = ((LAS float*)tb)[(hd0 + r) * 16 + fr]; const LAS float* v2p = (LAS float*)(tb + 128) + (hd0 + r) * 16;
#pragma unroll
                for (int j4 = 0; j4 < 4; ++j4) { const f32x4 vb = *(const LAS f32x4*)(v2p + j4 * 4);
#pragma unroll
                    for (int i = 0; i < 4; ++i) ck[r][j4 * 4 + i] = f2key(va + vb[i]); } }
            unsigned T[4]; bool done[4];
#pragma unroll
            for (int r = 0; r < 4; ++r) { T[r] = 0u; done[r] = false; }
#pragma unroll 1
            for (int bit = 31; bit >= 0; --bit) { const unsigned bm = 1u << bit; bool alld = true;
#pragma unroll
                for (int r = 0; r < 4; ++r) { const unsigned cand = T[r] | bm; int c = 0;
#pragma unroll
                    for (int j = 0; j < 16; ++j) c += (ck[r][j] >= cand) ? 1 : 0;
                    c = irow16_sum(c);
                    const bool upd = (c >= 16) && !done[r]; T[r] = upd ? cand : T[r]; done[r] = done[r] || (c == 16); alld = alld && done[r]; }
                if (__all(alld)) break; }
#pragma unroll
            for (int r = 0; r < 4; ++r) { const unsigned Tr = T[r]; int g = 0, e = 0;
#pragma unroll
                for (int j = 0; j < 16; ++j) { g += (ck[r][j] > Tr) ? 1 : 0; e += (ck[r][j] == Tr) ? 1 : 0; }
                int gpre = irow16_incl_scan(g) - g, epre = irow16_incl_scan(e) - e; const int ngt = irow16_sum(g); const int need = 16 - ngt;
                const int e1 = ((LAS int*)(tb + 256))[(hd0 + r) * 16 + fr] * 128; const LAS int* i2p = (LAS int*)(tb + 384) + (hd0 + r) * 16;
                LAS float* cs_ = (LAS float*)(tb + 512) + (hd0 + r) * 16; LAS int* ce_ = (LAS int*)(tb + 640) + (hd0 + r) * 16;
#pragma unroll
                for (int j = 0; j < 16; ++j) { const unsigned k = ck[r][j];
                    if (k > Tr) { cs_[gpre] = key2f(k); ce_[gpre] = e1 + i2p[j]; ++gpre; }
                    else if (k == Tr) { if (epre < need) { cs_[ngt + epre] = key2f(k); ce_[ngt + epre] = e1 + i2p[j]; } ++epre; } } }
        }
        asm volatile("s_waitcnt lgkmcnt(0)" ::: "memory");
#pragma unroll 1
      for (int t = 0; t < 2; ++t) {
        const int row = rowA + t; const int v = row < NLAT ? (row >> 12) : 4;
        LAS unsigned* tb = wbase + t * PT_WORDS;
        LAS float* v1l = (LAS float*)tb; LAS float* v2l = v1l + 128; LAS int* i1l = (LAS int*)(v2l + 128); LAS int* i2l = i1l + 128;
        LAS float* csl = (LAS float*)(i2l + 128); LAS int* cel = (LAS int*)(csl + 128); LAS int* el = cel + 128; LAS float* gl = (LAS float*)(el + 160); LAS float* su = gl + 128; LAS float* sv = su + 128;
        {
#pragma unroll
            for (int it = 0; it < 2; ++it) { const int idx = it * 64 + lane;
                const float sx = csl[idx]; const float mx = row16_max(sx); const float pe_ = __expf(sx - mx); const float sm = row16_sum(pe_);
                el[idx] = cel[idx]; gl[idx] = pe_ / sm; }
        }
        if (lane < 32) el[128 + lane] = el[0];
        asm volatile("s_waitcnt vmcnt(0) lgkmcnt(0)" ::: "memory");
        float hh[32]; ld16_bf16(HB + (size_t)row * D, lane, hh);
        f32x2 hh2[16];
#pragma unroll
        for (int i = 0; i < 16; ++i) hh2[i] = (f32x2){hh[2 * i], hh[2 * i + 1]};
        const bool b0_ = lane & 1, b1_ = lane & 2, b2_ = lane & 4;
        u32x4 A[8], B[8], C[8]; unsigned SA[8], SB[8], SC[8];
#define PEER_LOADT(buf, sbuf, tab, g) do { _Pragma("unroll") for (int x = 0; x < 8; ++x) { const int e = __builtin_amdgcn_readfirstlane(el[(g) * 8 + x]); const unsigned char* rp = (tab) + (size_t)e * TBS; \
            buf[x] = *(const u32x4*)(rp + 16 * lane); sbuf[x] = *(const bf16_t*)(rp + 1024 + 2 * lane); } } while (0)
#define PEER_LOADV(buf, g) do { _Pragma("unroll") for (int x = 0; x < 8; ++x) { const int e = __builtin_amdgcn_readfirstlane(el[(g) * 8 + x]); buf[x] = *(const u32x4*)(PV + (size_t)e * 1024 + 16 * lane); } } while (0)
#define FP4X8(w_, f0_, f1_, f2_, f3_) const f32x2 f0_ = __builtin_amdgcn_cvt_scalef32_pk_f32_fp4(w_, 1.0f, 0), f1_ = __builtin_amdgcn_cvt_scalef32_pk_f32_fp4(w_, 1.0f, 1), f2_ = __builtin_amdgcn_cvt_scalef32_pk_f32_fp4(w_, 1.0f, 2), f3_ = __builtin_amdgcn_cvt_scalef32_pk_f32_fp4(w_, 1.0f, 3)
#define PEER_DOT(buf, sbuf, g) do { float p_[8]; \
            _Pragma("unroll") for (int x = 0; x < 8; ++x) { f32x2 s2_ = {0.f, 0.f}; \
                _Pragma("unroll") for (int d = 0; d < 4; ++d) { const unsigned w_ = buf[x][d]; FP4X8(w_, f0_, f1_, f2_, f3_); const int o_ = (d >> 1) * 8 + (d & 1) * 4; \
                    s2_ = hh2[o_ + 0] * f0_ + s2_; s2_ = hh2[o_ + 1] * f1_ + s2_; s2_ = hh2[o_ + 2] * f2_ + s2_; s2_ = hh2[o_ + 3] * f3_ + s2_; } \
                p_[x] = (s2_.x + s2_.y) * __uint_as_float(sbuf[x] << 16); SBAR(); } \
              \
            float q_[4], r_[2]; \
            _Pragma("unroll") for (int j = 0; j < 4; ++j) { const float keep_ = b0_ ? p_[2 * j + 1] : p_[2 * j], send_ = b0_ ? p_[2 * j] : p_[2 * j + 1]; q_[j] = keep_ + dppf<0xB1>(send_); } \
            _Pragma("unroll") for (int j = 0; j < 2; ++j) { const float keep_ = b1_ ? q_[2 * j + 1] : q_[2 * j], send_ = b1_ ? q_[2 * j] : q_[2 * j + 1]; r_[j] = keep_ + dppf<0x4E>(send_); } \
            float t_; { const float keep_ = b2_ ? r_[1] : r_[0], send_ = b2_ ? r_[0] : r_[1]; const float up_ = dppf<0x104>(send_), dn_ = dppf<0x114>(send_); t_ = keep_ + (b2_ ? dn_ : up_); } \
            t_ += dppf<0x128>(t_); \
            { auto r16_ = __builtin_amdgcn_permlane16_swap(__float_as_uint(t_), __float_as_uint(t_), false, false); t_ = __uint_as_float(r16_[0]) + __uint_as_float(r16_[1]); } \
            { auto r32_ = __builtin_amdgcn_permlane32_swap(__float_as_uint(t_), __float_as_uint(t_), false, false); t_ = __uint_as_float(r32_[0]) + __uint_as_float(r32_[1]); } \
            const float av = gelu_erf(t_) * gl[(g) * 8 + (lane & 7)]; const bool me_ = (lane >> 3) == ((g) & 7); \
            avl = (me_ && (g) < 8) ? av : avl; avh = (me_ && (g) >= 8) ? av : avh; } while (0)
#define PIN_ACC() do { asm volatile("" : "+v"(acc2[0]), "+v"(acc2[1]), "+v"(acc2[2]), "+v"(acc2[3]), "+v"(acc2[4]), "+v"(acc2[5]), "+v"(acc2[6]), "+v"(acc2[7]), "+v"(acc2[8]), "+v"(acc2[9]), "+v"(acc2[10]), "+v"(acc2[11]), "+v"(acc2[12]), "+v"(acc2[13]), "+v"(acc2[14]), "+v"(acc2[15])); } while (0)
#define PEER_AXPY(buf, sbuf, g) do { _Pragma("unroll") for (int x = 0; x < 8; ++x) { const int idx = (g) * 8 + x; \
            const float av = __uint_as_float(__builtin_amdgcn_readlane(__float_as_uint(idx < 64 ? avl : avh), idx & 63)) * __uint_as_float(sbuf[x] << 16); const f32x2 av2_ = {av, av}; \
            _Pragma("unroll") for (int d = 0; d < 4; ++d) { const unsigned w_ = buf[x][d]; FP4X8(w_, f0_, f1_, f2_, f3_); const int o_ = (d >> 1) * 8 + (d & 1) * 4; \
                acc2[o_ + 0] = av2_ * f0_ + acc2[o_ + 0]; acc2[o_ + 1] = av2_ * f1_ + acc2[o_ + 1]; acc2[o_ + 2] = av2_ * f2_ + acc2[o_ + 2]; acc2[o_ + 3] = av2_ * f3_ + acc2[o_ + 3]; } PIN_ACC(); } } while (0)
        float avl = 0.f, avh = 0.f;
        PEER_LOADT(A, SA, PU, 0); PEER_LOADT(B, SB, PU, 1);
#pragma unroll 1
        for (int g = 0; g < 15; g += 3) { PEER_LOADT(C, SC, PU, g + 2); SBAR(); PEER_DOT(A, SA, g); SBAR(); PEER_LOADT(A, SA, PU, g + 3); SBAR(); PEER_DOT(B, SB, g + 1); SBAR(); PEER_LOADT(B, SB, PU, g + 4); SBAR(); PEER_DOT(C, SC, g + 2); SBAR(); }
        PEER_DOT(A, SA, 15); SBAR();
        f32x2 acc2[16];
#pragma unroll
        for (int i = 0; i < 16; ++i) acc2[i] = (f32x2){0.f, 0.f};
        float* xp = xres_row(F, row);
        PEER_LOADT(A, SA, PV, 0); PEER_LOADT(B, SB, PV, 1);
#pragma unroll 1
        for (int g = 0; g < 15; g += 3) { PEER_LOADT(C, SC, PV, g + 2); SBAR(); PEER_AXPY(A, SA, g); SBAR(); PEER_LOADT(A, SA, PV, g + 3); SBAR(); PEER_AXPY(B, SB, g + 1); SBAR(); PEER_LOADT(B, SB, PV, g + 4); SBAR(); PEER_AXPY(C, SC, g + 2); SBAR(); }
        float x1[32], g2[32]; ld16_f32(xp, lane, x1); ld16_f32(modl + (size_t)v * 12288 + 10240, lane, g2); SBAR();
        PEER_AXPY(A, SA, 15); SBAR();
#undef PEER_LOADT
#undef PEER_LOADV
#undef PEER_DOT
#undef PEER_AXPY
        float acc[32];
        {
#pragma unroll
          for (int i = 0; i < 32; ++i) acc[i] = ALPHA * x1[i] + g2[i] * acc2[i >> 1][i & 1]; }
        { float sm = 0.f;
#pragma unroll
          for (int i = 0; i < 32; ++i) sm += acc[i];
          const float mu = wave_sum(sm) * (1.f / 2048.f); float qq = 0.f;
#pragma unroll
          for (int i = 0; i < 32; ++i) { const float dd = acc[i] - mu; qq += dd * dd; }
          const float rstd = rsqrtf(wave_sum(qq) * (1.f / 2048.f) + LN_EPS);
#pragma unroll
          for (int q = 0; q < 2; ++q)
#pragma unroll
              for (int d = 0; d < 4; ++d) { const int o = 1024 * q + 16 * lane + 4 * d; const f32x4 gg = *(const f32x4*)(g2n + o), bb = *(const f32x4*)(b2n + o);
#pragma unroll
                  for (int i = 0; i < 4; ++i) acc[q * 16 + d * 4 + i] = (acc[q * 16 + d * 4 + i] - mu) * rstd * gg[i] + bb[i]; } }
        st16_f32(xp, lane, acc);
        if (!last) { const float* sh = modn + (size_t)v * 12288; const float* sc = sh + 2048;
#pragma unroll
            for (int q = 0; q < 2; ++q)
#pragma unroll
                for (int d = 0; d < 4; ++d) { const int o = 1024 * q + 16 * lane + 4 * d; const f32x4 hh4 = *(const f32x4*)(sh + o), cc4 = *(const f32x4*)(sc + o);
#pragma unroll
                    for (int i = 0; i < 4; ++i) acc[q * 16 + d * 4 + i] = clamp8(acc[q * 16 + d * 4 + i] * (1.f + cc4[i]) + hh4[i]); }
#pragma unroll
            for (int q = 0; q < 2; ++q) { u32x4 w;
#pragma unroll
                for (int d = 0; d < 4; ++d) w[d] = pk4_fp8(acc[q * 16 + d * 4 + 0], acc[q * 16 + d * 4 + 1], acc[q * 16 + d * 4 + 2], acc[q * 16 + d * 4 + 3]);
                *(u32x4*)(HB8w + (size_t)row * D + 1024 * q + 16 * lane) = w; } }
      }
    }
}
#ifdef DBG
constexpr size_t WS_DBG = WS_CTL + 131072;
constexpr int DBG_NS = 60;
__device__ __forceinline__ int dbg_row(int s) { return (s * 263 + 5) % NLAT; }
__global__ void __launch_bounds__(256) dbg_peer_pre(Args args, int l) {
    __shared__ float q[1024]; __shared__ float s1[128], s2[128]; __shared__ float v1[16], v2[16]; __shared__ int i1[16], i2[16]; __shared__ float cs[256]; __shared__ int ce[256];
    __shared__ float ts[16]; __shared__ int te[16]; __shared__ float red[256]; __shared__ float aval[128]; __shared__ int eid[128]; __shared__ float h2[2048];
    const int s = blockIdx.x, row = dbg_row(s), tid = threadIdx.x; unsigned char* ws = args.ws;
    const bf16_t* QP = (const bf16_t*)(ws + WS_QP); const bf16_t* HB = (const bf16_t*)(ws + WS_HB);
    float* dbgf = (float*)(ws + WS_DBG + 4096); int* dbge = (int*)(dbgf + DBG_NS * 2048); float* dbga = (float*)(dbge + DBG_NS * 128); float* dbgg = dbga + 3 * DBG_NS * 128;
    for (int i = tid; i < 1024; i += 256) q[i] = bf2f(QP[(size_t)row * 1024 + i]);
    for (int i = tid; i < 2048; i += 256) h2[i] = bf2f(HB[(size_t)row * D + i]);
    __syncthreads();
    const float* k1 = args.in[21] + (size_t)l * 8192; const float* k2 = args.in[22] + (size_t)l * 8192;
    for (int hd = 0; hd < 8; ++hd) {
        { const int k = tid & 127; const float* kk = (tid < 128 ? k1 : k2) + k * 64; const float* qq = q + hd * 128 + (tid < 128 ? 0 : 64); float a = 0.f; for (int d = 0; d < 64; ++d) a += qq[d] * kk[d]; (tid < 128 ? s1 : s2)[k] = a; }
        __syncthreads();
        { const int k = tid & 127; const float* sv = tid < 128 ? s1 : s2; const float me = sv[k]; int rank = 0; for (int j = 0; j < 128; ++j) rank += (sv[j] > me || (sv[j] == me && j < k)) ? 1 : 0;
          if (rank < 16) { (tid < 128 ? v1 : v2)[rank] = me; (tid < 128 ? i1 : i2)[rank] = k; } }
        __syncthreads();
        { const int i = tid >> 4, j = tid & 15; cs[tid] = v1[i] + v2[j]; ce[tid] = i1[i] * 128 + i2[j]; }
        __syncthreads();
        { const float me = cs[tid]; int rank = 0; for (int j = 0; j < 256; ++j) rank += (cs[j] > me || (cs[j] == me && j < tid)) ? 1 : 0; if (rank < 16) { ts[rank] = me; te[rank] = ce[tid]; } }
        __syncthreads();
        if (tid < 16) { float mx = ts[0]; float sm = 0.f; for (int j = 0; j < 16; ++j) sm += expf(ts[j] - mx); aval[hd * 16 + tid] = expf(ts[tid] - mx) / sm; eid[hd * 16 + tid] = te[tid]; dbgg[s * 128 + hd * 16 + tid] = aval[hd * 16 + tid]; }
        __syncthreads();
    }
    const float* U = args.in[23] + (size_t)l * 16384 * 2048; const float* V = args.in[24] + (size_t)l * 16384 * 2048;
    for (int e = 0; e < 128; ++e) { const float* ur = U + (size_t)eid[e] * 2048; float p = 0.f; for (int d = tid; d < 2048; d += 256) p += h2[d] * ur[d]; red[tid] = p; __syncthreads();
        for (int st = 128; st > 0; st >>= 1) { if (tid < st) red[tid] += red[tid + st]; __syncthreads(); }
        if (tid == 0) { const float sc = red[0]; aval[e] = 0.5f * sc * (1.f + erff(sc * 0.70710678f)) * aval[e]; } __syncthreads(); }
    float y[8]; const float* xr = args.out + (size_t)row * D; const int v = row >> 12; const float* mod = (const float*)(ws + WS_MOD) + (size_t)l * 5 * 12288 + (size_t)v * 12288;
    float sum = 0.f;
    for (int k = 0; k < 8; ++k) { const int d = tid + 256 * k; float o = 0.f; for (int e = 0; e < 128; ++e) o += aval[e] * V[(size_t)eid[e] * 2048 + d]; y[k] = ALPHA * xr[d] + mod[10240 + d] * o; sum += y[k]; }
    red[tid] = sum; __syncthreads(); for (int st = 128; st > 0; st >>= 1) { if (tid < st) red[tid] += red[tid + st]; __syncthreads(); } const float mu = red[0] / 2048.f; __syncthreads();
    float sq = 0.f; for (int k = 0; k < 8; ++k) sq += (y[k] - mu) * (y[k] - mu);
    red[tid] = sq; __syncthreads(); for (int st = 128; st > 0; st >>= 1) { if (tid < st) red[tid] += red[tid + st]; __syncthreads(); } const float rstd = rsqrtf(red[0] / 2048.f + LN_EPS);
    for (int k = 0; k < 8; ++k) { const int d = tid + 256 * k; dbgf[(size_t)s * 2048 + d] = (y[k] - mu) * rstd * args.in[25][l * D + d] + args.in[26][l * D + d]; }
    if (tid < 128) { dbge[s * 128 + tid] = eid[tid]; dbga[s * 128 + tid] = aval[tid]; }
}
__global__ void __launch_bounds__(256) dbg_peer_post(Args args) {
    __shared__ int bad_e, bad_x, bad_a, bad_g;
    const int s = blockIdx.x, row = dbg_row(s), tid = threadIdx.x; unsigned char* ws = args.ws; unsigned* cnt = (unsigned*)(ws + WS_DBG);
    float* dbgf = (float*)(ws + WS_DBG + 4096); int* dbge = (int*)(dbgf + DBG_NS * 2048); float* dbga = (float*)(dbge + DBG_NS * 128);
    int* fe = (int*)(dbga + DBG_NS * 128); float* fa = (float*)(fe + DBG_NS * 128); float* dbgg = dbga + 3 * DBG_NS * 128; float* fg = dbgg + DBG_NS * 128;
    if (tid == 0) { bad_e = 0; bad_x = 0; bad_a = 0; bad_g = 0; } __syncthreads();
    if (tid < 128) { const int hd = tid >> 4; const int e = dbge[s * 128 + tid]; bool found = false; float af = 0.f, gf = 0.f; for (int j = 0; j < 16; ++j) if (fe[s * 128 + hd * 16 + j] == e) { found = true; af = fa[s * 128 + hd * 16 + j]; gf = fg[s * 128 + hd * 16 + j]; }
        if (!found) atomicAdd(&bad_e, 1); else { const float ea = dbga[s * 128 + tid]; if (fabsf(af - ea) > 0.02f * fabsf(ea) + 2e-3f) atomicAdd(&bad_a, 1); const float eg = dbgg[s * 128 + tid]; if (fabsf(gf - eg) > 0.02f * fabsf(eg) + 1e-3f) atomicAdd(&bad_g, 1); } }
    for (int k = 0; k < 8; ++k) { const int d = tid + 256 * k; const float ex = dbgf[(size_t)s * 2048 + d], got = args.out[(size_t)row * D + d]; if (!(fabsf(got - ex) <= 0.03f + 0.03f * fabsf(ex))) atomicAdd(&bad_x, 1); }
    __syncthreads();
    if (tid == 0) { if (bad_e > 2) atomicAdd(&cnt[1], 1u); if (bad_g > 2) atomicAdd(&cnt[2], 1u); if (bad_a > 2) atomicAdd(&cnt[3], 1u); if (bad_x > 8) atomicAdd(&cnt[4], 1u); }
}
__global__ void dbg_report(Args args) {
    unsigned* cnt = (unsigned*)(args.ws + WS_DBG);
    float code = 0.f;
    for (int lv = 1; lv <= 9; ++lv) if (cnt[lv]) { int tenths = (int)(cnt[lv] * 10 / DBG_NS); if (tenths > 9) tenths = 9; code = 1000.f * lv + 100.f * tenths; break; }
    if (code != 0.f) for (int i = threadIdx.x; i < 4096; i += blockDim.x) args.out[i] = code;
}
#endif
template <int ABL>
__device__ __forceinline__ void p_attn_gqa(const Frame& F, int last) {
    LAS unsigned char* lds = F.lds;
    const unsigned char* QG = wsp<unsigned char>(F, WS_QG); const unsigned char* KG = wsp<unsigned char>(F, WS_KG); const unsigned char* VG = wsp<unsigned char>(F, WS_VG); unsigned char* OAB = wsp<unsigned char>(F, WS_OAB);
    const int nlat = NB * 8 * 16, nall = last ? nlat : nlat + NB * 8;
    for (int u = F.bid; u < nall; u += F.G) {
        int bh, q0, seq; size_t orow;
        if (u < nlat) {
            int uu = u;
            if (F.G == 256) {
                const int c = u & 255, i = u >> 8, xcd = c & 7, r = c >> 3, kvg = i * 4 + (xcd >> 1), within = (xcd & 1) * 32 + r;
                uu = (((kvg >> 1) * 8 + (kvg & 1) * 4 + (within >> 4)) << 4) | (within & 15); }
            bh = uu >> 4; const int qb = uu & 15; q0 = CTXL + qb * 256; seq = TT; orow = (size_t)(bh >> 3) * SEQ + qb * 256; }
        else { bh = u - nlat; q0 = 0; seq = CTXL; orow = (size_t)NLAT + (bh >> 3) * CTXL; }
        const int b = bh >> 3, h = bh & 7; const size_t kvo = (size_t)(b * 2 + (h >> 2)) * TT * 128;
        __syncthreads();
        att::attn_body<4, 0, ABL>(QG + ((size_t)bh * TT + q0) * 128, KG + kvo, VG + (size_t)(b * 2 + (h >> 2)) * 128 * TT, OAB + orow * D + 1024 + h * 128, seq, lds, F.tid);
    }
    __syncthreads();
}
template <int ABL>
__device__ __forceinline__ void p_attn_mla(const Frame& F, int last) {
    LAS unsigned char* lds = F.lds;
    const unsigned char* QM = wsp<unsigned char>(F, WS_QM); const unsigned char* KM = wsp<unsigned char>(F, WS_KM); const unsigned char* VM = wsp<unsigned char>(F, WS_VM); unsigned char* OAB = wsp<unsigned char>(F, WS_OAB);
    const int nlat = NB * 8 * 16, nall = last ? nlat : nlat + NB * 8;
    for (int u = F.bid; u < nall; u += F.G) {
        int bh, q0, seq; size_t orow;
        if (u < nlat) {
            int uu = u;
            if (F.G == 256) { const int c = u & 255, i = u >> 8, xcd = c & 7, r = c >> 3; uu = ((i * 16 + xcd * 2 + (r >> 4)) << 4) | (r & 15); }
            bh = uu >> 4; const int qb = uu & 15; q0 = CTXL + qb * 256; seq = TT; orow = (size_t)(bh >> 3) * SEQ + qb * 256; }
        else { bh = u - nlat; q0 = 0; seq = CTXL; orow = (size_t)NLAT + (bh >> 3) * CTXL; }
        const int h = bh & 7;
        __syncthreads();
        att::attn_body<2, 1, ABL>(QM + ((size_t)bh * TT + q0) * 128, KM + (size_t)bh * TT * 128, VM + (size_t)bh * 64 * TT, OAB + orow * D + h * 64, seq, lds, F.tid);
    }
    __syncthreads();
}
__device__ __forceinline__ void p_ret_out(const Frame& F, int l, int last) {
    const int c_lo = last ? 2 : 0, nc = 34 - c_lo, nu = NB * 8 * nc;
    for (int u = F.bid; u < nu; u += F.G) { const int bh = u / nc, c = c_lo + (u % nc); ret_out_unit(F, l, bh, c); }
    __syncthreads();
}

constexpr int LDS_BYTES = 147456;
constexpr int MISC_OFF = 147456 - 64;
constexpr int NPHASE = 22;
#ifndef PHM
#define PHM 0xFFFF
#endif
#ifndef PH_ATTR
#define PH_ATTR __forceinline__
#endif
template <int PART> __device__ PH_ATTR void ph_prologue(ArgP ap) { const Frame F = make_frame(ap); p0_prologue<PART>(F); }
__device__ PH_ATTR void ph_modreduce(ArgP ap) { const Frame F = make_frame(ap); p1_modreduce(F); }
__device__ PH_ATTR void ph_modulate0(ArgP ap) { const Frame F = make_frame(ap); p_modulate0(F); }
template <int GABL> __device__ PH_ATTR void ph_gemm_in(ArgP ap, int l) { const Frame F = make_frame(ap);
    pg8::Gemm g{wsp<bf16_t>(F, WS_HB8), wsp<bf16_t>(F, WS_WIN + l * SZ_WIN), NROW, NPT, 1024, 1024, 1024}; pg8::StaticOrder S; S.init(NROW, NPT, F.G, F.bid);
    float mul_, inv_; fp8_scale(wsp<unsigned>(F, WS_WSC)[l], mul_, inv_);
    EpiIn E{wsp<bf16_t>(F, WS_P1), wsp<bf16_t>(F, WS_G), inv_};
    pg8::gemm_phase<EpiIn, pg8::StaticOrder, GABL>(F.lds, F.tid, g, S, E); }
__device__ PH_ATTR void ph_post(ArgP ap, int l) { const Frame F = make_frame(ap); p_post(F, l); if (l == 1) cvt_peer(F, 1); }
__device__ PH_ATTR void ph_qup(ArgP ap, int l) { const Frame F = make_frame(ap);
    pg8::Gemm g{wsp<bf16_t>(F, WS_CQN), wsp<bf16_t>(F, WS_WQUP + l * SZ_WQUP), NROW, 768, 512, 512, 512}; pg8::StaticOrder S; S.init(NROW, 768, F.G, F.bid);
    EpiQup E{wsp<unsigned char>(F, WS_QM), wsp<f32x2>(F, WS_ROPE32)};
    pg8::gemm_phase<EpiQup, pg8::StaticOrder>(F.lds, F.tid, g, S, E); }
__device__ PH_ATTR void ph_kvup(ArgP ap, int l) { const Frame F = make_frame(ap);
    pg8::Gemm g{wsp<bf16_t>(F, WS_CKVN), wsp<bf16_t>(F, WS_WKVUP + l * SZ_WKVUP), NROW, 1024, 256, 256, 256}; pg8::StaticOrder S; S.init(NROW, 1024, F.G, F.bid);
    EpiKvup E{wsp<unsigned char>(F, WS_KM), wsp<unsigned char>(F, WS_VM)};
    pg8::gemm_phase<EpiKvup, pg8::StaticOrder>(F.lds, F.tid, g, S, E); }
__device__ PH_ATTR void ph_states(ArgP ap, int l) { const Frame F = make_frame(ap); p_ret_states(F, l); }
template <int ABL> __device__ PH_ATTR void ph_attn_gqa(ArgP ap, int last) { const Frame F = make_frame(ap); p_attn_gqa<ABL>(F, last); }
template <int ABL> __device__ PH_ATTR void ph_attn_mla(ArgP ap, int last) { const Frame F = make_frame(ap); p_attn_mla<ABL>(F, last); }
__device__ PH_ATTR void ph_ret_out(ArgP ap, int l, int last) { const Frame F = make_frame(ap); p_ret_out(F, l, last); }
template <int SEG> __device__ PH_ATTR void ph_merge(ArgP ap, int l, int Mx) { const Frame F = make_frame(ap);
    const bf16_t* OAB = wsp<bf16_t>(F, WS_OAB); bf16_t* MB = wsp<bf16_t>(F, WS_MB); const bf16_t* G = wsp<bf16_t>(F, WS_G);
    pg8::StaticOrder S; S.init(Mx, 2048, F.G, F.bid);
    const size_t wo = SEG == 0 ? WS_WBRA + l * SZ_WBRA : (SEG == 1 ? WS_WBRB + l * SZ_WBRB : WS_WBRC + l * SZ_WBRC); const int K = SEG == 2 ? 1024 : 512;
    pg8::Gemm g{OAB + SEG * 512, wsp<bf16_t>(F, wo), Mx, 2048, K, 2048, K}; EpiMerge<SEG> E{MB, G, wsp<unsigned char>(F, WS_MB8)}; pg8::gemm_phase<EpiMerge<SEG>, pg8::StaticOrder>(F.lds, F.tid, g, S, E); }
__device__ PH_ATTR void ph_merge3(ArgP ap, int l, int Mx) { const Frame F = make_frame(ap);
    pg8::StaticOrder S; S.init(Mx, 2048, F.G, F.bid);
    float m0_, i0_, m1_, i1_, m2_, i2_; fp8_scale(wsp<unsigned>(F, WS_WSC)[4 + l], m0_, i0_); fp8_scale(wsp<unsigned>(F, WS_WSC)[6 + l], m1_, i1_); fp8_scale(wsp<unsigned>(F, WS_WSC)[8 + l], m2_, i2_);
    pg8::Merge3 g{wsp<bf16_t>(F, WS_OAB), wsp<bf16_t>(F, WS_WBRA + l * SZ_WBRA), wsp<bf16_t>(F, WS_WBRB + l * SZ_WBRB), wsp<bf16_t>(F, WS_WBRC + l * SZ_WBRC), wsp<bf16_t>(F, WS_G), wsp<unsigned char>(F, WS_MB8), i0_ * m1_, i1_ * m2_, i2_};
    pg8::gemm_merge3<pg8::StaticOrder>(F.lds, F.tid, g, S); }
__device__ PH_ATTR void ph_out(ArgP ap, int l, int Mx) { const Frame F = make_frame(ap);
    pg8::Gemm g{wsp<bf16_t>(F, WS_MB8), wsp<bf16_t>(F, WS_WOUT + l * SZ_WOUT), Mx, 2048, 1024, 1024, 1024}; pg8::StaticOrder S; S.init(Mx, 2048, F.G, F.bid);
    float mul_, inv_; fp8_scale(wsp<unsigned>(F, WS_WSC)[2 + l], mul_, inv_);
    EpiOut E{l == 0 ? F.in(0) : F.out, l == 0 ? F.in(2) : wsp<float>(F, WS_XC), F.out, wsp<float>(F, WS_XC), wsp<float>(F, WS_MOD) + (size_t)l * 5 * 12288 + 4096, inv_ * (1.f / 16.f)};
    pg8::gemm_phase<EpiOut, pg8::StaticOrder>(F.lds, F.tid, g, S, E); }
__device__ PH_ATTR void ph_ln1(ArgP ap, int l, int last) { const Frame F = make_frame(ap); p_ln1(F, l, last); }
__device__ PH_ATTR void ph_peerq(ArgP ap, int l, int Mx) { const Frame F = make_frame(ap);
    pg8::Gemm g{wsp<bf16_t>(F, WS_HB), wsp<bf16_t>(F, WS_WPQ + l * SZ_WPQ), Mx, 1024, 2048, 2048, 2048}; pg8::StaticOrder S; S.init(Mx, 1024, F.G, F.bid);
    EpiPlain E{wsp<bf16_t>(F, WS_QP), 1024};
    pg8::gemm_phase<EpiPlain, pg8::StaticOrder>(F.lds, F.tid, g, S, E); }
__device__ PH_ATTR void ph_peer(ArgP ap, int l, int last) { const Frame F = make_frame(ap); p_peer(F, l, last); }

__global__ void __launch_bounds__(512, 2) mega_fwd(Args args) {
    extern __shared__ __attribute__((aligned(16))) unsigned char lds_raw[];
    const ArgP ap = (ArgP)__builtin_amdgcn_kernarg_segment_ptr();
    const int lo = ap->ph_lo, hi = ap->ph_hi;
    volatile LAS unsigned* misc = (volatile LAS unsigned*)((LAS unsigned char*)lds_raw + MISC_OFF);
    if (threadIdx.x < 4) misc[threadIdx.x] = 0u;
    __syncthreads();
    XcdBarrier bar; bar.bar = (unsigned*)(ap->ws + WS_CTL); bar.x = 0; bar.st = misc;
    if (hi - lo > 1) bar = xcd_barrier_post((unsigned*)(ap->ws + WS_CTL), misc);
#ifdef BENCH_K
    { float a[16]; f32x2 b2[8];
#pragma unroll
      for (int i = 0; i < 16; ++i) a[i] = 1.f + threadIdx.x * 1e-3f + i;
#pragma unroll
      for (int i = 0; i < 8; ++i) b2[i] = (f32x2){a[i], a[i + 8]};
      float c0 = a[3], c1 = a[5];
#define B16(INS) asm volatile(INS(0) INS(1) INS(2) INS(3) INS(4) INS(5) INS(6) INS(7) INS(8) INS(9) INS(10) INS(11) INS(12) INS(13) INS(14) INS(15) \
        : "+v"(a[0]), "+v"(a[1]), "+v"(a[2]), "+v"(a[3]), "+v"(a[4]), "+v"(a[5]), "+v"(a[6]), "+v"(a[7]), "+v"(a[8]), "+v"(a[9]), "+v"(a[10]), "+v"(a[11]), "+v"(a[12]), "+v"(a[13]), "+v"(a[14]), "+v"(a[15]) : "v"(c0), "v"(c1))
#define I_ADD(i) "v_add_f32 %" #i ", %" #i ", %16\n"
#define I_EXP(i) "v_exp_f32 %" #i ", %" #i "\n"
#define I_MAX3(i) "v_max3_f32 %" #i ", %" #i ", %16, %17\n"
#define I_CVT(i) "v_cvt_pk_fp8_f32 %" #i ", %16, %17\n"
#define I_DEP(i) "v_max3_f32 %0, %0, %16, %17\n"
#define I_DEPA(i) "v_add_f32 %0, %0, %16\n"
#define I_FMA(i) "v_fma_f32 %" #i ", %" #i ", %16, %17\n"
#define P8(INS) asm volatile(INS(0) INS(1) INS(2) INS(3) INS(4) INS(5) INS(6) INS(7) INS(0) INS(1) INS(2) INS(3) INS(4) INS(5) INS(6) INS(7) \
        : "+v"(b2[0]), "+v"(b2[1]), "+v"(b2[2]), "+v"(b2[3]), "+v"(b2[4]), "+v"(b2[5]), "+v"(b2[6]), "+v"(b2[7]) : "v"(b2[0]))
#define I_PKADD(i) "v_pk_add_f32 %" #i ", %" #i ", %8\n"
#define I_PKFMA(i) "v_pk_fma_f32 %" #i ", %" #i ", %8, %8\n"
#pragma unroll 1
      for (int it = 0; it < 20000; ++it) {
#if BENCH_K == 1
        B16(I_ADD);
#elif BENCH_K == 2
        B16(I_EXP);
#elif BENCH_K == 3
        B16(I_MAX3);
#elif BENCH_K == 4
        B16(I_CVT);
#elif BENCH_K == 5
        P8(I_PKADD);
#elif BENCH_K == 6
        P8(I_PKFMA);
#elif BENCH_K == 7
        B16(I_FMA);
#elif BENCH_K == 9
        B16(I_DEP);
#elif BENCH_K == 10
        B16(I_DEPA);
#endif
      }
#if BENCH_K == 11 || BENCH_K == 12
      { f32x16 q0 = {}, q1 = {}, q2 = {}, q3 = {}; att::i32x8a x8 = {1, 2, 3, 4, 5, 6, 7, (int)threadIdx.x};
#pragma unroll 1
        for (int it = 0; it < 2000; ++it) {
#pragma unroll
          for (int k = 0; k < 4; ++k) {
            q0 = __builtin_amdgcn_mfma_scale_f32_32x32x64_f8f6f4(x8, x8, q0, 0, 0, 0, 0x7F7F7F7F, 0, 0x7F7F7F7F); asm volatile("" : "+v"(q0));
#if BENCH_K == 11
            B16(I_ADD);
#else
            B16(I_EXP);
#endif
            q1 = __builtin_amdgcn_mfma_scale_f32_32x32x64_f8f6f4(x8, x8, q1, 0, 0, 0, 0x7F7F7F7F, 0, 0x7F7F7F7F); asm volatile("" : "+v"(q1));
#if BENCH_K == 11
            B16(I_ADD);
#else
            B16(I_EXP);
#endif
            q2 = __builtin_amdgcn_mfma_scale_f32_32x32x64_f8f6f4(x8, x8, q2, 0, 0, 0, 0x7F7F7F7F, 0, 0x7F7F7F7F); asm volatile("" : "+v"(q2));
#if BENCH_K == 11
            B16(I_ADD);
#else
            B16(I_EXP);
#endif
            q3 = __builtin_amdgcn_mfma_scale_f32_32x32x64_f8f6f4(x8, x8, q3, 0, 0, 0, 0x7F7F7F7F, 0, 0x7F7F7F7F); asm volatile("" : "+v"(q3));
#if BENCH_K == 11
            B16(I_ADD);
#else
            B16(I_EXP);
#endif
          }
          asm volatile("" : "+v"(x8)); } }
#endif
#if BENCH_K == 8
      { f32x16 q0 = {}, q1 = {}, q2 = {}, q3 = {}; att::i32x8a x8 = {1, 2, 3, 4, 5, 6, 7, (int)threadIdx.x};
#pragma unroll 1
        for (int it = 0; it < 2000; ++it) {
#pragma unroll
          for (int k = 0; k < 4; ++k) { q0 = __builtin_amdgcn_mfma_scale_f32_32x32x64_f8f6f4(x8, x8, q0, 0, 0, 0, 0x7F7F7F7F, 0, 0x7F7F7F7F); q1 = __builtin_amdgcn_mfma_scale_f32_32x32x64_f8f6f4(x8, x8, q1, 0, 0, 0, 0x7F7F7F7F, 0, 0x7F7F7F7F);
            q2 = __builtin_amdgcn_mfma_scale_f32_32x32x64_f8f6f4(x8, x8, q2, 0, 0, 0, 0x7F7F7F7F, 0, 0x7F7F7F7F); q3 = __builtin_amdgcn_mfma_scale_f32_32x32x64_f8f6f4(x8, x8, q3, 0, 0, 0, 0x7F7F7F7F, 0, 0x7F7F7F7F); }
          asm volatile("" : "+v"(q0), "+v"(q1), "+v"(q2), "+v"(q3), "+v"(x8)); } }
#endif
    }
#endif
#define IN(k) (lo <= (k) && (k) < hi)
#define SEAM(k) do { if (IN(k) && IN((k) + 1)) xcd_barrier(bar); } while (0)
    if (IN(0)) { if (PHM & 1) ph_prologue<7>(ap); if (REP_PRO) ph_prologue<REP_PRO>(ap); } SEAM(0);
    if (IN(1)) { if (PHM & 2) ph_modreduce(ap); if (REP_X & 32) ph_modreduce(ap); } SEAM(1);
#pragma unroll 1
    for (int l = 0; l < 2; ++l) {
        const int pb = 2 + 10 * l; const int last = (l == 1);
        const int Mx = last ? NLAT : NROW;
        if (l == 0) { if (IN(pb)) { if (PHM & 4) ph_modulate0(ap); if (REP_X & 64) ph_modulate0(ap); } SEAM(pb); }
        if (IN(pb + 1)) { if (REP_GIN) ph_gemm_in<GIN_ABL>(ap, l); if (PHM & 8) ph_gemm_in<0>(ap, l); } SEAM(pb + 1);
        if (IN(pb + 2)) { if (PHM & 16) ph_post(ap, l); if (REP_X & 1) ph_post(ap, l); } SEAM(pb + 2);
        if (IN(pb + 3)) { if (PHM & 32) ph_qup(ap, l); if (PHM & 64) ph_kvup(ap, l); if (PHM & 128) ph_states(ap, l); if (REP_X & 2) { ph_qup(ap, l); ph_kvup(ap, l); ph_states(ap, l); } } SEAM(pb + 3);
        if (IN(pb + 4)) { if (REP_ATTN & 1) ph_attn_gqa<ATT_ABL>(ap, last); if (REP_ATTN & 2) ph_attn_mla<ATT_ABL>(ap, last); if (PHM & 256) ph_attn_gqa<0>(ap, last); if (PHM & 512) ph_attn_mla<0>(ap, last); if (REP_X & 4) ph_ret_out(ap, l, last); if (PHM & 1024) ph_ret_out(ap, l, last); } SEAM(pb + 4);
        if (IN(pb + 5)) { if (PHM & 2048) { if (MERGE3) ph_merge3(ap, l, Mx); else { ph_merge<0>(ap, l, Mx); ph_merge<1>(ap, l, Mx); ph_merge<2>(ap, l, Mx); } } if (REP_X & 8) { if (MERGE3) ph_merge3(ap, l, Mx); else { ph_merge<0>(ap, l, Mx); ph_merge<1>(ap, l, Mx); ph_merge<2>(ap, l, Mx); } } } SEAM(pb + 5);
        if (IN(pb + 6)) { if (PHM & 4096) ph_out(ap, l, Mx); } SEAM(pb + 6);
        if (IN(pb + 7)) { if (PHM & 8192) ph_ln1(ap, l, last); } SEAM(pb + 7);
        if (IN(pb + 8)) { if (PHM & 16384) ph_peerq(ap, l, Mx); if (REP_X & 16) ph_peerq(ap, l, Mx); } SEAM(pb + 8);
        if (IN(pb + 9)) { if (PHM & 32768) ph_peer(ap, l, last); } SEAM(pb + 9);
    }
#undef IN
#undef SEAM
}

extern "C" void kernel_launch(void* const* d_in, const int* in_sizes, int n_in, void* d_out, int out_size, void* d_ws, size_t ws_size, hipStream_t stream) {
    static int grid = 0;
    if (grid == 0) {
        if (n_in != 27 || out_size != NLAT * D || ws_size < WS_END) { fprintf(stderr, "kernel_launch: unexpected shapes: n_in %d out %d ws %zu (need %zu)\n", n_in, out_size, ws_size, (size_t)WS_END); grid = -1; return; }
        int dev = 0, cus = 0, per_cu = 0;
        if (hipGetDevice(&dev) != hipSuccess || hipDeviceGetAttribute(&cus, hipDeviceAttributeMultiprocessorCount, dev) != hipSuccess) { grid = -1; return; }
        if (hipFuncSetAttribute((const void*)mega_fwd, hipFuncAttributeMaxDynamicSharedMemorySize, LDS_BYTES) != hipSuccess) { fprintf(stderr, "kernel_launch: hipFuncSetAttribute failed\n"); grid = -1; return; }
        if (hipOccupancyMaxActiveBlocksPerMultiprocessor(&per_cu, (const void*)mega_fwd, 512, LDS_BYTES) != hipSuccess || per_cu < 1) fprintf(stderr, "kernel_launch: occupancy query reports %d\n", per_cu);
        (void)hipGetLastError();
        grid = cus;
    }
    if (grid < 0) return;
    (void)hipMemsetAsync((char*)d_ws + WS_CTL, 0, 65536, stream);
#ifdef DBG
    (void)hipMemsetAsync((char*)d_ws + WS_CTL + 131072, 0, 4096, stream);
#endif
    Args a{};
    for (int i = 0; i < 27; ++i) a.in[i] = (const float*)d_in[i];
    a.out = (float*)d_out; a.ws = (unsigned char*)d_ws;
#if MK_PER_PHASE
    for (int p = 0; p < NPHASE; ++p) { if (p == 12) continue; a.ph_lo = p; a.ph_hi = p + 1;
#ifdef DBG
        if (p == 11) hipLaunchKernelGGL(dbg_peer_pre, dim3(DBG_NS), dim3(256), 0, stream, a, 0);
#endif
        hipLaunchKernelGGL(mega_fwd, dim3(grid), dim3(512), LDS_BYTES, stream, a);
#ifdef DBG
        if (p == 11) hipLaunchKernelGGL(dbg_peer_post, dim3(DBG_NS), dim3(256), 0, stream, a);
#endif
    }
#ifdef DBG
    hipLaunchKernelGGL(dbg_report, dim3(1), dim3(256), 0, stream, a);
#endif
#else
    a.ph_lo = 0; a.ph_hi = NPHASE;
    hipLaunchKernelGGL(mega_fwd, dim3(grid), dim3(512), LDS_BYTES, stream, a);
#endif
    const hipError_t le = hipPeekAtLastError();
    if (le != hipSuccess) fprintf(stderr, "kernel_launch: launch failed: %s\n", hipGetErrorName(le));
}
```

```cpp
#include <hip/hip_runtime.h>
#include <cstdio>
#include <cstdint>
#include <cstddef>

#ifndef MK_PER_PHASE
#define MK_PER_PHASE 0
#endif

#ifndef ABL_PEER
#define ABL_PEER 0
#endif
#ifndef REP_PEERG
#define REP_PEERG 0
#endif
#ifndef REP_PEERH
#define REP_PEERH 0
#endif
#ifndef REP_X
#define REP_X 0
#endif
#ifndef REP_PS1
#define REP_PS1 0
#endif
#ifndef REP_PS2
#define REP_PS2 0
#endif
#ifndef SIDE_ON
#define SIDE_ON 1
#endif
#ifndef REP_DOT
#define REP_DOT 0
#endif
#ifndef MERGE3
#define MERGE3 1
#endif
#ifndef REP_GIN
#define REP_GIN 0
#endif
#ifndef GIN_ABL
#define GIN_ABL 0
#endif
#ifndef ATT_ABL
#define ATT_ABL 0
#endif
#ifndef REP_ATTN
#define REP_ATTN 0
#endif
#ifndef REP_PRO
#define REP_PRO 0
#endif
#ifndef ABL_BR
#define ABL_BR 0
#endif
#ifndef ABL_MIX
#define ABL_MIX 0
#endif
#define LAS __attribute__((address_space(3)))
typedef unsigned short bf16_t;
typedef short bf16x8 __attribute__((ext_vector_type(8)));
typedef short s16x4 __attribute__((ext_vector_type(4)));
typedef float f32x2 __attribute__((ext_vector_type(2)));
typedef float f32x4 __attribute__((ext_vector_type(4)));
typedef float f32x8 __attribute__((ext_vector_type(8)));
typedef float f32x16 __attribute__((ext_vector_type(16)));
typedef unsigned u32x2 __attribute__((ext_vector_type(2)));
typedef unsigned u32x4 __attribute__((ext_vector_type(4)));
typedef __bf16 bf2_t __attribute__((ext_vector_type(2)));

constexpr int D = 2048, NB = 4, SEQ = 4096, CTXL = 256, TT = SEQ + CTXL;
constexpr int NLAT = NB * SEQ, NCTX = NB * CTXL, NROW = NLAT + NCTX;
constexpr int NP1 = 4096, NG = 6144, NPT = NP1 + NG;
constexpr int NIN = 10016;
constexpr float ALPHA = 1.4142135623730951f;
constexpr float LN_EPS = 1e-5f, RMS_EPS = 1e-6f;
constexpr float LOG2E = 1.4426950408889634f;
constexpr int C_CQ = 0, C_CKV = 512, C_GQ = 768, C_GK = 1792, C_GV = 2048, C_RQ = 2304, C_RK = 2560, C_RV = 2816, C_RG = 3328, C_KR = 3840;

constexpr size_t AL(size_t x) { return (x + 255) / 256 * 256; }
constexpr size_t WS_CTL = 0;                                    constexpr size_t CTL_BYTES = 1u << 20;
constexpr size_t WS_WSC = WS_CTL + 32768;
constexpr size_t WS_CVT = WS_CTL + 33024;
constexpr size_t WS_DEC = WS_CTL + 65536;
constexpr size_t WS_ROPE32 = WS_CTL + CTL_BYTES;
constexpr size_t WS_ROPE128 = WS_ROPE32 + AL(64 * 8 * 8);
constexpr size_t WS_MODP = WS_ROPE128 + AL(64 * 32 * 8);
constexpr size_t WS_MOD = WS_MODP + AL((size_t)16 * 2 * 5 * 12288 * 4);
constexpr size_t WS_WIN = WS_MOD + AL((size_t)2 * 5 * 12288 * 4);
constexpr size_t SZ_WIN = (size_t)NPT * D;
constexpr size_t WS_WQUP = WS_WIN + 2 * SZ_WIN;                 constexpr size_t SZ_WQUP = (size_t)768 * 512 * 2;
constexpr size_t WS_WKVUP = WS_WQUP + 2 * SZ_WQUP;              constexpr size_t SZ_WKVUP = (size_t)1024 * 256 * 2;
constexpr size_t WS_WBRA = WS_WKVUP + 2 * SZ_WKVUP;             constexpr size_t SZ_WBRA = (size_t)2048 * 512 * 2;
constexpr size_t WS_WBRB = WS_WBRA + 2 * SZ_WBRA;               constexpr size_t SZ_WBRB = SZ_WBRA;
constexpr size_t WS_WBRC = WS_WBRB + 2 * SZ_WBRB;               constexpr size_t SZ_WBRC = (size_t)2048 * 1024 * 2;
constexpr size_t WS_WOUT = WS_WBRC + 2 * SZ_WBRC;               constexpr size_t SZ_WOUT = (size_t)2048 * 2048 * 2;
constexpr size_t WS_WPQ = WS_WOUT + 2 * SZ_WOUT;                constexpr size_t SZ_WPQ = (size_t)1024 * 2048 * 2;
constexpr size_t WS_PSC = WS_WPQ + 2 * SZ_WPQ;
constexpr size_t WS_PU = WS_PSC + (size_t)4 * 16384 * 4;        constexpr size_t SZ_PT = (size_t)16384 * 1152;
constexpr size_t WS_PV = WS_PU + 2 * SZ_PT;
constexpr size_t WS_XC = WS_PV + 2 * SZ_PT;
constexpr size_t WS_HB = WS_XC + (size_t)NCTX * D * 4;
constexpr size_t WS_P1 = WS_HB + (size_t)NROW * D * 2;
constexpr size_t WS_G = WS_P1 + (size_t)NROW * NP1 * 2;
constexpr size_t WS_CQN = WS_G + (size_t)NROW * NG * 2;
constexpr size_t WS_CKVN = WS_CQN + (size_t)NROW * 512 * 2;
constexpr size_t WS_QM = WS_CKVN + (size_t)NROW * 256 * 2;
constexpr size_t SZ_Q128 = (size_t)NB * 8 * TT * 128 * 2;
constexpr size_t WS_KM = WS_QM + SZ_Q128;
constexpr size_t WS_VM = WS_KM + SZ_Q128;
constexpr size_t WS_QG = WS_VM + SZ_Q128 / 2;
constexpr size_t WS_KG = WS_QG + SZ_Q128;
constexpr size_t WS_VG = WS_KG + SZ_Q128 / 4;
constexpr size_t WS_RQ = WS_VG + SZ_Q128 / 4;
constexpr size_t WS_RK = WS_RQ + SZ_Q128 / 4;
constexpr size_t WS_RV = WS_RK + SZ_Q128 / 4;
constexpr size_t WS_ST = WS_RV + SZ_Q128 / 2;
constexpr size_t WS_OAB = WS_ST + (size_t)NB * 8 * 34 * 2 * 2048 * 4;
constexpr size_t WS_HB8 = WS_OAB + (size_t)NROW * D * 2;
constexpr size_t WS_MB8 = WS_HB8 + (size_t)NROW * D;
constexpr size_t WS_END = WS_MB8 + (size_t)NROW * D;
constexpr size_t WS_MB = WS_QM;
constexpr size_t WS_QP = WS_QG;
static_assert((size_t)NROW * D * 2 <= 2 * SZ_Q128, "MB alias");
static_assert((size_t)NROW * 1024 * 2 <= SZ_Q128, "QP alias");

__device__ __forceinline__ unsigned cvt_pk_bf16(float lo, float hi) { unsigned r; asm volatile("v_cvt_pk_bf16_f32 %0, %1, %2" : "=v"(r) : "v"(lo), "v"(hi)); return r; }
__device__ __forceinline__ bf16_t f2bf(float f) { return (bf16_t)(cvt_pk_bf16(f, 0.f) & 0xffffu); }
__device__ __forceinline__ float bf2f(bf16_t b) { return __uint_as_float(((unsigned)b) << 16); }
__device__ __forceinline__ float bflo(unsigned w) { return __uint_as_float(w << 16); }
__device__ __forceinline__ float bfhi(unsigned w) { return __uint_as_float(w & 0xffff0000u); }
template <int CTRL> __device__ __forceinline__ float dppf(float x) { return __int_as_float(__builtin_amdgcn_update_dpp(0, __float_as_int(x), CTRL, 0xF, 0xF, true)); }
__device__ __forceinline__ float row16_sum(float x) { x += dppf<0xB1>(x); x += dppf<0x4E>(x); x += dppf<0x141>(x); x += dppf<0x140>(x); return x; }
__device__ __forceinline__ float row16_max(float x) { x = fmaxf(x, dppf<0xB1>(x)); x = fmaxf(x, dppf<0x4E>(x)); x = fmaxf(x, dppf<0x141>(x)); x = fmaxf(x, dppf<0x140>(x)); return x; }
__device__ __forceinline__ float wave_sum(float x) {
    x = row16_sum(x);
    { auto r = __builtin_amdgcn_permlane16_swap(__float_as_uint(x), __float_as_uint(x), false, false); x = __uint_as_float(r[0]) + __uint_as_float(r[1]); }
    { auto r = __builtin_amdgcn_permlane32_swap(__float_as_uint(x), __float_as_uint(x), false, false); x = __uint_as_float(r[0]) + __uint_as_float(r[1]); }
    return x;
}
__device__ __forceinline__ unsigned pk4_fp8(float a, float b, float c, float d) { int t = 0; t = __builtin_amdgcn_cvt_pk_fp8_f32(a, b, t, false); t = __builtin_amdgcn_cvt_pk_fp8_f32(c, d, t, true); return (unsigned)t; }
__device__ __forceinline__ float clamp8(float x) { return fminf(fmaxf(x, -440.f), 440.f); }
__device__ __forceinline__ void fp8_scale(unsigned amax_bits, float& mul, float& inv) { const float am = __uint_as_float(amax_bits); int k = 0; if (am > 0.f) k = (int)floorf(log2f(256.f / am)); k = k > 60 ? 60 : (k < -60 ? -60 : k); mul = exp2f((float)k); inv = exp2f((float)-k); }
__device__ __forceinline__ float silu_f(float x) { return x * __builtin_amdgcn_rcpf(1.f + __builtin_amdgcn_exp2f(x * -1.4426950408889634f)); }
__device__ __forceinline__ float sigmoid_f(float x) { return __builtin_amdgcn_rcpf(1.f + __builtin_amdgcn_exp2f(x * -1.4426950408889634f)); }

__device__ __forceinline__ int vt_off(int tpos) { const int kk = tpos & 63; return (tpos & ~63) + ((kk >> 2) & 1) * 32 + ((kk >> 5) & 1) * 16 + (kk & 3) + 4 * ((kk >> 3) & 3); }
struct RowInfo { int b, tpos, pr, pc, v; bool lat; };
__device__ __forceinline__ RowInfo rowinfo(int row) {
    RowInfo r;
    if (row < NLAT) { r.lat = true; r.b = row >> 12; const int t = row & 4095; r.tpos = CTXL + t; r.pr = t >> 6; r.pc = t & 63; r.v = r.b; }
    else { const int q = row - NLAT; r.lat = false; r.b = q >> 8; r.tpos = q & 255; r.pr = 0; r.pc = 0; r.v = 4; }
    return r;
}

#define XB_TMO      128
#define XB_XCNT(j)  (256  + 64 * (j))
#define XB_XSUB(j)  (1280 + 64 * (j))
#define XB_XGEN(j)  (2304 + 64 * (j))
#define XB_TOP      3328
#define XB_TOPGEN   3392
#define XCD_BAR_WORDS 3456
#define XB_SPIN_CAP (1u << 22)

__device__ __forceinline__ unsigned xb_ld(unsigned* p)              { return __hip_atomic_load(p, __ATOMIC_RELAXED, __HIP_MEMORY_SCOPE_AGENT); }
__device__ __forceinline__ unsigned xb_add(unsigned* p, unsigned v) { return __hip_atomic_fetch_add(p, v, __ATOMIC_RELAXED, __HIP_MEMORY_SCOPE_AGENT); }
__device__ __forceinline__ unsigned xb_xcc_id() { return (unsigned)__builtin_amdgcn_s_getreg((3 << 11) | 20) & 0xFu; }
#define XB_SPIN(cond, bar) do { unsigned _sp = 0; while (cond) { __builtin_amdgcn_s_sleep(1); \
    if ((++_sp & 255u) == 0u) { if (xb_ld(&(bar)[XB_TMO])) break; if (_sp > XB_SPIN_CAP) { atomicAdd(&(bar)[XB_TMO], 1u); break; } } } } while (0)

struct XcdBarrier { unsigned* bar; unsigned x; volatile LAS unsigned* st; };

__device__ __forceinline__ XcdBarrier xcd_barrier_post(unsigned* bar, volatile LAS unsigned* st) {
    XcdBarrier b; b.bar = bar; b.x = xb_xcc_id(); b.st = st;
    if (threadIdx.x == 0) (void)xb_add(&bar[XB_XCNT(b.x)], 1u);
    return b;
}
__device__ __forceinline__ void xcd_barrier_complete(unsigned* bar, unsigned x, unsigned& nloc, unsigned& nx) {
    const unsigned G = gridDim.x * gridDim.y * gridDim.z;
    unsigned sum, cnt, mine, sp = 0u;
    for (;;) {
        sum = 0u; cnt = 0u; mine = 0u;
#pragma unroll
        for (unsigned j = 0; j < 16; ++j) { const unsigned c = xb_ld(&bar[XB_XCNT(j)]); sum += c; cnt += (c > 0u) ? 1u : 0u; mine = (j == x) ? c : mine; }
        if (sum == G) break;
        __builtin_amdgcn_s_sleep(1);
        if ((++sp & 255u) == 0u) { if (xb_ld(&bar[XB_TMO])) break; if (sp > XB_SPIN_CAP) { atomicAdd(&bar[XB_TMO], 1u); break; } }
    }
    nloc = mine > 0u ? mine : 1u; nx = cnt > 0u ? cnt : 1u;
}
__device__ __forceinline__ void xcd_barrier(const XcdBarrier& b) {
    asm volatile("s_waitcnt vmcnt(0)" ::: "memory");
    __syncthreads();
    if (threadIdx.x == 0) {
        unsigned* bar = b.bar;
        __builtin_amdgcn_s_waitcnt(0);
        unsigned nloc = b.st[0], nx = b.st[1];
        if (nloc == 0u) { xcd_barrier_complete(bar, b.x, nloc, nx); b.st[0] = nloc; b.st[1] = nx; }
        const unsigned old = xb_add(&bar[XB_XSUB(b.x)], 1u);
        const unsigned gen = old / nloc;
        if (old + 1u == (gen + 1u) * nloc) {
            __builtin_amdgcn_fence(__ATOMIC_RELEASE, "agent");
            asm volatile("s_waitcnt vmcnt(0)" ::: "memory");
            const unsigned og = xb_add(&bar[XB_TOP], 1u);
            const unsigned tg = og / nx;
            if (og + 1u == (tg + 1u) * nx) xb_add(&bar[XB_TOPGEN], 1u);
            else XB_SPIN(xb_ld(&bar[XB_TOPGEN]) == tg, bar);
            __builtin_amdgcn_fence(__ATOMIC_ACQUIRE, "agent");
            xb_add(&bar[XB_XGEN(b.x)], 1u);
            asm volatile("s_waitcnt vmcnt(0)" ::: "memory");
        } else {
            XB_SPIN(xb_ld(&bar[XB_XGEN(b.x)]) == gen, bar);
            __builtin_amdgcn_fence(__ATOMIC_ACQUIRE, "agent");
            asm volatile("s_waitcnt vmcnt(0)" ::: "memory");
        }
    }
    __syncthreads();
}
namespace pg8 {
constexpr int BM = 256, BK = 64, HALF = 128, HTB = HALF * BK * 2, STAGE_BYTES = 8 * HTB, NXCD = 8, WGM = 8;
__host__ __device__ __forceinline__ int lds_byte(int r, int c) { const int st = (r >> 4) * 2 + (c >> 5), rr = r & 15, cc = c & 31, ob = rr * 64 + cc * 2; return st * 1024 + (ob ^ (((ob >> 9) & 1) << 5)); }
__host__ __device__ __forceinline__ void stage_rc(int b, int& R, int& C) { const int st = b / 1024, sb = b % 1024, swz = sb ^ (((sb >> 9) & 1) << 5); R = (st >> 1) * 16 + swz / 64; C = (st & 1) * 32 + (swz % 64) / 2; }
__host__ __device__ __forceinline__ int perm32(int rho) { const int n = rho >> 4, i = rho & 15; return 8 * (i >> 2) + 4 * n + (i & 3); }

struct Unit { int pm, pn; };
typedef int i32x8 __attribute__((ext_vector_type(8))); typedef int i32x4v __attribute__((ext_vector_type(4)));
__device__ __forceinline__ i32x8 cat8(const bf16x8 a, const bf16x8 b) { const i32x4v x = __builtin_bit_cast(i32x4v, a), y = __builtin_bit_cast(i32x4v, b); return __builtin_shufflevector(x, y, 0, 1, 2, 3, 4, 5, 6, 7); }
struct Gemm { const bf16_t* A; const bf16_t* Bt; int M, N, K, lda, ldb; };

struct StaticOrder {
    int nM, nN, nwg, G, c;
    __host__ __device__ void init(int M, int N, int G_, int c_) { nM = M / BM; nN = N / BM; nwg = nM * nN; G = G_; c = c_; }
    __host__ __device__ bool next(int i, Unit& u) const {
        const long L = (long)i * G + c; if (L >= nwg) return false;
        int wgid = (int)L; { const int q = nwg / NXCD, r = nwg % NXCD, xcd = wgid % NXCD, off = wgid / NXCD; wgid = (xcd < r ? xcd * (q + 1) : r * (q + 1) + (xcd - r) * q) + off; }
        const int nig = WGM * nN, gid = wgid / nig, fm = gid * WGM, gsz = (nM - fm) < WGM ? (nM - fm) : WGM;
        u.pm = fm + ((wgid % nig) % gsz); u.pn = (wgid % nig) / gsz; return true;
    }
    __device__ __forceinline__ void a_ready(const Unit&) const {}
    __device__ __forceinline__ void done(const Unit&) const {}
};

template <class Epi, class Sched, int GABL = 0>
__device__ __forceinline__ void gemm_phase(LAS unsigned char* lds, const int tid, const Gemm g, const Sched& S, const Epi& E) {
    const int  wid = __builtin_amdgcn_readfirstlane(tid >> 6), lane = tid & 63, wr = wid >> 2, wc = wid & 3, fr = lane & 15, fq = lane >> 4;
    const int K = g.K, nt = K / BK;
    unsigned voffA[2], voffB[2];
#pragma unroll
    for (int i = 0; i < 2; ++i) { int R, C; stage_rc(tid * 16 + i * 8192, R, C); const int Rb = Epi::PERM ? ((R & ~31) + perm32(R & 31)) : R;
        voffA[i] = (unsigned)(R * g.lda + C) * 2u; voffB[i] = (unsigned)(Rb * g.ldb + C) * 2u; }
    const size_t kstep = (size_t)(BK * 2);
    const size_t hstepA = (size_t)HALF * g.lda * 2, hstepB = (size_t)HALF * g.ldb * 2;
    const size_t tstepA = 2 * hstepA, tstepB = 2 * hstepB;
    const unsigned ldsw = (unsigned)wid * 1024u;
    const int aoff = lds_byte(wr * 64 + fr, fq * 8), boff = lds_byte(wc * 32 + fr, fq * 8);
#define PG8_SA(b, h) (((b) * 2 + (h)) * HTB)
#define PG8_SB(b, h) ((4 + (b) * 2 + (h)) * HTB)
#define PG8_STAGE(bufoff, gbase, voff) do { if constexpr (!(GABL & 4)) _Pragma("unroll") for (int _i = 0; _i < 2; ++_i) \
        __builtin_amdgcn_global_load_lds((const unsigned*)((const char*)(gbase) + (voff)[_i]), (LAS unsigned*)(lds + (bufoff) + ldsw + _i * 8192), 16, 0, 0); } while (0)
#define PG8_LDA(dst, b, h) do { if constexpr (Epi::FP8) { _Pragma("unroll") for (int m = 0; m < 4; ++m) { const i32x4v lo_ = *(const LAS i32x4v*)(lds + PG8_SA(b, h) + aoff + m * 2048), hi_ = *(const LAS i32x4v*)(lds + PG8_SA(b, h) + aoff + m * 2048 + 1024); \
            dst##8[m] = __builtin_shufflevector(lo_, hi_, 0, 1, 2, 3, 4, 5, 6, 7); } } \
        else { _Pragma("unroll") for (int m = 0; m < 4; ++m) _Pragma("unroll") for (int k = 0; k < 2; ++k) dst[m][k] = *(const LAS bf16x8*)(lds + PG8_SA(b, h) + aoff + m * 2048 + k * 1024); } } while (0)
#define PG8_LDB(dst, b, h) do { if constexpr (Epi::FP8) { _Pragma("unroll") for (int n = 0; n < 2; ++n) { const i32x4v lo_ = *(const LAS i32x4v*)(lds + PG8_SB(b, h) + boff + n * 2048), hi_ = *(const LAS i32x4v*)(lds + PG8_SB(b, h) + boff + n * 2048 + 1024); \
            dst##8[n] = __builtin_shufflevector(lo_, hi_, 0, 1, 2, 3, 4, 5, 6, 7); } } \
        else { _Pragma("unroll") for (int n = 0; n < 2; ++n) _Pragma("unroll") for (int k = 0; k < 2; ++k) dst[n][k] = *(const LAS bf16x8*)(lds + PG8_SB(b, h) + boff + n * 2048 + k * 1024); } } while (0)
#define PG8_MMA(ai, bj, At, Bt) do { __builtin_amdgcn_s_setprio(1); _Pragma("unroll") for (int m = 0; m < 4; ++m) _Pragma("unroll") for (int n = 0; n < 2; ++n) { \
        if constexpr (Epi::FP8) { if constexpr (GABL & 8) asm volatile("" : "+v"(acc[ai][bj][m][n]) : "v"(Bt##8[n]), "v"(At##8[m]), "v"(sc1_)); else asm volatile("v_mfma_scale_f32_16x16x128_f8f6f4 %0, %1, %2, %0, %3, %3 op_sel_hi:[0,0,0]" : "+v"(acc[ai][bj][m][n]) : "v"(Bt##8[n]), "v"(At##8[m]), "v"(sc1_)); } \
        else { _Pragma("unroll") for (int k = 0; k < 2; ++k) acc[ai][bj][m][n] = __builtin_amdgcn_mfma_f32_16x16x32_bf16(Bt[n][k], At[m][k], acc[ai][bj][m][n], 0, 0, 0); } } __builtin_amdgcn_s_setprio(0); } while (0)
#define PG8_WAIT_V(n) asm volatile("s_waitcnt vmcnt(" #n ")" ::: "memory")
#define PG8_WAIT_L(n) asm volatile("s_waitcnt lgkmcnt(" #n ")" ::: "memory")
#define PG8_BAR __builtin_amdgcn_s_barrier()
#define PG8_SCHED __builtin_amdgcn_sched_barrier(0)
    Unit cur, nxt; int ui = 0;
    if (!S.next(0, cur)) return;
    f32x4 acc[2][2][4][2];
#pragma unroll
    for (int a = 0; a < 2; ++a)
#pragma unroll
        for (int b = 0; b < 2; ++b)
#pragma unroll
            for (int m = 0; m < 4; ++m)
#pragma unroll
                for (int n = 0; n < 2; ++n) acc[a][b][m][n] = (f32x4){0.f, 0.f, 0.f, 0.f};
    int sc1_ = 0x7F7F7F7F; asm volatile("" : "+v"(sc1_));
    bf16x8 At[4][2], B0[2][2], B1[2][2]; i32x8 At8[4], B08[2], B18[2];
    const char* cA = (const char*)g.A + (size_t)cur.pm * tstepA; const char* cB = (const char*)g.Bt + (size_t)cur.pn * tstepB;
    S.a_ready(cur);
    PG8_STAGE(PG8_SB(0, 0), cB, voffB); PG8_STAGE(PG8_SA(0, 0), cA, voffA); PG8_STAGE(PG8_SB(0, 1), cB + hstepB, voffB); PG8_STAGE(PG8_SA(0, 1), cA + hstepA, voffA);
    if (wr == 1) PG8_BAR;
    PG8_WAIT_V(4); PG8_BAR;
    PG8_STAGE(PG8_SB(1, 0), cB + kstep, voffB); PG8_STAGE(PG8_SA(1, 0), cA + kstep, voffA); PG8_STAGE(PG8_SB(1, 1), cB + hstepB + kstep, voffB);
    PG8_WAIT_V(6); PG8_BAR;
    for (;;) {
        const bool has_next = S.next(ui + 1, nxt);
        const char* nA = has_next ? (const char*)g.A + (size_t)nxt.pm * tstepA : cA; const char* nB = has_next ? (const char*)g.Bt + (size_t)nxt.pn * tstepB : cB;
#pragma unroll 1
        for (int t = 0; t < nt; t += 2) {
            const bool last = (t == nt - 2);
            const char* a1 = cA + (size_t)(t + 1) * kstep;
            const char* a2 = last ? nA : cA + (size_t)(t + 2) * kstep; const char* b2 = last ? nB : cB + (size_t)(t + 2) * kstep;
            const char* a3 = a2 + kstep; const char* b3 = b2 + kstep;
            if (last && has_next) S.a_ready(nxt);
            PG8_LDB(B0, 0, 0); PG8_SCHED; PG8_LDA(At, 0, 0); PG8_STAGE(PG8_SA(1, 1), a1 + hstepA, voffA);
            PG8_WAIT_L(8); PG8_BAR; PG8_WAIT_L(0); PG8_MMA(0, 0, At, B0); PG8_BAR; PG8_SCHED;
            PG8_LDB(B1, 0, 1); PG8_STAGE(PG8_SB(0, 0), b2, voffB);
            PG8_BAR; PG8_WAIT_L(0); PG8_MMA(0, 1, At, B1); PG8_BAR;
            PG8_LDA(At, 0, 1); PG8_STAGE(PG8_SA(0, 0), a2, voffA);
            PG8_BAR; PG8_WAIT_L(0); PG8_MMA(1, 0, At, B0); PG8_BAR; PG8_SCHED;
            PG8_STAGE(PG8_SB(0, 1), b2 + hstepB, voffB);
            PG8_WAIT_V(6); PG8_BAR; PG8_MMA(1, 1, At, B1); PG8_BAR;
            PG8_LDB(B0, 1, 0); PG8_SCHED; PG8_LDA(At, 1, 0); PG8_STAGE(PG8_SA(0, 1), a2 + hstepA, voffA);
            PG8_WAIT_L(8); PG8_BAR; PG8_WAIT_L(0); PG8_MMA(0, 0, At, B0); PG8_BAR; PG8_SCHED;
            PG8_LDB(B1, 1, 1); PG8_STAGE(PG8_SB(1, 0), b3, voffB);
            PG8_BAR; PG8_WAIT_L(0); PG8_MMA(0, 1, At, B1); PG8_BAR;
            PG8_LDA(At, 1, 1); PG8_STAGE(PG8_SA(1, 0), a3, voffA);
            PG8_BAR; PG8_WAIT_L(0); PG8_MMA(1, 0, At, B0); PG8_BAR; PG8_SCHED;
            PG8_STAGE(PG8_SB(1, 1), b3 + hstepB, voffB);
            PG8_WAIT_V(6); PG8_BAR; PG8_MMA(1, 1, At, B1); PG8_BAR;
        }
        if constexpr (Epi::FP8) asm volatile("s_nop 15\n\ts_nop 15" ::: "memory");
        if constexpr (GABL & 2) { pg8::Unit u2_ = cur; u2_.pm = 0; Epi E2_ = E; E2_.retarget(); E2_(acc, u2_, wr, wc, fr, fq); } else if constexpr (!(GABL & 1)) E(acc, cur, wr, wc, fr, fq); else asm volatile("" :: "v"(acc[0][0][0][0]), "v"(acc[1][1][3][1]), "v"(acc[0][1][2][0]), "v"(acc[1][0][1][1]));
        if (!has_next) break;
#pragma unroll
        for (int a = 0; a < 2; ++a)
#pragma unroll
            for (int b = 0; b < 2; ++b)
#pragma unroll
                for (int m = 0; m < 4; ++m)
#pragma unroll
                    for (int n = 0; n < 2; ++n) acc[a][b][m][n] = (f32x4){0.f, 0.f, 0.f, 0.f};
        cur = nxt; cA = nA; cB = nB; ++ui;
    }
    PG8_WAIT_V(0);
    if (wr == 0) PG8_BAR;
    PG8_BAR;
#undef PG8_SA
#undef PG8_SB
#undef PG8_STAGE
#undef PG8_LDA
#undef PG8_LDB
#undef PG8_MMA
#undef PG8_WAIT_V
#undef PG8_WAIT_L
#undef PG8_BAR
#undef PG8_SCHED
}
}

typedef f32x4 Acc[2][2][4][2];
#define EPI_LOOP_ROWS for (int ai = 0; ai < 2; ++ai) for (int m = 0; m < 4; ++m)
__device__ __forceinline__ u32x4 pack8(const f32x4 a, const f32x4 b) { u32x4 w; w.x = cvt_pk_bf16(a[0], a[1]); w.y = cvt_pk_bf16(a[2], a[3]); w.z = cvt_pk_bf16(b[0], b[1]); w.w = cvt_pk_bf16(b[2], b[3]); return w; }

struct EpiIn {
    static constexpr bool PERM = true, FP8 = true;
    bf16_t* P1; bf16_t* G; float inv;
    __device__ __forceinline__ void retarget() { P1 = (bf16_t*)((char*)P1 - WS_P1 + WS_END); G = P1 + 256 * NP1; }
    __device__ __forceinline__ void operator()(const Acc& acc, const pg8::Unit& u, int wr, int wc, int fr, int fq) const {
        const int row0 = u.pm * 256 + wr * 64 + fr; const bool gate = u.pn >= 16;
        bf16_t* base = gate ? G : P1; const int ld = gate ? NG : NP1; const int col0 = (gate ? (u.pn - 16) : u.pn) * 256 + wc * 32 + 8 * fq;
#pragma unroll
        for (int ai = 0; ai < 2; ++ai)
#pragma unroll
            for (int m = 0; m < 4; ++m) { bf16_t* rowp = base + (size_t)(row0 + ai * 128 + m * 16) * ld + col0;
#pragma unroll
                for (int bj = 0; bj < 2; ++bj) { f32x4 v0 = acc[ai][bj][m][0] * inv, v1 = acc[ai][bj][m][1] * inv;
                    if (gate) {
#pragma unroll
                        for (int j = 0; j < 4; ++j) { v0[j] = sigmoid_f(v0[j]); v1[j] = sigmoid_f(v1[j]); } }
                    __builtin_nontemporal_store(pack8(v0, v1), (u32x4*)(rowp + bj * 128)); } }
    }
};
struct EpiPlain {
    static constexpr bool PERM = true, FP8 = false;
    bf16_t* O; int ldc;
    __device__ __forceinline__ void operator()(const Acc& acc, const pg8::Unit& u, int wr, int wc, int fr, int fq) const {
        const int row0 = u.pm * 256 + wr * 64 + fr; const int col0 = u.pn * 256 + wc * 32 + 8 * fq;
#pragma unroll
        for (int ai = 0; ai < 2; ++ai)
#pragma unroll
            for (int m = 0; m < 4; ++m) { bf16_t* rowp = O + (size_t)(row0 + ai * 128 + m * 16) * ldc + col0;
#pragma unroll
                for (int bj = 0; bj < 2; ++bj) *(u32x4*)(rowp + bj * 128) = pack8(acc[ai][bj][m][0], acc[ai][bj][m][1]); }
    }
};
__device__ __forceinline__ void tile_info(int pm, int& b, int& tpos0, bool& lat) { lat = pm < 64; b = lat ? (pm >> 4) : (pm - 64); tpos0 = lat ? CTXL + ((pm & 15) << 8) : 0; }
struct EpiQup {
    static constexpr bool PERM = true, FP8 = false;
    unsigned char* QM; const f32x2* cs32;
    __device__ __forceinline__ void operator()(const Acc& acc, const pg8::Unit& u, int wr, int wc, int fr, int fq) const {
        int b, tpos0; bool lat; tile_info(u.pm, b, tpos0, lat);
        const int r0 = wr * 64 + fr;
#pragma unroll
        for (int bj = 0; bj < 2; ++bj) { const int c0 = u.pn * 256 + bj * 128 + wc * 32 + 8 * fq; const int hh = c0 / 96, j0 = c0 - hh * 96;
            unsigned char* hb = QM + ((size_t)(b * 8 + hh) * TT + tpos0 + r0) * 128;
            if (j0 < 64) {
#pragma unroll
                for (int ai = 0; ai < 2; ++ai)
#pragma unroll
                    for (int m = 0; m < 4; ++m) { const f32x4 a_ = acc[ai][bj][m][0], b_ = acc[ai][bj][m][1]; u32x2 w8; w8.x = pk4_fp8(clamp8(a_[0]), clamp8(a_[1]), clamp8(a_[2]), clamp8(a_[3])); w8.y = pk4_fp8(clamp8(b_[0]), clamp8(b_[1]), clamp8(b_[2]), clamp8(b_[3]));
                        *(u32x2*)(hb + (ai * 128 + m * 16) * 128 + j0) = w8; }
            } else { const int g8 = (j0 - 64) >> 3, part = g8 >> 1, pbase = (g8 & 1) * 4;
#pragma unroll
                for (int ai = 0; ai < 2; ++ai)
#pragma unroll
                    for (int m = 0; m < 4; ++m) { const int t = tpos0 - CTXL + r0 + ai * 128 + m * 16; const int pos = part ? (t & 63) : (t >> 6);
                        const f32x4 v0 = acc[ai][bj][m][0], v1 = acc[ai][bj][m][1];
                        float o1[4], o2[4]; const float x1[4] = {v0[0], v0[2], v1[0], v1[2]}, x2[4] = {v0[1], v0[3], v1[1], v1[3]};
#pragma unroll
                        for (int p = 0; p < 4; ++p) { const f32x2 cs = lat ? cs32[pos * 8 + pbase + p] : (f32x2){1.f, 0.f};
                            o1[p] = x1[p] * cs.x - x2[p] * cs.y; o2[p] = x1[p] * cs.y + x2[p] * cs.x; }
                        unsigned char* dst = hb + (ai * 128 + m * 16) * 128 + 64 + part * 16 + pbase;
                        *(unsigned*)dst = pk4_fp8(clamp8(o1[0]), clamp8(o1[1]), clamp8(o1[2]), clamp8(o1[3])); *(unsigned*)(dst + 8) = pk4_fp8(clamp8(o2[0]), clamp8(o2[1]), clamp8(o2[2]), clamp8(o2[3])); } } }
    }
};
struct EpiKvup {
    static constexpr bool PERM = true, FP8 = false;
    unsigned char* KM; unsigned char* VM;
    __device__ __forceinline__ void operator()(const Acc& acc, const pg8::Unit& u, int wr, int wc, int fr, int fq) const {
        int b, tpos0; bool lat; tile_info(u.pm, b, tpos0, lat);
        const int r0 = wr * 64 + fr; const int j0 = wc * 32 + 8 * fq;
#pragma unroll
        for (int bj = 0; bj < 2; ++bj) { const size_t tok = (size_t)(b * 8 + u.pn * 2 + bj) * TT + tpos0 + r0;
            if (j0 < 64) { unsigned char* d = KM + tok * 128 + j0;
#pragma unroll
                for (int ai = 0; ai < 2; ++ai)
#pragma unroll
                    for (int m = 0; m < 4; ++m) { const f32x4 a_ = acc[ai][bj][m][0], b_ = acc[ai][bj][m][1]; u32x2 w8; w8.x = pk4_fp8(clamp8(a_[0]), clamp8(a_[1]), clamp8(a_[2]), clamp8(a_[3])); w8.y = pk4_fp8(clamp8(b_[0]), clamp8(b_[1]), clamp8(b_[2]), clamp8(b_[3]));
                        *(u32x2*)(d + (ai * 128 + m * 16) * 128) = w8; } }
            else { unsigned char* d = VM + ((size_t)(b * 8 + u.pn * 2 + bj) * 64 + (j0 - 64)) * TT;
#pragma unroll
                for (int ai = 0; ai < 2; ++ai)
#pragma unroll
                    for (int m = 0; m < 4; ++m) { const f32x4 a_ = acc[ai][bj][m][0], b_ = acc[ai][bj][m][1]; const unsigned w0_ = pk4_fp8(clamp8(a_[0]), clamp8(a_[1]), clamp8(a_[2]), clamp8(a_[3])), w1_ = pk4_fp8(clamp8(b_[0]), clamp8(b_[1]), clamp8(b_[2]), clamp8(b_[3]));
                        unsigned char* q_ = d + vt_off(tpos0 + r0 + ai * 128 + m * 16);
                        q_[0] = (unsigned char)(w0_ & 0xffu); q_[TT] = (unsigned char)((w0_ >> 8) & 0xffu); q_[2 * TT] = (unsigned char)((w0_ >> 16) & 0xffu); q_[3 * TT] = (unsigned char)(w0_ >> 24);
                        q_[4 * TT] = (unsigned char)(w1_ & 0xffu); q_[5 * TT] = (unsigned char)((w1_ >> 8) & 0xffu); q_[6 * TT] = (unsigned char)((w1_ >> 16) & 0xffu); q_[7 * TT] = (unsigned char)(w1_ >> 24); } } }
    }
};
template <int SEG> struct EpiMerge {
    static constexpr bool PERM = true, FP8 = false;
    bf16_t* MB; const bf16_t* G; unsigned char* MB8;
    __device__ __forceinline__ void operator()(const Acc& acc, const pg8::Unit& u, int wr, int wc, int fr, int fq) const {
        const int row0 = u.pm * 256 + wr * 64 + fr; const int col0 = u.pn * 256 + wc * 32 + 8 * fq;
        const bf16_t* gp = G + (size_t)row0 * NG + SEG * 2048 + col0; bf16_t* mp = MB + (size_t)row0 * D + col0; unsigned char* m8 = MB8 + (size_t)row0 * D + col0;
#pragma unroll
        for (int ai = 0; ai < 2; ++ai) {
            u32x4 gw[4][2], ow[4][2];
#pragma unroll
            for (int m = 0; m < 4; ++m)
#pragma unroll
                for (int bj = 0; bj < 2; ++bj) { const size_t ro = (size_t)(ai * 128 + m * 16);
                    gw[m][bj] = *(const u32x4*)(gp + ro * NG + bj * 128);
                    if (SEG > 0) ow[m][bj] = __builtin_nontemporal_load((const u32x4*)(mp + ro * D + bj * 128)); }
#pragma unroll
            for (int m = 0; m < 4; ++m)
#pragma unroll
                for (int bj = 0; bj < 2; ++bj) { const size_t ro = (size_t)(ai * 128 + m * 16); const u32x4 g_ = gw[m][bj];
                    f32x4 v0 = acc[ai][bj][m][0], v1 = acc[ai][bj][m][1];
                    if (ABL_BR & (1 << SEG)) { v0 = (f32x4){0.f, 0.f, 0.f, 0.f}; v1 = v0; }
                    v0[0] *= bflo(g_.x); v0[1] *= bfhi(g_.x); v0[2] *= bflo(g_.y); v0[3] *= bfhi(g_.y);
                    v1[0] *= bflo(g_.z); v1[1] *= bfhi(g_.z); v1[2] *= bflo(g_.w); v1[3] *= bfhi(g_.w);
                    if (SEG > 0) { const u32x4 o = ow[m][bj];
                        v0[0] += bflo(o.x); v0[1] += bfhi(o.x); v0[2] += bflo(o.y); v0[3] += bfhi(o.y);
                        v1[0] += bflo(o.z); v1[1] += bfhi(o.z); v1[2] += bflo(o.w); v1[3] += bfhi(o.w); }
                    if (SEG < 2) *(u32x4*)(mp + ro * D + bj * 128) = pack8(v0, v1);
                    else { u32x2 w8; w8.x = pk4_fp8(clamp8(v0[0] * 16.f), clamp8(v0[1] * 16.f), clamp8(v0[2] * 16.f), clamp8(v0[3] * 16.f)); w8.y = pk4_fp8(clamp8(v1[0] * 16.f), clamp8(v1[1] * 16.f), clamp8(v1[2] * 16.f), clamp8(v1[3] * 16.f));
                        *(u32x2*)(m8 + ro * D + bj * 128) = w8; } }
        }
    }
};
namespace pg8 {
struct Merge3 { const bf16_t* A; const bf16_t* B0; const bf16_t* B1; const bf16_t* B2; const bf16_t* G; unsigned char* MB8; float r01, r12, fin; };
template <class Sched>
__device__ __forceinline__ void gemm_merge3(LAS unsigned char* lds, const int tid, const Merge3 g, const Sched& S) {
    constexpr int GABL = 0;
    const int wid = __builtin_amdgcn_readfirstlane(tid >> 6), lane = tid & 63, wr = wid >> 2, wc = wid & 3, fr = lane & 15, fq = lane >> 4;
    constexpr int NT = 16, LDA = 1024;
    int sc1_ = 0x7F7F7F7F; asm volatile("" : "+v"(sc1_));
    unsigned voffA[2], voffB5[2], voffB10[2];
#pragma unroll
    for (int i = 0; i < 2; ++i) { int R, C; stage_rc(tid * 16 + i * 8192, R, C); const int Rb = (R & ~31) + perm32(R & 31);
        voffA[i] = (unsigned)(R * LDA + C) * 2u; voffB5[i] = (unsigned)(Rb * 256 + C) * 2u; voffB10[i] = (unsigned)(Rb * 512 + C) * 2u; }
    const size_t kstep = (size_t)(BK * 2);
    const size_t hstepA = (size_t)HALF * LDA * 2, tstepA = 2 * hstepA;
    const unsigned ldsw = (unsigned)wid * 1024u;
    const int aoff = lds_byte(wr * 64 + fr, fq * 8), boff = lds_byte(wc * 32 + fr, fq * 8);
#define M3_TA(pm_, t_) ((const char*)g.A + (size_t)(pm_) * tstepA + (size_t)(t_) * kstep)
#define M3_TB(pn_, t_) ((t_) < 4 ? (const char*)g.B0 + (size_t)(pn_) * 131072 + (size_t)(t_) * kstep : ((t_) < 8 ? (const char*)g.B1 + (size_t)(pn_) * 131072 + (size_t)((t_) - 4) * kstep : (const char*)g.B2 + (size_t)(pn_) * 262144 + (size_t)((t_) - 8) * kstep))
#define PG8_SA(b, h) (((b) * 2 + (h)) * HTB)
#define PG8_SB(b, h) ((4 + (b) * 2 + (h)) * HTB)
#define PG8_STAGE(bufoff, gbase, voff) do { if constexpr (!(GABL & 4)) _Pragma("unroll") for (int _i = 0; _i < 2; ++_i) \
        __builtin_amdgcn_global_load_lds((const unsigned*)((const char*)(gbase) + (voff)[_i]), (LAS unsigned*)(lds + (bufoff) + ldsw + _i * 8192), 16, 0, 0); } while (0)
#define PG8_LDA(dst, b, h) do { _Pragma("unroll") for (int m = 0; m < 4; ++m) { const i32x4v lo_ = *(const LAS i32x4v*)(lds + PG8_SA(b, h) + aoff + m * 2048), hi_ = *(const LAS i32x4v*)(lds + PG8_SA(b, h) + aoff + m * 2048 + 1024); dst[m] = __builtin_shufflevector(lo_, hi_, 0, 1, 2, 3, 4, 5, 6, 7); } } while (0)
#define PG8_LDB(dst, b, h) do { _Pragma("unroll") for (int n = 0; n < 2; ++n) { const i32x4v lo_ = *(const LAS i32x4v*)(lds + PG8_SB(b, h) + boff + n * 2048), hi_ = *(const LAS i32x4v*)(lds + PG8_SB(b, h) + boff + n * 2048 + 1024); dst[n] = __builtin_shufflevector(lo_, hi_, 0, 1, 2, 3, 4, 5, 6, 7); } } while (0)
#define PG8_MMA(ai, bj, At, Bt) do { __builtin_amdgcn_s_setprio(1); _Pragma("unroll") for (int m = 0; m < 4; ++m) _Pragma("unroll") for (int n = 0; n < 2; ++n) \
        asm volatile("v_mfma_scale_f32_16x16x128_f8f6f4 %0, %1, %2, %0, %3, %3 op_sel_hi:[0,0,0]" : "+v"(acc[ai][bj][m][n]) : "v"(Bt[n]), "v"(At[m]), "v"(sc1_)); __builtin_amdgcn_s_setprio(0); } while (0)
#define PG8_WAIT_V(n) asm volatile("s_waitcnt vmcnt(" #n ")" ::: "memory")
#define PG8_WAIT_L(n) asm volatile("s_waitcnt lgkmcnt(" #n ")" ::: "memory")
#define PG8_BAR __builtin_amdgcn_s_barrier()
#define PG8_SCHED __builtin_amdgcn_sched_barrier(0)
    Unit cur, nxt; int ui = 0;
    if (!S.next(0, cur)) return;
    f32x4 acc[2][2][4][2];
#pragma unroll
    for (int a = 0; a < 2; ++a)
#pragma unroll
        for (int b = 0; b < 2; ++b)
#pragma unroll
            for (int m = 0; m < 4; ++m)
#pragma unroll
                for (int n = 0; n < 2; ++n) acc[a][b][m][n] = (f32x4){0.f, 0.f, 0.f, 0.f};
    i32x8 At[4], B0[2], B1[2];
    { const char* cA = M3_TA(cur.pm, 0); const char* cB = M3_TB(cur.pn, 0); const size_t hB = 65536;
      PG8_STAGE(PG8_SB(0, 0), cB, voffB5); PG8_STAGE(PG8_SA(0, 0), cA, voffA); PG8_STAGE(PG8_SB(0, 1), cB + hB, voffB5); PG8_STAGE(PG8_SA(0, 1), cA + hstepA, voffA);
      if (wr == 1) PG8_BAR;
      PG8_WAIT_V(4); PG8_BAR;
      PG8_STAGE(PG8_SB(1, 0), cB + kstep, voffB5); PG8_STAGE(PG8_SA(1, 0), cA + kstep, voffA); PG8_STAGE(PG8_SB(1, 1), cB + hB + kstep, voffB5);
      PG8_WAIT_V(6); PG8_BAR; }
    const int r0 = wr * 64 + fr, c0l = wc * 32 + 8 * fq;
    for (;;) {
        const bool has_next = S.next(ui + 1, nxt);
        const int npm = has_next ? nxt.pm : cur.pm, npn = has_next ? nxt.pn : cur.pn;
#pragma unroll 1
        for (int t = 0; t < NT; t += 2) {
            const bool last = (t == NT - 2);
            const int t2 = last ? 0 : t + 2;
            const char* a1 = M3_TA(cur.pm, t + 1);
            const char* a2 = last ? M3_TA(npm, 0) : M3_TA(cur.pm, t + 2); const char* b2 = last ? M3_TB(npn, 0) : M3_TB(cur.pn, t + 2);
            const char* a3 = a2 + kstep; const char* b3 = b2 + kstep;
            const bool wide = t2 >= 8; const size_t hB = wide ? 131072 : 65536;
            unsigned vB[2]; vB[0] = wide ? voffB10[0] : voffB5[0]; vB[1] = wide ? voffB10[1] : voffB5[1];
            PG8_LDB(B0, 0, 0); PG8_SCHED; PG8_LDA(At, 0, 0); PG8_STAGE(PG8_SA(1, 1), a1 + hstepA, voffA);
            PG8_WAIT_L(8); PG8_BAR; PG8_WAIT_L(0); PG8_MMA(0, 0, At, B0); PG8_BAR; PG8_SCHED;
            PG8_LDB(B1, 0, 1); PG8_STAGE(PG8_SB(0, 0), b2, vB);
            PG8_BAR; PG8_WAIT_L(0); PG8_MMA(0, 1, At, B1); PG8_BAR;
            PG8_LDA(At, 0, 1); PG8_STAGE(PG8_SA(0, 0), a2, voffA);
            PG8_BAR; PG8_WAIT_L(0); PG8_MMA(1, 0, At, B0); PG8_BAR; PG8_SCHED;
            PG8_STAGE(PG8_SB(0, 1), b2 + hB, vB);
            PG8_WAIT_V(6); PG8_BAR; PG8_MMA(1, 1, At, B1); PG8_BAR;
            PG8_LDB(B0, 1, 0); PG8_SCHED; PG8_LDA(At, 1, 0); PG8_STAGE(PG8_SA(0, 1), a2 + hstepA, voffA);
            PG8_WAIT_L(8); PG8_BAR; PG8_WAIT_L(0); PG8_MMA(0, 0, At, B0); PG8_BAR; PG8_SCHED;
            PG8_LDB(B1, 1, 1); PG8_STAGE(PG8_SB(1, 0), b3, vB);
            PG8_BAR; PG8_WAIT_L(0); PG8_MMA(0, 1, At, B1); PG8_BAR;
            PG8_LDA(At, 1, 1); PG8_STAGE(PG8_SA(1, 0), a3, voffA);
            PG8_BAR; PG8_WAIT_L(0); PG8_MMA(1, 0, At, B0); PG8_BAR; PG8_SCHED;
            PG8_STAGE(PG8_SB(1, 1), b3 + hB, vB);
            PG8_WAIT_V(6); PG8_BAR; PG8_MMA(1, 1, At, B1); PG8_BAR;
            if (t == 2 || t == 6) {
                asm volatile("s_nop 15\n\ts_nop 15" ::: "memory");
                const int sg = t == 2 ? 0 : 1; const float wr_ = sg ? g.r12 : g.r01;
                const bf16_t* gp = g.G + (size_t)(cur.pm * 256 + r0) * NG + sg * 2048 + cur.pn * 256 + c0l;
#pragma unroll
                for (int ai = 0; ai < 2; ++ai) { u32x4 ga[4][2], gb[4][2];
#pragma unroll
                    for (int m = 0; m < 4; ++m)
#pragma unroll
                        for (int bj = 0; bj < 2; ++bj) { const bf16_t* q_ = gp + (size_t)(ai * 128 + m * 16) * NG + bj * 128; ga[m][bj] = *(const u32x4*)q_; gb[m][bj] = *(const u32x4*)(q_ + 2048); }
#pragma unroll
                    for (int m = 0; m < 4; ++m)
#pragma unroll
                        for (int bj = 0; bj < 2; ++bj) { const u32x4 x_ = ga[m][bj], y_ = gb[m][bj];
#define M3_RT(xw, yw, lohi) (fmaxf(lohi(xw), 1e-6f) * wr_ * __builtin_amdgcn_rcpf(fmaxf(lohi(yw), 1e-6f)))
                            acc[ai][bj][m][0][0] *= M3_RT(x_.x, y_.x, bflo); acc[ai][bj][m][0][1] *= M3_RT(x_.x, y_.x, bfhi); acc[ai][bj][m][0][2] *= M3_RT(x_.y, y_.y, bflo); acc[ai][bj][m][0][3] *= M3_RT(x_.y, y_.y, bfhi);
                            acc[ai][bj][m][1][0] *= M3_RT(x_.z, y_.z, bflo); acc[ai][bj][m][1][1] *= M3_RT(x_.z, y_.z, bfhi); acc[ai][bj][m][1][2] *= M3_RT(x_.w, y_.w, bflo); acc[ai][bj][m][1][3] *= M3_RT(x_.w, y_.w, bfhi); } }
                asm volatile("s_waitcnt vmcnt(0)" ::: "memory");
            }
        }
        asm volatile("s_nop 15\n\ts_nop 15" ::: "memory");
        { const bf16_t* gp = g.G + (size_t)(cur.pm * 256 + r0) * NG + 2 * 2048 + cur.pn * 256 + c0l; unsigned char* m8 = g.MB8 + (size_t)(cur.pm * 256 + r0) * D + cur.pn * 256 + c0l;
#pragma unroll
          for (int ai = 0; ai < 2; ++ai) { u32x4 gc[4][2];
#pragma unroll
              for (int m = 0; m < 4; ++m)
#pragma unroll
                  for (int bj = 0; bj < 2; ++bj) gc[m][bj] = *(const u32x4*)(gp + (size_t)(ai * 128 + m * 16) * NG + bj * 128);
#pragma unroll
              for (int m = 0; m < 4; ++m)
#pragma unroll
                  for (int bj = 0; bj < 2; ++bj) { const u32x4 z_ = gc[m][bj]; const f32x4 v0 = acc[ai][bj][m][0], v1 = acc[ai][bj][m][1];
                      u32x2 w8; const float f_ = g.fin;
                      w8.x = pk4_fp8(clamp8(v0[0] * fmaxf(bflo(z_.x), 1e-6f) * f_), clamp8(v0[1] * fmaxf(bfhi(z_.x), 1e-6f) * f_), clamp8(v0[2] * fmaxf(bflo(z_.y), 1e-6f) * f_), clamp8(v0[3] * fmaxf(bfhi(z_.y), 1e-6f) * f_));
                      w8.y = pk4_fp8(clamp8(v1[0] * fmaxf(bflo(z_.z), 1e-6f) * f_), clamp8(v1[1] * fmaxf(bfhi(z_.z), 1e-6f) * f_), clamp8(v1[2] * fmaxf(bflo(z_.w), 1e-6f) * f_), clamp8(v1[3] * fmaxf(bfhi(z_.w), 1e-6f) * f_));
                      *(u32x2*)(m8 + (size_t)(ai * 128 + m * 16) * D + bj * 128) = w8; } } }
        if (!has_next) break;
#pragma unroll
        for (int a = 0; a < 2; ++a)
#pragma unroll
            for (int b = 0; b < 2; ++b)
#pragma unroll
                for (int m = 0; m < 4; ++m)
#pragma unroll
                    for (int n = 0; n < 2; ++n) acc[a][b][m][n] = (f32x4){0.f, 0.f, 0.f, 0.f};
        cur = nxt; ++ui;
    }
    PG8_WAIT_V(0);
    if (wr == 0) PG8_BAR;
    PG8_BAR;
#undef M3_RT
#undef M3_TA
#undef M3_TB
#undef PG8_SA
#undef PG8_SB
#undef PG8_STAGE
#undef PG8_LDA
#undef PG8_LDB
#undef PG8_MMA
#undef PG8_WAIT_V
#undef PG8_WAIT_L
#undef PG8_BAR
#undef PG8_SCHED
}
}
struct EpiOut {
    static constexpr bool PERM = false, FP8 = true;
    const float* src_lat; const float* src_ctx; float* dst_lat; float* dst_ctx; const float* g1; float inv;
    __device__ __forceinline__ void operator()(const Acc& acc, const pg8::Unit& u, int wr, int wc, int fr, int fq) const {
        const int row0 = u.pm * 256 + wr * 64 + fr; const int col0 = u.pn * 256 + wc * 32 + 4 * fq;
        const bool lat = (u.pm * 256) < NLAT;
        const float* src = (lat ? src_lat : src_ctx - (size_t)NLAT * D) + (size_t)row0 * D + col0; float* dst = (lat ? dst_lat : dst_ctx - (size_t)NLAT * D) + (size_t)row0 * D + col0;
#pragma unroll
        for (int ai = 0; ai < 2; ++ai) { const int rbase = u.pm * 256 + ai * 128 + wr * 64; const int v = lat ? (rbase >> 12) : 4; const float* gp = g1 + (size_t)v * 12288 + col0;
            f32x4 gg[2][2];
#pragma unroll
            for (int bj = 0; bj < 2; ++bj)
#pragma unroll
                for (int n = 0; n < 2; ++n) gg[bj][n] = *(const f32x4*)(gp + bj * 128 + n * 16);
#pragma unroll
            for (int mh = 0; mh < 2; ++mh) {
                f32x4 xr[2][2][2];
#pragma unroll
                for (int mm = 0; mm < 2; ++mm)
#pragma unroll
                    for (int bj = 0; bj < 2; ++bj)
#pragma unroll
                        for (int n = 0; n < 2; ++n) xr[mm][bj][n] = __builtin_nontemporal_load((const f32x4*)(src + (size_t)(ai * 128 + (mh * 2 + mm) * 16) * D + bj * 128 + n * 16));
#pragma unroll
                for (int mm = 0; mm < 2; ++mm)
#pragma unroll
                    for (int bj = 0; bj < 2; ++bj)
#pragma unroll
                        for (int n = 0; n < 2; ++n) { const int m = mh * 2 + mm;
                            *(f32x4*)(dst + (size_t)(ai * 128 + m * 16) * D + bj * 128 + n * 16) = ABL_MIX ? xr[mm][bj][n] * ALPHA : xr[mm][bj][n] * ALPHA + gg[bj][n] * (acc[ai][bj][m][n] * inv); } } }
    }
};

struct Args { const float* in[27]; float* out; unsigned char* ws; int ph_lo, ph_hi; };
typedef const Args __attribute__((address_space(4)))* ArgP;
struct Frame {
    LAS unsigned char* lds; int tid, lane, wave, G, bid;
    ArgP ap; float* out; unsigned char* ws;
    __device__ __forceinline__ const float* in(int i) const { return ap->in[i]; }
};
__device__ __forceinline__ Frame make_frame(ArgP ap) {
    { unsigned long long t = (unsigned long long)ap; asm volatile("" : "+s"(t)); ap = (ArgP)t; }
    extern __shared__ __attribute__((aligned(16))) unsigned char lds_raw[];
    Frame F; F.lds = (LAS unsigned char*)lds_raw; { int t_ = threadIdx.x; asm volatile("" : "+v"(t_)); F.tid = t_; }
    F.lane = F.tid & 63; F.wave = __builtin_amdgcn_readfirstlane(F.tid >> 6); F.G = gridDim.x; F.bid = blockIdx.x;
    F.ap = ap; F.out = ap->out; F.ws = ap->ws; return F;
}
template <class T> __device__ __forceinline__ T* wsp(const Frame& F, size_t off) { return (T*)(F.ws + off); }

__device__ __forceinline__ int win_col(int n) {
    if (n < 768) return n;
    if (n < 1792) return 2336 + (n - 768);
    if (n < 2048) return 3360 + (n - 1792);
    if (n < 2304) return 3616 + (n - 2048);
    if (n < 2560) return 800 + (n - 2304);
    if (n < 2816) return 1056 + (n - 2560);
    if (n < 3328) return 1312 + (n - 2816);
    if (n < 3840) return 1824 + (n - 3328);
    if (n < 3872) return 768 + (n - 3840);
    if (n < 4096) return -1;
    return 3872 + (n - 4096);
}
__device__ __forceinline__ int qup_col(int c) {
    const int hh = c / 96, j = c - hh * 96;
    if (j < 64) return c;
    const int jj = j - 64, g8 = jj >> 3, i = jj & 7, p = i >> 1, which = i & 1, part = g8 >> 1, pi = (g8 & 1) * 4 + p;
    return hh * 96 + 64 + part * 16 + which * 8 + pi;
}
template <int MAP>
__device__ __forceinline__ void transpose_cvt(const Frame& F, const float* __restrict__ src, bf16_t* __restrict__ dst, int K, int Nsrc, int Nd) {
    LAS float* tile = (LAS float*)F.lds;
    const int tk = K / 256, tn = Nd / 64, ntile = tk * tn;
    for (int t = F.bid; t < ntile; t += F.G) {
        const int k0 = (t % tk) * 256, n0 = (t / tk) * 64;
        const int nl = F.tid & 63, kq = F.tid >> 6;
        const int nd = n0 + nl; const int ns = MAP == 0 ? nd : (MAP == 1 ? win_col(nd) : qup_col(nd));
        float v[32];
#pragma unroll
        for (int i = 0; i < 32; ++i) v[i] = ns >= 0 ? src[(size_t)(k0 + kq + 8 * i) * Nsrc + ns] : 0.f;
#pragma unroll
        for (int i = 0; i < 32; ++i) tile[(kq + 8 * i) * 65 + nl] = v[i];
        __syncthreads();
        { const int n = F.tid >> 3, k32 = (F.tid & 7) * 32;
#pragma unroll
          for (int c = 0; c < 4; ++c) { float w[8];
#pragma unroll
              for (int j = 0; j < 8; ++j) w[j] = tile[(k32 + c * 8 + j) * 65 + n];
              u32x4 o; o.x = cvt_pk_bf16(w[0], w[1]); o.y = cvt_pk_bf16(w[2], w[3]); o.z = cvt_pk_bf16(w[4], w[5]); o.w = cvt_pk_bf16(w[6], w[7]);
              *(u32x4*)(dst + (size_t)(n0 + n) * K + k0 + k32 + c * 8) = o; } }
        __syncthreads();
    }
}
__device__ __forceinline__ void cvt_rows(const Frame& F, const float* __restrict__ src, bf16_t* __restrict__ dst, size_t n8) {
    for (size_t i = (size_t)F.bid * 512 + F.tid; i < n8; i += (size_t)F.G * 512) {
        const f32x4 a = __builtin_nontemporal_load((const f32x4*)(src + i * 8)), b = __builtin_nontemporal_load((const f32x4*)(src + i * 8 + 4));
        *(u32x4*)(dst + i * 8) = pack8(a, b);
    }
}
__device__ __forceinline__ void cvt_peer(const Frame& F, int l);
__device__ __forceinline__ float max4abs(float am, const f32x4 a) { return fmaxf(fmaxf(fmaxf(am, fabsf(a[0])), fabsf(a[1])), fmaxf(fabsf(a[2]), fabsf(a[3]))); }
__device__ __forceinline__ void absmax_commit(const Frame& F, float am, unsigned* dst) {
    am = row16_max(am);
    { auto r = __builtin_amdgcn_permlane16_swap(__float_as_uint(am), __float_as_uint(am), false, false); am = fmaxf(__uint_as_float(r[0]), __uint_as_float(r[1])); }
    { auto r = __builtin_amdgcn_permlane32_swap(__float_as_uint(am), __float_as_uint(am), false, false); am = fmaxf(__uint_as_float(r[0]), __uint_as_float(r[1])); }
    if (F.lane == 0) atomicMax(dst, __float_as_uint(am));
}
template <int NB>
__device__ __forceinline__ void absmax_f32(const Frame& F, const float* __restrict__ src, size_t n4, unsigned* dst) {
    float am = 0.f;
    const size_t stride = (size_t)F.G * 512; size_t i = (size_t)F.bid * 512 + F.tid;
    for (; i < n4; i += NB * stride) { f32x4 a[NB];
#pragma unroll
        for (int j = 0; j < NB; ++j) { const size_t ix = i + j * stride; a[j] = ix < n4 ? __builtin_nontemporal_load((const f32x4*)(src + ix * 4)) : (f32x4){0.f, 0.f, 0.f, 0.f}; }
#pragma unroll
        for (int j = 0; j < NB; ++j) am = max4abs(am, a[j]); }
    absmax_commit(F, am, dst);
}
__device__ __forceinline__ void absmax4_f32(const Frame& F, const float* s0, size_t n0, unsigned* d0, const float* s1, size_t n1, unsigned* d1, const float* s2, size_t n2, unsigned* d2, const float* s3, size_t n3, unsigned* d3) {
    const size_t stride = (size_t)F.G * 512, i0 = (size_t)F.bid * 512 + F.tid;
    f32x4 a0[2], a1[2], a2[4], a3[8];
#define AM4_LD(a, NB, s, n) _Pragma("unroll") for (int j = 0; j < NB; ++j) { const size_t ix = i0 + j * stride; a[j] = ix < n ? __builtin_nontemporal_load((const f32x4*)(s + ix * 4)) : (f32x4){0.f, 0.f, 0.f, 0.f}; }
    AM4_LD(a0, 2, s0, n0) AM4_LD(a1, 2, s1, n1) AM4_LD(a2, 4, s2, n2) AM4_LD(a3, 8, s3, n3)
#undef AM4_LD
#define AM4_RED(a, NB, s, n, d) { float am = 0.f; _Pragma("unroll") for (int j = 0; j < NB; ++j) am = max4abs(am, a[j]); \
        for (size_t i = i0 + NB * stride; i < n; i += stride) am = max4abs(am, *(const f32x4*)(s + i * 4)); absmax_commit(F, am, d); }
    AM4_RED(a0, 2, s0, n0, d0) AM4_RED(a1, 2, s1, n1, d1) AM4_RED(a2, 4, s2, n2, d2) AM4_RED(a3, 8, s3, n3, d3)
#undef AM4_RED
}
template <int MAP>
__device__ __forceinline__ void transpose_fp8(const Frame& F, const float* __restrict__ src, unsigned char* __restrict__ dst, int K, int Nsrc, int Nd, const unsigned* wsc) {
    float mul, inv; fp8_scale(__hip_atomic_load(wsc, __ATOMIC_RELAXED, __HIP_MEMORY_SCOPE_AGENT), mul, inv);
    LAS float* tile = (LAS float*)F.lds;
    const int tk = K / 256, tn = Nd / 64, ntile = tk * tn;
    for (int t = F.bid; t < ntile; t += F.G) {
        const int k0 = (t % tk) * 256, n0 = (t / tk) * 64;
        const int nl = F.tid & 63, kq = F.tid >> 6; const int ns = MAP ? win_col(n0 + nl) : n0 + nl;
        float v[32];
#pragma unroll
        for (int i = 0; i < 32; ++i) v[i] = ns >= 0 ? src[(size_t)(k0 + kq + 8 * i) * Nsrc + ns] : 0.f;
#pragma unroll
        for (int i = 0; i < 32; ++i) tile[(kq + 8 * i) * 65 + nl] = v[i] * mul;
        __syncthreads();
        { const int n = F.tid >> 3, k32 = (F.tid & 7) * 32;
#pragma unroll
          for (int c = 0; c < 2; ++c) { float w[16];
#pragma unroll
              for (int j = 0; j < 16; ++j) w[j] = tile[(k32 + c * 16 + j) * 65 + n];
              u32x4 o; o.x = pk4_fp8(w[0], w[1], w[2], w[3]); o.y = pk4_fp8(w[4], w[5], w[6], w[7]); o.z = pk4_fp8(w[8], w[9], w[10], w[11]); o.w = pk4_fp8(w[12], w[13], w[14], w[15]);
              *(u32x4*)(dst + (size_t)(n0 + n) * K + k0 + k32 + c * 16) = o; } }
        __syncthreads();
    }
}
template <int PART = 7>
__device__ __forceinline__ void p0_prologue(const Frame& F) {
    { const int gi = F.bid * 512 + F.tid;
      if (gi < 64 * 8) { const int pos = gi >> 3, f = gi & 7; const float inv = powf(10000.f, -(float)f / 8.f); const float a = (float)pos * inv; wsp<f32x2>(F, WS_ROPE32)[gi] = (f32x2){cosf(a), sinf(a)}; }
      else if (gi < 64 * 8 + 64 * 32) { const int g2 = gi - 512; const int pos = g2 >> 5, f = g2 & 31; const float inv = powf(10000.f, -(float)f / 32.f); const float a = (float)pos * inv; wsp<f32x2>(F, WS_ROPE128)[g2] = (f32x2){cosf(a), sinf(a)}; } }
    if (F.bid == 0 && F.tid < 32) wsp<float>(F, WS_DEC)[F.tid] = -log1pf(expf(-F.in(11)[F.tid])) * LOG2E;
#pragma unroll 1
    for (int s3 = 0; s3 < 3; ++s3) { const int part = (s3 + F.bid) % 3;
    if ((PART & 1) && part == 0) { LAS float* sl = (LAS float*)F.lds;
      float* modp = wsp<float>(F, WS_MODP);
      for (int u = F.bid; u < 2 * 24 * 16; u += F.G) {
          const int kc = u & 15, cb = (u >> 4) % 24, l = u / (16 * 24);
          __syncthreads();
          for (int i = F.tid; i < 640; i += 512) { const int v = i >> 7, k = kc * 128 + (i & 127); const float c = v < 4 ? F.in(1)[v * 2048 + k] : F.in(3)[k]; sl[i] = silu_f(c); }
          __syncthreads();
          const int col = cb * 512 + F.tid; const float* w = F.in(4) + ((size_t)l * 2048 + kc * 128) * 12288 + col;
          float a0 = 0.f, a1 = 0.f, a2 = 0.f, a3 = 0.f, a4 = 0.f;
#pragma unroll 32
          for (int k = 0; k < 128; ++k) { const float wv = w[(size_t)k * 12288]; a0 += sl[k] * wv; a1 += sl[128 + k] * wv; a2 += sl[256 + k] * wv; a3 += sl[384 + k] * wv; a4 += sl[512 + k] * wv; }
          float* o = modp + ((size_t)(kc * 2 + l) * 5) * 12288 + col;
          o[0] = a0; o[12288] = a1; o[2 * 12288] = a2; o[3 * 12288] = a3; o[4 * 12288] = a4;
      }
      __syncthreads(); }
    if ((PART & 2) && part == 1) for (int l = 0; l < 2; ++l) {
        absmax_f32<16>(F, F.in(6) + (size_t)l * 2048 * NIN, (size_t)2048 * NIN / 4, wsp<unsigned>(F, WS_WSC) + l);
        absmax4_f32(F, F.in(14) + (size_t)l * 512 * 2048, (size_t)512 * 2048 / 4, wsp<unsigned>(F, WS_WSC) + 4 + l, F.in(15) + (size_t)l * 512 * 2048, (size_t)512 * 2048 / 4, wsp<unsigned>(F, WS_WSC) + 6 + l,
                    F.in(16) + (size_t)l * 1024 * 2048, (size_t)1024 * 2048 / 4, wsp<unsigned>(F, WS_WSC) + 8 + l, F.in(17) + (size_t)l * 2048 * 2048, (size_t)2048 * 2048 / 4, wsp<unsigned>(F, WS_WSC) + 2 + l);
        transpose_cvt<2>(F, F.in(8) + (size_t)l * 512 * 768, wsp<bf16_t>(F, WS_WQUP + l * SZ_WQUP), 512, 768, 768);
        transpose_cvt<0>(F, F.in(10) + (size_t)l * 256 * 1024, wsp<bf16_t>(F, WS_WKVUP + l * SZ_WKVUP), 256, 1024, 1024);
        transpose_cvt<0>(F, F.in(20) + (size_t)l * 2048 * 1024, wsp<bf16_t>(F, WS_WPQ + l * SZ_WPQ), 2048, 1024, 1024);
    }
    if ((PART & 4) && part == 2) cvt_peer(F, 0);
    }
}
__device__ __forceinline__ void p1_modreduce(const Frame& F) {
    const float* modp = wsp<float>(F, WS_MODP); float* mod = wsp<float>(F, WS_MOD);
    for (int i = F.bid * 512 + F.tid; i < 2 * 5 * 12288; i += F.G * 512) {
        const int j = i % 12288, l = i / (5 * 12288);
        float s = F.in(5)[l * 12288 + j];
#pragma unroll
        for (int kc = 0; kc < 16; ++kc) s += modp[(size_t)kc * (2 * 5 * 12288) + i];
        mod[i] = s;
    }
    for (int l = 0; l < 2; ++l) {
        transpose_fp8<1>(F, F.in(6) + (size_t)l * 2048 * NIN, wsp<unsigned char>(F, WS_WIN + l * SZ_WIN), 2048, NIN, NPT, wsp<unsigned>(F, WS_WSC) + l);
        transpose_fp8<0>(F, F.in(17) + (size_t)l * 2048 * 2048, wsp<unsigned char>(F, WS_WOUT + l * SZ_WOUT), 2048, 2048, 2048, wsp<unsigned>(F, WS_WSC) + 2 + l);
        transpose_fp8<0>(F, F.in(14) + (size_t)l * 512 * 2048, wsp<unsigned char>(F, WS_WBRA + l * SZ_WBRA), 512, 2048, 2048, wsp<unsigned>(F, WS_WSC) + 4 + l);
        transpose_fp8<0>(F, F.in(15) + (size_t)l * 512 * 2048, wsp<unsigned char>(F, WS_WBRB + l * SZ_WBRB), 512, 2048, 2048, wsp<unsigned>(F, WS_WSC) + 6 + l);
        transpose_fp8<0>(F, F.in(16) + (size_t)l * 1024 * 2048, wsp<unsigned char>(F, WS_WBRC + l * SZ_WBRC), 1024, 2048, 2048, wsp<unsigned>(F, WS_WSC) + 8 + l);
    }
}
__device__ __forceinline__ void ld_row_f32(const float* p, int lane, float (&x)[32]) {
#pragma unroll
    for (int q = 0; q < 4; ++q) { const f32x4 a = *(const f32x4*)(p + 512 * q + 8 * lane), b = *(const f32x4*)(p + 512 * q + 8 * lane + 4);
        x[q * 8 + 0] = a[0]; x[q * 8 + 1] = a[1]; x[q * 8 + 2] = a[2]; x[q * 8 + 3] = a[3]; x[q * 8 + 4] = b[0]; x[q * 8 + 5] = b[1]; x[q * 8 + 6] = b[2]; x[q * 8 + 7] = b[3]; }
}
__device__ __forceinline__ void st_row_f32(float* p, int lane, const float (&x)[32]) {
#pragma unroll
    for (int q = 0; q < 4; ++q) { *(f32x4*)(p + 512 * q + 8 * lane) = (f32x4){x[q * 8 + 0], x[q * 8 + 1], x[q * 8 + 2], x[q * 8 + 3]}; *(f32x4*)(p + 512 * q + 8 * lane + 4) = (f32x4){x[q * 8 + 4], x[q * 8 + 5], x[q * 8 + 6], x[q * 8 + 7]}; }
}
__device__ __forceinline__ void st_row_bf16(bf16_t* p, int lane, const float (&x)[32]) {
#pragma unroll
    for (int q = 0; q < 4; ++q) { u32x4 w; w.x = cvt_pk_bf16(x[q * 8 + 0], x[q * 8 + 1]); w.y = cvt_pk_bf16(x[q * 8 + 2], x[q * 8 + 3]); w.z = cvt_pk_bf16(x[q * 8 + 4], x[q * 8 + 5]); w.w = cvt_pk_bf16(x[q * 8 + 6], x[q * 8 + 7]);
        *(u32x4*)(p + 512 * q + 8 * lane) = w; }
}
__device__ __forceinline__ void p_modulate0(const Frame& F) {
    const float* mod = wsp<float>(F, WS_MOD); unsigned char* hb8 = wsp<unsigned char>(F, WS_HB8);
    for (int row = F.bid * 8 + F.wave; row < NROW; row += F.G * 8) {
        const RowInfo ri = rowinfo(row);
        const float* xp = ri.lat ? F.in(0) + (size_t)row * D : F.in(2) + (size_t)(row - NLAT) * D;
        const float* mp = mod + (size_t)ri.v * 12288;
        float x[32], sh[32], sc[32];
        ld_row_f32(xp, F.lane, x); ld_row_f32(mp, F.lane, sh); ld_row_f32(mp + 2048, F.lane, sc);
#pragma unroll
        for (int i = 0; i < 32; ++i) x[i] = clamp8(x[i] * (1.f + sc[i]) + sh[i]);
#pragma unroll
        for (int q = 0; q < 4; ++q) { u32x2 w; w.x = pk4_fp8(x[q * 8 + 0], x[q * 8 + 1], x[q * 8 + 2], x[q * 8 + 3]); w.y = pk4_fp8(x[q * 8 + 4], x[q * 8 + 5], x[q * 8 + 6], x[q * 8 + 7]); *(u32x2*)(hb8 + (size_t)row * D + 512 * q + 8 * F.lane) = w; }
    }
}
__device__ __forceinline__ void p_post(const Frame& F, int l) {
    const bf16_t* P1 = wsp<bf16_t>(F, WS_P1);
    bf16_t* CQN = wsp<bf16_t>(F, WS_CQN); bf16_t* CKVN = wsp<bf16_t>(F, WS_CKVN);
    unsigned char* QG = wsp<unsigned char>(F, WS_QG); unsigned char* KG = wsp<unsigned char>(F, WS_KG); unsigned char* VG = wsp<unsigned char>(F, WS_VG);
    bf16_t* RQ = wsp<bf16_t>(F, WS_RQ); bf16_t* RK = wsp<bf16_t>(F, WS_RK); bf16_t* RV = wsp<bf16_t>(F, WS_RV);
    unsigned char* KM = wsp<unsigned char>(F, WS_KM); unsigned char* QM = wsp<unsigned char>(F, WS_QM);
    const f32x2* cs32 = wsp<f32x2>(F, WS_ROPE32); const f32x2* cs128 = wsp<f32x2>(F, WS_ROPE128);
    const float* gq_n = F.in(7) + l * 512; const float* gkv_n = F.in(9) + l * 256; const float* gqa_qn = F.in(12) + l * 128; const float* gqa_kn = F.in(13) + l * 128;
    LAS bf16_t* rs = (LAS bf16_t*)(F.lds + F.wave * 8192);
    const int lane = F.lane;
    const f32x4 gq0 = *(const f32x4*)(gq_n + lane * 8), gq1 = *(const f32x4*)(gq_n + lane * 8 + 4), gkv0 = *(const f32x4*)(gkv_n + lane * 4);
    const int gd0 = 2 * lane; const int gpart = gd0 >> 6, gdd = gd0 & 63; const bool glo = gdd < 32; const int gf = glo ? gdd : gdd - 32; const int gdp = glo ? gd0 + 32 : gd0 - 32;
    const float qn0 = gqa_qn[gd0], qn1 = gqa_qn[gd0 + 1], qnp0 = gqa_qn[gdp], qnp1 = gqa_qn[gdp + 1];
    const float kn0 = gqa_kn[gd0], kn1 = gqa_kn[gd0 + 1], knp0 = gqa_kn[gdp], knp1 = gqa_kn[gdp + 1];
    const int rhh = lane >> 3, rd0 = (lane & 7) * 4; const int rpart = rd0 >> 4, rdd = rd0 & 15; const bool rlo = rdd < 8; const int rf = rlo ? rdd : rdd - 8; const int rdp = rlo ? rd0 + 8 : rd0 - 8;
    const int step = F.G * 8;
    int row = F.bid * 8 + F.wave;
    u32x4 pre[8];
    if (row < NROW) {
#pragma unroll
        for (int q = 0; q < 8; ++q) pre[q] = *(const u32x4*)(P1 + (size_t)row * NP1 + q * 512 + lane * 8); }
#pragma unroll 1
    for (; row < NROW; row += step) {
        const RowInfo ri = rowinfo(row);
        const int posg = gpart ? ri.pc : ri.pr, posr = rpart ? ri.pc : ri.pr;
        const f32x2 one = {1.f, 0.f};
        const f32x2 csA = ri.lat ? cs128[posg * 32 + gf] : one, csB = ri.lat ? cs128[posg * 32 + gf + 1] : one;
        f32x2 cs[4];
#pragma unroll
        for (int i = 0; i < 4; ++i) cs[i] = ri.lat ? cs32[posr * 8 + rf + i] : one;
#pragma unroll
        for (int q = 0; q < 8; ++q) *(LAS u32x4*)(rs + q * 512 + lane * 8) = pre[q];
        { const int nrow = row + step; if (nrow < NROW) {
#pragma unroll
            for (int q = 0; q < 8; ++q) pre[q] = *(const u32x4*)(P1 + (size_t)nrow * NP1 + q * 512 + lane * 8); } }
        asm volatile("s_waitcnt lgkmcnt(0)" ::: "memory");
        { float x[8]; float ss = 0.f;
#pragma unroll
          for (int i = 0; i < 8; ++i) { x[i] = bf2f(rs[C_CQ + lane * 8 + i]); ss += x[i] * x[i]; }
          ss = wave_sum(ss); const float r = rsqrtf(ss * (1.f / 512.f) + RMS_EPS);
          *(u32x4*)(CQN + (size_t)row * 512 + lane * 8) = pack8((f32x4){x[0] * r * gq0[0], x[1] * r * gq0[1], x[2] * r * gq0[2], x[3] * r * gq0[3]}, (f32x4){x[4] * r * gq1[0], x[5] * r * gq1[1], x[6] * r * gq1[2], x[7] * r * gq1[3]}); }
        { float x[4]; float ss = 0.f;
#pragma unroll
          for (int i = 0; i < 4; ++i) { x[i] = bf2f(rs[C_CKV + lane * 4 + i]); ss += x[i] * x[i]; }
          ss = wave_sum(ss); const float r = rsqrtf(ss * (1.f / 256.f) + RMS_EPS);
          u32x2 w; w.x = cvt_pk_bf16(x[0] * r * gkv0[0], x[1] * r * gkv0[1]); w.y = cvt_pk_bf16(x[2] * r * gkv0[2], x[3] * r * gkv0[3]);
          *(u32x2*)(CKVN + (size_t)row * 256 + lane * 4) = w; }
        {
            const int d0 = gd0, dp = gdp; const bool lo = glo;
#pragma unroll 1
            for (int hh = 0; hh < 10; ++hh) {
                const bool isq = hh < 8; const int cbase = isq ? C_GQ + hh * 128 : C_GK + (hh - 8) * 128;
                const float g0 = isq ? qn0 : kn0, g1 = isq ? qn1 : kn1, gp0 = isq ? qnp0 : knp0, gp1 = isq ? qnp1 : knp1;
                const float a0 = bf2f(rs[cbase + d0]), a1 = bf2f(rs[cbase + d0 + 1]);
                float ss = wave_sum(a0 * a0 + a1 * a1); const float r = rsqrtf(ss * (1.f / 128.f) + RMS_EPS);
                const float n0 = a0 * r * g0, n1 = a1 * r * g1;
                const float p0 = bf2f(rs[cbase + dp]) * r * gp0, p1 = bf2f(rs[cbase + dp + 1]) * r * gp1;
                float o0, o1;
                if (lo) { o0 = n0 * csA.x - p0 * csA.y; o1 = n1 * csB.x - p1 * csB.y; }
                else    { o0 = p0 * csA.y + n0 * csA.x; o1 = p1 * csB.y + n1 * csB.x; }
                unsigned char* dst = isq ? QG + ((size_t)(ri.b * 8 + hh) * TT + ri.tpos) * 128 : KG + ((size_t)(ri.b * 2 + (hh - 8)) * TT + ri.tpos) * 128;
                *(unsigned short*)(dst + d0) = (unsigned short)(pk4_fp8(clamp8(o0), clamp8(o1), 0.f, 0.f) & 0xffffu);
            }
#pragma unroll
            for (int hh = 0; hh < 2; ++hh) { const unsigned w8_ = pk4_fp8(clamp8(bf2f(rs[C_GV + hh * 128 + d0])), clamp8(bf2f(rs[C_GV + hh * 128 + d0 + 1])), 0.f, 0.f); unsigned char* vp_ = VG + ((size_t)(ri.b * 2 + hh) * 128 + d0) * TT + vt_off(ri.tpos);
                vp_[0] = (unsigned char)(w8_ & 0xffu); vp_[TT] = (unsigned char)((w8_ >> 8) & 0xffu); }
        }
        {
            const int hh = rhh, d0 = rd0, dp = rdp; const bool lo = rlo;
#pragma unroll
            for (int which = 0; which < 2; ++which) {
                const int cbase = (which ? C_RK : C_RQ) + hh * 32; const float sc = which ? 0.17677669529663687f : 1.f;
                float o[4];
#pragma unroll
                for (int i = 0; i < 4; ++i) { const float n = bf2f(rs[cbase + d0 + i]), p = bf2f(rs[cbase + dp + i]);
                    o[i] = (lo ? (n * cs[i].x - p * cs[i].y) : (p * cs[i].y + n * cs[i].x)) * sc; }
                u32x2 w; w.x = cvt_pk_bf16(o[0], o[1]); w.y = cvt_pk_bf16(o[2], o[3]);
                *(u32x2*)((which ? RK : RQ) + ((size_t)(ri.b * 8 + hh) * TT + ri.tpos) * 32 + d0) = w;
            }
            { const int vh = lane >> 3, e0 = (lane & 7) * 8;
              *(u32x4*)(RV + ((size_t)(ri.b * 8 + vh) * TT + ri.tpos) * 64 + e0) = *(LAS u32x4*)(rs + C_RV + lane * 8); }
            { float o[4];
#pragma unroll
              for (int i = 0; i < 4; ++i) { const float n = bf2f(rs[C_KR + d0 + i]), p = bf2f(rs[C_KR + dp + i]); o[i] = lo ? (n * cs[i].x - p * cs[i].y) : (p * cs[i].y + n * cs[i].x); }
              const size_t tok_ = ((size_t)(ri.b * 8 + hh) * TT + ri.tpos) * 128;
              *(unsigned*)(KM + tok_ + 64 + d0) = pk4_fp8(clamp8(o[0]), clamp8(o[1]), clamp8(o[2]), clamp8(o[3]));
              *(unsigned*)(KM + tok_ + 96 + d0) = 0u; *(unsigned*)(QM + tok_ + 96 + d0) = 0u; }
        }
        asm volatile("s_waitcnt lgkmcnt(0)" ::: "memory");
    }
}

__device__ __forceinline__ void ret_logs(const Frame& F, int l, int h, float& lgf, float& lgb) {
    const float* t = wsp<float>(F, WS_DEC); lgf = t[(l * 2 + 0) * 8 + h]; lgb = t[(l * 2 + 1) * 8 + h];
}
constexpr int TP = 136;
template <bool WITH_K>
__device__ __forceinline__ void ret_stage(const Frame& F, const bf16_t* RKh, const bf16_t* RVh, int tpos0, float lgf, float lgb, LAS bf16_t* vt, LAS bf16_t* ktf, LAS bf16_t* ktb) {
#pragma unroll
    for (int i = 0; i < 2; ++i) { const int tok = (F.tid >> 3) + 64 * i, e0 = (F.tid & 7) * 8;
        const u32x4 w = *(const u32x4*)(RVh + (size_t)(tpos0 + tok) * 64 + e0); const unsigned ww[4] = {w.x, w.y, w.z, w.w};
#pragma unroll
        for (int j = 0; j < 4; ++j) { vt[(e0 + 2 * j) * TP + tok] = (bf16_t)(ww[j] & 0xffffu); vt[(e0 + 2 * j + 1) * TP + tok] = (bf16_t)(ww[j] >> 16); } }
    if (WITH_K) { const int tok = F.tid >> 2, k0 = (F.tid & 3) * 8;
        const u32x4 w = *(const u32x4*)(RKh + (size_t)(tpos0 + tok) * 32 + k0); const unsigned ww[4] = {w.x, w.y, w.z, w.w};
        const float zf = exp2f(lgf * (float)(127 - tok)), zb = exp2f(lgb * (float)tok);
#pragma unroll
        for (int j = 0; j < 4; ++j) { const float a = bflo(ww[j]), b = bfhi(ww[j]);
            ktf[(k0 + 2 * j) * TP + tok] = f2bf(a * zf); ktf[(k0 + 2 * j + 1) * TP + tok] = f2bf(b * zf);
            ktb[(k0 + 2 * j) * TP + tok] = f2bf(a * zb); ktb[(k0 + 2 * j + 1) * TP + tok] = f2bf(b * zb); } }
}
__device__ __forceinline__ void p_ret_states(const Frame& F, int l) {
    LAS bf16_t* vt = (LAS bf16_t*)F.lds; LAS bf16_t* ktf = vt + 64 * TP; LAS bf16_t* ktb = ktf + 32 * TP;
    float* ST = wsp<float>(F, WS_ST);
    const int lane = F.lane, w = F.wave, kb = w >> 2, eb = w & 3, fr = lane & 15, fq = lane >> 4;
    for (int u = F.bid; u < NB * 8 * 34; u += F.G) {
        const int c = u % 34, bh = u / 34, h = bh & 7;
        float lgf, lgb; ret_logs(F, l, h, lgf, lgb);
        __syncthreads();
        ret_stage<true>(F, wsp<bf16_t>(F, WS_RK) + (size_t)bh * TT * 32, wsp<bf16_t>(F, WS_RV) + (size_t)bh * TT * 64, c * 128, lgf, lgb, vt, ktf, ktb);
        __syncthreads();
        f32x4 sf = {0.f, 0.f, 0.f, 0.f}, sb = {0.f, 0.f, 0.f, 0.f};
#pragma unroll
        for (int ks = 0; ks < 4; ++ks) {
            const bf16x8 bv = *(const LAS bf16x8*)(vt + (eb * 16 + fr) * TP + ks * 32 + fq * 8);
            const bf16x8 af = *(const LAS bf16x8*)(ktf + (kb * 16 + fr) * TP + ks * 32 + fq * 8);
            const bf16x8 ab = *(const LAS bf16x8*)(ktb + (kb * 16 + fr) * TP + ks * 32 + fq * 8);
            sf = __builtin_amdgcn_mfma_f32_16x16x32_bf16(af, bv, sf, 0, 0, 0);
            sb = __builtin_amdgcn_mfma_f32_16x16x32_bf16(ab, bv, sb, 0, 0, 0);
        }
        float* o = ST + (size_t)u * 2 * 2048;
#pragma unroll
        for (int r = 0; r < 4; ++r) { const int kd = kb * 16 + fq * 4 + r, e = eb * 16 + fr; o[kd * 64 + e] = sf[r]; o[2048 + kd * 64 + e] = sb[r]; }
    }
}
constexpr int RP = 40;
constexpr int AP = 136;
__device__ __forceinline__ void ret_out_unit(const Frame& F, int l, int bh, int c) {
    LAS bf16_t* vt = (LAS bf16_t*)F.lds; LAS bf16_t* rtf = vt + 64 * TP; LAS bf16_t* rtb = rtf + 64 * RP; LAS bf16_t* as = rtb + 64 * RP + F.wave * 16 * AP;
    const int lane = F.lane, w = F.wave, fr = lane & 15, fq = lane >> 4, h = bh & 7, b = bh >> 3;
    const bf16_t* RQh = wsp<bf16_t>(F, WS_RQ) + (size_t)bh * TT * 32; const bf16_t* RKh = wsp<bf16_t>(F, WS_RK) + (size_t)bh * TT * 32; const bf16_t* RVh = wsp<bf16_t>(F, WS_RV) + (size_t)bh * TT * 64;
    const float* STh = wsp<float>(F, WS_ST) + (size_t)bh * 34 * 2 * 2048;
    float lgf, lgb; ret_logs(F, l, h, lgf, lgb);
    const int tpos0 = c * 128;
    __syncthreads();
    ret_stage<false>(F, RKh, RVh, tpos0, lgf, lgb, vt, nullptr, nullptr);
    { const int kd = F.tid >> 4, e4 = (F.tid & 15) * 4; f32x4 rf = {0.f, 0.f, 0.f, 0.f}, rb = {0.f, 0.f, 0.f, 0.f};
      if (c >= 2) {
          const int p = c - 2;
          const float kff = 80.f / (-lgf * 128.f), kfb = 80.f / (-lgb * 128.f); const int kcf = kff < 64.f ? (int)kff + 1 : 64, kcb = kfb < 64.f ? (int)kfb + 1 : 64;
          const int nf = c < kcf ? c : kcf, nb_ = (33 - p) < kcb ? (33 - p) : kcb;
          const float* sf = STh + kd * 64 + e4;
          for (int k0 = 0; k0 < nf; k0 += 8) { f32x4 v[8];
#pragma unroll
              for (int j = 0; j < 8; ++j) { const int k = k0 + j; const int cp = k < nf ? c - 1 - k : 0; v[j] = *(const f32x4*)(sf + (size_t)(cp * 2 + 0) * 2048); }
#pragma unroll
              for (int j = 0; j < 8; ++j) { const int k = k0 + j; const float wgt = k < nf ? __builtin_amdgcn_exp2f(lgf * 128.f * (float)k) : 0.f; rf += v[j] * wgt; } }
          for (int k0 = 0; k0 < nb_; k0 += 8) { f32x4 v[8];
#pragma unroll
              for (int j = 0; j < 8; ++j) { const int k = k0 + j; const int pp = k < nb_ ? p + 1 + k : 33; const int cs = pp < 32 ? pp + 2 : pp - 32; v[j] = *(const f32x4*)(sf + (size_t)(cs * 2 + 1) * 2048); }
#pragma unroll
              for (int j = 0; j < 8; ++j) { const int k = k0 + j; const float wgt = k < nb_ ? __builtin_amdgcn_exp2f(lgb * 128.f * (float)k) : 0.f; rb += v[j] * wgt; } }
      } else if (c == 0) { rb = *(const f32x4*)(STh + (size_t)(1 * 2 + 1) * 2048 + kd * 64 + e4); }
      else { rf = *(const f32x4*)(STh + (size_t)(0 * 2 + 0) * 2048 + kd * 64 + e4); }
#pragma unroll
      for (int j = 0; j < 4; ++j) { rtf[(e4 + j) * RP + kd] = f2bf(rf[j]); rtb[(e4 + j) * RP + kd] = f2bf(rb[j]); } }
    const int i0 = w * 16;
    const bf16x8 qa = *(const bf16x8*)(RQh + (size_t)(tpos0 + i0 + fr) * 32 + fq * 8);
    f32x4 s[8];
#pragma unroll
    for (int nb = 0; nb < 8; ++nb) { const bf16x8 kf = *(const bf16x8*)(RKh + (size_t)(tpos0 + nb * 16 + fr) * 32 + fq * 8);
        s[nb] = __builtin_amdgcn_mfma_f32_16x16x32_bf16(qa, kf, (f32x4){0.f, 0.f, 0.f, 0.f}, 0, 0, 0); }
#pragma unroll
    for (int nb = 0; nb < 8; ++nb)
#pragma unroll
        for (int r = 0; r < 4; ++r) { const int i = i0 + fq * 4 + r, j = nb * 16 + fr; const int df = i - j;
            const float mk = df > 0 ? exp2f(lgf * (float)df) : (df < 0 ? exp2f(lgb * (float)(-df)) : 2.f);
            as[(fq * 4 + r) * AP + j] = f2bf(s[nb][r] * mk); }
    __syncthreads();
    f32x4 y[4];
#pragma unroll
    for (int eb = 0; eb < 4; ++eb) y[eb] = (f32x4){0.f, 0.f, 0.f, 0.f};
#pragma unroll
    for (int ks = 0; ks < 4; ++ks) { const bf16x8 af = *(const LAS bf16x8*)(as + fr * AP + ks * 32 + fq * 8);
#pragma unroll
        for (int eb = 0; eb < 4; ++eb) { const bf16x8 bv = *(const LAS bf16x8*)(vt + (eb * 16 + fr) * TP + ks * 32 + fq * 8);
            y[eb] = __builtin_amdgcn_mfma_f32_16x16x32_bf16(af, bv, y[eb], 0, 0, 0); } }
    { const float xf = exp2f(lgf * (float)(i0 + fr + 1)), xb = exp2f(lgb * (float)(128 - (i0 + fr)));
      bf16x8 qf, qb;
#pragma unroll
      for (int j = 0; j < 8; ++j) { const float qv = bf2f((bf16_t)qa[j]); qf[j] = (short)f2bf(qv * xf); qb[j] = (short)f2bf(qv * xb); }
#pragma unroll
      for (int eb = 0; eb < 4; ++eb) { const bf16x8 bf_ = *(const LAS bf16x8*)(rtf + (eb * 16 + fr) * RP + fq * 8), bb_ = *(const LAS bf16x8*)(rtb + (eb * 16 + fr) * RP + fq * 8);
          y[eb] = __builtin_amdgcn_mfma_f32_16x16x32_bf16(qf, bf_, y[eb], 0, 0, 0);
          y[eb] = __builtin_amdgcn_mfma_f32_16x16x32_bf16(qb, bb_, y[eb], 0, 0, 0); } }
    const bf16_t* P1 = wsp<bf16_t>(F, WS_P1); unsigned char* OAB = wsp<unsigned char>(F, WS_OAB);
#pragma unroll
    for (int r = 0; r < 4; ++r) {
        float sm = y[0][r] + y[1][r] + y[2][r] + y[3][r]; sm = row16_sum(sm); const float mu = sm * (1.f / 64.f);
        float vs = 0.f;
#pragma unroll
        for (int eb = 0; eb < 4; ++eb) { const float d = y[eb][r] - mu; vs += d * d; }
        vs = row16_sum(vs); const float rstd = rsqrtf(vs * (1.f / 64.f) + LN_EPS);
        const int i = i0 + fq * 4 + r; const int tp = tpos0 + i; const size_t grow = tp >= CTXL ? (size_t)b * SEQ + (tp - CTXL) : (size_t)NLAT + b * CTXL + tp;
#pragma unroll
        for (int eb = 0; eb < 4; ++eb) { const int e = eb * 16 + fr; const float g = bf2f(P1[grow * NP1 + C_RG + h * 64 + e]);
            OAB[grow * D + 512 + h * 64 + e] = (unsigned char)(pk4_fp8(clamp8(silu_f(g) * (y[eb][r] - mu) * rstd * 16.f), 0.f, 0.f, 0.f) & 0xffu); }
    }
}
namespace att {
constexpr int NW = 8, QBLK = 32, KVBLK = 64;
constexpr int SHM_K = KVBLK * 128, SHM_V = 128 * 64;
constexpr size_t SHM_ATTN = 4 * SHM_K + 3 * SHM_V;
constexpr float THR = 1.9f, PSH = 6.f;
#define SBAR() __builtin_amdgcn_sched_barrier(0)
typedef int i32x8a __attribute__((ext_vector_type(8))); typedef int i32x4a __attribute__((ext_vector_type(4)));
template <int SC> struct Scale { static constexpr float S = SC == 0 ? 0.08838834764831845f : 0.10206207261596575f; static constexpr float C = S * 1.4426950408889634f; static constexpr float THRR = THR / S; };
#define KSWZ8(row, chunk) ((row) * 128 + ((((chunk) ^ (((row) >> 1) & 7))) << 4))
#define VSWZ8(col, chunk) ((col) * 64 + ((((chunk) ^ (((col) >> 2) & 3))) << 4))
#define MF8(A, B, C) mf8x<ABL>(A, B, C)
#define CAT8(lo, hi) __builtin_shufflevector(lo, hi, 0, 1, 2, 3, 4, 5, 6, 7)
#define LDS16(p) ((ABL & 8) ? __builtin_shufflevector(qr8[0], qr8[1], 0, 1, 10, 11) : *(const LAS i32x4a*)(p))
template <int A, int B, int ABL = 0> __device__ __forceinline__ void exp_rng(f32x16& p) {
#pragma unroll
  for (int r = A; r < B; ++r) p[r] = (ABL & 1) ? p[r] * p[r] : __builtin_amdgcn_exp2f(p[r]);
}
template <int ABL> __device__ __forceinline__ f32x16 mf8x(const i32x8a a, const i32x8a b, f32x16 c) {
  if constexpr (ABL & 2) { c[0] += __int_as_float(((a[0] ^ a[4]) + (b[0] ^ b[4])) & 0x3f000000); return c; }
  else return __builtin_amdgcn_mfma_scale_f32_32x32x64_f8f6f4(a, b, c, 0, 0, 0, 0x7F7F7F7F, 0, 0x7F7F7F7F);
}
__device__ __forceinline__ void pk_fma16(f32x16& p, float c, float d) { const f32x2 c2 = {c, c}, d2 = {d, d};
#pragma unroll
  for (int i = 0; i < 8; ++i) { f32x2 v = {p[2 * i], p[2 * i + 1]}; v = v * c2 + d2; p[2 * i] = v.x; p[2 * i + 1] = v.y; }
}
__device__ __forceinline__ void pk_mul16(f32x16& p, float c) { const f32x2 c2 = {c, c};
#pragma unroll
  for (int i = 0; i < 8; ++i) { f32x2 v = {p[2 * i], p[2 * i + 1]}; v = v * c2; p[2 * i] = v.x; p[2 * i + 1] = v.y; }
}
__device__ __forceinline__ float pk_sum32(const f32x16& p0, const f32x16& p1) { f32x2 s0 = {p0[0], p0[1]}, s1 = {p1[0], p1[1]};
#pragma unroll
  for (int i = 1; i < 8; ++i) { s0 += (f32x2){p0[2 * i], p0[2 * i + 1]}; s1 += (f32x2){p1[2 * i], p1[2 * i + 1]}; }
  s0 += s1; return s0.x + s0.y;
}
__device__ __forceinline__ float hsum(float v) { auto rr = __builtin_amdgcn_permlane32_swap(__float_as_uint(v), __float_as_uint(v), false, false); return __uint_as_float(rr[0]) + __uint_as_float(rr[1]); }
__device__ __forceinline__ float hmax(float v) { auto rr = __builtin_amdgcn_permlane32_swap(__float_as_uint(v), __float_as_uint(v), false, false); return fmaxf(__uint_as_float(rr[0]), __uint_as_float(rr[1])); }
template <int NDV, int SC, int ABL>
__device__ __forceinline__ void attn_body(const unsigned char* __restrict__ Qb, const unsigned char* __restrict__ Kh, const unsigned char* __restrict__ Vt,
                                          unsigned char* __restrict__ Ob, int seq, LAS unsigned char* lds, const int tid) {
  constexpr int ldo = 2048; constexpr float C = Scale<SC>::C, thr_raw = Scale<SC>::THRR;
  const int wid = __builtin_amdgcn_readfirstlane(tid >> 6), lane = tid & 63, r32 = lane & 31, hi = lane >> 5;
  LAS unsigned char* K_lds = lds; LAS unsigned char* V_lds = lds + 4 * SHM_K;
  float m_reg = -1e30f, l_reg = 0; f32x16 o[NDV] = {}; i32x8a qr8[2];
  const unsigned char* Qw = Qb + (long)(wid * QBLK + r32) * 128 + hi * 32;
#pragma unroll
  for (int blk = 0; blk < 2; ++blk) { const i32x4a lo_ = *reinterpret_cast<const i32x4a*>(Qw + blk * 64), hi_ = *reinterpret_cast<const i32x4a*>(Qw + blk * 64 + 16); qr8[blk] = CAT8(lo_, hi_); }
  const int NT = seq / KVBLK;
  const int kr8 = 8 * wid + (lane >> 3), vcol = 16 * (wid & (NDV * 2 - 1)) + (lane >> 2);
  const unsigned char* kgp = Kh + (long)kr8 * 128 + (((lane & 7) ^ ((kr8 >> 1) & 7)) << 4);
  const unsigned char* vgp = Vt + (long)vcol * TT + (((lane & 3) ^ ((vcol >> 2) & 3)) << 4);
  const int kdo = wid * 1024, vdo = (wid & (NDV * 2 - 1)) * 1024;
  const int ka0 = KSWZ8(r32, 2 * hi), ka1 = KSWZ8(r32, 2 * hi + 1), va0 = VSWZ8(r32, 2 * hi), va1 = VSWZ8(r32, 2 * hi + 1);
#define DMAK(t, bo) do { const int t_ = (t) < NT ? (t) : NT - 1; __builtin_amdgcn_global_load_lds((const unsigned*)(kgp + (long)t_ * (KVBLK * 128)), (LAS unsigned*)(K_lds + (bo) + kdo), 16, 0, 0); } while (0)
#define DMAV(t, bo) do { const int t_ = (t) < NT ? (t) : NT - 1; __builtin_amdgcn_global_load_lds((const unsigned*)(vgp + t_ * KVBLK), (LAS unsigned*)(V_lds + (bo) + vdo), 16, 0, 0); } while (0)
#define VMW(n) asm volatile("s_waitcnt vmcnt(" #n ")" ::: "memory")
#define BAR() __builtin_amdgcn_s_barrier()
  f32x16 pA0, pA1, pB0, pB1; float alA, alB; i32x8a pa;
#define PSM_MAX(p0, p1, al, mnC) do { float pm_ = fmaxf(p0[0], p1[0]);                                                                  \
    _Pragma("unroll") for (int r = 1; r < 16; ++r) pm_ = fmaxf(fmaxf(pm_, p0[r]), p1[r]);                                               \
    pm_ = hmax(pm_);                                                                                                                     \
    const bool keep_ = __all(pm_ - m_reg <= thr_raw); const float mn_ = keep_ ? m_reg : fmaxf(m_reg, pm_);                               \
    al = __builtin_amdgcn_exp2f((m_reg - mn_) * C); m_reg = mn_; mnC = PSH - mn_ * C; } while (0)
#define PT3(x, y, z) asm volatile("" : "+v"(x), "+v"(y), "+v"(z))
#define PT4(x, y, z, w) asm volatile("" : "+v"(x), "+v"(y), "+v"(z), "+v"(w))
#define STEP(j, pc0, pc1, alc, pn0, pn1, aln) do { const LAS unsigned char* Kr_ = K_lds + kb_rd; const LAS unsigned char* Vs_ = V_lds + vb_rd; float mnC_;  \
    i32x8a kc_ = CAT8(LDS16(Kr_ + (ka0 ^ 64)), LDS16(Kr_ + (ka1 ^ 64))), kd_ = CAT8(LDS16(Kr_ + 4096 + (ka0 ^ 64)), LDS16(Kr_ + 4096 + (ka1 ^ 64))); \
    pn0 = MF8(kpa, qr8[0], (f32x16){}); exp_rng<0, 6, ABL>(pc1); PT3(pn0, pc1, kpb);                                                     \
    pn1 = MF8(kpb, qr8[0], (f32x16){}); exp_rng<6, 12, ABL>(pc1); PT3(pn1, pc1, kc_);                                                    \
    pn0 = MF8(kc_, qr8[1], pn0); exp_rng<12, 16, ABL>(pc1);                                                                              \
    { float ps_ = pk_sum32(pc0, pc1); ps_ = hsum(ps_); l_reg = l_reg * alc + ps_; }                                                      \
    i32x8a va_ = CAT8(LDS16(Vs_ + va0), LDS16(Vs_ + va1)), vb_ = CAT8(LDS16(Vs_ + 2048 + va0), LDS16(Vs_ + 2048 + va1));                  \
    PT4(pn0, pc1, kd_, l_reg);                                                                                                           \
    pn1 = MF8(kd_, qr8[1], pn1);                                                                                                         \
    _Pragma("unroll") for (int q = 0; q < 4; ++q) { pa[q] = (int)pk4_fp8(pc0[4 * q], pc0[4 * q + 1], pc0[4 * q + 2], pc0[4 * q + 3]); pa[4 + q] = (int)pk4_fp8(pc1[4 * q], pc1[4 * q + 1], pc1[4 * q + 2], pc1[4 * q + 3]); } \
    PT3(pn1, pa, va_);                                                                                                                   \
    if constexpr (!(ABL & 128)) { DMAK((j) + 4, kb_wr); DMAV((j) + 2, vb_wr); }                                                          \
    o[0] = MF8(va_, pa, o[0]); PSM_MAX(pn0, pn1, aln, mnC_); PT4(o[0], pn0, vb_, mnC_);                                                  \
    o[1] = MF8(vb_, pa, o[1]); pk_fma16(pn0, C, mnC_); pk_fma16(pn1, C, mnC_); exp_rng<0, 4, ABL>(pn0);                                   \
    if constexpr (NDV == 4) { i32x8a vc_ = CAT8(LDS16(Vs_ + 4096 + va0), LDS16(Vs_ + 4096 + va1)), vd_ = CAT8(LDS16(Vs_ + 6144 + va0), LDS16(Vs_ + 6144 + va1)); \
      PT4(o[1], pn0, pn1, vc_); o[2] = MF8(vc_, pa, o[2]); exp_rng<4, 10, ABL>(pn0); PT3(o[2], pn0, vd_);                                \
      o[3] = MF8(vd_, pa, o[3]); exp_rng<10, 16, ABL>(pn0); }                                                                            \
    else { PT3(o[1], pn0, pn1); exp_rng<4, 16, ABL>(pn0); }                                                                              \
    { const LAS unsigned char* Kp_ = K_lds + kb_pf; kpa = CAT8(LDS16(Kp_ + ka0), LDS16(Kp_ + ka1)); kpb = CAT8(LDS16(Kp_ + 4096 + ka0), LDS16(Kp_ + 4096 + ka1)); } \
    PT3(o[NDV - 1], pn0, pn1); RESC(aln);                                                                                               \
    { const int t_ = kb_rd; kb_rd = kb_pf; kb_pf = kb_x; kb_x = kb_wr; kb_wr = t_; const int u_ = vb_rd; vb_rd = vb_n1; vb_n1 = vb_wr; vb_wr = u_; } \
    VMW(2); if constexpr (!(ABL & 4)) BAR(); } while (0)
#define RESC(a) do { if (__any((a) < 1.f)) { _Pragma("unroll") for (int d = 0; d < NDV; ++d) pk_mul16(o[d], (a)); } } while (0)
  i32x8a kpa, kpb; int kb_rd = SHM_K, kb_pf = 2 * SHM_K, kb_x = 3 * SHM_K, kb_wr = 0, vb_rd = 0, vb_n1 = SHM_V, vb_wr = 2 * SHM_V;
  DMAK(0, 0); DMAK(1, SHM_K); DMAK(2, 2 * SHM_K); DMAK(3, 3 * SHM_K); DMAV(0, 0); DMAV(1, SHM_V); VMW(0); BAR();
  { const LAS unsigned char* Ks_ = K_lds; float mnC_;
    pA0 = MF8(CAT8(LDS16(Ks_ + ka0), LDS16(Ks_ + ka1)), qr8[0], (f32x16){}); pA1 = MF8(CAT8(LDS16(Ks_ + 4096 + ka0), LDS16(Ks_ + 4096 + ka1)), qr8[0], (f32x16){});
    pA0 = MF8(CAT8(LDS16(Ks_ + (ka0 ^ 64)), LDS16(Ks_ + (ka1 ^ 64))), qr8[1], pA0); pA1 = MF8(CAT8(LDS16(Ks_ + 4096 + (ka0 ^ 64)), LDS16(Ks_ + 4096 + (ka1 ^ 64))), qr8[1], pA1);
    PSM_MAX(pA0, pA1, alA, mnC_); pk_fma16(pA0, C, mnC_); pk_fma16(pA1, C, mnC_); exp_rng<0, 16, ABL>(pA0);
    const LAS unsigned char* Kp_ = K_lds + SHM_K; kpa = CAT8(LDS16(Kp_ + ka0), LDS16(Kp_ + ka1)); kpb = CAT8(LDS16(Kp_ + 4096 + ka0), LDS16(Kp_ + 4096 + ka1)); }
  asm volatile("s_waitcnt lgkmcnt(0)" ::: "memory"); BAR();
  int j = 0;
  for (; j + 2 < NT; j += 2) { STEP(j, pA0, pA1, alA, pB0, pB1, alB); STEP(j + 1, pB0, pB1, alB, pA0, pA1, alA); }
  STEP(j, pA0, pA1, alA, pB0, pB1, alB);
  { exp_rng<0, 16, ABL>(pB1); float ps_ = pk_sum32(pB0, pB1); ps_ = hsum(ps_); l_reg = l_reg * alB + ps_;
#pragma unroll
    for (int q = 0; q < 4; ++q) { pa[q] = (int)pk4_fp8(pB0[4 * q], pB0[4 * q + 1], pB0[4 * q + 2], pB0[4 * q + 3]); pa[4 + q] = (int)pk4_fp8(pB1[4 * q], pB1[4 * q + 1], pB1[4 * q + 2], pB1[4 * q + 3]); }
    const LAS unsigned char* Vs_ = V_lds + vb_rd;
#pragma unroll
    for (int d0 = 0; d0 < NDV; ++d0) o[d0] = MF8(CAT8(LDS16(Vs_ + d0 * 2048 + va0), LDS16(Vs_ + d0 * 2048 + va1)), pa, o[d0]); }
  const float rl = __builtin_amdgcn_rcpf(l_reg) * 16.f;
  unsigned char* Ow = Ob + (long)(wid * QBLK + r32) * ldo + 4 * hi;
#pragma unroll
  for (int d0 = 0; d0 < NDV; ++d0)
#pragma unroll
    for (int g = 0; g < 4; ++g) *(unsigned*)(Ow + d0 * 32 + 8 * g) = pk4_fp8(clamp8(o[d0][4 * g] * rl), clamp8(o[d0][4 * g + 1] * rl), clamp8(o[d0][4 * g + 2] * rl), clamp8(o[d0][4 * g + 3] * rl));
#undef DMAK
#undef DMAV
#undef VMW
#undef BAR
#undef PSM_MAX
#undef REGION_X
#undef REGION_Y
#undef RESC
#undef STEP
#undef PT3
#undef PT4
}
}
__device__ __forceinline__ float* xres_row(const Frame& F, int row) { return row < NLAT ? F.out + (size_t)row * D : wsp<float>(F, WS_XC) + (size_t)(row - NLAT) * D; }
__device__ __forceinline__ void ln_row(float (&y)[32], const float* g, const float* b, int lane) {
    float s = 0.f;
#pragma unroll
    for (int i = 0; i < 32; ++i) s += y[i];
    const float mu = wave_sum(s) * (1.f / 2048.f);
    float q = 0.f;
#pragma unroll
    for (int i = 0; i < 32; ++i) { const float d = y[i] - mu; q += d * d; }
    const float rstd = rsqrtf(wave_sum(q) * (1.f / 2048.f) + LN_EPS);
#pragma unroll
    for (int qq = 0; qq < 4; ++qq) { const f32x4 g0 = *(const f32x4*)(g + 512 * qq + 8 * lane), g1 = *(const f32x4*)(g + 512 * qq + 8 * lane + 4), b0 = *(const f32x4*)(b + 512 * qq + 8 * lane), b1 = *(const f32x4*)(b + 512 * qq + 8 * lane + 4);
#pragma unroll
        for (int i = 0; i < 4; ++i) { y[qq * 8 + i] = (y[qq * 8 + i] - mu) * rstd * g0[i] + b0[i]; y[qq * 8 + 4 + i] = (y[qq * 8 + 4 + i] - mu) * rstd * g1[i] + b1[i]; } }
}
__device__ __forceinline__ void modulate_store(const float (&x)[32], const float* sh, const float* sc, bf16_t* dst, int lane) {
#pragma unroll
    for (int q = 0; q < 4; ++q) { const f32x4 h0 = *(const f32x4*)(sh + 512 * q + 8 * lane), h1 = *(const f32x4*)(sh + 512 * q + 8 * lane + 4), c0 = *(const f32x4*)(sc + 512 * q + 8 * lane), c1 = *(const f32x4*)(sc + 512 * q + 8 * lane + 4);
        f32x4 a, b;
#pragma unroll
        for (int i = 0; i < 4; ++i) { a[i] = x[q * 8 + i] * (1.f + c0[i]) + h0[i]; b[i] = x[q * 8 + 4 + i] * (1.f + c1[i]) + h1[i]; }
        *(u32x4*)(dst + 512 * q + 8 * lane) = pack8(a, b); }
}
__device__ __forceinline__ void p_ln1(const Frame& F, int l, bool last) {
    const float* mod = wsp<float>(F, WS_MOD) + (size_t)l * 5 * 12288; bf16_t* hb = wsp<bf16_t>(F, WS_HB);
    const float* g = F.in(18) + l * D; const float* b = F.in(19) + l * D;
    const int nrows = last ? NLAT : NROW; const int lane = F.lane, step = F.G * 8;
    float gg[32], bb[32]; ld_row_f32(g, lane, gg); ld_row_f32(b, lane, bb);
    int row = F.bid * 8 + F.wave;
    float yn[32];
    if (row < nrows) ld_row_f32(xres_row(F, row), lane, yn);
#pragma unroll 1
    for (; row < nrows; row += step) {
        const int v = row < NLAT ? (row >> 12) : 4; float* xp = xres_row(F, row);
        float y[32], sh[32], sc[32];
#pragma unroll
        for (int i = 0; i < 32; ++i) y[i] = yn[i];
        ld_row_f32(mod + (size_t)v * 12288 + 6144, lane, sh); ld_row_f32(mod + (size_t)v * 12288 + 8192, lane, sc);
        { const int nrow = row + step; if (nrow < nrows) ld_row_f32(xres_row(F, nrow), lane, yn); }
        float s = 0.f;
#pragma unroll
        for (int i = 0; i < 32; ++i) s += y[i];
        const float mu = wave_sum(s) * (1.f / 2048.f); float q = 0.f;
#pragma unroll
        for (int i = 0; i < 32; ++i) { const float d = y[i] - mu; q += d * d; }
        const float rstd = rsqrtf(wave_sum(q) * (1.f / 2048.f) + LN_EPS);
#pragma unroll
        for (int i = 0; i < 32; ++i) y[i] = (y[i] - mu) * rstd * gg[i] + bb[i];
        st_row_f32(xp, lane, y);
#pragma unroll
        for (int i = 0; i < 32; ++i) y[i] = y[i] * (1.f + sc[i]) + sh[i];
        st_row_bf16(hb + (size_t)row * D, lane, y);
    }
}

template <int NV>
__device__ __forceinline__ void top16(const float (&val)[NV], bool (&sel)[NV], int (&slot)[NV]) {
    unsigned key[NV];
#pragma unroll
    for (int v = 0; v < NV; ++v) { const unsigned u = __float_as_uint(val[v]); key[v] = (u & 0x80000000u) ? ~u : (u | 0x80000000u); }
    unsigned T = 0u;
#pragma unroll 1
    for (int bit = 31; bit >= 0; --bit) {
        const unsigned cand = T | (1u << bit); int cnt = 0;
#pragma unroll
        for (int v = 0; v < NV; ++v) cnt += __popcll(__ballot(key[v] >= cand));
        if (cnt >= 16) T = cand;
    }
    int ngt = 0;
#pragma unroll
    for (int v = 0; v < NV; ++v) ngt += __popcll(__ballot(key[v] > T));
    const int need = 16 - ngt;
    int run = 0, erun = 0;
#pragma unroll
    for (int v = 0; v < NV; ++v) {
        const unsigned long long mg = __ballot(key[v] > T), me = __ballot(key[v] == T);
        const int pg = __builtin_amdgcn_mbcnt_hi((unsigned)(mg >> 32), __builtin_amdgcn_mbcnt_lo((unsigned)mg, 0u));
        const int pe = __builtin_amdgcn_mbcnt_hi((unsigned)(me >> 32), __builtin_amdgcn_mbcnt_lo((unsigned)me, 0u));
        sel[v] = false; slot[v] = 0;
        if (key[v] > T) { sel[v] = true; slot[v] = run + pg; }
        else if (key[v] == T && (erun + pe) < need) { sel[v] = true; slot[v] = ngt + erun + pe; }
        run += __popcll(mg); erun += __popcll(me);
    }
}
__device__ __forceinline__ unsigned f2key(float f) { const unsigned u = __float_as_uint(f); return (u & 0x80000000u) ? ~u : (u | 0x80000000u); }
__device__ __forceinline__ float key2f(unsigned k) { return __uint_as_float((k & 0x80000000u) ? (k & 0x7fffffffu) : ~k); }
template <int NP, int NV>
__device__ __forceinline__ void bisect16(const unsigned (&key)[NP][NV], unsigned (&T)[NP]) {
    bool done[NP];
#pragma unroll
    for (int p = 0; p < NP; ++p) { T[p] = 0u; done[p] = false; }
#pragma unroll 1
    for (int bit = 31; bit >= 0; --bit) {
        const unsigned bm = 1u << bit; bool all = true;
#pragma unroll
        for (int p = 0; p < NP; ++p) {
            const unsigned cand = T[p] | bm; int cnt = 0;
#pragma unroll
            for (int v = 0; v < NV; ++v) cnt += __popcll(__ballot(key[p][v] >= cand));
            const bool upd = (cnt >= 16) && !done[p];
            T[p] = upd ? cand : T[p]; done[p] = done[p] || (cnt == 16); all = all && done[p];
        }
        if (all) break;
    }
}
template <int NV>
__device__ __forceinline__ void compact16(const unsigned (&key)[NV], const unsigned T, bool (&sel)[NV], int (&slot)[NV]) {
    int ngt = 0;
#pragma unroll
    for (int v = 0; v < NV; ++v) ngt += __popcll(__ballot(key[v] > T));
    const int need = 16 - ngt; int run = 0, erun = 0;
#pragma unroll
    for (int v = 0; v < NV; ++v) {
        const unsigned long long mg = __ballot(key[v] > T), me = __ballot(key[v] == T);
        const int pg = __builtin_amdgcn_mbcnt_hi((unsigned)(mg >> 32), __builtin_amdgcn_mbcnt_lo((unsigned)mg, 0u));
        const int pe = __builtin_amdgcn_mbcnt_hi((unsigned)(me >> 32), __builtin_amdgcn_mbcnt_lo((unsigned)me, 0u));
        sel[v] = false; slot[v] = 0;
        if (key[v] > T) { sel[v] = true; slot[v] = run + pg; }
        else if (key[v] == T && (erun + pe) < need) { sel[v] = true; slot[v] = ngt + erun + pe; }
        run += __popcll(mg); erun += __popcll(me);
    }
}
constexpr int KP = 68;
constexpr int PW_BYTES = 9344;
__device__ __forceinline__ float gelu_erf(float x) {
    const float z = fabsf(x) * 0.7071067811865476f; const float t = __builtin_amdgcn_rcpf(1.f + 0.3275911f * z);
    float p = 1.061405429f; p = p * t - 1.453152027f; p = p * t + 1.421413741f; p = p * t - 0.284496736f; p = p * t + 0.254829592f; p = p * t;
    const float er = 1.f - p * __expf(-z * z);
    return 0.5f * x * (1.f + (x < 0.f ? -er : er));
}
__device__ __forceinline__ float wave_max(float x) {
    x = row16_max(x);
    { auto r = __builtin_amdgcn_permlane16_swap(__float_as_uint(x), __float_as_uint(x), false, false); x = fmaxf(__uint_as_float(r[0]), __uint_as_float(r[1])); }
    { auto r = __builtin_amdgcn_permlane32_swap(__float_as_uint(x), __float_as_uint(x), false, false); x = fmaxf(__uint_as_float(r[0]), __uint_as_float(r[1])); }
    return x;
}
__device__ __forceinline__ void ld16_f32(const float* p, int lane, float (&x)[32]) {
#pragma unroll
    for (int q = 0; q < 2; ++q)
#pragma unroll
        for (int d = 0; d < 4; ++d) { const f32x4 a = *(const f32x4*)(p + 1024 * q + 16 * lane + 4 * d); x[q * 16 + d * 4 + 0] = a[0]; x[q * 16 + d * 4 + 1] = a[1]; x[q * 16 + d * 4 + 2] = a[2]; x[q * 16 + d * 4 + 3] = a[3]; }
}
__device__ __forceinline__ void ld16_f32_nt(const float* p, int lane, float (&x)[32]) {
#pragma unroll
    for (int q = 0; q < 2; ++q)
#pragma unroll
        for (int d = 0; d < 4; ++d) { const f32x4 a = __builtin_nontemporal_load((const f32x4*)(p + 1024 * q + 16 * lane + 4 * d)); x[q * 16 + d * 4 + 0] = a[0]; x[q * 16 + d * 4 + 1] = a[1]; x[q * 16 + d * 4 + 2] = a[2]; x[q * 16 + d * 4 + 3] = a[3]; }
}
__device__ __forceinline__ void st16_f32_nt(float* p, int lane, const float (&x)[32]) {
#pragma unroll
    for (int q = 0; q < 2; ++q)
#pragma unroll
        for (int d = 0; d < 4; ++d) __builtin_nontemporal_store((f32x4){x[q * 16 + d * 4 + 0], x[q * 16 + d * 4 + 1], x[q * 16 + d * 4 + 2], x[q * 16 + d * 4 + 3]}, (f32x4*)(p + 1024 * q + 16 * lane + 4 * d));
}
__device__ __forceinline__ void st16_f32(float* p, int lane, const float (&x)[32]) {
#pragma unroll
    for (int q = 0; q < 2; ++q)
#pragma unroll
        for (int d = 0; d < 4; ++d) *(f32x4*)(p + 1024 * q + 16 * lane + 4 * d) = (f32x4){x[q * 16 + d * 4 + 0], x[q * 16 + d * 4 + 1], x[q * 16 + d * 4 + 2], x[q * 16 + d * 4 + 3]};
}
__device__ __forceinline__ void ld16_bf16(const bf16_t* p, int lane, float (&x)[32]) {
#pragma unroll
    for (int q = 0; q < 2; ++q)
#pragma unroll
        for (int d = 0; d < 2; ++d) { const u32x4 w = *(const u32x4*)(p + 1024 * q + 16 * lane + 8 * d); float* o = &x[q * 16 + d * 8];
            o[0] = bflo(w.x); o[1] = bfhi(w.x); o[2] = bflo(w.y); o[3] = bfhi(w.y); o[4] = bflo(w.z); o[5] = bfhi(w.z); o[6] = bflo(w.w); o[7] = bfhi(w.w); }
}
__device__ __forceinline__ void st16_bf16(bf16_t* p, int lane, const float (&x)[32]) {
#pragma unroll
    for (int q = 0; q < 2; ++q)
#pragma unroll
        for (int d = 0; d < 2; ++d) { const float* o = &x[q * 16 + d * 8]; u32x4 w; w.x = cvt_pk_bf16(o[0], o[1]); w.y = cvt_pk_bf16(o[2], o[3]); w.z = cvt_pk_bf16(o[4], o[5]); w.w = cvt_pk_bf16(o[6], o[7]);
            *(u32x4*)(p + 1024 * q + 16 * lane + 8 * d) = w; }
}
constexpr int TBS = 1152;
__device__ __forceinline__ void ld_row_f32(int lane, const float* __restrict__ src, f32x4* a) {
#pragma unroll
    for (int q = 0; q < 2; ++q)
#pragma unroll
        for (int d = 0; d < 4; ++d) a[q * 4 + d] = __builtin_nontemporal_load((const f32x4*)(src + 1024 * q + 16 * lane + 4 * d));
}
__device__ __forceinline__ void cvt_row_fp4b(int lane, const f32x4* a, unsigned char* __restrict__ dst) {
    float x[32];
#pragma unroll
    for (int i = 0; i < 8; ++i) { x[i * 4 + 0] = a[i][0]; x[i * 4 + 1] = a[i][1]; x[i * 4 + 2] = a[i][2]; x[i * 4 + 3] = a[i][3]; }
    float am = 0.f;
#pragma unroll
    for (int i = 0; i < 32; ++i) am = fmaxf(am, fabsf(x[i]));
    const bf16_t sb = f2bf(am * (1.f / 6.f)); const float sf = bf2f(sb); const float sc = sf > 0.f ? __builtin_amdgcn_rcpf(sf) : 0.f;
    u32x4 w;
#pragma unroll
    for (int d = 0; d < 4; ++d) { unsigned t = 0u; const int o = (d >> 1) * 16 + (d & 1) * 8;
        t = __builtin_amdgcn_cvt_scalef32_pk_fp4_f32(t, x[o + 0] * sc, x[o + 1] * sc, 1.0f, 0); t = __builtin_amdgcn_cvt_scalef32_pk_fp4_f32(t, x[o + 2] * sc, x[o + 3] * sc, 1.0f, 1);
        t = __builtin_amdgcn_cvt_scalef32_pk_fp4_f32(t, x[o + 4] * sc, x[o + 5] * sc, 1.0f, 2); t = __builtin_amdgcn_cvt_scalef32_pk_fp4_f32(t, x[o + 6] * sc, x[o + 7] * sc, 1.0f, 3); w[d] = t; }
    *(u32x4*)(dst + 16 * lane) = w;
    *(bf16_t*)(dst + 1024 + 2 * lane) = sb;
}
__device__ __forceinline__ void cvt_row_fp4r(int lane, const float* __restrict__ src, unsigned char* __restrict__ dst, float* __restrict__ inv) {
    float x[32];
#pragma unroll
    for (int q = 0; q < 2; ++q)
#pragma unroll
        for (int d = 0; d < 4; ++d) { const f32x4 a = __builtin_nontemporal_load((const f32x4*)(src + 1024 * q + 16 * lane + 4 * d)); x[q * 16 + d * 4 + 0] = a[0]; x[q * 16 + d * 4 + 1] = a[1]; x[q * 16 + d * 4 + 2] = a[2]; x[q * 16 + d * 4 + 3] = a[3]; }
    float am = 0.f;
#pragma unroll
    for (int i = 0; i < 32; ++i) am = fmaxf(am, fabsf(x[i]));
    am = wave_max(am);
    const float sc = am > 0.f ? 6.f / am : 1.f;
    if (lane == 0) *inv = am > 0.f ? am * (1.f / 6.f) : 1.f;
    u32x4 w;
#pragma unroll
    for (int d = 0; d < 4; ++d) { unsigned t = 0u; const int o = (d >> 1) * 16 + (d & 1) * 8;
        t = __builtin_amdgcn_cvt_scalef32_pk_fp4_f32(t, x[o + 0] * sc, x[o + 1] * sc, 1.0f, 0); t = __builtin_amdgcn_cvt_scalef32_pk_fp4_f32(t, x[o + 2] * sc, x[o + 3] * sc, 1.0f, 1);
        t = __builtin_amdgcn_cvt_scalef32_pk_fp4_f32(t, x[o + 4] * sc, x[o + 5] * sc, 1.0f, 2); t = __builtin_amdgcn_cvt_scalef32_pk_fp4_f32(t, x[o + 6] * sc, x[o + 7] * sc, 1.0f, 3); w[d] = t; }
    *(u32x4*)(dst + 16 * lane) = w;
}
__device__ __forceinline__ void cvt_peer(const Frame& F, int l) {
    const int step = F.G * 8; int r = F.bid * 8 + F.wave;
    f32x4 cur[8], nxt[8];
    auto srcp = [&](int rr) { return (rr < 16384 ? F.in(23) : F.in(24)) + ((size_t)l * 16384 + (rr & 16383)) * 2048; };
    if (r < 32768) ld_row_f32(F.lane, srcp(r), cur);
    for (; r < 32768; r += step) {
        const int rn = r + step;
        if (rn < 32768) ld_row_f32(F.lane, srcp(rn), nxt);
        cvt_row_fp4b(F.lane, cur, wsp<unsigned char>(F, r < 16384 ? WS_PU : WS_PV) + (size_t)l * SZ_PT + (size_t)(r & 16383) * TBS);
#pragma unroll
        for (int i = 0; i < 8; ++i) cur[i] = nxt[i];
    }
}
#define PEER_G 4
template <int CTRL> __device__ __forceinline__ int dppi(int x) { return __builtin_amdgcn_update_dpp(0, x, CTRL, 0xF, 0xF, true); }
__device__ __forceinline__ int irow16_sum(int x) { x += dppi<0xB1>(x); x += dppi<0x4E>(x); x += dppi<0x141>(x); x += dppi<0x140>(x); return x; }
__device__ __forceinline__ int irow16_incl_scan(int x) { x += dppi<0x111>(x); x += dppi<0x112>(x); x += dppi<0x114>(x); x += dppi<0x118>(x); return x; }
constexpr int KBP = 72;
constexpr int PT_WORDS = 6 * 128 + 160 + 3 * 128;
constexpr int PWB = 2 * PT_WORDS * 4;
__device__ __forceinline__ void p_peer(const Frame& F, int l, bool last) {
    LAS bf16_t* kb1 = (LAS bf16_t*)F.lds; LAS bf16_t* kb2 = kb1 + 128 * KBP;
    LAS unsigned* wbase = (LAS unsigned*)(F.lds + 2 * 128 * KBP * 2 + F.wave * PWB);
    const int lane = F.lane, fr = lane & 15, fq = lane >> 4;
    __syncthreads();
    for (int i = F.tid; i < 128 * 64; i += 512) { const int r = i >> 6, d = i & 63; kb1[r * KBP + d] = f2bf(F.in(21)[(size_t)l * 8192 + i]); kb2[r * KBP + d] = f2bf(F.in(22)[(size_t)l * 8192 + i]); }
    __syncthreads();
    const bf16_t* QP = wsp<bf16_t>(F, WS_QP); const bf16_t* HB = wsp<bf16_t>(F, WS_HB); unsigned char* HB8w = wsp<unsigned char>(F, WS_HB8);
    const unsigned char* PU = wsp<unsigned char>(F, WS_PU) + (size_t)l * SZ_PT; const unsigned char* PV = wsp<unsigned char>(F, WS_PV) + (size_t)l * SZ_PT;
    const float* modl = wsp<float>(F, WS_MOD) + (size_t)l * 5 * 12288; const float* modn = wsp<float>(F, WS_MOD) + (size_t)(l + 1) * 5 * 12288;
    const float* g2n = F.in(25) + l * D; const float* b2n = F.in(26) + l * D;
    const int npairs = (last ? NLAT : NROW) / 2;
    const int per_wg = (npairs + F.G - 1) / F.G; const int p_lo = F.bid * per_wg; const int p_hi = (p_lo + per_wg) < npairs ? (p_lo + per_wg) : npairs;
    LAS int* wq = (LAS int*)(F.lds + 147456 - 32);
    if (F.tid == 0) *wq = 0;
    __syncthreads();
#pragma unroll 1
    for (;;) {
        int pi = 0; if (lane == 0) pi = __hip_atomic_fetch_add(wq, 1, __ATOMIC_RELAXED, __HIP_MEMORY_SCOPE_WORKGROUP);
        pi = p_lo + __builtin_amdgcn_readfirstlane(pi); if (pi >= p_hi) break;
        const int rowA = 2 * pi;
#pragma unroll 1
        for (int rep1_ = 0; rep1_ <= REP_PS1; ++rep1_) {
            unsigned kk[2][8][4];
            { int fr_ = fr; asm volatile("" : "+v"(fr_));
              const bf16_t* qrow = QP + (size_t)(rowA + (fr_ >> 3)) * 1024 + (fr_ & 7) * 128 + 8 * fq;
              bf16x8 af[2][2];
#pragma unroll
              for (int st = 0; st < 2; ++st)
#pragma unroll
                  for (int ks = 0; ks < 2; ++ks) af[st][ks] = *(const bf16x8*)(qrow + st * 64 + ks * 32);
#pragma unroll
              for (int st = 0; st < 2; ++st) { LAS bf16_t* kb = st ? kb2 : kb1;
#pragma unroll
                  for (int nb = 0; nb < 8; ++nb) { f32x4 c = {0.f, 0.f, 0.f, 0.f};
#pragma unroll
                      for (int ks = 0; ks < 2; ++ks) { const bf16x8 bfr = *(const LAS bf16x8*)(kb + (nb * 16 + fr) * KBP + ks * 32 + 8 * fq); c = __builtin_amdgcn_mfma_f32_16x16x32_bf16(af[st][ks], bfr, c, 0, 0, 0); }
#pragma unroll
                      for (int r = 0; r < 4; ++r) kk[st][nb][r] = f2key(c[r]); } } }
            unsigned T[2][4]; bool done[2][4];
#pragma unroll
            for (int st = 0; st < 2; ++st)
#pragma unroll
                for (int r = 0; r < 4; ++r) { T[st][r] = 0u; done[st][r] = false; }
#pragma unroll 1
            for (int bit = 31; bit >= 0; --bit) { const unsigned bm = 1u << bit; bool alld = true;
#pragma unroll
                for (int st = 0; st < 2; ++st)
#pragma unroll
                    for (int r = 0; r < 4; ++r) { const unsigned cand = T[st][r] | bm; int c = 0;
#pragma unroll
                        for (int nb = 0; nb < 8; ++nb) c += (kk[st][nb][r] >= cand) ? 1 : 0;
                        c = irow16_sum(c);
                        const bool upd = (c >= 16) && !done[st][r]; T[st][r] = upd ? cand : T[st][r]; done[st][r] = done[st][r] || (c == 16); alld = alld && done[st][r]; }
                if (__all(alld)) break; }
            const int tt = lane >> 5, hd0 = ((lane >> 4) & 1) * 4;
#pragma unroll
            for (int st = 0; st < 2; ++st)
#pragma unroll
                for (int r = 0; r < 4; ++r) { const unsigned Tr = T[st][r]; int g = 0, e = 0;
#pragma unroll
                    for (int nb = 0; nb < 8; ++nb) { g += (kk[st][nb][r] > Tr) ? 1 : 0; e += (kk[st][nb][r] == Tr) ? 1 : 0; }
                    int gpre = irow16_incl_scan(g) - g, epre = irow16_incl_scan(e) - e; const int ngt = irow16_sum(g); const int need = 16 - ngt;
                    LAS unsigned* tb = wbase + tt * PT_WORDS; LAS float* vl = (LAS float*)(tb + st * 128) + (hd0 + r) * 16; LAS int* il = (LAS int*)(tb + 256 + st * 128) + (hd0 + r) * 16;
#pragma unroll
                    for (int nb = 0; nb < 8; ++nb) { const unsigned k = kk[st][nb][r];
                        if (k > Tr) { vl[gpre] = key2f(k); il[gpre] = nb * 16 + fr; ++gpre; }
                        else if (k == Tr) { if (epre < need) { vl[ngt + epre] = key2f(k); il[ngt + epre] = nb * 16 + fr; } ++epre; } } }
        }
        asm volatile("s_waitcnt lgkmcnt(0)" ::: "memory");
        {
            const int tt = lane >> 5, hd0 = ((lane >> 4) & 1) * 4; LAS unsigned* tb = wbase + tt * PT_WORDS;
            unsigned ck[4][16];
#pragma unroll
            for (int r = 0; r < 4; ++r) { const float va = ((LAS float*)tb)[(hd0 + r) * 16 + fr]; const LAS float* v2p = (LAS float*)(tb + 128) + (hd0 + r) * 16;
#pragma unroll
                for (int j4 = 0; j4 < 4; ++j4) { const f32x4 vb = *(const LAS f32x4*)(v2p + j4 * 4);
#pragma unroll
                    for (int i = 0; i < 4; ++i) ck[r][j4 * 4 + i] = f2key(va + vb[i]); } }
            unsigned T[4]; bool done[4];
#pragma unroll
            for (int r = 0; r < 4; ++r) { T[r] = 0u; done[r] = false; }
#pragma unroll 1
            for (int bit = 31; bit >= 0; --bit) { const unsigned bm = 1u << bit; bool alld = true;
#pragma unroll
                for (int r = 0; r < 4; ++r) { const unsigned cand = T[r] | bm; int c = 0;
#pragma unroll
                    for (int j = 0; j < 16; ++j) c += (ck[r][j] >= cand) ? 1 : 0;
                    c = irow16_sum(c);
                    const bool upd = (c >= 16) && !done[r]; T[r] = upd ? cand : T[r]; done[r] = done[r] || (c == 16); alld = alld && done[r]; }
                if (__all(alld)) break; }
#pragma unroll
            for (int r = 0; r < 4; ++r) { const unsigned Tr = T[r]; int g = 0, e = 0;
#pragma unroll
                for (int j = 0; j < 16; ++j) { g += (ck[r][j] > Tr) ? 1 : 0; e += (ck[r][j] == Tr) ? 1 : 0; }
                int gpre = irow16_incl_scan(g) - g, epre = irow16_incl_scan(e) - e; const int ngt = irow16_sum(g); const int need = 16 - ngt;
                const int e1 = ((LAS int*)(tb + 256))[(hd0 + r) * 16 + fr] * 128; const LAS int* i2p = (LAS int*)(tb + 384) + (hd0 + r) * 16;
                LAS float* cs_ = (LAS float*)(tb + 512) + (hd0 + r) * 16; LAS int* ce_ = (LAS int*)(tb + 640) + (hd0 + r) * 16;
#pragma unroll
                for (int j = 0; j < 16; ++j) { const unsigned k = ck[r][j];
                    if (k > Tr) { cs_[gpre] = key2f(k); ce_[gpre] = e1 + i2p[j]; ++gpre; }
                    else if (k == Tr) { if (epre < need) { cs_[ngt + epre] = key2f(k); ce_[ngt + epre] = e1 + i2p[j]; } ++epre; } } }
        }
        asm volatile("s_waitcnt lgkmcnt(0)" ::: "memory");
#pragma unroll 1
      for (int t = 0; t < 2; ++t) {
        const int row = rowA + t; const int v = row < NLAT ? (row >> 12) : 4;
        LAS unsigned* tb = wbase + t * PT_WORDS;
        LAS float* v1l = (LAS float*)tb; LAS float* v2l = v1l + 128; LAS int* i1l = (LAS int*)(v2l + 128); LAS int* i2l = i1l + 128;
        LAS float* csl = (LAS float*)(i2l + 128); LAS int* cel = (LAS int*)(csl + 128); LAS int* el = cel + 128; LAS float* gl = (LAS float*)(el + 160); LAS float* su = gl + 128; LAS float* sv = su + 128;
        {
#pragma unroll
            for (int it = 0; it < 2; ++it) { const int idx = it * 64 + lane;
                const float sx = csl[idx]; const float mx = row16_max(sx); const float pe_ = __expf(sx - mx); const float sm = row16_sum(pe_);
                el[idx] = cel[idx]; gl[idx] = pe_ / sm; }
        }
        if (lane < 32) el[128 + lane] = el[0];
        asm volatile("s_waitcnt vmcnt(0) lgkmcnt(0)" ::: "memory");
        float hh[32]; ld16_bf16(HB + (size_t)row * D, lane, hh);
        f32x2 hh2[16];
#pragma unroll
        for (int i = 0; i < 16; ++i) hh2[i] = (f32x2){hh[2 * i], hh[2 * i + 1]};
        const bool b0_ = lane & 1, b1_ = lane & 2, b2_ = lane & 4;
        u32x4 A[8], B[8], C[8]; unsigned SA[8], SB[8], SC[8];
#define PEER_LOADT(buf, sbuf, tab, g) do { _Pragma("unroll") for (int x = 0; x < 8; ++x) { const int e = __builtin_amdgcn_readfirstlane(el[(g) * 8 + x]); const unsigned char* rp = (tab) + (size_t)e * TBS; \
            buf[x] = *(const u32x4*)(rp + 16 * lane); sbuf[x] = *(const bf16_t*)(rp + 1024 + 2 * lane); } } while (0)
#define PEER_LOADV(buf, g) do { _Pragma("unroll") for (int x = 0; x < 8; ++x) { const int e = __builtin_amdgcn_readfirstlane(el[(g) * 8 + x]); buf[x] = *(const u32x4*)(PV + (size_t)e * 1024 + 16 * lane); } } while (0)
#define FP4X8(w_, f0_, f1_, f2_, f3_) const f32x2 f0_ = __builtin_amdgcn_cvt_scalef32_pk_f32_fp4(w_, 1.0f, 0), f1_ = __builtin_amdgcn_cvt_scalef32_pk_f32_fp4(w_, 1.0f, 1), f2_ = __builtin_amdgcn_cvt_scalef32_pk_f32_fp4(w_, 1.0f, 2), f3_ = __builtin_amdgcn_cvt_scalef32_pk_f32_fp4(w_, 1.0f, 3)
#define PEER_DOT(buf, sbuf, g) do { float p_[8]; \
            _Pragma("unroll") for (int x = 0; x < 8; ++x) { f32x2 s2_ = {0.f, 0.f}; \
                _Pragma("unroll") for (int d = 0; d < 4; ++d) { const unsigned w_ = buf[x][d]; FP4X8(w_, f0_, f1_, f2_, f3_); const int o_ = (d >> 1) * 8 + (d & 1) * 4; \
                    s2_ = hh2[o_ + 0] * f0_ + s2_; s2_ = hh2[o_ + 1] * f1_ + s2_; s2_ = hh2[o_ + 2] * f2_ + s2_; s2_ = hh2[o_ + 3] * f3_ + s2_; } \
                p_[x] = (s2_.x + s2_.y) * __uint_as_float(sbuf[x] << 16); SBAR(); } \
              \
            float q_[4], r_[2]; \
            _Pragma("unroll") for (int j = 0; j < 4; ++j) { const float keep_ = b0_ ? p_[2 * j + 1] : p_[2 * j], send_ = b0_ ? p_[2 * j] : p_[2 * j + 1]; q_[j] = keep_ + dppf<0xB1>(send_); } \
            _Pragma("unroll") for (int j = 0; j < 2; ++j) { const float keep_ = b1_ ? q_[2 * j + 1] : q_[2 * j], send_ = b1_ ? q_[2 * j] : q_[2 * j + 1]; r_[j] = keep_ + dppf<0x4E>(send_); } \
            float t_; { const float keep_ = b2_ ? r_[1] : r_[0], send_ = b2_ ? r_[0] : r_[1]; const float up_ = dppf<0x104>(send_), dn_ = dppf<0x114>(send_); t_ = keep_ + (b2_ ? dn_ : up_); } \
            t_ += dppf<0x128>(t_); \
            { auto r16_ = __builtin_amdgcn_permlane16_swap(__float_as_uint(t_), __float_as_uint(t_), false, false); t_ = __uint_as_float(r16_[0]) + __uint_as_float(r16_[1]); } \
            { auto r32_ = __builtin_amdgcn_permlane32_swap(__float_as_uint(t_), __float_as_uint(t_), false, false); t_ = __uint_as_float(r32_[0]) + __uint_as_float(r32_[1]); } \
            const float av = gelu_erf(t_) * gl[(g) * 8 + (lane & 7)]; const bool me_ = (lane >> 3) == ((g) & 7); \
            avl = (me_ && (g) < 8) ? av : avl; avh = (me_ && (g) >= 8) ? av : avh; } while (0)
#define PIN_ACC() do { asm volatile("" : "+v"(acc2[0]), "+v"(acc2[1]), "+v"(acc2[2]), "+v"(acc2[3]), "+v"(acc2[4]), "+v"(acc2[5]), "+v"(acc2[6]), "+v"(acc2[7]), "+v"(acc2[8]), "+v"(acc2[9]), "+v"(acc2[10]), "+v"(acc2[11]), "+v"(acc2[12]), "+v"(acc2[13]), "+v"(acc2[14]), "+v"(acc2[15])); } while (0)
#define PEER_AXPY(buf, sbuf, g) do { _Pragma("unroll") for (int x = 0; x < 8; ++x) { const int idx = (g) * 8 + x; \
            const float av = __uint_as_float(__builtin_amdgcn_readlane(__float_as_uint(idx < 64 ? avl : avh), idx & 63)) * __uint_as_float(sbuf[x] << 16); const f32x2 av2_ = {av, av}; \
            _Pragma("unroll") for (int d = 0; d < 4; ++d) { const unsigned w_ = buf[x][d]; FP4X8(w_, f0_, f1_, f2_, f3_); const int o_ = (d >> 1) * 8 + (d & 1) * 4; \
                acc2[o_ + 0] = av2_ * f0_ + acc2[o_ + 0]; acc2[o_ + 1] = av2_ * f1_ + acc2[o_ + 1]; acc2[o_ + 2] = av2_ * f2_ + acc2[o_ + 2]; acc2[o_ + 3] = av2_ * f3_ + acc2[o_ + 3]; } PIN_ACC(); } } while (0)
        float avl = 0.f, avh = 0.f;
        PEER_LOADT(A, SA, PU, 0); PEER_LOADT(B, SB, PU, 1);
#pragma unroll 1
        for (int g = 0; g < 15; g += 3) { PEER_LOADT(C, SC, PU, g + 2); SBAR(); PEER_DOT(A, SA, g); SBAR(); PEER_LOADT(A, SA, PU, g + 3); SBAR(); PEER_DOT(B, SB, g + 1); SBAR(); PEER_LOADT(B, SB, PU, g + 4); SBAR(); PEER_DOT(C, SC, g + 2); SBAR(); }
        PEER_DOT(A, SA, 15); SBAR();
        f32x2 acc2[16];
#pragma unroll
        for (int i = 0; i < 16; ++i) acc2[i] = (f32x2){0.f, 0.f};
        float* xp = xres_row(F, row);
        PEER_LOADT(A, SA, PV, 0); PEER_LOADT(B, SB, PV, 1);
#pragma unroll 1
        for (int g = 0; g < 15; g += 3) { PEER_LOADT(C, SC, PV, g + 2); SBAR(); PEER_AXPY(A, SA, g); SBAR(); PEER_LOADT(A, SA, PV, g + 3); SBAR(); PEER_AXPY(B, SB, g + 1); SBAR(); PEER_LOADT(B, SB, PV, g + 4); SBAR(); PEER_AXPY(C, SC, g + 2); SBAR(); }
        float x1[32], g2[32]; ld16_f32(xp, lane, x1); ld16_f32(modl + (size_t)v * 12288 + 10240, lane, g2); SBAR();
        PEER_AXPY(A, SA, 15); SBAR();
#undef PEER_LOADT
#undef PEER_LOADV
#undef PEER_DOT
#undef PEER_AXPY
        float acc[32];
        {
#pragma unroll
          for (int i = 0; i < 32; ++i) acc[i] = ALPHA * x1[i] + g2[i] * acc2[i >> 1][i & 1]; }
        { float sm = 0.f;
#pragma unroll
          for (int i = 0; i < 32; ++i) sm += acc[i];
          const float mu = wave_sum(sm) * (1.f / 2048.f); float qq = 0.f;
#pragma unroll
          for (int i = 0; i < 32; ++i) { const float dd = acc[i] - mu; qq += dd * dd; }
          const float rstd = rsqrtf(wave_sum(qq) * (1.f / 2048.f) + LN_EPS);
#pragma unroll
          for (int q = 0; q < 2; ++q)
#pragma unroll
              for (int d = 0; d < 4; ++d) { const int o = 1024 * q + 16 * lane + 4 * d; const f32x4 gg = *(const f32x4*)(g2n + o), bb = *(const f32x4*)(b2n + o);
#pragma unroll
                  for (int i = 0; i < 4; ++i) acc[q * 16 + d * 4 + i] = (acc[q * 16 + d * 4 + i] - mu) * rstd * gg[i] + bb[i]; } }
        st16_f32(xp, lane, acc);
        if (!last) { const float* sh = modn + (size_t)v * 12288; const float* sc = sh + 2048;
#pragma unroll
            for (int q = 0; q < 2; ++q)
#pragma unroll
                for (int d = 0; d < 4; ++d) { const int o = 1024 * q + 16 * lane + 4 * d; const f32x4 hh4 = *(const f32x4*)(sh + o), cc4 = *(const f32x4*)(sc + o);
#pragma unroll
                    for (int i = 0; i < 4; ++i) acc[q * 16 + d * 4 + i] = clamp8(acc[q * 16 + d * 4 + i] * (1.f + cc4[i]) + hh4[i]); }
#pragma unroll
            for (int q = 0; q < 2; ++q) { u32x4 w;
#pragma unroll
                for (int d = 0; d < 4; ++d) w[d] = pk4_fp8(acc[q * 16 + d * 4 + 0], acc[q * 16 + d * 4 + 1], acc[q * 16 + d * 4 + 2], acc[q * 16 + d * 4 + 3]);
                *(u32x4*)(HB8w + (size_t)row * D + 1024 * q + 16 * lane) = w; } }
      }
    }
}
#ifdef DBG
constexpr size_t WS_DBG = WS_CTL + 131072;
constexpr int DBG_NS = 60;
__device__ __forceinline__ int dbg_row(int s) { return (s * 263 + 5) % NLAT; }
__global__ void __launch_bounds__(256) dbg_peer_pre(Args args, int l) {
    __shared__ float q[1024]; __shared__ float s1[128], s2[128]; __shared__ float v1[16], v2[16]; __shared__ int i1[16], i2[16]; __shared__ float cs[256]; __shared__ int ce[256];
    __shared__ float ts[16]; __shared__ int te[16]; __shared__ float red[256]; __shared__ float aval[128]; __shared__ int eid[128]; __shared__ float h2[2048];
    const int s = blockIdx.x, row = dbg_row(s), tid = threadIdx.x; unsigned char* ws = args.ws;
    const bf16_t* QP = (const bf16_t*)(ws + WS_QP); const bf16_t* HB = (const bf16_t*)(ws + WS_HB);
    float* dbgf = (float*)(ws + WS_DBG + 4096); int* dbge = (int*)(dbgf + DBG_NS * 2048); float* dbga = (float*)(dbge + DBG_NS * 128); float* dbgg = dbga + 3 * DBG_NS * 128;
    for (int i = tid; i < 1024; i += 256) q[i] = bf2f(QP[(size_t)row * 1024 + i]);
    for (int i = tid; i < 2048; i += 256) h2[i] = bf2f(HB[(size_t)row * D + i]);
    __syncthreads();
    const float* k1 = args.in[21] + (size_t)l * 8192; const float* k2 = args.in[22] + (size_t)l * 8192;
    for (int hd = 0; hd < 8; ++hd) {
        { const int k = tid & 127; const float* kk = (tid < 128 ? k1 : k2) + k * 64; const float* qq = q + hd * 128 + (tid < 128 ? 0 : 64); float a = 0.f; for (int d = 0; d < 64; ++d) a += qq[d] * kk[d]; (tid < 128 ? s1 : s2)[k] = a; }
        __syncthreads();
        { const int k = tid & 127; const float* sv = tid < 128 ? s1 : s2; const float me = sv[k]; int rank = 0; for (int j = 0; j < 128; ++j) rank += (sv[j] > me || (sv[j] == me && j < k)) ? 1 : 0;
          if (rank < 16) { (tid < 128 ? v1 : v2)[rank] = me; (tid < 128 ? i1 : i2)[rank] = k; } }
        __syncthreads();
        { const int i = tid >> 4, j = tid & 15; cs[tid] = v1[i] + v2[j]; ce[tid] = i1[i] * 128 + i2[j]; }
        __syncthreads();
        { const float me = cs[tid]; int rank = 0; for (int j = 0; j < 256; ++j) rank += (cs[j] > me || (cs[j] == me && j < tid)) ? 1 : 0; if (rank < 16) { ts[rank] = me; te[rank] = ce[tid]; } }
        __syncthreads();
        if (tid < 16) { float mx = ts[0]; float sm = 0.f; for (int j = 0; j < 16; ++j) sm += expf(ts[j] - mx); aval[hd * 16 + tid] = expf(ts[tid] - mx) / sm; eid[hd * 16 + tid] = te[tid]; dbgg[s * 128 + hd * 16 + tid] = aval[hd * 16 + tid]; }
        __syncthreads();
    }
    const float* U = args.in[23] + (size_t)l * 16384 * 2048; const float* V = args.in[24] + (size_t)l * 16384 * 2048;
    for (int e = 0; e < 128; ++e) { const float* ur = U + (size_t)eid[e] * 2048; float p = 0.f; for (int d = tid; d < 2048; d += 256) p += h2[d] * ur[d]; red[tid] = p; __syncthreads();
        for (int st = 128; st > 0; st >>= 1) { if (tid < st) red[tid] += red[tid + st]; __syncthreads(); }
        if (tid == 0) { const float sc = red[0]; aval[e] = 0.5f * sc * (1.f + erff(sc * 0.70710678f)) * aval[e]; } __syncthreads(); }
    float y[8]; const float* xr = args.out + (size_t)row * D; const int v = row >> 12; const float* mod = (const float*)(ws + WS_MOD) + (size_t)l * 5 * 12288 + (size_t)v * 12288;
    float sum = 0.f;
    for (int k = 0; k < 8; ++k) { const int d = tid + 256 * k; float o = 0.f; for (int e = 0; e < 128; ++e) o += aval[e] * V[(size_t)eid[e] * 2048 + d]; y[k] = ALPHA * xr[d] + mod[10240 + d] * o; sum += y[k]; }
    red[tid] = sum; __syncthreads(); for (int st = 128; st > 0; st >>= 1) { if (tid < st) red[tid] += red[tid + st]; __syncthreads(); } const float mu = red[0] / 2048.f; __syncthreads();
    float sq = 0.f; for (int k = 0; k < 8; ++k) sq += (y[k] - mu) * (y[k] - mu);
    red[tid] = sq; __syncthreads(); for (int st = 128; st > 0; st >>= 1) { if (tid < st) red[tid] += red[tid + st]; __syncthreads(); } const float rstd = rsqrtf(red[0] / 2048.f + LN_EPS);
    for (int k = 0; k < 8; ++k) { const int d = tid + 256 * k; dbgf[(size_t)s * 2048 + d] = (y[k] - mu) * rstd * args.in[25][l * D + d] + args.in[26][l * D + d]; }
    if (tid < 128) { dbge[s * 128 + tid] = eid[tid]; dbga[s * 128 + tid] = aval[tid]; }
}
__global__ void __launch_bounds__(256) dbg_peer_post(Args args) {
    __shared__ int bad_e, bad_x, bad_a, bad_g;
    const int s = blockIdx.x, row = dbg_row(s), tid = threadIdx.x; unsigned char* ws = args.ws; unsigned* cnt = (unsigned*)(ws + WS_DBG);
    float* dbgf = (float*)(ws + WS_DBG + 4096); int* dbge = (int*)(dbgf + DBG_NS * 2048); float* dbga = (float*)(dbge + DBG_NS * 128);
    int* fe = (int*)(dbga + DBG_NS * 128); float* fa = (float*)(fe + DBG_NS * 128); float* dbgg = dbga + 3 * DBG_NS * 128; float* fg = dbgg + DBG_NS * 128;
    if (tid == 0) { bad_e = 0; bad_x = 0; bad_a = 0; bad_g = 0; } __syncthreads();
    if (tid < 128) { const int hd = tid >> 4; const int e = dbge[s * 128 + tid]; bool found = false; float af = 0.f, gf = 0.f; for (int j = 0; j < 16; ++j) if (fe[s * 128 + hd * 16 + j] == e) { found = true; af = fa[s * 128 + hd * 16 + j]; gf = fg[s * 128 + hd * 16 + j]; }
        if (!found) atomicAdd(&bad_e, 1); else { const float ea = dbga[s * 128 + tid]; if (fabsf(af - ea) > 0.02f * fabsf(ea) + 2e-3f) atomicAdd(&bad_a, 1); const float eg = dbgg[s * 128 + tid]; if (fabsf(gf - eg) > 0.02f * fabsf(eg) + 1e-3f) atomicAdd(&bad_g, 1); } }
    for (int k = 0; k < 8; ++k) { const int d = tid + 256 * k; const float ex = dbgf[(size_t)s * 2048 + d], got = args.out[(size_t)row * D + d]; if (!(fabsf(got - ex) <= 0.03f + 0.03f * fabsf(ex))) atomicAdd(&bad_x, 1); }
    __syncthreads();
    if (tid == 0) { if (bad_e > 2) atomicAdd(&cnt[1], 1u); if (bad_g > 2) atomicAdd(&cnt[2], 1u); if (bad_a > 2) atomicAdd(&cnt[3], 1u); if (bad_x > 8) atomicAdd(&cnt[4], 1u); }
}
__global__ void dbg_report(Args args) {
    unsigned* cnt = (unsigned*)(args.ws + WS_DBG);
    float code = 0.f;
    for (int lv = 1; lv <= 9; ++lv) if (cnt[lv]) { int tenths = (int)(cnt[lv] * 10 / DBG_NS); if (tenths > 9) tenths = 9; code = 1000.f * lv + 100.f * tenths; break; }
    if (code != 0.f) for (int i = threadIdx.x; i < 4096; i += blockDim.x) args.out[i] = code;
}
#endif
template <int ABL>
__device__ __forceinline__ void p_attn_gqa(const Frame& F, int last) {
    LAS unsigned char* lds = F.lds;
    const unsigned char* QG = wsp<unsigned char>(F, WS_QG); const unsigned char* KG = wsp<unsigned char>(F, WS_KG); const unsigned char* VG = wsp<unsigned char>(F, WS_VG); unsigned char* OAB = wsp<unsigned char>(F, WS_OAB);
    const int nlat = NB * 8 * 16, nall = last ? nlat : nlat + NB * 8;
    for (int u = F.bid; u < nall; u += F.G) {
        int bh, q0, seq; size_t orow;
        if (u < nlat) {
            int uu = u;
            if (F.G == 256) {
                const int c = u & 255, i = u >> 8, xcd = c & 7, r = c >> 3, kvg = i * 4 + (xcd >> 1), within = (xcd & 1) * 32 + r;
                uu = (((kvg >> 1) * 8 + (kvg & 1) * 4 + (within >> 4)) << 4) | (within & 15); }
            bh = uu >> 4; const int qb = uu & 15; q0 = CTXL + qb * 256; seq = TT; orow = (size_t)(bh >> 3) * SEQ + qb * 256; }
        else { bh = u - nlat; q0 = 0; seq = CTXL; orow = (size_t)NLAT + (bh >> 3) * CTXL; }
        const int b = bh >> 3, h = bh & 7; const size_t kvo = (size_t)(b * 2 + (h >> 2)) * TT * 128;
        __syncthreads();
        att::attn_body<4, 0, ABL>(QG + ((size_t)bh * TT + q0) * 128, KG + kvo, VG + (size_t)(b * 2 + (h >> 2)) * 128 * TT, OAB + orow * D + 1024 + h * 128, seq, lds, F.tid);
    }
    __syncthreads();
}
template <int ABL>
__device__ __forceinline__ void p_attn_mla(const Frame& F, int last) {
    LAS unsigned char* lds = F.lds;
    const unsigned char* QM = wsp<unsigned char>(F, WS_QM); const unsigned char* KM = wsp<unsigned char>(F, WS_KM); const unsigned char* VM = wsp<unsigned char>(F, WS_VM); unsigned char* OAB = wsp<unsigned char>(F, WS_OAB);
    const int nlat = NB * 8 * 16, nall = last ? nlat : nlat + NB * 8;
    for (int u = F.bid; u < nall; u += F.G) {
        int bh, q0, seq; size_t orow;
        if (u < nlat) {
            int uu = u;
            if (F.G == 256) { const int c = u & 255, i = u >> 8, xcd = c & 7, r = c >> 3; uu = ((i * 16 + xcd * 2 + (r >> 4)) << 4) | (r & 15); }
            bh = uu >> 4; const int qb = uu & 15; q0 = CTXL + qb * 256; seq = TT; orow = (size_t)(bh >> 3) * SEQ + qb * 256; }
        else { bh = u - nlat; q0 = 0; seq = CTXL; orow = (size_t)NLAT + (bh >> 3) * CTXL; }
        const int h = bh & 7;
        __syncthreads();
        att::attn_body<2, 1, ABL>(QM + ((size_t)bh * TT + q0) * 128, KM + (size_t)bh * TT * 128, VM + (size_t)bh * 64 * TT, OAB + orow * D + h * 64, seq, lds, F.tid);
    }
    __syncthreads();
}
__device__ __forceinline__ void p_ret_out(const Frame& F, int l, int last) {
    const int c_lo = last ? 2 : 0, nc = 34 - c_lo, nu = NB * 8 * nc;
    for (int u = F.bid; u < nu; u += F.G) { const int bh = u / nc, c = c_lo + (u % nc); ret_out_unit(F, l, bh, c); }
    __syncthreads();
}

constexpr int LDS_BYTES = 147456;
constexpr int MISC_OFF = 147456 - 64;
constexpr int NPHASE = 22;
#ifndef PHM
#define PHM 0xFFFF
#endif
#ifndef PH_ATTR
#define PH_ATTR __forceinline__
#endif
template <int PART> __device__ PH_ATTR void ph_prologue(ArgP ap) { const Frame F = make_frame(ap); p0_prologue<PART>(F); }
__device__ PH_ATTR void ph_modreduce(ArgP ap) { const Frame F = make_frame(ap); p1_modreduce(F); }
__device__ PH_ATTR void ph_modulate0(ArgP ap) { const Frame F = make_frame(ap); p_modulate0(F); }
template <int GABL> __device__ PH_ATTR void ph_gemm_in(ArgP ap, int l) { const Frame F = make_frame(ap);
    pg8::Gemm g{wsp<bf16_t>(F, WS_HB8), wsp<bf16_t>(F, WS_WIN + l * SZ_WIN), NROW, NPT, 1024, 1024, 1024}; pg8::StaticOrder S; S.init(NROW, NPT, F.G, F.bid);
    float mul_, inv_; fp8_scale(wsp<unsigned>(F, WS_WSC)[l], mul_, inv_);
    EpiIn E{wsp<bf16_t>(F, WS_P1), wsp<bf16_t>(F, WS_G), inv_};
    pg8::gemm_phase<EpiIn, pg8::StaticOrder, GABL>(F.lds, F.tid, g, S, E); }
__device__ PH_ATTR void ph_post(ArgP ap, int l) { const Frame F = make_frame(ap); p_post(F, l); if (l == 1) cvt_peer(F, 1); }
__device__ PH_ATTR void ph_qup(ArgP ap, int l) { const Frame F = make_frame(ap);
    pg8::Gemm g{wsp<bf16_t>(F, WS_CQN), wsp<bf16_t>(F, WS_WQUP + l * SZ_WQUP), NROW, 768, 512, 512, 512}; pg8::StaticOrder S; S.init(NROW, 768, F.G, F.bid);
    EpiQup E{wsp<unsigned char>(F, WS_QM), wsp<f32x2>(F, WS_ROPE32)};
    pg8::gemm_phase<EpiQup, pg8::StaticOrder>(F.lds, F.tid, g, S, E); }
__device__ PH_ATTR void ph_kvup(ArgP ap, int l) { const Frame F = make_frame(ap);
    pg8::Gemm g{wsp<bf16_t>(F, WS_CKVN), wsp<bf16_t>(F, WS_WKVUP + l * SZ_WKVUP), NROW, 1024, 256, 256, 256}; pg8::StaticOrder S; S.init(NROW, 1024, F.G, F.bid);
    EpiKvup E{wsp<unsigned char>(F, WS_KM), wsp<unsigned char>(F, WS_VM)};
    pg8::gemm_phase<EpiKvup, pg8::StaticOrder>(F.lds, F.tid, g, S, E); }
__device__ PH_ATTR void ph_states(ArgP ap, int l) { const Frame F = make_frame(ap); p_ret_states(F, l); }
template <int ABL> __device__ PH_ATTR void ph_attn_gqa(ArgP ap, int last) { const Frame F = make_frame(ap); p_attn_gqa<ABL>(F, last); }
template <int ABL> __device__ PH_ATTR void ph_attn_mla(ArgP ap, int last) { const Frame F = make_frame(ap); p_attn_mla<ABL>(F, last); }
__device__ PH_ATTR void ph_ret_out(ArgP ap, int l, int last) { const Frame F = make_frame(ap); p_ret_out(F, l, last); }
template <int SEG> __device__ PH_ATTR void ph_merge(ArgP ap, int l, int Mx) { const Frame F = make_frame(ap);
    const bf16_t* OAB = wsp<bf16_t>(F, WS_OAB); bf16_t* MB = wsp<bf16_t>(F, WS_MB); const bf16_t* G = wsp<bf16_t>(F, WS_G);
    pg8::StaticOrder S; S.init(Mx, 2048, F.G, F.bid);
    const size_t wo = SEG == 0 ? WS_WBRA + l * SZ_WBRA : (SEG == 1 ? WS_WBRB + l * SZ_WBRB : WS_WBRC + l * SZ_WBRC); const int K = SEG == 2 ? 1024 : 512;
    pg8::Gemm g{OAB + SEG * 512, wsp<bf16_t>(F, wo), Mx, 2048, K, 2048, K}; EpiMerge<SEG> E{MB, G, wsp<unsigned char>(F, WS_MB8)}; pg8::gemm_phase<EpiMerge<SEG>, pg8::StaticOrder>(F.lds, F.tid, g, S, E); }
__device__ PH_ATTR void ph_merge3(ArgP ap, int l, int Mx) { const Frame F = make_frame(ap);
    pg8::StaticOrder S; S.init(Mx, 2048, F.G, F.bid);
    float m0_, i0_, m1_, i1_, m2_, i2_; fp8_scale(wsp<unsigned>(F, WS_WSC)[4 + l], m0_, i0_); fp8_scale(wsp<unsigned>(F, WS_WSC)[6 + l], m1_, i1_); fp8_scale(wsp<unsigned>(F, WS_WSC)[8 + l], m2_, i2_);
    pg8::Merge3 g{wsp<bf16_t>(F, WS_OAB), wsp<bf16_t>(F, WS_WBRA + l * SZ_WBRA), wsp<bf16_t>(F, WS_WBRB + l * SZ_WBRB), wsp<bf16_t>(F, WS_WBRC + l * SZ_WBRC), wsp<bf16_t>(F, WS_G), wsp<unsigned char>(F, WS_MB8), i0_ * m1_, i1_ * m2_, i2_};
    pg8::gemm_merge3<pg8::StaticOrder>(F.lds, F.tid, g, S); }
__device__ PH_ATTR void ph_out(ArgP ap, int l, int Mx) { const Frame F = make_frame(ap);
    pg8::Gemm g{wsp<bf16_t>(F, WS_MB8), wsp<bf16_t>(F, WS_WOUT + l * SZ_WOUT), Mx, 2048, 1024, 1024, 1024}; pg8::StaticOrder S; S.init(Mx, 2048, F.G, F.bid);
    float mul_, inv_; fp8_scale(wsp<unsigned>(F, WS_WSC)[2 + l], mul_, inv_);
    EpiOut E{l == 0 ? F.in(0) : F.out, l == 0 ? F.in(2) : wsp<float>(F, WS_XC), F.out, wsp<float>(F, WS_XC), wsp<float>(F, WS_MOD) + (size_t)l * 5 * 12288 + 4096, inv_ * (1.f / 16.f)};
    pg8::gemm_phase<EpiOut, pg8::StaticOrder>(F.lds, F.tid, g, S, E); }
__device__ PH_ATTR void ph_ln1(ArgP ap, int l, int last) { const Frame F = make_frame(ap); p_ln1(F, l, last); }
__device__ PH_ATTR void ph_peerq(ArgP ap, int l, int Mx) { const Frame F = make_frame(ap);
    pg8::Gemm g{wsp<bf16_t>(F, WS_HB), wsp<bf16_t>(F, WS_WPQ + l * SZ_WPQ), Mx, 1024, 2048, 2048, 2048}; pg8::StaticOrder S; S.init(Mx, 1024, F.G, F.bid);
    EpiPlain E{wsp<bf16_t>(F, WS_QP), 1024};
    pg8::gemm_phase<EpiPlain, pg8::StaticOrder>(F.lds, F.tid, g, S, E); }
__device__ PH_ATTR void ph_peer(ArgP ap, int l, int last) { const Frame F = make_frame(ap); p_peer(F, l, last); }

__global__ void __launch_bounds__(512, 2) mega_fwd(Args args) {
    extern __shared__ __attribute__((aligned(16))) unsigned char lds_raw[];
    const ArgP ap = (ArgP)__builtin_amdgcn_kernarg_segment_ptr();
    const int lo = ap->ph_lo, hi = ap->ph_hi;
    volatile LAS unsigned* misc = (volatile LAS unsigned*)((LAS unsigned char*)lds_raw + MISC_OFF);
    if (threadIdx.x < 4) misc[threadIdx.x] = 0u;
    __syncthreads();
    XcdBarrier bar; bar.bar = (unsigned*)(ap->ws + WS_CTL); bar.x = 0; bar.st = misc;
    if (hi - lo > 1) bar = xcd_barrier_post((unsigned*)(ap->ws + WS_CTL), misc);
#ifdef BENCH_K
    { float a[16]; f32x2 b2[8];
#pragma unroll
      for (int i = 0; i < 16; ++i) a[i] = 1.f + threadIdx.x * 1e-3f + i;
#pragma unroll
      for (int i = 0; i < 8; ++i) b2[i] = (f32x2){a[i], a[i + 8]};
      float c0 = a[3], c1 = a[5];
#define B16(INS) asm volatile(INS(0) INS(1) INS(2) INS(3) INS(4) INS(5) INS(6) INS(7) INS(8) INS(9) INS(10) INS(11) INS(12) INS(13) INS(14) INS(15) \
        : "+v"(a[0]), "+v"(a[1]), "+v"(a[2]), "+v"(a[3]), "+v"(a[4]), "+v"(a[5]), "+v"(a[6]), "+v"(a[7]), "+v"(a[8]), "+v"(a[9]), "+v"(a[10]), "+v"(a[11]), "+v"(a[12]), "+v"(a[13]), "+v"(a[14]), "+v"(a[15]) : "v"(c0), "v"(c1))
#define I_ADD(i) "v_add_f32 %" #i ", %" #i ", %16\n"
#define I_EXP(i) "v_exp_f32 %" #i ", %" #i "\n"
#define I_MAX3(i) "v_max3_f32 %" #i ", %" #i ", %16, %17\n"
#define I_CVT(i) "v_cvt_pk_fp8_f32 %" #i ", %16, %17\n"
#define I_DEP(i) "v_max3_f32 %0, %0, %16, %17\n"
#define I_DEPA(i) "v_add_f32 %0, %0, %16\n"
#define I_FMA(i) "v_fma_f32 %" #i ", %" #i ", %16, %17\n"
#define P8(INS) asm volatile(INS(0) INS(1) INS(2) INS(3) INS(4) INS(5) INS(6) INS(7) INS(0) INS(1) INS(2) INS(3) INS(4) INS(5) INS(6) INS(7) \
        : "+v"(b2[0]), "+v"(b2[1]), "+v"(b2[2]), "+v"(b2[3]), "+v"(b2[4]), "+v"(b2[5]), "+v"(b2[6]), "+v"(b2[7]) : "v"(b2[0]))
#define I_PKADD(i) "v_pk_add_f32 %" #i ", %" #i ", %8\n"
#define I_PKFMA(i) "v_pk_fma_f32 %" #i ", %" #i ", %8, %8\n"
#pragma unroll 1
      for (int it = 0; it < 20000; ++it) {
#if BENCH_K == 1
        B16(I_ADD);
#elif BENCH_K == 2
        B16(I_EXP);
#elif BENCH_K == 3
        B16(I_MAX3);
#elif BENCH_K == 4
        B16(I_CVT);
#elif BENCH_K == 5
        P8(I_PKADD);
#elif BENCH_K == 6
        P8(I_PKFMA);
#elif BENCH_K == 7
        B16(I_FMA);
#elif BENCH_K == 9
        B16(I_DEP);
#elif BENCH_K == 10
        B16(I_DEPA);
#endif
      }
#if BENCH_K == 11 || BENCH_K == 12
      { f32x16 q0 = {}, q1 = {}, q2 = {}, q3 = {}; att::i32x8a x8 = {1, 2, 3, 4, 5, 6, 7, (int)threadIdx.x};
#pragma unroll 1
        for (int it = 0; it < 2000; ++it) {
#pragma unroll
          for (int k = 0; k < 4; ++k) {
            q0 = __builtin_amdgcn_mfma_scale_f32_32x32x64_f8f6f4(x8, x8, q0, 0, 0, 0, 0x7F7F7F7F, 0, 0x7F7F7F7F); asm volatile("" : "+v"(q0));
#if BENCH_K == 11
            B16(I_ADD);
#else
            B16(I_EXP);
#endif
            q1 = __builtin_amdgcn_mfma_scale_f32_32x32x64_f8f6f4(x8, x8, q1, 0, 0, 0, 0x7F7F7F7F, 0, 0x7F7F7F7F); asm volatile("" : "+v"(q1));
#if BENCH_K == 11
            B16(I_ADD);
#else
            B16(I_EXP);
#endif
            q2 = __builtin_amdgcn_mfma_scale_f32_32x32x64_f8f6f4(x8, x8, q2, 0, 0, 0, 0x7F7F7F7F, 0, 0x7F7F7F7F); asm volatile("" : "+v"(q2));
#if BENCH_K == 11
            B16(I_ADD);
#else
            B16(I_EXP);
#endif
            q3 = __builtin_amdgcn_mfma_scale_f32_32x32x64_f8f6f4(x8, x8, q3, 0, 0, 0, 0x7F7F7F7F, 0, 0x7F7F7F7F); asm volatile("" : "+v"(q3));
#if BENCH_K == 11
            B16(I_ADD);
#else
            B16(I_EXP);
#endif
          }
          asm volatile("" : "+v"(x8)); } }
#endif
#if BENCH_K == 8
      { f32x16 q0 = {}, q1 = {}, q2 = {}, q3 = {}; att::i32x8a x8 = {1, 2, 3, 4, 5, 6, 7, (int)threadIdx.x};
#pragma unroll 1
        for (int it = 0; it < 2000; ++it) {
#pragma unroll
          for (int k = 0; k < 4; ++k) { q0 = __builtin_amdgcn_mfma_scale_f32_32x32x64_f8f6f4(x8, x8, q0, 0, 0, 0, 0x7F7F7F7F, 0, 0x7F7F7F7F); q1 = __builtin_amdgcn_mfma_scale_f32_32x32x64_f8f6f4(x8, x8, q1, 0, 0, 0, 0x7F7F7F7F, 0, 0x7F7F7F7F);
            q2 = __builtin_amdgcn_mfma_scale_f32_32x32x64_f8f6f4(x8, x8, q2, 0, 0, 0, 0x7F7F7F7F, 0, 0x7F7F7F7F); q3 = __builtin_amdgcn_mfma_scale_f32_32x32x64_f8f6f4(x8, x8, q3, 0, 0, 0, 0x7F7F7F7F, 0, 0x7F7F7F7F); }
          asm volatile("" : "+v"(q0), "+v"(q1), "+v"(q2), "+v"(q3), "+v"(x8)); } }
#endif
    }
#endif
#define IN(k) (lo <= (k) && (k) < hi)
#define SEAM(k) do { if (IN(k) && IN((k) + 1)) xcd_barrier(bar); } while (0)
    if (IN(0)) { if (PHM & 1) ph_prologue<7>(ap); if (REP_PRO) ph_prologue<REP_PRO>(ap); } SEAM(0);
    if (IN(1)) { if (PHM & 2) ph_modreduce(ap); if (REP_X & 32) ph_modreduce(ap); } SEAM(1);
#pragma unroll 1
    for (int l = 0; l < 2; ++l) {
        const int pb = 2 + 10 * l; const int last = (l == 1);
        const int Mx = last ? NLAT : NROW;
        if (l == 0) { if (IN(pb)) { if (PHM & 4) ph_modulate0(ap); if (REP_X & 64) ph_modulate0(ap); } SEAM(pb); }
        if (IN(pb + 1)) { if (REP_GIN) ph_gemm_in<GIN_ABL>(ap, l); if (PHM & 8) ph_gemm_in<0>(ap, l); } SEAM(pb + 1);
        if (IN(pb + 2)) { if (PHM & 16) ph_post(ap, l); if (REP_X & 1) ph_post(ap, l); } SEAM(pb + 2);
        if (IN(pb + 3)) { if (PHM & 32) ph_qup(ap, l); if (PHM & 64) ph_kvup(ap, l); if (PHM & 128) ph_states(ap, l); if (REP_X & 2) { ph_qup(ap, l); ph_kvup(ap, l); ph_states(ap, l); } } SEAM(pb + 3);
        if (IN(pb + 4)) { if (REP_ATTN & 1) ph_attn_gqa<ATT_ABL>(ap, last); if (REP_ATTN & 2) ph_attn_mla<ATT_ABL>(ap, last); if (PHM & 256) ph_attn_gqa<0>(ap, last); if (PHM & 512) ph_attn_mla<0>(ap, last); if (REP_X & 4) ph_ret_out(ap, l, last); if (PHM & 1024) ph_ret_out(ap, l, last); } SEAM(pb + 4);
        if (IN(pb + 5)) { if (PHM & 2048) { if (MERGE3) ph_merge3(ap, l, Mx); else { ph_merge<0>(ap, l, Mx); ph_merge<1>(ap, l, Mx); ph_merge<2>(ap, l, Mx); } } if (REP_X & 8) { if (MERGE3) ph_merge3(ap, l, Mx); else { ph_merge<0>(ap, l, Mx); ph_merge<1>(ap, l, Mx); ph_merge<2>(ap, l, Mx); } } } SEAM(pb + 5);
        if (IN(pb + 6)) { if (PHM & 4096) ph_out(ap, l, Mx); } SEAM(pb + 6);
        if (IN(pb + 7)) { if (PHM & 8192) ph_ln1(ap, l, last); } SEAM(pb + 7);
        if (IN(pb + 8)) { if (PHM & 16384) ph_peerq(ap, l, Mx); if (REP_X & 16) ph_peerq(ap, l, Mx); } SEAM(pb + 8);
        if (IN(pb + 9)) { if (PHM & 32768) ph_peer(ap, l, last); } SEAM(pb + 9);
    }
#undef IN
#undef SEAM
}

extern "C" void kernel_launch(void* const* d_in, const int* in_sizes, int n_in, void* d_out, int out_size, void* d_ws, size_t ws_size, hipStream_t stream) {
    static int grid = 0;
    if (grid == 0) {
        if (n_in != 27 || out_size != NLAT * D || ws_size < WS_END) { fprintf(stderr, "kernel_launch: unexpected shapes: n_in %d out %d ws %zu (need %zu)\n", n_in, out_size, ws_size, (size_t)WS_END); grid = -1; return; }
        int dev = 0, cus = 0, per_cu = 0;
        if (hipGetDevice(&dev) != hipSuccess || hipDeviceGetAttribute(&cus, hipDeviceAttributeMultiprocessorCount, dev) != hipSuccess) { grid = -1; return; }
        if (hipFuncSetAttribute((const void*)mega_fwd, hipFuncAttributeMaxDynamicSharedMemorySize, LDS_BYTES) != hipSuccess) { fprintf(stderr, "kernel_launch: hipFuncSetAttribute failed\n"); grid = -1; return; }
        if (hipOccupancyMaxActiveBlocksPerMultiprocessor(&per_cu, (const void*)mega_fwd, 512, LDS_BYTES) != hipSuccess || per_cu < 1) fprintf(stderr, "kernel_launch: occupancy query reports %d\n", per_cu);
        (void)hipGetLastError();
        grid = cus;
    }
    if (grid < 0) return;
    (void)hipMemsetAsync((char*)d_ws + WS_CTL, 0, 65536, stream);
#ifdef DBG
    (void)hipMemsetAsync((char*)d_ws + WS_CTL + 131072, 0, 4096, stream);
#endif
    Args a{};
    for (int i = 0; i < 27; ++i) a.in[i] = (const float*)d_in[i];
    a.out = (float*)d_out; a.ws = (unsigned char*)d_ws;
#if MK_PER_PHASE
    for (int p = 0; p < NPHASE; ++p) { if (p == 12) continue; a.ph_lo = p; a.ph_hi = p + 1;
#ifdef DBG
        if (p == 11) hipLaunchKernelGGL(dbg_peer_pre, dim3(DBG_NS), dim3(256), 0, stream, a, 0);
#endif
        hipLaunchKernelGGL(mega_fwd, dim3(grid), dim3(512), LDS_BYTES, stream, a);
#ifdef DBG
        if (p == 11) hipLaunchKernelGGL(dbg_peer_post, dim3(DBG_NS), dim3(256), 0, stream, a);
#endif
    }
#ifdef DBG
    hipLaunchKernelGGL(dbg_report, dim3(1), dim3(256), 0, stream, a);
#endif
#else
    a.ph_lo = 0; a.ph_hi = NPHASE;
    hipLaunchKernelGGL(mega_fwd, dim3(grid), dim3(512), LDS_BYTES, stream, a);
#endif
    const hipError_t le = hipPeekAtLastError();
    if (le != hipSuccess) fprintf(stderr, "kernel_launch: launch failed: %s\n", hipGetErrorName(le));
}
```

```cpp
#include <hip/hip_runtime.h>
#include <cstdio>
#include <cstdint>
#include <cstddef>

#ifndef MK_PER_PHASE
#define MK_PER_PHASE 0
#endif

#ifndef ABL_PEER
#define ABL_PEER 0
#endif
#ifndef REP_PEERG
#define REP_PEERG 0
#endif
#ifndef REP_PEERH
#define REP_PEERH 0
#endif
#ifndef REP_X
#define REP_X 0
#endif
#ifndef REP_PS1
#define REP_PS1 0
#endif
#ifndef REP_PS2
#define REP_PS2 0
#endif
#ifndef SIDE_ON
#define SIDE_ON 1
#endif
#ifndef REP_DOT
#define REP_DOT 0
#endif
#ifndef MERGE3
#define MERGE3 1
#endif
#ifndef REP_GIN
#define REP_GIN 0
#endif
#ifndef GIN_ABL
#define GIN_ABL 0
#endif
#ifndef ATT_ABL
#define ATT_ABL 0
#endif
#ifndef REP_ATTN
#define REP_ATTN 0
#endif
#ifndef REP_PRO
#define REP_PRO 0
#endif
#ifndef ABL_BR
#define ABL_BR 0
#endif
#ifndef ABL_MIX
#define ABL_MIX 0
#endif
#define LAS __attribute__((address_space(3)))
typedef unsigned short bf16_t;
typedef short bf16x8 __attribute__((ext_vector_type(8)));
typedef short s16x4 __attribute__((ext_vector_type(4)));
typedef float f32x2 __attribute__((ext_vector_type(2)));
typedef float f32x4 __attribute__((ext_vector_type(4)));
typedef float f32x8 __attribute__((ext_vector_type(8)));
typedef float f32x16 __attribute__((ext_vector_type(16)));
typedef unsigned u32x2 __attribute__((ext_vector_type(2)));
typedef unsigned u32x4 __attribute__((ext_vector_type(4)));
typedef __bf16 bf2_t __attribute__((ext_vector_type(2)));

constexpr int D = 2048, NB = 4, SEQ = 4096, CTXL = 256, TT = SEQ + CTXL;
constexpr int NLAT = NB * SEQ, NCTX = NB * CTXL, NROW = NLAT + NCTX;
constexpr int NP1 = 4096, NG = 6144, NPT = NP1 + NG;
constexpr int NIN = 10016;
constexpr float ALPHA = 1.4142135623730951f;
constexpr float LN_EPS = 1e-5f, RMS_EPS = 1e-6f;
constexpr float LOG2E = 1.4426950408889634f;
constexpr int C_CQ = 0, C_CKV = 512, C_GQ = 768, C_GK = 1792, C_GV = 2048, C_RQ = 2304, C_RK = 2560, C_RV = 2816, C_RG = 3328, C_KR = 3840;

constexpr size_t AL(size_t x) { return (x + 255) / 256 * 256; }
constexpr size_t WS_CTL = 0;                                    constexpr size_t CTL_BYTES = 1u << 20;
constexpr size_t WS_WSC = WS_CTL + 32768;
constexpr size_t WS_CVT = WS_CTL + 33024;
constexpr size_t WS_DEC = WS_CTL + 65536;
constexpr size_t WS_ROPE32 = WS_CTL + CTL_BYTES;
constexpr size_t WS_ROPE128 = WS_ROPE32 + AL(64 * 8 * 8);
constexpr size_t WS_MODP = WS_ROPE128 + AL(64 * 32 * 8);
constexpr size_t WS_MOD = WS_MODP + AL((size_t)16 * 2 * 5 * 12288 * 4);
constexpr size_t WS_WIN = WS_MOD + AL((size_t)2 * 5 * 12288 * 4);
constexpr size_t SZ_WIN = (size_t)NPT * D;
constexpr size_t WS_WQUP = WS_WIN + 2 * SZ_WIN;                 constexpr size_t SZ_WQUP = (size_t)768 * 512 * 2;
constexpr size_t WS_WKVUP = WS_WQUP + 2 * SZ_WQUP;              constexpr size_t SZ_WKVUP = (size_t)1024 * 256 * 2;
constexpr size_t WS_WBRA = WS_WKVUP + 2 * SZ_WKVUP;             constexpr size_t SZ_WBRA = (size_t)2048 * 512 * 2;
constexpr size_t WS_WBRB = WS_WBRA + 2 * SZ_WBRA;               constexpr size_t SZ_WBRB = SZ_WBRA;
constexpr size_t WS_WBRC = WS_WBRB + 2 * SZ_WBRB;               constexpr size_t SZ_WBRC = (size_t)2048 * 1024 * 2;
constexpr size_t WS_WOUT = WS_WBRC + 2 * SZ_WBRC;               constexpr size_t SZ_WOUT = (size_t)2048 * 2048 * 2;
constexpr size_t WS_WPQ = WS_WOUT + 2 * SZ_WOUT;                constexpr size_t SZ_WPQ = (size_t)1024 * 2048 * 2;
constexpr size_t WS_PSC = WS_WPQ + 2 * SZ_WPQ;
constexpr size_t WS_PU = WS_PSC + (size_t)4 * 16384 * 4;        constexpr size_t SZ_PT = (size_t)16384 * 1152;
constexpr size_t WS_PV = WS_PU + 2 * SZ_PT;
constexpr size_t WS_XC = WS_PV + 2 * SZ_PT;
constexpr size_t WS_HB = WS_XC + (size_t)NCTX * D * 4;
constexpr size_t WS_P1 = WS_HB + (size_t)NROW * D * 2;
constexpr size_t WS_G = WS_P1 + (size_t)NROW * NP1 * 2;
constexpr size_t WS_CQN = WS_G + (size_t)NROW * NG * 2;
constexpr size_t WS_CKVN = WS_CQN + (size_t)NROW * 512 * 2;
constexpr size_t WS_QM = WS_CKVN + (size_t)NROW * 256 * 2;
constexpr size_t SZ_Q128 = (size_t)NB * 8 * TT * 128 * 2;
constexpr size_t WS_KM = WS_QM + SZ_Q128;
constexpr size_t WS_VM = WS_KM + SZ_Q128;
constexpr size_t WS_QG = WS_VM + SZ_Q128 / 2;
constexpr size_t WS_KG = WS_QG + SZ_Q128;
constexpr size_t WS_VG = WS_KG + SZ_Q128 / 4;
constexpr size_t WS_RQ = WS_VG + SZ_Q128 / 4;
constexpr size_t WS_RK = WS_RQ + SZ_Q128 / 4;
constexpr size_t WS_RV = WS_RK + SZ_Q128 / 4;
constexpr size_t WS_ST = WS_RV + SZ_Q128 / 2;
constexpr size_t WS_OAB = WS_ST + (size_t)NB * 8 * 34 * 2 * 2048 * 4;
constexpr size_t WS_HB8 = WS_OAB + (size_t)NROW * D * 2;
constexpr size_t WS_MB8 = WS_HB8 + (size_t)NROW * D;
constexpr size_t WS_END = WS_MB8 + (size_t)NROW * D;
constexpr size_t WS_MB = WS_QM;
constexpr size_t WS_QP = WS_QG;
static_assert((size_t)NROW * D * 2 <= 2 * SZ_Q128, "MB alias");
static_assert((size_t)NROW * 1024 * 2 <= SZ_Q128, "QP alias");

__device__ __forceinline__ unsigned cvt_pk_bf16(float lo, float hi) { unsigned r; asm volatile("v_cvt_pk_bf16_f32 %0, %1, %2" : "=v"(r) : "v"(lo), "v"(hi)); return r; }
__device__ __forceinline__ bf16_t f2bf(float f) { return (bf16_t)(cvt_pk_bf16(f, 0.f) & 0xffffu); }
__device__ __forceinline__ float bf2f(bf16_t b) { return __uint_as_float(((unsigned)b) << 16); }
__device__ __forceinline__ float bflo(unsigned w) { return __uint_as_float(w << 16); }
__device__ __forceinline__ float bfhi(unsigned w) { return __uint_as_float(w & 0xffff0000u); }
template <int CTRL> __device__ __forceinline__ float dppf(float x) { return __int_as_float(__builtin_amdgcn_update_dpp(0, __float_as_int(x), CTRL, 0xF, 0xF, true)); }
__device__ __forceinline__ float row16_sum(float x) { x += dppf<0xB1>(x); x += dppf<0x4E>(x); x += dppf<0x141>(x); x += dppf<0x140>(x); return x; }
__device__ __forceinline__ float row16_max(float x) { x = fmaxf(x, dppf<0xB1>(x)); x = fmaxf(x, dppf<0x4E>(x)); x = fmaxf(x, dppf<0x141>(x)); x = fmaxf(x, dppf<0x140>(x)); return x; }
__device__ __forceinline__ float wave_sum(float x) {
    x = row16_sum(x);
    { auto r = __builtin_amdgcn_permlane16_swap(__float_as_uint(x), __float_as_uint(x), false, false); x = __uint_as_float(r[0]) + __uint_as_float(r[1]); }
    { auto r = __builtin_amdgcn_permlane32_swap(__float_as_uint(x), __float_as_uint(x), false, false); x = __uint_as_float(r[0]) + __uint_as_float(r[1]); }
    return x;
}
__device__ __forceinline__ unsigned pk4_fp8(float a, float b, float c, float d) { int t = 0; t = __builtin_amdgcn_cvt_pk_fp8_f32(a, b, t, false); t = __builtin_amdgcn_cvt_pk_fp8_f32(c, d, t, true); return (unsigned)t; }
__device__ __forceinline__ float clamp8(float x) { return fminf(fmaxf(x, -440.f), 440.f); }
__device__ __forceinline__ void fp8_scale(unsigned amax_bits, float& mul, float& inv) { const float am = __uint_as_float(amax_bits); int k = 0; if (am > 0.f) k = (int)floorf(log2f(256.f / am)); k = k > 60 ? 60 : (k < -60 ? -60 : k); mul = exp2f((float)k); inv = exp2f((float)-k); }
__device__ __forceinline__ float silu_f(float x) { return x * __builtin_amdgcn_rcpf(1.f + __builtin_amdgcn_exp2f(x * -1.4426950408889634f)); }
__device__ __forceinline__ float sigmoid_f(float x) { return __builtin_amdgcn_rcpf(1.f + __builtin_amdgcn_exp2f(x * -1.4426950408889634f)); }

__device__ __forceinline__ int vt_off(int tpos) { const int kk = tpos & 63; return (tpos & ~63) + ((kk >> 2) & 1) * 32 + ((kk >> 5) & 1) * 16 + (kk & 3) + 4 * ((kk >> 3) & 3); }
constexpr float QSC_G = 4.f * 0.08838834764831845f * 1.4426950408889634f, QSC_M = 4.f * 0.10206207261596575f * 1.4426950408889634f, KSC8 = 0.25f;
struct RowInfo { int b, tpos, pr, pc, v; bool lat; };
__device__ __forceinline__ RowInfo rowinfo(int row) {
    RowInfo r;
    if (row < NLAT) { r.lat = true; r.b = row >> 12; const int t = row & 4095; r.tpos = CTXL + t; r.pr = t >> 6; r.pc = t & 63; r.v = r.b; }
    else { const int q = row - NLAT; r.lat = false; r.b = q >> 8; r.tpos = q & 255; r.pr = 0; r.pc = 0; r.v = 4; }
    return r;
}

#define XB_TMO      128
#define XB_XCNT(j)  (256  + 64 * (j))
#define XB_XSUB(j)  (1280 + 64 * (j))
#define XB_XGEN(j)  (2304 + 64 * (j))
#define XB_TOP      3328
#define XB_TOPGEN   3392
#define XCD_BAR_WORDS 3456
#define XB_SPIN_CAP (1u << 22)

__device__ __forceinline__ unsigned xb_ld(unsigned* p)              { return __hip_atomic_load(p, __ATOMIC_RELAXED, __HIP_MEMORY_SCOPE_AGENT); }
__device__ __forceinline__ unsigned xb_add(unsigned* p, unsigned v) { return __hip_atomic_fetch_add(p, v, __ATOMIC_RELAXED, __HIP_MEMORY_SCOPE_AGENT); }
__device__ __forceinline__ unsigned xb_xcc_id() { return (unsigned)__builtin_amdgcn_s_getreg((3 << 11) | 20) & 0xFu; }
#define XB_SPIN(cond, bar) do { unsigned _sp = 0; while (cond) { __builtin_amdgcn_s_sleep(1); \
    if ((++_sp & 255u) == 0u) { if (xb_ld(&(bar)[XB_TMO])) break; if (_sp > XB_SPIN_CAP) { atomicAdd(&(bar)[XB_TMO], 1u); break; } } } } while (0)

struct XcdBarrier { unsigned* bar; unsigned x; volatile LAS unsigned* st; };

__device__ __forceinline__ XcdBarrier xcd_barrier_post(unsigned* bar, volatile LAS unsigned* st) {
    XcdBarrier b; b.bar = bar; b.x = xb_xcc_id(); b.st = st;
    if (threadIdx.x == 0) (void)xb_add(&bar[XB_XCNT(b.x)], 1u);
    return b;
}
__device__ __forceinline__ void xcd_barrier_complete(unsigned* bar, unsigned x, unsigned& nloc, unsigned& nx) {
    const unsigned G = gridDim.x * gridDim.y * gridDim.z;
    unsigned sum, cnt, mine, sp = 0u;
    for (;;) {
        sum = 0u; cnt = 0u; mine = 0u;
#pragma unroll
        for (unsigned j = 0; j < 16; ++j) { const unsigned c = xb_ld(&bar[XB_XCNT(j)]); sum += c; cnt += (c > 0u) ? 1u : 0u; mine = (j == x) ? c : mine; }
        if (sum == G) break;
        __builtin_amdgcn_s_sleep(1);
        if ((++sp & 255u) == 0u) { if (xb_ld(&bar[XB_TMO])) break; if (sp > XB_SPIN_CAP) { atomicAdd(&bar[XB_TMO], 1u); break; } }
    }
    nloc = mine > 0u ? mine : 1u; nx = cnt > 0u ? cnt : 1u;
}
__device__ __forceinline__ void xcd_barrier(const XcdBarrier& b) {
    asm volatile("s_waitcnt vmcnt(0)" ::: "memory");
    __syncthreads();
    if (threadIdx.x == 0) {
        unsigned* bar = b.bar;
        __builtin_amdgcn_s_waitcnt(0);
        unsigned nloc = b.st[0], nx = b.st[1];
        if (nloc == 0u) { xcd_barrier_complete(bar, b.x, nloc, nx); b.st[0] = nloc; b.st[1] = nx; }
        const unsigned old = xb_add(&bar[XB_XSUB(b.x)], 1u);
        const unsigned gen = old / nloc;
        if (old + 1u == (gen + 1u) * nloc) {
            __builtin_amdgcn_fence(__ATOMIC_RELEASE, "agent");
            asm volatile("s_waitcnt vmcnt(0)" ::: "memory");
            const unsigned og = xb_add(&bar[XB_TOP], 1u);
            const unsigned tg = og / nx;
            if (og + 1u == (tg + 1u) * nx) xb_add(&bar[XB_TOPGEN], 1u);
            else XB_SPIN(xb_ld(&bar[XB_TOPGEN]) == tg, bar);
            __builtin_amdgcn_fence(__ATOMIC_ACQUIRE, "agent");
            xb_add(&bar[XB_XGEN(b.x)], 1u);
            asm volatile("s_waitcnt vmcnt(0)" ::: "memory");
        } else {
            XB_SPIN(xb_ld(&bar[XB_XGEN(b.x)]) == gen, bar);
            __builtin_amdgcn_fence(__ATOMIC_ACQUIRE, "agent");
            asm volatile("s_waitcnt vmcnt(0)" ::: "memory");
        }
    }
    __syncthreads();
}
namespace pg8 {
constexpr int BM = 256, BK = 64, HALF = 128, HTB = HALF * BK * 2, STAGE_BYTES = 8 * HTB, NXCD = 8, WGM = 8;
__host__ __device__ __forceinline__ int lds_byte(int r, int c) { const int st = (r >> 4) * 2 + (c >> 5), rr = r & 15, cc = c & 31, ob = rr * 64 + cc * 2; return st * 1024 + (ob ^ (((ob >> 9) & 1) << 5)); }
__host__ __device__ __forceinline__ void stage_rc(int b, int& R, int& C) { const int st = b / 1024, sb = b % 1024, swz = sb ^ (((sb >> 9) & 1) << 5); R = (st >> 1) * 16 + swz / 64; C = (st & 1) * 32 + (swz % 64) / 2; }
__host__ __device__ __forceinline__ int perm32(int rho) { const int n = rho >> 4, i = rho & 15; return 8 * (i >> 2) + 4 * n + (i & 3); }

struct Unit { int pm, pn; };
typedef int i32x8 __attribute__((ext_vector_type(8))); typedef int i32x4v __attribute__((ext_vector_type(4)));
__device__ __forceinline__ i32x8 cat8(const bf16x8 a, const bf16x8 b) { const i32x4v x = __builtin_bit_cast(i32x4v, a), y = __builtin_bit_cast(i32x4v, b); return __builtin_shufflevector(x, y, 0, 1, 2, 3, 4, 5, 6, 7); }
struct Gemm { const bf16_t* A; const bf16_t* Bt; int M, N, K, lda, ldb; };

struct StaticOrder {
    int nM, nN, nwg, G, c;
    __host__ __device__ void init(int M, int N, int G_, int c_) { nM = M / BM; nN = N / BM; nwg = nM * nN; G = G_; c = c_; }
    __host__ __device__ bool next(int i, Unit& u) const {
        const long L = (long)i * G + c; if (L >= nwg) return false;
        int wgid = (int)L; { const int q = nwg / NXCD, r = nwg % NXCD, xcd = wgid % NXCD, off = wgid / NXCD; wgid = (xcd < r ? xcd * (q + 1) : r * (q + 1) + (xcd - r) * q) + off; }
        const int nig = WGM * nN, gid = wgid / nig, fm = gid * WGM, gsz = (nM - fm) < WGM ? (nM - fm) : WGM;
        u.pm = fm + ((wgid % nig) % gsz); u.pn = (wgid % nig) / gsz; return true;
    }
    __device__ __forceinline__ void a_ready(const Unit&) const {}
    __device__ __forceinline__ void done(const Unit&) const {}
};

template <class Epi, class Sched, int GABL = 0>
__device__ __forceinline__ void gemm_phase(LAS unsigned char* lds, const int tid, const Gemm g, const Sched& S, const Epi& E) {
    const int  wid = __builtin_amdgcn_readfirstlane(tid >> 6), lane = tid & 63, wr = wid >> 2, wc = wid & 3, fr = lane & 15, fq = lane >> 4;
    const int K = g.K, nt = K / BK;
    unsigned voffA[2], voffB[2];
#pragma unroll
    for (int i = 0; i < 2; ++i) { int R, C; stage_rc(tid * 16 + i * 8192, R, C); const int Rb = Epi::PERM ? ((R & ~31) + perm32(R & 31)) : R;
        voffA[i] = (unsigned)(R * g.lda + C) * 2u; voffB[i] = (unsigned)(Rb * g.ldb + C) * 2u; }
    const size_t kstep = (size_t)(BK * 2);
    const size_t hstepA = (size_t)HALF * g.lda * 2, hstepB = (size_t)HALF * g.ldb * 2;
    const size_t tstepA = 2 * hstepA, tstepB = 2 * hstepB;
    const unsigned ldsw = (unsigned)wid * 1024u;
    const int aoff = lds_byte(wr * 64 + fr, fq * 8), boff = lds_byte(wc * 32 + fr, fq * 8);
#define PG8_SA(b, h) (((b) * 2 + (h)) * HTB)
#define PG8_SB(b, h) ((4 + (b) * 2 + (h)) * HTB)
#define PG8_STAGE(bufoff, gbase, voff) do { if constexpr (!(GABL & 4)) _Pragma("unroll") for (int _i = 0; _i < 2; ++_i) \
        __builtin_amdgcn_global_load_lds((const unsigned*)((const char*)(gbase) + (voff)[_i]), (LAS unsigned*)(lds + (bufoff) + ldsw + _i * 8192), 16, 0, 0); } while (0)
#define PG8_LDA(dst, b, h) do { if constexpr (Epi::FP8) { _Pragma("unroll") for (int m = 0; m < 4; ++m) { const i32x4v lo_ = *(const LAS i32x4v*)(lds + PG8_SA(b, h) + aoff + m * 2048), hi_ = *(const LAS i32x4v*)(lds + PG8_SA(b, h) + aoff + m * 2048 + 1024); \
            dst##8[m] = __builtin_shufflevector(lo_, hi_, 0, 1, 2, 3, 4, 5, 6, 7); } } \
        else { _Pragma("unroll") for (int m = 0; m < 4; ++m) _Pragma("unroll") for (int k = 0; k < 2; ++k) dst[m][k] = *(const LAS bf16x8*)(lds + PG8_SA(b, h) + aoff + m * 2048 + k * 1024); } } while (0)
#define PG8_LDB(dst, b, h) do { if constexpr (Epi::FP8) { _Pragma("unroll") for (int n = 0; n < 2; ++n) { const i32x4v lo_ = *(const LAS i32x4v*)(lds + PG8_SB(b, h) + boff + n * 2048), hi_ = *(const LAS i32x4v*)(lds + PG8_SB(b, h) + boff + n * 2048 + 1024); \
            dst##8[n] = __builtin_shufflevector(lo_, hi_, 0, 1, 2, 3, 4, 5, 6, 7); } } \
        else { _Pragma("unroll") for (int n = 0; n < 2; ++n) _Pragma("unroll") for (int k = 0; k < 2; ++k) dst[n][k] = *(const LAS bf16x8*)(lds + PG8_SB(b, h) + boff + n * 2048 + k * 1024); } } while (0)
#define PG8_MMA(ai, bj, At, Bt) do { __builtin_amdgcn_s_setprio(1); _Pragma("unroll") for (int m = 0; m < 4; ++m) _Pragma("unroll") for (int n = 0; n < 2; ++n) { \
        if constexpr (Epi::FP8) { if constexpr (GABL & 8) asm volatile("" : "+v"(acc[ai][bj][m][n]) : "v"(Bt##8[n]), "v"(At##8[m]), "v"(sc1_)); else asm volatile("v_mfma_scale_f32_16x16x128_f8f6f4 %0, %1, %2, %0, %3, %3 op_sel_hi:[0,0,0]" : "+v"(acc[ai][bj][m][n]) : "v"(Bt##8[n]), "v"(At##8[m]), "v"(sc1_)); } \
        else { _Pragma("unroll") for (int k = 0; k < 2; ++k) acc[ai][bj][m][n] = __builtin_amdgcn_mfma_f32_16x16x32_bf16(Bt[n][k], At[m][k], acc[ai][bj][m][n], 0, 0, 0); } } __builtin_amdgcn_s_setprio(0); } while (0)
#define PG8_WAIT_V(n) asm volatile("s_waitcnt vmcnt(" #n ")" ::: "memory")
#define PG8_WAIT_L(n) asm volatile("s_waitcnt lgkmcnt(" #n ")" ::: "memory")
#define PG8_BAR __builtin_amdgcn_s_barrier()
#define PG8_SCHED __builtin_amdgcn_sched_barrier(0)
    Unit cur, nxt; int ui = 0;
    if (!S.next(0, cur)) return;
    f32x4 acc[2][2][4][2];
#pragma unroll
    for (int a = 0; a < 2; ++a)
#pragma unroll
        for (int b = 0; b < 2; ++b)
#pragma unroll
            for (int m = 0; m < 4; ++m)
#pragma unroll
                for (int n = 0; n < 2; ++n) acc[a][b][m][n] = (f32x4){0.f, 0.f, 0.f, 0.f};
    int sc1_ = 0x7F7F7F7F; asm volatile("" : "+v"(sc1_));
    bf16x8 At[4][2], B0[2][2], B1[2][2]; i32x8 At8[4], B08[2], B18[2];
    const char* cA = (const char*)g.A + (size_t)cur.pm * tstepA; const char* cB = (const char*)g.Bt + (size_t)cur.pn * tstepB;
    S.a_ready(cur);
    PG8_STAGE(PG8_SB(0, 0), cB, voffB); PG8_STAGE(PG8_SA(0, 0), cA, voffA); PG8_STAGE(PG8_SB(0, 1), cB + hstepB, voffB); PG8_STAGE(PG8_SA(0, 1), cA + hstepA, voffA);
    if (wr == 1) PG8_BAR;
    PG8_WAIT_V(4); PG8_BAR;
    PG8_STAGE(PG8_SB(1, 0), cB + kstep, voffB); PG8_STAGE(PG8_SA(1, 0), cA + kstep, voffA); PG8_STAGE(PG8_SB(1, 1), cB + hstepB + kstep, voffB);
    PG8_WAIT_V(6); PG8_BAR;
    for (;;) {
        const bool has_next = S.next(ui + 1, nxt);
        const char* nA = has_next ? (const char*)g.A + (size_t)nxt.pm * tstepA : cA; const char* nB = has_next ? (const char*)g.Bt + (size_t)nxt.pn * tstepB : cB;
#pragma unroll 1
        for (int t = 0; t < nt; t += 2) {
            const bool last = (t == nt - 2);
            const char* a1 = cA + (size_t)(t + 1) * kstep;
            const char* a2 = last ? nA : cA + (size_t)(t + 2) * kstep; const char* b2 = last ? nB : cB + (size_t)(t + 2) * kstep;
            const char* a3 = a2 + kstep; const char* b3 = b2 + kstep;
            if (last && has_next) S.a_ready(nxt);
            PG8_LDB(B0, 0, 0); PG8_SCHED; PG8_LDA(At, 0, 0); PG8_STAGE(PG8_SA(1, 1), a1 + hstepA, voffA);
            PG8_WAIT_L(8); PG8_BAR; PG8_WAIT_L(0); PG8_MMA(0, 0, At, B0); PG8_BAR; PG8_SCHED;
            PG8_LDB(B1, 0, 1); PG8_STAGE(PG8_SB(0, 0), b2, voffB);
            PG8_BAR; PG8_WAIT_L(0); PG8_MMA(0, 1, At, B1); PG8_BAR;
            PG8_LDA(At, 0, 1); PG8_STAGE(PG8_SA(0, 0), a2, voffA);
            PG8_BAR; PG8_WAIT_L(0); PG8_MMA(1, 0, At, B0); PG8_BAR; PG8_SCHED;
            PG8_STAGE(PG8_SB(0, 1), b2 + hstepB, voffB);
            PG8_WAIT_V(6); PG8_BAR; PG8_MMA(1, 1, At, B1); PG8_BAR;
            PG8_LDB(B0, 1, 0); PG8_SCHED; PG8_LDA(At, 1, 0); PG8_STAGE(PG8_SA(0, 1), a2 + hstepA, voffA);
            PG8_WAIT_L(8); PG8_BAR; PG8_WAIT_L(0); PG8_MMA(0, 0, At, B0); PG8_BAR; PG8_SCHED;
            PG8_LDB(B1, 1, 1); PG8_STAGE(PG8_SB(1, 0), b3, voffB);
            PG8_BAR; PG8_WAIT_L(0); PG8_MMA(0, 1, At, B1); PG8_BAR;
            PG8_LDA(At, 1, 1); PG8_STAGE(PG8_SA(1, 0), a3, voffA);
            PG8_BAR; PG8_WAIT_L(0); PG8_MMA(1, 0, At, B0); PG8_BAR; PG8_SCHED;
            PG8_STAGE(PG8_SB(1, 1), b3 + hstepB, voffB);
            PG8_WAIT_V(6); PG8_BAR; PG8_MMA(1, 1, At, B1); PG8_BAR;
        }
        if constexpr (Epi::FP8) asm volatile("s_nop 15\n\ts_nop 15" ::: "memory");
        if constexpr (GABL & 2) { pg8::Unit u2_ = cur; u2_.pm = 0; Epi E2_ = E; E2_.retarget(); E2_(acc, u2_, wr, wc, fr, fq); } else if constexpr (!(GABL & 1)) E(acc, cur, wr, wc, fr, fq); else asm volatile("" :: "v"(acc[0][0][0][0]), "v"(acc[1][1][3][1]), "v"(acc[0][1][2][0]), "v"(acc[1][0][1][1]));
        if (!has_next) break;
#pragma unroll
        for (int a = 0; a < 2; ++a)
#pragma unroll
            for (int b = 0; b < 2; ++b)
#pragma unroll
                for (int m = 0; m < 4; ++m)
#pragma unroll
                    for (int n = 0; n < 2; ++n) acc[a][b][m][n] = (f32x4){0.f, 0.f, 0.f, 0.f};
        cur = nxt; cA = nA; cB = nB; ++ui;
    }
    PG8_WAIT_V(0);
    if (wr == 0) PG8_BAR;
    PG8_BAR;
#undef PG8_SA
#undef PG8_SB
#undef PG8_STAGE
#undef PG8_LDA
#undef PG8_LDB
#undef PG8_MMA
#undef PG8_WAIT_V
#undef PG8_WAIT_L
#undef PG8_BAR
#undef PG8_SCHED
}
}

typedef f32x4 Acc[2][2][4][2];
#define EPI_LOOP_ROWS for (int ai = 0; ai < 2; ++ai) for (int m = 0; m < 4; ++m)
__device__ __forceinline__ u32x4 pack8(const f32x4 a, const f32x4 b) { u32x4 w; w.x = cvt_pk_bf16(a[0], a[1]); w.y = cvt_pk_bf16(a[2], a[3]); w.z = cvt_pk_bf16(b[0], b[1]); w.w = cvt_pk_bf16(b[2], b[3]); return w; }

struct EpiIn {
    static constexpr bool PERM = true, FP8 = true;
    bf16_t* P1; bf16_t* G; float inv;
    __device__ __forceinline__ void retarget() { P1 = (bf16_t*)((char*)P1 - WS_P1 + WS_END); G = P1 + 256 * NP1; }
    __device__ __forceinline__ void operator()(const Acc& acc, const pg8::Unit& u, int wr, int wc, int fr, int fq) const {
        const int row0 = u.pm * 256 + wr * 64 + fr; const bool gate = u.pn >= 16;
        bf16_t* base = gate ? G : P1; const int ld = gate ? NG : NP1; const int col0 = (gate ? (u.pn - 16) : u.pn) * 256 + wc * 32 + 8 * fq;
#pragma unroll
        for (int ai = 0; ai < 2; ++ai)
#pragma unroll
            for (int m = 0; m < 4; ++m) { bf16_t* rowp = base + (size_t)(row0 + ai * 128 + m * 16) * ld + col0;
#pragma unroll
                for (int bj = 0; bj < 2; ++bj) { f32x4 v0 = acc[ai][bj][m][0] * inv, v1 = acc[ai][bj][m][1] * inv;
                    if (gate) {
#pragma unroll
                        for (int j = 0; j < 4; ++j) { v0[j] = sigmoid_f(v0[j]); v1[j] = sigmoid_f(v1[j]); } }
                    __builtin_nontemporal_store(pack8(v0, v1), (u32x4*)(rowp + bj * 128)); } }
    }
};
struct EpiPlain {
    static constexpr bool PERM = true, FP8 = false;
    bf16_t* O; int ldc;
    __device__ __forceinline__ void operator()(const Acc& acc, const pg8::Unit& u, int wr, int wc, int fr, int fq) const {
        const int row0 = u.pm * 256 + wr * 64 + fr; const int col0 = u.pn * 256 + wc * 32 + 8 * fq;
#pragma unroll
        for (int ai = 0; ai < 2; ++ai)
#pragma unroll
            for (int m = 0; m < 4; ++m) { bf16_t* rowp = O + (size_t)(row0 + ai * 128 + m * 16) * ldc + col0;
#pragma unroll
                for (int bj = 0; bj < 2; ++bj) *(u32x4*)(rowp + bj * 128) = pack8(acc[ai][bj][m][0], acc[ai][bj][m][1]); }
    }
};
__device__ __forceinline__ void tile_info(int pm, int& b, int& tpos0, bool& lat) { lat = pm < 64; b = lat ? (pm >> 4) : (pm - 64); tpos0 = lat ? CTXL + ((pm & 15) << 8) : 0; }
struct EpiQup {
    static constexpr bool PERM = true, FP8 = false;
    unsigned char* QM; const f32x2* cs32;
    __device__ __forceinline__ void operator()(const Acc& acc, const pg8::Unit& u, int wr, int wc, int fr, int fq) const {
        int b, tpos0; bool lat; tile_info(u.pm, b, tpos0, lat);
        const int r0 = wr * 64 + fr;
#pragma unroll
        for (int bj = 0; bj < 2; ++bj) { const int c0 = u.pn * 256 + bj * 128 + wc * 32 + 8 * fq; const int hh = c0 / 96, j0 = c0 - hh * 96;
            unsigned char* hb = QM + ((size_t)(b * 8 + hh) * TT + tpos0 + r0) * 128;
            if (j0 < 64) {
#pragma unroll
                for (int ai = 0; ai < 2; ++ai)
#pragma unroll
                    for (int m = 0; m < 4; ++m) { const f32x4 a_ = acc[ai][bj][m][0] * QSC_M, b_ = acc[ai][bj][m][1] * QSC_M; u32x2 w8; w8.x = pk4_fp8(clamp8(a_[0]), clamp8(a_[1]), clamp8(a_[2]), clamp8(a_[3])); w8.y = pk4_fp8(clamp8(b_[0]), clamp8(b_[1]), clamp8(b_[2]), clamp8(b_[3]));
                        *(u32x2*)(hb + (ai * 128 + m * 16) * 128 + j0) = w8; }
            } else { const int g8 = (j0 - 64) >> 3, part = g8 >> 1, pbase = (g8 & 1) * 4;
#pragma unroll
                for (int ai = 0; ai < 2; ++ai)
#pragma unroll
                    for (int m = 0; m < 4; ++m) { const int t = tpos0 - CTXL + r0 + ai * 128 + m * 16; const int pos = part ? (t & 63) : (t >> 6);
                        const f32x4 v0 = acc[ai][bj][m][0] * QSC_M, v1 = acc[ai][bj][m][1] * QSC_M;
                        float o1[4], o2[4]; const float x1[4] = {v0[0], v0[2], v1[0], v1[2]}, x2[4] = {v0[1], v0[3], v1[1], v1[3]};
#pragma unroll
                        for (int p = 0; p < 4; ++p) { const f32x2 cs = lat ? cs32[pos * 8 + pbase + p] : (f32x2){1.f, 0.f};
                            o1[p] = x1[p] * cs.x - x2[p] * cs.y; o2[p] = x1[p] * cs.y + x2[p] * cs.x; }
                        unsigned char* dst = hb + (ai * 128 + m * 16) * 128 + 64 + part * 16 + pbase;
                        *(unsigned*)dst = pk4_fp8(clamp8(o1[0]), clamp8(o1[1]), clamp8(o1[2]), clamp8(o1[3])); *(unsigned*)(dst + 8) = pk4_fp8(clamp8(o2[0]), clamp8(o2[1]), clamp8(o2[2]), clamp8(o2[3])); } } }
    }
};
struct EpiKvup {
    static constexpr bool PERM = true, FP8 = false;
    unsigned char* KM; unsigned char* VM;
    __device__ __forceinline__ void operator()(const Acc& acc, const pg8::Unit& u, int wr, int wc, int fr, int fq) const {
        int b, tpos0; bool lat; tile_info(u.pm, b, tpos0, lat);
        const int r0 = wr * 64 + fr; const int j0 = wc * 32 + 8 * fq;
#pragma unroll
        for (int bj = 0; bj < 2; ++bj) { const size_t tok = (size_t)(b * 8 + u.pn * 2 + bj) * TT + tpos0 + r0;
            if (j0 < 64) { unsigned char* d = KM + tok * 128 + j0;
#pragma unroll
                for (int ai = 0; ai < 2; ++ai)
#pragma unroll
                    for (int m = 0; m < 4; ++m) { const f32x4 a_ = acc[ai][bj][m][0] * KSC8, b_ = acc[ai][bj][m][1] * KSC8; u32x2 w8; w8.x = pk4_fp8(clamp8(a_[0]), clamp8(a_[1]), clamp8(a_[2]), clamp8(a_[3])); w8.y = pk4_fp8(clamp8(b_[0]), clamp8(b_[1]), clamp8(b_[2]), clamp8(b_[3]));
                        *(u32x2*)(d + (ai * 128 + m * 16) * 128) = w8; } }
            else { unsigned char* d = VM + ((size_t)(b * 8 + u.pn * 2 + bj) * 64 + (j0 - 64)) * TT;
#pragma unroll
                for (int ai = 0; ai < 2; ++ai)
#pragma unroll
                    for (int m = 0; m < 4; ++m) { const f32x4 a_ = acc[ai][bj][m][0], b_ = acc[ai][bj][m][1]; const unsigned w0_ = pk4_fp8(clamp8(a_[0]), clamp8(a_[1]), clamp8(a_[2]), clamp8(a_[3])), w1_ = pk4_fp8(clamp8(b_[0]), clamp8(b_[1]), clamp8(b_[2]), clamp8(b_[3]));
                        unsigned char* q_ = d + vt_off(tpos0 + r0 + ai * 128 + m * 16);
                        q_[0] = (unsigned char)(w0_ & 0xffu); q_[TT] = (unsigned char)((w0_ >> 8) & 0xffu); q_[2 * TT] = (unsigned char)((w0_ >> 16) & 0xffu); q_[3 * TT] = (unsigned char)(w0_ >> 24);
                        q_[4 * TT] = (unsigned char)(w1_ & 0xffu); q_[5 * TT] = (unsigned char)((w1_ >> 8) & 0xffu); q_[6 * TT] = (unsigned char)((w1_ >> 16) & 0xffu); q_[7 * TT] = (unsigned char)(w1_ >> 24); } } }
    }
};
template <int SEG> struct EpiMerge {
    static constexpr bool PERM = true, FP8 = false;
    bf16_t* MB; const bf16_t* G; unsigned char* MB8;
    __device__ __forceinline__ void operator()(const Acc& acc, const pg8::Unit& u, int wr, int wc, int fr, int fq) const {
        const int row0 = u.pm * 256 + wr * 64 + fr; const int col0 = u.pn * 256 + wc * 32 + 8 * fq;
        const bf16_t* gp = G + (size_t)row0 * NG + SEG * 2048 + col0; bf16_t* mp = MB + (size_t)row0 * D + col0; unsigned char* m8 = MB8 + (size_t)row0 * D + col0;
#pragma unroll
        for (int ai = 0; ai < 2; ++ai) {
            u32x4 gw[4][2], ow[4][2];
#pragma unroll
            for (int m = 0; m < 4; ++m)
#pragma unroll
                for (int bj = 0; bj < 2; ++bj) { const size_t ro = (size_t)(ai * 128 + m * 16);
                    gw[m][bj] = *(const u32x4*)(gp + ro * NG + bj * 128);
                    if (SEG > 0) ow[m][bj] = __builtin_nontemporal_load((const u32x4*)(mp + ro * D + bj * 128)); }
#pragma unroll
            for (int m = 0; m < 4; ++m)
#pragma unroll
                for (int bj = 0; bj < 2; ++bj) { const size_t ro = (size_t)(ai * 128 + m * 16); const u32x4 g_ = gw[m][bj];
                    f32x4 v0 = acc[ai][bj][m][0], v1 = acc[ai][bj][m][1];
                    if (ABL_BR & (1 << SEG)) { v0 = (f32x4){0.f, 0.f, 0.f, 0.f}; v1 = v0; }
                    v0[0] *= bflo(g_.x); v0[1] *= bfhi(g_.x); v0[2] *= bflo(g_.y); v0[3] *= bfhi(g_.y);
                    v1[0] *= bflo(g_.z); v1[1] *= bfhi(g_.z); v1[2] *= bflo(g_.w); v1[3] *= bfhi(g_.w);
                    if (SEG > 0) { const u32x4 o = ow[m][bj];
                        v0[0] += bflo(o.x); v0[1] += bfhi(o.x); v0[2] += bflo(o.y); v0[3] += bfhi(o.y);
                        v1[0] += bflo(o.z); v1[1] += bfhi(o.z); v1[2] += bflo(o.w); v1[3] += bfhi(o.w); }
                    if (SEG < 2) *(u32x4*)(mp + ro * D + bj * 128) = pack8(v0, v1);
                    else { u32x2 w8; w8.x = pk4_fp8(clamp8(v0[0] * 16.f), clamp8(v0[1] * 16.f), clamp8(v0[2] * 16.f), clamp8(v0[3] * 16.f)); w8.y = pk4_fp8(clamp8(v1[0] * 16.f), clamp8(v1[1] * 16.f), clamp8(v1[2] * 16.f), clamp8(v1[3] * 16.f));
                        *(u32x2*)(m8 + ro * D + bj * 128) = w8; } }
        }
    }
};
namespace pg8 {
struct Merge3 { const bf16_t* A; const bf16_t* B0; const bf16_t* B1; const bf16_t* B2; const bf16_t* G; unsigned char* MB8; float r01, r12, fin; };
template <class Sched>
__device__ __forceinline__ void gemm_merge3(LAS unsigned char* lds, const int tid, const Merge3 g, const Sched& S) {
    constexpr int GABL = 0;
    const int wid = __builtin_amdgcn_readfirstlane(tid >> 6), lane = tid & 63, wr = wid >> 2, wc = wid & 3, fr = lane & 15, fq = lane >> 4;
    constexpr int NT = 16, LDA = 1024;
    int sc1_ = 0x7F7F7F7F; asm volatile("" : "+v"(sc1_));
    unsigned voffA[2], voffB5[2], voffB10[2];
#pragma unroll
    for (int i = 0; i < 2; ++i) { int R, C; stage_rc(tid * 16 + i * 8192, R, C); const int Rb = (R & ~31) + perm32(R & 31);
        voffA[i] = (unsigned)(R * LDA + C) * 2u; voffB5[i] = (unsigned)(Rb * 256 + C) * 2u; voffB10[i] = (unsigned)(Rb * 512 + C) * 2u; }
    const size_t kstep = (size_t)(BK * 2);
    const size_t hstepA = (size_t)HALF * LDA * 2, tstepA = 2 * hstepA;
    const unsigned ldsw = (unsigned)wid * 1024u;
    const int aoff = lds_byte(wr * 64 + fr, fq * 8), boff = lds_byte(wc * 32 + fr, fq * 8);
#define M3_TA(pm_, t_) ((const char*)g.A + (size_t)(pm_) * tstepA + (size_t)(t_) * kstep)
#define M3_TB(pn_, t_) ((t_) < 4 ? (const char*)g.B0 + (size_t)(pn_) * 131072 + (size_t)(t_) * kstep : ((t_) < 8 ? (const char*)g.B1 + (size_t)(pn_) * 131072 + (size_t)((t_) - 4) * kstep : (const char*)g.B2 + (size_t)(pn_) * 262144 + (size_t)((t_) - 8) * kstep))
#define PG8_SA(b, h) (((b) * 2 + (h)) * HTB)
#define PG8_SB(b, h) ((4 + (b) * 2 + (h)) * HTB)
#define PG8_STAGE(bufoff, gbase, voff) do { if constexpr (!(GABL & 4)) _Pragma("unroll") for (int _i = 0; _i < 2; ++_i) \
        __builtin_amdgcn_global_load_lds((const unsigned*)((const char*)(gbase) + (voff)[_i]), (LAS unsigned*)(lds + (bufoff) + ldsw + _i * 8192), 16, 0, 0); } while (0)
#define PG8_LDA(dst, b, h) do { _Pragma("unroll") for (int m = 0; m < 4; ++m) { const i32x4v lo_ = *(const LAS i32x4v*)(lds + PG8_SA(b, h) + aoff + m * 2048), hi_ = *(const LAS i32x4v*)(lds + PG8_SA(b, h) + aoff + m * 2048 + 1024); dst[m] = __builtin_shufflevector(lo_, hi_, 0, 1, 2, 3, 4, 5, 6, 7); } } while (0)
#define PG8_LDB(dst, b, h) do { _Pragma("unroll") for (int n = 0; n < 2; ++n) { const i32x4v lo_ = *(const LAS i32x4v*)(lds + PG8_SB(b, h) + boff + n * 2048), hi_ = *(const LAS i32x4v*)(lds + PG8_SB(b, h) + boff + n * 2048 + 1024); dst[n] = __builtin_shufflevector(lo_, hi_, 0, 1, 2, 3, 4, 5, 6, 7); } } while (0)
#define PG8_MMA(ai, bj, At, Bt) do { __builtin_amdgcn_s_setprio(1); _Pragma("unroll") for (int m = 0; m < 4; ++m) _Pragma("unroll") for (int n = 0; n < 2; ++n) \
        asm volatile("v_mfma_scale_f32_16x16x128_f8f6f4 %0, %1, %2, %0, %3, %3 op_sel_hi:[0,0,0]" : "+v"(acc[ai][bj][m][n]) : "v"(Bt[n]), "v"(At[m]), "v"(sc1_)); __builtin_amdgcn_s_setprio(0); } while (0)
#define PG8_WAIT_V(n) asm volatile("s_waitcnt vmcnt(" #n ")" ::: "memory")
#define PG8_WAIT_L(n) asm volatile("s_waitcnt lgkmcnt(" #n ")" ::: "memory")
#define PG8_BAR __builtin_amdgcn_s_barrier()
#define PG8_SCHED __builtin_amdgcn_sched_barrier(0)
    Unit cur, nxt; int ui = 0;
    if (!S.next(0, cur)) return;
    f32x4 acc[2][2][4][2];
#pragma unroll
    for (int a = 0; a < 2; ++a)
#pragma unroll
        for (int b = 0; b < 2; ++b)
#pragma unroll
            for (int m = 0; m < 4; ++m)
#pragma unroll
                for (int n = 0; n < 2; ++n) acc[a][b][m][n] = (f32x4){0.f, 0.f, 0.f, 0.f};
    i32x8 At[4], B0[2], B1[2];
    { const char* cA = M3_TA(cur.pm, 0); const char* cB = M3_TB(cur.pn, 0); const size_t hB = 65536;
      PG8_STAGE(PG8_SB(0, 0), cB, voffB5); PG8_STAGE(PG8_SA(0, 0), cA, voffA); PG8_STAGE(PG8_SB(0, 1), cB + hB, voffB5); PG8_STAGE(PG8_SA(0, 1), cA + hstepA, voffA);
      if (wr == 1) PG8_BAR;
      PG8_WAIT_V(4); PG8_BAR;
      PG8_STAGE(PG8_SB(1, 0), cB + kstep, voffB5); PG8_STAGE(PG8_SA(1, 0), cA + kstep, voffA); PG8_STAGE(PG8_SB(1, 1), cB + hB + kstep, voffB5);
      PG8_WAIT_V(6); PG8_BAR; }
    const int r0 = wr * 64 + fr, c0l = wc * 32 + 8 * fq;
    for (;;) {
        const bool has_next = S.next(ui + 1, nxt);
        const int npm = has_next ? nxt.pm : cur.pm, npn = has_next ? nxt.pn : cur.pn;
#pragma unroll 1
        for (int t = 0; t < NT; t += 2) {
            const bool last = (t == NT - 2);
            const int t2 = last ? 0 : t + 2;
            const char* a1 = M3_TA(cur.pm, t + 1);
            const char* a2 = last ? M3_TA(npm, 0) : M3_TA(cur.pm, t + 2); const char* b2 = last ? M3_TB(npn, 0) : M3_TB(cur.pn, t + 2);
            const char* a3 = a2 + kstep; const char* b3 = b2 + kstep;
            const bool wide = t2 >= 8; const size_t hB = wide ? 131072 : 65536;
            unsigned vB[2]; vB[0] = wide ? voffB10[0] : voffB5[0]; vB[1] = wide ? voffB10[1] : voffB5[1];
            PG8_LDB(B0, 0, 0); PG8_SCHED; PG8_LDA(At, 0, 0); PG8_STAGE(PG8_SA(1, 1), a1 + hstepA, voffA);
            PG8_WAIT_L(8); PG8_BAR; PG8_WAIT_L(0); PG8_MMA(0, 0, At, B0); PG8_BAR; PG8_SCHED;
            PG8_LDB(B1, 0, 1); PG8_STAGE(PG8_SB(0, 0), b2, vB);
            PG8_BAR; PG8_WAIT_L(0); PG8_MMA(0, 1, At, B1); PG8_BAR;
            PG8_LDA(At, 0, 1); PG8_STAGE(PG8_SA(0, 0), a2, voffA);
            PG8_BAR; PG8_WAIT_L(0); PG8_MMA(1, 0, At, B0); PG8_BAR; PG8_SCHED;
            PG8_STAGE(PG8_SB(0, 1), b2 + hB, vB);
            PG8_WAIT_V(6); PG8_BAR; PG8_MMA(1, 1, At, B1); PG8_BAR;
            PG8_LDB(B0, 1, 0); PG8_SCHED; PG8_LDA(At, 1, 0); PG8_STAGE(PG8_SA(0, 1), a2 + hstepA, voffA);
            PG8_WAIT_L(8); PG8_BAR; PG8_WAIT_L(0); PG8_MMA(0, 0, At, B0); PG8_BAR; PG8_SCHED;
            PG8_LDB(B1, 1, 1); PG8_STAGE(PG8_SB(1, 0), b3, vB);
            PG8_BAR; PG8_WAIT_L(0); PG8_MMA(0, 1, At, B1); PG8_BAR;
            PG8_LDA(At, 1, 1); PG8_STAGE(PG8_SA(1, 0), a3, voffA);
            PG8_BAR; PG8_WAIT_L(0); PG8_MMA(1, 0, At, B0); PG8_BAR; PG8_SCHED;
            PG8_STAGE(PG8_SB(1, 1), b3 + hB, vB);
            PG8_WAIT_V(6); PG8_BAR; PG8_MMA(1, 1, At, B1); PG8_BAR;
            if (t == 2 || t == 6) {
                asm volatile("s_nop 15\n\ts_nop 15" ::: "memory");
                const int sg = t == 2 ? 0 : 1; const float wr_ = sg ? g.r12 : g.r01;
                const bf16_t* gp = g.G + (size_t)(cur.pm * 256 + r0) * NG + sg * 2048 + cur.pn * 256 + c0l;
#pragma unroll
                for (int ai = 0; ai < 2; ++ai) { u32x4 ga[4][2], gb[4][2];
#pragma unroll
                    for (int m = 0; m < 4; ++m)
#pragma unroll
                        for (int bj = 0; bj < 2; ++bj) { const bf16_t* q_ = gp + (size_t)(ai * 128 + m * 16) * NG + bj * 128; ga[m][bj] = *(const u32x4*)q_; gb[m][bj] = *(const u32x4*)(q_ + 2048); }
#pragma unroll
                    for (int m = 0; m < 4; ++m)
#pragma unroll
                        for (int bj = 0; bj < 2; ++bj) { const u32x4 x_ = ga[m][bj], y_ = gb[m][bj];
#define M3_RT(xw, yw, lohi) (fmaxf(lohi(xw), 1e-6f) * wr_ * __builtin_amdgcn_rcpf(fmaxf(lohi(yw), 1e-6f)))
                            acc[ai][bj][m][0][0] *= M3_RT(x_.x, y_.x, bflo); acc[ai][bj][m][0][1] *= M3_RT(x_.x, y_.x, bfhi); acc[ai][bj][m][0][2] *= M3_RT(x_.y, y_.y, bflo); acc[ai][bj][m][0][3] *= M3_RT(x_.y, y_.y, bfhi);
                            acc[ai][bj][m][1][0] *= M3_RT(x_.z, y_.z, bflo); acc[ai][bj][m][1][1] *= M3_RT(x_.z, y_.z, bfhi); acc[ai][bj][m][1][2] *= M3_RT(x_.w, y_.w, bflo); acc[ai][bj][m][1][3] *= M3_RT(x_.w, y_.w, bfhi); } }
                asm volatile("s_waitcnt vmcnt(0)" ::: "memory");
            }
        }
        asm volatile("s_nop 15\n\ts_nop 15" ::: "memory");
        { const bf16_t* gp = g.G + (size_t)(cur.pm * 256 + r0) * NG + 2 * 2048 + cur.pn * 256 + c0l; unsigned char* m8 = g.MB8 + (size_t)(cur.pm * 256 + r0) * D + cur.pn * 256 + c0l;
#pragma unroll
          for (int ai = 0; ai < 2; ++ai) { u32x4 gc[4][2];
#pragma unroll
              for (int m = 0; m < 4; ++m)
#pragma unroll
                  for (int bj = 0; bj < 2; ++bj) gc[m][bj] = *(const u32x4*)(gp + (size_t)(ai * 128 + m * 16) * NG + bj * 128);
#pragma unroll
              for (int m = 0; m < 4; ++m)
#pragma unroll
                  for (int bj = 0; bj < 2; ++bj) { const u32x4 z_ = gc[m][bj]; const f32x4 v0 = acc[ai][bj][m][0], v1 = acc[ai][bj][m][1];
                      u32x2 w8; const float f_ = g.fin;
                      w8.x = pk4_fp8(clamp8(v0[0] * fmaxf(bflo(z_.x), 1e-6f) * f_), clamp8(v0[1] * fmaxf(bfhi(z_.x), 1e-6f) * f_), clamp8(v0[2] * fmaxf(bflo(z_.y), 1e-6f) * f_), clamp8(v0[3] * fmaxf(bfhi(z_.y), 1e-6f) * f_));
                      w8.y = pk4_fp8(clamp8(v1[0] * fmaxf(bflo(z_.z), 1e-6f) * f_), clamp8(v1[1] * fmaxf(bfhi(z_.z), 1e-6f) * f_), clamp8(v1[2] * fmaxf(bflo(z_.w), 1e-6f) * f_), clamp8(v1[3] * fmaxf(bfhi(z_.w), 1e-6f) * f_));
                      *(u32x2*)(m8 + (size_t)(ai * 128 + m * 16) * D + bj * 128) = w8; } } }
        if (!has_next) break;
#pragma unroll
        for (int a = 0; a < 2; ++a)
#pragma unroll
            for (int b = 0; b < 2; ++b)
#pragma unroll
                for (int m = 0; m < 4; ++m)
#pragma unroll
                    for (int n = 0; n < 2; ++n) acc[a][b][m][n] = (f32x4){0.f, 0.f, 0.f, 0.f};
        cur = nxt; ++ui;
    }
    PG8_WAIT_V(0);
    if (wr == 0) PG8_BAR;
    PG8_BAR;
#undef M3_RT
#undef M3_TA
#undef M3_TB
#undef PG8_SA
#undef PG8_SB
#undef PG8_STAGE
#undef PG8_LDA
#undef PG8_LDB
#undef PG8_MMA
#undef PG8_WAIT_V
#undef PG8_WAIT_L
#undef PG8_BAR
#undef PG8_SCHED
}
}
struct EpiOut {
    static constexpr bool PERM = false, FP8 = true;
    const float* src_lat; const float* src_ctx; float* dst_lat; float* dst_ctx; const float* g1; float inv;
    __device__ __forceinline__ void operator()(const Acc& acc, const pg8::Unit& u, int wr, int wc, int fr, int fq) const {
        const int row0 = u.pm * 256 + wr * 64 + fr; const int col0 = u.pn * 256 + wc * 32 + 4 * fq;
        const bool lat = (u.pm * 256) < NLAT;
        const float* src = (lat ? src_lat : src_ctx - (size_t)NLAT * D) + (size_t)row0 * D + col0; float* dst = (lat ? dst_lat : dst_ctx - (size_t)NLAT * D) + (size_t)row0 * D + col0;
#pragma unroll
        for (int ai = 0; ai < 2; ++ai) { const int rbase = u.pm * 256 + ai * 128 + wr * 64; const int v = lat ? (rbase >> 12) : 4; const float* gp = g1 + (size_t)v * 12288 + col0;
            f32x4 gg[2][2];
#pragma unroll
            for (int bj = 0; bj < 2; ++bj)
#pragma unroll
                for (int n = 0; n < 2; ++n) gg[bj][n] = *(const f32x4*)(gp + bj * 128 + n * 16);
#pragma unroll
            for (int mh = 0; mh < 2; ++mh) {
                f32x4 xr[2][2][2];
#pragma unroll
                for (int mm = 0; mm < 2; ++mm)
#pragma unroll
                    for (int bj = 0; bj < 2; ++bj)
#pragma unroll
                        for (int n = 0; n < 2; ++n) xr[mm][bj][n] = __builtin_nontemporal_load((const f32x4*)(src + (size_t)(ai * 128 + (mh * 2 + mm) * 16) * D + bj * 128 + n * 16));
#pragma unroll
                for (int mm = 0; mm < 2; ++mm)
#pragma unroll
                    for (int bj = 0; bj < 2; ++bj)
#pragma unroll
                        for (int n = 0; n < 2; ++n) { const int m = mh * 2 + mm;
                            *(f32x4*)(dst + (size_t)(ai * 128 + m * 16) * D + bj * 128 + n * 16) = ABL_MIX ? xr[mm][bj][n] * ALPHA : xr[mm][bj][n] * ALPHA + gg[bj][n] * (acc[ai][bj][m][n] * inv); } } }
    }
};

struct Args { const float* in[27]; float* out; unsigned char* ws; int ph_lo, ph_hi; };
typedef const Args __attribute__((address_space(4)))* ArgP;
struct Frame {
    LAS unsigned char* lds; int tid, lane, wave, G, bid;
    ArgP ap; float* out; unsigned char* ws;
    __device__ __forceinline__ const float* in(int i) const { return ap->in[i]; }
};
__device__ __forceinline__ Frame make_frame(ArgP ap) {
    { unsigned long long t = (unsigned long long)ap; asm volatile("" : "+s"(t)); ap = (ArgP)t; }
    extern __shared__ __attribute__((aligned(16))) unsigned char lds_raw[];
    Frame F; F.lds = (LAS unsigned char*)lds_raw; { int t_ = threadIdx.x; asm volatile("" : "+v"(t_)); F.tid = t_; }
    F.lane = F.tid & 63; F.wave = __builtin_amdgcn_readfirstlane(F.tid >> 6); F.G = gridDim.x; F.bid = blockIdx.x;
    F.ap = ap; F.out = ap->out; F.ws = ap->ws; return F;
}
template <class T> __device__ __forceinline__ T* wsp(const Frame& F, size_t off) { return (T*)(F.ws + off); }

__device__ __forceinline__ int win_col(int n) {
    if (n < 768) return n;
    if (n < 1792) return 2336 + (n - 768);
    if (n < 2048) return 3360 + (n - 1792);
    if (n < 2304) return 3616 + (n - 2048);
    if (n < 2560) return 800 + (n - 2304);
    if (n < 2816) return 1056 + (n - 2560);
    if (n < 3328) return 1312 + (n - 2816);
    if (n < 3840) return 1824 + (n - 3328);
    if (n < 3872) return 768 + (n - 3840);
    if (n < 4096) return -1;
    return 3872 + (n - 4096);
}
__device__ __forceinline__ int qup_col(int c) {
    const int hh = c / 96, j = c - hh * 96;
    if (j < 64) return c;
    const int jj = j - 64, g8 = jj >> 3, i = jj & 7, p = i >> 1, which = i & 1, part = g8 >> 1, pi = (g8 & 1) * 4 + p;
    return hh * 96 + 64 + part * 16 + which * 8 + pi;
}
template <int MAP>
__device__ __forceinline__ void transpose_cvt(const Frame& F, const float* __restrict__ src, bf16_t* __restrict__ dst, int K, int Nsrc, int Nd) {
    LAS float* tile = (LAS float*)F.lds;
    const int tk = K / 256, tn = Nd / 64, ntile = tk * tn;
    for (int t = F.bid; t < ntile; t += F.G) {
        const int k0 = (t % tk) * 256, n0 = (t / tk) * 64;
        const int nl = F.tid & 63, kq = F.tid >> 6;
        const int nd = n0 + nl; const int ns = MAP == 0 ? nd : (MAP == 1 ? win_col(nd) : qup_col(nd));
        float v[32];
#pragma unroll
        for (int i = 0; i < 32; ++i) v[i] = ns >= 0 ? src[(size_t)(k0 + kq + 8 * i) * Nsrc + ns] : 0.f;
#pragma unroll
        for (int i = 0; i < 32; ++i) tile[(kq + 8 * i) * 65 + nl] = v[i];
        __syncthreads();
        { const int n = F.tid >> 3, k32 = (F.tid & 7) * 32;
#pragma unroll
          for (int c = 0; c < 4; ++c) { float w[8];
#pragma unroll
              for (int j = 0; j < 8; ++j) w[j] = tile[(k32 + c * 8 + j) * 65 + n];
              u32x4 o; o.x = cvt_pk_bf16(w[0], w[1]); o.y = cvt_pk_bf16(w[2], w[3]); o.z = cvt_pk_bf16(w[4], w[5]); o.w = cvt_pk_bf16(w[6], w[7]);
              *(u32x4*)(dst + (size_t)(n0 + n) * K + k0 + k32 + c * 8) = o; } }
        __syncthreads();
    }
}
__device__ __forceinline__ void cvt_rows(const Frame& F, const float* __restrict__ src, bf16_t* __restrict__ dst, size_t n8) {
    for (size_t i = (size_t)F.bid * 512 + F.tid; i < n8; i += (size_t)F.G * 512) {
        const f32x4 a = __builtin_nontemporal_load((const f32x4*)(src + i * 8)), b = __builtin_nontemporal_load((const f32x4*)(src + i * 8 + 4));
        *(u32x4*)(dst + i * 8) = pack8(a, b);
    }
}
__device__ __forceinline__ void cvt_peer(const Frame& F, int l);
__device__ __forceinline__ float max4abs(float am, const f32x4 a) { return fmaxf(fmaxf(fmaxf(am, fabsf(a[0])), fabsf(a[1])), fmaxf(fabsf(a[2]), fabsf(a[3]))); }
__device__ __forceinline__ void absmax_commit(const Frame& F, float am, unsigned* dst) {
    am = row16_max(am);
    { auto r = __builtin_amdgcn_permlane16_swap(__float_as_uint(am), __float_as_uint(am), false, false); am = fmaxf(__uint_as_float(r[0]), __uint_as_float(r[1])); }
    { auto r = __builtin_amdgcn_permlane32_swap(__float_as_uint(am), __float_as_uint(am), false, false); am = fmaxf(__uint_as_float(r[0]), __uint_as_float(r[1])); }
    if (F.lane == 0) atomicMax(dst, __float_as_uint(am));
}
template <int NB>
__device__ __forceinline__ void absmax_f32(const Frame& F, const float* __restrict__ src, size_t n4, unsigned* dst) {
    float am = 0.f;
    const size_t stride = (size_t)F.G * 512; size_t i = (size_t)F.bid * 512 + F.tid;
    for (; i < n4; i += NB * stride) { f32x4 a[NB];
#pragma unroll
        for (int j = 0; j < NB; ++j) { const size_t ix = i + j * stride; a[j] = ix < n4 ? __builtin_nontemporal_load((const f32x4*)(src + ix * 4)) : (f32x4){0.f, 0.f, 0.f, 0.f}; }
#pragma unroll
        for (int j = 0; j < NB; ++j) am = max4abs(am, a[j]); }
    absmax_commit(F, am, dst);
}
__device__ __forceinline__ void absmax4_f32(const Frame& F, const float* s0, size_t n0, unsigned* d0, const float* s1, size_t n1, unsigned* d1, const float* s2, size_t n2, unsigned* d2, const float* s3, size_t n3, unsigned* d3) {
    const size_t stride = (size_t)F.G * 512, i0 = (size_t)F.bid * 512 + F.tid;
    f32x4 a0[2], a1[2], a2[4], a3[8];
#define AM4_LD(a, NB, s, n) _Pragma("unroll") for (int j = 0; j < NB; ++j) { const size_t ix = i0 + j * stride; a[j] = ix < n ? __builtin_nontemporal_load((const f32x4*)(s + ix * 4)) : (f32x4){0.f, 0.f, 0.f, 0.f}; }
    AM4_LD(a0, 2, s0, n0) AM4_LD(a1, 2, s1, n1) AM4_LD(a2, 4, s2, n2) AM4_LD(a3, 8, s3, n3)
#undef AM4_LD
#define AM4_RED(a, NB, s, n, d) { float am = 0.f; _Pragma("unroll") for (int j = 0; j < NB; ++j) am = max4abs(am, a[j]); \
        for (size_t i = i0 + NB * stride; i < n; i += stride) am = max4abs(am, *(const f32x4*)(s + i * 4)); absmax_commit(F, am, d); }
    AM4_RED(a0, 2, s0, n0, d0) AM4_RED(a1, 2, s1, n1, d1) AM4_RED(a2, 4, s2, n2, d2) AM4_RED(a3, 8, s3, n3, d3)
#undef AM4_RED
}
template <int MAP>
__device__ __forceinline__ void transpose_fp8(const Frame& F, const float* __restrict__ src, unsigned char* __restrict__ dst, int K, int Nsrc, int Nd, const unsigned* wsc) {
    float mul, inv; fp8_scale(__hip_atomic_load(wsc, __ATOMIC_RELAXED, __HIP_MEMORY_SCOPE_AGENT), mul, inv);
    LAS float* tile = (LAS float*)F.lds;
    const int tk = K / 256, tn = Nd / 64, ntile = tk * tn;
    for (int t = F.bid; t < ntile; t += F.G) {
        const int k0 = (t % tk) * 256, n0 = (t / tk) * 64;
        const int nl = F.tid & 63, kq = F.tid >> 6; const int ns = MAP ? win_col(n0 + nl) : n0 + nl;
        float v[32];
#pragma unroll
        for (int i = 0; i < 32; ++i) v[i] = ns >= 0 ? src[(size_t)(k0 + kq + 8 * i) * Nsrc + ns] : 0.f;
#pragma unroll
        for (int i = 0; i < 32; ++i) tile[(kq + 8 * i) * 65 + nl] = v[i] * mul;
        __syncthreads();
        { const int n = F.tid >> 3, k32 = (F.tid & 7) * 32;
#pragma unroll
          for (int c = 0; c < 2; ++c) { float w[16];
#pragma unroll
              for (int j = 0; j < 16; ++j) w[j] = tile[(k32 + c * 16 + j) * 65 + n];
              u32x4 o; o.x = pk4_fp8(w[0], w[1], w[2], w[3]); o.y = pk4_fp8(w[4], w[5], w[6], w[7]); o.z = pk4_fp8(w[8], w[9], w[10], w[11]); o.w = pk4_fp8(w[12], w[13], w[14], w[15]);
              *(u32x4*)(dst + (size_t)(n0 + n) * K + k0 + k32 + c * 16) = o; } }
        __syncthreads();
    }
}
template <int PART = 7>
__device__ __forceinline__ void p0_prologue(const Frame& F) {
    { const int gi = F.bid * 512 + F.tid;
      if (gi < 64 * 8) { const int pos = gi >> 3, f = gi & 7; const float inv = powf(10000.f, -(float)f / 8.f); const float a = (float)pos * inv; wsp<f32x2>(F, WS_ROPE32)[gi] = (f32x2){cosf(a), sinf(a)}; }
      else if (gi < 64 * 8 + 64 * 32) { const int g2 = gi - 512; const int pos = g2 >> 5, f = g2 & 31; const float inv = powf(10000.f, -(float)f / 32.f); const float a = (float)pos * inv; wsp<f32x2>(F, WS_ROPE128)[g2] = (f32x2){cosf(a), sinf(a)}; } }
    if (F.bid == 0 && F.tid < 32) wsp<float>(F, WS_DEC)[F.tid] = -log1pf(expf(-F.in(11)[F.tid])) * LOG2E;
#pragma unroll 1
    for (int s3 = 0; s3 < 3; ++s3) { const int part = (s3 + F.bid) % 3;
    if ((PART & 1) && part == 0) { LAS float* sl = (LAS float*)F.lds;
      float* modp = wsp<float>(F, WS_MODP);
      for (int u = F.bid; u < 2 * 24 * 16; u += F.G) {
          const int kc = u & 15, cb = (u >> 4) % 24, l = u / (16 * 24);
          __syncthreads();
          for (int i = F.tid; i < 640; i += 512) { const int v = i >> 7, k = kc * 128 + (i & 127); const float c = v < 4 ? F.in(1)[v * 2048 + k] : F.in(3)[k]; sl[i] = silu_f(c); }
          __syncthreads();
          const int col = cb * 512 + F.tid; const float* w = F.in(4) + ((size_t)l * 2048 + kc * 128) * 12288 + col;
          float a0 = 0.f, a1 = 0.f, a2 = 0.f, a3 = 0.f, a4 = 0.f;
#pragma unroll 32
          for (int k = 0; k < 128; ++k) { const float wv = w[(size_t)k * 12288]; a0 += sl[k] * wv; a1 += sl[128 + k] * wv; a2 += sl[256 + k] * wv; a3 += sl[384 + k] * wv; a4 += sl[512 + k] * wv; }
          float* o = modp + ((size_t)(kc * 2 + l) * 5) * 12288 + col;
          o[0] = a0; o[12288] = a1; o[2 * 12288] = a2; o[3 * 12288] = a3; o[4 * 12288] = a4;
      }
      __syncthreads(); }
    if ((PART & 2) && part == 1) for (int l = 0; l < 2; ++l) {
        absmax_f32<16>(F, F.in(6) + (size_t)l * 2048 * NIN, (size_t)2048 * NIN / 4, wsp<unsigned>(F, WS_WSC) + l);
        absmax4_f32(F, F.in(14) + (size_t)l * 512 * 2048, (size_t)512 * 2048 / 4, wsp<unsigned>(F, WS_WSC) + 4 + l, F.in(15) + (size_t)l * 512 * 2048, (size_t)512 * 2048 / 4, wsp<unsigned>(F, WS_WSC) + 6 + l,
                    F.in(16) + (size_t)l * 1024 * 2048, (size_t)1024 * 2048 / 4, wsp<unsigned>(F, WS_WSC) + 8 + l, F.in(17) + (size_t)l * 2048 * 2048, (size_t)2048 * 2048 / 4, wsp<unsigned>(F, WS_WSC) + 2 + l);
        transpose_cvt<2>(F, F.in(8) + (size_t)l * 512 * 768, wsp<bf16_t>(F, WS_WQUP + l * SZ_WQUP), 512, 768, 768);
        transpose_cvt<0>(F, F.in(10) + (size_t)l * 256 * 1024, wsp<bf16_t>(F, WS_WKVUP + l * SZ_WKVUP), 256, 1024, 1024);
        transpose_cvt<0>(F, F.in(20) + (size_t)l * 2048 * 1024, wsp<bf16_t>(F, WS_WPQ + l * SZ_WPQ), 2048, 1024, 1024);
    }
    if ((PART & 4) && part == 2) cvt_peer(F, 0);
    }
}
__device__ __forceinline__ void p1_modreduce(const Frame& F) {
    const float* modp = wsp<float>(F, WS_MODP); float* mod = wsp<float>(F, WS_MOD);
    for (int i = F.bid * 512 + F.tid; i < 2 * 5 * 12288; i += F.G * 512) {
        const int j = i % 12288, l = i / (5 * 12288);
        float s = F.in(5)[l * 12288 + j];
#pragma unroll
        for (int kc = 0; kc < 16; ++kc) s += modp[(size_t)kc * (2 * 5 * 12288) + i];
        mod[i] = s;
    }
    for (int l = 0; l < 2; ++l) {
        transpose_fp8<1>(F, F.in(6) + (size_t)l * 2048 * NIN, wsp<unsigned char>(F, WS_WIN + l * SZ_WIN), 2048, NIN, NPT, wsp<unsigned>(F, WS_WSC) + l);
        transpose_fp8<0>(F, F.in(17) + (size_t)l * 2048 * 2048, wsp<unsigned char>(F, WS_WOUT + l * SZ_WOUT), 2048, 2048, 2048, wsp<unsigned>(F, WS_WSC) + 2 + l);
        transpose_fp8<0>(F, F.in(14) + (size_t)l * 512 * 2048, wsp<unsigned char>(F, WS_WBRA + l * SZ_WBRA), 512, 2048, 2048, wsp<unsigned>(F, WS_WSC) + 4 + l);
        transpose_fp8<0>(F, F.in(15) + (size_t)l * 512 * 2048, wsp<unsigned char>(F, WS_WBRB + l * SZ_WBRB), 512, 2048, 2048, wsp<unsigned>(F, WS_WSC) + 6 + l);
        transpose_fp8<0>(F, F.in(16) + (size_t)l * 1024 * 2048, wsp<unsigned char>(F, WS_WBRC + l * SZ_WBRC), 1024, 2048, 2048, wsp<unsigned>(F, WS_WSC) + 8 + l);
    }
}
__device__ __forceinline__ void ld_row_f32(const float* p, int lane, float (&x)[32]) {
#pragma unroll
    for (int q = 0; q < 4; ++q) { const f32x4 a = *(const f32x4*)(p + 512 * q + 8 * lane), b = *(const f32x4*)(p + 512 * q + 8 * lane + 4);
        x[q * 8 + 0] = a[0]; x[q * 8 + 1] = a[1]; x[q * 8 + 2] = a[2]; x[q * 8 + 3] = a[3]; x[q * 8 + 4] = b[0]; x[q * 8 + 5] = b[1]; x[q * 8 + 6] = b[2]; x[q * 8 + 7] = b[3]; }
}
__device__ __forceinline__ void st_row_f32(float* p, int lane, const float (&x)[32]) {
#pragma unroll
    for (int q = 0; q < 4; ++q) { *(f32x4*)(p + 512 * q + 8 * lane) = (f32x4){x[q * 8 + 0], x[q * 8 + 1], x[q * 8 + 2], x[q * 8 + 3]}; *(f32x4*)(p + 512 * q + 8 * lane + 4) = (f32x4){x[q * 8 + 4], x[q * 8 + 5], x[q * 8 + 6], x[q * 8 + 7]}; }
}
__device__ __forceinline__ void st_row_bf16(bf16_t* p, int lane, const float (&x)[32]) {
#pragma unroll
    for (int q = 0; q < 4; ++q) { u32x4 w; w.x = cvt_pk_bf16(x[q * 8 + 0], x[q * 8 + 1]); w.y = cvt_pk_bf16(x[q * 8 + 2], x[q * 8 + 3]); w.z = cvt_pk_bf16(x[q * 8 + 4], x[q * 8 + 5]); w.w = cvt_pk_bf16(x[q * 8 + 6], x[q * 8 + 7]);
        *(u32x4*)(p + 512 * q + 8 * lane) = w; }
}
__device__ __forceinline__ void p_modulate0(const Frame& F) {
    const float* mod = wsp<float>(F, WS_MOD); unsigned char* hb8 = wsp<unsigned char>(F, WS_HB8);
    for (int row = F.bid * 8 + F.wave; row < NROW; row += F.G * 8) {
        const RowInfo ri = rowinfo(row);
        const float* xp = ri.lat ? F.in(0) + (size_t)row * D : F.in(2) + (size_t)(row - NLAT) * D;
        const float* mp = mod + (size_t)ri.v * 12288;
        float x[32], sh[32], sc[32];
        ld_row_f32(xp, F.lane, x); ld_row_f32(mp, F.lane, sh); ld_row_f32(mp + 2048, F.lane, sc);
#pragma unroll
        for (int i = 0; i < 32; ++i) x[i] = clamp8(x[i] * (1.f + sc[i]) + sh[i]);
#pragma unroll
        for (int q = 0; q < 4; ++q) { u32x2 w; w.x = pk4_fp8(x[q * 8 + 0], x[q * 8 + 1], x[q * 8 + 2], x[q * 8 + 3]); w.y = pk4_fp8(x[q * 8 + 4], x[q * 8 + 5], x[q * 8 + 6], x[q * 8 + 7]); *(u32x2*)(hb8 + (size_t)row * D + 512 * q + 8 * F.lane) = w; }
    }
}
__device__ __forceinline__ void p_post(const Frame& F, int l) {
    const bf16_t* P1 = wsp<bf16_t>(F, WS_P1);
    bf16_t* CQN = wsp<bf16_t>(F, WS_CQN); bf16_t* CKVN = wsp<bf16_t>(F, WS_CKVN);
    unsigned char* QG = wsp<unsigned char>(F, WS_QG); unsigned char* KG = wsp<unsigned char>(F, WS_KG); unsigned char* VG = wsp<unsigned char>(F, WS_VG);
    bf16_t* RQ = wsp<bf16_t>(F, WS_RQ); bf16_t* RK = wsp<bf16_t>(F, WS_RK); bf16_t* RV = wsp<bf16_t>(F, WS_RV);
    unsigned char* KM = wsp<unsigned char>(F, WS_KM); unsigned char* QM = wsp<unsigned char>(F, WS_QM);
    const f32x2* cs32 = wsp<f32x2>(F, WS_ROPE32); const f32x2* cs128 = wsp<f32x2>(F, WS_ROPE128);
    const float* gq_n = F.in(7) + l * 512; const float* gkv_n = F.in(9) + l * 256; const float* gqa_qn = F.in(12) + l * 128; const float* gqa_kn = F.in(13) + l * 128;
    LAS bf16_t* rs = (LAS bf16_t*)(F.lds + F.wave * 8192);
    const int lane = F.lane;
    const f32x4 gq0 = *(const f32x4*)(gq_n + lane * 8), gq1 = *(const f32x4*)(gq_n + lane * 8 + 4), gkv0 = *(const f32x4*)(gkv_n + lane * 4);
    const int gd0 = 2 * lane; const int gpart = gd0 >> 6, gdd = gd0 & 63; const bool glo = gdd < 32; const int gf = glo ? gdd : gdd - 32; const int gdp = glo ? gd0 + 32 : gd0 - 32;
    const float qn0 = gqa_qn[gd0], qn1 = gqa_qn[gd0 + 1], qnp0 = gqa_qn[gdp], qnp1 = gqa_qn[gdp + 1];
    const float kn0 = gqa_kn[gd0], kn1 = gqa_kn[gd0 + 1], knp0 = gqa_kn[gdp], knp1 = gqa_kn[gdp + 1];
    const int rhh = lane >> 3, rd0 = (lane & 7) * 4; const int rpart = rd0 >> 4, rdd = rd0 & 15; const bool rlo = rdd < 8; const int rf = rlo ? rdd : rdd - 8; const int rdp = rlo ? rd0 + 8 : rd0 - 8;
    const int step = F.G * 8;
    int row = F.bid * 8 + F.wave;
    u32x4 pre[8];
    if (row < NROW) {
#pragma unroll
        for (int q = 0; q < 8; ++q) pre[q] = *(const u32x4*)(P1 + (size_t)row * NP1 + q * 512 + lane * 8); }
#pragma unroll 1
    for (; row < NROW; row += step) {
        const RowInfo ri = rowinfo(row);
        const int posg = gpart ? ri.pc : ri.pr, posr = rpart ? ri.pc : ri.pr;
        const f32x2 one = {1.f, 0.f};
        const f32x2 csA = ri.lat ? cs128[posg * 32 + gf] : one, csB = ri.lat ? cs128[posg * 32 + gf + 1] : one;
        f32x2 cs[4];
#pragma unroll
        for (int i = 0; i < 4; ++i) cs[i] = ri.lat ? cs32[posr * 8 + rf + i] : one;
#pragma unroll
        for (int q = 0; q < 8; ++q) *(LAS u32x4*)(rs + q * 512 + lane * 8) = pre[q];
        { const int nrow = row + step; if (nrow < NROW) {
#pragma unroll
            for (int q = 0; q < 8; ++q) pre[q] = *(const u32x4*)(P1 + (size_t)nrow * NP1 + q * 512 + lane * 8); } }
        asm volatile("s_waitcnt lgkmcnt(0)" ::: "memory");
        { float x[8]; float ss = 0.f;
#pragma unroll
          for (int i = 0; i < 8; ++i) { x[i] = bf2f(rs[C_CQ + lane * 8 + i]); ss += x[i] * x[i]; }
          ss = wave_sum(ss); const float r = rsqrtf(ss * (1.f / 512.f) + RMS_EPS);
          *(u32x4*)(CQN + (size_t)row * 512 + lane * 8) = pack8((f32x4){x[0] * r * gq0[0], x[1] * r * gq0[1], x[2] * r * gq0[2], x[3] * r * gq0[3]}, (f32x4){x[4] * r * gq1[0], x[5] * r * gq1[1], x[6] * r * gq1[2], x[7] * r * gq1[3]}); }
        { float x[4]; float ss = 0.f;
#pragma unroll
          for (int i = 0; i < 4; ++i) { x[i] = bf2f(rs[C_CKV + lane * 4 + i]); ss += x[i] * x[i]; }
          ss = wave_sum(ss); const float r = rsqrtf(ss * (1.f / 256.f) + RMS_EPS);
          u32x2 w; w.x = cvt_pk_bf16(x[0] * r * gkv0[0], x[1] * r * gkv0[1]); w.y = cvt_pk_bf16(x[2] * r * gkv0[2], x[3] * r * gkv0[3]);
          *(u32x2*)(CKVN + (size_t)row * 256 + lane * 4) = w; }
        {
            const int d0 = gd0, dp = gdp; const bool lo = glo;
#pragma unroll 1
            for (int hh = 0; hh < 10; ++hh) {
                const bool isq = hh < 8; const int cbase = isq ? C_GQ + hh * 128 : C_GK + (hh - 8) * 128;
                const float g0 = isq ? qn0 : kn0, g1 = isq ? qn1 : kn1, gp0 = isq ? qnp0 : knp0, gp1 = isq ? qnp1 : knp1;
                const float a0 = bf2f(rs[cbase + d0]), a1 = bf2f(rs[cbase + d0 + 1]);
                float ss = wave_sum(a0 * a0 + a1 * a1); const float r = rsqrtf(ss * (1.f / 128.f) + RMS_EPS);
                const float n0 = a0 * r * g0, n1 = a1 * r * g1;
                const float p0 = bf2f(rs[cbase + dp]) * r * gp0, p1 = bf2f(rs[cbase + dp + 1]) * r * gp1;
                float o0, o1;
                if (lo) { o0 = n0 * csA.x - p0 * csA.y; o1 = n1 * csB.x - p1 * csB.y; }
                else    { o0 = p0 * csA.y + n0 * csA.x; o1 = p1 * csB.y + n1 * csB.x; }
                unsigned char* dst = isq ? QG + ((size_t)(ri.b * 8 + hh) * TT + ri.tpos) * 128 : KG + ((size_t)(ri.b * 2 + (hh - 8)) * TT + ri.tpos) * 128;
                const float sc8_ = isq ? QSC_G : KSC8;
                *(unsigned short*)(dst + d0) = (unsigned short)(pk4_fp8(clamp8(o0 * sc8_), clamp8(o1 * sc8_), 0.f, 0.f) & 0xffffu);
            }
#pragma unroll
            for (int hh = 0; hh < 2; ++hh) { const unsigned w8_ = pk4_fp8(clamp8(bf2f(rs[C_GV + hh * 128 + d0])), clamp8(bf2f(rs[C_GV + hh * 128 + d0 + 1])), 0.f, 0.f); unsigned char* vp_ = VG + ((size_t)(ri.b * 2 + hh) * 128 + d0) * TT + vt_off(ri.tpos);
                vp_[0] = (unsigned char)(w8_ & 0xffu); vp_[TT] = (unsigned char)((w8_ >> 8) & 0xffu); }
        }
        {
            const int hh = rhh, d0 = rd0, dp = rdp; const bool lo = rlo;
#pragma unroll
            for (int which = 0; which < 2; ++which) {
                const int cbase = (which ? C_RK : C_RQ) + hh * 32; const float sc = which ? 0.17677669529663687f : 1.f;
                float o[4];
#pragma unroll
                for (int i = 0; i < 4; ++i) { const float n = bf2f(rs[cbase + d0 + i]), p = bf2f(rs[cbase + dp + i]);
                    o[i] = (lo ? (n * cs[i].x - p * cs[i].y) : (p * cs[i].y + n * cs[i].x)) * sc; }
                u32x2 w; w.x = cvt_pk_bf16(o[0], o[1]); w.y = cvt_pk_bf16(o[2], o[3]);
                *(u32x2*)((which ? RK : RQ) + ((size_t)(ri.b * 8 + hh) * TT + ri.tpos) * 32 + d0) = w;
            }
            { const int vh = lane >> 3, e0 = (lane & 7) * 8;
              *(u32x4*)(RV + ((size_t)(ri.b * 8 + vh) * TT + ri.tpos) * 64 + e0) = *(LAS u32x4*)(rs + C_RV + lane * 8); }
            { float o[4];
#pragma unroll
              for (int i = 0; i < 4; ++i) { const float n = bf2f(rs[C_KR + d0 + i]), p = bf2f(rs[C_KR + dp + i]); o[i] = lo ? (n * cs[i].x - p * cs[i].y) : (p * cs[i].y + n * cs[i].x); }
              const size_t tok_ = ((size_t)(ri.b * 8 + hh) * TT + ri.tpos) * 128;
              *(unsigned*)(KM + tok_ + 64 + d0) = pk4_fp8(clamp8(o[0] * KSC8), clamp8(o[1] * KSC8), clamp8(o[2] * KSC8), clamp8(o[3] * KSC8));
              *(unsigned*)(KM + tok_ + 96 + d0) = 0u; *(unsigned*)(QM + tok_ + 96 + d0) = 0u; }
        }
        asm volatile("s_waitcnt lgkmcnt(0)" ::: "memory");
    }
}

__device__ __forceinline__ void ret_logs(const Frame& F, int l, int h, float& lgf, float& lgb) {
    const float* t = wsp<float>(F, WS_DEC); lgf = t[(l * 2 + 0) * 8 + h]; lgb = t[(l * 2 + 1) * 8 + h];
}
constexpr int TP = 136;
template <bool WITH_K>
__device__ __forceinline__ void ret_stage(const Frame& F, const bf16_t* RKh, const bf16_t* RVh, int tpos0, float lgf, float lgb, LAS bf16_t* vt, LAS bf16_t* ktf, LAS bf16_t* ktb) {
#pragma unroll
    for (int i = 0; i < 2; ++i) { const int tok = (F.tid >> 3) + 64 * i, e0 = (F.tid & 7) * 8;
        const u32x4 w = *(const u32x4*)(RVh + (size_t)(tpos0 + tok) * 64 + e0); const unsigned ww[4] = {w.x, w.y, w.z, w.w};
#pragma unroll
        for (int j = 0; j < 4; ++j) { vt[(e0 + 2 * j) * TP + tok] = (bf16_t)(ww[j] & 0xffffu); vt[(e0 + 2 * j + 1) * TP + tok] = (bf16_t)(ww[j] >> 16); } }
    if (WITH_K) { const int tok = F.tid >> 2, k0 = (F.tid & 3) * 8;
        const u32x4 w = *(const u32x4*)(RKh + (size_t)(tpos0 + tok) * 32 + k0); const unsigned ww[4] = {w.x, w.y, w.z, w.w};
        const float zf = exp2f(lgf * (float)(127 - tok)), zb = exp2f(lgb * (float)tok);
#pragma unroll
        for (int j = 0; j < 4; ++j) { const float a = bflo(ww[j]), b = bfhi(ww[j]);
            ktf[(k0 + 2 * j) * TP + tok] = f2bf(a * zf); ktf[(k0 + 2 * j + 1) * TP + tok] = f2bf(b * zf);
            ktb[(k0 + 2 * j) * TP + tok] = f2bf(a * zb); ktb[(k0 + 2 * j + 1) * TP + tok] = f2bf(b * zb); } }
}
__device__ __forceinline__ void p_ret_states(const Frame& F, int l) {
    LAS bf16_t* vt = (LAS bf16_t*)F.lds; LAS bf16_t* ktf = vt + 64 * TP; LAS bf16_t* ktb = ktf + 32 * TP;
    float* ST = wsp<float>(F, WS_ST);
    const int lane = F.lane, w = F.wave, kb = w >> 2, eb = w & 3, fr = lane & 15, fq = lane >> 4;
    for (int u = F.bid; u < NB * 8 * 34; u += F.G) {
        const int c = u % 34, bh = u / 34, h = bh & 7;
        float lgf, lgb; ret_logs(F, l, h, lgf, lgb);
        __syncthreads();
        ret_stage<true>(F, wsp<bf16_t>(F, WS_RK) + (size_t)bh * TT * 32, wsp<bf16_t>(F, WS_RV) + (size_t)bh * TT * 64, c * 128, lgf, lgb, vt, ktf, ktb);
        __syncthreads();
        f32x4 sf = {0.f, 0.f, 0.f, 0.f}, sb = {0.f, 0.f, 0.f, 0.f};
#pragma unroll
        for (int ks = 0; ks < 4; ++ks) {
            const bf16x8 bv = *(const LAS bf16x8*)(vt + (eb * 16 + fr) * TP + ks * 32 + fq * 8);
            const bf16x8 af = *(const LAS bf16x8*)(ktf + (kb * 16 + fr) * TP + ks * 32 + fq * 8);
            const bf16x8 ab = *(const LAS bf16x8*)(ktb + (kb * 16 + fr) * TP + ks * 32 + fq * 8);
            sf = __builtin_amdgcn_mfma_f32_16x16x32_bf16(af, bv, sf, 0, 0, 0);
            sb = __builtin_amdgcn_mfma_f32_16x16x32_bf16(ab, bv, sb, 0, 0, 0);
        }
        float* o = ST + (size_t)u * 2 * 2048;
#pragma unroll
        for (int r = 0; r < 4; ++r) { const int kd = kb * 16 + fq * 4 + r, e = eb * 16 + fr; o[kd * 64 + e] = sf[r]; o[2048 + kd * 64 + e] = sb[r]; }
    }
}
constexpr int RP = 40;
constexpr int AP = 136;
__device__ __forceinline__ void ret_out_unit(const Frame& F, int l, int bh, int c) {
    LAS bf16_t* vt = (LAS bf16_t*)F.lds; LAS bf16_t* rtf = vt + 64 * TP; LAS bf16_t* rtb = rtf + 64 * RP; LAS bf16_t* as = rtb + 64 * RP + F.wave * 16 * AP;
    const int lane = F.lane, w = F.wave, fr = lane & 15, fq = lane >> 4, h = bh & 7, b = bh >> 3;
    const bf16_t* RQh = wsp<bf16_t>(F, WS_RQ) + (size_t)bh * TT * 32; const bf16_t* RKh = wsp<bf16_t>(F, WS_RK) + (size_t)bh * TT * 32; const bf16_t* RVh = wsp<bf16_t>(F, WS_RV) + (size_t)bh * TT * 64;
    const float* STh = wsp<float>(F, WS_ST) + (size_t)bh * 34 * 2 * 2048;
    float lgf, lgb; ret_logs(F, l, h, lgf, lgb);
    const int tpos0 = c * 128;
    const int i0 = w * 16;
    const bf16x8 qa = *(const bf16x8*)(RQh + (size_t)(tpos0 + i0 + fr) * 32 + fq * 8);
    bf16x8 kfr[8];
#pragma unroll
    for (int nb = 0; nb < 8; ++nb) kfr[nb] = *(const bf16x8*)(RKh + (size_t)(tpos0 + nb * 16 + fr) * 32 + fq * 8);
    const bf16_t* P1 = wsp<bf16_t>(F, WS_P1); unsigned char* OAB = wsp<unsigned char>(F, WS_OAB);
    bf16_t gv[4][4];
#pragma unroll
    for (int r = 0; r < 4; ++r) { const int tp = tpos0 + i0 + fq * 4 + r; const size_t grow = tp >= CTXL ? (size_t)b * SEQ + (tp - CTXL) : (size_t)NLAT + b * CTXL + tp;
#pragma unroll
        for (int eb = 0; eb < 4; ++eb) gv[r][eb] = P1[grow * NP1 + C_RG + h * 64 + eb * 16 + fr]; }
    __syncthreads();
    ret_stage<false>(F, RKh, RVh, tpos0, lgf, lgb, vt, nullptr, nullptr);
    { const int kd = F.tid >> 4, e4 = (F.tid & 15) * 4; f32x4 rf = {0.f, 0.f, 0.f, 0.f}, rb = {0.f, 0.f, 0.f, 0.f};
      if (c >= 2) {
          const int p = c - 2;
          const float kff = 80.f / (-lgf * 128.f), kfb = 80.f / (-lgb * 128.f); const int kcf = kff < 64.f ? (int)kff + 1 : 64, kcb = kfb < 64.f ? (int)kfb + 1 : 64;
          const int nf = c < kcf ? c : kcf, nb_ = (33 - p) < kcb ? (33 - p) : kcb;
          const float* sf = STh + kd * 64 + e4;
          for (int k0 = 0; k0 < nf; k0 += 8) { f32x4 v[8];
#pragma unroll
              for (int j = 0; j < 8; ++j) { const int k = k0 + j; const int cp = k < nf ? c - 1 - k : 0; v[j] = *(const f32x4*)(sf + (size_t)(cp * 2 + 0) * 2048); }
#pragma unroll
              for (int j = 0; j < 8; ++j) { const int k = k0 + j; const float wgt = k < nf ? __builtin_amdgcn_exp2f(lgf * 128.f * (float)k) : 0.f; rf += v[j] * wgt; } }
          for (int k0 = 0; k0 < nb_; k0 += 8) { f32x4 v[8];
#pragma unroll
              for (int j = 0; j < 8; ++j) { const int k = k0 + j; const int pp = k < nb_ ? p + 1 + k : 33; const int cs = pp < 32 ? pp + 2 : pp - 32; v[j] = *(const f32x4*)(sf + (size_t)(cs * 2 + 1) * 2048); }
#pragma unroll
              for (int j = 0; j < 8; ++j) { const int k = k0 + j; const float wgt = k < nb_ ? __builtin_amdgcn_exp2f(lgb * 128.f * (float)k) : 0.f; rb += v[j] * wgt; } }
      } else if (c == 0) { rb = *(const f32x4*)(STh + (size_t)(1 * 2 + 1) * 2048 + kd * 64 + e4); }
      else { rf = *(const f32x4*)(STh + (size_t)(0 * 2 + 0) * 2048 + kd * 64 + e4); }
#pragma unroll
      for (int j = 0; j < 4; ++j) { rtf[(e4 + j) * RP + kd] = f2bf(rf[j]); rtb[(e4 + j) * RP + kd] = f2bf(rb[j]); } }
    f32x4 s[8];
#pragma unroll
    for (int nb = 0; nb < 8; ++nb) s[nb] = __builtin_amdgcn_mfma_f32_16x16x32_bf16(qa, kfr[nb], (f32x4){0.f, 0.f, 0.f, 0.f}, 0, 0, 0);
#pragma unroll
    for (int nb = 0; nb < 8; ++nb)
#pragma unroll
        for (int r = 0; r < 4; ++r) { const int i = i0 + fq * 4 + r, j = nb * 16 + fr; const int df = i - j;
            const float mk = df > 0 ? exp2f(lgf * (float)df) : (df < 0 ? exp2f(lgb * (float)(-df)) : 2.f);
            as[(fq * 4 + r) * AP + j] = f2bf(s[nb][r] * mk); }
    __syncthreads();
    f32x4 y[4];
#pragma unroll
    for (int eb = 0; eb < 4; ++eb) y[eb] = (f32x4){0.f, 0.f, 0.f, 0.f};
#pragma unroll
    for (int ks = 0; ks < 4; ++ks) { const bf16x8 af = *(const LAS bf16x8*)(as + fr * AP + ks * 32 + fq * 8);
#pragma unroll
        for (int eb = 0; eb < 4; ++eb) { const bf16x8 bv = *(const LAS bf16x8*)(vt + (eb * 16 + fr) * TP + ks * 32 + fq * 8);
            y[eb] = __builtin_amdgcn_mfma_f32_16x16x32_bf16(af, bv, y[eb], 0, 0, 0); } }
    { const float xf = exp2f(lgf * (float)(i0 + fr + 1)), xb = exp2f(lgb * (float)(128 - (i0 + fr)));
      bf16x8 qf, qb;
#pragma unroll
      for (int j = 0; j < 8; ++j) { const float qv = bf2f((bf16_t)qa[j]); qf[j] = (short)f2bf(qv * xf); qb[j] = (short)f2bf(qv * xb); }
#pragma unroll
      for (int eb = 0; eb < 4; ++eb) { const bf16x8 bf_ = *(const LAS bf16x8*)(rtf + (eb * 16 + fr) * RP + fq * 8), bb_ = *(const LAS bf16x8*)(rtb + (eb * 16 + fr) * RP + fq * 8);
          y[eb] = __builtin_amdgcn_mfma_f32_16x16x32_bf16(qf, bf_, y[eb], 0, 0, 0);
          y[eb] = __builtin_amdgcn_mfma_f32_16x16x32_bf16(qb, bb_, y[eb], 0, 0, 0); } }
#pragma unroll
    for (int r = 0; r < 4; ++r) {
        float sm = y[0][r] + y[1][r] + y[2][r] + y[3][r]; sm = row16_sum(sm); const float mu = sm * (1.f / 64.f);
        float vs = 0.f;
#pragma unroll
        for (int eb = 0; eb < 4; ++eb) { const float d = y[eb][r] - mu; vs += d * d; }
        vs = row16_sum(vs); const float rstd = rsqrtf(vs * (1.f / 64.f) + LN_EPS);
        const int i = i0 + fq * 4 + r; const int tp = tpos0 + i; const size_t grow = tp >= CTXL ? (size_t)b * SEQ + (tp - CTXL) : (size_t)NLAT + b * CTXL + tp;
#pragma unroll
        for (int eb = 0; eb < 4; ++eb) { const int e = eb * 16 + fr; const float g = bf2f(gv[r][eb]);
            OAB[grow * D + 512 + h * 64 + e] = (unsigned char)(pk4_fp8(clamp8(silu_f(g) * (y[eb][r] - mu) * rstd * 16.f), 0.f, 0.f, 0.f) & 0xffu); }
    }
}
namespace att {
constexpr int NW = 8, QBLK = 32, KVBLK = 64;
constexpr int SHM_K = KVBLK * 128, SHM_V = 128 * 64;
constexpr size_t SHM_ATTN = 4 * SHM_K + 3 * SHM_V;
constexpr float THR = 1.9f, PSH = 6.f, THR2 = THR * 1.4426950408889634f;
#define SBAR() __builtin_amdgcn_sched_barrier(0)
typedef int i32x8a __attribute__((ext_vector_type(8))); typedef int i32x4a __attribute__((ext_vector_type(4)));
template <int SC> struct Scale { static constexpr float S = SC == 0 ? 0.08838834764831845f : 0.10206207261596575f; static constexpr float C = S * 1.4426950408889634f; static constexpr float THRR = THR / S; };
#define KSWZ8(row, chunk) ((row) * 128 + ((((chunk) ^ (((row) >> 1) & 7))) << 4))
#define VSWZ8(col, chunk) ((col) * 64 + ((((chunk) ^ (((col) >> 2) & 3))) << 4))
#define MF8(A, B, C) mf8x<ABL>(A, B, C)
#define CAT8(lo, hi) __builtin_shufflevector(lo, hi, 0, 1, 2, 3, 4, 5, 6, 7)
#define LDS16(p) ((ABL & 8) ? __builtin_shufflevector(qr8[0], qr8[1], 0, 1, 10, 11) : *(const LAS i32x4a*)(p))
template <int A, int B, int ABL = 0> __device__ __forceinline__ void exp_rng(f32x16& p) {
#pragma unroll
  for (int r = A; r < B; ++r) p[r] = (ABL & 1) ? p[r] * p[r] : __builtin_amdgcn_exp2f(p[r]);
}
template <int ABL> __device__ __forceinline__ f32x16 mf8x(const i32x8a a, const i32x8a b, f32x16 c) {
  if constexpr (ABL & 2) { c[0] += __int_as_float(((a[0] ^ a[4]) + (b[0] ^ b[4])) & 0x3f000000); return c; }
  else return __builtin_amdgcn_mfma_scale_f32_32x32x64_f8f6f4(a, b, c, 0, 0, 0, 0x7F7F7F7F, 0, 0x7F7F7F7F);
}
__device__ __forceinline__ void pk_fma16(f32x16& p, float c, float d) { const f32x2 c2 = {c, c}, d2 = {d, d};
#pragma unroll
  for (int i = 0; i < 8; ++i) { f32x2 v = {p[2 * i], p[2 * i + 1]}; v = v * c2 + d2; p[2 * i] = v.x; p[2 * i + 1] = v.y; }
}
__device__ __forceinline__ void pk_add16(f32x16& p, float c) { const f32x2 c2 = {c, c};
#pragma unroll
  for (int i = 0; i < 8; ++i) { f32x2 v = {p[2 * i], p[2 * i + 1]}; v = v + c2; p[2 * i] = v.x; p[2 * i + 1] = v.y; }
}
__device__ __forceinline__ void pk_mul16(f32x16& p, float c) { const f32x2 c2 = {c, c};
#pragma unroll
  for (int i = 0; i < 8; ++i) { f32x2 v = {p[2 * i], p[2 * i + 1]}; v = v * c2; p[2 * i] = v.x; p[2 * i + 1] = v.y; }
}
__device__ __forceinline__ float pk_sum32(const f32x16& p0, const f32x16& p1) { f32x2 s0 = {p0[0], p0[1]}, s1 = {p1[0], p1[1]};
#pragma unroll
  for (int i = 1; i < 8; ++i) { s0 += (f32x2){p0[2 * i], p0[2 * i + 1]}; s1 += (f32x2){p1[2 * i], p1[2 * i + 1]}; }
  s0 += s1; return s0.x + s0.y;
}
__device__ __forceinline__ float hsum(float v) { auto rr = __builtin_amdgcn_permlane32_swap(__float_as_uint(v), __float_as_uint(v), false, false); return __uint_as_float(rr[0]) + __uint_as_float(rr[1]); }
__device__ __forceinline__ float hmax(float v) { auto rr = __builtin_amdgcn_permlane32_swap(__float_as_uint(v), __float_as_uint(v), false, false); return fmaxf(__uint_as_float(rr[0]), __uint_as_float(rr[1])); }
template <int NDV, int SC, int ABL>
__device__ __forceinline__ void attn_body(const unsigned char* __restrict__ Qb, const unsigned char* __restrict__ Kh, const unsigned char* __restrict__ Vt,
                                          unsigned char* __restrict__ Ob, int seq, LAS unsigned char* lds, const int tid) {
  constexpr int ldo = 2048;
  const int wid = __builtin_amdgcn_readfirstlane(tid >> 6), lane = tid & 63, r32 = lane & 31, hi = lane >> 5;
  LAS unsigned char* K_lds = lds; LAS unsigned char* V_lds = lds + 4 * SHM_K;
  float l_reg = 0; f32x16 o[NDV] = {}; f32x16 negm; i32x8a qr8[2];
  const unsigned char* Qw = Qb + (long)(wid * QBLK + r32) * 128 + hi * 32;
#pragma unroll
  for (int blk = 0; blk < 2; ++blk) { const i32x4a lo_ = *reinterpret_cast<const i32x4a*>(Qw + blk * 64), hi_ = *reinterpret_cast<const i32x4a*>(Qw + blk * 64 + 16); qr8[blk] = CAT8(lo_, hi_); }
  const int NT = seq / KVBLK;
  const int kr8 = 8 * wid + (lane >> 3), vcol = 16 * (wid & (NDV * 2 - 1)) + (lane >> 2);
  const unsigned char* kgp = Kh + (long)kr8 * 128 + (((lane & 7) ^ ((kr8 >> 1) & 7)) << 4);
  const unsigned char* vgp = Vt + (long)vcol * TT + (((lane & 3) ^ ((vcol >> 2) & 3)) << 4);
  const int kdo = wid * 1024, vdo = (wid & (NDV * 2 - 1)) * 1024;
  const int ka0 = KSWZ8(r32, 2 * hi), ka1 = KSWZ8(r32, 2 * hi + 1), va0 = VSWZ8(r32, 2 * hi), va1 = VSWZ8(r32, 2 * hi + 1);
#define DMAK(t, bo) do { const int t_ = (t) < NT ? (t) : NT - 1; __builtin_amdgcn_global_load_lds((const unsigned*)(kgp + (long)t_ * (KVBLK * 128)), (LAS unsigned*)(K_lds + (bo) + kdo), 16, 0, 0); } while (0)
#define DMAV(t, bo) do { const int t_ = (t) < NT ? (t) : NT - 1; __builtin_amdgcn_global_load_lds((const unsigned*)(vgp + t_ * KVBLK), (LAS unsigned*)(V_lds + (bo) + vdo), 16, 0, 0); } while (0)
#define VMW(n) asm volatile("s_waitcnt vmcnt(" #n ")" ::: "memory")
#define BAR() __builtin_amdgcn_s_barrier()
  f32x16 pA0, pA1, pB0, pB1; float alA, alB; i32x8a pa;
#define PSM2(p0, p1, al) do { float pm_ = fmaxf(p0[0], p1[0]);                                                                          \
    _Pragma("unroll") for (int r = 1; r < 16; ++r) pm_ = fmaxf(fmaxf(pm_, p0[r]), p1[r]);                                               \
    pm_ = hmax(pm_); al = 1.f;                                                                                                           \
    if (__builtin_expect(!__all(pm_ <= PSH + THR2), 0)) { const float d_ = fmaxf(pm_ - PSH, 0.f); al = __builtin_amdgcn_exp2f(-d_); pk_add16(p0, -d_); pk_add16(p1, -d_); pk_add16(negm, -d_); } } while (0)
#define PT3(x, y, z) asm volatile("" : "+v"(x), "+v"(y), "+v"(z))
#define PT4(x, y, z, w) asm volatile("" : "+v"(x), "+v"(y), "+v"(z), "+v"(w))
#define STEP(j, pc0, pc1, alc, pn0, pn1, aln) do { const LAS unsigned char* Kr_ = K_lds + kb_rd; const LAS unsigned char* Vs_ = V_lds + vb_rd;  \
    i32x8a kc_ = CAT8(LDS16(Kr_ + (ka0 ^ 64)), LDS16(Kr_ + (ka1 ^ 64))), kd_ = CAT8(LDS16(Kr_ + 4096 + (ka0 ^ 64)), LDS16(Kr_ + 4096 + (ka1 ^ 64))); \
    pn0 = MF8(kpa, qr8[0], negm); exp_rng<0, 6, ABL>(pc1); PT3(pn0, pc1, kpb);                                                     \
    pn1 = MF8(kpb, qr8[0], negm); exp_rng<6, 12, ABL>(pc1); PT3(pn1, pc1, kc_);                                                    \
    pn0 = MF8(kc_, qr8[1], pn0); exp_rng<12, 16, ABL>(pc1);                                                                              \
    { float ps_ = pk_sum32(pc0, pc1); ps_ = hsum(ps_); l_reg = l_reg * alc + ps_; }                                                      \
    i32x8a va_ = CAT8(LDS16(Vs_ + va0), LDS16(Vs_ + va1)), vb_ = CAT8(LDS16(Vs_ + 2048 + va0), LDS16(Vs_ + 2048 + va1));                  \
    PT4(pn0, pc1, kd_, l_reg);                                                                                                           \
    pn1 = MF8(kd_, qr8[1], pn1);                                                                                                         \
    _Pragma("unroll") for (int q = 0; q < 4; ++q) { pa[q] = (int)pk4_fp8(pc0[4 * q], pc0[4 * q + 1], pc0[4 * q + 2], pc0[4 * q + 3]); pa[4 + q] = (int)pk4_fp8(pc1[4 * q], pc1[4 * q + 1], pc1[4 * q + 2], pc1[4 * q + 3]); } \
    PT3(pn1, pa, va_);                                                                                                                   \
    if constexpr (!(ABL & 128)) { DMAK((j) + 4, kb_wr); DMAV((j) + 2, vb_wr); }                                                          \
    o[0] = MF8(va_, pa, o[0]); PSM2(pn0, pn1, aln); PT3(o[0], pn0, vb_);                                                  \
    o[1] = MF8(vb_, pa, o[1]); exp_rng<0, 4, ABL>(pn0);                                   \
    if constexpr (NDV == 4) { i32x8a vc_ = CAT8(LDS16(Vs_ + 4096 + va0), LDS16(Vs_ + 4096 + va1)), vd_ = CAT8(LDS16(Vs_ + 6144 + va0), LDS16(Vs_ + 6144 + va1)); \
      PT4(o[1], pn0, pn1, vc_); o[2] = MF8(vc_, pa, o[2]); exp_rng<4, 10, ABL>(pn0); PT3(o[2], pn0, vd_);                                \
      o[3] = MF8(vd_, pa, o[3]); exp_rng<10, 16, ABL>(pn0); }                                                                            \
    else { PT3(o[1], pn0, pn1); exp_rng<4, 16, ABL>(pn0); }                                                                              \
    { const LAS unsigned char* Kp_ = K_lds + kb_pf; kpa = CAT8(LDS16(Kp_ + ka0), LDS16(Kp_ + ka1)); kpb = CAT8(LDS16(Kp_ + 4096 + ka0), LDS16(Kp_ + 4096 + ka1)); } \
    PT3(o[NDV - 1], pn0, pn1); RESC(aln);                                                                                               \
    { const int t_ = kb_rd; kb_rd = kb_pf; kb_pf = kb_x; kb_x = kb_wr; kb_wr = t_; const int u_ = vb_rd; vb_rd = vb_n1; vb_n1 = vb_wr; vb_wr = u_; } \
    VMW(2); if constexpr (!(ABL & 4)) BAR(); } while (0)
#define RESC(a) do { if (__any((a) < 1.f)) { _Pragma("unroll") for (int d = 0; d < NDV; ++d) pk_mul16(o[d], (a)); } } while (0)
  i32x8a kpa, kpb; int kb_rd = SHM_K, kb_pf = 2 * SHM_K, kb_x = 3 * SHM_K, kb_wr = 0, vb_rd = 0, vb_n1 = SHM_V, vb_wr = 2 * SHM_V;
  DMAK(0, 0); DMAK(1, SHM_K); DMAK(2, 2 * SHM_K); DMAK(3, 3 * SHM_K); DMAV(0, 0); DMAV(1, SHM_V); VMW(0); BAR();
  { const LAS unsigned char* Ks_ = K_lds;
    pA0 = MF8(CAT8(LDS16(Ks_ + ka0), LDS16(Ks_ + ka1)), qr8[0], (f32x16){}); pA1 = MF8(CAT8(LDS16(Ks_ + 4096 + ka0), LDS16(Ks_ + 4096 + ka1)), qr8[0], (f32x16){});
    pA0 = MF8(CAT8(LDS16(Ks_ + (ka0 ^ 64)), LDS16(Ks_ + (ka1 ^ 64))), qr8[1], pA0); pA1 = MF8(CAT8(LDS16(Ks_ + 4096 + (ka0 ^ 64)), LDS16(Ks_ + 4096 + (ka1 ^ 64))), qr8[1], pA1);
    float pm_ = fmaxf(pA0[0], pA1[0]);
#pragma unroll
    for (int r = 1; r < 16; ++r) pm_ = fmaxf(fmaxf(pm_, pA0[r]), pA1[r]);
    pm_ = hmax(pm_);
    const float nv_ = PSH - pm_; pk_add16(pA0, nv_); pk_add16(pA1, nv_);
#pragma unroll
    for (int r = 0; r < 16; ++r) negm[r] = nv_;
    alA = 1.f; exp_rng<0, 16, ABL>(pA0);
    const LAS unsigned char* Kp_ = K_lds + SHM_K; kpa = CAT8(LDS16(Kp_ + ka0), LDS16(Kp_ + ka1)); kpb = CAT8(LDS16(Kp_ + 4096 + ka0), LDS16(Kp_ + 4096 + ka1)); }
  asm volatile("s_waitcnt lgkmcnt(0)" ::: "memory"); BAR();
  int j = 0;
  for (; j + 2 < NT; j += 2) { STEP(j, pA0, pA1, alA, pB0, pB1, alB); STEP(j + 1, pB0, pB1, alB, pA0, pA1, alA); }
  STEP(j, pA0, pA1, alA, pB0, pB1, alB);
  { exp_rng<0, 16, ABL>(pB1); float ps_ = pk_sum32(pB0, pB1); ps_ = hsum(ps_); l_reg = l_reg * alB + ps_;
#pragma unroll
    for (int q = 0; q < 4; ++q) { pa[q] = (int)pk4_fp8(pB0[4 * q], pB0[4 * q + 1], pB0[4 * q + 2], pB0[4 * q + 3]); pa[4 + q] = (int)pk4_fp8(pB1[4 * q], pB1[4 * q + 1], pB1[4 * q + 2], pB1[4 * q + 3]); }
    const LAS unsigned char* Vs_ = V_lds + vb_rd;
#pragma unroll
    for (int d0 = 0; d0 < NDV; ++d0) o[d0] = MF8(CAT8(LDS16(Vs_ + d0 * 2048 + va0), LDS16(Vs_ + d0 * 2048 + va1)), pa, o[d0]); }
  const float rl = __builtin_amdgcn_rcpf(l_reg) * 16.f;
  unsigned char* Ow = Ob + (long)(wid * QBLK + r32) * ldo + 4 * hi;
#pragma unroll
  for (int d0 = 0; d0 < NDV; ++d0)
#pragma unroll
    for (int g = 0; g < 4; ++g) *(unsigned*)(Ow + d0 * 32 + 8 * g) = pk4_fp8(clamp8(o[d0][4 * g] * rl), clamp8(o[d0][4 * g + 1] * rl), clamp8(o[d0][4 * g + 2] * rl), clamp8(o[d0][4 * g + 3] * rl));
#undef DMAK
#undef DMAV
#undef VMW
#undef BAR
#undef PSM2
#undef REGION_X
#undef REGION_Y
#undef RESC
#undef STEP
#undef PT3
#undef PT4
}
}
__device__ __forceinline__ float* xres_row(const Frame& F, int row) { return row < NLAT ? F.out + (size_t)row * D : wsp<float>(F, WS_XC) + (size_t)(row - NLAT) * D; }
__device__ __forceinline__ void ln_row(float (&y)[32], const float* g, const float* b, int lane) {
    float s = 0.f;
#pragma unroll
    for (int i = 0; i < 32; ++i) s += y[i];
    const float mu = wave_sum(s) * (1.f / 2048.f);
    float q = 0.f;
#pragma unroll
    for (int i = 0; i < 32; ++i) { const float d = y[i] - mu; q += d * d; }
    const float rstd = rsqrtf(wave_sum(q) * (1.f / 2048.f) + LN_EPS);
#pragma unroll
    for (int qq = 0; qq < 4; ++qq) { const f32x4 g0 = *(const f32x4*)(g + 512 * qq + 8 * lane), g1 = *(const f32x4*)(g + 512 * qq + 8 * lane + 4), b0 = *(const f32x4*)(b + 512 * qq + 8 * lane), b1 = *(const f32x4*)(b + 512 * qq + 8 * lane + 4);
#pragma unroll
        for (int i = 0; i < 4; ++i) { y[qq * 8 + i] = (y[qq * 8 + i] - mu) * rstd * g0[i] + b0[i]; y[qq * 8 + 4 + i] = (y[qq * 8 + 4 + i] - mu) * rstd * g1[i] + b1[i]; } }
}
__device__ __forceinline__ void modulate_store(const float (&x)[32], const float* sh, const float* sc, bf16_t* dst, int lane) {
#pragma unroll
    for (int q = 0; q < 4; ++q) { const f32x4 h0 = *(const f32x4*)(sh + 512 * q + 8 * lane), h1 = *(const f32x4*)(sh + 512 * q + 8 * lane + 4), c0 = *(const f32x4*)(sc + 512 * q + 8 * lane), c1 = *(const f32x4*)(sc + 512 * q + 8 * lane + 4);
        f32x4 a, b;
#pragma unroll
        for (int i = 0; i < 4; ++i) { a[i] = x[q * 8 + i] * (1.f + c0[i]) + h0[i]; b[i] = x[q * 8 + 4 + i] * (1.f + c1[i]) + h1[i]; }
        *(u32x4*)(dst + 512 * q + 8 * lane) = pack8(a, b); }
}
__device__ __forceinline__ void p_ln1(const Frame& F, int l, bool last) {
    const float* mod = wsp<float>(F, WS_MOD) + (size_t)l * 5 * 12288; bf16_t* hb = wsp<bf16_t>(F, WS_HB);
    const float* g = F.in(18) + l * D; const float* b = F.in(19) + l * D;
    const int nrows = last ? NLAT : NROW; const int lane = F.lane, step = F.G * 8;
    float gg[32], bb[32]; ld_row_f32(g, lane, gg); ld_row_f32(b, lane, bb);
    int row = F.bid * 8 + F.wave;
    float yn[32];
    if (row < nrows) ld_row_f32(xres_row(F, row), lane, yn);
#pragma unroll 1
    for (; row < nrows; row += step) {
        const int v = row < NLAT ? (row >> 12) : 4; float* xp = xres_row(F, row);
        float y[32], sh[32], sc[32];
#pragma unroll
        for (int i = 0; i < 32; ++i) y[i] = yn[i];
        ld_row_f32(mod + (size_t)v * 12288 + 6144, lane, sh); ld_row_f32(mod + (size_t)v * 12288 + 8192, lane, sc);
        { const int nrow = row + step; if (nrow < nrows) ld_row_f32(xres_row(F, nrow), lane, yn); }
        float s = 0.f;
#pragma unroll
        for (int i = 0; i < 32; ++i) s += y[i];
        const float mu = wave_sum(s) * (1.f / 2048.f); float q = 0.f;
#pragma unroll
        for (int i = 0; i < 32; ++i) { const float d = y[i] - mu; q += d * d; }
        const float rstd = rsqrtf(wave_sum(q) * (1.f / 2048.f) + LN_EPS);
#pragma unroll
        for (int i = 0; i < 32; ++i) y[i] = (y[i] - mu) * rstd * gg[i] + bb[i];
        st_row_f32(xp, lane, y);
#pragma unroll
        for (int i = 0; i < 32; ++i) y[i] = y[i] * (1.f + sc[i]) + sh[i];
        st_row_bf16(hb + (size_t)row * D, lane, y);
    }
}

template <int NV>
__device__ __forceinline__ void top16(const float (&val)[NV], bool (&sel)[NV], int (&slot)[NV]) {
    unsigned key[NV];
#pragma unroll
    for (int v = 0; v < NV; ++v) { const unsigned u = __float_as_uint(val[v]); key[v] = (u & 0x80000000u) ? ~u : (u | 0x80000000u); }
    unsigned T = 0u;
#pragma unroll 1
    for (int bit = 31; bit >= 0; --bit) {
        const unsigned cand = T | (1u << bit); int cnt = 0;
#pragma unroll
        for (int v = 0; v < NV; ++v) cnt += __popcll(__ballot(key[v] >= cand));
        if (cnt >= 16) T = cand;
    }
    int ngt = 0;
#pragma unroll
    for (int v = 0; v < NV; ++v) ngt += __popcll(__ballot(key[v] > T));
    const int need = 16 - ngt;
    int run = 0, erun = 0;
#pragma unroll
    for (int v = 0; v < NV; ++v) {
        const unsigned long long mg = __ballot(key[v] > T), me = __ballot(key[v] == T);
        const int pg = __builtin_amdgcn_mbcnt_hi((unsigned)(mg >> 32), __builtin_amdgcn_mbcnt_lo((unsigned)mg, 0u));
        const int pe = __builtin_amdgcn_mbcnt_hi((unsigned)(me >> 32), __builtin_amdgcn_mbcnt_lo((unsigned)me, 0u));
        sel[v] = false; slot[v] = 0;
        if (key[v] > T) { sel[v] = true; slot[v] = run + pg; }
        else if (key[v] == T && (erun + pe) < need) { sel[v] = true; slot[v] = ngt + erun + pe; }
        run += __popcll(mg); erun += __popcll(me);
    }
}
__device__ __forceinline__ unsigned f2key(float f) { const unsigned u = __float_as_uint(f); return (u & 0x80000000u) ? ~u : (u | 0x80000000u); }
__device__ __forceinline__ float key2f(unsigned k) { return __uint_as_float((k & 0x80000000u) ? (k & 0x7fffffffu) : ~k); }
template <int NP, int NV>
__device__ __forceinline__ void bisect16(const unsigned (&key)[NP][NV], unsigned (&T)[NP]) {
    bool done[NP];
#pragma unroll
    for (int p = 0; p < NP; ++p) { T[p] = 0u; done[p] = false; }
#pragma unroll 1
    for (int bit = 31; bit >= 0; --bit) {
        const unsigned bm = 1u << bit; bool all = true;
#pragma unroll
        for (int p = 0; p < NP; ++p) {
            const unsigned cand = T[p] | bm; int cnt = 0;
#pragma unroll
            for (int v = 0; v < NV; ++v) cnt += __popcll(__ballot(key[p][v] >= cand));
            const bool upd = (cnt >= 16) && !done[p];
            T[p] = upd ? cand : T[p]; done[p] = done[p] || (cnt == 16); all = all && done[p];
        }
        if (all) break;
    }
}
template <int NV>
__device__ __forceinline__ void compact16(const unsigned (&key)[NV], const unsigned T, bool (&sel)[NV], int (&slot)[NV]) {
    int ngt = 0;
#pragma unroll
    for (int v = 0; v < NV; ++v) ngt += __popcll(__ballot(key[v] > T));
    const int need = 16 - ngt; int run = 0, erun = 0;
#pragma unroll
    for (int v = 0; v < NV; ++v) {
        const unsigned long long mg = __ballot(key[v] > T), me = __ballot(key[v] == T);
        const int pg = __builtin_amdgcn_mbcnt_hi((unsigned)(mg >> 32), __builtin_amdgcn_mbcnt_lo((unsigned)mg, 0u));
        const int pe = __builtin_amdgcn_mbcnt_hi((unsigned)(me >> 32), __builtin_amdgcn_mbcnt_lo((unsigned)me, 0u));
        sel[v] = false; slot[v] = 0;
        if (key[v] > T) { sel[v] = true; slot[v] = run + pg; }
        else if (key[v] == T && (erun + pe) < need) { sel[v] = true; slot[v] = ngt + erun + pe; }
        run += __popcll(mg); erun += __popcll(me);
    }
}
constexpr int KP = 68;
constexpr int PW_BYTES = 9344;
__device__ __forceinline__ float gelu_erf(float x) {
    const float z = fabsf(x) * 0.7071067811865476f; const float t = __builtin_amdgcn_rcpf(1.f + 0.3275911f * z);
    float p = 1.061405429f; p = p * t - 1.453152027f; p = p * t + 1.421413741f; p = p * t - 0.284496736f; p = p * t + 0.254829592f; p = p * t;
    const float er = 1.f - p * __expf(-z * z);
    return 0.5f * x * (1.f + (x < 0.f ? -er : er));
}
__device__ __forceinline__ float wave_max(float x) {
    x = row16_max(x);
    { auto r = __builtin_amdgcn_permlane16_swap(__float_as_uint(x), __float_as_uint(x), false, false); x = fmaxf(__uint_as_float(r[0]), __uint_as_float(r[1])); }
    { auto r = __builtin_amdgcn_permlane32_swap(__float_as_uint(x), __float_as_uint(x), false, false); x = fmaxf(__uint_as_float(r[0]), __uint_as_float(r[1])); }
    return x;
}
__device__ __forceinline__ void ld16_f32(const float* p, int lane, float (&x)[32]) {
#pragma unroll
    for (int q = 0; q < 2; ++q)
#pragma unroll
        for (int d = 0; d < 4; ++d) { const f32x4 a = *(const f32x4*)(p + 1024 * q + 16 * lane + 4 * d); x[q * 16 + d * 4 + 0] = a[0]; x[q * 16 + d * 4 + 1] = a[1]; x[q * 16 + d * 4 + 2] = a[2]; x[q * 16 + d * 4 + 3] = a[3]; }
}
__device__ __forceinline__ void ld16_f32_nt(const float* p, int lane, float (&x)[32]) {
#pragma unroll
    for (int q = 0; q < 2; ++q)
#pragma unroll
        for (int d = 0; d < 4; ++d) { const f32x4 a = __builtin_nontemporal_load((const f32x4*)(p + 1024 * q + 16 * lane + 4 * d)); x[q * 16 + d * 4 + 0] = a[0]; x[q * 16 + d * 4 + 1] = a[1]; x[q * 16 + d * 4 + 2] = a[2]; x[q * 16 + d * 4 + 3] = a[3]; }
}
__device__ __forceinline__ void st16_f32_nt(float* p, int lane, const float (&x)[32]) {
#pragma unroll
    for (int q = 0; q < 2; ++q)
#pragma unroll
        for (int d = 0; d < 4; ++d) __builtin_nontemporal_store((f32x4){x[q * 16 + d * 4 + 0], x[q * 16 + d * 4 + 1], x[q * 16 + d * 4 + 2], x[q * 16 + d * 4 + 3]}, (f32x4*)(p + 1024 * q + 16 * lane + 4 * d));
}
__device__ __forceinline__ void st16_f32(float* p, int lane, const float (&x)[32]) {
#pragma unroll
    for (int q = 0; q < 2; ++q)
#pragma unroll
        for (int d = 0; d < 4; ++d) *(f32x4*)(p + 1024 * q + 16 * lane + 4 * d) = (f32x4){x[q * 16 + d * 4 + 0], x[q * 16 + d * 4 + 1], x[q * 16 + d * 4 + 2], x[q * 16 + d * 4 + 3]};
}
__device__ __forceinline__ void ld16_bf16(const bf16_t* p, int lane, float (&x)[32]) {
#pragma unroll
    for (int q = 0; q < 2; ++q)
#pragma unroll
        for (int d = 0; d < 2; ++d) { const u32x4 w = *(const u32x4*)(p + 1024 * q + 16 * lane + 8 * d); float* o = &x[q * 16 + d * 8];
            o[0] = bflo(w.x); o[1] = bfhi(w.x); o[2] = bflo(w.y); o[3] = bfhi(w.y); o[4] = bflo(w.z); o[5] = bfhi(w.z); o[6] = bflo(w.w); o[7] = bfhi(w.w); }
}
__device__ __forceinline__ void st16_bf16(bf16_t* p, int lane, const float (&x)[32]) {
#pragma unroll
    for (int q = 0; q < 2; ++q)
#pragma unroll
        for (int d = 0; d < 2; ++d) { const float* o = &x[q * 16 + d * 8]; u32x4 w; w.x = cvt_pk_bf16(o[0], o[1]); w.y = cvt_pk_bf16(o[2], o[3]); w.z = cvt_pk_bf16(o[4], o[5]); w.w = cvt_pk_bf16(o[6], o[7]);
            *(u32x4*)(p + 1024 * q + 16 * lane + 8 * d) = w; }
}
constexpr int TBS = 1152;
__device__ __forceinline__ void ld_row_f32(int lane, const float* __restrict__ src, f32x4* a) {
#pragma unroll
    for (int q = 0; q < 2; ++q)
#pragma unroll
        for (int d = 0; d < 4; ++d) a[q * 4 + d] = __builtin_nontemporal_load((const f32x4*)(src + 1024 * q + 16 * lane + 4 * d));
}
__device__ __forceinline__ void cvt_row_fp4b(int lane, const f32x4* a, unsigned char* __restrict__ dst) {
    float x[32];
#pragma unroll
    for (int i = 0; i < 8; ++i) { x[i * 4 + 0] = a[i][0]; x[i * 4 + 1] = a[i][1]; x[i * 4 + 2] = a[i][2]; x[i * 4 + 3] = a[i][3]; }
    float am = 0.f;
#pragma unroll
    for (int i = 0; i < 32; ++i) am = fmaxf(am, fabsf(x[i]));
    const bf16_t sb = f2bf(am * (1.f / 6.f)); const float sf = bf2f(sb); const float sc = sf > 0.f ? __builtin_amdgcn_rcpf(sf) : 0.f;
    u32x4 w;
#pragma unroll
    for (int d = 0; d < 4; ++d) { unsigned t = 0u; const int o = (d >> 1) * 16 + (d & 1) * 8;
        t = __builtin_amdgcn_cvt_scalef32_pk_fp4_f32(t, x[o + 0] * sc, x[o + 1] * sc, 1.0f, 0); t = __builtin_amdgcn_cvt_scalef32_pk_fp4_f32(t, x[o + 2] * sc, x[o + 3] * sc, 1.0f, 1);
        t = __builtin_amdgcn_cvt_scalef32_pk_fp4_f32(t, x[o + 4] * sc, x[o + 5] * sc, 1.0f, 2); t = __builtin_amdgcn_cvt_scalef32_pk_fp4_f32(t, x[o + 6] * sc, x[o + 7] * sc, 1.0f, 3); w[d] = t; }
    *(u32x4*)(dst + 16 * lane) = w;
    *(bf16_t*)(dst + 1024 + 2 * lane) = sb;
}
__device__ __forceinline__ void cvt_row_fp4r(int lane, const float* __restrict__ src, unsigned char* __restrict__ dst, float* __restrict__ inv) {
    float x[32];
#pragma unroll
    for (int q = 0; q < 2; ++q)
#pragma unroll
        for (int d = 0; d < 4; ++d) { const f32x4 a = __builtin_nontemporal_load((const f32x4*)(src + 1024 * q + 16 * lane + 4 * d)); x[q * 16 + d * 4 + 0] = a[0]; x[q * 16 + d * 4 + 1] = a[1]; x[q * 16 + d * 4 + 2] = a[2]; x[q * 16 + d * 4 + 3] = a[3]; }
    float am = 0.f;
#pragma unroll
    for (int i = 0; i < 32; ++i) am = fmaxf(am, fabsf(x[i]));
    am = wave_max(am);
    const float sc = am > 0.f ? 6.f / am : 1.f;
    if (lane == 0) *inv = am > 0.f ? am * (1.f / 6.f) : 1.f;
    u32x4 w;
#pragma unroll
    for (int d = 0; d < 4; ++d) { unsigned t = 0u; const int o = (d >> 1) * 16 + (d & 1) * 8;
        t = __builtin_amdgcn_cvt_scalef32_pk_fp4_f32(t, x[o + 0] * sc, x[o + 1] * sc, 1.0f, 0); t = __builtin_amdgcn_cvt_scalef32_pk_fp4_f32(t, x[o + 2] * sc, x[o + 3] * sc, 1.0f, 1);
        t = __builtin_amdgcn_cvt_scalef32_pk_fp4_f32(t, x[o + 4] * sc, x[o + 5] * sc, 1.0f, 2); t = __builtin_amdgcn_cvt_scalef32_pk_fp4_f32(t, x[o + 6] * sc, x[o + 7] * sc, 1.0f, 3); w[d] = t; }
    *(u32x4*)(dst + 16 * lane) = w;
}
__device__ __forceinline__ void cvt_peer(const Frame& F, int l) {
    const int step = F.G * 8; int r = F.bid * 8 + F.wave;
    f32x4 cur[8], nxt[8];
    auto srcp = [&](int rr) { return (rr < 16384 ? F.in(23) : F.in(24)) + ((size_t)l * 16384 + (rr & 16383)) * 2048; };
    if (r < 32768) ld_row_f32(F.lane, srcp(r), cur);
    for (; r < 32768; r += step) {
        const int rn = r + step;
        if (rn < 32768) ld_row_f32(F.lane, srcp(rn), nxt);
        cvt_row_fp4b(F.lane, cur, wsp<unsigned char>(F, r < 16384 ? WS_PU : WS_PV) + (size_t)l * SZ_PT + (size_t)(r & 16383) * TBS);
#pragma unroll
        for (int i = 0; i < 8; ++i) cur[i] = nxt[i];
    }
}
#define PEER_G 4
template <int CTRL> __device__ __forceinline__ int dppi(int x) { return __builtin_amdgcn_update_dpp(0, x, CTRL, 0xF, 0xF, true); }
__device__ __forceinline__ int irow16_sum(int x) { x += dppi<0xB1>(x); x += dppi<0x4E>(x); x += dppi<0x141>(x); x += dppi<0x140>(x); return x; }
__device__ __forceinline__ int irow16_incl_scan(int x) { x += dppi<0x111>(x); x += dppi<0x112>(x); x += dppi<0x114>(x); x += dppi<0x118>(x); return x; }
constexpr int KBP = 72;
constexpr int PT_WORDS = 6 * 128 + 160 + 3 * 128;
constexpr int PWB = 2 * PT_WORDS * 4;
__device__ __forceinline__ void p_peer(const Frame& F, int l, bool last) {
    LAS bf16_t* kb1 = (LAS bf16_t*)F.lds; LAS bf16_t* kb2 = kb1 + 128 * KBP;
    LAS unsigned* wbase = (LAS unsigned*)(F.lds + 2 * 128 * KBP * 2 + F.wave * PWB);
    const int lane = F.lane, fr = lane & 15, fq = lane >> 4;
    __syncthreads();
    for (int i = F.tid; i < 128 * 64; i += 512) { const int r = i >> 6, d = i & 63; kb1[r * KBP + d] = f2bf(F.in(21)[(size_t)l * 8192 + i]); kb2[r * KBP + d] = f2bf(F.in(22)[(size_t)l * 8192 + i]); }
    __syncthreads();
    const bf16_t* QP = wsp<bf16_t>(F, WS_QP); const bf16_t* HB = wsp<bf16_t>(F, WS_HB); unsigned char* HB8w = wsp<unsigned char>(F, WS_HB8);
    const unsigned char* PU = wsp<unsigned char>(F, WS_PU) + (size_t)l * SZ_PT; const unsigned char* PV = wsp<unsigned char>(F, WS_PV) + (size_t)l * SZ_PT;
    const float* modl = wsp<float>(F, WS_MOD) + (size_t)l * 5 * 12288; const float* modn = wsp<float>(F, WS_MOD) + (size_t)(l + 1) * 5 * 12288;
    const float* g2n = F.in(25) + l * D; const float* b2n = F.in(26) + l * D;
    const int npairs = (last ? NLAT : NROW) / 2;
    const int per_wg = (npairs + F.G - 1) / F.G; const int p_lo = F.bid * per_wg; const int p_hi = (p_lo + per_wg) < npairs ? (p_lo + per_wg) : npairs;
    LAS int* wq = (LAS int*)(F.lds + 147456 - 32);
    if (F.tid == 0) *wq = 0;
    __syncthreads();
#pragma unroll 1
    for (;;) {
        int pi = 0; if (lane == 0) pi = __hip_atomic_fetch_add(wq, 1, __ATOMIC_RELAXED, __HIP_MEMORY_SCOPE_WORKGROUP);
        pi = p_lo + __builtin_amdgcn_readfirstlane(pi); if (pi >= p_hi) break;
        const int rowA = 2 * pi;
#pragma unroll 1
        for (int rep1_ = 0; rep1_ <= REP_PS1; ++rep1_) {
            unsigned kk[2][8][4];
            { int fr_ = fr; asm volatile("" : "+v"(fr_));
              const bf16_t* qrow = QP + (size_t)(rowA + (fr_ >> 3)) * 1024 + (fr_ & 7) * 128 + 8 * fq;
              bf16x8 af[2][2];
#pragma unroll
              for (int st = 0; st < 2; ++st)
#pragma unroll
                  for (int ks = 0; ks < 2; ++ks) af[st][ks] = *(const bf16x8*)(qrow + st * 64 + ks * 32);
#pragma unroll
              for (int st = 0; st < 2; ++st) { LAS bf16_t* kb = st ? kb2 : kb1;
#pragma unroll
                  for (int nb = 0; nb < 8; ++nb) { f32x4 c = {0.f, 0.f, 0.f, 0.f};
#pragma unroll
                      for (int ks = 0; ks < 2; ++ks) { const bf16x8 bfr = *(const LAS bf16x8*)(kb + (nb * 16 + fr) * KBP + ks * 32 + 8 * fq); c = __builtin_amdgcn_mfma_f32_16x16x32_bf16(af[st][ks], bfr, c, 0, 0, 0); }
#pragma unroll
                      for (int r = 0; r < 4; ++r) kk[st][nb][r] = f2key(c[r]); } } }
            unsigned T[2][4]; bool done[2][4];
#pragma unroll
            for (int st = 0; st < 2; ++st)
#pragma unroll
                for (int r = 0; r < 4; ++r) { T[st][r] = 0u; done[st][r] = false; }
#pragma unroll 1
            for (int bit = 31; bit >= 0; --bit) { const unsigned bm = 1u << bit; bool alld = true;
#pragma unroll
                for (int st = 0; st < 2; ++st)
#pragma unroll
                    for (int r = 0; r < 4; ++r) { const unsigned cand = T[st][r] | bm; int c = 0;
#pragma unroll
                        for (int nb = 0; nb < 8; ++nb) c += (kk[st][nb][r] >= cand) ? 1 : 0;
                        c = irow16_sum(c);
                        const bool upd = (c >= 16) && !done[st][r]; T[st][r] = upd ? cand : T[st][r]; done[st][r] = done[st][r] || (c == 16); alld = alld && done[st][r]; }
                if (__all(alld)) break; }
            const int tt = lane >> 5, hd0 = ((lane >> 4) & 1) * 4;
#pragma unroll
            for (int st = 0; st < 2; ++st)
#pragma unroll
                for (int r = 0; r < 4; ++r) { const unsigned Tr = T[st][r]; int g = 0, e = 0;
#pragma unroll
                    for (int nb = 0; nb < 8; ++nb) { g += (kk[st][nb][r] > Tr) ? 1 : 0; e += (kk[st][nb][r] == Tr) ? 1 : 0; }
                    int gpre = irow16_incl_scan(g) - g, epre = irow16_incl_scan(e) - e; const int ngt = irow16_sum(g); const int need = 16 - ngt;
                    LAS unsigned* tb = wbase + tt * PT_WORDS; LAS float* vl = (LAS float*)(tb + st * 128) + (hd0 + r) * 16; LAS int* il = (LAS int*)(tb + 256 + st * 128) + (hd0 + r) * 16;
#pragma unroll
                    for (int nb = 0; nb < 8; ++nb) { const unsigned k = kk[st][nb][r];
                        if (k > Tr) { vl[gpre] = key2f(k); il[gpre] = nb * 16 + fr; ++gpre; }
                        else if (k == Tr) { if (epre < need) { vl[ngt + epre] = key2f(k); il[ngt + epre] = nb * 16 + fr; } ++epre; } } }
        }
        asm volatile("s_waitcnt lgkmcnt(0)" ::: "memory");
        {
            const int tt = lane >> 5, hd0 = ((lane >> 4) & 1) * 4; LAS unsigned* tb = wbase + tt * PT_WORDS;
            unsigned ck[4][16];
#pragma unroll
            for (int r = 0; r < 4; ++r) { const float va = ((LAS float*)tb)[(hd0 + r) * 16 + fr]; const LAS float* v2p = (LAS float*)(tb + 128) + (hd0 + r) * 16;
#pragma unroll
                for (int j4 = 0; j4 < 4; ++j4) { const f32x4 vb = *(const LAS f32x4*)(v2p + j4 * 4);
#pragma unroll
                    for (int i = 0; i < 4; ++i) ck[r][j4 * 4 + i] = f2key(va + vb[i]); } }
            unsigned T[4]; bool done[4];
#pragma unroll
            for (int r = 0; r < 4; ++r) { T[r] = 0u; done[r] = false; }
#pragma unroll 1
            for (int bit = 31; bit >= 0; --bit) { const unsigned bm = 1u << bit; bool alld = true;
#pragma unroll
                for (int r = 0; r < 4; ++r) { const unsigned cand = T[r] | bm; int c = 0;
#pragma unroll
                    for (int j = 0; j < 16; ++j) c += (ck[r][j] >= cand) ? 1 : 0;
                    c = irow16_sum(c);
                    const bool upd = (c >= 16) && !done[r]; T[r] = upd ? cand : T[r]; done[r] = done[r] || (c == 16); alld = alld && done[r]; }
                if (__all(alld)) break; }
#pragma unroll
            for (int r = 0; r < 4; ++r) { const unsigned Tr = T[r]; int g = 0, e = 0;
#pragma unroll
                for (int j = 0; j < 16; ++j) { g += (ck[r][j] > Tr) ? 1 : 0; e += (ck[r][j] == Tr) ? 1 : 0; }
                int gpre = irow16_incl_scan(g) - g, epre = irow16_incl_scan(e) - e; const int ngt = irow16_sum(g); const int need = 16 - ngt;
                const int e1 = ((LAS int*)(tb + 256))[(hd0 + r) * 16 + fr] * 128; const LAS int* i2p = (LAS int*)(tb + 384) + (hd0 + r) * 16;
                LAS float* cs_ = (LAS float*)(tb + 512) + (hd0 + r) * 16; LAS int* ce_ = (LAS int*)(tb + 640) + (hd0 + r) * 16;
#pragma unroll
                for (int j = 0; j < 16; ++j) { const unsigned k = ck[r][j];
                    if (k > Tr) { cs_[gpre] = key2f(k); ce_[gpre] = e1 + i2p[j]; ++gpre; }
                    else if (k == Tr) { if (epre < need) { cs_[ngt + epre] = key2f(k); ce_[ngt + epre] = e1 + i2p[j]; } ++epre; } } }
        }
        asm volatile("s_waitcnt lgkmcnt(0)" ::: "memory");
#pragma unroll 1
      for (int t = 0; t < 2; ++t) {
        const int row = rowA + t; const int v = row < NLAT ? (row >> 12) : 4;
        LAS unsigned* tb = wbase + t * PT_WORDS;
        LAS float* v1l = (LAS float*)tb; LAS float* v2l = v1l + 128; LAS int* i1l = (LAS int*)(v2l + 128); LAS int* i2l = i1l + 128;
        LAS float* csl = (LAS float*)(i2l + 128); LAS int* cel = (LAS int*)(csl + 128); LAS int* el = cel + 128; LAS float* gl = (LAS float*)(el + 160); LAS float* su = gl + 128; LAS float* sv = su + 128;
        {
#pragma unroll
            for (int it = 0; it < 2; ++it) { const int idx = it * 64 + lane;
                const float sx = csl[idx]; const float mx = row16_max(sx); const float pe_ = __expf(sx - mx); const float sm = row16_sum(pe_);
                el[idx] = cel[idx]; gl[idx] = pe_ / sm; }
        }
        if (lane < 32) el[128 + lane] = el[0];
        asm volatile("s_waitcnt vmcnt(0) lgkmcnt(0)" ::: "memory");
        const bool b0_ = lane & 1, b1_ = lane & 2, b2_ = lane & 4;
        u32x4 A[8], B[8], C[8]; unsigned SA[8], SB[8], SC[8];
#define PEER_LOADT(buf, sbuf, tab, g) do { _Pragma("unroll") for (int x = 0; x < 8; ++x) { const int e = __builtin_amdgcn_readfirstlane(el[(g) * 8 + x]); const unsigned char* rp = (tab) + (size_t)e * TBS; \
            buf[x] = *(const u32x4*)(rp + 16 * lane); sbuf[x] = *(const bf16_t*)(rp + 1024 + 2 * lane); } } while (0)
#define PEER_LOADV(buf, g) do { _Pragma("unroll") for (int x = 0; x < 8; ++x) { const int e = __builtin_amdgcn_readfirstlane(el[(g) * 8 + x]); buf[x] = *(const u32x4*)(PV + (size_t)e * 1024 + 16 * lane); } } while (0)
#define FP4X8(w_, f0_, f1_, f2_, f3_) const f32x2 f0_ = __builtin_amdgcn_cvt_scalef32_pk_f32_fp4(w_, 1.0f, 0), f1_ = __builtin_amdgcn_cvt_scalef32_pk_f32_fp4(w_, 1.0f, 1), f2_ = __builtin_amdgcn_cvt_scalef32_pk_f32_fp4(w_, 1.0f, 2), f3_ = __builtin_amdgcn_cvt_scalef32_pk_f32_fp4(w_, 1.0f, 3)
#define PEER_DOT(buf, sbuf, g) do { float p_[8]; \
            _Pragma("unroll") for (int x = 0; x < 8; ++x) { f32x2 s2_ = {0.f, 0.f}; \
                _Pragma("unroll") for (int d = 0; d < 4; ++d) { const unsigned w_ = buf[x][d]; FP4X8(w_, f0_, f1_, f2_, f3_); const int o_ = (d >> 1) * 8 + (d & 1) * 4; \
                    s2_ = hh2[o_ + 0] * f0_ + s2_; s2_ = hh2[o_ + 1] * f1_ + s2_; s2_ = hh2[o_ + 2] * f2_ + s2_; s2_ = hh2[o_ + 3] * f3_ + s2_; } \
                p_[x] = (s2_.x + s2_.y) * __uint_as_float(sbuf[x] << 16); SBAR(); } \
              \
            float q_[4], r_[2]; \
            _Pragma("unroll") for (int j = 0; j < 4; ++j) { const float keep_ = b0_ ? p_[2 * j + 1] : p_[2 * j], send_ = b0_ ? p_[2 * j] : p_[2 * j + 1]; q_[j] = keep_ + dppf<0xB1>(send_); } \
            _Pragma("unroll") for (int j = 0; j < 2; ++j) { const float keep_ = b1_ ? q_[2 * j + 1] : q_[2 * j], send_ = b1_ ? q_[2 * j] : q_[2 * j + 1]; r_[j] = keep_ + dppf<0x4E>(send_); } \
            float t_; { const float keep_ = b2_ ? r_[1] : r_[0], send_ = b2_ ? r_[0] : r_[1]; const float up_ = dppf<0x104>(send_), dn_ = dppf<0x114>(send_); t_ = keep_ + (b2_ ? dn_ : up_); } \
            t_ += dppf<0x128>(t_); \
            { auto r16_ = __builtin_amdgcn_permlane16_swap(__float_as_uint(t_), __float_as_uint(t_), false, false); t_ = __uint_as_float(r16_[0]) + __uint_as_float(r16_[1]); } \
            { auto r32_ = __builtin_amdgcn_permlane32_swap(__float_as_uint(t_), __float_as_uint(t_), false, false); t_ = __uint_as_float(r32_[0]) + __uint_as_float(r32_[1]); } \
            const float av = gelu_erf(t_) * gl[(g) * 8 + (lane & 7)]; const bool me_ = (lane >> 3) == ((g) & 7); \
            avl = (me_ && (g) < 8) ? av : avl; avh = (me_ && (g) >= 8) ? av : avh; } while (0)
#define PIN_ACC() do { asm volatile("" : "+v"(acc2[0]), "+v"(acc2[1]), "+v"(acc2[2]), "+v"(acc2[3]), "+v"(acc2[4]), "+v"(acc2[5]), "+v"(acc2[6]), "+v"(acc2[7]), "+v"(acc2[8]), "+v"(acc2[9]), "+v"(acc2[10]), "+v"(acc2[11]), "+v"(acc2[12]), "+v"(acc2[13]), "+v"(acc2[14]), "+v"(acc2[15])); } while (0)
#define PEER_AXPY(buf, sbuf, g) do { _Pragma("unroll") for (int x = 0; x < 8; ++x) { const int idx = (g) * 8 + x; \
            const float av = __uint_as_float(__builtin_amdgcn_readlane(__float_as_uint(idx < 64 ? avl : avh), idx & 63)) * __uint_as_float(sbuf[x] << 16); const f32x2 av2_ = {av, av}; \
            _Pragma("unroll") for (int d = 0; d < 4; ++d) { const unsigned w_ = buf[x][d]; FP4X8(w_, f0_, f1_, f2_, f3_); const int o_ = (d >> 1) * 8 + (d & 1) * 4; \
                acc2[o_ + 0] = av2_ * f0_ + acc2[o_ + 0]; acc2[o_ + 1] = av2_ * f1_ + acc2[o_ + 1]; acc2[o_ + 2] = av2_ * f2_ + acc2[o_ + 2]; acc2[o_ + 3] = av2_ * f3_ + acc2[o_ + 3]; } PIN_ACC(); } } while (0)
        float avl = 0.f, avh = 0.f;
        PEER_LOADT(A, SA, PU, 0); PEER_LOADT(B, SB, PU, 1); SBAR();
        float hh[32]; ld16_bf16(HB + (size_t)row * D, lane, hh);
        f32x2 hh2[16];
#pragma unroll
        for (int i = 0; i < 16; ++i) hh2[i] = (f32x2){hh[2 * i], hh[2 * i + 1]};
#pragma unroll 1
        for (int g = 0; g < 15; g += 3) { PEER_LOADT(C, SC, PU, g + 2); SBAR(); PEER_DOT(A, SA, g); SBAR(); PEER_LOADT(A, SA, PU, g + 3); SBAR(); PEER_DOT(B, SB, g + 1); SBAR();
            PEER_LOADT(B, SB, (g + 4 < 16 ? PU : PV), (g + 4) & 15); SBAR(); PEER_DOT(C, SC, g + 2); SBAR(); }
        PEER_LOADT(C, SC, PV, 1); SBAR();
        PEER_DOT(A, SA, 15); SBAR();
        f32x2 acc2[16];
#pragma unroll
        for (int i = 0; i < 16; ++i) acc2[i] = (f32x2){0.f, 0.f};
        float* xp = xres_row(F, row);
#pragma unroll 1
        for (int g = 0; g < 15; g += 3) { PEER_LOADT(A, SA, PV, g + 2); SBAR(); PEER_AXPY(B, SB, g); SBAR(); PEER_LOADT(B, SB, PV, g + 3); SBAR(); PEER_AXPY(C, SC, g + 1); SBAR(); PEER_LOADT(C, SC, PV, g + 4); SBAR(); PEER_AXPY(A, SA, g + 2); SBAR(); }
        float x1[32], g2[32]; ld16_f32(xp, lane, x1); ld16_f32(modl + (size_t)v * 12288 + 10240, lane, g2); SBAR();
        PEER_AXPY(B, SB, 15); SBAR();
#undef PEER_LOADT
#undef PEER_LOADV
#undef PEER_DOT
#undef PEER_AXPY
        float acc[32];
        {
#pragma unroll
          for (int i = 0; i < 32; ++i) acc[i] = ALPHA * x1[i] + g2[i] * acc2[i >> 1][i & 1]; }
        { float sm = 0.f;
#pragma unroll
          for (int i = 0; i < 32; ++i) sm += acc[i];
          const float mu = wave_sum(sm) * (1.f / 2048.f); float qq = 0.f;
#pragma unroll
          for (int i = 0; i < 32; ++i) { const float dd = acc[i] - mu; qq += dd * dd; }
          const float rstd = rsqrtf(wave_sum(qq) * (1.f / 2048.f) + LN_EPS);
#pragma unroll
          for (int q = 0; q < 2; ++q)
#pragma unroll
              for (int d = 0; d < 4; ++d) { const int o = 1024 * q + 16 * lane + 4 * d; const f32x4 gg = *(const f32x4*)(g2n + o), bb = *(const f32x4*)(b2n + o);
#pragma unroll
                  for (int i = 0; i < 4; ++i) acc[q * 16 + d * 4 + i] = (acc[q * 16 + d * 4 + i] - mu) * rstd * gg[i] + bb[i]; } }
        st16_f32(xp, lane, acc);
        if (!last) { const float* sh = modn + (size_t)v * 12288; const float* sc = sh + 2048;
#pragma unroll
            for (int q = 0; q < 2; ++q)
#pragma unroll
                for (int d = 0; d < 4; ++d) { const int o = 1024 * q + 16 * lane + 4 * d; const f32x4 hh4 = *(const f32x4*)(sh + o), cc4 = *(const f32x4*)(sc + o);
#pragma unroll
                    for (int i = 0; i < 4; ++i) acc[q * 16 + d * 4 + i] = clamp8(acc[q * 16 + d * 4 + i] * (1.f + cc4[i]) + hh4[i]); }
#pragma unroll
            for (int q = 0; q < 2; ++q) { u32x4 w;
#pragma unroll
                for (int d = 0; d < 4; ++d) w[d] = pk4_fp8(acc[q * 16 + d * 4 + 0], acc[q * 16 + d * 4 + 1], acc[q * 16 + d * 4 + 2], acc[q * 16 + d * 4 + 3]);
                *(u32x4*)(HB8w + (size_t)row * D + 1024 * q + 16 * lane) = w; } }
      }
    }
}
#ifdef DBG
constexpr size_t WS_DBG = WS_CTL + 131072;
constexpr int DBG_NS = 60;
__device__ __forceinline__ int dbg_row(int s) { return (s * 263 + 5) % NLAT; }
__global__ void __launch_bounds__(256) dbg_peer_pre(Args args, int l) {
    __shared__ float q[1024]; __shared__ float s1[128], s2[128]; __shared__ float v1[16], v2[16]; __shared__ int i1[16], i2[16]; __shared__ float cs[256]; __shared__ int ce[256];
    __shared__ float ts[16]; __shared__ int te[16]; __shared__ float red[256]; __shared__ float aval[128]; __shared__ int eid[128]; __shared__ float h2[2048];
    const int s = blockIdx.x, row = dbg_row(s), tid = threadIdx.x; unsigned char* ws = args.ws;
    const bf16_t* QP = (const bf16_t*)(ws + WS_QP); const bf16_t* HB = (const bf16_t*)(ws + WS_HB);
    float* dbgf = (float*)(ws + WS_DBG + 4096); int* dbge = (int*)(dbgf + DBG_NS * 2048); float* dbga = (float*)(dbge + DBG_NS * 128); float* dbgg = dbga + 3 * DBG_NS * 128;
    for (int i = tid; i < 1024; i += 256) q[i] = bf2f(QP[(size_t)row * 1024 + i]);
    for (int i = tid; i < 2048; i += 256) h2[i] = bf2f(HB[(size_t)row * D + i]);
    __syncthreads();
    const float* k1 = args.in[21] + (size_t)l * 8192; const float* k2 = args.in[22] + (size_t)l * 8192;
    for (int hd = 0; hd < 8; ++hd) {
        { const int k = tid & 127; const float* kk = (tid < 128 ? k1 : k2) + k * 64; const float* qq = q + hd * 128 + (tid < 128 ? 0 : 64); float a = 0.f; for (int d = 0; d < 64; ++d) a += qq[d] * kk[d]; (tid < 128 ? s1 : s2)[k] = a; }
        __syncthreads();
        { const int k = tid & 127; const float* sv = tid < 128 ? s1 : s2; const float me = sv[k]; int rank = 0; for (int j = 0; j < 128; ++j) rank += (sv[j] > me || (sv[j] == me && j < k)) ? 1 : 0;
          if (rank < 16) { (tid < 128 ? v1 : v2)[rank] = me; (tid < 128 ? i1 : i2)[rank] = k; } }
        __syncthreads();
        { const int i = tid >> 4, j = tid & 15; cs[tid] = v1[i] + v2[j]; ce[tid] = i1[i] * 128 + i2[j]; }
        __syncthreads();
        { const float me = cs[tid]; int rank = 0; for (int j = 0; j < 256; ++j) rank += (cs[j] > me || (cs[j] == me && j < tid)) ? 1 : 0; if (rank < 16) { ts[rank] = me; te[rank] = ce[tid]; } }
        __syncthreads();
        if (tid < 16) { float mx = ts[0]; float sm = 0.f; for (int j = 0; j < 16; ++j) sm += expf(ts[j] - mx); aval[hd * 16 + tid] = expf(ts[tid] - mx) / sm; eid[hd * 16 + tid] = te[tid]; dbgg[s * 128 + hd * 16 + tid] = aval[hd * 16 + tid]; }
        __syncthreads();
    }
    const float* U = args.in[23] + (size_t)l * 16384 * 2048; const float* V = args.in[24] + (size_t)l * 16384 * 2048;
    for (int e = 0; e < 128; ++e) { const float* ur = U + (size_t)eid[e] * 2048; float p = 0.f; for (int d = tid; d < 2048; d += 256) p += h2[d] * ur[d]; red[tid] = p; __syncthreads();
        for (int st = 128; st > 0; st >>= 1) { if (tid < st) red[tid] += red[tid + st]; __syncthreads(); }
        if (tid == 0) { const float sc = red[0]; aval[e] = 0.5f * sc * (1.f + erff(sc * 0.70710678f)) * aval[e]; } __syncthreads(); }
    float y[8]; const float* xr = args.out + (size_t)row * D; const int v = row >> 12; const float* mod = (const float*)(ws + WS_MOD) + (size_t)l * 5 * 12288 + (size_t)v * 12288;
    float sum = 0.f;
    for (int k = 0; k < 8; ++k) { const int d = tid + 256 * k; float o = 0.f; for (int e = 0; e < 128; ++e) o += aval[e] * V[(size_t)eid[e] * 2048 + d]; y[k] = ALPHA * xr[d] + mod[10240 + d] * o; sum += y[k]; }
    red[tid] = sum; __syncthreads(); for (int st = 128; st > 0; st >>= 1) { if (tid < st) red[tid] += red[tid + st]; __syncthreads(); } const float mu = red[0] / 2048.f; __syncthreads();
    float sq = 0.f; for (int k = 0; k < 8; ++k) sq += (y[k] - mu) * (y[k] - mu);
    red[tid] = sq; __syncthreads(); for (int st = 128; st > 0; st >>= 1) { if (tid < st) red[tid] += red[tid + st]; __syncthreads(); } const float rstd = rsqrtf(red[0] / 2048.f + LN_EPS);
    for (int k = 0; k < 8; ++k) { const int d = tid + 256 * k; dbgf[(size_t)s * 2048 + d] = (y[k] - mu) * rstd * args.in[25][l * D + d] + args.in[26][l * D + d]; }
    if (tid < 128) { dbge[s * 128 + tid] = eid[tid]; dbga[s * 128 + tid] = aval[tid]; }
}
__global__ void __launch_bounds__(256) dbg_peer_post(Args args) {
    __shared__ int bad_e, bad_x, bad_a, bad_g;
    const int s = blockIdx.x, row = dbg_row(s), tid = threadIdx.x; unsigned char* ws = args.ws; unsigned* cnt = (unsigned*)(ws + WS_DBG);
    float* dbgf = (float*)(ws + WS_DBG + 4096); int* dbge = (int*)(dbgf + DBG_NS * 2048); float* dbga = (float*)(dbge + DBG_NS * 128);
    int* fe = (int*)(dbga + DBG_NS * 128); float* fa = (float*)(fe + DBG_NS * 128); float* dbgg = dbga + 3 * DBG_NS * 128; float* fg = dbgg + DBG_NS * 128;
    if (tid == 0) { bad_e = 0; bad_x = 0; bad_a = 0; bad_g = 0; } __syncthreads();
    if (tid < 128) { const int hd = tid >> 4; const int e = dbge[s * 128 + tid]; bool found = false; float af = 0.f, gf = 0.f; for (int j = 0; j < 16; ++j) if (fe[s * 128 + hd * 16 + j] == e) { found = true; af = fa[s * 128 + hd * 16 + j]; gf = fg[s * 128 + hd * 16 + j]; }
        if (!found) atomicAdd(&bad_e, 1); else { const float ea = dbga[s * 128 + tid]; if (fabsf(af - ea) > 0.02f * fabsf(ea) + 2e-3f) atomicAdd(&bad_a, 1); const float eg = dbgg[s * 128 + tid]; if (fabsf(gf - eg) > 0.02f * fabsf(eg) + 1e-3f) atomicAdd(&bad_g, 1); } }
    for (int k = 0; k < 8; ++k) { const int d = tid + 256 * k; const float ex = dbgf[(size_t)s * 2048 + d], got = args.out[(size_t)row * D + d]; if (!(fabsf(got - ex) <= 0.03f + 0.03f * fabsf(ex))) atomicAdd(&bad_x, 1); }
    __syncthreads();
    if (tid == 0) { if (bad_e > 2) atomicAdd(&cnt[1], 1u); if (bad_g > 2) atomicAdd(&cnt[2], 1u); if (bad_a > 2) atomicAdd(&cnt[3], 1u); if (bad_x > 8) atomicAdd(&cnt[4], 1u); }
}
__global__ void dbg_report(Args args) {
    unsigned* cnt = (unsigned*)(args.ws + WS_DBG);
    float code = 0.f;
    for (int lv = 1; lv <= 9; ++lv) if (cnt[lv]) { int tenths = (int)(cnt[lv] * 10 / DBG_NS); if (tenths > 9) tenths = 9; code = 1000.f * lv + 100.f * tenths; break; }
    if (code != 0.f) for (int i = threadIdx.x; i < 4096; i += blockDim.x) args.out[i] = code;
}
#endif
template <int ABL>
__device__ __forceinline__ void p_attn_gqa(const Frame& F, int last) {
    LAS unsigned char* lds = F.lds;
    const unsigned char* QG = wsp<unsigned char>(F, WS_QG); const unsigned char* KG = wsp<unsigned char>(F, WS_KG); const unsigned char* VG = wsp<unsigned char>(F, WS_VG); unsigned char* OAB = wsp<unsigned char>(F, WS_OAB);
    const int nlat = NB * 8 * 16, nall = last ? nlat : nlat + NB * 8;
    for (int u = F.bid; u < nall; u += F.G) {
        int bh, q0, seq; size_t orow;
        if (u < nlat) {
            int uu = u;
            if (F.G == 256) {
                const int c = u & 255, i = u >> 8, xcd = c & 7, r = c >> 3, kvg = i * 4 + (xcd >> 1), within = (xcd & 1) * 32 + r;
                uu = (((kvg >> 1) * 8 + (kvg & 1) * 4 + (within >> 4)) << 4) | (within & 15); }
            bh = uu >> 4; const int qb = uu & 15; q0 = CTXL + qb * 256; seq = TT; orow = (size_t)(bh >> 3) * SEQ + qb * 256; }
        else { bh = u - nlat; q0 = 0; seq = CTXL; orow = (size_t)NLAT + (bh >> 3) * CTXL; }
        const int b = bh >> 3, h = bh & 7; const size_t kvo = (size_t)(b * 2 + (h >> 2)) * TT * 128;
        __syncthreads();
        att::attn_body<4, 0, ABL>(QG + ((size_t)bh * TT + q0) * 128, KG + kvo, VG + (size_t)(b * 2 + (h >> 2)) * 128 * TT, OAB + orow * D + 1024 + h * 128, seq, lds, F.tid);
    }
    __syncthreads();
}
template <int ABL>
__device__ __forceinline__ void p_attn_mla(const Frame& F, int last) {
    LAS unsigned char* lds = F.lds;
    const unsigned char* QM = wsp<unsigned char>(F, WS_QM); const unsigned char* KM = wsp<unsigned char>(F, WS_KM); const unsigned char* VM = wsp<unsigned char>(F, WS_VM); unsigned char* OAB = wsp<unsigned char>(F, WS_OAB);
    const int nlat = NB * 8 * 16, nall = last ? nlat : nlat + NB * 8;
    for (int u = F.bid; u < nall; u += F.G) {
        int bh, q0, seq; size_t orow;
        if (u < nlat) {
            int uu = u;
            if (F.G == 256) { const int c = u & 255, i = u >> 8, xcd = c & 7, r = c >> 3; uu = ((i * 16 + xcd * 2 + (r >> 4)) << 4) | (r & 15); }
            bh = uu >> 4; const int qb = uu & 15; q0 = CTXL + qb * 256; seq = TT; orow = (size_t)(bh >> 3) * SEQ + qb * 256; }
        else { bh = u - nlat; q0 = 0; seq = CTXL; orow = (size_t)NLAT + (bh >> 3) * CTXL; }
        const int h = bh & 7;
        __syncthreads();
        att::attn_body<2, 1, ABL>(QM + ((size_t)bh * TT + q0) * 128, KM + (size_t)bh * TT * 128, VM + (size_t)bh * 64 * TT, OAB + orow * D + h * 64, seq, lds, F.tid);
    }
    __syncthreads();
}
__device__ __forceinline__ void p_ret_out(const Frame& F, int l, int last) {
    const int c_lo = last ? 2 : 0, nc = 34 - c_lo, nu = NB * 8 * nc;
    for (int u = F.bid; u < nu; u += F.G) { const int bh = u / nc, c = c_lo + (u % nc); ret_out_unit(F, l, bh, c); }
    __syncthreads();
}

constexpr int LDS_BYTES = 147456;
constexpr int MISC_OFF = 147456 - 64;
constexpr int NPHASE = 22;
#ifndef PHM
#define PHM 0xFFFF
#endif
#ifndef PH_ATTR
#define PH_ATTR __forceinline__
#endif
template <int PART> __device__ PH_ATTR void ph_prologue(ArgP ap) { const Frame F = make_frame(ap); p0_prologue<PART>(F); }
__device__ PH_ATTR void ph_modreduce(ArgP ap) { const Frame F = make_frame(ap); p1_modreduce(F); }
__device__ PH_ATTR void ph_modulate0(ArgP ap) { const Frame F = make_frame(ap); p_modulate0(F); }
template <int GABL> __device__ PH_ATTR void ph_gemm_in(ArgP ap, int l) { const Frame F = make_frame(ap);
    pg8::Gemm g{wsp<bf16_t>(F, WS_HB8), wsp<bf16_t>(F, WS_WIN + l * SZ_WIN), NROW, NPT, 1024, 1024, 1024}; pg8::StaticOrder S; S.init(NROW, NPT, F.G, F.bid);
    float mul_, inv_; fp8_scale(wsp<unsigned>(F, WS_WSC)[l], mul_, inv_);
    EpiIn E{wsp<bf16_t>(F, WS_P1), wsp<bf16_t>(F, WS_G), inv_};
    pg8::gemm_phase<EpiIn, pg8::StaticOrder, GABL>(F.lds, F.tid, g, S, E); }
__device__ PH_ATTR void ph_post(ArgP ap, int l) { const Frame F = make_frame(ap); p_post(F, l); if (l == 1) cvt_peer(F, 1); }
__device__ PH_ATTR void ph_qup(ArgP ap, int l) { const Frame F = make_frame(ap);
    pg8::Gemm g{wsp<bf16_t>(F, WS_CQN), wsp<bf16_t>(F, WS_WQUP + l * SZ_WQUP), NROW, 768, 512, 512, 512}; pg8::StaticOrder S; S.init(NROW, 768, F.G, F.bid);
    EpiQup E{wsp<unsigned char>(F, WS_QM), wsp<f32x2>(F, WS_ROPE32)};
    pg8::gemm_phase<EpiQup, pg8::StaticOrder>(F.lds, F.tid, g, S, E); }
__device__ PH_ATTR void ph_kvup(ArgP ap, int l) { const Frame F = make_frame(ap);
    pg8::Gemm g{wsp<bf16_t>(F, WS_CKVN), wsp<bf16_t>(F, WS_WKVUP + l * SZ_WKVUP), NROW, 1024, 256, 256, 256}; pg8::StaticOrder S; S.init(NROW, 1024, F.G, F.bid);
    EpiKvup E{wsp<unsigned char>(F, WS_KM), wsp<unsigned char>(F, WS_VM)};
    pg8::gemm_phase<EpiKvup, pg8::StaticOrder>(F.lds, F.tid, g, S, E); }
__device__ PH_ATTR void ph_states(ArgP ap, int l) { const Frame F = make_frame(ap); p_ret_states(F, l); }
template <int ABL> __device__ PH_ATTR void ph_attn_gqa(ArgP ap, int last) { const Frame F = make_frame(ap); p_attn_gqa<ABL>(F, last); }
template <int ABL> __device__ PH_ATTR void ph_attn_mla(ArgP ap, int last) { const Frame F = make_frame(ap); p_attn_mla<ABL>(F, last); }
__device__ PH_ATTR void ph_ret_out(ArgP ap, int l, int last) { const Frame F = make_frame(ap); p_ret_out(F, l, last); }
template <int SEG> __device__ PH_ATTR void ph_merge(ArgP ap, int l, int Mx) { const Frame F = make_frame(ap);
    const bf16_t* OAB = wsp<bf16_t>(F, WS_OAB); bf16_t* MB = wsp<bf16_t>(F, WS_MB); const bf16_t* G = wsp<bf16_t>(F, WS_G);
    pg8::StaticOrder S; S.init(Mx, 2048, F.G, F.bid);
    const size_t wo = SEG == 0 ? WS_WBRA + l * SZ_WBRA : (SEG == 1 ? WS_WBRB + l * SZ_WBRB : WS_WBRC + l * SZ_WBRC); const int K = SEG == 2 ? 1024 : 512;
    pg8::Gemm g{OAB + SEG * 512, wsp<bf16_t>(F, wo), Mx, 2048, K, 2048, K}; EpiMerge<SEG> E{MB, G, wsp<unsigned char>(F, WS_MB8)}; pg8::gemm_phase<EpiMerge<SEG>, pg8::StaticOrder>(F.lds, F.tid, g, S, E); }
__device__ PH_ATTR void ph_merge3(ArgP ap, int l, int Mx) { const Frame F = make_frame(ap);
    pg8::StaticOrder S; S.init(Mx, 2048, F.G, F.bid);
    float m0_, i0_, m1_, i1_, m2_, i2_; fp8_scale(wsp<unsigned>(F, WS_WSC)[4 + l], m0_, i0_); fp8_scale(wsp<unsigned>(F, WS_WSC)[6 + l], m1_, i1_); fp8_scale(wsp<unsigned>(F, WS_WSC)[8 + l], m2_, i2_);
    pg8::Merge3 g{wsp<bf16_t>(F, WS_OAB), wsp<bf16_t>(F, WS_WBRA + l * SZ_WBRA), wsp<bf16_t>(F, WS_WBRB + l * SZ_WBRB), wsp<bf16_t>(F, WS_WBRC + l * SZ_WBRC), wsp<bf16_t>(F, WS_G), wsp<unsigned char>(F, WS_MB8), i0_ * m1_, i1_ * m2_, i2_};
    pg8::gemm_merge3<pg8::StaticOrder>(F.lds, F.tid, g, S); }
__device__ PH_ATTR void ph_out(ArgP ap, int l, int Mx) { const Frame F = make_frame(ap);
    pg8::Gemm g{wsp<bf16_t>(F, WS_MB8), wsp<bf16_t>(F, WS_WOUT + l * SZ_WOUT), Mx, 2048, 1024, 1024, 1024}; pg8::StaticOrder S; S.init(Mx, 2048, F.G, F.bid);
    float mul_, inv_; fp8_scale(wsp<unsigned>(F, WS_WSC)[2 + l], mul_, inv_);
    EpiOut E{l == 0 ? F.in(0) : F.out, l == 0 ? F.in(2) : wsp<float>(F, WS_XC), F.out, wsp<float>(F, WS_XC), wsp<float>(F, WS_MOD) + (size_t)l * 5 * 12288 + 4096, inv_ * (1.f / 16.f)};
    pg8::gemm_phase<EpiOut, pg8::StaticOrder>(F.lds, F.tid, g, S, E); }
__device__ PH_ATTR void ph_ln1(ArgP ap, int l, int last) { const Frame F = make_frame(ap); p_ln1(F, l, last); }
__device__ PH_ATTR void ph_peerq(ArgP ap, int l, int Mx) { const Frame F = make_frame(ap);
    pg8::Gemm g{wsp<bf16_t>(F, WS_HB), wsp<bf16_t>(F, WS_WPQ + l * SZ_WPQ), Mx, 1024, 2048, 2048, 2048}; pg8::StaticOrder S; S.init(Mx, 1024, F.G, F.bid);
    EpiPlain E{wsp<bf16_t>(F, WS_QP), 1024};
    pg8::gemm_phase<EpiPlain, pg8::StaticOrder>(F.lds, F.tid, g, S, E); }
__device__ PH_ATTR void ph_peer(ArgP ap, int l, int last) { const Frame F = make_frame(ap); p_peer(F, l, last); }

__global__ void __launch_bounds__(512, 2) mega_fwd(Args args) {
    extern __shared__ __attribute__((aligned(16))) unsigned char lds_raw[];
    const ArgP ap = (ArgP)__builtin_amdgcn_kernarg_segment_ptr();
    const int lo = ap->ph_lo, hi = ap->ph_hi;
    volatile LAS unsigned* misc = (volatile LAS unsigned*)((LAS unsigned char*)lds_raw + MISC_OFF);
    if (threadIdx.x < 4) misc[threadIdx.x] = 0u;
    __syncthreads();
    XcdBarrier bar; bar.bar = (unsigned*)(ap->ws + WS_CTL); bar.x = 0; bar.st = misc;
    if (hi - lo > 1) bar = xcd_barrier_post((unsigned*)(ap->ws + WS_CTL), misc);
#ifdef BENCH_K
    { float a[16]; f32x2 b2[8];
#pragma unroll
      for (int i = 0; i < 16; ++i) a[i] = 1.f + threadIdx.x * 1e-3f + i;
#pragma unroll
      for (int i = 0; i < 8; ++i) b2[i] = (f32x2){a[i], a[i + 8]};
      float c0 = a[3], c1 = a[5];
#define B16(INS) asm volatile(INS(0) INS(1) INS(2) INS(3) INS(4) INS(5) INS(6) INS(7) INS(8) INS(9) INS(10) INS(11) INS(12) INS(13) INS(14) INS(15) \
        : "+v"(a[0]), "+v"(a[1]), "+v"(a[2]), "+v"(a[3]), "+v"(a[4]), "+v"(a[5]), "+v"(a[6]), "+v"(a[7]), "+v"(a[8]), "+v"(a[9]), "+v"(a[10]), "+v"(a[11]), "+v"(a[12]), "+v"(a[13]), "+v"(a[14]), "+v"(a[15]) : "v"(c0), "v"(c1))
#define I_ADD(i) "v_add_f32 %" #i ", %" #i ", %16\n"
#define I_EXP(i) "v_exp_f32 %" #i ", %" #i "\n"
#define I_MAX3(i) "v_max3_f32 %" #i ", %" #i ", %16, %17\n"
#define I_CVT(i) "v_cvt_pk_fp8_f32 %" #i ", %16, %17\n"
#define I_DEP(i) "v_max3_f32 %0, %0, %16, %17\n"
#define I_DEPA(i) "v_add_f32 %0, %0, %16\n"
#define I_FMA(i) "v_fma_f32 %" #i ", %" #i ", %16, %17\n"
#define P8(INS) asm volatile(INS(0) INS(1) INS(2) INS(3) INS(4) INS(5) INS(6) INS(7) INS(0) INS(1) INS(2) INS(3) INS(4) INS(5) INS(6) INS(7) \
        : "+v"(b2[0]), "+v"(b2[1]), "+v"(b2[2]), "+v"(b2[3]), "+v"(b2[4]), "+v"(b2[5]), "+v"(b2[6]), "+v"(b2[7]) : "v"(b2[0]))
#define I_PKADD(i) "v_pk_add_f32 %" #i ", %" #i ", %8\n"
#define I_PKFMA(i) "v_pk_fma_f32 %" #i ", %" #i ", %8, %8\n"
#pragma unroll 1
      for (int it = 0; it < 20000; ++it) {
#if BENCH_K == 1
        B16(I_ADD);
#elif BENCH_K == 2
        B16(I_EXP);
#elif BENCH_K == 3
        B16(I_MAX3);
#elif BENCH_K == 4
        B16(I_CVT);
#elif BENCH_K == 5
        P8(I_PKADD);
#elif BENCH_K == 6
        P8(I_PKFMA);
#elif BENCH_K == 7
        B16(I_FMA);
#elif BENCH_K == 9
        B16(I_DEP);
#elif BENCH_K == 10
        B16(I_DEPA);
#endif
      }
#if BENCH_K == 11 || BENCH_K == 12
      { f32x16 q0 = {}, q1 = {}, q2 = {}, q3 = {}; att::i32x8a x8 = {1, 2, 3, 4, 5, 6, 7, (int)threadIdx.x};
#pragma unroll 1
        for (int it = 0; it < 2000; ++it) {
#pragma unroll
          for (int k = 0; k < 4; ++k) {
            q0 = __builtin_amdgcn_mfma_scale_f32_32x32x64_f8f6f4(x8, x8, q0, 0, 0, 0, 0x7F7F7F7F, 0, 0x7F7F7F7F); asm volatile("" : "+v"(q0));
#if BENCH_K == 11
            B16(I_ADD);
#else
            B16(I_EXP);
#endif
            q1 = __builtin_amdgcn_mfma_scale_f32_32x32x64_f8f6f4(x8, x8, q1, 0, 0, 0, 0x7F7F7F7F, 0, 0x7F7F7F7F); asm volatile("" : "+v"(q1));
#if BENCH_K == 11
            B16(I_ADD);
#else
            B16(I_EXP);
#endif
            q2 = __builtin_amdgcn_mfma_scale_f32_32x32x64_f8f6f4(x8, x8, q2, 0, 0, 0, 0x7F7F7F7F, 0, 0x7F7F7F7F); asm volatile("" : "+v"(q2));
#if BENCH_K == 11
            B16(I_ADD);
#else
            B16(I_EXP);
#endif
            q3 = __builtin_amdgcn_mfma_scale_f32_32x32x64_f8f6f4(x8, x8, q3, 0, 0, 0, 0x7F7F7F7F, 0, 0x7F7F7F7F); asm volatile("" : "+v"(q3));
#if BENCH_K == 11
            B16(I_ADD);
#else
            B16(I_EXP);
#endif
          }
          asm volatile("" : "+v"(x8)); } }
#endif
#if BENCH_K == 8
      { f32x16 q0 = {}, q1 = {}, q2 = {}, q3 = {}; att::i32x8a x8 = {1, 2, 3, 4, 5, 6, 7, (int)threadIdx.x};
#pragma unroll 1
        for (int it = 0; it < 2000; ++it) {
#pragma unroll
          for (int k = 0; k < 4; ++k) { q0 = __builtin_amdgcn_mfma_scale_f32_32x32x64_f8f6f4(x8, x8, q0, 0, 0, 0, 0x7F7F7F7F, 0, 0x7F7F7F7F); q1 = __builtin_amdgcn_mfma_scale_f32_32x32x64_f8f6f4(x8, x8, q1, 0, 0, 0, 0x7F7F7F7F, 0, 0x7F7F7F7F);
            q2 = __builtin_amdgcn_mfma_scale_f32_32x32x64_f8f6f4(x8, x8, q2, 0, 0, 0, 0x7F7F7F7F, 0, 0x7F7F7F7F); q3 = __builtin_amdgcn_mfma_scale_f32_32x32x64_f8f6f4(x8, x8, q3, 0, 0, 0, 0x7F7F7F7F, 0, 0x7F7F7F7F); }
          asm volatile("" : "+v"(q0), "+v"(q1), "+v"(q2), "+v"(q3), "+v"(x8)); } }
#endif
    }
#endif
#define IN(k) (lo <= (k) && (k) < hi)
#define SEAM(k) do { if (IN(k) && IN((k) + 1)) xcd_barrier(bar); } while (0)
    if (IN(0)) { if (PHM & 1) ph_prologue<7>(ap); if (REP_PRO) ph_prologue<REP_PRO>(ap); } SEAM(0);
    if (IN(1)) { if (PHM & 2) ph_modreduce(ap); if (REP_X & 32) ph_modreduce(ap); } SEAM(1);
#pragma unroll 1
    for (int l = 0; l < 2; ++l) {
        const int pb = 2 + 10 * l; const int last = (l == 1);
        const int Mx = last ? NLAT : NROW;
        if (l == 0) { if (IN(pb)) { if (PHM & 4) ph_modulate0(ap); if (REP_X & 64) ph_modulate0(ap); } SEAM(pb); }
        if (IN(pb + 1)) { if (REP_GIN) ph_gemm_in<GIN_ABL>(ap, l); if (PHM & 8) ph_gemm_in<0>(ap, l); } SEAM(pb + 1);
        if (IN(pb + 2)) { if (PHM & 16) ph_post(ap, l); if (REP_X & 1) ph_post(ap, l); } SEAM(pb + 2);
        if (IN(pb + 3)) { if (PHM & 32) ph_qup(ap, l); if (PHM & 64) ph_kvup(ap, l); if (PHM & 128) ph_states(ap, l); if (REP_X & 2) { ph_qup(ap, l); ph_kvup(ap, l); ph_states(ap, l); } } SEAM(pb + 3);
        if (IN(pb + 4)) { if (REP_ATTN & 1) ph_attn_gqa<ATT_ABL>(ap, last); if (REP_ATTN & 2) ph_attn_mla<ATT_ABL>(ap, last); if (PHM & 256) ph_attn_gqa<0>(ap, last); if (PHM & 512) ph_attn_mla<0>(ap, last); if (REP_X & 4) ph_ret_out(ap, l, last); if (PHM & 1024) ph_ret_out(ap, l, last); } SEAM(pb + 4);
        if (IN(pb + 5)) { if (PHM & 2048) { if (MERGE3) ph_merge3(ap, l, Mx); else { ph_merge<0>(ap, l, Mx); ph_merge<1>(ap, l, Mx); ph_merge<2>(ap, l, Mx); } } if (REP_X & 8) { if (MERGE3) ph_merge3(ap, l, Mx); else { ph_merge<0>(ap, l, Mx); ph_merge<1>(ap, l, Mx); ph_merge<2>(ap, l, Mx); } } } SEAM(pb + 5);
        if (IN(pb + 6)) { if (PHM & 4096) ph_out(ap, l, Mx); } SEAM(pb + 6);
        if (IN(pb + 7)) { if (PHM & 8192) ph_ln1(ap, l, last); } SEAM(pb + 7);
        if (IN(pb + 8)) { if (PHM & 16384) ph_peerq(ap, l, Mx); if (REP_X & 16) ph_peerq(ap, l, Mx); } SEAM(pb + 8);
        if (IN(pb + 9)) { if (PHM & 32768) ph_peer(ap, l, last); } SEAM(pb + 9);
    }
#undef IN
#undef SEAM
}

extern "C" void kernel_launch(void* const* d_in, const int* in_sizes, int n_in, void* d_out, int out_size, void* d_ws, size_t ws_size, hipStream_t stream) {
    static int grid = 0;
    if (grid == 0) {
        if (n_in != 27 || out_size != NLAT * D || ws_size < WS_END) { fprintf(stderr, "kernel_launch: unexpected shapes: n_in %d out %d ws %zu (need %zu)\n", n_in, out_size, ws_size, (size_t)WS_END); grid = -1; return; }
        int dev = 0, cus = 0, per_cu = 0;
        if (hipGetDevice(&dev) != hipSuccess || hipDeviceGetAttribute(&cus, hipDeviceAttributeMultiprocessorCount, dev) != hipSuccess) { grid = -1; return; }
        if (hipFuncSetAttribute((const void*)mega_fwd, hipFuncAttributeMaxDynamicSharedMemorySize, LDS_BYTES) != hipSuccess) { fprintf(stderr, "kernel_launch: hipFuncSetAttribute failed\n"); grid = -1; return; }
        if (hipOccupancyMaxActiveBlocksPerMultiprocessor(&per_cu, (const void*)mega_fwd, 512, LDS_BYTES) != hipSuccess || per_cu < 1) fprintf(stderr, "kernel_launch: occupancy query reports %d\n", per_cu);
        (void)hipGetLastError();
        grid = cus;
    }
    if (grid < 0) return;
    (void)hipMemsetAsync((char*)d_ws + WS_CTL, 0, 65536, stream);
#ifdef DBG
    (void)hipMemsetAsync((char*)d_ws + WS_CTL + 131072, 0, 4096, stream);
#endif
    Args a{};
    for (int i = 0; i < 27; ++i) a.in[i] = (const float*)d_in[i];
    a.out = (float*)d_out; a.ws = (unsigned char*)d_ws;
#if MK_PER_PHASE
    for (int p = 0; p < NPHASE; ++p) { if (p == 12) continue; a.ph_lo = p; a.ph_hi = p + 1;
#ifdef DBG
        if (p == 11) hipLaunchKernelGGL(dbg_peer_pre, dim3(DBG_NS), dim3(256), 0, stream, a, 0);
#endif
        hipLaunchKernelGGL(mega_fwd, dim3(grid), dim3(512), LDS_BYTES, stream, a);
#ifdef DBG
        if (p == 11) hipLaunchKernelGGL(dbg_peer_post, dim3(DBG_NS), dim3(256), 0, stream, a);
#endif
    }
#ifdef DBG
    hipLaunchKernelGGL(dbg_report, dim3(1), dim3(256), 0, stream, a);
#endif
#else
    a.ph_lo = 0; a.ph_hi = NPHASE;
    hipLaunchKernelGGL(mega_fwd, dim3(grid), dim3(512), LDS_BYTES, stream, a);
#endif
    const hipError_t le = hipPeekAtLastError();
    if (le != hipSuccess) fprintf(stderr, "kernel_launch: launch failed: %s\n", hipGetErrorName(le));
}
```

```cpp
#include <hip/hip_runtime.h>
#include <cstdio>
#include <cstdint>
#include <cstddef>

#ifndef MK_PER_PHASE
#define MK_PER_PHASE 0
#endif

#ifndef ABL_PEER
#define ABL_PEER 0
#endif
#ifndef REP_PEERG
#define REP_PEERG 0
#endif
#ifndef REP_PEERH
#define REP_PEERH 0
#endif
#ifndef REP_X
#define REP_X 0
#endif
#ifndef REP_PS1
#define REP_PS1 0
#endif
#ifndef REP_PS2
#define REP_PS2 0
#endif
#ifndef SIDE_ON
#define SIDE_ON 1
#endif
#ifndef REP_DOT
#define REP_DOT 0
#endif
#ifndef MERGE3
#define MERGE3 1
#endif
#ifndef REP_GIN
#define REP_GIN 0
#endif
#ifndef GIN_ABL
#define GIN_ABL 0
#endif
#ifndef ATT_ABL
#define ATT_ABL 0
#endif
#ifndef REP_ATTN
#define REP_ATTN 0
#endif
#ifndef REP_PRO
#define REP_PRO 0
#endif
#ifndef ABL_BR
#define ABL_BR 0
#endif
#ifndef ABL_MIX
#define ABL_MIX 0
#endif
#define LAS __attribute__((address_space(3)))
typedef unsigned short bf16_t;
typedef short bf16x8 __attribute__((ext_vector_type(8)));
typedef short s16x4 __attribute__((ext_vector_type(4)));
typedef float f32x2 __attribute__((ext_vector_type(2)));
typedef float f32x4 __attribute__((ext_vector_type(4)));
typedef float f32x8 __attribute__((ext_vector_type(8)));
typedef float f32x16 __attribute__((ext_vector_type(16)));
typedef unsigned u32x2 __attribute__((ext_vector_type(2)));
typedef unsigned u32x4 __attribute__((ext_vector_type(4)));
typedef __bf16 bf2_t __attribute__((ext_vector_type(2)));

constexpr int D = 2048, NB = 4, SEQ = 4096, CTXL = 256, TT = SEQ + CTXL;
constexpr int NLAT = NB * SEQ, NCTX = NB * CTXL, NROW = NLAT + NCTX;
constexpr int NP1 = 4096, NG = 6144, NPT = NP1 + NG;
constexpr int NIN = 10016;
constexpr float ALPHA = 1.4142135623730951f;
constexpr float LN_EPS = 1e-5f, RMS_EPS = 1e-6f;
constexpr float LOG2E = 1.4426950408889634f;
constexpr int C_CQ = 0, C_CKV = 512, C_GQ = 768, C_GK = 1792, C_GV = 2048, C_RQ = 2304, C_RK = 2560, C_RV = 2816, C_RG = 3328, C_KR = 3840;

constexpr size_t AL(size_t x) { return (x + 255) / 256 * 256; }
constexpr size_t WS_CTL = 0;                                    constexpr size_t CTL_BYTES = 1u << 20;
constexpr size_t WS_WSC = WS_CTL + 32768;
constexpr size_t WS_CVT = WS_CTL + 33024;
constexpr size_t WS_DEC = WS_CTL + 65536;
constexpr size_t WS_ROPE32 = WS_CTL + CTL_BYTES;
constexpr size_t WS_ROPE128 = WS_ROPE32 + AL(64 * 8 * 8);
constexpr size_t WS_MODP = WS_ROPE128 + AL(64 * 32 * 8);
constexpr size_t WS_MOD = WS_MODP + AL((size_t)16 * 2 * 5 * 12288 * 4);
constexpr size_t WS_WIN = WS_MOD + AL((size_t)2 * 5 * 12288 * 4);
constexpr size_t SZ_WIN = (size_t)NPT * D;
constexpr size_t WS_WQUP = WS_WIN + 2 * SZ_WIN;                 constexpr size_t SZ_WQUP = (size_t)768 * 512 * 2;
constexpr size_t WS_WKVUP = WS_WQUP + 2 * SZ_WQUP;              constexpr size_t SZ_WKVUP = (size_t)1024 * 256 * 2;
constexpr size_t WS_WBRA = WS_WKVUP + 2 * SZ_WKVUP;             constexpr size_t SZ_WBRA = (size_t)2048 * 512 * 2;
constexpr size_t WS_WBRB = WS_WBRA + 2 * SZ_WBRA;               constexpr size_t SZ_WBRB = SZ_WBRA;
constexpr size_t WS_WBRC = WS_WBRB + 2 * SZ_WBRB;               constexpr size_t SZ_WBRC = (size_t)2048 * 1024 * 2;
constexpr size_t WS_WOUT = WS_WBRC + 2 * SZ_WBRC;               constexpr size_t SZ_WOUT = (size_t)2048 * 2048 * 2;
constexpr size_t WS_WPQ = WS_WOUT + 2 * SZ_WOUT;                constexpr size_t SZ_WPQ = (size_t)1024 * 2048 * 2;
constexpr size_t WS_PSC = WS_WPQ + 2 * SZ_WPQ;
constexpr size_t WS_PU = WS_PSC + (size_t)4 * 16384 * 4;        constexpr size_t SZ_PT = (size_t)16384 * 1152;
constexpr size_t WS_PV = WS_PU + 2 * SZ_PT;
constexpr size_t WS_XC = WS_PV + 2 * SZ_PT;
constexpr size_t WS_HB = WS_XC + (size_t)NCTX * D * 4;
constexpr size_t WS_P1 = WS_HB + (size_t)NROW * D * 2;
constexpr size_t WS_G = WS_P1 + (size_t)NROW * NP1 * 2;
constexpr size_t WS_CQN = WS_G + (size_t)NROW * NG * 2;
constexpr size_t WS_CKVN = WS_CQN + (size_t)NROW * 512 * 2;
constexpr size_t WS_QM = WS_CKVN + (size_t)NROW * 256 * 2;
constexpr size_t SZ_Q128 = (size_t)NB * 8 * TT * 128 * 2;
constexpr size_t WS_KM = WS_QM + SZ_Q128;
constexpr size_t WS_VM = WS_KM + SZ_Q128;
constexpr size_t WS_QG = WS_VM + SZ_Q128 / 2;
constexpr size_t WS_KG = WS_QG + SZ_Q128;
constexpr size_t WS_VG = WS_KG + SZ_Q128 / 4;
constexpr size_t WS_RQ = WS_VG + SZ_Q128 / 4;
constexpr size_t WS_RK = WS_RQ + SZ_Q128 / 4;
constexpr size_t WS_RV = WS_RK + SZ_Q128 / 4;
constexpr size_t WS_ST = WS_RV + SZ_Q128 / 2;
constexpr size_t WS_OAB = WS_ST + (size_t)NB * 8 * 34 * 2 * 2048 * 4;
constexpr size_t WS_HB8 = WS_OAB + (size_t)NROW * D * 2;
constexpr size_t WS_MB8 = WS_HB8 + (size_t)NROW * D;
constexpr size_t WS_END = WS_MB8 + (size_t)NROW * D;
constexpr size_t WS_MB = WS_QM;
constexpr size_t WS_QP = WS_QG;
static_assert((size_t)NROW * D * 2 <= 2 * SZ_Q128, "MB alias");
static_assert((size_t)NROW * 1024 * 2 <= SZ_Q128, "QP alias");

__device__ __forceinline__ unsigned cvt_pk_bf16(float lo, float hi) { unsigned r; asm volatile("v_cvt_pk_bf16_f32 %0, %1, %2" : "=v"(r) : "v"(lo), "v"(hi)); return r; }
__device__ __forceinline__ bf16_t f2bf(float f) { return (bf16_t)(cvt_pk_bf16(f, 0.f) & 0xffffu); }
__device__ __forceinline__ float bf2f(bf16_t b) { return __uint_as_float(((unsigned)b) << 16); }
__device__ __forceinline__ float bflo(unsigned w) { return __uint_as_float(w << 16); }
__device__ __forceinline__ float bfhi(unsigned w) { return __uint_as_float(w & 0xffff0000u); }
template <int CTRL> __device__ __forceinline__ float dppf(float x) { return __int_as_float(__builtin_amdgcn_update_dpp(0, __float_as_int(x), CTRL, 0xF, 0xF, true)); }
__device__ __forceinline__ float row16_sum(float x) { x += dppf<0xB1>(x); x += dppf<0x4E>(x); x += dppf<0x141>(x); x += dppf<0x140>(x); return x; }
__device__ __forceinline__ float row16_max(float x) { x = fmaxf(x, dppf<0xB1>(x)); x = fmaxf(x, dppf<0x4E>(x)); x = fmaxf(x, dppf<0x141>(x)); x = fmaxf(x, dppf<0x140>(x)); return x; }
__device__ __forceinline__ float wave_sum(float x) {
    x = row16_sum(x);
    { auto r = __builtin_amdgcn_permlane16_swap(__float_as_uint(x), __float_as_uint(x), false, false); x = __uint_as_float(r[0]) + __uint_as_float(r[1]); }
    { auto r = __builtin_amdgcn_permlane32_swap(__float_as_uint(x), __float_as_uint(x), false, false); x = __uint_as_float(r[0]) + __uint_as_float(r[1]); }
    return x;
}
__device__ __forceinline__ unsigned pk4_fp8(float a, float b, float c, float d) { int t = 0; t = __builtin_amdgcn_cvt_pk_fp8_f32(a, b, t, false); t = __builtin_amdgcn_cvt_pk_fp8_f32(c, d, t, true); return (unsigned)t; }
__device__ __forceinline__ float clamp8(float x) { return fminf(fmaxf(x, -440.f), 440.f); }
__device__ __forceinline__ void fp8_scale(unsigned amax_bits, float& mul, float& inv) { const float am = __uint_as_float(amax_bits); int k = 0; if (am > 0.f) k = (int)floorf(log2f(256.f / am)); k = k > 60 ? 60 : (k < -60 ? -60 : k); mul = exp2f((float)k); inv = exp2f((float)-k); }
__device__ __forceinline__ float silu_f(float x) { return x * __builtin_amdgcn_rcpf(1.f + __builtin_amdgcn_exp2f(x * -1.4426950408889634f)); }
__device__ __forceinline__ float sigmoid_f(float x) { return __builtin_amdgcn_rcpf(1.f + __builtin_amdgcn_exp2f(x * -1.4426950408889634f)); }

__device__ __forceinline__ int vt_off(int tpos) { const int kk = tpos & 63; return (tpos & ~63) + ((kk >> 2) & 1) * 32 + ((kk >> 5) & 1) * 16 + (kk & 3) + 4 * ((kk >> 3) & 3); }
constexpr float QSC_G = 4.f * 0.08838834764831845f * 1.4426950408889634f, QSC_M = 4.f * 0.10206207261596575f * 1.4426950408889634f, KSC8 = 0.25f;
struct RowInfo { int b, tpos, pr, pc, v; bool lat; };
__device__ __forceinline__ RowInfo rowinfo(int row) {
    RowInfo r;
    if (row < NLAT) { r.lat = true; r.b = row >> 12; const int t = row & 4095; r.tpos = CTXL + t; r.pr = t >> 6; r.pc = t & 63; r.v = r.b; }
    else { const int q = row - NLAT; r.lat = false; r.b = q >> 8; r.tpos = q & 255; r.pr = 0; r.pc = 0; r.v = 4; }
    return r;
}

#define XB_TMO      128
#define XB_XCNT(j)  (256  + 64 * (j))
#define XB_XSUB(j)  (1280 + 64 * (j))
#define XB_XGEN(j)  (2304 + 64 * (j))
#define XB_TOP      3328
#define XB_TOPGEN   3392
#define XCD_BAR_WORDS 3456
#define XB_SPIN_CAP (1u << 22)

__device__ __forceinline__ unsigned xb_ld(unsigned* p)              { return __hip_atomic_load(p, __ATOMIC_RELAXED, __HIP_MEMORY_SCOPE_AGENT); }
__device__ __forceinline__ unsigned xb_add(unsigned* p, unsigned v) { return __hip_atomic_fetch_add(p, v, __ATOMIC_RELAXED, __HIP_MEMORY_SCOPE_AGENT); }
__device__ __forceinline__ unsigned xb_xcc_id() { return (unsigned)__builtin_amdgcn_s_getreg((3 << 11) | 20) & 0xFu; }
#define XB_SPIN(cond, bar) do { unsigned _sp = 0; while (cond) { __builtin_amdgcn_s_sleep(1); \
    if ((++_sp & 255u) == 0u) { if (xb_ld(&(bar)[XB_TMO])) break; if (_sp > XB_SPIN_CAP) { atomicAdd(&(bar)[XB_TMO], 1u); break; } } } } while (0)

struct XcdBarrier { unsigned* bar; unsigned x; volatile LAS unsigned* st; };

__device__ __forceinline__ XcdBarrier xcd_barrier_post(unsigned* bar, volatile LAS unsigned* st) {
    XcdBarrier b; b.bar = bar; b.x = xb_xcc_id(); b.st = st;
    if (threadIdx.x == 0) (void)xb_add(&bar[XB_XCNT(b.x)], 1u);
    return b;
}
__device__ __forceinline__ void xcd_barrier_complete(unsigned* bar, unsigned x, unsigned& nloc, unsigned& nx) {
    const unsigned G = gridDim.x * gridDim.y * gridDim.z;
    unsigned sum, cnt, mine, sp = 0u;
    for (;;) {
        sum = 0u; cnt = 0u; mine = 0u;
#pragma unroll
        for (unsigned j = 0; j < 16; ++j) { const unsigned c = xb_ld(&bar[XB_XCNT(j)]); sum += c; cnt += (c > 0u) ? 1u : 0u; mine = (j == x) ? c : mine; }
        if (sum == G) break;
        __builtin_amdgcn_s_sleep(1);
        if ((++sp & 255u) == 0u) { if (xb_ld(&bar[XB_TMO])) break; if (sp > XB_SPIN_CAP) { atomicAdd(&bar[XB_TMO], 1u); break; } }
    }
    nloc = mine > 0u ? mine : 1u; nx = cnt > 0u ? cnt : 1u;
}
__device__ __forceinline__ void xcd_barrier(const XcdBarrier& b) {
    asm volatile("s_waitcnt vmcnt(0)" ::: "memory");
    __syncthreads();
    if (threadIdx.x == 0) {
        unsigned* bar = b.bar;
        __builtin_amdgcn_s_waitcnt(0);
        unsigned nloc = b.st[0], nx = b.st[1];
        if (nloc == 0u) { xcd_barrier_complete(bar, b.x, nloc, nx); b.st[0] = nloc; b.st[1] = nx; }
        const unsigned old = xb_add(&bar[XB_XSUB(b.x)], 1u);
        const unsigned gen = old / nloc;
        if (old + 1u == (gen + 1u) * nloc) {
            __builtin_amdgcn_fence(__ATOMIC_RELEASE, "agent");
            asm volatile("s_waitcnt vmcnt(0)" ::: "memory");
            const unsigned og = xb_add(&bar[XB_TOP], 1u);
            const unsigned tg = og / nx;
            if (og + 1u == (tg + 1u) * nx) xb_add(&bar[XB_TOPGEN], 1u);
            else XB_SPIN(xb_ld(&bar[XB_TOPGEN]) == tg, bar);
            __builtin_amdgcn_fence(__ATOMIC_ACQUIRE, "agent");
            xb_add(&bar[XB_XGEN(b.x)], 1u);
            asm volatile("s_waitcnt vmcnt(0)" ::: "memory");
        } else {
            XB_SPIN(xb_ld(&bar[XB_XGEN(b.x)]) == gen, bar);
            __builtin_amdgcn_fence(__ATOMIC_ACQUIRE, "agent");
            asm volatile("s_waitcnt vmcnt(0)" ::: "memory");
        }
    }
    __syncthreads();
}
namespace pg8 {
constexpr int BM = 256, BK = 64, HALF = 128, HTB = HALF * BK * 2, STAGE_BYTES = 8 * HTB, NXCD = 8, WGM = 8;
__host__ __device__ __forceinline__ int lds_byte(int r, int c) { const int st = (r >> 4) * 2 + (c >> 5), rr = r & 15, cc = c & 31, ob = rr * 64 + cc * 2; return st * 1024 + (ob ^ (((ob >> 9) & 1) << 5)); }
__host__ __device__ __forceinline__ void stage_rc(int b, int& R, int& C) { const int st = b / 1024, sb = b % 1024, swz = sb ^ (((sb >> 9) & 1) << 5); R = (st >> 1) * 16 + swz / 64; C = (st & 1) * 32 + (swz % 64) / 2; }
__host__ __device__ __forceinline__ int perm32(int rho) { const int n = rho >> 4, i = rho & 15; return 8 * (i >> 2) + 4 * n + (i & 3); }

struct Unit { int pm, pn; };
typedef int i32x8 __attribute__((ext_vector_type(8))); typedef int i32x4v __attribute__((ext_vector_type(4)));
__device__ __forceinline__ i32x8 cat8(const bf16x8 a, const bf16x8 b) { const i32x4v x = __builtin_bit_cast(i32x4v, a), y = __builtin_bit_cast(i32x4v, b); return __builtin_shufflevector(x, y, 0, 1, 2, 3, 4, 5, 6, 7); }
struct Gemm { const bf16_t* A; const bf16_t* Bt; int M, N, K, lda, ldb; };

struct StaticOrder {
    int nM, nN, nwg, G, c;
    __host__ __device__ void init(int M, int N, int G_, int c_) { nM = M / BM; nN = N / BM; nwg = nM * nN; G = G_; c = c_; }
    __host__ __device__ bool next(int i, Unit& u) const {
        const long L = (long)i * G + c; if (L >= nwg) return false;
        int wgid = (int)L; { const int q = nwg / NXCD, r = nwg % NXCD, xcd = wgid % NXCD, off = wgid / NXCD; wgid = (xcd < r ? xcd * (q + 1) : r * (q + 1) + (xcd - r) * q) + off; }
        const int nig = WGM * nN, gid = wgid / nig, fm = gid * WGM, gsz = (nM - fm) < WGM ? (nM - fm) : WGM;
        u.pm = fm + ((wgid % nig) % gsz); u.pn = (wgid % nig) / gsz; return true;
    }
    __device__ __forceinline__ void a_ready(const Unit&) const {}
    __device__ __forceinline__ void done(const Unit&) const {}
};

template <class Epi, class Sched, int GABL = 0>
__device__ __forceinline__ void gemm_phase(LAS unsigned char* lds, const int tid, const Gemm g, const Sched& S, const Epi& E) {
    const int  wid = __builtin_amdgcn_readfirstlane(tid >> 6), lane = tid & 63, wr = wid >> 2, wc = wid & 3, fr = lane & 15, fq = lane >> 4;
    const int K = g.K, nt = K / BK;
    unsigned voffA[2], voffB[2];
#pragma unroll
    for (int i = 0; i < 2; ++i) { int R, C; stage_rc(tid * 16 + i * 8192, R, C); const int Rb = Epi::PERM ? ((R & ~31) + perm32(R & 31)) : R;
        voffA[i] = (unsigned)(R * g.lda + C) * 2u; voffB[i] = (unsigned)(Rb * g.ldb + C) * 2u; }
    const size_t kstep = (size_t)(BK * 2);
    const size_t hstepA = (size_t)HALF * g.lda * 2, hstepB = (size_t)HALF * g.ldb * 2;
    const size_t tstepA = 2 * hstepA, tstepB = 2 * hstepB;
    const unsigned ldsw = (unsigned)wid * 1024u;
    const int aoff = lds_byte(wr * 64 + fr, fq * 8), boff = lds_byte(wc * 32 + fr, fq * 8);
#define PG8_SA(b, h) (((b) * 2 + (h)) * HTB)
#define PG8_SB(b, h) ((4 + (b) * 2 + (h)) * HTB)
#define PG8_STAGE(bufoff, gbase, voff) do { if constexpr (!(GABL & 4)) _Pragma("unroll") for (int _i = 0; _i < 2; ++_i) \
        __builtin_amdgcn_global_load_lds((const unsigned*)((const char*)(gbase) + (voff)[_i]), (LAS unsigned*)(lds + (bufoff) + ldsw + _i * 8192), 16, 0, 0); } while (0)
#define PG8_LDA(dst, b, h) do { if constexpr (Epi::FP8) { _Pragma("unroll") for (int m = 0; m < 4; ++m) { const i32x4v lo_ = *(const LAS i32x4v*)(lds + PG8_SA(b, h) + aoff + m * 2048), hi_ = *(const LAS i32x4v*)(lds + PG8_SA(b, h) + aoff + m * 2048 + 1024); \
            dst##8[m] = __builtin_shufflevector(lo_, hi_, 0, 1, 2, 3, 4, 5, 6, 7); } } \
        else { _Pragma("unroll") for (int m = 0; m < 4; ++m) _Pragma("unroll") for (int k = 0; k < 2; ++k) dst[m][k] = *(const LAS bf16x8*)(lds + PG8_SA(b, h) + aoff + m * 2048 + k * 1024); } } while (0)
#define PG8_LDB(dst, b, h) do { if constexpr (Epi::FP8) { _Pragma("unroll") for (int n = 0; n < 2; ++n) { const i32x4v lo_ = *(const LAS i32x4v*)(lds + PG8_SB(b, h) + boff + n * 2048), hi_ = *(const LAS i32x4v*)(lds + PG8_SB(b, h) + boff + n * 2048 + 1024); \
            dst##8[n] = __builtin_shufflevector(lo_, hi_, 0, 1, 2, 3, 4, 5, 6, 7); } } \
        else { _Pragma("unroll") for (int n = 0; n < 2; ++n) _Pragma("unroll") for (int k = 0; k < 2; ++k) dst[n][k] = *(const LAS bf16x8*)(lds + PG8_SB(b, h) + boff + n * 2048 + k * 1024); } } while (0)
#define PG8_MMA(ai, bj, At, Bt) do { __builtin_amdgcn_s_setprio(1); _Pragma("unroll") for (int m = 0; m < 4; ++m) _Pragma("unroll") for (int n = 0; n < 2; ++n) { \
        if constexpr (Epi::FP8) { if constexpr (GABL & 8) asm volatile("" : "+v"(acc[ai][bj][m][n]) : "v"(Bt##8[n]), "v"(At##8[m]), "v"(sc1_)); else asm volatile("v_mfma_scale_f32_16x16x128_f8f6f4 %0, %1, %2, %0, %3, %3 op_sel_hi:[0,0,0]" : "+v"(acc[ai][bj][m][n]) : "v"(Bt##8[n]), "v"(At##8[m]), "v"(sc1_)); } \
        else { _Pragma("unroll") for (int k = 0; k < 2; ++k) acc[ai][bj][m][n] = __builtin_amdgcn_mfma_f32_16x16x32_bf16(Bt[n][k], At[m][k], acc[ai][bj][m][n], 0, 0, 0); } } __builtin_amdgcn_s_setprio(0); } while (0)
#define PG8_WAIT_V(n) asm volatile("s_waitcnt vmcnt(" #n ")" ::: "memory")
#define PG8_WAIT_L(n) asm volatile("s_waitcnt lgkmcnt(" #n ")" ::: "memory")
#define PG8_BAR __builtin_amdgcn_s_barrier()
#define PG8_SCHED __builtin_amdgcn_sched_barrier(0)
    Unit cur, nxt; int ui = 0;
    if (!S.next(0, cur)) return;
    f32x4 acc[2][2][4][2];
#pragma unroll
    for (int a = 0; a < 2; ++a)
#pragma unroll
        for (int b = 0; b < 2; ++b)
#pragma unroll
            for (int m = 0; m < 4; ++m)
#pragma unroll
                for (int n = 0; n < 2; ++n) acc[a][b][m][n] = (f32x4){0.f, 0.f, 0.f, 0.f};
    int sc1_ = 0x7F7F7F7F; asm volatile("" : "+v"(sc1_));
    bf16x8 At[4][2], B0[2][2], B1[2][2]; i32x8 At8[4], B08[2], B18[2];
    const char* cA = (const char*)g.A + (size_t)cur.pm * tstepA; const char* cB = (const char*)g.Bt + (size_t)cur.pn * tstepB;
    S.a_ready(cur);
    PG8_STAGE(PG8_SB(0, 0), cB, voffB); PG8_STAGE(PG8_SA(0, 0), cA, voffA); PG8_STAGE(PG8_SB(0, 1), cB + hstepB, voffB); PG8_STAGE(PG8_SA(0, 1), cA + hstepA, voffA);
    if (wr == 1) PG8_BAR;
    PG8_WAIT_V(4); PG8_BAR;
    PG8_STAGE(PG8_SB(1, 0), cB + kstep, voffB); PG8_STAGE(PG8_SA(1, 0), cA + kstep, voffA); PG8_STAGE(PG8_SB(1, 1), cB + hstepB + kstep, voffB);
    PG8_WAIT_V(6); PG8_BAR;
    for (;;) {
        const bool has_next = S.next(ui + 1, nxt);
        const char* nA = has_next ? (const char*)g.A + (size_t)nxt.pm * tstepA : cA; const char* nB = has_next ? (const char*)g.Bt + (size_t)nxt.pn * tstepB : cB;
#pragma unroll 1
        for (int t = 0; t < nt; t += 2) {
            const bool last = (t == nt - 2);
            const char* a1 = cA + (size_t)(t + 1) * kstep;
            const char* a2 = last ? nA : cA + (size_t)(t + 2) * kstep; const char* b2 = last ? nB : cB + (size_t)(t + 2) * kstep;
            const char* a3 = a2 + kstep; const char* b3 = b2 + kstep;
            if (last && has_next) S.a_ready(nxt);
            PG8_LDB(B0, 0, 0); PG8_SCHED; PG8_LDA(At, 0, 0); PG8_STAGE(PG8_SA(1, 1), a1 + hstepA, voffA);
            PG8_WAIT_L(8); PG8_BAR; PG8_WAIT_L(0); PG8_MMA(0, 0, At, B0); PG8_BAR; PG8_SCHED;
            PG8_LDB(B1, 0, 1); PG8_STAGE(PG8_SB(0, 0), b2, voffB);
            PG8_BAR; PG8_WAIT_L(0); PG8_MMA(0, 1, At, B1); PG8_BAR;
            PG8_LDA(At, 0, 1); PG8_STAGE(PG8_SA(0, 0), a2, voffA);
            PG8_BAR; PG8_WAIT_L(0); PG8_MMA(1, 0, At, B0); PG8_BAR; PG8_SCHED;
            PG8_STAGE(PG8_SB(0, 1), b2 + hstepB, voffB);
            PG8_WAIT_V(6); PG8_BAR; PG8_MMA(1, 1, At, B1); PG8_BAR;
            PG8_LDB(B0, 1, 0); PG8_SCHED; PG8_LDA(At, 1, 0); PG8_STAGE(PG8_SA(0, 1), a2 + hstepA, voffA);
            PG8_WAIT_L(8); PG8_BAR; PG8_WAIT_L(0); PG8_MMA(0, 0, At, B0); PG8_BAR; PG8_SCHED;
            PG8_LDB(B1, 1, 1); PG8_STAGE(PG8_SB(1, 0), b3, voffB);
            PG8_BAR; PG8_WAIT_L(0); PG8_MMA(0, 1, At, B1); PG8_BAR;
            PG8_LDA(At, 1, 1); PG8_STAGE(PG8_SA(1, 0), a3, voffA);
            PG8_BAR; PG8_WAIT_L(0); PG8_MMA(1, 0, At, B0); PG8_BAR; PG8_SCHED;
            PG8_STAGE(PG8_SB(1, 1), b3 + hstepB, voffB);
            PG8_WAIT_V(6); PG8_BAR; PG8_MMA(1, 1, At, B1); PG8_BAR;
        }
        if constexpr (Epi::FP8) asm volatile("s_nop 15\n\ts_nop 15" ::: "memory");
        if constexpr (GABL & 2) { pg8::Unit u2_ = cur; u2_.pm = 0; Epi E2_ = E; E2_.retarget(); E2_(acc, u2_, wr, wc, fr, fq); } else if constexpr (!(GABL & 1)) E(acc, cur, wr, wc, fr, fq); else asm volatile("" :: "v"(acc[0][0][0][0]), "v"(acc[1][1][3][1]), "v"(acc[0][1][2][0]), "v"(acc[1][0][1][1]));
        if (!has_next) break;
#pragma unroll
        for (int a = 0; a < 2; ++a)
#pragma unroll
            for (int b = 0; b < 2; ++b)
#pragma unroll
                for (int m = 0; m < 4; ++m)
#pragma unroll
                    for (int n = 0; n < 2; ++n) acc[a][b][m][n] = (f32x4){0.f, 0.f, 0.f, 0.f};
        cur = nxt; cA = nA; cB = nB; ++ui;
    }
    PG8_WAIT_V(0);
    if (wr == 0) PG8_BAR;
    PG8_BAR;
#undef PG8_SA
#undef PG8_SB
#undef PG8_STAGE
#undef PG8_LDA
#undef PG8_LDB
#undef PG8_MMA
#undef PG8_WAIT_V
#undef PG8_WAIT_L
#undef PG8_BAR
#undef PG8_SCHED
}
}

typedef f32x4 Acc[2][2][4][2];
#define EPI_LOOP_ROWS for (int ai = 0; ai < 2; ++ai) for (int m = 0; m < 4; ++m)
__device__ __forceinline__ u32x4 pack8(const f32x4 a, const f32x4 b) { u32x4 w; w.x = cvt_pk_bf16(a[0], a[1]); w.y = cvt_pk_bf16(a[2], a[3]); w.z = cvt_pk_bf16(b[0], b[1]); w.w = cvt_pk_bf16(b[2], b[3]); return w; }

struct EpiIn {
    static constexpr bool PERM = true, FP8 = true;
    bf16_t* P1; bf16_t* G; float inv;
    __device__ __forceinline__ void retarget() { P1 = (bf16_t*)((char*)P1 - WS_P1 + WS_END); G = P1 + 256 * NP1; }
    __device__ __forceinline__ void operator()(const Acc& acc, const pg8::Unit& u, int wr, int wc, int fr, int fq) const {
        const int row0 = u.pm * 256 + wr * 64 + fr; const bool gate = u.pn >= 16;
        bf16_t* base = gate ? G : P1; const int ld = gate ? NG : NP1; const int col0 = (gate ? (u.pn - 16) : u.pn) * 256 + wc * 32 + 8 * fq;
#pragma unroll
        for (int ai = 0; ai < 2; ++ai)
#pragma unroll
            for (int m = 0; m < 4; ++m) { bf16_t* rowp = base + (size_t)(row0 + ai * 128 + m * 16) * ld + col0;
#pragma unroll
                for (int bj = 0; bj < 2; ++bj) { f32x4 v0 = acc[ai][bj][m][0] * inv, v1 = acc[ai][bj][m][1] * inv;
                    if (gate) {
#pragma unroll
                        for (int j = 0; j < 4; ++j) { v0[j] = sigmoid_f(v0[j]); v1[j] = sigmoid_f(v1[j]); } }
                    __builtin_nontemporal_store(pack8(v0, v1), (u32x4*)(rowp + bj * 128)); } }
    }
};
struct EpiPlain {
    static constexpr bool PERM = true, FP8 = false;
    bf16_t* O; int ldc;
    __device__ __forceinline__ void operator()(const Acc& acc, const pg8::Unit& u, int wr, int wc, int fr, int fq) const {
        const int row0 = u.pm * 256 + wr * 64 + fr; const int col0 = u.pn * 256 + wc * 32 + 8 * fq;
#pragma unroll
        for (int ai = 0; ai < 2; ++ai)
#pragma unroll
            for (int m = 0; m < 4; ++m) { bf16_t* rowp = O + (size_t)(row0 + ai * 128 + m * 16) * ldc + col0;
#pragma unroll
                for (int bj = 0; bj < 2; ++bj) *(u32x4*)(rowp + bj * 128) = pack8(acc[ai][bj][m][0], acc[ai][bj][m][1]); }
    }
};
__device__ __forceinline__ void tile_info(int pm, int& b, int& tpos0, bool& lat) { lat = pm < 64; b = lat ? (pm >> 4) : (pm - 64); tpos0 = lat ? CTXL + ((pm & 15) << 8) : 0; }
struct EpiQup {
    static constexpr bool PERM = true, FP8 = false;
    unsigned char* QM; const f32x2* cs32;
    __device__ __forceinline__ void operator()(const Acc& acc, const pg8::Unit& u, int wr, int wc, int fr, int fq) const {
        int b, tpos0; bool lat; tile_info(u.pm, b, tpos0, lat);
        const int r0 = wr * 64 + fr;
#pragma unroll
        for (int bj = 0; bj < 2; ++bj) { const int c0 = u.pn * 256 + bj * 128 + wc * 32 + 8 * fq; const int hh = c0 / 96, j0 = c0 - hh * 96;
            unsigned char* hb = QM + ((size_t)(b * 8 + hh) * TT + tpos0 + r0) * 128;
            if (j0 < 64) {
#pragma unroll
                for (int ai = 0; ai < 2; ++ai)
#pragma unroll
                    for (int m = 0; m < 4; ++m) { const f32x4 a_ = acc[ai][bj][m][0] * QSC_M, b_ = acc[ai][bj][m][1] * QSC_M; u32x2 w8; w8.x = pk4_fp8(clamp8(a_[0]), clamp8(a_[1]), clamp8(a_[2]), clamp8(a_[3])); w8.y = pk4_fp8(clamp8(b_[0]), clamp8(b_[1]), clamp8(b_[2]), clamp8(b_[3]));
                        *(u32x2*)(hb + (ai * 128 + m * 16) * 128 + j0) = w8; }
            } else { const int g8 = (j0 - 64) >> 3, part = g8 >> 1, pbase = (g8 & 1) * 4;
#pragma unroll
                for (int ai = 0; ai < 2; ++ai)
#pragma unroll
                    for (int m = 0; m < 4; ++m) { const int t = tpos0 - CTXL + r0 + ai * 128 + m * 16; const int pos = part ? (t & 63) : (t >> 6);
                        const f32x4 v0 = acc[ai][bj][m][0] * QSC_M, v1 = acc[ai][bj][m][1] * QSC_M;
                        float o1[4], o2[4]; const float x1[4] = {v0[0], v0[2], v1[0], v1[2]}, x2[4] = {v0[1], v0[3], v1[1], v1[3]};
#pragma unroll
                        for (int p = 0; p < 4; ++p) { const f32x2 cs = lat ? cs32[pos * 8 + pbase + p] : (f32x2){1.f, 0.f};
                            o1[p] = x1[p] * cs.x - x2[p] * cs.y; o2[p] = x1[p] * cs.y + x2[p] * cs.x; }
                        unsigned char* dst = hb + (ai * 128 + m * 16) * 128 + 64 + part * 16 + pbase;
                        *(unsigned*)dst = pk4_fp8(clamp8(o1[0]), clamp8(o1[1]), clamp8(o1[2]), clamp8(o1[3])); *(unsigned*)(dst + 8) = pk4_fp8(clamp8(o2[0]), clamp8(o2[1]), clamp8(o2[2]), clamp8(o2[3])); } } }
    }
};
struct EpiKvup {
    static constexpr bool PERM = true, FP8 = false;
    unsigned char* KM; unsigned char* VM;
    __device__ __forceinline__ void operator()(const Acc& acc, const pg8::Unit& u, int wr, int wc, int fr, int fq) const {
        int b, tpos0; bool lat; tile_info(u.pm, b, tpos0, lat);
        const int r0 = wr * 64 + fr; const int j0 = wc * 32 + 8 * fq;
#pragma unroll
        for (int bj = 0; bj < 2; ++bj) { const size_t tok = (size_t)(b * 8 + u.pn * 2 + bj) * TT + tpos0 + r0;
            if (j0 < 64) { unsigned char* d = KM + tok * 128 + j0;
#pragma unroll
                for (int ai = 0; ai < 2; ++ai)
#pragma unroll
                    for (int m = 0; m < 4; ++m) { const f32x4 a_ = acc[ai][bj][m][0] * KSC8, b_ = acc[ai][bj][m][1] * KSC8; u32x2 w8; w8.x = pk4_fp8(clamp8(a_[0]), clamp8(a_[1]), clamp8(a_[2]), clamp8(a_[3])); w8.y = pk4_fp8(clamp8(b_[0]), clamp8(b_[1]), clamp8(b_[2]), clamp8(b_[3]));
                        *(u32x2*)(d + (ai * 128 + m * 16) * 128) = w8; } }
            else { unsigned char* d = VM + ((size_t)(b * 8 + u.pn * 2 + bj) * 64 + (j0 - 64)) * TT;
#pragma unroll
                for (int ai = 0; ai < 2; ++ai)
#pragma unroll
                    for (int m = 0; m < 4; ++m) { const f32x4 a_ = acc[ai][bj][m][0], b_ = acc[ai][bj][m][1]; const unsigned w0_ = pk4_fp8(clamp8(a_[0]), clamp8(a_[1]), clamp8(a_[2]), clamp8(a_[3])), w1_ = pk4_fp8(clamp8(b_[0]), clamp8(b_[1]), clamp8(b_[2]), clamp8(b_[3]));
                        unsigned char* q_ = d + vt_off(tpos0 + r0 + ai * 128 + m * 16);
                        q_[0] = (unsigned char)(w0_ & 0xffu); q_[TT] = (unsigned char)((w0_ >> 8) & 0xffu); q_[2 * TT] = (unsigned char)((w0_ >> 16) & 0xffu); q_[3 * TT] = (unsigned char)(w0_ >> 24);
                        q_[4 * TT] = (unsigned char)(w1_ & 0xffu); q_[5 * TT] = (unsigned char)((w1_ >> 8) & 0xffu); q_[6 * TT] = (unsigned char)((w1_ >> 16) & 0xffu); q_[7 * TT] = (unsigned char)(w1_ >> 24); } } }
    }
};
template <int SEG> struct EpiMerge {
    static constexpr bool PERM = true, FP8 = false;
    bf16_t* MB; const bf16_t* G; unsigned char* MB8;
    __device__ __forceinline__ void operator()(const Acc& acc, const pg8::Unit& u, int wr, int wc, int fr, int fq) const {
        const int row0 = u.pm * 256 + wr * 64 + fr; const int col0 = u.pn * 256 + wc * 32 + 8 * fq;
        const bf16_t* gp = G + (size_t)row0 * NG + SEG * 2048 + col0; bf16_t* mp = MB + (size_t)row0 * D + col0; unsigned char* m8 = MB8 + (size_t)row0 * D + col0;
#pragma unroll
        for (int ai = 0; ai < 2; ++ai) {
            u32x4 gw[4][2], ow[4][2];
#pragma unroll
            for (int m = 0; m < 4; ++m)
#pragma unroll
                for (int bj = 0; bj < 2; ++bj) { const size_t ro = (size_t)(ai * 128 + m * 16);
                    gw[m][bj] = *(const u32x4*)(gp + ro * NG + bj * 128);
                    if (SEG > 0) ow[m][bj] = __builtin_nontemporal_load((const u32x4*)(mp + ro * D + bj * 128)); }
#pragma unroll
            for (int m = 0; m < 4; ++m)
#pragma unroll
                for (int bj = 0; bj < 2; ++bj) { const size_t ro = (size_t)(ai * 128 + m * 16); const u32x4 g_ = gw[m][bj];
                    f32x4 v0 = acc[ai][bj][m][0], v1 = acc[ai][bj][m][1];
                    if (ABL_BR & (1 << SEG)) { v0 = (f32x4){0.f, 0.f, 0.f, 0.f}; v1 = v0; }
                    v0[0] *= bflo(g_.x); v0[1] *= bfhi(g_.x); v0[2] *= bflo(g_.y); v0[3] *= bfhi(g_.y);
                    v1[0] *= bflo(g_.z); v1[1] *= bfhi(g_.z); v1[2] *= bflo(g_.w); v1[3] *= bfhi(g_.w);
                    if (SEG > 0) { const u32x4 o = ow[m][bj];
                        v0[0] += bflo(o.x); v0[1] += bfhi(o.x); v0[2] += bflo(o.y); v0[3] += bfhi(o.y);
                        v1[0] += bflo(o.z); v1[1] += bfhi(o.z); v1[2] += bflo(o.w); v1[3] += bfhi(o.w); }
                    if (SEG < 2) *(u32x4*)(mp + ro * D + bj * 128) = pack8(v0, v1);
                    else { u32x2 w8; w8.x = pk4_fp8(clamp8(v0[0] * 16.f), clamp8(v0[1] * 16.f), clamp8(v0[2] * 16.f), clamp8(v0[3] * 16.f)); w8.y = pk4_fp8(clamp8(v1[0] * 16.f), clamp8(v1[1] * 16.f), clamp8(v1[2] * 16.f), clamp8(v1[3] * 16.f));
                        *(u32x2*)(m8 + ro * D + bj * 128) = w8; } }
        }
    }
};
namespace pg8 {
struct Merge3 { const bf16_t* A; const bf16_t* B0; const bf16_t* B1; const bf16_t* B2; const bf16_t* G; unsigned char* MB8; float r01, r12, fin; };
template <class Sched>
__device__ __forceinline__ void gemm_merge3(LAS unsigned char* lds, const int tid, const Merge3 g, const Sched& S) {
    constexpr int GABL = 0;
    const int wid = __builtin_amdgcn_readfirstlane(tid >> 6), lane = tid & 63, wr = wid >> 2, wc = wid & 3, fr = lane & 15, fq = lane >> 4;
    constexpr int NT = 16, LDA = 1024;
    int sc1_ = 0x7F7F7F7F; asm volatile("" : "+v"(sc1_));
    unsigned voffA[2], voffB5[2], voffB10[2];
#pragma unroll
    for (int i = 0; i < 2; ++i) { int R, C; stage_rc(tid * 16 + i * 8192, R, C); const int Rb = (R & ~31) + perm32(R & 31);
        voffA[i] = (unsigned)(R * LDA + C) * 2u; voffB5[i] = (unsigned)(Rb * 256 + C) * 2u; voffB10[i] = (unsigned)(Rb * 512 + C) * 2u; }
    const size_t kstep = (size_t)(BK * 2);
    const size_t hstepA = (size_t)HALF * LDA * 2, tstepA = 2 * hstepA;
    const unsigned ldsw = (unsigned)wid * 1024u;
    const int aoff = lds_byte(wr * 64 + fr, fq * 8), boff = lds_byte(wc * 32 + fr, fq * 8);
#define M3_TA(pm_, t_) ((const char*)g.A + (size_t)(pm_) * tstepA + (size_t)(t_) * kstep)
#define M3_TB(pn_, t_) ((t_) < 4 ? (const char*)g.B0 + (size_t)(pn_) * 131072 + (size_t)(t_) * kstep : ((t_) < 8 ? (const char*)g.B1 + (size_t)(pn_) * 131072 + (size_t)((t_) - 4) * kstep : (const char*)g.B2 + (size_t)(pn_) * 262144 + (size_t)((t_) - 8) * kstep))
#define PG8_SA(b, h) (((b) * 2 + (h)) * HTB)
#define PG8_SB(b, h) ((4 + (b) * 2 + (h)) * HTB)
#define PG8_STAGE(bufoff, gbase, voff) do { if constexpr (!(GABL & 4)) _Pragma("unroll") for (int _i = 0; _i < 2; ++_i) \
        __builtin_amdgcn_global_load_lds((const unsigned*)((const char*)(gbase) + (voff)[_i]), (LAS unsigned*)(lds + (bufoff) + ldsw + _i * 8192), 16, 0, 0); } while (0)
#define PG8_LDA(dst, b, h) do { _Pragma("unroll") for (int m = 0; m < 4; ++m) { const i32x4v lo_ = *(const LAS i32x4v*)(lds + PG8_SA(b, h) + aoff + m * 2048), hi_ = *(const LAS i32x4v*)(lds + PG8_SA(b, h) + aoff + m * 2048 + 1024); dst[m] = __builtin_shufflevector(lo_, hi_, 0, 1, 2, 3, 4, 5, 6, 7); } } while (0)
#define PG8_LDB(dst, b, h) do { _Pragma("unroll") for (int n = 0; n < 2; ++n) { const i32x4v lo_ = *(const LAS i32x4v*)(lds + PG8_SB(b, h) + boff + n * 2048), hi_ = *(const LAS i32x4v*)(lds + PG8_SB(b, h) + boff + n * 2048 + 1024); dst[n] = __builtin_shufflevector(lo_, hi_, 0, 1, 2, 3, 4, 5, 6, 7); } } while (0)
#define PG8_MMA(ai, bj, At, Bt) do { __builtin_amdgcn_s_setprio(1); _Pragma("unroll") for (int m = 0; m < 4; ++m) _Pragma("unroll") for (int n = 0; n < 2; ++n) \
        asm volatile("v_mfma_scale_f32_16x16x128_f8f6f4 %0, %1, %2, %0, %3, %3 op_sel_hi:[0,0,0]" : "+v"(acc[ai][bj][m][n]) : "v"(Bt[n]), "v"(At[m]), "v"(sc1_)); __builtin_amdgcn_s_setprio(0); } while (0)
#define PG8_WAIT_V(n) asm volatile("s_waitcnt vmcnt(" #n ")" ::: "memory")
#define PG8_WAIT_L(n) asm volatile("s_waitcnt lgkmcnt(" #n ")" ::: "memory")
#define PG8_BAR __builtin_amdgcn_s_barrier()
#define PG8_SCHED __builtin_amdgcn_sched_barrier(0)
    Unit cur, nxt; int ui = 0;
    if (!S.next(0, cur)) return;
    f32x4 acc[2][2][4][2];
#pragma unroll
    for (int a = 0; a < 2; ++a)
#pragma unroll
        for (int b = 0; b < 2; ++b)
#pragma unroll
            for (int m = 0; m < 4; ++m)
#pragma unroll
                for (int n = 0; n < 2; ++n) acc[a][b][m][n] = (f32x4){0.f, 0.f, 0.f, 0.f};
    i32x8 At[4], B0[2], B1[2];
    { const char* cA = M3_TA(cur.pm, 0); const char* cB = M3_TB(cur.pn, 0); const size_t hB = 65536;
      PG8_STAGE(PG8_SB(0, 0), cB, voffB5); PG8_STAGE(PG8_SA(0, 0), cA, voffA); PG8_STAGE(PG8_SB(0, 1), cB + hB, voffB5); PG8_STAGE(PG8_SA(0, 1), cA + hstepA, voffA);
      if (wr == 1) PG8_BAR;
      PG8_WAIT_V(4); PG8_BAR;
      PG8_STAGE(PG8_SB(1, 0), cB + kstep, voffB5); PG8_STAGE(PG8_SA(1, 0), cA + kstep, voffA); PG8_STAGE(PG8_SB(1, 1), cB + hB + kstep, voffB5);
      PG8_WAIT_V(6); PG8_BAR; }
    const int r0 = wr * 64 + fr, c0l = wc * 32 + 8 * fq;
    for (;;) {
        const bool has_next = S.next(ui + 1, nxt);
        const int npm = has_next ? nxt.pm : cur.pm, npn = has_next ? nxt.pn : cur.pn;
#pragma unroll 1
        for (int t = 0; t < NT; t += 2) {
            const bool last = (t == NT - 2);
            const int t2 = last ? 0 : t + 2;
            const char* a1 = M3_TA(cur.pm, t + 1);
            const char* a2 = last ? M3_TA(npm, 0) : M3_TA(cur.pm, t + 2); const char* b2 = last ? M3_TB(npn, 0) : M3_TB(cur.pn, t + 2);
            const char* a3 = a2 + kstep; const char* b3 = b2 + kstep;
            const bool wide = t2 >= 8; const size_t hB = wide ? 131072 : 65536;
            unsigned vB[2]; vB[0] = wide ? voffB10[0] : voffB5[0]; vB[1] = wide ? voffB10[1] : voffB5[1];
            PG8_LDB(B0, 0, 0); PG8_SCHED; PG8_LDA(At, 0, 0); PG8_STAGE(PG8_SA(1, 1), a1 + hstepA, voffA);
            PG8_WAIT_L(8); PG8_BAR; PG8_WAIT_L(0); PG8_MMA(0, 0, At, B0); PG8_BAR; PG8_SCHED;
            PG8_LDB(B1, 0, 1); PG8_STAGE(PG8_SB(0, 0), b2, vB);
            PG8_BAR; PG8_WAIT_L(0); PG8_MMA(0, 1, At, B1); PG8_BAR;
            PG8_LDA(At, 0, 1); PG8_STAGE(PG8_SA(0, 0), a2, voffA);
            PG8_BAR; PG8_WAIT_L(0); PG8_MMA(1, 0, At, B0); PG8_BAR; PG8_SCHED;
            PG8_STAGE(PG8_SB(0, 1), b2 + hB, vB);
            PG8_WAIT_V(6); PG8_BAR; PG8_MMA(1, 1, At, B1); PG8_BAR;
            PG8_LDB(B0, 1, 0); PG8_SCHED; PG8_LDA(At, 1, 0); PG8_STAGE(PG8_SA(0, 1), a2 + hstepA, voffA);
            PG8_WAIT_L(8); PG8_BAR; PG8_WAIT_L(0); PG8_MMA(0, 0, At, B0); PG8_BAR; PG8_SCHED;
            PG8_LDB(B1, 1, 1); PG8_STAGE(PG8_SB(1, 0), b3, vB);
            PG8_BAR; PG8_WAIT_L(0); PG8_MMA(0, 1, At, B1); PG8_BAR;
            PG8_LDA(At, 1, 1); PG8_STAGE(PG8_SA(1, 0), a3, voffA);
            PG8_BAR; PG8_WAIT_L(0); PG8_MMA(1, 0, At, B0); PG8_BAR; PG8_SCHED;
            PG8_STAGE(PG8_SB(1, 1), b3 + hB, vB);
            PG8_WAIT_V(6); PG8_BAR; PG8_MMA(1, 1, At, B1); PG8_BAR;
            if (t == 2 || t == 6) {
                asm volatile("s_nop 15\n\ts_nop 15" ::: "memory");
                const int sg = t == 2 ? 0 : 1; const float wr_ = sg ? g.r12 : g.r01;
                const bf16_t* gp = g.G + (size_t)(cur.pm * 256 + r0) * NG + sg * 2048 + cur.pn * 256 + c0l;
#pragma unroll
                for (int ai = 0; ai < 2; ++ai) { u32x4 ga[4][2], gb[4][2];
#pragma unroll
                    for (int m = 0; m < 4; ++m)
#pragma unroll
                        for (int bj = 0; bj < 2; ++bj) { const bf16_t* q_ = gp + (size_t)(ai * 128 + m * 16) * NG + bj * 128; ga[m][bj] = *(const u32x4*)q_; gb[m][bj] = *(const u32x4*)(q_ + 2048); }
#pragma unroll
                    for (int m = 0; m < 4; ++m)
#pragma unroll
                        for (int bj = 0; bj < 2; ++bj) { const u32x4 x_ = ga[m][bj], y_ = gb[m][bj];
#define M3_RT(xw, yw, lohi) (fmaxf(lohi(xw), 1e-6f) * wr_ * __builtin_amdgcn_rcpf(fmaxf(lohi(yw), 1e-6f)))
                            acc[ai][bj][m][0][0] *= M3_RT(x_.x, y_.x, bflo); acc[ai][bj][m][0][1] *= M3_RT(x_.x, y_.x, bfhi); acc[ai][bj][m][0][2] *= M3_RT(x_.y, y_.y, bflo); acc[ai][bj][m][0][3] *= M3_RT(x_.y, y_.y, bfhi);
                            acc[ai][bj][m][1][0] *= M3_RT(x_.z, y_.z, bflo); acc[ai][bj][m][1][1] *= M3_RT(x_.z, y_.z, bfhi); acc[ai][bj][m][1][2] *= M3_RT(x_.w, y_.w, bflo); acc[ai][bj][m][1][3] *= M3_RT(x_.w, y_.w, bfhi); } }
                asm volatile("s_waitcnt vmcnt(0)" ::: "memory");
            }
        }
        asm volatile("s_nop 15\n\ts_nop 15" ::: "memory");
        { const bf16_t* gp = g.G + (size_t)(cur.pm * 256 + r0) * NG + 2 * 2048 + cur.pn * 256 + c0l; unsigned char* m8 = g.MB8 + (size_t)(cur.pm * 256 + r0) * D + cur.pn * 256 + c0l;
#pragma unroll
          for (int ai = 0; ai < 2; ++ai) { u32x4 gc[4][2];
#pragma unroll
              for (int m = 0; m < 4; ++m)
#pragma unroll
                  for (int bj = 0; bj < 2; ++bj) gc[m][bj] = *(const u32x4*)(gp + (size_t)(ai * 128 + m * 16) * NG + bj * 128);
#pragma unroll
              for (int m = 0; m < 4; ++m)
#pragma unroll
                  for (int bj = 0; bj < 2; ++bj) { const u32x4 z_ = gc[m][bj]; const f32x4 v0 = acc[ai][bj][m][0], v1 = acc[ai][bj][m][1];
                      u32x2 w8; const float f_ = g.fin;
                      w8.x = pk4_fp8(clamp8(v0[0] * fmaxf(bflo(z_.x), 1e-6f) * f_), clamp8(v0[1] * fmaxf(bfhi(z_.x), 1e-6f) * f_), clamp8(v0[2] * fmaxf(bflo(z_.y), 1e-6f) * f_), clamp8(v0[3] * fmaxf(bfhi(z_.y), 1e-6f) * f_));
                      w8.y = pk4_fp8(clamp8(v1[0] * fmaxf(bflo(z_.z), 1e-6f) * f_), clamp8(v1[1] * fmaxf(bfhi(z_.z), 1e-6f) * f_), clamp8(v1[2] * fmaxf(bflo(z_.w), 1e-6f) * f_), clamp8(v1[3] * fmaxf(bfhi(z_.w), 1e-6f) * f_));
                      *(u32x2*)(m8 + (size_t)(ai * 128 + m * 16) * D + bj * 128) = w8; } } }
        if (!has_next) break;
#pragma unroll
        for (int a = 0; a < 2; ++a)
#pragma unroll
            for (int b = 0; b < 2; ++b)
#pragma unroll
                for (int m = 0; m < 4; ++m)
#pragma unroll
                    for (int n = 0; n < 2; ++n) acc[a][b][m][n] = (f32x4){0.f, 0.f, 0.f, 0.f};
        cur = nxt; ++ui;
    }
    PG8_WAIT_V(0);
    if (wr == 0) PG8_BAR;
    PG8_BAR;
#undef M3_RT
#undef M3_TA
#undef M3_TB
#undef PG8_SA
#undef PG8_SB
#undef PG8_STAGE
#undef PG8_LDA
#undef PG8_LDB
#undef PG8_MMA
#undef PG8_WAIT_V
#undef PG8_WAIT_L
#undef PG8_BAR
#undef PG8_SCHED
}
}
struct EpiOut {
    static constexpr bool PERM = false, FP8 = true;
    const float* src_lat; const float* src_ctx; float* dst_lat; float* dst_ctx; const float* g1; float inv;
    __device__ __forceinline__ void operator()(const Acc& acc, const pg8::Unit& u, int wr, int wc, int fr, int fq) const {
        const int row0 = u.pm * 256 + wr * 64 + fr; const int col0 = u.pn * 256 + wc * 32 + 4 * fq;
        const bool lat = (u.pm * 256) < NLAT;
        const float* src = (lat ? src_lat : src_ctx - (size_t)NLAT * D) + (size_t)row0 * D + col0; float* dst = (lat ? dst_lat : dst_ctx - (size_t)NLAT * D) + (size_t)row0 * D + col0;
#pragma unroll
        for (int ai = 0; ai < 2; ++ai) { const int rbase = u.pm * 256 + ai * 128 + wr * 64; const int v = lat ? (rbase >> 12) : 4; const float* gp = g1 + (size_t)v * 12288 + col0;
            f32x4 gg[2][2];
#pragma unroll
            for (int bj = 0; bj < 2; ++bj)
#pragma unroll
                for (int n = 0; n < 2; ++n) gg[bj][n] = *(const f32x4*)(gp + bj * 128 + n * 16);
#pragma unroll
            for (int mh = 0; mh < 2; ++mh) {
                f32x4 xr[2][2][2];
#pragma unroll
                for (int mm = 0; mm < 2; ++mm)
#pragma unroll
                    for (int bj = 0; bj < 2; ++bj)
#pragma unroll
                        for (int n = 0; n < 2; ++n) xr[mm][bj][n] = __builtin_nontemporal_load((const f32x4*)(src + (size_t)(ai * 128 + (mh * 2 + mm) * 16) * D + bj * 128 + n * 16));
#pragma unroll
                for (int mm = 0; mm < 2; ++mm)
#pragma unroll
                    for (int bj = 0; bj < 2; ++bj)
#pragma unroll
                        for (int n = 0; n < 2; ++n) { const int m = mh * 2 + mm;
                            *(f32x4*)(dst + (size_t)(ai * 128 + m * 16) * D + bj * 128 + n * 16) = ABL_MIX ? xr[mm][bj][n] * ALPHA : xr[mm][bj][n] * ALPHA + gg[bj][n] * (acc[ai][bj][m][n] * inv); } } }
    }
};

struct Args { const float* in[27]; float* out; unsigned char* ws; int ph_lo, ph_hi; };
typedef const Args __attribute__((address_space(4)))* ArgP;
struct Frame {
    LAS unsigned char* lds; int tid, lane, wave, G, bid;
    ArgP ap; float* out; unsigned char* ws;
    __device__ __forceinline__ const float* in(int i) const { return ap->in[i]; }
};
__device__ __forceinline__ Frame make_frame(ArgP ap) {
    { unsigned long long t = (unsigned long long)ap; asm volatile("" : "+s"(t)); ap = (ArgP)t; }
    extern __shared__ __attribute__((aligned(16))) unsigned char lds_raw[];
    Frame F; F.lds = (LAS unsigned char*)lds_raw; { int t_ = threadIdx.x; asm volatile("" : "+v"(t_)); F.tid = t_; }
    F.lane = F.tid & 63; F.wave = __builtin_amdgcn_readfirstlane(F.tid >> 6); F.G = gridDim.x; F.bid = blockIdx.x;
    F.ap = ap; F.out = ap->out; F.ws = ap->ws; return F;
}
template <class T> __device__ __forceinline__ T* wsp(const Frame& F, size_t off) { return (T*)(F.ws + off); }

__device__ __forceinline__ int win_col(int n) {
    if (n < 768) return n;
    if (n < 1792) return 2336 + (n - 768);
    if (n < 2048) return 3360 + (n - 1792);
    if (n < 2304) return 3616 + (n - 2048);
    if (n < 2560) return 800 + (n - 2304);
    if (n < 2816) return 1056 + (n - 2560);
    if (n < 3328) return 1312 + (n - 2816);
    if (n < 3840) return 1824 + (n - 3328);
    if (n < 3872) return 768 + (n - 3840);
    if (n < 4096) return -1;
    return 3872 + (n - 4096);
}
__device__ __forceinline__ int qup_col(int c) {
    const int hh = c / 96, j = c - hh * 96;
    if (j < 64) return c;
    const int jj = j - 64, g8 = jj >> 3, i = jj & 7, p = i >> 1, which = i & 1, part = g8 >> 1, pi = (g8 & 1) * 4 + p;
    return hh * 96 + 64 + part * 16 + which * 8 + pi;
}
template <int MAP>
__device__ __forceinline__ void transpose_cvt(const Frame& F, const float* __restrict__ src, bf16_t* __restrict__ dst, int K, int Nsrc, int Nd) {
    LAS float* tile = (LAS float*)F.lds;
    const int tk = K / 256, tn = Nd / 64, ntile = tk * tn;
    for (int t = F.bid; t < ntile; t += F.G) {
        const int k0 = (t % tk) * 256, n0 = (t / tk) * 64;
        const int nl = F.tid & 63, kq = F.tid >> 6;
        const int nd = n0 + nl; const int ns = MAP == 0 ? nd : (MAP == 1 ? win_col(nd) : qup_col(nd));
        float v[32];
#pragma unroll
        for (int i = 0; i < 32; ++i) v[i] = ns >= 0 ? src[(size_t)(k0 + kq + 8 * i) * Nsrc + ns] : 0.f;
#pragma unroll
        for (int i = 0; i < 32; ++i) tile[(kq + 8 * i) * 65 + nl] = v[i];
        __syncthreads();
        { const int n = F.tid >> 3, k32 = (F.tid & 7) * 32;
#pragma unroll
          for (int c = 0; c < 4; ++c) { float w[8];
#pragma unroll
              for (int j = 0; j < 8; ++j) w[j] = tile[(k32 + c * 8 + j) * 65 + n];
              u32x4 o; o.x = cvt_pk_bf16(w[0], w[1]); o.y = cvt_pk_bf16(w[2], w[3]); o.z = cvt_pk_bf16(w[4], w[5]); o.w = cvt_pk_bf16(w[6], w[7]);
              *(u32x4*)(dst + (size_t)(n0 + n) * K + k0 + k32 + c * 8) = o; } }
        __syncthreads();
    }
}
__device__ __forceinline__ void cvt_rows(const Frame& F, const float* __restrict__ src, bf16_t* __restrict__ dst, size_t n8) {
    for (size_t i = (size_t)F.bid * 512 + F.tid; i < n8; i += (size_t)F.G * 512) {
        const f32x4 a = __builtin_nontemporal_load((const f32x4*)(src + i * 8)), b = __builtin_nontemporal_load((const f32x4*)(src + i * 8 + 4));
        *(u32x4*)(dst + i * 8) = pack8(a, b);
    }
}
__device__ __forceinline__ void cvt_peer(const Frame& F, int l);
__device__ __forceinline__ float max4abs(float am, const f32x4 a) { return fmaxf(fmaxf(fmaxf(am, fabsf(a[0])), fabsf(a[1])), fmaxf(fabsf(a[2]), fabsf(a[3]))); }
__device__ __forceinline__ void absmax_commit(const Frame& F, float am, unsigned* dst) {
    am = row16_max(am);
    { auto r = __builtin_amdgcn_permlane16_swap(__float_as_uint(am), __float_as_uint(am), false, false); am = fmaxf(__uint_as_float(r[0]), __uint_as_float(r[1])); }
    { auto r = __builtin_amdgcn_permlane32_swap(__float_as_uint(am), __float_as_uint(am), false, false); am = fmaxf(__uint_as_float(r[0]), __uint_as_float(r[1])); }
    if (F.lane == 0) atomicMax(dst, __float_as_uint(am));
}
template <int NB>
__device__ __forceinline__ void absmax_f32(const Frame& F, const float* __restrict__ src, size_t n4, unsigned* dst) {
    float am = 0.f;
    const size_t stride = (size_t)F.G * 512; size_t i = (size_t)F.bid * 512 + F.tid;
    for (; i < n4; i += NB * stride) { f32x4 a[NB];
#pragma unroll
        for (int j = 0; j < NB; ++j) { const size_t ix = i + j * stride; a[j] = ix < n4 ? __builtin_nontemporal_load((const f32x4*)(src + ix * 4)) : (f32x4){0.f, 0.f, 0.f, 0.f}; }
#pragma unroll
        for (int j = 0; j < NB; ++j) am = max4abs(am, a[j]); }
    absmax_commit(F, am, dst);
}
__device__ __forceinline__ void absmax4_f32(const Frame& F, const float* s0, size_t n0, unsigned* d0, const float* s1, size_t n1, unsigned* d1, const float* s2, size_t n2, unsigned* d2, const float* s3, size_t n3, unsigned* d3) {
    const size_t stride = (size_t)F.G * 512, i0 = (size_t)F.bid * 512 + F.tid;
    f32x4 a0[2], a1[2], a2[4], a3[8];
#define AM4_LD(a, NB, s, n) _Pragma("unroll") for (int j = 0; j < NB; ++j) { const size_t ix = i0 + j * stride; a[j] = ix < n ? __builtin_nontemporal_load((const f32x4*)(s + ix * 4)) : (f32x4){0.f, 0.f, 0.f, 0.f}; }
    AM4_LD(a0, 2, s0, n0) AM4_LD(a1, 2, s1, n1) AM4_LD(a2, 4, s2, n2) AM4_LD(a3, 8, s3, n3)
#undef AM4_LD
#define AM4_RED(a, NB, s, n, d) { float am = 0.f; _Pragma("unroll") for (int j = 0; j < NB; ++j) am = max4abs(am, a[j]); \
        for (size_t i = i0 + NB * stride; i < n; i += stride) am = max4abs(am, *(const f32x4*)(s + i * 4)); absmax_commit(F, am, d); }
    AM4_RED(a0, 2, s0, n0, d0) AM4_RED(a1, 2, s1, n1, d1) AM4_RED(a2, 4, s2, n2, d2) AM4_RED(a3, 8, s3, n3, d3)
#undef AM4_RED
}
template <int MAP>
__device__ __forceinline__ void transpose_fp8(const Frame& F, const float* __restrict__ src, unsigned char* __restrict__ dst, int K, int Nsrc, int Nd, const unsigned* wsc) {
    float mul, inv; fp8_scale(__hip_atomic_load(wsc, __ATOMIC_RELAXED, __HIP_MEMORY_SCOPE_AGENT), mul, inv);
    LAS float* tile = (LAS float*)F.lds;
    const int tk = K / 256, tn = Nd / 64, ntile = tk * tn;
    for (int t = F.bid; t < ntile; t += F.G) {
        const int k0 = (t % tk) * 256, n0 = (t / tk) * 64;
        const int nl = F.tid & 63, kq = F.tid >> 6; const int ns = MAP ? win_col(n0 + nl) : n0 + nl;
        float v[32];
#pragma unroll
        for (int i = 0; i < 32; ++i) v[i] = ns >= 0 ? src[(size_t)(k0 + kq + 8 * i) * Nsrc + ns] : 0.f;
#pragma unroll
        for (int i = 0; i < 32; ++i) tile[(kq + 8 * i) * 65 + nl] = v[i] * mul;
        __syncthreads();
        { const int n = F.tid >> 3, k32 = (F.tid & 7) * 32;
#pragma unroll
          for (int c = 0; c < 2; ++c) { float w[16];
#pragma unroll
              for (int j = 0; j < 16; ++j) w[j] = tile[(k32 + c * 16 + j) * 65 + n];
              u32x4 o; o.x = pk4_fp8(w[0], w[1], w[2], w[3]); o.y = pk4_fp8(w[4], w[5], w[6], w[7]); o.z = pk4_fp8(w[8], w[9], w[10], w[11]); o.w = pk4_fp8(w[12], w[13], w[14], w[15]);
              *(u32x4*)(dst + (size_t)(n0 + n) * K + k0 + k32 + c * 16) = o; } }
        __syncthreads();
    }
}
template <int PART = 7>
__device__ __forceinline__ void p0_prologue(const Frame& F) {
    { const int gi = F.bid * 512 + F.tid;
      if (gi < 64 * 8) { const int pos = gi >> 3, f = gi & 7; const float inv = powf(10000.f, -(float)f / 8.f); const float a = (float)pos * inv; wsp<f32x2>(F, WS_ROPE32)[gi] = (f32x2){cosf(a), sinf(a)}; }
      else if (gi < 64 * 8 + 64 * 32) { const int g2 = gi - 512; const int pos = g2 >> 5, f = g2 & 31; const float inv = powf(10000.f, -(float)f / 32.f); const float a = (float)pos * inv; wsp<f32x2>(F, WS_ROPE128)[g2] = (f32x2){cosf(a), sinf(a)}; } }
    if (F.bid == 0 && F.tid < 32) wsp<float>(F, WS_DEC)[F.tid] = -log1pf(expf(-F.in(11)[F.tid])) * LOG2E;
#pragma unroll 1
    for (int s3 = 0; s3 < 3; ++s3) { const int part = (s3 + F.bid) % 3;
    if ((PART & 1) && part == 0) { LAS float* sl = (LAS float*)F.lds;
      float* modp = wsp<float>(F, WS_MODP);
      for (int u = F.bid; u < 2 * 24 * 16; u += F.G) {
          const int kc = u & 15, cb = (u >> 4) % 24, l = u / (16 * 24);
          __syncthreads();
          for (int i = F.tid; i < 640; i += 512) { const int v = i >> 7, k = kc * 128 + (i & 127); const float c = v < 4 ? F.in(1)[v * 2048 + k] : F.in(3)[k]; sl[i] = silu_f(c); }
          __syncthreads();
          const int col = cb * 512 + F.tid; const float* w = F.in(4) + ((size_t)l * 2048 + kc * 128) * 12288 + col;
          float a0 = 0.f, a1 = 0.f, a2 = 0.f, a3 = 0.f, a4 = 0.f;
#pragma unroll 32
          for (int k = 0; k < 128; ++k) { const float wv = w[(size_t)k * 12288]; a0 += sl[k] * wv; a1 += sl[128 + k] * wv; a2 += sl[256 + k] * wv; a3 += sl[384 + k] * wv; a4 += sl[512 + k] * wv; }
          float* o = modp + ((size_t)(kc * 2 + l) * 5) * 12288 + col;
          o[0] = a0; o[12288] = a1; o[2 * 12288] = a2; o[3 * 12288] = a3; o[4 * 12288] = a4;
      }
      __syncthreads(); }
    if ((PART & 2) && part == 1) for (int l = 0; l < 2; ++l) {
        absmax_f32<16>(F, F.in(6) + (size_t)l * 2048 * NIN, (size_t)2048 * NIN / 4, wsp<unsigned>(F, WS_WSC) + l);
        absmax4_f32(F, F.in(14) + (size_t)l * 512 * 2048, (size_t)512 * 2048 / 4, wsp<unsigned>(F, WS_WSC) + 4 + l, F.in(15) + (size_t)l * 512 * 2048, (size_t)512 * 2048 / 4, wsp<unsigned>(F, WS_WSC) + 6 + l,
                    F.in(16) + (size_t)l * 1024 * 2048, (size_t)1024 * 2048 / 4, wsp<unsigned>(F, WS_WSC) + 8 + l, F.in(17) + (size_t)l * 2048 * 2048, (size_t)2048 * 2048 / 4, wsp<unsigned>(F, WS_WSC) + 2 + l);
        transpose_cvt<2>(F, F.in(8) + (size_t)l * 512 * 768, wsp<bf16_t>(F, WS_WQUP + l * SZ_WQUP), 512, 768, 768);
        transpose_cvt<0>(F, F.in(10) + (size_t)l * 256 * 1024, wsp<bf16_t>(F, WS_WKVUP + l * SZ_WKVUP), 256, 1024, 1024);
        transpose_cvt<0>(F, F.in(20) + (size_t)l * 2048 * 1024, wsp<bf16_t>(F, WS_WPQ + l * SZ_WPQ), 2048, 1024, 1024);
    }
    if ((PART & 4) && part == 2) cvt_peer(F, 0);
    }
}
__device__ __forceinline__ void p1_modreduce(const Frame& F) {
    const float* modp = wsp<float>(F, WS_MODP); float* mod = wsp<float>(F, WS_MOD);
    for (int i = F.bid * 512 + F.tid; i < 2 * 5 * 12288; i += F.G * 512) {
        const int j = i % 12288, l = i / (5 * 12288);
        float s = F.in(5)[l * 12288 + j];
#pragma unroll
        for (int kc = 0; kc < 16; ++kc) s += modp[(size_t)kc * (2 * 5 * 12288) + i];
        mod[i] = s;
    }
    for (int l = 0; l < 2; ++l) {
        transpose_fp8<1>(F, F.in(6) + (size_t)l * 2048 * NIN, wsp<unsigned char>(F, WS_WIN + l * SZ_WIN), 2048, NIN, NPT, wsp<unsigned>(F, WS_WSC) + l);
        transpose_fp8<0>(F, F.in(17) + (size_t)l * 2048 * 2048, wsp<unsigned char>(F, WS_WOUT + l * SZ_WOUT), 2048, 2048, 2048, wsp<unsigned>(F, WS_WSC) + 2 + l);
        transpose_fp8<0>(F, F.in(14) + (size_t)l * 512 * 2048, wsp<unsigned char>(F, WS_WBRA + l * SZ_WBRA), 512, 2048, 2048, wsp<unsigned>(F, WS_WSC) + 4 + l);
        transpose_fp8<0>(F, F.in(15) + (size_t)l * 512 * 2048, wsp<unsigned char>(F, WS_WBRB + l * SZ_WBRB), 512, 2048, 2048, wsp<unsigned>(F, WS_WSC) + 6 + l);
        transpose_fp8<0>(F, F.in(16) + (size_t)l * 1024 * 2048, wsp<unsigned char>(F, WS_WBRC + l * SZ_WBRC), 1024, 2048, 2048, wsp<unsigned>(F, WS_WSC) + 8 + l);
    }
}
__device__ __forceinline__ void ld_row_f32(const float* p, int lane, float (&x)[32]) {
#pragma unroll
    for (int q = 0; q < 4; ++q) { const f32x4 a = *(const f32x4*)(p + 512 * q + 8 * lane), b = *(const f32x4*)(p + 512 * q + 8 * lane + 4);
        x[q * 8 + 0] = a[0]; x[q * 8 + 1] = a[1]; x[q * 8 + 2] = a[2]; x[q * 8 + 3] = a[3]; x[q * 8 + 4] = b[0]; x[q * 8 + 5] = b[1]; x[q * 8 + 6] = b[2]; x[q * 8 + 7] = b[3]; }
}
__device__ __forceinline__ void st_row_f32(float* p, int lane, const float (&x)[32]) {
#pragma unroll
    for (int q = 0; q < 4; ++q) { *(f32x4*)(p + 512 * q + 8 * lane) = (f32x4){x[q * 8 + 0], x[q * 8 + 1], x[q * 8 + 2], x[q * 8 + 3]}; *(f32x4*)(p + 512 * q + 8 * lane + 4) = (f32x4){x[q * 8 + 4], x[q * 8 + 5], x[q * 8 + 6], x[q * 8 + 7]}; }
}
__device__ __forceinline__ void st_row_bf16(bf16_t* p, int lane, const float (&x)[32]) {
#pragma unroll
    for (int q = 0; q < 4; ++q) { u32x4 w; w.x = cvt_pk_bf16(x[q * 8 + 0], x[q * 8 + 1]); w.y = cvt_pk_bf16(x[q * 8 + 2], x[q * 8 + 3]); w.z = cvt_pk_bf16(x[q * 8 + 4], x[q * 8 + 5]); w.w = cvt_pk_bf16(x[q * 8 + 6], x[q * 8 + 7]);
        *(u32x4*)(p + 512 * q + 8 * lane) = w; }
}
__device__ __forceinline__ void p_modulate0(const Frame& F) {
    const float* mod = wsp<float>(F, WS_MOD); unsigned char* hb8 = wsp<unsigned char>(F, WS_HB8);
    for (int row = F.bid * 8 + F.wave; row < NROW; row += F.G * 8) {
        const RowInfo ri = rowinfo(row);
        const float* xp = ri.lat ? F.in(0) + (size_t)row * D : F.in(2) + (size_t)(row - NLAT) * D;
        const float* mp = mod + (size_t)ri.v * 12288;
        float x[32], sh[32], sc[32];
        ld_row_f32(xp, F.lane, x); ld_row_f32(mp, F.lane, sh); ld_row_f32(mp + 2048, F.lane, sc);
#pragma unroll
        for (int i = 0; i < 32; ++i) x[i] = clamp8(x[i] * (1.f + sc[i]) + sh[i]);
#pragma unroll
        for (int q = 0; q < 4; ++q) { u32x2 w; w.x = pk4_fp8(x[q * 8 + 0], x[q * 8 + 1], x[q * 8 + 2], x[q * 8 + 3]); w.y = pk4_fp8(x[q * 8 + 4], x[q * 8 + 5], x[q * 8 + 6], x[q * 8 + 7]); *(u32x2*)(hb8 + (size_t)row * D + 512 * q + 8 * F.lane) = w; }
    }
}
__device__ __forceinline__ void p_post(const Frame& F, int l) {
    const bf16_t* P1 = wsp<bf16_t>(F, WS_P1);
    bf16_t* CQN = wsp<bf16_t>(F, WS_CQN); bf16_t* CKVN = wsp<bf16_t>(F, WS_CKVN);
    unsigned char* QG = wsp<unsigned char>(F, WS_QG); unsigned char* KG = wsp<unsigned char>(F, WS_KG); unsigned char* VG = wsp<unsigned char>(F, WS_VG);
    bf16_t* RQ = wsp<bf16_t>(F, WS_RQ); bf16_t* RK = wsp<bf16_t>(F, WS_RK); bf16_t* RV = wsp<bf16_t>(F, WS_RV);
    unsigned char* KM = wsp<unsigned char>(F, WS_KM); unsigned char* QM = wsp<unsigned char>(F, WS_QM);
    const f32x2* cs32 = wsp<f32x2>(F, WS_ROPE32); const f32x2* cs128 = wsp<f32x2>(F, WS_ROPE128);
    const float* gq_n = F.in(7) + l * 512; const float* gkv_n = F.in(9) + l * 256; const float* gqa_qn = F.in(12) + l * 128; const float* gqa_kn = F.in(13) + l * 128;
    LAS bf16_t* rs = (LAS bf16_t*)(F.lds + F.wave * 8192);
    const int lane = F.lane;
    const f32x4 gq0 = *(const f32x4*)(gq_n + lane * 8), gq1 = *(const f32x4*)(gq_n + lane * 8 + 4), gkv0 = *(const f32x4*)(gkv_n + lane * 4);
    const int gd0 = 2 * lane; const int gpart = gd0 >> 6, gdd = gd0 & 63; const bool glo = gdd < 32; const int gf = glo ? gdd : gdd - 32; const int gdp = glo ? gd0 + 32 : gd0 - 32;
    const float qn0 = gqa_qn[gd0], qn1 = gqa_qn[gd0 + 1], qnp0 = gqa_qn[gdp], qnp1 = gqa_qn[gdp + 1];
    const float kn0 = gqa_kn[gd0], kn1 = gqa_kn[gd0 + 1], knp0 = gqa_kn[gdp], knp1 = gqa_kn[gdp + 1];
    const int rhh = lane >> 3, rd0 = (lane & 7) * 4; const int rpart = rd0 >> 4, rdd = rd0 & 15; const bool rlo = rdd < 8; const int rf = rlo ? rdd : rdd - 8; const int rdp = rlo ? rd0 + 8 : rd0 - 8;
    const int step = F.G * 8;
    int row = F.bid * 8 + F.wave;
    u32x4 pre[8];
    if (row < NROW) {
#pragma unroll
        for (int q = 0; q < 8; ++q) pre[q] = *(const u32x4*)(P1 + (size_t)row * NP1 + q * 512 + lane * 8); }
#pragma unroll 1
    for (; row < NROW; row += step) {
        const RowInfo ri = rowinfo(row);
        const int posg = gpart ? ri.pc : ri.pr, posr = rpart ? ri.pc : ri.pr;
        const f32x2 one = {1.f, 0.f};
        const f32x2 csA = ri.lat ? cs128[posg * 32 + gf] : one, csB = ri.lat ? cs128[posg * 32 + gf + 1] : one;
        f32x2 cs[4];
#pragma unroll
        for (int i = 0; i < 4; ++i) cs[i] = ri.lat ? cs32[posr * 8 + rf + i] : one;
#pragma unroll
        for (int q = 0; q < 8; ++q) *(LAS u32x4*)(rs + q * 512 + lane * 8) = pre[q];
        { const int nrow = row + step; if (nrow < NROW) {
#pragma unroll
            for (int q = 0; q < 8; ++q) pre[q] = *(const u32x4*)(P1 + (size_t)nrow * NP1 + q * 512 + lane * 8); } }
        asm volatile("s_waitcnt lgkmcnt(0)" ::: "memory");
        { float x[8]; float ss = 0.f;
#pragma unroll
          for (int i = 0; i < 8; ++i) { x[i] = bf2f(rs[C_CQ + lane * 8 + i]); ss += x[i] * x[i]; }
          ss = wave_sum(ss); const float r = rsqrtf(ss * (1.f / 512.f) + RMS_EPS);
          *(u32x4*)(CQN + (size_t)row * 512 + lane * 8) = pack8((f32x4){x[0] * r * gq0[0], x[1] * r * gq0[1], x[2] * r * gq0[2], x[3] * r * gq0[3]}, (f32x4){x[4] * r * gq1[0], x[5] * r * gq1[1], x[6] * r * gq1[2], x[7] * r * gq1[3]}); }
        { float x[4]; float ss = 0.f;
#pragma unroll
          for (int i = 0; i < 4; ++i) { x[i] = bf2f(rs[C_CKV + lane * 4 + i]); ss += x[i] * x[i]; }
          ss = wave_sum(ss); const float r = rsqrtf(ss * (1.f / 256.f) + RMS_EPS);
          u32x2 w; w.x = cvt_pk_bf16(x[0] * r * gkv0[0], x[1] * r * gkv0[1]); w.y = cvt_pk_bf16(x[2] * r * gkv0[2], x[3] * r * gkv0[3]);
          *(u32x2*)(CKVN + (size_t)row * 256 + lane * 4) = w; }
        {
            const int d0 = gd0, dp = gdp; const bool lo = glo;
#pragma unroll 1
            for (int hh = 0; hh < 10; ++hh) {
                const bool isq = hh < 8; const int cbase = isq ? C_GQ + hh * 128 : C_GK + (hh - 8) * 128;
                const float g0 = isq ? qn0 : kn0, g1 = isq ? qn1 : kn1, gp0 = isq ? qnp0 : knp0, gp1 = isq ? qnp1 : knp1;
                const float a0 = bf2f(rs[cbase + d0]), a1 = bf2f(rs[cbase + d0 + 1]);
                float ss = wave_sum(a0 * a0 + a1 * a1); const float r = rsqrtf(ss * (1.f / 128.f) + RMS_EPS);
                const float n0 = a0 * r * g0, n1 = a1 * r * g1;
                const float p0 = bf2f(rs[cbase + dp]) * r * gp0, p1 = bf2f(rs[cbase + dp + 1]) * r * gp1;
                float o0, o1;
                if (lo) { o0 = n0 * csA.x - p0 * csA.y; o1 = n1 * csB.x - p1 * csB.y; }
                else    { o0 = p0 * csA.y + n0 * csA.x; o1 = p1 * csB.y + n1 * csB.x; }
                unsigned char* dst = isq ? QG + ((size_t)(ri.b * 8 + hh) * TT + ri.tpos) * 128 : KG + ((size_t)(ri.b * 2 + (hh - 8)) * TT + ri.tpos) * 128;
                const float sc8_ = isq ? QSC_G : KSC8;
                *(unsigned short*)(dst + d0) = (unsigned short)(pk4_fp8(clamp8(o0 * sc8_), clamp8(o1 * sc8_), 0.f, 0.f) & 0xffffu);
            }
#pragma unroll
            for (int hh = 0; hh < 2; ++hh) { const unsigned w8_ = pk4_fp8(clamp8(bf2f(rs[C_GV + hh * 128 + d0])), clamp8(bf2f(rs[C_GV + hh * 128 + d0 + 1])), 0.f, 0.f); unsigned char* vp_ = VG + ((size_t)(ri.b * 2 + hh) * 128 + d0) * TT + vt_off(ri.tpos);
                vp_[0] = (unsigned char)(w8_ & 0xffu); vp_[TT] = (unsigned char)((w8_ >> 8) & 0xffu); }
        }
        {
            const int hh = rhh, d0 = rd0, dp = rdp; const bool lo = rlo;
#pragma unroll
            for (int which = 0; which < 2; ++which) {
                const int cbase = (which ? C_RK : C_RQ) + hh * 32; const float sc = which ? 0.17677669529663687f : 1.f;
                float o[4];
#pragma unroll
                for (int i = 0; i < 4; ++i) { const float n = bf2f(rs[cbase + d0 + i]), p = bf2f(rs[cbase + dp + i]);
                    o[i] = (lo ? (n * cs[i].x - p * cs[i].y) : (p * cs[i].y + n * cs[i].x)) * sc; }
                u32x2 w; w.x = cvt_pk_bf16(o[0], o[1]); w.y = cvt_pk_bf16(o[2], o[3]);
                *(u32x2*)((which ? RK : RQ) + ((size_t)(ri.b * 8 + hh) * TT + ri.tpos) * 32 + d0) = w;
            }
            { const int vh = lane >> 3, e0 = (lane & 7) * 8;
              *(u32x4*)(RV + ((size_t)(ri.b * 8 + vh) * TT + ri.tpos) * 64 + e0) = *(LAS u32x4*)(rs + C_RV + lane * 8); }
            { float o[4];
#pragma unroll
              for (int i = 0; i < 4; ++i) { const float n = bf2f(rs[C_KR + d0 + i]), p = bf2f(rs[C_KR + dp + i]); o[i] = lo ? (n * cs[i].x - p * cs[i].y) : (p * cs[i].y + n * cs[i].x); }
              const size_t tok_ = ((size_t)(ri.b * 8 + hh) * TT + ri.tpos) * 128;
              *(unsigned*)(KM + tok_ + 64 + d0) = pk4_fp8(clamp8(o[0] * KSC8), clamp8(o[1] * KSC8), clamp8(o[2] * KSC8), clamp8(o[3] * KSC8));
              *(unsigned*)(KM + tok_ + 96 + d0) = 0u; *(unsigned*)(QM + tok_ + 96 + d0) = 0u; }
        }
        asm volatile("s_waitcnt lgkmcnt(0)" ::: "memory");
    }
}

__device__ __forceinline__ void ret_logs(const Frame& F, int l, int h, float& lgf, float& lgb) {
    const float* t = wsp<float>(F, WS_DEC); lgf = t[(l * 2 + 0) * 8 + h]; lgb = t[(l * 2 + 1) * 8 + h];
}
constexpr int TP = 136;
template <bool WITH_K>
__device__ __forceinline__ void ret_stage(const Frame& F, const bf16_t* RKh, const bf16_t* RVh, int tpos0, float lgf, float lgb, LAS bf16_t* vt, LAS bf16_t* ktf, LAS bf16_t* ktb) {
#pragma unroll
    for (int i = 0; i < 2; ++i) { const int tok = (F.tid >> 3) + 64 * i, e0 = (F.tid & 7) * 8;
        const u32x4 w = *(const u32x4*)(RVh + (size_t)(tpos0 + tok) * 64 + e0); const unsigned ww[4] = {w.x, w.y, w.z, w.w};
#pragma unroll
        for (int j = 0; j < 4; ++j) { vt[(e0 + 2 * j) * TP + tok] = (bf16_t)(ww[j] & 0xffffu); vt[(e0 + 2 * j + 1) * TP + tok] = (bf16_t)(ww[j] >> 16); } }
    if (WITH_K) { const int tok = F.tid >> 2, k0 = (F.tid & 3) * 8;
        const u32x4 w = *(const u32x4*)(RKh + (size_t)(tpos0 + tok) * 32 + k0); const unsigned ww[4] = {w.x, w.y, w.z, w.w};
        const float zf = exp2f(lgf * (float)(127 - tok)), zb = exp2f(lgb * (float)tok);
#pragma unroll
        for (int j = 0; j < 4; ++j) { const float a = bflo(ww[j]), b = bfhi(ww[j]);
            ktf[(k0 + 2 * j) * TP + tok] = f2bf(a * zf); ktf[(k0 + 2 * j + 1) * TP + tok] = f2bf(b * zf);
            ktb[(k0 + 2 * j) * TP + tok] = f2bf(a * zb); ktb[(k0 + 2 * j + 1) * TP + tok] = f2bf(b * zb); } }
}
__device__ __forceinline__ void p_ret_states(const Frame& F, int l) {
    LAS bf16_t* vt = (LAS bf16_t*)F.lds; LAS bf16_t* ktf = vt + 64 * TP; LAS bf16_t* ktb = ktf + 32 * TP;
    float* ST = wsp<float>(F, WS_ST);
    const int lane = F.lane, w = F.wave, kb = w >> 2, eb = w & 3, fr = lane & 15, fq = lane >> 4;
    for (int u = F.bid; u < NB * 8 * 34; u += F.G) {
        const int c = u % 34, bh = u / 34, h = bh & 7;
        float lgf, lgb; ret_logs(F, l, h, lgf, lgb);
        __syncthreads();
        ret_stage<true>(F, wsp<bf16_t>(F, WS_RK) + (size_t)bh * TT * 32, wsp<bf16_t>(F, WS_RV) + (size_t)bh * TT * 64, c * 128, lgf, lgb, vt, ktf, ktb);
        __syncthreads();
        f32x4 sf = {0.f, 0.f, 0.f, 0.f}, sb = {0.f, 0.f, 0.f, 0.f};
#pragma unroll
        for (int ks = 0; ks < 4; ++ks) {
            const bf16x8 bv = *(const LAS bf16x8*)(vt + (eb * 16 + fr) * TP + ks * 32 + fq * 8);
            const bf16x8 af = *(const LAS bf16x8*)(ktf + (kb * 16 + fr) * TP + ks * 32 + fq * 8);
            const bf16x8 ab = *(const LAS bf16x8*)(ktb + (kb * 16 + fr) * TP + ks * 32 + fq * 8);
            sf = __builtin_amdgcn_mfma_f32_16x16x32_bf16(af, bv, sf, 0, 0, 0);
            sb = __builtin_amdgcn_mfma_f32_16x16x32_bf16(ab, bv, sb, 0, 0, 0);
        }
        float* o = ST + (size_t)u * 2 * 2048;
#pragma unroll
        for (int r = 0; r < 4; ++r) { const int kd = kb * 16 + fq * 4 + r, e = eb * 16 + fr; o[kd * 64 + e] = sf[r]; o[2048 + kd * 64 + e] = sb[r]; }
    }
}
constexpr int RP = 40;
constexpr int AP = 136;
__device__ __forceinline__ void ret_out_unit(const Frame& F, int l, int bh, int c) {
    LAS bf16_t* vt = (LAS bf16_t*)F.lds; LAS bf16_t* rtf = vt + 64 * TP; LAS bf16_t* rtb = rtf + 64 * RP; LAS bf16_t* as = rtb + 64 * RP + F.wave * 16 * AP;
    const int lane = F.lane, w = F.wave, fr = lane & 15, fq = lane >> 4, h = bh & 7, b = bh >> 3;
    const bf16_t* RQh = wsp<bf16_t>(F, WS_RQ) + (size_t)bh * TT * 32; const bf16_t* RKh = wsp<bf16_t>(F, WS_RK) + (size_t)bh * TT * 32; const bf16_t* RVh = wsp<bf16_t>(F, WS_RV) + (size_t)bh * TT * 64;
    const float* STh = wsp<float>(F, WS_ST) + (size_t)bh * 34 * 2 * 2048;
    float lgf, lgb; ret_logs(F, l, h, lgf, lgb);
    const int tpos0 = c * 128;
    const int i0 = w * 16;
    const bf16x8 qa = *(const bf16x8*)(RQh + (size_t)(tpos0 + i0 + fr) * 32 + fq * 8);
    bf16x8 kfr[8];
#pragma unroll
    for (int nb = 0; nb < 8; ++nb) kfr[nb] = *(const bf16x8*)(RKh + (size_t)(tpos0 + nb * 16 + fr) * 32 + fq * 8);
    const bf16_t* P1 = wsp<bf16_t>(F, WS_P1); unsigned char* OAB = wsp<unsigned char>(F, WS_OAB);
    bf16_t gv[4][4];
#pragma unroll
    for (int r = 0; r < 4; ++r) { const int tp = tpos0 + i0 + fq * 4 + r; const size_t grow = tp >= CTXL ? (size_t)b * SEQ + (tp - CTXL) : (size_t)NLAT + b * CTXL + tp;
#pragma unroll
        for (int eb = 0; eb < 4; ++eb) gv[r][eb] = P1[grow * NP1 + C_RG + h * 64 + eb * 16 + fr]; }
    __syncthreads();
    ret_stage<false>(F, RKh, RVh, tpos0, lgf, lgb, vt, nullptr, nullptr);
    { const int kd = F.tid >> 4, e4 = (F.tid & 15) * 4; f32x4 rf = {0.f, 0.f, 0.f, 0.f}, rb = {0.f, 0.f, 0.f, 0.f};
      if (c >= 2) {
          const int p = c - 2;
          const float kff = 80.f / (-lgf * 128.f), kfb = 80.f / (-lgb * 128.f); const int kcf = kff < 64.f ? (int)kff + 1 : 64, kcb = kfb < 64.f ? (int)kfb + 1 : 64;
          const int nf = c < kcf ? c : kcf, nb_ = (33 - p) < kcb ? (33 - p) : kcb;
          const float* sf = STh + kd * 64 + e4;
          for (int k0 = 0; k0 < nf; k0 += 8) { f32x4 v[8];
#pragma unroll
              for (int j = 0; j < 8; ++j) { const int k = k0 + j; const int cp = k < nf ? c - 1 - k : 0; v[j] = *(const f32x4*)(sf + (size_t)(cp * 2 + 0) * 2048); }
#pragma unroll
              for (int j = 0; j < 8; ++j) { const int k = k0 + j; const float wgt = k < nf ? __builtin_amdgcn_exp2f(lgf * 128.f * (float)k) : 0.f; rf += v[j] * wgt; } }
          for (int k0 = 0; k0 < nb_; k0 += 8) { f32x4 v[8];
#pragma unroll
              for (int j = 0; j < 8; ++j) { const int k = k0 + j; const int pp = k < nb_ ? p + 1 + k : 33; const int cs = pp < 32 ? pp + 2 : pp - 32; v[j] = *(const f32x4*)(sf + (size_t)(cs * 2 + 1) * 2048); }
#pragma unroll
              for (int j = 0; j < 8; ++j) { const int k = k0 + j; const float wgt = k < nb_ ? __builtin_amdgcn_exp2f(lgb * 128.f * (float)k) : 0.f; rb += v[j] * wgt; } }
      } else if (c == 0) { rb = *(const f32x4*)(STh + (size_t)(1 * 2 + 1) * 2048 + kd * 64 + e4); }
      else { rf = *(const f32x4*)(STh + (size_t)(0 * 2 + 0) * 2048 + kd * 64 + e4); }
#pragma unroll
      for (int j = 0; j < 4; ++j) { rtf[(e4 + j) * RP + kd] = f2bf(rf[j]); rtb[(e4 + j) * RP + kd] = f2bf(rb[j]); } }
    f32x4 s[8];
#pragma unroll
    for (int nb = 0; nb < 8; ++nb) s[nb] = __builtin_amdgcn_mfma_f32_16x16x32_bf16(qa, kfr[nb], (f32x4){0.f, 0.f, 0.f, 0.f}, 0, 0, 0);
#pragma unroll
    for (int nb = 0; nb < 8; ++nb)
#pragma unroll
        for (int r = 0; r < 4; ++r) { const int i = i0 + fq * 4 + r, j = nb * 16 + fr; const int df = i - j;
            const float mk = df > 0 ? exp2f(lgf * (float)df) : (df < 0 ? exp2f(lgb * (float)(-df)) : 2.f);
            as[(fq * 4 + r) * AP + j] = f2bf(s[nb][r] * mk); }
    __syncthreads();
    f32x4 y[4];
#pragma unroll
    for (int eb = 0; eb < 4; ++eb) y[eb] = (f32x4){0.f, 0.f, 0.f, 0.f};
#pragma unroll
    for (int ks = 0; ks < 4; ++ks) { const bf16x8 af = *(const LAS bf16x8*)(as + fr * AP + ks * 32 + fq * 8);
#pragma unroll
        for (int eb = 0; eb < 4; ++eb) { const bf16x8 bv = *(const LAS bf16x8*)(vt + (eb * 16 + fr) * TP + ks * 32 + fq * 8);
            y[eb] = __builtin_amdgcn_mfma_f32_16x16x32_bf16(af, bv, y[eb], 0, 0, 0); } }
    { const float xf = exp2f(lgf * (float)(i0 + fr + 1)), xb = exp2f(lgb * (float)(128 - (i0 + fr)));
      bf16x8 qf, qb;
#pragma unroll
      for (int j = 0; j < 8; ++j) { const float qv = bf2f((bf16_t)qa[j]); qf[j] = (short)f2bf(qv * xf); qb[j] = (short)f2bf(qv * xb); }
#pragma unroll
      for (int eb = 0; eb < 4; ++eb) { const bf16x8 bf_ = *(const LAS bf16x8*)(rtf + (eb * 16 + fr) * RP + fq * 8), bb_ = *(const LAS bf16x8*)(rtb + (eb * 16 + fr) * RP + fq * 8);
          y[eb] = __builtin_amdgcn_mfma_f32_16x16x32_bf16(qf, bf_, y[eb], 0, 0, 0);
          y[eb] = __builtin_amdgcn_mfma_f32_16x16x32_bf16(qb, bb_, y[eb], 0, 0, 0); } }
#pragma unroll
    for (int r = 0; r < 4; ++r) {
        float sm = y[0][r] + y[1][r] + y[2][r] + y[3][r]; sm = row16_sum(sm); const float mu = sm * (1.f / 64.f);
        float vs = 0.f;
#pragma unroll
        for (int eb = 0; eb < 4; ++eb) { const float d = y[eb][r] - mu; vs += d * d; }
        vs = row16_sum(vs); const float rstd = rsqrtf(vs * (1.f / 64.f) + LN_EPS);
        const int i = i0 + fq * 4 + r; const int tp = tpos0 + i; const size_t grow = tp >= CTXL ? (size_t)b * SEQ + (tp - CTXL) : (size_t)NLAT + b * CTXL + tp;
#pragma unroll
        for (int eb = 0; eb < 4; ++eb) { const int e = eb * 16 + fr; const float g = bf2f(gv[r][eb]);
            OAB[grow * D + 512 + h * 64 + e] = (unsigned char)(pk4_fp8(clamp8(silu_f(g) * (y[eb][r] - mu) * rstd * 16.f), 0.f, 0.f, 0.f) & 0xffu); }
    }
}
namespace att {
constexpr int NW = 8, QBLK = 32, KVBLK = 64;
constexpr int SHM_K = KVBLK * 128, SHM_V = 128 * 64;
constexpr size_t SHM_ATTN = 4 * SHM_K + 3 * SHM_V + 2048;
constexpr float THR = 1.9f, PSH = 6.f, THR2 = THR * 1.4426950408889634f;
#define SBAR() __builtin_amdgcn_sched_barrier(0)
typedef int i32x8a __attribute__((ext_vector_type(8))); typedef int i32x4a __attribute__((ext_vector_type(4)));
template <int SC> struct Scale { static constexpr float S = SC == 0 ? 0.08838834764831845f : 0.10206207261596575f; static constexpr float C = S * 1.4426950408889634f; static constexpr float THRR = THR / S; };
#define KSWZ8(row, chunk) ((row) * 128 + ((((chunk) ^ (((row) >> 1) & 7))) << 4))
#define VSWZ8(col, chunk) ((col) * 64 + ((((chunk) ^ (((col) >> 2) & 3))) << 4))
#define MF8(A, B, C) mf8x<ABL>(A, B, C)
#define CAT8(lo, hi) __builtin_shufflevector(lo, hi, 0, 1, 2, 3, 4, 5, 6, 7)
#define LDS16(p) ((ABL & 8) ? __builtin_shufflevector(qr8[0], qr8[1], 0, 1, 10, 11) : *(const LAS i32x4a*)(p))
template <int A, int B, int ABL = 0> __device__ __forceinline__ void exp_rng(f32x16& p) {
#pragma unroll
  for (int r = A; r < B; ++r) p[r] = (ABL & 1) ? p[r] * p[r] : __builtin_amdgcn_exp2f(p[r]);
}
template <int ABL> __device__ __forceinline__ f32x16 mf8x(const i32x8a a, const i32x8a b, f32x16 c) {
  if constexpr (ABL & 2) { c[0] += __int_as_float(((a[0] ^ a[4]) + (b[0] ^ b[4])) & 0x3f000000); return c; }
  else return __builtin_amdgcn_mfma_scale_f32_32x32x64_f8f6f4(a, b, c, 0, 0, 0, 0x7F7F7F7F, 0, 0x7F7F7F7F);
}
__device__ __forceinline__ void pk_fma16(f32x16& p, float c, float d) { const f32x2 c2 = {c, c}, d2 = {d, d};
#pragma unroll
  for (int i = 0; i < 8; ++i) { f32x2 v = {p[2 * i], p[2 * i + 1]}; v = v * c2 + d2; p[2 * i] = v.x; p[2 * i + 1] = v.y; }
}
__device__ __forceinline__ void pk_add16(f32x16& p, float c) { const f32x2 c2 = {c, c};
#pragma unroll
  for (int i = 0; i < 8; ++i) { f32x2 v = {p[2 * i], p[2 * i + 1]}; v = v + c2; p[2 * i] = v.x; p[2 * i + 1] = v.y; }
}
__device__ __forceinline__ void pk_mul16(f32x16& p, float c) { const f32x2 c2 = {c, c};
#pragma unroll
  for (int i = 0; i < 8; ++i) { f32x2 v = {p[2 * i], p[2 * i + 1]}; v = v * c2; p[2 * i] = v.x; p[2 * i + 1] = v.y; }
}
__device__ __forceinline__ float pk_sum32(const f32x16& p0, const f32x16& p1) { f32x2 s0 = {p0[0], p0[1]}, s1 = {p1[0], p1[1]};
#pragma unroll
  for (int i = 1; i < 8; ++i) { s0 += (f32x2){p0[2 * i], p0[2 * i + 1]}; s1 += (f32x2){p1[2 * i], p1[2 * i + 1]}; }
  s0 += s1; return s0.x + s0.y;
}
__device__ __forceinline__ float hsum(float v) { auto rr = __builtin_amdgcn_permlane32_swap(__float_as_uint(v), __float_as_uint(v), false, false); return __uint_as_float(rr[0]) + __uint_as_float(rr[1]); }
__device__ __forceinline__ float hmax(float v) { auto rr = __builtin_amdgcn_permlane32_swap(__float_as_uint(v), __float_as_uint(v), false, false); return fmaxf(__uint_as_float(rr[0]), __uint_as_float(rr[1])); }
template <int NDV, int SC, int ABL>
__device__ __forceinline__ void attn_body(const unsigned char* __restrict__ Qb, const unsigned char* __restrict__ Kh, const unsigned char* __restrict__ Vt,
                                          unsigned char* __restrict__ Ob, int seq, LAS unsigned char* lds, const int tid) {
  constexpr int ldo = 2048;
  const int wid = __builtin_amdgcn_readfirstlane(tid >> 6), lane = tid & 63, r32 = lane & 31, hi = lane >> 5;
  LAS unsigned char* K_lds = lds; LAS unsigned char* V_lds = lds + 4 * SHM_K;
  constexpr bool LSUM = true, PF = (NDV == 2); constexpr int NO = NDV + (LSUM ? 1 : 0);
  float l_reg = 0; f32x16 o[NO] = {}; f32x16 negm; i32x8a qr8[2];
  LAS unsigned char* ones_lds = lds + 4 * SHM_K + 3 * SHM_V;
  i32x8a vones_r; { const int w1_ = r32 == 0 ? 0x38383838 : 0;
#pragma unroll
    for (int i = 0; i < 8; ++i) vones_r[i] = w1_; }
  if constexpr (NDV == 4) { if (tid < 128) *(LAS i32x4a*)(ones_lds + tid * 16) = (tid < 4) ? (i32x4a){0x38383838, 0x38383838, 0x38383838, 0x38383838} : (i32x4a){0, 0, 0, 0}; }
#define VONES() (NDV == 4 ? CAT8(LDS16(ones_lds + r32 * 64 + hi * 32), LDS16(ones_lds + r32 * 64 + hi * 32 + 16)) : vones_r)
  const unsigned char* Qw = Qb + (long)(wid * QBLK + r32) * 128 + hi * 32;
#pragma unroll
  for (int blk = 0; blk < 2; ++blk) { const i32x4a lo_ = *reinterpret_cast<const i32x4a*>(Qw + blk * 64), hi_ = *reinterpret_cast<const i32x4a*>(Qw + blk * 64 + 16); qr8[blk] = CAT8(lo_, hi_); }
  const int NT = seq / KVBLK;
  const int kr8 = 8 * wid + (lane >> 3), vcol = 16 * (wid & (NDV * 2 - 1)) + (lane >> 2);
  const unsigned char* kgp = Kh + (long)kr8 * 128 + (((lane & 7) ^ ((kr8 >> 1) & 7)) << 4);
  const unsigned char* vgp = Vt + (long)vcol * TT + (((lane & 3) ^ ((vcol >> 2) & 3)) << 4);
  const int kdo = wid * 1024, vdo = (wid & (NDV * 2 - 1)) * 1024;
  const int ka0 = KSWZ8(r32, 2 * hi), ka1 = KSWZ8(r32, 2 * hi + 1), va0 = VSWZ8(r32, 2 * hi), va1 = VSWZ8(r32, 2 * hi + 1);
#define DMAK(t, bo) do { const int t_ = (t) < NT ? (t) : NT - 1; __builtin_amdgcn_global_load_lds((const unsigned*)(kgp + (long)t_ * (KVBLK * 128)), (LAS unsigned*)(K_lds + (bo) + kdo), 16, 0, 0); } while (0)
#define DMAV(t, bo) do { const int t_ = (t) < NT ? (t) : NT - 1; __builtin_amdgcn_global_load_lds((const unsigned*)(vgp + t_ * KVBLK), (LAS unsigned*)(V_lds + (bo) + vdo), 16, 0, 0); } while (0)
#define VMW(n) asm volatile("s_waitcnt vmcnt(" #n ")" ::: "memory")
#define BAR() __builtin_amdgcn_s_barrier()
  f32x16 pA0, pA1, pB0, pB1; float alA, alB; i32x8a pa;
#define PSM2(p0, p1, al) do { float pm_ = fmaxf(p0[0], p1[0]);                                                                          \
    _Pragma("unroll") for (int r = 1; r < 16; ++r) pm_ = fmaxf(fmaxf(pm_, p0[r]), p1[r]);                                               \
    pm_ = hmax(pm_); al = 1.f;                                                                                                           \
    if (__builtin_expect(!__all(pm_ <= PSH + THR2), 0)) { const float d_ = fmaxf(pm_ - PSH, 0.f); al = __builtin_amdgcn_exp2f(-d_); pk_add16(p0, -d_); pk_add16(p1, -d_); pk_add16(negm, -d_); } } while (0)
#define PT3(x, y, z) asm volatile("" : "+v"(x), "+v"(y), "+v"(z))
#define PT4(x, y, z, w) asm volatile("" : "+v"(x), "+v"(y), "+v"(z), "+v"(w))
#define STEP(j, pc0, pc1, alc, pn0, pn1, aln) do { const LAS unsigned char* Kr_ = K_lds + kb_rd; const LAS unsigned char* Vs_ = V_lds + vb_rd;  \
    i32x8a kc_ = CAT8(LDS16(Kr_ + (ka0 ^ 64)), LDS16(Kr_ + (ka1 ^ 64))), kd_ = CAT8(LDS16(Kr_ + 4096 + (ka0 ^ 64)), LDS16(Kr_ + 4096 + (ka1 ^ 64))); \
    if constexpr (!PF) { kpa = CAT8(LDS16(Kr_ + ka0), LDS16(Kr_ + ka1)); kpb = CAT8(LDS16(Kr_ + 4096 + ka0), LDS16(Kr_ + 4096 + ka1)); }              \
    pn0 = MF8(kpa, qr8[0], negm); exp_rng<0, 6, ABL>(pc1); PT3(pn0, pc1, kpb);                                                     \
    pn1 = MF8(kpb, qr8[0], negm); exp_rng<6, 12, ABL>(pc1); PT3(pn1, pc1, kc_);                                                    \
    pn0 = MF8(kc_, qr8[1], pn0); exp_rng<12, 16, ABL>(pc1);                                                                              \
    if constexpr (!LSUM) { float ps_ = pk_sum32(pc0, pc1); ps_ = hsum(ps_); l_reg = l_reg * alc + ps_; }                                   \
    i32x8a va_ = CAT8(LDS16(Vs_ + va0), LDS16(Vs_ + va1)), vb_ = CAT8(LDS16(Vs_ + 2048 + va0), LDS16(Vs_ + 2048 + va1));                  \
    PT4(pn0, pc1, kd_, l_reg);                                                                                                           \
    pn1 = MF8(kd_, qr8[1], pn1);                                                                                                         \
    _Pragma("unroll") for (int q = 0; q < 4; ++q) { pa[q] = (int)pk4_fp8(pc0[4 * q], pc0[4 * q + 1], pc0[4 * q + 2], pc0[4 * q + 3]); pa[4 + q] = (int)pk4_fp8(pc1[4 * q], pc1[4 * q + 1], pc1[4 * q + 2], pc1[4 * q + 3]); } \
    PT3(pn1, pa, va_);                                                                                                                   \
    if constexpr (!(ABL & 128)) { DMAK((j) + 4, kb_wr); DMAV((j) + 2, vb_wr); }                                                          \
    o[0] = MF8(va_, pa, o[0]); PSM2(pn0, pn1, aln); PT3(o[0], pn0, vb_);                                                  \
    o[1] = MF8(vb_, pa, o[1]); exp_rng<0, 4, ABL>(pn0);                                   \
    if constexpr (NDV == 4) { i32x8a vc_ = CAT8(LDS16(Vs_ + 4096 + va0), LDS16(Vs_ + 4096 + va1)), vd_ = CAT8(LDS16(Vs_ + 6144 + va0), LDS16(Vs_ + 6144 + va1)); \
      PT4(o[1], pn0, pn1, vc_); o[2] = MF8(vc_, pa, o[2]); exp_rng<4, 10, ABL>(pn0); PT3(o[2], pn0, vd_);                                \
      o[3] = MF8(vd_, pa, o[3]); exp_rng<10, 14, ABL>(pn0); PT3(o[3], pn0, pn1); o[4] = MF8(VONES(), pa, o[4]); exp_rng<14, 16, ABL>(pn0); }      \
    else { PT3(o[1], pn0, pn1); o[2] = MF8(VONES(), pa, o[2]); exp_rng<4, 10, ABL>(pn0); PT3(o[2], pn0, pn1); exp_rng<10, 16, ABL>(pn0); }    \
    if constexpr (PF) { const LAS unsigned char* Kp_ = K_lds + kb_pf; kpa = CAT8(LDS16(Kp_ + ka0), LDS16(Kp_ + ka1)); kpb = CAT8(LDS16(Kp_ + 4096 + ka0), LDS16(Kp_ + 4096 + ka1)); } \
    PT3(o[NO - 1], pn0, pn1); RESC(aln);                                                                                               \
    { const int t_ = kb_rd; kb_rd = kb_pf; kb_pf = kb_x; kb_x = kb_wr; kb_wr = t_; const int u_ = vb_rd; vb_rd = vb_n1; vb_n1 = vb_wr; vb_wr = u_; } \
    VMW(2); if constexpr (!(ABL & 4)) BAR(); } while (0)
#define RESC(a) do { if (__any((a) < 1.f)) { _Pragma("unroll") for (int d = 0; d < NO; ++d) pk_mul16(o[d], (a)); } } while (0)
  i32x8a kpa, kpb; int kb_rd = SHM_K, kb_pf = 2 * SHM_K, kb_x = 3 * SHM_K, kb_wr = 0, vb_rd = 0, vb_n1 = SHM_V, vb_wr = 2 * SHM_V;
  DMAK(0, 0); DMAK(1, SHM_K); DMAK(2, 2 * SHM_K); DMAK(3, 3 * SHM_K); DMAV(0, 0); DMAV(1, SHM_V); VMW(0); BAR();
  { const LAS unsigned char* Ks_ = K_lds;
    pA0 = MF8(CAT8(LDS16(Ks_ + ka0), LDS16(Ks_ + ka1)), qr8[0], (f32x16){}); pA1 = MF8(CAT8(LDS16(Ks_ + 4096 + ka0), LDS16(Ks_ + 4096 + ka1)), qr8[0], (f32x16){});
    pA0 = MF8(CAT8(LDS16(Ks_ + (ka0 ^ 64)), LDS16(Ks_ + (ka1 ^ 64))), qr8[1], pA0); pA1 = MF8(CAT8(LDS16(Ks_ + 4096 + (ka0 ^ 64)), LDS16(Ks_ + 4096 + (ka1 ^ 64))), qr8[1], pA1);
    float pm_ = fmaxf(pA0[0], pA1[0]);
#pragma unroll
    for (int r = 1; r < 16; ++r) pm_ = fmaxf(fmaxf(pm_, pA0[r]), pA1[r]);
    pm_ = hmax(pm_);
    const float nv_ = PSH - pm_; pk_add16(pA0, nv_); pk_add16(pA1, nv_);
#pragma unroll
    for (int r = 0; r < 16; ++r) negm[r] = nv_;
    alA = 1.f; exp_rng<0, 16, ABL>(pA0);
    if constexpr (PF) { const LAS unsigned char* Kp_ = K_lds + SHM_K; kpa = CAT8(LDS16(Kp_ + ka0), LDS16(Kp_ + ka1)); kpb = CAT8(LDS16(Kp_ + 4096 + ka0), LDS16(Kp_ + 4096 + ka1)); } }
  asm volatile("s_waitcnt lgkmcnt(0)" ::: "memory"); BAR();
  int j = 0;
  for (; j + 2 < NT; j += 2) { STEP(j, pA0, pA1, alA, pB0, pB1, alB); STEP(j + 1, pB0, pB1, alB, pA0, pA1, alA); }
  STEP(j, pA0, pA1, alA, pB0, pB1, alB);
  { exp_rng<0, 16, ABL>(pB1); if constexpr (!LSUM) { float ps_ = pk_sum32(pB0, pB1); ps_ = hsum(ps_); l_reg = l_reg * alB + ps_; }
#pragma unroll
    for (int q = 0; q < 4; ++q) { pa[q] = (int)pk4_fp8(pB0[4 * q], pB0[4 * q + 1], pB0[4 * q + 2], pB0[4 * q + 3]); pa[4 + q] = (int)pk4_fp8(pB1[4 * q], pB1[4 * q + 1], pB1[4 * q + 2], pB1[4 * q + 3]); }
    const LAS unsigned char* Vs_ = V_lds + vb_rd;
#pragma unroll
    for (int d0 = 0; d0 < NDV; ++d0) o[d0] = MF8(CAT8(LDS16(Vs_ + d0 * 2048 + va0), LDS16(Vs_ + d0 * 2048 + va1)), pa, o[d0]);
    if constexpr (LSUM) { o[NDV] = MF8(VONES(), pa, o[NDV]); l_reg = hsum(o[NDV][0]); } }
  const float rl = __builtin_amdgcn_rcpf(l_reg) * 16.f;
  unsigned char* Ow = Ob + (long)(wid * QBLK + r32) * ldo + 4 * hi;
#pragma unroll
  for (int d0 = 0; d0 < NDV; ++d0)
#pragma unroll
    for (int g = 0; g < 4; ++g) *(unsigned*)(Ow + d0 * 32 + 8 * g) = pk4_fp8(clamp8(o[d0][4 * g] * rl), clamp8(o[d0][4 * g + 1] * rl), clamp8(o[d0][4 * g + 2] * rl), clamp8(o[d0][4 * g + 3] * rl));
#undef DMAK
#undef DMAV
#undef VMW
#undef BAR
#undef PSM2
#undef VONES
#undef REGION_X
#undef REGION_Y
#undef RESC
#undef STEP
#undef PT3
#undef PT4
}
}
__device__ __forceinline__ float* xres_row(const Frame& F, int row) { return row < NLAT ? F.out + (size_t)row * D : wsp<float>(F, WS_XC) + (size_t)(row - NLAT) * D; }
__device__ __forceinline__ void ln_row(float (&y)[32], const float* g, const float* b, int lane) {
    float s = 0.f;
#pragma unroll
    for (int i = 0; i < 32; ++i) s += y[i];
    const float mu = wave_sum(s) * (1.f / 2048.f);
    float q = 0.f;
#pragma unroll
    for (int i = 0; i < 32; ++i) { const float d = y[i] - mu; q += d * d; }
    const float rstd = rsqrtf(wave_sum(q) * (1.f / 2048.f) + LN_EPS);
#pragma unroll
    for (int qq = 0; qq < 4; ++qq) { const f32x4 g0 = *(const f32x4*)(g + 512 * qq + 8 * lane), g1 = *(const f32x4*)(g + 512 * qq + 8 * lane + 4), b0 = *(const f32x4*)(b + 512 * qq + 8 * lane), b1 = *(const f32x4*)(b + 512 * qq + 8 * lane + 4);
#pragma unroll
        for (int i = 0; i < 4; ++i) { y[qq * 8 + i] = (y[qq * 8 + i] - mu) * rstd * g0[i] + b0[i]; y[qq * 8 + 4 + i] = (y[qq * 8 + 4 + i] - mu) * rstd * g1[i] + b1[i]; } }
}
__device__ __forceinline__ void modulate_store(const float (&x)[32], const float* sh, const float* sc, bf16_t* dst, int lane) {
#pragma unroll
    for (int q = 0; q < 4; ++q) { const f32x4 h0 = *(const f32x4*)(sh + 512 * q + 8 * lane), h1 = *(const f32x4*)(sh + 512 * q + 8 * lane + 4), c0 = *(const f32x4*)(sc + 512 * q + 8 * lane), c1 = *(const f32x4*)(sc + 512 * q + 8 * lane + 4);
        f32x4 a, b;
#pragma unroll
        for (int i = 0; i < 4; ++i) { a[i] = x[q * 8 + i] * (1.f + c0[i]) + h0[i]; b[i] = x[q * 8 + 4 + i] * (1.f + c1[i]) + h1[i]; }
        *(u32x4*)(dst + 512 * q + 8 * lane) = pack8(a, b); }
}
__device__ __forceinline__ void p_ln1(const Frame& F, int l, bool last) {
    const float* mod = wsp<float>(F, WS_MOD) + (size_t)l * 5 * 12288; bf16_t* hb = wsp<bf16_t>(F, WS_HB);
    const float* g = F.in(18) + l * D; const float* b = F.in(19) + l * D;
    const int nrows = last ? NLAT : NROW; const int lane = F.lane, step = F.G * 8;
    float gg[32], bb[32]; ld_row_f32(g, lane, gg); ld_row_f32(b, lane, bb);
    int row = F.bid * 8 + F.wave;
    float yn[32];
    if (row < nrows) ld_row_f32(xres_row(F, row), lane, yn);
#pragma unroll 1
    for (; row < nrows; row += step) {
        const int v = row < NLAT ? (row >> 12) : 4; float* xp = xres_row(F, row);
        float y[32], sh[32], sc[32];
#pragma unroll
        for (int i = 0; i < 32; ++i) y[i] = yn[i];
        ld_row_f32(mod + (size_t)v * 12288 + 6144, lane, sh); ld_row_f32(mod + (size_t)v * 12288 + 8192, lane, sc);
        { const int nrow = row + step; if (nrow < nrows) ld_row_f32(xres_row(F, nrow), lane, yn); }
        float s = 0.f;
#pragma unroll
        for (int i = 0; i < 32; ++i) s += y[i];
        const float mu = wave_sum(s) * (1.f / 2048.f); float q = 0.f;
#pragma unroll
        for (int i = 0; i < 32; ++i) { const float d = y[i] - mu; q += d * d; }
        const float rstd = rsqrtf(wave_sum(q) * (1.f / 2048.f) + LN_EPS);
#pragma unroll
        for (int i = 0; i < 32; ++i) y[i] = (y[i] - mu) * rstd * gg[i] + bb[i];
        st_row_f32(xp, lane, y);
#pragma unroll
        for (int i = 0; i < 32; ++i) y[i] = y[i] * (1.f + sc[i]) + sh[i];
        st_row_bf16(hb + (size_t)row * D, lane, y);
    }
}

template <int NV>
__device__ __forceinline__ void top16(const float (&val)[NV], bool (&sel)[NV], int (&slot)[NV]) {
    unsigned key[NV];
#pragma unroll
    for (int v = 0; v < NV; ++v) { const unsigned u = __float_as_uint(val[v]); key[v] = (u & 0x80000000u) ? ~u : (u | 0x80000000u); }
    unsigned T = 0u;
#pragma unroll 1
    for (int bit = 31; bit >= 0; --bit) {
        const unsigned cand = T | (1u << bit); int cnt = 0;
#pragma unroll
        for (int v = 0; v < NV; ++v) cnt += __popcll(__ballot(key[v] >= cand));
        if (cnt >= 16) T = cand;
    }
    int ngt = 0;
#pragma unroll
    for (int v = 0; v < NV; ++v) ngt += __popcll(__ballot(key[v] > T));
    const int need = 16 - ngt;
    int run = 0, erun = 0;
#pragma unroll
    for (int v = 0; v < NV; ++v) {
        const unsigned long long mg = __ballot(key[v] > T), me = __ballot(key[v] == T);
        const int pg = __builtin_amdgcn_mbcnt_hi((unsigned)(mg >> 32), __builtin_amdgcn_mbcnt_lo((unsigned)mg, 0u));
        const int pe = __builtin_amdgcn_mbcnt_hi((unsigned)(me >> 32), __builtin_amdgcn_mbcnt_lo((unsigned)me, 0u));
        sel[v] = false; slot[v] = 0;
        if (key[v] > T) { sel[v] = true; slot[v] = run + pg; }
        else if (key[v] == T && (erun + pe) < need) { sel[v] = true; slot[v] = ngt + erun + pe; }
        run += __popcll(mg); erun += __popcll(me);
    }
}
__device__ __forceinline__ unsigned f2key(float f) { const unsigned u = __float_as_uint(f); return (u & 0x80000000u) ? ~u : (u | 0x80000000u); }
__device__ __forceinline__ float key2f(unsigned k) { return __uint_as_float((k & 0x80000000u) ? (k & 0x7fffffffu) : ~k); }
template <int NP, int NV>
__device__ __forceinline__ void bisect16(const unsigned (&key)[NP][NV], unsigned (&T)[NP]) {
    bool done[NP];
#pragma unroll
    for (int p = 0; p < NP; ++p) { T[p] = 0u; done[p] = false; }
#pragma unroll 1
    for (int bit = 31; bit >= 0; --bit) {
        const unsigned bm = 1u << bit; bool all = true;
#pragma unroll
        for (int p = 0; p < NP; ++p) {
            const unsigned cand = T[p] | bm; int cnt = 0;
#pragma unroll
            for (int v = 0; v < NV; ++v) cnt += __popcll(__ballot(key[p][v] >= cand));
            const bool upd = (cnt >= 16) && !done[p];
            T[p] = upd ? cand : T[p]; done[p] = done[p] || (cnt == 16); all = all && done[p];
        }
        if (all) break;
    }
}
template <int NV>
__device__ __forceinline__ void compact16(const unsigned (&key)[NV], const unsigned T, bool (&sel)[NV], int (&slot)[NV]) {
    int ngt = 0;
#pragma unroll
    for (int v = 0; v < NV; ++v) ngt += __popcll(__ballot(key[v] > T));
    const int need = 16 - ngt; int run = 0, erun = 0;
#pragma unroll
    for (int v = 0; v < NV; ++v) {
        const unsigned long long mg = __ballot(key[v] > T), me = __ballot(key[v] == T);
        const int pg = __builtin_amdgcn_mbcnt_hi((unsigned)(mg >> 32), __builtin_amdgcn_mbcnt_lo((unsigned)mg, 0u));
        const int pe = __builtin_amdgcn_mbcnt_hi((unsigned)(me >> 32), __builtin_amdgcn_mbcnt_lo((unsigned)me, 0u));
        sel[v] = false; slot[v] = 0;
        if (key[v] > T) { sel[v] = true; slot[v] = run + pg; }
        else if (key[v] == T && (erun + pe) < need) { sel[v] = true; slot[v] = ngt + erun + pe; }
        run += __popcll(mg); erun += __popcll(me);
    }
}
constexpr int KP = 68;
constexpr int PW_BYTES = 9344;
__device__ __forceinline__ float gelu_erf(float x) {
    const float z = fabsf(x) * 0.7071067811865476f; const float t = __builtin_amdgcn_rcpf(1.f + 0.3275911f * z);
    float p = 1.061405429f; p = p * t - 1.453152027f; p = p * t + 1.421413741f; p = p * t - 0.284496736f; p = p * t + 0.254829592f; p = p * t;
    const float er = 1.f - p * __expf(-z * z);
    return 0.5f * x * (1.f + (x < 0.f ? -er : er));
}
__device__ __forceinline__ float wave_max(float x) {
    x = row16_max(x);
    { auto r = __builtin_amdgcn_permlane16_swap(__float_as_uint(x), __float_as_uint(x), false, false); x = fmaxf(__uint_as_float(r[0]), __uint_as_float(r[1])); }
    { auto r = __builtin_amdgcn_permlane32_swap(__float_as_uint(x), __float_as_uint(x), false, false); x = fmaxf(__uint_as_float(r[0]), __uint_as_float(r[1])); }
    return x;
}
__device__ __forceinline__ void ld16_f32(const float* p, int lane, float (&x)[32]) {
#pragma unroll
    for (int q = 0; q < 2; ++q)
#pragma unroll
        for (int d = 0; d < 4; ++d) { const f32x4 a = *(const f32x4*)(p + 1024 * q + 16 * lane + 4 * d); x[q * 16 + d * 4 + 0] = a[0]; x[q * 16 + d * 4 + 1] = a[1]; x[q * 16 + d * 4 + 2] = a[2]; x[q * 16 + d * 4 + 3] = a[3]; }
}
__device__ __forceinline__ void ld16_f32_nt(const float* p, int lane, float (&x)[32]) {
#pragma unroll
    for (int q = 0; q < 2; ++q)
#pragma unroll
        for (int d = 0; d < 4; ++d) { const f32x4 a = __builtin_nontemporal_load((const f32x4*)(p + 1024 * q + 16 * lane + 4 * d)); x[q * 16 + d * 4 + 0] = a[0]; x[q * 16 + d * 4 + 1] = a[1]; x[q * 16 + d * 4 + 2] = a[2]; x[q * 16 + d * 4 + 3] = a[3]; }
}
__device__ __forceinline__ void st16_f32_nt(float* p, int lane, const float (&x)[32]) {
#pragma unroll
    for (int q = 0; q < 2; ++q)
#pragma unroll
        for (int d = 0; d < 4; ++d) __builtin_nontemporal_store((f32x4){x[q * 16 + d * 4 + 0], x[q * 16 + d * 4 + 1], x[q * 16 + d * 4 + 2], x[q * 16 + d * 4 + 3]}, (f32x4*)(p + 1024 * q + 16 * lane + 4 * d));
}
__device__ __forceinline__ void st16_f32(float* p, int lane, const float (&x)[32]) {
#pragma unroll
    for (int q = 0; q < 2; ++q)
#pragma unroll
        for (int d = 0; d < 4; ++d) *(f32x4*)(p + 1024 * q + 16 * lane + 4 * d) = (f32x4){x[q * 16 + d * 4 + 0], x[q * 16 + d * 4 + 1], x[q * 16 + d * 4 + 2], x[q * 16 + d * 4 + 3]};
}
__device__ __forceinline__ void ld16_bf16(const bf16_t* p, int lane, float (&x)[32]) {
#pragma unroll
    for (int q = 0; q < 2; ++q)
#pragma unroll
        for (int d = 0; d < 2; ++d) { const u32x4 w = *(const u32x4*)(p + 1024 * q + 16 * lane + 8 * d); float* o = &x[q * 16 + d * 8];
            o[0] = bflo(w.x); o[1] = bfhi(w.x); o[2] = bflo(w.y); o[3] = bfhi(w.y); o[4] = bflo(w.z); o[5] = bfhi(w.z); o[6] = bflo(w.w); o[7] = bfhi(w.w); }
}
__device__ __forceinline__ void st16_bf16(bf16_t* p, int lane, const float (&x)[32]) {
#pragma unroll
    for (int q = 0; q < 2; ++q)
#pragma unroll
        for (int d = 0; d < 2; ++d) { const float* o = &x[q * 16 + d * 8]; u32x4 w; w.x = cvt_pk_bf16(o[0], o[1]); w.y = cvt_pk_bf16(o[2], o[3]); w.z = cvt_pk_bf16(o[4], o[5]); w.w = cvt_pk_bf16(o[6], o[7]);
            *(u32x4*)(p + 1024 * q + 16 * lane + 8 * d) = w; }
}
constexpr int TBS = 1152;
__device__ __forceinline__ void ld_row_f32(int lane, const float* __restrict__ src, f32x4* a) {
#pragma unroll
    for (int q = 0; q < 2; ++q)
#pragma unroll
        for (int d = 0; d < 4; ++d) a[q * 4 + d] = __builtin_nontemporal_load((const f32x4*)(src + 1024 * q + 16 * lane + 4 * d));
}
__device__ __forceinline__ void cvt_row_fp4b(int lane, const f32x4* a, unsigned char* __restrict__ dst) {
    float x[32];
#pragma unroll
    for (int i = 0; i < 8; ++i) { x[i * 4 + 0] = a[i][0]; x[i * 4 + 1] = a[i][1]; x[i * 4 + 2] = a[i][2]; x[i * 4 + 3] = a[i][3]; }
    float am = 0.f;
#pragma unroll
    for (int i = 0; i < 32; ++i) am = fmaxf(am, fabsf(x[i]));
    const bf16_t sb = f2bf(am * (1.f / 6.f)); const float sf = bf2f(sb); const float sc = sf > 0.f ? __builtin_amdgcn_rcpf(sf) : 0.f;
    u32x4 w;
#pragma unroll
    for (int d = 0; d < 4; ++d) { unsigned t = 0u; const int o = (d >> 1) * 16 + (d & 1) * 8;
        t = __builtin_amdgcn_cvt_scalef32_pk_fp4_f32(t, x[o + 0] * sc, x[o + 1] * sc, 1.0f, 0); t = __builtin_amdgcn_cvt_scalef32_pk_fp4_f32(t, x[o + 2] * sc, x[o + 3] * sc, 1.0f, 1);
        t = __builtin_amdgcn_cvt_scalef32_pk_fp4_f32(t, x[o + 4] * sc, x[o + 5] * sc, 1.0f, 2); t = __builtin_amdgcn_cvt_scalef32_pk_fp4_f32(t, x[o + 6] * sc, x[o + 7] * sc, 1.0f, 3); w[d] = t; }
    *(u32x4*)(dst + 16 * lane) = w;
    *(bf16_t*)(dst + 1024 + 2 * lane) = sb;
}
__device__ __forceinline__ void cvt_row_fp4r(int lane, const float* __restrict__ src, unsigned char* __restrict__ dst, float* __restrict__ inv) {
    float x[32];
#pragma unroll
    for (int q = 0; q < 2; ++q)
#pragma unroll
        for (int d = 0; d < 4; ++d) { const f32x4 a = __builtin_nontemporal_load((const f32x4*)(src + 1024 * q + 16 * lane + 4 * d)); x[q * 16 + d * 4 + 0] = a[0]; x[q * 16 + d * 4 + 1] = a[1]; x[q * 16 + d * 4 + 2] = a[2]; x[q * 16 + d * 4 + 3] = a[3]; }
    float am = 0.f;
#pragma unroll
    for (int i = 0; i < 32; ++i) am = fmaxf(am, fabsf(x[i]));
    am = wave_max(am);
    const float sc = am > 0.f ? 6.f / am : 1.f;
    if (lane == 0) *inv = am > 0.f ? am * (1.f / 6.f) : 1.f;
    u32x4 w;
#pragma unroll
    for (int d = 0; d < 4; ++d) { unsigned t = 0u; const int o = (d >> 1) * 16 + (d & 1) * 8;
        t = __builtin_amdgcn_cvt_scalef32_pk_fp4_f32(t, x[o + 0] * sc, x[o + 1] * sc, 1.0f, 0); t = __builtin_amdgcn_cvt_scalef32_pk_fp4_f32(t, x[o + 2] * sc, x[o + 3] * sc, 1.0f, 1);
        t = __builtin_amdgcn_cvt_scalef32_pk_fp4_f32(t, x[o + 4] * sc, x[o + 5] * sc, 1.0f, 2); t = __builtin_amdgcn_cvt_scalef32_pk_fp4_f32(t, x[o + 6] * sc, x[o + 7] * sc, 1.0f, 3); w[d] = t; }
    *(u32x4*)(dst + 16 * lane) = w;
}
__device__ __forceinline__ void cvt_peer(const Frame& F, int l) {
    const int step = F.G * 8; int r = F.bid * 8 + F.wave;
    f32x4 cur[8], nxt[8];
    auto srcp = [&](int rr) { return (rr < 16384 ? F.in(23) : F.in(24)) + ((size_t)l * 16384 + (rr & 16383)) * 2048; };
    if (r < 32768) ld_row_f32(F.lane, srcp(r), cur);
    for (; r < 32768; r += step) {
        const int rn = r + step;
        if (rn < 32768) ld_row_f32(F.lane, srcp(rn), nxt);
        cvt_row_fp4b(F.lane, cur, wsp<unsigned char>(F, r < 16384 ? WS_PU : WS_PV) + (size_t)l * SZ_PT + (size_t)(r & 16383) * TBS);
#pragma unroll
        for (int i = 0; i < 8; ++i) cur[i] = nxt[i];
    }
}
#define PEER_G 4
template <int CTRL> __device__ __forceinline__ int dppi(int x) { return __builtin_amdgcn_update_dpp(0, x, CTRL, 0xF, 0xF, true); }
__device__ __forceinline__ int irow16_sum(int x) { x += dppi<0xB1>(x); x += dppi<0x4E>(x); x += dppi<0x141>(x); x += dppi<0x140>(x); return x; }
__device__ __forceinline__ int irow16_incl_scan(int x) { x += dppi<0x111>(x); x += dppi<0x112>(x); x += dppi<0x114>(x); x += dppi<0x118>(x); return x; }
constexpr int KBP = 72;
constexpr int PT_WORDS = 6 * 128 + 160 + 3 * 128;
constexpr int PWB = 2 * PT_WORDS * 4;
__device__ __forceinline__ void p_peer(const Frame& F, int l, bool last) {
    LAS bf16_t* kb1 = (LAS bf16_t*)F.lds; LAS bf16_t* kb2 = kb1 + 128 * KBP;
    LAS unsigned* wbase = (LAS unsigned*)(F.lds + 2 * 128 * KBP * 2 + F.wave * PWB);
    const int lane = F.lane, fr = lane & 15, fq = lane >> 4;
    __syncthreads();
    for (int i = F.tid; i < 128 * 64; i += 512) { const int r = i >> 6, d = i & 63; kb1[r * KBP + d] = f2bf(F.in(21)[(size_t)l * 8192 + i]); kb2[r * KBP + d] = f2bf(F.in(22)[(size_t)l * 8192 + i]); }
    __syncthreads();
    const bf16_t* QP = wsp<bf16_t>(F, WS_QP); const bf16_t* HB = wsp<bf16_t>(F, WS_HB); unsigned char* HB8w = wsp<unsigned char>(F, WS_HB8);
    const unsigned char* PU = wsp<unsigned char>(F, WS_PU) + (size_t)l * SZ_PT; const unsigned char* PV = wsp<unsigned char>(F, WS_PV) + (size_t)l * SZ_PT;
    const float* modl = wsp<float>(F, WS_MOD) + (size_t)l * 5 * 12288; const float* modn = wsp<float>(F, WS_MOD) + (size_t)(l + 1) * 5 * 12288;
    const float* g2n = F.in(25) + l * D; const float* b2n = F.in(26) + l * D;
    const int npairs = (last ? NLAT : NROW) / 2;
    const int per_wg = (npairs + F.G - 1) / F.G; const int p_lo = F.bid * per_wg; const int p_hi = (p_lo + per_wg) < npairs ? (p_lo + per_wg) : npairs;
    LAS int* wq = (LAS int*)(F.lds + 147456 - 32);
    if (F.tid == 0) *wq = 0;
    __syncthreads();
#pragma unroll 1
    for (;;) {
        int pi = 0; if (lane == 0) pi = __hip_atomic_fetch_add(wq, 1, __ATOMIC_RELAXED, __HIP_MEMORY_SCOPE_WORKGROUP);
        pi = p_lo + __builtin_amdgcn_readfirstlane(pi); if (pi >= p_hi) break;
        const int rowA = 2 * pi;
#pragma unroll 1
        for (int rep1_ = 0; rep1_ <= REP_PS1; ++rep1_) {
            unsigned kk[2][8][4];
            { int fr_ = fr; asm volatile("" : "+v"(fr_));
              const bf16_t* qrow = QP + (size_t)(rowA + (fr_ >> 3)) * 1024 + (fr_ & 7) * 128 + 8 * fq;
              bf16x8 af[2][2];
#pragma unroll
              for (int st = 0; st < 2; ++st)
#pragma unroll
                  for (int ks = 0; ks < 2; ++ks) af[st][ks] = *(const bf16x8*)(qrow + st * 64 + ks * 32);
#pragma unroll
              for (int st = 0; st < 2; ++st) { LAS bf16_t* kb = st ? kb2 : kb1;
#pragma unroll
                  for (int nb = 0; nb < 8; ++nb) { f32x4 c = {0.f, 0.f, 0.f, 0.f};
#pragma unroll
                      for (int ks = 0; ks < 2; ++ks) { const bf16x8 bfr = *(const LAS bf16x8*)(kb + (nb * 16 + fr) * KBP + ks * 32 + 8 * fq); c = __builtin_amdgcn_mfma_f32_16x16x32_bf16(af[st][ks], bfr, c, 0, 0, 0); }
#pragma unroll
                      for (int r = 0; r < 4; ++r) kk[st][nb][r] = f2key(c[r]); } } }
            unsigned T[2][4]; bool done[2][4];
#pragma unroll
            for (int st = 0; st < 2; ++st)
#pragma unroll
                for (int r = 0; r < 4; ++r) { T[st][r] = 0u; done[st][r] = false; }
#pragma unroll 1
            for (int bit = 31; bit >= 0; --bit) { const unsigned bm = 1u << bit; bool alld = true;
#pragma unroll
                for (int st = 0; st < 2; ++st)
#pragma unroll
                    for (int r = 0; r < 4; ++r) { const unsigned cand = T[st][r] | bm; int c = 0;
#pragma unroll
                        for (int nb = 0; nb < 8; ++nb) c += (kk[st][nb][r] >= cand) ? 1 : 0;
                        c = irow16_sum(c);
                        const bool upd = (c >= 16) && !done[st][r]; T[st][r] = upd ? cand : T[st][r]; done[st][r] = done[st][r] || (c == 16); alld = alld && done[st][r]; }
                if (__all(alld)) break; }
            const int tt = lane >> 5, hd0 = ((lane >> 4) & 1) * 4;
#pragma unroll
            for (int st = 0; st < 2; ++st)
#pragma unroll
                for (int r = 0; r < 4; ++r) { const unsigned Tr = T[st][r]; int g = 0, e = 0;
#pragma unroll
                    for (int nb = 0; nb < 8; ++nb) { g += (kk[st][nb][r] > Tr) ? 1 : 0; e += (kk[st][nb][r] == Tr) ? 1 : 0; }
                    int gpre = irow16_incl_scan(g) - g, epre = irow16_incl_scan(e) - e; const int ngt = irow16_sum(g); const int need = 16 - ngt;
                    LAS unsigned* tb = wbase + tt * PT_WORDS; LAS float* vl = (LAS float*)(tb + st * 128) + (hd0 + r) * 16; LAS int* il = (LAS int*)(tb + 256 + st * 128) + (hd0 + r) * 16;
#pragma unroll
                    for (int nb = 0; nb < 8; ++nb) { const unsigned k = kk[st][nb][r];
                        if (k > Tr) { vl[gpre] = key2f(k); il[gpre] = nb * 16 + fr; ++gpre; }
                        else if (k == Tr) { if (epre < need) { vl[ngt + epre] = key2f(k); il[ngt + epre] = nb * 16 + fr; } ++epre; } } }
        }
        asm volatile("s_waitcnt lgkmcnt(0)" ::: "memory");
        {
            const int tt = lane >> 5, hd0 = ((lane >> 4) & 1) * 4; LAS unsigned* tb = wbase + tt * PT_WORDS;
            unsigned ck[4][16];
#pragma unroll
            for (int r = 0; r < 4; ++r) { const float va = ((LAS float*)tb)[(hd0 + r) * 16 + fr]; const LAS float* v2p = (LAS float*)(tb + 128) + (hd0 + r) * 16;
#pragma unroll
                for (int j4 = 0; j4 < 4; ++j4) { const f32x4 vb = *(const LAS f32x4*)(v2p + j4 * 4);
#pragma unroll
                    for (int i = 0; i < 4; ++i) ck[r][j4 * 4 + i] = f2key(va + vb[i]); } }
            unsigned T[4]; bool done[4];
#pragma unroll
            for (int r = 0; r < 4; ++r) { T[r] = 0u; done[r] = false; }
#pragma unroll 1
            for (int bit = 31; bit >= 0; --bit) { const unsigned bm = 1u << bit; bool alld = true;
#pragma unroll
                for (int r = 0; r < 4; ++r) { const unsigned cand = T[r] | bm; int c = 0;
#pragma unroll
                    for (int j = 0; j < 16; ++j) c += (ck[r][j] >= cand) ? 1 : 0;
                    c = irow16_sum(c);
                    const bool upd = (c >= 16) && !done[r]; T[r] = upd ? cand : T[r]; done[r] = done[r] || (c == 16); alld = alld && done[r]; }
                if (__all(alld)) break; }
#pragma unroll
            for (int r = 0; r < 4; ++r) { const unsigned Tr = T[r]; int g = 0, e = 0;
#pragma unroll
                for (int j = 0; j < 16; ++j) { g += (ck[r][j] > Tr) ? 1 : 0; e += (ck[r][j] == Tr) ? 1 : 0; }
                int gpre = irow16_incl_scan(g) - g, epre = irow16_incl_scan(e) - e; const int ngt = irow16_sum(g); const int need = 16 - ngt;
                const int e1 = ((LAS int*)(tb + 256))[(hd0 + r) * 16 + fr] * 128; const LAS int* i2p = (LAS int*)(tb + 384) + (hd0 + r) * 16;
                LAS float* cs_ = (LAS float*)(tb + 512) + (hd0 + r) * 16; LAS int* ce_ = (LAS int*)(tb + 640) + (hd0 + r) * 16;
#pragma unroll
                for (int j = 0; j < 16; ++j) { const unsigned k = ck[r][j];
                    if (k > Tr) { cs_[gpre] = key2f(k); ce_[gpre] = e1 + i2p[j]; ++gpre; }
                    else if (k == Tr) { if (epre < need) { cs_[ngt + epre] = key2f(k); ce_[ngt + epre] = e1 + i2p[j]; } ++epre; } } }
        }
        asm volatile("s_waitcnt lgkmcnt(0)" ::: "memory");
#pragma unroll 1
      for (int t = 0; t < 2; ++t) {
        const int row = rowA + t; const int v = row < NLAT ? (row >> 12) : 4;
        LAS unsigned* tb = wbase + t * PT_WORDS;
        LAS float* v1l = (LAS float*)tb; LAS float* v2l = v1l + 128; LAS int* i1l = (LAS int*)(v2l + 128); LAS int* i2l = i1l + 128;
        LAS float* csl = (LAS float*)(i2l + 128); LAS int* cel = (LAS int*)(csl + 128); LAS int* el = cel + 128; LAS float* gl = (LAS float*)(el + 160); LAS float* su = gl + 128; LAS float* sv = su + 128;
        {
#pragma unroll
            for (int it = 0; it < 2; ++it) { const int idx = it * 64 + lane;
                const float sx = csl[idx]; const float mx = row16_max(sx); const float pe_ = __expf(sx - mx); const float sm = row16_sum(pe_);
                el[idx] = cel[idx]; gl[idx] = pe_ / sm; }
        }
        if (lane < 32) el[128 + lane] = el[0];
        asm volatile("s_waitcnt vmcnt(0) lgkmcnt(0)" ::: "memory");
        const bool b0_ = lane & 1, b1_ = lane & 2, b2_ = lane & 4;
        u32x4 A[8], B[8], C[8]; unsigned SA[8], SB[8], SC[8];
#define PEER_LOADT(buf, sbuf, tab, g) do { _Pragma("unroll") for (int x = 0; x < 8; ++x) { const int e = __builtin_amdgcn_readfirstlane(el[(g) * 8 + x]); const unsigned char* rp = (tab) + (size_t)e * TBS; \
            buf[x] = *(const u32x4*)(rp + 16 * lane); sbuf[x] = *(const bf16_t*)(rp + 1024 + 2 * lane); } } while (0)
#define PEER_LOADV(buf, g) do { _Pragma("unroll") for (int x = 0; x < 8; ++x) { const int e = __builtin_amdgcn_readfirstlane(el[(g) * 8 + x]); buf[x] = *(const u32x4*)(PV + (size_t)e * 1024 + 16 * lane); } } while (0)
#define FP4X8(w_, f0_, f1_, f2_, f3_) const f32x2 f0_ = __builtin_amdgcn_cvt_scalef32_pk_f32_fp4(w_, 1.0f, 0), f1_ = __builtin_amdgcn_cvt_scalef32_pk_f32_fp4(w_, 1.0f, 1), f2_ = __builtin_amdgcn_cvt_scalef32_pk_f32_fp4(w_, 1.0f, 2), f3_ = __builtin_amdgcn_cvt_scalef32_pk_f32_fp4(w_, 1.0f, 3)
#define PEER_DOT(buf, sbuf, g) do { float p_[8]; \
            _Pragma("unroll") for (int x = 0; x < 8; ++x) { f32x2 s2_ = {0.f, 0.f}; \
                _Pragma("unroll") for (int d = 0; d < 4; ++d) { const unsigned w_ = buf[x][d]; FP4X8(w_, f0_, f1_, f2_, f3_); const int o_ = (d >> 1) * 8 + (d & 1) * 4; \
                    s2_ = hh2[o_ + 0] * f0_ + s2_; s2_ = hh2[o_ + 1] * f1_ + s2_; s2_ = hh2[o_ + 2] * f2_ + s2_; s2_ = hh2[o_ + 3] * f3_ + s2_; } \
                p_[x] = (s2_.x + s2_.y) * __uint_as_float(sbuf[x] << 16); SBAR(); } \
              \
            float q_[4], r_[2]; \
            _Pragma("unroll") for (int j = 0; j < 4; ++j) { const float keep_ = b0_ ? p_[2 * j + 1] : p_[2 * j], send_ = b0_ ? p_[2 * j] : p_[2 * j + 1]; q_[j] = keep_ + dppf<0xB1>(send_); } \
            _Pragma("unroll") for (int j = 0; j < 2; ++j) { const float keep_ = b1_ ? q_[2 * j + 1] : q_[2 * j], send_ = b1_ ? q_[2 * j] : q_[2 * j + 1]; r_[j] = keep_ + dppf<0x4E>(send_); } \
            float t_; { const float keep_ = b2_ ? r_[1] : r_[0], send_ = b2_ ? r_[0] : r_[1]; const float up_ = dppf<0x104>(send_), dn_ = dppf<0x114>(send_); t_ = keep_ + (b2_ ? dn_ : up_); } \
            t_ += dppf<0x128>(t_); \
            { auto r16_ = __builtin_amdgcn_permlane16_swap(__float_as_uint(t_), __float_as_uint(t_), false, false); t_ = __uint_as_float(r16_[0]) + __uint_as_float(r16_[1]); } \
            { auto r32_ = __builtin_amdgcn_permlane32_swap(__float_as_uint(t_), __float_as_uint(t_), false, false); t_ = __uint_as_float(r32_[0]) + __uint_as_float(r32_[1]); } \
            const float av = gelu_erf(t_) * gl[(g) * 8 + (lane & 7)]; const bool me_ = (lane >> 3) == ((g) & 7); \
            avl = (me_ && (g) < 8) ? av : avl; avh = (me_ && (g) >= 8) ? av : avh; } while (0)
#define PIN_ACC() do { asm volatile("" : "+v"(acc2[0]), "+v"(acc2[1]), "+v"(acc2[2]), "+v"(acc2[3]), "+v"(acc2[4]), "+v"(acc2[5]), "+v"(acc2[6]), "+v"(acc2[7]), "+v"(acc2[8]), "+v"(acc2[9]), "+v"(acc2[10]), "+v"(acc2[11]), "+v"(acc2[12]), "+v"(acc2[13]), "+v"(acc2[14]), "+v"(acc2[15])); } while (0)
#define PEER_AXPY(buf, sbuf, g) do { _Pragma("unroll") for (int x = 0; x < 8; ++x) { const int idx = (g) * 8 + x; \
            const float av = __uint_as_float(__builtin_amdgcn_readlane(__float_as_uint(idx < 64 ? avl : avh), idx & 63)) * __uint_as_float(sbuf[x] << 16); const f32x2 av2_ = {av, av}; \
            _Pragma("unroll") for (int d = 0; d < 4; ++d) { const unsigned w_ = buf[x][d]; FP4X8(w_, f0_, f1_, f2_, f3_); const int o_ = (d >> 1) * 8 + (d & 1) * 4; \
                acc2[o_ + 0] = av2_ * f0_ + acc2[o_ + 0]; acc2[o_ + 1] = av2_ * f1_ + acc2[o_ + 1]; acc2[o_ + 2] = av2_ * f2_ + acc2[o_ + 2]; acc2[o_ + 3] = av2_ * f3_ + acc2[o_ + 3]; } PIN_ACC(); } } while (0)
        float avl = 0.f, avh = 0.f;
        PEER_LOADT(A, SA, PU, 0); PEER_LOADT(B, SB, PU, 1); SBAR();
        float hh[32]; ld16_bf16(HB + (size_t)row * D, lane, hh);
        f32x2 hh2[16];
#pragma unroll
        for (int i = 0; i < 16; ++i) hh2[i] = (f32x2){hh[2 * i], hh[2 * i + 1]};
#pragma unroll 1
        for (int g = 0; g < 15; g += 3) { PEER_LOADT(C, SC, PU, g + 2); SBAR(); PEER_DOT(A, SA, g); SBAR(); PEER_LOADT(A, SA, PU, g + 3); SBAR(); PEER_DOT(B, SB, g + 1); SBAR();
            PEER_LOADT(B, SB, (g + 4 < 16 ? PU : PV), (g + 4) & 15); SBAR(); PEER_DOT(C, SC, g + 2); SBAR(); }
        PEER_LOADT(C, SC, PV, 1); SBAR();
        PEER_DOT(A, SA, 15); SBAR();
        f32x2 acc2[16];
#pragma unroll
        for (int i = 0; i < 16; ++i) acc2[i] = (f32x2){0.f, 0.f};
        float* xp = xres_row(F, row);
#pragma unroll 1
        for (int g = 0; g < 15; g += 3) { PEER_LOADT(A, SA, PV, g + 2); SBAR(); PEER_AXPY(B, SB, g); SBAR(); PEER_LOADT(B, SB, PV, g + 3); SBAR(); PEER_AXPY(C, SC, g + 1); SBAR(); PEER_LOADT(C, SC, PV, g + 4); SBAR(); PEER_AXPY(A, SA, g + 2); SBAR(); }
        float x1[32], g2[32]; ld16_f32(xp, lane, x1); ld16_f32(modl + (size_t)v * 12288 + 10240, lane, g2); SBAR();
        PEER_AXPY(B, SB, 15); SBAR();
#undef PEER_LOADT
#undef PEER_LOADV
#undef PEER_DOT
#undef PEER_AXPY
        float acc[32];
        {
#pragma unroll
          for (int i = 0; i < 32; ++i) acc[i] = ALPHA * x1[i] + g2[i] * acc2[i >> 1][i & 1]; }
        { float sm = 0.f;
#pragma unroll
          for (int i = 0; i < 32; ++i) sm += acc[i];
          const float mu = wave_sum(sm) * (1.f / 2048.f); float qq = 0.f;
#pragma unroll
          for (int i = 0; i < 32; ++i) { const float dd = acc[i] - mu; qq += dd * dd; }
          const float rstd = rsqrtf(wave_sum(qq) * (1.f / 2048.f) + LN_EPS);
#pragma unroll
          for (int q = 0; q < 2; ++q)
#pragma unroll
              for (int d = 0; d < 4; ++d) { const int o = 1024 * q + 16 * lane + 4 * d; const f32x4 gg = *(const f32x4*)(g2n + o), bb = *(const f32x4*)(b2n + o);
#pragma unroll
                  for (int i = 0; i < 4; ++i) acc[q * 16 + d * 4 + i] = (acc[q * 16 + d * 4 + i] - mu) * rstd * gg[i] + bb[i]; } }
        st16_f32(xp, lane, acc);
        if (!last) { const float* sh = modn + (size_t)v * 12288; const float* sc = sh + 2048;
#pragma unroll
            for (int q = 0; q < 2; ++q)
#pragma unroll
                for (int d = 0; d < 4; ++d) { const int o = 1024 * q + 16 * lane + 4 * d; const f32x4 hh4 = *(const f32x4*)(sh + o), cc4 = *(const f32x4*)(sc + o);
#pragma unroll
                    for (int i = 0; i < 4; ++i) acc[q * 16 + d * 4 + i] = clamp8(acc[q * 16 + d * 4 + i] * (1.f + cc4[i]) + hh4[i]); }
#pragma unroll
            for (int q = 0; q < 2; ++q) { u32x4 w;
#pragma unroll
                for (int d = 0; d < 4; ++d) w[d] = pk4_fp8(acc[q * 16 + d * 4 + 0], acc[q * 16 + d * 4 + 1], acc[q * 16 + d * 4 + 2], acc[q * 16 + d * 4 + 3]);
                *(u32x4*)(HB8w + (size_t)row * D + 1024 * q + 16 * lane) = w; } }
      }
    }
}
#ifdef DBG
constexpr size_t WS_DBG = WS_CTL + 131072;
constexpr int DBG_NS = 60;
__device__ __forceinline__ int dbg_row(int s) { return (s * 263 + 5) % NLAT; }
__global__ void __launch_bounds__(256) dbg_peer_pre(Args args, int l) {
    __shared__ float q[1024]; __shared__ float s1[128], s2[128]; __shared__ float v1[16], v2[16]; __shared__ int i1[16], i2[16]; __shared__ float cs[256]; __shared__ int ce[256];
    __shared__ float ts[16]; __shared__ int te[16]; __shared__ float red[256]; __shared__ float aval[128]; __shared__ int eid[128]; __shared__ float h2[2048];
    const int s = blockIdx.x, row = dbg_row(s), tid = threadIdx.x; unsigned char* ws = args.ws;
    const bf16_t* QP = (const bf16_t*)(ws + WS_QP); const bf16_t* HB = (const bf16_t*)(ws + WS_HB);
    float* dbgf = (float*)(ws + WS_DBG + 4096); int* dbge = (int*)(dbgf + DBG_NS * 2048); float* dbga = (float*)(dbge + DBG_NS * 128); float* dbgg = dbga + 3 * DBG_NS * 128;
    for (int i = tid; i < 1024; i += 256) q[i] = bf2f(QP[(size_t)row * 1024 + i]);
    for (int i = tid; i < 2048; i += 256) h2[i] = bf2f(HB[(size_t)row * D + i]);
    __syncthreads();
    const float* k1 = args.in[21] + (size_t)l * 8192; const float* k2 = args.in[22] + (size_t)l * 8192;
    for (int hd = 0; hd < 8; ++hd) {
        { const int k = tid & 127; const float* kk = (tid < 128 ? k1 : k2) + k * 64; const float* qq = q + hd * 128 + (tid < 128 ? 0 : 64); float a = 0.f; for (int d = 0; d < 64; ++d) a += qq[d] * kk[d]; (tid < 128 ? s1 : s2)[k] = a; }
        __syncthreads();
        { const int k = tid & 127; const float* sv = tid < 128 ? s1 : s2; const float me = sv[k]; int rank = 0; for (int j = 0; j < 128; ++j) rank += (sv[j] > me || (sv[j] == me && j < k)) ? 1 : 0;
          if (rank < 16) { (tid < 128 ? v1 : v2)[rank] = me; (tid < 128 ? i1 : i2)[rank] = k; } }
        __syncthreads();
        { const int i = tid >> 4, j = tid & 15; cs[tid] = v1[i] + v2[j]; ce[tid] = i1[i] * 128 + i2[j]; }
        __syncthreads();
        { const float me = cs[tid]; int rank = 0; for (int j = 0; j < 256; ++j) rank += (cs[j] > me || (cs[j] == me && j < tid)) ? 1 : 0; if (rank < 16) { ts[rank] = me; te[rank] = ce[tid]; } }
        __syncthreads();
        if (tid < 16) { float mx = ts[0]; float sm = 0.f; for (int j = 0; j < 16; ++j) sm += expf(ts[j] - mx); aval[hd * 16 + tid] = expf(ts[tid] - mx) / sm; eid[hd * 16 + tid] = te[tid]; dbgg[s * 128 + hd * 16 + tid] = aval[hd * 16 + tid]; }
        __syncthreads();
    }
    const float* U = args.in[23] + (size_t)l * 16384 * 2048; const float* V = args.in[24] + (size_t)l * 16384 * 2048;
    for (int e = 0; e < 128; ++e) { const float* ur = U + (size_t)eid[e] * 2048; float p = 0.f; for (int d = tid; d < 2048; d += 256) p += h2[d] * ur[d]; red[tid] = p; __syncthreads();
        for (int st = 128; st > 0; st >>= 1) { if (tid < st) red[tid] += red[tid + st]; __syncthreads(); }
        if (tid == 0) { const float sc = red[0]; aval[e] = 0.5f * sc * (1.f + erff(sc * 0.70710678f)) * aval[e]; } __syncthreads(); }
    float y[8]; const float* xr = args.out + (size_t)row * D; const int v = row >> 12; const float* mod = (const float*)(ws + WS_MOD) + (size_t)l * 5 * 12288 + (size_t)v * 12288;
    float sum = 0.f;
    for (int k = 0; k < 8; ++k) { const int d = tid + 256 * k; float o = 0.f; for (int e = 0; e < 128; ++e) o += aval[e] * V[(size_t)eid[e] * 2048 + d]; y[k] = ALPHA * xr[d] + mod[10240 + d] * o; sum += y[k]; }
    red[tid] = sum; __syncthreads(); for (int st = 128; st > 0; st >>= 1) { if (tid < st) red[tid] += red[tid + st]; __syncthreads(); } const float mu = red[0] / 2048.f; __syncthreads();
    float sq = 0.f; for (int k = 0; k < 8; ++k) sq += (y[k] - mu) * (y[k] - mu);
    red[tid] = sq; __syncthreads(); for (int st = 128; st > 0; st >>= 1) { if (tid < st) red[tid] += red[tid + st]; __syncthreads(); } const float rstd = rsqrtf(red[0] / 2048.f + LN_EPS);
    for (int k = 0; k < 8; ++k) { const int d = tid + 256 * k; dbgf[(size_t)s * 2048 + d] = (y[k] - mu) * rstd * args.in[25][l * D + d] + args.in[26][l * D + d]; }
    if (tid < 128) { dbge[s * 128 + tid] = eid[tid]; dbga[s * 128 + tid] = aval[tid]; }
}
__global__ void __launch_bounds__(256) dbg_peer_post(Args args) {
    __shared__ int bad_e, bad_x, bad_a, bad_g;
    const int s = blockIdx.x, row = dbg_row(s), tid = threadIdx.x; unsigned char* ws = args.ws; unsigned* cnt = (unsigned*)(ws + WS_DBG);
    float* dbgf = (float*)(ws + WS_DBG + 4096); int* dbge = (int*)(dbgf + DBG_NS * 2048); float* dbga = (float*)(dbge + DBG_NS * 128);
    int* fe = (int*)(dbga + DBG_NS * 128); float* fa = (float*)(fe + DBG_NS * 128); float* dbgg = dbga + 3 * DBG_NS * 128; float* fg = dbgg + DBG_NS * 128;
    if (tid == 0) { bad_e = 0; bad_x = 0; bad_a = 0; bad_g = 0; } __syncthreads();
    if (tid < 128) { const int hd = tid >> 4; const int e = dbge[s * 128 + tid]; bool found = false; float af = 0.f, gf = 0.f; for (int j = 0; j < 16; ++j) if (fe[s * 128 + hd * 16 + j] == e) { found = true; af = fa[s * 128 + hd * 16 + j]; gf = fg[s * 128 + hd * 16 + j]; }
        if (!found) atomicAdd(&bad_e, 1); else { const float ea = dbga[s * 128 + tid]; if (fabsf(af - ea) > 0.02f * fabsf(ea) + 2e-3f) atomicAdd(&bad_a, 1); const float eg = dbgg[s * 128 + tid]; if (fabsf(gf - eg) > 0.02f * fabsf(eg) + 1e-3f) atomicAdd(&bad_g, 1); } }
    for (int k = 0; k < 8; ++k) { const int d = tid + 256 * k; const float ex = dbgf[(size_t)s * 2048 + d], got = args.out[(size_t)row * D + d]; if (!(fabsf(got - ex) <= 0.03f + 0.03f * fabsf(ex))) atomicAdd(&bad_x, 1); }
    __syncthreads();
    if (tid == 0) { if (bad_e > 2) atomicAdd(&cnt[1], 1u); if (bad_g > 2) atomicAdd(&cnt[2], 1u); if (bad_a > 2) atomicAdd(&cnt[3], 1u); if (bad_x > 8) atomicAdd(&cnt[4], 1u); }
}
__global__ void dbg_report(Args args) {
    unsigned* cnt = (unsigned*)(args.ws + WS_DBG);
    float code = 0.f;
    for (int lv = 1; lv <= 9; ++lv) if (cnt[lv]) { int tenths = (int)(cnt[lv] * 10 / DBG_NS); if (tenths > 9) tenths = 9; code = 1000.f * lv + 100.f * tenths; break; }
    if (code != 0.f) for (int i = threadIdx.x; i < 4096; i += blockDim.x) args.out[i] = code;
}
#endif
template <int ABL>
__device__ __forceinline__ void p_attn_gqa(const Frame& F, int last) {
    LAS unsigned char* lds = F.lds;
    const unsigned char* QG = wsp<unsigned char>(F, WS_QG); const unsigned char* KG = wsp<unsigned char>(F, WS_KG); const unsigned char* VG = wsp<unsigned char>(F, WS_VG); unsigned char* OAB = wsp<unsigned char>(F, WS_OAB);
    const int nlat = NB * 8 * 16, nall = last ? nlat : nlat + NB * 8;
    for (int u = F.bid; u < nall; u += F.G) {
        int bh, q0, seq; size_t orow;
        if (u < nlat) {
            int uu = u;
            if (F.G == 256) {
                const int c = u & 255, i = u >> 8, xcd = c & 7, r = c >> 3, kvg = i * 4 + (xcd >> 1), within = (xcd & 1) * 32 + r;
                uu = (((kvg >> 1) * 8 + (kvg & 1) * 4 + (within >> 4)) << 4) | (within & 15); }
            bh = uu >> 4; const int qb = uu & 15; q0 = CTXL + qb * 256; seq = TT; orow = (size_t)(bh >> 3) * SEQ + qb * 256; }
        else { bh = u - nlat; q0 = 0; seq = CTXL; orow = (size_t)NLAT + (bh >> 3) * CTXL; }
        const int b = bh >> 3, h = bh & 7; const size_t kvo = (size_t)(b * 2 + (h >> 2)) * TT * 128;
        __syncthreads();
        att::attn_body<4, 0, ABL>(QG + ((size_t)bh * TT + q0) * 128, KG + kvo, VG + (size_t)(b * 2 + (h >> 2)) * 128 * TT, OAB + orow * D + 1024 + h * 128, seq, lds, F.tid);
    }
    __syncthreads();
}
template <int ABL>
__device__ __forceinline__ void p_attn_mla(const Frame& F, int last) {
    LAS unsigned char* lds = F.lds;
    const unsigned char* QM = wsp<unsigned char>(F, WS_QM); const unsigned char* KM = wsp<unsigned char>(F, WS_KM); const unsigned char* VM = wsp<unsigned char>(F, WS_VM); unsigned char* OAB = wsp<unsigned char>(F, WS_OAB);
    const int nlat = NB * 8 * 16, nall = last ? nlat : nlat + NB * 8;
    for (int u = F.bid; u < nall; u += F.G) {
        int bh, q0, seq; size_t orow;
        if (u < nlat) {
            int uu = u;
            if (F.G == 256) { const int c = u & 255, i = u >> 8, xcd = c & 7, r = c >> 3; uu = ((i * 16 + xcd * 2 + (r >> 4)) << 4) | (r & 15); }
            bh = uu >> 4; const int qb = uu & 15; q0 = CTXL + qb * 256; seq = TT; orow = (size_t)(bh >> 3) * SEQ + qb * 256; }
        else { bh = u - nlat; q0 = 0; seq = CTXL; orow = (size_t)NLAT + (bh >> 3) * CTXL; }
        const int h = bh & 7;
        __syncthreads();
        att::attn_body<2, 1, ABL>(QM + ((size_t)bh * TT + q0) * 128, KM + (size_t)bh * TT * 128, VM + (size_t)bh * 64 * TT, OAB + orow * D + h * 64, seq, lds, F.tid);
    }
    __syncthreads();
}
__device__ __forceinline__ void p_ret_out(const Frame& F, int l, int last) {
    const int c_lo = last ? 2 : 0, nc = 34 - c_lo, nu = NB * 8 * nc;
    for (int u = F.bid; u < nu; u += F.G) { const int bh = u / nc, c = c_lo + (u % nc); ret_out_unit(F, l, bh, c); }
    __syncthreads();
}

constexpr int LDS_BYTES = 147456;
constexpr int MISC_OFF = 147456 - 64;
constexpr int NPHASE = 22;
#ifndef PHM
#define PHM 0xFFFF
#endif
#ifndef PH_ATTR
#define PH_ATTR __forceinline__
#endif
template <int PART> __device__ PH_ATTR void ph_prologue(ArgP ap) { const Frame F = make_frame(ap); p0_prologue<PART>(F); }
__device__ PH_ATTR void ph_modreduce(ArgP ap) { const Frame F = make_frame(ap); p1_modreduce(F); }
__device__ PH_ATTR void ph_modulate0(ArgP ap) { const Frame F = make_frame(ap); p_modulate0(F); }
template <int GABL> __device__ PH_ATTR void ph_gemm_in(ArgP ap, int l) { const Frame F = make_frame(ap);
    pg8::Gemm g{wsp<bf16_t>(F, WS_HB8), wsp<bf16_t>(F, WS_WIN + l * SZ_WIN), NROW, NPT, 1024, 1024, 1024}; pg8::StaticOrder S; S.init(NROW, NPT, F.G, F.bid);
    float mul_, inv_; fp8_scale(wsp<unsigned>(F, WS_WSC)[l], mul_, inv_);
    EpiIn E{wsp<bf16_t>(F, WS_P1), wsp<bf16_t>(F, WS_G), inv_};
    pg8::gemm_phase<EpiIn, pg8::StaticOrder, GABL>(F.lds, F.tid, g, S, E); }
__device__ PH_ATTR void ph_post(ArgP ap, int l) { const Frame F = make_frame(ap); p_post(F, l); if (l == 1) cvt_peer(F, 1); }
__device__ PH_ATTR void ph_qup(ArgP ap, int l) { const Frame F = make_frame(ap);
    pg8::Gemm g{wsp<bf16_t>(F, WS_CQN), wsp<bf16_t>(F, WS_WQUP + l * SZ_WQUP), NROW, 768, 512, 512, 512}; pg8::StaticOrder S; S.init(NROW, 768, F.G, F.bid);
    EpiQup E{wsp<unsigned char>(F, WS_QM), wsp<f32x2>(F, WS_ROPE32)};
    pg8::gemm_phase<EpiQup, pg8::StaticOrder>(F.lds, F.tid, g, S, E); }
__device__ PH_ATTR void ph_kvup(ArgP ap, int l) { const Frame F = make_frame(ap);
    pg8::Gemm g{wsp<bf16_t>(F, WS_CKVN), wsp<bf16_t>(F, WS_WKVUP + l * SZ_WKVUP), NROW, 1024, 256, 256, 256}; pg8::StaticOrder S; S.init(NROW, 1024, F.G, F.bid);
    EpiKvup E{wsp<unsigned char>(F, WS_KM), wsp<unsigned char>(F, WS_VM)};
    pg8::gemm_phase<EpiKvup, pg8::StaticOrder>(F.lds, F.tid, g, S, E); }
__device__ PH_ATTR void ph_states(ArgP ap, int l) { const Frame F = make_frame(ap); p_ret_states(F, l); }
template <int ABL> __device__ PH_ATTR void ph_attn_gqa(ArgP ap, int last) { const Frame F = make_frame(ap); p_attn_gqa<ABL>(F, last); }
template <int ABL> __device__ PH_ATTR void ph_attn_mla(ArgP ap, int last) { const Frame F = make_frame(ap); p_attn_mla<ABL>(F, last); }
__device__ PH_ATTR void ph_ret_out(ArgP ap, int l, int last) { const Frame F = make_frame(ap); p_ret_out(F, l, last); }
template <int SEG> __device__ PH_ATTR void ph_merge(ArgP ap, int l, int Mx) { const Frame F = make_frame(ap);
    const bf16_t* OAB = wsp<bf16_t>(F, WS_OAB); bf16_t* MB = wsp<bf16_t>(F, WS_MB); const bf16_t* G = wsp<bf16_t>(F, WS_G);
    pg8::StaticOrder S; S.init(Mx, 2048, F.G, F.bid);
    const size_t wo = SEG == 0 ? WS_WBRA + l * SZ_WBRA : (SEG == 1 ? WS_WBRB + l * SZ_WBRB : WS_WBRC + l * SZ_WBRC); const int K = SEG == 2 ? 1024 : 512;
    pg8::Gemm g{OAB + SEG * 512, wsp<bf16_t>(F, wo), Mx, 2048, K, 2048, K}; EpiMerge<SEG> E{MB, G, wsp<unsigned char>(F, WS_MB8)}; pg8::gemm_phase<EpiMerge<SEG>, pg8::StaticOrder>(F.lds, F.tid, g, S, E); }
__device__ PH_ATTR void ph_merge3(ArgP ap, int l, int Mx) { const Frame F = make_frame(ap);
    pg8::StaticOrder S; S.init(Mx, 2048, F.G, F.bid);
    float m0_, i0_, m1_, i1_, m2_, i2_; fp8_scale(wsp<unsigned>(F, WS_WSC)[4 + l], m0_, i0_); fp8_scale(wsp<unsigned>(F, WS_WSC)[6 + l], m1_, i1_); fp8_scale(wsp<unsigned>(F, WS_WSC)[8 + l], m2_, i2_);
    pg8::Merge3 g{wsp<bf16_t>(F, WS_OAB), wsp<bf16_t>(F, WS_WBRA + l * SZ_WBRA), wsp<bf16_t>(F, WS_WBRB + l * SZ_WBRB), wsp<bf16_t>(F, WS_WBRC + l * SZ_WBRC), wsp<bf16_t>(F, WS_G), wsp<unsigned char>(F, WS_MB8), i0_ * m1_, i1_ * m2_, i2_};
    pg8::gemm_merge3<pg8::StaticOrder>(F.lds, F.tid, g, S); }
__device__ PH_ATTR void ph_out(ArgP ap, int l, int Mx) { const Frame F = make_frame(ap);
    pg8::Gemm g{wsp<bf16_t>(F, WS_MB8), wsp<bf16_t>(F, WS_WOUT + l * SZ_WOUT), Mx, 2048, 1024, 1024, 1024}; pg8::StaticOrder S; S.init(Mx, 2048, F.G, F.bid);
    float mul_, inv_; fp8_scale(wsp<unsigned>(F, WS_WSC)[2 + l], mul_, inv_);
    EpiOut E{l == 0 ? F.in(0) : F.out, l == 0 ? F.in(2) : wsp<float>(F, WS_XC), F.out, wsp<float>(F, WS_XC), wsp<float>(F, WS_MOD) + (size_t)l * 5 * 12288 + 4096, inv_ * (1.f / 16.f)};
    pg8::gemm_phase<EpiOut, pg8::StaticOrder>(F.lds, F.tid, g, S, E); }
__device__ PH_ATTR void ph_ln1(ArgP ap, int l, int last) { const Frame F = make_frame(ap); p_ln1(F, l, last); }
__device__ PH_ATTR void ph_peerq(ArgP ap, int l, int Mx) { const Frame F = make_frame(ap);
    pg8::Gemm g{wsp<bf16_t>(F, WS_HB), wsp<bf16_t>(F, WS_WPQ + l * SZ_WPQ), Mx, 1024, 2048, 2048, 2048}; pg8::StaticOrder S; S.init(Mx, 1024, F.G, F.bid);
    EpiPlain E{wsp<bf16_t>(F, WS_QP), 1024};
    pg8::gemm_phase<EpiPlain, pg8::StaticOrder>(F.lds, F.tid, g, S, E); }
__device__ PH_ATTR void ph_peer(ArgP ap, int l, int last) { const Frame F = make_frame(ap); p_peer(F, l, last); }

__global__ void __launch_bounds__(512, 2) mega_fwd(Args args) {
    extern __shared__ __attribute__((aligned(16))) unsigned char lds_raw[];
    const ArgP ap = (ArgP)__builtin_amdgcn_kernarg_segment_ptr();
    const int lo = ap->ph_lo, hi = ap->ph_hi;
    volatile LAS unsigned* misc = (volatile LAS unsigned*)((LAS unsigned char*)lds_raw + MISC_OFF);
    if (threadIdx.x < 4) misc[threadIdx.x] = 0u;
    __syncthreads();
    XcdBarrier bar; bar.bar = (unsigned*)(ap->ws + WS_CTL); bar.x = 0; bar.st = misc;
    if (hi - lo > 1) bar = xcd_barrier_post((unsigned*)(ap->ws + WS_CTL), misc);
#ifdef BENCH_K
    { float a[16]; f32x2 b2[8];
#pragma unroll
      for (int i = 0; i < 16; ++i) a[i] = 1.f + threadIdx.x * 1e-3f + i;
#pragma unroll
      for (int i = 0; i < 8; ++i) b2[i] = (f32x2){a[i], a[i + 8]};
      float c0 = a[3], c1 = a[5];
#define B16(INS) asm volatile(INS(0) INS(1) INS(2) INS(3) INS(4) INS(5) INS(6) INS(7) INS(8) INS(9) INS(10) INS(11) INS(12) INS(13) INS(14) INS(15) \
        : "+v"(a[0]), "+v"(a[1]), "+v"(a[2]), "+v"(a[3]), "+v"(a[4]), "+v"(a[5]), "+v"(a[6]), "+v"(a[7]), "+v"(a[8]), "+v"(a[9]), "+v"(a[10]), "+v"(a[11]), "+v"(a[12]), "+v"(a[13]), "+v"(a[14]), "+v"(a[15]) : "v"(c0), "v"(c1))
#define I_ADD(i) "v_add_f32 %" #i ", %" #i ", %16\n"
#define I_EXP(i) "v_exp_f32 %" #i ", %" #i "\n"
#define I_MAX3(i) "v_max3_f32 %" #i ", %" #i ", %16, %17\n"
#define I_CVT(i) "v_cvt_pk_fp8_f32 %" #i ", %16, %17\n"
#define I_DEP(i) "v_max3_f32 %0, %0, %16, %17\n"
#define I_DEPA(i) "v_add_f32 %0, %0, %16\n"
#define I_FMA(i) "v_fma_f32 %" #i ", %" #i ", %16, %17\n"
#define P8(INS) asm volatile(INS(0) INS(1) INS(2) INS(3) INS(4) INS(5) INS(6) INS(7) INS(0) INS(1) INS(2) INS(3) INS(4) INS(5) INS(6) INS(7) \
        : "+v"(b2[0]), "+v"(b2[1]), "+v"(b2[2]), "+v"(b2[3]), "+v"(b2[4]), "+v"(b2[5]), "+v"(b2[6]), "+v"(b2[7]) : "v"(b2[0]))
#define I_PKADD(i) "v_pk_add_f32 %" #i ", %" #i ", %8\n"
#define I_PKFMA(i) "v_pk_fma_f32 %" #i ", %" #i ", %8, %8\n"
#pragma unroll 1
      for (int it = 0; it < 20000; ++it) {
#if BENCH_K == 1
        B16(I_ADD);
#elif BENCH_K == 2
        B16(I_EXP);
#elif BENCH_K == 3
        B16(I_MAX3);
#elif BENCH_K == 4
        B16(I_CVT);
#elif BENCH_K == 5
        P8(I_PKADD);
#elif BENCH_K == 6
        P8(I_PKFMA);
#elif BENCH_K == 7
        B16(I_FMA);
#elif BENCH_K == 9
        B16(I_DEP);
#elif BENCH_K == 10
        B16(I_DEPA);
#endif
      }
#if BENCH_K == 11 || BENCH_K == 12
      { f32x16 q0 = {}, q1 = {}, q2 = {}, q3 = {}; att::i32x8a x8 = {1, 2, 3, 4, 5, 6, 7, (int)threadIdx.x};
#pragma unroll 1
        for (int it = 0; it < 2000; ++it) {
#pragma unroll
          for (int k = 0; k < 4; ++k) {
            q0 = __builtin_amdgcn_mfma_scale_f32_32x32x64_f8f6f4(x8, x8, q0, 0, 0, 0, 0x7F7F7F7F, 0, 0x7F7F7F7F); asm volatile("" : "+v"(q0));
#if BENCH_K == 11
            B16(I_ADD);
#else
            B16(I_EXP);
#endif
            q1 = __builtin_amdgcn_mfma_scale_f32_32x32x64_f8f6f4(x8, x8, q1, 0, 0, 0, 0x7F7F7F7F, 0, 0x7F7F7F7F); asm volatile("" : "+v"(q1));
#if BENCH_K == 11
            B16(I_ADD);
#else
            B16(I_EXP);
#endif
            q2 = __builtin_amdgcn_mfma_scale_f32_32x32x64_f8f6f4(x8, x8, q2, 0, 0, 0, 0x7F7F7F7F, 0, 0x7F7F7F7F); asm volatile("" : "+v"(q2));
#if BENCH_K == 11
            B16(I_ADD);
#else
            B16(I_EXP);
#endif
            q3 = __builtin_amdgcn_mfma_scale_f32_32x32x64_f8f6f4(x8, x8, q3, 0, 0, 0, 0x7F7F7F7F, 0, 0x7F7F7F7F); asm volatile("" : "+v"(q3));
#if BENCH_K == 11
            B16(I_ADD);
#else
            B16(I_EXP);
#endif
          }
          asm volatile("" : "+v"(x8)); } }
#endif
#if BENCH_K == 8
      { f32x16 q0 = {}, q1 = {}, q2 = {}, q3 = {}; att::i32x8a x8 = {1, 2, 3, 4, 5, 6, 7, (int)threadIdx.x};
#pragma unroll 1
        for (int it = 0; it < 2000; ++it) {
#pragma unroll
          for (int k = 0; k < 4; ++k) { q0 = __builtin_amdgcn_mfma_scale_f32_32x32x64_f8f6f4(x8, x8, q0, 0, 0, 0, 0x7F7F7F7F, 0, 0x7F7F7F7F); q1 = __builtin_amdgcn_mfma_scale_f32_32x32x64_f8f6f4(x8, x8, q1, 0, 0, 0, 0x7F7F7F7F, 0, 0x7F7F7F7F);
            q2 = __builtin_amdgcn_mfma_scale_f32_32x32x64_f8f6f4(x8, x8, q2, 0, 0, 0, 0x7F7F7F7F, 0, 0x7F7F7F7F); q3 = __builtin_amdgcn_mfma_scale_f32_32x32x64_f8f6f4(x8, x8, q3, 0, 0, 0, 0x7F7F7F7F, 0, 0x7F7F7F7F); }
          asm volatile("" : "+v"(q0), "+v"(q1), "+v"(q2), "+v"(q3), "+v"(x8)); } }
#endif
    }
#endif
#define IN(k) (lo <= (k) && (k) < hi)
#define SEAM(k) do { if (IN(k) && IN((k) + 1)) xcd_barrier(bar); } while (0)
    if (IN(0)) { if (PHM & 1) ph_prologue<7>(ap); if (REP_PRO) ph_prologue<REP_PRO>(ap); } SEAM(0);
    if (IN(1)) { if (PHM & 2) ph_modreduce(ap); if (REP_X & 32) ph_modreduce(ap); } SEAM(1);
#pragma unroll 1
    for (int l = 0; l < 2; ++l) {
        const int pb = 2 + 10 * l; const int last = (l == 1);
        const int Mx = last ? NLAT : NROW;
        if (l == 0) { if (IN(pb)) { if (PHM & 4) ph_modulate0(ap); if (REP_X & 64) ph_modulate0(ap); } SEAM(pb); }
        if (IN(pb + 1)) { if (REP_GIN) ph_gemm_in<GIN_ABL>(ap, l); if (PHM & 8) ph_gemm_in<0>(ap, l); } SEAM(pb + 1);
        if (IN(pb + 2)) { if (PHM & 16) ph_post(ap, l); if (REP_X & 1) ph_post(ap, l); } SEAM(pb + 2);
        if (IN(pb + 3)) { if (PHM & 32) ph_qup(ap, l); if (PHM & 64) ph_kvup(ap, l); if (PHM & 128) ph_states(ap, l); if (REP_X & 2) { ph_qup(ap, l); ph_kvup(ap, l); ph_states(ap, l); } } SEAM(pb + 3);
        if (IN(pb + 4)) { if (REP_ATTN & 1) ph_attn_gqa<ATT_ABL>(ap, last); if (REP_ATTN & 2) ph_attn_mla<ATT_ABL>(ap, last); if (PHM & 256) ph_attn_gqa<0>(ap, last); if (PHM & 512) ph_attn_mla<0>(ap, last); if (REP_X & 4) ph_ret_out(ap, l, last); if (PHM & 1024) ph_ret_out(ap, l, last); } SEAM(pb + 4);
        if (IN(pb + 5)) { if (PHM & 2048) { if (MERGE3) ph_merge3(ap, l, Mx); else { ph_merge<0>(ap, l, Mx); ph_merge<1>(ap, l, Mx); ph_merge<2>(ap, l, Mx); } } if (REP_X & 8) { if (MERGE3) ph_merge3(ap, l, Mx); else { ph_merge<0>(ap, l, Mx); ph_merge<1>(ap, l, Mx); ph_merge<2>(ap, l, Mx); } } } SEAM(pb + 5);
        if (IN(pb + 6)) { if (PHM & 4096) ph_out(ap, l, Mx); } SEAM(pb + 6);
        if (IN(pb + 7)) { if (PHM & 8192) ph_ln1(ap, l, last); } SEAM(pb + 7);
        if (IN(pb + 8)) { if (PHM & 16384) ph_peerq(ap, l, Mx); if (REP_X & 16) ph_peerq(ap, l, Mx); } SEAM(pb + 8);
        if (IN(pb + 9)) { if (PHM & 32768) ph_peer(ap, l, last); } SEAM(pb + 9);
    }
#undef IN
#undef SEAM
}

extern "C" void kernel_launch(void* const* d_in, const int* in_sizes, int n_in, void* d_out, int out_size, void* d_ws, size_t ws_size, hipStream_t stream) {
    static int grid = 0;
    if (grid == 0) {
        if (n_in != 27 || out_size != NLAT * D || ws_size < WS_END) { fprintf(stderr, "kernel_launch: unexpected shapes: n_in %d out %d ws %zu (need %zu)\n", n_in, out_size, ws_size, (size_t)WS_END); grid = -1; return; }
        int dev = 0, cus = 0, per_cu = 0;
        if (hipGetDevice(&dev) != hipSuccess || hipDeviceGetAttribute(&cus, hipDeviceAttributeMultiprocessorCount, dev) != hipSuccess) { grid = -1; return; }
        if (hipFuncSetAttribute((const void*)mega_fwd, hipFuncAttributeMaxDynamicSharedMemorySize, LDS_BYTES) != hipSuccess) { fprintf(stderr, "kernel_launch: hipFuncSetAttribute failed\n"); grid = -1; return; }
        if (hipOccupancyMaxActiveBlocksPerMultiprocessor(&per_cu, (const void*)mega_fwd, 512, LDS_BYTES) != hipSuccess || per_cu < 1) fprintf(stderr, "kernel_launch: occupancy query reports %d\n", per_cu);
        (void)hipGetLastError();
        grid = cus;
    }
    if (grid < 0) return;
    (void)hipMemsetAsync((char*)d_ws + WS_CTL, 0, 65536, stream);
#ifdef DBG
    (void)hipMemsetAsync((char*)d_ws + WS_CTL + 131072, 0, 4096, stream);
#endif
    Args a{};
    for (int i = 0; i < 27; ++i) a.in[i] = (const float*)d_in[i];
    a.out = (float*)d_out; a.ws = (unsigned char*)d_ws;
#if MK_PER_PHASE
    for (int p = 0; p < NPHASE; ++p) { if (p == 12) continue; a.ph_lo = p; a.ph_hi = p + 1;
#ifdef DBG
        if (p == 11) hipLaunchKernelGGL(dbg_peer_pre, dim3(DBG_NS), dim3(256), 0, stream, a, 0);
#endif
        hipLaunchKernelGGL(mega_fwd, dim3(grid), dim3(512), LDS_BYTES, stream, a);
#ifdef DBG
        if (p == 11) hipLaunchKernelGGL(dbg_peer_post, dim3(DBG_NS), dim3(256), 0, stream, a);
#endif
    }
#ifdef DBG
    hipLaunchKernelGGL(dbg_report, dim3(1), dim3(256), 0, stream, a);
#endif
#else
    a.ph_lo = 0; a.ph_hi = NPHASE;
    hipLaunchKernelGGL(mega_fwd, dim3(grid), dim3(512), LDS_BYTES, stream, a);
#endif
    const hipError_t le = hipPeekAtLastError();
    if (le != hipSuccess) fprintf(stderr, "kernel_launch: launch failed: %s\n", hipGetErrorName(le));
}
```

```cpp
#include <hip/hip_runtime.h>
#include <cstdio>
#include <cstdint>
#include <cstddef>

#ifndef MK_PER_PHASE
#define MK_PER_PHASE 0
#endif

#ifndef ABL_PEER
#define ABL_PEER 0
#endif
#ifndef REP_PEERG
#define REP_PEERG 0
#endif
#ifndef REP_PEERH
#define REP_PEERH 0
#endif
#ifndef REP_X
#define REP_X 0
#endif
#ifndef REP_PS1
#define REP_PS1 0
#endif
#ifndef REP_PS2
#define REP_PS2 0
#endif
#ifndef SIDE_ON
#define SIDE_ON 1
#endif
#ifndef REP_DOT
#define REP_DOT 0
#endif
#ifndef MERGE3
#define MERGE3 1
#endif
#ifndef REP_GIN
#define REP_GIN 0
#endif
#ifndef PS1_ABL
#define PS1_ABL 0
#endif
#ifndef GIN_ABL
#define GIN_ABL 0
#endif
#ifndef ATT_ABL
#define ATT_ABL 0
#endif
#ifndef REP_ATTN
#define REP_ATTN 0
#endif
#ifndef REP_PRO
#define REP_PRO 0
#endif
#ifndef ABL_BR
#define ABL_BR 0
#endif
#ifndef ABL_MIX
#define ABL_MIX 0
#endif
#define LAS __attribute__((address_space(3)))
typedef unsigned short bf16_t;
typedef short bf16x8 __attribute__((ext_vector_type(8)));
typedef short s16x4 __attribute__((ext_vector_type(4)));
typedef float f32x2 __attribute__((ext_vector_type(2)));
typedef float f32x4 __attribute__((ext_vector_type(4)));
typedef float f32x8 __attribute__((ext_vector_type(8)));
typedef float f32x16 __attribute__((ext_vector_type(16)));
typedef unsigned u32x2 __attribute__((ext_vector_type(2)));
typedef unsigned u32x4 __attribute__((ext_vector_type(4)));
typedef __bf16 bf2_t __attribute__((ext_vector_type(2)));

constexpr int D = 2048, NB = 4, SEQ = 4096, CTXL = 256, TT = SEQ + CTXL;
constexpr int NLAT = NB * SEQ, NCTX = NB * CTXL, NROW = NLAT + NCTX;
constexpr int NP1 = 4096, NG = 6144, NPT = NP1 + NG;
constexpr int NIN = 10016;
constexpr float ALPHA = 1.4142135623730951f;
constexpr float LN_EPS = 1e-5f, RMS_EPS = 1e-6f;
constexpr float LOG2E = 1.4426950408889634f;
constexpr int C_CQ = 0, C_CKV = 512, C_GQ = 768, C_GK = 1792, C_GV = 2048, C_RQ = 2304, C_RK = 2560, C_RV = 2816, C_RG = 3328, C_KR = 3840;

constexpr size_t AL(size_t x) { return (x + 255) / 256 * 256; }
constexpr size_t WS_CTL = 0;                                    constexpr size_t CTL_BYTES = 1u << 20;
constexpr size_t WS_WSC = WS_CTL + 32768;
constexpr size_t WS_CVT = WS_CTL + 33024;
constexpr size_t WS_DEC = WS_CTL + 65536;
constexpr size_t WS_ROPE32 = WS_CTL + CTL_BYTES;
constexpr size_t WS_ROPE128 = WS_ROPE32 + AL(64 * 8 * 8);
constexpr size_t WS_MODP = WS_ROPE128 + AL(64 * 32 * 8);
constexpr size_t WS_MOD = WS_MODP + AL((size_t)16 * 2 * 5 * 12288 * 4);
constexpr size_t WS_WIN = WS_MOD + AL((size_t)2 * 5 * 12288 * 4);
constexpr size_t SZ_WIN = (size_t)NPT * D;
constexpr size_t WS_WQUP = WS_WIN + 2 * SZ_WIN;                 constexpr size_t SZ_WQUP = (size_t)768 * 512 * 2;
constexpr size_t WS_WKVUP = WS_WQUP + 2 * SZ_WQUP;              constexpr size_t SZ_WKVUP = (size_t)1024 * 256 * 2;
constexpr size_t WS_WBRA = WS_WKVUP + 2 * SZ_WKVUP;             constexpr size_t SZ_WBRA = (size_t)2048 * 512 * 2;
constexpr size_t WS_WBRB = WS_WBRA + 2 * SZ_WBRA;               constexpr size_t SZ_WBRB = SZ_WBRA;
constexpr size_t WS_WBRC = WS_WBRB + 2 * SZ_WBRB;               constexpr size_t SZ_WBRC = (size_t)2048 * 1024 * 2;
constexpr size_t WS_WOUT = WS_WBRC + 2 * SZ_WBRC;               constexpr size_t SZ_WOUT = (size_t)2048 * 2048 * 2;
constexpr size_t WS_WPQ = WS_WOUT + 2 * SZ_WOUT;                constexpr size_t SZ_WPQ = (size_t)1024 * 2048 * 2;
constexpr size_t WS_PSC = WS_WPQ + 2 * SZ_WPQ;
constexpr size_t WS_PU = WS_PSC + (size_t)4 * 16384 * 4;        constexpr size_t SZ_PT = (size_t)16384 * 1152;
constexpr size_t WS_PV = WS_PU + 2 * SZ_PT;
constexpr size_t WS_XC = WS_PV + 2 * SZ_PT;
constexpr size_t WS_HB = WS_XC + (size_t)NCTX * D * 4;
constexpr size_t WS_P1 = WS_HB + (size_t)NROW * D * 2;
constexpr size_t WS_G = WS_P1 + (size_t)NROW * NP1 * 2;
constexpr size_t WS_CQN = WS_G + (size_t)NROW * NG * 2;
constexpr size_t WS_CKVN = WS_CQN + (size_t)NROW * 512 * 2;
constexpr size_t WS_QM = WS_CKVN + (size_t)NROW * 256 * 2;
constexpr size_t SZ_Q128 = (size_t)NB * 8 * TT * 128 * 2;
constexpr size_t WS_KM = WS_QM + SZ_Q128;
constexpr size_t WS_VM = WS_KM + SZ_Q128;
constexpr size_t WS_QG = WS_VM + SZ_Q128 / 2;
constexpr size_t WS_KG = WS_QG + SZ_Q128;
constexpr size_t WS_VG = WS_KG + SZ_Q128 / 4;
constexpr size_t WS_RQ = WS_VG + SZ_Q128 / 4;
constexpr size_t WS_RK = WS_RQ + SZ_Q128 / 4;
constexpr size_t WS_RV = WS_RK + SZ_Q128 / 4;
constexpr size_t WS_ST = WS_RV + SZ_Q128 / 2;
constexpr size_t WS_OAB = WS_ST + (size_t)NB * 8 * 34 * 2 * 2048 * 4;
constexpr size_t WS_HB8 = WS_OAB + (size_t)NROW * D * 2;
constexpr size_t WS_MB8 = WS_HB8 + (size_t)NROW * D;
constexpr size_t WS_END = WS_MB8 + (size_t)NROW * D;
constexpr size_t WS_MB = WS_QM;
constexpr size_t WS_QP = WS_QG;
static_assert((size_t)NROW * D * 2 <= 2 * SZ_Q128, "MB alias");
static_assert((size_t)NROW * 1024 * 2 <= SZ_Q128, "QP alias");

__device__ __forceinline__ unsigned cvt_pk_bf16(float lo, float hi) { unsigned r; asm volatile("v_cvt_pk_bf16_f32 %0, %1, %2" : "=v"(r) : "v"(lo), "v"(hi)); return r; }
__device__ __forceinline__ bf16_t f2bf(float f) { return (bf16_t)(cvt_pk_bf16(f, 0.f) & 0xffffu); }
__device__ __forceinline__ float bf2f(bf16_t b) { return __uint_as_float(((unsigned)b) << 16); }
__device__ __forceinline__ float bflo(unsigned w) { return __uint_as_float(w << 16); }
__device__ __forceinline__ float bfhi(unsigned w) { return __uint_as_float(w & 0xffff0000u); }
template <int CTRL> __device__ __forceinline__ float dppf(float x) { return __int_as_float(__builtin_amdgcn_update_dpp(0, __float_as_int(x), CTRL, 0xF, 0xF, true)); }
__device__ __forceinline__ float row16_sum(float x) { x += dppf<0xB1>(x); x += dppf<0x4E>(x); x += dppf<0x141>(x); x += dppf<0x140>(x); return x; }
__device__ __forceinline__ float row16_max(float x) { x = fmaxf(x, dppf<0xB1>(x)); x = fmaxf(x, dppf<0x4E>(x)); x = fmaxf(x, dppf<0x141>(x)); x = fmaxf(x, dppf<0x140>(x)); return x; }
__device__ __forceinline__ float wave_sum(float x) {
    x = row16_sum(x);
    { auto r = __builtin_amdgcn_permlane16_swap(__float_as_uint(x), __float_as_uint(x), false, false); x = __uint_as_float(r[0]) + __uint_as_float(r[1]); }
    { auto r = __builtin_amdgcn_permlane32_swap(__float_as_uint(x), __float_as_uint(x), false, false); x = __uint_as_float(r[0]) + __uint_as_float(r[1]); }
    return x;
}
__device__ __forceinline__ unsigned pk4_fp8(float a, float b, float c, float d) { int t = 0; t = __builtin_amdgcn_cvt_pk_fp8_f32(a, b, t, false); t = __builtin_amdgcn_cvt_pk_fp8_f32(c, d, t, true); return (unsigned)t; }
__device__ __forceinline__ float clamp8(float x) { return fminf(fmaxf(x, -440.f), 440.f); }
__device__ __forceinline__ void fp8_scale(unsigned amax_bits, float& mul, float& inv) { const float am = __uint_as_float(amax_bits); int k = 0; if (am > 0.f) k = (int)floorf(log2f(256.f / am)); k = k > 60 ? 60 : (k < -60 ? -60 : k); mul = exp2f((float)k); inv = exp2f((float)-k); }
__device__ __forceinline__ float silu_f(float x) { return x * __builtin_amdgcn_rcpf(1.f + __builtin_amdgcn_exp2f(x * -1.4426950408889634f)); }
__device__ __forceinline__ float sigmoid_f(float x) { return __builtin_amdgcn_rcpf(1.f + __builtin_amdgcn_exp2f(x * -1.4426950408889634f)); }

__device__ __forceinline__ int vt_off(int tpos) { const int kk = tpos & 63; return (tpos & ~63) + ((kk >> 2) & 1) * 32 + ((kk >> 5) & 1) * 16 + (kk & 3) + 4 * ((kk >> 3) & 3); }
constexpr float QSC_G = 4.f * 0.08838834764831845f * 1.4426950408889634f, QSC_M = 4.f * 0.10206207261596575f * 1.4426950408889634f, KSC8 = 0.25f;
struct RowInfo { int b, tpos, pr, pc, v; bool lat; };
__device__ __forceinline__ RowInfo rowinfo(int row) {
    RowInfo r;
    if (row < NLAT) { r.lat = true; r.b = row >> 12; const int t = row & 4095; r.tpos = CTXL + t; r.pr = t >> 6; r.pc = t & 63; r.v = r.b; }
    else { const int q = row - NLAT; r.lat = false; r.b = q >> 8; r.tpos = q & 255; r.pr = 0; r.pc = 0; r.v = 4; }
    return r;
}

#define XB_TMO      128
#define XB_XCNT(j)  (256  + 64 * (j))
#define XB_XSUB(j)  (1280 + 64 * (j))
#define XB_XGEN(j)  (2304 + 64 * (j))
#define XB_TOP      3328
#define XB_TOPGEN   3392
#define XCD_BAR_WORDS 3456
#define XB_SPIN_CAP (1u << 22)

__device__ __forceinline__ unsigned xb_ld(unsigned* p)              { return __hip_atomic_load(p, __ATOMIC_RELAXED, __HIP_MEMORY_SCOPE_AGENT); }
__device__ __forceinline__ unsigned xb_add(unsigned* p, unsigned v) { return __hip_atomic_fetch_add(p, v, __ATOMIC_RELAXED, __HIP_MEMORY_SCOPE_AGENT); }
__device__ __forceinline__ unsigned xb_xcc_id() { return (unsigned)__builtin_amdgcn_s_getreg((3 << 11) | 20) & 0xFu; }
#define XB_SPIN(cond, bar) do { unsigned _sp = 0; while (cond) { __builtin_amdgcn_s_sleep(1); \
    if ((++_sp & 255u) == 0u) { if (xb_ld(&(bar)[XB_TMO])) break; if (_sp > XB_SPIN_CAP) { atomicAdd(&(bar)[XB_TMO], 1u); break; } } } } while (0)

struct XcdBarrier { unsigned* bar; unsigned x; volatile LAS unsigned* st; };

__device__ __forceinline__ XcdBarrier xcd_barrier_post(unsigned* bar, volatile LAS unsigned* st) {
    XcdBarrier b; b.bar = bar; b.x = xb_xcc_id(); b.st = st;
    if (threadIdx.x == 0) (void)xb_add(&bar[XB_XCNT(b.x)], 1u);
    return b;
}
__device__ __forceinline__ void xcd_barrier_complete(unsigned* bar, unsigned x, unsigned& nloc, unsigned& nx) {
    const unsigned G = gridDim.x * gridDim.y * gridDim.z;
    unsigned sum, cnt, mine, sp = 0u;
    for (;;) {
        sum = 0u; cnt = 0u; mine = 0u;
#pragma unroll
        for (unsigned j = 0; j < 16; ++j) { const unsigned c = xb_ld(&bar[XB_XCNT(j)]); sum += c; cnt += (c > 0u) ? 1u : 0u; mine = (j == x) ? c : mine; }
        if (sum == G) break;
        __builtin_amdgcn_s_sleep(1);
        if ((++sp & 255u) == 0u) { if (xb_ld(&bar[XB_TMO])) break; if (sp > XB_SPIN_CAP) { atomicAdd(&bar[XB_TMO], 1u); break; } }
    }
    nloc = mine > 0u ? mine : 1u; nx = cnt > 0u ? cnt : 1u;
}
__device__ __forceinline__ void xcd_barrier(const XcdBarrier& b) {
    asm volatile("s_waitcnt vmcnt(0)" ::: "memory");
    __syncthreads();
    if (threadIdx.x == 0) {
        unsigned* bar = b.bar;
        __builtin_amdgcn_s_waitcnt(0);
        unsigned nloc = b.st[0], nx = b.st[1];
        if (nloc == 0u) { xcd_barrier_complete(bar, b.x, nloc, nx); b.st[0] = nloc; b.st[1] = nx; }
        const unsigned old = xb_add(&bar[XB_XSUB(b.x)], 1u);
        const unsigned gen = old / nloc;
        if (old + 1u == (gen + 1u) * nloc) {
            __builtin_amdgcn_fence(__ATOMIC_RELEASE, "agent");
            asm volatile("s_waitcnt vmcnt(0)" ::: "memory");
            const unsigned og = xb_add(&bar[XB_TOP], 1u);
            const unsigned tg = og / nx;
            if (og + 1u == (tg + 1u) * nx) xb_add(&bar[XB_TOPGEN], 1u);
            else XB_SPIN(xb_ld(&bar[XB_TOPGEN]) == tg, bar);
            __builtin_amdgcn_fence(__ATOMIC_ACQUIRE, "agent");
            xb_add(&bar[XB_XGEN(b.x)], 1u);
            asm volatile("s_waitcnt vmcnt(0)" ::: "memory");
        } else {
            XB_SPIN(xb_ld(&bar[XB_XGEN(b.x)]) == gen, bar);
            __builtin_amdgcn_fence(__ATOMIC_ACQUIRE, "agent");
            asm volatile("s_waitcnt vmcnt(0)" ::: "memory");
        }
    }
    __syncthreads();
}
namespace pg8 {
constexpr int BM = 256, BK = 64, HALF = 128, HTB = HALF * BK * 2, STAGE_BYTES = 8 * HTB, NXCD = 8, WGM = 8;
__host__ __device__ __forceinline__ int lds_byte(int r, int c) { const int st = (r >> 4) * 2 + (c >> 5), rr = r & 15, cc = c & 31, ob = rr * 64 + cc * 2; return st * 1024 + (ob ^ (((ob >> 9) & 1) << 5)); }
__host__ __device__ __forceinline__ void stage_rc(int b, int& R, int& C) { const int st = b / 1024, sb = b % 1024, swz = sb ^ (((sb >> 9) & 1) << 5); R = (st >> 1) * 16 + swz / 64; C = (st & 1) * 32 + (swz % 64) / 2; }
__host__ __device__ __forceinline__ int perm32(int rho) { const int n = rho >> 4, i = rho & 15; return 8 * (i >> 2) + 4 * n + (i & 3); }

struct Unit { int pm, pn; };
typedef int i32x8 __attribute__((ext_vector_type(8))); typedef int i32x4v __attribute__((ext_vector_type(4)));
__device__ __forceinline__ i32x8 cat8(const bf16x8 a, const bf16x8 b) { const i32x4v x = __builtin_bit_cast(i32x4v, a), y = __builtin_bit_cast(i32x4v, b); return __builtin_shufflevector(x, y, 0, 1, 2, 3, 4, 5, 6, 7); }
struct Gemm { const bf16_t* A; const bf16_t* Bt; int M, N, K, lda, ldb; };

struct StaticOrder {
    int nM, nN, nwg, G, c;
    __host__ __device__ void init(int M, int N, int G_, int c_) { nM = M / BM; nN = N / BM; nwg = nM * nN; G = G_; c = c_; }
    __host__ __device__ bool next(int i, Unit& u) const {
        const long L = (long)i * G + c; if (L >= nwg) return false;
        int wgid = (int)L; { const int q = nwg / NXCD, r = nwg % NXCD, xcd = wgid % NXCD, off = wgid / NXCD; wgid = (xcd < r ? xcd * (q + 1) : r * (q + 1) + (xcd - r) * q) + off; }
        const int nig = WGM * nN, gid = wgid / nig, fm = gid * WGM, gsz = (nM - fm) < WGM ? (nM - fm) : WGM;
        u.pm = fm + ((wgid % nig) % gsz); u.pn = (wgid % nig) / gsz; return true;
    }
    __device__ __forceinline__ void a_ready(const Unit&) const {}
    __device__ __forceinline__ void done(const Unit&) const {}
};

template <class Epi, class Sched, int GABL = 0>
__device__ __forceinline__ void gemm_phase(LAS unsigned char* lds, const int tid, const Gemm g, const Sched& S, const Epi& E) {
    const int  wid = __builtin_amdgcn_readfirstlane(tid >> 6), lane = tid & 63, wr = wid >> 2, wc = wid & 3, fr = lane & 15, fq = lane >> 4;
    const int K = g.K, nt = K / BK;
    unsigned voffA[2], voffB[2];
#pragma unroll
    for (int i = 0; i < 2; ++i) { int R, C; stage_rc(tid * 16 + i * 8192, R, C); const int Rb = Epi::PERM ? ((R & ~31) + perm32(R & 31)) : R;
        voffA[i] = (unsigned)(R * g.lda + C) * 2u; voffB[i] = (unsigned)(Rb * g.ldb + C) * 2u; }
    const size_t kstep = (size_t)(BK * 2);
    const size_t hstepA = (size_t)HALF * g.lda * 2, hstepB = (size_t)HALF * g.ldb * 2;
    const size_t tstepA = 2 * hstepA, tstepB = 2 * hstepB;
    const unsigned ldsw = (unsigned)wid * 1024u;
    const int aoff = lds_byte(wr * 64 + fr, fq * 8), boff = lds_byte(wc * 32 + fr, fq * 8);
#define PG8_SA(b, h) (((b) * 2 + (h)) * HTB)
#define PG8_SB(b, h) ((4 + (b) * 2 + (h)) * HTB)
#define PG8_STAGE(bufoff, gbase, voff) do { if constexpr (!(GABL & 4)) _Pragma("unroll") for (int _i = 0; _i < 2; ++_i) \
        __builtin_amdgcn_global_load_lds((const unsigned*)((const char*)(gbase) + (voff)[_i]), (LAS unsigned*)(lds + (bufoff) + ldsw + _i * 8192), 16, 0, 0); } while (0)
#define PG8_LDA(dst, b, h) do { if constexpr (Epi::FP8) { _Pragma("unroll") for (int m = 0; m < 4; ++m) { const i32x4v lo_ = *(const LAS i32x4v*)(lds + PG8_SA(b, h) + aoff + m * 2048), hi_ = *(const LAS i32x4v*)(lds + PG8_SA(b, h) + aoff + m * 2048 + 1024); \
            dst##8[m] = __builtin_shufflevector(lo_, hi_, 0, 1, 2, 3, 4, 5, 6, 7); } } \
        else { _Pragma("unroll") for (int m = 0; m < 4; ++m) _Pragma("unroll") for (int k = 0; k < 2; ++k) dst[m][k] = *(const LAS bf16x8*)(lds + PG8_SA(b, h) + aoff + m * 2048 + k * 1024); } } while (0)
#define PG8_LDB(dst, b, h) do { if constexpr (Epi::FP8) { _Pragma("unroll") for (int n = 0; n < 2; ++n) { const i32x4v lo_ = *(const LAS i32x4v*)(lds + PG8_SB(b, h) + boff + n * 2048), hi_ = *(const LAS i32x4v*)(lds + PG8_SB(b, h) + boff + n * 2048 + 1024); \
            dst##8[n] = __builtin_shufflevector(lo_, hi_, 0, 1, 2, 3, 4, 5, 6, 7); } } \
        else { _Pragma("unroll") for (int n = 0; n < 2; ++n) _Pragma("unroll") for (int k = 0; k < 2; ++k) dst[n][k] = *(const LAS bf16x8*)(lds + PG8_SB(b, h) + boff + n * 2048 + k * 1024); } } while (0)
#define PG8_MMA(ai, bj, At, Bt) do { __builtin_amdgcn_s_setprio(1); _Pragma("unroll") for (int m = 0; m < 4; ++m) _Pragma("unroll") for (int n = 0; n < 2; ++n) { \
        if constexpr (Epi::FP8) { if constexpr (GABL & 8) asm volatile("" : "+v"(acc[ai][bj][m][n]) : "v"(Bt##8[n]), "v"(At##8[m]), "v"(sc1_)); else asm volatile("v_mfma_scale_f32_16x16x128_f8f6f4 %0, %1, %2, %0, %3, %3 op_sel_hi:[0,0,0]" : "+v"(acc[ai][bj][m][n]) : "v"(Bt##8[n]), "v"(At##8[m]), "v"(sc1_)); } \
        else { _Pragma("unroll") for (int k = 0; k < 2; ++k) acc[ai][bj][m][n] = __builtin_amdgcn_mfma_f32_16x16x32_bf16(Bt[n][k], At[m][k], acc[ai][bj][m][n], 0, 0, 0); } } __builtin_amdgcn_s_setprio(0); } while (0)
#define PG8_WAIT_V(n) asm volatile("s_waitcnt vmcnt(" #n ")" ::: "memory")
#define PG8_WAIT_L(n) asm volatile("s_waitcnt lgkmcnt(" #n ")" ::: "memory")
#define PG8_BAR __builtin_amdgcn_s_barrier()
#define PG8_SCHED __builtin_amdgcn_sched_barrier(0)
    Unit cur, nxt; int ui = 0;
    if (!S.next(0, cur)) return;
    f32x4 acc[2][2][4][2];
#pragma unroll
    for (int a = 0; a < 2; ++a)
#pragma unroll
        for (int b = 0; b < 2; ++b)
#pragma unroll
            for (int m = 0; m < 4; ++m)
#pragma unroll
                for (int n = 0; n < 2; ++n) acc[a][b][m][n] = (f32x4){0.f, 0.f, 0.f, 0.f};
    int sc1_ = 0x7F7F7F7F; asm volatile("" : "+v"(sc1_));
    bf16x8 At[4][2], B0[2][2], B1[2][2]; i32x8 At8[4], B08[2], B18[2];
    const char* cA = (const char*)g.A + (size_t)cur.pm * tstepA; const char* cB = (const char*)g.Bt + (size_t)cur.pn * tstepB;
    S.a_ready(cur);
    PG8_STAGE(PG8_SB(0, 0), cB, voffB); PG8_STAGE(PG8_SA(0, 0), cA, voffA); PG8_STAGE(PG8_SB(0, 1), cB + hstepB, voffB); PG8_STAGE(PG8_SA(0, 1), cA + hstepA, voffA);
    if (wr == 1) PG8_BAR;
    PG8_WAIT_V(4); PG8_BAR;
    PG8_STAGE(PG8_SB(1, 0), cB + kstep, voffB); PG8_STAGE(PG8_SA(1, 0), cA + kstep, voffA); PG8_STAGE(PG8_SB(1, 1), cB + hstepB + kstep, voffB);
    PG8_WAIT_V(6); PG8_BAR;
    for (;;) {
        const bool has_next = S.next(ui + 1, nxt);
        const char* nA = has_next ? (const char*)g.A + (size_t)nxt.pm * tstepA : cA; const char* nB = has_next ? (const char*)g.Bt + (size_t)nxt.pn * tstepB : cB;
#pragma unroll 1
        for (int t = 0; t < nt; t += 2) {
            const bool last = (t == nt - 2);
            const char* a1 = cA + (size_t)(t + 1) * kstep;
            const char* a2 = last ? nA : cA + (size_t)(t + 2) * kstep; const char* b2 = last ? nB : cB + (size_t)(t + 2) * kstep;
            const char* a3 = a2 + kstep; const char* b3 = b2 + kstep;
            if (last && has_next) S.a_ready(nxt);
            PG8_LDB(B0, 0, 0); PG8_SCHED; PG8_LDA(At, 0, 0); PG8_STAGE(PG8_SA(1, 1), a1 + hstepA, voffA);
            PG8_WAIT_L(8); PG8_BAR; PG8_WAIT_L(0); PG8_MMA(0, 0, At, B0); PG8_BAR; PG8_SCHED;
            PG8_LDB(B1, 0, 1); PG8_STAGE(PG8_SB(0, 0), b2, voffB);
            PG8_BAR; PG8_WAIT_L(0); PG8_MMA(0, 1, At, B1); PG8_BAR;
            PG8_LDA(At, 0, 1); PG8_STAGE(PG8_SA(0, 0), a2, voffA);
            PG8_BAR; PG8_WAIT_L(0); PG8_MMA(1, 0, At, B0); PG8_BAR; PG8_SCHED;
            PG8_STAGE(PG8_SB(0, 1), b2 + hstepB, voffB);
            PG8_WAIT_V(6); PG8_BAR; PG8_MMA(1, 1, At, B1); PG8_BAR;
            PG8_LDB(B0, 1, 0); PG8_SCHED; PG8_LDA(At, 1, 0); PG8_STAGE(PG8_SA(0, 1), a2 + hstepA, voffA);
            PG8_WAIT_L(8); PG8_BAR; PG8_WAIT_L(0); PG8_MMA(0, 0, At, B0); PG8_BAR; PG8_SCHED;
            PG8_LDB(B1, 1, 1); PG8_STAGE(PG8_SB(1, 0), b3, voffB);
            PG8_BAR; PG8_WAIT_L(0); PG8_MMA(0, 1, At, B1); PG8_BAR;
            PG8_LDA(At, 1, 1); PG8_STAGE(PG8_SA(1, 0), a3, voffA);
            PG8_BAR; PG8_WAIT_L(0); PG8_MMA(1, 0, At, B0); PG8_BAR; PG8_SCHED;
            PG8_STAGE(PG8_SB(1, 1), b3 + hstepB, voffB);
            PG8_WAIT_V(6); PG8_BAR; PG8_MMA(1, 1, At, B1); PG8_BAR;
        }
        if constexpr (Epi::FP8) asm volatile("s_nop 15\n\ts_nop 15" ::: "memory");
        if constexpr (GABL & 2) { pg8::Unit u2_ = cur; u2_.pm = 0; Epi E2_ = E; E2_.retarget(); E2_(acc, u2_, wr, wc, fr, fq); } else if constexpr (!(GABL & 1)) E(acc, cur, wr, wc, fr, fq); else asm volatile("" :: "v"(acc[0][0][0][0]), "v"(acc[1][1][3][1]), "v"(acc[0][1][2][0]), "v"(acc[1][0][1][1]));
        if (!has_next) break;
#pragma unroll
        for (int a = 0; a < 2; ++a)
#pragma unroll
            for (int b = 0; b < 2; ++b)
#pragma unroll
                for (int m = 0; m < 4; ++m)
#pragma unroll
                    for (int n = 0; n < 2; ++n) acc[a][b][m][n] = (f32x4){0.f, 0.f, 0.f, 0.f};
        cur = nxt; cA = nA; cB = nB; ++ui;
    }
    PG8_WAIT_V(0);
    if (wr == 0) PG8_BAR;
    PG8_BAR;
#undef PG8_SA
#undef PG8_SB
#undef PG8_STAGE
#undef PG8_LDA
#undef PG8_LDB
#undef PG8_MMA
#undef PG8_WAIT_V
#undef PG8_WAIT_L
#undef PG8_BAR
#undef PG8_SCHED
}
}

typedef f32x4 Acc[2][2][4][2];
#define EPI_LOOP_ROWS for (int ai = 0; ai < 2; ++ai) for (int m = 0; m < 4; ++m)
__device__ __forceinline__ u32x4 pack8(const f32x4 a, const f32x4 b) { u32x4 w; w.x = cvt_pk_bf16(a[0], a[1]); w.y = cvt_pk_bf16(a[2], a[3]); w.z = cvt_pk_bf16(b[0], b[1]); w.w = cvt_pk_bf16(b[2], b[3]); return w; }

struct EpiIn {
    static constexpr bool PERM = true, FP8 = true;
    bf16_t* P1; bf16_t* G; float inv;
    __device__ __forceinline__ void retarget() { P1 = (bf16_t*)((char*)P1 - WS_P1 + WS_END); G = P1 + 256 * NP1; }
    __device__ __forceinline__ void operator()(const Acc& acc, const pg8::Unit& u, int wr, int wc, int fr, int fq) const {
        const int row0 = u.pm * 256 + wr * 64 + fr; const bool gate = u.pn >= 16;
        const int col0 = (gate ? (u.pn - 16) : u.pn) * 256 + wc * 32 + 8 * fq;
#pragma unroll
        for (int ai = 0; ai < 2; ++ai)
#pragma unroll
            for (int m = 0; m < 4; ++m) { const size_t row = (size_t)(row0 + ai * 128 + m * 16);
#pragma unroll
                for (int bj = 0; bj < 2; ++bj) { f32x4 v0 = acc[ai][bj][m][0] * inv, v1 = acc[ai][bj][m][1] * inv;
                    if (gate) {
#pragma unroll
                        for (int j = 0; j < 4; ++j) { v0[j] = 256.f * sigmoid_f(v0[j]); v1[j] = 256.f * sigmoid_f(v1[j]); }
                        u32x2 w8; w8.x = pk4_fp8(v0[0], v0[1], v0[2], v0[3]); w8.y = pk4_fp8(v1[0], v1[1], v1[2], v1[3]);
                        __builtin_nontemporal_store(w8, (u32x2*)((unsigned char*)G + row * NG + col0 + bj * 128)); }
                    else __builtin_nontemporal_store(pack8(v0, v1), (u32x4*)(P1 + row * NP1 + col0 + bj * 128)); } }
    }
};
struct EpiPlain {
    static constexpr bool PERM = true, FP8 = false;
    bf16_t* O; int ldc;
    __device__ __forceinline__ void operator()(const Acc& acc, const pg8::Unit& u, int wr, int wc, int fr, int fq) const {
        const int row0 = u.pm * 256 + wr * 64 + fr; const int col0 = u.pn * 256 + wc * 32 + 8 * fq;
#pragma unroll
        for (int ai = 0; ai < 2; ++ai)
#pragma unroll
            for (int m = 0; m < 4; ++m) { bf16_t* rowp = O + (size_t)(row0 + ai * 128 + m * 16) * ldc + col0;
#pragma unroll
                for (int bj = 0; bj < 2; ++bj) *(u32x4*)(rowp + bj * 128) = pack8(acc[ai][bj][m][0], acc[ai][bj][m][1]); }
    }
};
__device__ __forceinline__ void tile_info(int pm, int& b, int& tpos0, bool& lat) { lat = pm < 64; b = lat ? (pm >> 4) : (pm - 64); tpos0 = lat ? CTXL + ((pm & 15) << 8) : 0; }
struct EpiQup {
    static constexpr bool PERM = true, FP8 = false;
    unsigned char* QM; const f32x2* cs32;
    __device__ __forceinline__ void operator()(const Acc& acc, const pg8::Unit& u, int wr, int wc, int fr, int fq) const {
        int b, tpos0; bool lat; tile_info(u.pm, b, tpos0, lat);
        const int r0 = wr * 64 + fr;
#pragma unroll
        for (int bj = 0; bj < 2; ++bj) { const int c0 = u.pn * 256 + bj * 128 + wc * 32 + 8 * fq; const int hh = c0 / 96, j0 = c0 - hh * 96;
            unsigned char* hb = QM + ((size_t)(b * 8 + hh) * TT + tpos0 + r0) * 128;
            if (j0 < 64) {
#pragma unroll
                for (int ai = 0; ai < 2; ++ai)
#pragma unroll
                    for (int m = 0; m < 4; ++m) { const f32x4 a_ = acc[ai][bj][m][0] * QSC_M, b_ = acc[ai][bj][m][1] * QSC_M; u32x2 w8; w8.x = pk4_fp8(clamp8(a_[0]), clamp8(a_[1]), clamp8(a_[2]), clamp8(a_[3])); w8.y = pk4_fp8(clamp8(b_[0]), clamp8(b_[1]), clamp8(b_[2]), clamp8(b_[3]));
                        *(u32x2*)(hb + (ai * 128 + m * 16) * 128 + j0) = w8; }
            } else { const int g8 = (j0 - 64) >> 3, part = g8 >> 1, pbase = (g8 & 1) * 4;
#pragma unroll
                for (int ai = 0; ai < 2; ++ai)
#pragma unroll
                    for (int m = 0; m < 4; ++m) { const int t = tpos0 - CTXL + r0 + ai * 128 + m * 16; const int pos = part ? (t & 63) : (t >> 6);
                        const f32x4 v0 = acc[ai][bj][m][0] * QSC_M, v1 = acc[ai][bj][m][1] * QSC_M;
                        float o1[4], o2[4]; const float x1[4] = {v0[0], v0[2], v1[0], v1[2]}, x2[4] = {v0[1], v0[3], v1[1], v1[3]};
#pragma unroll
                        for (int p = 0; p < 4; ++p) { const f32x2 cs = lat ? cs32[pos * 8 + pbase + p] : (f32x2){1.f, 0.f};
                            o1[p] = x1[p] * cs.x - x2[p] * cs.y; o2[p] = x1[p] * cs.y + x2[p] * cs.x; }
                        unsigned char* dst = hb + (ai * 128 + m * 16) * 128 + 64 + part * 16 + pbase;
                        *(unsigned*)dst = pk4_fp8(clamp8(o1[0]), clamp8(o1[1]), clamp8(o1[2]), clamp8(o1[3])); *(unsigned*)(dst + 8) = pk4_fp8(clamp8(o2[0]), clamp8(o2[1]), clamp8(o2[2]), clamp8(o2[3])); } } }
    }
};
struct EpiKvup {
    static constexpr bool PERM = true, FP8 = false;
    unsigned char* KM; unsigned char* VM;
    __device__ __forceinline__ void operator()(const Acc& acc, const pg8::Unit& u, int wr, int wc, int fr, int fq) const {
        int b, tpos0; bool lat; tile_info(u.pm, b, tpos0, lat);
        const int r0 = wr * 64 + fr; const int j0 = wc * 32 + 8 * fq;
#pragma unroll
        for (int bj = 0; bj < 2; ++bj) { const size_t tok = (size_t)(b * 8 + u.pn * 2 + bj) * TT + tpos0 + r0;
            if (j0 < 64) { unsigned char* d = KM + tok * 128 + j0;
#pragma unroll
                for (int ai = 0; ai < 2; ++ai)
#pragma unroll
                    for (int m = 0; m < 4; ++m) { const f32x4 a_ = acc[ai][bj][m][0] * KSC8, b_ = acc[ai][bj][m][1] * KSC8; u32x2 w8; w8.x = pk4_fp8(clamp8(a_[0]), clamp8(a_[1]), clamp8(a_[2]), clamp8(a_[3])); w8.y = pk4_fp8(clamp8(b_[0]), clamp8(b_[1]), clamp8(b_[2]), clamp8(b_[3]));
                        *(u32x2*)(d + (ai * 128 + m * 16) * 128) = w8; } }
            else { unsigned char* d = VM + ((size_t)(b * 8 + u.pn * 2 + bj) * 64 + (j0 - 64)) * TT;
#pragma unroll
                for (int ai = 0; ai < 2; ++ai)
#pragma unroll
                    for (int m = 0; m < 4; ++m) { const f32x4 a_ = acc[ai][bj][m][0], b_ = acc[ai][bj][m][1]; const unsigned w0_ = pk4_fp8(clamp8(a_[0]), clamp8(a_[1]), clamp8(a_[2]), clamp8(a_[3])), w1_ = pk4_fp8(clamp8(b_[0]), clamp8(b_[1]), clamp8(b_[2]), clamp8(b_[3]));
                        unsigned char* q_ = d + vt_off(tpos0 + r0 + ai * 128 + m * 16);
                        q_[0] = (unsigned char)(w0_ & 0xffu); q_[TT] = (unsigned char)((w0_ >> 8) & 0xffu); q_[2 * TT] = (unsigned char)((w0_ >> 16) & 0xffu); q_[3 * TT] = (unsigned char)(w0_ >> 24);
                        q_[4 * TT] = (unsigned char)(w1_ & 0xffu); q_[5 * TT] = (unsigned char)((w1_ >> 8) & 0xffu); q_[6 * TT] = (unsigned char)((w1_ >> 16) & 0xffu); q_[7 * TT] = (unsigned char)(w1_ >> 24); } } }
    }
};
template <int SEG> struct EpiMerge {
    static constexpr bool PERM = true, FP8 = false;
    bf16_t* MB; const bf16_t* G; unsigned char* MB8;
    __device__ __forceinline__ void operator()(const Acc& acc, const pg8::Unit& u, int wr, int wc, int fr, int fq) const {
        const int row0 = u.pm * 256 + wr * 64 + fr; const int col0 = u.pn * 256 + wc * 32 + 8 * fq;
        const bf16_t* gp = G + (size_t)row0 * NG + SEG * 2048 + col0; bf16_t* mp = MB + (size_t)row0 * D + col0; unsigned char* m8 = MB8 + (size_t)row0 * D + col0;
#pragma unroll
        for (int ai = 0; ai < 2; ++ai) {
            u32x4 gw[4][2], ow[4][2];
#pragma unroll
            for (int m = 0; m < 4; ++m)
#pragma unroll
                for (int bj = 0; bj < 2; ++bj) { const size_t ro = (size_t)(ai * 128 + m * 16);
                    gw[m][bj] = *(const u32x4*)(gp + ro * NG + bj * 128);
                    if (SEG > 0) ow[m][bj] = __builtin_nontemporal_load((const u32x4*)(mp + ro * D + bj * 128)); }
#pragma unroll
            for (int m = 0; m < 4; ++m)
#pragma unroll
                for (int bj = 0; bj < 2; ++bj) { const size_t ro = (size_t)(ai * 128 + m * 16); const u32x4 g_ = gw[m][bj];
                    f32x4 v0 = acc[ai][bj][m][0], v1 = acc[ai][bj][m][1];
                    if (ABL_BR & (1 << SEG)) { v0 = (f32x4){0.f, 0.f, 0.f, 0.f}; v1 = v0; }
                    v0[0] *= bflo(g_.x); v0[1] *= bfhi(g_.x); v0[2] *= bflo(g_.y); v0[3] *= bfhi(g_.y);
                    v1[0] *= bflo(g_.z); v1[1] *= bfhi(g_.z); v1[2] *= bflo(g_.w); v1[3] *= bfhi(g_.w);
                    if (SEG > 0) { const u32x4 o = ow[m][bj];
                        v0[0] += bflo(o.x); v0[1] += bfhi(o.x); v0[2] += bflo(o.y); v0[3] += bfhi(o.y);
                        v1[0] += bflo(o.z); v1[1] += bfhi(o.z); v1[2] += bflo(o.w); v1[3] += bfhi(o.w); }
                    if (SEG < 2) *(u32x4*)(mp + ro * D + bj * 128) = pack8(v0, v1);
                    else { u32x2 w8; w8.x = pk4_fp8(clamp8(v0[0] * 16.f), clamp8(v0[1] * 16.f), clamp8(v0[2] * 16.f), clamp8(v0[3] * 16.f)); w8.y = pk4_fp8(clamp8(v1[0] * 16.f), clamp8(v1[1] * 16.f), clamp8(v1[2] * 16.f), clamp8(v1[3] * 16.f));
                        *(u32x2*)(m8 + ro * D + bj * 128) = w8; } }
        }
    }
};
namespace pg8 {
struct Merge3 { const bf16_t* A; const bf16_t* B0; const bf16_t* B1; const bf16_t* B2; const bf16_t* G; unsigned char* MB8; float r01, r12, fin; };
template <class Sched>
__device__ __forceinline__ void gemm_merge3(LAS unsigned char* lds, const int tid, const Merge3 g, const Sched& S) {
    constexpr int GABL = 0;
    const int wid = __builtin_amdgcn_readfirstlane(tid >> 6), lane = tid & 63, wr = wid >> 2, wc = wid & 3, fr = lane & 15, fq = lane >> 4;
    constexpr int NT = 16, LDA = 1024;
    int sc1_ = 0x7F7F7F7F; asm volatile("" : "+v"(sc1_));
    unsigned voffA[2], voffB5[2], voffB10[2];
#pragma unroll
    for (int i = 0; i < 2; ++i) { int R, C; stage_rc(tid * 16 + i * 8192, R, C); const int Rb = (R & ~31) + perm32(R & 31);
        voffA[i] = (unsigned)(R * LDA + C) * 2u; voffB5[i] = (unsigned)(Rb * 256 + C) * 2u; voffB10[i] = (unsigned)(Rb * 512 + C) * 2u; }
    const size_t kstep = (size_t)(BK * 2);
    const size_t hstepA = (size_t)HALF * LDA * 2, tstepA = 2 * hstepA;
    const unsigned ldsw = (unsigned)wid * 1024u;
    const int aoff = lds_byte(wr * 64 + fr, fq * 8), boff = lds_byte(wc * 32 + fr, fq * 8);
#define M3_TA(pm_, t_) ((const char*)g.A + (size_t)(pm_) * tstepA + (size_t)(t_) * kstep)
#define M3_TB(pn_, t_) ((t_) < 4 ? (const char*)g.B0 + (size_t)(pn_) * 131072 + (size_t)(t_) * kstep : ((t_) < 8 ? (const char*)g.B1 + (size_t)(pn_) * 131072 + (size_t)((t_) - 4) * kstep : (const char*)g.B2 + (size_t)(pn_) * 262144 + (size_t)((t_) - 8) * kstep))
#define PG8_SA(b, h) (((b) * 2 + (h)) * HTB)
#define PG8_SB(b, h) ((4 + (b) * 2 + (h)) * HTB)
#define PG8_STAGE(bufoff, gbase, voff) do { if constexpr (!(GABL & 4)) _Pragma("unroll") for (int _i = 0; _i < 2; ++_i) \
        __builtin_amdgcn_global_load_lds((const unsigned*)((const char*)(gbase) + (voff)[_i]), (LAS unsigned*)(lds + (bufoff) + ldsw + _i * 8192), 16, 0, 0); } while (0)
#define PG8_LDA(dst, b, h) do { _Pragma("unroll") for (int m = 0; m < 4; ++m) { const i32x4v lo_ = *(const LAS i32x4v*)(lds + PG8_SA(b, h) + aoff + m * 2048), hi_ = *(const LAS i32x4v*)(lds + PG8_SA(b, h) + aoff + m * 2048 + 1024); dst[m] = __builtin_shufflevector(lo_, hi_, 0, 1, 2, 3, 4, 5, 6, 7); } } while (0)
#define PG8_LDB(dst, b, h) do { _Pragma("unroll") for (int n = 0; n < 2; ++n) { const i32x4v lo_ = *(const LAS i32x4v*)(lds + PG8_SB(b, h) + boff + n * 2048), hi_ = *(const LAS i32x4v*)(lds + PG8_SB(b, h) + boff + n * 2048 + 1024); dst[n] = __builtin_shufflevector(lo_, hi_, 0, 1, 2, 3, 4, 5, 6, 7); } } while (0)
#define PG8_MMA(ai, bj, At, Bt) do { __builtin_amdgcn_s_setprio(1); _Pragma("unroll") for (int m = 0; m < 4; ++m) _Pragma("unroll") for (int n = 0; n < 2; ++n) \
        asm volatile("v_mfma_scale_f32_16x16x128_f8f6f4 %0, %1, %2, %0, %3, %3 op_sel_hi:[0,0,0]" : "+v"(acc[ai][bj][m][n]) : "v"(Bt[n]), "v"(At[m]), "v"(sc1_)); __builtin_amdgcn_s_setprio(0); } while (0)
#define PG8_WAIT_V(n) asm volatile("s_waitcnt vmcnt(" #n ")" ::: "memory")
#define PG8_WAIT_L(n) asm volatile("s_waitcnt lgkmcnt(" #n ")" ::: "memory")
#define PG8_BAR __builtin_amdgcn_s_barrier()
#define PG8_SCHED __builtin_amdgcn_sched_barrier(0)
    Unit cur, nxt; int ui = 0;
    if (!S.next(0, cur)) return;
    f32x4 acc[2][2][4][2];
#pragma unroll
    for (int a = 0; a < 2; ++a)
#pragma unroll
        for (int b = 0; b < 2; ++b)
#pragma unroll
            for (int m = 0; m < 4; ++m)
#pragma unroll
                for (int n = 0; n < 2; ++n) acc[a][b][m][n] = (f32x4){0.f, 0.f, 0.f, 0.f};
    i32x8 At[4], B0[2], B1[2];
    { const char* cA = M3_TA(cur.pm, 0); const char* cB = M3_TB(cur.pn, 0); const size_t hB = 65536;
      PG8_STAGE(PG8_SB(0, 0), cB, voffB5); PG8_STAGE(PG8_SA(0, 0), cA, voffA); PG8_STAGE(PG8_SB(0, 1), cB + hB, voffB5); PG8_STAGE(PG8_SA(0, 1), cA + hstepA, voffA);
      if (wr == 1) PG8_BAR;
      PG8_WAIT_V(4); PG8_BAR;
      PG8_STAGE(PG8_SB(1, 0), cB + kstep, voffB5); PG8_STAGE(PG8_SA(1, 0), cA + kstep, voffA); PG8_STAGE(PG8_SB(1, 1), cB + hB + kstep, voffB5);
      PG8_WAIT_V(6); PG8_BAR; }
    const int r0 = wr * 64 + fr, c0l = wc * 32 + 8 * fq;
    for (;;) {
        const bool has_next = S.next(ui + 1, nxt);
        const int npm = has_next ? nxt.pm : cur.pm, npn = has_next ? nxt.pn : cur.pn;
#pragma unroll 1
        for (int t = 0; t < NT; t += 2) {
            const bool last = (t == NT - 2);
            const int t2 = last ? 0 : t + 2;
            const char* a1 = M3_TA(cur.pm, t + 1);
            const char* a2 = last ? M3_TA(npm, 0) : M3_TA(cur.pm, t + 2); const char* b2 = last ? M3_TB(npn, 0) : M3_TB(cur.pn, t + 2);
            const char* a3 = a2 + kstep; const char* b3 = b2 + kstep;
            const bool wide = t2 >= 8; const size_t hB = wide ? 131072 : 65536;
            unsigned vB[2]; vB[0] = wide ? voffB10[0] : voffB5[0]; vB[1] = wide ? voffB10[1] : voffB5[1];
            PG8_LDB(B0, 0, 0); PG8_SCHED; PG8_LDA(At, 0, 0); PG8_STAGE(PG8_SA(1, 1), a1 + hstepA, voffA);
            PG8_WAIT_L(8); PG8_BAR; PG8_WAIT_L(0); PG8_MMA(0, 0, At, B0); PG8_BAR; PG8_SCHED;
            PG8_LDB(B1, 0, 1); PG8_STAGE(PG8_SB(0, 0), b2, vB);
            PG8_BAR; PG8_WAIT_L(0); PG8_MMA(0, 1, At, B1); PG8_BAR;
            PG8_LDA(At, 0, 1); PG8_STAGE(PG8_SA(0, 0), a2, voffA);
            PG8_BAR; PG8_WAIT_L(0); PG8_MMA(1, 0, At, B0); PG8_BAR; PG8_SCHED;
            PG8_STAGE(PG8_SB(0, 1), b2 + hB, vB);
            PG8_WAIT_V(6); PG8_BAR; PG8_MMA(1, 1, At, B1); PG8_BAR;
            PG8_LDB(B0, 1, 0); PG8_SCHED; PG8_LDA(At, 1, 0); PG8_STAGE(PG8_SA(0, 1), a2 + hstepA, voffA);
            PG8_WAIT_L(8); PG8_BAR; PG8_WAIT_L(0); PG8_MMA(0, 0, At, B0); PG8_BAR; PG8_SCHED;
            PG8_LDB(B1, 1, 1); PG8_STAGE(PG8_SB(1, 0), b3, vB);
            PG8_BAR; PG8_WAIT_L(0); PG8_MMA(0, 1, At, B1); PG8_BAR;
            PG8_LDA(At, 1, 1); PG8_STAGE(PG8_SA(1, 0), a3, voffA);
            PG8_BAR; PG8_WAIT_L(0); PG8_MMA(1, 0, At, B0); PG8_BAR; PG8_SCHED;
            PG8_STAGE(PG8_SB(1, 1), b3 + hB, vB);
            PG8_WAIT_V(6); PG8_BAR; PG8_MMA(1, 1, At, B1); PG8_BAR;
            if (t == 2 || t == 6) {
                asm volatile("s_nop 15\n\ts_nop 15" ::: "memory");
                const int sg = t == 2 ? 0 : 1; const float wr_ = sg ? g.r12 : g.r01;
                const unsigned char* gp = (const unsigned char*)g.G + (size_t)(cur.pm * 256 + r0) * NG + sg * 2048 + cur.pn * 256 + c0l;
#pragma unroll
                for (int ai = 0; ai < 2; ++ai) { u32x2 ga[4][2], gb[4][2];
#pragma unroll
                    for (int m = 0; m < 4; ++m)
#pragma unroll
                        for (int bj = 0; bj < 2; ++bj) { const unsigned char* q_ = gp + (size_t)(ai * 128 + m * 16) * NG + bj * 128; ga[m][bj] = *(const u32x2*)q_; gb[m][bj] = *(const u32x2*)(q_ + 2048); }
#pragma unroll
                    for (int m = 0; m < 4; ++m)
#pragma unroll
                        for (int bj = 0; bj < 2; ++bj) { const u32x2 x_ = ga[m][bj], y_ = gb[m][bj];
#define M3_RT2(xw, yw, HI, E) (fmaxf(__builtin_amdgcn_cvt_pk_f32_fp8(xw, HI)[E], 0.0009765625f) * wr_ * __builtin_amdgcn_rcpf(fmaxf(__builtin_amdgcn_cvt_pk_f32_fp8(yw, HI)[E], 0.0009765625f)))
                            acc[ai][bj][m][0][0] *= M3_RT2(x_.x, y_.x, false, 0); acc[ai][bj][m][0][1] *= M3_RT2(x_.x, y_.x, false, 1); acc[ai][bj][m][0][2] *= M3_RT2(x_.x, y_.x, true, 0); acc[ai][bj][m][0][3] *= M3_RT2(x_.x, y_.x, true, 1);
                            acc[ai][bj][m][1][0] *= M3_RT2(x_.y, y_.y, false, 0); acc[ai][bj][m][1][1] *= M3_RT2(x_.y, y_.y, false, 1); acc[ai][bj][m][1][2] *= M3_RT2(x_.y, y_.y, true, 0); acc[ai][bj][m][1][3] *= M3_RT2(x_.y, y_.y, true, 1); } }
                asm volatile("s_waitcnt vmcnt(0)" ::: "memory");
            }
        }
        asm volatile("s_nop 15\n\ts_nop 15" ::: "memory");
        { const unsigned char* gp = (const unsigned char*)g.G + (size_t)(cur.pm * 256 + r0) * NG + 2 * 2048 + cur.pn * 256 + c0l; unsigned char* m8 = g.MB8 + (size_t)(cur.pm * 256 + r0) * D + cur.pn * 256 + c0l;
          u32x2 gc[2][4][2];
#pragma unroll
          for (int ai = 0; ai < 2; ++ai)
#pragma unroll
              for (int m = 0; m < 4; ++m)
#pragma unroll
                  for (int bj = 0; bj < 2; ++bj) gc[ai][m][bj] = *(const u32x2*)(gp + (size_t)(ai * 128 + m * 16) * NG + bj * 128);
          const float f_ = g.fin * (1.f / 256.f);
#define M3_G(w, HI, E) (fmaxf(__builtin_amdgcn_cvt_pk_f32_fp8(w, HI)[E], 0.0009765625f) * f_)
#pragma unroll
          for (int ai = 0; ai < 2; ++ai)
#pragma unroll
              for (int m = 0; m < 4; ++m)
#pragma unroll
                  for (int bj = 0; bj < 2; ++bj) { const u32x2 z_ = gc[ai][m][bj]; const f32x4 v0 = acc[ai][bj][m][0], v1 = acc[ai][bj][m][1];
                      u32x2 w8;
                      w8.x = pk4_fp8(clamp8(v0[0] * M3_G(z_.x, false, 0)), clamp8(v0[1] * M3_G(z_.x, false, 1)), clamp8(v0[2] * M3_G(z_.x, true, 0)), clamp8(v0[3] * M3_G(z_.x, true, 1)));
                      w8.y = pk4_fp8(clamp8(v1[0] * M3_G(z_.y, false, 0)), clamp8(v1[1] * M3_G(z_.y, false, 1)), clamp8(v1[2] * M3_G(z_.y, true, 0)), clamp8(v1[3] * M3_G(z_.y, true, 1)));
                      *(u32x2*)(m8 + (size_t)(ai * 128 + m * 16) * D + bj * 128) = w8; } }
        if (!has_next) break;
#pragma unroll
        for (int a = 0; a < 2; ++a)
#pragma unroll
            for (int b = 0; b < 2; ++b)
#pragma unroll
                for (int m = 0; m < 4; ++m)
#pragma unroll
                    for (int n = 0; n < 2; ++n) acc[a][b][m][n] = (f32x4){0.f, 0.f, 0.f, 0.f};
        cur = nxt; ++ui;
    }
    PG8_WAIT_V(0);
    if (wr == 0) PG8_BAR;
    PG8_BAR;
#undef M3_RT2
#undef M3_G
#undef M3_TA
#undef M3_TB
#undef PG8_SA
#undef PG8_SB
#undef PG8_STAGE
#undef PG8_LDA
#undef PG8_LDB
#undef PG8_MMA
#undef PG8_WAIT_V
#undef PG8_WAIT_L
#undef PG8_BAR
#undef PG8_SCHED
}
}
struct EpiOut {
    static constexpr bool PERM = false, FP8 = true;
    const float* src_lat; const float* src_ctx; float* dst_lat; float* dst_ctx; const float* g1; float inv;
    __device__ __forceinline__ void operator()(const Acc& acc, const pg8::Unit& u, int wr, int wc, int fr, int fq) const {
        const int row0 = u.pm * 256 + wr * 64 + fr; const int col0 = u.pn * 256 + wc * 32 + 4 * fq;
        const bool lat = (u.pm * 256) < NLAT;
        const float* src = (lat ? src_lat : src_ctx - (size_t)NLAT * D) + (size_t)row0 * D + col0; float* dst = (lat ? dst_lat : dst_ctx - (size_t)NLAT * D) + (size_t)row0 * D + col0;
#pragma unroll
        for (int ai = 0; ai < 2; ++ai) { const int rbase = u.pm * 256 + ai * 128 + wr * 64; const int v = lat ? (rbase >> 12) : 4; const float* gp = g1 + (size_t)v * 12288 + col0;
            f32x4 gg[2][2];
#pragma unroll
            for (int bj = 0; bj < 2; ++bj)
#pragma unroll
                for (int n = 0; n < 2; ++n) gg[bj][n] = *(const f32x4*)(gp + bj * 128 + n * 16);
#pragma unroll
            for (int mh = 0; mh < 2; ++mh) {
                f32x4 xr[2][2][2];
#pragma unroll
                for (int mm = 0; mm < 2; ++mm)
#pragma unroll
                    for (int bj = 0; bj < 2; ++bj)
#pragma unroll
                        for (int n = 0; n < 2; ++n) xr[mm][bj][n] = __builtin_nontemporal_load((const f32x4*)(src + (size_t)(ai * 128 + (mh * 2 + mm) * 16) * D + bj * 128 + n * 16));
#pragma unroll
                for (int mm = 0; mm < 2; ++mm)
#pragma unroll
                    for (int bj = 0; bj < 2; ++bj)
#pragma unroll
                        for (int n = 0; n < 2; ++n) { const int m = mh * 2 + mm;
                            *(f32x4*)(dst + (size_t)(ai * 128 + m * 16) * D + bj * 128 + n * 16) = ABL_MIX ? xr[mm][bj][n] * ALPHA : xr[mm][bj][n] * ALPHA + gg[bj][n] * (acc[ai][bj][m][n] * inv); } } }
    }
};

struct Args { const float* in[27]; float* out; unsigned char* ws; int ph_lo, ph_hi; };
typedef const Args __attribute__((address_space(4)))* ArgP;
struct Frame {
    LAS unsigned char* lds; int tid, lane, wave, G, bid;
    ArgP ap; float* out; unsigned char* ws;
    __device__ __forceinline__ const float* in(int i) const { return ap->in[i]; }
};
__device__ __forceinline__ Frame make_frame(ArgP ap) {
    { unsigned long long t = (unsigned long long)ap; asm volatile("" : "+s"(t)); ap = (ArgP)t; }
    extern __shared__ __attribute__((aligned(16))) unsigned char lds_raw[];
    Frame F; F.lds = (LAS unsigned char*)lds_raw; { int t_ = threadIdx.x; asm volatile("" : "+v"(t_)); F.tid = t_; }
    F.lane = F.tid & 63; F.wave = __builtin_amdgcn_readfirstlane(F.tid >> 6); F.G = gridDim.x; F.bid = blockIdx.x;
    F.ap = ap; F.out = ap->out; F.ws = ap->ws; return F;
}
template <class T> __device__ __forceinline__ T* wsp(const Frame& F, size_t off) { return (T*)(F.ws + off); }

__device__ __forceinline__ int win_col(int n) {
    if (n < 768) return n;
    if (n < 1792) return 2336 + (n - 768);
    if (n < 2048) return 3360 + (n - 1792);
    if (n < 2304) return 3616 + (n - 2048);
    if (n < 2560) return 800 + (n - 2304);
    if (n < 2816) return 1056 + (n - 2560);
    if (n < 3328) return 1312 + (n - 2816);
    if (n < 3840) return 1824 + (n - 3328);
    if (n < 3872) return 768 + (n - 3840);
    if (n < 4096) return -1;
    return 3872 + (n - 4096);
}
__device__ __forceinline__ int qup_col(int c) {
    const int hh = c / 96, j = c - hh * 96;
    if (j < 64) return c;
    const int jj = j - 64, g8 = jj >> 3, i = jj & 7, p = i >> 1, which = i & 1, part = g8 >> 1, pi = (g8 & 1) * 4 + p;
    return hh * 96 + 64 + part * 16 + which * 8 + pi;
}
template <int MAP>
__device__ __forceinline__ void transpose_cvt(const Frame& F, const float* __restrict__ src, bf16_t* __restrict__ dst, int K, int Nsrc, int Nd) {
    LAS float* tile = (LAS float*)F.lds;
    const int tk = K / 256, tn = Nd / 64, ntile = tk * tn;
    for (int t = F.bid; t < ntile; t += F.G) {
        const int k0 = (t % tk) * 256, n0 = (t / tk) * 64;
        const int nl = F.tid & 63, kq = F.tid >> 6;
        const int nd = n0 + nl; const int ns = MAP == 0 ? nd : (MAP == 1 ? win_col(nd) : qup_col(nd));
        float v[32];
#pragma unroll
        for (int i = 0; i < 32; ++i) v[i] = ns >= 0 ? src[(size_t)(k0 + kq + 8 * i) * Nsrc + ns] : 0.f;
#pragma unroll
        for (int i = 0; i < 32; ++i) tile[(kq + 8 * i) * 65 + nl] = v[i];
        __syncthreads();
        { const int n = F.tid >> 3, k32 = (F.tid & 7) * 32;
#pragma unroll
          for (int c = 0; c < 4; ++c) { float w[8];
#pragma unroll
              for (int j = 0; j < 8; ++j) w[j] = tile[(k32 + c * 8 + j) * 65 + n];
              u32x4 o; o.x = cvt_pk_bf16(w[0], w[1]); o.y = cvt_pk_bf16(w[2], w[3]); o.z = cvt_pk_bf16(w[4], w[5]); o.w = cvt_pk_bf16(w[6], w[7]);
              *(u32x4*)(dst + (size_t)(n0 + n) * K + k0 + k32 + c * 8) = o; } }
        __syncthreads();
    }
}
__device__ __forceinline__ void cvt_rows(const Frame& F, const float* __restrict__ src, bf16_t* __restrict__ dst, size_t n8) {
    for (size_t i = (size_t)F.bid * 512 + F.tid; i < n8; i += (size_t)F.G * 512) {
        const f32x4 a = __builtin_nontemporal_load((const f32x4*)(src + i * 8)), b = __builtin_nontemporal_load((const f32x4*)(src + i * 8 + 4));
        *(u32x4*)(dst + i * 8) = pack8(a, b);
    }
}
__device__ __forceinline__ void cvt_peer(const Frame& F, int l);
__device__ __forceinline__ float max4abs(float am, const f32x4 a) { return fmaxf(fmaxf(fmaxf(am, fabsf(a[0])), fabsf(a[1])), fmaxf(fabsf(a[2]), fabsf(a[3]))); }
__device__ __forceinline__ void absmax_commit(const Frame& F, float am, unsigned* dst) {
    am = row16_max(am);
    { auto r = __builtin_amdgcn_permlane16_swap(__float_as_uint(am), __float_as_uint(am), false, false); am = fmaxf(__uint_as_float(r[0]), __uint_as_float(r[1])); }
    { auto r = __builtin_amdgcn_permlane32_swap(__float_as_uint(am), __float_as_uint(am), false, false); am = fmaxf(__uint_as_float(r[0]), __uint_as_float(r[1])); }
    if (F.lane == 0) atomicMax(dst, __float_as_uint(am));
}
template <int NB>
__device__ __forceinline__ void absmax_f32(const Frame& F, const float* __restrict__ src, size_t n4, unsigned* dst) {
    float am = 0.f;
    const size_t stride = (size_t)F.G * 512; size_t i = (size_t)F.bid * 512 + F.tid;
    for (; i < n4; i += NB * stride) { f32x4 a[NB];
#pragma unroll
        for (int j = 0; j < NB; ++j) { const size_t ix = i + j * stride; a[j] = ix < n4 ? __builtin_nontemporal_load((const f32x4*)(src + ix * 4)) : (f32x4){0.f, 0.f, 0.f, 0.f}; }
#pragma unroll
        for (int j = 0; j < NB; ++j) am = max4abs(am, a[j]); }
    absmax_commit(F, am, dst);
}
__device__ __forceinline__ void absmax4_f32(const Frame& F, const float* s0, size_t n0, unsigned* d0, const float* s1, size_t n1, unsigned* d1, const float* s2, size_t n2, unsigned* d2, const float* s3, size_t n3, unsigned* d3) {
    const size_t stride = (size_t)F.G * 512, i0 = (size_t)F.bid * 512 + F.tid;
    f32x4 a0[2], a1[2], a2[4], a3[8];
#define AM4_LD(a, NB, s, n) _Pragma("unroll") for (int j = 0; j < NB; ++j) { const size_t ix = i0 + j * stride; a[j] = ix < n ? __builtin_nontemporal_load((const f32x4*)(s + ix * 4)) : (f32x4){0.f, 0.f, 0.f, 0.f}; }
    AM4_LD(a0, 2, s0, n0) AM4_LD(a1, 2, s1, n1) AM4_LD(a2, 4, s2, n2) AM4_LD(a3, 8, s3, n3)
#undef AM4_LD
#define AM4_RED(a, NB, s, n, d) { float am = 0.f; _Pragma("unroll") for (int j = 0; j < NB; ++j) am = max4abs(am, a[j]); \
        for (size_t i = i0 + NB * stride; i < n; i += stride) am = max4abs(am, *(const f32x4*)(s + i * 4)); absmax_commit(F, am, d); }
    AM4_RED(a0, 2, s0, n0, d0) AM4_RED(a1, 2, s1, n1, d1) AM4_RED(a2, 4, s2, n2, d2) AM4_RED(a3, 8, s3, n3, d3)
#undef AM4_RED
}
template <int MAP>
__device__ __forceinline__ void transpose_fp8(const Frame& F, const float* __restrict__ src, unsigned char* __restrict__ dst, int K, int Nsrc, int Nd, const unsigned* wsc) {
    float mul, inv; fp8_scale(__hip_atomic_load(wsc, __ATOMIC_RELAXED, __HIP_MEMORY_SCOPE_AGENT), mul, inv);
    LAS float* tile = (LAS float*)F.lds;
    const int tk = K / 256, tn = Nd / 64, ntile = tk * tn;
    for (int t = F.bid; t < ntile; t += F.G) {
        const int k0 = (t % tk) * 256, n0 = (t / tk) * 64;
        const int nl = F.tid & 63, kq = F.tid >> 6; const int ns = MAP ? win_col(n0 + nl) : n0 + nl;
        float v[32];
#pragma unroll
        for (int i = 0; i < 32; ++i) v[i] = ns >= 0 ? src[(size_t)(k0 + kq + 8 * i) * Nsrc + ns] : 0.f;
#pragma unroll
        for (int i = 0; i < 32; ++i) tile[(kq + 8 * i) * 65 + nl] = v[i] * mul;
        __syncthreads();
        { const int n = F.tid >> 3, k32 = (F.tid & 7) * 32;
#pragma unroll
          for (int c = 0; c < 2; ++c) { float w[16];
#pragma unroll
              for (int j = 0; j < 16; ++j) w[j] = tile[(k32 + c * 16 + j) * 65 + n];
              u32x4 o; o.x = pk4_fp8(w[0], w[1], w[2], w[3]); o.y = pk4_fp8(w[4], w[5], w[6], w[7]); o.z = pk4_fp8(w[8], w[9], w[10], w[11]); o.w = pk4_fp8(w[12], w[13], w[14], w[15]);
              *(u32x4*)(dst + (size_t)(n0 + n) * K + k0 + k32 + c * 16) = o; } }
        __syncthreads();
    }
}
template <int PART = 7>
__device__ __forceinline__ void p0_prologue(const Frame& F) {
    { const int gi = F.bid * 512 + F.tid;
      if (gi < 64 * 8) { const int pos = gi >> 3, f = gi & 7; const float inv = powf(10000.f, -(float)f / 8.f); const float a = (float)pos * inv; wsp<f32x2>(F, WS_ROPE32)[gi] = (f32x2){cosf(a), sinf(a)}; }
      else if (gi < 64 * 8 + 64 * 32) { const int g2 = gi - 512; const int pos = g2 >> 5, f = g2 & 31; const float inv = powf(10000.f, -(float)f / 32.f); const float a = (float)pos * inv; wsp<f32x2>(F, WS_ROPE128)[g2] = (f32x2){cosf(a), sinf(a)}; } }
    if (F.bid == 0 && F.tid < 32) wsp<float>(F, WS_DEC)[F.tid] = -log1pf(expf(-F.in(11)[F.tid])) * LOG2E;
#pragma unroll 1
    for (int s3 = 0; s3 < 3; ++s3) { const int part = (s3 + F.bid) % 3;
    if ((PART & 1) && part == 0) { LAS float* sl = (LAS float*)F.lds;
      float* modp = wsp<float>(F, WS_MODP);
      for (int u = F.bid; u < 2 * 24 * 16; u += F.G) {
          const int kc = u & 15, cb = (u >> 4) % 24, l = u / (16 * 24);
          __syncthreads();
          for (int i = F.tid; i < 640; i += 512) { const int v = i >> 7, k = kc * 128 + (i & 127); const float c = v < 4 ? F.in(1)[v * 2048 + k] : F.in(3)[k]; sl[i] = silu_f(c); }
          __syncthreads();
          const int col = cb * 512 + F.tid; const float* w = F.in(4) + ((size_t)l * 2048 + kc * 128) * 12288 + col;
          float a0 = 0.f, a1 = 0.f, a2 = 0.f, a3 = 0.f, a4 = 0.f;
#pragma unroll 32
          for (int k = 0; k < 128; ++k) { const float wv = w[(size_t)k * 12288]; a0 += sl[k] * wv; a1 += sl[128 + k] * wv; a2 += sl[256 + k] * wv; a3 += sl[384 + k] * wv; a4 += sl[512 + k] * wv; }
          float* o = modp + ((size_t)(kc * 2 + l) * 5) * 12288 + col;
          o[0] = a0; o[12288] = a1; o[2 * 12288] = a2; o[3 * 12288] = a3; o[4 * 12288] = a4;
      }
      __syncthreads(); }
    if ((PART & 2) && part == 1) for (int l = 0; l < 2; ++l) {
        absmax_f32<16>(F, F.in(6) + (size_t)l * 2048 * NIN, (size_t)2048 * NIN / 4, wsp<unsigned>(F, WS_WSC) + l);
        absmax4_f32(F, F.in(14) + (size_t)l * 512 * 2048, (size_t)512 * 2048 / 4, wsp<unsigned>(F, WS_WSC) + 4 + l, F.in(15) + (size_t)l * 512 * 2048, (size_t)512 * 2048 / 4, wsp<unsigned>(F, WS_WSC) + 6 + l,
                    F.in(16) + (size_t)l * 1024 * 2048, (size_t)1024 * 2048 / 4, wsp<unsigned>(F, WS_WSC) + 8 + l, F.in(17) + (size_t)l * 2048 * 2048, (size_t)2048 * 2048 / 4, wsp<unsigned>(F, WS_WSC) + 2 + l);
        transpose_cvt<2>(F, F.in(8) + (size_t)l * 512 * 768, wsp<bf16_t>(F, WS_WQUP + l * SZ_WQUP), 512, 768, 768);
        transpose_cvt<0>(F, F.in(10) + (size_t)l * 256 * 1024, wsp<bf16_t>(F, WS_WKVUP + l * SZ_WKVUP), 256, 1024, 1024);
        transpose_cvt<0>(F, F.in(20) + (size_t)l * 2048 * 1024, wsp<bf16_t>(F, WS_WPQ + l * SZ_WPQ), 2048, 1024, 1024);
    }
    if ((PART & 4) && part == 2) cvt_peer(F, 0);
    }
}
__device__ __forceinline__ void p1_modreduce(const Frame& F) {
    const float* modp = wsp<float>(F, WS_MODP); float* mod = wsp<float>(F, WS_MOD);
    for (int i = F.bid * 512 + F.tid; i < 2 * 5 * 12288; i += F.G * 512) {
        const int j = i % 12288, l = i / (5 * 12288);
        float s = F.in(5)[l * 12288 + j];
#pragma unroll
        for (int kc = 0; kc < 16; ++kc) s += modp[(size_t)kc * (2 * 5 * 12288) + i];
        mod[i] = s;
    }
    for (int l = 0; l < 2; ++l) {
        transpose_fp8<1>(F, F.in(6) + (size_t)l * 2048 * NIN, wsp<unsigned char>(F, WS_WIN + l * SZ_WIN), 2048, NIN, NPT, wsp<unsigned>(F, WS_WSC) + l);
        transpose_fp8<0>(F, F.in(17) + (size_t)l * 2048 * 2048, wsp<unsigned char>(F, WS_WOUT + l * SZ_WOUT), 2048, 2048, 2048, wsp<unsigned>(F, WS_WSC) + 2 + l);
        transpose_fp8<0>(F, F.in(14) + (size_t)l * 512 * 2048, wsp<unsigned char>(F, WS_WBRA + l * SZ_WBRA), 512, 2048, 2048, wsp<unsigned>(F, WS_WSC) + 4 + l);
        transpose_fp8<0>(F, F.in(15) + (size_t)l * 512 * 2048, wsp<unsigned char>(F, WS_WBRB + l * SZ_WBRB), 512, 2048, 2048, wsp<unsigned>(F, WS_WSC) + 6 + l);
        transpose_fp8<0>(F, F.in(16) + (size_t)l * 1024 * 2048, wsp<unsigned char>(F, WS_WBRC + l * SZ_WBRC), 1024, 2048, 2048, wsp<unsigned>(F, WS_WSC) + 8 + l);
    }
}
__device__ __forceinline__ void ld_row_f32(const float* p, int lane, float (&x)[32]) {
#pragma unroll
    for (int q = 0; q < 4; ++q) { const f32x4 a = *(const f32x4*)(p + 512 * q + 8 * lane), b = *(const f32x4*)(p + 512 * q + 8 * lane + 4);
        x[q * 8 + 0] = a[0]; x[q * 8 + 1] = a[1]; x[q * 8 + 2] = a[2]; x[q * 8 + 3] = a[3]; x[q * 8 + 4] = b[0]; x[q * 8 + 5] = b[1]; x[q * 8 + 6] = b[2]; x[q * 8 + 7] = b[3]; }
}
__device__ __forceinline__ void st_row_f32(float* p, int lane, const float (&x)[32]) {
#pragma unroll
    for (int q = 0; q < 4; ++q) { *(f32x4*)(p + 512 * q + 8 * lane) = (f32x4){x[q * 8 + 0], x[q * 8 + 1], x[q * 8 + 2], x[q * 8 + 3]}; *(f32x4*)(p + 512 * q + 8 * lane + 4) = (f32x4){x[q * 8 + 4], x[q * 8 + 5], x[q * 8 + 6], x[q * 8 + 7]}; }
}
__device__ __forceinline__ void st_row_bf16(bf16_t* p, int lane, const float (&x)[32]) {
#pragma unroll
    for (int q = 0; q < 4; ++q) { u32x4 w; w.x = cvt_pk_bf16(x[q * 8 + 0], x[q * 8 + 1]); w.y = cvt_pk_bf16(x[q * 8 + 2], x[q * 8 + 3]); w.z = cvt_pk_bf16(x[q * 8 + 4], x[q * 8 + 5]); w.w = cvt_pk_bf16(x[q * 8 + 6], x[q * 8 + 7]);
        *(u32x4*)(p + 512 * q + 8 * lane) = w; }
}
__device__ __forceinline__ void p_modulate0(const Frame& F) {
    const float* mod = wsp<float>(F, WS_MOD); unsigned char* hb8 = wsp<unsigned char>(F, WS_HB8);
    for (int row = F.bid * 8 + F.wave; row < NROW; row += F.G * 8) {
        const RowInfo ri = rowinfo(row);
        const float* xp = ri.lat ? F.in(0) + (size_t)row * D : F.in(2) + (size_t)(row - NLAT) * D;
        const float* mp = mod + (size_t)ri.v * 12288;
        float x[32], sh[32], sc[32];
        ld_row_f32(xp, F.lane, x); ld_row_f32(mp, F.lane, sh); ld_row_f32(mp + 2048, F.lane, sc);
#pragma unroll
        for (int i = 0; i < 32; ++i) x[i] = clamp8(x[i] * (1.f + sc[i]) + sh[i]);
#pragma unroll
        for (int q = 0; q < 4; ++q) { u32x2 w; w.x = pk4_fp8(x[q * 8 + 0], x[q * 8 + 1], x[q * 8 + 2], x[q * 8 + 3]); w.y = pk4_fp8(x[q * 8 + 4], x[q * 8 + 5], x[q * 8 + 6], x[q * 8 + 7]); *(u32x2*)(hb8 + (size_t)row * D + 512 * q + 8 * F.lane) = w; }
    }
}
__device__ __forceinline__ void p_post(const Frame& F, int l) {
    const bf16_t* P1 = wsp<bf16_t>(F, WS_P1);
    bf16_t* CQN = wsp<bf16_t>(F, WS_CQN); bf16_t* CKVN = wsp<bf16_t>(F, WS_CKVN);
    unsigned char* QG = wsp<unsigned char>(F, WS_QG); unsigned char* KG = wsp<unsigned char>(F, WS_KG); unsigned char* VG = wsp<unsigned char>(F, WS_VG);
    bf16_t* RQ = wsp<bf16_t>(F, WS_RQ); bf16_t* RK = wsp<bf16_t>(F, WS_RK); bf16_t* RV = wsp<bf16_t>(F, WS_RV);
    unsigned char* KM = wsp<unsigned char>(F, WS_KM); unsigned char* QM = wsp<unsigned char>(F, WS_QM);
    const f32x2* cs32 = wsp<f32x2>(F, WS_ROPE32); const f32x2* cs128 = wsp<f32x2>(F, WS_ROPE128);
    const float* gq_n = F.in(7) + l * 512; const float* gkv_n = F.in(9) + l * 256; const float* gqa_qn = F.in(12) + l * 128; const float* gqa_kn = F.in(13) + l * 128;
    LAS bf16_t* rs = (LAS bf16_t*)(F.lds + F.wave * 8192);
    const int lane = F.lane;
    const f32x4 gq0 = *(const f32x4*)(gq_n + lane * 8), gq1 = *(const f32x4*)(gq_n + lane * 8 + 4), gkv0 = *(const f32x4*)(gkv_n + lane * 4);
    const int gd0 = 2 * lane; const int gpart = gd0 >> 6, gdd = gd0 & 63; const bool glo = gdd < 32; const int gf = glo ? gdd : gdd - 32; const int gdp = glo ? gd0 + 32 : gd0 - 32;
    const float qn0 = gqa_qn[gd0], qn1 = gqa_qn[gd0 + 1], qnp0 = gqa_qn[gdp], qnp1 = gqa_qn[gdp + 1];
    const float kn0 = gqa_kn[gd0], kn1 = gqa_kn[gd0 + 1], knp0 = gqa_kn[gdp], knp1 = gqa_kn[gdp + 1];
    const int rhh = lane >> 3, rd0 = (lane & 7) * 4; const int rpart = rd0 >> 4, rdd = rd0 & 15; const bool rlo = rdd < 8; const int rf = rlo ? rdd : rdd - 8; const int rdp = rlo ? rd0 + 8 : rd0 - 8;
    const int step = F.G * 8;
    int row = F.bid * 8 + F.wave;
    u32x4 pre[8];
    if (row < NROW) {
#pragma unroll
        for (int q = 0; q < 8; ++q) pre[q] = *(const u32x4*)(P1 + (size_t)row * NP1 + q * 512 + lane * 8); }
#pragma unroll 1
    for (; row < NROW; row += step) {
        const RowInfo ri = rowinfo(row);
        const int posg = gpart ? ri.pc : ri.pr, posr = rpart ? ri.pc : ri.pr;
        const f32x2 one = {1.f, 0.f};
        const f32x2 csA = ri.lat ? cs128[posg * 32 + gf] : one, csB = ri.lat ? cs128[posg * 32 + gf + 1] : one;
        f32x2 cs[4];
#pragma unroll
        for (int i = 0; i < 4; ++i) cs[i] = ri.lat ? cs32[posr * 8 + rf + i] : one;
#pragma unroll
        for (int q = 0; q < 8; ++q) *(LAS u32x4*)(rs + q * 512 + lane * 8) = pre[q];
        { const int nrow = row + step; if (nrow < NROW) {
#pragma unroll
            for (int q = 0; q < 8; ++q) pre[q] = *(const u32x4*)(P1 + (size_t)nrow * NP1 + q * 512 + lane * 8); } }
        asm volatile("s_waitcnt lgkmcnt(0)" ::: "memory");
        { float x[8]; float ss = 0.f;
#pragma unroll
          for (int i = 0; i < 8; ++i) { x[i] = bf2f(rs[C_CQ + lane * 8 + i]); ss += x[i] * x[i]; }
          ss = wave_sum(ss); const float r = rsqrtf(ss * (1.f / 512.f) + RMS_EPS);
          *(u32x4*)(CQN + (size_t)row * 512 + lane * 8) = pack8((f32x4){x[0] * r * gq0[0], x[1] * r * gq0[1], x[2] * r * gq0[2], x[3] * r * gq0[3]}, (f32x4){x[4] * r * gq1[0], x[5] * r * gq1[1], x[6] * r * gq1[2], x[7] * r * gq1[3]}); }
        { float x[4]; float ss = 0.f;
#pragma unroll
          for (int i = 0; i < 4; ++i) { x[i] = bf2f(rs[C_CKV + lane * 4 + i]); ss += x[i] * x[i]; }
          ss = wave_sum(ss); const float r = rsqrtf(ss * (1.f / 256.f) + RMS_EPS);
          u32x2 w; w.x = cvt_pk_bf16(x[0] * r * gkv0[0], x[1] * r * gkv0[1]); w.y = cvt_pk_bf16(x[2] * r * gkv0[2], x[3] * r * gkv0[3]);
          *(u32x2*)(CKVN + (size_t)row * 256 + lane * 4) = w; }
        {
            const int d0 = gd0, dp = gdp; const bool lo = glo;
#pragma unroll 1
            for (int hh = 0; hh < 10; ++hh) {
                const bool isq = hh < 8; const int cbase = isq ? C_GQ + hh * 128 : C_GK + (hh - 8) * 128;
                const float g0 = isq ? qn0 : kn0, g1 = isq ? qn1 : kn1, gp0 = isq ? qnp0 : knp0, gp1 = isq ? qnp1 : knp1;
                const float a0 = bf2f(rs[cbase + d0]), a1 = bf2f(rs[cbase + d0 + 1]);
                float ss = wave_sum(a0 * a0 + a1 * a1); const float r = rsqrtf(ss * (1.f / 128.f) + RMS_EPS);
                const float n0 = a0 * r * g0, n1 = a1 * r * g1;
                const float p0 = bf2f(rs[cbase + dp]) * r * gp0, p1 = bf2f(rs[cbase + dp + 1]) * r * gp1;
                float o0, o1;
                if (lo) { o0 = n0 * csA.x - p0 * csA.y; o1 = n1 * csB.x - p1 * csB.y; }
                else    { o0 = p0 * csA.y + n0 * csA.x; o1 = p1 * csB.y + n1 * csB.x; }
                unsigned char* dst = isq ? QG + ((size_t)(ri.b * 8 + hh) * TT + ri.tpos) * 128 : KG + ((size_t)(ri.b * 2 + (hh - 8)) * TT + ri.tpos) * 128;
                const float sc8_ = isq ? QSC_G : KSC8;
                *(unsigned short*)(dst + d0) = (unsigned short)(pk4_fp8(clamp8(o0 * sc8_), clamp8(o1 * sc8_), 0.f, 0.f) & 0xffffu);
            }
#pragma unroll
            for (int hh = 0; hh < 2; ++hh) { const unsigned w8_ = pk4_fp8(clamp8(bf2f(rs[C_GV + hh * 128 + d0])), clamp8(bf2f(rs[C_GV + hh * 128 + d0 + 1])), 0.f, 0.f); unsigned char* vp_ = VG + ((size_t)(ri.b * 2 + hh) * 128 + d0) * TT + vt_off(ri.tpos);
                vp_[0] = (unsigned char)(w8_ & 0xffu); vp_[TT] = (unsigned char)((w8_ >> 8) & 0xffu); }
        }
        {
            const int hh = rhh, d0 = rd0, dp = rdp; const bool lo = rlo;
#pragma unroll
            for (int which = 0; which < 2; ++which) {
                const int cbase = (which ? C_RK : C_RQ) + hh * 32; const float sc = which ? 0.17677669529663687f : 1.f;
                float o[4];
#pragma unroll
                for (int i = 0; i < 4; ++i) { const float n = bf2f(rs[cbase + d0 + i]), p = bf2f(rs[cbase + dp + i]);
                    o[i] = (lo ? (n * cs[i].x - p * cs[i].y) : (p * cs[i].y + n * cs[i].x)) * sc; }
                u32x2 w; w.x = cvt_pk_bf16(o[0], o[1]); w.y = cvt_pk_bf16(o[2], o[3]);
                *(u32x2*)((which ? RK : RQ) + ((size_t)(ri.b * 8 + hh) * TT + ri.tpos) * 32 + d0) = w;
            }
            { const int vh = lane >> 3, e0 = (lane & 7) * 8;
              *(u32x4*)(RV + ((size_t)(ri.b * 8 + vh) * TT + ri.tpos) * 64 + e0) = *(LAS u32x4*)(rs + C_RV + lane * 8); }
            { float o[4];
#pragma unroll
              for (int i = 0; i < 4; ++i) { const float n = bf2f(rs[C_KR + d0 + i]), p = bf2f(rs[C_KR + dp + i]); o[i] = lo ? (n * cs[i].x - p * cs[i].y) : (p * cs[i].y + n * cs[i].x); }
              const size_t tok_ = ((size_t)(ri.b * 8 + hh) * TT + ri.tpos) * 128;
              *(unsigned*)(KM + tok_ + 64 + d0) = pk4_fp8(clamp8(o[0] * KSC8), clamp8(o[1] * KSC8), clamp8(o[2] * KSC8), clamp8(o[3] * KSC8));
              *(unsigned*)(KM + tok_ + 96 + d0) = 0u; *(unsigned*)(QM + tok_ + 96 + d0) = 0u; }
        }
        asm volatile("s_waitcnt lgkmcnt(0)" ::: "memory");
    }
}

__device__ __forceinline__ void ret_logs(const Frame& F, int l, int h, float& lgf, float& lgb) {
    const float* t = wsp<float>(F, WS_DEC); lgf = t[(l * 2 + 0) * 8 + h]; lgb = t[(l * 2 + 1) * 8 + h];
}
constexpr int TP = 136;
template <bool WITH_K>
__device__ __forceinline__ void ret_stage(const Frame& F, const bf16_t* RKh, const bf16_t* RVh, int tpos0, float lgf, float lgb, LAS bf16_t* vt, LAS bf16_t* ktf, LAS bf16_t* ktb) {
#pragma unroll
    for (int i = 0; i < 2; ++i) { const int tok = (F.tid >> 3) + 64 * i, e0 = (F.tid & 7) * 8;
        const u32x4 w = *(const u32x4*)(RVh + (size_t)(tpos0 + tok) * 64 + e0); const unsigned ww[4] = {w.x, w.y, w.z, w.w};
#pragma unroll
        for (int j = 0; j < 4; ++j) { vt[(e0 + 2 * j) * TP + tok] = (bf16_t)(ww[j] & 0xffffu); vt[(e0 + 2 * j + 1) * TP + tok] = (bf16_t)(ww[j] >> 16); } }
    if (WITH_K) { const int tok = F.tid >> 2, k0 = (F.tid & 3) * 8;
        const u32x4 w = *(const u32x4*)(RKh + (size_t)(tpos0 + tok) * 32 + k0); const unsigned ww[4] = {w.x, w.y, w.z, w.w};
        const float zf = exp2f(lgf * (float)(127 - tok)), zb = exp2f(lgb * (float)tok);
#pragma unroll
        for (int j = 0; j < 4; ++j) { const float a = bflo(ww[j]), b = bfhi(ww[j]);
            ktf[(k0 + 2 * j) * TP + tok] = f2bf(a * zf); ktf[(k0 + 2 * j + 1) * TP + tok] = f2bf(b * zf);
            ktb[(k0 + 2 * j) * TP + tok] = f2bf(a * zb); ktb[(k0 + 2 * j + 1) * TP + tok] = f2bf(b * zb); } }
}
__device__ __forceinline__ void p_ret_states(const Frame& F, int l) {
    LAS bf16_t* vt = (LAS bf16_t*)F.lds; LAS bf16_t* ktf = vt + 64 * TP; LAS bf16_t* ktb = ktf + 32 * TP;
    float* ST = wsp<float>(F, WS_ST);
    const int lane = F.lane, w = F.wave, kb = w >> 2, eb = w & 3, fr = lane & 15, fq = lane >> 4;
    for (int u = F.bid; u < NB * 8 * 34; u += F.G) {
        const int c = u % 34, bh = u / 34, h = bh & 7;
        float lgf, lgb; ret_logs(F, l, h, lgf, lgb);
        __syncthreads();
        ret_stage<true>(F, wsp<bf16_t>(F, WS_RK) + (size_t)bh * TT * 32, wsp<bf16_t>(F, WS_RV) + (size_t)bh * TT * 64, c * 128, lgf, lgb, vt, ktf, ktb);
        __syncthreads();
        f32x4 sf = {0.f, 0.f, 0.f, 0.f}, sb = {0.f, 0.f, 0.f, 0.f};
#pragma unroll
        for (int ks = 0; ks < 4; ++ks) {
            const bf16x8 bv = *(const LAS bf16x8*)(vt + (eb * 16 + fr) * TP + ks * 32 + fq * 8);
            const bf16x8 af = *(const LAS bf16x8*)(ktf + (kb * 16 + fr) * TP + ks * 32 + fq * 8);
            const bf16x8 ab = *(const LAS bf16x8*)(ktb + (kb * 16 + fr) * TP + ks * 32 + fq * 8);
            sf = __builtin_amdgcn_mfma_f32_16x16x32_bf16(af, bv, sf, 0, 0, 0);
            sb = __builtin_amdgcn_mfma_f32_16x16x32_bf16(ab, bv, sb, 0, 0, 0);
        }
        float* o = ST + (size_t)u * 2 * 2048;
#pragma unroll
        for (int r = 0; r < 4; ++r) { const int kd = kb * 16 + fq * 4 + r, e = eb * 16 + fr; o[kd * 64 + e] = sf[r]; o[2048 + kd * 64 + e] = sb[r]; }
    }
}
constexpr int RP = 40;
constexpr int AP = 136;
__device__ __forceinline__ void ret_out_unit(const Frame& F, int l, int bh, int c) {
    LAS bf16_t* vt = (LAS bf16_t*)F.lds; LAS bf16_t* rtf = vt + 64 * TP; LAS bf16_t* rtb = rtf + 64 * RP; LAS bf16_t* as = rtb + 64 * RP + F.wave * 16 * AP;
    const int lane = F.lane, w = F.wave, fr = lane & 15, fq = lane >> 4, h = bh & 7, b = bh >> 3;
    const bf16_t* RQh = wsp<bf16_t>(F, WS_RQ) + (size_t)bh * TT * 32; const bf16_t* RKh = wsp<bf16_t>(F, WS_RK) + (size_t)bh * TT * 32; const bf16_t* RVh = wsp<bf16_t>(F, WS_RV) + (size_t)bh * TT * 64;
    const float* STh = wsp<float>(F, WS_ST) + (size_t)bh * 34 * 2 * 2048;
    float lgf, lgb; ret_logs(F, l, h, lgf, lgb);
    const int tpos0 = c * 128;
    const int i0 = w * 16;
    const bf16x8 qa = *(const bf16x8*)(RQh + (size_t)(tpos0 + i0 + fr) * 32 + fq * 8);
    bf16x8 kfr[8];
#pragma unroll
    for (int nb = 0; nb < 8; ++nb) kfr[nb] = *(const bf16x8*)(RKh + (size_t)(tpos0 + nb * 16 + fr) * 32 + fq * 8);
    const bf16_t* P1 = wsp<bf16_t>(F, WS_P1); unsigned char* OAB = wsp<unsigned char>(F, WS_OAB);
    bf16_t gv[4][4];
#pragma unroll
    for (int r = 0; r < 4; ++r) { const int tp = tpos0 + i0 + fq * 4 + r; const size_t grow = tp >= CTXL ? (size_t)b * SEQ + (tp - CTXL) : (size_t)NLAT + b * CTXL + tp;
#pragma unroll
        for (int eb = 0; eb < 4; ++eb) gv[r][eb] = P1[grow * NP1 + C_RG + h * 64 + eb * 16 + fr]; }
    __syncthreads();
    ret_stage<false>(F, RKh, RVh, tpos0, lgf, lgb, vt, nullptr, nullptr);
    { const int kd = F.tid >> 4, e4 = (F.tid & 15) * 4; f32x4 rf = {0.f, 0.f, 0.f, 0.f}, rb = {0.f, 0.f, 0.f, 0.f};
      if (c >= 2) {
          const int p = c - 2;
          const float kff = 80.f / (-lgf * 128.f), kfb = 80.f / (-lgb * 128.f); const int kcf = kff < 64.f ? (int)kff + 1 : 64, kcb = kfb < 64.f ? (int)kfb + 1 : 64;
          const int nf = c < kcf ? c : kcf, nb_ = (33 - p) < kcb ? (33 - p) : kcb;
          const float* sf = STh + kd * 64 + e4;
          for (int k0 = 0; k0 < nf; k0 += 8) { f32x4 v[8];
#pragma unroll
              for (int j = 0; j < 8; ++j) { const int k = k0 + j; const int cp = k < nf ? c - 1 - k : 0; v[j] = *(const f32x4*)(sf + (size_t)(cp * 2 + 0) * 2048); }
#pragma unroll
              for (int j = 0; j < 8; ++j) { const int k = k0 + j; const float wgt = k < nf ? __builtin_amdgcn_exp2f(lgf * 128.f * (float)k) : 0.f; rf += v[j] * wgt; } }
          for (int k0 = 0; k0 < nb_; k0 += 8) { f32x4 v[8];
#pragma unroll
              for (int j = 0; j < 8; ++j) { const int k = k0 + j; const int pp = k < nb_ ? p + 1 + k : 33; const int cs = pp < 32 ? pp + 2 : pp - 32; v[j] = *(const f32x4*)(sf + (size_t)(cs * 2 + 1) * 2048); }
#pragma unroll
              for (int j = 0; j < 8; ++j) { const int k = k0 + j; const float wgt = k < nb_ ? __builtin_amdgcn_exp2f(lgb * 128.f * (float)k) : 0.f; rb += v[j] * wgt; } }
      } else if (c == 0) { rb = *(const f32x4*)(STh + (size_t)(1 * 2 + 1) * 2048 + kd * 64 + e4); }
      else { rf = *(const f32x4*)(STh + (size_t)(0 * 2 + 0) * 2048 + kd * 64 + e4); }
#pragma unroll
      for (int j = 0; j < 4; ++j) { rtf[(e4 + j) * RP + kd] = f2bf(rf[j]); rtb[(e4 + j) * RP + kd] = f2bf(rb[j]); } }
    f32x4 s[8];
#pragma unroll
    for (int nb = 0; nb < 8; ++nb) s[nb] = __builtin_amdgcn_mfma_f32_16x16x32_bf16(qa, kfr[nb], (f32x4){0.f, 0.f, 0.f, 0.f}, 0, 0, 0);
#pragma unroll
    for (int nb = 0; nb < 8; ++nb)
#pragma unroll
        for (int r = 0; r < 4; ++r) { const int i = i0 + fq * 4 + r, j = nb * 16 + fr; const int df = i - j;
            const float mk = df > 0 ? exp2f(lgf * (float)df) : (df < 0 ? exp2f(lgb * (float)(-df)) : 2.f);
            as[(fq * 4 + r) * AP + j] = f2bf(s[nb][r] * mk); }
    __syncthreads();
    f32x4 y[4];
#pragma unroll
    for (int eb = 0; eb < 4; ++eb) y[eb] = (f32x4){0.f, 0.f, 0.f, 0.f};
#pragma unroll
    for (int ks = 0; ks < 4; ++ks) { const bf16x8 af = *(const LAS bf16x8*)(as + fr * AP + ks * 32 + fq * 8);
#pragma unroll
        for (int eb = 0; eb < 4; ++eb) { const bf16x8 bv = *(const LAS bf16x8*)(vt + (eb * 16 + fr) * TP + ks * 32 + fq * 8);
            y[eb] = __builtin_amdgcn_mfma_f32_16x16x32_bf16(af, bv, y[eb], 0, 0, 0); } }
    { const float xf = exp2f(lgf * (float)(i0 + fr + 1)), xb = exp2f(lgb * (float)(128 - (i0 + fr)));
      bf16x8 qf, qb;
#pragma unroll
      for (int j = 0; j < 8; ++j) { const float qv = bf2f((bf16_t)qa[j]); qf[j] = (short)f2bf(qv * xf); qb[j] = (short)f2bf(qv * xb); }
#pragma unroll
      for (int eb = 0; eb < 4; ++eb) { const bf16x8 bf_ = *(const LAS bf16x8*)(rtf + (eb * 16 + fr) * RP + fq * 8), bb_ = *(const LAS bf16x8*)(rtb + (eb * 16 + fr) * RP + fq * 8);
          y[eb] = __builtin_amdgcn_mfma_f32_16x16x32_bf16(qf, bf_, y[eb], 0, 0, 0);
          y[eb] = __builtin_amdgcn_mfma_f32_16x16x32_bf16(qb, bb_, y[eb], 0, 0, 0); } }
#pragma unroll
    for (int r = 0; r < 4; ++r) {
        float sm = y[0][r] + y[1][r] + y[2][r] + y[3][r]; sm = row16_sum(sm); const float mu = sm * (1.f / 64.f);
        float vs = 0.f;
#pragma unroll
        for (int eb = 0; eb < 4; ++eb) { const float d = y[eb][r] - mu; vs += d * d; }
        vs = row16_sum(vs); const float rstd = rsqrtf(vs * (1.f / 64.f) + LN_EPS);
        const int i = i0 + fq * 4 + r; const int tp = tpos0 + i; const size_t grow = tp >= CTXL ? (size_t)b * SEQ + (tp - CTXL) : (size_t)NLAT + b * CTXL + tp;
#pragma unroll
        for (int eb = 0; eb < 4; ++eb) { const int e = eb * 16 + fr; const float g = bf2f(gv[r][eb]);
            OAB[grow * D + 512 + h * 64 + e] = (unsigned char)(pk4_fp8(clamp8(silu_f(g) * (y[eb][r] - mu) * rstd * 16.f), 0.f, 0.f, 0.f) & 0xffu); }
    }
}
namespace att {
constexpr int NW = 8, QBLK = 32, KVBLK = 64;
constexpr int SHM_K = KVBLK * 128, SHM_V = 128 * 64;
constexpr size_t SHM_ATTN = 4 * SHM_K + 3 * SHM_V + 2048;
constexpr float THR = 1.9f, PSH = 6.f, THR2 = THR * 1.4426950408889634f;
#define SBAR() __builtin_amdgcn_sched_barrier(0)
typedef int i32x8a __attribute__((ext_vector_type(8))); typedef int i32x4a __attribute__((ext_vector_type(4)));
template <int SC> struct Scale { static constexpr float S = SC == 0 ? 0.08838834764831845f : 0.10206207261596575f; static constexpr float C = S * 1.4426950408889634f; static constexpr float THRR = THR / S; };
#define KSWZ8(row, chunk) ((row) * 128 + ((((chunk) ^ (((row) >> 1) & 7))) << 4))
#define VSWZ8(col, chunk) ((col) * 64 + ((((chunk) ^ (((col) >> 2) & 3))) << 4))
#define MF8(A, B, C) mf8x<ABL>(A, B, C)
#define CAT8(lo, hi) __builtin_shufflevector(lo, hi, 0, 1, 2, 3, 4, 5, 6, 7)
#define LDS16(p) ((ABL & 8) ? __builtin_shufflevector(qr8[0], qr8[1], 0, 1, 10, 11) : *(const LAS i32x4a*)(p))
template <int A, int B, int ABL = 0> __device__ __forceinline__ void exp_rng(f32x16& p) {
#pragma unroll
  for (int r = A; r < B; ++r) p[r] = (ABL & 1) ? p[r] * p[r] : __builtin_amdgcn_exp2f(p[r]);
}
template <int ABL> __device__ __forceinline__ f32x16 mf8x(const i32x8a a, const i32x8a b, f32x16 c) {
  if constexpr (ABL & 2) { c[0] += __int_as_float(((a[0] ^ a[4]) + (b[0] ^ b[4])) & 0x3f000000); return c; }
  else return __builtin_amdgcn_mfma_scale_f32_32x32x64_f8f6f4(a, b, c, 0, 0, 0, 0x7F7F7F7F, 0, 0x7F7F7F7F);
}
__device__ __forceinline__ void pk_fma16(f32x16& p, float c, float d) { const f32x2 c2 = {c, c}, d2 = {d, d};
#pragma unroll
  for (int i = 0; i < 8; ++i) { f32x2 v = {p[2 * i], p[2 * i + 1]}; v = v * c2 + d2; p[2 * i] = v.x; p[2 * i + 1] = v.y; }
}
__device__ __forceinline__ void pk_add16(f32x16& p, float c) { const f32x2 c2 = {c, c};
#pragma unroll
  for (int i = 0; i < 8; ++i) { f32x2 v = {p[2 * i], p[2 * i + 1]}; v = v + c2; p[2 * i] = v.x; p[2 * i + 1] = v.y; }
}
__device__ __forceinline__ void pk_mul16(f32x16& p, float c) { const f32x2 c2 = {c, c};
#pragma unroll
  for (int i = 0; i < 8; ++i) { f32x2 v = {p[2 * i], p[2 * i + 1]}; v = v * c2; p[2 * i] = v.x; p[2 * i + 1] = v.y; }
}
__device__ __forceinline__ float pk_sum32(const f32x16& p0, const f32x16& p1) { f32x2 s0 = {p0[0], p0[1]}, s1 = {p1[0], p1[1]};
#pragma unroll
  for (int i = 1; i < 8; ++i) { s0 += (f32x2){p0[2 * i], p0[2 * i + 1]}; s1 += (f32x2){p1[2 * i], p1[2 * i + 1]}; }
  s0 += s1; return s0.x + s0.y;
}
__device__ __forceinline__ float hsum(float v) { auto rr = __builtin_amdgcn_permlane32_swap(__float_as_uint(v), __float_as_uint(v), false, false); return __uint_as_float(rr[0]) + __uint_as_float(rr[1]); }
__device__ __forceinline__ float hmax(float v) { auto rr = __builtin_amdgcn_permlane32_swap(__float_as_uint(v), __float_as_uint(v), false, false); return fmaxf(__uint_as_float(rr[0]), __uint_as_float(rr[1])); }
template <int NDV, int SC, int ABL>
__device__ __forceinline__ void attn_body(const unsigned char* __restrict__ Qb, const unsigned char* __restrict__ Kh, const unsigned char* __restrict__ Vt,
                                          unsigned char* __restrict__ Ob, int seq, LAS unsigned char* lds, const int tid) {
  constexpr int ldo = 2048;
  const int wid = __builtin_amdgcn_readfirstlane(tid >> 6), lane = tid & 63, r32 = lane & 31, hi = lane >> 5;
  LAS unsigned char* K_lds = lds; LAS unsigned char* V_lds = lds + 4 * SHM_K;
  constexpr bool LSUM = true, PF = (NDV == 2); constexpr int NO = NDV + (LSUM ? 1 : 0);
  float l_reg = 0; f32x16 o[NO] = {}; f32x16 negm; i32x8a qr8[2];
  LAS unsigned char* ones_lds = lds + 4 * SHM_K + 3 * SHM_V;
  i32x8a vones_r; { const int w1_ = r32 == 0 ? 0x38383838 : 0;
#pragma unroll
    for (int i = 0; i < 8; ++i) vones_r[i] = w1_; }
  if constexpr (NDV == 4) { if (tid < 128) *(LAS i32x4a*)(ones_lds + tid * 16) = (tid < 4) ? (i32x4a){0x38383838, 0x38383838, 0x38383838, 0x38383838} : (i32x4a){0, 0, 0, 0}; }
#define VONES() (NDV == 4 ? CAT8(LDS16(ones_lds + r32 * 64 + hi * 32), LDS16(ones_lds + r32 * 64 + hi * 32 + 16)) : vones_r)
  const unsigned char* Qw = Qb + (long)(wid * QBLK + r32) * 128 + hi * 32;
#pragma unroll
  for (int blk = 0; blk < 2; ++blk) { const i32x4a lo_ = *reinterpret_cast<const i32x4a*>(Qw + blk * 64), hi_ = *reinterpret_cast<const i32x4a*>(Qw + blk * 64 + 16); qr8[blk] = CAT8(lo_, hi_); }
  const int NT = seq / KVBLK;
  const int kr8 = 8 * wid + (lane >> 3), vcol = 16 * (wid & (NDV * 2 - 1)) + (lane >> 2);
  const unsigned char* kgp = Kh + (long)kr8 * 128 + (((lane & 7) ^ ((kr8 >> 1) & 7)) << 4);
  const unsigned char* vgp = Vt + (long)vcol * TT + (((lane & 3) ^ ((vcol >> 2) & 3)) << 4);
  const int kdo = wid * 1024, vdo = (wid & (NDV * 2 - 1)) * 1024;
  const int ka0 = KSWZ8(r32, 2 * hi), ka1 = KSWZ8(r32, 2 * hi + 1), va0 = VSWZ8(r32, 2 * hi), va1 = VSWZ8(r32, 2 * hi + 1);
#define DMAK(t, bo) do { const int t_ = (t) < NT ? (t) : NT - 1; __builtin_amdgcn_global_load_lds((const unsigned*)(kgp + (long)t_ * (KVBLK * 128)), (LAS unsigned*)(K_lds + (bo) + kdo), 16, 0, 0); } while (0)
#define DMAV(t, bo) do { const int t_ = (t) < NT ? (t) : NT - 1; __builtin_amdgcn_global_load_lds((const unsigned*)(vgp + t_ * KVBLK), (LAS unsigned*)(V_lds + (bo) + vdo), 16, 0, 0); } while (0)
#define VMW(n) asm volatile("s_waitcnt vmcnt(" #n ")" ::: "memory")
#define BAR() __builtin_amdgcn_s_barrier()
  f32x16 pA0, pA1, pB0, pB1; float alA, alB; i32x8a pa;
#define PSM2(p0, p1, al) do { float pm_ = fmaxf(p0[0], p1[0]);                                                                          \
    _Pragma("unroll") for (int r = 1; r < 16; ++r) pm_ = fmaxf(fmaxf(pm_, p0[r]), p1[r]);                                               \
    pm_ = hmax(pm_); al = 1.f;                                                                                                           \
    if (__builtin_expect(!__all(pm_ <= PSH + THR2), 0)) { const float d_ = fmaxf(pm_ - PSH, 0.f); al = __builtin_amdgcn_exp2f(-d_); pk_add16(p0, -d_); pk_add16(p1, -d_); pk_add16(negm, -d_); } } while (0)
#define PT3(x, y, z) asm volatile("" : "+v"(x), "+v"(y), "+v"(z))
#define PT4(x, y, z, w) asm volatile("" : "+v"(x), "+v"(y), "+v"(z), "+v"(w))
#define STEP(j, pc0, pc1, alc, pn0, pn1, aln) do { const LAS unsigned char* Kr_ = K_lds + kb_rd; const LAS unsigned char* Vs_ = V_lds + vb_rd;  \
    i32x8a kc_ = CAT8(LDS16(Kr_ + (ka0 ^ 64)), LDS16(Kr_ + (ka1 ^ 64))), kd_ = CAT8(LDS16(Kr_ + 4096 + (ka0 ^ 64)), LDS16(Kr_ + 4096 + (ka1 ^ 64))); \
    if constexpr (!PF) { kpa = CAT8(LDS16(Kr_ + ka0), LDS16(Kr_ + ka1)); kpb = CAT8(LDS16(Kr_ + 4096 + ka0), LDS16(Kr_ + 4096 + ka1)); }              \
    pn0 = MF8(kpa, qr8[0], negm); exp_rng<0, 6, ABL>(pc1); PT3(pn0, pc1, kpb);                                                     \
    pn1 = MF8(kpb, qr8[0], negm); exp_rng<6, 12, ABL>(pc1); PT3(pn1, pc1, kc_);                                                    \
    pn0 = MF8(kc_, qr8[1], pn0); exp_rng<12, 16, ABL>(pc1);                                                                              \
    if constexpr (!LSUM) { float ps_ = pk_sum32(pc0, pc1); ps_ = hsum(ps_); l_reg = l_reg * alc + ps_; }                                   \
    i32x8a va_ = CAT8(LDS16(Vs_ + va0), LDS16(Vs_ + va1)), vb_ = CAT8(LDS16(Vs_ + 2048 + va0), LDS16(Vs_ + 2048 + va1));                  \
    PT4(pn0, pc1, kd_, l_reg);                                                                                                           \
    pn1 = MF8(kd_, qr8[1], pn1);                                                                                                         \
    _Pragma("unroll") for (int q = 0; q < 4; ++q) { pa[q] = (int)pk4_fp8(pc0[4 * q], pc0[4 * q + 1], pc0[4 * q + 2], pc0[4 * q + 3]); pa[4 + q] = (int)pk4_fp8(pc1[4 * q], pc1[4 * q + 1], pc1[4 * q + 2], pc1[4 * q + 3]); } \
    PT3(pn1, pa, va_);                                                                                                                   \
    if constexpr (!(ABL & 128)) { DMAK((j) + 4, kb_wr); DMAV((j) + 2, vb_wr); }                                                          \
    o[0] = MF8(va_, pa, o[0]); PSM2(pn0, pn1, aln); PT3(o[0], pn0, vb_);                                                  \
    o[1] = MF8(vb_, pa, o[1]); exp_rng<0, 4, ABL>(pn0);                                   \
    if constexpr (NDV == 4) { i32x8a vc_ = CAT8(LDS16(Vs_ + 4096 + va0), LDS16(Vs_ + 4096 + va1)), vd_ = CAT8(LDS16(Vs_ + 6144 + va0), LDS16(Vs_ + 6144 + va1)); \
      PT4(o[1], pn0, pn1, vc_); o[2] = MF8(vc_, pa, o[2]); exp_rng<4, 10, ABL>(pn0); PT3(o[2], pn0, vd_);                                \
      o[3] = MF8(vd_, pa, o[3]); exp_rng<10, 14, ABL>(pn0); PT3(o[3], pn0, pn1); o[4] = MF8(VONES(), pa, o[4]); exp_rng<14, 16, ABL>(pn0); }      \
    else { PT3(o[1], pn0, pn1); o[2] = MF8(VONES(), pa, o[2]); exp_rng<4, 10, ABL>(pn0); PT3(o[2], pn0, pn1); exp_rng<10, 16, ABL>(pn0); }    \
    if constexpr (PF) { const LAS unsigned char* Kp_ = K_lds + kb_pf; kpa = CAT8(LDS16(Kp_ + ka0), LDS16(Kp_ + ka1)); kpb = CAT8(LDS16(Kp_ + 4096 + ka0), LDS16(Kp_ + 4096 + ka1)); } \
    PT3(o[NO - 1], pn0, pn1); RESC(aln);                                                                                               \
    { const int t_ = kb_rd; kb_rd = kb_pf; kb_pf = kb_x; kb_x = kb_wr; kb_wr = t_; const int u_ = vb_rd; vb_rd = vb_n1; vb_n1 = vb_wr; vb_wr = u_; } \
    VMW(2); if constexpr (!(ABL & 4)) BAR(); } while (0)
#define RESC(a) do { if (__any((a) < 1.f)) { _Pragma("unroll") for (int d = 0; d < NO; ++d) pk_mul16(o[d], (a)); } } while (0)
  i32x8a kpa, kpb; int kb_rd = SHM_K, kb_pf = 2 * SHM_K, kb_x = 3 * SHM_K, kb_wr = 0, vb_rd = 0, vb_n1 = SHM_V, vb_wr = 2 * SHM_V;
  DMAK(0, 0); DMAK(1, SHM_K); DMAK(2, 2 * SHM_K); DMAK(3, 3 * SHM_K); DMAV(0, 0); DMAV(1, SHM_V); VMW(0); BAR();
  { const LAS unsigned char* Ks_ = K_lds;
    pA0 = MF8(CAT8(LDS16(Ks_ + ka0), LDS16(Ks_ + ka1)), qr8[0], (f32x16){}); pA1 = MF8(CAT8(LDS16(Ks_ + 4096 + ka0), LDS16(Ks_ + 4096 + ka1)), qr8[0], (f32x16){});
    pA0 = MF8(CAT8(LDS16(Ks_ + (ka0 ^ 64)), LDS16(Ks_ + (ka1 ^ 64))), qr8[1], pA0); pA1 = MF8(CAT8(LDS16(Ks_ + 4096 + (ka0 ^ 64)), LDS16(Ks_ + 4096 + (ka1 ^ 64))), qr8[1], pA1);
    float pm_ = fmaxf(pA0[0], pA1[0]);
#pragma unroll
    for (int r = 1; r < 16; ++r) pm_ = fmaxf(fmaxf(pm_, pA0[r]), pA1[r]);
    pm_ = hmax(pm_);
    const float nv_ = PSH - pm_; pk_add16(pA0, nv_); pk_add16(pA1, nv_);
#pragma unroll
    for (int r = 0; r < 16; ++r) negm[r] = nv_;
    alA = 1.f; exp_rng<0, 16, ABL>(pA0);
    if constexpr (PF) { const LAS unsigned char* Kp_ = K_lds + SHM_K; kpa = CAT8(LDS16(Kp_ + ka0), LDS16(Kp_ + ka1)); kpb = CAT8(LDS16(Kp_ + 4096 + ka0), LDS16(Kp_ + 4096 + ka1)); } }
  asm volatile("s_waitcnt lgkmcnt(0)" ::: "memory"); BAR();
  int j = 0;
  for (; j + 2 < NT; j += 2) { STEP(j, pA0, pA1, alA, pB0, pB1, alB); STEP(j + 1, pB0, pB1, alB, pA0, pA1, alA); }
  STEP(j, pA0, pA1, alA, pB0, pB1, alB);
  { exp_rng<0, 16, ABL>(pB1); if constexpr (!LSUM) { float ps_ = pk_sum32(pB0, pB1); ps_ = hsum(ps_); l_reg = l_reg * alB + ps_; }
#pragma unroll
    for (int q = 0; q < 4; ++q) { pa[q] = (int)pk4_fp8(pB0[4 * q], pB0[4 * q + 1], pB0[4 * q + 2], pB0[4 * q + 3]); pa[4 + q] = (int)pk4_fp8(pB1[4 * q], pB1[4 * q + 1], pB1[4 * q + 2], pB1[4 * q + 3]); }
    const LAS unsigned char* Vs_ = V_lds + vb_rd;
#pragma unroll
    for (int d0 = 0; d0 < NDV; ++d0) o[d0] = MF8(CAT8(LDS16(Vs_ + d0 * 2048 + va0), LDS16(Vs_ + d0 * 2048 + va1)), pa, o[d0]);
    if constexpr (LSUM) { o[NDV] = MF8(VONES(), pa, o[NDV]); l_reg = hsum(o[NDV][0]); } }
  const float rl = __builtin_amdgcn_rcpf(l_reg) * 16.f;
  unsigned char* Ow = Ob + (long)(wid * QBLK + r32) * ldo + 4 * hi;
#pragma unroll
  for (int d0 = 0; d0 < NDV; ++d0)
#pragma unroll
    for (int g = 0; g < 4; ++g) *(unsigned*)(Ow + d0 * 32 + 8 * g) = pk4_fp8(clamp8(o[d0][4 * g] * rl), clamp8(o[d0][4 * g + 1] * rl), clamp8(o[d0][4 * g + 2] * rl), clamp8(o[d0][4 * g + 3] * rl));
#undef DMAK
#undef DMAV
#undef VMW
#undef BAR
#undef PSM2
#undef VONES
#undef REGION_X
#undef REGION_Y
#undef RESC
#undef STEP
#undef PT3
#undef PT4
}
}
__device__ __forceinline__ float* xres_row(const Frame& F, int row) { return row < NLAT ? F.out + (size_t)row * D : wsp<float>(F, WS_XC) + (size_t)(row - NLAT) * D; }
__device__ __forceinline__ void ln_row(float (&y)[32], const float* g, const float* b, int lane) {
    float s = 0.f;
#pragma unroll
    for (int i = 0; i < 32; ++i) s += y[i];
    const float mu = wave_sum(s) * (1.f / 2048.f);
    float q = 0.f;
#pragma unroll
    for (int i = 0; i < 32; ++i) { const float d = y[i] - mu; q += d * d; }
    const float rstd = rsqrtf(wave_sum(q) * (1.f / 2048.f) + LN_EPS);
#pragma unroll
    for (int qq = 0; qq < 4; ++qq) { const f32x4 g0 = *(const f32x4*)(g + 512 * qq + 8 * lane), g1 = *(const f32x4*)(g + 512 * qq + 8 * lane + 4), b0 = *(const f32x4*)(b + 512 * qq + 8 * lane), b1 = *(const f32x4*)(b + 512 * qq + 8 * lane + 4);
#pragma unroll
        for (int i = 0; i < 4; ++i) { y[qq * 8 + i] = (y[qq * 8 + i] - mu) * rstd * g0[i] + b0[i]; y[qq * 8 + 4 + i] = (y[qq * 8 + 4 + i] - mu) * rstd * g1[i] + b1[i]; } }
}
__device__ __forceinline__ void modulate_store(const float (&x)[32], const float* sh, const float* sc, bf16_t* dst, int lane) {
#pragma unroll
    for (int q = 0; q < 4; ++q) { const f32x4 h0 = *(const f32x4*)(sh + 512 * q + 8 * lane), h1 = *(const f32x4*)(sh + 512 * q + 8 * lane + 4), c0 = *(const f32x4*)(sc + 512 * q + 8 * lane), c1 = *(const f32x4*)(sc + 512 * q + 8 * lane + 4);
        f32x4 a, b;
#pragma unroll
        for (int i = 0; i < 4; ++i) { a[i] = x[q * 8 + i] * (1.f + c0[i]) + h0[i]; b[i] = x[q * 8 + 4 + i] * (1.f + c1[i]) + h1[i]; }
        *(u32x4*)(dst + 512 * q + 8 * lane) = pack8(a, b); }
}
__device__ __forceinline__ void p_ln1(const Frame& F, int l, bool last) {
    const float* mod = wsp<float>(F, WS_MOD) + (size_t)l * 5 * 12288; bf16_t* hb = wsp<bf16_t>(F, WS_HB);
    const float* g = F.in(18) + l * D; const float* b = F.in(19) + l * D;
    const int nrows = last ? NLAT : NROW; const int lane = F.lane, step = F.G * 8;
    float gg[32], bb[32]; ld_row_f32(g, lane, gg); ld_row_f32(b, lane, bb);
    int row = F.bid * 8 + F.wave;
    float yn[32];
    if (row < nrows) ld_row_f32(xres_row(F, row), lane, yn);
#pragma unroll 1
    for (; row < nrows; row += step) {
        const int v = row < NLAT ? (row >> 12) : 4; float* xp = xres_row(F, row);
        float y[32], sh[32], sc[32];
#pragma unroll
        for (int i = 0; i < 32; ++i) y[i] = yn[i];
        ld_row_f32(mod + (size_t)v * 12288 + 6144, lane, sh); ld_row_f32(mod + (size_t)v * 12288 + 8192, lane, sc);
        { const int nrow = row + step; if (nrow < nrows) ld_row_f32(xres_row(F, nrow), lane, yn); }
        float s = 0.f;
#pragma unroll
        for (int i = 0; i < 32; ++i) s += y[i];
        const float mu = wave_sum(s) * (1.f / 2048.f); float q = 0.f;
#pragma unroll
        for (int i = 0; i < 32; ++i) { const float d = y[i] - mu; q += d * d; }
        const float rstd = rsqrtf(wave_sum(q) * (1.f / 2048.f) + LN_EPS);
#pragma unroll
        for (int i = 0; i < 32; ++i) y[i] = (y[i] - mu) * rstd * gg[i] + bb[i];
        st_row_f32(xp, lane, y);
#pragma unroll
        for (int i = 0; i < 32; ++i) y[i] = y[i] * (1.f + sc[i]) + sh[i];
        st_row_bf16(hb + (size_t)row * D, lane, y);
    }
}

template <int NV>
__device__ __forceinline__ void top16(const float (&val)[NV], bool (&sel)[NV], int (&slot)[NV]) {
    unsigned key[NV];
#pragma unroll
    for (int v = 0; v < NV; ++v) { const unsigned u = __float_as_uint(val[v]); key[v] = (u & 0x80000000u) ? ~u : (u | 0x80000000u); }
    unsigned T = 0u;
#pragma unroll 1
    for (int bit = 31; bit >= 0; --bit) {
        const unsigned cand = T | (1u << bit); int cnt = 0;
#pragma unroll
        for (int v = 0; v < NV; ++v) cnt += __popcll(__ballot(key[v] >= cand));
        if (cnt >= 16) T = cand;
    }
    int ngt = 0;
#pragma unroll
    for (int v = 0; v < NV; ++v) ngt += __popcll(__ballot(key[v] > T));
    const int need = 16 - ngt;
    int run = 0, erun = 0;
#pragma unroll
    for (int v = 0; v < NV; ++v) {
        const unsigned long long mg = __ballot(key[v] > T), me = __ballot(key[v] == T);
        const int pg = __builtin_amdgcn_mbcnt_hi((unsigned)(mg >> 32), __builtin_amdgcn_mbcnt_lo((unsigned)mg, 0u));
        const int pe = __builtin_amdgcn_mbcnt_hi((unsigned)(me >> 32), __builtin_amdgcn_mbcnt_lo((unsigned)me, 0u));
        sel[v] = false; slot[v] = 0;
        if (key[v] > T) { sel[v] = true; slot[v] = run + pg; }
        else if (key[v] == T && (erun + pe) < need) { sel[v] = true; slot[v] = ngt + erun + pe; }
        run += __popcll(mg); erun += __popcll(me);
    }
}
__device__ __forceinline__ unsigned f2key(float f) { const unsigned u = __float_as_uint(f); return (u & 0x80000000u) ? ~u : (u | 0x80000000u); }
__device__ __forceinline__ float key2f(unsigned k) { return __uint_as_float((k & 0x80000000u) ? (k & 0x7fffffffu) : ~k); }
template <int NP, int NV>
__device__ __forceinline__ void bisect16(const unsigned (&key)[NP][NV], unsigned (&T)[NP]) {
    bool done[NP];
#pragma unroll
    for (int p = 0; p < NP; ++p) { T[p] = 0u; done[p] = false; }
#pragma unroll 1
    for (int bit = 31; bit >= 0; --bit) {
        const unsigned bm = 1u << bit; bool all = true;
#pragma unroll
        for (int p = 0; p < NP; ++p) {
            const unsigned cand = T[p] | bm; int cnt = 0;
#pragma unroll
            for (int v = 0; v < NV; ++v) cnt += __popcll(__ballot(key[p][v] >= cand));
            const bool upd = (cnt >= 16) && !done[p];
            T[p] = upd ? cand : T[p]; done[p] = done[p] || (cnt == 16); all = all && done[p];
        }
        if (all) break;
    }
}
template <int NV>
__device__ __forceinline__ void compact16(const unsigned (&key)[NV], const unsigned T, bool (&sel)[NV], int (&slot)[NV]) {
    int ngt = 0;
#pragma unroll
    for (int v = 0; v < NV; ++v) ngt += __popcll(__ballot(key[v] > T));
    const int need = 16 - ngt; int run = 0, erun = 0;
#pragma unroll
    for (int v = 0; v < NV; ++v) {
        const unsigned long long mg = __ballot(key[v] > T), me = __ballot(key[v] == T);
        const int pg = __builtin_amdgcn_mbcnt_hi((unsigned)(mg >> 32), __builtin_amdgcn_mbcnt_lo((unsigned)mg, 0u));
        const int pe = __builtin_amdgcn_mbcnt_hi((unsigned)(me >> 32), __builtin_amdgcn_mbcnt_lo((unsigned)me, 0u));
        sel[v] = false; slot[v] = 0;
        if (key[v] > T) { sel[v] = true; slot[v] = run + pg; }
        else if (key[v] == T && (erun + pe) < need) { sel[v] = true; slot[v] = ngt + erun + pe; }
        run += __popcll(mg); erun += __popcll(me);
    }
}
constexpr int KP = 68;
constexpr int PW_BYTES = 9344;
__device__ __forceinline__ float gelu_erf(float x) {
    const float z = fabsf(x) * 0.7071067811865476f; const float t = __builtin_amdgcn_rcpf(1.f + 0.3275911f * z);
    float p = 1.061405429f; p = p * t - 1.453152027f; p = p * t + 1.421413741f; p = p * t - 0.284496736f; p = p * t + 0.254829592f; p = p * t;
    const float er = 1.f - p * __expf(-z * z);
    return 0.5f * x * (1.f + (x < 0.f ? -er : er));
}
__device__ __forceinline__ float wave_max(float x) {
    x = row16_max(x);
    { auto r = __builtin_amdgcn_permlane16_swap(__float_as_uint(x), __float_as_uint(x), false, false); x = fmaxf(__uint_as_float(r[0]), __uint_as_float(r[1])); }
    { auto r = __builtin_amdgcn_permlane32_swap(__float_as_uint(x), __float_as_uint(x), false, false); x = fmaxf(__uint_as_float(r[0]), __uint_as_float(r[1])); }
    return x;
}
__device__ __forceinline__ void ld16_f32(const float* p, int lane, float (&x)[32]) {
#pragma unroll
    for (int q = 0; q < 2; ++q)
#pragma unroll
        for (int d = 0; d < 4; ++d) { const f32x4 a = *(const f32x4*)(p + 1024 * q + 16 * lane + 4 * d); x[q * 16 + d * 4 + 0] = a[0]; x[q * 16 + d * 4 + 1] = a[1]; x[q * 16 + d * 4 + 2] = a[2]; x[q * 16 + d * 4 + 3] = a[3]; }
}
__device__ __forceinline__ void ld16_f32_nt(const float* p, int lane, float (&x)[32]) {
#pragma unroll
    for (int q = 0; q < 2; ++q)
#pragma unroll
        for (int d = 0; d < 4; ++d) { const f32x4 a = __builtin_nontemporal_load((const f32x4*)(p + 1024 * q + 16 * lane + 4 * d)); x[q * 16 + d * 4 + 0] = a[0]; x[q * 16 + d * 4 + 1] = a[1]; x[q * 16 + d * 4 + 2] = a[2]; x[q * 16 + d * 4 + 3] = a[3]; }
}
__device__ __forceinline__ void st16_f32_nt(float* p, int lane, const float (&x)[32]) {
#pragma unroll
    for (int q = 0; q < 2; ++q)
#pragma unroll
        for (int d = 0; d < 4; ++d) __builtin_nontemporal_store((f32x4){x[q * 16 + d * 4 + 0], x[q * 16 + d * 4 + 1], x[q * 16 + d * 4 + 2], x[q * 16 + d * 4 + 3]}, (f32x4*)(p + 1024 * q + 16 * lane + 4 * d));
}
__device__ __forceinline__ void st16_f32(float* p, int lane, const float (&x)[32]) {
#pragma unroll
    for (int q = 0; q < 2; ++q)
#pragma unroll
        for (int d = 0; d < 4; ++d) *(f32x4*)(p + 1024 * q + 16 * lane + 4 * d) = (f32x4){x[q * 16 + d * 4 + 0], x[q * 16 + d * 4 + 1], x[q * 16 + d * 4 + 2], x[q * 16 + d * 4 + 3]};
}
__device__ __forceinline__ void ld16_bf16(const bf16_t* p, int lane, float (&x)[32]) {
#pragma unroll
    for (int q = 0; q < 2; ++q)
#pragma unroll
        for (int d = 0; d < 2; ++d) { const u32x4 w = *(const u32x4*)(p + 1024 * q + 16 * lane + 8 * d); float* o = &x[q * 16 + d * 8];
            o[0] = bflo(w.x); o[1] = bfhi(w.x); o[2] = bflo(w.y); o[3] = bfhi(w.y); o[4] = bflo(w.z); o[5] = bfhi(w.z); o[6] = bflo(w.w); o[7] = bfhi(w.w); }
}
__device__ __forceinline__ void st16_bf16(bf16_t* p, int lane, const float (&x)[32]) {
#pragma unroll
    for (int q = 0; q < 2; ++q)
#pragma unroll
        for (int d = 0; d < 2; ++d) { const float* o = &x[q * 16 + d * 8]; u32x4 w; w.x = cvt_pk_bf16(o[0], o[1]); w.y = cvt_pk_bf16(o[2], o[3]); w.z = cvt_pk_bf16(o[4], o[5]); w.w = cvt_pk_bf16(o[6], o[7]);
            *(u32x4*)(p + 1024 * q + 16 * lane + 8 * d) = w; }
}
constexpr int TBS = 1152;
__device__ __forceinline__ void ld_row_f32(int lane, const float* __restrict__ src, f32x4* a) {
#pragma unroll
    for (int q = 0; q < 2; ++q)
#pragma unroll
        for (int d = 0; d < 4; ++d) a[q * 4 + d] = __builtin_nontemporal_load((const f32x4*)(src + 1024 * q + 16 * lane + 4 * d));
}
__device__ __forceinline__ void cvt_row_fp4b(int lane, const f32x4* a, unsigned char* __restrict__ dst) {
    float x[32];
#pragma unroll
    for (int i = 0; i < 8; ++i) { x[i * 4 + 0] = a[i][0]; x[i * 4 + 1] = a[i][1]; x[i * 4 + 2] = a[i][2]; x[i * 4 + 3] = a[i][3]; }
    float am = 0.f;
#pragma unroll
    for (int i = 0; i < 32; ++i) am = fmaxf(am, fabsf(x[i]));
    const bf16_t sb = f2bf(am * (1.f / 6.f)); const float sf = bf2f(sb); const float sc = sf > 0.f ? __builtin_amdgcn_rcpf(sf) : 0.f;
    u32x4 w;
#pragma unroll
    for (int d = 0; d < 4; ++d) { unsigned t = 0u; const int o = (d >> 1) * 16 + (d & 1) * 8;
        t = __builtin_amdgcn_cvt_scalef32_pk_fp4_f32(t, x[o + 0] * sc, x[o + 1] * sc, 1.0f, 0); t = __builtin_amdgcn_cvt_scalef32_pk_fp4_f32(t, x[o + 2] * sc, x[o + 3] * sc, 1.0f, 1);
        t = __builtin_amdgcn_cvt_scalef32_pk_fp4_f32(t, x[o + 4] * sc, x[o + 5] * sc, 1.0f, 2); t = __builtin_amdgcn_cvt_scalef32_pk_fp4_f32(t, x[o + 6] * sc, x[o + 7] * sc, 1.0f, 3); w[d] = t; }
    *(u32x4*)(dst + 16 * lane) = w;
    *(bf16_t*)(dst + 1024 + 2 * lane) = sb;
}
__device__ __forceinline__ void cvt_row_fp4r(int lane, const float* __restrict__ src, unsigned char* __restrict__ dst, float* __restrict__ inv) {
    float x[32];
#pragma unroll
    for (int q = 0; q < 2; ++q)
#pragma unroll
        for (int d = 0; d < 4; ++d) { const f32x4 a = __builtin_nontemporal_load((const f32x4*)(src + 1024 * q + 16 * lane + 4 * d)); x[q * 16 + d * 4 + 0] = a[0]; x[q * 16 + d * 4 + 1] = a[1]; x[q * 16 + d * 4 + 2] = a[2]; x[q * 16 + d * 4 + 3] = a[3]; }
    float am = 0.f;
#pragma unroll
    for (int i = 0; i < 32; ++i) am = fmaxf(am, fabsf(x[i]));
    am = wave_max(am);
    const float sc = am > 0.f ? 6.f / am : 1.f;
    if (lane == 0) *inv = am > 0.f ? am * (1.f / 6.f) : 1.f;
    u32x4 w;
#pragma unroll
    for (int d = 0; d < 4; ++d) { unsigned t = 0u; const int o = (d >> 1) * 16 + (d & 1) * 8;
        t = __builtin_amdgcn_cvt_scalef32_pk_fp4_f32(t, x[o + 0] * sc, x[o + 1] * sc, 1.0f, 0); t = __builtin_amdgcn_cvt_scalef32_pk_fp4_f32(t, x[o + 2] * sc, x[o + 3] * sc, 1.0f, 1);
        t = __builtin_amdgcn_cvt_scalef32_pk_fp4_f32(t, x[o + 4] * sc, x[o + 5] * sc, 1.0f, 2); t = __builtin_amdgcn_cvt_scalef32_pk_fp4_f32(t, x[o + 6] * sc, x[o + 7] * sc, 1.0f, 3); w[d] = t; }
    *(u32x4*)(dst + 16 * lane) = w;
}
__device__ __forceinline__ void cvt_peer(const Frame& F, int l) {
    const int step = F.G * 8; int r = F.bid * 8 + F.wave;
    f32x4 cur[8], nxt[8];
    auto srcp = [&](int rr) { return (rr < 16384 ? F.in(23) : F.in(24)) + ((size_t)l * 16384 + (rr & 16383)) * 2048; };
    if (r < 32768) ld_row_f32(F.lane, srcp(r), cur);
    for (; r < 32768; r += step) {
        const int rn = r + step;
        if (rn < 32768) ld_row_f32(F.lane, srcp(rn), nxt);
        cvt_row_fp4b(F.lane, cur, wsp<unsigned char>(F, r < 16384 ? WS_PU : WS_PV) + (size_t)l * SZ_PT + (size_t)(r & 16383) * TBS);
#pragma unroll
        for (int i = 0; i < 8; ++i) cur[i] = nxt[i];
    }
}
#define PEER_G 4
template <int CTRL> __device__ __forceinline__ int dppi(int x) { return __builtin_amdgcn_update_dpp(0, x, CTRL, 0xF, 0xF, true); }
__device__ __forceinline__ int irow16_sum(int x) { x += dppi<0xB1>(x); x += dppi<0x4E>(x); x += dppi<0x141>(x); x += dppi<0x140>(x); return x; }
__device__ __forceinline__ int irow16_incl_scan(int x) { x += dppi<0x111>(x); x += dppi<0x112>(x); x += dppi<0x114>(x); x += dppi<0x118>(x); return x; }
constexpr int KBP = 72;
constexpr int PT_WORDS = 6 * 128 + 160 + 3 * 128;
constexpr int PWB = 2 * PT_WORDS * 4;
__device__ __forceinline__ void p_peer(const Frame& F, int l, bool last) {
    LAS bf16_t* kb1 = (LAS bf16_t*)F.lds; LAS bf16_t* kb2 = kb1 + 128 * KBP;
    LAS unsigned* wbase = (LAS unsigned*)(F.lds + 2 * 128 * KBP * 2 + F.wave * PWB);
    const int lane = F.lane, fr = lane & 15, fq = lane >> 4;
    __syncthreads();
    for (int i = F.tid; i < 128 * 64; i += 512) { const int r = i >> 6, d = i & 63; kb1[r * KBP + d] = f2bf(F.in(21)[(size_t)l * 8192 + i]); kb2[r * KBP + d] = f2bf(F.in(22)[(size_t)l * 8192 + i]); }
    __syncthreads();
    const bf16_t* QP = wsp<bf16_t>(F, WS_QP); const bf16_t* HB = wsp<bf16_t>(F, WS_HB); unsigned char* HB8w = wsp<unsigned char>(F, WS_HB8);
    const unsigned char* PU = wsp<unsigned char>(F, WS_PU) + (size_t)l * SZ_PT; const unsigned char* PV = wsp<unsigned char>(F, WS_PV) + (size_t)l * SZ_PT;
    const float* modl = wsp<float>(F, WS_MOD) + (size_t)l * 5 * 12288; const float* modn = wsp<float>(F, WS_MOD) + (size_t)(l + 1) * 5 * 12288;
    const float* g2n = F.in(25) + l * D; const float* b2n = F.in(26) + l * D;
    const int npairs = (last ? NLAT : NROW) / 2;
    const int per_wg = (npairs + F.G - 1) / F.G; const int p_lo = F.bid * per_wg; const int p_hi = (p_lo + per_wg) < npairs ? (p_lo + per_wg) : npairs;
    LAS int* wq = (LAS int*)(F.lds + 147456 - 32);
    if (F.tid == 0) *wq = 0;
    __syncthreads();
#pragma unroll 1
    for (;;) {
        int pi = 0; if (lane == 0) pi = __hip_atomic_fetch_add(wq, 1, __ATOMIC_RELAXED, __HIP_MEMORY_SCOPE_WORKGROUP);
        pi = p_lo + __builtin_amdgcn_readfirstlane(pi); if (pi >= p_hi) break;
        const int rowA = 2 * pi;
#pragma unroll 1
        for (int rep1_ = 0; rep1_ <= REP_PS1; ++rep1_) {
            unsigned kk[2][8][4];
            { int fr_ = fr; asm volatile("" : "+v"(fr_));
              const bf16_t* qrow = QP + (size_t)(rowA + (fr_ >> 3)) * 1024 + (fr_ & 7) * 128 + 8 * fq;
              bf16x8 af[2][2];
#pragma unroll
              for (int st = 0; st < 2; ++st)
#pragma unroll
                  for (int ks = 0; ks < 2; ++ks) af[st][ks] = *(const bf16x8*)(qrow + st * 64 + ks * 32);
#pragma unroll
              for (int st = 0; st < 2; ++st) { LAS bf16_t* kb = st ? kb2 : kb1;
#pragma unroll
                  for (int nb = 0; nb < 8; ++nb) { f32x4 c = {0.f, 0.f, 0.f, 0.f};
#pragma unroll
                      for (int ks = 0; ks < 2; ++ks) { const bf16x8 bfr = *(const LAS bf16x8*)(kb + (nb * 16 + fr) * KBP + ks * 32 + 8 * fq); c = __builtin_amdgcn_mfma_f32_16x16x32_bf16(af[st][ks], bfr, c, 0, 0, 0); }
#pragma unroll
                      for (int r = 0; r < 4; ++r) kk[st][nb][r] = f2key(c[r]); } } }
            unsigned T[2][4]; bool done[2][4];
#pragma unroll
            for (int st = 0; st < 2; ++st)
#pragma unroll
                for (int r = 0; r < 4; ++r) { T[st][r] = 0u; done[st][r] = false; }
#pragma unroll 1
            for (int bit = ((PS1_ABL & 1) && rep1_ < REP_PS1) ? -1 : 31; bit >= 0; --bit) { const unsigned bm = 1u << bit; bool alld = true;
#pragma unroll
                for (int st = 0; st < 2; ++st)
#pragma unroll
                    for (int r = 0; r < 4; ++r) { const unsigned cand = T[st][r] | bm; int c = 0;
#pragma unroll
                        for (int nb = 0; nb < 8; ++nb) c += (kk[st][nb][r] >= cand) ? 1 : 0;
                        c = irow16_sum(c);
                        const bool upd = (c >= 16) && !done[st][r]; T[st][r] = upd ? cand : T[st][r]; done[st][r] = done[st][r] || (c == 16); alld = alld && done[st][r]; }
                if (__all(alld)) break; }
            const int tt = lane >> 5, hd0 = ((lane >> 4) & 1) * 4;
            if (!((PS1_ABL & 2) && rep1_ < REP_PS1))
#pragma unroll
            for (int st = 0; st < 2; ++st)
#pragma unroll
                for (int r = 0; r < 4; ++r) { const unsigned Tr = T[st][r]; int g = 0, e = 0;
#pragma unroll
                    for (int nb = 0; nb < 8; ++nb) { g += (kk[st][nb][r] > Tr) ? 1 : 0; e += (kk[st][nb][r] == Tr) ? 1 : 0; }
                    int gpre = irow16_incl_scan(g) - g, epre = irow16_incl_scan(e) - e; const int ngt = irow16_sum(g); const int need = 16 - ngt;
                    LAS unsigned* tb = wbase + tt * PT_WORDS; LAS float* vl = (LAS float*)(tb + st * 128) + (hd0 + r) * 16; LAS int* il = (LAS int*)(tb + 256 + st * 128) + (hd0 + r) * 16;
#pragma unroll
                    for (int nb = 0; nb < 8; ++nb) { const unsigned k = kk[st][nb][r];
                        if (k > Tr) { vl[gpre] = key2f(k); il[gpre] = nb * 16 + fr; ++gpre; }
                        else if (k == Tr) { if (epre < need) { vl[ngt + epre] = key2f(k); il[ngt + epre] = nb * 16 + fr; } ++epre; } } }
        }
        asm volatile("s_waitcnt lgkmcnt(0)" ::: "memory");
        {
            const int tt = lane >> 5, hd0 = ((lane >> 4) & 1) * 4; LAS unsigned* tb = wbase + tt * PT_WORDS;
            unsigned ck[4][16];
#pragma unroll
            for (int r = 0; r < 4; ++r) { const float va = ((LAS float*)tb)[(hd0 + r) * 16 + fr]; const LAS float* v2p = (LAS float*)(tb + 128) + (hd0 + r) * 16;
#pragma unroll
                for (int j4 = 0; j4 < 4; ++j4) { const f32x4 vb = *(const LAS f32x4*)(v2p + j4 * 4);
#pragma unroll
                    for (int i = 0; i < 4; ++i) ck[r][j4 * 4 + i] = f2key(va + vb[i]); } }
            unsigned T[4]; bool done[4];
#pragma unroll
            for (int r = 0; r < 4; ++r) { T[r] = 0u; done[r] = false; }
#pragma unroll 1
            for (int bit = 31; bit >= 0; --bit) { const unsigned bm = 1u << bit; bool alld = true;
#pragma unroll
                for (int r = 0; r < 4; ++r) { const unsigned cand = T[r] | bm; int c = 0;
#pragma unroll
                    for (int j = 0; j < 16; ++j) c += (ck[r][j] >= cand) ? 1 : 0;
                    c = irow16_sum(c);
                    const bool upd = (c >= 16) && !done[r]; T[r] = upd ? cand : T[r]; done[r] = done[r] || (c == 16); alld = alld && done[r]; }
                if (__all(alld)) break; }
#pragma unroll
            for (int r = 0; r < 4; ++r) { const unsigned Tr = T[r]; int g = 0, e = 0;
#pragma unroll
                for (int j = 0; j < 16; ++j) { g += (ck[r][j] > Tr) ? 1 : 0; e += (ck[r][j] == Tr) ? 1 : 0; }
                int gpre = irow16_incl_scan(g) - g, epre = irow16_incl_scan(e) - e; const int ngt = irow16_sum(g); const int need = 16 - ngt;
                const int e1 = ((LAS int*)(tb + 256))[(hd0 + r) * 16 + fr] * 128; const LAS int* i2p = (LAS int*)(tb + 384) + (hd0 + r) * 16;
                LAS float* cs_ = (LAS float*)(tb + 512) + (hd0 + r) * 16; LAS int* ce_ = (LAS int*)(tb + 640) + (hd0 + r) * 16;
#pragma unroll
                for (int j = 0; j < 16; ++j) { const unsigned k = ck[r][j];
                    if (k > Tr) { cs_[gpre] = key2f(k); ce_[gpre] = e1 + i2p[j]; ++gpre; }
                    else if (k == Tr) { if (epre < need) { cs_[ngt + epre] = key2f(k); ce_[ngt + epre] = e1 + i2p[j]; } ++epre; } } }
        }
        asm volatile("s_waitcnt lgkmcnt(0)" ::: "memory");
#pragma unroll 1
      for (int t = 0; t < 2; ++t) {
        const int row = rowA + t; const int v = row < NLAT ? (row >> 12) : 4;
        LAS unsigned* tb = wbase + t * PT_WORDS;
        LAS float* v1l = (LAS float*)tb; LAS float* v2l = v1l + 128; LAS int* i1l = (LAS int*)(v2l + 128); LAS int* i2l = i1l + 128;
        LAS float* csl = (LAS float*)(i2l + 128); LAS int* cel = (LAS int*)(csl + 128); LAS int* el = cel + 128; LAS float* gl = (LAS float*)(el + 160); LAS float* su = gl + 128; LAS float* sv = su + 128;
        {
#pragma unroll
            for (int it = 0; it < 2; ++it) { const int idx = it * 64 + lane;
                const float sx = csl[idx]; const float mx = row16_max(sx); const float pe_ = __expf(sx - mx); const float sm = row16_sum(pe_);
                el[idx] = cel[idx]; gl[idx] = pe_ / sm; }
        }
        if (lane < 32) el[128 + lane] = el[0];
        asm volatile("s_waitcnt vmcnt(0) lgkmcnt(0)" ::: "memory");
        const bool b0_ = lane & 1, b1_ = lane & 2, b2_ = lane & 4;
        u32x4 A[8], B[8], C[8]; unsigned SA[8], SB[8], SC[8];
#define PEER_LOADT(buf, sbuf, tab, g) do { _Pragma("unroll") for (int x = 0; x < 8; ++x) { const int e = __builtin_amdgcn_readfirstlane(el[(g) * 8 + x]); const unsigned char* rp = (tab) + (size_t)e * TBS; \
            buf[x] = *(const u32x4*)(rp + 16 * lane); sbuf[x] = *(const bf16_t*)(rp + 1024 + 2 * lane); } } while (0)
#define PEER_LOADV(buf, g) do { _Pragma("unroll") for (int x = 0; x < 8; ++x) { const int e = __builtin_amdgcn_readfirstlane(el[(g) * 8 + x]); buf[x] = *(const u32x4*)(PV + (size_t)e * 1024 + 16 * lane); } } while (0)
#define FP4X8(w_, f0_, f1_, f2_, f3_) const f32x2 f0_ = __builtin_amdgcn_cvt_scalef32_pk_f32_fp4(w_, 1.0f, 0), f1_ = __builtin_amdgcn_cvt_scalef32_pk_f32_fp4(w_, 1.0f, 1), f2_ = __builtin_amdgcn_cvt_scalef32_pk_f32_fp4(w_, 1.0f, 2), f3_ = __builtin_amdgcn_cvt_scalef32_pk_f32_fp4(w_, 1.0f, 3)
#define PEER_DOT(buf, sbuf, g) do { float p_[8]; \
            _Pragma("unroll") for (int x = 0; x < 8; ++x) { f32x2 s2_ = {0.f, 0.f}; \
                _Pragma("unroll") for (int d = 0; d < 4; ++d) { const unsigned w_ = buf[x][d]; FP4X8(w_, f0_, f1_, f2_, f3_); const int o_ = (d >> 1) * 8 + (d & 1) * 4; \
                    s2_ = hh2[o_ + 0] * f0_ + s2_; s2_ = hh2[o_ + 1] * f1_ + s2_; s2_ = hh2[o_ + 2] * f2_ + s2_; s2_ = hh2[o_ + 3] * f3_ + s2_; } \
                p_[x] = (s2_.x + s2_.y) * __uint_as_float(sbuf[x] << 16); SBAR(); } \
              \
            float q_[4], r_[2]; \
            _Pragma("unroll") for (int j = 0; j < 4; ++j) { const float keep_ = b0_ ? p_[2 * j + 1] : p_[2 * j], send_ = b0_ ? p_[2 * j] : p_[2 * j + 1]; q_[j] = keep_ + dppf<0xB1>(send_); } \
            _Pragma("unroll") for (int j = 0; j < 2; ++j) { const float keep_ = b1_ ? q_[2 * j + 1] : q_[2 * j], send_ = b1_ ? q_[2 * j] : q_[2 * j + 1]; r_[j] = keep_ + dppf<0x4E>(send_); } \
            float t_; { const float keep_ = b2_ ? r_[1] : r_[0], send_ = b2_ ? r_[0] : r_[1]; const float up_ = dppf<0x104>(send_), dn_ = dppf<0x114>(send_); t_ = keep_ + (b2_ ? dn_ : up_); } \
            t_ += dppf<0x128>(t_); \
            { auto r16_ = __builtin_amdgcn_permlane16_swap(__float_as_uint(t_), __float_as_uint(t_), false, false); t_ = __uint_as_float(r16_[0]) + __uint_as_float(r16_[1]); } \
            { auto r32_ = __builtin_amdgcn_permlane32_swap(__float_as_uint(t_), __float_as_uint(t_), false, false); t_ = __uint_as_float(r32_[0]) + __uint_as_float(r32_[1]); } \
            const float av = gelu_erf(t_) * gl[(g) * 8 + (lane & 7)]; const bool me_ = (lane >> 3) == ((g) & 7); \
            avl = (me_ && (g) < 8) ? av : avl; avh = (me_ && (g) >= 8) ? av : avh; } while (0)
#define PIN_ACC() do { asm volatile("" : "+v"(acc2[0]), "+v"(acc2[1]), "+v"(acc2[2]), "+v"(acc2[3]), "+v"(acc2[4]), "+v"(acc2[5]), "+v"(acc2[6]), "+v"(acc2[7]), "+v"(acc2[8]), "+v"(acc2[9]), "+v"(acc2[10]), "+v"(acc2[11]), "+v"(acc2[12]), "+v"(acc2[13]), "+v"(acc2[14]), "+v"(acc2[15])); } while (0)
#define PEER_AXPY(buf, sbuf, g) do { _Pragma("unroll") for (int x = 0; x < 8; ++x) { const int idx = (g) * 8 + x; \
            const float av = __uint_as_float(__builtin_amdgcn_readlane(__float_as_uint(idx < 64 ? avl : avh), idx & 63)) * __uint_as_float(sbuf[x] << 16); const f32x2 av2_ = {av, av}; \
            _Pragma("unroll") for (int d = 0; d < 4; ++d) { const unsigned w_ = buf[x][d]; FP4X8(w_, f0_, f1_, f2_, f3_); const int o_ = (d >> 1) * 8 + (d & 1) * 4; \
                acc2[o_ + 0] = av2_ * f0_ + acc2[o_ + 0]; acc2[o_ + 1] = av2_ * f1_ + acc2[o_ + 1]; acc2[o_ + 2] = av2_ * f2_ + acc2[o_ + 2]; acc2[o_ + 3] = av2_ * f3_ + acc2[o_ + 3]; } PIN_ACC(); } } while (0)
        float avl = 0.f, avh = 0.f;
        PEER_LOADT(A, SA, PU, 0); PEER_LOADT(B, SB, PU, 1); SBAR();
        float hh[32]; ld16_bf16(HB + (size_t)row * D, lane, hh);
        f32x2 hh2[16];
#pragma unroll
        for (int i = 0; i < 16; ++i) hh2[i] = (f32x2){hh[2 * i], hh[2 * i + 1]};
#pragma unroll 1
        for (int g = 0; g < 15; g += 3) { PEER_LOADT(C, SC, PU, g + 2); SBAR(); PEER_DOT(A, SA, g); SBAR(); PEER_LOADT(A, SA, PU, g + 3); SBAR(); PEER_DOT(B, SB, g + 1); SBAR();
            PEER_LOADT(B, SB, (g + 4 < 16 ? PU : PV), (g + 4) & 15); SBAR(); PEER_DOT(C, SC, g + 2); SBAR(); }
        PEER_LOADT(C, SC, PV, 1); SBAR();
        PEER_DOT(A, SA, 15); SBAR();
        f32x2 acc2[16];
#pragma unroll
        for (int i = 0; i < 16; ++i) acc2[i] = (f32x2){0.f, 0.f};
        float* xp = xres_row(F, row);
#pragma unroll 1
        for (int g = 0; g < 15; g += 3) { PEER_LOADT(A, SA, PV, g + 2); SBAR(); PEER_AXPY(B, SB, g); SBAR(); PEER_LOADT(B, SB, PV, g + 3); SBAR(); PEER_AXPY(C, SC, g + 1); SBAR(); PEER_LOADT(C, SC, PV, g + 4); SBAR(); PEER_AXPY(A, SA, g + 2); SBAR(); }
        float x1[32], g2[32]; ld16_f32(xp, lane, x1); ld16_f32(modl + (size_t)v * 12288 + 10240, lane, g2); SBAR();
        PEER_AXPY(B, SB, 15); SBAR();
#undef PEER_LOADT
#undef PEER_LOADV
#undef PEER_DOT
#undef PEER_AXPY
        float acc[32];
        {
#pragma unroll
          for (int i = 0; i < 32; ++i) acc[i] = ALPHA * x1[i] + g2[i] * acc2[i >> 1][i & 1]; }
        { float sm = 0.f;
#pragma unroll
          for (int i = 0; i < 32; ++i) sm += acc[i];
          const float mu = wave_sum(sm) * (1.f / 2048.f); float qq = 0.f;
#pragma unroll
          for (int i = 0; i < 32; ++i) { const float dd = acc[i] - mu; qq += dd * dd; }
          const float rstd = rsqrtf(wave_sum(qq) * (1.f / 2048.f) + LN_EPS);
#pragma unroll
          for (int q = 0; q < 2; ++q)
#pragma unroll
              for (int d = 0; d < 4; ++d) { const int o = 1024 * q + 16 * lane + 4 * d; const f32x4 gg = *(const f32x4*)(g2n + o), bb = *(const f32x4*)(b2n + o);
#pragma unroll
                  for (int i = 0; i < 4; ++i) acc[q * 16 + d * 4 + i] = (acc[q * 16 + d * 4 + i] - mu) * rstd * gg[i] + bb[i]; } }
        st16_f32(xp, lane, acc);
        if (!last) { const float* sh = modn + (size_t)v * 12288; const float* sc = sh + 2048;
#pragma unroll
            for (int q = 0; q < 2; ++q)
#pragma unroll
                for (int d = 0; d < 4; ++d) { const int o = 1024 * q + 16 * lane + 4 * d; const f32x4 hh4 = *(const f32x4*)(sh + o), cc4 = *(const f32x4*)(sc + o);
#pragma unroll
                    for (int i = 0; i < 4; ++i) acc[q * 16 + d * 4 + i] = clamp8(acc[q * 16 + d * 4 + i] * (1.f + cc4[i]) + hh4[i]); }
#pragma unroll
            for (int q = 0; q < 2; ++q) { u32x4 w;
#pragma unroll
                for (int d = 0; d < 4; ++d) w[d] = pk4_fp8(acc[q * 16 + d * 4 + 0], acc[q * 16 + d * 4 + 1], acc[q * 16 + d * 4 + 2], acc[q * 16 + d * 4 + 3]);
                *(u32x4*)(HB8w + (size_t)row * D + 1024 * q + 16 * lane) = w; } }
      }
    }
}
#ifdef DBG
constexpr size_t WS_DBG = WS_CTL + 131072;
constexpr int DBG_NS = 60;
__device__ __forceinline__ int dbg_row(int s) { return (s * 263 + 5) % NLAT; }
__global__ void __launch_bounds__(256) dbg_peer_pre(Args args, int l) {
    __shared__ float q[1024]; __shared__ float s1[128], s2[128]; __shared__ float v1[16], v2[16]; __shared__ int i1[16], i2[16]; __shared__ float cs[256]; __shared__ int ce[256];
    __shared__ float ts[16]; __shared__ int te[16]; __shared__ float red[256]; __shared__ float aval[128]; __shared__ int eid[128]; __shared__ float h2[2048];
    const int s = blockIdx.x, row = dbg_row(s), tid = threadIdx.x; unsigned char* ws = args.ws;
    const bf16_t* QP = (const bf16_t*)(ws + WS_QP); const bf16_t* HB = (const bf16_t*)(ws + WS_HB);
    float* dbgf = (float*)(ws + WS_DBG + 4096); int* dbge = (int*)(dbgf + DBG_NS * 2048); float* dbga = (float*)(dbge + DBG_NS * 128); float* dbgg = dbga + 3 * DBG_NS * 128;
    for (int i = tid; i < 1024; i += 256) q[i] = bf2f(QP[(size_t)row * 1024 + i]);
    for (int i = tid; i < 2048; i += 256) h2[i] = bf2f(HB[(size_t)row * D + i]);
    __syncthreads();
    const float* k1 = args.in[21] + (size_t)l * 8192; const float* k2 = args.in[22] + (size_t)l * 8192;
    for (int hd = 0; hd < 8; ++hd) {
        { const int k = tid & 127; const float* kk = (tid < 128 ? k1 : k2) + k * 64; const float* qq = q + hd * 128 + (tid < 128 ? 0 : 64); float a = 0.f; for (int d = 0; d < 64; ++d) a += qq[d] * kk[d]; (tid < 128 ? s1 : s2)[k] = a; }
        __syncthreads();
        { const int k = tid & 127; const float* sv = tid < 128 ? s1 : s2; const float me = sv[k]; int rank = 0; for (int j = 0; j < 128; ++j) rank += (sv[j] > me || (sv[j] == me && j < k)) ? 1 : 0;
          if (rank < 16) { (tid < 128 ? v1 : v2)[rank] = me; (tid < 128 ? i1 : i2)[rank] = k; } }
        __syncthreads();
        { const int i = tid >> 4, j = tid & 15; cs[tid] = v1[i] + v2[j]; ce[tid] = i1[i] * 128 + i2[j]; }
        __syncthreads();
        { const float me = cs[tid]; int rank = 0; for (int j = 0; j < 256; ++j) rank += (cs[j] > me || (cs[j] == me && j < tid)) ? 1 : 0; if (rank < 16) { ts[rank] = me; te[rank] = ce[tid]; } }
        __syncthreads();
        if (tid < 16) { float mx = ts[0]; float sm = 0.f; for (int j = 0; j < 16; ++j) sm += expf(ts[j] - mx); aval[hd * 16 + tid] = expf(ts[tid] - mx) / sm; eid[hd * 16 + tid] = te[tid]; dbgg[s * 128 + hd * 16 + tid] = aval[hd * 16 + tid]; }
        __syncthreads();
    }
    const float* U = args.in[23] + (size_t)l * 16384 * 2048; const float* V = args.in[24] + (size_t)l * 16384 * 2048;
    for (int e = 0; e < 128; ++e) { const float* ur = U + (size_t)eid[e] * 2048; float p = 0.f; for (int d = tid; d < 2048; d += 256) p += h2[d] * ur[d]; red[tid] = p; __syncthreads();
        for (int st = 128; st > 0; st >>= 1) { if (tid < st) red[tid] += red[tid + st]; __syncthreads(); }
        if (tid == 0) { const float sc = red[0]; aval[e] = 0.5f * sc * (1.f + erff(sc * 0.70710678f)) * aval[e]; } __syncthreads(); }
    float y[8]; const float* xr = args.out + (size_t)row * D; const int v = row >> 12; const float* mod = (const float*)(ws + WS_MOD) + (size_t)l * 5 * 12288 + (size_t)v * 12288;
    float sum = 0.f;
    for (int k = 0; k < 8; ++k) { const int d = tid + 256 * k; float o = 0.f; for (int e = 0; e < 128; ++e) o += aval[e] * V[(size_t)eid[e] * 2048 + d]; y[k] = ALPHA * xr[d] + mod[10240 + d] * o; sum += y[k]; }
    red[tid] = sum; __syncthreads(); for (int st = 128; st > 0; st >>= 1) { if (tid < st) red[tid] += red[tid + st]; __syncthreads(); } const float mu = red[0] / 2048.f; __syncthreads();
    float sq = 0.f; for (int k = 0; k < 8; ++k) sq += (y[k] - mu) * (y[k] - mu);
    red[tid] = sq; __syncthreads(); for (int st = 128; st > 0; st >>= 1) { if (tid < st) red[tid] += red[tid + st]; __syncthreads(); } const float rstd = rsqrtf(red[0] / 2048.f + LN_EPS);
    for (int k = 0; k < 8; ++k) { const int d = tid + 256 * k; dbgf[(size_t)s * 2048 + d] = (y[k] - mu) * rstd * args.in[25][l * D + d] + args.in[26][l * D + d]; }
    if (tid < 128) { dbge[s * 128 + tid] = eid[tid]; dbga[s * 128 + tid] = aval[tid]; }
}
__global__ void __launch_bounds__(256) dbg_peer_post(Args args) {
    __shared__ int bad_e, bad_x, bad_a, bad_g;
    const int s = blockIdx.x, row = dbg_row(s), tid = threadIdx.x; unsigned char* ws = args.ws; unsigned* cnt = (unsigned*)(ws + WS_DBG);
    float* dbgf = (float*)(ws + WS_DBG + 4096); int* dbge = (int*)(dbgf + DBG_NS * 2048); float* dbga = (float*)(dbge + DBG_NS * 128);
    int* fe = (int*)(dbga + DBG_NS * 128); float* fa = (float*)(fe + DBG_NS * 128); float* dbgg = dbga + 3 * DBG_NS * 128; float* fg = dbgg + DBG_NS * 128;
    if (tid == 0) { bad_e = 0; bad_x = 0; bad_a = 0; bad_g = 0; } __syncthreads();
    if (tid < 128) { const int hd = tid >> 4; const int e = dbge[s * 128 + tid]; bool found = false; float af = 0.f, gf = 0.f; for (int j = 0; j < 16; ++j) if (fe[s * 128 + hd * 16 + j] == e) { found = true; af = fa[s * 128 + hd * 16 + j]; gf = fg[s * 128 + hd * 16 + j]; }
        if (!found) atomicAdd(&bad_e, 1); else { const float ea = dbga[s * 128 + tid]; if (fabsf(af - ea) > 0.02f * fabsf(ea) + 2e-3f) atomicAdd(&bad_a, 1); const float eg = dbgg[s * 128 + tid]; if (fabsf(gf - eg) > 0.02f * fabsf(eg) + 1e-3f) atomicAdd(&bad_g, 1); } }
    for (int k = 0; k < 8; ++k) { const int d = tid + 256 * k; const float ex = dbgf[(size_t)s * 2048 + d], got = args.out[(size_t)row * D + d]; if (!(fabsf(got - ex) <= 0.03f + 0.03f * fabsf(ex))) atomicAdd(&bad_x, 1); }
    __syncthreads();
    if (tid == 0) { if (bad_e > 2) atomicAdd(&cnt[1], 1u); if (bad_g > 2) atomicAdd(&cnt[2], 1u); if (bad_a > 2) atomicAdd(&cnt[3], 1u); if (bad_x > 8) atomicAdd(&cnt[4], 1u); }
}
__global__ void dbg_report(Args args) {
    unsigned* cnt = (unsigned*)(args.ws + WS_DBG);
    float code = 0.f;
    for (int lv = 1; lv <= 9; ++lv) if (cnt[lv]) { int tenths = (int)(cnt[lv] * 10 / DBG_NS); if (tenths > 9) tenths = 9; code = 1000.f * lv + 100.f * tenths; break; }
    if (code != 0.f) for (int i = threadIdx.x; i < 4096; i += blockDim.x) args.out[i] = code;
}
#endif
template <int ABL>
__device__ __forceinline__ void p_attn_gqa(const Frame& F, int last) {
    LAS unsigned char* lds = F.lds;
    const unsigned char* QG = wsp<unsigned char>(F, WS_QG); const unsigned char* KG = wsp<unsigned char>(F, WS_KG); const unsigned char* VG = wsp<unsigned char>(F, WS_VG); unsigned char* OAB = wsp<unsigned char>(F, WS_OAB);
    const int nlat = NB * 8 * 16, nall = last ? nlat : nlat + NB * 8;
    for (int u = F.bid; u < nall; u += F.G) {
        int bh, q0, seq; size_t orow;
        if (u < nlat) {
            int uu = u;
            if (F.G == 256) {
                const int c = u & 255, i = u >> 8, xcd = c & 7, r = c >> 3, kvg = i * 4 + (xcd >> 1), within = (xcd & 1) * 32 + r;
                uu = (((kvg >> 1) * 8 + (kvg & 1) * 4 + (within >> 4)) << 4) | (within & 15); }
            bh = uu >> 4; const int qb = uu & 15; q0 = CTXL + qb * 256; seq = TT; orow = (size_t)(bh >> 3) * SEQ + qb * 256; }
        else { bh = u - nlat; q0 = 0; seq = CTXL; orow = (size_t)NLAT + (bh >> 3) * CTXL; }
        const int b = bh >> 3, h = bh & 7; const size_t kvo = (size_t)(b * 2 + (h >> 2)) * TT * 128;
        __syncthreads();
        att::attn_body<4, 0, ABL>(QG + ((size_t)bh * TT + q0) * 128, KG + kvo, VG + (size_t)(b * 2 + (h >> 2)) * 128 * TT, OAB + orow * D + 1024 + h * 128, seq, lds, F.tid);
    }
    __syncthreads();
}
template <int ABL>
__device__ __forceinline__ void p_attn_mla(const Frame& F, int last) {
    LAS unsigned char* lds = F.lds;
    const unsigned char* QM = wsp<unsigned char>(F, WS_QM); const unsigned char* KM = wsp<unsigned char>(F, WS_KM); const unsigned char* VM = wsp<unsigned char>(F, WS_VM); unsigned char* OAB = wsp<unsigned char>(F, WS_OAB);
    const int nlat = NB * 8 * 16, nall = last ? nlat : nlat + NB * 8;
    for (int u = F.bid; u < nall; u += F.G) {
        int bh, q0, seq; size_t orow;
        if (u < nlat) {
            int uu = u;
            if (F.G == 256) { const int c = u & 255, i = u >> 8, xcd = c & 7, r = c >> 3; uu = ((i * 16 + xcd * 2 + (r >> 4)) << 4) | (r & 15); }
            bh = uu >> 4; const int qb = uu & 15; q0 = CTXL + qb * 256; seq = TT; orow = (size_t)(bh >> 3) * SEQ + qb * 256; }
        else { bh = u - nlat; q0 = 0; seq = CTXL; orow = (size_t)NLAT + (bh >> 3) * CTXL; }
        const int h = bh & 7;
        __syncthreads();
        att::attn_body<2, 1, ABL>(QM + ((size_t)bh * TT + q0) * 128, KM + (size_t)bh * TT * 128, VM + (size_t)bh * 64 * TT, OAB + orow * D + h * 64, seq, lds, F.tid);
    }
    __syncthreads();
}
__device__ __forceinline__ void p_ret_out(const Frame& F, int l, int last) {
    const int c_lo = last ? 2 : 0, nc = 34 - c_lo, nu = NB * 8 * nc;
    for (int u = F.bid; u < nu; u += F.G) { const int bh = u / nc, c = c_lo + (u % nc); ret_out_unit(F, l, bh, c); }
    __syncthreads();
}

constexpr int LDS_BYTES = 147456;
constexpr int MISC_OFF = 147456 - 64;
constexpr int NPHASE = 22;
#ifndef PHM
#define PHM 0xFFFF
#endif
#ifndef PH_ATTR
#define PH_ATTR __forceinline__
#endif
template <int PART> __device__ PH_ATTR void ph_prologue(ArgP ap) { const Frame F = make_frame(ap); p0_prologue<PART>(F); }
__device__ PH_ATTR void ph_modreduce(ArgP ap) { const Frame F = make_frame(ap); p1_modreduce(F); }
__device__ PH_ATTR void ph_modulate0(ArgP ap) { const Frame F = make_frame(ap); p_modulate0(F); }
template <int GABL> __device__ PH_ATTR void ph_gemm_in(ArgP ap, int l) { const Frame F = make_frame(ap);
    pg8::Gemm g{wsp<bf16_t>(F, WS_HB8), wsp<bf16_t>(F, WS_WIN + l * SZ_WIN), NROW, NPT, 1024, 1024, 1024}; pg8::StaticOrder S; S.init(NROW, NPT, F.G, F.bid);
    float mul_, inv_; fp8_scale(wsp<unsigned>(F, WS_WSC)[l], mul_, inv_);
    EpiIn E{wsp<bf16_t>(F, WS_P1), wsp<bf16_t>(F, WS_G), inv_};
    pg8::gemm_phase<EpiIn, pg8::StaticOrder, GABL>(F.lds, F.tid, g, S, E); }
__device__ PH_ATTR void ph_post(ArgP ap, int l) { const Frame F = make_frame(ap); p_post(F, l); if (l == 1) cvt_peer(F, 1); }
__device__ PH_ATTR void ph_qup(ArgP ap, int l) { const Frame F = make_frame(ap);
    pg8::Gemm g{wsp<bf16_t>(F, WS_CQN), wsp<bf16_t>(F, WS_WQUP + l * SZ_WQUP), NROW, 768, 512, 512, 512}; pg8::StaticOrder S; S.init(NROW, 768, F.G, F.bid);
    EpiQup E{wsp<unsigned char>(F, WS_QM), wsp<f32x2>(F, WS_ROPE32)};
    pg8::gemm_phase<EpiQup, pg8::StaticOrder>(F.lds, F.tid, g, S, E); }
__device__ PH_ATTR void ph_kvup(ArgP ap, int l) { const Frame F = make_frame(ap);
    pg8::Gemm g{wsp<bf16_t>(F, WS_CKVN), wsp<bf16_t>(F, WS_WKVUP + l * SZ_WKVUP), NROW, 1024, 256, 256, 256}; pg8::StaticOrder S; S.init(NROW, 1024, F.G, F.bid);
    EpiKvup E{wsp<unsigned char>(F, WS_KM), wsp<unsigned char>(F, WS_VM)};
    pg8::gemm_phase<EpiKvup, pg8::StaticOrder>(F.lds, F.tid, g, S, E); }
__device__ PH_ATTR void ph_states(ArgP ap, int l) { const Frame F = make_frame(ap); p_ret_states(F, l); }
template <int ABL> __device__ PH_ATTR void ph_attn_gqa(ArgP ap, int last) { const Frame F = make_frame(ap); p_attn_gqa<ABL>(F, last); }
template <int ABL> __device__ PH_ATTR void ph_attn_mla(ArgP ap, int last) { const Frame F = make_frame(ap); p_attn_mla<ABL>(F, last); }
__device__ PH_ATTR void ph_ret_out(ArgP ap, int l, int last) { const Frame F = make_frame(ap); p_ret_out(F, l, last); }
template <int SEG> __device__ PH_ATTR void ph_merge(ArgP ap, int l, int Mx) { const Frame F = make_frame(ap);
    const bf16_t* OAB = wsp<bf16_t>(F, WS_OAB); bf16_t* MB = wsp<bf16_t>(F, WS_MB); const bf16_t* G = wsp<bf16_t>(F, WS_G);
    pg8::StaticOrder S; S.init(Mx, 2048, F.G, F.bid);
    const size_t wo = SEG == 0 ? WS_WBRA + l * SZ_WBRA : (SEG == 1 ? WS_WBRB + l * SZ_WBRB : WS_WBRC + l * SZ_WBRC); const int K = SEG == 2 ? 1024 : 512;
    pg8::Gemm g{OAB + SEG * 512, wsp<bf16_t>(F, wo), Mx, 2048, K, 2048, K}; EpiMerge<SEG> E{MB, G, wsp<unsigned char>(F, WS_MB8)}; pg8::gemm_phase<EpiMerge<SEG>, pg8::StaticOrder>(F.lds, F.tid, g, S, E); }
__device__ PH_ATTR void ph_merge3(ArgP ap, int l, int Mx) { const Frame F = make_frame(ap);
    pg8::StaticOrder S; S.init(Mx, 2048, F.G, F.bid);
    float m0_, i0_, m1_, i1_, m2_, i2_; fp8_scale(wsp<unsigned>(F, WS_WSC)[4 + l], m0_, i0_); fp8_scale(wsp<unsigned>(F, WS_WSC)[6 + l], m1_, i1_); fp8_scale(wsp<unsigned>(F, WS_WSC)[8 + l], m2_, i2_);
    pg8::Merge3 g{wsp<bf16_t>(F, WS_OAB), wsp<bf16_t>(F, WS_WBRA + l * SZ_WBRA), wsp<bf16_t>(F, WS_WBRB + l * SZ_WBRB), wsp<bf16_t>(F, WS_WBRC + l * SZ_WBRC), wsp<bf16_t>(F, WS_G), wsp<unsigned char>(F, WS_MB8), i0_ * m1_, i1_ * m2_, i2_};
    pg8::gemm_merge3<pg8::StaticOrder>(F.lds, F.tid, g, S); }
__device__ PH_ATTR void ph_out(ArgP ap, int l, int Mx) { const Frame F = make_frame(ap);
    pg8::Gemm g{wsp<bf16_t>(F, WS_MB8), wsp<bf16_t>(F, WS_WOUT + l * SZ_WOUT), Mx, 2048, 1024, 1024, 1024}; pg8::StaticOrder S; S.init(Mx, 2048, F.G, F.bid);
    float mul_, inv_; fp8_scale(wsp<unsigned>(F, WS_WSC)[2 + l], mul_, inv_);
    EpiOut E{l == 0 ? F.in(0) : F.out, l == 0 ? F.in(2) : wsp<float>(F, WS_XC), F.out, wsp<float>(F, WS_XC), wsp<float>(F, WS_MOD) + (size_t)l * 5 * 12288 + 4096, inv_ * (1.f / 16.f)};
    pg8::gemm_phase<EpiOut, pg8::StaticOrder>(F.lds, F.tid, g, S, E); }
__device__ PH_ATTR void ph_ln1(ArgP ap, int l, int last) { const Frame F = make_frame(ap); p_ln1(F, l, last); }
__device__ PH_ATTR void ph_peerq(ArgP ap, int l, int Mx) { const Frame F = make_frame(ap);
    pg8::Gemm g{wsp<bf16_t>(F, WS_HB), wsp<bf16_t>(F, WS_WPQ + l * SZ_WPQ), Mx, 1024, 2048, 2048, 2048}; pg8::StaticOrder S; S.init(Mx, 1024, F.G, F.bid);
    EpiPlain E{wsp<bf16_t>(F, WS_QP), 1024};
    pg8::gemm_phase<EpiPlain, pg8::StaticOrder>(F.lds, F.tid, g, S, E); }
__device__ PH_ATTR void ph_peer(ArgP ap, int l, int last) { const Frame F = make_frame(ap); p_peer(F, l, last); }

__global__ void __launch_bounds__(512, 2) mega_fwd(Args args) {
    extern __shared__ __attribute__((aligned(16))) unsigned char lds_raw[];
    const ArgP ap = (ArgP)__builtin_amdgcn_kernarg_segment_ptr();
    const int lo = ap->ph_lo, hi = ap->ph_hi;
    volatile LAS unsigned* misc = (volatile LAS unsigned*)((LAS unsigned char*)lds_raw + MISC_OFF);
    if (threadIdx.x < 4) misc[threadIdx.x] = 0u;
    __syncthreads();
    XcdBarrier bar; bar.bar = (unsigned*)(ap->ws + WS_CTL); bar.x = 0; bar.st = misc;
    if (hi - lo > 1) bar = xcd_barrier_post((unsigned*)(ap->ws + WS_CTL), misc);
#ifdef BENCH_K
    { float a[16]; f32x2 b2[8];
#pragma unroll
      for (int i = 0; i < 16; ++i) a[i] = 1.f + threadIdx.x * 1e-3f + i;
#pragma unroll
      for (int i = 0; i < 8; ++i) b2[i] = (f32x2){a[i], a[i + 8]};
      float c0 = a[3], c1 = a[5];
#define B16(INS) asm volatile(INS(0) INS(1) INS(2) INS(3) INS(4) INS(5) INS(6) INS(7) INS(8) INS(9) INS(10) INS(11) INS(12) INS(13) INS(14) INS(15) \
        : "+v"(a[0]), "+v"(a[1]), "+v"(a[2]), "+v"(a[3]), "+v"(a[4]), "+v"(a[5]), "+v"(a[6]), "+v"(a[7]), "+v"(a[8]), "+v"(a[9]), "+v"(a[10]), "+v"(a[11]), "+v"(a[12]), "+v"(a[13]), "+v"(a[14]), "+v"(a[15]) : "v"(c0), "v"(c1))
#define I_ADD(i) "v_add_f32 %" #i ", %" #i ", %16\n"
#define I_EXP(i) "v_exp_f32 %" #i ", %" #i "\n"
#define I_MAX3(i) "v_max3_f32 %" #i ", %" #i ", %16, %17\n"
#define I_CVT(i) "v_cvt_pk_fp8_f32 %" #i ", %16, %17\n"
#define I_DEP(i) "v_max3_f32 %0, %0, %16, %17\n"
#define I_DEPA(i) "v_add_f32 %0, %0, %16\n"
#define I_FMA(i) "v_fma_f32 %" #i ", %" #i ", %16, %17\n"
#define P8(INS) asm volatile(INS(0) INS(1) INS(2) INS(3) INS(4) INS(5) INS(6) INS(7) INS(0) INS(1) INS(2) INS(3) INS(4) INS(5) INS(6) INS(7) \
        : "+v"(b2[0]), "+v"(b2[1]), "+v"(b2[2]), "+v"(b2[3]), "+v"(b2[4]), "+v"(b2[5]), "+v"(b2[6]), "+v"(b2[7]) : "v"(b2[0]))
#define I_PKADD(i) "v_pk_add_f32 %" #i ", %" #i ", %8\n"
#define I_PKFMA(i) "v_pk_fma_f32 %" #i ", %" #i ", %8, %8\n"
#pragma unroll 1
      for (int it = 0; it < 20000; ++it) {
#if BENCH_K == 1
        B16(I_ADD);
#elif BENCH_K == 2
        B16(I_EXP);
#elif BENCH_K == 3
        B16(I_MAX3);
#elif BENCH_K == 4
        B16(I_CVT);
#elif BENCH_K == 5
        P8(I_PKADD);
#elif BENCH_K == 6
        P8(I_PKFMA);
#elif BENCH_K == 7
        B16(I_FMA);
#elif BENCH_K == 9
        B16(I_DEP);
#elif BENCH_K == 10
        B16(I_DEPA);
#endif
      }
#if BENCH_K == 11 || BENCH_K == 12
      { f32x16 q0 = {}, q1 = {}, q2 = {}, q3 = {}; att::i32x8a x8 = {1, 2, 3, 4, 5, 6, 7, (int)threadIdx.x};
#pragma unroll 1
        for (int it = 0; it < 2000; ++it) {
#pragma unroll
          for (int k = 0; k < 4; ++k) {
            q0 = __builtin_amdgcn_mfma_scale_f32_32x32x64_f8f6f4(x8, x8, q0, 0, 0, 0, 0x7F7F7F7F, 0, 0x7F7F7F7F); asm volatile("" : "+v"(q0));
#if BENCH_K == 11
            B16(I_ADD);
#else
            B16(I_EXP);
#endif
            q1 = __builtin_amdgcn_mfma_scale_f32_32x32x64_f8f6f4(x8, x8, q1, 0, 0, 0, 0x7F7F7F7F, 0, 0x7F7F7F7F); asm volatile("" : "+v"(q1));
#if BENCH_K == 11
            B16(I_ADD);
#else
            B16(I_EXP);
#endif
            q2 = __builtin_amdgcn_mfma_scale_f32_32x32x64_f8f6f4(x8, x8, q2, 0, 0, 0, 0x7F7F7F7F, 0, 0x7F7F7F7F); asm volatile("" : "+v"(q2));
#if BENCH_K == 11
            B16(I_ADD);
#else
            B16(I_EXP);
#endif
            q3 = __builtin_amdgcn_mfma_scale_f32_32x32x64_f8f6f4(x8, x8, q3, 0, 0, 0, 0x7F7F7F7F, 0, 0x7F7F7F7F); asm volatile("" : "+v"(q3));
#if BENCH_K == 11
            B16(I_ADD);
#else
            B16(I_EXP);
#endif
          }
          asm volatile("" : "+v"(x8)); } }
#endif
#if BENCH_K == 8
      { f32x16 q0 = {}, q1 = {}, q2 = {}, q3 = {}; att::i32x8a x8 = {1, 2, 3, 4, 5, 6, 7, (int)threadIdx.x};
#pragma unroll 1
        for (int it = 0; it < 2000; ++it) {
#pragma unroll
          for (int k = 0; k < 4; ++k) { q0 = __builtin_amdgcn_mfma_scale_f32_32x32x64_f8f6f4(x8, x8, q0, 0, 0, 0, 0x7F7F7F7F, 0, 0x7F7F7F7F); q1 = __builtin_amdgcn_mfma_scale_f32_32x32x64_f8f6f4(x8, x8, q1, 0, 0, 0, 0x7F7F7F7F, 0, 0x7F7F7F7F);
            q2 = __builtin_amdgcn_mfma_scale_f32_32x32x64_f8f6f4(x8, x8, q2, 0, 0, 0, 0x7F7F7F7F, 0, 0x7F7F7F7F); q3 = __builtin_amdgcn_mfma_scale_f32_32x32x64_f8f6f4(x8, x8, q3, 0, 0, 0, 0x7F7F7F7F, 0, 0x7F7F7F7F); }
          asm volatile("" : "+v"(q0), "+v"(q1), "+v"(q2), "+v"(q3), "+v"(x8)); } }
#endif
    }
#endif
#define IN(k) (lo <= (k) && (k) < hi)
#define SEAM(k) do { if (IN(k) && IN((k) + 1)) xcd_barrier(bar); } while (0)
    if (IN(0)) { if (PHM & 1) ph_prologue<7>(ap); if (REP_PRO) ph_prologue<REP_PRO>(ap); } SEAM(0);
    if (IN(1)) { if (PHM & 2) ph_modreduce(ap); if (REP_X & 32) ph_modreduce(ap); } SEAM(1);
#pragma unroll 1
    for (int l = 0; l < 2; ++l) {
        const int pb = 2 + 10 * l; const int last = (l == 1);
        const int Mx = last ? NLAT : NROW;
        if (l == 0) { if (IN(pb)) { if (PHM & 4) ph_modulate0(ap); if (REP_X & 64) ph_modulate0(ap); } SEAM(pb); }
        if (IN(pb + 1)) { if (REP_GIN) ph_gemm_in<GIN_ABL>(ap, l); if (PHM & 8) ph_gemm_in<0>(ap, l); } SEAM(pb + 1);
        if (IN(pb + 2)) { if (PHM & 16) ph_post(ap, l); if (REP_X & 1) ph_post(ap, l); } SEAM(pb + 2);
        if (IN(pb + 3)) { if (PHM & 32) ph_qup(ap, l); if (PHM & 64) ph_kvup(ap, l); if (PHM & 128) ph_states(ap, l); if (REP_X & 2) { ph_qup(ap, l); ph_kvup(ap, l); ph_states(ap, l); } } SEAM(pb + 3);
        if (IN(pb + 4)) { if (REP_ATTN & 1) ph_attn_gqa<ATT_ABL>(ap, last); if (REP_ATTN & 2) ph_attn_mla<ATT_ABL>(ap, last); if (PHM & 256) ph_attn_gqa<0>(ap, last); if (PHM & 512) ph_attn_mla<0>(ap, last); if (REP_X & 4) ph_ret_out(ap, l, last); if (PHM & 1024) ph_ret_out(ap, l, last); } SEAM(pb + 4);
        if (IN(pb + 5)) { if (PHM & 2048) { if (MERGE3) ph_merge3(ap, l, Mx); else { ph_merge<0>(ap, l, Mx); ph_merge<1>(ap, l, Mx); ph_merge<2>(ap, l, Mx); } } if (REP_X & 8) { if (MERGE3) ph_merge3(ap, l, Mx); else { ph_merge<0>(ap, l, Mx); ph_merge<1>(ap, l, Mx); ph_merge<2>(ap, l, Mx); } } } SEAM(pb + 5);
        if (IN(pb + 6)) { if (PHM & 4096) ph_out(ap, l, Mx); if (REP_X & 128) ph_out(ap, l, Mx); } SEAM(pb + 6);
        if (IN(pb + 7)) { if (PHM & 8192) ph_ln1(ap, l, last); if (REP_X & 256) ph_ln1(ap, l, last); } SEAM(pb + 7);
        if (IN(pb + 8)) { if (PHM & 16384) ph_peerq(ap, l, Mx); if (REP_X & 16) ph_peerq(ap, l, Mx); } SEAM(pb + 8);
        if (IN(pb + 9)) { if (PHM & 32768) ph_peer(ap, l, last); } SEAM(pb + 9);
    }
#undef IN
#undef SEAM
}

extern "C" void kernel_launch(void* const* d_in, const int* in_sizes, int n_in, void* d_out, int out_size, void* d_ws, size_t ws_size, hipStream_t stream) {
    static int grid = 0;
    if (grid == 0) {
        if (n_in != 27 || out_size != NLAT * D || ws_size < WS_END) { fprintf(stderr, "kernel_launch: unexpected shapes: n_in %d out %d ws %zu (need %zu)\n", n_in, out_size, ws_size, (size_t)WS_END); grid = -1; return; }
        int dev = 0, cus = 0, per_cu = 0;
        if (hipGetDevice(&dev) != hipSuccess || hipDeviceGetAttribute(&cus, hipDeviceAttributeMultiprocessorCount, dev) != hipSuccess) { grid = -1; return; }
        if (hipFuncSetAttribute((const void*)mega_fwd, hipFuncAttributeMaxDynamicSharedMemorySize, LDS_BYTES) != hipSuccess) { fprintf(stderr, "kernel_launch: hipFuncSetAttribute failed\n"); grid = -1; return; }
        if (hipOccupancyMaxActiveBlocksPerMultiprocessor(&per_cu, (const void*)mega_fwd, 512, LDS_BYTES) != hipSuccess || per_cu < 1) fprintf(stderr, "kernel_launch: occupancy query reports %d\n", per_cu);
        (void)hipGetLastError();
        grid = cus;
    }
    if (grid < 0) return;
    (void)hipMemsetAsync((char*)d_ws + WS_CTL, 0, 65536, stream);
#ifdef DBG
    (void)hipMemsetAsync((char*)d_ws + WS_CTL + 131072, 0, 4096, stream);
#endif
    Args a{};
    for (int i = 0; i < 27; ++i) a.in[i] = (const float*)d_in[i];
    a.out = (float*)d_out; a.ws = (unsigned char*)d_ws;
#if MK_PER_PHASE
    for (int p = 0; p < NPHASE; ++p) { if (p == 12) continue; a.ph_lo = p; a.ph_hi = p + 1;
#ifdef DBG
        if (p == 11) hipLaunchKernelGGL(dbg_peer_pre, dim3(DBG_NS), dim3(256), 0, stream, a, 0);
#endif
        hipLaunchKernelGGL(mega_fwd, dim3(grid), dim3(512), LDS_BYTES, stream, a);
#ifdef DBG
        if (p == 11) hipLaunchKernelGGL(dbg_peer_post, dim3(DBG_NS), dim3(256), 0, stream, a);
#endif
    }
#ifdef DBG
    hipLaunchKernelGGL(dbg_report, dim3(1), dim3(256), 0, stream, a);
#endif
#else
    a.ph_lo = 0; a.ph_hi = NPHASE;
    hipLaunchKernelGGL(mega_fwd, dim3(grid), dim3(512), LDS_BYTES, stream, a);
#endif
    const hipError_t le = hipPeekAtLastError();
    if (le != hipSuccess) fprintf(stderr, "kernel_launch: launch failed: %s\n", hipGetErrorName(le));
}
```

```cpp
#include <hip/hip_runtime.h>
#include <cstdio>
#include <cstdint>
#include <cstddef>

#ifndef MK_PER_PHASE
#define MK_PER_PHASE 0
#endif

#ifndef ABL_PEER
#define ABL_PEER 0
#endif
#ifndef REP_PEERG
#define REP_PEERG 0
#endif
#ifndef REP_PEERH
#define REP_PEERH 0
#endif
#ifndef REP_X
#define REP_X 0
#endif
#ifndef REP_PS1
#define REP_PS1 0
#endif
#ifndef REP_PS2
#define REP_PS2 0
#endif
#ifndef SIDE_ON
#define SIDE_ON 1
#endif
#ifndef REP_DOT
#define REP_DOT 0
#endif
#ifndef MERGE3
#define MERGE3 1
#endif
#ifndef REP_GIN
#define REP_GIN 0
#endif
#ifndef PS1_ABL
#define PS1_ABL 0
#endif
#ifndef GIN_ABL
#define GIN_ABL 0
#endif
#ifndef ATT_ABL
#define ATT_ABL 0
#endif
#ifndef REP_ATTN
#define REP_ATTN 0
#endif
#ifndef REP_PRO
#define REP_PRO 0
#endif
#ifndef ABL_BR
#define ABL_BR 0
#endif
#ifndef ABL_MIX
#define ABL_MIX 0
#endif
#define LAS __attribute__((address_space(3)))
typedef unsigned short bf16_t;
typedef short bf16x8 __attribute__((ext_vector_type(8)));
typedef short s16x4 __attribute__((ext_vector_type(4)));
typedef float f32x2 __attribute__((ext_vector_type(2)));
typedef float f32x4 __attribute__((ext_vector_type(4)));
typedef float f32x8 __attribute__((ext_vector_type(8)));
typedef float f32x16 __attribute__((ext_vector_type(16)));
typedef unsigned u32x2 __attribute__((ext_vector_type(2)));
typedef unsigned u32x4 __attribute__((ext_vector_type(4)));
typedef __bf16 bf2_t __attribute__((ext_vector_type(2)));

constexpr int D = 2048, NB = 4, SEQ = 4096, CTXL = 256, TT = SEQ + CTXL;
constexpr int NLAT = NB * SEQ, NCTX = NB * CTXL, NROW = NLAT + NCTX;
constexpr int NP1 = 4096, NG = 6144, NPT = NP1 + NG;
constexpr int NIN = 10016;
constexpr float ALPHA = 1.4142135623730951f;
constexpr float LN_EPS = 1e-5f, RMS_EPS = 1e-6f;
constexpr float LOG2E = 1.4426950408889634f;
constexpr int C_CQ = 0, C_CKV = 512, C_GQ = 768, C_GK = 1792, C_GV = 2048, C_RQ = 2304, C_RK = 2560, C_RV = 2816, C_RG = 3328, C_KR = 3840;

constexpr size_t AL(size_t x) { return (x + 255) / 256 * 256; }
constexpr size_t WS_CTL = 0;                                    constexpr size_t CTL_BYTES = 1u << 20;
constexpr size_t WS_WSC = WS_CTL + 32768;
constexpr size_t WS_CVT = WS_CTL + 33024;
constexpr size_t WS_DEC = WS_CTL + 65536;
constexpr size_t WS_ROPE32 = WS_CTL + CTL_BYTES;
constexpr size_t WS_ROPE128 = WS_ROPE32 + AL(64 * 8 * 8);
constexpr size_t WS_MODP = WS_ROPE128 + AL(64 * 32 * 8);
constexpr size_t WS_MOD = WS_MODP + AL((size_t)16 * 2 * 5 * 12288 * 4);
constexpr size_t WS_WIN = WS_MOD + AL((size_t)2 * 5 * 12288 * 4);
constexpr size_t SZ_WIN = (size_t)NPT * D;
constexpr size_t WS_WQUP = WS_WIN + 2 * SZ_WIN;                 constexpr size_t SZ_WQUP = (size_t)768 * 512 * 2;
constexpr size_t WS_WKVUP = WS_WQUP + 2 * SZ_WQUP;              constexpr size_t SZ_WKVUP = (size_t)1024 * 256 * 2;
constexpr size_t WS_WBRA = WS_WKVUP + 2 * SZ_WKVUP;             constexpr size_t SZ_WBRA = (size_t)2048 * 512 * 2;
constexpr size_t WS_WBRB = WS_WBRA + 2 * SZ_WBRA;               constexpr size_t SZ_WBRB = SZ_WBRA;
constexpr size_t WS_WBRC = WS_WBRB + 2 * SZ_WBRB;               constexpr size_t SZ_WBRC = (size_t)2048 * 1024 * 2;
constexpr size_t WS_WOUT = WS_WBRC + 2 * SZ_WBRC;               constexpr size_t SZ_WOUT = (size_t)2048 * 2048 * 2;
constexpr size_t WS_WPQ = WS_WOUT + 2 * SZ_WOUT;                constexpr size_t SZ_WPQ = (size_t)1024 * 2048 * 2;
constexpr size_t WS_PSC = WS_WPQ + 2 * SZ_WPQ;
constexpr size_t WS_PU = WS_PSC + (size_t)4 * 16384 * 4;        constexpr size_t SZ_PT = (size_t)16384 * 1152;
constexpr size_t WS_PV = WS_PU + 2 * SZ_PT;
constexpr size_t WS_XC = WS_PV + 2 * SZ_PT;
constexpr size_t WS_HB = WS_XC + (size_t)NCTX * D * 4;
constexpr size_t WS_P1 = WS_HB + (size_t)NROW * D * 2;
constexpr size_t WS_G = WS_P1 + (size_t)NROW * NP1 * 2;
constexpr size_t WS_CQN = WS_G + (size_t)NROW * NG * 2;
constexpr size_t WS_CKVN = WS_CQN + (size_t)NROW * 512 * 2;
constexpr size_t WS_QM = WS_CKVN + (size_t)NROW * 256 * 2;
constexpr size_t SZ_Q128 = (size_t)NB * 8 * TT * 128 * 2;
constexpr size_t WS_KM = WS_QM + SZ_Q128;
constexpr size_t WS_VM = WS_KM + SZ_Q128;
constexpr size_t WS_QG = WS_VM + SZ_Q128 / 2;
constexpr size_t WS_KG = WS_QG + SZ_Q128;
constexpr size_t WS_VG = WS_KG + SZ_Q128 / 4;
constexpr size_t WS_RQ = WS_VG + SZ_Q128 / 4;
constexpr size_t WS_RK = WS_RQ + SZ_Q128 / 4;
constexpr size_t WS_RV = WS_RK + SZ_Q128 / 4;
constexpr size_t WS_ST = WS_RV + SZ_Q128 / 2;
constexpr size_t WS_OAB = WS_ST + (size_t)NB * 8 * 34 * 2 * 2048 * 4;
constexpr size_t WS_HB8 = WS_OAB + (size_t)NROW * D * 2;
constexpr size_t WS_MB8 = WS_HB8 + (size_t)NROW * D;
constexpr size_t WS_S1 = WS_MB8 + (size_t)NROW * D;
constexpr size_t WS_END = WS_S1 + (size_t)NROW * D * 2;
constexpr size_t WS_MB = WS_QM;
constexpr size_t WS_QP = WS_QG;
static_assert((size_t)NROW * D * 2 <= 2 * SZ_Q128, "MB alias");
static_assert((size_t)NROW * 1024 * 2 <= SZ_Q128, "QP alias");

__device__ __forceinline__ unsigned cvt_pk_bf16(float lo, float hi) { unsigned r; asm volatile("v_cvt_pk_bf16_f32 %0, %1, %2" : "=v"(r) : "v"(lo), "v"(hi)); return r; }
__device__ __forceinline__ bf16_t f2bf(float f) { return (bf16_t)(cvt_pk_bf16(f, 0.f) & 0xffffu); }
__device__ __forceinline__ float bf2f(bf16_t b) { return __uint_as_float(((unsigned)b) << 16); }
__device__ __forceinline__ float bflo(unsigned w) { return __uint_as_float(w << 16); }
__device__ __forceinline__ float bfhi(unsigned w) { return __uint_as_float(w & 0xffff0000u); }
template <int CTRL> __device__ __forceinline__ float dppf(float x) { return __int_as_float(__builtin_amdgcn_update_dpp(0, __float_as_int(x), CTRL, 0xF, 0xF, true)); }
__device__ __forceinline__ float row16_sum(float x) { x += dppf<0xB1>(x); x += dppf<0x4E>(x); x += dppf<0x141>(x); x += dppf<0x140>(x); return x; }
__device__ __forceinline__ float row16_max(float x) { x = fmaxf(x, dppf<0xB1>(x)); x = fmaxf(x, dppf<0x4E>(x)); x = fmaxf(x, dppf<0x141>(x)); x = fmaxf(x, dppf<0x140>(x)); return x; }
__device__ __forceinline__ float wave_sum(float x) {
    x = row16_sum(x);
    { auto r = __builtin_amdgcn_permlane16_swap(__float_as_uint(x), __float_as_uint(x), false, false); x = __uint_as_float(r[0]) + __uint_as_float(r[1]); }
    { auto r = __builtin_amdgcn_permlane32_swap(__float_as_uint(x), __float_as_uint(x), false, false); x = __uint_as_float(r[0]) + __uint_as_float(r[1]); }
    return x;
}
__device__ __forceinline__ unsigned pk4_fp8(float a, float b, float c, float d) { int t = 0; t = __builtin_amdgcn_cvt_pk_fp8_f32(a, b, t, false); t = __builtin_amdgcn_cvt_pk_fp8_f32(c, d, t, true); return (unsigned)t; }
__device__ __forceinline__ float clamp8(float x) { return fminf(fmaxf(x, -440.f), 440.f); }
__device__ __forceinline__ void fp8_scale(unsigned amax_bits, float& mul, float& inv) { const float am = __uint_as_float(amax_bits); int k = 0; if (am > 0.f) k = (int)floorf(log2f(256.f / am)); k = k > 60 ? 60 : (k < -60 ? -60 : k); mul = exp2f((float)k); inv = exp2f((float)-k); }
__device__ __forceinline__ float silu_f(float x) { return x * __builtin_amdgcn_rcpf(1.f + __builtin_amdgcn_exp2f(x * -1.4426950408889634f)); }
__device__ __forceinline__ float sigmoid_f(float x) { return __builtin_amdgcn_rcpf(1.f + __builtin_amdgcn_exp2f(x * -1.4426950408889634f)); }

__device__ __forceinline__ int vt_off(int tpos) { const int kk = tpos & 63; return (tpos & ~63) + ((kk >> 2) & 1) * 32 + ((kk >> 5) & 1) * 16 + (kk & 3) + 4 * ((kk >> 3) & 3); }
constexpr float QSC_G = 4.f * 0.08838834764831845f * 1.4426950408889634f, QSC_M = 4.f * 0.10206207261596575f * 1.4426950408889634f, KSC8 = 0.25f;
struct RowInfo { int b, tpos, pr, pc, v; bool lat; };
__device__ __forceinline__ RowInfo rowinfo(int row) {
    RowInfo r;
    if (row < NLAT) { r.lat = true; r.b = row >> 12; const int t = row & 4095; r.tpos = CTXL + t; r.pr = t >> 6; r.pc = t & 63; r.v = r.b; }
    else { const int q = row - NLAT; r.lat = false; r.b = q >> 8; r.tpos = q & 255; r.pr = 0; r.pc = 0; r.v = 4; }
    return r;
}

#define XB_TMO      128
#define XB_XCNT(j)  (256  + 64 * (j))
#define XB_XSUB(j)  (1280 + 64 * (j))
#define XB_XGEN(j)  (2304 + 64 * (j))
#define XB_TOP      3328
#define XB_TOPGEN   3392
#define XCD_BAR_WORDS 3456
#define XB_SPIN_CAP (1u << 22)

__device__ __forceinline__ unsigned xb_ld(unsigned* p)              { return __hip_atomic_load(p, __ATOMIC_RELAXED, __HIP_MEMORY_SCOPE_AGENT); }
__device__ __forceinline__ unsigned xb_add(unsigned* p, unsigned v) { return __hip_atomic_fetch_add(p, v, __ATOMIC_RELAXED, __HIP_MEMORY_SCOPE_AGENT); }
__device__ __forceinline__ unsigned xb_xcc_id() { return (unsigned)__builtin_amdgcn_s_getreg((3 << 11) | 20) & 0xFu; }
#define XB_SPIN(cond, bar) do { unsigned _sp = 0; while (cond) { __builtin_amdgcn_s_sleep(1); \
    if ((++_sp & 255u) == 0u) { if (xb_ld(&(bar)[XB_TMO])) break; if (_sp > XB_SPIN_CAP) { atomicAdd(&(bar)[XB_TMO], 1u); break; } } } } while (0)

struct XcdBarrier { unsigned* bar; unsigned x; volatile LAS unsigned* st; };

__device__ __forceinline__ XcdBarrier xcd_barrier_post(unsigned* bar, volatile LAS unsigned* st) {
    XcdBarrier b; b.bar = bar; b.x = xb_xcc_id(); b.st = st;
    if (threadIdx.x == 0) (void)xb_add(&bar[XB_XCNT(b.x)], 1u);
    return b;
}
__device__ __forceinline__ void xcd_barrier_complete(unsigned* bar, unsigned x, unsigned& nloc, unsigned& nx) {
    const unsigned G = gridDim.x * gridDim.y * gridDim.z;
    unsigned sum, cnt, mine, sp = 0u;
    for (;;) {
        sum = 0u; cnt = 0u; mine = 0u;
#pragma unroll
        for (unsigned j = 0; j < 16; ++j) { const unsigned c = xb_ld(&bar[XB_XCNT(j)]); sum += c; cnt += (c > 0u) ? 1u : 0u; mine = (j == x) ? c : mine; }
        if (sum == G) break;
        __builtin_amdgcn_s_sleep(1);
        if ((++sp & 255u) == 0u) { if (xb_ld(&bar[XB_TMO])) break; if (sp > XB_SPIN_CAP) { atomicAdd(&bar[XB_TMO], 1u); break; } }
    }
    nloc = mine > 0u ? mine : 1u; nx = cnt > 0u ? cnt : 1u;
}
__device__ __forceinline__ void xcd_barrier(const XcdBarrier& b) {
    asm volatile("s_waitcnt vmcnt(0)" ::: "memory");
    __syncthreads();
    if (threadIdx.x == 0) {
        unsigned* bar = b.bar;
        __builtin_amdgcn_s_waitcnt(0);
        unsigned nloc = b.st[0], nx = b.st[1];
        if (nloc == 0u) { xcd_barrier_complete(bar, b.x, nloc, nx); b.st[0] = nloc; b.st[1] = nx; }
        const unsigned old = xb_add(&bar[XB_XSUB(b.x)], 1u);
        const unsigned gen = old / nloc;
        if (old + 1u == (gen + 1u) * nloc) {
            __builtin_amdgcn_fence(__ATOMIC_RELEASE, "agent");
            asm volatile("s_waitcnt vmcnt(0)" ::: "memory");
            const unsigned og = xb_add(&bar[XB_TOP], 1u);
            const unsigned tg = og / nx;
            if (og + 1u == (tg + 1u) * nx) xb_add(&bar[XB_TOPGEN], 1u);
            else XB_SPIN(xb_ld(&bar[XB_TOPGEN]) == tg, bar);
            __builtin_amdgcn_fence(__ATOMIC_ACQUIRE, "agent");
            xb_add(&bar[XB_XGEN(b.x)], 1u);
            asm volatile("s_waitcnt vmcnt(0)" ::: "memory");
        } else {
            XB_SPIN(xb_ld(&bar[XB_XGEN(b.x)]) == gen, bar);
            __builtin_amdgcn_fence(__ATOMIC_ACQUIRE, "agent");
            asm volatile("s_waitcnt vmcnt(0)" ::: "memory");
        }
    }
    __syncthreads();
}
namespace pg8 {
constexpr int BM = 256, BK = 64, HALF = 128, HTB = HALF * BK * 2, STAGE_BYTES = 8 * HTB, NXCD = 8, WGM = 8;
__host__ __device__ __forceinline__ int lds_byte(int r, int c) { const int st = (r >> 4) * 2 + (c >> 5), rr = r & 15, cc = c & 31, ob = rr * 64 + cc * 2; return st * 1024 + (ob ^ (((ob >> 9) & 1) << 5)); }
__host__ __device__ __forceinline__ void stage_rc(int b, int& R, int& C) { const int st = b / 1024, sb = b % 1024, swz = sb ^ (((sb >> 9) & 1) << 5); R = (st >> 1) * 16 + swz / 64; C = (st & 1) * 32 + (swz % 64) / 2; }
__host__ __device__ __forceinline__ int perm32(int rho) { const int n = rho >> 4, i = rho & 15; return 8 * (i >> 2) + 4 * n + (i & 3); }

struct Unit { int pm, pn; };
typedef int i32x8 __attribute__((ext_vector_type(8))); typedef int i32x4v __attribute__((ext_vector_type(4)));
__device__ __forceinline__ i32x8 cat8(const bf16x8 a, const bf16x8 b) { const i32x4v x = __builtin_bit_cast(i32x4v, a), y = __builtin_bit_cast(i32x4v, b); return __builtin_shufflevector(x, y, 0, 1, 2, 3, 4, 5, 6, 7); }
struct Gemm { const bf16_t* A; const bf16_t* Bt; int M, N, K, lda, ldb; };

struct StaticOrder {
    int nM, nN, nwg, G, c;
    __host__ __device__ void init(int M, int N, int G_, int c_) { nM = M / BM; nN = N / BM; nwg = nM * nN; G = G_; c = c_; }
    __host__ __device__ bool next(int i, Unit& u) const {
        const long L = (long)i * G + c; if (L >= nwg) return false;
        int wgid = (int)L; { const int q = nwg / NXCD, r = nwg % NXCD, xcd = wgid % NXCD, off = wgid / NXCD; wgid = (xcd < r ? xcd * (q + 1) : r * (q + 1) + (xcd - r) * q) + off; }
        const int nig = WGM * nN, gid = wgid / nig, fm = gid * WGM, gsz = (nM - fm) < WGM ? (nM - fm) : WGM;
        u.pm = fm + ((wgid % nig) % gsz); u.pn = (wgid % nig) / gsz; return true;
    }
    __device__ __forceinline__ void a_ready(const Unit&) const {}
    __device__ __forceinline__ void done(const Unit&) const {}
};

template <class Epi, class Sched, int GABL = 0>
__device__ __forceinline__ void gemm_phase(LAS unsigned char* lds, const int tid, const Gemm g, const Sched& S, const Epi& E) {
    const int  wid = __builtin_amdgcn_readfirstlane(tid >> 6), lane = tid & 63, wr = wid >> 2, wc = wid & 3, fr = lane & 15, fq = lane >> 4;
    const int K = g.K, nt = K / BK;
    unsigned voffA[2], voffB[2];
#pragma unroll
    for (int i = 0; i < 2; ++i) { int R, C; stage_rc(tid * 16 + i * 8192, R, C); const int Rb = Epi::PERM ? ((R & ~31) + perm32(R & 31)) : R;
        voffA[i] = (unsigned)(R * g.lda + C) * 2u; voffB[i] = (unsigned)(Rb * g.ldb + C) * 2u; }
    const size_t kstep = (size_t)(BK * 2);
    const size_t hstepA = (size_t)HALF * g.lda * 2, hstepB = (size_t)HALF * g.ldb * 2;
    const size_t tstepA = 2 * hstepA, tstepB = 2 * hstepB;
    const unsigned ldsw = (unsigned)wid * 1024u;
    const int aoff = lds_byte(wr * 64 + fr, fq * 8), boff = lds_byte(wc * 32 + fr, fq * 8);
#define PG8_SA(b, h) (((b) * 2 + (h)) * HTB)
#define PG8_SB(b, h) ((4 + (b) * 2 + (h)) * HTB)
#define PG8_STAGE(bufoff, gbase, voff) do { if constexpr (!(GABL & 4)) _Pragma("unroll") for (int _i = 0; _i < 2; ++_i) \
        __builtin_amdgcn_global_load_lds((const unsigned*)((const char*)(gbase) + (voff)[_i]), (LAS unsigned*)(lds + (bufoff) + ldsw + _i * 8192), 16, 0, 0); } while (0)
#define PG8_LDA(dst, b, h) do { if constexpr (Epi::FP8) { _Pragma("unroll") for (int m = 0; m < 4; ++m) { const i32x4v lo_ = *(const LAS i32x4v*)(lds + PG8_SA(b, h) + aoff + m * 2048), hi_ = *(const LAS i32x4v*)(lds + PG8_SA(b, h) + aoff + m * 2048 + 1024); \
            dst##8[m] = __builtin_shufflevector(lo_, hi_, 0, 1, 2, 3, 4, 5, 6, 7); } } \
        else { _Pragma("unroll") for (int m = 0; m < 4; ++m) _Pragma("unroll") for (int k = 0; k < 2; ++k) dst[m][k] = *(const LAS bf16x8*)(lds + PG8_SA(b, h) + aoff + m * 2048 + k * 1024); } } while (0)
#define PG8_LDB(dst, b, h) do { if constexpr (Epi::FP8) { _Pragma("unroll") for (int n = 0; n < 2; ++n) { const i32x4v lo_ = *(const LAS i32x4v*)(lds + PG8_SB(b, h) + boff + n * 2048), hi_ = *(const LAS i32x4v*)(lds + PG8_SB(b, h) + boff + n * 2048 + 1024); \
            dst##8[n] = __builtin_shufflevector(lo_, hi_, 0, 1, 2, 3, 4, 5, 6, 7); } } \
        else { _Pragma("unroll") for (int n = 0; n < 2; ++n) _Pragma("unroll") for (int k = 0; k < 2; ++k) dst[n][k] = *(const LAS bf16x8*)(lds + PG8_SB(b, h) + boff + n * 2048 + k * 1024); } } while (0)
#define PG8_MMA(ai, bj, At, Bt) do { __builtin_amdgcn_s_setprio(1); _Pragma("unroll") for (int m = 0; m < 4; ++m) _Pragma("unroll") for (int n = 0; n < 2; ++n) { \
        if constexpr (Epi::FP8) { if constexpr (GABL & 8) asm volatile("" : "+v"(acc[ai][bj][m][n]) : "v"(Bt##8[n]), "v"(At##8[m]), "v"(sc1_)); else asm volatile("v_mfma_scale_f32_16x16x128_f8f6f4 %0, %1, %2, %0, %3, %3 op_sel_hi:[0,0,0]" : "+v"(acc[ai][bj][m][n]) : "v"(Bt##8[n]), "v"(At##8[m]), "v"(sc1_)); } \
        else { _Pragma("unroll") for (int k = 0; k < 2; ++k) acc[ai][bj][m][n] = __builtin_amdgcn_mfma_f32_16x16x32_bf16(Bt[n][k], At[m][k], acc[ai][bj][m][n], 0, 0, 0); } } __builtin_amdgcn_s_setprio(0); } while (0)
#define PG8_WAIT_V(n) asm volatile("s_waitcnt vmcnt(" #n ")" ::: "memory")
#define PG8_WAIT_L(n) asm volatile("s_waitcnt lgkmcnt(" #n ")" ::: "memory")
#define PG8_BAR __builtin_amdgcn_s_barrier()
#define PG8_SCHED __builtin_amdgcn_sched_barrier(0)
    Unit cur, nxt; int ui = 0;
    if (!S.next(0, cur)) return;
    f32x4 acc[2][2][4][2];
#pragma unroll
    for (int a = 0; a < 2; ++a)
#pragma unroll
        for (int b = 0; b < 2; ++b)
#pragma unroll
            for (int m = 0; m < 4; ++m)
#pragma unroll
                for (int n = 0; n < 2; ++n) acc[a][b][m][n] = (f32x4){0.f, 0.f, 0.f, 0.f};
    int sc1_ = 0x7F7F7F7F; asm volatile("" : "+v"(sc1_));
    bf16x8 At[4][2], B0[2][2], B1[2][2]; i32x8 At8[4], B08[2], B18[2];
    const char* cA = (const char*)g.A + (size_t)cur.pm * tstepA; const char* cB = (const char*)g.Bt + (size_t)cur.pn * tstepB;
    S.a_ready(cur);
    PG8_STAGE(PG8_SB(0, 0), cB, voffB); PG8_STAGE(PG8_SA(0, 0), cA, voffA); PG8_STAGE(PG8_SB(0, 1), cB + hstepB, voffB); PG8_STAGE(PG8_SA(0, 1), cA + hstepA, voffA);
    if (wr == 1) PG8_BAR;
    PG8_WAIT_V(4); PG8_BAR;
    PG8_STAGE(PG8_SB(1, 0), cB + kstep, voffB); PG8_STAGE(PG8_SA(1, 0), cA + kstep, voffA); PG8_STAGE(PG8_SB(1, 1), cB + hstepB + kstep, voffB);
    PG8_WAIT_V(6); PG8_BAR;
    for (;;) {
        const bool has_next = S.next(ui + 1, nxt);
        const char* nA = has_next ? (const char*)g.A + (size_t)nxt.pm * tstepA : cA; const char* nB = has_next ? (const char*)g.Bt + (size_t)nxt.pn * tstepB : cB;
#pragma unroll 1
        for (int t = 0; t < nt; t += 2) {
            const bool last = (t == nt - 2);
            const char* a1 = cA + (size_t)(t + 1) * kstep;
            const char* a2 = last ? nA : cA + (size_t)(t + 2) * kstep; const char* b2 = last ? nB : cB + (size_t)(t + 2) * kstep;
            const char* a3 = a2 + kstep; const char* b3 = b2 + kstep;
            if (last && has_next) S.a_ready(nxt);
            PG8_LDB(B0, 0, 0); PG8_SCHED; PG8_LDA(At, 0, 0); PG8_STAGE(PG8_SA(1, 1), a1 + hstepA, voffA);
            PG8_WAIT_L(8); PG8_BAR; PG8_WAIT_L(0); PG8_MMA(0, 0, At, B0); PG8_BAR; PG8_SCHED;
            PG8_LDB(B1, 0, 1); PG8_STAGE(PG8_SB(0, 0), b2, voffB);
            PG8_BAR; PG8_WAIT_L(0); PG8_MMA(0, 1, At, B1); PG8_BAR;
            PG8_LDA(At, 0, 1); PG8_STAGE(PG8_SA(0, 0), a2, voffA);
            PG8_BAR; PG8_WAIT_L(0); PG8_MMA(1, 0, At, B0); PG8_BAR; PG8_SCHED;
            PG8_STAGE(PG8_SB(0, 1), b2 + hstepB, voffB);
            PG8_WAIT_V(6); PG8_BAR; PG8_MMA(1, 1, At, B1); PG8_BAR;
            PG8_LDB(B0, 1, 0); PG8_SCHED; PG8_LDA(At, 1, 0); PG8_STAGE(PG8_SA(0, 1), a2 + hstepA, voffA);
            PG8_WAIT_L(8); PG8_BAR; PG8_WAIT_L(0); PG8_MMA(0, 0, At, B0); PG8_BAR; PG8_SCHED;
            PG8_LDB(B1, 1, 1); PG8_STAGE(PG8_SB(1, 0), b3, voffB);
            PG8_BAR; PG8_WAIT_L(0); PG8_MMA(0, 1, At, B1); PG8_BAR;
            PG8_LDA(At, 1, 1); PG8_STAGE(PG8_SA(1, 0), a3, voffA);
            PG8_BAR; PG8_WAIT_L(0); PG8_MMA(1, 0, At, B0); PG8_BAR; PG8_SCHED;
            PG8_STAGE(PG8_SB(1, 1), b3 + hstepB, voffB);
            PG8_WAIT_V(6); PG8_BAR; PG8_MMA(1, 1, At, B1); PG8_BAR;
        }
        if constexpr (Epi::FP8) asm volatile("s_nop 15\n\ts_nop 15" ::: "memory");
        if constexpr (GABL & 2) { pg8::Unit u2_ = cur; u2_.pm = 0; Epi E2_ = E; E2_.retarget(); E2_(acc, u2_, wr, wc, fr, fq); } else if constexpr (!(GABL & 1)) E(acc, cur, wr, wc, fr, fq); else asm volatile("" :: "v"(acc[0][0][0][0]), "v"(acc[1][1][3][1]), "v"(acc[0][1][2][0]), "v"(acc[1][0][1][1]));
        if (!has_next) break;
#pragma unroll
        for (int a = 0; a < 2; ++a)
#pragma unroll
            for (int b = 0; b < 2; ++b)
#pragma unroll
                for (int m = 0; m < 4; ++m)
#pragma unroll
                    for (int n = 0; n < 2; ++n) acc[a][b][m][n] = (f32x4){0.f, 0.f, 0.f, 0.f};
        cur = nxt; cA = nA; cB = nB; ++ui;
    }
    PG8_WAIT_V(0);
    if (wr == 0) PG8_BAR;
    PG8_BAR;
#undef PG8_SA
#undef PG8_SB
#undef PG8_STAGE
#undef PG8_LDA
#undef PG8_LDB
#undef PG8_MMA
#undef PG8_WAIT_V
#undef PG8_WAIT_L
#undef PG8_BAR
#undef PG8_SCHED
}
}

typedef f32x4 Acc[2][2][4][2];
#define EPI_LOOP_ROWS for (int ai = 0; ai < 2; ++ai) for (int m = 0; m < 4; ++m)
__device__ __forceinline__ u32x4 pack8(const f32x4 a, const f32x4 b) { u32x4 w; w.x = cvt_pk_bf16(a[0], a[1]); w.y = cvt_pk_bf16(a[2], a[3]); w.z = cvt_pk_bf16(b[0], b[1]); w.w = cvt_pk_bf16(b[2], b[3]); return w; }

struct EpiIn {
    static constexpr bool PERM = true, FP8 = true;
    bf16_t* P1; bf16_t* G; float inv;
    __device__ __forceinline__ void retarget() { P1 = (bf16_t*)((char*)P1 - WS_P1 + WS_END); G = P1 + 256 * NP1; }
    __device__ __forceinline__ void operator()(const Acc& acc, const pg8::Unit& u, int wr, int wc, int fr, int fq) const {
        const int row0 = u.pm * 256 + wr * 64 + fr; const bool gate = u.pn >= 16;
        const int col0 = (gate ? (u.pn - 16) : u.pn) * 256 + wc * 32 + 8 * fq;
#pragma unroll
        for (int ai = 0; ai < 2; ++ai)
#pragma unroll
            for (int m = 0; m < 4; ++m) { const size_t row = (size_t)(row0 + ai * 128 + m * 16);
#pragma unroll
                for (int bj = 0; bj < 2; ++bj) { f32x4 v0 = acc[ai][bj][m][0] * inv, v1 = acc[ai][bj][m][1] * inv;
                    if (gate) {
#pragma unroll
                        for (int j = 0; j < 4; ++j) { v0[j] = 256.f * sigmoid_f(v0[j]); v1[j] = 256.f * sigmoid_f(v1[j]); }
                        u32x2 w8; w8.x = pk4_fp8(v0[0], v0[1], v0[2], v0[3]); w8.y = pk4_fp8(v1[0], v1[1], v1[2], v1[3]);
                        __builtin_nontemporal_store(w8, (u32x2*)((unsigned char*)G + row * NG + col0 + bj * 128)); }
                    else __builtin_nontemporal_store(pack8(v0, v1), (u32x4*)(P1 + row * NP1 + col0 + bj * 128)); } }
    }
};
struct EpiPlain {
    static constexpr bool PERM = true, FP8 = false;
    bf16_t* O; int ldc;
    __device__ __forceinline__ void operator()(const Acc& acc, const pg8::Unit& u, int wr, int wc, int fr, int fq) const {
        const int row0 = u.pm * 256 + wr * 64 + fr; const int col0 = u.pn * 256 + wc * 32 + 8 * fq;
#pragma unroll
        for (int ai = 0; ai < 2; ++ai)
#pragma unroll
            for (int m = 0; m < 4; ++m) { bf16_t* rowp = O + (size_t)(row0 + ai * 128 + m * 16) * ldc + col0;
#pragma unroll
                for (int bj = 0; bj < 2; ++bj) *(u32x4*)(rowp + bj * 128) = pack8(acc[ai][bj][m][0], acc[ai][bj][m][1]); }
    }
};
__device__ __forceinline__ void tile_info(int pm, int& b, int& tpos0, bool& lat) { lat = pm < 64; b = lat ? (pm >> 4) : (pm - 64); tpos0 = lat ? CTXL + ((pm & 15) << 8) : 0; }
struct EpiQup {
    static constexpr bool PERM = true, FP8 = false;
    unsigned char* QM; const f32x2* cs32;
    __device__ __forceinline__ void operator()(const Acc& acc, const pg8::Unit& u, int wr, int wc, int fr, int fq) const {
        int b, tpos0; bool lat; tile_info(u.pm, b, tpos0, lat);
        const int r0 = wr * 64 + fr;
#pragma unroll
        for (int bj = 0; bj < 2; ++bj) { const int c0 = u.pn * 256 + bj * 128 + wc * 32 + 8 * fq; const int hh = c0 / 96, j0 = c0 - hh * 96;
            unsigned char* hb = QM + ((size_t)(b * 8 + hh) * TT + tpos0 + r0) * 128;
            if (j0 < 64) {
#pragma unroll
                for (int ai = 0; ai < 2; ++ai)
#pragma unroll
                    for (int m = 0; m < 4; ++m) { const f32x4 a_ = acc[ai][bj][m][0] * QSC_M, b_ = acc[ai][bj][m][1] * QSC_M; u32x2 w8; w8.x = pk4_fp8(clamp8(a_[0]), clamp8(a_[1]), clamp8(a_[2]), clamp8(a_[3])); w8.y = pk4_fp8(clamp8(b_[0]), clamp8(b_[1]), clamp8(b_[2]), clamp8(b_[3]));
                        *(u32x2*)(hb + (ai * 128 + m * 16) * 128 + j0) = w8; }
            } else { const int g8 = (j0 - 64) >> 3, part = g8 >> 1, pbase = (g8 & 1) * 4;
#pragma unroll
                for (int ai = 0; ai < 2; ++ai)
#pragma unroll
                    for (int m = 0; m < 4; ++m) { const int t = tpos0 - CTXL + r0 + ai * 128 + m * 16; const int pos = part ? (t & 63) : (t >> 6);
                        const f32x4 v0 = acc[ai][bj][m][0] * QSC_M, v1 = acc[ai][bj][m][1] * QSC_M;
                        float o1[4], o2[4]; const float x1[4] = {v0[0], v0[2], v1[0], v1[2]}, x2[4] = {v0[1], v0[3], v1[1], v1[3]};
#pragma unroll
                        for (int p = 0; p < 4; ++p) { const f32x2 cs = lat ? cs32[pos * 8 + pbase + p] : (f32x2){1.f, 0.f};
                            o1[p] = x1[p] * cs.x - x2[p] * cs.y; o2[p] = x1[p] * cs.y + x2[p] * cs.x; }
                        unsigned char* dst = hb + (ai * 128 + m * 16) * 128 + 64 + part * 16 + pbase;
                        *(unsigned*)dst = pk4_fp8(clamp8(o1[0]), clamp8(o1[1]), clamp8(o1[2]), clamp8(o1[3])); *(unsigned*)(dst + 8) = pk4_fp8(clamp8(o2[0]), clamp8(o2[1]), clamp8(o2[2]), clamp8(o2[3])); } } }
    }
};
struct EpiKvup {
    static constexpr bool PERM = true, FP8 = false;
    unsigned char* KM; unsigned char* VM;
    __device__ __forceinline__ void operator()(const Acc& acc, const pg8::Unit& u, int wr, int wc, int fr, int fq) const {
        int b, tpos0; bool lat; tile_info(u.pm, b, tpos0, lat);
        const int r0 = wr * 64 + fr; const int j0 = wc * 32 + 8 * fq;
#pragma unroll
        for (int bj = 0; bj < 2; ++bj) { const size_t tok = (size_t)(b * 8 + u.pn * 2 + bj) * TT + tpos0 + r0;
            if (j0 < 64) { unsigned char* d = KM + tok * 128 + j0;
#pragma unroll
                for (int ai = 0; ai < 2; ++ai)
#pragma unroll
                    for (int m = 0; m < 4; ++m) { const f32x4 a_ = acc[ai][bj][m][0] * KSC8, b_ = acc[ai][bj][m][1] * KSC8; u32x2 w8; w8.x = pk4_fp8(clamp8(a_[0]), clamp8(a_[1]), clamp8(a_[2]), clamp8(a_[3])); w8.y = pk4_fp8(clamp8(b_[0]), clamp8(b_[1]), clamp8(b_[2]), clamp8(b_[3]));
                        *(u32x2*)(d + (ai * 128 + m * 16) * 128) = w8; } }
            else { unsigned char* d = VM + ((size_t)(b * 8 + u.pn * 2 + bj) * 64 + (j0 - 64)) * TT;
#pragma unroll
                for (int ai = 0; ai < 2; ++ai)
#pragma unroll
                    for (int m = 0; m < 4; ++m) { const f32x4 a_ = acc[ai][bj][m][0], b_ = acc[ai][bj][m][1]; const unsigned w0_ = pk4_fp8(clamp8(a_[0]), clamp8(a_[1]), clamp8(a_[2]), clamp8(a_[3])), w1_ = pk4_fp8(clamp8(b_[0]), clamp8(b_[1]), clamp8(b_[2]), clamp8(b_[3]));
                        unsigned char* q_ = d + vt_off(tpos0 + r0 + ai * 128 + m * 16);
                        q_[0] = (unsigned char)(w0_ & 0xffu); q_[TT] = (unsigned char)((w0_ >> 8) & 0xffu); q_[2 * TT] = (unsigned char)((w0_ >> 16) & 0xffu); q_[3 * TT] = (unsigned char)(w0_ >> 24);
                        q_[4 * TT] = (unsigned char)(w1_ & 0xffu); q_[5 * TT] = (unsigned char)((w1_ >> 8) & 0xffu); q_[6 * TT] = (unsigned char)((w1_ >> 16) & 0xffu); q_[7 * TT] = (unsigned char)(w1_ >> 24); } } }
    }
};
template <int SEG> struct EpiMerge {
    static constexpr bool PERM = true, FP8 = false;
    bf16_t* MB; const bf16_t* G; unsigned char* MB8;
    __device__ __forceinline__ void operator()(const Acc& acc, const pg8::Unit& u, int wr, int wc, int fr, int fq) const {
        const int row0 = u.pm * 256 + wr * 64 + fr; const int col0 = u.pn * 256 + wc * 32 + 8 * fq;
        const bf16_t* gp = G + (size_t)row0 * NG + SEG * 2048 + col0; bf16_t* mp = MB + (size_t)row0 * D + col0; unsigned char* m8 = MB8 + (size_t)row0 * D + col0;
#pragma unroll
        for (int ai = 0; ai < 2; ++ai) {
            u32x4 gw[4][2], ow[4][2];
#pragma unroll
            for (int m = 0; m < 4; ++m)
#pragma unroll
                for (int bj = 0; bj < 2; ++bj) { const size_t ro = (size_t)(ai * 128 + m * 16);
                    gw[m][bj] = *(const u32x4*)(gp + ro * NG + bj * 128);
                    if (SEG > 0) ow[m][bj] = __builtin_nontemporal_load((const u32x4*)(mp + ro * D + bj * 128)); }
#pragma unroll
            for (int m = 0; m < 4; ++m)
#pragma unroll
                for (int bj = 0; bj < 2; ++bj) { const size_t ro = (size_t)(ai * 128 + m * 16); const u32x4 g_ = gw[m][bj];
                    f32x4 v0 = acc[ai][bj][m][0], v1 = acc[ai][bj][m][1];
                    if (ABL_BR & (1 << SEG)) { v0 = (f32x4){0.f, 0.f, 0.f, 0.f}; v1 = v0; }
                    v0[0] *= bflo(g_.x); v0[1] *= bfhi(g_.x); v0[2] *= bflo(g_.y); v0[3] *= bfhi(g_.y);
                    v1[0] *= bflo(g_.z); v1[1] *= bfhi(g_.z); v1[2] *= bflo(g_.w); v1[3] *= bfhi(g_.w);
                    if (SEG > 0) { const u32x4 o = ow[m][bj];
                        v0[0] += bflo(o.x); v0[1] += bfhi(o.x); v0[2] += bflo(o.y); v0[3] += bfhi(o.y);
                        v1[0] += bflo(o.z); v1[1] += bfhi(o.z); v1[2] += bflo(o.w); v1[3] += bfhi(o.w); }
                    if (SEG < 2) *(u32x4*)(mp + ro * D + bj * 128) = pack8(v0, v1);
                    else { u32x2 w8; w8.x = pk4_fp8(clamp8(v0[0] * 16.f), clamp8(v0[1] * 16.f), clamp8(v0[2] * 16.f), clamp8(v0[3] * 16.f)); w8.y = pk4_fp8(clamp8(v1[0] * 16.f), clamp8(v1[1] * 16.f), clamp8(v1[2] * 16.f), clamp8(v1[3] * 16.f));
                        *(u32x2*)(m8 + ro * D + bj * 128) = w8; } }
        }
    }
};
namespace pg8 {
struct Merge3 { const bf16_t* A; const bf16_t* B0; const bf16_t* B1; const bf16_t* B2; const bf16_t* G; unsigned char* MB8; float r01, r12, fin; };
template <class Sched>
__device__ __forceinline__ void gemm_merge3(LAS unsigned char* lds, const int tid, const Merge3 g, const Sched& S) {
    constexpr int GABL = 0;
    const int wid = __builtin_amdgcn_readfirstlane(tid >> 6), lane = tid & 63, wr = wid >> 2, wc = wid & 3, fr = lane & 15, fq = lane >> 4;
    constexpr int NT = 16, LDA = 1024;
    int sc1_ = 0x7F7F7F7F; asm volatile("" : "+v"(sc1_));
    unsigned voffA[2], voffB5[2], voffB10[2];
#pragma unroll
    for (int i = 0; i < 2; ++i) { int R, C; stage_rc(tid * 16 + i * 8192, R, C); const int Rb = (R & ~31) + perm32(R & 31);
        voffA[i] = (unsigned)(R * LDA + C) * 2u; voffB5[i] = (unsigned)(Rb * 256 + C) * 2u; voffB10[i] = (unsigned)(Rb * 512 + C) * 2u; }
    const size_t kstep = (size_t)(BK * 2);
    const size_t hstepA = (size_t)HALF * LDA * 2, tstepA = 2 * hstepA;
    const unsigned ldsw = (unsigned)wid * 1024u;
    const int aoff = lds_byte(wr * 64 + fr, fq * 8), boff = lds_byte(wc * 32 + fr, fq * 8);
#define M3_TA(pm_, t_) ((const char*)g.A + (size_t)(pm_) * tstepA + (size_t)(t_) * kstep)
#define M3_TB(pn_, t_) ((t_) < 4 ? (const char*)g.B0 + (size_t)(pn_) * 131072 + (size_t)(t_) * kstep : ((t_) < 8 ? (const char*)g.B1 + (size_t)(pn_) * 131072 + (size_t)((t_) - 4) * kstep : (const char*)g.B2 + (size_t)(pn_) * 262144 + (size_t)((t_) - 8) * kstep))
#define PG8_SA(b, h) (((b) * 2 + (h)) * HTB)
#define PG8_SB(b, h) ((4 + (b) * 2 + (h)) * HTB)
#define PG8_STAGE(bufoff, gbase, voff) do { if constexpr (!(GABL & 4)) _Pragma("unroll") for (int _i = 0; _i < 2; ++_i) \
        __builtin_amdgcn_global_load_lds((const unsigned*)((const char*)(gbase) + (voff)[_i]), (LAS unsigned*)(lds + (bufoff) + ldsw + _i * 8192), 16, 0, 0); } while (0)
#define PG8_LDA(dst, b, h) do { _Pragma("unroll") for (int m = 0; m < 4; ++m) { const i32x4v lo_ = *(const LAS i32x4v*)(lds + PG8_SA(b, h) + aoff + m * 2048), hi_ = *(const LAS i32x4v*)(lds + PG8_SA(b, h) + aoff + m * 2048 + 1024); dst[m] = __builtin_shufflevector(lo_, hi_, 0, 1, 2, 3, 4, 5, 6, 7); } } while (0)
#define PG8_LDB(dst, b, h) do { _Pragma("unroll") for (int n = 0; n < 2; ++n) { const i32x4v lo_ = *(const LAS i32x4v*)(lds + PG8_SB(b, h) + boff + n * 2048), hi_ = *(const LAS i32x4v*)(lds + PG8_SB(b, h) + boff + n * 2048 + 1024); dst[n] = __builtin_shufflevector(lo_, hi_, 0, 1, 2, 3, 4, 5, 6, 7); } } while (0)
#define PG8_MMA(ai, bj, At, Bt) do { __builtin_amdgcn_s_setprio(1); _Pragma("unroll") for (int m = 0; m < 4; ++m) _Pragma("unroll") for (int n = 0; n < 2; ++n) \
        asm volatile("v_mfma_scale_f32_16x16x128_f8f6f4 %0, %1, %2, %0, %3, %3 op_sel_hi:[0,0,0]" : "+v"(acc[ai][bj][m][n]) : "v"(Bt[n]), "v"(At[m]), "v"(sc1_)); __builtin_amdgcn_s_setprio(0); } while (0)
#define PG8_WAIT_V(n) asm volatile("s_waitcnt vmcnt(" #n ")" ::: "memory")
#define PG8_WAIT_L(n) asm volatile("s_waitcnt lgkmcnt(" #n ")" ::: "memory")
#define PG8_BAR __builtin_amdgcn_s_barrier()
#define PG8_SCHED __builtin_amdgcn_sched_barrier(0)
    Unit cur, nxt; int ui = 0;
    if (!S.next(0, cur)) return;
    f32x4 acc[2][2][4][2];
#pragma unroll
    for (int a = 0; a < 2; ++a)
#pragma unroll
        for (int b = 0; b < 2; ++b)
#pragma unroll
            for (int m = 0; m < 4; ++m)
#pragma unroll
                for (int n = 0; n < 2; ++n) acc[a][b][m][n] = (f32x4){0.f, 0.f, 0.f, 0.f};
    i32x8 At[4], B0[2], B1[2];
    { const char* cA = M3_TA(cur.pm, 0); const char* cB = M3_TB(cur.pn, 0); const size_t hB = 65536;
      PG8_STAGE(PG8_SB(0, 0), cB, voffB5); PG8_STAGE(PG8_SA(0, 0), cA, voffA); PG8_STAGE(PG8_SB(0, 1), cB + hB, voffB5); PG8_STAGE(PG8_SA(0, 1), cA + hstepA, voffA);
      if (wr == 1) PG8_BAR;
      PG8_WAIT_V(4); PG8_BAR;
      PG8_STAGE(PG8_SB(1, 0), cB + kstep, voffB5); PG8_STAGE(PG8_SA(1, 0), cA + kstep, voffA); PG8_STAGE(PG8_SB(1, 1), cB + hB + kstep, voffB5);
      PG8_WAIT_V(6); PG8_BAR; }
    const int r0 = wr * 64 + fr, c0l = wc * 32 + 8 * fq;
    for (;;) {
        const bool has_next = S.next(ui + 1, nxt);
        const int npm = has_next ? nxt.pm : cur.pm, npn = has_next ? nxt.pn : cur.pn;
#pragma unroll 1
        for (int t = 0; t < NT; t += 2) {
            const bool last = (t == NT - 2);
            const int t2 = last ? 0 : t + 2;
            const char* a1 = M3_TA(cur.pm, t + 1);
            const char* a2 = last ? M3_TA(npm, 0) : M3_TA(cur.pm, t + 2); const char* b2 = last ? M3_TB(npn, 0) : M3_TB(cur.pn, t + 2);
            const char* a3 = a2 + kstep; const char* b3 = b2 + kstep;
            const bool wide = t2 >= 8; const size_t hB = wide ? 131072 : 65536;
            unsigned vB[2]; vB[0] = wide ? voffB10[0] : voffB5[0]; vB[1] = wide ? voffB10[1] : voffB5[1];
            PG8_LDB(B0, 0, 0); PG8_SCHED; PG8_LDA(At, 0, 0); PG8_STAGE(PG8_SA(1, 1), a1 + hstepA, voffA);
            PG8_WAIT_L(8); PG8_BAR; PG8_WAIT_L(0); PG8_MMA(0, 0, At, B0); PG8_BAR; PG8_SCHED;
            PG8_LDB(B1, 0, 1); PG8_STAGE(PG8_SB(0, 0), b2, vB);
            PG8_BAR; PG8_WAIT_L(0); PG8_MMA(0, 1, At, B1); PG8_BAR;
            PG8_LDA(At, 0, 1); PG8_STAGE(PG8_SA(0, 0), a2, voffA);
            PG8_BAR; PG8_WAIT_L(0); PG8_MMA(1, 0, At, B0); PG8_BAR; PG8_SCHED;
            PG8_STAGE(PG8_SB(0, 1), b2 + hB, vB);
            PG8_WAIT_V(6); PG8_BAR; PG8_MMA(1, 1, At, B1); PG8_BAR;
            PG8_LDB(B0, 1, 0); PG8_SCHED; PG8_LDA(At, 1, 0); PG8_STAGE(PG8_SA(0, 1), a2 + hstepA, voffA);
            PG8_WAIT_L(8); PG8_BAR; PG8_WAIT_L(0); PG8_MMA(0, 0, At, B0); PG8_BAR; PG8_SCHED;
            PG8_LDB(B1, 1, 1); PG8_STAGE(PG8_SB(1, 0), b3, vB);
            PG8_BAR; PG8_WAIT_L(0); PG8_MMA(0, 1, At, B1); PG8_BAR;
            PG8_LDA(At, 1, 1); PG8_STAGE(PG8_SA(1, 0), a3, voffA);
            PG8_BAR; PG8_WAIT_L(0); PG8_MMA(1, 0, At, B0); PG8_BAR; PG8_SCHED;
            PG8_STAGE(PG8_SB(1, 1), b3 + hB, vB);
            PG8_WAIT_V(6); PG8_BAR; PG8_MMA(1, 1, At, B1); PG8_BAR;
            if (t == 2 || t == 6) {
                asm volatile("s_nop 15\n\ts_nop 15" ::: "memory");
                const int sg = t == 2 ? 0 : 1; const float wr_ = sg ? g.r12 : g.r01;
                const unsigned char* gp = (const unsigned char*)g.G + (size_t)(cur.pm * 256 + r0) * NG + sg * 2048 + cur.pn * 256 + c0l;
#pragma unroll
                for (int ai = 0; ai < 2; ++ai) { u32x2 ga[4][2], gb[4][2];
#pragma unroll
                    for (int m = 0; m < 4; ++m)
#pragma unroll
                        for (int bj = 0; bj < 2; ++bj) { const unsigned char* q_ = gp + (size_t)(ai * 128 + m * 16) * NG + bj * 128; ga[m][bj] = *(const u32x2*)q_; gb[m][bj] = *(const u32x2*)(q_ + 2048); }
#pragma unroll
                    for (int m = 0; m < 4; ++m)
#pragma unroll
                        for (int bj = 0; bj < 2; ++bj) { const u32x2 x_ = ga[m][bj], y_ = gb[m][bj];
#define M3_RT2(xw, yw, HI, E) (fmaxf(__builtin_amdgcn_cvt_pk_f32_fp8(xw, HI)[E], 0.0009765625f) * wr_ * __builtin_amdgcn_rcpf(fmaxf(__builtin_amdgcn_cvt_pk_f32_fp8(yw, HI)[E], 0.0009765625f)))
                            acc[ai][bj][m][0][0] *= M3_RT2(x_.x, y_.x, false, 0); acc[ai][bj][m][0][1] *= M3_RT2(x_.x, y_.x, false, 1); acc[ai][bj][m][0][2] *= M3_RT2(x_.x, y_.x, true, 0); acc[ai][bj][m][0][3] *= M3_RT2(x_.x, y_.x, true, 1);
                            acc[ai][bj][m][1][0] *= M3_RT2(x_.y, y_.y, false, 0); acc[ai][bj][m][1][1] *= M3_RT2(x_.y, y_.y, false, 1); acc[ai][bj][m][1][2] *= M3_RT2(x_.y, y_.y, true, 0); acc[ai][bj][m][1][3] *= M3_RT2(x_.y, y_.y, true, 1); } }
                asm volatile("s_waitcnt vmcnt(0)" ::: "memory");
            }
        }
        asm volatile("s_nop 15\n\ts_nop 15" ::: "memory");
        { const unsigned char* gp = (const unsigned char*)g.G + (size_t)(cur.pm * 256 + r0) * NG + 2 * 2048 + cur.pn * 256 + c0l; unsigned char* m8 = g.MB8 + (size_t)(cur.pm * 256 + r0) * D + cur.pn * 256 + c0l;
          u32x2 gc[2][4][2];
#pragma unroll
          for (int ai = 0; ai < 2; ++ai)
#pragma unroll
              for (int m = 0; m < 4; ++m)
#pragma unroll
                  for (int bj = 0; bj < 2; ++bj) gc[ai][m][bj] = *(const u32x2*)(gp + (size_t)(ai * 128 + m * 16) * NG + bj * 128);
          const float f_ = g.fin * (1.f / 256.f);
#define M3_G(w, HI, E) (fmaxf(__builtin_amdgcn_cvt_pk_f32_fp8(w, HI)[E], 0.0009765625f) * f_)
#pragma unroll
          for (int ai = 0; ai < 2; ++ai)
#pragma unroll
              for (int m = 0; m < 4; ++m)
#pragma unroll
                  for (int bj = 0; bj < 2; ++bj) { const u32x2 z_ = gc[ai][m][bj]; const f32x4 v0 = acc[ai][bj][m][0], v1 = acc[ai][bj][m][1];
                      u32x2 w8;
                      w8.x = pk4_fp8(clamp8(v0[0] * M3_G(z_.x, false, 0)), clamp8(v0[1] * M3_G(z_.x, false, 1)), clamp8(v0[2] * M3_G(z_.x, true, 0)), clamp8(v0[3] * M3_G(z_.x, true, 1)));
                      w8.y = pk4_fp8(clamp8(v1[0] * M3_G(z_.y, false, 0)), clamp8(v1[1] * M3_G(z_.y, false, 1)), clamp8(v1[2] * M3_G(z_.y, true, 0)), clamp8(v1[3] * M3_G(z_.y, true, 1)));
                      *(u32x2*)(m8 + (size_t)(ai * 128 + m * 16) * D + bj * 128) = w8; } }
        if (!has_next) break;
#pragma unroll
        for (int a = 0; a < 2; ++a)
#pragma unroll
            for (int b = 0; b < 2; ++b)
#pragma unroll
                for (int m = 0; m < 4; ++m)
#pragma unroll
                    for (int n = 0; n < 2; ++n) acc[a][b][m][n] = (f32x4){0.f, 0.f, 0.f, 0.f};
        cur = nxt; ++ui;
    }
    PG8_WAIT_V(0);
    if (wr == 0) PG8_BAR;
    PG8_BAR;
#undef M3_RT2
#undef M3_G
#undef M3_TA
#undef M3_TB
#undef PG8_SA
#undef PG8_SB
#undef PG8_STAGE
#undef PG8_LDA
#undef PG8_LDB
#undef PG8_MMA
#undef PG8_WAIT_V
#undef PG8_WAIT_L
#undef PG8_BAR
#undef PG8_SCHED
}
}
struct EpiOut {
    static constexpr bool PERM = false, FP8 = true;
    const float* src_lat; const float* src_ctx; bf16_t* S1; const float* g1; float inv;
    __device__ __forceinline__ void operator()(const Acc& acc, const pg8::Unit& u, int wr, int wc, int fr, int fq) const {
        const int row0 = u.pm * 256 + wr * 64 + fr; const int col0 = u.pn * 256 + wc * 32 + 4 * fq;
        const bool lat = (u.pm * 256) < NLAT;
        const float* src = (lat ? src_lat : src_ctx - (size_t)NLAT * D) + (size_t)row0 * D + col0; bf16_t* dst = S1 + (size_t)row0 * D + col0;
#pragma unroll
        for (int ai = 0; ai < 2; ++ai) { const int rbase = u.pm * 256 + ai * 128 + wr * 64; const int v = lat ? (rbase >> 12) : 4; const float* gp = g1 + (size_t)v * 12288 + col0;
            f32x4 gg[2][2];
#pragma unroll
            for (int bj = 0; bj < 2; ++bj)
#pragma unroll
                for (int n = 0; n < 2; ++n) gg[bj][n] = *(const f32x4*)(gp + bj * 128 + n * 16);
#pragma unroll
            for (int mh = 0; mh < 2; ++mh) {
                f32x4 xr[2][2][2];
#pragma unroll
                for (int mm = 0; mm < 2; ++mm)
#pragma unroll
                    for (int bj = 0; bj < 2; ++bj)
#pragma unroll
                        for (int n = 0; n < 2; ++n) xr[mm][bj][n] = __builtin_nontemporal_load((const f32x4*)(src + (size_t)(ai * 128 + (mh * 2 + mm) * 16) * D + bj * 128 + n * 16));
#pragma unroll
                for (int mm = 0; mm < 2; ++mm)
#pragma unroll
                    for (int bj = 0; bj < 2; ++bj)
#pragma unroll
                        for (int n = 0; n < 2; ++n) { const int m = mh * 2 + mm;
                            const f32x4 y_ = ABL_MIX ? xr[mm][bj][n] * ALPHA : xr[mm][bj][n] * ALPHA + gg[bj][n] * (acc[ai][bj][m][n] * inv);
                            *(u32x2*)(dst + (size_t)(ai * 128 + m * 16) * D + bj * 128 + n * 16) = (u32x2){cvt_pk_bf16(y_[0], y_[1]), cvt_pk_bf16(y_[2], y_[3])}; } } }
    }
};

struct Args { const float* in[27]; float* out; unsigned char* ws; int ph_lo, ph_hi; };
typedef const Args __attribute__((address_space(4)))* ArgP;
struct Frame {
    LAS unsigned char* lds; int tid, lane, wave, G, bid;
    ArgP ap; float* out; unsigned char* ws;
    __device__ __forceinline__ const float* in(int i) const { return ap->in[i]; }
};
__device__ __forceinline__ Frame make_frame(ArgP ap) {
    { unsigned long long t = (unsigned long long)ap; asm volatile("" : "+s"(t)); ap = (ArgP)t; }
    extern __shared__ __attribute__((aligned(16))) unsigned char lds_raw[];
    Frame F; F.lds = (LAS unsigned char*)lds_raw; { int t_ = threadIdx.x; asm volatile("" : "+v"(t_)); F.tid = t_; }
    F.lane = F.tid & 63; F.wave = __builtin_amdgcn_readfirstlane(F.tid >> 6); F.G = gridDim.x; F.bid = blockIdx.x;
    F.ap = ap; F.out = ap->out; F.ws = ap->ws; return F;
}
template <class T> __device__ __forceinline__ T* wsp(const Frame& F, size_t off) { return (T*)(F.ws + off); }

__device__ __forceinline__ int win_col(int n) {
    if (n < 768) return n;
    if (n < 1792) return 2336 + (n - 768);
    if (n < 2048) return 3360 + (n - 1792);
    if (n < 2304) return 3616 + (n - 2048);
    if (n < 2560) return 800 + (n - 2304);
    if (n < 2816) return 1056 + (n - 2560);
    if (n < 3328) return 1312 + (n - 2816);
    if (n < 3840) return 1824 + (n - 3328);
    if (n < 3872) return 768 + (n - 3840);
    if (n < 4096) return -1;
    return 3872 + (n - 4096);
}
__device__ __forceinline__ int qup_col(int c) {
    const int hh = c / 96, j = c - hh * 96;
    if (j < 64) return c;
    const int jj = j - 64, g8 = jj >> 3, i = jj & 7, p = i >> 1, which = i & 1, part = g8 >> 1, pi = (g8 & 1) * 4 + p;
    return hh * 96 + 64 + part * 16 + which * 8 + pi;
}
template <int MAP>
__device__ __forceinline__ void transpose_cvt(const Frame& F, const float* __restrict__ src, bf16_t* __restrict__ dst, int K, int Nsrc, int Nd) {
    LAS float* tile = (LAS float*)F.lds;
    const int tk = K / 256, tn = Nd / 64, ntile = tk * tn;
    for (int t = F.bid; t < ntile; t += F.G) {
        const int k0 = (t % tk) * 256, n0 = (t / tk) * 64;
        const int nl = F.tid & 63, kq = F.tid >> 6;
        const int nd = n0 + nl; const int ns = MAP == 0 ? nd : (MAP == 1 ? win_col(nd) : qup_col(nd));
        float v[32];
#pragma unroll
        for (int i = 0; i < 32; ++i) v[i] = ns >= 0 ? src[(size_t)(k0 + kq + 8 * i) * Nsrc + ns] : 0.f;
#pragma unroll
        for (int i = 0; i < 32; ++i) tile[(kq + 8 * i) * 65 + nl] = v[i];
        __syncthreads();
        { const int n = F.tid >> 3, k32 = (F.tid & 7) * 32;
#pragma unroll
          for (int c = 0; c < 4; ++c) { float w[8];
#pragma unroll
              for (int j = 0; j < 8; ++j) w[j] = tile[(k32 + c * 8 + j) * 65 + n];
              u32x4 o; o.x = cvt_pk_bf16(w[0], w[1]); o.y = cvt_pk_bf16(w[2], w[3]); o.z = cvt_pk_bf16(w[4], w[5]); o.w = cvt_pk_bf16(w[6], w[7]);
              *(u32x4*)(dst + (size_t)(n0 + n) * K + k0 + k32 + c * 8) = o; } }
        __syncthreads();
    }
}
__device__ __forceinline__ void cvt_rows(const Frame& F, const float* __restrict__ src, bf16_t* __restrict__ dst, size_t n8) {
    for (size_t i = (size_t)F.bid * 512 + F.tid; i < n8; i += (size_t)F.G * 512) {
        const f32x4 a = __builtin_nontemporal_load((const f32x4*)(src + i * 8)), b = __builtin_nontemporal_load((const f32x4*)(src + i * 8 + 4));
        *(u32x4*)(dst + i * 8) = pack8(a, b);
    }
}
__device__ __forceinline__ void cvt_peer(const Frame& F, int l);
__device__ __forceinline__ float max4abs(float am, const f32x4 a) { return fmaxf(fmaxf(fmaxf(am, fabsf(a[0])), fabsf(a[1])), fmaxf(fabsf(a[2]), fabsf(a[3]))); }
__device__ __forceinline__ void absmax_commit(const Frame& F, float am, unsigned* dst) {
    am = row16_max(am);
    { auto r = __builtin_amdgcn_permlane16_swap(__float_as_uint(am), __float_as_uint(am), false, false); am = fmaxf(__uint_as_float(r[0]), __uint_as_float(r[1])); }
    { auto r = __builtin_amdgcn_permlane32_swap(__float_as_uint(am), __float_as_uint(am), false, false); am = fmaxf(__uint_as_float(r[0]), __uint_as_float(r[1])); }
    if (F.lane == 0) atomicMax(dst, __float_as_uint(am));
}
template <int NB>
__device__ __forceinline__ void absmax_f32(const Frame& F, const float* __restrict__ src, size_t n4, unsigned* dst) {
    float am = 0.f;
    const size_t stride = (size_t)F.G * 512; size_t i = (size_t)F.bid * 512 + F.tid;
    for (; i < n4; i += NB * stride) { f32x4 a[NB];
#pragma unroll
        for (int j = 0; j < NB; ++j) { const size_t ix = i + j * stride; a[j] = ix < n4 ? __builtin_nontemporal_load((const f32x4*)(src + ix * 4)) : (f32x4){0.f, 0.f, 0.f, 0.f}; }
#pragma unroll
        for (int j = 0; j < NB; ++j) am = max4abs(am, a[j]); }
    absmax_commit(F, am, dst);
}
__device__ __forceinline__ void absmax4_f32(const Frame& F, const float* s0, size_t n0, unsigned* d0, const float* s1, size_t n1, unsigned* d1, const float* s2, size_t n2, unsigned* d2, const float* s3, size_t n3, unsigned* d3) {
    const size_t stride = (size_t)F.G * 512, i0 = (size_t)F.bid * 512 + F.tid;
    f32x4 a0[2], a1[2], a2[4], a3[8];
#define AM4_LD(a, NB, s, n) _Pragma("unroll") for (int j = 0; j < NB; ++j) { const size_t ix = i0 + j * stride; a[j] = ix < n ? __builtin_nontemporal_load((const f32x4*)(s + ix * 4)) : (f32x4){0.f, 0.f, 0.f, 0.f}; }
    AM4_LD(a0, 2, s0, n0) AM4_LD(a1, 2, s1, n1) AM4_LD(a2, 4, s2, n2) AM4_LD(a3, 8, s3, n3)
#undef AM4_LD
#define AM4_RED(a, NB, s, n, d) { float am = 0.f; _Pragma("unroll") for (int j = 0; j < NB; ++j) am = max4abs(am, a[j]); \
        for (size_t i = i0 + NB * stride; i < n; i += stride) am = max4abs(am, *(const f32x4*)(s + i * 4)); absmax_commit(F, am, d); }
    AM4_RED(a0, 2, s0, n0, d0) AM4_RED(a1, 2, s1, n1, d1) AM4_RED(a2, 4, s2, n2, d2) AM4_RED(a3, 8, s3, n3, d3)
#undef AM4_RED
}
template <int MAP>
__device__ __forceinline__ void transpose_fp8(const Frame& F, const float* __restrict__ src, unsigned char* __restrict__ dst, int K, int Nsrc, int Nd, const unsigned* wsc) {
    float mul, inv; fp8_scale(__hip_atomic_load(wsc, __ATOMIC_RELAXED, __HIP_MEMORY_SCOPE_AGENT), mul, inv);
    LAS float* tile = (LAS float*)F.lds;
    const int tk = K / 256, tn = Nd / 64, ntile = tk * tn;
    for (int t = F.bid; t < ntile; t += F.G) {
        const int k0 = (t % tk) * 256, n0 = (t / tk) * 64;
        const int nl = F.tid & 63, kq = F.tid >> 6; const int ns = MAP ? win_col(n0 + nl) : n0 + nl;
        float v[32];
#pragma unroll
        for (int i = 0; i < 32; ++i) v[i] = ns >= 0 ? src[(size_t)(k0 + kq + 8 * i) * Nsrc + ns] : 0.f;
#pragma unroll
        for (int i = 0; i < 32; ++i) tile[(kq + 8 * i) * 65 + nl] = v[i] * mul;
        __syncthreads();
        { const int n = F.tid >> 3, k32 = (F.tid & 7) * 32;
#pragma unroll
          for (int c = 0; c < 2; ++c) { float w[16];
#pragma unroll
              for (int j = 0; j < 16; ++j) w[j] = tile[(k32 + c * 16 + j) * 65 + n];
              u32x4 o; o.x = pk4_fp8(w[0], w[1], w[2], w[3]); o.y = pk4_fp8(w[4], w[5], w[6], w[7]); o.z = pk4_fp8(w[8], w[9], w[10], w[11]); o.w = pk4_fp8(w[12], w[13], w[14], w[15]);
              *(u32x4*)(dst + (size_t)(n0 + n) * K + k0 + k32 + c * 16) = o; } }
        __syncthreads();
    }
}
template <int PART = 7>
__device__ __forceinline__ void p0_prologue(const Frame& F) {
    { const int gi = F.bid * 512 + F.tid;
      if (gi < 64 * 8) { const int pos = gi >> 3, f = gi & 7; const float inv = powf(10000.f, -(float)f / 8.f); const float a = (float)pos * inv; wsp<f32x2>(F, WS_ROPE32)[gi] = (f32x2){cosf(a), sinf(a)}; }
      else if (gi < 64 * 8 + 64 * 32) { const int g2 = gi - 512; const int pos = g2 >> 5, f = g2 & 31; const float inv = powf(10000.f, -(float)f / 32.f); const float a = (float)pos * inv; wsp<f32x2>(F, WS_ROPE128)[g2] = (f32x2){cosf(a), sinf(a)}; } }
    if (F.bid == 0 && F.tid < 32) wsp<float>(F, WS_DEC)[F.tid] = -log1pf(expf(-F.in(11)[F.tid])) * LOG2E;
#pragma unroll 1
    for (int s3 = 0; s3 < 3; ++s3) { const int part = (s3 + F.bid) % 3;
    if ((PART & 1) && part == 0) { LAS float* sl = (LAS float*)F.lds;
      float* modp = wsp<float>(F, WS_MODP);
      for (int u = F.bid; u < 2 * 24 * 16; u += F.G) {
          const int kc = u & 15, cb = (u >> 4) % 24, l = u / (16 * 24);
          __syncthreads();
          for (int i = F.tid; i < 640; i += 512) { const int v = i >> 7, k = kc * 128 + (i & 127); const float c = v < 4 ? F.in(1)[v * 2048 + k] : F.in(3)[k]; sl[i] = silu_f(c); }
          __syncthreads();
          const int col = cb * 512 + F.tid; const float* w = F.in(4) + ((size_t)l * 2048 + kc * 128) * 12288 + col;
          float a0 = 0.f, a1 = 0.f, a2 = 0.f, a3 = 0.f, a4 = 0.f;
#pragma unroll 32
          for (int k = 0; k < 128; ++k) { const float wv = w[(size_t)k * 12288]; a0 += sl[k] * wv; a1 += sl[128 + k] * wv; a2 += sl[256 + k] * wv; a3 += sl[384 + k] * wv; a4 += sl[512 + k] * wv; }
          float* o = modp + ((size_t)(kc * 2 + l) * 5) * 12288 + col;
          o[0] = a0; o[12288] = a1; o[2 * 12288] = a2; o[3 * 12288] = a3; o[4 * 12288] = a4;
      }
      __syncthreads(); }
    if ((PART & 2) && part == 1) for (int l = 0; l < 2; ++l) {
        absmax_f32<16>(F, F.in(6) + (size_t)l * 2048 * NIN, (size_t)2048 * NIN / 4, wsp<unsigned>(F, WS_WSC) + l);
        absmax4_f32(F, F.in(14) + (size_t)l * 512 * 2048, (size_t)512 * 2048 / 4, wsp<unsigned>(F, WS_WSC) + 4 + l, F.in(15) + (size_t)l * 512 * 2048, (size_t)512 * 2048 / 4, wsp<unsigned>(F, WS_WSC) + 6 + l,
                    F.in(16) + (size_t)l * 1024 * 2048, (size_t)1024 * 2048 / 4, wsp<unsigned>(F, WS_WSC) + 8 + l, F.in(17) + (size_t)l * 2048 * 2048, (size_t)2048 * 2048 / 4, wsp<unsigned>(F, WS_WSC) + 2 + l);
        transpose_cvt<2>(F, F.in(8) + (size_t)l * 512 * 768, wsp<bf16_t>(F, WS_WQUP + l * SZ_WQUP), 512, 768, 768);
        transpose_cvt<0>(F, F.in(10) + (size_t)l * 256 * 1024, wsp<bf16_t>(F, WS_WKVUP + l * SZ_WKVUP), 256, 1024, 1024);
        transpose_cvt<0>(F, F.in(20) + (size_t)l * 2048 * 1024, wsp<bf16_t>(F, WS_WPQ + l * SZ_WPQ), 2048, 1024, 1024);
    }
    if ((PART & 4) && part == 2) cvt_peer(F, 0);
    }
}
__device__ __forceinline__ void p1_modreduce(const Frame& F) {
    const float* modp = wsp<float>(F, WS_MODP); float* mod = wsp<float>(F, WS_MOD);
    for (int i = F.bid * 512 + F.tid; i < 2 * 5 * 12288; i += F.G * 512) {
        const int j = i % 12288, l = i / (5 * 12288);
        float s = F.in(5)[l * 12288 + j];
#pragma unroll
        for (int kc = 0; kc < 16; ++kc) s += modp[(size_t)kc * (2 * 5 * 12288) + i];
        mod[i] = s;
    }
    for (int l = 0; l < 2; ++l) {
        transpose_fp8<1>(F, F.in(6) + (size_t)l * 2048 * NIN, wsp<unsigned char>(F, WS_WIN + l * SZ_WIN), 2048, NIN, NPT, wsp<unsigned>(F, WS_WSC) + l);
        transpose_fp8<0>(F, F.in(17) + (size_t)l * 2048 * 2048, wsp<unsigned char>(F, WS_WOUT + l * SZ_WOUT), 2048, 2048, 2048, wsp<unsigned>(F, WS_WSC) + 2 + l);
        transpose_fp8<0>(F, F.in(14) + (size_t)l * 512 * 2048, wsp<unsigned char>(F, WS_WBRA + l * SZ_WBRA), 512, 2048, 2048, wsp<unsigned>(F, WS_WSC) + 4 + l);
        transpose_fp8<0>(F, F.in(15) + (size_t)l * 512 * 2048, wsp<unsigned char>(F, WS_WBRB + l * SZ_WBRB), 512, 2048, 2048, wsp<unsigned>(F, WS_WSC) + 6 + l);
        transpose_fp8<0>(F, F.in(16) + (size_t)l * 1024 * 2048, wsp<unsigned char>(F, WS_WBRC + l * SZ_WBRC), 1024, 2048, 2048, wsp<unsigned>(F, WS_WSC) + 8 + l);
    }
}
__device__ __forceinline__ void ld_row_f32(const float* p, int lane, float (&x)[32]) {
#pragma unroll
    for (int q = 0; q < 4; ++q) { const f32x4 a = *(const f32x4*)(p + 512 * q + 8 * lane), b = *(const f32x4*)(p + 512 * q + 8 * lane + 4);
        x[q * 8 + 0] = a[0]; x[q * 8 + 1] = a[1]; x[q * 8 + 2] = a[2]; x[q * 8 + 3] = a[3]; x[q * 8 + 4] = b[0]; x[q * 8 + 5] = b[1]; x[q * 8 + 6] = b[2]; x[q * 8 + 7] = b[3]; }
}
__device__ __forceinline__ void st_row_f32(float* p, int lane, const float (&x)[32]) {
#pragma unroll
    for (int q = 0; q < 4; ++q) { *(f32x4*)(p + 512 * q + 8 * lane) = (f32x4){x[q * 8 + 0], x[q * 8 + 1], x[q * 8 + 2], x[q * 8 + 3]}; *(f32x4*)(p + 512 * q + 8 * lane + 4) = (f32x4){x[q * 8 + 4], x[q * 8 + 5], x[q * 8 + 6], x[q * 8 + 7]}; }
}
__device__ __forceinline__ void ld_row_bf16(const bf16_t* p, int lane, float (&x)[32]) {
#pragma unroll
    for (int q = 0; q < 4; ++q) { const u32x4 w = *(const u32x4*)(p + 512 * q + 8 * lane);
        x[q * 8 + 0] = bflo(w.x); x[q * 8 + 1] = bfhi(w.x); x[q * 8 + 2] = bflo(w.y); x[q * 8 + 3] = bfhi(w.y); x[q * 8 + 4] = bflo(w.z); x[q * 8 + 5] = bfhi(w.z); x[q * 8 + 6] = bflo(w.w); x[q * 8 + 7] = bfhi(w.w); }
}
__device__ __forceinline__ void st_row_bf16(bf16_t* p, int lane, const float (&x)[32]) {
#pragma unroll
    for (int q = 0; q < 4; ++q) { u32x4 w; w.x = cvt_pk_bf16(x[q * 8 + 0], x[q * 8 + 1]); w.y = cvt_pk_bf16(x[q * 8 + 2], x[q * 8 + 3]); w.z = cvt_pk_bf16(x[q * 8 + 4], x[q * 8 + 5]); w.w = cvt_pk_bf16(x[q * 8 + 6], x[q * 8 + 7]);
        *(u32x4*)(p + 512 * q + 8 * lane) = w; }
}
__device__ __forceinline__ void p_modulate0(const Frame& F) {
    const float* mod = wsp<float>(F, WS_MOD); unsigned char* hb8 = wsp<unsigned char>(F, WS_HB8);
    for (int row = F.bid * 8 + F.wave; row < NROW; row += F.G * 8) {
        const RowInfo ri = rowinfo(row);
        const float* xp = ri.lat ? F.in(0) + (size_t)row * D : F.in(2) + (size_t)(row - NLAT) * D;
        const float* mp = mod + (size_t)ri.v * 12288;
        float x[32], sh[32], sc[32];
        ld_row_f32(xp, F.lane, x); ld_row_f32(mp, F.lane, sh); ld_row_f32(mp + 2048, F.lane, sc);
#pragma unroll
        for (int i = 0; i < 32; ++i) x[i] = clamp8(x[i] * (1.f + sc[i]) + sh[i]);
#pragma unroll
        for (int q = 0; q < 4; ++q) { u32x2 w; w.x = pk4_fp8(x[q * 8 + 0], x[q * 8 + 1], x[q * 8 + 2], x[q * 8 + 3]); w.y = pk4_fp8(x[q * 8 + 4], x[q * 8 + 5], x[q * 8 + 6], x[q * 8 + 7]); *(u32x2*)(hb8 + (size_t)row * D + 512 * q + 8 * F.lane) = w; }
    }
}
__device__ __forceinline__ void p_post(const Frame& F, int l) {
    const bf16_t* P1 = wsp<bf16_t>(F, WS_P1);
    bf16_t* CQN = wsp<bf16_t>(F, WS_CQN); bf16_t* CKVN = wsp<bf16_t>(F, WS_CKVN);
    unsigned char* QG = wsp<unsigned char>(F, WS_QG); unsigned char* KG = wsp<unsigned char>(F, WS_KG); unsigned char* VG = wsp<unsigned char>(F, WS_VG);
    bf16_t* RQ = wsp<bf16_t>(F, WS_RQ); bf16_t* RK = wsp<bf16_t>(F, WS_RK); bf16_t* RV = wsp<bf16_t>(F, WS_RV);
    unsigned char* KM = wsp<unsigned char>(F, WS_KM); unsigned char* QM = wsp<unsigned char>(F, WS_QM);
    const f32x2* cs32 = wsp<f32x2>(F, WS_ROPE32); const f32x2* cs128 = wsp<f32x2>(F, WS_ROPE128);
    const float* gq_n = F.in(7) + l * 512; const float* gkv_n = F.in(9) + l * 256; const float* gqa_qn = F.in(12) + l * 128; const float* gqa_kn = F.in(13) + l * 128;
    LAS bf16_t* rs = (LAS bf16_t*)(F.lds + F.wave * 8192);
    const int lane = F.lane;
    const f32x4 gq0 = *(const f32x4*)(gq_n + lane * 8), gq1 = *(const f32x4*)(gq_n + lane * 8 + 4), gkv0 = *(const f32x4*)(gkv_n + lane * 4);
    const int gd0 = 2 * lane; const int gpart = gd0 >> 6, gdd = gd0 & 63; const bool glo = gdd < 32; const int gf = glo ? gdd : gdd - 32; const int gdp = glo ? gd0 + 32 : gd0 - 32;
    const float qn0 = gqa_qn[gd0], qn1 = gqa_qn[gd0 + 1], qnp0 = gqa_qn[gdp], qnp1 = gqa_qn[gdp + 1];
    const float kn0 = gqa_kn[gd0], kn1 = gqa_kn[gd0 + 1], knp0 = gqa_kn[gdp], knp1 = gqa_kn[gdp + 1];
    const int rhh = lane >> 3, rd0 = (lane & 7) * 4; const int rpart = rd0 >> 4, rdd = rd0 & 15; const bool rlo = rdd < 8; const int rf = rlo ? rdd : rdd - 8; const int rdp = rlo ? rd0 + 8 : rd0 - 8;
    const int step = F.G * 8;
    int row = F.bid * 8 + F.wave;
    u32x4 pre[8];
    if (row < NROW) {
#pragma unroll
        for (int q = 0; q < 8; ++q) pre[q] = *(const u32x4*)(P1 + (size_t)row * NP1 + q * 512 + lane * 8); }
#pragma unroll 1
    for (; row < NROW; row += step) {
        const RowInfo ri = rowinfo(row);
        const int posg = gpart ? ri.pc : ri.pr, posr = rpart ? ri.pc : ri.pr;
        const f32x2 one = {1.f, 0.f};
        const f32x2 csA = ri.lat ? cs128[posg * 32 + gf] : one, csB = ri.lat ? cs128[posg * 32 + gf + 1] : one;
        f32x2 cs[4];
#pragma unroll
        for (int i = 0; i < 4; ++i) cs[i] = ri.lat ? cs32[posr * 8 + rf + i] : one;
#pragma unroll
        for (int q = 0; q < 8; ++q) *(LAS u32x4*)(rs + q * 512 + lane * 8) = pre[q];
        { const int nrow = row + step; if (nrow < NROW) {
#pragma unroll
            for (int q = 0; q < 8; ++q) pre[q] = *(const u32x4*)(P1 + (size_t)nrow * NP1 + q * 512 + lane * 8); } }
        asm volatile("s_waitcnt lgkmcnt(0)" ::: "memory");
        { float x[8]; float ss = 0.f;
#pragma unroll
          for (int i = 0; i < 8; ++i) { x[i] = bf2f(rs[C_CQ + lane * 8 + i]); ss += x[i] * x[i]; }
          ss = wave_sum(ss); const float r = rsqrtf(ss * (1.f / 512.f) + RMS_EPS);
          *(u32x4*)(CQN + (size_t)row * 512 + lane * 8) = pack8((f32x4){x[0] * r * gq0[0], x[1] * r * gq0[1], x[2] * r * gq0[2], x[3] * r * gq0[3]}, (f32x4){x[4] * r * gq1[0], x[5] * r * gq1[1], x[6] * r * gq1[2], x[7] * r * gq1[3]}); }
        { float x[4]; float ss = 0.f;
#pragma unroll
          for (int i = 0; i < 4; ++i) { x[i] = bf2f(rs[C_CKV + lane * 4 + i]); ss += x[i] * x[i]; }
          ss = wave_sum(ss); const float r = rsqrtf(ss * (1.f / 256.f) + RMS_EPS);
          u32x2 w; w.x = cvt_pk_bf16(x[0] * r * gkv0[0], x[1] * r * gkv0[1]); w.y = cvt_pk_bf16(x[2] * r * gkv0[2], x[3] * r * gkv0[3]);
          *(u32x2*)(CKVN + (size_t)row * 256 + lane * 4) = w; }
        {
            const int d0 = gd0, dp = gdp; const bool lo = glo;
#pragma unroll 1
            for (int hh = 0; hh < 10; ++hh) {
                const bool isq = hh < 8; const int cbase = isq ? C_GQ + hh * 128 : C_GK + (hh - 8) * 128;
                const float g0 = isq ? qn0 : kn0, g1 = isq ? qn1 : kn1, gp0 = isq ? qnp0 : knp0, gp1 = isq ? qnp1 : knp1;
                const float a0 = bf2f(rs[cbase + d0]), a1 = bf2f(rs[cbase + d0 + 1]);
                float ss = wave_sum(a0 * a0 + a1 * a1); const float r = rsqrtf(ss * (1.f / 128.f) + RMS_EPS);
                const float n0 = a0 * r * g0, n1 = a1 * r * g1;
                const float p0 = bf2f(rs[cbase + dp]) * r * gp0, p1 = bf2f(rs[cbase + dp + 1]) * r * gp1;
                float o0, o1;
                if (lo) { o0 = n0 * csA.x - p0 * csA.y; o1 = n1 * csB.x - p1 * csB.y; }
                else    { o0 = p0 * csA.y + n0 * csA.x; o1 = p1 * csB.y + n1 * csB.x; }
                unsigned char* dst = isq ? QG + ((size_t)(ri.b * 8 + hh) * TT + ri.tpos) * 128 : KG + ((size_t)(ri.b * 2 + (hh - 8)) * TT + ri.tpos) * 128;
                const float sc8_ = isq ? QSC_G : KSC8;
                *(unsigned short*)(dst + d0) = (unsigned short)(pk4_fp8(clamp8(o0 * sc8_), clamp8(o1 * sc8_), 0.f, 0.f) & 0xffffu);
            }
#pragma unroll
            for (int hh = 0; hh < 2; ++hh) { const unsigned w8_ = pk4_fp8(clamp8(bf2f(rs[C_GV + hh * 128 + d0])), clamp8(bf2f(rs[C_GV + hh * 128 + d0 + 1])), 0.f, 0.f); unsigned char* vp_ = VG + ((size_t)(ri.b * 2 + hh) * 128 + d0) * TT + vt_off(ri.tpos);
                vp_[0] = (unsigned char)(w8_ & 0xffu); vp_[TT] = (unsigned char)((w8_ >> 8) & 0xffu); }
        }
        {
            const int hh = rhh, d0 = rd0, dp = rdp; const bool lo = rlo;
#pragma unroll
            for (int which = 0; which < 2; ++which) {
                const int cbase = (which ? C_RK : C_RQ) + hh * 32; const float sc = which ? 0.17677669529663687f : 1.f;
                float o[4];
#pragma unroll
                for (int i = 0; i < 4; ++i) { const float n = bf2f(rs[cbase + d0 + i]), p = bf2f(rs[cbase + dp + i]);
                    o[i] = (lo ? (n * cs[i].x - p * cs[i].y) : (p * cs[i].y + n * cs[i].x)) * sc; }
                u32x2 w; w.x = cvt_pk_bf16(o[0], o[1]); w.y = cvt_pk_bf16(o[2], o[3]);
                *(u32x2*)((which ? RK : RQ) + ((size_t)(ri.b * 8 + hh) * TT + ri.tpos) * 32 + d0) = w;
            }
            { const int vh = lane >> 3, e0 = (lane & 7) * 8;
              *(u32x4*)(RV + ((size_t)(ri.b * 8 + vh) * TT + ri.tpos) * 64 + e0) = *(LAS u32x4*)(rs + C_RV + lane * 8); }
            { float o[4];
#pragma unroll
              for (int i = 0; i < 4; ++i) { const float n = bf2f(rs[C_KR + d0 + i]), p = bf2f(rs[C_KR + dp + i]); o[i] = lo ? (n * cs[i].x - p * cs[i].y) : (p * cs[i].y + n * cs[i].x); }
              const size_t tok_ = ((size_t)(ri.b * 8 + hh) * TT + ri.tpos) * 128;
              *(unsigned*)(KM + tok_ + 64 + d0) = pk4_fp8(clamp8(o[0] * KSC8), clamp8(o[1] * KSC8), clamp8(o[2] * KSC8), clamp8(o[3] * KSC8));
              *(unsigned*)(KM + tok_ + 96 + d0) = 0u; *(unsigned*)(QM + tok_ + 96 + d0) = 0u; }
        }
        asm volatile("s_waitcnt lgkmcnt(0)" ::: "memory");
    }
}

__device__ __forceinline__ void ret_logs(const Frame& F, int l, int h, float& lgf, float& lgb) {
    const float* t = wsp<float>(F, WS_DEC); lgf = t[(l * 2 + 0) * 8 + h]; lgb = t[(l * 2 + 1) * 8 + h];
}
constexpr int TP = 136;
template <bool WITH_K>
__device__ __forceinline__ void ret_stage(const Frame& F, const bf16_t* RKh, const bf16_t* RVh, int tpos0, float lgf, float lgb, LAS bf16_t* vt, LAS bf16_t* ktf, LAS bf16_t* ktb) {
#pragma unroll
    for (int i = 0; i < 2; ++i) { const int tok = (F.tid >> 3) + 64 * i, e0 = (F.tid & 7) * 8;
        const u32x4 w = *(const u32x4*)(RVh + (size_t)(tpos0 + tok) * 64 + e0); const unsigned ww[4] = {w.x, w.y, w.z, w.w};
#pragma unroll
        for (int j = 0; j < 4; ++j) { vt[(e0 + 2 * j) * TP + tok] = (bf16_t)(ww[j] & 0xffffu); vt[(e0 + 2 * j + 1) * TP + tok] = (bf16_t)(ww[j] >> 16); } }
    if (WITH_K) { const int tok = F.tid >> 2, k0 = (F.tid & 3) * 8;
        const u32x4 w = *(const u32x4*)(RKh + (size_t)(tpos0 + tok) * 32 + k0); const unsigned ww[4] = {w.x, w.y, w.z, w.w};
        const float zf = exp2f(lgf * (float)(127 - tok)), zb = exp2f(lgb * (float)tok);
#pragma unroll
        for (int j = 0; j < 4; ++j) { const float a = bflo(ww[j]), b = bfhi(ww[j]);
            ktf[(k0 + 2 * j) * TP + tok] = f2bf(a * zf); ktf[(k0 + 2 * j + 1) * TP + tok] = f2bf(b * zf);
            ktb[(k0 + 2 * j) * TP + tok] = f2bf(a * zb); ktb[(k0 + 2 * j + 1) * TP + tok] = f2bf(b * zb); } }
}
__device__ __forceinline__ void p_ret_states(const Frame& F, int l) {
    LAS bf16_t* vt = (LAS bf16_t*)F.lds; LAS bf16_t* ktf = vt + 64 * TP; LAS bf16_t* ktb = ktf + 32 * TP;
    float* ST = wsp<float>(F, WS_ST);
    const int lane = F.lane, w = F.wave, kb = w >> 2, eb = w & 3, fr = lane & 15, fq = lane >> 4;
    for (int u = F.bid; u < NB * 8 * 34; u += F.G) {
        const int c = u % 34, bh = u / 34, h = bh & 7;
        float lgf, lgb; ret_logs(F, l, h, lgf, lgb);
        __syncthreads();
        ret_stage<true>(F, wsp<bf16_t>(F, WS_RK) + (size_t)bh * TT * 32, wsp<bf16_t>(F, WS_RV) + (size_t)bh * TT * 64, c * 128, lgf, lgb, vt, ktf, ktb);
        __syncthreads();
        f32x4 sf = {0.f, 0.f, 0.f, 0.f}, sb = {0.f, 0.f, 0.f, 0.f};
#pragma unroll
        for (int ks = 0; ks < 4; ++ks) {
            const bf16x8 bv = *(const LAS bf16x8*)(vt + (eb * 16 + fr) * TP + ks * 32 + fq * 8);
            const bf16x8 af = *(const LAS bf16x8*)(ktf + (kb * 16 + fr) * TP + ks * 32 + fq * 8);
            const bf16x8 ab = *(const LAS bf16x8*)(ktb + (kb * 16 + fr) * TP + ks * 32 + fq * 8);
            sf = __builtin_amdgcn_mfma_f32_16x16x32_bf16(af, bv, sf, 0, 0, 0);
            sb = __builtin_amdgcn_mfma_f32_16x16x32_bf16(ab, bv, sb, 0, 0, 0);
        }
        float* o = ST + (size_t)u * 2 * 2048;
#pragma unroll
        for (int r = 0; r < 4; ++r) { const int kd = kb * 16 + fq * 4 + r, e = eb * 16 + fr; o[kd * 64 + e] = sf[r]; o[2048 + kd * 64 + e] = sb[r]; }
    }
}
constexpr int RP = 40;
constexpr int AP = 136;
__device__ __forceinline__ void ret_out_unit(const Frame& F, int l, int bh, int c) {
    LAS bf16_t* vt = (LAS bf16_t*)F.lds; LAS bf16_t* rtf = vt + 64 * TP; LAS bf16_t* rtb = rtf + 64 * RP; LAS bf16_t* as = rtb + 64 * RP + F.wave * 16 * AP;
    const int lane = F.lane, w = F.wave, fr = lane & 15, fq = lane >> 4, h = bh & 7, b = bh >> 3;
    const bf16_t* RQh = wsp<bf16_t>(F, WS_RQ) + (size_t)bh * TT * 32; const bf16_t* RKh = wsp<bf16_t>(F, WS_RK) + (size_t)bh * TT * 32; const bf16_t* RVh = wsp<bf16_t>(F, WS_RV) + (size_t)bh * TT * 64;
    const float* STh = wsp<float>(F, WS_ST) + (size_t)bh * 34 * 2 * 2048;
    float lgf, lgb; ret_logs(F, l, h, lgf, lgb);
    const int tpos0 = c * 128;
    const int i0 = w * 16;
    const bf16x8 qa = *(const bf16x8*)(RQh + (size_t)(tpos0 + i0 + fr) * 32 + fq * 8);
    bf16x8 kfr[8];
#pragma unroll
    for (int nb = 0; nb < 8; ++nb) kfr[nb] = *(const bf16x8*)(RKh + (size_t)(tpos0 + nb * 16 + fr) * 32 + fq * 8);
    const bf16_t* P1 = wsp<bf16_t>(F, WS_P1); unsigned char* OAB = wsp<unsigned char>(F, WS_OAB);
    bf16_t gv[4][4];
#pragma unroll
    for (int r = 0; r < 4; ++r) { const int tp = tpos0 + i0 + fq * 4 + r; const size_t grow = tp >= CTXL ? (size_t)b * SEQ + (tp - CTXL) : (size_t)NLAT + b * CTXL + tp;
#pragma unroll
        for (int eb = 0; eb < 4; ++eb) gv[r][eb] = P1[grow * NP1 + C_RG + h * 64 + eb * 16 + fr]; }
    __syncthreads();
    ret_stage<false>(F, RKh, RVh, tpos0, lgf, lgb, vt, nullptr, nullptr);
    { const int kd = F.tid >> 4, e4 = (F.tid & 15) * 4; f32x4 rf = {0.f, 0.f, 0.f, 0.f}, rb = {0.f, 0.f, 0.f, 0.f};
      if (c >= 2) {
          const int p = c - 2;
          const float kff = 80.f / (-lgf * 128.f), kfb = 80.f / (-lgb * 128.f); const int kcf = kff < 64.f ? (int)kff + 1 : 64, kcb = kfb < 64.f ? (int)kfb + 1 : 64;
          const int nf = c < kcf ? c : kcf, nb_ = (33 - p) < kcb ? (33 - p) : kcb;
          const float* sf = STh + kd * 64 + e4;
          for (int k0 = 0; k0 < nf; k0 += 8) { f32x4 v[8];
#pragma unroll
              for (int j = 0; j < 8; ++j) { const int k = k0 + j; const int cp = k < nf ? c - 1 - k : 0; v[j] = *(const f32x4*)(sf + (size_t)(cp * 2 + 0) * 2048); }
#pragma unroll
              for (int j = 0; j < 8; ++j) { const int k = k0 + j; const float wgt = k < nf ? __builtin_amdgcn_exp2f(lgf * 128.f * (float)k) : 0.f; rf += v[j] * wgt; } }
          for (int k0 = 0; k0 < nb_; k0 += 8) { f32x4 v[8];
#pragma unroll
              for (int j = 0; j < 8; ++j) { const int k = k0 + j; const int pp = k < nb_ ? p + 1 + k : 33; const int cs = pp < 32 ? pp + 2 : pp - 32; v[j] = *(const f32x4*)(sf + (size_t)(cs * 2 + 1) * 2048); }
#pragma unroll
              for (int j = 0; j < 8; ++j) { const int k = k0 + j; const float wgt = k < nb_ ? __builtin_amdgcn_exp2f(lgb * 128.f * (float)k) : 0.f; rb += v[j] * wgt; } }
      } else if (c == 0) { rb = *(const f32x4*)(STh + (size_t)(1 * 2 + 1) * 2048 + kd * 64 + e4); }
      else { rf = *(const f32x4*)(STh + (size_t)(0 * 2 + 0) * 2048 + kd * 64 + e4); }
#pragma unroll
      for (int j = 0; j < 4; ++j) { rtf[(e4 + j) * RP + kd] = f2bf(rf[j]); rtb[(e4 + j) * RP + kd] = f2bf(rb[j]); } }
    f32x4 s[8];
#pragma unroll
    for (int nb = 0; nb < 8; ++nb) s[nb] = __builtin_amdgcn_mfma_f32_16x16x32_bf16(qa, kfr[nb], (f32x4){0.f, 0.f, 0.f, 0.f}, 0, 0, 0);
#pragma unroll
    for (int nb = 0; nb < 8; ++nb)
#pragma unroll
        for (int r = 0; r < 4; ++r) { const int i = i0 + fq * 4 + r, j = nb * 16 + fr; const int df = i - j;
            const float mk = df > 0 ? exp2f(lgf * (float)df) : (df < 0 ? exp2f(lgb * (float)(-df)) : 2.f);
            as[(fq * 4 + r) * AP + j] = f2bf(s[nb][r] * mk); }
    __syncthreads();
    f32x4 y[4];
#pragma unroll
    for (int eb = 0; eb < 4; ++eb) y[eb] = (f32x4){0.f, 0.f, 0.f, 0.f};
#pragma unroll
    for (int ks = 0; ks < 4; ++ks) { const bf16x8 af = *(const LAS bf16x8*)(as + fr * AP + ks * 32 + fq * 8);
#pragma unroll
        for (int eb = 0; eb < 4; ++eb) { const bf16x8 bv = *(const LAS bf16x8*)(vt + (eb * 16 + fr) * TP + ks * 32 + fq * 8);
            y[eb] = __builtin_amdgcn_mfma_f32_16x16x32_bf16(af, bv, y[eb], 0, 0, 0); } }
    { const float xf = exp2f(lgf * (float)(i0 + fr + 1)), xb = exp2f(lgb * (float)(128 - (i0 + fr)));
      bf16x8 qf, qb;
#pragma unroll
      for (int j = 0; j < 8; ++j) { const float qv = bf2f((bf16_t)qa[j]); qf[j] = (short)f2bf(qv * xf); qb[j] = (short)f2bf(qv * xb); }
#pragma unroll
      for (int eb = 0; eb < 4; ++eb) { const bf16x8 bf_ = *(const LAS bf16x8*)(rtf + (eb * 16 + fr) * RP + fq * 8), bb_ = *(const LAS bf16x8*)(rtb + (eb * 16 + fr) * RP + fq * 8);
          y[eb] = __builtin_amdgcn_mfma_f32_16x16x32_bf16(qf, bf_, y[eb], 0, 0, 0);
          y[eb] = __builtin_amdgcn_mfma_f32_16x16x32_bf16(qb, bb_, y[eb], 0, 0, 0); } }
#pragma unroll
    for (int r = 0; r < 4; ++r) {
        float sm = y[0][r] + y[1][r] + y[2][r] + y[3][r]; sm = row16_sum(sm); const float mu = sm * (1.f / 64.f);
        float vs = 0.f;
#pragma unroll
        for (int eb = 0; eb < 4; ++eb) { const float d = y[eb][r] - mu; vs += d * d; }
        vs = row16_sum(vs); const float rstd = rsqrtf(vs * (1.f / 64.f) + LN_EPS);
        const int i = i0 + fq * 4 + r; const int tp = tpos0 + i; const size_t grow = tp >= CTXL ? (size_t)b * SEQ + (tp - CTXL) : (size_t)NLAT + b * CTXL + tp;
#pragma unroll
        for (int eb = 0; eb < 4; ++eb) { const int e = eb * 16 + fr; const float g = bf2f(gv[r][eb]);
            OAB[grow * D + 512 + h * 64 + e] = (unsigned char)(pk4_fp8(clamp8(silu_f(g) * (y[eb][r] - mu) * rstd * 16.f), 0.f, 0.f, 0.f) & 0xffu); }
    }
}
namespace att {
constexpr int NW = 8, QBLK = 32, KVBLK = 64;
constexpr int SHM_K = KVBLK * 128, SHM_V = 128 * 64;
constexpr size_t SHM_ATTN = 4 * SHM_K + 3 * SHM_V + 2048;
constexpr float THR = 1.9f, PSH = 6.f, THR2 = THR * 1.4426950408889634f;
#define SBAR() __builtin_amdgcn_sched_barrier(0)
typedef int i32x8a __attribute__((ext_vector_type(8))); typedef int i32x4a __attribute__((ext_vector_type(4)));
template <int SC> struct Scale { static constexpr float S = SC == 0 ? 0.08838834764831845f : 0.10206207261596575f; static constexpr float C = S * 1.4426950408889634f; static constexpr float THRR = THR / S; };
#define KSWZ8(row, chunk) ((row) * 128 + ((((chunk) ^ (((row) >> 1) & 7))) << 4))
#define VSWZ8(col, chunk) ((col) * 64 + ((((chunk) ^ (((col) >> 2) & 3))) << 4))
#define MF8(A, B, C) mf8x<ABL>(A, B, C)
#define CAT8(lo, hi) __builtin_shufflevector(lo, hi, 0, 1, 2, 3, 4, 5, 6, 7)
#define LDS16(p) ((ABL & 8) ? __builtin_shufflevector(qr8[0], qr8[1], 0, 1, 10, 11) : *(const LAS i32x4a*)(p))
template <int A, int B, int ABL = 0> __device__ __forceinline__ void exp_rng(f32x16& p) {
#pragma unroll
  for (int r = A; r < B; ++r) p[r] = (ABL & 1) ? p[r] * p[r] : __builtin_amdgcn_exp2f(p[r]);
}
template <int ABL> __device__ __forceinline__ f32x16 mf8x(const i32x8a a, const i32x8a b, f32x16 c) {
  if constexpr (ABL & 2) { c[0] += __int_as_float(((a[0] ^ a[4]) + (b[0] ^ b[4])) & 0x3f000000); return c; }
  else return __builtin_amdgcn_mfma_scale_f32_32x32x64_f8f6f4(a, b, c, 0, 0, 0, 0x7F7F7F7F, 0, 0x7F7F7F7F);
}
__device__ __forceinline__ void pk_fma16(f32x16& p, float c, float d) { const f32x2 c2 = {c, c}, d2 = {d, d};
#pragma unroll
  for (int i = 0; i < 8; ++i) { f32x2 v = {p[2 * i], p[2 * i + 1]}; v = v * c2 + d2; p[2 * i] = v.x; p[2 * i + 1] = v.y; }
}
__device__ __forceinline__ void pk_add16(f32x16& p, float c) { const f32x2 c2 = {c, c};
#pragma unroll
  for (int i = 0; i < 8; ++i) { f32x2 v = {p[2 * i], p[2 * i + 1]}; v = v + c2; p[2 * i] = v.x; p[2 * i + 1] = v.y; }
}
__device__ __forceinline__ void pk_mul16(f32x16& p, float c) { const f32x2 c2 = {c, c};
#pragma unroll
  for (int i = 0; i < 8; ++i) { f32x2 v = {p[2 * i], p[2 * i + 1]}; v = v * c2; p[2 * i] = v.x; p[2 * i + 1] = v.y; }
}
__device__ __forceinline__ float pk_sum32(const f32x16& p0, const f32x16& p1) { f32x2 s0 = {p0[0], p0[1]}, s1 = {p1[0], p1[1]};
#pragma unroll
  for (int i = 1; i < 8; ++i) { s0 += (f32x2){p0[2 * i], p0[2 * i + 1]}; s1 += (f32x2){p1[2 * i], p1[2 * i + 1]}; }
  s0 += s1; return s0.x + s0.y;
}
__device__ __forceinline__ float hsum(float v) { auto rr = __builtin_amdgcn_permlane32_swap(__float_as_uint(v), __float_as_uint(v), false, false); return __uint_as_float(rr[0]) + __uint_as_float(rr[1]); }
__device__ __forceinline__ float hmax(float v) { auto rr = __builtin_amdgcn_permlane32_swap(__float_as_uint(v), __float_as_uint(v), false, false); return fmaxf(__uint_as_float(rr[0]), __uint_as_float(rr[1])); }
template <int NDV, int SC, int ABL>
__device__ __forceinline__ void attn_body(const unsigned char* __restrict__ Qb, const unsigned char* __restrict__ Kh, const unsigned char* __restrict__ Vt,
                                          unsigned char* __restrict__ Ob, int seq, LAS unsigned char* lds, const int tid) {
  constexpr int ldo = 2048;
  const int wid = __builtin_amdgcn_readfirstlane(tid >> 6), lane = tid & 63, r32 = lane & 31, hi = lane >> 5;
  LAS unsigned char* K_lds = lds; LAS unsigned char* V_lds = lds + 4 * SHM_K;
  constexpr bool LSUM = true, PF = (NDV == 2); constexpr int NO = NDV + (LSUM ? 1 : 0);
  float l_reg = 0; f32x16 o[NO] = {}; f32x16 negm; i32x8a qr8[2];
  LAS unsigned char* ones_lds = lds + 4 * SHM_K + 3 * SHM_V;
  i32x8a vones_r; { const int w1_ = r32 == 0 ? 0x38383838 : 0;
#pragma unroll
    for (int i = 0; i < 8; ++i) vones_r[i] = w1_; }
  if constexpr (NDV == 4) { int t4_ = tid; asm volatile("" : "+v"(t4_));
    const int w1_ = t4_ < 4 ? 0x38383838 : 0; if (t4_ < 128) *(LAS i32x4a*)(ones_lds + t4_ * 16) = (i32x4a){w1_, w1_, w1_, w1_}; }
#define VONES() (NDV == 4 ? CAT8(LDS16(ones_lds + r32 * 64 + hi * 32), LDS16(ones_lds + r32 * 64 + hi * 32 + 16)) : vones_r)
  const unsigned char* Qw = Qb + (long)(wid * QBLK + r32) * 128 + hi * 32;
#pragma unroll
  for (int blk = 0; blk < 2; ++blk) { const i32x4a lo_ = *reinterpret_cast<const i32x4a*>(Qw + blk * 64), hi_ = *reinterpret_cast<const i32x4a*>(Qw + blk * 64 + 16); qr8[blk] = CAT8(lo_, hi_); }
  const int NT = seq / KVBLK;
  const int kr8 = 8 * wid + (lane >> 3), vcol = 16 * (wid & (NDV * 2 - 1)) + (lane >> 2);
  const unsigned char* kgp = Kh + (long)kr8 * 128 + (((lane & 7) ^ ((kr8 >> 1) & 7)) << 4);
  const unsigned char* vgp = Vt + (long)vcol * TT + (((lane & 3) ^ ((vcol >> 2) & 3)) << 4);
  const int kdo = wid * 1024, vdo = (wid & (NDV * 2 - 1)) * 1024;
  const int ka0 = KSWZ8(r32, 2 * hi), ka1 = KSWZ8(r32, 2 * hi + 1), va0 = VSWZ8(r32, 2 * hi), va1 = VSWZ8(r32, 2 * hi + 1);
#define DMAK(t, bo) do { const int t_ = (t) < NT ? (t) : NT - 1; __builtin_amdgcn_global_load_lds((const unsigned*)(kgp + (long)t_ * (KVBLK * 128)), (LAS unsigned*)(K_lds + (bo) + kdo), 16, 0, 0); } while (0)
#define DMAV(t, bo) do { const int t_ = (t) < NT ? (t) : NT - 1; __builtin_amdgcn_global_load_lds((const unsigned*)(vgp + t_ * KVBLK), (LAS unsigned*)(V_lds + (bo) + vdo), 16, 0, 0); } while (0)
#define VMW(n) asm volatile("s_waitcnt vmcnt(" #n ")" ::: "memory")
#define BAR() __builtin_amdgcn_s_barrier()
  f32x16 pA0, pA1, pB0, pB1; float alA, alB; i32x8a pa;
#define PSM2(p0, p1, al) do { float pm_ = fmaxf(p0[0], p1[0]);                                                                          \
    _Pragma("unroll") for (int r = 1; r < 16; ++r) pm_ = fmaxf(fmaxf(pm_, p0[r]), p1[r]);                                               \
    pm_ = hmax(pm_); al = 1.f;                                                                                                           \
    if (__builtin_expect(!__all(pm_ <= PSH + THR2), 0)) { const float d_ = fmaxf(pm_ - PSH, 0.f); al = __builtin_amdgcn_exp2f(-d_); pk_add16(p0, -d_); pk_add16(p1, -d_); pk_add16(negm, -d_); } } while (0)
#define PT3(x, y, z) asm volatile("" : "+v"(x), "+v"(y), "+v"(z))
#define PT4(x, y, z, w) asm volatile("" : "+v"(x), "+v"(y), "+v"(z), "+v"(w))
#define STEP(j, pc0, pc1, alc, pn0, pn1, aln) do { const LAS unsigned char* Kr_ = K_lds + kb_rd; const LAS unsigned char* Vs_ = V_lds + vb_rd;  \
    i32x8a kc_ = CAT8(LDS16(Kr_ + (ka0 ^ 64)), LDS16(Kr_ + (ka1 ^ 64))), kd_ = CAT8(LDS16(Kr_ + 4096 + (ka0 ^ 64)), LDS16(Kr_ + 4096 + (ka1 ^ 64))); \
    if constexpr (!PF) { kpa = CAT8(LDS16(Kr_ + ka0), LDS16(Kr_ + ka1)); kpb = CAT8(LDS16(Kr_ + 4096 + ka0), LDS16(Kr_ + 4096 + ka1)); }              \
    pn0 = MF8(kpa, qr8[0], negm); exp_rng<0, 6, ABL>(pc1); PT3(pn0, pc1, kpb);                                                     \
    pn1 = MF8(kpb, qr8[0], negm); exp_rng<6, 12, ABL>(pc1); PT3(pn1, pc1, kc_);                                                    \
    pn0 = MF8(kc_, qr8[1], pn0); exp_rng<12, 16, ABL>(pc1);                                                                              \
    if constexpr (!LSUM) { float ps_ = pk_sum32(pc0, pc1); ps_ = hsum(ps_); l_reg = l_reg * alc + ps_; }                                   \
    i32x8a va_ = CAT8(LDS16(Vs_ + va0), LDS16(Vs_ + va1)), vb_ = CAT8(LDS16(Vs_ + 2048 + va0), LDS16(Vs_ + 2048 + va1));                  \
    PT4(pn0, pc1, kd_, l_reg);                                                                                                           \
    pn1 = MF8(kd_, qr8[1], pn1);                                                                                                         \
    _Pragma("unroll") for (int q = 0; q < 4; ++q) { pa[q] = (int)pk4_fp8(pc0[4 * q], pc0[4 * q + 1], pc0[4 * q + 2], pc0[4 * q + 3]); pa[4 + q] = (int)pk4_fp8(pc1[4 * q], pc1[4 * q + 1], pc1[4 * q + 2], pc1[4 * q + 3]); } \
    PT3(pn1, pa, va_);                                                                                                                   \
    if constexpr (!(ABL & 128)) { DMAK((j) + 4, kb_wr); DMAV((j) + 2, vb_wr); }                                                          \
    o[0] = MF8(va_, pa, o[0]); PSM2(pn0, pn1, aln); PT3(o[0], pn0, vb_);                                                  \
    o[1] = MF8(vb_, pa, o[1]); exp_rng<0, 4, ABL>(pn0);                                   \
    if constexpr (NDV == 4) { i32x8a vc_ = CAT8(LDS16(Vs_ + 4096 + va0), LDS16(Vs_ + 4096 + va1)), vd_ = CAT8(LDS16(Vs_ + 6144 + va0), LDS16(Vs_ + 6144 + va1)); \
      PT4(o[1], pn0, pn1, vc_); o[2] = MF8(vc_, pa, o[2]); exp_rng<4, 10, ABL>(pn0); PT3(o[2], pn0, vd_);                                \
      o[3] = MF8(vd_, pa, o[3]); exp_rng<10, 14, ABL>(pn0); PT3(o[3], pn0, pn1); o[4] = MF8(VONES(), pa, o[4]); exp_rng<14, 16, ABL>(pn0); }      \
    else { PT3(o[1], pn0, pn1); o[2] = MF8(VONES(), pa, o[2]); exp_rng<4, 10, ABL>(pn0); PT3(o[2], pn0, pn1); exp_rng<10, 16, ABL>(pn0); }    \
    if constexpr (PF) { const LAS unsigned char* Kp_ = K_lds + kb_pf; kpa = CAT8(LDS16(Kp_ + ka0), LDS16(Kp_ + ka1)); kpb = CAT8(LDS16(Kp_ + 4096 + ka0), LDS16(Kp_ + 4096 + ka1)); } \
    PT3(o[NO - 1], pn0, pn1); RESC(aln);                                                                                               \
    { const int t_ = kb_rd; kb_rd = kb_pf; kb_pf = kb_x; kb_x = kb_wr; kb_wr = t_; const int u_ = vb_rd; vb_rd = vb_n1; vb_n1 = vb_wr; vb_wr = u_; } \
    VMW(2); if constexpr (!(ABL & 4)) BAR(); } while (0)
#define RESC(a) do { if (__any((a) < 1.f)) { _Pragma("unroll") for (int d = 0; d < NO; ++d) pk_mul16(o[d], (a)); } } while (0)
  i32x8a kpa, kpb; int kb_rd = SHM_K, kb_pf = 2 * SHM_K, kb_x = 3 * SHM_K, kb_wr = 0, vb_rd = 0, vb_n1 = SHM_V, vb_wr = 2 * SHM_V;
  DMAK(0, 0); DMAK(1, SHM_K); DMAK(2, 2 * SHM_K); DMAK(3, 3 * SHM_K); DMAV(0, 0); DMAV(1, SHM_V); VMW(0); BAR();
  { const LAS unsigned char* Ks_ = K_lds;
    pA0 = MF8(CAT8(LDS16(Ks_ + ka0), LDS16(Ks_ + ka1)), qr8[0], (f32x16){}); pA1 = MF8(CAT8(LDS16(Ks_ + 4096 + ka0), LDS16(Ks_ + 4096 + ka1)), qr8[0], (f32x16){});
    pA0 = MF8(CAT8(LDS16(Ks_ + (ka0 ^ 64)), LDS16(Ks_ + (ka1 ^ 64))), qr8[1], pA0); pA1 = MF8(CAT8(LDS16(Ks_ + 4096 + (ka0 ^ 64)), LDS16(Ks_ + 4096 + (ka1 ^ 64))), qr8[1], pA1);
    float pm_ = fmaxf(pA0[0], pA1[0]);
#pragma unroll
    for (int r = 1; r < 16; ++r) pm_ = fmaxf(fmaxf(pm_, pA0[r]), pA1[r]);
    pm_ = hmax(pm_);
    const float nv_ = PSH - pm_; pk_add16(pA0, nv_); pk_add16(pA1, nv_);
#pragma unroll
    for (int r = 0; r < 16; ++r) negm[r] = nv_;
    alA = 1.f; exp_rng<0, 16, ABL>(pA0);
    if constexpr (PF) { const LAS unsigned char* Kp_ = K_lds + SHM_K; kpa = CAT8(LDS16(Kp_ + ka0), LDS16(Kp_ + ka1)); kpb = CAT8(LDS16(Kp_ + 4096 + ka0), LDS16(Kp_ + 4096 + ka1)); } }
  asm volatile("s_waitcnt lgkmcnt(0)" ::: "memory"); BAR();
  int j = 0;
  for (; j + 2 < NT; j += 2) { STEP(j, pA0, pA1, alA, pB0, pB1, alB); STEP(j + 1, pB0, pB1, alB, pA0, pA1, alA); }
  STEP(j, pA0, pA1, alA, pB0, pB1, alB);
  { exp_rng<0, 16, ABL>(pB1); if constexpr (!LSUM) { float ps_ = pk_sum32(pB0, pB1); ps_ = hsum(ps_); l_reg = l_reg * alB + ps_; }
#pragma unroll
    for (int q = 0; q < 4; ++q) { pa[q] = (int)pk4_fp8(pB0[4 * q], pB0[4 * q + 1], pB0[4 * q + 2], pB0[4 * q + 3]); pa[4 + q] = (int)pk4_fp8(pB1[4 * q], pB1[4 * q + 1], pB1[4 * q + 2], pB1[4 * q + 3]); }
    const LAS unsigned char* Vs_ = V_lds + vb_rd;
#pragma unroll
    for (int d0 = 0; d0 < NDV; ++d0) o[d0] = MF8(CAT8(LDS16(Vs_ + d0 * 2048 + va0), LDS16(Vs_ + d0 * 2048 + va1)), pa, o[d0]);
    if constexpr (LSUM) { o[NDV] = MF8(VONES(), pa, o[NDV]); l_reg = hsum(o[NDV][0]); } }
  const float rl = __builtin_amdgcn_rcpf(l_reg) * 16.f;
  unsigned char* Ow = Ob + (long)(wid * QBLK + r32) * ldo + 4 * hi;
#pragma unroll
  for (int d0 = 0; d0 < NDV; ++d0)
#pragma unroll
    for (int g = 0; g < 4; ++g) *(unsigned*)(Ow + d0 * 32 + 8 * g) = pk4_fp8(clamp8(o[d0][4 * g] * rl), clamp8(o[d0][4 * g + 1] * rl), clamp8(o[d0][4 * g + 2] * rl), clamp8(o[d0][4 * g + 3] * rl));
#undef DMAK
#undef DMAV
#undef VMW
#undef BAR
#undef PSM2
#undef VONES
#undef REGION_X
#undef REGION_Y
#undef RESC
#undef STEP
#undef PT3
#undef PT4
}
}
__device__ __forceinline__ float* xres_row(const Frame& F, int row) { return row < NLAT ? F.out + (size_t)row * D : wsp<float>(F, WS_XC) + (size_t)(row - NLAT) * D; }
__device__ __forceinline__ void ln_row(float (&y)[32], const float* g, const float* b, int lane) {
    float s = 0.f;
#pragma unroll
    for (int i = 0; i < 32; ++i) s += y[i];
    const float mu = wave_sum(s) * (1.f / 2048.f);
    float q = 0.f;
#pragma unroll
    for (int i = 0; i < 32; ++i) { const float d = y[i] - mu; q += d * d; }
    const float rstd = rsqrtf(wave_sum(q) * (1.f / 2048.f) + LN_EPS);
#pragma unroll
    for (int qq = 0; qq < 4; ++qq) { const f32x4 g0 = *(const f32x4*)(g + 512 * qq + 8 * lane), g1 = *(const f32x4*)(g + 512 * qq + 8 * lane + 4), b0 = *(const f32x4*)(b + 512 * qq + 8 * lane), b1 = *(const f32x4*)(b + 512 * qq + 8 * lane + 4);
#pragma unroll
        for (int i = 0; i < 4; ++i) { y[qq * 8 + i] = (y[qq * 8 + i] - mu) * rstd * g0[i] + b0[i]; y[qq * 8 + 4 + i] = (y[qq * 8 + 4 + i] - mu) * rstd * g1[i] + b1[i]; } }
}
__device__ __forceinline__ void modulate_store(const float (&x)[32], const float* sh, const float* sc, bf16_t* dst, int lane) {
#pragma unroll
    for (int q = 0; q < 4; ++q) { const f32x4 h0 = *(const f32x4*)(sh + 512 * q + 8 * lane), h1 = *(const f32x4*)(sh + 512 * q + 8 * lane + 4), c0 = *(const f32x4*)(sc + 512 * q + 8 * lane), c1 = *(const f32x4*)(sc + 512 * q + 8 * lane + 4);
        f32x4 a, b;
#pragma unroll
        for (int i = 0; i < 4; ++i) { a[i] = x[q * 8 + i] * (1.f + c0[i]) + h0[i]; b[i] = x[q * 8 + 4 + i] * (1.f + c1[i]) + h1[i]; }
        *(u32x4*)(dst + 512 * q + 8 * lane) = pack8(a, b); }
}
__device__ __forceinline__ void p_ln1(const Frame& F, int l, bool last) {
    const float* mod = wsp<float>(F, WS_MOD) + (size_t)l * 5 * 12288; bf16_t* hb = wsp<bf16_t>(F, WS_HB);
    const float* g = F.in(18) + l * D; const float* b = F.in(19) + l * D;
    const int nrows = last ? NLAT : NROW; const int lane = F.lane, step = F.G * 8;
    float gg[32], bb[32]; ld_row_f32(g, lane, gg); ld_row_f32(b, lane, bb);
    int row = F.bid * 8 + F.wave;
    float yn[32];
    bf16_t* S1 = wsp<bf16_t>(F, WS_S1);
    if (row < nrows) ld_row_bf16(S1 + (size_t)row * D, lane, yn);
#pragma unroll 1
    for (; row < nrows; row += step) {
        const int v = row < NLAT ? (row >> 12) : 4; bf16_t* xp = S1 + (size_t)row * D;
        float y[32], sh[32], sc[32];
#pragma unroll
        for (int i = 0; i < 32; ++i) y[i] = yn[i];
        ld_row_f32(mod + (size_t)v * 12288 + 6144, lane, sh); ld_row_f32(mod + (size_t)v * 12288 + 8192, lane, sc);
        { const int nrow = row + step; if (nrow < nrows) ld_row_bf16(S1 + (size_t)nrow * D, lane, yn); }
        float s = 0.f;
#pragma unroll
        for (int i = 0; i < 32; ++i) s += y[i];
        const float mu = wave_sum(s) * (1.f / 2048.f); float q = 0.f;
#pragma unroll
        for (int i = 0; i < 32; ++i) { const float d = y[i] - mu; q += d * d; }
        const float rstd = rsqrtf(wave_sum(q) * (1.f / 2048.f) + LN_EPS);
#pragma unroll
        for (int i = 0; i < 32; ++i) y[i] = (y[i] - mu) * rstd * gg[i] + bb[i];
        st_row_bf16(xp, lane, y);
#pragma unroll
        for (int i = 0; i < 32; ++i) y[i] = y[i] * (1.f + sc[i]) + sh[i];
        st_row_bf16(hb + (size_t)row * D, lane, y);
    }
}

template <int NV>
__device__ __forceinline__ void top16(const float (&val)[NV], bool (&sel)[NV], int (&slot)[NV]) {
    unsigned key[NV];
#pragma unroll
    for (int v = 0; v < NV; ++v) { const unsigned u = __float_as_uint(val[v]); key[v] = (u & 0x80000000u) ? ~u : (u | 0x80000000u); }
    unsigned T = 0u;
#pragma unroll 1
    for (int bit = 31; bit >= 0; --bit) {
        const unsigned cand = T | (1u << bit); int cnt = 0;
#pragma unroll
        for (int v = 0; v < NV; ++v) cnt += __popcll(__ballot(key[v] >= cand));
        if (cnt >= 16) T = cand;
    }
    int ngt = 0;
#pragma unroll
    for (int v = 0; v < NV; ++v) ngt += __popcll(__ballot(key[v] > T));
    const int need = 16 - ngt;
    int run = 0, erun = 0;
#pragma unroll
    for (int v = 0; v < NV; ++v) {
        const unsigned long long mg = __ballot(key[v] > T), me = __ballot(key[v] == T);
        const int pg = __builtin_amdgcn_mbcnt_hi((unsigned)(mg >> 32), __builtin_amdgcn_mbcnt_lo((unsigned)mg, 0u));
        const int pe = __builtin_amdgcn_mbcnt_hi((unsigned)(me >> 32), __builtin_amdgcn_mbcnt_lo((unsigned)me, 0u));
        sel[v] = false; slot[v] = 0;
        if (key[v] > T) { sel[v] = true; slot[v] = run + pg; }
        else if (key[v] == T && (erun + pe) < need) { sel[v] = true; slot[v] = ngt + erun + pe; }
        run += __popcll(mg); erun += __popcll(me);
    }
}
__device__ __forceinline__ unsigned f2key(float f) { const unsigned u = __float_as_uint(f); return (u & 0x80000000u) ? ~u : (u | 0x80000000u); }
__device__ __forceinline__ float key2f(unsigned k) { return __uint_as_float((k & 0x80000000u) ? (k & 0x7fffffffu) : ~k); }
template <int NP, int NV>
__device__ __forceinline__ void bisect16(const unsigned (&key)[NP][NV], unsigned (&T)[NP]) {
    bool done[NP];
#pragma unroll
    for (int p = 0; p < NP; ++p) { T[p] = 0u; done[p] = false; }
#pragma unroll 1
    for (int bit = 31; bit >= 0; --bit) {
        const unsigned bm = 1u << bit; bool all = true;
#pragma unroll
        for (int p = 0; p < NP; ++p) {
            const unsigned cand = T[p] | bm; int cnt = 0;
#pragma unroll
            for (int v = 0; v < NV; ++v) cnt += __popcll(__ballot(key[p][v] >= cand));
            const bool upd = (cnt >= 16) && !done[p];
            T[p] = upd ? cand : T[p]; done[p] = done[p] || (cnt == 16); all = all && done[p];
        }
        if (all) break;
    }
}
template <int NV>
__device__ __forceinline__ void compact16(const unsigned (&key)[NV], const unsigned T, bool (&sel)[NV], int (&slot)[NV]) {
    int ngt = 0;
#pragma unroll
    for (int v = 0; v < NV; ++v) ngt += __popcll(__ballot(key[v] > T));
    const int need = 16 - ngt; int run = 0, erun = 0;
#pragma unroll
    for (int v = 0; v < NV; ++v) {
        const unsigned long long mg = __ballot(key[v] > T), me = __ballot(key[v] == T);
        const int pg = __builtin_amdgcn_mbcnt_hi((unsigned)(mg >> 32), __builtin_amdgcn_mbcnt_lo((unsigned)mg, 0u));
        const int pe = __builtin_amdgcn_mbcnt_hi((unsigned)(me >> 32), __builtin_amdgcn_mbcnt_lo((unsigned)me, 0u));
        sel[v] = false; slot[v] = 0;
        if (key[v] > T) { sel[v] = true; slot[v] = run + pg; }
        else if (key[v] == T && (erun + pe) < need) { sel[v] = true; slot[v] = ngt + erun + pe; }
        run += __popcll(mg); erun += __popcll(me);
    }
}
constexpr int KP = 68;
constexpr int PW_BYTES = 9344;
__device__ __forceinline__ float gelu_erf(float x) {
    const float z = fabsf(x) * 0.7071067811865476f; const float t = __builtin_amdgcn_rcpf(1.f + 0.3275911f * z);
    float p = 1.061405429f; p = p * t - 1.453152027f; p = p * t + 1.421413741f; p = p * t - 0.284496736f; p = p * t + 0.254829592f; p = p * t;
    const float er = 1.f - p * __expf(-z * z);
    return 0.5f * x * (1.f + (x < 0.f ? -er : er));
}
__device__ __forceinline__ float wave_max(float x) {
    x = row16_max(x);
    { auto r = __builtin_amdgcn_permlane16_swap(__float_as_uint(x), __float_as_uint(x), false, false); x = fmaxf(__uint_as_float(r[0]), __uint_as_float(r[1])); }
    { auto r = __builtin_amdgcn_permlane32_swap(__float_as_uint(x), __float_as_uint(x), false, false); x = fmaxf(__uint_as_float(r[0]), __uint_as_float(r[1])); }
    return x;
}
__device__ __forceinline__ void ld16_f32(const float* p, int lane, float (&x)[32]) {
#pragma unroll
    for (int q = 0; q < 2; ++q)
#pragma unroll
        for (int d = 0; d < 4; ++d) { const f32x4 a = *(const f32x4*)(p + 1024 * q + 16 * lane + 4 * d); x[q * 16 + d * 4 + 0] = a[0]; x[q * 16 + d * 4 + 1] = a[1]; x[q * 16 + d * 4 + 2] = a[2]; x[q * 16 + d * 4 + 3] = a[3]; }
}
__device__ __forceinline__ void ld16_f32_nt(const float* p, int lane, float (&x)[32]) {
#pragma unroll
    for (int q = 0; q < 2; ++q)
#pragma unroll
        for (int d = 0; d < 4; ++d) { const f32x4 a = __builtin_nontemporal_load((const f32x4*)(p + 1024 * q + 16 * lane + 4 * d)); x[q * 16 + d * 4 + 0] = a[0]; x[q * 16 + d * 4 + 1] = a[1]; x[q * 16 + d * 4 + 2] = a[2]; x[q * 16 + d * 4 + 3] = a[3]; }
}
__device__ __forceinline__ void st16_f32_nt(float* p, int lane, const float (&x)[32]) {
#pragma unroll
    for (int q = 0; q < 2; ++q)
#pragma unroll
        for (int d = 0; d < 4; ++d) __builtin_nontemporal_store((f32x4){x[q * 16 + d * 4 + 0], x[q * 16 + d * 4 + 1], x[q * 16 + d * 4 + 2], x[q * 16 + d * 4 + 3]}, (f32x4*)(p + 1024 * q + 16 * lane + 4 * d));
}
__device__ __forceinline__ void st16_f32(float* p, int lane, const float (&x)[32]) {
#pragma unroll
    for (int q = 0; q < 2; ++q)
#pragma unroll
        for (int d = 0; d < 4; ++d) *(f32x4*)(p + 1024 * q + 16 * lane + 4 * d) = (f32x4){x[q * 16 + d * 4 + 0], x[q * 16 + d * 4 + 1], x[q * 16 + d * 4 + 2], x[q * 16 + d * 4 + 3]};
}
__device__ __forceinline__ void ld16_bf16(const bf16_t* p, int lane, float (&x)[32]) {
#pragma unroll
    for (int q = 0; q < 2; ++q)
#pragma unroll
        for (int d = 0; d < 2; ++d) { const u32x4 w = *(const u32x4*)(p + 1024 * q + 16 * lane + 8 * d); float* o = &x[q * 16 + d * 8];
            o[0] = bflo(w.x); o[1] = bfhi(w.x); o[2] = bflo(w.y); o[3] = bfhi(w.y); o[4] = bflo(w.z); o[5] = bfhi(w.z); o[6] = bflo(w.w); o[7] = bfhi(w.w); }
}
__device__ __forceinline__ void st16_bf16(bf16_t* p, int lane, const float (&x)[32]) {
#pragma unroll
    for (int q = 0; q < 2; ++q)
#pragma unroll
        for (int d = 0; d < 2; ++d) { const float* o = &x[q * 16 + d * 8]; u32x4 w; w.x = cvt_pk_bf16(o[0], o[1]); w.y = cvt_pk_bf16(o[2], o[3]); w.z = cvt_pk_bf16(o[4], o[5]); w.w = cvt_pk_bf16(o[6], o[7]);
            *(u32x4*)(p + 1024 * q + 16 * lane + 8 * d) = w; }
}
constexpr int TBS = 1152;
__device__ __forceinline__ void ld_row_f32(int lane, const float* __restrict__ src, f32x4* a) {
#pragma unroll
    for (int q = 0; q < 2; ++q)
#pragma unroll
        for (int d = 0; d < 4; ++d) a[q * 4 + d] = __builtin_nontemporal_load((const f32x4*)(src + 1024 * q + 16 * lane + 4 * d));
}
__device__ __forceinline__ void cvt_row_fp4b(int lane, const f32x4* a, unsigned char* __restrict__ dst) {
    float x[32];
#pragma unroll
    for (int i = 0; i < 8; ++i) { x[i * 4 + 0] = a[i][0]; x[i * 4 + 1] = a[i][1]; x[i * 4 + 2] = a[i][2]; x[i * 4 + 3] = a[i][3]; }
    float am = 0.f;
#pragma unroll
    for (int i = 0; i < 32; ++i) am = fmaxf(am, fabsf(x[i]));
    const bf16_t sb = f2bf(am * (1.f / 6.f)); const float sf = bf2f(sb); const float sc = sf > 0.f ? __builtin_amdgcn_rcpf(sf) : 0.f;
    u32x4 w;
#pragma unroll
    for (int d = 0; d < 4; ++d) { unsigned t = 0u; const int o = (d >> 1) * 16 + (d & 1) * 8;
        t = __builtin_amdgcn_cvt_scalef32_pk_fp4_f32(t, x[o + 0] * sc, x[o + 1] * sc, 1.0f, 0); t = __builtin_amdgcn_cvt_scalef32_pk_fp4_f32(t, x[o + 2] * sc, x[o + 3] * sc, 1.0f, 1);
        t = __builtin_amdgcn_cvt_scalef32_pk_fp4_f32(t, x[o + 4] * sc, x[o + 5] * sc, 1.0f, 2); t = __builtin_amdgcn_cvt_scalef32_pk_fp4_f32(t, x[o + 6] * sc, x[o + 7] * sc, 1.0f, 3); w[d] = t; }
    *(u32x4*)(dst + 16 * lane) = w;
    *(bf16_t*)(dst + 1024 + 2 * lane) = sb;
}
__device__ __forceinline__ void cvt_row_fp4r(int lane, const float* __restrict__ src, unsigned char* __restrict__ dst, float* __restrict__ inv) {
    float x[32];
#pragma unroll
    for (int q = 0; q < 2; ++q)
#pragma unroll
        for (int d = 0; d < 4; ++d) { const f32x4 a = __builtin_nontemporal_load((const f32x4*)(src + 1024 * q + 16 * lane + 4 * d)); x[q * 16 + d * 4 + 0] = a[0]; x[q * 16 + d * 4 + 1] = a[1]; x[q * 16 + d * 4 + 2] = a[2]; x[q * 16 + d * 4 + 3] = a[3]; }
    float am = 0.f;
#pragma unroll
    for (int i = 0; i < 32; ++i) am = fmaxf(am, fabsf(x[i]));
    am = wave_max(am);
    const float sc = am > 0.f ? 6.f / am : 1.f;
    if (lane == 0) *inv = am > 0.f ? am * (1.f / 6.f) : 1.f;
    u32x4 w;
#pragma unroll
    for (int d = 0; d < 4; ++d) { unsigned t = 0u; const int o = (d >> 1) * 16 + (d & 1) * 8;
        t = __builtin_amdgcn_cvt_scalef32_pk_fp4_f32(t, x[o + 0] * sc, x[o + 1] * sc, 1.0f, 0); t = __builtin_amdgcn_cvt_scalef32_pk_fp4_f32(t, x[o + 2] * sc, x[o + 3] * sc, 1.0f, 1);
        t = __builtin_amdgcn_cvt_scalef32_pk_fp4_f32(t, x[o + 4] * sc, x[o + 5] * sc, 1.0f, 2); t = __builtin_amdgcn_cvt_scalef32_pk_fp4_f32(t, x[o + 6] * sc, x[o + 7] * sc, 1.0f, 3); w[d] = t; }
    *(u32x4*)(dst + 16 * lane) = w;
}
__device__ __forceinline__ void cvt_peer(const Frame& F, int l) {
    const int step = F.G * 8; int r = F.bid * 8 + F.wave;
    f32x4 cur[8], nxt[8];
    auto srcp = [&](int rr) { return (rr < 16384 ? F.in(23) : F.in(24)) + ((size_t)l * 16384 + (rr & 16383)) * 2048; };
    if (r < 32768) ld_row_f32(F.lane, srcp(r), cur);
    for (; r < 32768; r += step) {
        const int rn = r + step;
        if (rn < 32768) ld_row_f32(F.lane, srcp(rn), nxt);
        cvt_row_fp4b(F.lane, cur, wsp<unsigned char>(F, r < 16384 ? WS_PU : WS_PV) + (size_t)l * SZ_PT + (size_t)(r & 16383) * TBS);
#pragma unroll
        for (int i = 0; i < 8; ++i) cur[i] = nxt[i];
    }
}
#define PEER_G 4
template <int CTRL> __device__ __forceinline__ int dppi(int x) { return __builtin_amdgcn_update_dpp(0, x, CTRL, 0xF, 0xF, true); }
__device__ __forceinline__ int irow16_sum(int x) { x += dppi<0xB1>(x); x += dppi<0x4E>(x); x += dppi<0x141>(x); x += dppi<0x140>(x); return x; }
__device__ __forceinline__ int irow16_incl_scan(int x) { x += dppi<0x111>(x); x += dppi<0x112>(x); x += dppi<0x114>(x); x += dppi<0x118>(x); return x; }
constexpr int KBP = 72;
constexpr int PT_WORDS = 6 * 128 + 160 + 3 * 128;
constexpr int PWB = 2 * PT_WORDS * 4;
__device__ __forceinline__ void p_peer(const Frame& F, int l, bool last) {
    LAS bf16_t* kb1 = (LAS bf16_t*)F.lds; LAS bf16_t* kb2 = kb1 + 128 * KBP;
    LAS unsigned* wbase = (LAS unsigned*)(F.lds + 2 * 128 * KBP * 2 + F.wave * PWB);
    const int lane = F.lane, fr = lane & 15, fq = lane >> 4;
    __syncthreads();
    for (int i = F.tid; i < 128 * 64; i += 512) { const int r = i >> 6, d = i & 63; kb1[r * KBP + d] = f2bf(F.in(21)[(size_t)l * 8192 + i]); kb2[r * KBP + d] = f2bf(F.in(22)[(size_t)l * 8192 + i]); }
    __syncthreads();
    const bf16_t* QP = wsp<bf16_t>(F, WS_QP); const bf16_t* HB = wsp<bf16_t>(F, WS_HB); unsigned char* HB8w = wsp<unsigned char>(F, WS_HB8);
    const unsigned char* PU = wsp<unsigned char>(F, WS_PU) + (size_t)l * SZ_PT; const unsigned char* PV = wsp<unsigned char>(F, WS_PV) + (size_t)l * SZ_PT;
    const float* modl = wsp<float>(F, WS_MOD) + (size_t)l * 5 * 12288; const float* modn = wsp<float>(F, WS_MOD) + (size_t)(l + 1) * 5 * 12288;
    const float* g2n = F.in(25) + l * D; const float* b2n = F.in(26) + l * D;
    const int npairs = (last ? NLAT : NROW) / 2;
    const int per_wg = (npairs + F.G - 1) / F.G; const int p_lo = F.bid * per_wg; const int p_hi = (p_lo + per_wg) < npairs ? (p_lo + per_wg) : npairs;
    LAS int* wq = (LAS int*)(F.lds + 147456 - 32);
    if (F.tid == 0) *wq = 0;
    __syncthreads();
#pragma unroll 1
    for (;;) {
        int pi = 0; if (lane == 0) pi = __hip_atomic_fetch_add(wq, 1, __ATOMIC_RELAXED, __HIP_MEMORY_SCOPE_WORKGROUP);
        pi = p_lo + __builtin_amdgcn_readfirstlane(pi); if (pi >= p_hi) break;
        const int rowA = 2 * pi;
#pragma unroll 1
        for (int rep1_ = 0; rep1_ <= REP_PS1; ++rep1_) {
            unsigned kk[2][8][4];
            { int fr_ = fr; asm volatile("" : "+v"(fr_));
              const bf16_t* qrow = QP + (size_t)(rowA + (fr_ >> 3)) * 1024 + (fr_ & 7) * 128 + 8 * fq;
              bf16x8 af[2][2];
#pragma unroll
              for (int st = 0; st < 2; ++st)
#pragma unroll
                  for (int ks = 0; ks < 2; ++ks) af[st][ks] = *(const bf16x8*)(qrow + st * 64 + ks * 32);
#pragma unroll
              for (int st = 0; st < 2; ++st) { LAS bf16_t* kb = st ? kb2 : kb1;
#pragma unroll
                  for (int nb = 0; nb < 8; ++nb) { f32x4 c = {0.f, 0.f, 0.f, 0.f};
#pragma unroll
                      for (int ks = 0; ks < 2; ++ks) { const bf16x8 bfr = *(const LAS bf16x8*)(kb + (nb * 16 + fr) * KBP + ks * 32 + 8 * fq); c = __builtin_amdgcn_mfma_f32_16x16x32_bf16(af[st][ks], bfr, c, 0, 0, 0); }
#pragma unroll
                      for (int r = 0; r < 4; ++r) kk[st][nb][r] = f2key(c[r]); } } }
            unsigned T[2][4]; bool done[2][4];
#pragma unroll
            for (int st = 0; st < 2; ++st)
#pragma unroll
                for (int r = 0; r < 4; ++r) { T[st][r] = 0u; done[st][r] = false; }
#pragma unroll 1
            for (int bit = ((PS1_ABL & 1) && rep1_ < REP_PS1) ? -1 : 31; bit >= 0; --bit) { const unsigned bm = 1u << bit; bool alld = true;
#pragma unroll
                for (int st = 0; st < 2; ++st)
#pragma unroll
                    for (int r = 0; r < 4; ++r) { const unsigned cand = T[st][r] | bm; int c = 0;
#pragma unroll
                        for (int nb = 0; nb < 8; ++nb) c += (kk[st][nb][r] >= cand) ? 1 : 0;
                        c = irow16_sum(c);
                        const bool upd = (c >= 16) && !done[st][r]; T[st][r] = upd ? cand : T[st][r]; done[st][r] = done[st][r] || (c == 16); alld = alld && done[st][r]; }
                if (__all(alld)) break; }
            const int tt = lane >> 5, hd0 = ((lane >> 4) & 1) * 4;
            if (!((PS1_ABL & 2) && rep1_ < REP_PS1))
#pragma unroll
            for (int st = 0; st < 2; ++st)
#pragma unroll
                for (int r = 0; r < 4; ++r) { const unsigned Tr = T[st][r]; int g = 0, e = 0;
#pragma unroll
                    for (int nb = 0; nb < 8; ++nb) { g += (kk[st][nb][r] > Tr) ? 1 : 0; e += (kk[st][nb][r] == Tr) ? 1 : 0; }
                    int gpre = irow16_incl_scan(g) - g, epre = irow16_incl_scan(e) - e; const int ngt = irow16_sum(g); const int need = 16 - ngt;
                    LAS unsigned* tb = wbase + tt * PT_WORDS; LAS float* vl = (LAS float*)(tb + st * 128) + (hd0 + r) * 16; LAS int* il = (LAS int*)(tb + 256 + st * 128) + (hd0 + r) * 16;
#pragma unroll
                    for (int nb = 0; nb < 8; ++nb) { const unsigned k = kk[st][nb][r];
                        if (k > Tr) { vl[gpre] = key2f(k); il[gpre] = nb * 16 + fr; ++gpre; }
                        else if (k == Tr) { if (epre < need) { vl[ngt + epre] = key2f(k); il[ngt + epre] = nb * 16 + fr; } ++epre; } } }
        }
        asm volatile("s_waitcnt lgkmcnt(0)" ::: "memory");
        {
            const int tt = lane >> 5, hd0 = ((lane >> 4) & 1) * 4; LAS unsigned* tb = wbase + tt * PT_WORDS;
            unsigned ck[4][16];
#pragma unroll
            for (int r = 0; r < 4; ++r) { const float va = ((LAS float*)tb)[(hd0 + r) * 16 + fr]; const LAS float* v2p = (LAS float*)(tb + 128) + (hd0 + r) * 16;
#pragma unroll
                for (int j4 = 0; j4 < 4; ++j4) { const f32x4 vb = *(const LAS f32x4*)(v2p + j4 * 4);
#pragma unroll
                    for (int i = 0; i < 4; ++i) ck[r][j4 * 4 + i] = f2key(va + vb[i]); } }
            unsigned T[4]; bool done[4];
#pragma unroll
            for (int r = 0; r < 4; ++r) { T[r] = 0u; done[r] = false; }
#pragma unroll 1
            for (int bit = 31; bit >= 0; --bit) { const unsigned bm = 1u << bit; bool alld = true;
#pragma unroll
                for (int r = 0; r < 4; ++r) { const unsigned cand = T[r] | bm; int c = 0;
#pragma unroll
                    for (int j = 0; j < 16; ++j) c += (ck[r][j] >= cand) ? 1 : 0;
                    c = irow16_sum(c);
                    const bool upd = (c >= 16) && !done[r]; T[r] = upd ? cand : T[r]; done[r] = done[r] || (c == 16); alld = alld && done[r]; }
                if (__all(alld)) break; }
#pragma unroll
            for (int r = 0; r < 4; ++r) { const unsigned Tr = T[r]; int g = 0, e = 0;
#pragma unroll
                for (int j = 0; j < 16; ++j) { g += (ck[r][j] > Tr) ? 1 : 0; e += (ck[r][j] == Tr) ? 1 : 0; }
                int gpre = irow16_incl_scan(g) - g, epre = irow16_incl_scan(e) - e; const int ngt = irow16_sum(g); const int need = 16 - ngt;
                const int e1 = ((LAS int*)(tb + 256))[(hd0 + r) * 16 + fr] * 128; const LAS int* i2p = (LAS int*)(tb + 384) + (hd0 + r) * 16;
                LAS float* cs_ = (LAS float*)(tb + 512) + (hd0 + r) * 16; LAS int* ce_ = (LAS int*)(tb + 640) + (hd0 + r) * 16;
#pragma unroll
                for (int j = 0; j < 16; ++j) { const unsigned k = ck[r][j];
                    if (k > Tr) { cs_[gpre] = key2f(k); ce_[gpre] = e1 + i2p[j]; ++gpre; }
                    else if (k == Tr) { if (epre < need) { cs_[ngt + epre] = key2f(k); ce_[ngt + epre] = e1 + i2p[j]; } ++epre; } } }
        }
        asm volatile("s_waitcnt lgkmcnt(0)" ::: "memory");
#pragma unroll 1
      for (int t = 0; t < 2; ++t) {
        const int row = rowA + t; const int v = row < NLAT ? (row >> 12) : 4;
        LAS unsigned* tb = wbase + t * PT_WORDS;
        LAS float* v1l = (LAS float*)tb; LAS float* v2l = v1l + 128; LAS int* i1l = (LAS int*)(v2l + 128); LAS int* i2l = i1l + 128;
        LAS float* csl = (LAS float*)(i2l + 128); LAS int* cel = (LAS int*)(csl + 128); LAS int* el = cel + 128; LAS float* gl = (LAS float*)(el + 160); LAS float* su = gl + 128; LAS float* sv = su + 128;
        {
#pragma unroll
            for (int it = 0; it < 2; ++it) { const int idx = it * 64 + lane;
                const float sx = csl[idx]; const float mx = row16_max(sx); const float pe_ = __expf(sx - mx); const float sm = row16_sum(pe_);
                el[idx] = cel[idx]; gl[idx] = pe_ / sm; }
        }
        if (lane < 32) el[128 + lane] = el[0];
        asm volatile("s_waitcnt vmcnt(0) lgkmcnt(0)" ::: "memory");
        const bool b0_ = lane & 1, b1_ = lane & 2, b2_ = lane & 4;
        u32x4 A[8], B[8], C[8]; unsigned SA[8], SB[8], SC[8];
#define PEER_LOADT(buf, sbuf, tab, g) do { _Pragma("unroll") for (int x = 0; x < 8; ++x) { const int e = __builtin_amdgcn_readfirstlane(el[(g) * 8 + x]); const unsigned char* rp = (tab) + (size_t)e * TBS; \
            buf[x] = *(const u32x4*)(rp + 16 * lane); sbuf[x] = *(const bf16_t*)(rp + 1024 + 2 * lane); } } while (0)
#define PEER_LOADV(buf, g) do { _Pragma("unroll") for (int x = 0; x < 8; ++x) { const int e = __builtin_amdgcn_readfirstlane(el[(g) * 8 + x]); buf[x] = *(const u32x4*)(PV + (size_t)e * 1024 + 16 * lane); } } while (0)
#define FP4X8(w_, f0_, f1_, f2_, f3_) const f32x2 f0_ = __builtin_amdgcn_cvt_scalef32_pk_f32_fp4(w_, 1.0f, 0), f1_ = __builtin_amdgcn_cvt_scalef32_pk_f32_fp4(w_, 1.0f, 1), f2_ = __builtin_amdgcn_cvt_scalef32_pk_f32_fp4(w_, 1.0f, 2), f3_ = __builtin_amdgcn_cvt_scalef32_pk_f32_fp4(w_, 1.0f, 3)
#define PEER_DOT(buf, sbuf, g) do { float p_[8]; \
            _Pragma("unroll") for (int x = 0; x < 8; ++x) { f32x2 s2_ = {0.f, 0.f}; \
                _Pragma("unroll") for (int d = 0; d < 4; ++d) { const unsigned w_ = buf[x][d]; FP4X8(w_, f0_, f1_, f2_, f3_); const int o_ = (d >> 1) * 8 + (d & 1) * 4; \
                    s2_ = hh2[o_ + 0] * f0_ + s2_; s2_ = hh2[o_ + 1] * f1_ + s2_; s2_ = hh2[o_ + 2] * f2_ + s2_; s2_ = hh2[o_ + 3] * f3_ + s2_; } \
                p_[x] = (s2_.x + s2_.y) * __uint_as_float(sbuf[x] << 16); SBAR(); } \
              \
            float q_[4], r_[2]; \
            _Pragma("unroll") for (int j = 0; j < 4; ++j) { const float keep_ = b0_ ? p_[2 * j + 1] : p_[2 * j], send_ = b0_ ? p_[2 * j] : p_[2 * j + 1]; q_[j] = keep_ + dppf<0xB1>(send_); } \
            _Pragma("unroll") for (int j = 0; j < 2; ++j) { const float keep_ = b1_ ? q_[2 * j + 1] : q_[2 * j], send_ = b1_ ? q_[2 * j] : q_[2 * j + 1]; r_[j] = keep_ + dppf<0x4E>(send_); } \
            float t_; { const float keep_ = b2_ ? r_[1] : r_[0], send_ = b2_ ? r_[0] : r_[1]; const float up_ = dppf<0x104>(send_), dn_ = dppf<0x114>(send_); t_ = keep_ + (b2_ ? dn_ : up_); } \
            t_ += dppf<0x128>(t_); \
            { auto r16_ = __builtin_amdgcn_permlane16_swap(__float_as_uint(t_), __float_as_uint(t_), false, false); t_ = __uint_as_float(r16_[0]) + __uint_as_float(r16_[1]); } \
            { auto r32_ = __builtin_amdgcn_permlane32_swap(__float_as_uint(t_), __float_as_uint(t_), false, false); t_ = __uint_as_float(r32_[0]) + __uint_as_float(r32_[1]); } \
            const float av = gelu_erf(t_) * gl[(g) * 8 + (lane & 7)]; const bool me_ = (lane >> 3) == ((g) & 7); \
            avl = (me_ && (g) < 8) ? av : avl; avh = (me_ && (g) >= 8) ? av : avh; } while (0)
#define PIN_ACC() do { asm volatile("" : "+v"(acc2[0]), "+v"(acc2[1]), "+v"(acc2[2]), "+v"(acc2[3]), "+v"(acc2[4]), "+v"(acc2[5]), "+v"(acc2[6]), "+v"(acc2[7]), "+v"(acc2[8]), "+v"(acc2[9]), "+v"(acc2[10]), "+v"(acc2[11]), "+v"(acc2[12]), "+v"(acc2[13]), "+v"(acc2[14]), "+v"(acc2[15])); } while (0)
#define PEER_AXPY(buf, sbuf, g) do { _Pragma("unroll") for (int x = 0; x < 8; ++x) { const int idx = (g) * 8 + x; \
            const float av = __uint_as_float(__builtin_amdgcn_readlane(__float_as_uint(idx < 64 ? avl : avh), idx & 63)) * __uint_as_float(sbuf[x] << 16); const f32x2 av2_ = {av, av}; \
            _Pragma("unroll") for (int d = 0; d < 4; ++d) { const unsigned w_ = buf[x][d]; FP4X8(w_, f0_, f1_, f2_, f3_); const int o_ = (d >> 1) * 8 + (d & 1) * 4; \
                acc2[o_ + 0] = av2_ * f0_ + acc2[o_ + 0]; acc2[o_ + 1] = av2_ * f1_ + acc2[o_ + 1]; acc2[o_ + 2] = av2_ * f2_ + acc2[o_ + 2]; acc2[o_ + 3] = av2_ * f3_ + acc2[o_ + 3]; } PIN_ACC(); } } while (0)
        float avl = 0.f, avh = 0.f;
        PEER_LOADT(A, SA, PU, 0); PEER_LOADT(B, SB, PU, 1); SBAR();
        float hh[32]; ld16_bf16(HB + (size_t)row * D, lane, hh);
        f32x2 hh2[16];
#pragma unroll
        for (int i = 0; i < 16; ++i) hh2[i] = (f32x2){hh[2 * i], hh[2 * i + 1]};
#pragma unroll 1
        for (int g = 0; g < 15; g += 3) { PEER_LOADT(C, SC, PU, g + 2); SBAR(); PEER_DOT(A, SA, g); SBAR(); PEER_LOADT(A, SA, PU, g + 3); SBAR(); PEER_DOT(B, SB, g + 1); SBAR();
            PEER_LOADT(B, SB, (g + 4 < 16 ? PU : PV), (g + 4) & 15); SBAR(); PEER_DOT(C, SC, g + 2); SBAR(); }
        PEER_LOADT(C, SC, PV, 1); SBAR();
        PEER_DOT(A, SA, 15); SBAR();
        f32x2 acc2[16];
#pragma unroll
        for (int i = 0; i < 16; ++i) acc2[i] = (f32x2){0.f, 0.f};
#pragma unroll 1
        for (int g = 0; g < 15; g += 3) { PEER_LOADT(A, SA, PV, g + 2); SBAR(); PEER_AXPY(B, SB, g); SBAR(); PEER_LOADT(B, SB, PV, g + 3); SBAR(); PEER_AXPY(C, SC, g + 1); SBAR(); PEER_LOADT(C, SC, PV, g + 4); SBAR(); PEER_AXPY(A, SA, g + 2); SBAR(); }
        float x1[32], g2[32]; ld16_bf16(wsp<bf16_t>(F, WS_S1) + (size_t)row * D, lane, x1); ld16_f32(modl + (size_t)v * 12288 + 10240, lane, g2); SBAR();
        PEER_AXPY(B, SB, 15); SBAR();
#undef PEER_LOADT
#undef PEER_LOADV
#undef PEER_DOT
#undef PEER_AXPY
        float acc[32];
        {
#pragma unroll
          for (int i = 0; i < 32; ++i) acc[i] = ALPHA * x1[i] + g2[i] * acc2[i >> 1][i & 1]; }
        { float sm = 0.f;
#pragma unroll
          for (int i = 0; i < 32; ++i) sm += acc[i];
          const float mu = wave_sum(sm) * (1.f / 2048.f); float qq = 0.f;
#pragma unroll
          for (int i = 0; i < 32; ++i) { const float dd = acc[i] - mu; qq += dd * dd; }
          const float rstd = rsqrtf(wave_sum(qq) * (1.f / 2048.f) + LN_EPS);
#pragma unroll
          for (int q = 0; q < 2; ++q)
#pragma unroll
              for (int d = 0; d < 4; ++d) { const int o = 1024 * q + 16 * lane + 4 * d; const f32x4 gg = *(const f32x4*)(g2n + o), bb = *(const f32x4*)(b2n + o);
#pragma unroll
                  for (int i = 0; i < 4; ++i) acc[q * 16 + d * 4 + i] = (acc[q * 16 + d * 4 + i] - mu) * rstd * gg[i] + bb[i]; } }
        st16_f32(xres_row(F, row), lane, acc);
        if (!last) { const float* sh = modn + (size_t)v * 12288; const float* sc = sh + 2048;
#pragma unroll
            for (int q = 0; q < 2; ++q)
#pragma unroll
                for (int d = 0; d < 4; ++d) { const int o = 1024 * q + 16 * lane + 4 * d; const f32x4 hh4 = *(const f32x4*)(sh + o), cc4 = *(const f32x4*)(sc + o);
#pragma unroll
                    for (int i = 0; i < 4; ++i) acc[q * 16 + d * 4 + i] = clamp8(acc[q * 16 + d * 4 + i] * (1.f + cc4[i]) + hh4[i]); }
#pragma unroll
            for (int q = 0; q < 2; ++q) { u32x4 w;
#pragma unroll
                for (int d = 0; d < 4; ++d) w[d] = pk4_fp8(acc[q * 16 + d * 4 + 0], acc[q * 16 + d * 4 + 1], acc[q * 16 + d * 4 + 2], acc[q * 16 + d * 4 + 3]);
                *(u32x4*)(HB8w + (size_t)row * D + 1024 * q + 16 * lane) = w; } }
      }
    }
}
#ifdef DBG
constexpr size_t WS_DBG = WS_CTL + 131072;
constexpr int DBG_NS = 60;
__device__ __forceinline__ int dbg_row(int s) { return (s * 263 + 5) % NLAT; }
__global__ void __launch_bounds__(256) dbg_peer_pre(Args args, int l) {
    __shared__ float q[1024]; __shared__ float s1[128], s2[128]; __shared__ float v1[16], v2[16]; __shared__ int i1[16], i2[16]; __shared__ float cs[256]; __shared__ int ce[256];
    __shared__ float ts[16]; __shared__ int te[16]; __shared__ float red[256]; __shared__ float aval[128]; __shared__ int eid[128]; __shared__ float h2[2048];
    const int s = blockIdx.x, row = dbg_row(s), tid = threadIdx.x; unsigned char* ws = args.ws;
    const bf16_t* QP = (const bf16_t*)(ws + WS_QP); const bf16_t* HB = (const bf16_t*)(ws + WS_HB);
    float* dbgf = (float*)(ws + WS_DBG + 4096); int* dbge = (int*)(dbgf + DBG_NS * 2048); float* dbga = (float*)(dbge + DBG_NS * 128); float* dbgg = dbga + 3 * DBG_NS * 128;
    for (int i = tid; i < 1024; i += 256) q[i] = bf2f(QP[(size_t)row * 1024 + i]);
    for (int i = tid; i < 2048; i += 256) h2[i] = bf2f(HB[(size_t)row * D + i]);
    __syncthreads();
    const float* k1 = args.in[21] + (size_t)l * 8192; const float* k2 = args.in[22] + (size_t)l * 8192;
    for (int hd = 0; hd < 8; ++hd) {
        { const int k = tid & 127; const float* kk = (tid < 128 ? k1 : k2) + k * 64; const float* qq = q + hd * 128 + (tid < 128 ? 0 : 64); float a = 0.f; for (int d = 0; d < 64; ++d) a += qq[d] * kk[d]; (tid < 128 ? s1 : s2)[k] = a; }
        __syncthreads();
        { const int k = tid & 127; const float* sv = tid < 128 ? s1 : s2; const float me = sv[k]; int rank = 0; for (int j = 0; j < 128; ++j) rank += (sv[j] > me || (sv[j] == me && j < k)) ? 1 : 0;
          if (rank < 16) { (tid < 128 ? v1 : v2)[rank] = me; (tid < 128 ? i1 : i2)[rank] = k; } }
        __syncthreads();
        { const int i = tid >> 4, j = tid & 15; cs[tid] = v1[i] + v2[j]; ce[tid] = i1[i] * 128 + i2[j]; }
        __syncthreads();
        { const float me = cs[tid]; int rank = 0; for (int j = 0; j < 256; ++j) rank += (cs[j] > me || (cs[j] == me && j < tid)) ? 1 : 0; if (rank < 16) { ts[rank] = me; te[rank] = ce[tid]; } }
        __syncthreads();
        if (tid < 16) { float mx = ts[0]; float sm = 0.f; for (int j = 0; j < 16; ++j) sm += expf(ts[j] - mx); aval[hd * 16 + tid] = expf(ts[tid] - mx) / sm; eid[hd * 16 + tid] = te[tid]; dbgg[s * 128 + hd * 16 + tid] = aval[hd * 16 + tid]; }
        __syncthreads();
    }
    const float* U = args.in[23] + (size_t)l * 16384 * 2048; const float* V = args.in[24] + (size_t)l * 16384 * 2048;
    for (int e = 0; e < 128; ++e) { const float* ur = U + (size_t)eid[e] * 2048; float p = 0.f; for (int d = tid; d < 2048; d += 256) p += h2[d] * ur[d]; red[tid] = p; __syncthreads();
        for (int st = 128; st > 0; st >>= 1) { if (tid < st) red[tid] += red[tid + st]; __syncthreads(); }
        if (tid == 0) { const float sc = red[0]; aval[e] = 0.5f * sc * (1.f + erff(sc * 0.70710678f)) * aval[e]; } __syncthreads(); }
    float y[8]; const float* xr = args.out + (size_t)row * D; const int v = row >> 12; const float* mod = (const float*)(ws + WS_MOD) + (size_t)l * 5 * 12288 + (size_t)v * 12288;
    float sum = 0.f;
    for (int k = 0; k < 8; ++k) { const int d = tid + 256 * k; float o = 0.f; for (int e = 0; e < 128; ++e) o += aval[e] * V[(size_t)eid[e] * 2048 + d]; y[k] = ALPHA * xr[d] + mod[10240 + d] * o; sum += y[k]; }
    red[tid] = sum; __syncthreads(); for (int st = 128; st > 0; st >>= 1) { if (tid < st) red[tid] += red[tid + st]; __syncthreads(); } const float mu = red[0] / 2048.f; __syncthreads();
    float sq = 0.f; for (int k = 0; k < 8; ++k) sq += (y[k] - mu) * (y[k] - mu);
    red[tid] = sq; __syncthreads(); for (int st = 128; st > 0; st >>= 1) { if (tid < st) red[tid] += red[tid + st]; __syncthreads(); } const float rstd = rsqrtf(red[0] / 2048.f + LN_EPS);
    for (int k = 0; k < 8; ++k) { const int d = tid + 256 * k; dbgf[(size_t)s * 2048 + d] = (y[k] - mu) * rstd * args.in[25][l * D + d] + args.in[26][l * D + d]; }
    if (tid < 128) { dbge[s * 128 + tid] = eid[tid]; dbga[s * 128 + tid] = aval[tid]; }
}
__global__ void __launch_bounds__(256) dbg_peer_post(Args args) {
    __shared__ int bad_e, bad_x, bad_a, bad_g;
    const int s = blockIdx.x, row = dbg_row(s), tid = threadIdx.x; unsigned char* ws = args.ws; unsigned* cnt = (unsigned*)(ws + WS_DBG);
    float* dbgf = (float*)(ws + WS_DBG + 4096); int* dbge = (int*)(dbgf + DBG_NS * 2048); float* dbga = (float*)(dbge + DBG_NS * 128);
    int* fe = (int*)(dbga + DBG_NS * 128); float* fa = (float*)(fe + DBG_NS * 128); float* dbgg = dbga + 3 * DBG_NS * 128; float* fg = dbgg + DBG_NS * 128;
    if (tid == 0) { bad_e = 0; bad_x = 0; bad_a = 0; bad_g = 0; } __syncthreads();
    if (tid < 128) { const int hd = tid >> 4; const int e = dbge[s * 128 + tid]; bool found = false; float af = 0.f, gf = 0.f; for (int j = 0; j < 16; ++j) if (fe[s * 128 + hd * 16 + j] == e) { found = true; af = fa[s * 128 + hd * 16 + j]; gf = fg[s * 128 + hd * 16 + j]; }
        if (!found) atomicAdd(&bad_e, 1); else { const float ea = dbga[s * 128 + tid]; if (fabsf(af - ea) > 0.02f * fabsf(ea) + 2e-3f) atomicAdd(&bad_a, 1); const float eg = dbgg[s * 128 + tid]; if (fabsf(gf - eg) > 0.02f * fabsf(eg) + 1e-3f) atomicAdd(&bad_g, 1); } }
    for (int k = 0; k < 8; ++k) { const int d = tid + 256 * k; const float ex = dbgf[(size_t)s * 2048 + d], got = args.out[(size_t)row * D + d]; if (!(fabsf(got - ex) <= 0.03f + 0.03f * fabsf(ex))) atomicAdd(&bad_x, 1); }
    __syncthreads();
    if (tid == 0) { if (bad_e > 2) atomicAdd(&cnt[1], 1u); if (bad_g > 2) atomicAdd(&cnt[2], 1u); if (bad_a > 2) atomicAdd(&cnt[3], 1u); if (bad_x > 8) atomicAdd(&cnt[4], 1u); }
}
__global__ void dbg_report(Args args) {
    unsigned* cnt = (unsigned*)(args.ws + WS_DBG);
    float code = 0.f;
    for (int lv = 1; lv <= 9; ++lv) if (cnt[lv]) { int tenths = (int)(cnt[lv] * 10 / DBG_NS); if (tenths > 9) tenths = 9; code = 1000.f * lv + 100.f * tenths; break; }
    if (code != 0.f) for (int i = threadIdx.x; i < 4096; i += blockDim.x) args.out[i] = code;
}
#endif
template <int ABL>
__device__ __forceinline__ void p_attn_gqa(const Frame& F, int last) {
    LAS unsigned char* lds = F.lds;
    const unsigned char* QG = wsp<unsigned char>(F, WS_QG); const unsigned char* KG = wsp<unsigned char>(F, WS_KG); const unsigned char* VG = wsp<unsigned char>(F, WS_VG); unsigned char* OAB = wsp<unsigned char>(F, WS_OAB);
    const int nlat = NB * 8 * 16, nall = last ? nlat : nlat + NB * 8;
    for (int u = F.bid; u < nall; u += F.G) {
        int bh, q0, seq; size_t orow;
        if (u < nlat) {
            int uu = u;
            if (F.G == 256) {
                const int c = u & 255, i = u >> 8, xcd = c & 7, r = c >> 3, kvg = i * 4 + (xcd >> 1), within = (xcd & 1) * 32 + r;
                uu = (((kvg >> 1) * 8 + (kvg & 1) * 4 + (within >> 4)) << 4) | (within & 15); }
            bh = uu >> 4; const int qb = uu & 15; q0 = CTXL + qb * 256; seq = TT; orow = (size_t)(bh >> 3) * SEQ + qb * 256; }
        else { bh = u - nlat; q0 = 0; seq = CTXL; orow = (size_t)NLAT + (bh >> 3) * CTXL; }
        const int b = bh >> 3, h = bh & 7; const size_t kvo = (size_t)(b * 2 + (h >> 2)) * TT * 128;
        __syncthreads();
        att::attn_body<4, 0, ABL>(QG + ((size_t)bh * TT + q0) * 128, KG + kvo, VG + (size_t)(b * 2 + (h >> 2)) * 128 * TT, OAB + orow * D + 1024 + h * 128, seq, lds, F.tid);
    }
    __syncthreads();
}
template <int ABL>
__device__ __forceinline__ void p_attn_mla(const Frame& F, int last) {
    LAS unsigned char* lds = F.lds;
    const unsigned char* QM = wsp<unsigned char>(F, WS_QM); const unsigned char* KM = wsp<unsigned char>(F, WS_KM); const unsigned char* VM = wsp<unsigned char>(F, WS_VM); unsigned char* OAB = wsp<unsigned char>(F, WS_OAB);
    const int nlat = NB * 8 * 16, nall = last ? nlat : nlat + NB * 8;
    for (int u = F.bid; u < nall; u += F.G) {
        int bh, q0, seq; size_t orow;
        if (u < nlat) {
            int uu = u;
            if (F.G == 256) { const int c = u & 255, i = u >> 8, xcd = c & 7, r = c >> 3; uu = ((i * 16 + xcd * 2 + (r >> 4)) << 4) | (r & 15); }
            bh = uu >> 4; const int qb = uu & 15; q0 = CTXL + qb * 256; seq = TT; orow = (size_t)(bh >> 3) * SEQ + qb * 256; }
        else { bh = u - nlat; q0 = 0; seq = CTXL; orow = (size_t)NLAT + (bh >> 3) * CTXL; }
        const int h = bh & 7;
        __syncthreads();
        att::attn_body<2, 1, ABL>(QM + ((size_t)bh * TT + q0) * 128, KM + (size_t)bh * TT * 128, VM + (size_t)bh * 64 * TT, OAB + orow * D + h * 64, seq, lds, F.tid);
    }
    __syncthreads();
}
__device__ __forceinline__ void p_ret_out(const Frame& F, int l, int last) {
    const int c_lo = last ? 2 : 0, nc = 34 - c_lo, nu = NB * 8 * nc;
    for (int u = F.bid; u < nu; u += F.G) { const int bh = u / nc, c = c_lo + (u % nc); ret_out_unit(F, l, bh, c); }
    __syncthreads();
}

constexpr int LDS_BYTES = 147456;
constexpr int MISC_OFF = 147456 - 64;
constexpr int NPHASE = 22;
#ifndef PHM
#define PHM 0xFFFF
#endif
#ifndef PH_ATTR
#define PH_ATTR __forceinline__
#endif
template <int PART> __device__ PH_ATTR void ph_prologue(ArgP ap) { const Frame F = make_frame(ap); p0_prologue<PART>(F); }
__device__ PH_ATTR void ph_modreduce(ArgP ap) { const Frame F = make_frame(ap); p1_modreduce(F); }
__device__ PH_ATTR void ph_modulate0(ArgP ap) { const Frame F = make_frame(ap); p_modulate0(F); }
template <int GABL> __device__ PH_ATTR void ph_gemm_in(ArgP ap, int l) { const Frame F = make_frame(ap);
    pg8::Gemm g{wsp<bf16_t>(F, WS_HB8), wsp<bf16_t>(F, WS_WIN + l * SZ_WIN), NROW, NPT, 1024, 1024, 1024}; pg8::StaticOrder S; S.init(NROW, NPT, F.G, F.bid);
    float mul_, inv_; fp8_scale(wsp<unsigned>(F, WS_WSC)[l], mul_, inv_);
    EpiIn E{wsp<bf16_t>(F, WS_P1), wsp<bf16_t>(F, WS_G), inv_};
    pg8::gemm_phase<EpiIn, pg8::StaticOrder, GABL>(F.lds, F.tid, g, S, E); }
__device__ PH_ATTR void ph_post(ArgP ap, int l) { const Frame F = make_frame(ap); p_post(F, l); if (l == 1) cvt_peer(F, 1); }
__device__ PH_ATTR void ph_qup(ArgP ap, int l) { const Frame F = make_frame(ap);
    pg8::Gemm g{wsp<bf16_t>(F, WS_CQN), wsp<bf16_t>(F, WS_WQUP + l * SZ_WQUP), NROW, 768, 512, 512, 512}; pg8::StaticOrder S; S.init(NROW, 768, F.G, F.bid);
    EpiQup E{wsp<unsigned char>(F, WS_QM), wsp<f32x2>(F, WS_ROPE32)};
    pg8::gemm_phase<EpiQup, pg8::StaticOrder>(F.lds, F.tid, g, S, E); }
__device__ PH_ATTR void ph_kvup(ArgP ap, int l) { const Frame F = make_frame(ap);
    pg8::Gemm g{wsp<bf16_t>(F, WS_CKVN), wsp<bf16_t>(F, WS_WKVUP + l * SZ_WKVUP), NROW, 1024, 256, 256, 256}; pg8::StaticOrder S; S.init(NROW, 1024, F.G, F.bid);
    EpiKvup E{wsp<unsigned char>(F, WS_KM), wsp<unsigned char>(F, WS_VM)};
    pg8::gemm_phase<EpiKvup, pg8::StaticOrder>(F.lds, F.tid, g, S, E); }
__device__ PH_ATTR void ph_states(ArgP ap, int l) { const Frame F = make_frame(ap); p_ret_states(F, l); }
template <int ABL> __device__ PH_ATTR void ph_attn_gqa(ArgP ap, int last) { const Frame F = make_frame(ap); p_attn_gqa<ABL>(F, last); }
template <int ABL> __device__ PH_ATTR void ph_attn_mla(ArgP ap, int last) { const Frame F = make_frame(ap); p_attn_mla<ABL>(F, last); }
__device__ PH_ATTR void ph_ret_out(ArgP ap, int l, int last) { const Frame F = make_frame(ap); p_ret_out(F, l, last); }
template <int SEG> __device__ PH_ATTR void ph_merge(ArgP ap, int l, int Mx) { const Frame F = make_frame(ap);
    const bf16_t* OAB = wsp<bf16_t>(F, WS_OAB); bf16_t* MB = wsp<bf16_t>(F, WS_MB); const bf16_t* G = wsp<bf16_t>(F, WS_G);
    pg8::StaticOrder S; S.init(Mx, 2048, F.G, F.bid);
    const size_t wo = SEG == 0 ? WS_WBRA + l * SZ_WBRA : (SEG == 1 ? WS_WBRB + l * SZ_WBRB : WS_WBRC + l * SZ_WBRC); const int K = SEG == 2 ? 1024 : 512;
    pg8::Gemm g{OAB + SEG * 512, wsp<bf16_t>(F, wo), Mx, 2048, K, 2048, K}; EpiMerge<SEG> E{MB, G, wsp<unsigned char>(F, WS_MB8)}; pg8::gemm_phase<EpiMerge<SEG>, pg8::StaticOrder>(F.lds, F.tid, g, S, E); }
__device__ PH_ATTR void ph_merge3(ArgP ap, int l, int Mx) { const Frame F = make_frame(ap);
    pg8::StaticOrder S; S.init(Mx, 2048, F.G, F.bid);
    float m0_, i0_, m1_, i1_, m2_, i2_; fp8_scale(wsp<unsigned>(F, WS_WSC)[4 + l], m0_, i0_); fp8_scale(wsp<unsigned>(F, WS_WSC)[6 + l], m1_, i1_); fp8_scale(wsp<unsigned>(F, WS_WSC)[8 + l], m2_, i2_);
    pg8::Merge3 g{wsp<bf16_t>(F, WS_OAB), wsp<bf16_t>(F, WS_WBRA + l * SZ_WBRA), wsp<bf16_t>(F, WS_WBRB + l * SZ_WBRB), wsp<bf16_t>(F, WS_WBRC + l * SZ_WBRC), wsp<bf16_t>(F, WS_G), wsp<unsigned char>(F, WS_MB8), i0_ * m1_, i1_ * m2_, i2_};
    pg8::gemm_merge3<pg8::StaticOrder>(F.lds, F.tid, g, S); }
__device__ PH_ATTR void ph_out(ArgP ap, int l, int Mx) { const Frame F = make_frame(ap);
    pg8::Gemm g{wsp<bf16_t>(F, WS_MB8), wsp<bf16_t>(F, WS_WOUT + l * SZ_WOUT), Mx, 2048, 1024, 1024, 1024}; pg8::StaticOrder S; S.init(Mx, 2048, F.G, F.bid);
    float mul_, inv_; fp8_scale(wsp<unsigned>(F, WS_WSC)[2 + l], mul_, inv_);
    EpiOut E{l == 0 ? F.in(0) : F.out, l == 0 ? F.in(2) : wsp<float>(F, WS_XC), wsp<bf16_t>(F, WS_S1), wsp<float>(F, WS_MOD) + (size_t)l * 5 * 12288 + 4096, inv_ * (1.f / 16.f)};
    pg8::gemm_phase<EpiOut, pg8::StaticOrder>(F.lds, F.tid, g, S, E); }
__device__ PH_ATTR void ph_ln1(ArgP ap, int l, int last) { const Frame F = make_frame(ap); p_ln1(F, l, last); }
__device__ PH_ATTR void ph_peerq(ArgP ap, int l, int Mx) { const Frame F = make_frame(ap);
    pg8::Gemm g{wsp<bf16_t>(F, WS_HB), wsp<bf16_t>(F, WS_WPQ + l * SZ_WPQ), Mx, 1024, 2048, 2048, 2048}; pg8::StaticOrder S; S.init(Mx, 1024, F.G, F.bid);
    EpiPlain E{wsp<bf16_t>(F, WS_QP), 1024};
    pg8::gemm_phase<EpiPlain, pg8::StaticOrder>(F.lds, F.tid, g, S, E); }
__device__ PH_ATTR void ph_peer(ArgP ap, int l, int last) { const Frame F = make_frame(ap); p_peer(F, l, last); }

__global__ void __launch_bounds__(512, 2) mega_fwd(Args args) {
    extern __shared__ __attribute__((aligned(16))) unsigned char lds_raw[];
    const ArgP ap = (ArgP)__builtin_amdgcn_kernarg_segment_ptr();
    const int lo = ap->ph_lo, hi = ap->ph_hi;
    volatile LAS unsigned* misc = (volatile LAS unsigned*)((LAS unsigned char*)lds_raw + MISC_OFF);
    if (threadIdx.x < 4) misc[threadIdx.x] = 0u;
    __syncthreads();
    XcdBarrier bar; bar.bar = (unsigned*)(ap->ws + WS_CTL); bar.x = 0; bar.st = misc;
    if (hi - lo > 1) bar = xcd_barrier_post((unsigned*)(ap->ws + WS_CTL), misc);
#ifdef BENCH_K
    { float a[16]; f32x2 b2[8];
#pragma unroll
      for (int i = 0; i < 16; ++i) a[i] = 1.f + threadIdx.x * 1e-3f + i;
#pragma unroll
      for (int i = 0; i < 8; ++i) b2[i] = (f32x2){a[i], a[i + 8]};
      float c0 = a[3], c1 = a[5];
#define B16(INS) asm volatile(INS(0) INS(1) INS(2) INS(3) INS(4) INS(5) INS(6) INS(7) INS(8) INS(9) INS(10) INS(11) INS(12) INS(13) INS(14) INS(15) \
        : "+v"(a[0]), "+v"(a[1]), "+v"(a[2]), "+v"(a[3]), "+v"(a[4]), "+v"(a[5]), "+v"(a[6]), "+v"(a[7]), "+v"(a[8]), "+v"(a[9]), "+v"(a[10]), "+v"(a[11]), "+v"(a[12]), "+v"(a[13]), "+v"(a[14]), "+v"(a[15]) : "v"(c0), "v"(c1))
#define I_ADD(i) "v_add_f32 %" #i ", %" #i ", %16\n"
#define I_EXP(i) "v_exp_f32 %" #i ", %" #i "\n"
#define I_MAX3(i) "v_max3_f32 %" #i ", %" #i ", %16, %17\n"
#define I_CVT(i) "v_cvt_pk_fp8_f32 %" #i ", %16, %17\n"
#define I_DEP(i) "v_max3_f32 %0, %0, %16, %17\n"
#define I_DEPA(i) "v_add_f32 %0, %0, %16\n"
#define I_FMA(i) "v_fma_f32 %" #i ", %" #i ", %16, %17\n"
#define P8(INS) asm volatile(INS(0) INS(1) INS(2) INS(3) INS(4) INS(5) INS(6) INS(7) INS(0) INS(1) INS(2) INS(3) INS(4) INS(5) INS(6) INS(7) \
        : "+v"(b2[0]), "+v"(b2[1]), "+v"(b2[2]), "+v"(b2[3]), "+v"(b2[4]), "+v"(b2[5]), "+v"(b2[6]), "+v"(b2[7]) : "v"(b2[0]))
#define I_PKADD(i) "v_pk_add_f32 %" #i ", %" #i ", %8\n"
#define I_PKFMA(i) "v_pk_fma_f32 %" #i ", %" #i ", %8, %8\n"
#pragma unroll 1
      for (int it = 0; it < 20000; ++it) {
#if BENCH_K == 1
        B16(I_ADD);
#elif BENCH_K == 2
        B16(I_EXP);
#elif BENCH_K == 3
        B16(I_MAX3);
#elif BENCH_K == 4
        B16(I_CVT);
#elif BENCH_K == 5
        P8(I_PKADD);
#elif BENCH_K == 6
        P8(I_PKFMA);
#elif BENCH_K == 7
        B16(I_FMA);
#elif BENCH_K == 9
        B16(I_DEP);
#elif BENCH_K == 10
        B16(I_DEPA);
#endif
      }
#if BENCH_K == 11 || BENCH_K == 12
      { f32x16 q0 = {}, q1 = {}, q2 = {}, q3 = {}; att::i32x8a x8 = {1, 2, 3, 4, 5, 6, 7, (int)threadIdx.x};
#pragma unroll 1
        for (int it = 0; it < 2000; ++it) {
#pragma unroll
          for (int k = 0; k < 4; ++k) {
            q0 = __builtin_amdgcn_mfma_scale_f32_32x32x64_f8f6f4(x8, x8, q0, 0, 0, 0, 0x7F7F7F7F, 0, 0x7F7F7F7F); asm volatile("" : "+v"(q0));
#if BENCH_K == 11
            B16(I_ADD);
#else
            B16(I_EXP);
#endif
            q1 = __builtin_amdgcn_mfma_scale_f32_32x32x64_f8f6f4(x8, x8, q1, 0, 0, 0, 0x7F7F7F7F, 0, 0x7F7F7F7F); asm volatile("" : "+v"(q1));
#if BENCH_K == 11
            B16(I_ADD);
#else
            B16(I_EXP);
#endif
            q2 = __builtin_amdgcn_mfma_scale_f32_32x32x64_f8f6f4(x8, x8, q2, 0, 0, 0, 0x7F7F7F7F, 0, 0x7F7F7F7F); asm volatile("" : "+v"(q2));
#if BENCH_K == 11
            B16(I_ADD);
#else
            B16(I_EXP);
#endif
            q3 = __builtin_amdgcn_mfma_scale_f32_32x32x64_f8f6f4(x8, x8, q3, 0, 0, 0, 0x7F7F7F7F, 0, 0x7F7F7F7F); asm volatile("" : "+v"(q3));
#if BENCH_K == 11
            B16(I_ADD);
#else
            B16(I_EXP);
#endif
          }
          asm volatile("" : "+v"(x8)); } }
#endif
#if BENCH_K == 8
      { f32x16 q0 = {}, q1 = {}, q2 = {}, q3 = {}; att::i32x8a x8 = {1, 2, 3, 4, 5, 6, 7, (int)threadIdx.x};
#pragma unroll 1
        for (int it = 0; it < 2000; ++it) {
#pragma unroll
          for (int k = 0; k < 4; ++k) { q0 = __builtin_amdgcn_mfma_scale_f32_32x32x64_f8f6f4(x8, x8, q0, 0, 0, 0, 0x7F7F7F7F, 0, 0x7F7F7F7F); q1 = __builtin_amdgcn_mfma_scale_f32_32x32x64_f8f6f4(x8, x8, q1, 0, 0, 0, 0x7F7F7F7F, 0, 0x7F7F7F7F);
            q2 = __builtin_amdgcn_mfma_scale_f32_32x32x64_f8f6f4(x8, x8, q2, 0, 0, 0, 0x7F7F7F7F, 0, 0x7F7F7F7F); q3 = __builtin_amdgcn_mfma_scale_f32_32x32x64_f8f6f4(x8, x8, q3, 0, 0, 0, 0x7F7F7F7F, 0, 0x7F7F7F7F); }
          asm volatile("" : "+v"(q0), "+v"(q1), "+v"(q2), "+v"(q3), "+v"(x8)); } }
#endif
    }
#endif
#define IN(k) (lo <= (k) && (k) < hi)
#define SEAM(k) do { if (IN(k) && IN((k) + 1)) xcd_barrier(bar); } while (0)
    if (IN(0)) { if (PHM & 1) ph_prologue<7>(ap); if (REP_PRO) ph_prologue<REP_PRO>(ap); } SEAM(0);
    if (IN(1)) { if (PHM & 2) ph_modreduce(ap); if (REP_X & 32) ph_modreduce(ap); } SEAM(1);
#pragma unroll 1
    for (int l = 0; l < 2; ++l) {
        const int pb = 2 + 10 * l; const int last = (l == 1);
        const int Mx = last ? NLAT : NROW;
        if (l == 0) { if (IN(pb)) { if (PHM & 4) ph_modulate0(ap); if (REP_X & 64) ph_modulate0(ap); } SEAM(pb); }
        if (IN(pb + 1)) { if (REP_GIN) ph_gemm_in<GIN_ABL>(ap, l); if (PHM & 8) ph_gemm_in<0>(ap, l); } SEAM(pb + 1);
        if (IN(pb + 2)) { if (PHM & 16) ph_post(ap, l); if (REP_X & 1) ph_post(ap, l); } SEAM(pb + 2);
        if (IN(pb + 3)) { if (PHM & 32) ph_qup(ap, l); if (PHM & 64) ph_kvup(ap, l); if (PHM & 128) ph_states(ap, l); if (REP_X & 2) { ph_qup(ap, l); ph_kvup(ap, l); ph_states(ap, l); } } SEAM(pb + 3);
        if (IN(pb + 4)) { if (REP_ATTN & 1) ph_attn_gqa<ATT_ABL>(ap, last); if (REP_ATTN & 2) ph_attn_mla<ATT_ABL>(ap, last); if (PHM & 256) ph_attn_gqa<0>(ap, last); if (PHM & 512) ph_attn_mla<0>(ap, last); if (REP_X & 4) ph_ret_out(ap, l, last); if (PHM & 1024) ph_ret_out(ap, l, last); } SEAM(pb + 4);
        if (IN(pb + 5)) { if (PHM & 2048) { if (MERGE3) ph_merge3(ap, l, Mx); else { ph_merge<0>(ap, l, Mx); ph_merge<1>(ap, l, Mx); ph_merge<2>(ap, l, Mx); } } if (REP_X & 8) { if (MERGE3) ph_merge3(ap, l, Mx); else { ph_merge<0>(ap, l, Mx); ph_merge<1>(ap, l, Mx); ph_merge<2>(ap, l, Mx); } } } SEAM(pb + 5);
        if (IN(pb + 6)) { if (PHM & 4096) ph_out(ap, l, Mx); if (REP_X & 128) ph_out(ap, l, Mx); } SEAM(pb + 6);
        if (IN(pb + 7)) { if (PHM & 8192) ph_ln1(ap, l, last); if (REP_X & 256) ph_ln1(ap, l, last); } SEAM(pb + 7);
        if (IN(pb + 8)) { if (PHM & 16384) ph_peerq(ap, l, Mx); if (REP_X & 16) ph_peerq(ap, l, Mx); } SEAM(pb + 8);
        if (IN(pb + 9)) { if (PHM & 32768) ph_peer(ap, l, last); } SEAM(pb + 9);
    }
#undef IN
#undef SEAM
}

extern "C" void kernel_launch(void* const* d_in, const int* in_sizes, int n_in, void* d_out, int out_size, void* d_ws, size_t ws_size, hipStream_t stream) {
    static int grid = 0;
    if (grid == 0) {
        if (n_in != 27 || out_size != NLAT * D || ws_size < WS_END) { fprintf(stderr, "kernel_launch: unexpected shapes: n_in %d out %d ws %zu (need %zu)\n", n_in, out_size, ws_size, (size_t)WS_END); grid = -1; return; }
        int dev = 0, cus = 0, per_cu = 0;
        if (hipGetDevice(&dev) != hipSuccess || hipDeviceGetAttribute(&cus, hipDeviceAttributeMultiprocessorCount, dev) != hipSuccess) { grid = -1; return; }
        if (hipFuncSetAttribute((const void*)mega_fwd, hipFuncAttributeMaxDynamicSharedMemorySize, LDS_BYTES) != hipSuccess) { fprintf(stderr, "kernel_launch: hipFuncSetAttribute failed\n"); grid = -1; return; }
        if (hipOccupancyMaxActiveBlocksPerMultiprocessor(&per_cu, (const void*)mega_fwd, 512, LDS_BYTES) != hipSuccess || per_cu < 1) fprintf(stderr, "kernel_launch: occupancy query reports %d\n", per_cu);
        (void)hipGetLastError();
        grid = cus;
    }
    if (grid < 0) return;
    (void)hipMemsetAsync((char*)d_ws + WS_CTL, 0, 65536, stream);
#ifdef DBG
    (void)hipMemsetAsync((char*)d_ws + WS_CTL + 131072, 0, 4096, stream);
#endif
    Args a{};
    for (int i = 0; i < 27; ++i) a.in[i] = (const float*)d_in[i];
    a.out = (float*)d_out; a.ws = (unsigned char*)d_ws;
#if MK_PER_PHASE
    for (int p = 0; p < NPHASE; ++p) { if (p == 12) continue; a.ph_lo = p; a.ph_hi = p + 1;
#ifdef DBG
        if (p == 11) hipLaunchKernelGGL(dbg_peer_pre, dim3(DBG_NS), dim3(256), 0, stream, a, 0);
#endif
        hipLaunchKernelGGL(mega_fwd, dim3(grid), dim3(512), LDS_BYTES, stream, a);
#ifdef DBG
        if (p == 11) hipLaunchKernelGGL(dbg_peer_post, dim3(DBG_NS), dim3(256), 0, stream, a);
#endif
    }
#ifdef DBG
    hipLaunchKernelGGL(dbg_report, dim3(1), dim3(256), 0, stream, a);
#endif
#else
    a.ph_lo = 0; a.ph_hi = NPHASE;
    hipLaunchKernelGGL(mega_fwd, dim3(grid), dim3(512), LDS_BYTES, stream, a);
#endif
    const hipError_t le = hipPeekAtLastError();
    if (le != hipSuccess) fprintf(stderr, "kernel_launch: launch failed: %s\n", hipGetErrorName(le));
}
```

```cpp
#include <hip/hip_runtime.h>
#include <cstdio>
#include <cstdint>
#include <cstddef>

#ifndef MK_PER_PHASE
#define MK_PER_PHASE 0
#endif

#ifndef ABL_PEER
#define ABL_PEER 0
#endif
#ifndef REP_PEERG
#define REP_PEERG 0
#endif
#ifndef REP_PEERH
#define REP_PEERH 0
#endif
#ifndef REP_X
#define REP_X 0
#endif
#ifndef REP_PS1
#define REP_PS1 0
#endif
#ifndef REP_PS2
#define REP_PS2 0
#endif
#ifndef SIDE_ON
#define SIDE_ON 1
#endif
#ifndef REP_DOT
#define REP_DOT 0
#endif
#ifndef MERGE3
#define MERGE3 1
#endif
#ifndef REP_GIN
#define REP_GIN 0
#endif
#ifndef PS1_ABL
#define PS1_ABL 0
#endif
#ifndef GIN_ABL
#define GIN_ABL 0
#endif
#ifndef ATT_ABL
#define ATT_ABL 0
#endif
#ifndef REP_ATTN
#define REP_ATTN 0
#endif
#ifndef REP_PRO
#define REP_PRO 0
#endif
#ifndef ABL_BR
#define ABL_BR 0
#endif
#ifndef ABL_MIX
#define ABL_MIX 0
#endif
#define LAS __attribute__((address_space(3)))
typedef unsigned short bf16_t;
typedef short bf16x8 __attribute__((ext_vector_type(8)));
typedef short s16x4 __attribute__((ext_vector_type(4)));
typedef float f32x2 __attribute__((ext_vector_type(2)));
typedef float f32x4 __attribute__((ext_vector_type(4)));
typedef float f32x8 __attribute__((ext_vector_type(8)));
typedef float f32x16 __attribute__((ext_vector_type(16)));
typedef unsigned u32x2 __attribute__((ext_vector_type(2)));
typedef unsigned u32x4 __attribute__((ext_vector_type(4)));
typedef __bf16 bf2_t __attribute__((ext_vector_type(2)));

constexpr int D = 2048, NB = 4, SEQ = 4096, CTXL = 256, TT = SEQ + CTXL;
constexpr int NLAT = NB * SEQ, NCTX = NB * CTXL, NROW = NLAT + NCTX;
constexpr int NP1 = 4096, NG = 6144, NPT = NP1 + NG;
constexpr int NIN = 10016;
constexpr float ALPHA = 1.4142135623730951f;
constexpr float LN_EPS = 1e-5f, RMS_EPS = 1e-6f;
constexpr float LOG2E = 1.4426950408889634f;
constexpr int C_CQ = 0, C_CKV = 512, C_GQ = 768, C_GK = 1792, C_GV = 2048, C_RQ = 2304, C_RK = 2560, C_RV = 2816, C_RG = 3328, C_KR = 3840;

constexpr size_t AL(size_t x) { return (x + 255) / 256 * 256; }
constexpr size_t WS_CTL = 0;                                    constexpr size_t CTL_BYTES = 1u << 20;
constexpr size_t WS_WSC = WS_CTL + 32768;
constexpr size_t WS_CVT = WS_CTL + 33024;
constexpr size_t WS_DEC = WS_CTL + 65536;
constexpr size_t WS_ROPE32 = WS_CTL + CTL_BYTES;
constexpr size_t WS_ROPE128 = WS_ROPE32 + AL(64 * 8 * 8);
constexpr size_t WS_MODP = WS_ROPE128 + AL(64 * 32 * 8);
constexpr size_t WS_MOD = WS_MODP + AL((size_t)16 * 2 * 5 * 12288 * 4);
constexpr size_t WS_WIN = WS_MOD + AL((size_t)2 * 5 * 12288 * 4);
constexpr size_t SZ_WIN = (size_t)NPT * D;
constexpr size_t WS_WQUP = WS_WIN + 2 * SZ_WIN;                 constexpr size_t SZ_WQUP = (size_t)768 * 512 * 2;
constexpr size_t WS_WKVUP = WS_WQUP + 2 * SZ_WQUP;              constexpr size_t SZ_WKVUP = (size_t)1024 * 256 * 2;
constexpr size_t WS_WBRA = WS_WKVUP + 2 * SZ_WKVUP;             constexpr size_t SZ_WBRA = (size_t)2048 * 512 * 2;
constexpr size_t WS_WBRB = WS_WBRA + 2 * SZ_WBRA;               constexpr size_t SZ_WBRB = SZ_WBRA;
constexpr size_t WS_WBRC = WS_WBRB + 2 * SZ_WBRB;               constexpr size_t SZ_WBRC = (size_t)2048 * 1024 * 2;
constexpr size_t WS_WOUT = WS_WBRC + 2 * SZ_WBRC;               constexpr size_t SZ_WOUT = (size_t)2048 * 2048 * 2;
constexpr size_t WS_WPQ = WS_WOUT + 2 * SZ_WOUT;                constexpr size_t SZ_WPQ = (size_t)1024 * 2048 * 2;
constexpr size_t WS_PSC = WS_WPQ + 2 * SZ_WPQ;
constexpr size_t WS_PU = WS_PSC + (size_t)4 * 16384 * 4;        constexpr size_t SZ_PT = (size_t)16384 * 1152;
constexpr size_t WS_PV = WS_PU + 2 * SZ_PT;
constexpr size_t WS_XC = WS_PV + 2 * SZ_PT;
constexpr size_t WS_HB = WS_XC + (size_t)NCTX * D * 4;
constexpr size_t WS_P1 = WS_HB + (size_t)NROW * D * 2;
constexpr size_t WS_G = WS_P1 + (size_t)NROW * NP1 * 2;
constexpr size_t WS_CQN = WS_G + (size_t)NROW * NG * 2;
constexpr size_t WS_CKVN = WS_CQN + (size_t)NROW * 512 * 2;
constexpr size_t WS_QM = WS_CKVN + (size_t)NROW * 256 * 2;
constexpr size_t SZ_Q128 = (size_t)NB * 8 * TT * 128 * 2;
constexpr size_t WS_KM = WS_QM + SZ_Q128;
constexpr size_t WS_VM = WS_KM + SZ_Q128;
constexpr size_t WS_QG = WS_VM + SZ_Q128 / 2;
constexpr size_t WS_KG = WS_QG + SZ_Q128;
constexpr size_t WS_VG = WS_KG + SZ_Q128 / 4;
constexpr size_t WS_RQ = WS_VG + SZ_Q128 / 4;
constexpr size_t WS_RK = WS_RQ + SZ_Q128 / 4;
constexpr size_t WS_RV = WS_RK + SZ_Q128 / 4;
constexpr size_t WS_ST = WS_RV + SZ_Q128 / 2;
constexpr size_t WS_OAB = WS_ST + (size_t)NB * 8 * 34 * 2 * 2048 * 4;
constexpr size_t WS_HB8 = WS_OAB + (size_t)NROW * D * 2;
constexpr size_t WS_MB8 = WS_HB8 + (size_t)NROW * D;
constexpr size_t WS_S1 = WS_MB8 + (size_t)NROW * D;
constexpr size_t WS_END = WS_S1 + (size_t)NROW * D * 2;
constexpr size_t WS_MB = WS_QM;
constexpr size_t WS_QP = WS_QG;
static_assert((size_t)NROW * D * 2 <= 2 * SZ_Q128, "MB alias");
static_assert((size_t)NROW * 1024 * 2 <= SZ_Q128, "QP alias");

__device__ __forceinline__ unsigned cvt_pk_bf16(float lo, float hi) { unsigned r; asm volatile("v_cvt_pk_bf16_f32 %0, %1, %2" : "=v"(r) : "v"(lo), "v"(hi)); return r; }
__device__ __forceinline__ bf16_t f2bf(float f) { return (bf16_t)(cvt_pk_bf16(f, 0.f) & 0xffffu); }
__device__ __forceinline__ float bf2f(bf16_t b) { return __uint_as_float(((unsigned)b) << 16); }
__device__ __forceinline__ float bflo(unsigned w) { return __uint_as_float(w << 16); }
__device__ __forceinline__ float bfhi(unsigned w) { return __uint_as_float(w & 0xffff0000u); }
template <int CTRL> __device__ __forceinline__ float dppf(float x) { return __int_as_float(__builtin_amdgcn_update_dpp(0, __float_as_int(x), CTRL, 0xF, 0xF, true)); }
__device__ __forceinline__ float row16_sum(float x) { x += dppf<0xB1>(x); x += dppf<0x4E>(x); x += dppf<0x141>(x); x += dppf<0x140>(x); return x; }
__device__ __forceinline__ float row16_max(float x) { x = fmaxf(x, dppf<0xB1>(x)); x = fmaxf(x, dppf<0x4E>(x)); x = fmaxf(x, dppf<0x141>(x)); x = fmaxf(x, dppf<0x140>(x)); return x; }
__device__ __forceinline__ float wave_sum(float x) {
    x = row16_sum(x);
    { auto r = __builtin_amdgcn_permlane16_swap(__float_as_uint(x), __float_as_uint(x), false, false); x = __uint_as_float(r[0]) + __uint_as_float(r[1]); }
    { auto r = __builtin_amdgcn_permlane32_swap(__float_as_uint(x), __float_as_uint(x), false, false); x = __uint_as_float(r[0]) + __uint_as_float(r[1]); }
    return x;
}
__device__ __forceinline__ unsigned pk4_fp8(float a, float b, float c, float d) { int t = 0; t = __builtin_amdgcn_cvt_pk_fp8_f32(a, b, t, false); t = __builtin_amdgcn_cvt_pk_fp8_f32(c, d, t, true); return (unsigned)t; }
__device__ __forceinline__ float clamp8(float x) { return fminf(fmaxf(x, -440.f), 440.f); }
__device__ __forceinline__ void fp8_scale(unsigned amax_bits, float& mul, float& inv) { const float am = __uint_as_float(amax_bits); int k = 0; if (am > 0.f) k = (int)floorf(log2f(256.f / am)); k = k > 60 ? 60 : (k < -60 ? -60 : k); mul = exp2f((float)k); inv = exp2f((float)-k); }
__device__ __forceinline__ float silu_f(float x) { return x * __builtin_amdgcn_rcpf(1.f + __builtin_amdgcn_exp2f(x * -1.4426950408889634f)); }
__device__ __forceinline__ float sigmoid_f(float x) { return __builtin_amdgcn_rcpf(1.f + __builtin_amdgcn_exp2f(x * -1.4426950408889634f)); }

__device__ __forceinline__ int vt_off(int tpos) { const int kk = tpos & 63; return (tpos & ~63) + ((kk >> 2) & 1) * 32 + ((kk >> 5) & 1) * 16 + (kk & 3) + 4 * ((kk >> 3) & 3); }
constexpr float QSC_G = 4.f * 0.08838834764831845f * 1.4426950408889634f, QSC_M = 4.f * 0.10206207261596575f * 1.4426950408889634f, KSC8 = 0.25f;
struct RowInfo { int b, tpos, pr, pc, v; bool lat; };
__device__ __forceinline__ RowInfo rowinfo(int row) {
    RowInfo r;
    if (row < NLAT) { r.lat = true; r.b = row >> 12; const int t = row & 4095; r.tpos = CTXL + t; r.pr = t >> 6; r.pc = t & 63; r.v = r.b; }
    else { const int q = row - NLAT; r.lat = false; r.b = q >> 8; r.tpos = q & 255; r.pr = 0; r.pc = 0; r.v = 4; }
    return r;
}

#define XB_TMO      128
#define XB_XCNT(j)  (256  + 64 * (j))
#define XB_XSUB(j)  (1280 + 64 * (j))
#define XB_XGEN(j)  (2304 + 64 * (j))
#define XB_TOP      3328
#define XB_TOPGEN   3392
#define XCD_BAR_WORDS 3456
#define XB_SPIN_CAP (1u << 22)

__device__ __forceinline__ unsigned xb_ld(unsigned* p)              { return __hip_atomic_load(p, __ATOMIC_RELAXED, __HIP_MEMORY_SCOPE_AGENT); }
__device__ __forceinline__ unsigned xb_add(unsigned* p, unsigned v) { return __hip_atomic_fetch_add(p, v, __ATOMIC_RELAXED, __HIP_MEMORY_SCOPE_AGENT); }
__device__ __forceinline__ unsigned xb_xcc_id() { return (unsigned)__builtin_amdgcn_s_getreg((3 << 11) | 20) & 0xFu; }
#define XB_SPIN(cond, bar) do { unsigned _sp = 0; while (cond) { __builtin_amdgcn_s_sleep(1); \
    if ((++_sp & 255u) == 0u) { if (xb_ld(&(bar)[XB_TMO])) break; if (_sp > XB_SPIN_CAP) { atomicAdd(&(bar)[XB_TMO], 1u); break; } } } } while (0)

struct XcdBarrier { unsigned* bar; unsigned x; volatile LAS unsigned* st; };

__device__ __forceinline__ XcdBarrier xcd_barrier_post(unsigned* bar, volatile LAS unsigned* st) {
    XcdBarrier b; b.bar = bar; b.x = xb_xcc_id(); b.st = st;
    if (threadIdx.x == 0) (void)xb_add(&bar[XB_XCNT(b.x)], 1u);
    return b;
}
__device__ __forceinline__ void xcd_barrier_complete(unsigned* bar, unsigned x, unsigned& nloc, unsigned& nx) {
    const unsigned G = gridDim.x * gridDim.y * gridDim.z;
    unsigned sum, cnt, mine, sp = 0u;
    for (;;) {
        sum = 0u; cnt = 0u; mine = 0u;
#pragma unroll
        for (unsigned j = 0; j < 16; ++j) { const unsigned c = xb_ld(&bar[XB_XCNT(j)]); sum += c; cnt += (c > 0u) ? 1u : 0u; mine = (j == x) ? c : mine; }
        if (sum == G) break;
        __builtin_amdgcn_s_sleep(1);
        if ((++sp & 255u) == 0u) { if (xb_ld(&bar[XB_TMO])) break; if (sp > XB_SPIN_CAP) { atomicAdd(&bar[XB_TMO], 1u); break; } }
    }
    nloc = mine > 0u ? mine : 1u; nx = cnt > 0u ? cnt : 1u;
}
__device__ __forceinline__ void xcd_barrier(const XcdBarrier& b) {
    asm volatile("s_waitcnt vmcnt(0)" ::: "memory");
    __syncthreads();
    if (threadIdx.x == 0) {
        unsigned* bar = b.bar;
        __builtin_amdgcn_s_waitcnt(0);
        unsigned nloc = b.st[0], nx = b.st[1];
        if (nloc == 0u) { xcd_barrier_complete(bar, b.x, nloc, nx); b.st[0] = nloc; b.st[1] = nx; }
        const unsigned old = xb_add(&bar[XB_XSUB(b.x)], 1u);
        const unsigned gen = old / nloc;
        if (old + 1u == (gen + 1u) * nloc) {
            __builtin_amdgcn_fence(__ATOMIC_RELEASE, "agent");
            asm volatile("s_waitcnt vmcnt(0)" ::: "memory");
            const unsigned og = xb_add(&bar[XB_TOP], 1u);
            const unsigned tg = og / nx;
            if (og + 1u == (tg + 1u) * nx) xb_add(&bar[XB_TOPGEN], 1u);
            else XB_SPIN(xb_ld(&bar[XB_TOPGEN]) == tg, bar);
            __builtin_amdgcn_fence(__ATOMIC_ACQUIRE, "agent");
            xb_add(&bar[XB_XGEN(b.x)], 1u);
            asm volatile("s_waitcnt vmcnt(0)" ::: "memory");
        } else {
            XB_SPIN(xb_ld(&bar[XB_XGEN(b.x)]) == gen, bar);
            __builtin_amdgcn_fence(__ATOMIC_ACQUIRE, "agent");
            asm volatile("s_waitcnt vmcnt(0)" ::: "memory");
        }
    }
    __syncthreads();
}
namespace pg8 {
constexpr int BM = 256, BK = 64, HALF = 128, HTB = HALF * BK * 2, STAGE_BYTES = 8 * HTB, NXCD = 8, WGM = 8;
__host__ __device__ __forceinline__ int lds_byte(int r, int c) { const int st = (r >> 4) * 2 + (c >> 5), rr = r & 15, cc = c & 31, ob = rr * 64 + cc * 2; return st * 1024 + (ob ^ (((ob >> 9) & 1) << 5)); }
__host__ __device__ __forceinline__ void stage_rc(int b, int& R, int& C) { const int st = b / 1024, sb = b % 1024, swz = sb ^ (((sb >> 9) & 1) << 5); R = (st >> 1) * 16 + swz / 64; C = (st & 1) * 32 + (swz % 64) / 2; }
__host__ __device__ __forceinline__ int perm32(int rho) { const int n = rho >> 4, i = rho & 15; return 8 * (i >> 2) + 4 * n + (i & 3); }

struct Unit { int pm, pn; };
typedef int i32x8 __attribute__((ext_vector_type(8))); typedef int i32x4v __attribute__((ext_vector_type(4)));
__device__ __forceinline__ i32x8 cat8(const bf16x8 a, const bf16x8 b) { const i32x4v x = __builtin_bit_cast(i32x4v, a), y = __builtin_bit_cast(i32x4v, b); return __builtin_shufflevector(x, y, 0, 1, 2, 3, 4, 5, 6, 7); }
struct Gemm { const bf16_t* A; const bf16_t* Bt; int M, N, K, lda, ldb; };

struct StaticOrder {
    int nM, nN, nwg, G, c;
    __host__ __device__ void init(int M, int N, int G_, int c_) { nM = M / BM; nN = N / BM; nwg = nM * nN; G = G_; c = c_; }
    __host__ __device__ bool next(int i, Unit& u) const {
        const long L = (long)i * G + c; if (L >= nwg) return false;
        int wgid = (int)L; { const int q = nwg / NXCD, r = nwg % NXCD, xcd = wgid % NXCD, off = wgid / NXCD; wgid = (xcd < r ? xcd * (q + 1) : r * (q + 1) + (xcd - r) * q) + off; }
        const int nig = WGM * nN, gid = wgid / nig, fm = gid * WGM, gsz = (nM - fm) < WGM ? (nM - fm) : WGM;
        u.pm = fm + ((wgid % nig) % gsz); u.pn = (wgid % nig) / gsz; return true;
    }
    __device__ __forceinline__ void a_ready(const Unit&) const {}
    __device__ __forceinline__ void done(const Unit&) const {}
};

template <class Epi, class Sched, int GABL = 0>
__device__ __forceinline__ void gemm_phase(LAS unsigned char* lds, const int tid, const Gemm g, const Sched& S, const Epi& E) {
    const int  wid = __builtin_amdgcn_readfirstlane(tid >> 6), lane = tid & 63, wr = wid >> 2, wc = wid & 3, fr = lane & 15, fq = lane >> 4;
    const int K = g.K, nt = K / BK;
    unsigned voffA[2], voffB[2];
#pragma unroll
    for (int i = 0; i < 2; ++i) { int R, C; stage_rc(tid * 16 + i * 8192, R, C); const int Rb = Epi::PERM ? ((R & ~31) + perm32(R & 31)) : R;
        voffA[i] = (unsigned)(R * g.lda + C) * 2u; voffB[i] = (unsigned)(Rb * g.ldb + C) * 2u; }
    const size_t kstep = (size_t)(BK * 2);
    const size_t hstepA = (size_t)HALF * g.lda * 2, hstepB = (size_t)HALF * g.ldb * 2;
    const size_t tstepA = 2 * hstepA, tstepB = 2 * hstepB;
    const unsigned ldsw = (unsigned)wid * 1024u;
    const int aoff = lds_byte(wr * 64 + fr, fq * 8), boff = lds_byte(wc * 32 + fr, fq * 8);
#define PG8_SA(b, h) (((b) * 2 + (h)) * HTB)
#define PG8_SB(b, h) ((4 + (b) * 2 + (h)) * HTB)
#define PG8_STAGE(bufoff, gbase, voff) do { if constexpr (!(GABL & 4)) _Pragma("unroll") for (int _i = 0; _i < 2; ++_i) \
        __builtin_amdgcn_global_load_lds((const unsigned*)((const char*)(gbase) + (voff)[_i]), (LAS unsigned*)(lds + (bufoff) + ldsw + _i * 8192), 16, 0, 0); } while (0)
#define PG8_LDA(dst, b, h) do { if constexpr (Epi::FP8) { _Pragma("unroll") for (int m = 0; m < 4; ++m) { const i32x4v lo_ = *(const LAS i32x4v*)(lds + PG8_SA(b, h) + aoff + m * 2048), hi_ = *(const LAS i32x4v*)(lds + PG8_SA(b, h) + aoff + m * 2048 + 1024); \
            dst##8[m] = __builtin_shufflevector(lo_, hi_, 0, 1, 2, 3, 4, 5, 6, 7); } } \
        else { _Pragma("unroll") for (int m = 0; m < 4; ++m) _Pragma("unroll") for (int k = 0; k < 2; ++k) dst[m][k] = *(const LAS bf16x8*)(lds + PG8_SA(b, h) + aoff + m * 2048 + k * 1024); } } while (0)
#define PG8_LDB(dst, b, h) do { if constexpr (Epi::FP8) { _Pragma("unroll") for (int n = 0; n < 2; ++n) { const i32x4v lo_ = *(const LAS i32x4v*)(lds + PG8_SB(b, h) + boff + n * 2048), hi_ = *(const LAS i32x4v*)(lds + PG8_SB(b, h) + boff + n * 2048 + 1024); \
            dst##8[n] = __builtin_shufflevector(lo_, hi_, 0, 1, 2, 3, 4, 5, 6, 7); } } \
        else { _Pragma("unroll") for (int n = 0; n < 2; ++n) _Pragma("unroll") for (int k = 0; k < 2; ++k) dst[n][k] = *(const LAS bf16x8*)(lds + PG8_SB(b, h) + boff + n * 2048 + k * 1024); } } while (0)
#define PG8_MMA(ai, bj, At, Bt) do { __builtin_amdgcn_s_setprio(1); _Pragma("unroll") for (int m = 0; m < 4; ++m) _Pragma("unroll") for (int n = 0; n < 2; ++n) { \
        if constexpr (Epi::FP8) { if constexpr (GABL & 8) asm volatile("" : "+v"(acc[ai][bj][m][n]) : "v"(Bt##8[n]), "v"(At##8[m]), "v"(sc1_)); else asm volatile("v_mfma_scale_f32_16x16x128_f8f6f4 %0, %1, %2, %0, %3, %3 op_sel_hi:[0,0,0]" : "+v"(acc[ai][bj][m][n]) : "v"(Bt##8[n]), "v"(At##8[m]), "v"(sc1_)); } \
        else { _Pragma("unroll") for (int k = 0; k < 2; ++k) acc[ai][bj][m][n] = __builtin_amdgcn_mfma_f32_16x16x32_bf16(Bt[n][k], At[m][k], acc[ai][bj][m][n], 0, 0, 0); } } __builtin_amdgcn_s_setprio(0); } while (0)
#define PG8_WAIT_V(n) asm volatile("s_waitcnt vmcnt(" #n ")" ::: "memory")
#define PG8_WAIT_L(n) asm volatile("s_waitcnt lgkmcnt(" #n ")" ::: "memory")
#define PG8_BAR __builtin_amdgcn_s_barrier()
#define PG8_SCHED __builtin_amdgcn_sched_barrier(0)
    Unit cur, nxt; int ui = 0;
    if (!S.next(0, cur)) return;
    f32x4 acc[2][2][4][2];
#pragma unroll
    for (int a = 0; a < 2; ++a)
#pragma unroll
        for (int b = 0; b < 2; ++b)
#pragma unroll
            for (int m = 0; m < 4; ++m)
#pragma unroll
                for (int n = 0; n < 2; ++n) acc[a][b][m][n] = (f32x4){0.f, 0.f, 0.f, 0.f};
    int sc1_ = 0x7F7F7F7F; asm volatile("" : "+v"(sc1_));
    bf16x8 At[4][2], B0[2][2], B1[2][2]; i32x8 At8[4], B08[2], B18[2];
    const char* cA = (const char*)g.A + (size_t)cur.pm * tstepA; const char* cB = (const char*)g.Bt + (size_t)cur.pn * tstepB;
    S.a_ready(cur);
    PG8_STAGE(PG8_SB(0, 0), cB, voffB); PG8_STAGE(PG8_SA(0, 0), cA, voffA); PG8_STAGE(PG8_SB(0, 1), cB + hstepB, voffB); PG8_STAGE(PG8_SA(0, 1), cA + hstepA, voffA);
    if (wr == 1) PG8_BAR;
    PG8_WAIT_V(4); PG8_BAR;
    PG8_STAGE(PG8_SB(1, 0), cB + kstep, voffB); PG8_STAGE(PG8_SA(1, 0), cA + kstep, voffA); PG8_STAGE(PG8_SB(1, 1), cB + hstepB + kstep, voffB);
    PG8_WAIT_V(6); PG8_BAR;
    for (;;) {
        const bool has_next = S.next(ui + 1, nxt);
        const char* nA = has_next ? (const char*)g.A + (size_t)nxt.pm * tstepA : cA; const char* nB = has_next ? (const char*)g.Bt + (size_t)nxt.pn * tstepB : cB;
#pragma unroll 1
        for (int t = 0; t < nt; t += 2) {
            const bool last = (t == nt - 2);
            const char* a1 = cA + (size_t)(t + 1) * kstep;
            const char* a2 = last ? nA : cA + (size_t)(t + 2) * kstep; const char* b2 = last ? nB : cB + (size_t)(t + 2) * kstep;
            const char* a3 = a2 + kstep; const char* b3 = b2 + kstep;
            if (last && has_next) S.a_ready(nxt);
            PG8_LDB(B0, 0, 0); PG8_SCHED; PG8_LDA(At, 0, 0); PG8_STAGE(PG8_SA(1, 1), a1 + hstepA, voffA);
            PG8_WAIT_L(8); PG8_BAR; PG8_WAIT_L(0); PG8_MMA(0, 0, At, B0); PG8_BAR; PG8_SCHED;
            PG8_LDB(B1, 0, 1); PG8_STAGE(PG8_SB(0, 0), b2, voffB);
            PG8_BAR; PG8_WAIT_L(0); PG8_MMA(0, 1, At, B1); PG8_BAR;
            PG8_LDA(At, 0, 1); PG8_STAGE(PG8_SA(0, 0), a2, voffA);
            PG8_BAR; PG8_WAIT_L(0); PG8_MMA(1, 0, At, B0); PG8_BAR; PG8_SCHED;
            PG8_STAGE(PG8_SB(0, 1), b2 + hstepB, voffB);
            PG8_WAIT_V(6); PG8_BAR; PG8_MMA(1, 1, At, B1); PG8_BAR;
            PG8_LDB(B0, 1, 0); PG8_SCHED; PG8_LDA(At, 1, 0); PG8_STAGE(PG8_SA(0, 1), a2 + hstepA, voffA);
            PG8_WAIT_L(8); PG8_BAR; PG8_WAIT_L(0); PG8_MMA(0, 0, At, B0); PG8_BAR; PG8_SCHED;
            PG8_LDB(B1, 1, 1); PG8_STAGE(PG8_SB(1, 0), b3, voffB);
            PG8_BAR; PG8_WAIT_L(0); PG8_MMA(0, 1, At, B1); PG8_BAR;
            PG8_LDA(At, 1, 1); PG8_STAGE(PG8_SA(1, 0), a3, voffA);
            PG8_BAR; PG8_WAIT_L(0); PG8_MMA(1, 0, At, B0); PG8_BAR; PG8_SCHED;
            PG8_STAGE(PG8_SB(1, 1), b3 + hstepB, voffB);
            PG8_WAIT_V(6); PG8_BAR; PG8_MMA(1, 1, At, B1); PG8_BAR;
        }
        if constexpr (Epi::FP8) asm volatile("s_nop 15\n\ts_nop 15" ::: "memory");
        if constexpr (GABL & 2) { pg8::Unit u2_ = cur; u2_.pm = 0; Epi E2_ = E; E2_.retarget(); E2_(acc, u2_, wr, wc, fr, fq); } else if constexpr (!(GABL & 1)) E(acc, cur, wr, wc, fr, fq); else asm volatile("" :: "v"(acc[0][0][0][0]), "v"(acc[1][1][3][1]), "v"(acc[0][1][2][0]), "v"(acc[1][0][1][1]));
        if (!has_next) break;
#pragma unroll
        for (int a = 0; a < 2; ++a)
#pragma unroll
            for (int b = 0; b < 2; ++b)
#pragma unroll
                for (int m = 0; m < 4; ++m)
#pragma unroll
                    for (int n = 0; n < 2; ++n) acc[a][b][m][n] = (f32x4){0.f, 0.f, 0.f, 0.f};
        cur = nxt; cA = nA; cB = nB; ++ui;
    }
    PG8_WAIT_V(0);
    if (wr == 0) PG8_BAR;
    PG8_BAR;
#undef PG8_SA
#undef PG8_SB
#undef PG8_STAGE
#undef PG8_LDA
#undef PG8_LDB
#undef PG8_MMA
#undef PG8_WAIT_V
#undef PG8_WAIT_L
#undef PG8_BAR
#undef PG8_SCHED
}
}

typedef f32x4 Acc[2][2][4][2];
#define EPI_LOOP_ROWS for (int ai = 0; ai < 2; ++ai) for (int m = 0; m < 4; ++m)
__device__ __forceinline__ u32x4 pack8(const f32x4 a, const f32x4 b) { u32x4 w; w.x = cvt_pk_bf16(a[0], a[1]); w.y = cvt_pk_bf16(a[2], a[3]); w.z = cvt_pk_bf16(b[0], b[1]); w.w = cvt_pk_bf16(b[2], b[3]); return w; }

struct EpiIn {
    static constexpr bool PERM = true, FP8 = true;
    bf16_t* P1; bf16_t* G; float inv;
    __device__ __forceinline__ void retarget() { P1 = (bf16_t*)((char*)P1 - WS_P1 + WS_END); G = P1 + 256 * NP1; }
    __device__ __forceinline__ void operator()(const Acc& acc, const pg8::Unit& u, int wr, int wc, int fr, int fq) const {
        const int row0 = u.pm * 256 + wr * 64 + fr; const bool gate = u.pn >= 16;
        const int col0 = (gate ? (u.pn - 16) : u.pn) * 256 + wc * 32 + 8 * fq;
#pragma unroll
        for (int ai = 0; ai < 2; ++ai)
#pragma unroll
            for (int m = 0; m < 4; ++m) { const size_t row = (size_t)(row0 + ai * 128 + m * 16);
#pragma unroll
                for (int bj = 0; bj < 2; ++bj) { f32x4 v0 = acc[ai][bj][m][0] * inv, v1 = acc[ai][bj][m][1] * inv;
                    if (gate) {
#pragma unroll
                        for (int j = 0; j < 4; ++j) { v0[j] = 256.f * sigmoid_f(v0[j]); v1[j] = 256.f * sigmoid_f(v1[j]); }
                        u32x2 w8; w8.x = pk4_fp8(v0[0], v0[1], v0[2], v0[3]); w8.y = pk4_fp8(v1[0], v1[1], v1[2], v1[3]);
                        __builtin_nontemporal_store(w8, (u32x2*)((unsigned char*)G + row * NG + col0 + bj * 128)); }
                    else { u32x2 w8; w8.x = pk4_fp8(clamp8(v0[0] * 16.f), clamp8(v0[1] * 16.f), clamp8(v0[2] * 16.f), clamp8(v0[3] * 16.f)); w8.y = pk4_fp8(clamp8(v1[0] * 16.f), clamp8(v1[1] * 16.f), clamp8(v1[2] * 16.f), clamp8(v1[3] * 16.f));
                        __builtin_nontemporal_store(w8, (u32x2*)((unsigned char*)P1 + row * NP1 + col0 + bj * 128)); } } }
    }
};
struct EpiPlain {
    static constexpr bool PERM = true, FP8 = false;
    bf16_t* O; int ldc;
    __device__ __forceinline__ void operator()(const Acc& acc, const pg8::Unit& u, int wr, int wc, int fr, int fq) const {
        const int row0 = u.pm * 256 + wr * 64 + fr; const int col0 = u.pn * 256 + wc * 32 + 8 * fq;
#pragma unroll
        for (int ai = 0; ai < 2; ++ai)
#pragma unroll
            for (int m = 0; m < 4; ++m) { bf16_t* rowp = O + (size_t)(row0 + ai * 128 + m * 16) * ldc + col0;
#pragma unroll
                for (int bj = 0; bj < 2; ++bj) *(u32x4*)(rowp + bj * 128) = pack8(acc[ai][bj][m][0], acc[ai][bj][m][1]); }
    }
};
__device__ __forceinline__ void tile_info(int pm, int& b, int& tpos0, bool& lat) { lat = pm < 64; b = lat ? (pm >> 4) : (pm - 64); tpos0 = lat ? CTXL + ((pm & 15) << 8) : 0; }
struct EpiQup {
    static constexpr bool PERM = true, FP8 = false;
    unsigned char* QM; const f32x2* cs32;
    __device__ __forceinline__ void operator()(const Acc& acc, const pg8::Unit& u, int wr, int wc, int fr, int fq) const {
        int b, tpos0; bool lat; tile_info(u.pm, b, tpos0, lat);
        const int r0 = wr * 64 + fr;
#pragma unroll
        for (int bj = 0; bj < 2; ++bj) { const int c0 = u.pn * 256 + bj * 128 + wc * 32 + 8 * fq; const int hh = c0 / 96, j0 = c0 - hh * 96;
            unsigned char* hb = QM + ((size_t)(b * 8 + hh) * TT + tpos0 + r0) * 128;
            if (j0 < 64) {
#pragma unroll
                for (int ai = 0; ai < 2; ++ai)
#pragma unroll
                    for (int m = 0; m < 4; ++m) { const f32x4 a_ = acc[ai][bj][m][0] * QSC_M, b_ = acc[ai][bj][m][1] * QSC_M; u32x2 w8; w8.x = pk4_fp8(clamp8(a_[0]), clamp8(a_[1]), clamp8(a_[2]), clamp8(a_[3])); w8.y = pk4_fp8(clamp8(b_[0]), clamp8(b_[1]), clamp8(b_[2]), clamp8(b_[3]));
                        *(u32x2*)(hb + (ai * 128 + m * 16) * 128 + j0) = w8; }
            } else { const int g8 = (j0 - 64) >> 3, part = g8 >> 1, pbase = (g8 & 1) * 4;
#pragma unroll
                for (int ai = 0; ai < 2; ++ai)
#pragma unroll
                    for (int m = 0; m < 4; ++m) { const int t = tpos0 - CTXL + r0 + ai * 128 + m * 16; const int pos = part ? (t & 63) : (t >> 6);
                        const f32x4 v0 = acc[ai][bj][m][0] * QSC_M, v1 = acc[ai][bj][m][1] * QSC_M;
                        float o1[4], o2[4]; const float x1[4] = {v0[0], v0[2], v1[0], v1[2]}, x2[4] = {v0[1], v0[3], v1[1], v1[3]};
#pragma unroll
                        for (int p = 0; p < 4; ++p) { const f32x2 cs = lat ? cs32[pos * 8 + pbase + p] : (f32x2){1.f, 0.f};
                            o1[p] = x1[p] * cs.x - x2[p] * cs.y; o2[p] = x1[p] * cs.y + x2[p] * cs.x; }
                        unsigned char* dst = hb + (ai * 128 + m * 16) * 128 + 64 + part * 16 + pbase;
                        *(unsigned*)dst = pk4_fp8(clamp8(o1[0]), clamp8(o1[1]), clamp8(o1[2]), clamp8(o1[3])); *(unsigned*)(dst + 8) = pk4_fp8(clamp8(o2[0]), clamp8(o2[1]), clamp8(o2[2]), clamp8(o2[3])); } } }
    }
};
struct EpiKvup {
    static constexpr bool PERM = true, FP8 = false;
    unsigned char* KM; unsigned char* VM;
    __device__ __forceinline__ void operator()(const Acc& acc, const pg8::Unit& u, int wr, int wc, int fr, int fq) const {
        int b, tpos0; bool lat; tile_info(u.pm, b, tpos0, lat);
        const int r0 = wr * 64 + fr; const int j0 = wc * 32 + 8 * fq;
#pragma unroll
        for (int bj = 0; bj < 2; ++bj) { const size_t tok = (size_t)(b * 8 + u.pn * 2 + bj) * TT + tpos0 + r0;
            if (j0 < 64) { unsigned char* d = KM + tok * 128 + j0;
#pragma unroll
                for (int ai = 0; ai < 2; ++ai)
#pragma unroll
                    for (int m = 0; m < 4; ++m) { const f32x4 a_ = acc[ai][bj][m][0] * KSC8, b_ = acc[ai][bj][m][1] * KSC8; u32x2 w8; w8.x = pk4_fp8(clamp8(a_[0]), clamp8(a_[1]), clamp8(a_[2]), clamp8(a_[3])); w8.y = pk4_fp8(clamp8(b_[0]), clamp8(b_[1]), clamp8(b_[2]), clamp8(b_[3]));
                        *(u32x2*)(d + (ai * 128 + m * 16) * 128) = w8; } }
            else { unsigned char* d = VM + ((size_t)(b * 8 + u.pn * 2 + bj) * 64 + (j0 - 64)) * TT;
#pragma unroll
                for (int ai = 0; ai < 2; ++ai)
#pragma unroll
                    for (int m = 0; m < 4; ++m) { const f32x4 a_ = acc[ai][bj][m][0], b_ = acc[ai][bj][m][1]; const unsigned w0_ = pk4_fp8(clamp8(a_[0]), clamp8(a_[1]), clamp8(a_[2]), clamp8(a_[3])), w1_ = pk4_fp8(clamp8(b_[0]), clamp8(b_[1]), clamp8(b_[2]), clamp8(b_[3]));
                        unsigned char* q_ = d + vt_off(tpos0 + r0 + ai * 128 + m * 16);
                        q_[0] = (unsigned char)(w0_ & 0xffu); q_[TT] = (unsigned char)((w0_ >> 8) & 0xffu); q_[2 * TT] = (unsigned char)((w0_ >> 16) & 0xffu); q_[3 * TT] = (unsigned char)(w0_ >> 24);
                        q_[4 * TT] = (unsigned char)(w1_ & 0xffu); q_[5 * TT] = (unsigned char)((w1_ >> 8) & 0xffu); q_[6 * TT] = (unsigned char)((w1_ >> 16) & 0xffu); q_[7 * TT] = (unsigned char)(w1_ >> 24); } } }
    }
};
template <int SEG> struct EpiMerge {
    static constexpr bool PERM = true, FP8 = false;
    bf16_t* MB; const bf16_t* G; unsigned char* MB8;
    __device__ __forceinline__ void operator()(const Acc& acc, const pg8::Unit& u, int wr, int wc, int fr, int fq) const {
        const int row0 = u.pm * 256 + wr * 64 + fr; const int col0 = u.pn * 256 + wc * 32 + 8 * fq;
        const bf16_t* gp = G + (size_t)row0 * NG + SEG * 2048 + col0; bf16_t* mp = MB + (size_t)row0 * D + col0; unsigned char* m8 = MB8 + (size_t)row0 * D + col0;
#pragma unroll
        for (int ai = 0; ai < 2; ++ai) {
            u32x4 gw[4][2], ow[4][2];
#pragma unroll
            for (int m = 0; m < 4; ++m)
#pragma unroll
                for (int bj = 0; bj < 2; ++bj) { const size_t ro = (size_t)(ai * 128 + m * 16);
                    gw[m][bj] = *(const u32x4*)(gp + ro * NG + bj * 128);
                    if (SEG > 0) ow[m][bj] = __builtin_nontemporal_load((const u32x4*)(mp + ro * D + bj * 128)); }
#pragma unroll
            for (int m = 0; m < 4; ++m)
#pragma unroll
                for (int bj = 0; bj < 2; ++bj) { const size_t ro = (size_t)(ai * 128 + m * 16); const u32x4 g_ = gw[m][bj];
                    f32x4 v0 = acc[ai][bj][m][0], v1 = acc[ai][bj][m][1];
                    if (ABL_BR & (1 << SEG)) { v0 = (f32x4){0.f, 0.f, 0.f, 0.f}; v1 = v0; }
                    v0[0] *= bflo(g_.x); v0[1] *= bfhi(g_.x); v0[2] *= bflo(g_.y); v0[3] *= bfhi(g_.y);
                    v1[0] *= bflo(g_.z); v1[1] *= bfhi(g_.z); v1[2] *= bflo(g_.w); v1[3] *= bfhi(g_.w);
                    if (SEG > 0) { const u32x4 o = ow[m][bj];
                        v0[0] += bflo(o.x); v0[1] += bfhi(o.x); v0[2] += bflo(o.y); v0[3] += bfhi(o.y);
                        v1[0] += bflo(o.z); v1[1] += bfhi(o.z); v1[2] += bflo(o.w); v1[3] += bfhi(o.w); }
                    if (SEG < 2) *(u32x4*)(mp + ro * D + bj * 128) = pack8(v0, v1);
                    else { u32x2 w8; w8.x = pk4_fp8(clamp8(v0[0] * 16.f), clamp8(v0[1] * 16.f), clamp8(v0[2] * 16.f), clamp8(v0[3] * 16.f)); w8.y = pk4_fp8(clamp8(v1[0] * 16.f), clamp8(v1[1] * 16.f), clamp8(v1[2] * 16.f), clamp8(v1[3] * 16.f));
                        *(u32x2*)(m8 + ro * D + bj * 128) = w8; } }
        }
    }
};
namespace pg8 {
struct Merge3 { const bf16_t* A; const bf16_t* B0; const bf16_t* B1; const bf16_t* B2; const bf16_t* G; unsigned char* MB8; float r01, r12, fin; };
template <class Sched>
__device__ __forceinline__ void gemm_merge3(LAS unsigned char* lds, const int tid, const Merge3 g, const Sched& S) {
    constexpr int GABL = 0;
    const int wid = __builtin_amdgcn_readfirstlane(tid >> 6), lane = tid & 63, wr = wid >> 2, wc = wid & 3, fr = lane & 15, fq = lane >> 4;
    constexpr int NT = 16, LDA = 1024;
    int sc1_ = 0x7F7F7F7F; asm volatile("" : "+v"(sc1_));
    unsigned voffA[2], voffB5[2], voffB10[2];
#pragma unroll
    for (int i = 0; i < 2; ++i) { int R, C; stage_rc(tid * 16 + i * 8192, R, C); const int Rb = (R & ~31) + perm32(R & 31);
        voffA[i] = (unsigned)(R * LDA + C) * 2u; voffB5[i] = (unsigned)(Rb * 256 + C) * 2u; voffB10[i] = (unsigned)(Rb * 512 + C) * 2u; }
    const size_t kstep = (size_t)(BK * 2);
    const size_t hstepA = (size_t)HALF * LDA * 2, tstepA = 2 * hstepA;
    const unsigned ldsw = (unsigned)wid * 1024u;
    const int aoff = lds_byte(wr * 64 + fr, fq * 8), boff = lds_byte(wc * 32 + fr, fq * 8);
#define M3_TA(pm_, t_) ((const char*)g.A + (size_t)(pm_) * tstepA + (size_t)(t_) * kstep)
#define M3_TB(pn_, t_) ((t_) < 4 ? (const char*)g.B0 + (size_t)(pn_) * 131072 + (size_t)(t_) * kstep : ((t_) < 8 ? (const char*)g.B1 + (size_t)(pn_) * 131072 + (size_t)((t_) - 4) * kstep : (const char*)g.B2 + (size_t)(pn_) * 262144 + (size_t)((t_) - 8) * kstep))
#define PG8_SA(b, h) (((b) * 2 + (h)) * HTB)
#define PG8_SB(b, h) ((4 + (b) * 2 + (h)) * HTB)
#define PG8_STAGE(bufoff, gbase, voff) do { if constexpr (!(GABL & 4)) _Pragma("unroll") for (int _i = 0; _i < 2; ++_i) \
        __builtin_amdgcn_global_load_lds((const unsigned*)((const char*)(gbase) + (voff)[_i]), (LAS unsigned*)(lds + (bufoff) + ldsw + _i * 8192), 16, 0, 0); } while (0)
#define PG8_LDA(dst, b, h) do { _Pragma("unroll") for (int m = 0; m < 4; ++m) { const i32x4v lo_ = *(const LAS i32x4v*)(lds + PG8_SA(b, h) + aoff + m * 2048), hi_ = *(const LAS i32x4v*)(lds + PG8_SA(b, h) + aoff + m * 2048 + 1024); dst[m] = __builtin_shufflevector(lo_, hi_, 0, 1, 2, 3, 4, 5, 6, 7); } } while (0)
#define PG8_LDB(dst, b, h) do { _Pragma("unroll") for (int n = 0; n < 2; ++n) { const i32x4v lo_ = *(const LAS i32x4v*)(lds + PG8_SB(b, h) + boff + n * 2048), hi_ = *(const LAS i32x4v*)(lds + PG8_SB(b, h) + boff + n * 2048 + 1024); dst[n] = __builtin_shufflevector(lo_, hi_, 0, 1, 2, 3, 4, 5, 6, 7); } } while (0)
#define PG8_MMA(ai, bj, At, Bt) do { __builtin_amdgcn_s_setprio(1); _Pragma("unroll") for (int m = 0; m < 4; ++m) _Pragma("unroll") for (int n = 0; n < 2; ++n) \
        asm volatile("v_mfma_scale_f32_16x16x128_f8f6f4 %0, %1, %2, %0, %3, %3 op_sel_hi:[0,0,0]" : "+v"(acc[ai][bj][m][n]) : "v"(Bt[n]), "v"(At[m]), "v"(sc1_)); __builtin_amdgcn_s_setprio(0); } while (0)
#define PG8_WAIT_V(n) asm volatile("s_waitcnt vmcnt(" #n ")" ::: "memory")
#define PG8_WAIT_L(n) asm volatile("s_waitcnt lgkmcnt(" #n ")" ::: "memory")
#define PG8_BAR __builtin_amdgcn_s_barrier()
#define PG8_SCHED __builtin_amdgcn_sched_barrier(0)
    Unit cur, nxt; int ui = 0;
    if (!S.next(0, cur)) return;
    f32x4 acc[2][2][4][2];
#pragma unroll
    for (int a = 0; a < 2; ++a)
#pragma unroll
        for (int b = 0; b < 2; ++b)
#pragma unroll
            for (int m = 0; m < 4; ++m)
#pragma unroll
                for (int n = 0; n < 2; ++n) acc[a][b][m][n] = (f32x4){0.f, 0.f, 0.f, 0.f};
    i32x8 At[4], B0[2], B1[2];
    { const char* cA = M3_TA(cur.pm, 0); const char* cB = M3_TB(cur.pn, 0); const size_t hB = 65536;
      PG8_STAGE(PG8_SB(0, 0), cB, voffB5); PG8_STAGE(PG8_SA(0, 0), cA, voffA); PG8_STAGE(PG8_SB(0, 1), cB + hB, voffB5); PG8_STAGE(PG8_SA(0, 1), cA + hstepA, voffA);
      if (wr == 1) PG8_BAR;
      PG8_WAIT_V(4); PG8_BAR;
      PG8_STAGE(PG8_SB(1, 0), cB + kstep, voffB5); PG8_STAGE(PG8_SA(1, 0), cA + kstep, voffA); PG8_STAGE(PG8_SB(1, 1), cB + hB + kstep, voffB5);
      PG8_WAIT_V(6); PG8_BAR; }
    const int r0 = wr * 64 + fr, c0l = wc * 32 + 8 * fq;
    for (;;) {
        const bool has_next = S.next(ui + 1, nxt);
        const int npm = has_next ? nxt.pm : cur.pm, npn = has_next ? nxt.pn : cur.pn;
#pragma unroll 1
        for (int t = 0; t < NT; t += 2) {
            const bool last = (t == NT - 2);
            const int t2 = last ? 0 : t + 2;
            const char* a1 = M3_TA(cur.pm, t + 1);
            const char* a2 = last ? M3_TA(npm, 0) : M3_TA(cur.pm, t + 2); const char* b2 = last ? M3_TB(npn, 0) : M3_TB(cur.pn, t + 2);
            const char* a3 = a2 + kstep; const char* b3 = b2 + kstep;
            const bool wide = t2 >= 8; const size_t hB = wide ? 131072 : 65536;
            unsigned vB[2]; vB[0] = wide ? voffB10[0] : voffB5[0]; vB[1] = wide ? voffB10[1] : voffB5[1];
            PG8_LDB(B0, 0, 0); PG8_SCHED; PG8_LDA(At, 0, 0); PG8_STAGE(PG8_SA(1, 1), a1 + hstepA, voffA);
            PG8_WAIT_L(8); PG8_BAR; PG8_WAIT_L(0); PG8_MMA(0, 0, At, B0); PG8_BAR; PG8_SCHED;
            PG8_LDB(B1, 0, 1); PG8_STAGE(PG8_SB(0, 0), b2, vB);
            PG8_BAR; PG8_WAIT_L(0); PG8_MMA(0, 1, At, B1); PG8_BAR;
            PG8_LDA(At, 0, 1); PG8_STAGE(PG8_SA(0, 0), a2, voffA);
            PG8_BAR; PG8_WAIT_L(0); PG8_MMA(1, 0, At, B0); PG8_BAR; PG8_SCHED;
            PG8_STAGE(PG8_SB(0, 1), b2 + hB, vB);
            PG8_WAIT_V(6); PG8_BAR; PG8_MMA(1, 1, At, B1); PG8_BAR;
            PG8_LDB(B0, 1, 0); PG8_SCHED; PG8_LDA(At, 1, 0); PG8_STAGE(PG8_SA(0, 1), a2 + hstepA, voffA);
            PG8_WAIT_L(8); PG8_BAR; PG8_WAIT_L(0); PG8_MMA(0, 0, At, B0); PG8_BAR; PG8_SCHED;
            PG8_LDB(B1, 1, 1); PG8_STAGE(PG8_SB(1, 0), b3, vB);
            PG8_BAR; PG8_WAIT_L(0); PG8_MMA(0, 1, At, B1); PG8_BAR;
            PG8_LDA(At, 1, 1); PG8_STAGE(PG8_SA(1, 0), a3, voffA);
            PG8_BAR; PG8_WAIT_L(0); PG8_MMA(1, 0, At, B0); PG8_BAR; PG8_SCHED;
            PG8_STAGE(PG8_SB(1, 1), b3 + hB, vB);
            PG8_WAIT_V(6); PG8_BAR; PG8_MMA(1, 1, At, B1); PG8_BAR;
            if (t == 2 || t == 6) {
                asm volatile("s_nop 15\n\ts_nop 15" ::: "memory");
                const int sg = t == 2 ? 0 : 1; const float wr_ = sg ? g.r12 : g.r01;
                const unsigned char* gp = (const unsigned char*)g.G + (size_t)(cur.pm * 256 + r0) * NG + sg * 2048 + cur.pn * 256 + c0l;
#pragma unroll
                for (int ai = 0; ai < 2; ++ai) { u32x2 ga[4][2], gb[4][2];
#pragma unroll
                    for (int m = 0; m < 4; ++m)
#pragma unroll
                        for (int bj = 0; bj < 2; ++bj) { const unsigned char* q_ = gp + (size_t)(ai * 128 + m * 16) * NG + bj * 128; ga[m][bj] = *(const u32x2*)q_; gb[m][bj] = *(const u32x2*)(q_ + 2048); }
#pragma unroll
                    for (int m = 0; m < 4; ++m)
#pragma unroll
                        for (int bj = 0; bj < 2; ++bj) { const u32x2 x_ = ga[m][bj], y_ = gb[m][bj];
#define M3_RT2(xw, yw, HI, E) (fmaxf(__builtin_amdgcn_cvt_pk_f32_fp8(xw, HI)[E], 0.0009765625f) * wr_ * __builtin_amdgcn_rcpf(fmaxf(__builtin_amdgcn_cvt_pk_f32_fp8(yw, HI)[E], 0.0009765625f)))
                            acc[ai][bj][m][0][0] *= M3_RT2(x_.x, y_.x, false, 0); acc[ai][bj][m][0][1] *= M3_RT2(x_.x, y_.x, false, 1); acc[ai][bj][m][0][2] *= M3_RT2(x_.x, y_.x, true, 0); acc[ai][bj][m][0][3] *= M3_RT2(x_.x, y_.x, true, 1);
                            acc[ai][bj][m][1][0] *= M3_RT2(x_.y, y_.y, false, 0); acc[ai][bj][m][1][1] *= M3_RT2(x_.y, y_.y, false, 1); acc[ai][bj][m][1][2] *= M3_RT2(x_.y, y_.y, true, 0); acc[ai][bj][m][1][3] *= M3_RT2(x_.y, y_.y, true, 1); } }
                asm volatile("s_waitcnt vmcnt(0)" ::: "memory");
            }
        }
        asm volatile("s_nop 15\n\ts_nop 15" ::: "memory");
        { const unsigned char* gp = (const unsigned char*)g.G + (size_t)(cur.pm * 256 + r0) * NG + 2 * 2048 + cur.pn * 256 + c0l; unsigned char* m8 = g.MB8 + (size_t)(cur.pm * 256 + r0) * D + cur.pn * 256 + c0l;
          u32x2 gc[2][4][2];
#pragma unroll
          for (int ai = 0; ai < 2; ++ai)
#pragma unroll
              for (int m = 0; m < 4; ++m)
#pragma unroll
                  for (int bj = 0; bj < 2; ++bj) gc[ai][m][bj] = *(const u32x2*)(gp + (size_t)(ai * 128 + m * 16) * NG + bj * 128);
          const float f_ = g.fin * (1.f / 256.f);
#define M3_G(w, HI, E) (fmaxf(__builtin_amdgcn_cvt_pk_f32_fp8(w, HI)[E], 0.0009765625f) * f_)
#pragma unroll
          for (int ai = 0; ai < 2; ++ai)
#pragma unroll
              for (int m = 0; m < 4; ++m)
#pragma unroll
                  for (int bj = 0; bj < 2; ++bj) { const u32x2 z_ = gc[ai][m][bj]; const f32x4 v0 = acc[ai][bj][m][0], v1 = acc[ai][bj][m][1];
                      u32x2 w8;
                      w8.x = pk4_fp8(clamp8(v0[0] * M3_G(z_.x, false, 0)), clamp8(v0[1] * M3_G(z_.x, false, 1)), clamp8(v0[2] * M3_G(z_.x, true, 0)), clamp8(v0[3] * M3_G(z_.x, true, 1)));
                      w8.y = pk4_fp8(clamp8(v1[0] * M3_G(z_.y, false, 0)), clamp8(v1[1] * M3_G(z_.y, false, 1)), clamp8(v1[2] * M3_G(z_.y, true, 0)), clamp8(v1[3] * M3_G(z_.y, true, 1)));
                      *(u32x2*)(m8 + (size_t)(ai * 128 + m * 16) * D + bj * 128) = w8; } }
        if (!has_next) break;
#pragma unroll
        for (int a = 0; a < 2; ++a)
#pragma unroll
            for (int b = 0; b < 2; ++b)
#pragma unroll
                for (int m = 0; m < 4; ++m)
#pragma unroll
                    for (int n = 0; n < 2; ++n) acc[a][b][m][n] = (f32x4){0.f, 0.f, 0.f, 0.f};
        cur = nxt; ++ui;
    }
    PG8_WAIT_V(0);
    if (wr == 0) PG8_BAR;
    PG8_BAR;
#undef M3_RT2
#undef M3_G
#undef M3_TA
#undef M3_TB
#undef PG8_SA
#undef PG8_SB
#undef PG8_STAGE
#undef PG8_LDA
#undef PG8_LDB
#undef PG8_MMA
#undef PG8_WAIT_V
#undef PG8_WAIT_L
#undef PG8_BAR
#undef PG8_SCHED
}
}
template <bool SRC16>
struct EpiOutT {
    static constexpr bool PERM = false, FP8 = true;
    const float* src_lat; const float* src_ctx; bf16_t* S1; const float* g1; float inv;
    __device__ __forceinline__ void operator()(const Acc& acc, const pg8::Unit& u, int wr, int wc, int fr, int fq) const {
        const int row0 = u.pm * 256 + wr * 64 + fr; const int col0 = u.pn * 256 + wc * 32 + 4 * fq;
        const bool lat = (u.pm * 256) < NLAT;
        const float* src = (lat ? src_lat : src_ctx - (size_t)NLAT * D) + (size_t)row0 * D + col0; bf16_t* dst = S1 + (size_t)row0 * D + col0;
#pragma unroll
        for (int ai = 0; ai < 2; ++ai) { const int rbase = u.pm * 256 + ai * 128 + wr * 64; const int v = lat ? (rbase >> 12) : 4; const float* gp = g1 + (size_t)v * 12288 + col0;
            f32x4 gg[2][2];
#pragma unroll
            for (int bj = 0; bj < 2; ++bj)
#pragma unroll
                for (int n = 0; n < 2; ++n) gg[bj][n] = *(const f32x4*)(gp + bj * 128 + n * 16);
#pragma unroll
            for (int mh = 0; mh < 2; ++mh) {
                f32x4 xr[2][2][2];
#pragma unroll
                for (int mm = 0; mm < 2; ++mm)
#pragma unroll
                    for (int bj = 0; bj < 2; ++bj)
#pragma unroll
                        for (int n = 0; n < 2; ++n) { const size_t o_ = (size_t)(ai * 128 + (mh * 2 + mm) * 16) * D + bj * 128 + n * 16;
                            if constexpr (SRC16) { const u32x2 w_ = *(const u32x2*)(dst + o_); xr[mm][bj][n] = (f32x4){bflo(w_.x), bfhi(w_.x), bflo(w_.y), bfhi(w_.y)}; }
                            else xr[mm][bj][n] = __builtin_nontemporal_load((const f32x4*)(src + o_)); }
#pragma unroll
                for (int mm = 0; mm < 2; ++mm)
#pragma unroll
                    for (int bj = 0; bj < 2; ++bj)
#pragma unroll
                        for (int n = 0; n < 2; ++n) { const int m = mh * 2 + mm;
                            const f32x4 y_ = ABL_MIX ? xr[mm][bj][n] * ALPHA : xr[mm][bj][n] * ALPHA + gg[bj][n] * (acc[ai][bj][m][n] * inv);
                            *(u32x2*)(dst + (size_t)(ai * 128 + m * 16) * D + bj * 128 + n * 16) = (u32x2){cvt_pk_bf16(y_[0], y_[1]), cvt_pk_bf16(y_[2], y_[3])}; } } }
    }
};

struct Args { const float* in[27]; float* out; unsigned char* ws; int ph_lo, ph_hi; };
typedef const Args __attribute__((address_space(4)))* ArgP;
struct Frame {
    LAS unsigned char* lds; int tid, lane, wave, G, bid;
    ArgP ap; float* out; unsigned char* ws;
    __device__ __forceinline__ const float* in(int i) const { return ap->in[i]; }
};
__device__ __forceinline__ Frame make_frame(ArgP ap) {
    { unsigned long long t = (unsigned long long)ap; asm volatile("" : "+s"(t)); ap = (ArgP)t; }
    extern __shared__ __attribute__((aligned(16))) unsigned char lds_raw[];
    Frame F; F.lds = (LAS unsigned char*)lds_raw; { int t_ = threadIdx.x; asm volatile("" : "+v"(t_)); F.tid = t_; }
    F.lane = F.tid & 63; F.wave = __builtin_amdgcn_readfirstlane(F.tid >> 6); F.G = gridDim.x; F.bid = blockIdx.x;
    F.ap = ap; F.out = ap->out; F.ws = ap->ws; return F;
}
template <class T> __device__ __forceinline__ T* wsp(const Frame& F, size_t off) { return (T*)(F.ws + off); }

__device__ __forceinline__ int win_col(int n) {
    if (n < 768) return n;
    if (n < 1792) return 2336 + (n - 768);
    if (n < 2048) return 3360 + (n - 1792);
    if (n < 2304) return 3616 + (n - 2048);
    if (n < 2560) return 800 + (n - 2304);
    if (n < 2816) return 1056 + (n - 2560);
    if (n < 3328) return 1312 + (n - 2816);
    if (n < 3840) return 1824 + (n - 3328);
    if (n < 3872) return 768 + (n - 3840);
    if (n < 4096) return -1;
    return 3872 + (n - 4096);
}
__device__ __forceinline__ int qup_col(int c) {
    const int hh = c / 96, j = c - hh * 96;
    if (j < 64) return c;
    const int jj = j - 64, g8 = jj >> 3, i = jj & 7, p = i >> 1, which = i & 1, part = g8 >> 1, pi = (g8 & 1) * 4 + p;
    return hh * 96 + 64 + part * 16 + which * 8 + pi;
}
template <int MAP>
__device__ __forceinline__ void transpose_cvt(const Frame& F, const float* __restrict__ src, bf16_t* __restrict__ dst, int K, int Nsrc, int Nd) {
    LAS float* tile = (LAS float*)F.lds;
    const int tk = K / 256, tn = Nd / 64, ntile = tk * tn;
    for (int t = F.bid; t < ntile; t += F.G) {
        const int k0 = (t % tk) * 256, n0 = (t / tk) * 64;
        const int nl = F.tid & 63, kq = F.tid >> 6;
        const int nd = n0 + nl; const int ns = MAP == 0 ? nd : (MAP == 1 ? win_col(nd) : qup_col(nd));
        float v[32];
#pragma unroll
        for (int i = 0; i < 32; ++i) v[i] = ns >= 0 ? src[(size_t)(k0 + kq + 8 * i) * Nsrc + ns] : 0.f;
#pragma unroll
        for (int i = 0; i < 32; ++i) tile[(kq + 8 * i) * 65 + nl] = v[i];
        __syncthreads();
        { const int n = F.tid >> 3, k32 = (F.tid & 7) * 32;
#pragma unroll
          for (int c = 0; c < 4; ++c) { float w[8];
#pragma unroll
              for (int j = 0; j < 8; ++j) w[j] = tile[(k32 + c * 8 + j) * 65 + n];
              u32x4 o; o.x = cvt_pk_bf16(w[0], w[1]); o.y = cvt_pk_bf16(w[2], w[3]); o.z = cvt_pk_bf16(w[4], w[5]); o.w = cvt_pk_bf16(w[6], w[7]);
              *(u32x4*)(dst + (size_t)(n0 + n) * K + k0 + k32 + c * 8) = o; } }
        __syncthreads();
    }
}
__device__ __forceinline__ void cvt_rows(const Frame& F, const float* __restrict__ src, bf16_t* __restrict__ dst, size_t n8) {
    for (size_t i = (size_t)F.bid * 512 + F.tid; i < n8; i += (size_t)F.G * 512) {
        const f32x4 a = __builtin_nontemporal_load((const f32x4*)(src + i * 8)), b = __builtin_nontemporal_load((const f32x4*)(src + i * 8 + 4));
        *(u32x4*)(dst + i * 8) = pack8(a, b);
    }
}
__device__ __forceinline__ void cvt_peer(const Frame& F, int l);
__device__ __forceinline__ float max4abs(float am, const f32x4 a) { return fmaxf(fmaxf(fmaxf(am, fabsf(a[0])), fabsf(a[1])), fmaxf(fabsf(a[2]), fabsf(a[3]))); }
__device__ __forceinline__ void absmax_commit(const Frame& F, float am, unsigned* dst) {
    am = row16_max(am);
    { auto r = __builtin_amdgcn_permlane16_swap(__float_as_uint(am), __float_as_uint(am), false, false); am = fmaxf(__uint_as_float(r[0]), __uint_as_float(r[1])); }
    { auto r = __builtin_amdgcn_permlane32_swap(__float_as_uint(am), __float_as_uint(am), false, false); am = fmaxf(__uint_as_float(r[0]), __uint_as_float(r[1])); }
    if (F.lane == 0) atomicMax(dst, __float_as_uint(am));
}
template <int NB>
__device__ __forceinline__ void absmax_f32(const Frame& F, const float* __restrict__ src, size_t n4, unsigned* dst) {
    float am = 0.f;
    const size_t stride = (size_t)F.G * 512; size_t i = (size_t)F.bid * 512 + F.tid;
    for (; i < n4; i += NB * stride) { f32x4 a[NB];
#pragma unroll
        for (int j = 0; j < NB; ++j) { const size_t ix = i + j * stride; a[j] = ix < n4 ? __builtin_nontemporal_load((const f32x4*)(src + ix * 4)) : (f32x4){0.f, 0.f, 0.f, 0.f}; }
#pragma unroll
        for (int j = 0; j < NB; ++j) am = max4abs(am, a[j]); }
    absmax_commit(F, am, dst);
}
__device__ __forceinline__ void absmax4_f32(const Frame& F, const float* s0, size_t n0, unsigned* d0, const float* s1, size_t n1, unsigned* d1, const float* s2, size_t n2, unsigned* d2, const float* s3, size_t n3, unsigned* d3) {
    const size_t stride = (size_t)F.G * 512, i0 = (size_t)F.bid * 512 + F.tid;
    f32x4 a0[2], a1[2], a2[4], a3[8];
#define AM4_LD(a, NB, s, n) _Pragma("unroll") for (int j = 0; j < NB; ++j) { const size_t ix = i0 + j * stride; a[j] = ix < n ? __builtin_nontemporal_load((const f32x4*)(s + ix * 4)) : (f32x4){0.f, 0.f, 0.f, 0.f}; }
    AM4_LD(a0, 2, s0, n0) AM4_LD(a1, 2, s1, n1) AM4_LD(a2, 4, s2, n2) AM4_LD(a3, 8, s3, n3)
#undef AM4_LD
#define AM4_RED(a, NB, s, n, d) { float am = 0.f; _Pragma("unroll") for (int j = 0; j < NB; ++j) am = max4abs(am, a[j]); \
        for (size_t i = i0 + NB * stride; i < n; i += stride) am = max4abs(am, *(const f32x4*)(s + i * 4)); absmax_commit(F, am, d); }
    AM4_RED(a0, 2, s0, n0, d0) AM4_RED(a1, 2, s1, n1, d1) AM4_RED(a2, 4, s2, n2, d2) AM4_RED(a3, 8, s3, n3, d3)
#undef AM4_RED
}
template <int MAP>
__device__ __forceinline__ void transpose_fp8(const Frame& F, const float* __restrict__ src, unsigned char* __restrict__ dst, int K, int Nsrc, int Nd, const unsigned* wsc) {
    float mul, inv; fp8_scale(__hip_atomic_load(wsc, __ATOMIC_RELAXED, __HIP_MEMORY_SCOPE_AGENT), mul, inv);
    LAS float* tile = (LAS float*)F.lds;
    const int tk = K / 256, tn = Nd / 64, ntile = tk * tn;
    for (int t = F.bid; t < ntile; t += F.G) {
        const int k0 = (t % tk) * 256, n0 = (t / tk) * 64;
        const int nl = F.tid & 63, kq = F.tid >> 6; const int ns = MAP ? win_col(n0 + nl) : n0 + nl;
        float v[32];
#pragma unroll
        for (int i = 0; i < 32; ++i) v[i] = ns >= 0 ? src[(size_t)(k0 + kq + 8 * i) * Nsrc + ns] : 0.f;
#pragma unroll
        for (int i = 0; i < 32; ++i) tile[(kq + 8 * i) * 65 + nl] = v[i] * mul;
        __syncthreads();
        { const int n = F.tid >> 3, k32 = (F.tid & 7) * 32;
#pragma unroll
          for (int c = 0; c < 2; ++c) { float w[16];
#pragma unroll
              for (int j = 0; j < 16; ++j) w[j] = tile[(k32 + c * 16 + j) * 65 + n];
              u32x4 o; o.x = pk4_fp8(w[0], w[1], w[2], w[3]); o.y = pk4_fp8(w[4], w[5], w[6], w[7]); o.z = pk4_fp8(w[8], w[9], w[10], w[11]); o.w = pk4_fp8(w[12], w[13], w[14], w[15]);
              *(u32x4*)(dst + (size_t)(n0 + n) * K + k0 + k32 + c * 16) = o; } }
        __syncthreads();
    }
}
template <int PART = 7>
__device__ __forceinline__ void p0_prologue(const Frame& F) {
    { const int gi = F.bid * 512 + F.tid;
      if (gi < 64 * 8) { const int pos = gi >> 3, f = gi & 7; const float inv = powf(10000.f, -(float)f / 8.f); const float a = (float)pos * inv; wsp<f32x2>(F, WS_ROPE32)[gi] = (f32x2){cosf(a), sinf(a)}; }
      else if (gi < 64 * 8 + 64 * 32) { const int g2 = gi - 512; const int pos = g2 >> 5, f = g2 & 31; const float inv = powf(10000.f, -(float)f / 32.f); const float a = (float)pos * inv; wsp<f32x2>(F, WS_ROPE128)[g2] = (f32x2){cosf(a), sinf(a)}; } }
    if (F.bid == 0 && F.tid < 32) wsp<float>(F, WS_DEC)[F.tid] = -log1pf(expf(-F.in(11)[F.tid])) * LOG2E;
#pragma unroll 1
    for (int s3 = 0; s3 < 3; ++s3) { const int part = (s3 + F.bid) % 3;
    if ((PART & 1) && part == 0) { LAS float* sl = (LAS float*)F.lds;
      float* modp = wsp<float>(F, WS_MODP);
      for (int u = F.bid; u < 2 * 24 * 16; u += F.G) {
          const int kc = u & 15, cb = (u >> 4) % 24, l = u / (16 * 24);
          __syncthreads();
          for (int i = F.tid; i < 640; i += 512) { const int v = i >> 7, k = kc * 128 + (i & 127); const float c = v < 4 ? F.in(1)[v * 2048 + k] : F.in(3)[k]; sl[i] = silu_f(c); }
          __syncthreads();
          const int col = cb * 512 + F.tid; const float* w = F.in(4) + ((size_t)l * 2048 + kc * 128) * 12288 + col;
          float a0 = 0.f, a1 = 0.f, a2 = 0.f, a3 = 0.f, a4 = 0.f;
#pragma unroll 32
          for (int k = 0; k < 128; ++k) { const float wv = w[(size_t)k * 12288]; a0 += sl[k] * wv; a1 += sl[128 + k] * wv; a2 += sl[256 + k] * wv; a3 += sl[384 + k] * wv; a4 += sl[512 + k] * wv; }
          float* o = modp + ((size_t)(kc * 2 + l) * 5) * 12288 + col;
          o[0] = a0; o[12288] = a1; o[2 * 12288] = a2; o[3 * 12288] = a3; o[4 * 12288] = a4;
      }
      __syncthreads(); }
    if ((PART & 2) && part == 1) for (int l = 0; l < 2; ++l) {
        absmax_f32<16>(F, F.in(6) + (size_t)l * 2048 * NIN, (size_t)2048 * NIN / 4, wsp<unsigned>(F, WS_WSC) + l);
        absmax4_f32(F, F.in(14) + (size_t)l * 512 * 2048, (size_t)512 * 2048 / 4, wsp<unsigned>(F, WS_WSC) + 4 + l, F.in(15) + (size_t)l * 512 * 2048, (size_t)512 * 2048 / 4, wsp<unsigned>(F, WS_WSC) + 6 + l,
                    F.in(16) + (size_t)l * 1024 * 2048, (size_t)1024 * 2048 / 4, wsp<unsigned>(F, WS_WSC) + 8 + l, F.in(17) + (size_t)l * 2048 * 2048, (size_t)2048 * 2048 / 4, wsp<unsigned>(F, WS_WSC) + 2 + l);
        transpose_cvt<2>(F, F.in(8) + (size_t)l * 512 * 768, wsp<bf16_t>(F, WS_WQUP + l * SZ_WQUP), 512, 768, 768);
        transpose_cvt<0>(F, F.in(10) + (size_t)l * 256 * 1024, wsp<bf16_t>(F, WS_WKVUP + l * SZ_WKVUP), 256, 1024, 1024);
        transpose_cvt<0>(F, F.in(20) + (size_t)l * 2048 * 1024, wsp<bf16_t>(F, WS_WPQ + l * SZ_WPQ), 2048, 1024, 1024);
    }
    if ((PART & 4) && part == 2) cvt_peer(F, 0);
    }
}
__device__ __forceinline__ void p1_modreduce(const Frame& F) {
    const float* modp = wsp<float>(F, WS_MODP); float* mod = wsp<float>(F, WS_MOD);
    for (int i = F.bid * 512 + F.tid; i < 2 * 5 * 12288; i += F.G * 512) {
        const int j = i % 12288, l = i / (5 * 12288);
        float s = F.in(5)[l * 12288 + j];
#pragma unroll
        for (int kc = 0; kc < 16; ++kc) s += modp[(size_t)kc * (2 * 5 * 12288) + i];
        mod[i] = s;
    }
    for (int l = 0; l < 2; ++l) {
        transpose_fp8<1>(F, F.in(6) + (size_t)l * 2048 * NIN, wsp<unsigned char>(F, WS_WIN + l * SZ_WIN), 2048, NIN, NPT, wsp<unsigned>(F, WS_WSC) + l);
        transpose_fp8<0>(F, F.in(17) + (size_t)l * 2048 * 2048, wsp<unsigned char>(F, WS_WOUT + l * SZ_WOUT), 2048, 2048, 2048, wsp<unsigned>(F, WS_WSC) + 2 + l);
        transpose_fp8<0>(F, F.in(14) + (size_t)l * 512 * 2048, wsp<unsigned char>(F, WS_WBRA + l * SZ_WBRA), 512, 2048, 2048, wsp<unsigned>(F, WS_WSC) + 4 + l);
        transpose_fp8<0>(F, F.in(15) + (size_t)l * 512 * 2048, wsp<unsigned char>(F, WS_WBRB + l * SZ_WBRB), 512, 2048, 2048, wsp<unsigned>(F, WS_WSC) + 6 + l);
        transpose_fp8<0>(F, F.in(16) + (size_t)l * 1024 * 2048, wsp<unsigned char>(F, WS_WBRC + l * SZ_WBRC), 1024, 2048, 2048, wsp<unsigned>(F, WS_WSC) + 8 + l);
    }
}
__device__ __forceinline__ void ld_row_f32(const float* p, int lane, float (&x)[32]) {
#pragma unroll
    for (int q = 0; q < 4; ++q) { const f32x4 a = *(const f32x4*)(p + 512 * q + 8 * lane), b = *(const f32x4*)(p + 512 * q + 8 * lane + 4);
        x[q * 8 + 0] = a[0]; x[q * 8 + 1] = a[1]; x[q * 8 + 2] = a[2]; x[q * 8 + 3] = a[3]; x[q * 8 + 4] = b[0]; x[q * 8 + 5] = b[1]; x[q * 8 + 6] = b[2]; x[q * 8 + 7] = b[3]; }
}
__device__ __forceinline__ void st_row_f32(float* p, int lane, const float (&x)[32]) {
#pragma unroll
    for (int q = 0; q < 4; ++q) { *(f32x4*)(p + 512 * q + 8 * lane) = (f32x4){x[q * 8 + 0], x[q * 8 + 1], x[q * 8 + 2], x[q * 8 + 3]}; *(f32x4*)(p + 512 * q + 8 * lane + 4) = (f32x4){x[q * 8 + 4], x[q * 8 + 5], x[q * 8 + 6], x[q * 8 + 7]}; }
}
__device__ __forceinline__ void ld_row_bf16(const bf16_t* p, int lane, float (&x)[32]) {
#pragma unroll
    for (int q = 0; q < 4; ++q) { const u32x4 w = *(const u32x4*)(p + 512 * q + 8 * lane);
        x[q * 8 + 0] = bflo(w.x); x[q * 8 + 1] = bfhi(w.x); x[q * 8 + 2] = bflo(w.y); x[q * 8 + 3] = bfhi(w.y); x[q * 8 + 4] = bflo(w.z); x[q * 8 + 5] = bfhi(w.z); x[q * 8 + 6] = bflo(w.w); x[q * 8 + 7] = bfhi(w.w); }
}
__device__ __forceinline__ void st_row_bf16(bf16_t* p, int lane, const float (&x)[32]) {
#pragma unroll
    for (int q = 0; q < 4; ++q) { u32x4 w; w.x = cvt_pk_bf16(x[q * 8 + 0], x[q * 8 + 1]); w.y = cvt_pk_bf16(x[q * 8 + 2], x[q * 8 + 3]); w.z = cvt_pk_bf16(x[q * 8 + 4], x[q * 8 + 5]); w.w = cvt_pk_bf16(x[q * 8 + 6], x[q * 8 + 7]);
        *(u32x4*)(p + 512 * q + 8 * lane) = w; }
}
__device__ __forceinline__ void p_modulate0(const Frame& F) {
    const float* mod = wsp<float>(F, WS_MOD); unsigned char* hb8 = wsp<unsigned char>(F, WS_HB8);
    for (int row = F.bid * 8 + F.wave; row < NROW; row += F.G * 8) {
        const RowInfo ri = rowinfo(row);
        const float* xp = ri.lat ? F.in(0) + (size_t)row * D : F.in(2) + (size_t)(row - NLAT) * D;
        const float* mp = mod + (size_t)ri.v * 12288;
        float x[32], sh[32], sc[32];
        ld_row_f32(xp, F.lane, x); ld_row_f32(mp, F.lane, sh); ld_row_f32(mp + 2048, F.lane, sc);
#pragma unroll
        for (int i = 0; i < 32; ++i) x[i] = clamp8(x[i] * (1.f + sc[i]) + sh[i]);
#pragma unroll
        for (int q = 0; q < 4; ++q) { u32x2 w; w.x = pk4_fp8(x[q * 8 + 0], x[q * 8 + 1], x[q * 8 + 2], x[q * 8 + 3]); w.y = pk4_fp8(x[q * 8 + 4], x[q * 8 + 5], x[q * 8 + 6], x[q * 8 + 7]); *(u32x2*)(hb8 + (size_t)row * D + 512 * q + 8 * F.lane) = w; }
    }
}
__device__ __forceinline__ void p_post(const Frame& F, int l) {
    const unsigned char* P1 = wsp<unsigned char>(F, WS_P1);
    bf16_t* CQN = wsp<bf16_t>(F, WS_CQN); bf16_t* CKVN = wsp<bf16_t>(F, WS_CKVN);
    unsigned char* QG = wsp<unsigned char>(F, WS_QG); unsigned char* KG = wsp<unsigned char>(F, WS_KG); unsigned char* VG = wsp<unsigned char>(F, WS_VG);
    bf16_t* RQ = wsp<bf16_t>(F, WS_RQ); bf16_t* RK = wsp<bf16_t>(F, WS_RK); bf16_t* RV = wsp<bf16_t>(F, WS_RV);
    unsigned char* KM = wsp<unsigned char>(F, WS_KM); unsigned char* QM = wsp<unsigned char>(F, WS_QM);
    const f32x2* cs32 = wsp<f32x2>(F, WS_ROPE32); const f32x2* cs128 = wsp<f32x2>(F, WS_ROPE128);
    const float* gq_n = F.in(7) + l * 512; const float* gkv_n = F.in(9) + l * 256; const float* gqa_qn = F.in(12) + l * 128; const float* gqa_kn = F.in(13) + l * 128;
    LAS bf16_t* rs = (LAS bf16_t*)(F.lds + F.wave * 8192);
    const int lane = F.lane;
    const f32x4 gq0 = *(const f32x4*)(gq_n + lane * 8), gq1 = *(const f32x4*)(gq_n + lane * 8 + 4), gkv0 = *(const f32x4*)(gkv_n + lane * 4);
    const int gd0 = 2 * lane; const int gpart = gd0 >> 6, gdd = gd0 & 63; const bool glo = gdd < 32; const int gf = glo ? gdd : gdd - 32; const int gdp = glo ? gd0 + 32 : gd0 - 32;
    const float qn0 = gqa_qn[gd0], qn1 = gqa_qn[gd0 + 1], qnp0 = gqa_qn[gdp], qnp1 = gqa_qn[gdp + 1];
    const float kn0 = gqa_kn[gd0], kn1 = gqa_kn[gd0 + 1], knp0 = gqa_kn[gdp], knp1 = gqa_kn[gdp + 1];
    const int rhh = lane >> 3, rd0 = (lane & 7) * 4; const int rpart = rd0 >> 4, rdd = rd0 & 15; const bool rlo = rdd < 8; const int rf = rlo ? rdd : rdd - 8; const int rdp = rlo ? rd0 + 8 : rd0 - 8;
    const int step = F.G * 8;
    int row = F.bid * 8 + F.wave;
    u32x4 pre[4];
    if (row < NROW) {
#pragma unroll
        for (int q = 0; q < 4; ++q) pre[q] = *(const u32x4*)(P1 + (size_t)row * NP1 + q * 1024 + lane * 16); }
#pragma unroll 1
    for (; row < NROW; row += step) {
        const RowInfo ri = rowinfo(row);
        const int posg = gpart ? ri.pc : ri.pr, posr = rpart ? ri.pc : ri.pr;
        const f32x2 one = {1.f, 0.f};
        const f32x2 csA = ri.lat ? cs128[posg * 32 + gf] : one, csB = ri.lat ? cs128[posg * 32 + gf + 1] : one;
        f32x2 cs[4];
#pragma unroll
        for (int i = 0; i < 4; ++i) cs[i] = ri.lat ? cs32[posr * 8 + rf + i] : one;
#pragma unroll
        for (int q = 0; q < 4; ++q) {
#pragma unroll
            for (int hf = 0; hf < 2; ++hf) { const unsigned wa = hf ? pre[q].z : pre[q].x, wb = hf ? pre[q].w : pre[q].y;
                const f32x2 a0 = __builtin_amdgcn_cvt_pk_f32_fp8(wa, false) * 0.0625f, a1 = __builtin_amdgcn_cvt_pk_f32_fp8(wa, true) * 0.0625f, b0 = __builtin_amdgcn_cvt_pk_f32_fp8(wb, false) * 0.0625f, b1 = __builtin_amdgcn_cvt_pk_f32_fp8(wb, true) * 0.0625f;
                u32x4 o_; o_.x = cvt_pk_bf16(a0.x, a0.y); o_.y = cvt_pk_bf16(a1.x, a1.y); o_.z = cvt_pk_bf16(b0.x, b0.y); o_.w = cvt_pk_bf16(b1.x, b1.y);
                *(LAS u32x4*)(rs + q * 1024 + lane * 16 + hf * 8) = o_; } }
        { const int nrow = row + step; if (nrow < NROW) {
#pragma unroll
            for (int q = 0; q < 4; ++q) pre[q] = *(const u32x4*)(P1 + (size_t)nrow * NP1 + q * 1024 + lane * 16); } }
        asm volatile("s_waitcnt lgkmcnt(0)" ::: "memory");
        { float x[8]; float ss = 0.f;
#pragma unroll
          for (int i = 0; i < 8; ++i) { x[i] = bf2f(rs[C_CQ + lane * 8 + i]); ss += x[i] * x[i]; }
          ss = wave_sum(ss); const float r = rsqrtf(ss * (1.f / 512.f) + RMS_EPS);
          *(u32x4*)(CQN + (size_t)row * 512 + lane * 8) = pack8((f32x4){x[0] * r * gq0[0], x[1] * r * gq0[1], x[2] * r * gq0[2], x[3] * r * gq0[3]}, (f32x4){x[4] * r * gq1[0], x[5] * r * gq1[1], x[6] * r * gq1[2], x[7] * r * gq1[3]}); }
        { float x[4]; float ss = 0.f;
#pragma unroll
          for (int i = 0; i < 4; ++i) { x[i] = bf2f(rs[C_CKV + lane * 4 + i]); ss += x[i] * x[i]; }
          ss = wave_sum(ss); const float r = rsqrtf(ss * (1.f / 256.f) + RMS_EPS);
          u32x2 w; w.x = cvt_pk_bf16(x[0] * r * gkv0[0], x[1] * r * gkv0[1]); w.y = cvt_pk_bf16(x[2] * r * gkv0[2], x[3] * r * gkv0[3]);
          *(u32x2*)(CKVN + (size_t)row * 256 + lane * 4) = w; }
        {
            const int d0 = gd0, dp = gdp; const bool lo = glo;
#pragma unroll 1
            for (int hh = 0; hh < 10; ++hh) {
                const bool isq = hh < 8; const int cbase = isq ? C_GQ + hh * 128 : C_GK + (hh - 8) * 128;
                const float g0 = isq ? qn0 : kn0, g1 = isq ? qn1 : kn1, gp0 = isq ? qnp0 : knp0, gp1 = isq ? qnp1 : knp1;
                const float a0 = bf2f(rs[cbase + d0]), a1 = bf2f(rs[cbase + d0 + 1]);
                float ss = wave_sum(a0 * a0 + a1 * a1); const float r = rsqrtf(ss * (1.f / 128.f) + RMS_EPS);
                const float n0 = a0 * r * g0, n1 = a1 * r * g1;
                const float p0 = bf2f(rs[cbase + dp]) * r * gp0, p1 = bf2f(rs[cbase + dp + 1]) * r * gp1;
                float o0, o1;
                if (lo) { o0 = n0 * csA.x - p0 * csA.y; o1 = n1 * csB.x - p1 * csB.y; }
                else    { o0 = p0 * csA.y + n0 * csA.x; o1 = p1 * csB.y + n1 * csB.x; }
                unsigned char* dst = isq ? QG + ((size_t)(ri.b * 8 + hh) * TT + ri.tpos) * 128 : KG + ((size_t)(ri.b * 2 + (hh - 8)) * TT + ri.tpos) * 128;
                const float sc8_ = isq ? QSC_G : KSC8;
                *(unsigned short*)(dst + d0) = (unsigned short)(pk4_fp8(clamp8(o0 * sc8_), clamp8(o1 * sc8_), 0.f, 0.f) & 0xffffu);
            }
#pragma unroll
            for (int hh = 0; hh < 2; ++hh) { const unsigned w8_ = pk4_fp8(clamp8(bf2f(rs[C_GV + hh * 128 + d0])), clamp8(bf2f(rs[C_GV + hh * 128 + d0 + 1])), 0.f, 0.f); unsigned char* vp_ = VG + ((size_t)(ri.b * 2 + hh) * 128 + d0) * TT + vt_off(ri.tpos);
                vp_[0] = (unsigned char)(w8_ & 0xffu); vp_[TT] = (unsigned char)((w8_ >> 8) & 0xffu); }
        }
        {
            const int hh = rhh, d0 = rd0, dp = rdp; const bool lo = rlo;
#pragma unroll
            for (int which = 0; which < 2; ++which) {
                const int cbase = (which ? C_RK : C_RQ) + hh * 32; const float sc = which ? 0.17677669529663687f : 1.f;
                float o[4];
#pragma unroll
                for (int i = 0; i < 4; ++i) { const float n = bf2f(rs[cbase + d0 + i]), p = bf2f(rs[cbase + dp + i]);
                    o[i] = (lo ? (n * cs[i].x - p * cs[i].y) : (p * cs[i].y + n * cs[i].x)) * sc; }
                u32x2 w; w.x = cvt_pk_bf16(o[0], o[1]); w.y = cvt_pk_bf16(o[2], o[3]);
                *(u32x2*)((which ? RK : RQ) + ((size_t)(ri.b * 8 + hh) * TT + ri.tpos) * 32 + d0) = w;
            }
            { const int vh = lane >> 3, e0 = (lane & 7) * 8;
              *(u32x4*)(RV + ((size_t)(ri.b * 8 + vh) * TT + ri.tpos) * 64 + e0) = *(LAS u32x4*)(rs + C_RV + lane * 8); }
            { float o[4];
#pragma unroll
              for (int i = 0; i < 4; ++i) { const float n = bf2f(rs[C_KR + d0 + i]), p = bf2f(rs[C_KR + dp + i]); o[i] = lo ? (n * cs[i].x - p * cs[i].y) : (p * cs[i].y + n * cs[i].x); }
              const size_t tok_ = ((size_t)(ri.b * 8 + hh) * TT + ri.tpos) * 128;
              *(unsigned*)(KM + tok_ + 64 + d0) = pk4_fp8(clamp8(o[0] * KSC8), clamp8(o[1] * KSC8), clamp8(o[2] * KSC8), clamp8(o[3] * KSC8));
              *(unsigned*)(KM + tok_ + 96 + d0) = 0u; *(unsigned*)(QM + tok_ + 96 + d0) = 0u; }
        }
        asm volatile("s_waitcnt lgkmcnt(0)" ::: "memory");
    }
}

__device__ __forceinline__ void ret_logs(const Frame& F, int l, int h, float& lgf, float& lgb) {
    const float* t = wsp<float>(F, WS_DEC); lgf = t[(l * 2 + 0) * 8 + h]; lgb = t[(l * 2 + 1) * 8 + h];
}
constexpr int TP = 136;
template <bool WITH_K>
__device__ __forceinline__ void ret_stage(const Frame& F, const bf16_t* RKh, const bf16_t* RVh, int tpos0, float lgf, float lgb, LAS bf16_t* vt, LAS bf16_t* ktf, LAS bf16_t* ktb) {
#pragma unroll
    for (int i = 0; i < 2; ++i) { const int tok = (F.tid >> 3) + 64 * i, e0 = (F.tid & 7) * 8;
        const u32x4 w = *(const u32x4*)(RVh + (size_t)(tpos0 + tok) * 64 + e0); const unsigned ww[4] = {w.x, w.y, w.z, w.w};
#pragma unroll
        for (int j = 0; j < 4; ++j) { vt[(e0 + 2 * j) * TP + tok] = (bf16_t)(ww[j] & 0xffffu); vt[(e0 + 2 * j + 1) * TP + tok] = (bf16_t)(ww[j] >> 16); } }
    if (WITH_K) { const int tok = F.tid >> 2, k0 = (F.tid & 3) * 8;
        const u32x4 w = *(const u32x4*)(RKh + (size_t)(tpos0 + tok) * 32 + k0); const unsigned ww[4] = {w.x, w.y, w.z, w.w};
        const float zf = exp2f(lgf * (float)(127 - tok)), zb = exp2f(lgb * (float)tok);
#pragma unroll
        for (int j = 0; j < 4; ++j) { const float a = bflo(ww[j]), b = bfhi(ww[j]);
            ktf[(k0 + 2 * j) * TP + tok] = f2bf(a * zf); ktf[(k0 + 2 * j + 1) * TP + tok] = f2bf(b * zf);
            ktb[(k0 + 2 * j) * TP + tok] = f2bf(a * zb); ktb[(k0 + 2 * j + 1) * TP + tok] = f2bf(b * zb); } }
}
__device__ __forceinline__ void p_ret_states(const Frame& F, int l) {
    LAS bf16_t* vt = (LAS bf16_t*)F.lds; LAS bf16_t* ktf = vt + 64 * TP; LAS bf16_t* ktb = ktf + 32 * TP;
    float* ST = wsp<float>(F, WS_ST);
    const int lane = F.lane, w = F.wave, kb = w >> 2, eb = w & 3, fr = lane & 15, fq = lane >> 4;
    for (int u = F.bid; u < NB * 8 * 34; u += F.G) {
        const int c = u % 34, bh = u / 34, h = bh & 7;
        float lgf, lgb; ret_logs(F, l, h, lgf, lgb);
        __syncthreads();
        ret_stage<true>(F, wsp<bf16_t>(F, WS_RK) + (size_t)bh * TT * 32, wsp<bf16_t>(F, WS_RV) + (size_t)bh * TT * 64, c * 128, lgf, lgb, vt, ktf, ktb);
        __syncthreads();
        f32x4 sf = {0.f, 0.f, 0.f, 0.f}, sb = {0.f, 0.f, 0.f, 0.f};
#pragma unroll
        for (int ks = 0; ks < 4; ++ks) {
            const bf16x8 bv = *(const LAS bf16x8*)(vt + (eb * 16 + fr) * TP + ks * 32 + fq * 8);
            const bf16x8 af = *(const LAS bf16x8*)(ktf + (kb * 16 + fr) * TP + ks * 32 + fq * 8);
            const bf16x8 ab = *(const LAS bf16x8*)(ktb + (kb * 16 + fr) * TP + ks * 32 + fq * 8);
            sf = __builtin_amdgcn_mfma_f32_16x16x32_bf16(af, bv, sf, 0, 0, 0);
            sb = __builtin_amdgcn_mfma_f32_16x16x32_bf16(ab, bv, sb, 0, 0, 0);
        }
        float* o = ST + (size_t)u * 2 * 2048;
#pragma unroll
        for (int r = 0; r < 4; ++r) { const int kd = kb * 16 + fq * 4 + r, e = eb * 16 + fr; o[kd * 64 + e] = sf[r]; o[2048 + kd * 64 + e] = sb[r]; }
    }
}
constexpr int RP = 40;
constexpr int AP = 136;
__device__ __forceinline__ void ret_out_unit(const Frame& F, int l, int bh, int c) {
    LAS bf16_t* vt = (LAS bf16_t*)F.lds; LAS bf16_t* rtf = vt + 64 * TP; LAS bf16_t* rtb = rtf + 64 * RP; LAS bf16_t* as = rtb + 64 * RP + F.wave * 16 * AP;
    const int lane = F.lane, w = F.wave, fr = lane & 15, fq = lane >> 4, h = bh & 7, b = bh >> 3;
    const bf16_t* RQh = wsp<bf16_t>(F, WS_RQ) + (size_t)bh * TT * 32; const bf16_t* RKh = wsp<bf16_t>(F, WS_RK) + (size_t)bh * TT * 32; const bf16_t* RVh = wsp<bf16_t>(F, WS_RV) + (size_t)bh * TT * 64;
    const float* STh = wsp<float>(F, WS_ST) + (size_t)bh * 34 * 2 * 2048;
    float lgf, lgb; ret_logs(F, l, h, lgf, lgb);
    const int tpos0 = c * 128;
    const int i0 = w * 16;
    const bf16x8 qa = *(const bf16x8*)(RQh + (size_t)(tpos0 + i0 + fr) * 32 + fq * 8);
    bf16x8 kfr[8];
#pragma unroll
    for (int nb = 0; nb < 8; ++nb) kfr[nb] = *(const bf16x8*)(RKh + (size_t)(tpos0 + nb * 16 + fr) * 32 + fq * 8);
    const unsigned char* P1 = wsp<unsigned char>(F, WS_P1); unsigned char* OAB = wsp<unsigned char>(F, WS_OAB);
    unsigned char gv[4][4];
#pragma unroll
    for (int r = 0; r < 4; ++r) { const int tp = tpos0 + i0 + fq * 4 + r; const size_t grow = tp >= CTXL ? (size_t)b * SEQ + (tp - CTXL) : (size_t)NLAT + b * CTXL + tp;
#pragma unroll
        for (int eb = 0; eb < 4; ++eb) gv[r][eb] = P1[grow * NP1 + C_RG + h * 64 + eb * 16 + fr]; }
    __syncthreads();
    ret_stage<false>(F, RKh, RVh, tpos0, lgf, lgb, vt, nullptr, nullptr);
    { const int kd = F.tid >> 4, e4 = (F.tid & 15) * 4; f32x4 rf = {0.f, 0.f, 0.f, 0.f}, rb = {0.f, 0.f, 0.f, 0.f};
      if (c >= 2) {
          const int p = c - 2;
          const float kff = 80.f / (-lgf * 128.f), kfb = 80.f / (-lgb * 128.f); const int kcf = kff < 64.f ? (int)kff + 1 : 64, kcb = kfb < 64.f ? (int)kfb + 1 : 64;
          const int nf = c < kcf ? c : kcf, nb_ = (33 - p) < kcb ? (33 - p) : kcb;
          const float* sf = STh + kd * 64 + e4;
          for (int k0 = 0; k0 < nf; k0 += 8) { f32x4 v[8];
#pragma unroll
              for (int j = 0; j < 8; ++j) { const int k = k0 + j; const int cp = k < nf ? c - 1 - k : 0; v[j] = *(const f32x4*)(sf + (size_t)(cp * 2 + 0) * 2048); }
#pragma unroll
              for (int j = 0; j < 8; ++j) { const int k = k0 + j; const float wgt = k < nf ? __builtin_amdgcn_exp2f(lgf * 128.f * (float)k) : 0.f; rf += v[j] * wgt; } }
          for (int k0 = 0; k0 < nb_; k0 += 8) { f32x4 v[8];
#pragma unroll
              for (int j = 0; j < 8; ++j) { const int k = k0 + j; const int pp = k < nb_ ? p + 1 + k : 33; const int cs = pp < 32 ? pp + 2 : pp - 32; v[j] = *(const f32x4*)(sf + (size_t)(cs * 2 + 1) * 2048); }
#pragma unroll
              for (int j = 0; j < 8; ++j) { const int k = k0 + j; const float wgt = k < nb_ ? __builtin_amdgcn_exp2f(lgb * 128.f * (float)k) : 0.f; rb += v[j] * wgt; } }
      } else if (c == 0) { rb = *(const f32x4*)(STh + (size_t)(1 * 2 + 1) * 2048 + kd * 64 + e4); }
      else { rf = *(const f32x4*)(STh + (size_t)(0 * 2 + 0) * 2048 + kd * 64 + e4); }
#pragma unroll
      for (int j = 0; j < 4; ++j) { rtf[(e4 + j) * RP + kd] = f2bf(rf[j]); rtb[(e4 + j) * RP + kd] = f2bf(rb[j]); } }
    f32x4 s[8];
#pragma unroll
    for (int nb = 0; nb < 8; ++nb) s[nb] = __builtin_amdgcn_mfma_f32_16x16x32_bf16(qa, kfr[nb], (f32x4){0.f, 0.f, 0.f, 0.f}, 0, 0, 0);
#pragma unroll
    for (int nb = 0; nb < 8; ++nb)
#pragma unroll
        for (int r = 0; r < 4; ++r) { const int i = i0 + fq * 4 + r, j = nb * 16 + fr; const int df = i - j;
            const float mk = df > 0 ? exp2f(lgf * (float)df) : (df < 0 ? exp2f(lgb * (float)(-df)) : 2.f);
            as[(fq * 4 + r) * AP + j] = f2bf(s[nb][r] * mk); }
    __syncthreads();
    f32x4 y[4];
#pragma unroll
    for (int eb = 0; eb < 4; ++eb) y[eb] = (f32x4){0.f, 0.f, 0.f, 0.f};
#pragma unroll
    for (int ks = 0; ks < 4; ++ks) { const bf16x8 af = *(const LAS bf16x8*)(as + fr * AP + ks * 32 + fq * 8);
#pragma unroll
        for (int eb = 0; eb < 4; ++eb) { const bf16x8 bv = *(const LAS bf16x8*)(vt + (eb * 16 + fr) * TP + ks * 32 + fq * 8);
            y[eb] = __builtin_amdgcn_mfma_f32_16x16x32_bf16(af, bv, y[eb], 0, 0, 0); } }
    { const float xf = exp2f(lgf * (float)(i0 + fr + 1)), xb = exp2f(lgb * (float)(128 - (i0 + fr)));
      bf16x8 qf, qb;
#pragma unroll
      for (int j = 0; j < 8; ++j) { const float qv = bf2f((bf16_t)qa[j]); qf[j] = (short)f2bf(qv * xf); qb[j] = (short)f2bf(qv * xb); }
#pragma unroll
      for (int eb = 0; eb < 4; ++eb) { const bf16x8 bf_ = *(const LAS bf16x8*)(rtf + (eb * 16 + fr) * RP + fq * 8), bb_ = *(const LAS bf16x8*)(rtb + (eb * 16 + fr) * RP + fq * 8);
          y[eb] = __builtin_amdgcn_mfma_f32_16x16x32_bf16(qf, bf_, y[eb], 0, 0, 0);
          y[eb] = __builtin_amdgcn_mfma_f32_16x16x32_bf16(qb, bb_, y[eb], 0, 0, 0); } }
#pragma unroll
    for (int r = 0; r < 4; ++r) {
        float sm = y[0][r] + y[1][r] + y[2][r] + y[3][r]; sm = row16_sum(sm); const float mu = sm * (1.f / 64.f);
        float vs = 0.f;
#pragma unroll
        for (int eb = 0; eb < 4; ++eb) { const float d = y[eb][r] - mu; vs += d * d; }
        vs = row16_sum(vs); const float rstd = rsqrtf(vs * (1.f / 64.f) + LN_EPS);
        const int i = i0 + fq * 4 + r; const int tp = tpos0 + i; const size_t grow = tp >= CTXL ? (size_t)b * SEQ + (tp - CTXL) : (size_t)NLAT + b * CTXL + tp;
#pragma unroll
        for (int eb = 0; eb < 4; ++eb) { const int e = eb * 16 + fr; const float g = __builtin_amdgcn_cvt_f32_fp8((int)gv[r][eb], 0) * 0.0625f;
            OAB[grow * D + 512 + h * 64 + e] = (unsigned char)(pk4_fp8(clamp8(silu_f(g) * (y[eb][r] - mu) * rstd * 16.f), 0.f, 0.f, 0.f) & 0xffu); }
    }
}
namespace att {
constexpr int NW = 8, QBLK = 32, KVBLK = 64;
constexpr int SHM_K = KVBLK * 128, SHM_V = 128 * 64;
constexpr size_t SHM_ATTN = 4 * SHM_K + 3 * SHM_V + 2048;
constexpr float THR = 1.9f, PSH = 6.f, THR2 = THR * 1.4426950408889634f;
#define SBAR() __builtin_amdgcn_sched_barrier(0)
typedef int i32x8a __attribute__((ext_vector_type(8))); typedef int i32x4a __attribute__((ext_vector_type(4)));
template <int SC> struct Scale { static constexpr float S = SC == 0 ? 0.08838834764831845f : 0.10206207261596575f; static constexpr float C = S * 1.4426950408889634f; static constexpr float THRR = THR / S; };
#define KSWZ8(row, chunk) ((row) * 128 + ((((chunk) ^ (((row) >> 1) & 7))) << 4))
#define VSWZ8(col, chunk) ((col) * 64 + ((((chunk) ^ (((col) >> 2) & 3))) << 4))
#define MF8(A, B, C) mf8x<ABL>(A, B, C)
#define CAT8(lo, hi) __builtin_shufflevector(lo, hi, 0, 1, 2, 3, 4, 5, 6, 7)
#define LDS16(p) ((ABL & 8) ? __builtin_shufflevector(qr8[0], qr8[1], 0, 1, 10, 11) : *(const LAS i32x4a*)(p))
template <int A, int B, int ABL = 0> __device__ __forceinline__ void exp_rng(f32x16& p) {
#pragma unroll
  for (int r = A; r < B; ++r) p[r] = (ABL & 1) ? p[r] * p[r] : __builtin_amdgcn_exp2f(p[r]);
}
template <int ABL> __device__ __forceinline__ f32x16 mf8x(const i32x8a a, const i32x8a b, f32x16 c) {
  if constexpr (ABL & 2) { c[0] += __int_as_float(((a[0] ^ a[4]) + (b[0] ^ b[4])) & 0x3f000000); return c; }
  else return __builtin_amdgcn_mfma_scale_f32_32x32x64_f8f6f4(a, b, c, 0, 0, 0, 0x7F7F7F7F, 0, 0x7F7F7F7F);
}
__device__ __forceinline__ void pk_fma16(f32x16& p, float c, float d) { const f32x2 c2 = {c, c}, d2 = {d, d};
#pragma unroll
  for (int i = 0; i < 8; ++i) { f32x2 v = {p[2 * i], p[2 * i + 1]}; v = v * c2 + d2; p[2 * i] = v.x; p[2 * i + 1] = v.y; }
}
__device__ __forceinline__ void pk_add16(f32x16& p, float c) { const f32x2 c2 = {c, c};
#pragma unroll
  for (int i = 0; i < 8; ++i) { f32x2 v = {p[2 * i], p[2 * i + 1]}; v = v + c2; p[2 * i] = v.x; p[2 * i + 1] = v.y; }
}
__device__ __forceinline__ void pk_mul16(f32x16& p, float c) { const f32x2 c2 = {c, c};
#pragma unroll
  for (int i = 0; i < 8; ++i) { f32x2 v = {p[2 * i], p[2 * i + 1]}; v = v * c2; p[2 * i] = v.x; p[2 * i + 1] = v.y; }
}
__device__ __forceinline__ float pk_sum32(const f32x16& p0, const f32x16& p1) { f32x2 s0 = {p0[0], p0[1]}, s1 = {p1[0], p1[1]};
#pragma unroll
  for (int i = 1; i < 8; ++i) { s0 += (f32x2){p0[2 * i], p0[2 * i + 1]}; s1 += (f32x2){p1[2 * i], p1[2 * i + 1]}; }
  s0 += s1; return s0.x + s0.y;
}
__device__ __forceinline__ float hsum(float v) { auto rr = __builtin_amdgcn_permlane32_swap(__float_as_uint(v), __float_as_uint(v), false, false); return __uint_as_float(rr[0]) + __uint_as_float(rr[1]); }
__device__ __forceinline__ float hmax(float v) { auto rr = __builtin_amdgcn_permlane32_swap(__float_as_uint(v), __float_as_uint(v), false, false); return fmaxf(__uint_as_float(rr[0]), __uint_as_float(rr[1])); }
template <int NDV, int SC, int ABL>
__device__ __forceinline__ void attn_body(const unsigned char* __restrict__ Qb, const unsigned char* __restrict__ Kh, const unsigned char* __restrict__ Vt,
                                          unsigned char* __restrict__ Ob, int seq, LAS unsigned char* lds, const int tid) {
  constexpr int ldo = 2048;
  const int wid = __builtin_amdgcn_readfirstlane(tid >> 6), lane = tid & 63, r32 = lane & 31, hi = lane >> 5;
  LAS unsigned char* K_lds = lds; LAS unsigned char* V_lds = lds + 4 * SHM_K;
  constexpr bool LSUM = true, PF = (NDV == 2); constexpr int NO = NDV + (LSUM ? 1 : 0);
  float l_reg = 0; f32x16 o[NO] = {}; f32x16 negm; i32x8a qr8[2];
  LAS unsigned char* ones_lds = lds + 4 * SHM_K + 3 * SHM_V;
  i32x8a vones_r; { const int w1_ = r32 == 0 ? 0x38383838 : 0;
#pragma unroll
    for (int i = 0; i < 8; ++i) vones_r[i] = w1_; }
  if constexpr (NDV == 4) { int t4_ = tid; asm volatile("" : "+v"(t4_));
    const int w1_ = t4_ < 4 ? 0x38383838 : 0; if (t4_ < 128) *(LAS i32x4a*)(ones_lds + t4_ * 16) = (i32x4a){w1_, w1_, w1_, w1_}; }
#define VONES() (NDV == 4 ? CAT8(LDS16(ones_lds + r32 * 64 + hi * 32), LDS16(ones_lds + r32 * 64 + hi * 32 + 16)) : vones_r)
  const unsigned char* Qw = Qb + (long)(wid * QBLK + r32) * 128 + hi * 32;
#pragma unroll
  for (int blk = 0; blk < 2; ++blk) { const i32x4a lo_ = *reinterpret_cast<const i32x4a*>(Qw + blk * 64), hi_ = *reinterpret_cast<const i32x4a*>(Qw + blk * 64 + 16); qr8[blk] = CAT8(lo_, hi_); }
  const int NT = seq / KVBLK;
  const int kr8 = 8 * wid + (lane >> 3), vcol = 16 * (wid & (NDV * 2 - 1)) + (lane >> 2);
  const unsigned char* kgp = Kh + (long)kr8 * 128 + (((lane & 7) ^ ((kr8 >> 1) & 7)) << 4);
  const unsigned char* vgp = Vt + (long)vcol * TT + (((lane & 3) ^ ((vcol >> 2) & 3)) << 4);
  const int kdo = wid * 1024, vdo = (wid & (NDV * 2 - 1)) * 1024;
  const int ka0 = KSWZ8(r32, 2 * hi), ka1 = KSWZ8(r32, 2 * hi + 1), va0 = VSWZ8(r32, 2 * hi), va1 = VSWZ8(r32, 2 * hi + 1);
#define DMAK(t, bo) do { const int t_ = (t) < NT ? (t) : NT - 1; __builtin_amdgcn_global_load_lds((const unsigned*)(kgp + (long)t_ * (KVBLK * 128)), (LAS unsigned*)(K_lds + (bo) + kdo), 16, 0, 0); } while (0)
#define DMAV(t, bo) do { const int t_ = (t) < NT ? (t) : NT - 1; __builtin_amdgcn_global_load_lds((const unsigned*)(vgp + t_ * KVBLK), (LAS unsigned*)(V_lds + (bo) + vdo), 16, 0, 0); } while (0)
#define VMW(n) asm volatile("s_waitcnt vmcnt(" #n ")" ::: "memory")
#define BAR() __builtin_amdgcn_s_barrier()
  f32x16 pA0, pA1, pB0, pB1; float alA, alB; i32x8a pa;
#define PSM2(p0, p1, al) do { float pm_ = fmaxf(p0[0], p1[0]);                                                                          \
    _Pragma("unroll") for (int r = 1; r < 16; ++r) pm_ = fmaxf(fmaxf(pm_, p0[r]), p1[r]);                                               \
    pm_ = hmax(pm_); al = 1.f;                                                                                                           \
    if (__builtin_expect(!__all(pm_ <= PSH + THR2), 0)) { const float d_ = fmaxf(pm_ - PSH, 0.f); al = __builtin_amdgcn_exp2f(-d_); pk_add16(p0, -d_); pk_add16(p1, -d_); pk_add16(negm, -d_); } } while (0)
#define PT3(x, y, z) asm volatile("" : "+v"(x), "+v"(y), "+v"(z))
#define PT4(x, y, z, w) asm volatile("" : "+v"(x), "+v"(y), "+v"(z), "+v"(w))
#define STEP(j, pc0, pc1, alc, pn0, pn1, aln) do { const LAS unsigned char* Kr_ = K_lds + kb_rd; const LAS unsigned char* Vs_ = V_lds + vb_rd;  \
    i32x8a kc_ = CAT8(LDS16(Kr_ + (ka0 ^ 64)), LDS16(Kr_ + (ka1 ^ 64))), kd_ = CAT8(LDS16(Kr_ + 4096 + (ka0 ^ 64)), LDS16(Kr_ + 4096 + (ka1 ^ 64))); \
    if constexpr (!PF) { kpa = CAT8(LDS16(Kr_ + ka0), LDS16(Kr_ + ka1)); kpb = CAT8(LDS16(Kr_ + 4096 + ka0), LDS16(Kr_ + 4096 + ka1)); }              \
    pn0 = MF8(kpa, qr8[0], negm); exp_rng<0, 6, ABL>(pc1); PT3(pn0, pc1, kpb);                                                     \
    pn1 = MF8(kpb, qr8[0], negm); exp_rng<6, 12, ABL>(pc1); PT3(pn1, pc1, kc_);                                                    \
    pn0 = MF8(kc_, qr8[1], pn0); exp_rng<12, 16, ABL>(pc1);                                                                              \
    if constexpr (!LSUM) { float ps_ = pk_sum32(pc0, pc1); ps_ = hsum(ps_); l_reg = l_reg * alc + ps_; }                                   \
    i32x8a va_ = CAT8(LDS16(Vs_ + va0), LDS16(Vs_ + va1)), vb_ = CAT8(LDS16(Vs_ + 2048 + va0), LDS16(Vs_ + 2048 + va1));                  \
    PT4(pn0, pc1, kd_, l_reg);                                                                                                           \
    pn1 = MF8(kd_, qr8[1], pn1);                                                                                                         \
    _Pragma("unroll") for (int q = 0; q < 4; ++q) { pa[q] = (int)pk4_fp8(pc0[4 * q], pc0[4 * q + 1], pc0[4 * q + 2], pc0[4 * q + 3]); pa[4 + q] = (int)pk4_fp8(pc1[4 * q], pc1[4 * q + 1], pc1[4 * q + 2], pc1[4 * q + 3]); } \
    PT3(pn1, pa, va_);                                                                                                                   \
    if constexpr (!(ABL & 128)) { DMAK((j) + 4, kb_wr); DMAV((j) + 2, vb_wr); }                                                          \
    o[0] = MF8(va_, pa, o[0]); PSM2(pn0, pn1, aln); PT3(o[0], pn0, vb_);                                                  \
    o[1] = MF8(vb_, pa, o[1]); exp_rng<0, 4, ABL>(pn0);                                   \
    if constexpr (NDV == 4) { i32x8a vc_ = CAT8(LDS16(Vs_ + 4096 + va0), LDS16(Vs_ + 4096 + va1)), vd_ = CAT8(LDS16(Vs_ + 6144 + va0), LDS16(Vs_ + 6144 + va1)); \
      PT4(o[1], pn0, pn1, vc_); o[2] = MF8(vc_, pa, o[2]); exp_rng<4, 10, ABL>(pn0); PT3(o[2], pn0, vd_);                                \
      o[3] = MF8(vd_, pa, o[3]); exp_rng<10, 14, ABL>(pn0); PT3(o[3], pn0, pn1); o[4] = MF8(VONES(), pa, o[4]); exp_rng<14, 16, ABL>(pn0); }      \
    else { PT3(o[1], pn0, pn1); o[2] = MF8(VONES(), pa, o[2]); exp_rng<4, 10, ABL>(pn0); PT3(o[2], pn0, pn1); exp_rng<10, 16, ABL>(pn0); }    \
    if constexpr (PF) { const LAS unsigned char* Kp_ = K_lds + kb_pf; kpa = CAT8(LDS16(Kp_ + ka0), LDS16(Kp_ + ka1)); kpb = CAT8(LDS16(Kp_ + 4096 + ka0), LDS16(Kp_ + 4096 + ka1)); } \
    PT3(o[NO - 1], pn0, pn1); RESC(aln);                                                                                               \
    { const int t_ = kb_rd; kb_rd = kb_pf; kb_pf = kb_x; kb_x = kb_wr; kb_wr = t_; const int u_ = vb_rd; vb_rd = vb_n1; vb_n1 = vb_wr; vb_wr = u_; } \
    VMW(2); if constexpr (!(ABL & 4)) BAR(); } while (0)
#define RESC(a) do { if (__any((a) < 1.f)) { _Pragma("unroll") for (int d = 0; d < NO; ++d) pk_mul16(o[d], (a)); } } while (0)
  i32x8a kpa, kpb; int kb_rd = SHM_K, kb_pf = 2 * SHM_K, kb_x = 3 * SHM_K, kb_wr = 0, vb_rd = 0, vb_n1 = SHM_V, vb_wr = 2 * SHM_V;
  DMAK(0, 0); DMAK(1, SHM_K); DMAK(2, 2 * SHM_K); DMAK(3, 3 * SHM_K); DMAV(0, 0); DMAV(1, SHM_V); VMW(0); BAR();
  { const LAS unsigned char* Ks_ = K_lds;
    pA0 = MF8(CAT8(LDS16(Ks_ + ka0), LDS16(Ks_ + ka1)), qr8[0], (f32x16){}); pA1 = MF8(CAT8(LDS16(Ks_ + 4096 + ka0), LDS16(Ks_ + 4096 + ka1)), qr8[0], (f32x16){});
    pA0 = MF8(CAT8(LDS16(Ks_ + (ka0 ^ 64)), LDS16(Ks_ + (ka1 ^ 64))), qr8[1], pA0); pA1 = MF8(CAT8(LDS16(Ks_ + 4096 + (ka0 ^ 64)), LDS16(Ks_ + 4096 + (ka1 ^ 64))), qr8[1], pA1);
    float pm_ = fmaxf(pA0[0], pA1[0]);
#pragma unroll
    for (int r = 1; r < 16; ++r) pm_ = fmaxf(fmaxf(pm_, pA0[r]), pA1[r]);
    pm_ = hmax(pm_);
    const float nv_ = PSH - pm_; pk_add16(pA0, nv_); pk_add16(pA1, nv_);
#pragma unroll
    for (int r = 0; r < 16; ++r) negm[r] = nv_;
    alA = 1.f; exp_rng<0, 16, ABL>(pA0);
    if constexpr (PF) { const LAS unsigned char* Kp_ = K_lds + SHM_K; kpa = CAT8(LDS16(Kp_ + ka0), LDS16(Kp_ + ka1)); kpb = CAT8(LDS16(Kp_ + 4096 + ka0), LDS16(Kp_ + 4096 + ka1)); } }
  asm volatile("s_waitcnt lgkmcnt(0)" ::: "memory"); BAR();
  int j = 0;
  for (; j + 2 < NT; j += 2) { STEP(j, pA0, pA1, alA, pB0, pB1, alB); STEP(j + 1, pB0, pB1, alB, pA0, pA1, alA); }
  STEP(j, pA0, pA1, alA, pB0, pB1, alB);
  { exp_rng<0, 16, ABL>(pB1); if constexpr (!LSUM) { float ps_ = pk_sum32(pB0, pB1); ps_ = hsum(ps_); l_reg = l_reg * alB + ps_; }
#pragma unroll
    for (int q = 0; q < 4; ++q) { pa[q] = (int)pk4_fp8(pB0[4 * q], pB0[4 * q + 1], pB0[4 * q + 2], pB0[4 * q + 3]); pa[4 + q] = (int)pk4_fp8(pB1[4 * q], pB1[4 * q + 1], pB1[4 * q + 2], pB1[4 * q + 3]); }
    const LAS unsigned char* Vs_ = V_lds + vb_rd;
#pragma unroll
    for (int d0 = 0; d0 < NDV; ++d0) o[d0] = MF8(CAT8(LDS16(Vs_ + d0 * 2048 + va0), LDS16(Vs_ + d0 * 2048 + va1)), pa, o[d0]);
    if constexpr (LSUM) { o[NDV] = MF8(VONES(), pa, o[NDV]); l_reg = hsum(o[NDV][0]); } }
  const float rl = __builtin_amdgcn_rcpf(l_reg) * 16.f;
  unsigned char* Ow = Ob + (long)(wid * QBLK + r32) * ldo + 4 * hi;
#pragma unroll
  for (int d0 = 0; d0 < NDV; ++d0)
#pragma unroll
    for (int g = 0; g < 4; ++g) *(unsigned*)(Ow + d0 * 32 + 8 * g) = pk4_fp8(clamp8(o[d0][4 * g] * rl), clamp8(o[d0][4 * g + 1] * rl), clamp8(o[d0][4 * g + 2] * rl), clamp8(o[d0][4 * g + 3] * rl));
#undef DMAK
#undef DMAV
#undef VMW
#undef BAR
#undef PSM2
#undef VONES
#undef REGION_X
#undef REGION_Y
#undef RESC
#undef STEP
#undef PT3
#undef PT4
}
}
__device__ __forceinline__ float* xres_row(const Frame& F, int row) { return row < NLAT ? F.out + (size_t)row * D : wsp<float>(F, WS_XC) + (size_t)(row - NLAT) * D; }
__device__ __forceinline__ void ln_row(float (&y)[32], const float* g, const float* b, int lane) {
    float s = 0.f;
#pragma unroll
    for (int i = 0; i < 32; ++i) s += y[i];
    const float mu = wave_sum(s) * (1.f / 2048.f);
    float q = 0.f;
#pragma unroll
    for (int i = 0; i < 32; ++i) { const float d = y[i] - mu; q += d * d; }
    const float rstd = rsqrtf(wave_sum(q) * (1.f / 2048.f) + LN_EPS);
#pragma unroll
    for (int qq = 0; qq < 4; ++qq) { const f32x4 g0 = *(const f32x4*)(g + 512 * qq + 8 * lane), g1 = *(const f32x4*)(g + 512 * qq + 8 * lane + 4), b0 = *(const f32x4*)(b + 512 * qq + 8 * lane), b1 = *(const f32x4*)(b + 512 * qq + 8 * lane + 4);
#pragma unroll
        for (int i = 0; i < 4; ++i) { y[qq * 8 + i] = (y[qq * 8 + i] - mu) * rstd * g0[i] + b0[i]; y[qq * 8 + 4 + i] = (y[qq * 8 + 4 + i] - mu) * rstd * g1[i] + b1[i]; } }
}
__device__ __forceinline__ void modulate_store(const float (&x)[32], const float* sh, const float* sc, bf16_t* dst, int lane) {
#pragma unroll
    for (int q = 0; q < 4; ++q) { const f32x4 h0 = *(const f32x4*)(sh + 512 * q + 8 * lane), h1 = *(const f32x4*)(sh + 512 * q + 8 * lane + 4), c0 = *(const f32x4*)(sc + 512 * q + 8 * lane), c1 = *(const f32x4*)(sc + 512 * q + 8 * lane + 4);
        f32x4 a, b;
#pragma unroll
        for (int i = 0; i < 4; ++i) { a[i] = x[q * 8 + i] * (1.f + c0[i]) + h0[i]; b[i] = x[q * 8 + 4 + i] * (1.f + c1[i]) + h1[i]; }
        *(u32x4*)(dst + 512 * q + 8 * lane) = pack8(a, b); }
}
__device__ __forceinline__ void p_ln1(const Frame& F, int l, bool last) {
    const float* mod = wsp<float>(F, WS_MOD) + (size_t)l * 5 * 12288; bf16_t* hb = wsp<bf16_t>(F, WS_HB);
    const float* g = F.in(18) + l * D; const float* b = F.in(19) + l * D;
    const int nrows = last ? NLAT : NROW; const int lane = F.lane, step = F.G * 8;
    float gg[32], bb[32]; ld_row_f32(g, lane, gg); ld_row_f32(b, lane, bb);
    int row = F.bid * 8 + F.wave;
    float yn[32];
    bf16_t* S1 = wsp<bf16_t>(F, WS_S1);
    if (row < nrows) ld_row_bf16(S1 + (size_t)row * D, lane, yn);
#pragma unroll 1
    for (; row < nrows; row += step) {
        const int v = row < NLAT ? (row >> 12) : 4; bf16_t* xp = S1 + (size_t)row * D;
        float y[32], sh[32], sc[32];
#pragma unroll
        for (int i = 0; i < 32; ++i) y[i] = yn[i];
        ld_row_f32(mod + (size_t)v * 12288 + 6144, lane, sh); ld_row_f32(mod + (size_t)v * 12288 + 8192, lane, sc);
        { const int nrow = row + step; if (nrow < nrows) ld_row_bf16(S1 + (size_t)nrow * D, lane, yn); }
        float s = 0.f;
#pragma unroll
        for (int i = 0; i < 32; ++i) s += y[i];
        const float mu = wave_sum(s) * (1.f / 2048.f); float q = 0.f;
#pragma unroll
        for (int i = 0; i < 32; ++i) { const float d = y[i] - mu; q += d * d; }
        const float rstd = rsqrtf(wave_sum(q) * (1.f / 2048.f) + LN_EPS);
#pragma unroll
        for (int i = 0; i < 32; ++i) y[i] = (y[i] - mu) * rstd * gg[i] + bb[i];
        st_row_bf16(xp, lane, y);
#pragma unroll
        for (int i = 0; i < 32; ++i) y[i] = y[i] * (1.f + sc[i]) + sh[i];
        st_row_bf16(hb + (size_t)row * D, lane, y);
    }
}

template <int NV>
__device__ __forceinline__ void top16(const float (&val)[NV], bool (&sel)[NV], int (&slot)[NV]) {
    unsigned key[NV];
#pragma unroll
    for (int v = 0; v < NV; ++v) { const unsigned u = __float_as_uint(val[v]); key[v] = (u & 0x80000000u) ? ~u : (u | 0x80000000u); }
    unsigned T = 0u;
#pragma unroll 1
    for (int bit = 31; bit >= 0; --bit) {
        const unsigned cand = T | (1u << bit); int cnt = 0;
#pragma unroll
        for (int v = 0; v < NV; ++v) cnt += __popcll(__ballot(key[v] >= cand));
        if (cnt >= 16) T = cand;
    }
    int ngt = 0;
#pragma unroll
    for (int v = 0; v < NV; ++v) ngt += __popcll(__ballot(key[v] > T));
    const int need = 16 - ngt;
    int run = 0, erun = 0;
#pragma unroll
    for (int v = 0; v < NV; ++v) {
        const unsigned long long mg = __ballot(key[v] > T), me = __ballot(key[v] == T);
        const int pg = __builtin_amdgcn_mbcnt_hi((unsigned)(mg >> 32), __builtin_amdgcn_mbcnt_lo((unsigned)mg, 0u));
        const int pe = __builtin_amdgcn_mbcnt_hi((unsigned)(me >> 32), __builtin_amdgcn_mbcnt_lo((unsigned)me, 0u));
        sel[v] = false; slot[v] = 0;
        if (key[v] > T) { sel[v] = true; slot[v] = run + pg; }
        else if (key[v] == T && (erun + pe) < need) { sel[v] = true; slot[v] = ngt + erun + pe; }
        run += __popcll(mg); erun += __popcll(me);
    }
}
__device__ __forceinline__ unsigned f2key(float f) { const unsigned u = __float_as_uint(f); return (u & 0x80000000u) ? ~u : (u | 0x80000000u); }
__device__ __forceinline__ float key2f(unsigned k) { return __uint_as_float((k & 0x80000000u) ? (k & 0x7fffffffu) : ~k); }
template <int NP, int NV>
__device__ __forceinline__ void bisect16(const unsigned (&key)[NP][NV], unsigned (&T)[NP]) {
    bool done[NP];
#pragma unroll
    for (int p = 0; p < NP; ++p) { T[p] = 0u; done[p] = false; }
#pragma unroll 1
    for (int bit = 31; bit >= 0; --bit) {
        const unsigned bm = 1u << bit; bool all = true;
#pragma unroll
        for (int p = 0; p < NP; ++p) {
            const unsigned cand = T[p] | bm; int cnt = 0;
#pragma unroll
            for (int v = 0; v < NV; ++v) cnt += __popcll(__ballot(key[p][v] >= cand));
            const bool upd = (cnt >= 16) && !done[p];
            T[p] = upd ? cand : T[p]; done[p] = done[p] || (cnt == 16); all = all && done[p];
        }
        if (all) break;
    }
}
template <int NV>
__device__ __forceinline__ void compact16(const unsigned (&key)[NV], const unsigned T, bool (&sel)[NV], int (&slot)[NV]) {
    int ngt = 0;
#pragma unroll
    for (int v = 0; v < NV; ++v) ngt += __popcll(__ballot(key[v] > T));
    const int need = 16 - ngt; int run = 0, erun = 0;
#pragma unroll
    for (int v = 0; v < NV; ++v) {
        const unsigned long long mg = __ballot(key[v] > T), me = __ballot(key[v] == T);
        const int pg = __builtin_amdgcn_mbcnt_hi((unsigned)(mg >> 32), __builtin_amdgcn_mbcnt_lo((unsigned)mg, 0u));
        const int pe = __builtin_amdgcn_mbcnt_hi((unsigned)(me >> 32), __builtin_amdgcn_mbcnt_lo((unsigned)me, 0u));
        sel[v] = false; slot[v] = 0;
        if (key[v] > T) { sel[v] = true; slot[v] = run + pg; }
        else if (key[v] == T && (erun + pe) < need) { sel[v] = true; slot[v] = ngt + erun + pe; }
        run += __popcll(mg); erun += __popcll(me);
    }
}
constexpr int KP = 68;
constexpr int PW_BYTES = 9344;
__device__ __forceinline__ float gelu_erf(float x) {
    const float z = fabsf(x) * 0.7071067811865476f; const float t = __builtin_amdgcn_rcpf(1.f + 0.3275911f * z);
    float p = 1.061405429f; p = p * t - 1.453152027f; p = p * t + 1.421413741f; p = p * t - 0.284496736f; p = p * t + 0.254829592f; p = p * t;
    const float er = 1.f - p * __expf(-z * z);
    return 0.5f * x * (1.f + (x < 0.f ? -er : er));
}
__device__ __forceinline__ float wave_max(float x) {
    x = row16_max(x);
    { auto r = __builtin_amdgcn_permlane16_swap(__float_as_uint(x), __float_as_uint(x), false, false); x = fmaxf(__uint_as_float(r[0]), __uint_as_float(r[1])); }
    { auto r = __builtin_amdgcn_permlane32_swap(__float_as_uint(x), __float_as_uint(x), false, false); x = fmaxf(__uint_as_float(r[0]), __uint_as_float(r[1])); }
    return x;
}
__device__ __forceinline__ void ld16_f32(const float* p, int lane, float (&x)[32]) {
#pragma unroll
    for (int q = 0; q < 2; ++q)
#pragma unroll
        for (int d = 0; d < 4; ++d) { const f32x4 a = *(const f32x4*)(p + 1024 * q + 16 * lane + 4 * d); x[q * 16 + d * 4 + 0] = a[0]; x[q * 16 + d * 4 + 1] = a[1]; x[q * 16 + d * 4 + 2] = a[2]; x[q * 16 + d * 4 + 3] = a[3]; }
}
__device__ __forceinline__ void ld16_f32_nt(const float* p, int lane, float (&x)[32]) {
#pragma unroll
    for (int q = 0; q < 2; ++q)
#pragma unroll
        for (int d = 0; d < 4; ++d) { const f32x4 a = __builtin_nontemporal_load((const f32x4*)(p + 1024 * q + 16 * lane + 4 * d)); x[q * 16 + d * 4 + 0] = a[0]; x[q * 16 + d * 4 + 1] = a[1]; x[q * 16 + d * 4 + 2] = a[2]; x[q * 16 + d * 4 + 3] = a[3]; }
}
__device__ __forceinline__ void st16_f32_nt(float* p, int lane, const float (&x)[32]) {
#pragma unroll
    for (int q = 0; q < 2; ++q)
#pragma unroll
        for (int d = 0; d < 4; ++d) __builtin_nontemporal_store((f32x4){x[q * 16 + d * 4 + 0], x[q * 16 + d * 4 + 1], x[q * 16 + d * 4 + 2], x[q * 16 + d * 4 + 3]}, (f32x4*)(p + 1024 * q + 16 * lane + 4 * d));
}
__device__ __forceinline__ void st16_f32(float* p, int lane, const float (&x)[32]) {
#pragma unroll
    for (int q = 0; q < 2; ++q)
#pragma unroll
        for (int d = 0; d < 4; ++d) *(f32x4*)(p + 1024 * q + 16 * lane + 4 * d) = (f32x4){x[q * 16 + d * 4 + 0], x[q * 16 + d * 4 + 1], x[q * 16 + d * 4 + 2], x[q * 16 + d * 4 + 3]};
}
__device__ __forceinline__ void ld16_bf16(const bf16_t* p, int lane, float (&x)[32]) {
#pragma unroll
    for (int q = 0; q < 2; ++q)
#pragma unroll
        for (int d = 0; d < 2; ++d) { const u32x4 w = *(const u32x4*)(p + 1024 * q + 16 * lane + 8 * d); float* o = &x[q * 16 + d * 8];
            o[0] = bflo(w.x); o[1] = bfhi(w.x); o[2] = bflo(w.y); o[3] = bfhi(w.y); o[4] = bflo(w.z); o[5] = bfhi(w.z); o[6] = bflo(w.w); o[7] = bfhi(w.w); }
}
__device__ __forceinline__ void st16_bf16(bf16_t* p, int lane, const float (&x)[32]) {
#pragma unroll
    for (int q = 0; q < 2; ++q)
#pragma unroll
        for (int d = 0; d < 2; ++d) { const float* o = &x[q * 16 + d * 8]; u32x4 w; w.x = cvt_pk_bf16(o[0], o[1]); w.y = cvt_pk_bf16(o[2], o[3]); w.z = cvt_pk_bf16(o[4], o[5]); w.w = cvt_pk_bf16(o[6], o[7]);
            *(u32x4*)(p + 1024 * q + 16 * lane + 8 * d) = w; }
}
constexpr int TBS = 1152;
__device__ __forceinline__ void ld_row_f32(int lane, const float* __restrict__ src, f32x4* a) {
#pragma unroll
    for (int q = 0; q < 2; ++q)
#pragma unroll
        for (int d = 0; d < 4; ++d) a[q * 4 + d] = __builtin_nontemporal_load((const f32x4*)(src + 1024 * q + 16 * lane + 4 * d));
}
__device__ __forceinline__ void cvt_row_fp4b(int lane, const f32x4* a, unsigned char* __restrict__ dst) {
    float x[32];
#pragma unroll
    for (int i = 0; i < 8; ++i) { x[i * 4 + 0] = a[i][0]; x[i * 4 + 1] = a[i][1]; x[i * 4 + 2] = a[i][2]; x[i * 4 + 3] = a[i][3]; }
    float am = 0.f;
#pragma unroll
    for (int i = 0; i < 32; ++i) am = fmaxf(am, fabsf(x[i]));
    const bf16_t sb = f2bf(am * (1.f / 6.f)); const float sf = bf2f(sb); const float sc = sf > 0.f ? __builtin_amdgcn_rcpf(sf) : 0.f;
    u32x4 w;
#pragma unroll
    for (int d = 0; d < 4; ++d) { unsigned t = 0u; const int o = (d >> 1) * 16 + (d & 1) * 8;
        t = __builtin_amdgcn_cvt_scalef32_pk_fp4_f32(t, x[o + 0] * sc, x[o + 1] * sc, 1.0f, 0); t = __builtin_amdgcn_cvt_scalef32_pk_fp4_f32(t, x[o + 2] * sc, x[o + 3] * sc, 1.0f, 1);
        t = __builtin_amdgcn_cvt_scalef32_pk_fp4_f32(t, x[o + 4] * sc, x[o + 5] * sc, 1.0f, 2); t = __builtin_amdgcn_cvt_scalef32_pk_fp4_f32(t, x[o + 6] * sc, x[o + 7] * sc, 1.0f, 3); w[d] = t; }
    *(u32x4*)(dst + 16 * lane) = w;
    *(bf16_t*)(dst + 1024 + 2 * lane) = sb;
}
__device__ __forceinline__ void cvt_row_fp4r(int lane, const float* __restrict__ src, unsigned char* __restrict__ dst, float* __restrict__ inv) {
    float x[32];
#pragma unroll
    for (int q = 0; q < 2; ++q)
#pragma unroll
        for (int d = 0; d < 4; ++d) { const f32x4 a = __builtin_nontemporal_load((const f32x4*)(src + 1024 * q + 16 * lane + 4 * d)); x[q * 16 + d * 4 + 0] = a[0]; x[q * 16 + d * 4 + 1] = a[1]; x[q * 16 + d * 4 + 2] = a[2]; x[q * 16 + d * 4 + 3] = a[3]; }
    float am = 0.f;
#pragma unroll
    for (int i = 0; i < 32; ++i) am = fmaxf(am, fabsf(x[i]));
    am = wave_max(am);
    const float sc = am > 0.f ? 6.f / am : 1.f;
    if (lane == 0) *inv = am > 0.f ? am * (1.f / 6.f) : 1.f;
    u32x4 w;
#pragma unroll
    for (int d = 0; d < 4; ++d) { unsigned t = 0u; const int o = (d >> 1) * 16 + (d & 1) * 8;
        t = __builtin_amdgcn_cvt_scalef32_pk_fp4_f32(t, x[o + 0] * sc, x[o + 1] * sc, 1.0f, 0); t = __builtin_amdgcn_cvt_scalef32_pk_fp4_f32(t, x[o + 2] * sc, x[o + 3] * sc, 1.0f, 1);
        t = __builtin_amdgcn_cvt_scalef32_pk_fp4_f32(t, x[o + 4] * sc, x[o + 5] * sc, 1.0f, 2); t = __builtin_amdgcn_cvt_scalef32_pk_fp4_f32(t, x[o + 6] * sc, x[o + 7] * sc, 1.0f, 3); w[d] = t; }
    *(u32x4*)(dst + 16 * lane) = w;
}
__device__ __forceinline__ void cvt_peer(const Frame& F, int l) {
    const int step = F.G * 8; int r = F.bid * 8 + F.wave;
    f32x4 cur[8], nxt[8];
    auto srcp = [&](int rr) { return (rr < 16384 ? F.in(23) : F.in(24)) + ((size_t)l * 16384 + (rr & 16383)) * 2048; };
    if (r < 32768) ld_row_f32(F.lane, srcp(r), cur);
    for (; r < 32768; r += step) {
        const int rn = r + step;
        if (rn < 32768) ld_row_f32(F.lane, srcp(rn), nxt);
        cvt_row_fp4b(F.lane, cur, wsp<unsigned char>(F, r < 16384 ? WS_PU : WS_PV) + (size_t)l * SZ_PT + (size_t)(r & 16383) * TBS);
#pragma unroll
        for (int i = 0; i < 8; ++i) cur[i] = nxt[i];
    }
}
#define PEER_G 4
template <int CTRL> __device__ __forceinline__ int dppi(int x) { return __builtin_amdgcn_update_dpp(0, x, CTRL, 0xF, 0xF, true); }
__device__ __forceinline__ int irow16_sum(int x) { x += dppi<0xB1>(x); x += dppi<0x4E>(x); x += dppi<0x141>(x); x += dppi<0x140>(x); return x; }
__device__ __forceinline__ int irow16_incl_scan(int x) { x += dppi<0x111>(x); x += dppi<0x112>(x); x += dppi<0x114>(x); x += dppi<0x118>(x); return x; }
constexpr int KBP = 72;
constexpr int PT_WORDS = 6 * 128 + 160 + 3 * 128;
constexpr int PWB = 2 * PT_WORDS * 4;
__device__ __forceinline__ void p_peer(const Frame& F, int l, bool last) {
    LAS bf16_t* kb1 = (LAS bf16_t*)F.lds; LAS bf16_t* kb2 = kb1 + 128 * KBP;
    LAS unsigned* wbase = (LAS unsigned*)(F.lds + 2 * 128 * KBP * 2 + F.wave * PWB);
    const int lane = F.lane, fr = lane & 15, fq = lane >> 4;
    __syncthreads();
    for (int i = F.tid; i < 128 * 64; i += 512) { const int r = i >> 6, d = i & 63; kb1[r * KBP + d] = f2bf(F.in(21)[(size_t)l * 8192 + i]); kb2[r * KBP + d] = f2bf(F.in(22)[(size_t)l * 8192 + i]); }
    __syncthreads();
    const bf16_t* QP = wsp<bf16_t>(F, WS_QP); const bf16_t* HB = wsp<bf16_t>(F, WS_HB); unsigned char* HB8w = wsp<unsigned char>(F, WS_HB8);
    const unsigned char* PU = wsp<unsigned char>(F, WS_PU) + (size_t)l * SZ_PT; const unsigned char* PV = wsp<unsigned char>(F, WS_PV) + (size_t)l * SZ_PT;
    const float* modl = wsp<float>(F, WS_MOD) + (size_t)l * 5 * 12288; const float* modn = wsp<float>(F, WS_MOD) + (size_t)(l + 1) * 5 * 12288;
    const float* g2n = F.in(25) + l * D; const float* b2n = F.in(26) + l * D;
    const int npairs = (last ? NLAT : NROW) / 2;
    const int per_wg = (npairs + F.G - 1) / F.G; const int p_lo = F.bid * per_wg; const int p_hi = (p_lo + per_wg) < npairs ? (p_lo + per_wg) : npairs;
    LAS int* wq = (LAS int*)(F.lds + 147456 - 32);
    if (F.tid == 0) *wq = 0;
    __syncthreads();
#pragma unroll 1
    for (;;) {
        int pi = 0; if (lane == 0) pi = __hip_atomic_fetch_add(wq, 1, __ATOMIC_RELAXED, __HIP_MEMORY_SCOPE_WORKGROUP);
        pi = p_lo + __builtin_amdgcn_readfirstlane(pi); if (pi >= p_hi) break;
        const int rowA = 2 * pi;
#pragma unroll 1
        for (int rep1_ = 0; rep1_ <= REP_PS1; ++rep1_) {
            unsigned kk[2][8][4];
            { int fr_ = fr; asm volatile("" : "+v"(fr_));
              const bf16_t* qrow = QP + (size_t)(rowA + (fr_ >> 3)) * 1024 + (fr_ & 7) * 128 + 8 * fq;
              bf16x8 af[2][2];
#pragma unroll
              for (int st = 0; st < 2; ++st)
#pragma unroll
                  for (int ks = 0; ks < 2; ++ks) af[st][ks] = *(const bf16x8*)(qrow + st * 64 + ks * 32);
#pragma unroll
              for (int st = 0; st < 2; ++st) { LAS bf16_t* kb = st ? kb2 : kb1;
#pragma unroll
                  for (int nb = 0; nb < 8; ++nb) { f32x4 c = {0.f, 0.f, 0.f, 0.f};
#pragma unroll
                      for (int ks = 0; ks < 2; ++ks) { const bf16x8 bfr = *(const LAS bf16x8*)(kb + (nb * 16 + fr) * KBP + ks * 32 + 8 * fq); c = __builtin_amdgcn_mfma_f32_16x16x32_bf16(af[st][ks], bfr, c, 0, 0, 0); }
#pragma unroll
                      for (int r = 0; r < 4; ++r) kk[st][nb][r] = f2key(c[r]); } } }
            unsigned T[2][4]; bool done[2][4];
#pragma unroll
            for (int st = 0; st < 2; ++st)
#pragma unroll
                for (int r = 0; r < 4; ++r) { T[st][r] = 0u; done[st][r] = false; }
#pragma unroll 1
            for (int bit = ((PS1_ABL & 1) && rep1_ < REP_PS1) ? -1 : 31; bit >= 0; --bit) { const unsigned bm = 1u << bit; bool alld = true;
#pragma unroll
                for (int st = 0; st < 2; ++st)
#pragma unroll
                    for (int r = 0; r < 4; ++r) { const unsigned cand = T[st][r] | bm; int c = 0;
#pragma unroll
                        for (int nb = 0; nb < 8; ++nb) c += (kk[st][nb][r] >= cand) ? 1 : 0;
                        c = irow16_sum(c);
                        const bool upd = (c >= 16) && !done[st][r]; T[st][r] = upd ? cand : T[st][r]; done[st][r] = done[st][r] || (c == 16); alld = alld && done[st][r]; }
                if (__all(alld)) break; }
            const int tt = lane >> 5, hd0 = ((lane >> 4) & 1) * 4;
            if (!((PS1_ABL & 2) && rep1_ < REP_PS1))
#pragma unroll
            for (int st = 0; st < 2; ++st)
#pragma unroll
                for (int r = 0; r < 4; ++r) { const unsigned Tr = T[st][r]; int g = 0, e = 0;
#pragma unroll
                    for (int nb = 0; nb < 8; ++nb) { g += (kk[st][nb][r] > Tr) ? 1 : 0; e += (kk[st][nb][r] == Tr) ? 1 : 0; }
                    int gpre = irow16_incl_scan(g) - g, epre = irow16_incl_scan(e) - e; const int ngt = irow16_sum(g); const int need = 16 - ngt;
                    LAS unsigned* tb = wbase + tt * PT_WORDS; LAS float* vl = (LAS float*)(tb + st * 128) + (hd0 + r) * 16; LAS int* il = (LAS int*)(tb + 256 + st * 128) + (hd0 + r) * 16;
#pragma unroll
                    for (int nb = 0; nb < 8; ++nb) { const unsigned k = kk[st][nb][r];
                        if (k > Tr) { vl[gpre] = key2f(k); il[gpre] = nb * 16 + fr; ++gpre; }
                        else if (k == Tr) { if (epre < need) { vl[ngt + epre] = key2f(k); il[ngt + epre] = nb * 16 + fr; } ++epre; } } }
        }
        asm volatile("s_waitcnt lgkmcnt(0)" ::: "memory");
        {
            const int tt = lane >> 5, hd0 = ((lane >> 4) & 1) * 4; LAS unsigned* tb = wbase + tt * PT_WORDS;
            unsigned ck[4][16];
#pragma unroll
            for (int r = 0; r < 4; ++r) { const float va = ((LAS float*)tb)[(hd0 + r) * 16 + fr]; const LAS float* v2p = (LAS float*)(tb + 128) + (hd0 + r) * 16;
#pragma unroll
                for (int j4 = 0; j4 < 4; ++j4) { const f32x4 vb = *(const LAS f32x4*)(v2p + j4 * 4);
#pragma unroll
                    for (int i = 0; i < 4; ++i) ck[r][j4 * 4 + i] = f2key(va + vb[i]); } }
            unsigned T[4]; bool done[4];
#pragma unroll
            for (int r = 0; r < 4; ++r) { T[r] = 0u; done[r] = false; }
#pragma unroll 1
            for (int bit = 31; bit >= 0; --bit) { const unsigned bm = 1u << bit; bool alld = true;
#pragma unroll
                for (int r = 0; r < 4; ++r) { const unsigned cand = T[r] | bm; int c = 0;
#pragma unroll
                    for (int j = 0; j < 16; ++j) c += (ck[r][j] >= cand) ? 1 : 0;
                    c = irow16_sum(c);
                    const bool upd = (c >= 16) && !done[r]; T[r] = upd ? cand : T[r]; done[r] = done[r] || (c == 16); alld = alld && done[r]; }
                if (__all(alld)) break; }
#pragma unroll
            for (int r = 0; r < 4; ++r) { const unsigned Tr = T[r]; int g = 0, e = 0;
#pragma unroll
                for (int j = 0; j < 16; ++j) { g += (ck[r][j] > Tr) ? 1 : 0; e += (ck[r][j] == Tr) ? 1 : 0; }
                int gpre = irow16_incl_scan(g) - g, epre = irow16_incl_scan(e) - e; const int ngt = irow16_sum(g); const int need = 16 - ngt;
                const int e1 = ((LAS int*)(tb + 256))[(hd0 + r) * 16 + fr] * 128; const LAS int* i2p = (LAS int*)(tb + 384) + (hd0 + r) * 16;
                LAS float* cs_ = (LAS float*)(tb + 512) + (hd0 + r) * 16; LAS int* ce_ = (LAS int*)(tb + 640) + (hd0 + r) * 16;
#pragma unroll
                for (int j = 0; j < 16; ++j) { const unsigned k = ck[r][j];
                    if (k > Tr) { cs_[gpre] = key2f(k); ce_[gpre] = e1 + i2p[j]; ++gpre; }
                    else if (k == Tr) { if (epre < need) { cs_[ngt + epre] = key2f(k); ce_[ngt + epre] = e1 + i2p[j]; } ++epre; } } }
        }
        asm volatile("s_waitcnt lgkmcnt(0)" ::: "memory");
#pragma unroll 1
      for (int t = 0; t < 2; ++t) {
        const int row = rowA + t; const int v = row < NLAT ? (row >> 12) : 4;
        LAS unsigned* tb = wbase + t * PT_WORDS;
        LAS float* v1l = (LAS float*)tb; LAS float* v2l = v1l + 128; LAS int* i1l = (LAS int*)(v2l + 128); LAS int* i2l = i1l + 128;
        LAS float* csl = (LAS float*)(i2l + 128); LAS int* cel = (LAS int*)(csl + 128); LAS int* el = cel + 128; LAS float* gl = (LAS float*)(el + 160); LAS float* su = gl + 128; LAS float* sv = su + 128;
        {
#pragma unroll
            for (int it = 0; it < 2; ++it) { const int idx = it * 64 + lane;
                const float sx = csl[idx]; const float mx = row16_max(sx); const float pe_ = __expf(sx - mx); const float sm = row16_sum(pe_);
                el[idx] = cel[idx]; gl[idx] = pe_ / sm; }
        }
        if (lane < 32) el[128 + lane] = el[0];
        asm volatile("s_waitcnt vmcnt(0) lgkmcnt(0)" ::: "memory");
        const bool b0_ = lane & 1, b1_ = lane & 2, b2_ = lane & 4;
        u32x4 A[8], B[8], C[8]; unsigned SA[8], SB[8], SC[8];
#define PEER_LOADT(buf, sbuf, tab, g) do { _Pragma("unroll") for (int x = 0; x < 8; ++x) { const int e = __builtin_amdgcn_readfirstlane(el[(g) * 8 + x]); const unsigned char* rp = (tab) + (size_t)e * TBS; \
            buf[x] = *(const u32x4*)(rp + 16 * lane); sbuf[x] = *(const bf16_t*)(rp + 1024 + 2 * lane); } } while (0)
#define PEER_LOADV(buf, g) do { _Pragma("unroll") for (int x = 0; x < 8; ++x) { const int e = __builtin_amdgcn_readfirstlane(el[(g) * 8 + x]); buf[x] = *(const u32x4*)(PV + (size_t)e * 1024 + 16 * lane); } } while (0)
#define FP4X8(w_, f0_, f1_, f2_, f3_) const f32x2 f0_ = __builtin_amdgcn_cvt_scalef32_pk_f32_fp4(w_, 1.0f, 0), f1_ = __builtin_amdgcn_cvt_scalef32_pk_f32_fp4(w_, 1.0f, 1), f2_ = __builtin_amdgcn_cvt_scalef32_pk_f32_fp4(w_, 1.0f, 2), f3_ = __builtin_amdgcn_cvt_scalef32_pk_f32_fp4(w_, 1.0f, 3)
#define PEER_DOT(buf, sbuf, g) do { float p_[8]; \
            _Pragma("unroll") for (int x = 0; x < 8; ++x) { f32x2 s2_ = {0.f, 0.f}; \
                _Pragma("unroll") for (int d = 0; d < 4; ++d) { const unsigned w_ = buf[x][d]; FP4X8(w_, f0_, f1_, f2_, f3_); const int o_ = (d >> 1) * 8 + (d & 1) * 4; \
                    s2_ = hh2[o_ + 0] * f0_ + s2_; s2_ = hh2[o_ + 1] * f1_ + s2_; s2_ = hh2[o_ + 2] * f2_ + s2_; s2_ = hh2[o_ + 3] * f3_ + s2_; } \
                p_[x] = (s2_.x + s2_.y) * __uint_as_float(sbuf[x] << 16); SBAR(); } \
              \
            float q_[4], r_[2]; \
            _Pragma("unroll") for (int j = 0; j < 4; ++j) { const float keep_ = b0_ ? p_[2 * j + 1] : p_[2 * j], send_ = b0_ ? p_[2 * j] : p_[2 * j + 1]; q_[j] = keep_ + dppf<0xB1>(send_); } \
            _Pragma("unroll") for (int j = 0; j < 2; ++j) { const float keep_ = b1_ ? q_[2 * j + 1] : q_[2 * j], send_ = b1_ ? q_[2 * j] : q_[2 * j + 1]; r_[j] = keep_ + dppf<0x4E>(send_); } \
            float t_; { const float keep_ = b2_ ? r_[1] : r_[0], send_ = b2_ ? r_[0] : r_[1]; const float up_ = dppf<0x104>(send_), dn_ = dppf<0x114>(send_); t_ = keep_ + (b2_ ? dn_ : up_); } \
            t_ += dppf<0x128>(t_); \
            { auto r16_ = __builtin_amdgcn_permlane16_swap(__float_as_uint(t_), __float_as_uint(t_), false, false); t_ = __uint_as_float(r16_[0]) + __uint_as_float(r16_[1]); } \
            { auto r32_ = __builtin_amdgcn_permlane32_swap(__float_as_uint(t_), __float_as_uint(t_), false, false); t_ = __uint_as_float(r32_[0]) + __uint_as_float(r32_[1]); } \
            const float av = gelu_erf(t_) * gl[(g) * 8 + (lane & 7)]; const bool me_ = (lane >> 3) == ((g) & 7); \
            avl = (me_ && (g) < 8) ? av : avl; avh = (me_ && (g) >= 8) ? av : avh; } while (0)
#define PIN_ACC() do { asm volatile("" : "+v"(acc2[0]), "+v"(acc2[1]), "+v"(acc2[2]), "+v"(acc2[3]), "+v"(acc2[4]), "+v"(acc2[5]), "+v"(acc2[6]), "+v"(acc2[7]), "+v"(acc2[8]), "+v"(acc2[9]), "+v"(acc2[10]), "+v"(acc2[11]), "+v"(acc2[12]), "+v"(acc2[13]), "+v"(acc2[14]), "+v"(acc2[15])); } while (0)
#define PEER_AXPY(buf, sbuf, g) do { _Pragma("unroll") for (int x = 0; x < 8; ++x) { const int idx = (g) * 8 + x; \
            const float av = __uint_as_float(__builtin_amdgcn_readlane(__float_as_uint(idx < 64 ? avl : avh), idx & 63)) * __uint_as_float(sbuf[x] << 16); const f32x2 av2_ = {av, av}; \
            _Pragma("unroll") for (int d = 0; d < 4; ++d) { const unsigned w_ = buf[x][d]; FP4X8(w_, f0_, f1_, f2_, f3_); const int o_ = (d >> 1) * 8 + (d & 1) * 4; \
                acc2[o_ + 0] = av2_ * f0_ + acc2[o_ + 0]; acc2[o_ + 1] = av2_ * f1_ + acc2[o_ + 1]; acc2[o_ + 2] = av2_ * f2_ + acc2[o_ + 2]; acc2[o_ + 3] = av2_ * f3_ + acc2[o_ + 3]; } PIN_ACC(); } } while (0)
        float avl = 0.f, avh = 0.f;
        PEER_LOADT(A, SA, PU, 0); PEER_LOADT(B, SB, PU, 1); SBAR();
        float hh[32]; ld16_bf16(HB + (size_t)row * D, lane, hh);
        f32x2 hh2[16];
#pragma unroll
        for (int i = 0; i < 16; ++i) hh2[i] = (f32x2){hh[2 * i], hh[2 * i + 1]};
#pragma unroll 1
        for (int g = 0; g < 15; g += 3) { PEER_LOADT(C, SC, PU, g + 2); SBAR(); PEER_DOT(A, SA, g); SBAR(); PEER_LOADT(A, SA, PU, g + 3); SBAR(); PEER_DOT(B, SB, g + 1); SBAR();
            PEER_LOADT(B, SB, (g + 4 < 16 ? PU : PV), (g + 4) & 15); SBAR(); PEER_DOT(C, SC, g + 2); SBAR(); }
        PEER_LOADT(C, SC, PV, 1); SBAR();
        PEER_DOT(A, SA, 15); SBAR();
        f32x2 acc2[16];
#pragma unroll
        for (int i = 0; i < 16; ++i) acc2[i] = (f32x2){0.f, 0.f};
#pragma unroll 1
        for (int g = 0; g < 15; g += 3) { PEER_LOADT(A, SA, PV, g + 2); SBAR(); PEER_AXPY(B, SB, g); SBAR(); PEER_LOADT(B, SB, PV, g + 3); SBAR(); PEER_AXPY(C, SC, g + 1); SBAR(); PEER_LOADT(C, SC, PV, g + 4); SBAR(); PEER_AXPY(A, SA, g + 2); SBAR(); }
        float x1[32], g2[32]; ld16_bf16(wsp<bf16_t>(F, WS_S1) + (size_t)row * D, lane, x1); ld16_f32(modl + (size_t)v * 12288 + 10240, lane, g2); SBAR();
        PEER_AXPY(B, SB, 15); SBAR();
#undef PEER_LOADT
#undef PEER_LOADV
#undef PEER_DOT
#undef PEER_AXPY
        float acc[32];
        {
#pragma unroll
          for (int i = 0; i < 32; ++i) acc[i] = ALPHA * x1[i] + g2[i] * acc2[i >> 1][i & 1]; }
        { float sm = 0.f;
#pragma unroll
          for (int i = 0; i < 32; ++i) sm += acc[i];
          const float mu = wave_sum(sm) * (1.f / 2048.f); float qq = 0.f;
#pragma unroll
          for (int i = 0; i < 32; ++i) { const float dd = acc[i] - mu; qq += dd * dd; }
          const float rstd = rsqrtf(wave_sum(qq) * (1.f / 2048.f) + LN_EPS);
#pragma unroll
          for (int q = 0; q < 2; ++q)
#pragma unroll
              for (int d = 0; d < 4; ++d) { const int o = 1024 * q + 16 * lane + 4 * d; const f32x4 gg = *(const f32x4*)(g2n + o), bb = *(const f32x4*)(b2n + o);
#pragma unroll
                  for (int i = 0; i < 4; ++i) acc[q * 16 + d * 4 + i] = (acc[q * 16 + d * 4 + i] - mu) * rstd * gg[i] + bb[i]; } }
        if (last) st16_f32(xres_row(F, row), lane, acc); else st16_bf16(wsp<bf16_t>(F, WS_S1) + (size_t)row * D, lane, acc);
        if (!last) { const float* sh = modn + (size_t)v * 12288; const float* sc = sh + 2048;
#pragma unroll
            for (int q = 0; q < 2; ++q)
#pragma unroll
                for (int d = 0; d < 4; ++d) { const int o = 1024 * q + 16 * lane + 4 * d; const f32x4 hh4 = *(const f32x4*)(sh + o), cc4 = *(const f32x4*)(sc + o);
#pragma unroll
                    for (int i = 0; i < 4; ++i) acc[q * 16 + d * 4 + i] = clamp8(acc[q * 16 + d * 4 + i] * (1.f + cc4[i]) + hh4[i]); }
#pragma unroll
            for (int q = 0; q < 2; ++q) { u32x4 w;
#pragma unroll
                for (int d = 0; d < 4; ++d) w[d] = pk4_fp8(acc[q * 16 + d * 4 + 0], acc[q * 16 + d * 4 + 1], acc[q * 16 + d * 4 + 2], acc[q * 16 + d * 4 + 3]);
                *(u32x4*)(HB8w + (size_t)row * D + 1024 * q + 16 * lane) = w; } }
      }
    }
}
#ifdef DBG
constexpr size_t WS_DBG = WS_CTL + 131072;
constexpr int DBG_NS = 60;
__device__ __forceinline__ int dbg_row(int s) { return (s * 263 + 5) % NLAT; }
__global__ void __launch_bounds__(256) dbg_peer_pre(Args args, int l) {
    __shared__ float q[1024]; __shared__ float s1[128], s2[128]; __shared__ float v1[16], v2[16]; __shared__ int i1[16], i2[16]; __shared__ float cs[256]; __shared__ int ce[256];
    __shared__ float ts[16]; __shared__ int te[16]; __shared__ float red[256]; __shared__ float aval[128]; __shared__ int eid[128]; __shared__ float h2[2048];
    const int s = blockIdx.x, row = dbg_row(s), tid = threadIdx.x; unsigned char* ws = args.ws;
    const bf16_t* QP = (const bf16_t*)(ws + WS_QP); const bf16_t* HB = (const bf16_t*)(ws + WS_HB);
    float* dbgf = (float*)(ws + WS_DBG + 4096); int* dbge = (int*)(dbgf + DBG_NS * 2048); float* dbga = (float*)(dbge + DBG_NS * 128); float* dbgg = dbga + 3 * DBG_NS * 128;
    for (int i = tid; i < 1024; i += 256) q[i] = bf2f(QP[(size_t)row * 1024 + i]);
    for (int i = tid; i < 2048; i += 256) h2[i] = bf2f(HB[(size_t)row * D + i]);
    __syncthreads();
    const float* k1 = args.in[21] + (size_t)l * 8192; const float* k2 = args.in[22] + (size_t)l * 8192;
    for (int hd = 0; hd < 8; ++hd) {
        { const int k = tid & 127; const float* kk = (tid < 128 ? k1 : k2) + k * 64; const float* qq = q + hd * 128 + (tid < 128 ? 0 : 64); float a = 0.f; for (int d = 0; d < 64; ++d) a += qq[d] * kk[d]; (tid < 128 ? s1 : s2)[k] = a; }
        __syncthreads();
        { const int k = tid & 127; const float* sv = tid < 128 ? s1 : s2; const float me = sv[k]; int rank = 0; for (int j = 0; j < 128; ++j) rank += (sv[j] > me || (sv[j] == me && j < k)) ? 1 : 0;
          if (rank < 16) { (tid < 128 ? v1 : v2)[rank] = me; (tid < 128 ? i1 : i2)[rank] = k; } }
        __syncthreads();
        { const int i = tid >> 4, j = tid & 15; cs[tid] = v1[i] + v2[j]; ce[tid] = i1[i] * 128 + i2[j]; }
        __syncthreads();
        { const float me = cs[tid]; int rank = 0; for (int j = 0; j < 256; ++j) rank += (cs[j] > me || (cs[j] == me && j < tid)) ? 1 : 0; if (rank < 16) { ts[rank] = me; te[rank] = ce[tid]; } }
        __syncthreads();
        if (tid < 16) { float mx = ts[0]; float sm = 0.f; for (int j = 0; j < 16; ++j) sm += expf(ts[j] - mx); aval[hd * 16 + tid] = expf(ts[tid] - mx) / sm; eid[hd * 16 + tid] = te[tid]; dbgg[s * 128 + hd * 16 + tid] = aval[hd * 16 + tid]; }
        __syncthreads();
    }
    const float* U = args.in[23] + (size_t)l * 16384 * 2048; const float* V = args.in[24] + (size_t)l * 16384 * 2048;
    for (int e = 0; e < 128; ++e) { const float* ur = U + (size_t)eid[e] * 2048; float p = 0.f; for (int d = tid; d < 2048; d += 256) p += h2[d] * ur[d]; red[tid] = p; __syncthreads();
        for (int st = 128; st > 0; st >>= 1) { if (tid < st) red[tid] += red[tid + st]; __syncthreads(); }
        if (tid == 0) { const float sc = red[0]; aval[e] = 0.5f * sc * (1.f + erff(sc * 0.70710678f)) * aval[e]; } __syncthreads(); }
    float y[8]; const float* xr = args.out + (size_t)row * D; const int v = row >> 12; const float* mod = (const float*)(ws + WS_MOD) + (size_t)l * 5 * 12288 + (size_t)v * 12288;
    float sum = 0.f;
    for (int k = 0; k < 8; ++k) { const int d = tid + 256 * k; float o = 0.f; for (int e = 0; e < 128; ++e) o += aval[e] * V[(size_t)eid[e] * 2048 + d]; y[k] = ALPHA * xr[d] + mod[10240 + d] * o; sum += y[k]; }
    red[tid] = sum; __syncthreads(); for (int st = 128; st > 0; st >>= 1) { if (tid < st) red[tid] += red[tid + st]; __syncthreads(); } const float mu = red[0] / 2048.f; __syncthreads();
    float sq = 0.f; for (int k = 0; k < 8; ++k) sq += (y[k] - mu) * (y[k] - mu);
    red[tid] = sq; __syncthreads(); for (int st = 128; st > 0; st >>= 1) { if (tid < st) red[tid] += red[tid + st]; __syncthreads(); } const float rstd = rsqrtf(red[0] / 2048.f + LN_EPS);
    for (int k = 0; k < 8; ++k) { const int d = tid + 256 * k; dbgf[(size_t)s * 2048 + d] = (y[k] - mu) * rstd * args.in[25][l * D + d] + args.in[26][l * D + d]; }
    if (tid < 128) { dbge[s * 128 + tid] = eid[tid]; dbga[s * 128 + tid] = aval[tid]; }
}
__global__ void __launch_bounds__(256) dbg_peer_post(Args args) {
    __shared__ int bad_e, bad_x, bad_a, bad_g;
    const int s = blockIdx.x, row = dbg_row(s), tid = threadIdx.x; unsigned char* ws = args.ws; unsigned* cnt = (unsigned*)(ws + WS_DBG);
    float* dbgf = (float*)(ws + WS_DBG + 4096); int* dbge = (int*)(dbgf + DBG_NS * 2048); float* dbga = (float*)(dbge + DBG_NS * 128);
    int* fe = (int*)(dbga + DBG_NS * 128); float* fa = (float*)(fe + DBG_NS * 128); float* dbgg = dbga + 3 * DBG_NS * 128; float* fg = dbgg + DBG_NS * 128;
    if (tid == 0) { bad_e = 0; bad_x = 0; bad_a = 0; bad_g = 0; } __syncthreads();
    if (tid < 128) { const int hd = tid >> 4; const int e = dbge[s * 128 + tid]; bool found = false; float af = 0.f, gf = 0.f; for (int j = 0; j < 16; ++j) if (fe[s * 128 + hd * 16 + j] == e) { found = true; af = fa[s * 128 + hd * 16 + j]; gf = fg[s * 128 + hd * 16 + j]; }
        if (!found) atomicAdd(&bad_e, 1); else { const float ea = dbga[s * 128 + tid]; if (fabsf(af - ea) > 0.02f * fabsf(ea) + 2e-3f) atomicAdd(&bad_a, 1); const float eg = dbgg[s * 128 + tid]; if (fabsf(gf - eg) > 0.02f * fabsf(eg) + 1e-3f) atomicAdd(&bad_g, 1); } }
    for (int k = 0; k < 8; ++k) { const int d = tid + 256 * k; const float ex = dbgf[(size_t)s * 2048 + d], got = args.out[(size_t)row * D + d]; if (!(fabsf(got - ex) <= 0.03f + 0.03f * fabsf(ex))) atomicAdd(&bad_x, 1); }
    __syncthreads();
    if (tid == 0) { if (bad_e > 2) atomicAdd(&cnt[1], 1u); if (bad_g > 2) atomicAdd(&cnt[2], 1u); if (bad_a > 2) atomicAdd(&cnt[3], 1u); if (bad_x > 8) atomicAdd(&cnt[4], 1u); }
}
__global__ void dbg_report(Args args) {
    unsigned* cnt = (unsigned*)(args.ws + WS_DBG);
    float code = 0.f;
    for (int lv = 1; lv <= 9; ++lv) if (cnt[lv]) { int tenths = (int)(cnt[lv] * 10 / DBG_NS); if (tenths > 9) tenths = 9; code = 1000.f * lv + 100.f * tenths; break; }
    if (code != 0.f) for (int i = threadIdx.x; i < 4096; i += blockDim.x) args.out[i] = code;
}
#endif
template <int ABL>
__device__ __forceinline__ void p_attn_gqa(const Frame& F, int last) {
    LAS unsigned char* lds = F.lds;
    const unsigned char* QG = wsp<unsigned char>(F, WS_QG); const unsigned char* KG = wsp<unsigned char>(F, WS_KG); const unsigned char* VG = wsp<unsigned char>(F, WS_VG); unsigned char* OAB = wsp<unsigned char>(F, WS_OAB);
    const int nlat = NB * 8 * 16, nall = last ? nlat : nlat + NB * 8;
    for (int u = F.bid; u < nall; u += F.G) {
        int bh, q0, seq; size_t orow;
        if (u < nlat) {
            int uu = u;
            if (F.G == 256) {
                const int c = u & 255, i = u >> 8, xcd = c & 7, r = c >> 3, kvg = i * 4 + (xcd >> 1), within = (xcd & 1) * 32 + r;
                uu = (((kvg >> 1) * 8 + (kvg & 1) * 4 + (within >> 4)) << 4) | (within & 15); }
            bh = uu >> 4; const int qb = uu & 15; q0 = CTXL + qb * 256; seq = TT; orow = (size_t)(bh >> 3) * SEQ + qb * 256; }
        else { bh = u - nlat; q0 = 0; seq = CTXL; orow = (size_t)NLAT + (bh >> 3) * CTXL; }
        const int b = bh >> 3, h = bh & 7; const size_t kvo = (size_t)(b * 2 + (h >> 2)) * TT * 128;
        __syncthreads();
        att::attn_body<4, 0, ABL>(QG + ((size_t)bh * TT + q0) * 128, KG + kvo, VG + (size_t)(b * 2 + (h >> 2)) * 128 * TT, OAB + orow * D + 1024 + h * 128, seq, lds, F.tid);
    }
    __syncthreads();
}
template <int ABL>
__device__ __forceinline__ void p_attn_mla(const Frame& F, int last) {
    LAS unsigned char* lds = F.lds;
    const unsigned char* QM = wsp<unsigned char>(F, WS_QM); const unsigned char* KM = wsp<unsigned char>(F, WS_KM); const unsigned char* VM = wsp<unsigned char>(F, WS_VM); unsigned char* OAB = wsp<unsigned char>(F, WS_OAB);
    const int nlat = NB * 8 * 16, nall = last ? nlat : nlat + NB * 8;
    for (int u = F.bid; u < nall; u += F.G) {
        int bh, q0, seq; size_t orow;
        if (u < nlat) {
            int uu = u;
            if (F.G == 256) { const int c = u & 255, i = u >> 8, xcd = c & 7, r = c >> 3; uu = ((i * 16 + xcd * 2 + (r >> 4)) << 4) | (r & 15); }
            bh = uu >> 4; const int qb = uu & 15; q0 = CTXL + qb * 256; seq = TT; orow = (size_t)(bh >> 3) * SEQ + qb * 256; }
        else { bh = u - nlat; q0 = 0; seq = CTXL; orow = (size_t)NLAT + (bh >> 3) * CTXL; }
        const int h = bh & 7;
        __syncthreads();
        att::attn_body<2, 1, ABL>(QM + ((size_t)bh * TT + q0) * 128, KM + (size_t)bh * TT * 128, VM + (size_t)bh * 64 * TT, OAB + orow * D + h * 64, seq, lds, F.tid);
    }
    __syncthreads();
}
__device__ __forceinline__ void p_ret_out(const Frame& F, int l, int last) {
    const int c_lo = last ? 2 : 0, nc = 34 - c_lo, nu = NB * 8 * nc;
    for (int u = F.bid; u < nu; u += F.G) { const int bh = u / nc, c = c_lo + (u % nc); ret_out_unit(F, l, bh, c); }
    __syncthreads();
}

constexpr int LDS_BYTES = 147456;
constexpr int MISC_OFF = 147456 - 64;
constexpr int NPHASE = 22;
#ifndef PHM
#define PHM 0xFFFF
#endif
#ifndef PH_ATTR
#define PH_ATTR __forceinline__
#endif
template <int PART> __device__ PH_ATTR void ph_prologue(ArgP ap) { const Frame F = make_frame(ap); p0_prologue<PART>(F); }
__device__ PH_ATTR void ph_modreduce(ArgP ap) { const Frame F = make_frame(ap); p1_modreduce(F); }
__device__ PH_ATTR void ph_modulate0(ArgP ap) { const Frame F = make_frame(ap); p_modulate0(F); }
template <int GABL> __device__ PH_ATTR void ph_gemm_in(ArgP ap, int l) { const Frame F = make_frame(ap);
    pg8::Gemm g{wsp<bf16_t>(F, WS_HB8), wsp<bf16_t>(F, WS_WIN + l * SZ_WIN), NROW, NPT, 1024, 1024, 1024}; pg8::StaticOrder S; S.init(NROW, NPT, F.G, F.bid);
    float mul_, inv_; fp8_scale(wsp<unsigned>(F, WS_WSC)[l], mul_, inv_);
    EpiIn E{wsp<bf16_t>(F, WS_P1), wsp<bf16_t>(F, WS_G), inv_};
    pg8::gemm_phase<EpiIn, pg8::StaticOrder, GABL>(F.lds, F.tid, g, S, E); }
__device__ PH_ATTR void ph_post(ArgP ap, int l) { const Frame F = make_frame(ap); p_post(F, l); if (l == 1) cvt_peer(F, 1); }
__device__ PH_ATTR void ph_qup(ArgP ap, int l) { const Frame F = make_frame(ap);
    pg8::Gemm g{wsp<bf16_t>(F, WS_CQN), wsp<bf16_t>(F, WS_WQUP + l * SZ_WQUP), NROW, 768, 512, 512, 512}; pg8::StaticOrder S; S.init(NROW, 768, F.G, F.bid);
    EpiQup E{wsp<unsigned char>(F, WS_QM), wsp<f32x2>(F, WS_ROPE32)};
    pg8::gemm_phase<EpiQup, pg8::StaticOrder>(F.lds, F.tid, g, S, E); }
__device__ PH_ATTR void ph_kvup(ArgP ap, int l) { const Frame F = make_frame(ap);
    pg8::Gemm g{wsp<bf16_t>(F, WS_CKVN), wsp<bf16_t>(F, WS_WKVUP + l * SZ_WKVUP), NROW, 1024, 256, 256, 256}; pg8::StaticOrder S; S.init(NROW, 1024, F.G, F.bid);
    EpiKvup E{wsp<unsigned char>(F, WS_KM), wsp<unsigned char>(F, WS_VM)};
    pg8::gemm_phase<EpiKvup, pg8::StaticOrder>(F.lds, F.tid, g, S, E); }
__device__ PH_ATTR void ph_states(ArgP ap, int l) { const Frame F = make_frame(ap); p_ret_states(F, l); }
template <int ABL> __device__ PH_ATTR void ph_attn_gqa(ArgP ap, int last) { const Frame F = make_frame(ap); p_attn_gqa<ABL>(F, last); }
template <int ABL> __device__ PH_ATTR void ph_attn_mla(ArgP ap, int last) { const Frame F = make_frame(ap); p_attn_mla<ABL>(F, last); }
__device__ PH_ATTR void ph_ret_out(ArgP ap, int l, int last) { const Frame F = make_frame(ap); p_ret_out(F, l, last); }
template <int SEG> __device__ PH_ATTR void ph_merge(ArgP ap, int l, int Mx) { const Frame F = make_frame(ap);
    const bf16_t* OAB = wsp<bf16_t>(F, WS_OAB); bf16_t* MB = wsp<bf16_t>(F, WS_MB); const bf16_t* G = wsp<bf16_t>(F, WS_G);
    pg8::StaticOrder S; S.init(Mx, 2048, F.G, F.bid);
    const size_t wo = SEG == 0 ? WS_WBRA + l * SZ_WBRA : (SEG == 1 ? WS_WBRB + l * SZ_WBRB : WS_WBRC + l * SZ_WBRC); const int K = SEG == 2 ? 1024 : 512;
    pg8::Gemm g{OAB + SEG * 512, wsp<bf16_t>(F, wo), Mx, 2048, K, 2048, K}; EpiMerge<SEG> E{MB, G, wsp<unsigned char>(F, WS_MB8)}; pg8::gemm_phase<EpiMerge<SEG>, pg8::StaticOrder>(F.lds, F.tid, g, S, E); }
__device__ PH_ATTR void ph_merge3(ArgP ap, int l, int Mx) { const Frame F = make_frame(ap);
    pg8::StaticOrder S; S.init(Mx, 2048, F.G, F.bid);
    float m0_, i0_, m1_, i1_, m2_, i2_; fp8_scale(wsp<unsigned>(F, WS_WSC)[4 + l], m0_, i0_); fp8_scale(wsp<unsigned>(F, WS_WSC)[6 + l], m1_, i1_); fp8_scale(wsp<unsigned>(F, WS_WSC)[8 + l], m2_, i2_);
    pg8::Merge3 g{wsp<bf16_t>(F, WS_OAB), wsp<bf16_t>(F, WS_WBRA + l * SZ_WBRA), wsp<bf16_t>(F, WS_WBRB + l * SZ_WBRB), wsp<bf16_t>(F, WS_WBRC + l * SZ_WBRC), wsp<bf16_t>(F, WS_G), wsp<unsigned char>(F, WS_MB8), i0_ * m1_, i1_ * m2_, i2_};
    pg8::gemm_merge3<pg8::StaticOrder>(F.lds, F.tid, g, S); }
__device__ PH_ATTR void ph_out(ArgP ap, int l, int Mx) { const Frame F = make_frame(ap);
    pg8::Gemm g{wsp<bf16_t>(F, WS_MB8), wsp<bf16_t>(F, WS_WOUT + l * SZ_WOUT), Mx, 2048, 1024, 1024, 1024}; pg8::StaticOrder S; S.init(Mx, 2048, F.G, F.bid);
    float mul_, inv_; fp8_scale(wsp<unsigned>(F, WS_WSC)[2 + l], mul_, inv_);
    if (l == 0) { EpiOutT<false> E{F.in(0), F.in(2), wsp<bf16_t>(F, WS_S1), wsp<float>(F, WS_MOD) + (size_t)l * 5 * 12288 + 4096, inv_ * (1.f / 16.f)}; pg8::gemm_phase<EpiOutT<false>, pg8::StaticOrder>(F.lds, F.tid, g, S, E); }
    else { EpiOutT<true> E{nullptr, nullptr, wsp<bf16_t>(F, WS_S1), wsp<float>(F, WS_MOD) + (size_t)l * 5 * 12288 + 4096, inv_ * (1.f / 16.f)}; pg8::gemm_phase<EpiOutT<true>, pg8::StaticOrder>(F.lds, F.tid, g, S, E); } }
__device__ PH_ATTR void ph_ln1(ArgP ap, int l, int last) { const Frame F = make_frame(ap); p_ln1(F, l, last); }
__device__ PH_ATTR void ph_peerq(ArgP ap, int l, int Mx) { const Frame F = make_frame(ap);
    pg8::Gemm g{wsp<bf16_t>(F, WS_HB), wsp<bf16_t>(F, WS_WPQ + l * SZ_WPQ), Mx, 1024, 2048, 2048, 2048}; pg8::StaticOrder S; S.init(Mx, 1024, F.G, F.bid);
    EpiPlain E{wsp<bf16_t>(F, WS_QP), 1024};
    pg8::gemm_phase<EpiPlain, pg8::StaticOrder>(F.lds, F.tid, g, S, E); }
__device__ PH_ATTR void ph_peer(ArgP ap, int l, int last) { const Frame F = make_frame(ap); p_peer(F, l, last); }

__global__ void __launch_bounds__(512, 2) mega_fwd(Args args) {
    extern __shared__ __attribute__((aligned(16))) unsigned char lds_raw[];
    const ArgP ap = (ArgP)__builtin_amdgcn_kernarg_segment_ptr();
    const int lo = ap->ph_lo, hi = ap->ph_hi;
    volatile LAS unsigned* misc = (volatile LAS unsigned*)((LAS unsigned char*)lds_raw + MISC_OFF);
    if (threadIdx.x < 4) misc[threadIdx.x] = 0u;
    __syncthreads();
    XcdBarrier bar; bar.bar = (unsigned*)(ap->ws + WS_CTL); bar.x = 0; bar.st = misc;
    if (hi - lo > 1) bar = xcd_barrier_post((unsigned*)(ap->ws + WS_CTL), misc);
#ifdef BENCH_K
    { float a[16]; f32x2 b2[8];
#pragma unroll
      for (int i = 0; i < 16; ++i) a[i] = 1.f + threadIdx.x * 1e-3f + i;
#pragma unroll
      for (int i = 0; i < 8; ++i) b2[i] = (f32x2){a[i], a[i + 8]};
      float c0 = a[3], c1 = a[5];
#define B16(INS) asm volatile(INS(0) INS(1) INS(2) INS(3) INS(4) INS(5) INS(6) INS(7) INS(8) INS(9) INS(10) INS(11) INS(12) INS(13) INS(14) INS(15) \
        : "+v"(a[0]), "+v"(a[1]), "+v"(a[2]), "+v"(a[3]), "+v"(a[4]), "+v"(a[5]), "+v"(a[6]), "+v"(a[7]), "+v"(a[8]), "+v"(a[9]), "+v"(a[10]), "+v"(a[11]), "+v"(a[12]), "+v"(a[13]), "+v"(a[14]), "+v"(a[15]) : "v"(c0), "v"(c1))
#define I_ADD(i) "v_add_f32 %" #i ", %" #i ", %16\n"
#define I_EXP(i) "v_exp_f32 %" #i ", %" #i "\n"
#define I_MAX3(i) "v_max3_f32 %" #i ", %" #i ", %16, %17\n"
#define I_CVT(i) "v_cvt_pk_fp8_f32 %" #i ", %16, %17\n"
#define I_DEP(i) "v_max3_f32 %0, %0, %16, %17\n"
#define I_DEPA(i) "v_add_f32 %0, %0, %16\n"
#define I_FMA(i) "v_fma_f32 %" #i ", %" #i ", %16, %17\n"
#define P8(INS) asm volatile(INS(0) INS(1) INS(2) INS(3) INS(4) INS(5) INS(6) INS(7) INS(0) INS(1) INS(2) INS(3) INS(4) INS(5) INS(6) INS(7) \
        : "+v"(b2[0]), "+v"(b2[1]), "+v"(b2[2]), "+v"(b2[3]), "+v"(b2[4]), "+v"(b2[5]), "+v"(b2[6]), "+v"(b2[7]) : "v"(b2[0]))
#define I_PKADD(i) "v_pk_add_f32 %" #i ", %" #i ", %8\n"
#define I_PKFMA(i) "v_pk_fma_f32 %" #i ", %" #i ", %8, %8\n"
#pragma unroll 1
      for (int it = 0; it < 20000; ++it) {
#if BENCH_K == 1
        B16(I_ADD);
#elif BENCH_K == 2
        B16(I_EXP);
#elif BENCH_K == 3
        B16(I_MAX3);
#elif BENCH_K == 4
        B16(I_CVT);
#elif BENCH_K == 5
        P8(I_PKADD);
#elif BENCH_K == 6
        P8(I_PKFMA);
#elif BENCH_K == 7
        B16(I_FMA);
#elif BENCH_K == 9
        B16(I_DEP);
#elif BENCH_K == 10
        B16(I_DEPA);
#endif
      }
#if BENCH_K == 11 || BENCH_K == 12
      { f32x16 q0 = {}, q1 = {}, q2 = {}, q3 = {}; att::i32x8a x8 = {1, 2, 3, 4, 5, 6, 7, (int)threadIdx.x};
#pragma unroll 1
        for (int it = 0; it < 2000; ++it) {
#pragma unroll
          for (int k = 0; k < 4; ++k) {
            q0 = __builtin_amdgcn_mfma_scale_f32_32x32x64_f8f6f4(x8, x8, q0, 0, 0, 0, 0x7F7F7F7F, 0, 0x7F7F7F7F); asm volatile("" : "+v"(q0));
#if BENCH_K == 11
            B16(I_ADD);
#else
            B16(I_EXP);
#endif
            q1 = __builtin_amdgcn_mfma_scale_f32_32x32x64_f8f6f4(x8, x8, q1, 0, 0, 0, 0x7F7F7F7F, 0, 0x7F7F7F7F); asm volatile("" : "+v"(q1));
#if BENCH_K == 11
            B16(I_ADD);
#else
            B16(I_EXP);
#endif
            q2 = __builtin_amdgcn_mfma_scale_f32_32x32x64_f8f6f4(x8, x8, q2, 0, 0, 0, 0x7F7F7F7F, 0, 0x7F7F7F7F); asm volatile("" : "+v"(q2));
#if BENCH_K == 11
            B16(I_ADD);
#else
            B16(I_EXP);
#endif
            q3 = __builtin_amdgcn_mfma_scale_f32_32x32x64_f8f6f4(x8, x8, q3, 0, 0, 0, 0x7F7F7F7F, 0, 0x7F7F7F7F); asm volatile("" : "+v"(q3));
#if BENCH_K == 11
            B16(I_ADD);
#else
            B16(I_EXP);
#endif
          }
          asm volatile("" : "+v"(x8)); } }
#endif
#if BENCH_K == 8
      { f32x16 q0 = {}, q1 = {}, q2 = {}, q3 = {}; att::i32x8a x8 = {1, 2, 3, 4, 5, 6, 7, (int)threadIdx.x};
#pragma unroll 1
        for (int it = 0; it < 2000; ++it) {
#pragma unroll
          for (int k = 0; k < 4; ++k) { q0 = __builtin_amdgcn_mfma_scale_f32_32x32x64_f8f6f4(x8, x8, q0, 0, 0, 0, 0x7F7F7F7F, 0, 0x7F7F7F7F); q1 = __builtin_amdgcn_mfma_scale_f32_32x32x64_f8f6f4(x8, x8, q1, 0, 0, 0, 0x7F7F7F7F, 0, 0x7F7F7F7F);
            q2 = __builtin_amdgcn_mfma_scale_f32_32x32x64_f8f6f4(x8, x8, q2, 0, 0, 0, 0x7F7F7F7F, 0, 0x7F7F7F7F); q3 = __builtin_amdgcn_mfma_scale_f32_32x32x64_f8f6f4(x8, x8, q3, 0, 0, 0, 0x7F7F7F7F, 0, 0x7F7F7F7F); }
          asm volatile("" : "+v"(q0), "+v"(q1), "+v"(q2), "+v"(q3), "+v"(x8)); } }
#endif
    }
#endif
#define IN(k) (lo <= (k) && (k) < hi)
#define SEAM(k) do { if (IN(k) && IN((k) + 1)) xcd_barrier(bar); } while (0)
    if (IN(0)) { if (PHM & 1) ph_prologue<7>(ap); if (REP_PRO) ph_prologue<REP_PRO>(ap); } SEAM(0);
    if (IN(1)) { if (PHM & 2) ph_modreduce(ap); if (REP_X & 32) ph_modreduce(ap); } SEAM(1);
#pragma unroll 1
    for (int l = 0; l < 2; ++l) {
        const int pb = 2 + 10 * l; const int last = (l == 1);
        const int Mx = last ? NLAT : NROW;
        if (l == 0) { if (IN(pb)) { if (PHM & 4) ph_modulate0(ap); if (REP_X & 64) ph_modulate0(ap); } SEAM(pb); }
        if (IN(pb + 1)) { if (REP_GIN) ph_gemm_in<GIN_ABL>(ap, l); if (PHM & 8) ph_gemm_in<0>(ap, l); } SEAM(pb + 1);
        if (IN(pb + 2)) { if (PHM & 16) ph_post(ap, l); if (REP_X & 1) ph_post(ap, l); } SEAM(pb + 2);
        if (IN(pb + 3)) { if (PHM & 32) ph_qup(ap, l); if (PHM & 64) ph_kvup(ap, l); if (PHM & 128) ph_states(ap, l); if (REP_X & 2) { ph_qup(ap, l); ph_kvup(ap, l); ph_states(ap, l); } } SEAM(pb + 3);
        if (IN(pb + 4)) { if (REP_ATTN & 1) ph_attn_gqa<ATT_ABL>(ap, last); if (REP_ATTN & 2) ph_attn_mla<ATT_ABL>(ap, last); if (PHM & 256) ph_attn_gqa<0>(ap, last); if (PHM & 512) ph_attn_mla<0>(ap, last); if (REP_X & 4) ph_ret_out(ap, l, last); if (PHM & 1024) ph_ret_out(ap, l, last); } SEAM(pb + 4);
        if (IN(pb + 5)) { if (PHM & 2048) { if (MERGE3) ph_merge3(ap, l, Mx); else { ph_merge<0>(ap, l, Mx); ph_merge<1>(ap, l, Mx); ph_merge<2>(ap, l, Mx); } } if (REP_X & 8) { if (MERGE3) ph_merge3(ap, l, Mx); else { ph_merge<0>(ap, l, Mx); ph_merge<1>(ap, l, Mx); ph_merge<2>(ap, l, Mx); } } } SEAM(pb + 5);
        if (IN(pb + 6)) { if (PHM & 4096) ph_out(ap, l, Mx); if (REP_X & 128) ph_out(ap, l, Mx); } SEAM(pb + 6);
        if (IN(pb + 7)) { if (PHM & 8192) ph_ln1(ap, l, last); if (REP_X & 256) ph_ln1(ap, l, last); } SEAM(pb + 7);
        if (IN(pb + 8)) { if (PHM & 16384) ph_peerq(ap, l, Mx); if (REP_X & 16) ph_peerq(ap, l, Mx); } SEAM(pb + 8);
        if (IN(pb + 9)) { if (PHM & 32768) ph_peer(ap, l, last); } SEAM(pb + 9);
    }
#undef IN
#undef SEAM
}

extern "C" void kernel_launch(void* const* d_in, const int* in_sizes, int n_in, void* d_out, int out_size, void* d_ws, size_t ws_size, hipStream_t stream) {
    static int grid = 0;
    if (grid == 0) {
        if (n_in != 27 || out_size != NLAT * D || ws_size < WS_END) { fprintf(stderr, "kernel_launch: unexpected shapes: n_in %d out %d ws %zu (need %zu)\n", n_in, out_size, ws_size, (size_t)WS_END); grid = -1; return; }
        int dev = 0, cus = 0, per_cu = 0;
        if (hipGetDevice(&dev) != hipSuccess || hipDeviceGetAttribute(&cus, hipDeviceAttributeMultiprocessorCount, dev) != hipSuccess) { grid = -1; return; }
        if (hipFuncSetAttribute((const void*)mega_fwd, hipFuncAttributeMaxDynamicSharedMemorySize, LDS_BYTES) != hipSuccess) { fprintf(stderr, "kernel_launch: hipFuncSetAttribute failed\n"); grid = -1; return; }
        if (hipOccupancyMaxActiveBlocksPerMultiprocessor(&per_cu, (const void*)mega_fwd, 512, LDS_BYTES) != hipSuccess || per_cu < 1) fprintf(stderr, "kernel_launch: occupancy query reports %d\n", per_cu);
        (void)hipGetLastError();
        grid = cus;
    }
    if (grid < 0) return;
    (void)hipMemsetAsync((char*)d_ws + WS_CTL, 0, 65536, stream);
#ifdef DBG
    (void)hipMemsetAsync((char*)d_ws + WS_CTL + 131072, 0, 4096, stream);
#endif
    Args a{};
    for (int i = 0; i < 27; ++i) a.in[i] = (const float*)d_in[i];
    a.out = (float*)d_out; a.ws = (unsigned char*)d_ws;
#if MK_PER_PHASE
    for (int p = 0; p < NPHASE; ++p) { if (p == 12) continue; a.ph_lo = p; a.ph_hi = p + 1;
#ifdef DBG
        if (p == 11) hipLaunchKernelGGL(dbg_peer_pre, dim3(DBG_NS), dim3(256), 0, stream, a, 0);
#endif
        hipLaunchKernelGGL(mega_fwd, dim3(grid), dim3(512), LDS_BYTES, stream, a);
#ifdef DBG
        if (p == 11) hipLaunchKernelGGL(dbg_peer_post, dim3(DBG_NS), dim3(256), 0, stream, a);
#endif
    }
#ifdef DBG
    hipLaunchKernelGGL(dbg_report, dim3(1), dim3(256), 0, stream, a);
#endif
#else
    a.ph_lo = 0; a.ph_hi = NPHASE;
    hipLaunchKernelGGL(mega_fwd, dim3(grid), dim3(512), LDS_BYTES, stream, a);
#endif
    const hipError_t le = hipPeekAtLastError();
    if (le != hipSuccess) fprintf(stderr, "kernel_launch: launch failed: %s\n", hipGetErrorName(le));
}
```

```cpp
#include <hip/hip_runtime.h>
#include <cstdio>
#include <cstdint>
#include <cstddef>

#ifndef MK_PER_PHASE
#define MK_PER_PHASE 0
#endif

#ifndef ABL_PEER
#define ABL_PEER 0
#endif
#ifndef REP_PEERG
#define REP_PEERG 0
#endif
#ifndef REP_PEERH
#define REP_PEERH 0
#endif
#ifndef REP_X
#define REP_X 0
#endif
#ifndef REP_PS1
#define REP_PS1 0
#endif
#ifndef REP_PS2
#define REP_PS2 0
#endif
#ifndef SIDE_ON
#define SIDE_ON 1
#endif
#ifndef REP_DOT
#define REP_DOT 0
#endif
#ifndef MERGE3
#define MERGE3 1
#endif
#ifndef REP_GIN
#define REP_GIN 0
#endif
#ifndef PS1_ABL
#define PS1_ABL 0
#endif
#ifndef GIN_ABL
#define GIN_ABL 0
#endif
#ifndef ATT_ABL
#define ATT_ABL 0
#endif
#ifndef REP_ATTN
#define REP_ATTN 0
#endif
#ifndef REP_PRO
#define REP_PRO 0
#endif
#ifndef ABL_BR
#define ABL_BR 0
#endif
#ifndef ABL_MIX
#define ABL_MIX 0
#endif
#define LAS __attribute__((address_space(3)))
typedef unsigned short bf16_t;
typedef short bf16x8 __attribute__((ext_vector_type(8)));
typedef short s16x4 __attribute__((ext_vector_type(4)));
typedef float f32x2 __attribute__((ext_vector_type(2)));
typedef float f32x4 __attribute__((ext_vector_type(4)));
typedef float f32x8 __attribute__((ext_vector_type(8)));
typedef float f32x16 __attribute__((ext_vector_type(16)));
typedef unsigned u32x2 __attribute__((ext_vector_type(2)));
typedef unsigned u32x4 __attribute__((ext_vector_type(4)));
typedef __bf16 bf2_t __attribute__((ext_vector_type(2)));

constexpr int D = 2048, NB = 4, SEQ = 4096, CTXL = 256, TT = SEQ + CTXL;
constexpr int NLAT = NB * SEQ, NCTX = NB * CTXL, NROW = NLAT + NCTX;
constexpr int NP1 = 4096, NG = 6144, NPT = NP1 + NG;
constexpr int NIN = 10016;
constexpr float ALPHA = 1.4142135623730951f;
constexpr float LN_EPS = 1e-5f, RMS_EPS = 1e-6f;
constexpr float LOG2E = 1.4426950408889634f;
constexpr int C_CQ = 0, C_CKV = 512, C_GQ = 768, C_GK = 1792, C_GV = 2048, C_RQ = 2304, C_RK = 2560, C_RV = 2816, C_RG = 3328, C_KR = 3840;

constexpr size_t AL(size_t x) { return (x + 255) / 256 * 256; }
constexpr size_t WS_CTL = 0;                                    constexpr size_t CTL_BYTES = 1u << 20;
constexpr size_t WS_WSC = WS_CTL + 32768;
constexpr size_t WS_CVT = WS_CTL + 33024;
constexpr size_t WS_DEC = WS_CTL + 65536;
constexpr size_t WS_ROPE32 = WS_CTL + CTL_BYTES;
constexpr size_t WS_ROPE128 = WS_ROPE32 + AL(64 * 8 * 8);
constexpr size_t WS_MODP = WS_ROPE128 + AL(64 * 32 * 8);
constexpr size_t WS_MOD = WS_MODP + AL((size_t)16 * 2 * 5 * 12288 * 4);
constexpr size_t WS_WIN = WS_MOD + AL((size_t)2 * 5 * 12288 * 4);
constexpr size_t SZ_WIN = (size_t)NPT * D;
constexpr size_t WS_WQUP = WS_WIN + 2 * SZ_WIN;                 constexpr size_t SZ_WQUP = (size_t)768 * 512 * 2;
constexpr size_t WS_WKVUP = WS_WQUP + 2 * SZ_WQUP;              constexpr size_t SZ_WKVUP = (size_t)1024 * 256 * 2;
constexpr size_t WS_WBRA = WS_WKVUP + 2 * SZ_WKVUP;             constexpr size_t SZ_WBRA = (size_t)2048 * 512 * 2;
constexpr size_t WS_WBRB = WS_WBRA + 2 * SZ_WBRA;               constexpr size_t SZ_WBRB = SZ_WBRA;
constexpr size_t WS_WBRC = WS_WBRB + 2 * SZ_WBRB;               constexpr size_t SZ_WBRC = (size_t)2048 * 1024 * 2;
constexpr size_t WS_WOUT = WS_WBRC + 2 * SZ_WBRC;               constexpr size_t SZ_WOUT = (size_t)2048 * 2048 * 2;
constexpr size_t WS_WPQ = WS_WOUT + 2 * SZ_WOUT;                constexpr size_t SZ_WPQ = (size_t)1024 * 2048 * 2;
constexpr size_t WS_PSC = WS_WPQ + 2 * SZ_WPQ;
constexpr size_t WS_PU = WS_PSC + (size_t)4 * 16384 * 4;        constexpr size_t SZ_PT = (size_t)16384 * 1152;
constexpr size_t WS_PV = WS_PU + 2 * SZ_PT;
constexpr size_t WS_XC = WS_PV + 2 * SZ_PT;
constexpr size_t WS_HB = WS_XC + (size_t)NCTX * D * 4;
constexpr size_t WS_P1 = WS_HB + (size_t)NROW * D * 2;
constexpr size_t WS_G = WS_P1 + (size_t)NROW * NP1 * 2;
constexpr size_t WS_CQN = WS_G + (size_t)NROW * NG * 2;
constexpr size_t WS_CKVN = WS_CQN + (size_t)NROW * 512 * 2;
constexpr size_t WS_QM = WS_CKVN + (size_t)NROW * 256 * 2;
constexpr size_t SZ_Q128 = (size_t)NB * 8 * TT * 128 * 2;
constexpr size_t WS_KM = WS_QM + SZ_Q128;
constexpr size_t WS_VM = WS_KM + SZ_Q128;
constexpr size_t WS_QG = WS_VM + SZ_Q128 / 2;
constexpr size_t WS_KG = WS_QG + SZ_Q128;
constexpr size_t WS_VG = WS_KG + SZ_Q128 / 4;
constexpr size_t WS_RQ = WS_VG + SZ_Q128 / 4;
constexpr size_t WS_RK = WS_RQ + SZ_Q128 / 4;
constexpr size_t WS_RV = WS_RK + SZ_Q128 / 4;
constexpr size_t WS_ST = WS_RV + SZ_Q128 / 2;
constexpr size_t WS_OAB = WS_ST + (size_t)NB * 8 * 34 * 2 * 2048 * 4;
constexpr size_t WS_HB8 = WS_OAB + (size_t)NROW * D * 2;
constexpr size_t WS_MB8 = WS_HB8 + (size_t)NROW * D;
constexpr size_t WS_S1 = WS_MB8 + (size_t)NROW * D;
constexpr size_t WS_END = WS_S1 + (size_t)NROW * D * 2;
constexpr size_t WS_MB = WS_QM;
constexpr size_t WS_QP = WS_QG;
static_assert((size_t)NROW * D * 2 <= 2 * SZ_Q128, "MB alias");
static_assert((size_t)NROW * 1024 * 2 <= SZ_Q128, "QP alias");

__device__ __forceinline__ unsigned cvt_pk_bf16(float lo, float hi) { unsigned r; asm volatile("v_cvt_pk_bf16_f32 %0, %1, %2" : "=v"(r) : "v"(lo), "v"(hi)); return r; }
__device__ __forceinline__ bf16_t f2bf(float f) { return (bf16_t)(cvt_pk_bf16(f, 0.f) & 0xffffu); }
__device__ __forceinline__ float bf2f(bf16_t b) { return __uint_as_float(((unsigned)b) << 16); }
__device__ __forceinline__ float bflo(unsigned w) { return __uint_as_float(w << 16); }
__device__ __forceinline__ float bfhi(unsigned w) { return __uint_as_float(w & 0xffff0000u); }
template <int CTRL> __device__ __forceinline__ float dppf(float x) { return __int_as_float(__builtin_amdgcn_update_dpp(0, __float_as_int(x), CTRL, 0xF, 0xF, true)); }
__device__ __forceinline__ float row16_sum(float x) { x += dppf<0xB1>(x); x += dppf<0x4E>(x); x += dppf<0x141>(x); x += dppf<0x140>(x); return x; }
__device__ __forceinline__ float row16_max(float x) { x = fmaxf(x, dppf<0xB1>(x)); x = fmaxf(x, dppf<0x4E>(x)); x = fmaxf(x, dppf<0x141>(x)); x = fmaxf(x, dppf<0x140>(x)); return x; }
__device__ __forceinline__ float wave_sum(float x) {
    x = row16_sum(x);
    { auto r = __builtin_amdgcn_permlane16_swap(__float_as_uint(x), __float_as_uint(x), false, false); x = __uint_as_float(r[0]) + __uint_as_float(r[1]); }
    { auto r = __builtin_amdgcn_permlane32_swap(__float_as_uint(x), __float_as_uint(x), false, false); x = __uint_as_float(r[0]) + __uint_as_float(r[1]); }
    return x;
}
__device__ __forceinline__ unsigned pk4_fp8(float a, float b, float c, float d) { int t = 0; t = __builtin_amdgcn_cvt_pk_fp8_f32(a, b, t, false); t = __builtin_amdgcn_cvt_pk_fp8_f32(c, d, t, true); return (unsigned)t; }
__device__ __forceinline__ float clamp8(float x) { return fminf(fmaxf(x, -440.f), 440.f); }
__device__ __forceinline__ void fp8_scale(unsigned amax_bits, float& mul, float& inv) { const float am = __uint_as_float(amax_bits); int k = 0; if (am > 0.f) k = (int)floorf(log2f(256.f / am)); k = k > 60 ? 60 : (k < -60 ? -60 : k); mul = exp2f((float)k); inv = exp2f((float)-k); }
__device__ __forceinline__ float silu_f(float x) { return x * __builtin_amdgcn_rcpf(1.f + __builtin_amdgcn_exp2f(x * -1.4426950408889634f)); }
__device__ __forceinline__ float sigmoid_f(float x) { return __builtin_amdgcn_rcpf(1.f + __builtin_amdgcn_exp2f(x * -1.4426950408889634f)); }

__device__ __forceinline__ int vt_off(int tpos) { const int kk = tpos & 63; return (tpos & ~63) + ((kk >> 2) & 1) * 32 + ((kk >> 5) & 1) * 16 + (kk & 3) + 4 * ((kk >> 3) & 3); }
constexpr float QSC_G = 4.f * 0.08838834764831845f * 1.4426950408889634f, QSC_M = 4.f * 0.10206207261596575f * 1.4426950408889634f, KSC8 = 0.25f;
__device__ __forceinline__ int p1_pos(int c) { const int cl = c & 255; return (c & ~255) + (((cl >> 5) & 3) << 6) + (((cl >> 3) & 3) << 4) + ((cl >> 7) << 3) + (cl & 7); }
#define SIDE_CVT_OK(G_) (((NROW / 256 * 8) % (G_)) != 0 && ((NROW / 256 * 4) % (G_)) != 0)
struct RowInfo { int b, tpos, pr, pc, v; bool lat; };
__device__ __forceinline__ RowInfo rowinfo(int row) {
    RowInfo r;
    if (row < NLAT) { r.lat = true; r.b = row >> 12; const int t = row & 4095; r.tpos = CTXL + t; r.pr = t >> 6; r.pc = t & 63; r.v = r.b; }
    else { const int q = row - NLAT; r.lat = false; r.b = q >> 8; r.tpos = q & 255; r.pr = 0; r.pc = 0; r.v = 4; }
    return r;
}

#define XB_TMO      128
#define XB_XCNT(j)  (256  + 64 * (j))
#define XB_XSUB(j)  (1280 + 64 * (j))
#define XB_XGEN(j)  (2304 + 64 * (j))
#define XB_TOP      3328
#define XB_TOPGEN   3392
#define XCD_BAR_WORDS 3456
#define XB_SPIN_CAP (1u << 22)

__device__ __forceinline__ unsigned xb_ld(unsigned* p)              { return __hip_atomic_load(p, __ATOMIC_RELAXED, __HIP_MEMORY_SCOPE_AGENT); }
__device__ __forceinline__ unsigned xb_add(unsigned* p, unsigned v) { return __hip_atomic_fetch_add(p, v, __ATOMIC_RELAXED, __HIP_MEMORY_SCOPE_AGENT); }
__device__ __forceinline__ unsigned xb_xcc_id() { return (unsigned)__builtin_amdgcn_s_getreg((3 << 11) | 20) & 0xFu; }
#define XB_SPIN(cond, bar) do { unsigned _sp = 0; while (cond) { __builtin_amdgcn_s_sleep(1); \
    if ((++_sp & 255u) == 0u) { if (xb_ld(&(bar)[XB_TMO])) break; if (_sp > XB_SPIN_CAP) { atomicAdd(&(bar)[XB_TMO], 1u); break; } } } } while (0)

struct XcdBarrier { unsigned* bar; unsigned x; volatile LAS unsigned* st; };

__device__ __forceinline__ XcdBarrier xcd_barrier_post(unsigned* bar, volatile LAS unsigned* st) {
    XcdBarrier b; b.bar = bar; b.x = xb_xcc_id(); b.st = st;
    if (threadIdx.x == 0) (void)xb_add(&bar[XB_XCNT(b.x)], 1u);
    return b;
}
__device__ __forceinline__ void xcd_barrier_complete(unsigned* bar, unsigned x, unsigned& nloc, unsigned& nx) {
    const unsigned G = gridDim.x * gridDim.y * gridDim.z;
    unsigned sum, cnt, mine, sp = 0u;
    for (;;) {
        sum = 0u; cnt = 0u; mine = 0u;
#pragma unroll
        for (unsigned j = 0; j < 16; ++j) { const unsigned c = xb_ld(&bar[XB_XCNT(j)]); sum += c; cnt += (c > 0u) ? 1u : 0u; mine = (j == x) ? c : mine; }
        if (sum == G) break;
        __builtin_amdgcn_s_sleep(1);
        if ((++sp & 255u) == 0u) { if (xb_ld(&bar[XB_TMO])) break; if (sp > XB_SPIN_CAP) { atomicAdd(&bar[XB_TMO], 1u); break; } }
    }
    nloc = mine > 0u ? mine : 1u; nx = cnt > 0u ? cnt : 1u;
}
__device__ __forceinline__ void xcd_barrier(const XcdBarrier& b) {
    asm volatile("s_waitcnt vmcnt(0)" ::: "memory");
    __syncthreads();
    if (threadIdx.x == 0) {
        unsigned* bar = b.bar;
        __builtin_amdgcn_s_waitcnt(0);
        unsigned nloc = b.st[0], nx = b.st[1];
        if (nloc == 0u) { xcd_barrier_complete(bar, b.x, nloc, nx); b.st[0] = nloc; b.st[1] = nx; }
        const unsigned old = xb_add(&bar[XB_XSUB(b.x)], 1u);
        const unsigned gen = old / nloc;
        if (old + 1u == (gen + 1u) * nloc) {
            __builtin_amdgcn_fence(__ATOMIC_RELEASE, "agent");
            asm volatile("s_waitcnt vmcnt(0)" ::: "memory");
            const unsigned og = xb_add(&bar[XB_TOP], 1u);
            const unsigned tg = og / nx;
            if (og + 1u == (tg + 1u) * nx) xb_add(&bar[XB_TOPGEN], 1u);
            else XB_SPIN(xb_ld(&bar[XB_TOPGEN]) == tg, bar);
            __builtin_amdgcn_fence(__ATOMIC_ACQUIRE, "agent");
            xb_add(&bar[XB_XGEN(b.x)], 1u);
            asm volatile("s_waitcnt vmcnt(0)" ::: "memory");
        } else {
            XB_SPIN(xb_ld(&bar[XB_XGEN(b.x)]) == gen, bar);
            __builtin_amdgcn_fence(__ATOMIC_ACQUIRE, "agent");
            asm volatile("s_waitcnt vmcnt(0)" ::: "memory");
        }
    }
    __syncthreads();
}
namespace pg8 {
constexpr int BM = 256, BK = 64, HALF = 128, HTB = HALF * BK * 2, STAGE_BYTES = 8 * HTB, NXCD = 8, WGM = 8;
__host__ __device__ __forceinline__ int lds_byte(int r, int c) { const int st = (r >> 4) * 2 + (c >> 5), rr = r & 15, cc = c & 31, ob = rr * 64 + cc * 2; return st * 1024 + (ob ^ (((ob >> 9) & 1) << 5)); }
__host__ __device__ __forceinline__ void stage_rc(int b, int& R, int& C) { const int st = b / 1024, sb = b % 1024, swz = sb ^ (((sb >> 9) & 1) << 5); R = (st >> 1) * 16 + swz / 64; C = (st & 1) * 32 + (swz % 64) / 2; }
__host__ __device__ __forceinline__ int perm32(int rho) { const int n = rho >> 4, i = rho & 15; return 8 * (i >> 2) + 4 * n + (i & 3); }

struct Unit { int pm, pn; };
typedef int i32x8 __attribute__((ext_vector_type(8))); typedef int i32x4v __attribute__((ext_vector_type(4)));
__device__ __forceinline__ i32x8 cat8(const bf16x8 a, const bf16x8 b) { const i32x4v x = __builtin_bit_cast(i32x4v, a), y = __builtin_bit_cast(i32x4v, b); return __builtin_shufflevector(x, y, 0, 1, 2, 3, 4, 5, 6, 7); }
struct Gemm { const bf16_t* A; const bf16_t* Bt; int M, N, K, lda, ldb; };

struct StaticOrder {
    int nM, nN, nwg, G, c;
    __host__ __device__ void init(int M, int N, int G_, int c_) { nM = M / BM; nN = N / BM; nwg = nM * nN; G = G_; c = c_; }
    __host__ __device__ bool next(int i, Unit& u) const {
        const long L = (long)i * G + c; if (L >= nwg) return false;
        int wgid = (int)L; { const int q = nwg / NXCD, r = nwg % NXCD, xcd = wgid % NXCD, off = wgid / NXCD; wgid = (xcd < r ? xcd * (q + 1) : r * (q + 1) + (xcd - r) * q) + off; }
        const int nig = WGM * nN, gid = wgid / nig, fm = gid * WGM, gsz = (nM - fm) < WGM ? (nM - fm) : WGM;
        u.pm = fm + ((wgid % nig) % gsz); u.pn = (wgid % nig) / gsz; return true;
    }
    __device__ __forceinline__ void a_ready(const Unit&) const {}
    __device__ __forceinline__ void done(const Unit&) const {}
};

template <class Epi, class Sched, int GABL = 0>
__device__ __forceinline__ void gemm_phase(LAS unsigned char* lds, const int tid, const Gemm g, const Sched& S, const Epi& E) {
    const int  wid = __builtin_amdgcn_readfirstlane(tid >> 6), lane = tid & 63, wr = wid >> 2, wc = wid & 3, fr = lane & 15, fq = lane >> 4;
    const int K = g.K, nt = K / BK;
    unsigned voffA[2], voffB[2];
#pragma unroll
    for (int i = 0; i < 2; ++i) { int R, C; stage_rc(tid * 16 + i * 8192, R, C); const int Rb = Epi::PERM ? ((R & ~31) + perm32(R & 31)) : R;
        voffA[i] = (unsigned)(R * g.lda + C) * 2u; voffB[i] = (unsigned)(Rb * g.ldb + C) * 2u; }
    const size_t kstep = (size_t)(BK * 2);
    const size_t hstepA = (size_t)HALF * g.lda * 2, hstepB = (size_t)HALF * g.ldb * 2;
    const size_t tstepA = 2 * hstepA, tstepB = 2 * hstepB;
    const unsigned ldsw = (unsigned)wid * 1024u;
    const int aoff = lds_byte(wr * 64 + fr, fq * 8), boff = lds_byte(wc * 32 + fr, fq * 8);
#define PG8_SA(b, h) (((b) * 2 + (h)) * HTB)
#define PG8_SB(b, h) ((4 + (b) * 2 + (h)) * HTB)
#define PG8_STAGE(bufoff, gbase, voff) do { if constexpr (!(GABL & 4)) _Pragma("unroll") for (int _i = 0; _i < 2; ++_i) \
        __builtin_amdgcn_global_load_lds((const unsigned*)((const char*)(gbase) + (voff)[_i]), (LAS unsigned*)(lds + (bufoff) + ldsw + _i * 8192), 16, 0, 0); } while (0)
#define PG8_LDA(dst, b, h) do { if constexpr (Epi::FP8) { _Pragma("unroll") for (int m = 0; m < 4; ++m) { const i32x4v lo_ = *(const LAS i32x4v*)(lds + PG8_SA(b, h) + aoff + m * 2048), hi_ = *(const LAS i32x4v*)(lds + PG8_SA(b, h) + aoff + m * 2048 + 1024); \
            dst##8[m] = __builtin_shufflevector(lo_, hi_, 0, 1, 2, 3, 4, 5, 6, 7); } } \
        else { _Pragma("unroll") for (int m = 0; m < 4; ++m) _Pragma("unroll") for (int k = 0; k < 2; ++k) dst[m][k] = *(const LAS bf16x8*)(lds + PG8_SA(b, h) + aoff + m * 2048 + k * 1024); } } while (0)
#define PG8_LDB(dst, b, h) do { if constexpr (Epi::FP8) { _Pragma("unroll") for (int n = 0; n < 2; ++n) { const i32x4v lo_ = *(const LAS i32x4v*)(lds + PG8_SB(b, h) + boff + n * 2048), hi_ = *(const LAS i32x4v*)(lds + PG8_SB(b, h) + boff + n * 2048 + 1024); \
            dst##8[n] = __builtin_shufflevector(lo_, hi_, 0, 1, 2, 3, 4, 5, 6, 7); } } \
        else { _Pragma("unroll") for (int n = 0; n < 2; ++n) _Pragma("unroll") for (int k = 0; k < 2; ++k) dst[n][k] = *(const LAS bf16x8*)(lds + PG8_SB(b, h) + boff + n * 2048 + k * 1024); } } while (0)
#define PG8_MMA(ai, bj, At, Bt) do { __builtin_amdgcn_s_setprio(1); _Pragma("unroll") for (int m = 0; m < 4; ++m) _Pragma("unroll") for (int n = 0; n < 2; ++n) { \
        if constexpr (Epi::FP8) { if constexpr (GABL & 8) asm volatile("" : "+v"(acc[ai][bj][m][n]) : "v"(Bt##8[n]), "v"(At##8[m]), "v"(sc1_)); else asm volatile("v_mfma_scale_f32_16x16x128_f8f6f4 %0, %1, %2, %0, %3, %3 op_sel_hi:[0,0,0]" : "+v"(acc[ai][bj][m][n]) : "v"(Bt##8[n]), "v"(At##8[m]), "v"(sc1_)); } \
        else { _Pragma("unroll") for (int k = 0; k < 2; ++k) acc[ai][bj][m][n] = __builtin_amdgcn_mfma_f32_16x16x32_bf16(Bt[n][k], At[m][k], acc[ai][bj][m][n], 0, 0, 0); } } __builtin_amdgcn_s_setprio(0); } while (0)
#define PG8_WAIT_V(n) asm volatile("s_waitcnt vmcnt(" #n ")" ::: "memory")
#define PG8_WAIT_L(n) asm volatile("s_waitcnt lgkmcnt(" #n ")" ::: "memory")
#define PG8_BAR __builtin_amdgcn_s_barrier()
#define PG8_SCHED __builtin_amdgcn_sched_barrier(0)
    Unit cur, nxt; int ui = 0;
    if (!S.next(0, cur)) return;
    f32x4 acc[2][2][4][2];
#pragma unroll
    for (int a = 0; a < 2; ++a)
#pragma unroll
        for (int b = 0; b < 2; ++b)
#pragma unroll
            for (int m = 0; m < 4; ++m)
#pragma unroll
                for (int n = 0; n < 2; ++n) acc[a][b][m][n] = (f32x4){0.f, 0.f, 0.f, 0.f};
    int sc1_ = 0x7F7F7F7F; asm volatile("" : "+v"(sc1_));
    bf16x8 At[4][2], B0[2][2], B1[2][2]; i32x8 At8[4], B08[2], B18[2];
    const char* cA = (const char*)g.A + (size_t)cur.pm * tstepA; const char* cB = (const char*)g.Bt + (size_t)cur.pn * tstepB;
    S.a_ready(cur);
    PG8_STAGE(PG8_SB(0, 0), cB, voffB); PG8_STAGE(PG8_SA(0, 0), cA, voffA); PG8_STAGE(PG8_SB(0, 1), cB + hstepB, voffB); PG8_STAGE(PG8_SA(0, 1), cA + hstepA, voffA);
    if (wr == 1) PG8_BAR;
    PG8_WAIT_V(4); PG8_BAR;
    PG8_STAGE(PG8_SB(1, 0), cB + kstep, voffB); PG8_STAGE(PG8_SA(1, 0), cA + kstep, voffA); PG8_STAGE(PG8_SB(1, 1), cB + hstepB + kstep, voffB);
    PG8_WAIT_V(6); PG8_BAR;
    for (;;) {
        const bool has_next = S.next(ui + 1, nxt);
        const char* nA = has_next ? (const char*)g.A + (size_t)nxt.pm * tstepA : cA; const char* nB = has_next ? (const char*)g.Bt + (size_t)nxt.pn * tstepB : cB;
#pragma unroll 1
        for (int t = 0; t < nt; t += 2) {
            const bool last = (t == nt - 2);
            const char* a1 = cA + (size_t)(t + 1) * kstep;
            const char* a2 = last ? nA : cA + (size_t)(t + 2) * kstep; const char* b2 = last ? nB : cB + (size_t)(t + 2) * kstep;
            const char* a3 = a2 + kstep; const char* b3 = b2 + kstep;
            if (last && has_next) S.a_ready(nxt);
            PG8_LDB(B0, 0, 0); PG8_SCHED; PG8_LDA(At, 0, 0); PG8_STAGE(PG8_SA(1, 1), a1 + hstepA, voffA);
            PG8_WAIT_L(8); PG8_BAR; PG8_WAIT_L(0); PG8_MMA(0, 0, At, B0); PG8_BAR; PG8_SCHED;
            PG8_LDB(B1, 0, 1); PG8_STAGE(PG8_SB(0, 0), b2, voffB);
            PG8_BAR; PG8_WAIT_L(0); PG8_MMA(0, 1, At, B1); PG8_BAR;
            PG8_LDA(At, 0, 1); PG8_STAGE(PG8_SA(0, 0), a2, voffA);
            PG8_BAR; PG8_WAIT_L(0); PG8_MMA(1, 0, At, B0); PG8_BAR; PG8_SCHED;
            PG8_STAGE(PG8_SB(0, 1), b2 + hstepB, voffB);
            PG8_WAIT_V(6); PG8_BAR; PG8_MMA(1, 1, At, B1); PG8_BAR;
            PG8_LDB(B0, 1, 0); PG8_SCHED; PG8_LDA(At, 1, 0); PG8_STAGE(PG8_SA(0, 1), a2 + hstepA, voffA);
            PG8_WAIT_L(8); PG8_BAR; PG8_WAIT_L(0); PG8_MMA(0, 0, At, B0); PG8_BAR; PG8_SCHED;
            PG8_LDB(B1, 1, 1); PG8_STAGE(PG8_SB(1, 0), b3, voffB);
            PG8_BAR; PG8_WAIT_L(0); PG8_MMA(0, 1, At, B1); PG8_BAR;
            PG8_LDA(At, 1, 1); PG8_STAGE(PG8_SA(1, 0), a3, voffA);
            PG8_BAR; PG8_WAIT_L(0); PG8_MMA(1, 0, At, B0); PG8_BAR; PG8_SCHED;
            PG8_STAGE(PG8_SB(1, 1), b3 + hstepB, voffB);
            PG8_WAIT_V(6); PG8_BAR; PG8_MMA(1, 1, At, B1); PG8_BAR;
        }
        if constexpr (Epi::FP8) asm volatile("s_nop 15\n\ts_nop 15" ::: "memory");
        if constexpr (GABL & 2) { pg8::Unit u2_ = cur; u2_.pm = 0; Epi E2_ = E; E2_.retarget(); E2_(acc, u2_, wr, wc, fr, fq); } else if constexpr (!(GABL & 1)) E(acc, cur, wr, wc, fr, fq); else asm volatile("" :: "v"(acc[0][0][0][0]), "v"(acc[1][1][3][1]), "v"(acc[0][1][2][0]), "v"(acc[1][0][1][1]));
        if (!has_next) break;
#pragma unroll
        for (int a = 0; a < 2; ++a)
#pragma unroll
            for (int b = 0; b < 2; ++b)
#pragma unroll
                for (int m = 0; m < 4; ++m)
#pragma unroll
                    for (int n = 0; n < 2; ++n) acc[a][b][m][n] = (f32x4){0.f, 0.f, 0.f, 0.f};
        cur = nxt; cA = nA; cB = nB; ++ui;
    }
    PG8_WAIT_V(0);
    if (wr == 0) PG8_BAR;
    PG8_BAR;
#undef PG8_SA
#undef PG8_SB
#undef PG8_STAGE
#undef PG8_LDA
#undef PG8_LDB
#undef PG8_MMA
#undef PG8_WAIT_V
#undef PG8_WAIT_L
#undef PG8_BAR
#undef PG8_SCHED
}
}

typedef f32x4 Acc[2][2][4][2];
#define EPI_LOOP_ROWS for (int ai = 0; ai < 2; ++ai) for (int m = 0; m < 4; ++m)
__device__ __forceinline__ u32x4 pack8(const f32x4 a, const f32x4 b) { u32x4 w; w.x = cvt_pk_bf16(a[0], a[1]); w.y = cvt_pk_bf16(a[2], a[3]); w.z = cvt_pk_bf16(b[0], b[1]); w.w = cvt_pk_bf16(b[2], b[3]); return w; }

struct EpiIn {
    static constexpr bool PERM = true, FP8 = true;
    bf16_t* P1; bf16_t* G; float inv;
    __device__ __forceinline__ void retarget() { P1 = (bf16_t*)((char*)P1 - WS_P1 + WS_END); G = P1 + 256 * NP1; }
    __device__ __forceinline__ void operator()(const Acc& acc, const pg8::Unit& u, int wr, int wc, int fr, int fq) const {
        const int row0 = u.pm * 256 + wr * 64 + fr; const bool gate = u.pn >= 16;
        const int col0 = u.pn * 256 + wc * 32 + 8 * fq;
        unsigned char* gt = (unsigned char*)G + ((size_t)(u.pm * 24 + (u.pn - 16)) << 16) + (size_t)((wr * 4 + wc) * 8192 + (fq * 16 + fr) * 16);
#pragma unroll
        for (int ai = 0; ai < 2; ++ai)
#pragma unroll
            for (int m = 0; m < 4; ++m) { const size_t row = (size_t)(row0 + ai * 128 + m * 16);
                if (gate) { u32x4 w8;
#pragma unroll
                    for (int bj = 0; bj < 2; ++bj) { f32x4 v0 = acc[ai][bj][m][0] * inv, v1 = acc[ai][bj][m][1] * inv;
#pragma unroll
                        for (int j = 0; j < 4; ++j) { v0[j] = 256.f * sigmoid_f(v0[j]); v1[j] = 256.f * sigmoid_f(v1[j]); }
                        const unsigned a_ = pk4_fp8(v0[0], v0[1], v0[2], v0[3]), b_ = pk4_fp8(v1[0], v1[1], v1[2], v1[3]);
                        if (bj == 0) { w8.x = a_; w8.y = b_; } else { w8.z = a_; w8.w = b_; } }
                    __builtin_nontemporal_store(w8, (u32x4*)(gt + (ai * 4 + m) * 1024)); }
                else {
#pragma unroll
                    for (int bj = 0; bj < 2; ++bj) { const f32x4 v0 = acc[ai][bj][m][0] * inv, v1 = acc[ai][bj][m][1] * inv;
                        u32x2 w8; w8.x = pk4_fp8(clamp8(v0[0] * 16.f), clamp8(v0[1] * 16.f), clamp8(v0[2] * 16.f), clamp8(v0[3] * 16.f)); w8.y = pk4_fp8(clamp8(v1[0] * 16.f), clamp8(v1[1] * 16.f), clamp8(v1[2] * 16.f), clamp8(v1[3] * 16.f));
                        __builtin_nontemporal_store(w8, (u32x2*)((unsigned char*)P1 + row * NP1 + col0 + bj * 128)); } } }
    }
};
struct EpiPlain {
    static constexpr bool PERM = true, FP8 = false;
    bf16_t* O; int ldc;
    __device__ __forceinline__ void operator()(const Acc& acc, const pg8::Unit& u, int wr, int wc, int fr, int fq) const {
        const int row0 = u.pm * 256 + wr * 64 + fr; const int col0 = u.pn * 256 + wc * 32 + 8 * fq;
#pragma unroll
        for (int ai = 0; ai < 2; ++ai)
#pragma unroll
            for (int m = 0; m < 4; ++m) { bf16_t* rowp = O + (size_t)(row0 + ai * 128 + m * 16) * ldc + col0;
#pragma unroll
                for (int bj = 0; bj < 2; ++bj) *(u32x4*)(rowp + bj * 128) = pack8(acc[ai][bj][m][0], acc[ai][bj][m][1]); }
    }
};
__device__ __forceinline__ void tile_info(int pm, int& b, int& tpos0, bool& lat) { lat = pm < 64; b = lat ? (pm >> 4) : (pm - 64); tpos0 = lat ? CTXL + ((pm & 15) << 8) : 0; }
struct EpiQup {
    static constexpr bool PERM = true, FP8 = false;
    unsigned char* QM; const f32x2* cs32;
    __device__ __forceinline__ void operator()(const Acc& acc, const pg8::Unit& u, int wr, int wc, int fr, int fq) const {
        int b, tpos0; bool lat; tile_info(u.pm, b, tpos0, lat);
        const int r0 = wr * 64 + fr;
#pragma unroll
        for (int bj = 0; bj < 2; ++bj) { const int c0 = u.pn * 256 + bj * 128 + wc * 32 + 8 * fq; const int hh = c0 / 96, j0 = c0 - hh * 96;
            unsigned char* hb = QM + ((size_t)(b * 8 + hh) * TT + tpos0 + r0) * 128;
            if (j0 < 64) {
#pragma unroll
                for (int ai = 0; ai < 2; ++ai)
#pragma unroll
                    for (int m = 0; m < 4; ++m) { const f32x4 a_ = acc[ai][bj][m][0] * QSC_M, b_ = acc[ai][bj][m][1] * QSC_M; u32x2 w8; w8.x = pk4_fp8(clamp8(a_[0]), clamp8(a_[1]), clamp8(a_[2]), clamp8(a_[3])); w8.y = pk4_fp8(clamp8(b_[0]), clamp8(b_[1]), clamp8(b_[2]), clamp8(b_[3]));
                        *(u32x2*)(hb + (ai * 128 + m * 16) * 128 + j0) = w8; }
            } else { const int g8 = (j0 - 64) >> 3, part = g8 >> 1, pbase = (g8 & 1) * 4;
#pragma unroll
                for (int ai = 0; ai < 2; ++ai)
#pragma unroll
                    for (int m = 0; m < 4; ++m) { const int t = tpos0 - CTXL + r0 + ai * 128 + m * 16; const int pos = part ? (t & 63) : (t >> 6);
                        const f32x4 v0 = acc[ai][bj][m][0] * QSC_M, v1 = acc[ai][bj][m][1] * QSC_M;
                        float o1[4], o2[4]; const float x1[4] = {v0[0], v0[2], v1[0], v1[2]}, x2[4] = {v0[1], v0[3], v1[1], v1[3]};
#pragma unroll
                        for (int p = 0; p < 4; ++p) { const f32x2 cs = lat ? cs32[pos * 8 + pbase + p] : (f32x2){1.f, 0.f};
                            o1[p] = x1[p] * cs.x - x2[p] * cs.y; o2[p] = x1[p] * cs.y + x2[p] * cs.x; }
                        unsigned char* dst = hb + (ai * 128 + m * 16) * 128 + 64 + part * 16 + pbase;
                        *(unsigned*)dst = pk4_fp8(clamp8(o1[0]), clamp8(o1[1]), clamp8(o1[2]), clamp8(o1[3])); *(unsigned*)(dst + 8) = pk4_fp8(clamp8(o2[0]), clamp8(o2[1]), clamp8(o2[2]), clamp8(o2[3])); } } }
    }
};
struct EpiKvup {
    static constexpr bool PERM = true, FP8 = false;
    unsigned char* KM; unsigned char* VM;
    __device__ __forceinline__ void operator()(const Acc& acc, const pg8::Unit& u, int wr, int wc, int fr, int fq) const {
        int b, tpos0; bool lat; tile_info(u.pm, b, tpos0, lat);
        const int r0 = wr * 64 + fr; const int j0 = wc * 32 + 8 * fq;
#pragma unroll
        for (int bj = 0; bj < 2; ++bj) { const size_t tok = (size_t)(b * 8 + u.pn * 2 + bj) * TT + tpos0 + r0;
            if (j0 < 64) { unsigned char* d = KM + tok * 128 + j0;
#pragma unroll
                for (int ai = 0; ai < 2; ++ai)
#pragma unroll
                    for (int m = 0; m < 4; ++m) { const f32x4 a_ = acc[ai][bj][m][0] * KSC8, b_ = acc[ai][bj][m][1] * KSC8; u32x2 w8; w8.x = pk4_fp8(clamp8(a_[0]), clamp8(a_[1]), clamp8(a_[2]), clamp8(a_[3])); w8.y = pk4_fp8(clamp8(b_[0]), clamp8(b_[1]), clamp8(b_[2]), clamp8(b_[3]));
                        *(u32x2*)(d + (ai * 128 + m * 16) * 128) = w8; } }
            else { unsigned char* d = VM + ((size_t)(b * 8 + u.pn * 2 + bj) * 64 + (j0 - 64)) * TT;
#pragma unroll
                for (int ai = 0; ai < 2; ++ai)
#pragma unroll
                    for (int m = 0; m < 4; ++m) { const f32x4 a_ = acc[ai][bj][m][0], b_ = acc[ai][bj][m][1]; const unsigned w0_ = pk4_fp8(clamp8(a_[0]), clamp8(a_[1]), clamp8(a_[2]), clamp8(a_[3])), w1_ = pk4_fp8(clamp8(b_[0]), clamp8(b_[1]), clamp8(b_[2]), clamp8(b_[3]));
                        unsigned char* q_ = d + vt_off(tpos0 + r0 + ai * 128 + m * 16);
                        q_[0] = (unsigned char)(w0_ & 0xffu); q_[TT] = (unsigned char)((w0_ >> 8) & 0xffu); q_[2 * TT] = (unsigned char)((w0_ >> 16) & 0xffu); q_[3 * TT] = (unsigned char)(w0_ >> 24);
                        q_[4 * TT] = (unsigned char)(w1_ & 0xffu); q_[5 * TT] = (unsigned char)((w1_ >> 8) & 0xffu); q_[6 * TT] = (unsigned char)((w1_ >> 16) & 0xffu); q_[7 * TT] = (unsigned char)(w1_ >> 24); } } }
    }
};
template <int SEG> struct EpiMerge {
    static constexpr bool PERM = true, FP8 = false;
    bf16_t* MB; const bf16_t* G; unsigned char* MB8;
    __device__ __forceinline__ void operator()(const Acc& acc, const pg8::Unit& u, int wr, int wc, int fr, int fq) const {
        const int row0 = u.pm * 256 + wr * 64 + fr; const int col0 = u.pn * 256 + wc * 32 + 8 * fq;
        const bf16_t* gp = G + (size_t)row0 * NG + SEG * 2048 + col0; bf16_t* mp = MB + (size_t)row0 * D + col0; unsigned char* m8 = MB8 + (size_t)row0 * D + col0;
#pragma unroll
        for (int ai = 0; ai < 2; ++ai) {
            u32x4 gw[4][2], ow[4][2];
#pragma unroll
            for (int m = 0; m < 4; ++m)
#pragma unroll
                for (int bj = 0; bj < 2; ++bj) { const size_t ro = (size_t)(ai * 128 + m * 16);
                    gw[m][bj] = *(const u32x4*)(gp + ro * NG + bj * 128);
                    if (SEG > 0) ow[m][bj] = __builtin_nontemporal_load((const u32x4*)(mp + ro * D + bj * 128)); }
#pragma unroll
            for (int m = 0; m < 4; ++m)
#pragma unroll
                for (int bj = 0; bj < 2; ++bj) { const size_t ro = (size_t)(ai * 128 + m * 16); const u32x4 g_ = gw[m][bj];
                    f32x4 v0 = acc[ai][bj][m][0], v1 = acc[ai][bj][m][1];
                    if (ABL_BR & (1 << SEG)) { v0 = (f32x4){0.f, 0.f, 0.f, 0.f}; v1 = v0; }
                    v0[0] *= bflo(g_.x); v0[1] *= bfhi(g_.x); v0[2] *= bflo(g_.y); v0[3] *= bfhi(g_.y);
                    v1[0] *= bflo(g_.z); v1[1] *= bfhi(g_.z); v1[2] *= bflo(g_.w); v1[3] *= bfhi(g_.w);
                    if (SEG > 0) { const u32x4 o = ow[m][bj];
                        v0[0] += bflo(o.x); v0[1] += bfhi(o.x); v0[2] += bflo(o.y); v0[3] += bfhi(o.y);
                        v1[0] += bflo(o.z); v1[1] += bfhi(o.z); v1[2] += bflo(o.w); v1[3] += bfhi(o.w); }
                    if (SEG < 2) *(u32x4*)(mp + ro * D + bj * 128) = pack8(v0, v1);
                    else { u32x2 w8; w8.x = pk4_fp8(clamp8(v0[0] * 16.f), clamp8(v0[1] * 16.f), clamp8(v0[2] * 16.f), clamp8(v0[3] * 16.f)); w8.y = pk4_fp8(clamp8(v1[0] * 16.f), clamp8(v1[1] * 16.f), clamp8(v1[2] * 16.f), clamp8(v1[3] * 16.f));
                        *(u32x2*)(m8 + ro * D + bj * 128) = w8; } }
        }
    }
};
namespace pg8 {
struct Merge3 { const bf16_t* A; const bf16_t* B0; const bf16_t* B1; const bf16_t* B2; const bf16_t* G; unsigned char* MB8; float r01, r12, fin; };
template <class Sched>
__device__ __forceinline__ void gemm_merge3(LAS unsigned char* lds, const int tid, const Merge3 g, const Sched& S) {
    constexpr int GABL = 0;
    const int wid = __builtin_amdgcn_readfirstlane(tid >> 6), lane = tid & 63, wr = wid >> 2, wc = wid & 3, fr = lane & 15, fq = lane >> 4;
    constexpr int NT = 16, LDA = 1024;
    int sc1_ = 0x7F7F7F7F; asm volatile("" : "+v"(sc1_));
    unsigned voffA[2], voffB5[2], voffB10[2];
#pragma unroll
    for (int i = 0; i < 2; ++i) { int R, C; stage_rc(tid * 16 + i * 8192, R, C); const int Rb = (R & ~31) + perm32(R & 31);
        voffA[i] = (unsigned)(R * LDA + C) * 2u; voffB5[i] = (unsigned)(Rb * 256 + C) * 2u; voffB10[i] = (unsigned)(Rb * 512 + C) * 2u; }
    const size_t kstep = (size_t)(BK * 2);
    const size_t hstepA = (size_t)HALF * LDA * 2, tstepA = 2 * hstepA;
    const unsigned ldsw = (unsigned)wid * 1024u;
    const int aoff = lds_byte(wr * 64 + fr, fq * 8), boff = lds_byte(wc * 32 + fr, fq * 8);
#define M3_TA(pm_, t_) ((const char*)g.A + (size_t)(pm_) * tstepA + (size_t)(t_) * kstep)
#define M3_TB(pn_, t_) ((t_) < 4 ? (const char*)g.B0 + (size_t)(pn_) * 131072 + (size_t)(t_) * kstep : ((t_) < 8 ? (const char*)g.B1 + (size_t)(pn_) * 131072 + (size_t)((t_) - 4) * kstep : (const char*)g.B2 + (size_t)(pn_) * 262144 + (size_t)((t_) - 8) * kstep))
#define PG8_SA(b, h) (((b) * 2 + (h)) * HTB)
#define PG8_SB(b, h) ((4 + (b) * 2 + (h)) * HTB)
#define PG8_STAGE(bufoff, gbase, voff) do { if constexpr (!(GABL & 4)) _Pragma("unroll") for (int _i = 0; _i < 2; ++_i) \
        __builtin_amdgcn_global_load_lds((const unsigned*)((const char*)(gbase) + (voff)[_i]), (LAS unsigned*)(lds + (bufoff) + ldsw + _i * 8192), 16, 0, 0); } while (0)
#define PG8_LDA(dst, b, h) do { _Pragma("unroll") for (int m = 0; m < 4; ++m) { const i32x4v lo_ = *(const LAS i32x4v*)(lds + PG8_SA(b, h) + aoff + m * 2048), hi_ = *(const LAS i32x4v*)(lds + PG8_SA(b, h) + aoff + m * 2048 + 1024); dst[m] = __builtin_shufflevector(lo_, hi_, 0, 1, 2, 3, 4, 5, 6, 7); } } while (0)
#define PG8_LDB(dst, b, h) do { _Pragma("unroll") for (int n = 0; n < 2; ++n) { const i32x4v lo_ = *(const LAS i32x4v*)(lds + PG8_SB(b, h) + boff + n * 2048), hi_ = *(const LAS i32x4v*)(lds + PG8_SB(b, h) + boff + n * 2048 + 1024); dst[n] = __builtin_shufflevector(lo_, hi_, 0, 1, 2, 3, 4, 5, 6, 7); } } while (0)
#define PG8_MMA(ai, bj, At, Bt) do { __builtin_amdgcn_s_setprio(1); _Pragma("unroll") for (int m = 0; m < 4; ++m) _Pragma("unroll") for (int n = 0; n < 2; ++n) \
        asm volatile("v_mfma_scale_f32_16x16x128_f8f6f4 %0, %1, %2, %0, %3, %3 op_sel_hi:[0,0,0]" : "+v"(acc[ai][bj][m][n]) : "v"(Bt[n]), "v"(At[m]), "v"(sc1_)); __builtin_amdgcn_s_setprio(0); } while (0)
#define PG8_WAIT_V(n) asm volatile("s_waitcnt vmcnt(" #n ")" ::: "memory")
#define PG8_WAIT_L(n) asm volatile("s_waitcnt lgkmcnt(" #n ")" ::: "memory")
#define PG8_BAR __builtin_amdgcn_s_barrier()
#define PG8_SCHED __builtin_amdgcn_sched_barrier(0)
    Unit cur, nxt; int ui = 0;
    if (!S.next(0, cur)) return;
    f32x4 acc[2][2][4][2];
#pragma unroll
    for (int a = 0; a < 2; ++a)
#pragma unroll
        for (int b = 0; b < 2; ++b)
#pragma unroll
            for (int m = 0; m < 4; ++m)
#pragma unroll
                for (int n = 0; n < 2; ++n) acc[a][b][m][n] = (f32x4){0.f, 0.f, 0.f, 0.f};
    i32x8 At[4], B0[2], B1[2];
    { const char* cA = M3_TA(cur.pm, 0); const char* cB = M3_TB(cur.pn, 0); const size_t hB = 65536;
      PG8_STAGE(PG8_SB(0, 0), cB, voffB5); PG8_STAGE(PG8_SA(0, 0), cA, voffA); PG8_STAGE(PG8_SB(0, 1), cB + hB, voffB5); PG8_STAGE(PG8_SA(0, 1), cA + hstepA, voffA);
      if (wr == 1) PG8_BAR;
      PG8_WAIT_V(4); PG8_BAR;
      PG8_STAGE(PG8_SB(1, 0), cB + kstep, voffB5); PG8_STAGE(PG8_SA(1, 0), cA + kstep, voffA); PG8_STAGE(PG8_SB(1, 1), cB + hB + kstep, voffB5);
      PG8_WAIT_V(6); PG8_BAR; }
    const int r0 = wr * 64 + fr, c0l = wc * 32 + 8 * fq;
    for (;;) {
        const bool has_next = S.next(ui + 1, nxt);
        const int npm = has_next ? nxt.pm : cur.pm, npn = has_next ? nxt.pn : cur.pn;
#pragma unroll 1
        for (int t = 0; t < NT; t += 2) {
            const bool last = (t == NT - 2);
            const int t2 = last ? 0 : t + 2;
            const char* a1 = M3_TA(cur.pm, t + 1);
            const char* a2 = last ? M3_TA(npm, 0) : M3_TA(cur.pm, t + 2); const char* b2 = last ? M3_TB(npn, 0) : M3_TB(cur.pn, t + 2);
            const char* a3 = a2 + kstep; const char* b3 = b2 + kstep;
            const bool wide = t2 >= 8; const size_t hB = wide ? 131072 : 65536;
            unsigned vB[2]; vB[0] = wide ? voffB10[0] : voffB5[0]; vB[1] = wide ? voffB10[1] : voffB5[1];
            PG8_LDB(B0, 0, 0); PG8_SCHED; PG8_LDA(At, 0, 0); PG8_STAGE(PG8_SA(1, 1), a1 + hstepA, voffA);
            PG8_WAIT_L(8); PG8_BAR; PG8_WAIT_L(0); PG8_MMA(0, 0, At, B0); PG8_BAR; PG8_SCHED;
            PG8_LDB(B1, 0, 1); PG8_STAGE(PG8_SB(0, 0), b2, vB);
            PG8_BAR; PG8_WAIT_L(0); PG8_MMA(0, 1, At, B1); PG8_BAR;
            PG8_LDA(At, 0, 1); PG8_STAGE(PG8_SA(0, 0), a2, voffA);
            PG8_BAR; PG8_WAIT_L(0); PG8_MMA(1, 0, At, B0); PG8_BAR; PG8_SCHED;
            PG8_STAGE(PG8_SB(0, 1), b2 + hB, vB);
            PG8_WAIT_V(6); PG8_BAR; PG8_MMA(1, 1, At, B1); PG8_BAR;
            PG8_LDB(B0, 1, 0); PG8_SCHED; PG8_LDA(At, 1, 0); PG8_STAGE(PG8_SA(0, 1), a2 + hstepA, voffA);
            PG8_WAIT_L(8); PG8_BAR; PG8_WAIT_L(0); PG8_MMA(0, 0, At, B0); PG8_BAR; PG8_SCHED;
            PG8_LDB(B1, 1, 1); PG8_STAGE(PG8_SB(1, 0), b3, vB);
            PG8_BAR; PG8_WAIT_L(0); PG8_MMA(0, 1, At, B1); PG8_BAR;
            PG8_LDA(At, 1, 1); PG8_STAGE(PG8_SA(1, 0), a3, voffA);
            PG8_BAR; PG8_WAIT_L(0); PG8_MMA(1, 0, At, B0); PG8_BAR; PG8_SCHED;
            PG8_STAGE(PG8_SB(1, 1), b3 + hB, vB);
            PG8_WAIT_V(6); PG8_BAR; PG8_MMA(1, 1, At, B1); PG8_BAR;
            if (t == 2 || t == 6) {
                asm volatile("s_nop 15\n\ts_nop 15" ::: "memory");
                const int sg = t == 2 ? 0 : 1; const float wr_ = sg ? g.r12 : g.r01;
                const unsigned char* gp = (const unsigned char*)g.G + ((size_t)(cur.pm * 24 + sg * 8 + cur.pn) << 16) + (size_t)(wid * 8192 + lane * 16);
#pragma unroll
                for (int ai = 0; ai < 2; ++ai) { u32x4 ga[4], gb[4];
#pragma unroll
                    for (int m = 0; m < 4; ++m) { ga[m] = *(const u32x4*)(gp + (ai * 4 + m) * 1024); gb[m] = *(const u32x4*)(gp + (8 << 16) + (ai * 4 + m) * 1024); }
#pragma unroll
                    for (int m = 0; m < 4; ++m)
#pragma unroll
                        for (int bj = 0; bj < 2; ++bj) { const u32x2 x_ = bj ? (u32x2){ga[m].z, ga[m].w} : (u32x2){ga[m].x, ga[m].y}, y_ = bj ? (u32x2){gb[m].z, gb[m].w} : (u32x2){gb[m].x, gb[m].y};
#define M3_RT2(xw, yw, HI, E) (fmaxf(__builtin_amdgcn_cvt_pk_f32_fp8(xw, HI)[E], 0.0009765625f) * wr_ * __builtin_amdgcn_rcpf(fmaxf(__builtin_amdgcn_cvt_pk_f32_fp8(yw, HI)[E], 0.0009765625f)))
                            acc[ai][bj][m][0][0] *= M3_RT2(x_.x, y_.x, false, 0); acc[ai][bj][m][0][1] *= M3_RT2(x_.x, y_.x, false, 1); acc[ai][bj][m][0][2] *= M3_RT2(x_.x, y_.x, true, 0); acc[ai][bj][m][0][3] *= M3_RT2(x_.x, y_.x, true, 1);
                            acc[ai][bj][m][1][0] *= M3_RT2(x_.y, y_.y, false, 0); acc[ai][bj][m][1][1] *= M3_RT2(x_.y, y_.y, false, 1); acc[ai][bj][m][1][2] *= M3_RT2(x_.y, y_.y, true, 0); acc[ai][bj][m][1][3] *= M3_RT2(x_.y, y_.y, true, 1); } }
                asm volatile("s_waitcnt vmcnt(0)" ::: "memory");
            }
        }
        asm volatile("s_nop 15\n\ts_nop 15" ::: "memory");
        { const unsigned char* gp = (const unsigned char*)g.G + ((size_t)(cur.pm * 24 + 16 + cur.pn) << 16) + (size_t)(wid * 8192 + lane * 16); unsigned char* m8 = g.MB8 + (size_t)(cur.pm * 256 + r0) * D + cur.pn * 256 + c0l;
          u32x2 gc[2][4][2];
#pragma unroll
          for (int ai = 0; ai < 2; ++ai)
#pragma unroll
              for (int m = 0; m < 4; ++m) { const u32x4 w_ = *(const u32x4*)(gp + (ai * 4 + m) * 1024); gc[ai][m][0] = (u32x2){w_.x, w_.y}; gc[ai][m][1] = (u32x2){w_.z, w_.w}; }
          const float f_ = g.fin * (1.f / 256.f);
#define M3_G(w, HI, E) (fmaxf(__builtin_amdgcn_cvt_pk_f32_fp8(w, HI)[E], 0.0009765625f) * f_)
#pragma unroll
          for (int ai = 0; ai < 2; ++ai)
#pragma unroll
              for (int m = 0; m < 4; ++m)
#pragma unroll
                  for (int bj = 0; bj < 2; ++bj) { const u32x2 z_ = gc[ai][m][bj]; const f32x4 v0 = acc[ai][bj][m][0], v1 = acc[ai][bj][m][1];
                      u32x2 w8;
                      w8.x = pk4_fp8(clamp8(v0[0] * M3_G(z_.x, false, 0)), clamp8(v0[1] * M3_G(z_.x, false, 1)), clamp8(v0[2] * M3_G(z_.x, true, 0)), clamp8(v0[3] * M3_G(z_.x, true, 1)));
                      w8.y = pk4_fp8(clamp8(v1[0] * M3_G(z_.y, false, 0)), clamp8(v1[1] * M3_G(z_.y, false, 1)), clamp8(v1[2] * M3_G(z_.y, true, 0)), clamp8(v1[3] * M3_G(z_.y, true, 1)));
                      *(u32x2*)(m8 + (size_t)(ai * 128 + m * 16) * D + bj * 128) = w8; } }
        if (!has_next) break;
#pragma unroll
        for (int a = 0; a < 2; ++a)
#pragma unroll
            for (int b = 0; b < 2; ++b)
#pragma unroll
                for (int m = 0; m < 4; ++m)
#pragma unroll
                    for (int n = 0; n < 2; ++n) acc[a][b][m][n] = (f32x4){0.f, 0.f, 0.f, 0.f};
        cur = nxt; ++ui;
    }
    PG8_WAIT_V(0);
    if (wr == 0) PG8_BAR;
    PG8_BAR;
#undef M3_RT2
#undef M3_G
#undef M3_TA
#undef M3_TB
#undef PG8_SA
#undef PG8_SB
#undef PG8_STAGE
#undef PG8_LDA
#undef PG8_LDB
#undef PG8_MMA
#undef PG8_WAIT_V
#undef PG8_WAIT_L
#undef PG8_BAR
#undef PG8_SCHED
}
}
template <bool SRC16>
struct EpiOutT {
    static constexpr bool PERM = false, FP8 = true;
    const float* src_lat; const float* src_ctx; bf16_t* S1; const float* g1; float inv;
    __device__ __forceinline__ void operator()(const Acc& acc, const pg8::Unit& u, int wr, int wc, int fr, int fq) const {
        const int row0 = u.pm * 256 + wr * 64 + fr; const int col0 = u.pn * 256 + wc * 32 + 4 * fq;
        const bool lat = (u.pm * 256) < NLAT;
        const float* src = (lat ? src_lat : src_ctx - (size_t)NLAT * D) + (size_t)row0 * D + col0; bf16_t* dst = S1 + (size_t)row0 * D + col0;
#pragma unroll
        for (int ai = 0; ai < 2; ++ai) { const int rbase = u.pm * 256 + ai * 128 + wr * 64; const int v = lat ? (rbase >> 12) : 4; const float* gp = g1 + (size_t)v * 12288 + col0;
            f32x4 gg[2][2];
#pragma unroll
            for (int bj = 0; bj < 2; ++bj)
#pragma unroll
                for (int n = 0; n < 2; ++n) gg[bj][n] = *(const f32x4*)(gp + bj * 128 + n * 16);
#pragma unroll
            for (int mh = 0; mh < 2; ++mh) {
                f32x4 xr[2][2][2];
#pragma unroll
                for (int mm = 0; mm < 2; ++mm)
#pragma unroll
                    for (int bj = 0; bj < 2; ++bj)
#pragma unroll
                        for (int n = 0; n < 2; ++n) { const size_t o_ = (size_t)(ai * 128 + (mh * 2 + mm) * 16) * D + bj * 128 + n * 16;
                            if constexpr (SRC16) { const u32x2 w_ = *(const u32x2*)(dst + o_); xr[mm][bj][n] = (f32x4){bflo(w_.x), bfhi(w_.x), bflo(w_.y), bfhi(w_.y)}; }
                            else xr[mm][bj][n] = __builtin_nontemporal_load((const f32x4*)(src + o_)); }
#pragma unroll
                for (int mm = 0; mm < 2; ++mm)
#pragma unroll
                    for (int bj = 0; bj < 2; ++bj)
#pragma unroll
                        for (int n = 0; n < 2; ++n) { const int m = mh * 2 + mm;
                            const f32x4 y_ = ABL_MIX ? xr[mm][bj][n] * ALPHA : xr[mm][bj][n] * ALPHA + gg[bj][n] * (acc[ai][bj][m][n] * inv);
                            *(u32x2*)(dst + (size_t)(ai * 128 + m * 16) * D + bj * 128 + n * 16) = (u32x2){cvt_pk_bf16(y_[0], y_[1]), cvt_pk_bf16(y_[2], y_[3])}; } } }
    }
};

struct Args { const float* in[27]; float* out; unsigned char* ws; int ph_lo, ph_hi; };
typedef const Args __attribute__((address_space(4)))* ArgP;
struct Frame {
    LAS unsigned char* lds; int tid, lane, wave, G, bid;
    ArgP ap; float* out; unsigned char* ws;
    __device__ __forceinline__ const float* in(int i) const { return ap->in[i]; }
};
__device__ __forceinline__ Frame make_frame(ArgP ap) {
    { unsigned long long t = (unsigned long long)ap; asm volatile("" : "+s"(t)); ap = (ArgP)t; }
    extern __shared__ __attribute__((aligned(16))) unsigned char lds_raw[];
    Frame F; F.lds = (LAS unsigned char*)lds_raw; { int t_ = threadIdx.x; asm volatile("" : "+v"(t_)); F.tid = t_; }
    F.lane = F.tid & 63; F.wave = __builtin_amdgcn_readfirstlane(F.tid >> 6); F.G = gridDim.x; F.bid = blockIdx.x;
    F.ap = ap; F.out = ap->out; F.ws = ap->ws; return F;
}
template <class T> __device__ __forceinline__ T* wsp(const Frame& F, size_t off) { return (T*)(F.ws + off); }

__device__ __forceinline__ int win_col(int n) {
    if (n < 768) return n;
    if (n < 1792) return 2336 + (n - 768);
    if (n < 2048) return 3360 + (n - 1792);
    if (n < 2304) return 3616 + (n - 2048);
    if (n < 2560) return 800 + (n - 2304);
    if (n < 2816) return 1056 + (n - 2560);
    if (n < 3328) return 1312 + (n - 2816);
    if (n < 3840) return 1824 + (n - 3328);
    if (n < 3872) return 768 + (n - 3840);
    if (n < 4096) return -1;
    return 3872 + (n - 4096);
}
__device__ __forceinline__ int qup_col(int c) {
    const int hh = c / 96, j = c - hh * 96;
    if (j < 64) return c;
    const int jj = j - 64, g8 = jj >> 3, i = jj & 7, p = i >> 1, which = i & 1, part = g8 >> 1, pi = (g8 & 1) * 4 + p;
    return hh * 96 + 64 + part * 16 + which * 8 + pi;
}
template <int MAP>
__device__ __forceinline__ void transpose_cvt(const Frame& F, const float* __restrict__ src, bf16_t* __restrict__ dst, int K, int Nsrc, int Nd) {
    LAS float* tile = (LAS float*)F.lds;
    const int tk = K / 256, tn = Nd / 64, ntile = tk * tn;
    for (int t = F.bid; t < ntile; t += F.G) {
        const int k0 = (t % tk) * 256, n0 = (t / tk) * 64;
        const int nl = F.tid & 63, kq = F.tid >> 6;
        const int nd = n0 + nl; const int ns = MAP == 0 ? nd : (MAP == 1 ? win_col(nd) : qup_col(nd));
        float v[32];
#pragma unroll
        for (int i = 0; i < 32; ++i) v[i] = ns >= 0 ? src[(size_t)(k0 + kq + 8 * i) * Nsrc + ns] : 0.f;
#pragma unroll
        for (int i = 0; i < 32; ++i) tile[(kq + 8 * i) * 65 + nl] = v[i];
        __syncthreads();
        { const int n = F.tid >> 3, k32 = (F.tid & 7) * 32;
#pragma unroll
          for (int c = 0; c < 4; ++c) { float w[8];
#pragma unroll
              for (int j = 0; j < 8; ++j) w[j] = tile[(k32 + c * 8 + j) * 65 + n];
              u32x4 o; o.x = cvt_pk_bf16(w[0], w[1]); o.y = cvt_pk_bf16(w[2], w[3]); o.z = cvt_pk_bf16(w[4], w[5]); o.w = cvt_pk_bf16(w[6], w[7]);
              *(u32x4*)(dst + (size_t)(n0 + n) * K + k0 + k32 + c * 8) = o; } }
        __syncthreads();
    }
}
__device__ __forceinline__ void cvt_rows(const Frame& F, const float* __restrict__ src, bf16_t* __restrict__ dst, size_t n8) {
    for (size_t i = (size_t)F.bid * 512 + F.tid; i < n8; i += (size_t)F.G * 512) {
        const f32x4 a = __builtin_nontemporal_load((const f32x4*)(src + i * 8)), b = __builtin_nontemporal_load((const f32x4*)(src + i * 8 + 4));
        *(u32x4*)(dst + i * 8) = pack8(a, b);
    }
}
__device__ __forceinline__ void cvt_peer(const Frame& F, int l);
__device__ __forceinline__ float max4abs(float am, const f32x4 a) { return fmaxf(fmaxf(fmaxf(am, fabsf(a[0])), fabsf(a[1])), fmaxf(fabsf(a[2]), fabsf(a[3]))); }
__device__ __forceinline__ float wave_absmax(float am) {
    am = row16_max(am);
    { auto r = __builtin_amdgcn_permlane16_swap(__float_as_uint(am), __float_as_uint(am), false, false); am = fmaxf(__uint_as_float(r[0]), __uint_as_float(r[1])); }
    { auto r = __builtin_amdgcn_permlane32_swap(__float_as_uint(am), __float_as_uint(am), false, false); am = fmaxf(__uint_as_float(r[0]), __uint_as_float(r[1])); }
    return am;
}
__device__ __forceinline__ void absmax_commit4(const Frame& F, float a0, float a1, float a2, float a3, unsigned* d0, unsigned* d1, unsigned* d2, unsigned* d3, int nts) {
    LAS float* sl = (LAS float*)F.lds;
    __syncthreads();
    { const float w0 = wave_absmax(a0), w1 = wave_absmax(a1), w2 = wave_absmax(a2), w3 = wave_absmax(a3);
      if (F.lane == 0) { sl[F.wave] = w0; sl[8 + F.wave] = w1; sl[16 + F.wave] = w2; sl[24 + F.wave] = w3; } }
    __syncthreads();
    if (F.tid < nts) { float m = sl[F.tid * 8];
#pragma unroll
        for (int i = 1; i < 8; ++i) m = fmaxf(m, sl[F.tid * 8 + i]);
        unsigned* d = F.tid == 0 ? d0 : (F.tid == 1 ? d1 : (F.tid == 2 ? d2 : d3));
        atomicMax(d, __float_as_uint(m)); }
    __syncthreads();
}
template <int NB>
__device__ __forceinline__ void absmax_f32(const Frame& F, const float* __restrict__ src, size_t n4, unsigned* dst) {
    float am = 0.f;
    const size_t stride = (size_t)F.G * 512; size_t i = (size_t)F.bid * 512 + F.tid;
    for (; i < n4; i += NB * stride) { f32x4 a[NB];
#pragma unroll
        for (int j = 0; j < NB; ++j) { const size_t ix = i + j * stride; a[j] = ix < n4 ? __builtin_nontemporal_load((const f32x4*)(src + ix * 4)) : (f32x4){0.f, 0.f, 0.f, 0.f}; }
#pragma unroll
        for (int j = 0; j < NB; ++j) am = max4abs(am, a[j]); }
    absmax_commit4(F, am, 0.f, 0.f, 0.f, dst, dst, dst, dst, 1);
}
__device__ __forceinline__ void absmax4_f32(const Frame& F, const float* s0, size_t n0, unsigned* d0, const float* s1, size_t n1, unsigned* d1, const float* s2, size_t n2, unsigned* d2, const float* s3, size_t n3, unsigned* d3) {
    const size_t stride = (size_t)F.G * 512, i0 = (size_t)F.bid * 512 + F.tid;
    f32x4 a0[2], a1[2], a2[4], a3[8];
#define AM4_LD(a, NB, s, n) _Pragma("unroll") for (int j = 0; j < NB; ++j) { const size_t ix = i0 + j * stride; a[j] = ix < n ? __builtin_nontemporal_load((const f32x4*)(s + ix * 4)) : (f32x4){0.f, 0.f, 0.f, 0.f}; }
    AM4_LD(a0, 2, s0, n0) AM4_LD(a1, 2, s1, n1) AM4_LD(a2, 4, s2, n2) AM4_LD(a3, 8, s3, n3)
#undef AM4_LD
    float am0_, am1_, am2_, am3_;
#define AM4_RED(a, NB, s, n, out) { float am = 0.f; _Pragma("unroll") for (int j = 0; j < NB; ++j) am = max4abs(am, a[j]); \
        for (size_t i = i0 + NB * stride; i < n; i += stride) am = max4abs(am, *(const f32x4*)(s + i * 4)); out = am; }
    AM4_RED(a0, 2, s0, n0, am0_) AM4_RED(a1, 2, s1, n1, am1_) AM4_RED(a2, 4, s2, n2, am2_) AM4_RED(a3, 8, s3, n3, am3_)
    absmax_commit4(F, am0_, am1_, am2_, am3_, d0, d1, d2, d3, 4);
#undef AM4_RED
}
template <int MAP>
__device__ __forceinline__ void transpose_fp8(const Frame& F, const float* __restrict__ src, unsigned char* __restrict__ dst, int K, int Nsrc, int Nd, const unsigned* wsc) {
    float mul, inv; fp8_scale(__hip_atomic_load(wsc, __ATOMIC_RELAXED, __HIP_MEMORY_SCOPE_AGENT), mul, inv);
    LAS float* tile = (LAS float*)F.lds;
    const int tk = K / 256, tn = Nd / 64, ntile = tk * tn;
    for (int t = F.bid; t < ntile; t += F.G) {
        const int k0 = (t % tk) * 256, n0 = (t / tk) * 64;
        const int nl = F.tid & 63, kq = F.tid >> 6; const int ns = MAP ? win_col(n0 + nl) : n0 + nl;
        float v[32];
#pragma unroll
        for (int i = 0; i < 32; ++i) v[i] = ns >= 0 ? src[(size_t)(k0 + kq + 8 * i) * Nsrc + ns] : 0.f;
#pragma unroll
        for (int i = 0; i < 32; ++i) tile[(kq + 8 * i) * 65 + nl] = v[i] * mul;
        __syncthreads();
        { const int n = F.tid >> 3, k32 = (F.tid & 7) * 32;
#pragma unroll
          for (int c = 0; c < 2; ++c) { float w[16];
#pragma unroll
              for (int j = 0; j < 16; ++j) w[j] = tile[(k32 + c * 16 + j) * 65 + n];
              u32x4 o; o.x = pk4_fp8(w[0], w[1], w[2], w[3]); o.y = pk4_fp8(w[4], w[5], w[6], w[7]); o.z = pk4_fp8(w[8], w[9], w[10], w[11]); o.w = pk4_fp8(w[12], w[13], w[14], w[15]);
              *(u32x4*)(dst + (size_t)(n0 + n) * K + k0 + k32 + c * 16) = o; } }
        __syncthreads();
    }
}
template <int PART = 7>
__device__ __forceinline__ void p0_prologue(const Frame& F) {
    { const int gi = F.bid * 512 + F.tid;
      if (gi < 64 * 8) { const int pos = gi >> 3, f = gi & 7; const float inv = powf(10000.f, -(float)f / 8.f); const float a = (float)pos * inv; wsp<f32x2>(F, WS_ROPE32)[gi] = (f32x2){cosf(a), sinf(a)}; }
      else if (gi < 64 * 8 + 64 * 32) { const int g2 = gi - 512; const int pos = g2 >> 5, f = g2 & 31; const float inv = powf(10000.f, -(float)f / 32.f); const float a = (float)pos * inv; wsp<f32x2>(F, WS_ROPE128)[g2] = (f32x2){cosf(a), sinf(a)}; } }
    if (F.bid == 0 && F.tid < 32) wsp<float>(F, WS_DEC)[F.tid] = -log1pf(expf(-F.in(11)[F.tid])) * LOG2E;
#pragma unroll 1
    for (int s3 = 0; s3 < 3; ++s3) { const int part = (s3 + F.bid) % 3;
    if ((PART & 1) && part == 0) { LAS float* sl = (LAS float*)F.lds;
      float* modp = wsp<float>(F, WS_MODP);
      for (int u = F.bid; u < 2 * 24 * 16; u += F.G) {
          const int kc = u & 15, cb = (u >> 4) % 24, l = u / (16 * 24);
          __syncthreads();
          for (int i = F.tid; i < 640; i += 512) { const int v = i >> 7, k = kc * 128 + (i & 127); const float c = v < 4 ? F.in(1)[v * 2048 + k] : F.in(3)[k]; sl[i] = silu_f(c); }
          __syncthreads();
          const int col = cb * 512 + F.tid; const float* w = F.in(4) + ((size_t)l * 2048 + kc * 128) * 12288 + col;
          float a0 = 0.f, a1 = 0.f, a2 = 0.f, a3 = 0.f, a4 = 0.f;
#pragma unroll 32
          for (int k = 0; k < 128; ++k) { const float wv = w[(size_t)k * 12288]; a0 += sl[k] * wv; a1 += sl[128 + k] * wv; a2 += sl[256 + k] * wv; a3 += sl[384 + k] * wv; a4 += sl[512 + k] * wv; }
          float* o = modp + ((size_t)(kc * 2 + l) * 5) * 12288 + col;
          o[0] = a0; o[12288] = a1; o[2 * 12288] = a2; o[3 * 12288] = a3; o[4 * 12288] = a4;
      }
      __syncthreads(); }
    if ((PART & 2) && part == 1) for (int l = 0; l < 2; ++l) {
        absmax_f32<16>(F, F.in(6) + (size_t)l * 2048 * NIN, (size_t)2048 * NIN / 4, wsp<unsigned>(F, WS_WSC) + l);
        absmax4_f32(F, F.in(14) + (size_t)l * 512 * 2048, (size_t)512 * 2048 / 4, wsp<unsigned>(F, WS_WSC) + 4 + l, F.in(15) + (size_t)l * 512 * 2048, (size_t)512 * 2048 / 4, wsp<unsigned>(F, WS_WSC) + 6 + l,
                    F.in(16) + (size_t)l * 1024 * 2048, (size_t)1024 * 2048 / 4, wsp<unsigned>(F, WS_WSC) + 8 + l, F.in(17) + (size_t)l * 2048 * 2048, (size_t)2048 * 2048 / 4, wsp<unsigned>(F, WS_WSC) + 2 + l);
        if constexpr (!(PART & 8)) {
        transpose_cvt<2>(F, F.in(8) + (size_t)l * 512 * 768, wsp<bf16_t>(F, WS_WQUP + l * SZ_WQUP), 512, 768, 768);
        transpose_cvt<0>(F, F.in(10) + (size_t)l * 256 * 1024, wsp<bf16_t>(F, WS_WKVUP + l * SZ_WKVUP), 256, 1024, 1024);
        transpose_cvt<0>(F, F.in(20) + (size_t)l * 2048 * 1024, wsp<bf16_t>(F, WS_WPQ + l * SZ_WPQ), 2048, 1024, 1024); }
    }
    if ((PART & 4) && part == 2) cvt_peer(F, 0);
    }
}
__device__ __forceinline__ void p1_modreduce(const Frame& F) {
    const float* modp = wsp<float>(F, WS_MODP); float* mod = wsp<float>(F, WS_MOD);
    for (int i = F.bid * 512 + F.tid; i < 2 * 5 * 12288; i += F.G * 512) {
        const int j = i % 12288, l = i / (5 * 12288);
        float s = F.in(5)[l * 12288 + j];
#pragma unroll
        for (int kc = 0; kc < 16; ++kc) s += modp[(size_t)kc * (2 * 5 * 12288) + i];
        mod[i] = s;
    }
    for (int l = 0; l < 2; ++l) {
        transpose_fp8<1>(F, F.in(6) + (size_t)l * 2048 * NIN, wsp<unsigned char>(F, WS_WIN + l * SZ_WIN), 2048, NIN, NPT, wsp<unsigned>(F, WS_WSC) + l);
        transpose_fp8<0>(F, F.in(17) + (size_t)l * 2048 * 2048, wsp<unsigned char>(F, WS_WOUT + l * SZ_WOUT), 2048, 2048, 2048, wsp<unsigned>(F, WS_WSC) + 2 + l);
        transpose_fp8<0>(F, F.in(14) + (size_t)l * 512 * 2048, wsp<unsigned char>(F, WS_WBRA + l * SZ_WBRA), 512, 2048, 2048, wsp<unsigned>(F, WS_WSC) + 4 + l);
        transpose_fp8<0>(F, F.in(15) + (size_t)l * 512 * 2048, wsp<unsigned char>(F, WS_WBRB + l * SZ_WBRB), 512, 2048, 2048, wsp<unsigned>(F, WS_WSC) + 6 + l);
        transpose_fp8<0>(F, F.in(16) + (size_t)l * 1024 * 2048, wsp<unsigned char>(F, WS_WBRC + l * SZ_WBRC), 1024, 2048, 2048, wsp<unsigned>(F, WS_WSC) + 8 + l);
    }
}
__device__ __forceinline__ void ld_row_f32(const float* p, int lane, float (&x)[32]) {
#pragma unroll
    for (int q = 0; q < 4; ++q) { const f32x4 a = *(const f32x4*)(p + 512 * q + 8 * lane), b = *(const f32x4*)(p + 512 * q + 8 * lane + 4);
        x[q * 8 + 0] = a[0]; x[q * 8 + 1] = a[1]; x[q * 8 + 2] = a[2]; x[q * 8 + 3] = a[3]; x[q * 8 + 4] = b[0]; x[q * 8 + 5] = b[1]; x[q * 8 + 6] = b[2]; x[q * 8 + 7] = b[3]; }
}
__device__ __forceinline__ void st_row_f32(float* p, int lane, const float (&x)[32]) {
#pragma unroll
    for (int q = 0; q < 4; ++q) { *(f32x4*)(p + 512 * q + 8 * lane) = (f32x4){x[q * 8 + 0], x[q * 8 + 1], x[q * 8 + 2], x[q * 8 + 3]}; *(f32x4*)(p + 512 * q + 8 * lane + 4) = (f32x4){x[q * 8 + 4], x[q * 8 + 5], x[q * 8 + 6], x[q * 8 + 7]}; }
}
__device__ __forceinline__ void ld_row_bf16(const bf16_t* p, int lane, float (&x)[32]) {
#pragma unroll
    for (int q = 0; q < 4; ++q) { const u32x4 w = *(const u32x4*)(p + 512 * q + 8 * lane);
        x[q * 8 + 0] = bflo(w.x); x[q * 8 + 1] = bfhi(w.x); x[q * 8 + 2] = bflo(w.y); x[q * 8 + 3] = bfhi(w.y); x[q * 8 + 4] = bflo(w.z); x[q * 8 + 5] = bfhi(w.z); x[q * 8 + 6] = bflo(w.w); x[q * 8 + 7] = bfhi(w.w); }
}
__device__ __forceinline__ void st_row_bf16(bf16_t* p, int lane, const float (&x)[32]) {
#pragma unroll
    for (int q = 0; q < 4; ++q) { u32x4 w; w.x = cvt_pk_bf16(x[q * 8 + 0], x[q * 8 + 1]); w.y = cvt_pk_bf16(x[q * 8 + 2], x[q * 8 + 3]); w.z = cvt_pk_bf16(x[q * 8 + 4], x[q * 8 + 5]); w.w = cvt_pk_bf16(x[q * 8 + 6], x[q * 8 + 7]);
        *(u32x4*)(p + 512 * q + 8 * lane) = w; }
}
__device__ __forceinline__ void p_modulate0(const Frame& F) {
    const float* mod = wsp<float>(F, WS_MOD); unsigned char* hb8 = wsp<unsigned char>(F, WS_HB8);
    for (int row = F.bid * 8 + F.wave; row < NROW; row += F.G * 8) {
        const RowInfo ri = rowinfo(row);
        const float* xp = ri.lat ? F.in(0) + (size_t)row * D : F.in(2) + (size_t)(row - NLAT) * D;
        const float* mp = mod + (size_t)ri.v * 12288;
        float x[32], sh[32], sc[32];
        ld_row_f32(xp, F.lane, x); ld_row_f32(mp, F.lane, sh); ld_row_f32(mp + 2048, F.lane, sc);
#pragma unroll
        for (int i = 0; i < 32; ++i) x[i] = clamp8(x[i] * (1.f + sc[i]) + sh[i]);
#pragma unroll
        for (int q = 0; q < 4; ++q) { u32x2 w; w.x = pk4_fp8(x[q * 8 + 0], x[q * 8 + 1], x[q * 8 + 2], x[q * 8 + 3]); w.y = pk4_fp8(x[q * 8 + 4], x[q * 8 + 5], x[q * 8 + 6], x[q * 8 + 7]); *(u32x2*)(hb8 + (size_t)row * D + 512 * q + 8 * F.lane) = w; }
    }
}
__device__ __forceinline__ void p_post(const Frame& F, int l) {
    const unsigned char* P1 = wsp<unsigned char>(F, WS_P1);
    bf16_t* CQN = wsp<bf16_t>(F, WS_CQN); bf16_t* CKVN = wsp<bf16_t>(F, WS_CKVN);
    unsigned char* QG = wsp<unsigned char>(F, WS_QG); unsigned char* KG = wsp<unsigned char>(F, WS_KG); unsigned char* VG = wsp<unsigned char>(F, WS_VG);
    bf16_t* RQ = wsp<bf16_t>(F, WS_RQ); bf16_t* RK = wsp<bf16_t>(F, WS_RK); bf16_t* RV = wsp<bf16_t>(F, WS_RV);
    unsigned char* KM = wsp<unsigned char>(F, WS_KM); unsigned char* QM = wsp<unsigned char>(F, WS_QM);
    const f32x2* cs32 = wsp<f32x2>(F, WS_ROPE32); const f32x2* cs128 = wsp<f32x2>(F, WS_ROPE128);
    const float* gq_n = F.in(7) + l * 512; const float* gkv_n = F.in(9) + l * 256; const float* gqa_qn = F.in(12) + l * 128; const float* gqa_kn = F.in(13) + l * 128;
    LAS bf16_t* rs = (LAS bf16_t*)(F.lds + F.wave * 8192);
    const int lane = F.lane;
    const f32x4 gq0 = *(const f32x4*)(gq_n + lane * 8), gq1 = *(const f32x4*)(gq_n + lane * 8 + 4), gkv0 = *(const f32x4*)(gkv_n + lane * 4);
    const int gd0 = 2 * lane; const int gpart = gd0 >> 6, gdd = gd0 & 63; const bool glo = gdd < 32; const int gf = glo ? gdd : gdd - 32; const int gdp = glo ? gd0 + 32 : gd0 - 32;
    const float qn0 = gqa_qn[gd0], qn1 = gqa_qn[gd0 + 1], qnp0 = gqa_qn[gdp], qnp1 = gqa_qn[gdp + 1];
    const float kn0 = gqa_kn[gd0], kn1 = gqa_kn[gd0 + 1], knp0 = gqa_kn[gdp], knp1 = gqa_kn[gdp + 1];
    const int rhh = lane >> 3, rd0 = (lane & 7) * 4; const int rpart = rd0 >> 4, rdd = rd0 & 15; const bool rlo = rdd < 8; const int rf = rlo ? rdd : rdd - 8; const int rdp = rlo ? rd0 + 8 : rd0 - 8;
    const int step = F.G * 8;
    int row = F.bid * 8 + F.wave;
    u32x4 pre[4];
    if (row < NROW) {
#pragma unroll
        for (int q = 0; q < 4; ++q) pre[q] = *(const u32x4*)(P1 + (size_t)row * NP1 + q * 1024 + lane * 16); }
#pragma unroll 1
    for (; row < NROW; row += step) {
        const RowInfo ri = rowinfo(row);
        const int posg = gpart ? ri.pc : ri.pr, posr = rpart ? ri.pc : ri.pr;
        const f32x2 one = {1.f, 0.f};
        const f32x2 csA = ri.lat ? cs128[posg * 32 + gf] : one, csB = ri.lat ? cs128[posg * 32 + gf + 1] : one;
        f32x2 cs[4];
#pragma unroll
        for (int i = 0; i < 4; ++i) cs[i] = ri.lat ? cs32[posr * 8 + rf + i] : one;
#pragma unroll
        for (int q = 0; q < 4; ++q) {
#pragma unroll
            for (int hf = 0; hf < 2; ++hf) { const unsigned wa = hf ? pre[q].z : pre[q].x, wb = hf ? pre[q].w : pre[q].y;
                const f32x2 a0 = __builtin_amdgcn_cvt_pk_f32_fp8(wa, false) * 0.0625f, a1 = __builtin_amdgcn_cvt_pk_f32_fp8(wa, true) * 0.0625f, b0 = __builtin_amdgcn_cvt_pk_f32_fp8(wb, false) * 0.0625f, b1 = __builtin_amdgcn_cvt_pk_f32_fp8(wb, true) * 0.0625f;
                u32x4 o_; o_.x = cvt_pk_bf16(a0.x, a0.y); o_.y = cvt_pk_bf16(a1.x, a1.y); o_.z = cvt_pk_bf16(b0.x, b0.y); o_.w = cvt_pk_bf16(b1.x, b1.y);
                *(LAS u32x4*)(rs + q * 1024 + lane * 16 + hf * 8) = o_; } }
        { const int nrow = row + step; if (nrow < NROW) {
#pragma unroll
            for (int q = 0; q < 4; ++q) pre[q] = *(const u32x4*)(P1 + (size_t)nrow * NP1 + q * 1024 + lane * 16); } }
        asm volatile("s_waitcnt lgkmcnt(0)" ::: "memory");
        { float x[8]; float ss = 0.f;
#pragma unroll
          for (int i = 0; i < 8; ++i) { x[i] = bf2f(rs[C_CQ + lane * 8 + i]); ss += x[i] * x[i]; }
          ss = wave_sum(ss); const float r = rsqrtf(ss * (1.f / 512.f) + RMS_EPS);
          *(u32x4*)(CQN + (size_t)row * 512 + lane * 8) = pack8((f32x4){x[0] * r * gq0[0], x[1] * r * gq0[1], x[2] * r * gq0[2], x[3] * r * gq0[3]}, (f32x4){x[4] * r * gq1[0], x[5] * r * gq1[1], x[6] * r * gq1[2], x[7] * r * gq1[3]}); }
        { float x[4]; float ss = 0.f;
#pragma unroll
          for (int i = 0; i < 4; ++i) { x[i] = bf2f(rs[C_CKV + lane * 4 + i]); ss += x[i] * x[i]; }
          ss = wave_sum(ss); const float r = rsqrtf(ss * (1.f / 256.f) + RMS_EPS);
          u32x2 w; w.x = cvt_pk_bf16(x[0] * r * gkv0[0], x[1] * r * gkv0[1]); w.y = cvt_pk_bf16(x[2] * r * gkv0[2], x[3] * r * gkv0[3]);
          *(u32x2*)(CKVN + (size_t)row * 256 + lane * 4) = w; }
        {
            const int d0 = gd0, dp = gdp; const bool lo = glo;
#pragma unroll
            for (int hh = 0; hh < 10; ++hh) {
                const bool isq = hh < 8; const int cbase = isq ? C_GQ + hh * 128 : C_GK + (hh - 8) * 128;
                const float g0 = isq ? qn0 : kn0, g1 = isq ? qn1 : kn1, gp0 = isq ? qnp0 : knp0, gp1 = isq ? qnp1 : knp1;
                const float a0 = bf2f(rs[cbase + d0]), a1 = bf2f(rs[cbase + d0 + 1]);
                float ss = wave_sum(a0 * a0 + a1 * a1); const float r = rsqrtf(ss * (1.f / 128.f) + RMS_EPS);
                const float n0 = a0 * r * g0, n1 = a1 * r * g1;
                const float p0 = bf2f(rs[cbase + dp]) * r * gp0, p1 = bf2f(rs[cbase + dp + 1]) * r * gp1;
                float o0, o1;
                if (lo) { o0 = n0 * csA.x - p0 * csA.y; o1 = n1 * csB.x - p1 * csB.y; }
                else    { o0 = p0 * csA.y + n0 * csA.x; o1 = p1 * csB.y + n1 * csB.x; }
                unsigned char* dst = isq ? QG + ((size_t)(ri.b * 8 + hh) * TT + ri.tpos) * 128 : KG + ((size_t)(ri.b * 2 + (hh - 8)) * TT + ri.tpos) * 128;
                const float sc8_ = isq ? QSC_G : KSC8;
                *(unsigned short*)(dst + d0) = (unsigned short)(pk4_fp8(clamp8(o0 * sc8_), clamp8(o1 * sc8_), 0.f, 0.f) & 0xffffu);
            }
#pragma unroll
            for (int hh = 0; hh < 2; ++hh) { const unsigned w8_ = pk4_fp8(clamp8(bf2f(rs[C_GV + hh * 128 + d0])), clamp8(bf2f(rs[C_GV + hh * 128 + d0 + 1])), 0.f, 0.f); unsigned char* vp_ = VG + ((size_t)(ri.b * 2 + hh) * 128 + d0) * TT + vt_off(ri.tpos);
                vp_[0] = (unsigned char)(w8_ & 0xffu); vp_[TT] = (unsigned char)((w8_ >> 8) & 0xffu); }
        }
        {
            const int hh = rhh, d0 = rd0, dp = rdp; const bool lo = rlo;
#pragma unroll
            for (int which = 0; which < 2; ++which) {
                const int cbase = (which ? C_RK : C_RQ) + hh * 32; const float sc = which ? 0.17677669529663687f : 1.f;
                float o[4];
#pragma unroll
                for (int i = 0; i < 4; ++i) { const float n = bf2f(rs[cbase + d0 + i]), p = bf2f(rs[cbase + dp + i]);
                    o[i] = (lo ? (n * cs[i].x - p * cs[i].y) : (p * cs[i].y + n * cs[i].x)) * sc; }
                u32x2 w; w.x = cvt_pk_bf16(o[0], o[1]); w.y = cvt_pk_bf16(o[2], o[3]);
                *(u32x2*)((which ? RK : RQ) + ((size_t)(ri.b * 8 + hh) * TT + ri.tpos) * 32 + d0) = w;
            }
            { const int vh = lane >> 3, e0 = (lane & 7) * 8;
              *(u32x4*)(RV + ((size_t)(ri.b * 8 + vh) * TT + ri.tpos) * 64 + e0) = *(LAS u32x4*)(rs + C_RV + lane * 8); }
            { float o[4];
#pragma unroll
              for (int i = 0; i < 4; ++i) { const float n = bf2f(rs[C_KR + d0 + i]), p = bf2f(rs[C_KR + dp + i]); o[i] = lo ? (n * cs[i].x - p * cs[i].y) : (p * cs[i].y + n * cs[i].x); }
              const size_t tok_ = ((size_t)(ri.b * 8 + hh) * TT + ri.tpos) * 128;
              *(unsigned*)(KM + tok_ + 64 + d0) = pk4_fp8(clamp8(o[0] * KSC8), clamp8(o[1] * KSC8), clamp8(o[2] * KSC8), clamp8(o[3] * KSC8));
              *(unsigned*)(KM + tok_ + 96 + d0) = 0u; *(unsigned*)(QM + tok_ + 96 + d0) = 0u; }
        }
        asm volatile("s_waitcnt lgkmcnt(0)" ::: "memory");
    }
}

__device__ __forceinline__ void ret_logs(const Frame& F, int l, int h, float& lgf, float& lgb) {
    const float* t = wsp<float>(F, WS_DEC); lgf = t[(l * 2 + 0) * 8 + h]; lgb = t[(l * 2 + 1) * 8 + h];
}
constexpr int TP = 136;
template <bool WITH_K>
__device__ __forceinline__ void ret_stage(const Frame& F, const bf16_t* RKh, const bf16_t* RVh, int tpos0, float lgf, float lgb, LAS bf16_t* vt, LAS bf16_t* ktf, LAS bf16_t* ktb) {
#pragma unroll
    for (int i = 0; i < 2; ++i) { const int tok = (F.tid >> 3) + 64 * i, e0 = (F.tid & 7) * 8;
        const u32x4 w = *(const u32x4*)(RVh + (size_t)(tpos0 + tok) * 64 + e0); const unsigned ww[4] = {w.x, w.y, w.z, w.w};
#pragma unroll
        for (int j = 0; j < 4; ++j) { vt[(e0 + 2 * j) * TP + tok] = (bf16_t)(ww[j] & 0xffffu); vt[(e0 + 2 * j + 1) * TP + tok] = (bf16_t)(ww[j] >> 16); } }
    if (WITH_K) { const int tok = F.tid >> 2, k0 = (F.tid & 3) * 8;
        const u32x4 w = *(const u32x4*)(RKh + (size_t)(tpos0 + tok) * 32 + k0); const unsigned ww[4] = {w.x, w.y, w.z, w.w};
        const float zf = exp2f(lgf * (float)(127 - tok)), zb = exp2f(lgb * (float)tok);
#pragma unroll
        for (int j = 0; j < 4; ++j) { const float a = bflo(ww[j]), b = bfhi(ww[j]);
            ktf[(k0 + 2 * j) * TP + tok] = f2bf(a * zf); ktf[(k0 + 2 * j + 1) * TP + tok] = f2bf(b * zf);
            ktb[(k0 + 2 * j) * TP + tok] = f2bf(a * zb); ktb[(k0 + 2 * j + 1) * TP + tok] = f2bf(b * zb); } }
}
__device__ __forceinline__ void p_ret_states(const Frame& F, int l) {
    LAS bf16_t* vt = (LAS bf16_t*)F.lds; LAS bf16_t* ktf = vt + 64 * TP; LAS bf16_t* ktb = ktf + 32 * TP;
    float* ST = wsp<float>(F, WS_ST);
    const int lane = F.lane, w = F.wave, kb = w >> 2, eb = w & 3, fr = lane & 15, fq = lane >> 4;
    for (int u = F.bid; u < NB * 8 * 34; u += F.G) {
        const int c = u % 34, bh = u / 34, h = bh & 7;
        float lgf, lgb; ret_logs(F, l, h, lgf, lgb);
        __syncthreads();
        ret_stage<true>(F, wsp<bf16_t>(F, WS_RK) + (size_t)bh * TT * 32, wsp<bf16_t>(F, WS_RV) + (size_t)bh * TT * 64, c * 128, lgf, lgb, vt, ktf, ktb);
        __syncthreads();
        f32x4 sf = {0.f, 0.f, 0.f, 0.f}, sb = {0.f, 0.f, 0.f, 0.f};
#pragma unroll
        for (int ks = 0; ks < 4; ++ks) {
            const bf16x8 bv = *(const LAS bf16x8*)(vt + (eb * 16 + fr) * TP + ks * 32 + fq * 8);
            const bf16x8 af = *(const LAS bf16x8*)(ktf + (kb * 16 + fr) * TP + ks * 32 + fq * 8);
            const bf16x8 ab = *(const LAS bf16x8*)(ktb + (kb * 16 + fr) * TP + ks * 32 + fq * 8);
            sf = __builtin_amdgcn_mfma_f32_16x16x32_bf16(af, bv, sf, 0, 0, 0);
            sb = __builtin_amdgcn_mfma_f32_16x16x32_bf16(ab, bv, sb, 0, 0, 0);
        }
        float* o = ST + (size_t)u * 2 * 2048;
#pragma unroll
        for (int r = 0; r < 4; ++r) { const int kd = kb * 16 + fq * 4 + r, e = eb * 16 + fr; o[kd * 64 + e] = sf[r]; o[2048 + kd * 64 + e] = sb[r]; }
    }
}
constexpr int RP = 40;
constexpr int AP = 136;
__device__ __forceinline__ void ret_out_unit(const Frame& F, int l, int bh, int c) {
    LAS bf16_t* vt = (LAS bf16_t*)F.lds; LAS bf16_t* rtf = vt + 64 * TP; LAS bf16_t* rtb = rtf + 64 * RP; LAS bf16_t* as = rtb + 64 * RP + F.wave * 16 * AP;
    const int lane = F.lane, w = F.wave, fr = lane & 15, fq = lane >> 4, h = bh & 7, b = bh >> 3;
    const bf16_t* RQh = wsp<bf16_t>(F, WS_RQ) + (size_t)bh * TT * 32; const bf16_t* RKh = wsp<bf16_t>(F, WS_RK) + (size_t)bh * TT * 32; const bf16_t* RVh = wsp<bf16_t>(F, WS_RV) + (size_t)bh * TT * 64;
    const float* STh = wsp<float>(F, WS_ST) + (size_t)bh * 34 * 2 * 2048;
    float lgf, lgb; ret_logs(F, l, h, lgf, lgb);
    const int tpos0 = c * 128;
    const int i0 = w * 16;
    const bf16x8 qa = *(const bf16x8*)(RQh + (size_t)(tpos0 + i0 + fr) * 32 + fq * 8);
    bf16x8 kfr[8];
#pragma unroll
    for (int nb = 0; nb < 8; ++nb) kfr[nb] = *(const bf16x8*)(RKh + (size_t)(tpos0 + nb * 16 + fr) * 32 + fq * 8);
    const unsigned char* P1 = wsp<unsigned char>(F, WS_P1); unsigned char* OAB = wsp<unsigned char>(F, WS_OAB);
    unsigned char gv[4][4];
#pragma unroll
    for (int r = 0; r < 4; ++r) { const int tp = tpos0 + i0 + fq * 4 + r; const size_t grow = tp >= CTXL ? (size_t)b * SEQ + (tp - CTXL) : (size_t)NLAT + b * CTXL + tp;
#pragma unroll
        for (int eb = 0; eb < 4; ++eb) gv[r][eb] = P1[grow * NP1 + C_RG + h * 64 + eb * 16 + fr]; }
    __syncthreads();
    ret_stage<false>(F, RKh, RVh, tpos0, lgf, lgb, vt, nullptr, nullptr);
    { const int kd = F.tid >> 4, e4 = (F.tid & 15) * 4; f32x4 rf = {0.f, 0.f, 0.f, 0.f}, rb = {0.f, 0.f, 0.f, 0.f};
      if (c >= 2) {
          const int p = c - 2;
          const float kff = 80.f / (-lgf * 128.f), kfb = 80.f / (-lgb * 128.f); const int kcf = kff < 64.f ? (int)kff + 1 : 64, kcb = kfb < 64.f ? (int)kfb + 1 : 64;
          const int nf = c < kcf ? c : kcf, nb_ = (33 - p) < kcb ? (33 - p) : kcb;
          const float* sf = STh + kd * 64 + e4;
          for (int k0 = 0; k0 < nf; k0 += 8) { f32x4 v[8];
#pragma unroll
              for (int j = 0; j < 8; ++j) { const int k = k0 + j; const int cp = k < nf ? c - 1 - k : 0; v[j] = *(const f32x4*)(sf + (size_t)(cp * 2 + 0) * 2048); }
#pragma unroll
              for (int j = 0; j < 8; ++j) { const int k = k0 + j; const float wgt = k < nf ? __builtin_amdgcn_exp2f(lgf * 128.f * (float)k) : 0.f; rf += v[j] * wgt; } }
          for (int k0 = 0; k0 < nb_; k0 += 8) { f32x4 v[8];
#pragma unroll
              for (int j = 0; j < 8; ++j) { const int k = k0 + j; const int pp = k < nb_ ? p + 1 + k : 33; const int cs = pp < 32 ? pp + 2 : pp - 32; v[j] = *(const f32x4*)(sf + (size_t)(cs * 2 + 1) * 2048); }
#pragma unroll
              for (int j = 0; j < 8; ++j) { const int k = k0 + j; const float wgt = k < nb_ ? __builtin_amdgcn_exp2f(lgb * 128.f * (float)k) : 0.f; rb += v[j] * wgt; } }
      } else if (c == 0) { rb = *(const f32x4*)(STh + (size_t)(1 * 2 + 1) * 2048 + kd * 64 + e4); }
      else { rf = *(const f32x4*)(STh + (size_t)(0 * 2 + 0) * 2048 + kd * 64 + e4); }
#pragma unroll
      for (int j = 0; j < 4; ++j) { rtf[(e4 + j) * RP + kd] = f2bf(rf[j]); rtb[(e4 + j) * RP + kd] = f2bf(rb[j]); } }
    f32x4 s[8];
#pragma unroll
    for (int nb = 0; nb < 8; ++nb) s[nb] = __builtin_amdgcn_mfma_f32_16x16x32_bf16(qa, kfr[nb], (f32x4){0.f, 0.f, 0.f, 0.f}, 0, 0, 0);
#pragma unroll
    for (int nb = 0; nb < 8; ++nb)
#pragma unroll
        for (int r = 0; r < 4; ++r) { const int i = i0 + fq * 4 + r, j = nb * 16 + fr; const int df = i - j;
            const float mk = df > 0 ? exp2f(lgf * (float)df) : (df < 0 ? exp2f(lgb * (float)(-df)) : 2.f);
            as[(fq * 4 + r) * AP + j] = f2bf(s[nb][r] * mk); }
    __syncthreads();
    f32x4 y[4];
#pragma unroll
    for (int eb = 0; eb < 4; ++eb) y[eb] = (f32x4){0.f, 0.f, 0.f, 0.f};
#pragma unroll
    for (int ks = 0; ks < 4; ++ks) { const bf16x8 af = *(const LAS bf16x8*)(as + fr * AP + ks * 32 + fq * 8);
#pragma unroll
        for (int eb = 0; eb < 4; ++eb) { const bf16x8 bv = *(const LAS bf16x8*)(vt + (eb * 16 + fr) * TP + ks * 32 + fq * 8);
            y[eb] = __builtin_amdgcn_mfma_f32_16x16x32_bf16(af, bv, y[eb], 0, 0, 0); } }
    { const float xf = exp2f(lgf * (float)(i0 + fr + 1)), xb = exp2f(lgb * (float)(128 - (i0 + fr)));
      bf16x8 qf, qb;
#pragma unroll
      for (int j = 0; j < 8; ++j) { const float qv = bf2f((bf16_t)qa[j]); qf[j] = (short)f2bf(qv * xf); qb[j] = (short)f2bf(qv * xb); }
#pragma unroll
      for (int eb = 0; eb < 4; ++eb) { const bf16x8 bf_ = *(const LAS bf16x8*)(rtf + (eb * 16 + fr) * RP + fq * 8), bb_ = *(const LAS bf16x8*)(rtb + (eb * 16 + fr) * RP + fq * 8);
          y[eb] = __builtin_amdgcn_mfma_f32_16x16x32_bf16(qf, bf_, y[eb], 0, 0, 0);
          y[eb] = __builtin_amdgcn_mfma_f32_16x16x32_bf16(qb, bb_, y[eb], 0, 0, 0); } }
#pragma unroll
    for (int r = 0; r < 4; ++r) {
        float sm = y[0][r] + y[1][r] + y[2][r] + y[3][r]; sm = row16_sum(sm); const float mu = sm * (1.f / 64.f);
        float vs = 0.f;
#pragma unroll
        for (int eb = 0; eb < 4; ++eb) { const float d = y[eb][r] - mu; vs += d * d; }
        vs = row16_sum(vs); const float rstd = rsqrtf(vs * (1.f / 64.f) + LN_EPS);
        const int i = i0 + fq * 4 + r; const int tp = tpos0 + i; const size_t grow = tp >= CTXL ? (size_t)b * SEQ + (tp - CTXL) : (size_t)NLAT + b * CTXL + tp;
#pragma unroll
        for (int eb = 0; eb < 4; ++eb) { const int e = eb * 16 + fr; const float g = __builtin_amdgcn_cvt_f32_fp8((int)gv[r][eb], 0) * 0.0625f;
            OAB[grow * D + 512 + h * 64 + e] = (unsigned char)(pk4_fp8(clamp8(silu_f(g) * (y[eb][r] - mu) * rstd * 16.f), 0.f, 0.f, 0.f) & 0xffu); }
    }
}
namespace att {
constexpr int NW = 8, QBLK = 32, KVBLK = 64;
constexpr int SHM_K = KVBLK * 128, SHM_V = 128 * 64;
constexpr size_t SHM_ATTN = 4 * SHM_K + 3 * SHM_V + 2048;
constexpr float THR = 1.9f, PSH = 6.f, THR2 = THR * 1.4426950408889634f;
#define SBAR() __builtin_amdgcn_sched_barrier(0)
typedef int i32x8a __attribute__((ext_vector_type(8))); typedef int i32x4a __attribute__((ext_vector_type(4)));
template <int SC> struct Scale { static constexpr float S = SC == 0 ? 0.08838834764831845f : 0.10206207261596575f; static constexpr float C = S * 1.4426950408889634f; static constexpr float THRR = THR / S; };
#define KSWZ8(row, chunk) ((row) * 128 + ((((chunk) ^ (((row) >> 1) & 7))) << 4))
#define VSWZ8(col, chunk) ((col) * 64 + ((((chunk) ^ (((col) >> 2) & 3))) << 4))
#define MF8(A, B, C) mf8x<ABL>(A, B, C)
#define CAT8(lo, hi) __builtin_shufflevector(lo, hi, 0, 1, 2, 3, 4, 5, 6, 7)
#define LDS16(p) ((ABL & 8) ? __builtin_shufflevector(qr8[0], qr8[1], 0, 1, 10, 11) : *(const LAS i32x4a*)(p))
template <int A, int B, int ABL = 0> __device__ __forceinline__ void exp_rng(f32x16& p) {
#pragma unroll
  for (int r = A; r < B; ++r) p[r] = (ABL & 1) ? p[r] * p[r] : __builtin_amdgcn_exp2f(p[r]);
}
template <int ABL> __device__ __forceinline__ f32x16 mf8x(const i32x8a a, const i32x8a b, f32x16 c) {
  if constexpr (ABL & 2) { c[0] += __int_as_float(((a[0] ^ a[4]) + (b[0] ^ b[4])) & 0x3f000000); return c; }
  else return __builtin_amdgcn_mfma_scale_f32_32x32x64_f8f6f4(a, b, c, 0, 0, 0, 0x7F7F7F7F, 0, 0x7F7F7F7F);
}
__device__ __forceinline__ void pk_fma16(f32x16& p, float c, float d) { const f32x2 c2 = {c, c}, d2 = {d, d};
#pragma unroll
  for (int i = 0; i < 8; ++i) { f32x2 v = {p[2 * i], p[2 * i + 1]}; v = v * c2 + d2; p[2 * i] = v.x; p[2 * i + 1] = v.y; }
}
__device__ __forceinline__ void pk_add16(f32x16& p, float c) { const f32x2 c2 = {c, c};
#pragma unroll
  for (int i = 0; i < 8; ++i) { f32x2 v = {p[2 * i], p[2 * i + 1]}; v = v + c2; p[2 * i] = v.x; p[2 * i + 1] = v.y; }
}
__device__ __forceinline__ void pk_mul16(f32x16& p, float c) { const f32x2 c2 = {c, c};
#pragma unroll
  for (int i = 0; i < 8; ++i) { f32x2 v = {p[2 * i], p[2 * i + 1]}; v = v * c2; p[2 * i] = v.x; p[2 * i + 1] = v.y; }
}
__device__ __forceinline__ float pk_sum32(const f32x16& p0, const f32x16& p1) { f32x2 s0 = {p0[0], p0[1]}, s1 = {p1[0], p1[1]};
#pragma unroll
  for (int i = 1; i < 8; ++i) { s0 += (f32x2){p0[2 * i], p0[2 * i + 1]}; s1 += (f32x2){p1[2 * i], p1[2 * i + 1]}; }
  s0 += s1; return s0.x + s0.y;
}
__device__ __forceinline__ float hsum(float v) { auto rr = __builtin_amdgcn_permlane32_swap(__float_as_uint(v), __float_as_uint(v), false, false); return __uint_as_float(rr[0]) + __uint_as_float(rr[1]); }
__device__ __forceinline__ float hmax(float v) { auto rr = __builtin_amdgcn_permlane32_swap(__float_as_uint(v), __float_as_uint(v), false, false); return fmaxf(__uint_as_float(rr[0]), __uint_as_float(rr[1])); }
template <int NDV, int SC, int ABL>
__device__ __forceinline__ void attn_body(const unsigned char* __restrict__ Qb, const unsigned char* __restrict__ Kh, const unsigned char* __restrict__ Vt,
                                          unsigned char* __restrict__ Ob, int seq, LAS unsigned char* lds, const int tid) {
  constexpr int ldo = 2048;
  const int wid = __builtin_amdgcn_readfirstlane(tid >> 6), lane = tid & 63, r32 = lane & 31, hi = lane >> 5;
  LAS unsigned char* K_lds = lds; LAS unsigned char* V_lds = lds + 4 * SHM_K;
  constexpr bool LSUM = true, PF = (NDV == 2); constexpr int NO = NDV + (LSUM ? 1 : 0);
  float l_reg = 0; f32x16 o[NO] = {}; f32x16 negm; i32x8a qr8[2];
  LAS unsigned char* ones_lds = lds + 4 * SHM_K + 3 * SHM_V;
  i32x8a vones_r; { const int w1_ = r32 == 0 ? 0x38383838 : 0;
#pragma unroll
    for (int i = 0; i < 8; ++i) vones_r[i] = w1_; }
  if constexpr (NDV == 4) { int t4_ = tid; asm volatile("" : "+v"(t4_));
    const int w1_ = t4_ < 4 ? 0x38383838 : 0; if (t4_ < 128) *(LAS i32x4a*)(ones_lds + t4_ * 16) = (i32x4a){w1_, w1_, w1_, w1_}; }
#define VONES() (NDV == 4 ? CAT8(LDS16(ones_lds + r32 * 64 + hi * 32), LDS16(ones_lds + r32 * 64 + hi * 32 + 16)) : vones_r)
  const unsigned char* Qw = Qb + (long)(wid * QBLK + r32) * 128 + hi * 32;
#pragma unroll
  for (int blk = 0; blk < 2; ++blk) { const i32x4a lo_ = *reinterpret_cast<const i32x4a*>(Qw + blk * 64), hi_ = *reinterpret_cast<const i32x4a*>(Qw + blk * 64 + 16); qr8[blk] = CAT8(lo_, hi_); }
  const int NT = seq / KVBLK;
  const int kr8 = 8 * wid + (lane >> 3), vcol = 16 * (wid & (NDV * 2 - 1)) + (lane >> 2);
  const unsigned char* kgp = Kh + (long)kr8 * 128 + (((lane & 7) ^ ((kr8 >> 1) & 7)) << 4);
  const unsigned char* vgp = Vt + (long)vcol * TT + (((lane & 3) ^ ((vcol >> 2) & 3)) << 4);
  const int kdo = wid * 1024, vdo = (wid & (NDV * 2 - 1)) * 1024;
  const int ka0 = KSWZ8(r32, 2 * hi), ka1 = KSWZ8(r32, 2 * hi + 1), va0 = VSWZ8(r32, 2 * hi), va1 = VSWZ8(r32, 2 * hi + 1);
#define DMAK(t, bo) do { const int t_ = (t) < NT ? (t) : NT - 1; __builtin_amdgcn_global_load_lds((const unsigned*)(kgp + (long)t_ * (KVBLK * 128)), (LAS unsigned*)(K_lds + (bo) + kdo), 16, 0, 0); } while (0)
#define DMAV(t, bo) do { const int t_ = (t) < NT ? (t) : NT - 1; __builtin_amdgcn_global_load_lds((const unsigned*)(vgp + t_ * KVBLK), (LAS unsigned*)(V_lds + (bo) + vdo), 16, 0, 0); } while (0)
#define VMW(n) asm volatile("s_waitcnt vmcnt(" #n ")" ::: "memory")
#define BAR() __builtin_amdgcn_s_barrier()
  f32x16 pA0, pA1, pB0, pB1; float alA, alB; i32x8a pa;
#define PSM2(p0, p1, al) do { float pm_ = fmaxf(p0[0], p1[0]);                                                                          \
    _Pragma("unroll") for (int r = 1; r < 16; ++r) pm_ = fmaxf(fmaxf(pm_, p0[r]), p1[r]);                                               \
    pm_ = hmax(pm_); al = 1.f;                                                                                                           \
    if (__builtin_expect(!__all(pm_ <= PSH + THR2), 0)) { const float d_ = fmaxf(pm_ - PSH, 0.f); al = __builtin_amdgcn_exp2f(-d_); pk_add16(p0, -d_); pk_add16(p1, -d_); pk_add16(negm, -d_); } } while (0)
#define PT3(x, y, z) asm volatile("" : "+v"(x), "+v"(y), "+v"(z))
#define PT4(x, y, z, w) asm volatile("" : "+v"(x), "+v"(y), "+v"(z), "+v"(w))
#define STEP(j, pc0, pc1, alc, pn0, pn1, aln) do { const LAS unsigned char* Kr_ = K_lds + kb_rd; const LAS unsigned char* Vs_ = V_lds + vb_rd;  \
    i32x8a kc_ = CAT8(LDS16(Kr_ + (ka0 ^ 64)), LDS16(Kr_ + (ka1 ^ 64))), kd_ = CAT8(LDS16(Kr_ + 4096 + (ka0 ^ 64)), LDS16(Kr_ + 4096 + (ka1 ^ 64))); \
    if constexpr (!PF) { kpa = CAT8(LDS16(Kr_ + ka0), LDS16(Kr_ + ka1)); kpb = CAT8(LDS16(Kr_ + 4096 + ka0), LDS16(Kr_ + 4096 + ka1)); }              \
    pn0 = MF8(kpa, qr8[0], negm); exp_rng<0, 6, ABL>(pc1); PT3(pn0, pc1, kpb);                                                     \
    pn1 = MF8(kpb, qr8[0], negm); exp_rng<6, 12, ABL>(pc1); PT3(pn1, pc1, kc_);                                                    \
    pn0 = MF8(kc_, qr8[1], pn0); exp_rng<12, 16, ABL>(pc1);                                                                              \
    if constexpr (!LSUM) { float ps_ = pk_sum32(pc0, pc1); ps_ = hsum(ps_); l_reg = l_reg * alc + ps_; }                                   \
    i32x8a va_ = CAT8(LDS16(Vs_ + va0), LDS16(Vs_ + va1)), vb_ = CAT8(LDS16(Vs_ + 2048 + va0), LDS16(Vs_ + 2048 + va1));                  \
    PT4(pn0, pc1, kd_, l_reg);                                                                                                           \
    pn1 = MF8(kd_, qr8[1], pn1);                                                                                                         \
    _Pragma("unroll") for (int q = 0; q < 4; ++q) { pa[q] = (int)pk4_fp8(pc0[4 * q], pc0[4 * q + 1], pc0[4 * q + 2], pc0[4 * q + 3]); pa[4 + q] = (int)pk4_fp8(pc1[4 * q], pc1[4 * q + 1], pc1[4 * q + 2], pc1[4 * q + 3]); } \
    PT3(pn1, pa, va_);                                                                                                                   \
    if constexpr (!(ABL & 128)) { DMAK((j) + 4, kb_wr); DMAV((j) + 2, vb_wr); }                                                          \
    o[0] = MF8(va_, pa, o[0]); PSM2(pn0, pn1, aln); PT3(o[0], pn0, vb_);                                                  \
    o[1] = MF8(vb_, pa, o[1]); exp_rng<0, 4, ABL>(pn0);                                   \
    if constexpr (NDV == 4) { i32x8a vc_ = CAT8(LDS16(Vs_ + 4096 + va0), LDS16(Vs_ + 4096 + va1)), vd_ = CAT8(LDS16(Vs_ + 6144 + va0), LDS16(Vs_ + 6144 + va1)); \
      PT4(o[1], pn0, pn1, vc_); o[2] = MF8(vc_, pa, o[2]); exp_rng<4, 10, ABL>(pn0); PT3(o[2], pn0, vd_);                                \
      o[3] = MF8(vd_, pa, o[3]); exp_rng<10, 14, ABL>(pn0); PT3(o[3], pn0, pn1); o[4] = MF8(VONES(), pa, o[4]); exp_rng<14, 16, ABL>(pn0); }      \
    else { PT3(o[1], pn0, pn1); o[2] = MF8(VONES(), pa, o[2]); exp_rng<4, 10, ABL>(pn0); PT3(o[2], pn0, pn1); exp_rng<10, 16, ABL>(pn0); }    \
    if constexpr (PF) { const LAS unsigned char* Kp_ = K_lds + kb_pf; kpa = CAT8(LDS16(Kp_ + ka0), LDS16(Kp_ + ka1)); kpb = CAT8(LDS16(Kp_ + 4096 + ka0), LDS16(Kp_ + 4096 + ka1)); } \
    PT3(o[NO - 1], pn0, pn1); RESC(aln);                                                                                               \
    { const int t_ = kb_rd; kb_rd = kb_pf; kb_pf = kb_x; kb_x = kb_wr; kb_wr = t_; const int u_ = vb_rd; vb_rd = vb_n1; vb_n1 = vb_wr; vb_wr = u_; } \
    VMW(2); if constexpr (!(ABL & 4)) BAR(); } while (0)
#define RESC(a) do { if (__any((a) < 1.f)) { _Pragma("unroll") for (int d = 0; d < NO; ++d) pk_mul16(o[d], (a)); } } while (0)
  i32x8a kpa, kpb; int kb_rd = SHM_K, kb_pf = 2 * SHM_K, kb_x = 3 * SHM_K, kb_wr = 0, vb_rd = 0, vb_n1 = SHM_V, vb_wr = 2 * SHM_V;
  DMAK(0, 0); DMAK(1, SHM_K); DMAK(2, 2 * SHM_K); DMAK(3, 3 * SHM_K); DMAV(0, 0); DMAV(1, SHM_V); VMW(0); BAR();
  { const LAS unsigned char* Ks_ = K_lds;
    pA0 = MF8(CAT8(LDS16(Ks_ + ka0), LDS16(Ks_ + ka1)), qr8[0], (f32x16){}); pA1 = MF8(CAT8(LDS16(Ks_ + 4096 + ka0), LDS16(Ks_ + 4096 + ka1)), qr8[0], (f32x16){});
    pA0 = MF8(CAT8(LDS16(Ks_ + (ka0 ^ 64)), LDS16(Ks_ + (ka1 ^ 64))), qr8[1], pA0); pA1 = MF8(CAT8(LDS16(Ks_ + 4096 + (ka0 ^ 64)), LDS16(Ks_ + 4096 + (ka1 ^ 64))), qr8[1], pA1);
    float pm_ = fmaxf(pA0[0], pA1[0]);
#pragma unroll
    for (int r = 1; r < 16; ++r) pm_ = fmaxf(fmaxf(pm_, pA0[r]), pA1[r]);
    pm_ = hmax(pm_);
    const float nv_ = PSH - pm_; pk_add16(pA0, nv_); pk_add16(pA1, nv_);
#pragma unroll
    for (int r = 0; r < 16; ++r) negm[r] = nv_;
    alA = 1.f; exp_rng<0, 16, ABL>(pA0);
    if constexpr (PF) { const LAS unsigned char* Kp_ = K_lds + SHM_K; kpa = CAT8(LDS16(Kp_ + ka0), LDS16(Kp_ + ka1)); kpb = CAT8(LDS16(Kp_ + 4096 + ka0), LDS16(Kp_ + 4096 + ka1)); } }
  asm volatile("s_waitcnt lgkmcnt(0)" ::: "memory"); BAR();
  int j = 0;
  for (; j + 2 < NT; j += 2) { STEP(j, pA0, pA1, alA, pB0, pB1, alB); STEP(j + 1, pB0, pB1, alB, pA0, pA1, alA); }
  STEP(j, pA0, pA1, alA, pB0, pB1, alB);
  { exp_rng<0, 16, ABL>(pB1); if constexpr (!LSUM) { float ps_ = pk_sum32(pB0, pB1); ps_ = hsum(ps_); l_reg = l_reg * alB + ps_; }
#pragma unroll
    for (int q = 0; q < 4; ++q) { pa[q] = (int)pk4_fp8(pB0[4 * q], pB0[4 * q + 1], pB0[4 * q + 2], pB0[4 * q + 3]); pa[4 + q] = (int)pk4_fp8(pB1[4 * q], pB1[4 * q + 1], pB1[4 * q + 2], pB1[4 * q + 3]); }
    const LAS unsigned char* Vs_ = V_lds + vb_rd;
#pragma unroll
    for (int d0 = 0; d0 < NDV; ++d0) o[d0] = MF8(CAT8(LDS16(Vs_ + d0 * 2048 + va0), LDS16(Vs_ + d0 * 2048 + va1)), pa, o[d0]);
    if constexpr (LSUM) { o[NDV] = MF8(VONES(), pa, o[NDV]); l_reg = hsum(o[NDV][0]); } }
  const float rl = __builtin_amdgcn_rcpf(l_reg) * 16.f;
  unsigned char* Ow = Ob + (long)(wid * QBLK + r32) * ldo + 4 * hi;
#pragma unroll
  for (int d0 = 0; d0 < NDV; ++d0)
#pragma unroll
    for (int g = 0; g < 4; ++g) *(unsigned*)(Ow + d0 * 32 + 8 * g) = pk4_fp8(clamp8(o[d0][4 * g] * rl), clamp8(o[d0][4 * g + 1] * rl), clamp8(o[d0][4 * g + 2] * rl), clamp8(o[d0][4 * g + 3] * rl));
#undef DMAK
#undef DMAV
#undef VMW
#undef BAR
#undef PSM2
#undef VONES
#undef REGION_X
#undef REGION_Y
#undef RESC
#undef STEP
#undef PT3
#undef PT4
}
}
__device__ __forceinline__ float* xres_row(const Frame& F, int row) { return row < NLAT ? F.out + (size_t)row * D : wsp<float>(F, WS_XC) + (size_t)(row - NLAT) * D; }
__device__ __forceinline__ void ln_row(float (&y)[32], const float* g, const float* b, int lane) {
    float s = 0.f;
#pragma unroll
    for (int i = 0; i < 32; ++i) s += y[i];
    const float mu = wave_sum(s) * (1.f / 2048.f);
    float q = 0.f;
#pragma unroll
    for (int i = 0; i < 32; ++i) { const float d = y[i] - mu; q += d * d; }
    const float rstd = rsqrtf(wave_sum(q) * (1.f / 2048.f) + LN_EPS);
#pragma unroll
    for (int qq = 0; qq < 4; ++qq) { const f32x4 g0 = *(const f32x4*)(g + 512 * qq + 8 * lane), g1 = *(const f32x4*)(g + 512 * qq + 8 * lane + 4), b0 = *(const f32x4*)(b + 512 * qq + 8 * lane), b1 = *(const f32x4*)(b + 512 * qq + 8 * lane + 4);
#pragma unroll
        for (int i = 0; i < 4; ++i) { y[qq * 8 + i] = (y[qq * 8 + i] - mu) * rstd * g0[i] + b0[i]; y[qq * 8 + 4 + i] = (y[qq * 8 + 4 + i] - mu) * rstd * g1[i] + b1[i]; } }
}
__device__ __forceinline__ void modulate_store(const float (&x)[32], const float* sh, const float* sc, bf16_t* dst, int lane) {
#pragma unroll
    for (int q = 0; q < 4; ++q) { const f32x4 h0 = *(const f32x4*)(sh + 512 * q + 8 * lane), h1 = *(const f32x4*)(sh + 512 * q + 8 * lane + 4), c0 = *(const f32x4*)(sc + 512 * q + 8 * lane), c1 = *(const f32x4*)(sc + 512 * q + 8 * lane + 4);
        f32x4 a, b;
#pragma unroll
        for (int i = 0; i < 4; ++i) { a[i] = x[q * 8 + i] * (1.f + c0[i]) + h0[i]; b[i] = x[q * 8 + 4 + i] * (1.f + c1[i]) + h1[i]; }
        *(u32x4*)(dst + 512 * q + 8 * lane) = pack8(a, b); }
}
__device__ __forceinline__ void p_ln1(const Frame& F, int l, bool last) {
    const float* mod = wsp<float>(F, WS_MOD) + (size_t)l * 5 * 12288; bf16_t* hb = wsp<bf16_t>(F, WS_HB);
    const float* g = F.in(18) + l * D; const float* b = F.in(19) + l * D;
    const int nrows = last ? NLAT : NROW; const int lane = F.lane, step = F.G * 8;
    float gg[32], bb[32]; ld_row_f32(g, lane, gg); ld_row_f32(b, lane, bb);
    int row = F.bid * 8 + F.wave;
    float yn[32];
    bf16_t* S1 = wsp<bf16_t>(F, WS_S1);
    if (row < nrows) ld_row_bf16(S1 + (size_t)row * D, lane, yn);
#pragma unroll 1
    for (; row < nrows; row += step) {
        const int v = row < NLAT ? (row >> 12) : 4; bf16_t* xp = S1 + (size_t)row * D;
        float y[32], sh[32], sc[32];
#pragma unroll
        for (int i = 0; i < 32; ++i) y[i] = yn[i];
        ld_row_f32(mod + (size_t)v * 12288 + 6144, lane, sh); ld_row_f32(mod + (size_t)v * 12288 + 8192, lane, sc);
        { const int nrow = row + step; if (nrow < nrows) ld_row_bf16(S1 + (size_t)nrow * D, lane, yn); }
        float s = 0.f;
#pragma unroll
        for (int i = 0; i < 32; ++i) s += y[i];
        const float mu = wave_sum(s) * (1.f / 2048.f); float q = 0.f;
#pragma unroll
        for (int i = 0; i < 32; ++i) { const float d = y[i] - mu; q += d * d; }
        const float rstd = rsqrtf(wave_sum(q) * (1.f / 2048.f) + LN_EPS);
#pragma unroll
        for (int i = 0; i < 32; ++i) y[i] = (y[i] - mu) * rstd * gg[i] + bb[i];
        st_row_bf16(xp, lane, y);
#pragma unroll
        for (int i = 0; i < 32; ++i) y[i] = y[i] * (1.f + sc[i]) + sh[i];
        st_row_bf16(hb + (size_t)row * D, lane, y);
    }
}

template <int NV>
__device__ __forceinline__ void top16(const float (&val)[NV], bool (&sel)[NV], int (&slot)[NV]) {
    unsigned key[NV];
#pragma unroll
    for (int v = 0; v < NV; ++v) { const unsigned u = __float_as_uint(val[v]); key[v] = (u & 0x80000000u) ? ~u : (u | 0x80000000u); }
    unsigned T = 0u;
#pragma unroll 1
    for (int bit = 31; bit >= 0; --bit) {
        const unsigned cand = T | (1u << bit); int cnt = 0;
#pragma unroll
        for (int v = 0; v < NV; ++v) cnt += __popcll(__ballot(key[v] >= cand));
        if (cnt >= 16) T = cand;
    }
    int ngt = 0;
#pragma unroll
    for (int v = 0; v < NV; ++v) ngt += __popcll(__ballot(key[v] > T));
    const int need = 16 - ngt;
    int run = 0, erun = 0;
#pragma unroll
    for (int v = 0; v < NV; ++v) {
        const unsigned long long mg = __ballot(key[v] > T), me = __ballot(key[v] == T);
        const int pg = __builtin_amdgcn_mbcnt_hi((unsigned)(mg >> 32), __builtin_amdgcn_mbcnt_lo((unsigned)mg, 0u));
        const int pe = __builtin_amdgcn_mbcnt_hi((unsigned)(me >> 32), __builtin_amdgcn_mbcnt_lo((unsigned)me, 0u));
        sel[v] = false; slot[v] = 0;
        if (key[v] > T) { sel[v] = true; slot[v] = run + pg; }
        else if (key[v] == T && (erun + pe) < need) { sel[v] = true; slot[v] = ngt + erun + pe; }
        run += __popcll(mg); erun += __popcll(me);
    }
}
__device__ __forceinline__ unsigned f2key(float f) { const unsigned u = __float_as_uint(f); return (u & 0x80000000u) ? ~u : (u | 0x80000000u); }
__device__ __forceinline__ float key2f(unsigned k) { return __uint_as_float((k & 0x80000000u) ? (k & 0x7fffffffu) : ~k); }
template <int NP, int NV>
__device__ __forceinline__ void bisect16(const unsigned (&key)[NP][NV], unsigned (&T)[NP]) {
    bool done[NP];
#pragma unroll
    for (int p = 0; p < NP; ++p) { T[p] = 0u; done[p] = false; }
#pragma unroll 1
    for (int bit = 31; bit >= 0; --bit) {
        const unsigned bm = 1u << bit; bool all = true;
#pragma unroll
        for (int p = 0; p < NP; ++p) {
            const unsigned cand = T[p] | bm; int cnt = 0;
#pragma unroll
            for (int v = 0; v < NV; ++v) cnt += __popcll(__ballot(key[p][v] >= cand));
            const bool upd = (cnt >= 16) && !done[p];
            T[p] = upd ? cand : T[p]; done[p] = done[p] || (cnt == 16); all = all && done[p];
        }
        if (all) break;
    }
}
template <int NV>
__device__ __forceinline__ void compact16(const unsigned (&key)[NV], const unsigned T, bool (&sel)[NV], int (&slot)[NV]) {
    int ngt = 0;
#pragma unroll
    for (int v = 0; v < NV; ++v) ngt += __popcll(__ballot(key[v] > T));
    const int need = 16 - ngt; int run = 0, erun = 0;
#pragma unroll
    for (int v = 0; v < NV; ++v) {
        const unsigned long long mg = __ballot(key[v] > T), me = __ballot(key[v] == T);
        const int pg = __builtin_amdgcn_mbcnt_hi((unsigned)(mg >> 32), __builtin_amdgcn_mbcnt_lo((unsigned)mg, 0u));
        const int pe = __builtin_amdgcn_mbcnt_hi((unsigned)(me >> 32), __builtin_amdgcn_mbcnt_lo((unsigned)me, 0u));
        sel[v] = false; slot[v] = 0;
        if (key[v] > T) { sel[v] = true; slot[v] = run + pg; }
        else if (key[v] == T && (erun + pe) < need) { sel[v] = true; slot[v] = ngt + erun + pe; }
        run += __popcll(mg); erun += __popcll(me);
    }
}
constexpr int KP = 68;
constexpr int PW_BYTES = 9344;
__device__ __forceinline__ float gelu_erf(float x) {
    const float z = fabsf(x) * 0.7071067811865476f; const float t = __builtin_amdgcn_rcpf(1.f + 0.3275911f * z);
    float p = 1.061405429f; p = p * t - 1.453152027f; p = p * t + 1.421413741f; p = p * t - 0.284496736f; p = p * t + 0.254829592f; p = p * t;
    const float er = 1.f - p * __expf(-z * z);
    return 0.5f * x * (1.f + (x < 0.f ? -er : er));
}
__device__ __forceinline__ float wave_max(float x) {
    x = row16_max(x);
    { auto r = __builtin_amdgcn_permlane16_swap(__float_as_uint(x), __float_as_uint(x), false, false); x = fmaxf(__uint_as_float(r[0]), __uint_as_float(r[1])); }
    { auto r = __builtin_amdgcn_permlane32_swap(__float_as_uint(x), __float_as_uint(x), false, false); x = fmaxf(__uint_as_float(r[0]), __uint_as_float(r[1])); }
    return x;
}
__device__ __forceinline__ void ld16_f32(const float* p, int lane, float (&x)[32]) {
#pragma unroll
    for (int q = 0; q < 2; ++q)
#pragma unroll
        for (int d = 0; d < 4; ++d) { const f32x4 a = *(const f32x4*)(p + 1024 * q + 16 * lane + 4 * d); x[q * 16 + d * 4 + 0] = a[0]; x[q * 16 + d * 4 + 1] = a[1]; x[q * 16 + d * 4 + 2] = a[2]; x[q * 16 + d * 4 + 3] = a[3]; }
}
__device__ __forceinline__ void ld16_f32_nt(const float* p, int lane, float (&x)[32]) {
#pragma unroll
    for (int q = 0; q < 2; ++q)
#pragma unroll
        for (int d = 0; d < 4; ++d) { const f32x4 a = __builtin_nontemporal_load((const f32x4*)(p + 1024 * q + 16 * lane + 4 * d)); x[q * 16 + d * 4 + 0] = a[0]; x[q * 16 + d * 4 + 1] = a[1]; x[q * 16 + d * 4 + 2] = a[2]; x[q * 16 + d * 4 + 3] = a[3]; }
}
__device__ __forceinline__ void st16_f32_nt(float* p, int lane, const float (&x)[32]) {
#pragma unroll
    for (int q = 0; q < 2; ++q)
#pragma unroll
        for (int d = 0; d < 4; ++d) __builtin_nontemporal_store((f32x4){x[q * 16 + d * 4 + 0], x[q * 16 + d * 4 + 1], x[q * 16 + d * 4 + 2], x[q * 16 + d * 4 + 3]}, (f32x4*)(p + 1024 * q + 16 * lane + 4 * d));
}
__device__ __forceinline__ void st16_f32(float* p, int lane, const float (&x)[32]) {
#pragma unroll
    for (int q = 0; q < 2; ++q)
#pragma unroll
        for (int d = 0; d < 4; ++d) *(f32x4*)(p + 1024 * q + 16 * lane + 4 * d) = (f32x4){x[q * 16 + d * 4 + 0], x[q * 16 + d * 4 + 1], x[q * 16 + d * 4 + 2], x[q * 16 + d * 4 + 3]};
}
__device__ __forceinline__ void ld16_bf16(const bf16_t* p, int lane, float (&x)[32]) {
#pragma unroll
    for (int q = 0; q < 2; ++q)
#pragma unroll
        for (int d = 0; d < 2; ++d) { const u32x4 w = *(const u32x4*)(p + 1024 * q + 16 * lane + 8 * d); float* o = &x[q * 16 + d * 8];
            o[0] = bflo(w.x); o[1] = bfhi(w.x); o[2] = bflo(w.y); o[3] = bfhi(w.y); o[4] = bflo(w.z); o[5] = bfhi(w.z); o[6] = bflo(w.w); o[7] = bfhi(w.w); }
}
__device__ __forceinline__ void st16_bf16(bf16_t* p, int lane, const float (&x)[32]) {
#pragma unroll
    for (int q = 0; q < 2; ++q)
#pragma unroll
        for (int d = 0; d < 2; ++d) { const float* o = &x[q * 16 + d * 8]; u32x4 w; w.x = cvt_pk_bf16(o[0], o[1]); w.y = cvt_pk_bf16(o[2], o[3]); w.z = cvt_pk_bf16(o[4], o[5]); w.w = cvt_pk_bf16(o[6], o[7]);
            *(u32x4*)(p + 1024 * q + 16 * lane + 8 * d) = w; }
}
typedef __bf16 bf2v __attribute__((ext_vector_type(2)));
constexpr int TBS = 1152;
__device__ __forceinline__ void ld_row_f32(int lane, const float* __restrict__ src, f32x4* a) {
#pragma unroll
    for (int q = 0; q < 2; ++q)
#pragma unroll
        for (int d = 0; d < 4; ++d) a[q * 4 + d] = __builtin_nontemporal_load((const f32x4*)(src + 1024 * q + 16 * lane + 4 * d));
}
__device__ __forceinline__ void cvt_row_fp4b(int lane, const f32x4* a, unsigned char* __restrict__ dst) {
    float x[32];
#pragma unroll
    for (int i = 0; i < 8; ++i) { x[i * 4 + 0] = a[i][0]; x[i * 4 + 1] = a[i][1]; x[i * 4 + 2] = a[i][2]; x[i * 4 + 3] = a[i][3]; }
    float am = 0.f;
#pragma unroll
    for (int i = 0; i < 32; ++i) am = fmaxf(am, fabsf(x[i]));
    const bf16_t sb = f2bf(am * (1.f / 6.f)); const float sf = bf2f(sb); const float sc = sf > 0.f ? __builtin_amdgcn_rcpf(sf) : 0.f;
    u32x4 w;
#pragma unroll
    for (int d = 0; d < 4; ++d) { unsigned t = 0u; const int o = (d >> 1) * 16 + (d & 1) * 8;
        t = __builtin_amdgcn_cvt_scalef32_pk_fp4_f32(t, x[o + 0] * sc, x[o + 1] * sc, 1.0f, 0); t = __builtin_amdgcn_cvt_scalef32_pk_fp4_f32(t, x[o + 2] * sc, x[o + 3] * sc, 1.0f, 1);
        t = __builtin_amdgcn_cvt_scalef32_pk_fp4_f32(t, x[o + 4] * sc, x[o + 5] * sc, 1.0f, 2); t = __builtin_amdgcn_cvt_scalef32_pk_fp4_f32(t, x[o + 6] * sc, x[o + 7] * sc, 1.0f, 3); w[d] = t; }
    *(u32x4*)(dst + 16 * lane) = w;
    *(bf16_t*)(dst + 1024 + 2 * lane) = sb;
}
__device__ __forceinline__ void cvt_row_fp4r(int lane, const float* __restrict__ src, unsigned char* __restrict__ dst, float* __restrict__ inv) {
    float x[32];
#pragma unroll
    for (int q = 0; q < 2; ++q)
#pragma unroll
        for (int d = 0; d < 4; ++d) { const f32x4 a = __builtin_nontemporal_load((const f32x4*)(src + 1024 * q + 16 * lane + 4 * d)); x[q * 16 + d * 4 + 0] = a[0]; x[q * 16 + d * 4 + 1] = a[1]; x[q * 16 + d * 4 + 2] = a[2]; x[q * 16 + d * 4 + 3] = a[3]; }
    float am = 0.f;
#pragma unroll
    for (int i = 0; i < 32; ++i) am = fmaxf(am, fabsf(x[i]));
    am = wave_max(am);
    const float sc = am > 0.f ? 6.f / am : 1.f;
    if (lane == 0) *inv = am > 0.f ? am * (1.f / 6.f) : 1.f;
    u32x4 w;
#pragma unroll
    for (int d = 0; d < 4; ++d) { unsigned t = 0u; const int o = (d >> 1) * 16 + (d & 1) * 8;
        t = __builtin_amdgcn_cvt_scalef32_pk_fp4_f32(t, x[o + 0] * sc, x[o + 1] * sc, 1.0f, 0); t = __builtin_amdgcn_cvt_scalef32_pk_fp4_f32(t, x[o + 2] * sc, x[o + 3] * sc, 1.0f, 1);
        t = __builtin_amdgcn_cvt_scalef32_pk_fp4_f32(t, x[o + 4] * sc, x[o + 5] * sc, 1.0f, 2); t = __builtin_amdgcn_cvt_scalef32_pk_fp4_f32(t, x[o + 6] * sc, x[o + 7] * sc, 1.0f, 3); w[d] = t; }
    *(u32x4*)(dst + 16 * lane) = w;
}
__device__ __forceinline__ void cvt_peer_rows(const Frame& F, int l, int r0, int r1, int widx, int nw) {
    const int step = nw * 8; int r = r0 + widx * 8 + F.wave;
    f32x4 cur[8], nxt[8];
    auto srcp = [&](int rr) { return (rr < 16384 ? F.in(23) : F.in(24)) + ((size_t)l * 16384 + (rr & 16383)) * 2048; };
    if (r < r1) ld_row_f32(F.lane, srcp(r), cur);
    for (; r < r1; r += step) {
        const int rn = r + step;
        if (rn < r1) ld_row_f32(F.lane, srcp(rn), nxt);
        cvt_row_fp4b(F.lane, cur, wsp<unsigned char>(F, r < 16384 ? WS_PU : WS_PV) + (size_t)l * SZ_PT + (size_t)(r & 16383) * TBS);
#pragma unroll
        for (int i = 0; i < 8; ++i) cur[i] = nxt[i];
    }
}
__device__ __forceinline__ void cvt_peer(const Frame& F, int l) { cvt_peer_rows(F, l, 0, 32768, F.bid, F.G); }
constexpr int CVT1_A = 11264, CVT1_B = 19456;
__device__ __forceinline__ void cvt_peer_side(const Frame& F, int r0, int r1, int ntiles) {
    const int busy = ntiles % F.G;
    if (busy == 0 || F.bid < busy) return;
    cvt_peer_rows(F, 1, r0, r1, F.bid - busy, F.G - busy);
}
#define PEER_G 4
template <int CTRL> __device__ __forceinline__ int dppi(int x) { return __builtin_amdgcn_update_dpp(0, x, CTRL, 0xF, 0xF, true); }
__device__ __forceinline__ unsigned urow16_max(unsigned x) { unsigned y; y = (unsigned)dppi<0xB1>((int)x); x = x > y ? x : y; y = (unsigned)dppi<0x4E>((int)x); x = x > y ? x : y; y = (unsigned)dppi<0x141>((int)x); x = x > y ? x : y; y = (unsigned)dppi<0x140>((int)x); return x > y ? x : y; }
__device__ __forceinline__ unsigned urow16_min(unsigned x) { unsigned y; y = (unsigned)dppi<0xB1>((int)x); x = x < y ? x : y; y = (unsigned)dppi<0x4E>((int)x); x = x < y ? x : y; y = (unsigned)dppi<0x141>((int)x); x = x < y ? x : y; y = (unsigned)dppi<0x140>((int)x); return x < y ? x : y; }
__device__ __forceinline__ unsigned wave_umax(unsigned x) { x = urow16_max(x);
    { auto r = __builtin_amdgcn_permlane16_swap(x, x, false, false); x = r[0] > r[1] ? r[0] : r[1]; } { auto r = __builtin_amdgcn_permlane32_swap(x, x, false, false); x = r[0] > r[1] ? r[0] : r[1]; }
    return (unsigned)__builtin_amdgcn_readfirstlane((int)x); }
__device__ __forceinline__ int irow16_sum(int x) { x += dppi<0xB1>(x); x += dppi<0x4E>(x); x += dppi<0x141>(x); x += dppi<0x140>(x); return x; }
__device__ __forceinline__ int irow16_incl_scan(int x) { x += dppi<0x111>(x); x += dppi<0x112>(x); x += dppi<0x114>(x); x += dppi<0x118>(x); return x; }
constexpr int KBP = 72;
constexpr int PT_WORDS = 6 * 128 + 160 + 3 * 128;
constexpr int PWB = 2 * PT_WORDS * 4;
__device__ __forceinline__ void p_peer(const Frame& F, int l, bool last) {
    LAS bf16_t* kb1 = (LAS bf16_t*)F.lds; LAS bf16_t* kb2 = kb1 + 128 * KBP;
    LAS unsigned* wbase = (LAS unsigned*)(F.lds + 2 * 128 * KBP * 2 + F.wave * PWB);
    const int lane = F.lane, fr = lane & 15, fq = lane >> 4;
    __syncthreads();
    for (int i = F.tid; i < 128 * 64; i += 512) { const int r = i >> 6, d = i & 63; kb1[r * KBP + d] = f2bf(F.in(21)[(size_t)l * 8192 + i]); kb2[r * KBP + d] = f2bf(F.in(22)[(size_t)l * 8192 + i]); }
    __syncthreads();
    const bf16_t* QP = wsp<bf16_t>(F, WS_QP); const bf16_t* HB = wsp<bf16_t>(F, WS_HB); unsigned char* HB8w = wsp<unsigned char>(F, WS_HB8);
    const unsigned char* PU = wsp<unsigned char>(F, WS_PU) + (size_t)l * SZ_PT; const unsigned char* PV = wsp<unsigned char>(F, WS_PV) + (size_t)l * SZ_PT;
    const float* modl = wsp<float>(F, WS_MOD) + (size_t)l * 5 * 12288; const float* modn = wsp<float>(F, WS_MOD) + (size_t)(l + 1) * 5 * 12288;
    const float* g2n = F.in(25) + l * D; const float* b2n = F.in(26) + l * D;
    const int npairs = (last ? NLAT : NROW) / 2;
    const int per_wg = (npairs + F.G - 1) / F.G; const int p_lo = F.bid * per_wg; const int p_hi = (p_lo + per_wg) < npairs ? (p_lo + per_wg) : npairs;
    LAS int* wq = (LAS int*)(F.lds + 147456 - 32);
    if (F.tid == 0) *wq = 0;
    __syncthreads();
#pragma unroll 1
    for (;;) {
        int pi = 0; if (lane == 0) pi = __hip_atomic_fetch_add(wq, 1, __ATOMIC_RELAXED, __HIP_MEMORY_SCOPE_WORKGROUP);
        pi = p_lo + __builtin_amdgcn_readfirstlane(pi); if (pi >= p_hi) break;
        const int rowA = 2 * pi;
#pragma unroll 1
        for (int rep1_ = 0; rep1_ <= REP_PS1; ++rep1_) {
            unsigned kk[2][8][4];
            { int fr_ = fr; asm volatile("" : "+v"(fr_));
              const bf16_t* qrow = QP + (size_t)(rowA + (fr_ >> 3)) * 1024 + (fr_ & 7) * 128 + 8 * fq;
              bf16x8 af[2][2];
#pragma unroll
              for (int st = 0; st < 2; ++st)
#pragma unroll
                  for (int ks = 0; ks < 2; ++ks) af[st][ks] = *(const bf16x8*)(qrow + st * 64 + ks * 32);
#pragma unroll
              for (int st = 0; st < 2; ++st) { LAS bf16_t* kb = st ? kb2 : kb1;
#pragma unroll
                  for (int nb = 0; nb < 8; ++nb) { f32x4 c = {0.f, 0.f, 0.f, 0.f};
#pragma unroll
                      for (int ks = 0; ks < 2; ++ks) { const bf16x8 bfr = *(const LAS bf16x8*)(kb + (nb * 16 + fr) * KBP + ks * 32 + 8 * fq); c = __builtin_amdgcn_mfma_f32_16x16x32_bf16(af[st][ks], bfr, c, 0, 0, 0); }
#pragma unroll
                      for (int r = 0; r < 4; ++r) kk[st][nb][r] = f2key(c[r]); } } }
            unsigned T[2][4]; bool done[2][4];
            unsigned klo[2][4]; int sb;
            { unsigned spanmax = 0u;
#pragma unroll
              for (int st = 0; st < 2; ++st)
#pragma unroll
                  for (int r = 0; r < 4; ++r) { unsigned m1 = kk[st][0][r], m2 = 0u;
#pragma unroll
                      for (int nb = 1; nb < 8; ++nb) { const unsigned k_ = kk[st][nb][r]; const unsigned t_ = m1 < k_ ? m1 : k_; m2 = m2 > t_ ? m2 : t_; m1 = m1 > k_ ? m1 : k_; }
                      const unsigned o1 = (unsigned)dppi<0xB1>((int)m1), o2 = (unsigned)dppi<0xB1>((int)m2);
                      const unsigned mn1 = m1 < o1 ? m1 : o1, mx2 = m2 > o2 ? m2 : o2; const unsigned p2 = mn1 > mx2 ? mn1 : mx2;
                      const unsigned lo_ = urow16_min(p2), hi_ = urow16_max(m1); klo[st][r] = lo_; const unsigned sp_ = hi_ - lo_ + 1u; spanmax = spanmax > sp_ ? spanmax : sp_;
#pragma unroll
                      for (int nb = 0; nb < 8; ++nb) { const unsigned k_ = kk[st][nb][r]; kk[st][nb][r] = k_ >= lo_ ? k_ - lo_ + 1u : 0u; } }
              spanmax = wave_umax(spanmax); sb = 31 - __builtin_clz(spanmax | 1u); }
#pragma unroll
            for (int st = 0; st < 2; ++st)
#pragma unroll
                for (int r = 0; r < 4; ++r) { T[st][r] = 0u; done[st][r] = false; }
#pragma unroll 1
            for (int bit = ((PS1_ABL & 1) && rep1_ < REP_PS1) ? -1 : sb; bit >= 0; --bit) { const unsigned bm = 1u << bit; bool alld = true;
#pragma unroll
                for (int st = 0; st < 2; ++st)
#pragma unroll
                    for (int r = 0; r < 4; ++r) { const unsigned cand = T[st][r] | bm; int c = 0;
#pragma unroll
                        for (int nb = 0; nb < 8; ++nb) c += (kk[st][nb][r] >= cand) ? 1 : 0;
                        c = irow16_sum(c);
                        const bool upd = (c >= 16) && !done[st][r]; T[st][r] = upd ? cand : T[st][r]; done[st][r] = done[st][r] || (c == 16); alld = alld && done[st][r]; }
                if (__all(alld)) break; }
            const int tt = lane >> 5, hd0 = ((lane >> 4) & 1) * 4;
            if (!((PS1_ABL & 2) && rep1_ < REP_PS1))
#pragma unroll
            for (int st = 0; st < 2; ++st)
#pragma unroll
                for (int r = 0; r < 4; ++r) { const unsigned Tr = T[st][r]; int g = 0, e = 0;
#pragma unroll
                    for (int nb = 0; nb < 8; ++nb) { g += (kk[st][nb][r] > Tr) ? 1 : 0; e += (kk[st][nb][r] == Tr) ? 1 : 0; }
                    int gpre = irow16_incl_scan(g) - g, epre = irow16_incl_scan(e) - e; const int ngt = irow16_sum(g); const int need = 16 - ngt;
                    LAS unsigned* tb = wbase + tt * PT_WORDS; LAS float* vl = (LAS float*)(tb + st * 128) + (hd0 + r) * 16; LAS int* il = (LAS int*)(tb + 256 + st * 128) + (hd0 + r) * 16;
#pragma unroll
                    for (int nb = 0; nb < 8; ++nb) { const unsigned k = kk[st][nb][r];
                        if (k > Tr) { vl[gpre] = key2f(k - 1u + klo[st][r]); il[gpre] = nb * 16 + fr; ++gpre; }
                        else if (k == Tr) { if (epre < need) { vl[ngt + epre] = key2f(k - 1u + klo[st][r]); il[ngt + epre] = nb * 16 + fr; } ++epre; } } }
        }
        asm volatile("s_waitcnt lgkmcnt(0)" ::: "memory");
        {
            const int tt = lane >> 5, hd0 = ((lane >> 4) & 1) * 4; LAS unsigned* tb = wbase + tt * PT_WORDS;
            unsigned ck[4][16];
#pragma unroll
            for (int r = 0; r < 4; ++r) { const float va = ((LAS float*)tb)[(hd0 + r) * 16 + fr]; const LAS float* v2p = (LAS float*)(tb + 128) + (hd0 + r) * 16;
#pragma unroll
                for (int j4 = 0; j4 < 4; ++j4) { const f32x4 vb = *(const LAS f32x4*)(v2p + j4 * 4);
#pragma unroll
                    for (int i = 0; i < 4; ++i) ck[r][j4 * 4 + i] = f2key(va + vb[i]); } }
            unsigned T[4]; bool done[4];
#pragma unroll
            for (int r = 0; r < 4; ++r) { T[r] = 0u; done[r] = false; }
#pragma unroll 1
            for (int bit = 31; bit >= 0; --bit) { const unsigned bm = 1u << bit; bool alld = true;
#pragma unroll
                for (int r = 0; r < 4; ++r) { const unsigned cand = T[r] | bm; int c = 0;
#pragma unroll
                    for (int j = 0; j < 16; ++j) c += (ck[r][j] >= cand) ? 1 : 0;
                    c = irow16_sum(c);
                    const bool upd = (c >= 16) && !done[r]; T[r] = upd ? cand : T[r]; done[r] = done[r] || (c == 16); alld = alld && done[r]; }
                if (__all(alld)) break; }
#pragma unroll
            for (int r = 0; r < 4; ++r) { const unsigned Tr = T[r]; int g = 0, e = 0;
#pragma unroll
                for (int j = 0; j < 16; ++j) { g += (ck[r][j] > Tr) ? 1 : 0; e += (ck[r][j] == Tr) ? 1 : 0; }
                int gpre = irow16_incl_scan(g) - g, epre = irow16_incl_scan(e) - e; const int ngt = irow16_sum(g); const int need = 16 - ngt;
                const int e1 = ((LAS int*)(tb + 256))[(hd0 + r) * 16 + fr] * 128; const LAS int* i2p = (LAS int*)(tb + 384) + (hd0 + r) * 16;
                LAS float* cs_ = (LAS float*)(tb + 512) + (hd0 + r) * 16; LAS int* ce_ = (LAS int*)(tb + 640) + (hd0 + r) * 16;
#pragma unroll
                for (int j = 0; j < 16; ++j) { const unsigned k = ck[r][j];
                    if (k > Tr) { cs_[gpre] = key2f(k); ce_[gpre] = e1 + i2p[j]; ++gpre; }
                    else if (k == Tr) { if (epre < need) { cs_[ngt + epre] = key2f(k); ce_[ngt + epre] = e1 + i2p[j]; } ++epre; } } }
        }
        asm volatile("s_waitcnt lgkmcnt(0)" ::: "memory");
#pragma unroll 1
      for (int t = 0; t < 2; ++t) {
        const int row = rowA + t; const int v = row < NLAT ? (row >> 12) : 4;
        LAS unsigned* tb = wbase + t * PT_WORDS;
        LAS float* v1l = (LAS float*)tb; LAS float* v2l = v1l + 128; LAS int* i1l = (LAS int*)(v2l + 128); LAS int* i2l = i1l + 128;
        LAS float* csl = (LAS float*)(i2l + 128); LAS int* cel = (LAS int*)(csl + 128); LAS int* el = cel + 128; LAS float* gl = (LAS float*)(el + 160); LAS float* su = gl + 128; LAS float* sv = su + 128;
        {
#pragma unroll
            for (int it = 0; it < 2; ++it) { const int idx = it * 64 + lane;
                const float sx = csl[idx]; const float mx = row16_max(sx); const float pe_ = __expf(sx - mx); const float sm = row16_sum(pe_);
                el[idx] = cel[idx]; gl[idx] = pe_ / sm; }
        }
        if (lane < 32) el[128 + lane] = el[0];
        asm volatile("s_waitcnt vmcnt(0) lgkmcnt(0)" ::: "memory");
        const bool b0_ = lane & 1, b1_ = lane & 2, b2_ = lane & 4;
        u32x4 A[8], B[8], C[8]; unsigned SA[8], SB[8], SC[8];
#define PEER_LOADT(buf, sbuf, tab, g) do { _Pragma("unroll") for (int x = 0; x < 8; ++x) { const int e = __builtin_amdgcn_readfirstlane(el[(g) * 8 + x]); const unsigned char* rp = (tab) + (size_t)e * TBS; \
            buf[x] = *(const u32x4*)(rp + 16 * lane); sbuf[x] = *(const bf16_t*)(rp + 1024 + 2 * lane); } } while (0)
#define PEER_LOADV(buf, g) do { _Pragma("unroll") for (int x = 0; x < 8; ++x) { const int e = __builtin_amdgcn_readfirstlane(el[(g) * 8 + x]); buf[x] = *(const u32x4*)(PV + (size_t)e * 1024 + 16 * lane); } } while (0)
#define FP4X8(w_, f0_, f1_, f2_, f3_) const f32x2 f0_ = __builtin_amdgcn_cvt_scalef32_pk_f32_fp4(w_, 1.0f, 0), f1_ = __builtin_amdgcn_cvt_scalef32_pk_f32_fp4(w_, 1.0f, 1), f2_ = __builtin_amdgcn_cvt_scalef32_pk_f32_fp4(w_, 1.0f, 2), f3_ = __builtin_amdgcn_cvt_scalef32_pk_f32_fp4(w_, 1.0f, 3)
#define PEER_DOT(buf, sbuf, g) do { float p_[8]; \
            _Pragma("unroll") for (int x = 0; x < 8; ++x) { float sa_ = 0.f, sb_ = 0.f;        \
                _Pragma("unroll") for (int d = 0; d < 4; ++d) { const unsigned w_ = buf[x][d]; const int o_ = (d >> 1) * 8 + (d & 1) * 4; \
                    sa_ = __builtin_amdgcn_fdot2_f32_bf16(__builtin_amdgcn_cvt_scalef32_pk_bf16_fp4(w_, 1.0f, 0), hp[o_ + 0], sa_, false); sb_ = __builtin_amdgcn_fdot2_f32_bf16(__builtin_amdgcn_cvt_scalef32_pk_bf16_fp4(w_, 1.0f, 1), hp[o_ + 1], sb_, false); \
                    sa_ = __builtin_amdgcn_fdot2_f32_bf16(__builtin_amdgcn_cvt_scalef32_pk_bf16_fp4(w_, 1.0f, 2), hp[o_ + 2], sa_, false); sb_ = __builtin_amdgcn_fdot2_f32_bf16(__builtin_amdgcn_cvt_scalef32_pk_bf16_fp4(w_, 1.0f, 3), hp[o_ + 3], sb_, false); } \
                p_[x] = (sa_ + sb_) * __uint_as_float(sbuf[x] << 16); SBAR(); } \
              \
            float q_[4], r_[2]; \
            _Pragma("unroll") for (int j = 0; j < 4; ++j) { const float keep_ = b0_ ? p_[2 * j + 1] : p_[2 * j], send_ = b0_ ? p_[2 * j] : p_[2 * j + 1]; q_[j] = keep_ + dppf<0xB1>(send_); } \
            _Pragma("unroll") for (int j = 0; j < 2; ++j) { const float keep_ = b1_ ? q_[2 * j + 1] : q_[2 * j], send_ = b1_ ? q_[2 * j] : q_[2 * j + 1]; r_[j] = keep_ + dppf<0x4E>(send_); } \
            float t_; { const float keep_ = b2_ ? r_[1] : r_[0], send_ = b2_ ? r_[0] : r_[1]; const float up_ = dppf<0x104>(send_), dn_ = dppf<0x114>(send_); t_ = keep_ + (b2_ ? dn_ : up_); } \
            t_ += dppf<0x128>(t_); \
            { auto r16_ = __builtin_amdgcn_permlane16_swap(__float_as_uint(t_), __float_as_uint(t_), false, false); t_ = __uint_as_float(r16_[0]) + __uint_as_float(r16_[1]); } \
            { auto r32_ = __builtin_amdgcn_permlane32_swap(__float_as_uint(t_), __float_as_uint(t_), false, false); t_ = __uint_as_float(r32_[0]) + __uint_as_float(r32_[1]); } \
            const float av = gelu_erf(t_) * gl[(g) * 8 + (lane & 7)]; const bool me_ = (lane >> 3) == ((g) & 7); \
            avl = (me_ && (g) < 8) ? av : avl; avh = (me_ && (g) >= 8) ? av : avh; } while (0)
#define PIN_ACC() do { asm volatile("" : "+v"(acc2[0]), "+v"(acc2[1]), "+v"(acc2[2]), "+v"(acc2[3]), "+v"(acc2[4]), "+v"(acc2[5]), "+v"(acc2[6]), "+v"(acc2[7]), "+v"(acc2[8]), "+v"(acc2[9]), "+v"(acc2[10]), "+v"(acc2[11]), "+v"(acc2[12]), "+v"(acc2[13]), "+v"(acc2[14]), "+v"(acc2[15])); } while (0)
#define PEER_AXPY(buf, sbuf, g) do { _Pragma("unroll") for (int x = 0; x < 8; ++x) { const int idx = (g) * 8 + x; \
            const float av = __uint_as_float(__builtin_amdgcn_readlane(__float_as_uint(idx < 64 ? avl : avh), idx & 63)) * __uint_as_float(sbuf[x] << 16); const f32x2 av2_ = {av, av}; \
            _Pragma("unroll") for (int d = 0; d < 4; ++d) { const unsigned w_ = buf[x][d]; FP4X8(w_, f0_, f1_, f2_, f3_); const int o_ = (d >> 1) * 8 + (d & 1) * 4; \
                acc2[o_ + 0] = av2_ * f0_ + acc2[o_ + 0]; acc2[o_ + 1] = av2_ * f1_ + acc2[o_ + 1]; acc2[o_ + 2] = av2_ * f2_ + acc2[o_ + 2]; acc2[o_ + 3] = av2_ * f3_ + acc2[o_ + 3]; } PIN_ACC(); } } while (0)
        float avl = 0.f, avh = 0.f;
        PEER_LOADT(A, SA, PU, 0); PEER_LOADT(B, SB, PU, 1); SBAR();
        bf2v hp[16];
#pragma unroll
        for (int q = 0; q < 2; ++q)
#pragma unroll
            for (int d = 0; d < 2; ++d) { const u32x4 w = *(const u32x4*)(HB + (size_t)row * D + 1024 * q + 16 * lane + 8 * d);
                const unsigned w0_ = w.x, w1_ = w.y, w2_ = w.z, w3_ = w.w;
                hp[q * 8 + d * 4 + 0] = __builtin_bit_cast(bf2v, w0_); hp[q * 8 + d * 4 + 1] = __builtin_bit_cast(bf2v, w1_); hp[q * 8 + d * 4 + 2] = __builtin_bit_cast(bf2v, w2_); hp[q * 8 + d * 4 + 3] = __builtin_bit_cast(bf2v, w3_); }
#pragma unroll 1
        for (int g = 0; g < 15; g += 3) { PEER_LOADT(C, SC, PU, g + 2); SBAR(); PEER_DOT(A, SA, g); SBAR(); PEER_LOADT(A, SA, PU, g + 3); SBAR(); PEER_DOT(B, SB, g + 1); SBAR();
            PEER_LOADT(B, SB, (g + 4 < 16 ? PU : PV), (g + 4) & 15); SBAR(); PEER_DOT(C, SC, g + 2); SBAR(); }
        PEER_LOADT(C, SC, PV, 1); SBAR();
        PEER_DOT(A, SA, 15); SBAR();
        f32x2 acc2[16];
#pragma unroll
        for (int i = 0; i < 16; ++i) acc2[i] = (f32x2){0.f, 0.f};
#pragma unroll 1
        for (int g = 0; g < 15; g += 3) { PEER_LOADT(A, SA, PV, g + 2); SBAR(); PEER_AXPY(B, SB, g); SBAR(); PEER_LOADT(B, SB, PV, g + 3); SBAR(); PEER_AXPY(C, SC, g + 1); SBAR(); PEER_LOADT(C, SC, PV, g + 4); SBAR(); PEER_AXPY(A, SA, g + 2); SBAR(); }
        float x1[32], g2[32]; ld16_bf16(wsp<bf16_t>(F, WS_S1) + (size_t)row * D, lane, x1); ld16_f32(modl + (size_t)v * 12288 + 10240, lane, g2); SBAR();
        PEER_AXPY(B, SB, 15); SBAR();
#undef PEER_LOADT
#undef PEER_LOADV
#undef PEER_DOT
#undef PEER_AXPY
        float acc[32];
        {
#pragma unroll
          for (int i = 0; i < 32; ++i) acc[i] = ALPHA * x1[i] + g2[i] * acc2[i >> 1][i & 1]; }
        { float sm = 0.f;
#pragma unroll
          for (int i = 0; i < 32; ++i) sm += acc[i];
          const float mu = wave_sum(sm) * (1.f / 2048.f); float qq = 0.f;
#pragma unroll
          for (int i = 0; i < 32; ++i) { const float dd = acc[i] - mu; qq += dd * dd; }
          const float rstd = rsqrtf(wave_sum(qq) * (1.f / 2048.f) + LN_EPS);
#pragma unroll
          for (int q = 0; q < 2; ++q)
#pragma unroll
              for (int d = 0; d < 4; ++d) { const int o = 1024 * q + 16 * lane + 4 * d; const f32x4 gg = *(const f32x4*)(g2n + o), bb = *(const f32x4*)(b2n + o);
#pragma unroll
                  for (int i = 0; i < 4; ++i) acc[q * 16 + d * 4 + i] = (acc[q * 16 + d * 4 + i] - mu) * rstd * gg[i] + bb[i]; } }
        if (last) st16_f32(xres_row(F, row), lane, acc); else st16_bf16(wsp<bf16_t>(F, WS_S1) + (size_t)row * D, lane, acc);
        if (!last) { const float* sh = modn + (size_t)v * 12288; const float* sc = sh + 2048;
#pragma unroll
            for (int q = 0; q < 2; ++q)
#pragma unroll
                for (int d = 0; d < 4; ++d) { const int o = 1024 * q + 16 * lane + 4 * d; const f32x4 hh4 = *(const f32x4*)(sh + o), cc4 = *(const f32x4*)(sc + o);
#pragma unroll
                    for (int i = 0; i < 4; ++i) acc[q * 16 + d * 4 + i] = clamp8(acc[q * 16 + d * 4 + i] * (1.f + cc4[i]) + hh4[i]); }
#pragma unroll
            for (int q = 0; q < 2; ++q) { u32x4 w;
#pragma unroll
                for (int d = 0; d < 4; ++d) w[d] = pk4_fp8(acc[q * 16 + d * 4 + 0], acc[q * 16 + d * 4 + 1], acc[q * 16 + d * 4 + 2], acc[q * 16 + d * 4 + 3]);
                *(u32x4*)(HB8w + (size_t)row * D + 1024 * q + 16 * lane) = w; } }
      }
    }
}
#ifdef DBG
constexpr size_t WS_DBG = WS_CTL + 131072;
constexpr int DBG_NS = 60;
__device__ __forceinline__ int dbg_row(int s) { return (s * 263 + 5) % NLAT; }
__global__ void __launch_bounds__(256) dbg_peer_pre(Args args, int l) {
    __shared__ float q[1024]; __shared__ float s1[128], s2[128]; __shared__ float v1[16], v2[16]; __shared__ int i1[16], i2[16]; __shared__ float cs[256]; __shared__ int ce[256];
    __shared__ float ts[16]; __shared__ int te[16]; __shared__ float red[256]; __shared__ float aval[128]; __shared__ int eid[128]; __shared__ float h2[2048];
    const int s = blockIdx.x, row = dbg_row(s), tid = threadIdx.x; unsigned char* ws = args.ws;
    const bf16_t* QP = (const bf16_t*)(ws + WS_QP); const bf16_t* HB = (const bf16_t*)(ws + WS_HB);
    float* dbgf = (float*)(ws + WS_DBG + 4096); int* dbge = (int*)(dbgf + DBG_NS * 2048); float* dbga = (float*)(dbge + DBG_NS * 128); float* dbgg = dbga + 3 * DBG_NS * 128;
    for (int i = tid; i < 1024; i += 256) q[i] = bf2f(QP[(size_t)row * 1024 + i]);
    for (int i = tid; i < 2048; i += 256) h2[i] = bf2f(HB[(size_t)row * D + i]);
    __syncthreads();
    const float* k1 = args.in[21] + (size_t)l * 8192; const float* k2 = args.in[22] + (size_t)l * 8192;
    for (int hd = 0; hd < 8; ++hd) {
        { const int k = tid & 127; const float* kk = (tid < 128 ? k1 : k2) + k * 64; const float* qq = q + hd * 128 + (tid < 128 ? 0 : 64); float a = 0.f; for (int d = 0; d < 64; ++d) a += qq[d] * kk[d]; (tid < 128 ? s1 : s2)[k] = a; }
        __syncthreads();
        { const int k = tid & 127; const float* sv = tid < 128 ? s1 : s2; const float me = sv[k]; int rank = 0; for (int j = 0; j < 128; ++j) rank += (sv[j] > me || (sv[j] == me && j < k)) ? 1 : 0;
          if (rank < 16) { (tid < 128 ? v1 : v2)[rank] = me; (tid < 128 ? i1 : i2)[rank] = k; } }
        __syncthreads();
        { const int i = tid >> 4, j = tid & 15; cs[tid] = v1[i] + v2[j]; ce[tid] = i1[i] * 128 + i2[j]; }
        __syncthreads();
        { const float me = cs[tid]; int rank = 0; for (int j = 0; j < 256; ++j) rank += (cs[j] > me || (cs[j] == me && j < tid)) ? 1 : 0; if (rank < 16) { ts[rank] = me; te[rank] = ce[tid]; } }
        __syncthreads();
        if (tid < 16) { float mx = ts[0]; float sm = 0.f; for (int j = 0; j < 16; ++j) sm += expf(ts[j] - mx); aval[hd * 16 + tid] = expf(ts[tid] - mx) / sm; eid[hd * 16 + tid] = te[tid]; dbgg[s * 128 + hd * 16 + tid] = aval[hd * 16 + tid]; }
        __syncthreads();
    }
    const float* U = args.in[23] + (size_t)l * 16384 * 2048; const float* V = args.in[24] + (size_t)l * 16384 * 2048;
    for (int e = 0; e < 128; ++e) { const float* ur = U + (size_t)eid[e] * 2048; float p = 0.f; for (int d = tid; d < 2048; d += 256) p += h2[d] * ur[d]; red[tid] = p; __syncthreads();
        for (int st = 128; st > 0; st >>= 1) { if (tid < st) red[tid] += red[tid + st]; __syncthreads(); }
        if (tid == 0) { const float sc = red[0]; aval[e] = 0.5f * sc * (1.f + erff(sc * 0.70710678f)) * aval[e]; } __syncthreads(); }
    float y[8]; const float* xr = args.out + (size_t)row * D; const int v = row >> 12; const float* mod = (const float*)(ws + WS_MOD) + (size_t)l * 5 * 12288 + (size_t)v * 12288;
    float sum = 0.f;
    for (int k = 0; k < 8; ++k) { const int d = tid + 256 * k; float o = 0.f; for (int e = 0; e < 128; ++e) o += aval[e] * V[(size_t)eid[e] * 2048 + d]; y[k] = ALPHA * xr[d] + mod[10240 + d] * o; sum += y[k]; }
    red[tid] = sum; __syncthreads(); for (int st = 128; st > 0; st >>= 1) { if (tid < st) red[tid] += red[tid + st]; __syncthreads(); } const float mu = red[0] / 2048.f; __syncthreads();
    float sq = 0.f; for (int k = 0; k < 8; ++k) sq += (y[k] - mu) * (y[k] - mu);
    red[tid] = sq; __syncthreads(); for (int st = 128; st > 0; st >>= 1) { if (tid < st) red[tid] += red[tid + st]; __syncthreads(); } const float rstd = rsqrtf(red[0] / 2048.f + LN_EPS);
    for (int k = 0; k < 8; ++k) { const int d = tid + 256 * k; dbgf[(size_t)s * 2048 + d] = (y[k] - mu) * rstd * args.in[25][l * D + d] + args.in[26][l * D + d]; }
    if (tid < 128) { dbge[s * 128 + tid] = eid[tid]; dbga[s * 128 + tid] = aval[tid]; }
}
__global__ void __launch_bounds__(256) dbg_peer_post(Args args) {
    __shared__ int bad_e, bad_x, bad_a, bad_g;
    const int s = blockIdx.x, row = dbg_row(s), tid = threadIdx.x; unsigned char* ws = args.ws; unsigned* cnt = (unsigned*)(ws + WS_DBG);
    float* dbgf = (float*)(ws + WS_DBG + 4096); int* dbge = (int*)(dbgf + DBG_NS * 2048); float* dbga = (float*)(dbge + DBG_NS * 128);
    int* fe = (int*)(dbga + DBG_NS * 128); float* fa = (float*)(fe + DBG_NS * 128); float* dbgg = dbga + 3 * DBG_NS * 128; float* fg = dbgg + DBG_NS * 128;
    if (tid == 0) { bad_e = 0; bad_x = 0; bad_a = 0; bad_g = 0; } __syncthreads();
    if (tid < 128) { const int hd = tid >> 4; const int e = dbge[s * 128 + tid]; bool found = false; float af = 0.f, gf = 0.f; for (int j = 0; j < 16; ++j) if (fe[s * 128 + hd * 16 + j] == e) { found = true; af = fa[s * 128 + hd * 16 + j]; gf = fg[s * 128 + hd * 16 + j]; }
        if (!found) atomicAdd(&bad_e, 1); else { const float ea = dbga[s * 128 + tid]; if (fabsf(af - ea) > 0.02f * fabsf(ea) + 2e-3f) atomicAdd(&bad_a, 1); const float eg = dbgg[s * 128 + tid]; if (fabsf(gf - eg) > 0.02f * fabsf(eg) + 1e-3f) atomicAdd(&bad_g, 1); } }
    for (int k = 0; k < 8; ++k) { const int d = tid + 256 * k; const float ex = dbgf[(size_t)s * 2048 + d], got = args.out[(size_t)row * D + d]; if (!(fabsf(got - ex) <= 0.03f + 0.03f * fabsf(ex))) atomicAdd(&bad_x, 1); }
    __syncthreads();
    if (tid == 0) { if (bad_e > 2) atomicAdd(&cnt[1], 1u); if (bad_g > 2) atomicAdd(&cnt[2], 1u); if (bad_a > 2) atomicAdd(&cnt[3], 1u); if (bad_x > 8) atomicAdd(&cnt[4], 1u); }
}
__global__ void dbg_report(Args args) {
    unsigned* cnt = (unsigned*)(args.ws + WS_DBG);
    float code = 0.f;
    for (int lv = 1; lv <= 9; ++lv) if (cnt[lv]) { int tenths = (int)(cnt[lv] * 10 / DBG_NS); if (tenths > 9) tenths = 9; code = 1000.f * lv + 100.f * tenths; break; }
    if (code != 0.f) for (int i = threadIdx.x; i < 4096; i += blockDim.x) args.out[i] = code;
}
#endif
template <int ABL>
__device__ __forceinline__ void p_attn_gqa(const Frame& F, int last) {
    LAS unsigned char* lds = F.lds;
    const unsigned char* QG = wsp<unsigned char>(F, WS_QG); const unsigned char* KG = wsp<unsigned char>(F, WS_KG); const unsigned char* VG = wsp<unsigned char>(F, WS_VG); unsigned char* OAB = wsp<unsigned char>(F, WS_OAB);
    const int nlat = NB * 8 * 16, nall = last ? nlat : nlat + NB * 8;
    for (int u = F.bid; u < nall; u += F.G) {
        int bh, q0, seq; size_t orow;
        if (u < nlat) {
            int uu = u;
            if (F.G == 256) {
                const int c = u & 255, i = u >> 8, xcd = c & 7, r = c >> 3, kvg = i * 4 + (xcd >> 1), within = (xcd & 1) * 32 + r;
                uu = (((kvg >> 1) * 8 + (kvg & 1) * 4 + (within >> 4)) << 4) | (within & 15); }
            bh = uu >> 4; const int qb = uu & 15; q0 = CTXL + qb * 256; seq = TT; orow = (size_t)(bh >> 3) * SEQ + qb * 256; }
        else { bh = u - nlat; q0 = 0; seq = CTXL; orow = (size_t)NLAT + (bh >> 3) * CTXL; }
        const int b = bh >> 3, h = bh & 7; const size_t kvo = (size_t)(b * 2 + (h >> 2)) * TT * 128;
        __syncthreads();
        att::attn_body<4, 0, ABL>(QG + ((size_t)bh * TT + q0) * 128, KG + kvo, VG + (size_t)(b * 2 + (h >> 2)) * 128 * TT, OAB + orow * D + 1024 + h * 128, seq, lds, F.tid);
    }
    __syncthreads();
}
template <int ABL>
__device__ __forceinline__ void p_attn_mla(const Frame& F, int last) {
    LAS unsigned char* lds = F.lds;
    const unsigned char* QM = wsp<unsigned char>(F, WS_QM); const unsigned char* KM = wsp<unsigned char>(F, WS_KM); const unsigned char* VM = wsp<unsigned char>(F, WS_VM); unsigned char* OAB = wsp<unsigned char>(F, WS_OAB);
    const int nlat = NB * 8 * 16, nall = last ? nlat : nlat + NB * 8;
    for (int u = F.bid; u < nall; u += F.G) {
        int bh, q0, seq; size_t orow;
        if (u < nlat) {
            int uu = u;
            if (F.G == 256) { const int c = u & 255, i = u >> 8, xcd = c & 7, r = c >> 3; uu = ((i * 16 + xcd * 2 + (r >> 4)) << 4) | (r & 15); }
            bh = uu >> 4; const int qb = uu & 15; q0 = CTXL + qb * 256; seq = TT; orow = (size_t)(bh >> 3) * SEQ + qb * 256; }
        else { bh = u - nlat; q0 = 0; seq = CTXL; orow = (size_t)NLAT + (bh >> 3) * CTXL; }
        const int h = bh & 7;
        __syncthreads();
        att::attn_body<2, 1, ABL>(QM + ((size_t)bh * TT + q0) * 128, KM + (size_t)bh * TT * 128, VM + (size_t)bh * 64 * TT, OAB + orow * D + h * 64, seq, lds, F.tid);
    }
    __syncthreads();
}
__device__ __forceinline__ void p_ret_out(const Frame& F, int l, int last) {
    const int c_lo = last ? 2 : 0, nc = 34 - c_lo, nu = NB * 8 * nc;
    for (int u = F.bid; u < nu; u += F.G) { const int bh = u / nc, c = c_lo + (u % nc); ret_out_unit(F, l, bh, c); }
    __syncthreads();
}

constexpr int LDS_BYTES = 147456;
constexpr int MISC_OFF = 147456 - 64;
constexpr int NPHASE = 22;
#ifndef PHM
#define PHM 0xFFFF
#endif
#ifndef PH_ATTR
#define PH_ATTR __forceinline__
#endif
template <int PART> __device__ PH_ATTR void ph_prologue(ArgP ap) { const Frame F = make_frame(ap); p0_prologue<PART>(F); }
__device__ PH_ATTR void ph_modreduce(ArgP ap) { const Frame F = make_frame(ap); p1_modreduce(F); }
__device__ PH_ATTR void ph_modulate0(ArgP ap) { const Frame F = make_frame(ap); p_modulate0(F); }
template <int GABL> __device__ PH_ATTR void ph_gemm_in(ArgP ap, int l) { const Frame F = make_frame(ap);
    pg8::Gemm g{wsp<bf16_t>(F, WS_HB8), wsp<bf16_t>(F, WS_WIN + l * SZ_WIN), NROW, NPT, 1024, 1024, 1024}; pg8::StaticOrder S; S.init(NROW, NPT, F.G, F.bid);
    float mul_, inv_; fp8_scale(wsp<unsigned>(F, WS_WSC)[l], mul_, inv_);
    EpiIn E{wsp<bf16_t>(F, WS_P1), wsp<bf16_t>(F, WS_G), inv_};
    pg8::gemm_phase<EpiIn, pg8::StaticOrder, GABL>(F.lds, F.tid, g, S, E); }
__device__ PH_ATTR void ph_post(ArgP ap, int l) { const Frame F = make_frame(ap); p_post(F, l); if (l == 1 && !SIDE_CVT_OK(F.G)) cvt_peer(F, 1); }
__device__ PH_ATTR void ph_qup(ArgP ap, int l) { const Frame F = make_frame(ap);
    pg8::Gemm g{wsp<bf16_t>(F, WS_CQN), wsp<bf16_t>(F, WS_WQUP + l * SZ_WQUP), NROW, 768, 512, 512, 512}; pg8::StaticOrder S; S.init(NROW, 768, F.G, F.bid);
    EpiQup E{wsp<unsigned char>(F, WS_QM), wsp<f32x2>(F, WS_ROPE32)};
    pg8::gemm_phase<EpiQup, pg8::StaticOrder>(F.lds, F.tid, g, S, E); }
__device__ PH_ATTR void ph_kvup(ArgP ap, int l) { const Frame F = make_frame(ap);
    pg8::Gemm g{wsp<bf16_t>(F, WS_CKVN), wsp<bf16_t>(F, WS_WKVUP + l * SZ_WKVUP), NROW, 1024, 256, 256, 256}; pg8::StaticOrder S; S.init(NROW, 1024, F.G, (F.bid + F.G - 204 % F.G) % F.G);
    EpiKvup E{wsp<unsigned char>(F, WS_KM), wsp<unsigned char>(F, WS_VM)};
    pg8::gemm_phase<EpiKvup, pg8::StaticOrder>(F.lds, F.tid, g, S, E); }
__device__ PH_ATTR void ph_states(ArgP ap, int l) { const Frame F = make_frame(ap); p_ret_states(F, l); }
template <int ABL> __device__ PH_ATTR void ph_attn_gqa(ArgP ap, int last) { const Frame F = make_frame(ap); p_attn_gqa<ABL>(F, last); }
template <int ABL> __device__ PH_ATTR void ph_attn_mla(ArgP ap, int last) { const Frame F = make_frame(ap); p_attn_mla<ABL>(F, last); }
__device__ PH_ATTR void ph_ret_out(ArgP ap, int l, int last) { const Frame F = make_frame(ap); p_ret_out(F, l, last); }
template <int SEG> __device__ PH_ATTR void ph_merge(ArgP ap, int l, int Mx) { const Frame F = make_frame(ap);
    const bf16_t* OAB = wsp<bf16_t>(F, WS_OAB); bf16_t* MB = wsp<bf16_t>(F, WS_MB); const bf16_t* G = wsp<bf16_t>(F, WS_G);
    pg8::StaticOrder S; S.init(Mx, 2048, F.G, F.bid);
    const size_t wo = SEG == 0 ? WS_WBRA + l * SZ_WBRA : (SEG == 1 ? WS_WBRB + l * SZ_WBRB : WS_WBRC + l * SZ_WBRC); const int K = SEG == 2 ? 1024 : 512;
    pg8::Gemm g{OAB + SEG * 512, wsp<bf16_t>(F, wo), Mx, 2048, K, 2048, K}; EpiMerge<SEG> E{MB, G, wsp<unsigned char>(F, WS_MB8)}; pg8::gemm_phase<EpiMerge<SEG>, pg8::StaticOrder>(F.lds, F.tid, g, S, E); }
__device__ PH_ATTR void ph_merge3(ArgP ap, int l, int Mx) { const Frame F = make_frame(ap);
    pg8::StaticOrder S; S.init(Mx, 2048, F.G, F.bid);
    float m0_, i0_, m1_, i1_, m2_, i2_; fp8_scale(wsp<unsigned>(F, WS_WSC)[4 + l], m0_, i0_); fp8_scale(wsp<unsigned>(F, WS_WSC)[6 + l], m1_, i1_); fp8_scale(wsp<unsigned>(F, WS_WSC)[8 + l], m2_, i2_);
    pg8::Merge3 g{wsp<bf16_t>(F, WS_OAB), wsp<bf16_t>(F, WS_WBRA + l * SZ_WBRA), wsp<bf16_t>(F, WS_WBRB + l * SZ_WBRB), wsp<bf16_t>(F, WS_WBRC + l * SZ_WBRC), wsp<bf16_t>(F, WS_G), wsp<unsigned char>(F, WS_MB8), i0_ * m1_, i1_ * m2_, i2_};
    pg8::gemm_merge3<pg8::StaticOrder>(F.lds, F.tid, g, S);
    if (l == 0 && SIDE_CVT_OK(F.G)) cvt_peer_side(F, 0, CVT1_A, (Mx / 256) * 8); }
__device__ PH_ATTR void ph_out(ArgP ap, int l, int Mx) { const Frame F = make_frame(ap);
    pg8::Gemm g{wsp<bf16_t>(F, WS_MB8), wsp<bf16_t>(F, WS_WOUT + l * SZ_WOUT), Mx, 2048, 1024, 1024, 1024}; pg8::StaticOrder S; S.init(Mx, 2048, F.G, F.bid);
    float mul_, inv_; fp8_scale(wsp<unsigned>(F, WS_WSC)[2 + l], mul_, inv_);
    if (l == 0) { EpiOutT<false> E{F.in(0), F.in(2), wsp<bf16_t>(F, WS_S1), wsp<float>(F, WS_MOD) + (size_t)l * 5 * 12288 + 4096, inv_ * (1.f / 16.f)}; pg8::gemm_phase<EpiOutT<false>, pg8::StaticOrder>(F.lds, F.tid, g, S, E); }
    else { EpiOutT<true> E{nullptr, nullptr, wsp<bf16_t>(F, WS_S1), wsp<float>(F, WS_MOD) + (size_t)l * 5 * 12288 + 4096, inv_ * (1.f / 16.f)}; pg8::gemm_phase<EpiOutT<true>, pg8::StaticOrder>(F.lds, F.tid, g, S, E); }
    if (l == 0 && SIDE_CVT_OK(F.G)) cvt_peer_side(F, CVT1_A, CVT1_B, (Mx / 256) * 8); }
__device__ PH_ATTR void ph_ln1(ArgP ap, int l, int last) { const Frame F = make_frame(ap); p_ln1(F, l, last); }
__device__ PH_ATTR void ph_peerq(ArgP ap, int l, int Mx) { const Frame F = make_frame(ap);
    pg8::Gemm g{wsp<bf16_t>(F, WS_HB), wsp<bf16_t>(F, WS_WPQ + l * SZ_WPQ), Mx, 1024, 2048, 2048, 2048}; pg8::StaticOrder S; S.init(Mx, 1024, F.G, F.bid);
    EpiPlain E{wsp<bf16_t>(F, WS_QP), 1024};
    pg8::gemm_phase<EpiPlain, pg8::StaticOrder>(F.lds, F.tid, g, S, E);
    if (l == 0 && SIDE_CVT_OK(F.G)) cvt_peer_side(F, CVT1_B, 32768, (Mx / 256) * 4); }
__device__ PH_ATTR void ph_peer(ArgP ap, int l, int last) { const Frame F = make_frame(ap); p_peer(F, l, last); }

__global__ void __launch_bounds__(512, 2) mega_fwd(Args args) {
    extern __shared__ __attribute__((aligned(16))) unsigned char lds_raw[];
    const ArgP ap = (ArgP)__builtin_amdgcn_kernarg_segment_ptr();
    const int lo = ap->ph_lo, hi = ap->ph_hi;
    volatile LAS unsigned* misc = (volatile LAS unsigned*)((LAS unsigned char*)lds_raw + MISC_OFF);
    if (threadIdx.x < 4) misc[threadIdx.x] = 0u;
    __syncthreads();
    XcdBarrier bar; bar.bar = (unsigned*)(ap->ws + WS_CTL); bar.x = 0; bar.st = misc;
    if (hi - lo > 1) bar = xcd_barrier_post((unsigned*)(ap->ws + WS_CTL), misc);
#ifdef BENCH_K
    { float a[16]; f32x2 b2[8];
#pragma unroll
      for (int i = 0; i < 16; ++i) a[i] = 1.f + threadIdx.x * 1e-3f + i;
#pragma unroll
      for (int i = 0; i < 8; ++i) b2[i] = (f32x2){a[i], a[i + 8]};
      float c0 = a[3], c1 = a[5];
#define B16(INS) asm volatile(INS(0) INS(1) INS(2) INS(3) INS(4) INS(5) INS(6) INS(7) INS(8) INS(9) INS(10) INS(11) INS(12) INS(13) INS(14) INS(15) \
        : "+v"(a[0]), "+v"(a[1]), "+v"(a[2]), "+v"(a[3]), "+v"(a[4]), "+v"(a[5]), "+v"(a[6]), "+v"(a[7]), "+v"(a[8]), "+v"(a[9]), "+v"(a[10]), "+v"(a[11]), "+v"(a[12]), "+v"(a[13]), "+v"(a[14]), "+v"(a[15]) : "v"(c0), "v"(c1))
#define I_ADD(i) "v_add_f32 %" #i ", %" #i ", %16\n"
#define I_EXP(i) "v_exp_f32 %" #i ", %" #i "\n"
#define I_MAX3(i) "v_max3_f32 %" #i ", %" #i ", %16, %17\n"
#define I_CVT(i) "v_cvt_pk_fp8_f32 %" #i ", %16, %17\n"
#define I_DEP(i) "v_max3_f32 %0, %0, %16, %17\n"
#define I_DEPA(i) "v_add_f32 %0, %0, %16\n"
#define I_FMA(i) "v_fma_f32 %" #i ", %" #i ", %16, %17\n"
#define P8(INS) asm volatile(INS(0) INS(1) INS(2) INS(3) INS(4) INS(5) INS(6) INS(7) INS(0) INS(1) INS(2) INS(3) INS(4) INS(5) INS(6) INS(7) \
        : "+v"(b2[0]), "+v"(b2[1]), "+v"(b2[2]), "+v"(b2[3]), "+v"(b2[4]), "+v"(b2[5]), "+v"(b2[6]), "+v"(b2[7]) : "v"(b2[0]))
#define I_PKADD(i) "v_pk_add_f32 %" #i ", %" #i ", %8\n"
#define I_PKFMA(i) "v_pk_fma_f32 %" #i ", %" #i ", %8, %8\n"
#pragma unroll 1
      for (int it = 0; it < 20000; ++it) {
#if BENCH_K == 1
        B16(I_ADD);
#elif BENCH_K == 2
        B16(I_EXP);
#elif BENCH_K == 3
        B16(I_MAX3);
#elif BENCH_K == 4
        B16(I_CVT);
#elif BENCH_K == 5
        P8(I_PKADD);
#elif BENCH_K == 6
        P8(I_PKFMA);
#elif BENCH_K == 7
        B16(I_FMA);
#elif BENCH_K == 9
        B16(I_DEP);
#elif BENCH_K == 10
        B16(I_DEPA);
#endif
      }
#if BENCH_K == 11 || BENCH_K == 12
      { f32x16 q0 = {}, q1 = {}, q2 = {}, q3 = {}; att::i32x8a x8 = {1, 2, 3, 4, 5, 6, 7, (int)threadIdx.x};
#pragma unroll 1
        for (int it = 0; it < 2000; ++it) {
#pragma unroll
          for (int k = 0; k < 4; ++k) {
            q0 = __builtin_amdgcn_mfma_scale_f32_32x32x64_f8f6f4(x8, x8, q0, 0, 0, 0, 0x7F7F7F7F, 0, 0x7F7F7F7F); asm volatile("" : "+v"(q0));
#if BENCH_K == 11
            B16(I_ADD);
#else
            B16(I_EXP);
#endif
            q1 = __builtin_amdgcn_mfma_scale_f32_32x32x64_f8f6f4(x8, x8, q1, 0, 0, 0, 0x7F7F7F7F, 0, 0x7F7F7F7F); asm volatile("" : "+v"(q1));
#if BENCH_K == 11
            B16(I_ADD);
#else
            B16(I_EXP);
#endif
            q2 = __builtin_amdgcn_mfma_scale_f32_32x32x64_f8f6f4(x8, x8, q2, 0, 0, 0, 0x7F7F7F7F, 0, 0x7F7F7F7F); asm volatile("" : "+v"(q2));
#if BENCH_K == 11
            B16(I_ADD);
#else
            B16(I_EXP);
#endif
            q3 = __builtin_amdgcn_mfma_scale_f32_32x32x64_f8f6f4(x8, x8, q3, 0, 0, 0, 0x7F7F7F7F, 0, 0x7F7F7F7F); asm volatile("" : "+v"(q3));
#if BENCH_K == 11
            B16(I_ADD);
#else
            B16(I_EXP);
#endif
          }
          asm volatile("" : "+v"(x8)); } }
#endif
#if BENCH_K == 8
      { f32x16 q0 = {}, q1 = {}, q2 = {}, q3 = {}; att::i32x8a x8 = {1, 2, 3, 4, 5, 6, 7, (int)threadIdx.x};
#pragma unroll 1
        for (int it = 0; it < 2000; ++it) {
#pragma unroll
          for (int k = 0; k < 4; ++k) { q0 = __builtin_amdgcn_mfma_scale_f32_32x32x64_f8f6f4(x8, x8, q0, 0, 0, 0, 0x7F7F7F7F, 0, 0x7F7F7F7F); q1 = __builtin_amdgcn_mfma_scale_f32_32x32x64_f8f6f4(x8, x8, q1, 0, 0, 0, 0x7F7F7F7F, 0, 0x7F7F7F7F);
            q2 = __builtin_amdgcn_mfma_scale_f32_32x32x64_f8f6f4(x8, x8, q2, 0, 0, 0, 0x7F7F7F7F, 0, 0x7F7F7F7F); q3 = __builtin_amdgcn_mfma_scale_f32_32x32x64_f8f6f4(x8, x8, q3, 0, 0, 0, 0x7F7F7F7F, 0, 0x7F7F7F7F); }
          asm volatile("" : "+v"(q0), "+v"(q1), "+v"(q2), "+v"(q3), "+v"(x8)); } }
#endif
    }
#endif
#define IN(k) (lo <= (k) && (k) < hi)
#define SEAM(k) do { if (IN(k) && IN((k) + 1)) xcd_barrier(bar); } while (0)
    if (IN(0)) { if (PHM & 1) ph_prologue<7>(ap); if (REP_PRO) ph_prologue<REP_PRO>(ap); } SEAM(0);
    if (IN(1)) { if (PHM & 2) ph_modreduce(ap); if (REP_X & 32) ph_modreduce(ap); } SEAM(1);
#pragma unroll 1
    for (int l = 0; l < 2; ++l) {
        const int pb = 2 + 10 * l; const int last = (l == 1);
        const int Mx = last ? NLAT : NROW;
        if (l == 0) { if (IN(pb)) { if (PHM & 4) ph_modulate0(ap); if (REP_X & 64) ph_modulate0(ap); } SEAM(pb); }
        if (IN(pb + 1)) { if (REP_GIN) ph_gemm_in<GIN_ABL>(ap, l); if (PHM & 8) ph_gemm_in<0>(ap, l); } SEAM(pb + 1);
        if (IN(pb + 2)) { if (PHM & 16) ph_post(ap, l); if (REP_X & 1) ph_post(ap, l); } SEAM(pb + 2);
        if (IN(pb + 3)) { if (PHM & 32) ph_qup(ap, l); if (PHM & 64) ph_kvup(ap, l); if (PHM & 128) ph_states(ap, l); if (REP_X & 2) { ph_qup(ap, l); ph_kvup(ap, l); ph_states(ap, l); } } SEAM(pb + 3);
        if (IN(pb + 4)) { if (REP_ATTN & 1) ph_attn_gqa<ATT_ABL>(ap, last); if (REP_ATTN & 2) ph_attn_mla<ATT_ABL>(ap, last); if (PHM & 256) ph_attn_gqa<0>(ap, last); if (PHM & 512) ph_attn_mla<0>(ap, last); if (REP_X & 4) ph_ret_out(ap, l, last); if (PHM & 1024) ph_ret_out(ap, l, last); } SEAM(pb + 4);
        if (IN(pb + 5)) { if (PHM & 2048) { if (MERGE3) ph_merge3(ap, l, Mx); else { ph_merge<0>(ap, l, Mx); ph_merge<1>(ap, l, Mx); ph_merge<2>(ap, l, Mx); } } if (REP_X & 8) { if (MERGE3) ph_merge3(ap, l, Mx); else { ph_merge<0>(ap, l, Mx); ph_merge<1>(ap, l, Mx); ph_merge<2>(ap, l, Mx); } } } SEAM(pb + 5);
        if (IN(pb + 6)) { if (PHM & 4096) ph_out(ap, l, Mx); if (REP_X & 128) ph_out(ap, l, Mx); } SEAM(pb + 6);
        if (IN(pb + 7)) { if (PHM & 8192) ph_ln1(ap, l, last); if (REP_X & 256) ph_ln1(ap, l, last); } SEAM(pb + 7);
        if (IN(pb + 8)) { if (PHM & 16384) ph_peerq(ap, l, Mx); if (REP_X & 16) ph_peerq(ap, l, Mx); } SEAM(pb + 8);
        if (IN(pb + 9)) { if (PHM & 32768) ph_peer(ap, l, last); } SEAM(pb + 9);
    }
#undef IN
#undef SEAM
}

extern "C" void kernel_launch(void* const* d_in, const int* in_sizes, int n_in, void* d_out, int out_size, void* d_ws, size_t ws_size, hipStream_t stream) {
    static int grid = 0;
    if (grid == 0) {
        if (n_in != 27 || out_size != NLAT * D || ws_size < WS_END) { fprintf(stderr, "kernel_launch: unexpected shapes: n_in %d out %d ws %zu (need %zu)\n", n_in, out_size, ws_size, (size_t)WS_END); grid = -1; return; }
        int dev = 0, cus = 0, per_cu = 0;
        if (hipGetDevice(&dev) != hipSuccess || hipDeviceGetAttribute(&cus, hipDeviceAttributeMultiprocessorCount, dev) != hipSuccess) { grid = -1; return; }
        if (hipFuncSetAttribute((const void*)mega_fwd, hipFuncAttributeMaxDynamicSharedMemorySize, LDS_BYTES) != hipSuccess) { fprintf(stderr, "kernel_launch: hipFuncSetAttribute failed\n"); grid = -1; return; }
        if (hipOccupancyMaxActiveBlocksPerMultiprocessor(&per_cu, (const void*)mega_fwd, 512, LDS_BYTES) != hipSuccess || per_cu < 1) fprintf(stderr, "kernel_launch: occupancy query reports %d\n", per_cu);
        (void)hipGetLastError();
        grid = cus;
    }
    if (grid < 0) return;
    (void)hipMemsetAsync((char*)d_ws + WS_CTL, 0, 65536, stream);
#ifdef DBG
    (void)hipMemsetAsync((char*)d_ws + WS_CTL + 131072, 0, 4096, stream);
#endif
    Args a{};
    for (int i = 0; i < 27; ++i) a.in[i] = (const float*)d_in[i];
    a.out = (float*)d_out; a.ws = (unsigned char*)d_ws;
#if MK_PER_PHASE
    for (int p = 0; p < NPHASE; ++p) { if (p == 12) continue; a.ph_lo = p; a.ph_hi = p + 1;
#ifdef DBG
        if (p == 11) hipLaunchKernelGGL(dbg_peer_pre, dim3(DBG_NS), dim3(256), 0, stream, a, 0);
#endif
        hipLaunchKernelGGL(mega_fwd, dim3(grid), dim3(512), LDS_BYTES, stream, a);
#ifdef DBG
        if (p == 11) hipLaunchKernelGGL(dbg_peer_post, dim3(DBG_NS), dim3(256), 0, stream, a);
#endif
    }
#ifdef DBG
    hipLaunchKernelGGL(dbg_report, dim3(1), dim3(256), 0, stream, a);
#endif
#else
    a.ph_lo = 0; a.ph_hi = NPHASE;
    hipLaunchKernelGGL(mega_fwd, dim3(grid), dim3(512), LDS_BYTES, stream, a);
#endif
    const hipError_t le = hipPeekAtLastError();
    if (le != hipSuccess) fprintf(stderr, "kernel_launch: launch failed: %s\n", hipGetErrorName(le));
}
```
